# Optimizing an MI355X kernel written in HIP

```python
import jax, jax.numpy as jnp
from jax import lax
import numpy as np

D_MODEL = 1024
BATCH = 16
SEQ = 2048
DEPTH = 2

CHUNK = 64
N_MIXERS = 2
N_GLA_LAYERS = (DEPTH + 1) // 2
N_SGU_LAYERS = DEPTH // 2
EPS = 1e-6

GLA_HEADS = 4
GLA_DK = D_MODEL // 2 // GLA_HEADS
GLA_DV = D_MODEL // GLA_HEADS
GLA_HK = GLA_HEADS * GLA_DK
GLA_HV = GLA_HEADS * GLA_DV
GLA_GATE_RANK = 16
GLA_TAU = 16.0
GLA_IN = 2 * GLA_HK + 2 * GLA_HV + GLA_GATE_RANK

SGU_BLOCK = 128
SGU_GROUPS = 4
SGU_FFN = 4 * D_MODEL
SGU_HALF = SGU_FFN // 2
SGU_GC = SGU_HALF // SGU_GROUPS

N_GROUPS = 4
EXPERTS_PER_GROUP = 8
N_EXPERTS = N_GROUPS * EXPERTS_PER_GROUP
TOP_K = 2
EXPERT_FF = D_MODEL // 2
ROUTE_BLOCK = 128

kernel_name = "hybrid_gla_sgu_hier_moe"


def rmsnorm(x, g):
    xf = x.astype(jnp.float32)
    y = xf * lax.rsqrt(jnp.mean(xf * xf, axis=-1, keepdims=True) + EPS)
    return (y * g.astype(jnp.float32)).astype(x.dtype)


def layernorm(x, g, b):
    xf = x.astype(jnp.float32)
    mu = jnp.mean(xf, axis=-1, keepdims=True)
    xc = xf - mu
    y = xc * lax.rsqrt(jnp.mean(xc * xc, axis=-1, keepdims=True) + EPS)
    return (y * g.astype(jnp.float32) + b.astype(jnp.float32)).astype(x.dtype)


def gla_mixer(h, w_in, w_gate_up, b_gate, head_g, w_out):
    B, S, _ = h.shape
    N = S // CHUNK
    proj = h @ w_in
    q, k, v, r, glr = jnp.split(
        proj, [GLA_HK, 2 * GLA_HK, 2 * GLA_HK + GLA_HV, 2 * GLA_HK + 2 * GLA_HV], axis=-1)
    log_a = jax.nn.log_sigmoid((glr @ w_gate_up + b_gate).astype(jnp.float32)) / GLA_TAU
    scale = GLA_DK ** -0.5

    def to_chunks(t, d):
        return t.astype(jnp.float32).reshape(B, N, CHUNK, GLA_HEADS, d).transpose(1, 0, 3, 2, 4)

    qc = to_chunks(q, GLA_DK) * scale
    kc = to_chunks(k, GLA_DK)
    vc = to_chunks(v, GLA_DV)
    gc = to_chunks(log_a, GLA_DK)

    def step(state, inp):
        q_, k_, v_, g_ = inp
        b = jnp.cumsum(g_, axis=2)
        b_end = b[:, :, -1:, :]
        k_dec = k_ * jnp.exp(b_end - b)
        att = jnp.einsum('bhtk,bhsk->bhts', q_, k_dec)
        o = (jnp.einsum('bhtk,bhkv->bhtv', q_ * jnp.exp(b_end), state)
             + jnp.einsum('bhts,bhsv->bhtv', att, v_))
        new_state = (jnp.exp(b_end)[:, :, 0, :, None] * state
                     + jnp.einsum('bhsk,bhsv->bhkv', k_dec, v_))
        return new_state, o

    s0 = jnp.zeros((B, GLA_HEADS, GLA_DK, GLA_DV), jnp.float32)
    _, o = lax.scan(step, s0, (qc, kc, vc, gc))
    o = o.transpose(1, 0, 3, 2, 4).reshape(B, S, GLA_HEADS, GLA_DV)
    o = rmsnorm(o, head_g).reshape(B, S, GLA_HV)
    o = o * jax.nn.silu(r.astype(jnp.float32))
    return o.astype(h.dtype) @ w_out


def sgu_mixer(h, w_in, ln_g, ln_b, w_s, b_s, w_out):
    B, S, _ = h.shape
    z = jax.nn.gelu(h @ w_in, approximate=False)
    u, v = jnp.split(z, 2, axis=-1)
    v = layernorm(v, ln_g, ln_b)
    pos = jnp.arange(SGU_BLOCK)
    mask = (pos[:, None] // CHUNK) >= (pos[None, :] // CHUNK)
    ws = jnp.where(mask[None], w_s, jnp.zeros_like(w_s))
    vb = v.reshape(B, S // SGU_BLOCK, SGU_BLOCK, SGU_GROUPS, SGU_GC)
    mixed = jnp.einsum('gts,bnsgc->bntgc', ws, vb) + b_s.T[None, None, :, :, None]
    out = u * mixed.reshape(B, S, SGU_HALF)
    return out @ w_out


def routed_experts(xt, expert, gate, w1, w3, w2):
    T, D = xt.shape
    A = T * TOP_K
    NB = -(-A // ROUTE_BLOCK) + N_EXPERTS
    flat_e = expert.reshape(A).astype(jnp.int32)
    flat_tok = jnp.arange(A, dtype=jnp.int32) // TOP_K
    flat_gate = gate.reshape(A)
    order = jnp.argsort(flat_e)
    e_sorted = flat_e[order]
    counts = jnp.bincount(flat_e, length=N_EXPERTS).astype(jnp.int32)
    padded = ((counts + ROUTE_BLOCK - 1) // ROUTE_BLOCK) * ROUTE_BLOCK
    pad_end = jnp.cumsum(padded)
    pad_start = pad_end - padded
    start = jnp.cumsum(counts) - counts
    dest = pad_start[e_sorted] + jnp.arange(A, dtype=jnp.int32) - start[e_sorted]
    buf_tok = jnp.full((NB * ROUTE_BLOCK,), T, jnp.int32).at[dest].set(flat_tok[order])
    buf_gate = jnp.zeros((NB * ROUTE_BLOCK,), flat_gate.dtype).at[dest].set(flat_gate[order])
    blk_e = jnp.minimum(
        jnp.searchsorted(pad_end, jnp.arange(NB, dtype=jnp.int32) * ROUTE_BLOCK, side='right'),
        N_EXPERTS - 1)
    x_pad = jnp.concatenate([xt, jnp.zeros((1, D), xt.dtype)], axis=0)
    xb = x_pad[buf_tok].reshape(NB, ROUTE_BLOCK, D)

    def run(args):
        xblk, e = args
        hid = jax.nn.silu(xblk @ w1[e]) * (xblk @ w3[e])
        return hid @ w2[e]

    yb = lax.map(run, (xb, blk_e)).reshape(NB * ROUTE_BLOCK, D)
    y = jax.ops.segment_sum(yb * buf_gate[:, None].astype(yb.dtype), buf_tok, num_segments=T + 1)
    return y[:T]


def hier_moe(h, w_group, b_group, w_sub, b_sub, w1, w3, w2):
    B, S, D = h.shape
    T = B * S
    xt = h.reshape(T, D)
    xf = xt.astype(jnp.float32)
    p_group = jax.nn.softmax(xf @ w_group.astype(jnp.float32) + b_group.astype(jnp.float32), axis=-1)
    g_w, g_idx = lax.top_k(p_group, 1)
    sub_logits = (jnp.einsum('td,gde->tge', xf, w_sub.astype(jnp.float32))
                  + b_sub.astype(jnp.float32))
    chosen = jnp.take_along_axis(sub_logits, g_idx[:, :, None], axis=1)[:, 0]
    p_sub = jax.nn.softmax(chosen, axis=-1)
    s_w, s_idx = lax.top_k(p_sub, TOP_K)
    s_w = s_w / jnp.sum(s_w, axis=-1, keepdims=True)
    gate = (g_w * s_w).astype(h.dtype)
    expert = g_idx * EXPERTS_PER_GROUP + s_idx
    return routed_experts(xt, expert, gate, w1, w3, w2).reshape(B, S, D)


def setup_inputs(seed: int = 0) -> dict:
    key = jax.random.key(seed)
    ks = jax.random.split(key, 24)
    f32 = jnp.float32
    nrm = lambda k, shape, s: jax.random.normal(k, shape, f32) * s
    NA, NS = N_GLA_LAYERS, N_SGU_LAYERS
    return {
        "x": nrm(ks[0], (BATCH, SEQ, D_MODEL), 1.0),
        "gla_norm": 1.0 + nrm(ks[1], (NA, D_MODEL), 0.02),
        "gla_w_in": nrm(ks[2], (NA, D_MODEL, GLA_IN), D_MODEL ** -0.5),
        "gla_w_gate_up": nrm(ks[3], (NA, GLA_GATE_RANK, GLA_HK), GLA_GATE_RANK ** -0.5),
        "gla_b_gate": nrm(ks[4], (NA, GLA_HK), 0.1),
        "gla_head_g": 1.0 + nrm(ks[5], (NA, GLA_HEADS, GLA_DV), 0.02),
        "gla_w_out": nrm(ks[6], (NA, GLA_HV, D_MODEL), GLA_HV ** -0.5),
        "sgu_norm": 1.0 + nrm(ks[7], (NS, D_MODEL), 0.02),
        "sgu_w_in": nrm(ks[8], (NS, D_MODEL, SGU_FFN), D_MODEL ** -0.5),
        "sgu_ln_g": 1.0 + nrm(ks[9], (NS, SGU_HALF), 0.02),
        "sgu_ln_b": nrm(ks[10], (NS, SGU_HALF), 0.02),
        "sgu_w_s": nrm(ks[11], (NS, SGU_GROUPS, SGU_BLOCK, SGU_BLOCK), SGU_BLOCK ** -0.5),
        "sgu_b_s": 1.0 + nrm(ks[12], (NS, SGU_GROUPS, SGU_BLOCK), 0.1),
        "sgu_w_out": nrm(ks[13], (NS, SGU_HALF, D_MODEL), SGU_HALF ** -0.5),
        "moe_norm": 1.0 + nrm(ks[14], (DEPTH, D_MODEL), 0.02),
        "moe_w_group": nrm(ks[15], (DEPTH, D_MODEL, N_GROUPS), D_MODEL ** -0.5),
        "moe_b_group": nrm(ks[16], (DEPTH, N_GROUPS), 0.01),
        "moe_w_sub": nrm(ks[17], (DEPTH, N_GROUPS, D_MODEL, EXPERTS_PER_GROUP), D_MODEL ** -0.5),
        "moe_b_sub": nrm(ks[18], (DEPTH, N_GROUPS, EXPERTS_PER_GROUP), 0.01),
        "moe_w1": nrm(ks[19], (DEPTH, N_EXPERTS, D_MODEL, EXPERT_FF), D_MODEL ** -0.5),
        "moe_w3": nrm(ks[20], (DEPTH, N_EXPERTS, D_MODEL, EXPERT_FF), D_MODEL ** -0.5),
        "moe_w2": nrm(ks[21], (DEPTH, N_EXPERTS, EXPERT_FF, D_MODEL), EXPERT_FF ** -0.5),
        "final_norm": 1.0 + nrm(ks[22], (D_MODEL,), 0.02),
    }


def reference(x, gla_norm, gla_w_in, gla_w_gate_up, gla_b_gate, gla_head_g, gla_w_out,
              sgu_norm, sgu_w_in, sgu_ln_g, sgu_ln_b, sgu_w_s, sgu_b_s, sgu_w_out,
              moe_norm, moe_w_group, moe_b_group, moe_w_sub, moe_b_sub, moe_w1, moe_w3, moe_w2,
              final_norm):
    for i in range(DEPTH):
        j = i // N_MIXERS
        if i % N_MIXERS == 0:
            x = x + gla_mixer(rmsnorm(x, gla_norm[j]), gla_w_in[j], gla_w_gate_up[j],
                              gla_b_gate[j], gla_head_g[j], gla_w_out[j])
        else:
            x = x + sgu_mixer(rmsnorm(x, sgu_norm[j]), sgu_w_in[j], sgu_ln_g[j], sgu_ln_b[j],
                              sgu_w_s[j], sgu_b_s[j], sgu_w_out[j])
        x = x + hier_moe(rmsnorm(x, moe_norm[i]), moe_w_group[i], moe_b_group[i], moe_w_sub[i],
                         moe_b_sub[i], moe_w1[i], moe_w3[i], moe_w2[i])
    return rmsnorm(x, final_norm)
```

```cpp
#define NAIVE_MASK 0x9495u
#define ONE_LAUNCH 1
#include <hip/hip_runtime.h>
#include <hip/hip_cooperative_groups.h>
#include <cstdio>
#include <cstdint>
namespace cg = cooperative_groups;

#ifndef NAIVE_MASK
#define NAIVE_MASK 0x0u
#endif
#ifndef ONE_LAUNCH
#define ONE_LAUNCH 1
#endif

constexpr int T = 32768, D = 1024, NBATCH = 16, SEQ = 2048;
constexpr int GLA_H = 4, DK = 128, DV = 256, HK = 512, HV = 1024, RANK = 16, GLA_IN = 3088, NQKVR = 3072, CHUNK = 64, NCHUNK = 32;
constexpr int SGU_FFN = 4096, SGU_HALF = 2048, SGU_BLK = 128, SGU_GC = 512;
constexpr int NE = 32, EPG = 8, FF = 512;
constexpr float EPS = 1e-6f;
constexpr int NTHREADS = 512, NWAVES = 8;
constexpr int NPHASE = 15;

constexpr size_t MiB = 1u << 20;
constexpr size_t WS_CTL = 0, CTL_ZERO_BYTES = 64 * 1024;
constexpr size_t WS_GLR = 1 * MiB;
constexpr size_t WS_GATE = 3 * MiB;
constexpr size_t WS_EID = 3 * MiB + 512 * 1024;
constexpr size_t WS_STATS = 4 * MiB;
constexpr size_t WS_LIST = 12 * MiB;
constexpr size_t WS_WIN = 16 * MiB;
constexpr size_t WS_WOUT = 22 * MiB;
constexpr size_t WS_WSIN = 24 * MiB;
constexpr size_t WS_WSOUT = 32 * MiB;
constexpr size_t WS_W13 = 36 * MiB;
constexpr size_t WS_W2 = 164 * MiB;
constexpr size_t WS_XN = 228 * MiB;
constexpr size_t WS_QKVR = 292 * MiB;
constexpr size_t WS_HID = 292 * MiB;
constexpr size_t WS_Y = 364 * MiB;
constexpr size_t WS_U = 292 * MiB;
constexpr size_t WS_V = 420 * MiB;
constexpr size_t WS_END = 548 * MiB;
constexpr int CW_BAR = 1024;
constexpr int CW_CNT = 8192;

#define GAS __attribute__((address_space(1)))
#define LAS __attribute__((address_space(3)))
typedef unsigned short bf16;
typedef unsigned v4u __attribute__((ext_vector_type(4)));
typedef unsigned v2u __attribute__((ext_vector_type(2)));
typedef float f32x4 __attribute__((ext_vector_type(4)));
typedef float f32x16 __attribute__((ext_vector_type(16)));
typedef short bf16x8 __attribute__((ext_vector_type(8)));
typedef short s16x4 __attribute__((ext_vector_type(4)));
#define LDS_WAIT() asm volatile("s_waitcnt lgkmcnt(0)" ::: "memory")
#define VM_WAIT() asm volatile("s_waitcnt vmcnt(0)" ::: "memory")
__device__ __forceinline__ unsigned f2bf(float f) { unsigned u = __builtin_bit_cast(unsigned, f); return (u + 0x7fffu + ((u >> 16) & 1u)) >> 16; }
__device__ __forceinline__ unsigned pk2(float lo, float hi) { return f2bf(lo) | (f2bf(hi) << 16); }
__device__ __forceinline__ float bf2f(unsigned short b) { return __builtin_bit_cast(float, (unsigned)b << 16); }
__device__ __forceinline__ float bflo(unsigned w) { return __builtin_bit_cast(float, w << 16); }
__device__ __forceinline__ float bfhi(unsigned w) { return __builtin_bit_cast(float, w & 0xffff0000u); }
__device__ __forceinline__ float wave_sum(float v) {
#pragma unroll
    for (int o = 1; o < 64; o <<= 1) v += __shfl_xor(v, o);
    return v;
}
__device__ __forceinline__ float silu_f(float x) { return x / (1.f + __expf(-x)); }
__device__ __forceinline__ float gelu_erf(float x) { return 0.5f * x * (1.f + erff(x * 0.70710678118654752f)); }
__device__ __forceinline__ float logsigmoid_f(float x) { return fminf(x, 0.f) - log1pf(__expf(-fabsf(x))); }
namespace pg8 {
#define PG8_LAS __attribute__((address_space(3)))
typedef unsigned short bf16_t;
typedef short bf16x8 __attribute__((ext_vector_type(8)));
typedef float f32x4 __attribute__((ext_vector_type(4)));
typedef unsigned u32x4 __attribute__((ext_vector_type(4)));
constexpr int BM = 256, BK = 64, HALF = 128, HTB = HALF * BK * 2  , STAGE_BYTES = 8 * HTB, NXCD = 8, WGM = 8;

__host__ __device__ __forceinline__ int lds_byte(int r, int c) { const int st = (r >> 4) * 2 + (c >> 5), rr = r & 15, cc = c & 31, ob = rr * 64 + cc * 2; return st * 1024 + (ob ^ (((ob >> 9) & 1) << 5)); }
__host__ __device__ __forceinline__ void stage_rc(int b, int& R, int& C) { const int st = b / 1024, sb = b % 1024, swz = sb ^ (((sb >> 9) & 1) << 5); R = (st >> 1) * 16 + swz / 64; C = (st & 1) * 32 + (swz % 64) / 2; }
__host__ __device__ __forceinline__ int perm32(int rho) { const int n = rho >> 4, i = rho & 15; return 8 * (i >> 2) + 4 * n + (i & 3); }

struct Unit { int pm, pn, e, slot; };

struct DenseOrder {
    int nM, nN, nwg, G, c, K; const char* Bt;
    __device__ void init(int M, int N, int K_, const bf16_t* Bt_, int G_, int c_) { nM = M / BM; nN = N / BM; nwg = nM * nN; G = G_; c = c_; K = K_; Bt = (const char*)Bt_; }
    __device__ __forceinline__ bool next(int i, Unit& u) const {
        const long L = (long)i * G + c; if (L >= nwg) return false;
        int wgid = (int)L; { const int q = nwg / NXCD, r = nwg % NXCD, xcd = wgid % NXCD, off = wgid / NXCD; wgid = (xcd < r ? xcd * (q + 1) : r * (q + 1) + (xcd - r) * q) + off; }
        const int nig = WGM * nN, gid = wgid / nig, fm = gid * WGM, gsz = (nM - fm) < WGM ? (nM - fm) : WGM;
        u.pm = fm + ((wgid % nig) % gsz); u.pn = (wgid % nig) / gsz; u.e = 0; u.slot = 0; return true;
    }
    __device__ __forceinline__ const char* bptr(const Unit& u) const { return Bt + (size_t)u.pn * BM * K * 2; }
    __device__ __forceinline__ unsigned aoff(const Unit& u, int h, int R, int C) const { return (unsigned)(((u.pm * BM + h * HALF + R) * K + C) * 2); }
    __device__ __forceinline__ void a_ready(const Unit&) const {}
    __device__ __forceinline__ void done(const Unit&) const {}
};

__device__ __forceinline__ unsigned cvt_pk_bf16(float lo, float hi) { unsigned r; asm volatile("v_cvt_pk_bf16_f32 %0, %1, %2" : "=v"(r) : "v"(lo), "v"(hi)); return r; }
typedef float f32x2 __attribute__((ext_vector_type(2)));
__device__ __forceinline__ f32x2 gelu_pk(f32x2 v) {
    const f32x2 av = __builtin_elementwise_abs(v), d = av * 0.2316418882f + 1.0f;
    f32x2 t; t.x = __builtin_amdgcn_rcpf(d.x); t.y = __builtin_amdgcn_rcpf(d.y);
    f32x2 q = t * 0.5307027145f + (-0.7265760135f); q = q * t + 0.7107068705f; q = q * t + (-0.142248368f); q = q * t + 0.127414796f; q = q * t;
    const f32x2 s = (v * v) * (-0.72134752044f);
    f32x2 e; e.x = __builtin_amdgcn_exp2f(s.x); e.y = __builtin_amdgcn_exp2f(s.y);
    const f32x2 m = v * (q * e), r = v - m;
    f32x2 o; o.x = v.x < 0.f ? m.x : r.x; o.y = v.y < 0.f ? m.y : r.y; return o;
}

template <class Epi, class Sched>
__device__ __forceinline__ void gemm_phase(PG8_LAS unsigned char* lds, const bf16_t* Abase, const int K, const Sched& S, const Epi& E) {
    const int tid = threadIdx.x, wid = __builtin_amdgcn_readfirstlane(tid >> 6), lane = tid & 63, wr = wid >> 2, wc = wid & 3, fr = lane & 15, fq = lane >> 4;
    const int nt = K / BK;
    int sR[2], sC[2]; unsigned voffB[2];
#pragma unroll
    for (int i = 0; i < 2; ++i) { stage_rc(tid * 16 + i * 8192, sR[i], sC[i]); const int Rb = Epi::PERM ? ((sR[i] & ~31) + perm32(sR[i] & 31)) : sR[i]; voffB[i] = (unsigned)(Rb * K + sC[i]) * 2u; }
    const size_t kstep = (size_t)(BK * 2);
    const size_t hstep = (size_t)HALF * K * 2;
    const unsigned ldsw = (unsigned)wid * 1024u;
    const int aoff = lds_byte(wr * 64 + fr, fq * 8), boff = lds_byte(wc * 32 + fr, fq * 8);
    const char* const Ab = (const char*)Abase;
#define PG8_SA(b, h) (((b) * 2 + (h)) * HTB)
#define PG8_SB(b, h) ((4 + (b) * 2 + (h)) * HTB)
#define PG8_STAGE(bufoff, gbase, voff) do { _Pragma("unroll") for (int _i = 0; _i < 2; ++_i) \
        __builtin_amdgcn_global_load_lds((const unsigned*)((const char*)(gbase) + (voff)[_i]), (PG8_LAS unsigned*)(lds + (bufoff) + ldsw + _i * 8192), 16, 0, 0); } while (0)
#define PG8_LDA(dst, b, h) do { _Pragma("unroll") for (int m = 0; m < 4; ++m) _Pragma("unroll") for (int k = 0; k < 2; ++k) dst[m][k] = *(const PG8_LAS bf16x8*)(lds + PG8_SA(b, h) + aoff + m * 2048 + k * 1024); } while (0)
#define PG8_LDB(dst, b, h) do { _Pragma("unroll") for (int n = 0; n < 2; ++n) _Pragma("unroll") for (int k = 0; k < 2; ++k) dst[n][k] = *(const PG8_LAS bf16x8*)(lds + PG8_SB(b, h) + boff + n * 2048 + k * 1024); } while (0)
#define PG8_MMA(ai, bj, At, Bt) do { __builtin_amdgcn_s_setprio(1); _Pragma("unroll") for (int m = 0; m < 4; ++m) _Pragma("unroll") for (int n = 0; n < 2; ++n) _Pragma("unroll") for (int k = 0; k < 2; ++k) \
        acc[ai][bj][m][n] = __builtin_amdgcn_mfma_f32_16x16x32_bf16(Bt[n][k], At[m][k], acc[ai][bj][m][n], 0, 0, 0); __builtin_amdgcn_s_setprio(0); } while (0)
#define PG8_WAIT_V(n) asm volatile("s_waitcnt vmcnt(" #n ")" ::: "memory")
#define PG8_WAIT_L(n) asm volatile("s_waitcnt lgkmcnt(" #n ")" ::: "memory")
#define PG8_BAR __builtin_amdgcn_s_barrier()
#define PG8_SCHED __builtin_amdgcn_sched_barrier(0)
    Unit cur, nxt; int ui = 0;
    if (!S.next(0, cur)) return;
    f32x4 acc[2][2][4][2];
#pragma unroll
    for (int a = 0; a < 2; ++a)
#pragma unroll
        for (int b = 0; b < 2; ++b)
#pragma unroll
            for (int m = 0; m < 4; ++m)
#pragma unroll
                for (int n = 0; n < 2; ++n) acc[a][b][m][n] = (f32x4){0.f, 0.f, 0.f, 0.f};
    bf16x8 At[4][2], B0[2][2], B1[2][2];
    unsigned gc[2][2], gn[2][2];
#pragma unroll
    for (int h = 0; h < 2; ++h)
#pragma unroll
        for (int i = 0; i < 2; ++i) gc[h][i] = S.aoff(cur, h, sR[i], sC[i]);
    const char* cB = S.bptr(cur);
    S.a_ready(cur);
    PG8_STAGE(PG8_SB(0, 0), cB, voffB); PG8_STAGE(PG8_SB(0, 1), cB + hstep, voffB); PG8_STAGE(PG8_SA(0, 0), Ab, gc[0]); PG8_STAGE(PG8_SA(0, 1), Ab, gc[1]);
    if (wr == 1) PG8_BAR;
    PG8_WAIT_V(2); PG8_BAR;
    PG8_STAGE(PG8_SB(1, 0), cB + kstep, voffB); PG8_STAGE(PG8_SA(1, 0), Ab + kstep, gc[0]); PG8_STAGE(PG8_SB(1, 1), cB + hstep + kstep, voffB);
    PG8_WAIT_V(6); PG8_BAR;
    for (;;) {
        const bool has_next = S.next(ui + 1, nxt);
        const char* nB = has_next ? S.bptr(nxt) : cB;
#pragma unroll
        for (int h = 0; h < 2; ++h)
#pragma unroll
            for (int i = 0; i < 2; ++i) gn[h][i] = has_next ? S.aoff(nxt, h, sR[i], sC[i]) : gc[h][i];
        for (int t = 0; t < nt; t += 2) {
            const bool last = (t == nt - 2);
            const char* a1 = Ab + (size_t)(t + 1) * kstep;
            const char* a2 = last ? Ab : Ab + (size_t)(t + 2) * kstep; const char* b2 = last ? nB : cB + (size_t)(t + 2) * kstep;
            const char* a3 = a2 + kstep; const char* b3 = b2 + kstep;
            unsigned g2[2][2];
#pragma unroll
            for (int h = 0; h < 2; ++h)
#pragma unroll
                for (int i = 0; i < 2; ++i) g2[h][i] = last ? gn[h][i] : gc[h][i];
            if (last && has_next) S.a_ready(nxt);
            PG8_LDB(B0, 0, 0); PG8_LDB(B1, 0, 1); PG8_SCHED; PG8_LDA(At, 0, 0); PG8_STAGE(PG8_SA(1, 1), a1, gc[1]);
            PG8_WAIT_V(8); PG8_WAIT_L(0); PG8_BAR; PG8_MMA(0, 0, At, B0); PG8_MMA(0, 1, At, B1); PG8_BAR; PG8_SCHED;
            PG8_LDA(At, 0, 1); PG8_STAGE(PG8_SB(0, 0), b2, voffB); PG8_STAGE(PG8_SB(0, 1), b2 + hstep, voffB); PG8_STAGE(PG8_SA(0, 0), a2, g2[0]);
            PG8_WAIT_V(8); PG8_WAIT_L(0); PG8_BAR; PG8_MMA(1, 0, At, B0); PG8_MMA(1, 1, At, B1); PG8_BAR; PG8_SCHED;
            PG8_LDB(B0, 1, 0); PG8_LDB(B1, 1, 1); PG8_SCHED; PG8_LDA(At, 1, 0); PG8_STAGE(PG8_SA(0, 1), a2, g2[1]);
            PG8_WAIT_V(8); PG8_WAIT_L(0); PG8_BAR; PG8_MMA(0, 0, At, B0); PG8_MMA(0, 1, At, B1); PG8_BAR; PG8_SCHED;
            PG8_LDA(At, 1, 1); PG8_STAGE(PG8_SB(1, 0), b3, voffB); PG8_STAGE(PG8_SB(1, 1), b3 + hstep, voffB); PG8_STAGE(PG8_SA(1, 0), a3, g2[0]);
            PG8_WAIT_V(8); PG8_WAIT_L(0); PG8_BAR; PG8_MMA(1, 0, At, B0); PG8_MMA(1, 1, At, B1); PG8_BAR; PG8_SCHED;
        }
        if (wr == 0) PG8_BAR;
        E(acc, cur, wr, wc, fr, fq); S.done(cur);
        if (!has_next) break;
#pragma unroll
        for (int a = 0; a < 2; ++a)
#pragma unroll
            for (int b = 0; b < 2; ++b)
#pragma unroll
                for (int m = 0; m < 4; ++m)
#pragma unroll
                    for (int n = 0; n < 2; ++n) acc[a][b][m][n] = (f32x4){0.f, 0.f, 0.f, 0.f};
        cur = nxt; cB = nB; ++ui;
#pragma unroll
        for (int h = 0; h < 2; ++h)
#pragma unroll
            for (int i = 0; i < 2; ++i) gc[h][i] = gn[h][i];
        if (wr == 1) PG8_BAR;
    }
    PG8_WAIT_V(0);
    PG8_BAR;
#undef PG8_SA
#undef PG8_SB
#undef PG8_STAGE
#undef PG8_LDA
#undef PG8_LDB
#undef PG8_MMA
#undef PG8_WAIT_V
#undef PG8_WAIT_L
#undef PG8_BAR
#undef PG8_SCHED
}
}
constexpr int LX_PTR = 155648 - 256;
struct Frame {
    LAS unsigned char* lds;
    int tid, lane, wave, G, bid;
    float* out; unsigned char* ws;
    __device__ __forceinline__ const float* inp(int i) const {
        const LAS unsigned* p = (const LAS unsigned*)(lds + LX_PTR) + 2 * i;
        const unsigned lo = __builtin_amdgcn_readfirstlane(p[0]), hi = __builtin_amdgcn_readfirstlane(p[1]);
        return (const float*)(((unsigned long long)hi << 32) | lo);
    }
};
enum { I_X = 0, I_GLA_NORM, I_GLA_WIN, I_GLA_WGU, I_GLA_BG, I_GLA_HG, I_GLA_WOUT, I_SGU_NORM, I_SGU_WIN, I_SGU_LNG, I_SGU_LNB, I_SGU_WS, I_SGU_BS, I_SGU_WOUT,
       I_MOE_NORM, I_MOE_WG, I_MOE_BG, I_MOE_WSUB, I_MOE_BSUB, I_MOE_W1, I_MOE_W3, I_MOE_W2, I_FINAL };
#define WSP(type, off) ((type*)(F.ws + (off)))

__device__ __forceinline__ void n_convert(Frame& F, const float* W, int ldw, int K, int N, const float* kscale, int qcols, float qs, bf16* WT, int rowmap) {
    const size_t total = (size_t)N * K, stride = (size_t)F.G * NTHREADS;
    for (size_t idx = (size_t)F.bid * NTHREADS + F.tid; idx < total; idx += stride) {
        const int n = (int)(idx / K), k = (int)(idx % K);
        float v = W[(size_t)k * ldw + n]; if (kscale) v *= kscale[k]; if (n < qcols) v *= qs;
        const int dr = rowmap == 0 ? n : ((n >> 7) * 256 + (n & 127) + (rowmap == 2 ? 128 : 0));
        WT[(size_t)dr * K + k] = (bf16)f2bf(v);
    }
}
__device__ __forceinline__ void n_convert_gla(Frame& F) {
    n_convert(F, F.inp(I_GLA_WIN), GLA_IN, D, NQKVR, F.inp(I_GLA_NORM), HK, 0.08838834764831845f, WSP(bf16, WS_WIN), 0);
    n_convert(F, F.inp(I_GLA_WOUT), D, HV, D, F.inp(I_GLA_HG), 0, 1.f, WSP(bf16, WS_WOUT), 0);
}
__device__ __forceinline__ void n_convert_rest(Frame& F) {
    n_convert(F, F.inp(I_SGU_WIN), SGU_FFN, D, SGU_FFN, F.inp(I_SGU_NORM), 0, 1.f, WSP(bf16, WS_WSIN), 0);
    n_convert(F, F.inp(I_SGU_WOUT), D, SGU_HALF, D, nullptr, 0, 1.f, WSP(bf16, WS_WSOUT), 0);
    for (int le = 0; le < 2 * NE; ++le) {
        const int L = le / NE;
        n_convert(F, F.inp(I_MOE_W1) + (size_t)le * D * FF, FF, D, FF, F.inp(I_MOE_NORM) + L * D, 0, 1.f, WSP(bf16, WS_W13) + (size_t)le * 1024 * 1024, 1);
        n_convert(F, F.inp(I_MOE_W3) + (size_t)le * D * FF, FF, D, FF, F.inp(I_MOE_NORM) + L * D, 0, 1.f, WSP(bf16, WS_W13) + (size_t)le * 1024 * 1024, 2);
        n_convert(F, F.inp(I_MOE_W2) + (size_t)le * FF * D, D, FF, D, nullptr, 0, 1.f, WSP(bf16, WS_W2) + (size_t)le * 1024 * 512, 0);
    }
}

template <int MODE> __device__ __forceinline__ void n_rowpass(Frame& F, int L) {
    const float* src = MODE == 0 ? F.inp(I_X) : F.out;
    bf16* xn = WSP(bf16, WS_XN);
    const bf16* y = WSP(bf16, WS_Y);
    unsigned* ctl = WSP(unsigned, WS_CTL);
    for (int row = F.bid * NWAVES + F.wave; row < T; row += F.G * NWAVES) {
        f32x4 v[4]; float ss = 0.f;
#pragma unroll
        for (int j = 0; j < 4; ++j) {
            const int k = 4 * F.lane + 256 * j;
            v[j] = *(const f32x4*)(src + (size_t)row * D + k);
            if (MODE >= 2) {
                const v2u a = *(const v2u*)(y + (size_t)row * D + k), b = *(const v2u*)(y + ((size_t)T + row) * D + k);
                v[j].x += bflo(a.x) + bflo(b.x); v[j].y += bfhi(a.x) + bfhi(b.x); v[j].z += bflo(a.y) + bflo(b.y); v[j].w += bfhi(a.y) + bfhi(b.y);
            }
            ss += v[j].x * v[j].x + v[j].y * v[j].y + v[j].z * v[j].z + v[j].w * v[j].w;
        }
        const float rstd = 1.f / sqrtf(wave_sum(ss) * (1.f / D) + EPS);
        if (MODE == 0) {
            const float* gn = F.inp(I_GLA_NORM); const float* w = F.inp(I_GLA_WIN);
            for (int c = 0; c < RANK; ++c) {
                float p = 0.f;
#pragma unroll
                for (int j = 0; j < 4; ++j) { const int k = 4 * F.lane + 256 * j;
                    p += v[j].x * gn[k] * w[(size_t)k * GLA_IN + NQKVR + c] + v[j].y * gn[k + 1] * w[(size_t)(k + 1) * GLA_IN + NQKVR + c]
                       + v[j].z * gn[k + 2] * w[(size_t)(k + 2) * GLA_IN + NQKVR + c] + v[j].w * gn[k + 3] * w[(size_t)(k + 3) * GLA_IN + NQKVR + c]; }
                p = wave_sum(p) * rstd;
                if (F.lane == 0) WSP(float, WS_GLR)[(size_t)row * RANK + c] = p;
            }
        }
        if (MODE == 1) {
            const float* gn = F.inp(I_MOE_NORM) + L * D; const float* wg = F.inp(I_MOE_WG) + (size_t)L * D * 4; const float* wsb = F.inp(I_MOE_WSUB) + (size_t)L * 4 * D * EPG;
            float lg[4], ls[EPG];
            for (int c = 0; c < 4; ++c) { float p = 0.f;
#pragma unroll
                for (int j = 0; j < 4; ++j) { const int k = 4 * F.lane + 256 * j;
                    p += v[j].x * gn[k] * wg[(k) * 4 + c] + v[j].y * gn[k + 1] * wg[(k + 1) * 4 + c] + v[j].z * gn[k + 2] * wg[(k + 2) * 4 + c] + v[j].w * gn[k + 3] * wg[(k + 3) * 4 + c]; }
                lg[c] = wave_sum(p) * rstd + F.inp(I_MOE_BG)[L * 4 + c]; }
            int g = 0; float gm = lg[0];
            for (int c = 1; c < 4; ++c) if (lg[c] > gm) { gm = lg[c]; g = c; }
            float gs = 0.f; for (int c = 0; c < 4; ++c) gs += __expf(lg[c] - gm);
            const float g_w = 1.f / gs;
            for (int e = 0; e < EPG; ++e) { float p = 0.f;
#pragma unroll
                for (int j = 0; j < 4; ++j) { const int k = 4 * F.lane + 256 * j; const float* ww = wsb + ((size_t)g * D + k) * EPG + e;
                    p += v[j].x * gn[k] * ww[0] + v[j].y * gn[k + 1] * ww[EPG] + v[j].z * gn[k + 2] * ww[2 * EPG] + v[j].w * gn[k + 3] * ww[3 * EPG]; }
                ls[e] = wave_sum(p) * rstd + F.inp(I_MOE_BSUB)[(L * 4 + g) * EPG + e]; }
            int i1 = 0; float m1 = ls[0];
            for (int e = 1; e < EPG; ++e) if (ls[e] > m1) { m1 = ls[e]; i1 = e; }
            int i2 = -1; float m2 = -3.0e38f;
            for (int e = 0; e < EPG; ++e) if (e != i1 && ls[e] > m2) { m2 = ls[e]; i2 = e; }
            const float w1 = 1.f / (1.f + __expf(m2 - m1)), w2 = 1.f - w1;
            if (F.lane == 0) {
                const int e1 = g * EPG + i1, e2 = g * EPG + i2;
                WSP(int, WS_EID)[row * 2] = e1; WSP(int, WS_EID)[row * 2 + 1] = e2;
                WSP(float, WS_GATE)[row * 2] = g_w * w1; WSP(float, WS_GATE)[row * 2 + 1] = g_w * w2;
                const unsigned p1 = atomicAdd(&ctl[CW_CNT + L * 2048 + 64 * e1], 1u), p2 = atomicAdd(&ctl[CW_CNT + L * 2048 + 64 * e2], 1u);
                WSP(int, WS_LIST)[(size_t)e1 * T + p1] = row * 2; WSP(int, WS_LIST)[(size_t)e2 * T + p2] = row * 2 + 1;
            }
        }
#pragma unroll
        for (int j = 0; j < 4; ++j) {
            const int k = 4 * F.lane + 256 * j;
            if (MODE == 2) *(f32x4*)(F.out + (size_t)row * D + k) = v[j];
            if (MODE == 3) { const f32x4 g = *(const f32x4*)(F.inp(I_FINAL) + k); *(f32x4*)(F.out + (size_t)row * D + k) = v[j] * rstd * g; }
            else { v2u o; o.x = pk2(v[j].x * rstd, v[j].y * rstd); o.y = pk2(v[j].z * rstd, v[j].w * rstd); *(v2u*)(xn + (size_t)row * D + k) = o; }
        }
    }
}

template <class Fn> __device__ __forceinline__ void n_gemm(Frame& F, const bf16* A, int lda, const bf16* Bt, int ldb, int M, int N, int K, Fn f) {
    LAS float* As = (LAS float*)F.lds; LAS float* Bs = As + 64 * 33;
    const int ntn = N / 64, ntiles = (M / 64) * ntn, ty = F.tid >> 4, tx = F.tid & 15, lr = F.tid >> 3, lc = (F.tid & 7) * 4;
    for (int tile = F.bid; tile < ntiles; tile += F.G) {
        const int tm = tile / ntn, tn = tile % ntn;
        float acc[2][4] = {};
        for (int k0 = 0; k0 < K; k0 += 32) {
            const v2u a = *(const v2u*)(A + (size_t)(tm * 64 + lr) * lda + k0 + lc), b = *(const v2u*)(Bt + (size_t)(tn * 64 + lr) * ldb + k0 + lc);
            As[lr * 33 + lc] = bflo(a.x); As[lr * 33 + lc + 1] = bfhi(a.x); As[lr * 33 + lc + 2] = bflo(a.y); As[lr * 33 + lc + 3] = bfhi(a.y);
            Bs[lr * 33 + lc] = bflo(b.x); Bs[lr * 33 + lc + 1] = bfhi(b.x); Bs[lr * 33 + lc + 2] = bflo(b.y); Bs[lr * 33 + lc + 3] = bfhi(b.y);
            __syncthreads();
#pragma unroll 8
            for (int kk = 0; kk < 32; ++kk) {
                const float a0 = As[(2 * ty) * 33 + kk], a1 = As[(2 * ty + 1) * 33 + kk];
#pragma unroll
                for (int i = 0; i < 4; ++i) { const float bb = Bs[(4 * tx + i) * 33 + kk]; acc[0][i] += a0 * bb; acc[1][i] += a1 * bb; }
            }
            __syncthreads();
        }
#pragma unroll
        for (int r = 0; r < 2; ++r)
#pragma unroll
            for (int i = 0; i < 4; ++i) f(tm * 64 + 2 * ty + r, tn * 64 + 4 * tx + i, acc[r][i]);
    }
}

__device__ __forceinline__ void n_scan(Frame& F) {
    LAS float* gl = (LAS float*)F.lds;
    LAS float* kd = gl + 64 * 16;
    LAS float* qs = kd + 64 * 128;
    LAS float* os = qs + 64 * 128;
    LAS float* part = os + 64 * 256;
    LAS float* dec = part + 4 * 128;
    const bf16* qkvr = WSP(bf16, WS_QKVR); const float* glr = WSP(float, WS_GLR); bf16* aout = WSP(bf16, WS_XN);
    for (int item = F.bid; item < NBATCH * GLA_H; item += F.G) {
        const int b = item / GLA_H, h = item % GLA_H;
        float S[64];
#pragma unroll
        for (int i = 0; i < 64; ++i) S[i] = 0.f;
        const int dk = F.tid & 127, tg = F.tid >> 7, j = F.tid & 255, hf = F.tid >> 8;
        for (int c = 0; c < NCHUNK; ++c) {
            const size_t t0 = (size_t)b * SEQ + c * CHUNK;
            for (int i = F.tid; i < 64 * 16; i += NTHREADS) gl[i] = glr[t0 * RANK + i];
            __syncthreads();
            float wgu[RANK];
#pragma unroll
            for (int r = 0; r < RANK; ++r) wgu[r] = F.inp(I_GLA_WGU)[r * HK + h * DK + dk];
            const float bgv = F.inp(I_GLA_BG)[h * DK + dk];
            float run = 0.f;
            for (int jj = 0; jj < 16; ++jj) {
                const int tok = tg * 16 + jj; float a = bgv;
#pragma unroll
                for (int r = 0; r < RANK; ++r) a += gl[tok * 16 + r] * wgu[r];
                run += logsigmoid_f(a) * (1.f / 16.f);
            }
            part[tg * 128 + dk] = run;
            __syncthreads();
            float off = 0.f, tot = 0.f;
#pragma unroll
            for (int g = 0; g < 4; ++g) { const float pv = part[g * 128 + dk]; if (g < tg) off += pv; tot += pv; }
            run = off;
            for (int jj = 0; jj < 16; ++jj) {
                const int tok = tg * 16 + jj; float a = bgv;
#pragma unroll
                for (int r = 0; r < RANK; ++r) a += gl[tok * 16 + r] * wgu[r];
                run += logsigmoid_f(a) * (1.f / 16.f);
                const float kv = bf2f(qkvr[(t0 + tok) * NQKVR + HK + h * DK + dk]);
                kd[tok * 128 + dk] = kv * __expf(tot - run);
                qs[tok * 128 + dk] = bf2f(qkvr[(t0 + tok) * NQKVR + h * DK + dk]);
            }
            if (tg == 0) dec[dk] = __expf(tot);
            __syncthreads();
#pragma unroll
            for (int ib = 0; ib < 4; ++ib) {
#pragma unroll
                for (int i = 0; i < 16; ++i) S[ib * 16 + i] *= dec[64 * hf + ib * 16 + i];
                asm volatile("" ::: "memory"); }
            for (int s = 0; s < CHUNK; ++s) {
                const float vv = bf2f(qkvr[(t0 + s) * NQKVR + 2 * HK + h * DV + j]);
#pragma unroll
                for (int ib = 0; ib < 4; ++ib) {
#pragma unroll
                    for (int i = 0; i < 16; ++i) S[ib * 16 + i] += kd[s * 128 + 64 * hf + ib * 16 + i] * vv;
                    asm volatile("" ::: "memory"); }
            }
            for (int ph = 0; ph < 2; ++ph) {
                if (hf == ph) {
                    for (int t = 0; t < CHUNK; ++t) {
                        float o = 0.f;
#pragma unroll
                        for (int ib = 0; ib < 4; ++ib) {
#pragma unroll
                            for (int i = 0; i < 16; ++i) o += qs[t * 128 + 64 * hf + ib * 16 + i] * S[ib * 16 + i];
                            asm volatile("" ::: "memory"); }
                        if (ph == 0) os[t * 256 + j] = o; else os[t * 256 + j] += o;
                    }
                }
                __syncthreads();
            }
            {
                const int tok = F.tid >> 3, cc = F.tid & 7; float ss = 0.f;
                for (int jj = 0; jj < 32; ++jj) { const float o = os[tok * 256 + cc * 32 + jj]; ss += o * o; }
                ss += __shfl_xor(ss, 1); ss += __shfl_xor(ss, 2); ss += __shfl_xor(ss, 4);
                const float rms = 1.f / sqrtf(ss * (1.f / DV) + EPS);
                for (int jj = 0; jj < 32; ++jj) {
                    const int col = h * DV + cc * 32 + jj;
                    const float rr = bf2f(qkvr[(t0 + tok) * NQKVR + 2 * HK + HV + col]);
                    aout[(t0 + tok) * D + col] = (bf16)f2bf(os[tok * 256 + cc * 32 + jj] * rms * silu_f(rr));
                }
            }
            __syncthreads();
        }
    }
}

__device__ __forceinline__ void n_moe(Frame& F, int L) {
    LAS float* xs = (LAS float*)F.lds; LAS float* hl = xs + D;
    const bf16* xn = WSP(bf16, WS_XN); bf16* y = WSP(bf16, WS_Y);
    const bf16* W13 = WSP(bf16, WS_W13) + (size_t)L * NE * 1024 * 1024; const bf16* W2 = WSP(bf16, WS_W2) + (size_t)L * NE * 1024 * 512;
    for (int a = F.bid; a < 2 * T; a += F.G) {
        const int tok = a >> 1, k = a & 1, e = WSP(int, WS_EID)[a]; const float gate = WSP(float, WS_GATE)[a];
        for (int i = F.tid; i < D; i += NTHREADS) xs[i] = bf2f(xn[(size_t)tok * D + i]);
        __syncthreads();
        for (int jj = 0; jj < 64; ++jj) {
            const int j = F.wave * 64 + jj; const bf16* r1 = W13 + ((size_t)e * 1024 + (j >> 7) * 256 + (j & 127)) * 1024; const bf16* r3 = r1 + 128 * 1024;
            float d1 = 0.f, d3 = 0.f;
#pragma unroll
            for (int i = 0; i < 2; ++i) { const int kk = F.lane * 8 + 512 * i; const v4u a1 = *(const v4u*)(r1 + kk), a3 = *(const v4u*)(r3 + kk);
                d1 += xs[kk] * bflo(a1.x) + xs[kk + 1] * bfhi(a1.x) + xs[kk + 2] * bflo(a1.y) + xs[kk + 3] * bfhi(a1.y) + xs[kk + 4] * bflo(a1.z) + xs[kk + 5] * bfhi(a1.z) + xs[kk + 6] * bflo(a1.w) + xs[kk + 7] * bfhi(a1.w);
                d3 += xs[kk] * bflo(a3.x) + xs[kk + 1] * bfhi(a3.x) + xs[kk + 2] * bflo(a3.y) + xs[kk + 3] * bfhi(a3.y) + xs[kk + 4] * bflo(a3.z) + xs[kk + 5] * bfhi(a3.z) + xs[kk + 6] * bflo(a3.w) + xs[kk + 7] * bfhi(a3.w); }
            d1 = wave_sum(d1); d3 = wave_sum(d3);
            if (F.lane == 0) hl[j] = bf2f((bf16)f2bf(silu_f(d1) * d3));
        }
        __syncthreads();
        for (int cc = 0; cc < 128; ++cc) {
            const int c = F.wave * 128 + cc; const bf16* r2 = W2 + ((size_t)e * 1024 + c) * 512; const int kk = F.lane * 8; const v4u a2 = *(const v4u*)(r2 + kk);
            float d = hl[kk] * bflo(a2.x) + hl[kk + 1] * bfhi(a2.x) + hl[kk + 2] * bflo(a2.y) + hl[kk + 3] * bfhi(a2.y) + hl[kk + 4] * bflo(a2.z) + hl[kk + 5] * bfhi(a2.z) + hl[kk + 6] * bflo(a2.w) + hl[kk + 7] * bfhi(a2.w);
            d = wave_sum(d);
            if (F.lane == 0) y[((size_t)k * T + tok) * D + c] = (bf16)f2bf(gate * d);
        }
        __syncthreads();
    }
}

__device__ __forceinline__ void n_stats(Frame& F) {
    const bf16* v = WSP(bf16, WS_V); float* st = WSP(float, WS_STATS);
    for (size_t it = (size_t)F.bid * NTHREADS + F.tid; it < (size_t)T * 32; it += (size_t)F.G * NTHREADS) {
        const int row = (int)(it >> 5), p = (int)(it & 31), pnv = p >> 2, wc = p & 3; float s = 0.f, q = 0.f;
        for (int bj = 0; bj < 2; ++bj) for (int j = 0; j < 32; ++j) { const float x = bf2f(v[(size_t)row * SGU_HALF + pnv * 256 + bj * 128 + wc * 32 + j]); s += x; q += x * x; }
        st[((size_t)p * T + row) * 2] = s; st[((size_t)p * T + row) * 2 + 1] = q;
    }
}
__device__ __forceinline__ void n_mix(Frame& F) {
    LAS float* wl = (LAS float*)F.lds;
    LAS float* vls = wl + 128 * 128;
    LAS float* mu = vls + 128 * 128; LAS float* rs = mu + 128; LAS float* red = rs + 128;
    bf16* u = WSP(bf16, WS_U); const bf16* v = WSP(bf16, WS_V);
    for (int bn = F.bid; bn < T / SGU_BLK; bn += F.G) {
        const size_t t0 = (size_t)bn * SGU_BLK;
        __syncthreads();
        { const int row = F.tid >> 2, q4 = F.tid & 3; float s = 0.f, q = 0.f;
          for (int i = 0; i < 512; ++i) { const float x = bf2f(v[(t0 + row) * SGU_HALF + q4 * 512 + i]); s += x; q += x * x; }
          red[(row * 4 + q4) * 2] = s; red[(row * 4 + q4) * 2 + 1] = q; }
        __syncthreads();
        if (F.tid < 128) { float s = 0.f, q = 0.f; for (int p = 0; p < 4; ++p) { s += red[(F.tid * 4 + p) * 2]; q += red[(F.tid * 4 + p) * 2 + 1]; }
            const float m = s * (1.f / SGU_HALF); mu[F.tid] = m; rs[F.tid] = 1.f / sqrtf(q * (1.f / SGU_HALF) - m * m + EPS); }
        for (int g = 0; g < 4; ++g) {
            __syncthreads();
            for (int i = F.tid; i < 128 * 128; i += NTHREADS) { const int t = i >> 7, s = i & 127; wl[i] = ((t >> 6) >= (s >> 6)) ? F.inp(I_SGU_WS)[(size_t)g * 128 * 128 + i] : 0.f; }
            for (int cb = 0; cb < 4; ++cb) {
                const int c0 = g * SGU_GC + cb * 128;
                __syncthreads();
                for (int i = F.tid; i < 128 * 128; i += NTHREADS) { const int s = i >> 7, c = i & 127;
                    vls[i] = (bf2f(v[(t0 + s) * SGU_HALF + c0 + c]) - mu[s]) * rs[s] * F.inp(I_SGU_LNG)[c0 + c] + F.inp(I_SGU_LNB)[c0 + c]; }
                __syncthreads();
                const int c = F.tid & 127, tq = F.tid >> 7;
                for (int tt = 0; tt < 32; ++tt) {
                    const int t = tq * 32 + tt; float acc = 0.f;
                    for (int s = 0; s < 128; ++s) acc += wl[t * 128 + s] * vls[s * 128 + c];
                    const float mixed = acc + F.inp(I_SGU_BS)[g * 128 + t];
                    u[(t0 + t) * SGU_HALF + c0 + c] = (bf16)f2bf(bf2f(u[(t0 + t) * SGU_HALF + c0 + c]) * mixed);
                }
            }
        }
    }
}
constexpr int RING_BYTES = 131072;
constexpr int LX_TST = RING_BYTES;
constexpr int MOE_MAXU = 6;
constexpr int LX_TAB = RING_BYTES + 512;
constexpr int LX_GT = LX_TAB + MOE_MAXU * 1024;

struct EpiStoreBf16 {
    static constexpr bool PERM = true;
    bf16* O; int ldc;
    __device__ __forceinline__ void operator()(const pg8::f32x4 (&acc)[2][2][4][2], const pg8::Unit& u, int wr, int wc, int fr, int fq) const {
        const int row0 = u.pm * 256 + wr * 64 + fr, col0 = u.pn * 256 + wc * 32 + 8 * fq;
#pragma unroll
        for (int ai = 0; ai < 2; ++ai)
#pragma unroll
            for (int m = 0; m < 4; ++m) { bf16* rowp = O + (size_t)(row0 + ai * 128 + m * 16) * ldc + col0;
#pragma unroll
                for (int bj = 0; bj < 2; ++bj) { const pg8::f32x4 v0 = acc[ai][bj][m][0], v1 = acc[ai][bj][m][1];
                    v4u w; w.x = pg8::cvt_pk_bf16(v0[0], v0[1]); w.y = pg8::cvt_pk_bf16(v0[2], v0[3]); w.z = pg8::cvt_pk_bf16(v1[0], v1[1]); w.w = pg8::cvt_pk_bf16(v1[2], v1[3]);
                    *(v4u*)(rowp + bj * 128) = w; } }
    }
};
struct EpiResF32 {
    static constexpr bool PERM = false;
    const float* res; float* out;
    __device__ __forceinline__ void operator()(const pg8::f32x4 (&acc)[2][2][4][2], const pg8::Unit& u, int wr, int wc, int fr, int fq) const {
        const int row0 = u.pm * 256 + wr * 64 + fr, col0 = u.pn * 256 + wc * 32 + 4 * fq;
#pragma unroll
        for (int ai = 0; ai < 2; ++ai)
#pragma unroll
            for (int m = 0; m < 4; ++m) { const size_t off = (size_t)(row0 + ai * 128 + m * 16) * D + col0;
#pragma unroll
                for (int bj = 0; bj < 2; ++bj)
#pragma unroll
                    for (int n = 0; n < 2; ++n) { const pg8::f32x4 r = *(const pg8::f32x4*)(res + off + bj * 128 + n * 16); *(pg8::f32x4*)(out + off + bj * 128 + n * 16) = r + acc[ai][bj][m][n]; } }
    }
};
struct EpiGeluSplit {
    static constexpr bool PERM = true;
    bf16* U; bf16* V; float* st;
    __device__ __forceinline__ void operator()(const pg8::f32x4 (&acc)[2][2][4][2], const pg8::Unit& u, int wr, int wc, int fr, int fq) const {
        const bool isv = u.pn >= 8; const int pnl = isv ? u.pn - 8 : u.pn;
        bf16* O = isv ? V : U;
        const int row0 = u.pm * 256 + wr * 64 + fr, col0 = pnl * 256 + wc * 32 + 8 * fq;
#pragma unroll
        for (int ai = 0; ai < 2; ++ai)
#pragma unroll
            for (int m = 0; m < 4; ++m) { const int row = row0 + ai * 128 + m * 16; bf16* rowp = O + (size_t)row * SGU_HALF + col0; float s = 0.f, q = 0.f;
#pragma unroll
                for (int bj = 0; bj < 2; ++bj) { const pg8::f32x4 v0 = acc[ai][bj][m][0], v1 = acc[ai][bj][m][1];
                    const pg8::f32x2 a = pg8::gelu_pk((pg8::f32x2){v0[0], v0[1]}), b = pg8::gelu_pk((pg8::f32x2){v0[2], v0[3]}), c = pg8::gelu_pk((pg8::f32x2){v1[0], v1[1]}), d = pg8::gelu_pk((pg8::f32x2){v1[2], v1[3]});
                    s += (a.x + a.y) + (b.x + b.y) + (c.x + c.y) + (d.x + d.y);
                    q += (a.x * a.x + a.y * a.y) + (b.x * b.x + b.y * b.y) + (c.x * c.x + c.y * c.y) + (d.x * d.x + d.y * d.y);
                    v4u w; w.x = pg8::cvt_pk_bf16(a.x, a.y); w.y = pg8::cvt_pk_bf16(b.x, b.y); w.z = pg8::cvt_pk_bf16(c.x, c.y); w.w = pg8::cvt_pk_bf16(d.x, d.y);
                    *(v4u*)(rowp + bj * 128) = w; }
                if (isv) { s += __shfl_xor(s, 16); s += __shfl_xor(s, 32); q += __shfl_xor(q, 16); q += __shfl_xor(q, 32);
                    if (fq == 0) { pg8::f32x2 o = {s, q}; *(pg8::f32x2*)(st + ((size_t)(pnl * 4 + wc) * T + row) * 2) = o; } } }
    }
};

__device__ __forceinline__ void f_gemm_in(Frame& F) {
    pg8::DenseOrder S; S.init(T, NQKVR, D, WSP(bf16, WS_WIN), F.G, F.bid);
    EpiStoreBf16 E{WSP(bf16, WS_QKVR), NQKVR};
    pg8::gemm_phase(F.lds, WSP(bf16, WS_XN), D, S, E);
}
__device__ __forceinline__ void f_gemm_out(Frame& F) {
    pg8::DenseOrder S; S.init(T, D, HV, WSP(bf16, WS_WOUT), F.G, F.bid);
    EpiResF32 E{F.inp(I_X), F.out};
    pg8::gemm_phase(F.lds, WSP(bf16, WS_XN), HV, S, E);
}
__device__ __forceinline__ void f_gemm_sgu_in(Frame& F) {
    pg8::DenseOrder S; S.init(T, SGU_FFN, D, WSP(bf16, WS_WSIN), F.G, F.bid);
    EpiGeluSplit E{WSP(bf16, WS_U), WSP(bf16, WS_V), WSP(float, WS_STATS)};
    pg8::gemm_phase(F.lds, WSP(bf16, WS_XN), D, S, E);
}
__device__ __forceinline__ void f_gemm_sgu_out(Frame& F) {
    pg8::DenseOrder S; S.init(T, D, SGU_HALF, WSP(bf16, WS_WSOUT), F.G, F.bid);
    EpiResF32 E{F.out, F.out};
    pg8::gemm_phase(F.lds, WSP(bf16, WS_U), SGU_HALF, S, E);
}

struct MoeOrder {
    int G, c, nunits, ibase, K, mode;
    const char* W; size_t estride;
    LAS const int* tst; LAS const int* tab;
    __device__ __forceinline__ bool next(int i, pg8::Unit& u) const {
        if (i >= MOE_MAXU) return false;
        const int Lu = (ibase + i) * G + c; if (Lu >= nunits) return false;
        const int rt = Lu >> 2; int e = 0;
        while (e < NE - 1 && tst[e + 1] <= rt) ++e;
        u.pm = rt; u.pn = Lu & 3; u.e = e; u.slot = i; return true;
    }
    __device__ __forceinline__ const char* bptr(const pg8::Unit& u) const { return W + (size_t)u.e * estride + (size_t)u.pn * 256 * K * 2; }
    __device__ __forceinline__ unsigned aoff(const pg8::Unit& u, int h, int R, int C) const {
        if (mode == 0) { int ent = tab[u.slot * 256 + h * 128 + R]; ent = ent < 0 ? 0 : ent; return (unsigned)(((ent >> 1) * K + C) * 2); }
        return (unsigned)(((u.pm * 256 + h * 128 + R) * K + C) * 2);
    }
    __device__ __forceinline__ void a_ready(const pg8::Unit&) const {}
    __device__ __forceinline__ void done(const pg8::Unit&) const {}
};
struct EpiSwiglu {
    static constexpr bool PERM = true;
    bf16* H;
    __device__ __forceinline__ void operator()(const pg8::f32x4 (&acc)[2][2][4][2], const pg8::Unit& u, int wr, int wc, int fr, int fq) const {
        const int row0 = u.pm * 256 + wr * 64 + fr, col0 = u.pn * 128 + wc * 32 + 8 * fq;
#pragma unroll
        for (int ai = 0; ai < 2; ++ai)
#pragma unroll
            for (int m = 0; m < 4; ++m) { bf16* rowp = H + (size_t)(row0 + ai * 128 + m * 16) * FF + col0; float h[8];
#pragma unroll
                for (int n = 0; n < 2; ++n)
#pragma unroll
                    for (int i = 0; i < 4; ++i) { const float a = acc[ai][0][m][n][i], b = acc[ai][1][m][n][i]; h[n * 4 + i] = a * __builtin_amdgcn_rcpf(1.f + __expf(-a)) * b; }
                v4u w; w.x = pg8::cvt_pk_bf16(h[0], h[1]); w.y = pg8::cvt_pk_bf16(h[2], h[3]); w.z = pg8::cvt_pk_bf16(h[4], h[5]); w.w = pg8::cvt_pk_bf16(h[6], h[7]);
                *(v4u*)rowp = w; }
    }
};
struct EpiScatterY {
    static constexpr bool PERM = true;
    bf16* Y; LAS const int* tab; LAS const float* gt;
    __device__ __forceinline__ void operator()(const pg8::f32x4 (&acc)[2][2][4][2], const pg8::Unit& u, int wr, int wc, int fr, int fq) const {
        const int col0 = u.pn * 256 + wc * 32 + 8 * fq;
#pragma unroll
        for (int ai = 0; ai < 2; ++ai)
#pragma unroll
            for (int m = 0; m < 4; ++m) { const int r = ai * 128 + wr * 64 + m * 16 + fr; const int ent = tab[u.slot * 256 + r]; const float g = gt[u.slot * 256 + r];
                if (ent >= 0) { bf16* rowp = Y + ((size_t)(ent & 1) * T + (ent >> 1)) * D + col0;
#pragma unroll
                    for (int bj = 0; bj < 2; ++bj) { const pg8::f32x4 v0 = acc[ai][bj][m][0] * g, v1 = acc[ai][bj][m][1] * g;
                        v4u w; w.x = pg8::cvt_pk_bf16(v0[0], v0[1]); w.y = pg8::cvt_pk_bf16(v0[2], v0[3]); w.z = pg8::cvt_pk_bf16(v1[0], v1[1]); w.w = pg8::cvt_pk_bf16(v1[2], v1[3]);
                        *(v4u*)(rowp + bj * 128) = w; } } }
    }
};
template <int MODE> __device__ __forceinline__ void f_moe_gemm(Frame& F, int L) {
    LAS int* tst = (LAS int*)(F.lds + LX_TST); LAS int* cntl = tst + 64; LAS int* tab = (LAS int*)(F.lds + LX_TAB); LAS float* gt = (LAS float*)(F.lds + LX_GT);
    unsigned* ctl = WSP(unsigned, WS_CTL);
    __syncthreads();
    if (F.tid < NE) cntl[F.tid] = (int)__hip_atomic_load(&ctl[CW_CNT + L * 2048 + 64 * F.tid], __ATOMIC_RELAXED, __HIP_MEMORY_SCOPE_AGENT);
    __syncthreads();
    if (F.tid == 0) { int s = 0; for (int e = 0; e < NE; ++e) { tst[e] = s; s += (cntl[e] + 255) >> 8; } tst[NE] = s; }
    __syncthreads();
    MoeOrder S; S.G = F.G; S.c = F.bid; S.nunits = 4 * tst[NE]; S.K = MODE == 0 ? D : FF; S.mode = MODE; S.tst = tst; S.tab = tab;
    S.W = MODE == 0 ? (const char*)(WSP(bf16, WS_W13) + (size_t)L * NE * 1024 * 1024) : (const char*)(WSP(bf16, WS_W2) + (size_t)L * NE * 1024 * 512);
    S.estride = MODE == 0 ? (size_t)1024 * 1024 * 2 : (size_t)1024 * 512 * 2;
    const int* list = WSP(int, WS_LIST); const float* gates = WSP(float, WS_GATE);
    for (int ibase = 0; ibase * F.G + F.bid < S.nunits; ibase += MOE_MAXU) {
        S.ibase = ibase;
        for (int i = 0; i < MOE_MAXU; ++i) {
            pg8::Unit u; if (!S.next(i, u)) break;
            const int tin = u.pm - tst[u.e];
            if (F.tid < 256) { const int idx = tin * 256 + F.tid; int ent = -1; float g = 0.f;
                if (idx < cntl[u.e]) { ent = list[(size_t)u.e * T + idx]; g = gates[ent]; }
                tab[i * 256 + F.tid] = ent; gt[i * 256 + F.tid] = g; }
        }
        __syncthreads();
        if (MODE == 0) { EpiSwiglu E{WSP(bf16, WS_HID)}; pg8::gemm_phase(F.lds, WSP(bf16, WS_XN), D, S, E); }
        else { EpiScatterY E{WSP(bf16, WS_Y), tab, gt}; pg8::gemm_phase(F.lds, WSP(bf16, WS_HID), FF, S, E); }
        __syncthreads();
    }
}
__device__ __forceinline__ void f_moe1(Frame& F, int L) { f_moe_gemm<0>(F, L); }
__device__ __forceinline__ void f_moe2(Frame& F, int L) { f_moe_gemm<1>(F, L); }
__device__ __forceinline__ void f_prep0(Frame&) {}
__device__ __forceinline__ void f_scan_convert(Frame&) {}
__device__ __forceinline__ void f_rowpass_add(Frame&) {}
__device__ __forceinline__ void f_mix(Frame&) {}
__device__ __forceinline__ void f_rowpass_router(Frame&, int) {}
__device__ __forceinline__ void f_final(Frame&) {}
constexpr int LDS_BYTES = 155648;
struct Args { const float* in[23]; float* out; unsigned char* ws; int ph_lo, ph_hi; };
#define NAIVE(k) ((NAIVE_MASK >> (k)) & 1u)

struct EpiN1 { bf16* o; __device__ void operator()(int r, int c, float v) const { o[(size_t)r * NQKVR + c] = (bf16)f2bf(v); } };
struct EpiN3 { const float* res; float* o; __device__ void operator()(int r, int c, float v) const { o[(size_t)r * D + c] = res[(size_t)r * D + c] + v; } };
struct EpiN8 { bf16* u; bf16* v; __device__ void operator()(int r, int c, float x) const { const float z = gelu_erf(x); if (c < SGU_HALF) u[(size_t)r * SGU_HALF + c] = (bf16)f2bf(z); else v[(size_t)r * SGU_HALF + c - SGU_HALF] = (bf16)f2bf(z); } };

__global__ void __launch_bounds__(NTHREADS, 2) fwd(Args args) {
    extern __shared__ __attribute__((aligned(16))) unsigned char lds_raw[];
    Frame F;
    F.lds = (LAS unsigned char*)lds_raw;
    F.tid = threadIdx.x; F.lane = F.tid & 63; F.wave = __builtin_amdgcn_readfirstlane(F.tid >> 6); F.G = gridDim.x; F.bid = blockIdx.x;
    F.out = args.out; F.ws = args.ws;
    if (F.tid == 0) {
        LAS unsigned long long* pt = (LAS unsigned long long*)(F.lds + LX_PTR);
#pragma unroll
        for (int i = 0; i < 23; ++i) pt[i] = (unsigned long long)args.in[i];
    }
    __syncthreads();
    const int lo = args.ph_lo, hi = args.ph_hi;
#if ONE_LAUNCH
    cg::grid_group grid = cg::this_grid();
#define GRID_BAR() grid.sync()
#else
#define GRID_BAR() do { } while (0)
#endif
#define IN(k) (lo <= (k) && (k) < hi)
#define SEAM(k) do { if (IN(k) && IN((k) + 1)) GRID_BAR(); } while (0)

    if (IN(0)) {
        if (NAIVE(0)) { n_convert_gla(F); n_rowpass<0>(F, 0); } else { f_prep0(F); }
    }
    SEAM(0);
    if (IN(1)) {
        if (NAIVE(1)) n_gemm(F, WSP(bf16, WS_XN), D, WSP(bf16, WS_WIN), D, T, NQKVR, D, EpiN1{WSP(bf16, WS_QKVR)}); else f_gemm_in(F);
    }
    SEAM(1);
    if (IN(2)) {
        if (NAIVE(2)) { n_scan(F); n_convert_rest(F); } else { f_scan_convert(F); }
    }
    SEAM(2);
    if (IN(3)) {
        if (NAIVE(3)) n_gemm(F, WSP(bf16, WS_XN), D, WSP(bf16, WS_WOUT), D, T, D, HV, EpiN3{F.inp(I_X), F.out}); else f_gemm_out(F);
    }
    SEAM(3);
#define MOE_BLOCK(L, pb) do { \
        if (IN(pb)) { if (NAIVE(pb)) n_rowpass<1>(F, L); else f_rowpass_router(F, L); } \
        SEAM(pb); \
        if (IN((pb) + 1)) { if (NAIVE((pb) + 1)) n_moe(F, L); else f_moe1(F, L); } \
        SEAM((pb) + 1); \
        if (IN((pb) + 2)) { if (!NAIVE((pb) + 1)) f_moe2(F, L); } \
        SEAM((pb) + 2); } while (0)
    MOE_BLOCK(0, 4);
    if (IN(7)) { if (NAIVE(7)) n_rowpass<2>(F, 0); else f_rowpass_add(F); }
    SEAM(7);
    if (IN(8)) { if (NAIVE(8)) n_gemm(F, WSP(bf16, WS_XN), D, WSP(bf16, WS_WSIN), D, T, SGU_FFN, D, EpiN8{WSP(bf16, WS_U), WSP(bf16, WS_V)}); else f_gemm_sgu_in(F); }
    if (NAIVE(8)) { SEAM(8); if (IN(9)) n_stats(F); SEAM(9); } else { if (IN(8) && IN(10)) GRID_BAR(); }
    if (IN(10)) { if (NAIVE(10)) n_mix(F); else f_mix(F); }
    SEAM(10);
    if (IN(11)) { if (NAIVE(11)) n_gemm(F, WSP(bf16, WS_U), SGU_HALF, WSP(bf16, WS_WSOUT), SGU_HALF, T, D, SGU_HALF, EpiN3{F.out, F.out}); else f_gemm_sgu_out(F); }
    SEAM(11);
    MOE_BLOCK(1, 12);
    if (IN(15)) { if (NAIVE(15)) n_rowpass<3>(F, 0); else f_final(F); }
}

extern "C" void kernel_launch(void* const* d_in, const int* in_sizes, int n_in, void* d_out, int out_size, void* d_ws, size_t ws_size, hipStream_t stream) {
    static int grid = 0;
    if (grid == 0) {
        if (n_in != 23 || out_size != T * D || ws_size < WS_END) { fprintf(stderr, "kernel_launch: unexpected shapes (n_in %d out %d ws %zu)\n", n_in, out_size, ws_size); grid = -1; return; }
        int dev = 0, cus = 0, per_cu = 0;
        hipGetDevice(&dev); hipDeviceGetAttribute(&cus, hipDeviceAttributeMultiprocessorCount, dev);
        hipFuncSetAttribute((const void*)fwd, hipFuncAttributeMaxDynamicSharedMemorySize, LDS_BYTES);
        hipOccupancyMaxActiveBlocksPerMultiprocessor(&per_cu, (const void*)fwd, NTHREADS, LDS_BYTES);
        (void)hipGetLastError();
        if (per_cu < 1) { fprintf(stderr, "kernel_launch: occupancy query says %d blocks per CU\n", per_cu); per_cu = 1; }
        grid = cus;
    }
    if (grid < 0) return;
    hipMemsetAsync((char*)d_ws + WS_CTL, 0, CTL_ZERO_BYTES, stream);
    Args a{};
    for (int i = 0; i < 23; ++i) a.in[i] = (const float*)d_in[i];
    a.out = (float*)d_out; a.ws = (unsigned char*)d_ws;
#if ONE_LAUNCH
    a.ph_lo = 0; a.ph_hi = 16;
    void* kargs[] = {&a};
    hipError_t e = hipLaunchCooperativeKernel((const void*)fwd, dim3(grid), dim3(NTHREADS), kargs, LDS_BYTES, stream);
    if (e != hipSuccess) fprintf(stderr, "cooperative launch failed: %s (grid %d)\n", hipGetErrorString(e), grid);
#else
    for (int p = 0; p < 16; ++p) {
        if (p == 9 && !NAIVE(8)) continue;
        if ((p == 6 || p == 14) && NAIVE(p - 1)) continue;
        a.ph_lo = p; a.ph_hi = p + 1;
        hipLaunchKernelGGL(fwd, dim3(grid), dim3(NTHREADS), LDS_BYTES, stream, a);
    }
#endif
}
```

```cpp
#define NAIVE_MASK 0x0u
#define ONE_LAUNCH 1
#include <hip/hip_runtime.h>
#include <hip/hip_cooperative_groups.h>
#include <cstdio>
#include <cstdint>
namespace cg = cooperative_groups;

#ifndef NAIVE_MASK
#define NAIVE_MASK 0x0u
#endif
#ifndef ONE_LAUNCH
#define ONE_LAUNCH 1
#endif

constexpr int T = 32768, D = 1024, NBATCH = 16, SEQ = 2048;
constexpr int GLA_H = 4, DK = 128, DV = 256, HK = 512, HV = 1024, RANK = 16, GLA_IN = 3088, NQKVR = 3072, CHUNK = 64, NCHUNK = 32;
constexpr int SGU_FFN = 4096, SGU_HALF = 2048, SGU_BLK = 128, SGU_GC = 512;
constexpr int NE = 32, EPG = 8, FF = 512;
constexpr float EPS = 1e-6f;
constexpr int NTHREADS = 512, NWAVES = 8;
constexpr int NPHASE = 15;

constexpr size_t MiB = 1u << 20;
constexpr size_t WS_CTL = 0, CTL_ZERO_BYTES = 64 * 1024;
constexpr size_t WS_GLR = 1 * MiB;
constexpr size_t WS_GATE = 3 * MiB;
constexpr size_t WS_EID = 3 * MiB + 512 * 1024;
constexpr size_t WS_STATS = 4 * MiB;
constexpr size_t WS_LIST = 12 * MiB;
constexpr size_t WS_WIN = 16 * MiB;
constexpr size_t WS_WOUT = 22 * MiB;
constexpr size_t WS_WSIN = 24 * MiB;
constexpr size_t WS_WSOUT = 32 * MiB;
constexpr size_t WS_W13 = 36 * MiB;
constexpr size_t WS_W2 = 164 * MiB;
constexpr size_t WS_XN = 228 * MiB;
constexpr size_t WS_QKVR = 292 * MiB;
constexpr size_t WS_HID = 292 * MiB;
constexpr size_t WS_Y = 364 * MiB;
constexpr size_t WS_U = 292 * MiB;
constexpr size_t WS_V = 420 * MiB;
constexpr size_t WS_END = 548 * MiB;
constexpr int CW_BAR = 1024;
constexpr int CW_CNT = 8192;

#define GAS __attribute__((address_space(1)))
#define LAS __attribute__((address_space(3)))
typedef unsigned short bf16;
typedef unsigned v4u __attribute__((ext_vector_type(4)));
typedef unsigned v2u __attribute__((ext_vector_type(2)));
typedef float f32x4 __attribute__((ext_vector_type(4)));
typedef float f32x16 __attribute__((ext_vector_type(16)));
typedef short bf16x8 __attribute__((ext_vector_type(8)));
typedef short s16x4 __attribute__((ext_vector_type(4)));
#define LDS_WAIT() asm volatile("s_waitcnt lgkmcnt(0)" ::: "memory")
#define VM_WAIT() asm volatile("s_waitcnt vmcnt(0)" ::: "memory")
__device__ __forceinline__ unsigned f2bf(float f) { unsigned u = __builtin_bit_cast(unsigned, f); return (u + 0x7fffu + ((u >> 16) & 1u)) >> 16; }
__device__ __forceinline__ unsigned pk2(float lo, float hi) { return f2bf(lo) | (f2bf(hi) << 16); }
__device__ __forceinline__ float bf2f(unsigned short b) { return __builtin_bit_cast(float, (unsigned)b << 16); }
__device__ __forceinline__ float bflo(unsigned w) { return __builtin_bit_cast(float, w << 16); }
__device__ __forceinline__ float bfhi(unsigned w) { return __builtin_bit_cast(float, w & 0xffff0000u); }
__device__ __forceinline__ float wave_sum(float v) {
#pragma unroll
    for (int o = 1; o < 64; o <<= 1) v += __shfl_xor(v, o);
    return v;
}
__device__ __forceinline__ float silu_f(float x) { return x / (1.f + __expf(-x)); }
__device__ __forceinline__ float gelu_erf(float x) { return 0.5f * x * (1.f + erff(x * 0.70710678118654752f)); }
__device__ __forceinline__ float logsigmoid_f(float x) { return fminf(x, 0.f) - log1pf(__expf(-fabsf(x))); }
namespace pg8 {
#define PG8_LAS __attribute__((address_space(3)))
typedef unsigned short bf16_t;
typedef short bf16x8 __attribute__((ext_vector_type(8)));
typedef float f32x4 __attribute__((ext_vector_type(4)));
typedef unsigned u32x4 __attribute__((ext_vector_type(4)));
constexpr int BM = 256, BK = 64, HALF = 128, HTB = HALF * BK * 2  , STAGE_BYTES = 8 * HTB, NXCD = 8, WGM = 8;

__host__ __device__ __forceinline__ int lds_byte(int r, int c) { const int st = (r >> 4) * 2 + (c >> 5), rr = r & 15, cc = c & 31, ob = rr * 64 + cc * 2; return st * 1024 + (ob ^ (((ob >> 9) & 1) << 5)); }
__host__ __device__ __forceinline__ void stage_rc(int b, int& R, int& C) { const int st = b / 1024, sb = b % 1024, swz = sb ^ (((sb >> 9) & 1) << 5); R = (st >> 1) * 16 + swz / 64; C = (st & 1) * 32 + (swz % 64) / 2; }
__host__ __device__ __forceinline__ int perm32(int rho) { const int n = rho >> 4, i = rho & 15; return 8 * (i >> 2) + 4 * n + (i & 3); }

struct Unit { int pm, pn, e, slot; };

struct DenseOrder {
    static constexpr bool GATHER = false;
    int nM, nN, nwg, G, c, K; const char* Bt;
    __device__ void init(int M, int N, int K_, const bf16_t* Bt_, int G_, int c_) { nM = M / BM; nN = N / BM; nwg = nM * nN; G = G_; c = c_; K = K_; Bt = (const char*)Bt_; }
    __device__ __forceinline__ bool next(int i, Unit& u) const {
        const long L = (long)i * G + c; if (L >= nwg) return false;
        int wgid = (int)L; { const int q = nwg / NXCD, r = nwg % NXCD, xcd = wgid % NXCD, off = wgid / NXCD; wgid = (xcd < r ? xcd * (q + 1) : r * (q + 1) + (xcd - r) * q) + off; }
        const int nig = WGM * nN, gid = wgid / nig, fm = gid * WGM, gsz = (nM - fm) < WGM ? (nM - fm) : WGM;
        u.pm = fm + ((wgid % nig) % gsz); u.pn = (wgid % nig) / gsz; u.e = 0; u.slot = 0; return true;
    }
    __device__ __forceinline__ const char* bptr(const Unit& u) const { return Bt + (size_t)u.pn * BM * K * 2; }
    __device__ __forceinline__ size_t abase(const Unit& u) const { return (size_t)u.pm * BM * K * 2; }
    __device__ __forceinline__ unsigned aoff(const Unit& u, int h, int R, int C) const { return (unsigned)(((u.pm * BM + h * HALF + R) * K + C) * 2); }
    __device__ __forceinline__ void a_ready(const Unit&) const {}
    __device__ __forceinline__ void done(const Unit&) const {}
};

__device__ __forceinline__ unsigned cvt_pk_bf16(float lo, float hi) { unsigned r; asm volatile("v_cvt_pk_bf16_f32 %0, %1, %2" : "=v"(r) : "v"(lo), "v"(hi)); return r; }
typedef float f32x2 __attribute__((ext_vector_type(2)));
__device__ __forceinline__ f32x2 gelu_pk(f32x2 v) {
    const f32x2 av = __builtin_elementwise_abs(v), d = av * 0.2316418882f + 1.0f;
    f32x2 t; t.x = __builtin_amdgcn_rcpf(d.x); t.y = __builtin_amdgcn_rcpf(d.y);
    f32x2 q = t * 0.5307027145f + (-0.7265760135f); q = q * t + 0.7107068705f; q = q * t + (-0.142248368f); q = q * t + 0.127414796f; q = q * t;
    const f32x2 s = (v * v) * (-0.72134752044f);
    f32x2 e; e.x = __builtin_amdgcn_exp2f(s.x); e.y = __builtin_amdgcn_exp2f(s.y);
    const f32x2 m = v * (q * e), r = v - m;
    f32x2 o; o.x = v.x < 0.f ? m.x : r.x; o.y = v.y < 0.f ? m.y : r.y; return o;
}

template <class Epi, class Sched>
__device__ __forceinline__ void gemm_phase(PG8_LAS unsigned char* lds, const bf16_t* Abase, const int K, const Sched& S, const Epi& E) {
    const int tid = threadIdx.x, wid = __builtin_amdgcn_readfirstlane(tid >> 6), lane = tid & 63, wr = wid >> 2, wc = wid & 3, fr = lane & 15, fq = lane >> 4;
    const int nt = K / BK;
    int sR[2], sC[2]; unsigned voffA[2], voffB[2];
#pragma unroll
    for (int i = 0; i < 2; ++i) { stage_rc(tid * 16 + i * 8192, sR[i], sC[i]); const int Rb = Epi::PERM ? ((sR[i] & ~31) + perm32(sR[i] & 31)) : sR[i];
        voffA[i] = (unsigned)(sR[i] * K + sC[i]) * 2u; voffB[i] = (unsigned)(Rb * K + sC[i]) * 2u; }
    const size_t kstep = (size_t)(BK * 2);
    const size_t hstep = (size_t)HALF * K * 2;
    const unsigned ldsw = (unsigned)wid * 1024u;
    const int aoff = lds_byte(wr * 64 + fr, fq * 8), boff = lds_byte(wc * 32 + fr, fq * 8);
    const char* const Ab = (const char*)Abase;
#define PG8_SA(b, h) (((b) * 2 + (h)) * HTB)
#define PG8_SB(b, h) ((4 + (b) * 2 + (h)) * HTB)
#define PG8_STAGE(bufoff, gbase, voff) do { _Pragma("unroll") for (int _i = 0; _i < 2; ++_i) \
        __builtin_amdgcn_global_load_lds((const unsigned*)((const char*)(gbase) + (voff)[_i]), (PG8_LAS unsigned*)(lds + (bufoff) + ldsw + _i * 8192), 16, 0, 0); } while (0)
#define PG8_STAGE_A(bufoff, nx, h, kt) do { if constexpr (Sched::GATHER) { PG8_STAGE(bufoff, Ab + (size_t)(kt) * kstep, gc[h]); } \
        else PG8_STAGE(bufoff, ((nx) ? xA : cA) + (size_t)(h) * hstep + (size_t)(kt) * kstep, voffA); } while (0)
#define PG8_LDA(dst, b, h) do { _Pragma("unroll") for (int m = 0; m < 4; ++m) _Pragma("unroll") for (int k = 0; k < 2; ++k) dst[m][k] = *(const PG8_LAS bf16x8*)(lds + PG8_SA(b, h) + aoff + m * 2048 + k * 1024); } while (0)
#define PG8_LDB(dst, b, h) do { _Pragma("unroll") for (int n = 0; n < 2; ++n) _Pragma("unroll") for (int k = 0; k < 2; ++k) dst[n][k] = *(const PG8_LAS bf16x8*)(lds + PG8_SB(b, h) + boff + n * 2048 + k * 1024); } while (0)
#define PG8_MMA(ai, bj, At, Bt) do { __builtin_amdgcn_s_setprio(1); _Pragma("unroll") for (int m = 0; m < 4; ++m) _Pragma("unroll") for (int n = 0; n < 2; ++n) _Pragma("unroll") for (int k = 0; k < 2; ++k) \
        acc[ai][bj][m][n] = __builtin_amdgcn_mfma_f32_16x16x32_bf16(Bt[n][k], At[m][k], acc[ai][bj][m][n], 0, 0, 0); __builtin_amdgcn_s_setprio(0); } while (0)
#define PG8_WAIT_V(n) asm volatile("s_waitcnt vmcnt(" #n ")" ::: "memory")
#define PG8_WAIT_L(n) asm volatile("s_waitcnt lgkmcnt(" #n ")" ::: "memory")
#define PG8_BAR __builtin_amdgcn_s_barrier()
#define PG8_SCHED __builtin_amdgcn_sched_barrier(0)
    Unit cur, nxt; int ui = 0;
    if (!S.next(0, cur)) return;
    f32x4 acc[2][2][4][2];
#pragma unroll
    for (int a = 0; a < 2; ++a)
#pragma unroll
        for (int b = 0; b < 2; ++b)
#pragma unroll
            for (int m = 0; m < 4; ++m)
#pragma unroll
                for (int n = 0; n < 2; ++n) acc[a][b][m][n] = (f32x4){0.f, 0.f, 0.f, 0.f};
    bf16x8 At[4][2], B0[2][2], B1[2][2];
    unsigned gc[2][2];
    const char* cA = Ab; const char* xA = Ab;
    if constexpr (Sched::GATHER) {
#pragma unroll
        for (int h = 0; h < 2; ++h)
#pragma unroll
            for (int i = 0; i < 2; ++i) gc[h][i] = S.aoff(cur, h, sR[i], sC[i]);
    } else { cA = Ab + S.abase(cur); xA = cA; }
    const char* cB = S.bptr(cur);
    S.a_ready(cur);
    PG8_STAGE(PG8_SB(0, 0), cB, voffB); PG8_STAGE(PG8_SB(0, 1), cB + hstep, voffB); PG8_STAGE_A(PG8_SA(0, 0), false, 0, 0); PG8_STAGE_A(PG8_SA(0, 1), false, 1, 0);
    if (wr == 1) PG8_BAR;
    PG8_WAIT_V(2); PG8_BAR;
    PG8_STAGE(PG8_SB(1, 0), cB + kstep, voffB); PG8_STAGE_A(PG8_SA(1, 0), false, 0, 1); PG8_STAGE(PG8_SB(1, 1), cB + hstep + kstep, voffB);
    PG8_WAIT_V(6); PG8_BAR;
    for (;;) {
        const bool has_next = S.next(ui + 1, nxt);
        const char* nB = has_next ? S.bptr(nxt) : cB;
        for (int t = 0; t < nt; t += 2) {
            const bool last = (t == nt - 2);
            const int kt2 = last ? 0 : t + 2;
            const char* b2 = last ? nB : cB + (size_t)(t + 2) * kstep; const char* b3 = b2 + kstep;
            if (last && has_next) {
                if constexpr (!Sched::GATHER) xA = Ab + S.abase(nxt);
                S.a_ready(nxt);
            }
            PG8_LDB(B0, 0, 0); PG8_LDB(B1, 0, 1); PG8_SCHED; PG8_LDA(At, 0, 0); PG8_STAGE_A(PG8_SA(1, 1), false, 1, t + 1);
            if constexpr (Sched::GATHER) { if (last && has_next) {
#pragma unroll
                for (int h = 0; h < 2; ++h)
#pragma unroll
                    for (int i = 0; i < 2; ++i) gc[h][i] = S.aoff(nxt, h, sR[i], sC[i]); } }
            PG8_WAIT_V(8); PG8_WAIT_L(0); PG8_BAR; PG8_MMA(0, 0, At, B0); PG8_MMA(0, 1, At, B1); PG8_BAR; PG8_SCHED;
            PG8_LDA(At, 0, 1); PG8_STAGE(PG8_SB(0, 0), b2, voffB); PG8_STAGE(PG8_SB(0, 1), b2 + hstep, voffB); PG8_STAGE_A(PG8_SA(0, 0), last, 0, kt2);
            PG8_WAIT_V(8); PG8_WAIT_L(0); PG8_BAR; PG8_MMA(1, 0, At, B0); PG8_MMA(1, 1, At, B1); PG8_BAR; PG8_SCHED;
            PG8_LDB(B0, 1, 0); PG8_LDB(B1, 1, 1); PG8_SCHED; PG8_LDA(At, 1, 0); PG8_STAGE_A(PG8_SA(0, 1), last, 1, kt2);
            PG8_WAIT_V(8); PG8_WAIT_L(0); PG8_BAR; PG8_MMA(0, 0, At, B0); PG8_MMA(0, 1, At, B1); PG8_BAR; PG8_SCHED;
            PG8_LDA(At, 1, 1); PG8_STAGE(PG8_SB(1, 0), b3, voffB); PG8_STAGE(PG8_SB(1, 1), b3 + hstep, voffB); PG8_STAGE_A(PG8_SA(1, 0), last, 0, kt2 + 1);
            PG8_WAIT_V(8); PG8_WAIT_L(0); PG8_BAR; PG8_MMA(1, 0, At, B0); PG8_MMA(1, 1, At, B1); PG8_BAR; PG8_SCHED;
        }
        if (wr == 0) PG8_BAR;
        E(acc, cur, wr, wc, fr, fq); S.done(cur);
        if (!has_next) break;
#pragma unroll
        for (int a = 0; a < 2; ++a)
#pragma unroll
            for (int b = 0; b < 2; ++b)
#pragma unroll
                for (int m = 0; m < 4; ++m)
#pragma unroll
                    for (int n = 0; n < 2; ++n) acc[a][b][m][n] = (f32x4){0.f, 0.f, 0.f, 0.f};
        cur = nxt; cB = nB; ++ui;
        if constexpr (!Sched::GATHER) cA = xA;
        if (wr == 1) PG8_BAR;
    }
    PG8_WAIT_V(0);
    PG8_BAR;
#undef PG8_STAGE_A
#undef PG8_SA
#undef PG8_SB
#undef PG8_STAGE
#undef PG8_LDA
#undef PG8_LDB
#undef PG8_MMA
#undef PG8_WAIT_V
#undef PG8_WAIT_L
#undef PG8_BAR
#undef PG8_SCHED
}
}
constexpr int LX_PTR = 155648 - 256;
#define FTID ((int)threadIdx.x)
#define FLANE ((int)threadIdx.x & 63)
#define FWAVE ((int)__builtin_amdgcn_readfirstlane((int)threadIdx.x >> 6))
struct Frame {
    LAS unsigned char* lds;
    int G, bid;
    float* out; unsigned char* ws;
    __device__ __forceinline__ const float* inp(int i) const {
        const LAS unsigned* p = (const LAS unsigned*)(lds + LX_PTR) + 2 * i;
        const unsigned lo = __builtin_amdgcn_readfirstlane(p[0]), hi = __builtin_amdgcn_readfirstlane(p[1]);
        return (const float*)(((unsigned long long)hi << 32) | lo);
    }
};
enum { I_X = 0, I_GLA_NORM, I_GLA_WIN, I_GLA_WGU, I_GLA_BG, I_GLA_HG, I_GLA_WOUT, I_SGU_NORM, I_SGU_WIN, I_SGU_LNG, I_SGU_LNB, I_SGU_WS, I_SGU_BS, I_SGU_WOUT,
       I_MOE_NORM, I_MOE_WG, I_MOE_BG, I_MOE_WSUB, I_MOE_BSUB, I_MOE_W1, I_MOE_W3, I_MOE_W2, I_FINAL };
#define WSP(type, off) ((type*)(F.ws + (off)))

__device__ __forceinline__ void n_convert(Frame& F, const float* W, int ldw, int K, int N, const float* kscale, int qcols, float qs, bf16* WT, int rowmap) {
    const size_t total = (size_t)N * K, stride = (size_t)F.G * NTHREADS;
    for (size_t idx = (size_t)F.bid * NTHREADS + FTID; idx < total; idx += stride) {
        const int n = (int)(idx / K), k = (int)(idx % K);
        float v = W[(size_t)k * ldw + n]; if (kscale) v *= kscale[k]; if (n < qcols) v *= qs;
        const int dr = rowmap == 0 ? n : ((n >> 7) * 256 + (n & 127) + (rowmap == 2 ? 128 : 0));
        WT[(size_t)dr * K + k] = (bf16)f2bf(v);
    }
}
__device__ __forceinline__ void n_convert_gla(Frame& F) {
    n_convert(F, F.inp(I_GLA_WIN), GLA_IN, D, NQKVR, F.inp(I_GLA_NORM), HK, 0.08838834764831845f, WSP(bf16, WS_WIN), 0);
    n_convert(F, F.inp(I_GLA_WOUT), D, HV, D, F.inp(I_GLA_HG), 0, 1.f, WSP(bf16, WS_WOUT), 0);
}
__device__ __forceinline__ void n_convert_rest(Frame& F) {
    n_convert(F, F.inp(I_SGU_WIN), SGU_FFN, D, SGU_FFN, F.inp(I_SGU_NORM), 0, 1.f, WSP(bf16, WS_WSIN), 0);
    n_convert(F, F.inp(I_SGU_WOUT), D, SGU_HALF, D, nullptr, 0, 1.f, WSP(bf16, WS_WSOUT), 0);
    for (int le = 0; le < 2 * NE; ++le) {
        const int L = le / NE;
        n_convert(F, F.inp(I_MOE_W1) + (size_t)le * D * FF, FF, D, FF, F.inp(I_MOE_NORM) + L * D, 0, 1.f, WSP(bf16, WS_W13) + (size_t)le * 1024 * 1024, 1);
        n_convert(F, F.inp(I_MOE_W3) + (size_t)le * D * FF, FF, D, FF, F.inp(I_MOE_NORM) + L * D, 0, 1.f, WSP(bf16, WS_W13) + (size_t)le * 1024 * 1024, 2);
        n_convert(F, F.inp(I_MOE_W2) + (size_t)le * FF * D, D, FF, D, nullptr, 0, 1.f, WSP(bf16, WS_W2) + (size_t)le * 1024 * 512, 0);
    }
}

template <int MODE> __device__ __forceinline__ void n_rowpass(Frame& F, int L) {
    const float* src = MODE == 0 ? F.inp(I_X) : F.out;
    bf16* xn = WSP(bf16, WS_XN);
    const bf16* y = WSP(bf16, WS_Y);
    unsigned* ctl = WSP(unsigned, WS_CTL);
    for (int row = F.bid * NWAVES + FWAVE; row < T; row += F.G * NWAVES) {
        f32x4 v[4]; float ss = 0.f;
#pragma unroll
        for (int j = 0; j < 4; ++j) {
            const int k = 4 * FLANE + 256 * j;
            v[j] = *(const f32x4*)(src + (size_t)row * D + k);
            if (MODE >= 2) {
                const v2u a = *(const v2u*)(y + (size_t)row * D + k), b = *(const v2u*)(y + ((size_t)T + row) * D + k);
                v[j].x += bflo(a.x) + bflo(b.x); v[j].y += bfhi(a.x) + bfhi(b.x); v[j].z += bflo(a.y) + bflo(b.y); v[j].w += bfhi(a.y) + bfhi(b.y);
            }
            ss += v[j].x * v[j].x + v[j].y * v[j].y + v[j].z * v[j].z + v[j].w * v[j].w;
        }
        const float rstd = 1.f / sqrtf(wave_sum(ss) * (1.f / D) + EPS);
        if (MODE == 0) {
            const float* gn = F.inp(I_GLA_NORM); const float* w = F.inp(I_GLA_WIN);
            for (int c = 0; c < RANK; ++c) {
                float p = 0.f;
#pragma unroll
                for (int j = 0; j < 4; ++j) { const int k = 4 * FLANE + 256 * j;
                    p += v[j].x * gn[k] * w[(size_t)k * GLA_IN + NQKVR + c] + v[j].y * gn[k + 1] * w[(size_t)(k + 1) * GLA_IN + NQKVR + c]
                       + v[j].z * gn[k + 2] * w[(size_t)(k + 2) * GLA_IN + NQKVR + c] + v[j].w * gn[k + 3] * w[(size_t)(k + 3) * GLA_IN + NQKVR + c]; }
                p = wave_sum(p) * rstd;
                if (FLANE == 0) WSP(float, WS_GLR)[(size_t)row * RANK + c] = p;
            }
        }
        if (MODE == 1) {
            const float* gn = F.inp(I_MOE_NORM) + L * D; const float* wg = F.inp(I_MOE_WG) + (size_t)L * D * 4; const float* wsb = F.inp(I_MOE_WSUB) + (size_t)L * 4 * D * EPG;
            float lg[4], ls[EPG];
            for (int c = 0; c < 4; ++c) { float p = 0.f;
#pragma unroll
                for (int j = 0; j < 4; ++j) { const int k = 4 * FLANE + 256 * j;
                    p += v[j].x * gn[k] * wg[(k) * 4 + c] + v[j].y * gn[k + 1] * wg[(k + 1) * 4 + c] + v[j].z * gn[k + 2] * wg[(k + 2) * 4 + c] + v[j].w * gn[k + 3] * wg[(k + 3) * 4 + c]; }
                lg[c] = wave_sum(p) * rstd + F.inp(I_MOE_BG)[L * 4 + c]; }
            int g = 0; float gm = lg[0];
            for (int c = 1; c < 4; ++c) if (lg[c] > gm) { gm = lg[c]; g = c; }
            float gs = 0.f; for (int c = 0; c < 4; ++c) gs += __expf(lg[c] - gm);
            const float g_w = 1.f / gs;
            for (int e = 0; e < EPG; ++e) { float p = 0.f;
#pragma unroll
                for (int j = 0; j < 4; ++j) { const int k = 4 * FLANE + 256 * j; const float* ww = wsb + ((size_t)g * D + k) * EPG + e;
                    p += v[j].x * gn[k] * ww[0] + v[j].y * gn[k + 1] * ww[EPG] + v[j].z * gn[k + 2] * ww[2 * EPG] + v[j].w * gn[k + 3] * ww[3 * EPG]; }
                ls[e] = wave_sum(p) * rstd + F.inp(I_MOE_BSUB)[(L * 4 + g) * EPG + e]; }
            int i1 = 0; float m1 = ls[0];
            for (int e = 1; e < EPG; ++e) if (ls[e] > m1) { m1 = ls[e]; i1 = e; }
            int i2 = -1; float m2 = -3.0e38f;
            for (int e = 0; e < EPG; ++e) if (e != i1 && ls[e] > m2) { m2 = ls[e]; i2 = e; }
            const float w1 = 1.f / (1.f + __expf(m2 - m1)), w2 = 1.f - w1;
            if (FLANE == 0) {
                const int e1 = g * EPG + i1, e2 = g * EPG + i2;
                WSP(int, WS_EID)[row * 2] = e1; WSP(int, WS_EID)[row * 2 + 1] = e2;
                WSP(float, WS_GATE)[row * 2] = g_w * w1; WSP(float, WS_GATE)[row * 2 + 1] = g_w * w2;
                const unsigned p1 = atomicAdd(&ctl[CW_CNT + L * 2048 + 64 * e1], 1u), p2 = atomicAdd(&ctl[CW_CNT + L * 2048 + 64 * e2], 1u);
                WSP(int, WS_LIST)[(size_t)e1 * T + p1] = row * 2; WSP(int, WS_LIST)[(size_t)e2 * T + p2] = row * 2 + 1;
            }
        }
#pragma unroll
        for (int j = 0; j < 4; ++j) {
            const int k = 4 * FLANE + 256 * j;
            if (MODE == 2) *(f32x4*)(F.out + (size_t)row * D + k) = v[j];
            if (MODE == 3) { const f32x4 g = *(const f32x4*)(F.inp(I_FINAL) + k); *(f32x4*)(F.out + (size_t)row * D + k) = v[j] * rstd * g; }
            else { v2u o; o.x = pk2(v[j].x * rstd, v[j].y * rstd); o.y = pk2(v[j].z * rstd, v[j].w * rstd); *(v2u*)(xn + (size_t)row * D + k) = o; }
        }
    }
}

template <class Fn> __device__ __forceinline__ void n_gemm(Frame& F, const bf16* A, int lda, const bf16* Bt, int ldb, int M, int N, int K, Fn f) {
    LAS float* As = (LAS float*)F.lds; LAS float* Bs = As + 64 * 33;
    const int ntn = N / 64, ntiles = (M / 64) * ntn, ty = FTID >> 4, tx = FTID & 15, lr = FTID >> 3, lc = (FTID & 7) * 4;
    for (int tile = F.bid; tile < ntiles; tile += F.G) {
        const int tm = tile / ntn, tn = tile % ntn;
        float acc[2][4] = {};
        for (int k0 = 0; k0 < K; k0 += 32) {
            const v2u a = *(const v2u*)(A + (size_t)(tm * 64 + lr) * lda + k0 + lc), b = *(const v2u*)(Bt + (size_t)(tn * 64 + lr) * ldb + k0 + lc);
            As[lr * 33 + lc] = bflo(a.x); As[lr * 33 + lc + 1] = bfhi(a.x); As[lr * 33 + lc + 2] = bflo(a.y); As[lr * 33 + lc + 3] = bfhi(a.y);
            Bs[lr * 33 + lc] = bflo(b.x); Bs[lr * 33 + lc + 1] = bfhi(b.x); Bs[lr * 33 + lc + 2] = bflo(b.y); Bs[lr * 33 + lc + 3] = bfhi(b.y);
            __syncthreads();
#pragma unroll 8
            for (int kk = 0; kk < 32; ++kk) {
                const float a0 = As[(2 * ty) * 33 + kk], a1 = As[(2 * ty + 1) * 33 + kk];
#pragma unroll
                for (int i = 0; i < 4; ++i) { const float bb = Bs[(4 * tx + i) * 33 + kk]; acc[0][i] += a0 * bb; acc[1][i] += a1 * bb; }
            }
            __syncthreads();
        }
#pragma unroll
        for (int r = 0; r < 2; ++r)
#pragma unroll
            for (int i = 0; i < 4; ++i) f(tm * 64 + 2 * ty + r, tn * 64 + 4 * tx + i, acc[r][i]);
    }
}

__device__ __forceinline__ void n_scan(Frame& F) {
    LAS float* gl = (LAS float*)F.lds;
    LAS float* kd = gl + 64 * 16;
    LAS float* qs = kd + 64 * 128;
    LAS float* os = qs + 64 * 128;
    LAS float* part = os + 64 * 256;
    LAS float* dec = part + 4 * 128;
    const bf16* qkvr = WSP(bf16, WS_QKVR); const float* glr = WSP(float, WS_GLR); bf16* aout = WSP(bf16, WS_XN);
    for (int item = F.bid; item < NBATCH * GLA_H; item += F.G) {
        const int b = item / GLA_H, h = item % GLA_H;
        float S[64];
#pragma unroll
        for (int i = 0; i < 64; ++i) S[i] = 0.f;
        const int dk = FTID & 127, tg = FTID >> 7, j = FTID & 255, hf = FTID >> 8;
        for (int c = 0; c < NCHUNK; ++c) {
            const size_t t0 = (size_t)b * SEQ + c * CHUNK;
            for (int i = FTID; i < 64 * 16; i += NTHREADS) gl[i] = glr[t0 * RANK + i];
            __syncthreads();
            float wgu[RANK];
#pragma unroll
            for (int r = 0; r < RANK; ++r) wgu[r] = F.inp(I_GLA_WGU)[r * HK + h * DK + dk];
            const float bgv = F.inp(I_GLA_BG)[h * DK + dk];
            float run = 0.f;
            for (int jj = 0; jj < 16; ++jj) {
                const int tok = tg * 16 + jj; float a = bgv;
#pragma unroll
                for (int r = 0; r < RANK; ++r) a += gl[tok * 16 + r] * wgu[r];
                run += logsigmoid_f(a) * (1.f / 16.f);
            }
            part[tg * 128 + dk] = run;
            __syncthreads();
            float off = 0.f, tot = 0.f;
#pragma unroll
            for (int g = 0; g < 4; ++g) { const float pv = part[g * 128 + dk]; if (g < tg) off += pv; tot += pv; }
            run = off;
            for (int jj = 0; jj < 16; ++jj) {
                const int tok = tg * 16 + jj; float a = bgv;
#pragma unroll
                for (int r = 0; r < RANK; ++r) a += gl[tok * 16 + r] * wgu[r];
                run += logsigmoid_f(a) * (1.f / 16.f);
                const float kv = bf2f(qkvr[(t0 + tok) * NQKVR + HK + h * DK + dk]);
                kd[tok * 128 + dk] = kv * __expf(tot - run);
                qs[tok * 128 + dk] = bf2f(qkvr[(t0 + tok) * NQKVR + h * DK + dk]);
            }
            if (tg == 0) dec[dk] = __expf(tot);
            __syncthreads();
#pragma unroll
            for (int ib = 0; ib < 4; ++ib) {
#pragma unroll
                for (int i = 0; i < 16; ++i) S[ib * 16 + i] *= dec[64 * hf + ib * 16 + i];
                asm volatile("" ::: "memory"); }
            for (int s = 0; s < CHUNK; ++s) {
                const float vv = bf2f(qkvr[(t0 + s) * NQKVR + 2 * HK + h * DV + j]);
#pragma unroll
                for (int ib = 0; ib < 4; ++ib) {
#pragma unroll
                    for (int i = 0; i < 16; ++i) S[ib * 16 + i] += kd[s * 128 + 64 * hf + ib * 16 + i] * vv;
                    asm volatile("" ::: "memory"); }
            }
            for (int ph = 0; ph < 2; ++ph) {
                if (hf == ph) {
                    for (int t = 0; t < CHUNK; ++t) {
                        float o = 0.f;
#pragma unroll
                        for (int ib = 0; ib < 4; ++ib) {
#pragma unroll
                            for (int i = 0; i < 16; ++i) o += qs[t * 128 + 64 * hf + ib * 16 + i] * S[ib * 16 + i];
                            asm volatile("" ::: "memory"); }
                        if (ph == 0) os[t * 256 + j] = o; else os[t * 256 + j] += o;
                    }
                }
                __syncthreads();
            }
            {
                const int tok = FTID >> 3, cc = FTID & 7; float ss = 0.f;
                for (int jj = 0; jj < 32; ++jj) { const float o = os[tok * 256 + cc * 32 + jj]; ss += o * o; }
                ss += __shfl_xor(ss, 1); ss += __shfl_xor(ss, 2); ss += __shfl_xor(ss, 4);
                const float rms = 1.f / sqrtf(ss * (1.f / DV) + EPS);
                for (int jj = 0; jj < 32; ++jj) {
                    const int col = h * DV + cc * 32 + jj;
                    const float rr = bf2f(qkvr[(t0 + tok) * NQKVR + 2 * HK + HV + col]);
                    aout[(t0 + tok) * D + col] = (bf16)f2bf(os[tok * 256 + cc * 32 + jj] * rms * silu_f(rr));
                }
            }
            __syncthreads();
        }
    }
}

__device__ __forceinline__ void n_moe(Frame& F, int L) {
    LAS float* xs = (LAS float*)F.lds; LAS float* hl = xs + D;
    const bf16* xn = WSP(bf16, WS_XN); bf16* y = WSP(bf16, WS_Y);
    const bf16* W13 = WSP(bf16, WS_W13) + (size_t)L * NE * 1024 * 1024; const bf16* W2 = WSP(bf16, WS_W2) + (size_t)L * NE * 1024 * 512;
    for (int a = F.bid; a < 2 * T; a += F.G) {
        const int tok = a >> 1, k = a & 1, e = WSP(int, WS_EID)[a]; const float gate = WSP(float, WS_GATE)[a];
        for (int i = FTID; i < D; i += NTHREADS) xs[i] = bf2f(xn[(size_t)tok * D + i]);
        __syncthreads();
        for (int jj = 0; jj < 64; ++jj) {
            const int j = FWAVE * 64 + jj; const bf16* r1 = W13 + ((size_t)e * 1024 + (j >> 7) * 256 + (j & 127)) * 1024; const bf16* r3 = r1 + 128 * 1024;
            float d1 = 0.f, d3 = 0.f;
#pragma unroll
            for (int i = 0; i < 2; ++i) { const int kk = FLANE * 8 + 512 * i; const v4u a1 = *(const v4u*)(r1 + kk), a3 = *(const v4u*)(r3 + kk);
                d1 += xs[kk] * bflo(a1.x) + xs[kk + 1] * bfhi(a1.x) + xs[kk + 2] * bflo(a1.y) + xs[kk + 3] * bfhi(a1.y) + xs[kk + 4] * bflo(a1.z) + xs[kk + 5] * bfhi(a1.z) + xs[kk + 6] * bflo(a1.w) + xs[kk + 7] * bfhi(a1.w);
                d3 += xs[kk] * bflo(a3.x) + xs[kk + 1] * bfhi(a3.x) + xs[kk + 2] * bflo(a3.y) + xs[kk + 3] * bfhi(a3.y) + xs[kk + 4] * bflo(a3.z) + xs[kk + 5] * bfhi(a3.z) + xs[kk + 6] * bflo(a3.w) + xs[kk + 7] * bfhi(a3.w); }
            d1 = wave_sum(d1); d3 = wave_sum(d3);
            if (FLANE == 0) hl[j] = bf2f((bf16)f2bf(silu_f(d1) * d3));
        }
        __syncthreads();
        for (int cc = 0; cc < 128; ++cc) {
            const int c = FWAVE * 128 + cc; const bf16* r2 = W2 + ((size_t)e * 1024 + c) * 512; const int kk = FLANE * 8; const v4u a2 = *(const v4u*)(r2 + kk);
            float d = hl[kk] * bflo(a2.x) + hl[kk + 1] * bfhi(a2.x) + hl[kk + 2] * bflo(a2.y) + hl[kk + 3] * bfhi(a2.y) + hl[kk + 4] * bflo(a2.z) + hl[kk + 5] * bfhi(a2.z) + hl[kk + 6] * bflo(a2.w) + hl[kk + 7] * bfhi(a2.w);
            d = wave_sum(d);
            if (FLANE == 0) y[((size_t)k * T + tok) * D + c] = (bf16)f2bf(gate * d);
        }
        __syncthreads();
    }
}

__device__ __forceinline__ void n_stats(Frame& F) {
    const bf16* v = WSP(bf16, WS_V); float* st = WSP(float, WS_STATS);
    for (size_t it = (size_t)F.bid * NTHREADS + FTID; it < (size_t)T * 32; it += (size_t)F.G * NTHREADS) {
        const int row = (int)(it >> 5), p = (int)(it & 31), pnv = p >> 2, wc = p & 3; float s = 0.f, q = 0.f;
        for (int bj = 0; bj < 2; ++bj) for (int j = 0; j < 32; ++j) { const float x = bf2f(v[(size_t)row * SGU_HALF + pnv * 256 + bj * 128 + wc * 32 + j]); s += x; q += x * x; }
        st[((size_t)p * T + row) * 2] = s; st[((size_t)p * T + row) * 2 + 1] = q;
    }
}
__device__ __forceinline__ void n_mix(Frame& F) {
    LAS float* wl = (LAS float*)F.lds;
    LAS float* vls = wl + 128 * 128;
    LAS float* mu = vls + 128 * 128; LAS float* rs = mu + 128; LAS float* red = rs + 128;
    bf16* u = WSP(bf16, WS_U); const bf16* v = WSP(bf16, WS_V);
    for (int bn = F.bid; bn < T / SGU_BLK; bn += F.G) {
        const size_t t0 = (size_t)bn * SGU_BLK;
        __syncthreads();
        { const int row = FTID >> 2, q4 = FTID & 3; float s = 0.f, q = 0.f;
          for (int i = 0; i < 512; ++i) { const float x = bf2f(v[(t0 + row) * SGU_HALF + q4 * 512 + i]); s += x; q += x * x; }
          red[(row * 4 + q4) * 2] = s; red[(row * 4 + q4) * 2 + 1] = q; }
        __syncthreads();
        if (FTID < 128) { float s = 0.f, q = 0.f; for (int p = 0; p < 4; ++p) { s += red[(FTID * 4 + p) * 2]; q += red[(FTID * 4 + p) * 2 + 1]; }
            const float m = s * (1.f / SGU_HALF); mu[FTID] = m; rs[FTID] = 1.f / sqrtf(q * (1.f / SGU_HALF) - m * m + EPS); }
        for (int g = 0; g < 4; ++g) {
            __syncthreads();
            for (int i = FTID; i < 128 * 128; i += NTHREADS) { const int t = i >> 7, s = i & 127; wl[i] = ((t >> 6) >= (s >> 6)) ? F.inp(I_SGU_WS)[(size_t)g * 128 * 128 + i] : 0.f; }
            for (int cb = 0; cb < 4; ++cb) {
                const int c0 = g * SGU_GC + cb * 128;
                __syncthreads();
                for (int i = FTID; i < 128 * 128; i += NTHREADS) { const int s = i >> 7, c = i & 127;
                    vls[i] = (bf2f(v[(t0 + s) * SGU_HALF + c0 + c]) - mu[s]) * rs[s] * F.inp(I_SGU_LNG)[c0 + c] + F.inp(I_SGU_LNB)[c0 + c]; }
                __syncthreads();
                const int c = FTID & 127, tq = FTID >> 7;
                for (int tt = 0; tt < 32; ++tt) {
                    const int t = tq * 32 + tt; float acc = 0.f;
                    for (int s = 0; s < 128; ++s) acc += wl[t * 128 + s] * vls[s * 128 + c];
                    const float mixed = acc + F.inp(I_SGU_BS)[g * 128 + t];
                    u[(t0 + t) * SGU_HALF + c0 + c] = (bf16)f2bf(bf2f(u[(t0 + t) * SGU_HALF + c0 + c]) * mixed);
                }
            }
        }
    }
}
constexpr int RING_BYTES = 131072;
constexpr int LX_TST = RING_BYTES;
constexpr int MOE_MAXU = 6;
constexpr int LX_TAB = RING_BYTES + 512;
constexpr int LX_GT = LX_TAB + MOE_MAXU * 1024;

struct EpiStoreBf16 {
    static constexpr bool PERM = true;
    bf16* O; int ldc;
    __device__ __forceinline__ void operator()(const pg8::f32x4 (&acc)[2][2][4][2], const pg8::Unit& u, int wr, int wc, int fr, int fq) const {
        const int row0 = u.pm * 256 + wr * 64 + fr, col0 = u.pn * 256 + wc * 32 + 8 * fq;
#pragma unroll
        for (int ai = 0; ai < 2; ++ai)
#pragma unroll
            for (int m = 0; m < 4; ++m) { bf16* rowp = O + (size_t)(row0 + ai * 128 + m * 16) * ldc + col0;
#pragma unroll
                for (int bj = 0; bj < 2; ++bj) { const pg8::f32x4 v0 = acc[ai][bj][m][0], v1 = acc[ai][bj][m][1];
                    v4u w; w.x = pg8::cvt_pk_bf16(v0[0], v0[1]); w.y = pg8::cvt_pk_bf16(v0[2], v0[3]); w.z = pg8::cvt_pk_bf16(v1[0], v1[1]); w.w = pg8::cvt_pk_bf16(v1[2], v1[3]);
                    *(v4u*)(rowp + bj * 128) = w; } }
    }
};
struct EpiResF32 {
    static constexpr bool PERM = false;
    const float* res; float* out;
    __device__ __forceinline__ void operator()(const pg8::f32x4 (&acc)[2][2][4][2], const pg8::Unit& u, int wr, int wc, int fr, int fq) const {
        const int row0 = u.pm * 256 + wr * 64 + fr, col0 = u.pn * 256 + wc * 32 + 4 * fq;
#pragma unroll
        for (int ai = 0; ai < 2; ++ai)
#pragma unroll
            for (int m = 0; m < 4; ++m) { const size_t off = (size_t)(row0 + ai * 128 + m * 16) * D + col0;
#pragma unroll
                for (int bj = 0; bj < 2; ++bj)
#pragma unroll
                    for (int n = 0; n < 2; ++n) { const pg8::f32x4 r = *(const pg8::f32x4*)(res + off + bj * 128 + n * 16); *(pg8::f32x4*)(out + off + bj * 128 + n * 16) = r + acc[ai][bj][m][n]; } }
    }
};
struct EpiGeluSplit {
    static constexpr bool PERM = true;
    bf16* U; bf16* V; float* st;
    __device__ __forceinline__ void operator()(const pg8::f32x4 (&acc)[2][2][4][2], const pg8::Unit& u, int wr, int wc, int fr, int fq) const {
        const bool isv = u.pn >= 8; const int pnl = isv ? u.pn - 8 : u.pn;
        bf16* O = isv ? V : U;
        const int row0 = u.pm * 256 + wr * 64 + fr, col0 = pnl * 256 + wc * 32 + 8 * fq;
#pragma unroll
        for (int ai = 0; ai < 2; ++ai)
#pragma unroll
            for (int m = 0; m < 4; ++m) { const int row = row0 + ai * 128 + m * 16; bf16* rowp = O + (size_t)row * SGU_HALF + col0; float s = 0.f, q = 0.f;
#pragma unroll
                for (int bj = 0; bj < 2; ++bj) { const pg8::f32x4 v0 = acc[ai][bj][m][0], v1 = acc[ai][bj][m][1];
                    const pg8::f32x2 a = pg8::gelu_pk((pg8::f32x2){v0[0], v0[1]}), b = pg8::gelu_pk((pg8::f32x2){v0[2], v0[3]}), c = pg8::gelu_pk((pg8::f32x2){v1[0], v1[1]}), d = pg8::gelu_pk((pg8::f32x2){v1[2], v1[3]});
                    s += (a.x + a.y) + (b.x + b.y) + (c.x + c.y) + (d.x + d.y);
                    q += (a.x * a.x + a.y * a.y) + (b.x * b.x + b.y * b.y) + (c.x * c.x + c.y * c.y) + (d.x * d.x + d.y * d.y);
                    v4u w; w.x = pg8::cvt_pk_bf16(a.x, a.y); w.y = pg8::cvt_pk_bf16(b.x, b.y); w.z = pg8::cvt_pk_bf16(c.x, c.y); w.w = pg8::cvt_pk_bf16(d.x, d.y);
                    *(v4u*)(rowp + bj * 128) = w; }
                if (isv) { s += __shfl_xor(s, 16); s += __shfl_xor(s, 32); q += __shfl_xor(q, 16); q += __shfl_xor(q, 32);
                    if (fq == 0) { pg8::f32x2 o = {s, q}; *(pg8::f32x2*)(st + ((size_t)(pnl * 4 + wc) * T + row) * 2) = o; } } }
    }
};

__device__ __forceinline__ void f_gemm_in(Frame& F) {
    pg8::DenseOrder S; S.init(T, NQKVR, D, WSP(bf16, WS_WIN), F.G, F.bid);
    EpiStoreBf16 E{WSP(bf16, WS_QKVR), NQKVR};
    pg8::gemm_phase(F.lds, WSP(bf16, WS_XN), D, S, E);
}
__device__ __forceinline__ void f_gemm_out(Frame& F) {
    pg8::DenseOrder S; S.init(T, D, HV, WSP(bf16, WS_WOUT), F.G, F.bid);
    EpiResF32 E{F.inp(I_X), F.out};
    pg8::gemm_phase(F.lds, WSP(bf16, WS_XN), HV, S, E);
}
__device__ __forceinline__ void f_gemm_sgu_in(Frame& F) {
    pg8::DenseOrder S; S.init(T, SGU_FFN, D, WSP(bf16, WS_WSIN), F.G, F.bid);
    EpiGeluSplit E{WSP(bf16, WS_U), WSP(bf16, WS_V), WSP(float, WS_STATS)};
    pg8::gemm_phase(F.lds, WSP(bf16, WS_XN), D, S, E);
}
__device__ __forceinline__ void f_gemm_sgu_out(Frame& F) {
    pg8::DenseOrder S; S.init(T, D, SGU_HALF, WSP(bf16, WS_WSOUT), F.G, F.bid);
    EpiResF32 E{F.out, F.out};
    pg8::gemm_phase(F.lds, WSP(bf16, WS_U), SGU_HALF, S, E);
}

template <bool GATHER_> struct MoeOrder {
    static constexpr bool GATHER = GATHER_;
    int G, c, nunits, ibase, K, mode;
    const char* W; size_t estride;
    LAS const int* tst; LAS const int* tab;
    __device__ __forceinline__ bool next(int i, pg8::Unit& u) const {
        if (i >= MOE_MAXU) return false;
        const int Lu = (ibase + i) * G + c; if (Lu >= nunits) return false;
        const int rt = Lu >> 2; int e = 0;
        while (e < NE - 1 && tst[e + 1] <= rt) ++e;
        u.pm = rt; u.pn = Lu & 3; u.e = e; u.slot = i; return true;
    }
    __device__ __forceinline__ const char* bptr(const pg8::Unit& u) const { return W + (size_t)u.e * estride + (size_t)u.pn * 256 * K * 2; }
    __device__ __forceinline__ size_t abase(const pg8::Unit& u) const { return (size_t)u.pm * 256 * K * 2; }
    __device__ __forceinline__ unsigned aoff(const pg8::Unit& u, int h, int R, int C) const {
        if (mode == 0) { int ent = tab[u.slot * 256 + h * 128 + R]; ent = ent < 0 ? 0 : ent; return (unsigned)(((ent >> 1) * K + C) * 2); }
        return (unsigned)(((u.pm * 256 + h * 128 + R) * K + C) * 2);
    }
    __device__ __forceinline__ void a_ready(const pg8::Unit&) const {}
    __device__ __forceinline__ void done(const pg8::Unit&) const {}
};
struct EpiSwiglu {
    static constexpr bool PERM = true;
    bf16* H;
    __device__ __forceinline__ void operator()(const pg8::f32x4 (&acc)[2][2][4][2], const pg8::Unit& u, int wr, int wc, int fr, int fq) const {
        const int row0 = u.pm * 256 + wr * 64 + fr, col0 = u.pn * 128 + wc * 32 + 8 * fq;
#pragma unroll
        for (int ai = 0; ai < 2; ++ai)
#pragma unroll
            for (int m = 0; m < 4; ++m) { bf16* rowp = H + (size_t)(row0 + ai * 128 + m * 16) * FF + col0; float h[8];
#pragma unroll
                for (int n = 0; n < 2; ++n)
#pragma unroll
                    for (int i = 0; i < 4; ++i) { const float a = acc[ai][0][m][n][i], b = acc[ai][1][m][n][i]; h[n * 4 + i] = a * __builtin_amdgcn_rcpf(1.f + __expf(-a)) * b; }
                v4u w; w.x = pg8::cvt_pk_bf16(h[0], h[1]); w.y = pg8::cvt_pk_bf16(h[2], h[3]); w.z = pg8::cvt_pk_bf16(h[4], h[5]); w.w = pg8::cvt_pk_bf16(h[6], h[7]);
                *(v4u*)rowp = w; }
    }
};
struct EpiScatterY {
    static constexpr bool PERM = true;
    bf16* Y; LAS const int* tab; LAS const float* gt;
    __device__ __forceinline__ void operator()(const pg8::f32x4 (&acc)[2][2][4][2], const pg8::Unit& u, int wr, int wc, int fr, int fq) const {
        const int col0 = u.pn * 256 + wc * 32 + 8 * fq;
#pragma unroll
        for (int ai = 0; ai < 2; ++ai)
#pragma unroll
            for (int m = 0; m < 4; ++m) { const int r = ai * 128 + wr * 64 + m * 16 + fr; const int ent = tab[u.slot * 256 + r]; const float g = gt[u.slot * 256 + r];
                if (ent >= 0) { bf16* rowp = Y + ((size_t)(ent & 1) * T + (ent >> 1)) * D + col0;
#pragma unroll
                    for (int bj = 0; bj < 2; ++bj) { const pg8::f32x4 v0 = acc[ai][bj][m][0] * g, v1 = acc[ai][bj][m][1] * g;
                        v4u w; w.x = pg8::cvt_pk_bf16(v0[0], v0[1]); w.y = pg8::cvt_pk_bf16(v0[2], v0[3]); w.z = pg8::cvt_pk_bf16(v1[0], v1[1]); w.w = pg8::cvt_pk_bf16(v1[2], v1[3]);
                        *(v4u*)(rowp + bj * 128) = w; } } }
    }
};
template <int MODE> __device__ __forceinline__ void f_moe_gemm(Frame& F, int L) {
    LAS int* tst = (LAS int*)(F.lds + LX_TST); LAS int* cntl = tst + 64; LAS int* tab = (LAS int*)(F.lds + LX_TAB); LAS float* gt = (LAS float*)(F.lds + LX_GT);
    unsigned* ctl = WSP(unsigned, WS_CTL);
    __syncthreads();
    if (FTID < NE) cntl[FTID] = (int)__hip_atomic_load(&ctl[CW_CNT + L * 2048 + 64 * FTID], __ATOMIC_RELAXED, __HIP_MEMORY_SCOPE_AGENT);
    __syncthreads();
    if (FTID == 0) { int s = 0; for (int e = 0; e < NE; ++e) { tst[e] = s; s += (cntl[e] + 255) >> 8; } tst[NE] = s; }
    __syncthreads();
    MoeOrder<MODE == 0> S; S.G = F.G; S.c = F.bid; S.nunits = 4 * tst[NE]; S.K = MODE == 0 ? D : FF; S.mode = MODE; S.tst = tst; S.tab = tab;
    S.W = MODE == 0 ? (const char*)(WSP(bf16, WS_W13) + (size_t)L * NE * 1024 * 1024) : (const char*)(WSP(bf16, WS_W2) + (size_t)L * NE * 1024 * 512);
    S.estride = MODE == 0 ? (size_t)1024 * 1024 * 2 : (size_t)1024 * 512 * 2;
    const int* list = WSP(int, WS_LIST); const float* gates = WSP(float, WS_GATE);
    for (int ibase = 0; ibase * F.G + F.bid < S.nunits; ibase += MOE_MAXU) {
        S.ibase = ibase;
        for (int i = 0; i < MOE_MAXU; ++i) {
            pg8::Unit u; if (!S.next(i, u)) break;
            const int tin = u.pm - tst[u.e];
            if (FTID < 256) { const int idx = tin * 256 + FTID; int ent = -1; float g = 0.f;
                if (idx < cntl[u.e]) { ent = list[(size_t)u.e * T + idx]; g = gates[ent]; }
                tab[i * 256 + FTID] = ent; gt[i * 256 + FTID] = g; }
        }
        __syncthreads();
        if (MODE == 0) { EpiSwiglu E{WSP(bf16, WS_HID)}; pg8::gemm_phase(F.lds, WSP(bf16, WS_XN), D, S, E); }
        else { EpiScatterY E{WSP(bf16, WS_Y), tab, gt}; pg8::gemm_phase(F.lds, WSP(bf16, WS_HID), FF, S, E); }
        __syncthreads();
    }
}
__device__ __forceinline__ void f_moe1(Frame& F, int L) { f_moe_gemm<0>(F, L); }
__device__ __forceinline__ void f_moe2(Frame& F, int L) { f_moe_gemm<1>(F, L); }
__device__ __forceinline__ void transpose_item(const float* W, int ldw, const float* kscale, float cs, bf16* WT, int K, int dst_row0, LAS float* scr, int k0, int n0, int lane) {
#pragma unroll 8
    for (int i = 0; i < 32; ++i) { const int kk = 2 * i + (lane >> 5); float v = W[(size_t)(k0 + kk) * ldw + n0 + (lane & 31)] * cs; if (kscale) v *= kscale[k0 + kk]; scr[kk * 33 + (lane & 31)] = v; }
    LDS_WAIT(); asm volatile("" ::: "memory");
    const int c = lane & 7;
#pragma unroll
    for (int j = 0; j < 4; ++j) { const int n = (lane >> 3) + 8 * j; const LAS float* s = scr + (8 * c) * 33 + n;
        v4u o; o.x = pk2(s[0 * 33], s[1 * 33]); o.y = pk2(s[2 * 33], s[3 * 33]); o.z = pk2(s[4 * 33], s[5 * 33]); o.w = pk2(s[6 * 33], s[7 * 33]);
        *(v4u*)(WT + (size_t)(dst_row0 + n) * K + k0 + 8 * c) = o; }
    LDS_WAIT(); asm volatile("" ::: "memory");
}
__device__ __forceinline__ void convert_job_item(const float* W, int ldw, int K, int N, const float* kscale, int qcols, float qs, bf16* WT, int rowmap, LAS float* scr, int item, int lane) {
    const int nblk = N / 32, kb = item / nblk, nb = item % nblk, k0 = 64 * kb, n0 = 32 * nb;
    const int dr = rowmap == 0 ? n0 : ((n0 >> 7) * 256 + (n0 & 127) + (rowmap == 2 ? 128 : 0));
    transpose_item(W, ldw, kscale, n0 < qcols ? qs : 1.f, WT, K, dr, scr, k0, n0, lane);
}
__device__ __forceinline__ void f_convert_gla(Frame& F) {
    LAS float* scr = (LAS float*)(F.lds + FWAVE * 8448);
    const int gw = F.bid * NWAVES + FWAVE, NGW = F.G * NWAVES;
    constexpr int I0 = (D / 64) * (NQKVR / 32), I1 = (HV / 64) * (D / 32);
    for (int it = gw; it < I0 + I1; it += NGW) {
        if (it < I0) convert_job_item(F.inp(I_GLA_WIN), GLA_IN, D, NQKVR, F.inp(I_GLA_NORM), HK, 0.08838834764831845f, WSP(bf16, WS_WIN), 0, scr, it, FLANE);
        else convert_job_item(F.inp(I_GLA_WOUT), D, HV, D, F.inp(I_GLA_HG), 0, 1.f, WSP(bf16, WS_WOUT), 0, scr, it - I0, FLANE);
    }
}
__device__ __forceinline__ void f_convert_rest(Frame& F, int cw, int NCW) {
    LAS float* scr = (LAS float*)(F.lds + FWAVE * 8448);
    constexpr int I0 = (D / 64) * (SGU_FFN / 32), I1 = (SGU_HALF / 64) * (D / 32), IE1 = (D / 64) * (FF / 32), IE2 = (FF / 64) * (D / 32);
    constexpr int IM = 2 * NE * IE1;
    static_assert(IE1 == IE2, "w1 / w2 item counts");
    for (int it = cw; it < I0 + I1 + 3 * IM; it += NCW) {
        int r = it;
        if (r < I0) { convert_job_item(F.inp(I_SGU_WIN), SGU_FFN, D, SGU_FFN, F.inp(I_SGU_NORM), 0, 1.f, WSP(bf16, WS_WSIN), 0, scr, r, FLANE); continue; } r -= I0;
        if (r < I1) { convert_job_item(F.inp(I_SGU_WOUT), D, SGU_HALF, D, nullptr, 0, 1.f, WSP(bf16, WS_WSOUT), 0, scr, r, FLANE); continue; } r -= I1;
        const int which = r / IM; r -= which * IM; const int le = r / IE1, li = r % IE1, L = le / NE;
        if (which == 0) convert_job_item(F.inp(I_MOE_W1) + (size_t)le * D * FF, FF, D, FF, F.inp(I_MOE_NORM) + L * D, 0, 1.f, WSP(bf16, WS_W13) + (size_t)le * 1024 * 1024, 1, scr, li, FLANE);
        else if (which == 1) convert_job_item(F.inp(I_MOE_W3) + (size_t)le * D * FF, FF, D, FF, F.inp(I_MOE_NORM) + L * D, 0, 1.f, WSP(bf16, WS_W13) + (size_t)le * 1024 * 1024, 2, scr, li, FLANE);
        else convert_job_item(F.inp(I_MOE_W2) + (size_t)le * FF * D, D, FF, D, nullptr, 0, 1.f, WSP(bf16, WS_W2) + (size_t)le * 1024 * 512, 0, scr, li, FLANE);
    }
}

constexpr int SC_K = 0, SC_KSTR = 320;
constexpr int SC_V = 20480, SC_VSTR = 576;
constexpr int SC_Q = 57344, SC_QSTR = 272;
constexpr int SC_O = 74752, SC_OSTR = 528;
constexpr int SC_GL = 108544, SC_PART = 112640, SC_DEC = 114688, SC_WG = 115200;
__device__ __forceinline__ s16x4 tr_read16(LAS const unsigned char* p) {
    typedef short v4i16_t __attribute__((ext_vector_type(4)));
    return __builtin_bit_cast(s16x4, __builtin_amdgcn_ds_read_tr16_b64_v4i16((LAS v4i16_t*)p));
}
__device__ __forceinline__ void f_scan_item(Frame& F, int item) {
    const int b = item / GLA_H, h = item % GLA_H;
    const bf16* qkvr = WSP(bf16, WS_QKVR); const float* glr = WSP(float, WS_GLR); bf16* aout = WSP(bf16, WS_XN);
    LAS unsigned char* L = F.lds;
    LAS float* gl = (LAS float*)(L + SC_GL); LAS float* part = (LAS float*)(L + SC_PART); LAS float* dec = (LAS float*)(L + SC_DEC);
    const int tid = FTID, lane = FLANE, w = FWAVE;
    const int r32 = lane & 31, hh = lane >> 5, blk = (lane >> 4) & 1, q4 = (lane & 15) >> 2, p4 = lane & 3;
    const int dk = tid & 127, tg = tid >> 7;
    LAS float* wgl = (LAS float*)(L + SC_WG);
    __syncthreads();
    for (int i = tid; i < 17 * 128; i += NTHREADS) { const int r = i >> 7, d = i & 127; wgl[i] = r < RANK ? F.inp(I_GLA_WGU)[r * HK + h * DK + d] : F.inp(I_GLA_BG)[h * DK + d]; }
    f32x16 st[4];
#pragma unroll
    for (int i = 0; i < 4; ++i)
#pragma unroll
        for (int j = 0; j < 16; ++j) st[i][j] = 0.f;
    v4u rk[2], rq[2], rv[4]; f32x4 rg;
    const size_t rowb = (size_t)b * SEQ;
    const unsigned vo_kq = (unsigned)(((tid >> 4) * NQKVR + (tid & 15) * 8) * 2), vo_v = (unsigned)(((tid >> 5) * NQKVR + (tid & 31) * 8) * 2), vo_g = (unsigned)(tid * 16);
    const unsigned lo_k = (unsigned)(SC_K + (tid >> 4) * SC_KSTR + (tid & 15) * 16), lo_q = (unsigned)(SC_Q + (tid >> 4) * SC_QSTR + (tid & 15) * 16), lo_v = (unsigned)(SC_V + (tid >> 5) * SC_VSTR + (tid & 31) * 16);
#define SC_LOAD(c) do { size_t cb_ = (rowb + (size_t)(c) * CHUNK) * NQKVR * 2; asm volatile("" : "+s"(cb_)); const char* gb_ = (const char*)qkvr + cb_ + (size_t)(h * DK * 2); \
        _Pragma("unroll") for (int i = 0; i < 2; ++i) { \
            rk[i] = *(const v4u*)(gb_ + (size_t)(HK * 2 + i * 32 * NQKVR * 2) + vo_kq); rq[i] = *(const v4u*)(gb_ + (size_t)(i * 32 * NQKVR * 2) + vo_kq); } \
        _Pragma("unroll") for (int i = 0; i < 4; ++i) rv[i] = *(const v4u*)(gb_ + (size_t)(2 * HK * 2 + h * (DV - DK) * 2 + i * 16 * NQKVR * 2) + vo_v); \
        if (tid < 256) rg = *(const f32x4*)((const char*)glr + (rowb + (size_t)(c) * CHUNK) * RANK * 4 + vo_g); } while (0)
#define SC_STORE() do { \
        _Pragma("unroll") for (int i = 0; i < 2; ++i) { *(LAS v4u*)(L + lo_k + i * 32 * SC_KSTR) = rk[i]; *(LAS v4u*)(L + lo_q + i * 32 * SC_QSTR) = rq[i]; } \
        _Pragma("unroll") for (int i = 0; i < 4; ++i) *(LAS v4u*)(L + lo_v + i * 16 * SC_VSTR) = rv[i]; \
        if (tid < 256) *(LAS f32x4*)(gl + tid * 4) = rg; } while (0)
    SC_LOAD(0);
    for (int c = 0; c < NCHUNK; ++c) {
        const size_t t0 = rowb + (size_t)c * CHUNK;
        SC_STORE();
        __syncthreads();
        if (c + 1 < NCHUNK) SC_LOAD(c + 1);
        LAS float* bcs = (LAS float*)(L + SC_O);
        float run = 0.f;
        float wgu[RANK];
#pragma unroll
        for (int r = 0; r < RANK; ++r) wgu[r] = wgl[r * 128 + dk];
        const float bgv = wgl[RANK * 128 + dk];
#pragma unroll 2
        for (int j = 0; j < 16; ++j) {
            const int tok = tg * 16 + j; float a = bgv;
#pragma unroll
            for (int r4 = 0; r4 < 4; ++r4) { const f32x4 g4 = *(const LAS f32x4*)(gl + tok * 16 + r4 * 4); a += g4[0] * wgu[r4 * 4] + g4[1] * wgu[r4 * 4 + 1] + g4[2] * wgu[r4 * 4 + 2] + g4[3] * wgu[r4 * 4 + 3]; }
            const float ls = fminf(a, 0.f) - __logf(1.f + __expf(-fabsf(a)));
            run += ls * (1.f / 16.f); bcs[tok * 128 + dk] = run;
        }
        part[tg * 128 + dk] = run;
        __syncthreads();
        {
            float off = 0.f, tot = 0.f;
#pragma unroll
            for (int g = 0; g < 4; ++g) { const float pv = part[g * 128 + dk]; if (g < tg) off += pv; tot += pv; }
            const float base = tot - off;
#pragma unroll 4
            for (int j = 0; j < 16; ++j) {
                LAS unsigned short* kp = (LAS unsigned short*)(L + SC_K + (tg * 16 + j) * SC_KSTR + dk * 2);
                *kp = (unsigned short)f2bf(bf2f(*kp) * __expf(base - bcs[(tg * 16 + j) * 128 + dk]));
            }
            if (tg == 0) dec[dk] = __expf(tot);
        }
        __syncthreads();
#pragma unroll
        for (int i = 0; i < 4; ++i)
#pragma unroll
            for (int g4 = 0; g4 < 4; ++g4) { const f32x4 d4 = *(const LAS f32x4*)(dec + 32 * i + 8 * g4 + 4 * hh);
#pragma unroll
                for (int j = 0; j < 4; ++j) st[i][4 * g4 + j] *= d4[j]; }
#pragma unroll
        for (int s = 0; s < 4; ++s) {
            const int trow = 16 * s + 8 * hh + q4;
            const s16x4 v0 = tr_read16(L + SC_V + trow * SC_VSTR + (32 * w + 16 * blk + 4 * p4) * 2), v1 = tr_read16(L + SC_V + (trow + 4) * SC_VSTR + (32 * w + 16 * blk + 4 * p4) * 2);
            const bf16x8 Bv = {v0[0], v0[1], v0[2], v0[3], v1[0], v1[1], v1[2], v1[3]};
#pragma unroll
            for (int i = 0; i < 4; ++i) {
                const s16x4 k0 = tr_read16(L + SC_K + trow * SC_KSTR + (32 * i + 16 * blk + 4 * p4) * 2), k1 = tr_read16(L + SC_K + (trow + 4) * SC_KSTR + (32 * i + 16 * blk + 4 * p4) * 2);
                const bf16x8 Ak = {k0[0], k0[1], k0[2], k0[3], k1[0], k1[1], k1[2], k1[3]};
                st[i] = __builtin_amdgcn_mfma_f32_32x32x16_bf16(Ak, Bv, st[i], 0, 0, 0);
            }
            asm volatile("" ::: "memory");
        }
        f32x16 oacc[2];
#pragma unroll
        for (int ot = 0; ot < 2; ++ot)
#pragma unroll
            for (int j = 0; j < 16; ++j) oacc[ot][j] = 0.f;
#pragma unroll
        for (int i = 0; i < 4; ++i)
#pragma unroll
            for (int s2 = 0; s2 < 2; ++s2) {
                v4u pb; pb.x = pk2(st[i][8 * s2 + 0], st[i][8 * s2 + 1]); pb.y = pk2(st[i][8 * s2 + 2], st[i][8 * s2 + 3]); pb.z = pk2(st[i][8 * s2 + 4], st[i][8 * s2 + 5]); pb.w = pk2(st[i][8 * s2 + 6], st[i][8 * s2 + 7]);
                const bf16x8 Bs = __builtin_bit_cast(bf16x8, pb);
#pragma unroll
                for (int ot = 0; ot < 2; ++ot) {
                    LAS const unsigned char* qp = L + SC_Q + (32 * ot + r32) * SC_QSTR + (32 * i + 16 * s2 + 4 * hh) * 2;
                    const v2u a0 = *(const LAS v2u*)qp, a1 = *(const LAS v2u*)(qp + 16);
                    v4u pa; pa.x = a0.x; pa.y = a0.y; pa.z = a1.x; pa.w = a1.y;
                    oacc[ot] = __builtin_amdgcn_mfma_f32_32x32x16_bf16(__builtin_bit_cast(bf16x8, pa), Bs, oacc[ot], 0, 0, 0);
                }
                asm volatile("" ::: "memory");
            }
#pragma unroll
        for (int ot = 0; ot < 2; ++ot)
#pragma unroll
            for (int rg16 = 0; rg16 < 16; ++rg16) {
                const int tok = 32 * ot + (rg16 & 3) + 8 * (rg16 >> 2) + 4 * hh;
                *(LAS unsigned short*)(L + SC_O + tok * SC_OSTR + (32 * w + r32) * 2) = (unsigned short)f2bf(oacc[ot][rg16]);
            }
        __syncthreads();
        {
            const int tok = tid >> 3, cc = tid & 7;
            size_t eb_ = t0 * NQKVR * 2; asm volatile("" : "+s"(eb_));
            const char* rb_ = (const char*)qkvr + eb_ + (size_t)((2 * HK + HV + h * DV) * 2); const unsigned vo_r = (unsigned)((tok * NQKVR + cc * 32) * 2);
            v4u ov[4], rr[4]; float ss = 0.f;
#pragma unroll
            for (int i = 0; i < 4; ++i) { ov[i] = *(const LAS v4u*)(L + SC_O + tok * SC_OSTR + cc * 64 + i * 16); rr[i] = *(const v4u*)(rb_ + vo_r + i * 16); }
#pragma unroll
            for (int i = 0; i < 4; ++i) { const float a0 = bflo(ov[i].x), a1 = bfhi(ov[i].x), a2 = bflo(ov[i].y), a3 = bfhi(ov[i].y), a4 = bflo(ov[i].z), a5 = bfhi(ov[i].z), a6 = bflo(ov[i].w), a7 = bfhi(ov[i].w);
                ss += (a0 * a0 + a1 * a1) + (a2 * a2 + a3 * a3) + (a4 * a4 + a5 * a5) + (a6 * a6 + a7 * a7); }
            ss += __shfl_xor(ss, 1); ss += __shfl_xor(ss, 2); ss += __shfl_xor(ss, 4);
            const float rms = 1.f / sqrtf(ss * (1.f / DV) + EPS);
            size_t ob_ = (t0 * D + h * DV) * 2; asm volatile("" : "+s"(ob_)); const unsigned vo_o = (unsigned)((tok * D + cc * 32) * 2);
#pragma unroll
            for (int i = 0; i < 4; ++i) {
                v4u o;
                o.x = pk2(bflo(ov[i].x) * rms * silu_f(bflo(rr[i].x)), bfhi(ov[i].x) * rms * silu_f(bfhi(rr[i].x)));
                o.y = pk2(bflo(ov[i].y) * rms * silu_f(bflo(rr[i].y)), bfhi(ov[i].y) * rms * silu_f(bfhi(rr[i].y)));
                o.z = pk2(bflo(ov[i].z) * rms * silu_f(bflo(rr[i].z)), bfhi(ov[i].z) * rms * silu_f(bfhi(rr[i].z)));
                o.w = pk2(bflo(ov[i].w) * rms * silu_f(bflo(rr[i].w)), bfhi(ov[i].w) * rms * silu_f(bfhi(rr[i].w)));
                *(v4u*)((char*)aout + ob_ + vo_o + i * 16) = o;
            }
        }
    }
    __syncthreads();
#undef SC_LOAD
#undef SC_STORE
}
__device__ __forceinline__ void f_scan_convert(Frame& F) {
    constexpr int NITEM = NBATCH * GLA_H;
    const bool split = F.G >= 2 * NITEM;
    if (!split || F.bid < NITEM) for (int it = F.bid; it < NITEM; it += F.G) f_scan_item(F, it);
    if (!split) f_convert_rest(F, F.bid * NWAVES + FWAVE, F.G * NWAVES);
    else if (F.bid >= NITEM) f_convert_rest(F, (F.bid - NITEM) * NWAVES + FWAVE, (F.G - NITEM) * NWAVES);
}
constexpr int MX_W = 0, MX_WSTR = 272;
constexpr int MX_V0 = 34816, MX_VSTR = 320, MX_VBYTES = 40960;
constexpr int MX_MU = 116736;
__device__ __forceinline__ void f_mix(Frame& F) {
    LAS unsigned char* L = F.lds;
    LAS float* mu = (LAS float*)(L + MX_MU); LAS float* rs = mu + 128; LAS float* m1 = rs + 128; LAS float* m0 = m1 + 128; LAS float* bsg = m0 + 128;
    bf16* u = WSP(bf16, WS_U); const bf16* v = WSP(bf16, WS_V); const float* st = WSP(float, WS_STATS);
    const int tid = FTID, lane = FLANE, w = FWAVE;
    const int r32 = lane & 31, hh = lane >> 5, blk = (lane >> 4) & 1, q4 = (lane & 15) >> 2, p4 = lane & 3;
    const int ct = w >> 1, th = w & 1;
    const float* lng = F.inp(I_SGU_LNG); const float* lnb = F.inp(I_SGU_LNB);
    for (int bn = F.bid; bn < T / SGU_BLK; bn += F.G) {
        const size_t t0 = (size_t)bn * SGU_BLK;
        __syncthreads();
        if (tid < 128) { float s = 0.f, q = 0.f;
            for (int p = 0; p < 32; ++p) { const pg8::f32x2 a = *(const pg8::f32x2*)(st + ((size_t)p * T + t0 + tid) * 2); s += a.x; q += a.y; }
            const float m = s * (1.f / SGU_HALF); mu[tid] = m; rs[tid] = 1.f / sqrtf(fmaxf(q * (1.f / SGU_HALF) - m * m, 0.f) + EPS); }
        v4u pre[4];
#define MX_LOAD(g_, cq_) do { size_t vb_ = (t0 * SGU_HALF + (g_) * SGU_GC + (cq_) * 128) * 2; asm volatile("" : "+s"(vb_)); \
        _Pragma("unroll") for (int i = 0; i < 4; ++i) pre[i] = *(const v4u*)((const char*)v + vb_ + (size_t)(i * 32 * SGU_HALF * 2) + (unsigned)(((tid >> 4) * SGU_HALF + (tid & 15) * 8) * 2)); } while (0)
#define MX_STORE(buf_) do { _Pragma("unroll") for (int i = 0; i < 4; ++i) *(LAS v4u*)(L + MX_V0 + (buf_) * MX_VBYTES + ((tid >> 4) + 32 * i) * MX_VSTR + (tid & 15) * 16) = pre[i]; } while (0)
        MX_LOAD(0, 0);
        for (int g = 0; g < 4; ++g) {
            __syncthreads();
            {
                const int t = tid >> 2, sq = tid & 3; const float* wsrc = F.inp(I_SGU_WS) + ((size_t)g * 128 + t) * 128 + sq * 32;
                float a1 = 0.f, a0 = 0.f;
#pragma unroll
                for (int i = 0; i < 4; ++i) {
                    const f32x4 x0 = *(const f32x4*)(wsrc + i * 8), x1 = *(const f32x4*)(wsrc + i * 8 + 4); float wv[8] = {x0[0], x0[1], x0[2], x0[3], x1[0], x1[1], x1[2], x1[3]}; unsigned short hb[8];
#pragma unroll
                    for (int j = 0; j < 8; ++j) { const int s = sq * 32 + i * 8 + j; const float wm = ((t >> 6) >= (s >> 6)) ? wv[j] : 0.f; a0 += wm; hb[j] = (unsigned short)f2bf(wm * rs[s]); a1 += bf2f(hb[j]) * mu[s]; }
                    v4u o; o.x = hb[0] | ((unsigned)hb[1] << 16); o.y = hb[2] | ((unsigned)hb[3] << 16); o.z = hb[4] | ((unsigned)hb[5] << 16); o.w = hb[6] | ((unsigned)hb[7] << 16);
                    *(LAS v4u*)(L + MX_W + t * MX_WSTR + (sq * 32 + i * 8) * 2) = o;
                }
                a1 += __shfl_xor(a1, 1); a1 += __shfl_xor(a1, 2); a0 += __shfl_xor(a0, 1); a0 += __shfl_xor(a0, 2);
                if (sq == 0) { m1[t] = a1; m0[t] = a0; }
                if (tid < 128) bsg[tid] = F.inp(I_SGU_BS)[g * 128 + tid];
            }
            for (int cq = 0; cq < 4; ++cq) {
                const int it = g * 4 + cq, buf = it & 1;
                MX_STORE(buf);
                __syncthreads();
                if (it + 1 < 16) MX_LOAD((it + 1) >> 2, (it + 1) & 3);
                f32x16 acc[2];
#pragma unroll
                for (int tt = 0; tt < 2; ++tt)
#pragma unroll
                    for (int j = 0; j < 16; ++j) acc[tt][j] = 0.f;
                LAS const unsigned char* Vb = L + MX_V0 + buf * MX_VBYTES;
                const int nks = th == 0 ? 4 : 8;
                for (int ks = 0; ks < nks; ++ks) {
                    const int srow = 16 * ks + 8 * hh + q4;
                    const s16x4 a0 = tr_read16(Vb + srow * MX_VSTR + (32 * ct + 16 * blk + 4 * p4) * 2), a1 = tr_read16(Vb + (srow + 4) * MX_VSTR + (32 * ct + 16 * blk + 4 * p4) * 2);
                    const bf16x8 Av = {a0[0], a0[1], a0[2], a0[3], a1[0], a1[1], a1[2], a1[3]};
#pragma unroll
                    for (int tt = 0; tt < 2; ++tt) {
                        const bf16x8 Bw = *(const LAS bf16x8*)(L + MX_W + (64 * th + 32 * tt + r32) * MX_WSTR + (16 * ks + 8 * hh) * 2);
                        acc[tt] = __builtin_amdgcn_mfma_f32_32x32x16_bf16(Av, Bw, acc[tt], 0, 0, 0);
                    }
                }
                const int cbase = g * SGU_GC + cq * 128 + 32 * ct + 4 * hh;
#pragma unroll
                for (int tt = 0; tt < 2; ++tt) {
                    const int t = 64 * th + 32 * tt + r32; const float tm1 = m1[t], tm0 = m0[t], tb = bsg[t];
                    bf16* up = u + (t0 + t) * SGU_HALF + cbase;
#pragma unroll
                    for (int g4 = 0; g4 < 4; ++g4) {
                        const v2u uu = *(const v2u*)(up + 8 * g4); const f32x4 lg = *(const f32x4*)(lng + cbase + 8 * g4), lb = *(const f32x4*)(lnb + cbase + 8 * g4);
                        const float o0 = bflo(uu.x) * (lg[0] * (acc[tt][4 * g4 + 0] - tm1) + lb[0] * tm0 + tb), o1 = bfhi(uu.x) * (lg[1] * (acc[tt][4 * g4 + 1] - tm1) + lb[1] * tm0 + tb);
                        const float o2 = bflo(uu.y) * (lg[2] * (acc[tt][4 * g4 + 2] - tm1) + lb[2] * tm0 + tb), o3 = bfhi(uu.y) * (lg[3] * (acc[tt][4 * g4 + 3] - tm1) + lb[3] * tm0 + tb);
                        v2u o; o.x = pk2(o0, o1); o.y = pk2(o2, o3); *(v2u*)(up + 8 * g4) = o;
                    }
                }
            }
        }
#undef MX_LOAD
#undef MX_STORE
    }
}
constexpr int RW_STR = 2064;
constexpr int RW_LG = 48 * RW_STR;
constexpr int RW_HIST = RW_LG + 8 * 16 * 48 * 4;
template <int MODE> __device__ __forceinline__ void f_rowgroup(Frame& F, int Lyr) {
    constexpr int NCT = MODE == 0 ? 1 : 3;
    LAS unsigned char* L = F.lds;
    const int tid = FTID, lane = FLANE, w = FWAVE, rw = lane & 15, q = lane >> 4;
    const float* src = MODE == 0 ? F.inp(I_X) : F.out;
    bf16* xn = WSP(bf16, WS_XN);
    __syncthreads();
    for (int k = tid; k < D; k += NTHREADS) {
        if (MODE == 0) {
            const float gn = F.inp(I_GLA_NORM)[k]; const float* wr_ = F.inp(I_GLA_WIN) + (size_t)k * GLA_IN + NQKVR;
#pragma unroll
            for (int c4 = 0; c4 < 4; ++c4) { const f32x4 x = *(const f32x4*)(wr_ + 4 * c4);
#pragma unroll
                for (int j = 0; j < 4; ++j) *(LAS unsigned short*)(L + (4 * c4 + j) * RW_STR + k * 2) = (unsigned short)f2bf(x[j] * gn); }
        } else {
            const float gn = F.inp(I_MOE_NORM)[Lyr * D + k];
            const f32x4 xg = *(const f32x4*)(F.inp(I_MOE_WG) + ((size_t)Lyr * D + k) * 4);
#pragma unroll
            for (int j = 0; j < 4; ++j) *(LAS unsigned short*)(L + j * RW_STR + k * 2) = (unsigned short)f2bf(xg[j] * gn);
#pragma unroll
            for (int g = 0; g < 4; ++g) { const float* ws_ = F.inp(I_MOE_WSUB) + (((size_t)Lyr * 4 + g) * D + k) * EPG; const f32x4 a = *(const f32x4*)ws_, b = *(const f32x4*)(ws_ + 4);
#pragma unroll
                for (int j = 0; j < 4; ++j) { *(LAS unsigned short*)(L + (4 + 8 * g + j) * RW_STR + k * 2) = (unsigned short)f2bf(a[j] * gn); *(LAS unsigned short*)(L + (8 + 8 * g + j) * RW_STR + k * 2) = (unsigned short)f2bf(b[j] * gn); } }
#pragma unroll
            for (int c = 36; c < 48; ++c) *(LAS unsigned short*)(L + c * RW_STR + k * 2) = 0;
        }
    }
    LAS int* hist = (LAS int*)(L + RW_HIST); LAS int* hbase = hist + 32;
    if (MODE == 1 && tid < 32) hist[tid] = 0;
    __syncthreads();
    const int ngroups = T / 16, niter = (ngroups + F.G * NWAVES - 1) / (F.G * NWAVES);
    for (int iter = 0; iter < niter; ++iter) {
        const int grp = (iter * F.G + F.bid) * NWAVES + w; const bool valid = grp < ngroups;
        const size_t row = (size_t)grp * 16 + rw;
        float rstd = 0.f; pg8::f32x4 acc[NCT];
        if (valid) {
#pragma unroll
            for (int c = 0; c < NCT; ++c) acc[c] = (pg8::f32x4){0.f, 0.f, 0.f, 0.f};
            const float* xr = src + row * D + 8 * q; float ss = 0.f;
#pragma unroll 4
            for (int s = 0; s < 32; ++s) {
                const f32x4 x0 = *(const f32x4*)(xr + 32 * s), x1 = *(const f32x4*)(xr + 32 * s + 4);
                ss += (x0[0] * x0[0] + x0[1] * x0[1]) + (x0[2] * x0[2] + x0[3] * x0[3]) + (x1[0] * x1[0] + x1[1] * x1[1]) + (x1[2] * x1[2] + x1[3] * x1[3]);
                v4u pa; pa.x = pk2(x0[0], x0[1]); pa.y = pk2(x0[2], x0[3]); pa.z = pk2(x1[0], x1[1]); pa.w = pk2(x1[2], x1[3]);
                const bf16x8 A = __builtin_bit_cast(bf16x8, pa);
#pragma unroll
                for (int c = 0; c < NCT; ++c) { const bf16x8 B = *(const LAS bf16x8*)(L + (16 * c + rw) * RW_STR + (32 * s + 8 * q) * 2); acc[c] = __builtin_amdgcn_mfma_f32_16x16x32_bf16(A, B, acc[c], 0, 0, 0); }
            }
            ss += __shfl_xor(ss, 16); ss += __shfl_xor(ss, 32);
            rstd = 1.f / sqrtf(ss * (1.f / D) + EPS);
        }
        float rs4[4];
#pragma unroll
        for (int i = 0; i < 4; ++i) rs4[i] = __shfl(rstd, 4 * q + i);
        int e1 = 0, e2 = 0, rk1 = 0, rk2 = 0; float gt1 = 0.f, gt2 = 0.f;
        if (MODE == 0) {
            if (valid) {
                float* glr = WSP(float, WS_GLR);
#pragma unroll
                for (int i = 0; i < 4; ++i) glr[((size_t)grp * 16 + 4 * q + i) * RANK + rw] = acc[0][i] * rs4[i];
            }
        } else {
            LAS float* lgw = (LAS float*)(L + RW_LG) + w * 16 * 48;
            if (valid) {
#pragma unroll
                for (int c = 0; c < NCT; ++c)
#pragma unroll
                    for (int i = 0; i < 4; ++i) lgw[(4 * q + i) * 48 + 16 * c + rw] = acc[c][i] * rs4[i];
            }
            LDS_WAIT(); asm volatile("" ::: "memory");
            if (valid && lane < 16) {
                const LAS float* lr = lgw + lane * 48; const float* bg = F.inp(I_MOE_BG) + Lyr * 4;
                float lg[4];
#pragma unroll
                for (int c = 0; c < 4; ++c) lg[c] = lr[c] + bg[c];
                int g = 0; float gm = lg[0];
#pragma unroll
                for (int c = 1; c < 4; ++c) if (lg[c] > gm) { gm = lg[c]; g = c; }
                float gs = 0.f;
#pragma unroll
                for (int c = 0; c < 4; ++c) gs += __expf(lg[c] - gm);
                const float g_w = 1.f / gs; const float* bs = F.inp(I_MOE_BSUB) + (Lyr * 4 + g) * EPG;
                int i1 = 0, i2 = 0; float m1v = -3.0e38f, m2v = -3.0e38f;
                for (int e = 0; e < EPG; ++e) { const float x = lr[4 + 8 * g + e] + bs[e];
                    if (x > m1v) { m2v = m1v; i2 = i1; m1v = x; i1 = e; } else if (x > m2v) { m2v = x; i2 = e; } }
                const float w1 = 1.f / (1.f + __expf(m2v - m1v));
                e1 = g * EPG + i1; e2 = g * EPG + i2; gt1 = g_w * w1; gt2 = g_w * (1.f - w1);
                rk1 = __hip_atomic_fetch_add(&hist[e1], 1, __ATOMIC_RELAXED, __HIP_MEMORY_SCOPE_WORKGROUP); rk2 = __hip_atomic_fetch_add(&hist[e2], 1, __ATOMIC_RELAXED, __HIP_MEMORY_SCOPE_WORKGROUP);
            }
            __syncthreads();
            if (tid < 32) { const int hcount = hist[tid]; hbase[tid] = hcount ? (int)atomicAdd(WSP(unsigned, WS_CTL) + CW_CNT + Lyr * 2048 + 64 * tid, (unsigned)hcount) : 0; hist[tid] = 0; }
            __syncthreads();
            if (valid && lane < 16) {
                const int tok = grp * 16 + lane; const int p1 = hbase[e1] + rk1, p2 = hbase[e2] + rk2;
                WSP(int, WS_LIST)[(size_t)e1 * T + p1] = tok * 2; WSP(int, WS_LIST)[(size_t)e2 * T + p2] = tok * 2 + 1;
                WSP(int, WS_EID)[tok * 2] = e1; WSP(int, WS_EID)[tok * 2 + 1] = e2; WSP(float, WS_GATE)[tok * 2] = gt1; WSP(float, WS_GATE)[tok * 2 + 1] = gt2;
            }
        }
        if (valid) {
            const float* xr = src + row * D + 8 * q; bf16* xo = xn + row * D + 8 * q;
#pragma unroll 4
            for (int s = 0; s < 32; ++s) {
                const f32x4 x0 = *(const f32x4*)(xr + 32 * s), x1 = *(const f32x4*)(xr + 32 * s + 4);
                v4u o; o.x = pk2(x0[0] * rstd, x0[1] * rstd); o.y = pk2(x0[2] * rstd, x0[3] * rstd); o.z = pk2(x1[0] * rstd, x1[1] * rstd); o.w = pk2(x1[2] * rstd, x1[3] * rstd);
                *(v4u*)(xo + 32 * s) = o;
            }
        }
    }
    __syncthreads();
}
__device__ __forceinline__ void f_prep0(Frame& F) { f_convert_gla(F); f_rowgroup<0>(F, 0); }
__device__ __forceinline__ void f_rowpass_router(Frame& F, int L) { f_rowgroup<1>(F, L); }
__device__ __forceinline__ void f_rowpass_add(Frame& F) { n_rowpass<2>(F, 0); }
__device__ __forceinline__ void f_final(Frame& F) { n_rowpass<3>(F, 0); }
constexpr int LDS_BYTES = 155648;
struct Args { const float* in[23]; float* out; unsigned char* ws; int ph_lo, ph_hi; };
#define NAIVE(k) ((NAIVE_MASK >> (k)) & 1u)

struct EpiN1 { bf16* o; __device__ void operator()(int r, int c, float v) const { o[(size_t)r * NQKVR + c] = (bf16)f2bf(v); } };
struct EpiN3 { const float* res; float* o; __device__ void operator()(int r, int c, float v) const { o[(size_t)r * D + c] = res[(size_t)r * D + c] + v; } };
struct EpiN8 { bf16* u; bf16* v; __device__ void operator()(int r, int c, float x) const { const float z = gelu_erf(x); if (c < SGU_HALF) u[(size_t)r * SGU_HALF + c] = (bf16)f2bf(z); else v[(size_t)r * SGU_HALF + c - SGU_HALF] = (bf16)f2bf(z); } };

__global__ void __launch_bounds__(NTHREADS, 2) fwd(Args args) {
    extern __shared__ __attribute__((aligned(16))) unsigned char lds_raw[];
    Frame F;
    F.lds = (LAS unsigned char*)lds_raw;
    F.G = gridDim.x; F.bid = blockIdx.x;
    F.out = args.out; F.ws = args.ws;
    if (FTID == 0) {
        LAS unsigned long long* pt = (LAS unsigned long long*)(F.lds + LX_PTR);
#pragma unroll
        for (int i = 0; i < 23; ++i) pt[i] = (unsigned long long)args.in[i];
    }
    __syncthreads();
    const int lo = args.ph_lo, hi = args.ph_hi;
#if ONE_LAUNCH
    cg::grid_group grid = cg::this_grid();
#define GRID_BAR() grid.sync()
#else
#define GRID_BAR() do { } while (0)
#endif
#define IN(k) (lo <= (k) && (k) < hi)
#define SEAM(k) do { if (IN(k) && IN((k) + 1)) GRID_BAR(); } while (0)

    if (IN(0)) {
        if (NAIVE(0)) { n_convert_gla(F); n_rowpass<0>(F, 0); } else { f_prep0(F); }
    }
    SEAM(0);
    if (IN(1)) {
        if (NAIVE(1)) n_gemm(F, WSP(bf16, WS_XN), D, WSP(bf16, WS_WIN), D, T, NQKVR, D, EpiN1{WSP(bf16, WS_QKVR)}); else f_gemm_in(F);
    }
    SEAM(1);
    if (IN(2)) {
        if (NAIVE(2)) { n_scan(F); n_convert_rest(F); } else { f_scan_convert(F); }
    }
    SEAM(2);
    if (IN(3)) {
        if (NAIVE(3)) n_gemm(F, WSP(bf16, WS_XN), D, WSP(bf16, WS_WOUT), D, T, D, HV, EpiN3{F.inp(I_X), F.out}); else f_gemm_out(F);
    }
    SEAM(3);
#define MOE_BLOCK(L, pb) do { \
        if (IN(pb)) { if (NAIVE(pb)) n_rowpass<1>(F, L); else f_rowpass_router(F, L); } \
        SEAM(pb); \
        if (IN((pb) + 1)) { if (NAIVE((pb) + 1)) n_moe(F, L); else f_moe1(F, L); } \
        SEAM((pb) + 1); \
        if (IN((pb) + 2)) { if (!NAIVE((pb) + 1)) f_moe2(F, L); } \
        SEAM((pb) + 2); } while (0)
    MOE_BLOCK(0, 4);
    if (IN(7)) { if (NAIVE(7)) n_rowpass<2>(F, 0); else f_rowpass_add(F); }
    SEAM(7);
    if (IN(8)) { if (NAIVE(8)) n_gemm(F, WSP(bf16, WS_XN), D, WSP(bf16, WS_WSIN), D, T, SGU_FFN, D, EpiN8{WSP(bf16, WS_U), WSP(bf16, WS_V)}); else f_gemm_sgu_in(F); }
    if (NAIVE(8)) { SEAM(8); if (IN(9)) n_stats(F); SEAM(9); } else { if (IN(8) && IN(10)) GRID_BAR(); }
    if (IN(10)) { if (NAIVE(10)) n_mix(F); else f_mix(F); }
    SEAM(10);
    if (IN(11)) { if (NAIVE(11)) n_gemm(F, WSP(bf16, WS_U), SGU_HALF, WSP(bf16, WS_WSOUT), SGU_HALF, T, D, SGU_HALF, EpiN3{F.out, F.out}); else f_gemm_sgu_out(F); }
    SEAM(11);
    MOE_BLOCK(1, 12);
    if (IN(15)) { if (NAIVE(15)) n_rowpass<3>(F, 0); else f_final(F); }
}

extern "C" void kernel_launch(void* const* d_in, const int* in_sizes, int n_in, void* d_out, int out_size, void* d_ws, size_t ws_size, hipStream_t stream) {
    static int grid = 0;
    if (grid == 0) {
        if (n_in != 23 || out_size != T * D || ws_size < WS_END) { fprintf(stderr, "kernel_launch: unexpected shapes (n_in %d out %d ws %zu)\n", n_in, out_size, ws_size); grid = -1; return; }
        int dev = 0, cus = 0, per_cu = 0;
        hipGetDevice(&dev); hipDeviceGetAttribute(&cus, hipDeviceAttributeMultiprocessorCount, dev);
        hipFuncSetAttribute((const void*)fwd, hipFuncAttributeMaxDynamicSharedMemorySize, LDS_BYTES);
        hipOccupancyMaxActiveBlocksPerMultiprocessor(&per_cu, (const void*)fwd, NTHREADS, LDS_BYTES);
        (void)hipGetLastError();
        if (per_cu < 1) { fprintf(stderr, "kernel_launch: occupancy query says %d blocks per CU\n", per_cu); per_cu = 1; }
        grid = cus;
    }
    if (grid < 0) return;
    hipMemsetAsync((char*)d_ws + WS_CTL, 0, CTL_ZERO_BYTES, stream);
    Args a{};
    for (int i = 0; i < 23; ++i) a.in[i] = (const float*)d_in[i];
    a.out = (float*)d_out; a.ws = (unsigned char*)d_ws;
#if ONE_LAUNCH
    a.ph_lo = 0; a.ph_hi = 16;
    void* kargs[] = {&a};
    hipError_t e = hipLaunchCooperativeKernel((const void*)fwd, dim3(grid), dim3(NTHREADS), kargs, LDS_BYTES, stream);
    if (e != hipSuccess) fprintf(stderr, "cooperative launch failed: %s (grid %d)\n", hipGetErrorString(e), grid);
#else
    for (int p = 0; p < 16; ++p) {
        if (p == 9 && !NAIVE(8)) continue;
        if ((p == 6 || p == 14) && NAIVE(p - 1)) continue;
        a.ph_lo = p; a.ph_hi = p + 1;
        hipLaunchKernelGGL(fwd, dim3(grid), dim3(NTHREADS), LDS_BYTES, stream, a);
    }
#endif
}
```

```cpp
#define NAIVE_MASK 0x0u
#define ONE_LAUNCH 1
#include <hip/hip_runtime.h>
#include <hip/hip_cooperative_groups.h>
#include <cstdio>
#include <cstdint>
namespace cg = cooperative_groups;

#ifndef NAIVE_MASK
#define NAIVE_MASK 0x0u
#endif
#ifndef ONE_LAUNCH
#define ONE_LAUNCH 1
#endif

constexpr int T = 32768, D = 1024, NBATCH = 16, SEQ = 2048;
constexpr int GLA_H = 4, DK = 128, DV = 256, HK = 512, HV = 1024, RANK = 16, GLA_IN = 3088, NQKVR = 3072, CHUNK = 64, NCHUNK = 32;
constexpr int SGU_FFN = 4096, SGU_HALF = 2048, SGU_BLK = 128, SGU_GC = 512;
constexpr int NE = 32, EPG = 8, FF = 512;
constexpr float EPS = 1e-6f;
constexpr int NTHREADS = 512, NWAVES = 8;
constexpr int NPHASE = 15;

constexpr size_t MiB = 1u << 20;
constexpr size_t WS_CTL = 0, CTL_ZERO_BYTES = 64 * 1024;
constexpr size_t WS_GLR = 1 * MiB;
constexpr size_t WS_GATE = 3 * MiB;
constexpr size_t WS_EID = 3 * MiB + 512 * 1024;
constexpr size_t WS_STATS = 4 * MiB;
constexpr size_t WS_LIST = 12 * MiB;
constexpr size_t WS_WIN = 16 * MiB;
constexpr size_t WS_WOUT = 22 * MiB;
constexpr size_t WS_WSIN = 24 * MiB;
constexpr size_t WS_WSOUT = 32 * MiB;
constexpr size_t WS_W13 = 36 * MiB;
constexpr size_t WS_W2 = 164 * MiB;
constexpr size_t WS_XN = 228 * MiB;
constexpr size_t WS_AOUT = 484 * MiB;
constexpr size_t WS_RS = 3 * MiB + 256 * 1024;
constexpr size_t WS_QKVR = 292 * MiB;
constexpr size_t WS_HID = 292 * MiB;
constexpr size_t WS_Y = 364 * MiB;
constexpr size_t WS_U = 292 * MiB;
constexpr size_t WS_V = 420 * MiB;
constexpr size_t WS_END = 548 * MiB;
constexpr int CW_BAR = 1024;
constexpr int CW_CNT = 8192;

#define GAS __attribute__((address_space(1)))
#define LAS __attribute__((address_space(3)))
typedef unsigned short bf16;
typedef unsigned v4u __attribute__((ext_vector_type(4)));
typedef unsigned v2u __attribute__((ext_vector_type(2)));
typedef float f32x4 __attribute__((ext_vector_type(4)));
typedef float f32x16 __attribute__((ext_vector_type(16)));
typedef short bf16x8 __attribute__((ext_vector_type(8)));
typedef short s16x4 __attribute__((ext_vector_type(4)));
#define LDS_WAIT() asm volatile("s_waitcnt lgkmcnt(0)" ::: "memory")
#define VM_WAIT() asm volatile("s_waitcnt vmcnt(0)" ::: "memory")
typedef float f32x2_t __attribute__((ext_vector_type(2))); typedef __bf16 bf16x2_t __attribute__((ext_vector_type(2)));
__device__ __forceinline__ unsigned pk2(float lo, float hi) { f32x2_t v = {lo, hi}; bf16x2_t b = __builtin_convertvector(v, bf16x2_t); return __builtin_bit_cast(unsigned, b); }
__device__ __forceinline__ unsigned f2bf(float f) { return pk2(f, 0.f) & 0xffffu; }
__device__ __forceinline__ float bf2f(unsigned short b) { return __builtin_bit_cast(float, (unsigned)b << 16); }
__device__ __forceinline__ float bflo(unsigned w) { return __builtin_bit_cast(float, w << 16); }
__device__ __forceinline__ float bfhi(unsigned w) { return __builtin_bit_cast(float, w & 0xffff0000u); }
__device__ __forceinline__ float wave_sum(float v) {
#pragma unroll
    for (int o = 1; o < 64; o <<= 1) v += __shfl_xor(v, o);
    return v;
}
__device__ __forceinline__ float silu_f(float x) { return x * __builtin_amdgcn_rcpf(1.f + __expf(-x)); }
__device__ __forceinline__ float gelu_erf(float x) { return 0.5f * x * (1.f + erff(x * 0.70710678118654752f)); }
__device__ __forceinline__ float logsigmoid_f(float x) { return fminf(x, 0.f) - log1pf(__expf(-fabsf(x))); }
namespace pg8 {
#define PG8_LAS __attribute__((address_space(3)))
typedef unsigned short bf16_t;
typedef short bf16x8 __attribute__((ext_vector_type(8)));
typedef float f32x4 __attribute__((ext_vector_type(4)));
typedef unsigned u32x4 __attribute__((ext_vector_type(4)));
constexpr int BM = 256, BK = 64, HALF = 128, HTB = HALF * BK * 2  , STAGE_BYTES = 8 * HTB, NXCD = 8, WGM = 8;

__host__ __device__ __forceinline__ int lds_byte(int r, int c) { const int st = (r >> 4) * 2 + (c >> 5), rr = r & 15, cc = c & 31, ob = rr * 64 + cc * 2; return st * 1024 + (ob ^ (((ob >> 9) & 1) << 5)); }
__host__ __device__ __forceinline__ void stage_rc(int b, int& R, int& C) { const int st = b / 1024, sb = b % 1024, swz = sb ^ (((sb >> 9) & 1) << 5); R = (st >> 1) * 16 + swz / 64; C = (st & 1) * 32 + (swz % 64) / 2; }
__host__ __device__ __forceinline__ int perm32(int rho) { const int n = rho >> 4, i = rho & 15; return 8 * (i >> 2) + 4 * n + (i & 3); }

struct Unit { int pm, pn, e, slot; };

struct DenseOrder {
    static constexpr bool GATHER = false;
    int nM, nN, nwg, G, c, K; const char* Bt;
    __device__ void init(int M, int N, int K_, const bf16_t* Bt_, int G_, int c_) { nM = M / BM; nN = N / BM; nwg = nM * nN; G = G_; c = c_; K = K_; Bt = (const char*)Bt_; }
    __device__ __forceinline__ bool next(int i, Unit& u) const {
        const long L = (long)i * G + c; if (L >= nwg) return false;
        int wgid = (int)L; { const int q = nwg / NXCD, r = nwg % NXCD, xcd = wgid % NXCD, off = wgid / NXCD; wgid = (xcd < r ? xcd * (q + 1) : r * (q + 1) + (xcd - r) * q) + off; }
        const int nig = WGM * nN, gid = wgid / nig, fm = gid * WGM, gsz = (nM - fm) < WGM ? (nM - fm) : WGM;
        u.pm = fm + ((wgid % nig) % gsz); u.pn = (wgid % nig) / gsz; u.e = 0; u.slot = 0; return true;
    }
    __device__ __forceinline__ const char* bptr(const Unit& u) const { return Bt + (size_t)u.pn * BM * K * 2; }
    __device__ __forceinline__ size_t abase(const Unit& u) const { return (size_t)u.pm * BM * K * 2; }
    __device__ __forceinline__ unsigned aoff(const Unit& u, int h, int R, int C) const { return (unsigned)(((u.pm * BM + h * HALF + R) * K + C) * 2); }
    __device__ __forceinline__ void a_ready(const Unit&) const {}
    __device__ __forceinline__ void done(const Unit&) const {}
};

__device__ __forceinline__ unsigned cvt_pk_bf16(float lo, float hi) { unsigned r; asm volatile("v_cvt_pk_bf16_f32 %0, %1, %2" : "=v"(r) : "v"(lo), "v"(hi)); return r; }
typedef float f32x2 __attribute__((ext_vector_type(2)));
__device__ __forceinline__ f32x2 gelu_pk(f32x2 v) {
    const f32x2 av = __builtin_elementwise_abs(v), d = av * 0.2316418882f + 1.0f;
    f32x2 t; t.x = __builtin_amdgcn_rcpf(d.x); t.y = __builtin_amdgcn_rcpf(d.y);
    f32x2 q = t * 0.5307027145f + (-0.7265760135f); q = q * t + 0.7107068705f; q = q * t + (-0.142248368f); q = q * t + 0.127414796f; q = q * t;
    const f32x2 s = (v * v) * (-0.72134752044f);
    f32x2 e; e.x = __builtin_amdgcn_exp2f(s.x); e.y = __builtin_amdgcn_exp2f(s.y);
    const f32x2 m = v * (q * e), r = v - m;
    f32x2 o; o.x = v.x < 0.f ? m.x : r.x; o.y = v.y < 0.f ? m.y : r.y; return o;
}

template <class Epi, class Sched>
__device__ __forceinline__ void gemm_phase(PG8_LAS unsigned char* lds, const bf16_t* Abase, const int K, const Sched& S, const Epi& E) {
    const int tid = threadIdx.x, wid = __builtin_amdgcn_readfirstlane(tid >> 6), lane = tid & 63, wr = wid >> 2, wc = wid & 3, fr = lane & 15, fq = lane >> 4;
    const int nt = K / BK;
    int sR[2], sC[2]; unsigned voffA[2], voffB[2];
#pragma unroll
    for (int i = 0; i < 2; ++i) { stage_rc(tid * 16 + i * 8192, sR[i], sC[i]); const int Rb = Epi::PERM ? ((sR[i] & ~31) + perm32(sR[i] & 31)) : sR[i];
        voffA[i] = (unsigned)(sR[i] * K + sC[i]) * 2u; voffB[i] = (unsigned)(Rb * K + sC[i]) * 2u; }
    const size_t kstep = (size_t)(BK * 2);
    const size_t hstep = (size_t)HALF * K * 2;
    const unsigned ldsw = (unsigned)wid * 1024u;
    const int aoff = lds_byte(wr * 64 + fr, fq * 8), boff = lds_byte(wc * 32 + fr, fq * 8);
    const char* const Ab = (const char*)Abase;
#define PG8_SA(b, h) (((b) * 2 + (h)) * HTB)
#define PG8_SB(b, h) ((4 + (b) * 2 + (h)) * HTB)
#define PG8_STAGE(bufoff, gbase, voff) do { _Pragma("unroll") for (int _i = 0; _i < 2; ++_i) \
        __builtin_amdgcn_global_load_lds((const unsigned*)((const char*)(gbase) + (voff)[_i]), (PG8_LAS unsigned*)(lds + (bufoff) + ldsw + _i * 8192), 16, 0, 0); } while (0)
#define PG8_STAGE_A(bufoff, nx, h, kt) do { if constexpr (Sched::GATHER) { PG8_STAGE(bufoff, Ab + (size_t)(kt) * kstep, gc[h]); } \
        else PG8_STAGE(bufoff, ((nx) ? xA : cA) + (size_t)(h) * hstep + (size_t)(kt) * kstep, voffA); } while (0)
#define PG8_LDA(dst, b, h) do { _Pragma("unroll") for (int m = 0; m < 4; ++m) _Pragma("unroll") for (int k = 0; k < 2; ++k) dst[m][k] = *(const PG8_LAS bf16x8*)(lds + PG8_SA(b, h) + aoff + m * 2048 + k * 1024); } while (0)
#define PG8_LDB(dst, b, h) do { _Pragma("unroll") for (int n = 0; n < 2; ++n) _Pragma("unroll") for (int k = 0; k < 2; ++k) dst[n][k] = *(const PG8_LAS bf16x8*)(lds + PG8_SB(b, h) + boff + n * 2048 + k * 1024); } while (0)
#define PG8_MMA(ai, bj, At, Bt) do { __builtin_amdgcn_s_setprio(1); _Pragma("unroll") for (int m = 0; m < 4; ++m) _Pragma("unroll") for (int n = 0; n < 2; ++n) _Pragma("unroll") for (int k = 0; k < 2; ++k) \
        acc[ai][bj][m][n] = __builtin_amdgcn_mfma_f32_16x16x32_bf16(Bt[n][k], At[m][k], acc[ai][bj][m][n], 0, 0, 0); __builtin_amdgcn_s_setprio(0); } while (0)
#define PG8_WAIT_V(n) asm volatile("s_waitcnt vmcnt(" #n ")" ::: "memory")
#define PG8_WAIT_L(n) asm volatile("s_waitcnt lgkmcnt(" #n ")" ::: "memory")
#define PG8_BAR __builtin_amdgcn_s_barrier()
#define PG8_SCHED __builtin_amdgcn_sched_barrier(0)
    Unit cur, nxt; int ui = 0;
    if (!S.next(0, cur)) return;
    f32x4 acc[2][2][4][2];
#pragma unroll
    for (int a = 0; a < 2; ++a)
#pragma unroll
        for (int b = 0; b < 2; ++b)
#pragma unroll
            for (int m = 0; m < 4; ++m)
#pragma unroll
                for (int n = 0; n < 2; ++n) acc[a][b][m][n] = (f32x4){0.f, 0.f, 0.f, 0.f};
    bf16x8 At[4][2], B0[2][2], B1[2][2];
    unsigned gc[2][2];
    const char* cA = Ab; const char* xA = Ab;
    if constexpr (Sched::GATHER) {
#pragma unroll
        for (int h = 0; h < 2; ++h)
#pragma unroll
            for (int i = 0; i < 2; ++i) gc[h][i] = S.aoff(cur, h, sR[i], sC[i]);
    } else { cA = Ab + S.abase(cur); xA = cA; }
    const char* cB = S.bptr(cur);
    S.a_ready(cur);
    PG8_STAGE(PG8_SB(0, 0), cB, voffB); PG8_STAGE(PG8_SB(0, 1), cB + hstep, voffB); PG8_STAGE_A(PG8_SA(0, 0), false, 0, 0); PG8_STAGE_A(PG8_SA(0, 1), false, 1, 0);
    if (wr == 1) PG8_BAR;
    PG8_WAIT_V(2); PG8_BAR;
    PG8_STAGE(PG8_SB(1, 0), cB + kstep, voffB); PG8_STAGE_A(PG8_SA(1, 0), false, 0, 1); PG8_STAGE(PG8_SB(1, 1), cB + hstep + kstep, voffB);
    PG8_WAIT_V(6); PG8_BAR;
    for (;;) {
        const bool has_next = S.next(ui + 1, nxt);
        const char* nB = has_next ? S.bptr(nxt) : cB;
        for (int t = 0; t < nt; t += 2) {
            const bool last = (t == nt - 2);
            const int kt2 = last ? 0 : t + 2;
            const char* b2 = last ? nB : cB + (size_t)(t + 2) * kstep; const char* b3 = b2 + kstep;
            if (last && has_next) {
                if constexpr (!Sched::GATHER) xA = Ab + S.abase(nxt);
                S.a_ready(nxt);
            }
            PG8_LDB(B0, 0, 0); PG8_LDB(B1, 0, 1); PG8_SCHED; PG8_LDA(At, 0, 0); PG8_STAGE_A(PG8_SA(1, 1), false, 1, t + 1);
            if constexpr (Sched::GATHER) { if (last && has_next) {
#pragma unroll
                for (int h = 0; h < 2; ++h)
#pragma unroll
                    for (int i = 0; i < 2; ++i) gc[h][i] = S.aoff(nxt, h, sR[i], sC[i]); } }
            PG8_WAIT_V(8); PG8_WAIT_L(0); PG8_BAR; PG8_MMA(0, 0, At, B0); PG8_MMA(0, 1, At, B1); PG8_BAR; PG8_SCHED;
            PG8_LDA(At, 0, 1); PG8_STAGE(PG8_SB(0, 0), b2, voffB); PG8_STAGE(PG8_SB(0, 1), b2 + hstep, voffB); PG8_STAGE_A(PG8_SA(0, 0), last, 0, kt2);
            PG8_WAIT_V(8); PG8_WAIT_L(0); PG8_BAR; PG8_MMA(1, 0, At, B0); PG8_MMA(1, 1, At, B1); PG8_BAR; PG8_SCHED;
            PG8_LDB(B0, 1, 0); PG8_LDB(B1, 1, 1); PG8_SCHED; PG8_LDA(At, 1, 0); PG8_STAGE_A(PG8_SA(0, 1), last, 1, kt2);
            PG8_WAIT_V(8); PG8_WAIT_L(0); PG8_BAR; PG8_MMA(0, 0, At, B0); PG8_MMA(0, 1, At, B1); PG8_BAR; PG8_SCHED;
            PG8_LDA(At, 1, 1); PG8_STAGE(PG8_SB(1, 0), b3, voffB); PG8_STAGE(PG8_SB(1, 1), b3 + hstep, voffB); PG8_STAGE_A(PG8_SA(1, 0), last, 0, kt2 + 1);
            PG8_WAIT_V(8); PG8_WAIT_L(0); PG8_BAR; PG8_MMA(1, 0, At, B0); PG8_MMA(1, 1, At, B1); PG8_BAR; PG8_SCHED;
        }
        if (wr == 0) PG8_BAR;
        E(acc, cur, wr, wc, fr, fq); S.done(cur);
        if (!has_next) break;
#pragma unroll
        for (int a = 0; a < 2; ++a)
#pragma unroll
            for (int b = 0; b < 2; ++b)
#pragma unroll
                for (int m = 0; m < 4; ++m)
#pragma unroll
                    for (int n = 0; n < 2; ++n) acc[a][b][m][n] = (f32x4){0.f, 0.f, 0.f, 0.f};
        cur = nxt; cB = nB; ++ui;
        if constexpr (!Sched::GATHER) cA = xA;
        if (wr == 1) PG8_BAR;
    }
    PG8_WAIT_V(0);
    PG8_BAR;
#undef PG8_STAGE_A
#undef PG8_SA
#undef PG8_SB
#undef PG8_STAGE
#undef PG8_LDA
#undef PG8_LDB
#undef PG8_MMA
#undef PG8_WAIT_V
#undef PG8_WAIT_L
#undef PG8_BAR
#undef PG8_SCHED
}
}
constexpr int LX_PTR = 155648 - 256;
#define FTID ((int)threadIdx.x)
#define FLANE ((int)threadIdx.x & 63)
#define FWAVE ((int)__builtin_amdgcn_readfirstlane((int)threadIdx.x >> 6))
struct Frame {
    LAS unsigned char* lds;
    int G, bid;
    float* out; unsigned char* ws;
    __device__ __forceinline__ const float* inp(int i) const {
        const LAS unsigned* p = (const LAS unsigned*)(lds + LX_PTR) + 2 * i;
        const unsigned lo = __builtin_amdgcn_readfirstlane(p[0]), hi = __builtin_amdgcn_readfirstlane(p[1]);
        return (const float*)(((unsigned long long)hi << 32) | lo);
    }
};
enum { I_X = 0, I_GLA_NORM, I_GLA_WIN, I_GLA_WGU, I_GLA_BG, I_GLA_HG, I_GLA_WOUT, I_SGU_NORM, I_SGU_WIN, I_SGU_LNG, I_SGU_LNB, I_SGU_WS, I_SGU_BS, I_SGU_WOUT,
       I_MOE_NORM, I_MOE_WG, I_MOE_BG, I_MOE_WSUB, I_MOE_BSUB, I_MOE_W1, I_MOE_W3, I_MOE_W2, I_FINAL };
#define WSP(type, off) ((type*)(F.ws + (off)))

__device__ __forceinline__ void n_convert(Frame& F, const float* W, int ldw, int K, int N, const float* kscale, int qcols, float qs, bf16* WT, int rowmap) {
    const size_t total = (size_t)N * K, stride = (size_t)F.G * NTHREADS;
    for (size_t idx = (size_t)F.bid * NTHREADS + FTID; idx < total; idx += stride) {
        const int n = (int)(idx / K), k = (int)(idx % K);
        float v = W[(size_t)k * ldw + n]; if (kscale) v *= kscale[k]; if (n < qcols) v *= qs;
        const int dr = rowmap == 0 ? n : ((n >> 7) * 256 + (n & 127) + (rowmap == 2 ? 128 : 0));
        WT[(size_t)dr * K + k] = (bf16)f2bf(v);
    }
}
__device__ __forceinline__ void n_convert_gla(Frame& F) {
    n_convert(F, F.inp(I_GLA_WIN), GLA_IN, D, NQKVR, F.inp(I_GLA_NORM), HK, 0.08838834764831845f, WSP(bf16, WS_WIN), 0);
    n_convert(F, F.inp(I_GLA_WOUT), D, HV, D, F.inp(I_GLA_HG), 0, 1.f, WSP(bf16, WS_WOUT), 0);
}
__device__ __forceinline__ void n_convert_rest(Frame& F) {
    n_convert(F, F.inp(I_SGU_WIN), SGU_FFN, D, SGU_FFN, F.inp(I_SGU_NORM), 0, 1.f, WSP(bf16, WS_WSIN), 0);
    n_convert(F, F.inp(I_SGU_WOUT), D, SGU_HALF, D, nullptr, 0, 1.f, WSP(bf16, WS_WSOUT), 0);
    for (int le = 0; le < 2 * NE; ++le) {
        const int L = le / NE;
        n_convert(F, F.inp(I_MOE_W1) + (size_t)le * D * FF, FF, D, FF, F.inp(I_MOE_NORM) + L * D, 0, 1.f, WSP(bf16, WS_W13) + (size_t)le * 1024 * 1024, 1);
        n_convert(F, F.inp(I_MOE_W3) + (size_t)le * D * FF, FF, D, FF, F.inp(I_MOE_NORM) + L * D, 0, 1.f, WSP(bf16, WS_W13) + (size_t)le * 1024 * 1024, 2);
        n_convert(F, F.inp(I_MOE_W2) + (size_t)le * FF * D, D, FF, D, nullptr, 0, 1.f, WSP(bf16, WS_W2) + (size_t)le * 1024 * 512, 0);
    }
}

template <int MODE> __device__ __forceinline__ void n_rowpass(Frame& F, int L) {
    const float* src = MODE == 0 ? F.inp(I_X) : F.out;
    bf16* xn = WSP(bf16, WS_XN);
    const bf16* y = WSP(bf16, WS_Y);
    unsigned* ctl = WSP(unsigned, WS_CTL);
    for (int row = F.bid * NWAVES + FWAVE; row < T; row += F.G * NWAVES) {
        f32x4 v[4]; float ss = 0.f;
#pragma unroll
        for (int j = 0; j < 4; ++j) {
            const int k = 4 * FLANE + 256 * j;
            v[j] = *(const f32x4*)(src + (size_t)row * D + k);
            if (MODE >= 2) {
                const v2u a = *(const v2u*)(y + (size_t)row * D + k), b = *(const v2u*)(y + ((size_t)T + row) * D + k);
                v[j].x += bflo(a.x) + bflo(b.x); v[j].y += bfhi(a.x) + bfhi(b.x); v[j].z += bflo(a.y) + bflo(b.y); v[j].w += bfhi(a.y) + bfhi(b.y);
            }
            ss += v[j].x * v[j].x + v[j].y * v[j].y + v[j].z * v[j].z + v[j].w * v[j].w;
        }
        const float rstd = 1.f / sqrtf(wave_sum(ss) * (1.f / D) + EPS);
        if (MODE == 0) {
            const float* gn = F.inp(I_GLA_NORM); const float* w = F.inp(I_GLA_WIN);
            for (int c = 0; c < RANK; ++c) {
                float p = 0.f;
#pragma unroll
                for (int j = 0; j < 4; ++j) { const int k = 4 * FLANE + 256 * j;
                    p += v[j].x * gn[k] * w[(size_t)k * GLA_IN + NQKVR + c] + v[j].y * gn[k + 1] * w[(size_t)(k + 1) * GLA_IN + NQKVR + c]
                       + v[j].z * gn[k + 2] * w[(size_t)(k + 2) * GLA_IN + NQKVR + c] + v[j].w * gn[k + 3] * w[(size_t)(k + 3) * GLA_IN + NQKVR + c]; }
                p = wave_sum(p) * rstd;
                if (FLANE == 0) WSP(float, WS_GLR)[(size_t)row * RANK + c] = p;
            }
        }
        if (MODE == 1) {
            const float* gn = F.inp(I_MOE_NORM) + L * D; const float* wg = F.inp(I_MOE_WG) + (size_t)L * D * 4; const float* wsb = F.inp(I_MOE_WSUB) + (size_t)L * 4 * D * EPG;
            float lg[4], ls[EPG];
            for (int c = 0; c < 4; ++c) { float p = 0.f;
#pragma unroll
                for (int j = 0; j < 4; ++j) { const int k = 4 * FLANE + 256 * j;
                    p += v[j].x * gn[k] * wg[(k) * 4 + c] + v[j].y * gn[k + 1] * wg[(k + 1) * 4 + c] + v[j].z * gn[k + 2] * wg[(k + 2) * 4 + c] + v[j].w * gn[k + 3] * wg[(k + 3) * 4 + c]; }
                lg[c] = wave_sum(p) * rstd + F.inp(I_MOE_BG)[L * 4 + c]; }
            int g = 0; float gm = lg[0];
            for (int c = 1; c < 4; ++c) if (lg[c] > gm) { gm = lg[c]; g = c; }
            float gs = 0.f; for (int c = 0; c < 4; ++c) gs += __expf(lg[c] - gm);
            const float g_w = 1.f / gs;
            for (int e = 0; e < EPG; ++e) { float p = 0.f;
#pragma unroll
                for (int j = 0; j < 4; ++j) { const int k = 4 * FLANE + 256 * j; const float* ww = wsb + ((size_t)g * D + k) * EPG + e;
                    p += v[j].x * gn[k] * ww[0] + v[j].y * gn[k + 1] * ww[EPG] + v[j].z * gn[k + 2] * ww[2 * EPG] + v[j].w * gn[k + 3] * ww[3 * EPG]; }
                ls[e] = wave_sum(p) * rstd + F.inp(I_MOE_BSUB)[(L * 4 + g) * EPG + e]; }
            int i1 = 0; float m1 = ls[0];
            for (int e = 1; e < EPG; ++e) if (ls[e] > m1) { m1 = ls[e]; i1 = e; }
            int i2 = -1; float m2 = -3.0e38f;
            for (int e = 0; e < EPG; ++e) if (e != i1 && ls[e] > m2) { m2 = ls[e]; i2 = e; }
            const float w1 = 1.f / (1.f + __expf(m2 - m1)), w2 = 1.f - w1;
            if (FLANE == 0) {
                const int e1 = g * EPG + i1, e2 = g * EPG + i2;
                WSP(int, WS_EID)[row * 2] = e1; WSP(int, WS_EID)[row * 2 + 1] = e2;
                WSP(float, WS_GATE)[row * 2] = g_w * w1; WSP(float, WS_GATE)[row * 2 + 1] = g_w * w2;
                const unsigned p1 = atomicAdd(&ctl[CW_CNT + L * 2048 + 64 * e1], 1u), p2 = atomicAdd(&ctl[CW_CNT + L * 2048 + 64 * e2], 1u);
                WSP(int, WS_LIST)[(size_t)e1 * T + p1] = row * 2; WSP(int, WS_LIST)[(size_t)e2 * T + p2] = row * 2 + 1;
            }
        }
#pragma unroll
        for (int j = 0; j < 4; ++j) {
            const int k = 4 * FLANE + 256 * j;
            if (MODE == 2) *(f32x4*)(F.out + (size_t)row * D + k) = v[j];
            if (MODE == 3) { const f32x4 g = *(const f32x4*)(F.inp(I_FINAL) + k); *(f32x4*)(F.out + (size_t)row * D + k) = v[j] * rstd * g; }
            else { v2u o; o.x = pk2(v[j].x * rstd, v[j].y * rstd); o.y = pk2(v[j].z * rstd, v[j].w * rstd); *(v2u*)(xn + (size_t)row * D + k) = o; }
        }
    }
}

template <class Fn> __device__ __forceinline__ void n_gemm(Frame& F, const bf16* A, int lda, const bf16* Bt, int ldb, int M, int N, int K, Fn f) {
    LAS float* As = (LAS float*)F.lds; LAS float* Bs = As + 64 * 33;
    const int ntn = N / 64, ntiles = (M / 64) * ntn, ty = FTID >> 4, tx = FTID & 15, lr = FTID >> 3, lc = (FTID & 7) * 4;
    for (int tile = F.bid; tile < ntiles; tile += F.G) {
        const int tm = tile / ntn, tn = tile % ntn;
        float acc[2][4] = {};
        for (int k0 = 0; k0 < K; k0 += 32) {
            const v2u a = *(const v2u*)(A + (size_t)(tm * 64 + lr) * lda + k0 + lc), b = *(const v2u*)(Bt + (size_t)(tn * 64 + lr) * ldb + k0 + lc);
            As[lr * 33 + lc] = bflo(a.x); As[lr * 33 + lc + 1] = bfhi(a.x); As[lr * 33 + lc + 2] = bflo(a.y); As[lr * 33 + lc + 3] = bfhi(a.y);
            Bs[lr * 33 + lc] = bflo(b.x); Bs[lr * 33 + lc + 1] = bfhi(b.x); Bs[lr * 33 + lc + 2] = bflo(b.y); Bs[lr * 33 + lc + 3] = bfhi(b.y);
            __syncthreads();
#pragma unroll 8
            for (int kk = 0; kk < 32; ++kk) {
                const float a0 = As[(2 * ty) * 33 + kk], a1 = As[(2 * ty + 1) * 33 + kk];
#pragma unroll
                for (int i = 0; i < 4; ++i) { const float bb = Bs[(4 * tx + i) * 33 + kk]; acc[0][i] += a0 * bb; acc[1][i] += a1 * bb; }
            }
            __syncthreads();
        }
#pragma unroll
        for (int r = 0; r < 2; ++r)
#pragma unroll
            for (int i = 0; i < 4; ++i) f(tm * 64 + 2 * ty + r, tn * 64 + 4 * tx + i, acc[r][i]);
    }
}

__device__ __forceinline__ void n_scan(Frame& F) {
    LAS float* gl = (LAS float*)F.lds;
    LAS float* kd = gl + 64 * 16;
    LAS float* qs = kd + 64 * 128;
    LAS float* os = qs + 64 * 128;
    LAS float* part = os + 64 * 256;
    LAS float* dec = part + 4 * 128;
    const bf16* qkvr = WSP(bf16, WS_QKVR); const float* glr = WSP(float, WS_GLR); bf16* aout = WSP(bf16, WS_XN);
    for (int item = F.bid; item < NBATCH * GLA_H; item += F.G) {
        const int b = item / GLA_H, h = item % GLA_H;
        float S[64];
#pragma unroll
        for (int i = 0; i < 64; ++i) S[i] = 0.f;
        const int dk = FTID & 127, tg = FTID >> 7, j = FTID & 255, hf = FTID >> 8;
        for (int c = 0; c < NCHUNK; ++c) {
            const size_t t0 = (size_t)b * SEQ + c * CHUNK;
            for (int i = FTID; i < 64 * 16; i += NTHREADS) gl[i] = glr[t0 * RANK + i];
            __syncthreads();
            float wgu[RANK];
#pragma unroll
            for (int r = 0; r < RANK; ++r) wgu[r] = F.inp(I_GLA_WGU)[r * HK + h * DK + dk];
            const float bgv = F.inp(I_GLA_BG)[h * DK + dk];
            float run = 0.f;
            for (int jj = 0; jj < 16; ++jj) {
                const int tok = tg * 16 + jj; float a = bgv;
#pragma unroll
                for (int r = 0; r < RANK; ++r) a += gl[tok * 16 + r] * wgu[r];
                run += logsigmoid_f(a) * (1.f / 16.f);
            }
            part[tg * 128 + dk] = run;
            __syncthreads();
            float off = 0.f, tot = 0.f;
#pragma unroll
            for (int g = 0; g < 4; ++g) { const float pv = part[g * 128 + dk]; if (g < tg) off += pv; tot += pv; }
            run = off;
            for (int jj = 0; jj < 16; ++jj) {
                const int tok = tg * 16 + jj; float a = bgv;
#pragma unroll
                for (int r = 0; r < RANK; ++r) a += gl[tok * 16 + r] * wgu[r];
                run += logsigmoid_f(a) * (1.f / 16.f);
                const float kv = bf2f(qkvr[(t0 + tok) * NQKVR + HK + h * DK + dk]);
                kd[tok * 128 + dk] = kv * __expf(tot - run);
                qs[tok * 128 + dk] = bf2f(qkvr[(t0 + tok) * NQKVR + h * DK + dk]);
            }
            if (tg == 0) dec[dk] = __expf(tot);
            __syncthreads();
#pragma unroll
            for (int ib = 0; ib < 4; ++ib) {
#pragma unroll
                for (int i = 0; i < 16; ++i) S[ib * 16 + i] *= dec[64 * hf + ib * 16 + i];
                asm volatile("" ::: "memory"); }
            for (int s = 0; s < CHUNK; ++s) {
                const float vv = bf2f(qkvr[(t0 + s) * NQKVR + 2 * HK + h * DV + j]);
#pragma unroll
                for (int ib = 0; ib < 4; ++ib) {
#pragma unroll
                    for (int i = 0; i < 16; ++i) S[ib * 16 + i] += kd[s * 128 + 64 * hf + ib * 16 + i] * vv;
                    asm volatile("" ::: "memory"); }
            }
            for (int ph = 0; ph < 2; ++ph) {
                if (hf == ph) {
                    for (int t = 0; t < CHUNK; ++t) {
                        float o = 0.f;
#pragma unroll
                        for (int ib = 0; ib < 4; ++ib) {
#pragma unroll
                            for (int i = 0; i < 16; ++i) o += qs[t * 128 + 64 * hf + ib * 16 + i] * S[ib * 16 + i];
                            asm volatile("" ::: "memory"); }
                        if (ph == 0) os[t * 256 + j] = o; else os[t * 256 + j] += o;
                    }
                }
                __syncthreads();
            }
            {
                const int tok = FTID >> 3, cc = FTID & 7; float ss = 0.f;
                for (int jj = 0; jj < 32; ++jj) { const float o = os[tok * 256 + cc * 32 + jj]; ss += o * o; }
                ss += __shfl_xor(ss, 1); ss += __shfl_xor(ss, 2); ss += __shfl_xor(ss, 4);
                const float rms = 1.f / sqrtf(ss * (1.f / DV) + EPS);
                for (int jj = 0; jj < 32; ++jj) {
                    const int col = h * DV + cc * 32 + jj;
                    const float rr = bf2f(qkvr[(t0 + tok) * NQKVR + 2 * HK + HV + col]);
                    aout[(t0 + tok) * D + col] = (bf16)f2bf(os[tok * 256 + cc * 32 + jj] * rms * silu_f(rr));
                }
            }
            __syncthreads();
        }
    }
}

__device__ __forceinline__ void n_moe(Frame& F, int L) {
    LAS float* xs = (LAS float*)F.lds; LAS float* hl = xs + D;
    const bf16* xn = WSP(bf16, WS_XN); bf16* y = WSP(bf16, WS_Y);
    const bf16* W13 = WSP(bf16, WS_W13) + (size_t)L * NE * 1024 * 1024; const bf16* W2 = WSP(bf16, WS_W2) + (size_t)L * NE * 1024 * 512;
    for (int a = F.bid; a < 2 * T; a += F.G) {
        const int tok = a >> 1, k = a & 1, e = WSP(int, WS_EID)[a]; const float gate = WSP(float, WS_GATE)[a];
        for (int i = FTID; i < D; i += NTHREADS) xs[i] = bf2f(xn[(size_t)tok * D + i]);
        __syncthreads();
        for (int jj = 0; jj < 64; ++jj) {
            const int j = FWAVE * 64 + jj; const bf16* r1 = W13 + ((size_t)e * 1024 + (j >> 7) * 256 + (j & 127)) * 1024; const bf16* r3 = r1 + 128 * 1024;
            float d1 = 0.f, d3 = 0.f;
#pragma unroll
            for (int i = 0; i < 2; ++i) { const int kk = FLANE * 8 + 512 * i; const v4u a1 = *(const v4u*)(r1 + kk), a3 = *(const v4u*)(r3 + kk);
                d1 += xs[kk] * bflo(a1.x) + xs[kk + 1] * bfhi(a1.x) + xs[kk + 2] * bflo(a1.y) + xs[kk + 3] * bfhi(a1.y) + xs[kk + 4] * bflo(a1.z) + xs[kk + 5] * bfhi(a1.z) + xs[kk + 6] * bflo(a1.w) + xs[kk + 7] * bfhi(a1.w);
                d3 += xs[kk] * bflo(a3.x) + xs[kk + 1] * bfhi(a3.x) + xs[kk + 2] * bflo(a3.y) + xs[kk + 3] * bfhi(a3.y) + xs[kk + 4] * bflo(a3.z) + xs[kk + 5] * bfhi(a3.z) + xs[kk + 6] * bflo(a3.w) + xs[kk + 7] * bfhi(a3.w); }
            d1 = wave_sum(d1); d3 = wave_sum(d3);
            if (FLANE == 0) hl[j] = bf2f((bf16)f2bf(silu_f(d1) * d3));
        }
        __syncthreads();
        for (int cc = 0; cc < 128; ++cc) {
            const int c = FWAVE * 128 + cc; const bf16* r2 = W2 + ((size_t)e * 1024 + c) * 512; const int kk = FLANE * 8; const v4u a2 = *(const v4u*)(r2 + kk);
            float d = hl[kk] * bflo(a2.x) + hl[kk + 1] * bfhi(a2.x) + hl[kk + 2] * bflo(a2.y) + hl[kk + 3] * bfhi(a2.y) + hl[kk + 4] * bflo(a2.z) + hl[kk + 5] * bfhi(a2.z) + hl[kk + 6] * bflo(a2.w) + hl[kk + 7] * bfhi(a2.w);
            d = wave_sum(d);
            if (FLANE == 0) y[((size_t)k * T + tok) * D + c] = (bf16)f2bf(gate * d);
        }
        __syncthreads();
    }
}

__device__ __forceinline__ void n_stats(Frame& F) {
    const bf16* v = WSP(bf16, WS_V); float* st = WSP(float, WS_STATS);
    for (size_t it = (size_t)F.bid * NTHREADS + FTID; it < (size_t)T * 32; it += (size_t)F.G * NTHREADS) {
        const int row = (int)(it >> 5), p = (int)(it & 31), pnv = p >> 2, wc = p & 3; float s = 0.f, q = 0.f;
        for (int bj = 0; bj < 2; ++bj) for (int j = 0; j < 32; ++j) { const float x = bf2f(v[(size_t)row * SGU_HALF + pnv * 256 + bj * 128 + wc * 32 + j]); s += x; q += x * x; }
        st[((size_t)p * T + row) * 2] = s; st[((size_t)p * T + row) * 2 + 1] = q;
    }
}
__device__ __forceinline__ void n_mix(Frame& F) {
    LAS float* wl = (LAS float*)F.lds;
    LAS float* vls = wl + 128 * 128;
    LAS float* mu = vls + 128 * 128; LAS float* rs = mu + 128; LAS float* red = rs + 128;
    bf16* u = WSP(bf16, WS_U); const bf16* v = WSP(bf16, WS_V);
    for (int bn = F.bid; bn < T / SGU_BLK; bn += F.G) {
        const size_t t0 = (size_t)bn * SGU_BLK;
        __syncthreads();
        { const int row = FTID >> 2, q4 = FTID & 3; float s = 0.f, q = 0.f;
          for (int i = 0; i < 512; ++i) { const float x = bf2f(v[(t0 + row) * SGU_HALF + q4 * 512 + i]); s += x; q += x * x; }
          red[(row * 4 + q4) * 2] = s; red[(row * 4 + q4) * 2 + 1] = q; }
        __syncthreads();
        if (FTID < 128) { float s = 0.f, q = 0.f; for (int p = 0; p < 4; ++p) { s += red[(FTID * 4 + p) * 2]; q += red[(FTID * 4 + p) * 2 + 1]; }
            const float m = s * (1.f / SGU_HALF); mu[FTID] = m; rs[FTID] = 1.f / sqrtf(q * (1.f / SGU_HALF) - m * m + EPS); }
        for (int g = 0; g < 4; ++g) {
            __syncthreads();
            for (int i = FTID; i < 128 * 128; i += NTHREADS) { const int t = i >> 7, s = i & 127; wl[i] = ((t >> 6) >= (s >> 6)) ? F.inp(I_SGU_WS)[(size_t)g * 128 * 128 + i] : 0.f; }
            for (int cb = 0; cb < 4; ++cb) {
                const int c0 = g * SGU_GC + cb * 128;
                __syncthreads();
                for (int i = FTID; i < 128 * 128; i += NTHREADS) { const int s = i >> 7, c = i & 127;
                    vls[i] = (bf2f(v[(t0 + s) * SGU_HALF + c0 + c]) - mu[s]) * rs[s] * F.inp(I_SGU_LNG)[c0 + c] + F.inp(I_SGU_LNB)[c0 + c]; }
                __syncthreads();
                const int c = FTID & 127, tq = FTID >> 7;
                for (int tt = 0; tt < 32; ++tt) {
                    const int t = tq * 32 + tt; float acc = 0.f;
                    for (int s = 0; s < 128; ++s) acc += wl[t * 128 + s] * vls[s * 128 + c];
                    const float mixed = acc + F.inp(I_SGU_BS)[g * 128 + t];
                    u[(t0 + t) * SGU_HALF + c0 + c] = (bf16)f2bf(bf2f(u[(t0 + t) * SGU_HALF + c0 + c]) * mixed);
                }
            }
        }
    }
}
#define XB_TMO      128
#define XB_XCNT(j)  (256  + 64 * (j))
#define XB_XSUB(j)  (1280 + 64 * (j))
#define XB_XGEN(j)  (2304 + 64 * (j))
#define XB_TOP      3328
#define XB_TOPGEN   3392
#define XCD_BAR_WORDS 3456
#define XB_SPIN_CAP (1u << 18)

__device__ __forceinline__ unsigned xb_ld(unsigned* p)              { return __hip_atomic_load(p, __ATOMIC_RELAXED, __HIP_MEMORY_SCOPE_AGENT); }
__device__ __forceinline__ unsigned xb_add(unsigned* p, unsigned v) { return __hip_atomic_fetch_add(p, v, __ATOMIC_RELAXED, __HIP_MEMORY_SCOPE_AGENT); }
__device__ __forceinline__ unsigned xb_xcc_id() { return (unsigned)__builtin_amdgcn_s_getreg((3 << 11) | 20) & 0xFu; }
#define XB_SPIN(cond, bar) do { unsigned _sp = 0; while (cond) { __builtin_amdgcn_s_sleep(1); \
    if ((++_sp & 255u) == 0u) { if (xb_ld(&(bar)[XB_TMO])) break; if (_sp > XB_SPIN_CAP) { atomicAdd(&(bar)[XB_TMO], 1u); break; } } } } while (0)

struct XcdBarrier {
    unsigned* bar; unsigned x;
    volatile LAS unsigned* st;
};

__device__ __forceinline__ XcdBarrier xcd_barrier_post(unsigned* bar, volatile LAS unsigned* st) {
    XcdBarrier b; b.bar = bar; b.x = xb_xcc_id(); b.st = st;
    if (threadIdx.x == 0) (void)xb_add(&bar[XB_XCNT(b.x)], 1u);
    return b;
}
__device__ __forceinline__ void xcd_barrier_complete(unsigned* bar, unsigned x, unsigned& nloc, unsigned& nx) {
    const unsigned G = gridDim.x * gridDim.y * gridDim.z;
    unsigned sum, cnt, mine, sp = 0u;
    for (;;) {
        sum = 0u; cnt = 0u; mine = 0u;
#pragma unroll
        for (unsigned j = 0; j < 16; ++j) { const unsigned c = xb_ld(&bar[XB_XCNT(j)]); sum += c; cnt += (c > 0u) ? 1u : 0u; mine = (j == x) ? c : mine; }
        if (sum == G) break;
        __builtin_amdgcn_s_sleep(1);
        if ((++sp & 255u) == 0u) { if (xb_ld(&bar[XB_TMO])) break; if (sp > XB_SPIN_CAP) { atomicAdd(&bar[XB_TMO], 1u); break; } }
    }
    nloc = mine > 0u ? mine : 1u; nx = cnt > 0u ? cnt : 1u;
}

__device__ __forceinline__ void xcd_barrier(const XcdBarrier& b) {
    asm volatile("s_waitcnt vmcnt(0)" ::: "memory");
    __syncthreads();
    if (threadIdx.x == 0) {
        unsigned* bar = b.bar;
        __builtin_amdgcn_s_waitcnt(0);
        unsigned nloc = b.st[0], nx = b.st[1];
        if (nloc == 0u) { xcd_barrier_complete(bar, b.x, nloc, nx); b.st[0] = nloc; b.st[1] = nx; }
        const unsigned old = xb_add(&bar[XB_XSUB(b.x)], 1u);
        const unsigned gen = old / nloc;
        if (old + 1u == (gen + 1u) * nloc) {
            __builtin_amdgcn_fence(__ATOMIC_RELEASE, "agent");
            asm volatile("s_waitcnt vmcnt(0)" ::: "memory");
            const unsigned og = xb_add(&bar[XB_TOP], 1u);
            const unsigned tg = og / nx;
            if (og + 1u == (tg + 1u) * nx) xb_add(&bar[XB_TOPGEN], 1u);
            else XB_SPIN(xb_ld(&bar[XB_TOPGEN]) == tg, bar);
            __builtin_amdgcn_fence(__ATOMIC_ACQUIRE, "agent");
            xb_add(&bar[XB_XGEN(b.x)], 1u);
            asm volatile("s_waitcnt vmcnt(0)" ::: "memory");
        } else {
            XB_SPIN(xb_ld(&bar[XB_XGEN(b.x)]) == gen, bar);
            __builtin_amdgcn_fence(__ATOMIC_ACQUIRE, "agent");
            asm volatile("s_waitcnt vmcnt(0)" ::: "memory");
        }
    }
    __syncthreads();
}
constexpr int RING_BYTES = 131072;
constexpr int LX_TST = RING_BYTES;
constexpr int MOE_MAXU = 6;
constexpr int LX_TAB = RING_BYTES + 512;
constexpr int LX_GT = LX_TAB + MOE_MAXU * 1024;

struct EpiStoreBf16 {
    static constexpr bool PERM = true;
    bf16* O; int ldc; const float* rs;
    __device__ __forceinline__ void operator()(const pg8::f32x4 (&acc)[2][2][4][2], const pg8::Unit& u, int wr, int wc, int fr, int fq) const {
        const int row0 = u.pm * 256 + wr * 64 + fr, col0 = u.pn * 256 + wc * 32 + 8 * fq;
#pragma unroll
        for (int ai = 0; ai < 2; ++ai)
#pragma unroll
            for (int m = 0; m < 4; ++m) { const int row = row0 + ai * 128 + m * 16; bf16* rowp = O + (size_t)row * ldc + col0; const float sc = rs[row];
#pragma unroll
                for (int bj = 0; bj < 2; ++bj) { const pg8::f32x4 v0 = acc[ai][bj][m][0] * sc, v1 = acc[ai][bj][m][1] * sc;
                    v4u w; w.x = pg8::cvt_pk_bf16(v0[0], v0[1]); w.y = pg8::cvt_pk_bf16(v0[2], v0[3]); w.z = pg8::cvt_pk_bf16(v1[0], v1[1]); w.w = pg8::cvt_pk_bf16(v1[2], v1[3]);
                    *(v4u*)(rowp + bj * 128) = w; } }
    }
};
struct EpiResBf16 {
    static constexpr bool PERM = true;
    bf16* X;
    __device__ __forceinline__ void operator()(const pg8::f32x4 (&acc)[2][2][4][2], const pg8::Unit& u, int wr, int wc, int fr, int fq) const {
        const int row0 = u.pm * 256 + wr * 64 + fr, col0 = u.pn * 256 + wc * 32 + 8 * fq;
#pragma unroll
        for (int ai = 0; ai < 2; ++ai)
#pragma unroll
            for (int m = 0; m < 4; ++m) { bf16* rowp = X + (size_t)(row0 + ai * 128 + m * 16) * D + col0;
#pragma unroll
                for (int bj = 0; bj < 2; ++bj) { const v4u r = *(const v4u*)(rowp + bj * 128); const pg8::f32x4 v0 = acc[ai][bj][m][0], v1 = acc[ai][bj][m][1];
                    v4u w; w.x = pg8::cvt_pk_bf16(bflo(r.x) + v0[0], bfhi(r.x) + v0[1]); w.y = pg8::cvt_pk_bf16(bflo(r.y) + v0[2], bfhi(r.y) + v0[3]);
                    w.z = pg8::cvt_pk_bf16(bflo(r.z) + v1[0], bfhi(r.z) + v1[1]); w.w = pg8::cvt_pk_bf16(bflo(r.w) + v1[2], bfhi(r.w) + v1[3]);
                    *(v4u*)(rowp + bj * 128) = w; } }
    }
};
struct EpiResF32 {
    static constexpr bool PERM = false;
    const float* res; float* out;
    __device__ __forceinline__ void operator()(const pg8::f32x4 (&acc)[2][2][4][2], const pg8::Unit& u, int wr, int wc, int fr, int fq) const {
        const int row0 = u.pm * 256 + wr * 64 + fr, col0 = u.pn * 256 + wc * 32 + 4 * fq;
#pragma unroll
        for (int ai = 0; ai < 2; ++ai)
#pragma unroll
            for (int m = 0; m < 4; ++m) { const size_t off = (size_t)(row0 + ai * 128 + m * 16) * D + col0;
#pragma unroll
                for (int bj = 0; bj < 2; ++bj)
#pragma unroll
                    for (int n = 0; n < 2; ++n) { const pg8::f32x4 r = *(const pg8::f32x4*)(res + off + bj * 128 + n * 16); *(pg8::f32x4*)(out + off + bj * 128 + n * 16) = r + acc[ai][bj][m][n]; } }
    }
};
struct EpiGeluSplit {
    static constexpr bool PERM = true;
    bf16* U; bf16* V; float* st; const float* rs;
    __device__ __forceinline__ void operator()(const pg8::f32x4 (&acc)[2][2][4][2], const pg8::Unit& u, int wr, int wc, int fr, int fq) const {
        const bool isv = u.pn >= 8; const int pnl = isv ? u.pn - 8 : u.pn;
        bf16* O = isv ? V : U;
        const int row0 = u.pm * 256 + wr * 64 + fr, col0 = pnl * 256 + wc * 32 + 8 * fq;
#pragma unroll
        for (int ai = 0; ai < 2; ++ai)
#pragma unroll
            for (int m = 0; m < 4; ++m) { const int row = row0 + ai * 128 + m * 16; bf16* rowp = O + (size_t)row * SGU_HALF + col0; float s = 0.f, q = 0.f; const float sc = rs[row];
#pragma unroll
                for (int bj = 0; bj < 2; ++bj) { const pg8::f32x4 v0 = acc[ai][bj][m][0] * sc, v1 = acc[ai][bj][m][1] * sc;
                    const pg8::f32x2 a = pg8::gelu_pk((pg8::f32x2){v0[0], v0[1]}), b = pg8::gelu_pk((pg8::f32x2){v0[2], v0[3]}), c = pg8::gelu_pk((pg8::f32x2){v1[0], v1[1]}), d = pg8::gelu_pk((pg8::f32x2){v1[2], v1[3]});
                    s += (a.x + a.y) + (b.x + b.y) + (c.x + c.y) + (d.x + d.y);
                    q += (a.x * a.x + a.y * a.y) + (b.x * b.x + b.y * b.y) + (c.x * c.x + c.y * c.y) + (d.x * d.x + d.y * d.y);
                    v4u w; w.x = pg8::cvt_pk_bf16(a.x, a.y); w.y = pg8::cvt_pk_bf16(b.x, b.y); w.z = pg8::cvt_pk_bf16(c.x, c.y); w.w = pg8::cvt_pk_bf16(d.x, d.y);
                    *(v4u*)(rowp + bj * 128) = w; }
                if (isv) { s += __shfl_xor(s, 16); s += __shfl_xor(s, 32); q += __shfl_xor(q, 16); q += __shfl_xor(q, 32);
                    if (fq == 0) { pg8::f32x2 o = {s, q}; *(pg8::f32x2*)(st + ((size_t)(pnl * 4 + wc) * T + row) * 2) = o; } } }
    }
};

__device__ __forceinline__ void f_gemm_in(Frame& F) {
    pg8::DenseOrder S; S.init(T, NQKVR, D, WSP(bf16, WS_WIN), F.G, F.bid);
    EpiStoreBf16 E{WSP(bf16, WS_QKVR), NQKVR, WSP(float, WS_RS)};
    pg8::gemm_phase(F.lds, WSP(bf16, WS_XN), D, S, E);
}
__device__ __forceinline__ void f_gemm_out(Frame& F) {
    pg8::DenseOrder S; S.init(T, D, HV, WSP(bf16, WS_WOUT), F.G, F.bid);
    EpiResBf16 E{WSP(bf16, WS_XN)};
    pg8::gemm_phase(F.lds, WSP(bf16, WS_AOUT), HV, S, E);
}
__device__ __forceinline__ void f_gemm_sgu_in(Frame& F) {
    pg8::DenseOrder S; S.init(T, SGU_FFN, D, WSP(bf16, WS_WSIN), F.G, F.bid);
    EpiGeluSplit E{WSP(bf16, WS_U), WSP(bf16, WS_V), WSP(float, WS_STATS), WSP(float, WS_RS)};
    pg8::gemm_phase(F.lds, WSP(bf16, WS_XN), D, S, E);
}
__device__ __forceinline__ void f_gemm_sgu_out(Frame& F) {
    pg8::DenseOrder S; S.init(T, D, SGU_HALF, WSP(bf16, WS_WSOUT), F.G, F.bid);
    EpiResBf16 E{WSP(bf16, WS_XN)};
    pg8::gemm_phase(F.lds, WSP(bf16, WS_U), SGU_HALF, S, E);
}

template <bool GATHER_> struct MoeOrder {
    static constexpr bool GATHER = GATHER_;
    int G, c, nunits, ibase, K, mode;
    const char* W; size_t estride;
    LAS const int* tst; LAS const int* tab;
    __device__ __forceinline__ bool next(int i, pg8::Unit& u) const {
        if (i >= MOE_MAXU) return false;
        const int Lu = (ibase + i) * G + c; if (Lu >= nunits) return false;
        const int rt = Lu >> 2; int e = 0;
        while (e < NE - 1 && tst[e + 1] <= rt) ++e;
        u.pm = rt; u.pn = Lu & 3; u.e = e; u.slot = i; return true;
    }
    __device__ __forceinline__ const char* bptr(const pg8::Unit& u) const { return W + (size_t)u.e * estride + (size_t)u.pn * 256 * K * 2; }
    __device__ __forceinline__ size_t abase(const pg8::Unit& u) const { return (size_t)u.pm * 256 * K * 2; }
    __device__ __forceinline__ unsigned aoff(const pg8::Unit& u, int h, int R, int C) const {
        if (mode == 0) { int ent = tab[u.slot * 256 + h * 128 + R]; ent = ent < 0 ? 0 : ent; return (unsigned)(((ent >> 1) * K + C) * 2); }
        return (unsigned)(((u.pm * 256 + h * 128 + R) * K + C) * 2);
    }
    __device__ __forceinline__ void a_ready(const pg8::Unit&) const {}
    __device__ __forceinline__ void done(const pg8::Unit&) const {}
};
struct EpiSwiglu {
    static constexpr bool PERM = true;
    bf16* H; LAS const float* gt;
    __device__ __forceinline__ void operator()(const pg8::f32x4 (&acc)[2][2][4][2], const pg8::Unit& u, int wr, int wc, int fr, int fq) const {
        const int row0 = u.pm * 256 + wr * 64 + fr, col0 = u.pn * 128 + wc * 32 + 8 * fq;
#pragma unroll
        for (int ai = 0; ai < 2; ++ai)
#pragma unroll
            for (int m = 0; m < 4; ++m) { bf16* rowp = H + (size_t)(row0 + ai * 128 + m * 16) * FF + col0; float h[8]; const float sc = gt[u.slot * 256 + ai * 128 + wr * 64 + m * 16 + fr];
#pragma unroll
                for (int n = 0; n < 2; ++n)
#pragma unroll
                    for (int i = 0; i < 4; ++i) { const float a = acc[ai][0][m][n][i] * sc, b = acc[ai][1][m][n][i] * sc; h[n * 4 + i] = a * __builtin_amdgcn_rcpf(1.f + __expf(-a)) * b; }
                v4u w; w.x = pg8::cvt_pk_bf16(h[0], h[1]); w.y = pg8::cvt_pk_bf16(h[2], h[3]); w.z = pg8::cvt_pk_bf16(h[4], h[5]); w.w = pg8::cvt_pk_bf16(h[6], h[7]);
                *(v4u*)rowp = w; }
    }
};
struct EpiScatterY {
    static constexpr bool PERM = true;
    bf16* Y; LAS const int* tab; LAS const float* gt;
    __device__ __forceinline__ void operator()(const pg8::f32x4 (&acc)[2][2][4][2], const pg8::Unit& u, int wr, int wc, int fr, int fq) const {
        const int col0 = u.pn * 256 + wc * 32 + 8 * fq;
#pragma unroll
        for (int ai = 0; ai < 2; ++ai)
#pragma unroll
            for (int m = 0; m < 4; ++m) { const int r = ai * 128 + wr * 64 + m * 16 + fr; const int ent = tab[u.slot * 256 + r]; const float g = gt[u.slot * 256 + r];
                if (ent >= 0) { bf16* rowp = Y + ((size_t)(ent & 1) * T + (ent >> 1)) * D + col0;
#pragma unroll
                    for (int bj = 0; bj < 2; ++bj) { const pg8::f32x4 v0 = acc[ai][bj][m][0] * g, v1 = acc[ai][bj][m][1] * g;
                        v4u w; w.x = pg8::cvt_pk_bf16(v0[0], v0[1]); w.y = pg8::cvt_pk_bf16(v0[2], v0[3]); w.z = pg8::cvt_pk_bf16(v1[0], v1[1]); w.w = pg8::cvt_pk_bf16(v1[2], v1[3]);
                        *(v4u*)(rowp + bj * 128) = w; } } }
    }
};
template <int MODE> __device__ __forceinline__ void f_moe_gemm(Frame& F, int L) {
    LAS int* tst = (LAS int*)(F.lds + LX_TST); LAS int* cntl = tst + 64; LAS int* tab = (LAS int*)(F.lds + LX_TAB); LAS float* gt = (LAS float*)(F.lds + LX_GT);
    unsigned* ctl = WSP(unsigned, WS_CTL);
    __syncthreads();
    if (FTID < NE) cntl[FTID] = (int)__hip_atomic_load(&ctl[CW_CNT + L * 2048 + 64 * FTID], __ATOMIC_RELAXED, __HIP_MEMORY_SCOPE_AGENT);
    __syncthreads();
    if (FTID == 0) { int s = 0; for (int e = 0; e < NE; ++e) { tst[e] = s; s += (cntl[e] + 255) >> 8; } tst[NE] = s; }
    __syncthreads();
    MoeOrder<MODE == 0> S; S.G = F.G; S.c = F.bid; S.nunits = 4 * tst[NE]; S.K = MODE == 0 ? D : FF; S.mode = MODE; S.tst = tst; S.tab = tab;
    S.W = MODE == 0 ? (const char*)(WSP(bf16, WS_W13) + (size_t)L * NE * 1024 * 1024) : (const char*)(WSP(bf16, WS_W2) + (size_t)L * NE * 1024 * 512);
    S.estride = MODE == 0 ? (size_t)1024 * 1024 * 2 : (size_t)1024 * 512 * 2;
    const int* list = WSP(int, WS_LIST); const float* gates = WSP(float, WS_GATE);
    for (int ibase = 0; ibase * F.G + F.bid < S.nunits; ibase += MOE_MAXU) {
        S.ibase = ibase;
        for (int i = 0; i < MOE_MAXU; ++i) {
            pg8::Unit u; if (!S.next(i, u)) break;
            const int tin = u.pm - tst[u.e];
            if (FTID < 256) { const int idx = tin * 256 + FTID; int ent = -1; float g = 0.f;
                if (idx < cntl[u.e]) { ent = list[(size_t)u.e * T + idx]; g = MODE == 0 ? WSP(float, WS_RS)[ent >> 1] : gates[ent]; }
                tab[i * 256 + FTID] = ent; gt[i * 256 + FTID] = g; }
        }
        __syncthreads();
        if (MODE == 0) { EpiSwiglu E{WSP(bf16, WS_HID), gt}; pg8::gemm_phase(F.lds, WSP(bf16, WS_XN), D, S, E); }
        else { EpiScatterY E{WSP(bf16, WS_Y), tab, gt}; pg8::gemm_phase(F.lds, WSP(bf16, WS_HID), FF, S, E); }
        __syncthreads();
    }
}
__device__ __forceinline__ void f_moe1(Frame& F, int L) { f_moe_gemm<0>(F, L); }
__device__ __forceinline__ void f_moe2(Frame& F, int L) { f_moe_gemm<1>(F, L); }
__device__ __forceinline__ void transpose_item(const float* W, int ldw, const float* kscale, float cs, bf16* WT, int K, int dst_row0, LAS float* scr, int k0, int n0, int lane) {
    f32x4 x[8]; float ks[8];
    const int kr = lane >> 3, n4 = (lane & 7) * 4;
#pragma unroll
    for (int i = 0; i < 8; ++i) { x[i] = *(const f32x4*)(W + (size_t)(k0 + 8 * i + kr) * ldw + n0 + n4); ks[i] = kscale ? kscale[k0 + 8 * i + kr] * cs : cs; }
#pragma unroll
    for (int i = 0; i < 8; ++i) { LAS float* d = scr + (8 * i + kr) * 33 + n4; d[0] = x[i][0] * ks[i]; d[1] = x[i][1] * ks[i]; d[2] = x[i][2] * ks[i]; d[3] = x[i][3] * ks[i]; }
    LDS_WAIT(); asm volatile("" ::: "memory");
    const int c = lane & 7;
#pragma unroll
    for (int j = 0; j < 4; ++j) { const int n = (lane >> 3) + 8 * j; const LAS float* s = scr + (8 * c) * 33 + n;
        v4u o; o.x = pk2(s[0 * 33], s[1 * 33]); o.y = pk2(s[2 * 33], s[3 * 33]); o.z = pk2(s[4 * 33], s[5 * 33]); o.w = pk2(s[6 * 33], s[7 * 33]);
        *(v4u*)(WT + (size_t)(dst_row0 + n) * K + k0 + 8 * c) = o; }
    LDS_WAIT(); asm volatile("" ::: "memory");
}
__device__ __forceinline__ void convert_job_item(const float* W, int ldw, int K, int N, const float* kscale, int qcols, float qs, bf16* WT, int rowmap, LAS float* scr, int item, int lane) {
    const int nblk = N / 32, kb = item / nblk, nb = item % nblk, k0 = 64 * kb, n0 = 32 * nb;
    const int dr = rowmap == 0 ? n0 : ((n0 >> 7) * 256 + (n0 & 127) + (rowmap == 2 ? 128 : 0));
    transpose_item(W, ldw, kscale, n0 < qcols ? qs : 1.f, WT, K, dr, scr, k0, n0, lane);
}
__device__ __forceinline__ void f_convert_gla(Frame& F) {
    LAS float* scr = (LAS float*)(F.lds + FWAVE * 8448);
    const int gw = F.bid * NWAVES + FWAVE, NGW = F.G * NWAVES;
    constexpr int I0 = (D / 64) * (NQKVR / 32), I1 = (HV / 64) * (D / 32);
    for (int it = gw; it < I0 + I1; it += NGW) {
        if (it < I0) convert_job_item(F.inp(I_GLA_WIN), GLA_IN, D, NQKVR, F.inp(I_GLA_NORM), HK, 0.08838834764831845f, WSP(bf16, WS_WIN), 0, scr, it, FLANE);
        else convert_job_item(F.inp(I_GLA_WOUT), D, HV, D, F.inp(I_GLA_HG), 0, 1.f, WSP(bf16, WS_WOUT), 0, scr, it - I0, FLANE);
    }
}
__device__ __forceinline__ void f_convert_rest(Frame& F, int cw, int NCW) {
    LAS float* scr = (LAS float*)(F.lds + FWAVE * 8448);
    constexpr int I0 = (D / 64) * (SGU_FFN / 32), I1 = (SGU_HALF / 64) * (D / 32), IE1 = (D / 64) * (FF / 32), IE2 = (FF / 64) * (D / 32);
    constexpr int IM = 2 * NE * IE1;
    static_assert(IE1 == IE2, "w1 / w2 item counts");
    for (int it = cw; it < I0 + I1 + 3 * IM; it += NCW) {
        int r = it;
        if (r < I0) { convert_job_item(F.inp(I_SGU_WIN), SGU_FFN, D, SGU_FFN, F.inp(I_SGU_NORM), 0, 1.f, WSP(bf16, WS_WSIN), 0, scr, r, FLANE); continue; } r -= I0;
        if (r < I1) { convert_job_item(F.inp(I_SGU_WOUT), D, SGU_HALF, D, nullptr, 0, 1.f, WSP(bf16, WS_WSOUT), 0, scr, r, FLANE); continue; } r -= I1;
        const int which = r / IM; r -= which * IM; const int le = r / IE1, li = r % IE1, L = le / NE;
        if (which == 0) convert_job_item(F.inp(I_MOE_W1) + (size_t)le * D * FF, FF, D, FF, F.inp(I_MOE_NORM) + L * D, 0, 1.f, WSP(bf16, WS_W13) + (size_t)le * 1024 * 1024, 1, scr, li, FLANE);
        else if (which == 1) convert_job_item(F.inp(I_MOE_W3) + (size_t)le * D * FF, FF, D, FF, F.inp(I_MOE_NORM) + L * D, 0, 1.f, WSP(bf16, WS_W13) + (size_t)le * 1024 * 1024, 2, scr, li, FLANE);
        else convert_job_item(F.inp(I_MOE_W2) + (size_t)le * FF * D, D, FF, D, nullptr, 0, 1.f, WSP(bf16, WS_W2) + (size_t)le * 1024 * 512, 0, scr, li, FLANE);
    }
}

constexpr int SC_K = 0, SC_KSTR = 320;
constexpr int SC_V = 20480, SC_VSTR = 576;
constexpr int SC_Q = 57344, SC_QSTR = 272;
constexpr int SC_O = 74752, SC_OSTR = 528;
constexpr int SC_GL = 108544, SC_PART = 112640, SC_DEC = 114688, SC_WG = 115200;
__device__ __forceinline__ s16x4 tr_read16(LAS const unsigned char* p) {
    typedef short v4i16_t __attribute__((ext_vector_type(4)));
    return __builtin_bit_cast(s16x4, __builtin_amdgcn_ds_read_tr16_b64_v4i16((LAS v4i16_t*)p));
}
__device__ __forceinline__ void f_scan_item(Frame& F, int item) {
    const int b = item / GLA_H, h = item % GLA_H;
    const bf16* qkvr = WSP(bf16, WS_QKVR); const float* glr = WSP(float, WS_GLR); bf16* aout = WSP(bf16, WS_AOUT);
    LAS unsigned char* L = F.lds;
    LAS float* gl = (LAS float*)(L + SC_GL); LAS float* part = (LAS float*)(L + SC_PART); LAS float* dec = (LAS float*)(L + SC_DEC);
    const int tid = FTID, lane = FLANE, w = FWAVE;
    const int r32 = lane & 31, hh = lane >> 5, blk = (lane >> 4) & 1, q4 = (lane & 15) >> 2, p4 = lane & 3;
    const int dk = tid & 127, tg = tid >> 7;
    const int gq = lane >> 4, gcol = lane & 15, gdk = 16 * w + gcol;
    bf16x8 gBh, gBl;
    { unsigned ph[4], pl[4];
#pragma unroll
      for (int j = 0; j < 4; ++j) { const float x0 = gq < 2 ? F.inp(I_GLA_WGU)[(8 * gq + 2 * j) * HK + h * DK + gdk] : 0.f, x1 = gq < 2 ? F.inp(I_GLA_WGU)[(8 * gq + 2 * j + 1) * HK + h * DK + gdk] : 0.f;
          ph[j] = pk2(x0, x1); pl[j] = pk2(x0 - bflo(ph[j]), x1 - bfhi(ph[j])); }
      v4u vh = {ph[0], ph[1], ph[2], ph[3]}, vl = {pl[0], pl[1], pl[2], pl[3]};
      gBh = __builtin_bit_cast(bf16x8, vh); gBl = __builtin_bit_cast(bf16x8, vl); }
    const float gbias = F.inp(I_GLA_BG)[h * DK + gdk];
    __syncthreads();
    f32x16 st[4];
#pragma unroll
    for (int i = 0; i < 4; ++i)
#pragma unroll
        for (int j = 0; j < 16; ++j) st[i][j] = 0.f;
    v4u rk[2], rq[2], rv[4]; f32x4 rg;
    const size_t rowb = (size_t)b * SEQ;
    const unsigned vo_kq = (unsigned)(((tid >> 4) * NQKVR + (tid & 15) * 8) * 2), vo_v = (unsigned)(((tid >> 5) * NQKVR + (tid & 31) * 8) * 2), vo_g = (unsigned)(tid * 16);
    const unsigned lo_k = (unsigned)(SC_K + (tid >> 4) * SC_KSTR + (tid & 15) * 16), lo_q = (unsigned)(SC_Q + (tid >> 4) * SC_QSTR + (tid & 15) * 16), lo_v = (unsigned)(SC_V + (tid >> 5) * SC_VSTR + (tid & 31) * 16);
#define SC_LOAD(c) do { size_t cb_ = (rowb + (size_t)(c) * CHUNK) * NQKVR * 2; asm volatile("" : "+s"(cb_)); const char* gb_ = (const char*)qkvr + cb_ + (size_t)(h * DK * 2); \
        _Pragma("unroll") for (int i = 0; i < 2; ++i) { \
            rk[i] = *(const v4u*)(gb_ + (size_t)(HK * 2 + i * 32 * NQKVR * 2) + vo_kq); rq[i] = *(const v4u*)(gb_ + (size_t)(i * 32 * NQKVR * 2) + vo_kq); } \
        _Pragma("unroll") for (int i = 0; i < 4; ++i) rv[i] = *(const v4u*)(gb_ + (size_t)(2 * HK * 2 + h * (DV - DK) * 2 + i * 16 * NQKVR * 2) + vo_v); \
        if (tid < 256) rg = *(const f32x4*)((const char*)glr + (rowb + (size_t)(c) * CHUNK) * RANK * 4 + vo_g); } while (0)
#define SC_STORE() do { \
        _Pragma("unroll") for (int i = 0; i < 2; ++i) { *(LAS v4u*)(L + lo_k + i * 32 * SC_KSTR) = rk[i]; *(LAS v4u*)(L + lo_q + i * 32 * SC_QSTR) = rq[i]; } \
        _Pragma("unroll") for (int i = 0; i < 4; ++i) *(LAS v4u*)(L + lo_v + i * 16 * SC_VSTR) = rv[i]; \
        if (tid < 256) *(LAS f32x4*)(gl + tid * 4) = rg; } while (0)
    SC_LOAD(0);
    SC_STORE();
    for (int c = 0; c < NCHUNK; ++c) {
        const size_t t0 = rowb + (size_t)c * CHUNK;
        __syncthreads();
        if (c + 1 < NCHUNK) SC_LOAD(c + 1);
        {
            pg8::f32x4 g4[4]; float tsum[4], pre[4];
#pragma unroll
            for (int t = 0; t < 4; ++t) {
                v4u ah = {0u, 0u, 0u, 0u}, al = {0u, 0u, 0u, 0u};
                if (gq < 2) { const f32x4 x0 = *(const LAS f32x4*)(gl + (16 * t + gcol) * 16 + 8 * gq), x1 = *(const LAS f32x4*)(gl + (16 * t + gcol) * 16 + 8 * gq + 4);
                    ah.x = pk2(x0[0], x0[1]); ah.y = pk2(x0[2], x0[3]); ah.z = pk2(x1[0], x1[1]); ah.w = pk2(x1[2], x1[3]);
                    al.x = pk2(x0[0] - bflo(ah.x), x0[1] - bfhi(ah.x)); al.y = pk2(x0[2] - bflo(ah.y), x0[3] - bfhi(ah.y)); al.z = pk2(x1[0] - bflo(ah.z), x1[1] - bfhi(ah.z)); al.w = pk2(x1[2] - bflo(ah.w), x1[3] - bfhi(ah.w)); }
                pg8::f32x4 a4 = {gbias, gbias, gbias, gbias};
                a4 = __builtin_amdgcn_mfma_f32_16x16x32_bf16(__builtin_bit_cast(bf16x8, ah), gBh, a4, 0, 0, 0);
                a4 = __builtin_amdgcn_mfma_f32_16x16x32_bf16(__builtin_bit_cast(bf16x8, al), gBh, a4, 0, 0, 0);
                a4 = __builtin_amdgcn_mfma_f32_16x16x32_bf16(__builtin_bit_cast(bf16x8, ah), gBl, a4, 0, 0, 0);
#pragma unroll
                for (int i = 0; i < 4; ++i) { const float a = a4[i]; a4[i] = (fminf(a, 0.f) - __logf(1.f + __expf(-fabsf(a)))) * (1.f / 16.f); }
                a4[1] += a4[0]; a4[2] += a4[1]; a4[3] += a4[2];
                g4[t] = a4;
                const float s0 = a4[3], x1 = __shfl_xor(s0, 16), x2 = __shfl_xor(s0, 32), x3 = __shfl_xor(x1, 32);
                tsum[t] = (s0 + x1) + (x2 + x3);
                pre[t] = ((gq ^ 1) < gq ? x1 : 0.f) + ((gq ^ 2) < gq ? x2 : 0.f) + ((gq ^ 3) < gq ? x3 : 0.f);
            }
            const float tot = (tsum[0] + tsum[1]) + (tsum[2] + tsum[3]);
            float basep = 0.f;
#pragma unroll
            for (int t = 0; t < 4; ++t) {
#pragma unroll
                for (int i = 0; i < 4; ++i) {
                    LAS unsigned short* kp = (LAS unsigned short*)(L + SC_K + (16 * t + 4 * gq + i) * SC_KSTR + gdk * 2);
                    *kp = (unsigned short)f2bf(bf2f(*kp) * __expf(tot - (basep + pre[t] + g4[t][i])));
                }
                basep += tsum[t];
            }
            if (gq == 0) dec[gdk] = __expf(tot);
        }
        __syncthreads();
        const int etok = tid >> 3, ecc = tid & 7;
        v4u rr[4];
        { size_t eb_ = t0 * NQKVR * 2; asm volatile("" : "+s"(eb_));
          const char* rb_ = (const char*)qkvr + eb_ + (size_t)((2 * HK + HV + h * DV) * 2); const unsigned vo_r = (unsigned)((etok * NQKVR + ecc * 32) * 2);
#pragma unroll
          for (int i = 0; i < 4; ++i) rr[i] = *(const v4u*)(rb_ + vo_r + i * 16); }
#pragma unroll
        for (int i = 0; i < 4; ++i)
#pragma unroll
            for (int g4 = 0; g4 < 4; ++g4) { const f32x4 d4 = *(const LAS f32x4*)(dec + 32 * i + 8 * g4 + 4 * hh);
#pragma unroll
                for (int j = 0; j < 4; ++j) st[i][4 * g4 + j] *= d4[j]; }
#pragma unroll
        for (int s = 0; s < 4; ++s) {
            const int trow = 16 * s + 8 * hh + q4;
            const s16x4 v0 = tr_read16(L + SC_V + trow * SC_VSTR + (32 * w + 16 * blk + 4 * p4) * 2), v1 = tr_read16(L + SC_V + (trow + 4) * SC_VSTR + (32 * w + 16 * blk + 4 * p4) * 2);
            const bf16x8 Bv = {v0[0], v0[1], v0[2], v0[3], v1[0], v1[1], v1[2], v1[3]};
#pragma unroll
            for (int i = 0; i < 4; ++i) {
                const s16x4 k0 = tr_read16(L + SC_K + trow * SC_KSTR + (32 * i + 16 * blk + 4 * p4) * 2), k1 = tr_read16(L + SC_K + (trow + 4) * SC_KSTR + (32 * i + 16 * blk + 4 * p4) * 2);
                const bf16x8 Ak = {k0[0], k0[1], k0[2], k0[3], k1[0], k1[1], k1[2], k1[3]};
                st[i] = __builtin_amdgcn_mfma_f32_32x32x16_bf16(Ak, Bv, st[i], 0, 0, 0);
            }
            asm volatile("" ::: "memory");
        }
        f32x16 oacc[2];
#pragma unroll
        for (int ot = 0; ot < 2; ++ot)
#pragma unroll
            for (int j = 0; j < 16; ++j) oacc[ot][j] = 0.f;
#pragma unroll
        for (int i = 0; i < 4; ++i)
#pragma unroll
            for (int s2 = 0; s2 < 2; ++s2) {
                v4u pb; pb.x = pk2(st[i][8 * s2 + 0], st[i][8 * s2 + 1]); pb.y = pk2(st[i][8 * s2 + 2], st[i][8 * s2 + 3]); pb.z = pk2(st[i][8 * s2 + 4], st[i][8 * s2 + 5]); pb.w = pk2(st[i][8 * s2 + 6], st[i][8 * s2 + 7]);
                const bf16x8 Bs = __builtin_bit_cast(bf16x8, pb);
#pragma unroll
                for (int ot = 0; ot < 2; ++ot) {
                    LAS const unsigned char* qp = L + SC_Q + (32 * ot + r32) * SC_QSTR + (32 * i + 16 * s2 + 4 * hh) * 2;
                    const v2u a0 = *(const LAS v2u*)qp, a1 = *(const LAS v2u*)(qp + 16);
                    v4u pa; pa.x = a0.x; pa.y = a0.y; pa.z = a1.x; pa.w = a1.y;
                    oacc[ot] = __builtin_amdgcn_mfma_f32_32x32x16_bf16(__builtin_bit_cast(bf16x8, pa), Bs, oacc[ot], 0, 0, 0);
                }
                asm volatile("" ::: "memory");
            }
#pragma unroll
        for (int ot = 0; ot < 2; ++ot)
#pragma unroll
            for (int rg16 = 0; rg16 < 16; ++rg16) {
                const int tok = 32 * ot + (rg16 & 3) + 8 * (rg16 >> 2) + 4 * hh;
                *(LAS unsigned short*)(L + SC_O + tok * SC_OSTR + (32 * w + r32) * 2) = (unsigned short)f2bf(oacc[ot][rg16]);
            }
        __syncthreads();
        if (c + 1 < NCHUNK) SC_STORE();
        {
            const int tok = etok, cc = ecc;
            v4u ov[4]; float ss = 0.f;
#pragma unroll
            for (int i = 0; i < 4; ++i) ov[i] = *(const LAS v4u*)(L + SC_O + tok * SC_OSTR + cc * 64 + i * 16);
#pragma unroll
            for (int i = 0; i < 4; ++i) { const float a0 = bflo(ov[i].x), a1 = bfhi(ov[i].x), a2 = bflo(ov[i].y), a3 = bfhi(ov[i].y), a4 = bflo(ov[i].z), a5 = bfhi(ov[i].z), a6 = bflo(ov[i].w), a7 = bfhi(ov[i].w);
                ss += (a0 * a0 + a1 * a1) + (a2 * a2 + a3 * a3) + (a4 * a4 + a5 * a5) + (a6 * a6 + a7 * a7); }
            ss += __shfl_xor(ss, 1); ss += __shfl_xor(ss, 2); ss += __shfl_xor(ss, 4);
            const float rms = __builtin_amdgcn_rsqf(ss * (1.f / DV) + EPS);
            size_t ob_ = (t0 * D + h * DV) * 2; asm volatile("" : "+s"(ob_)); const unsigned vo_o = (unsigned)((tok * D + cc * 32) * 2);
#pragma unroll
            for (int i = 0; i < 4; ++i) {
                v4u o;
                o.x = pk2(bflo(ov[i].x) * rms * silu_f(bflo(rr[i].x)), bfhi(ov[i].x) * rms * silu_f(bfhi(rr[i].x)));
                o.y = pk2(bflo(ov[i].y) * rms * silu_f(bflo(rr[i].y)), bfhi(ov[i].y) * rms * silu_f(bfhi(rr[i].y)));
                o.z = pk2(bflo(ov[i].z) * rms * silu_f(bflo(rr[i].z)), bfhi(ov[i].z) * rms * silu_f(bfhi(rr[i].z)));
                o.w = pk2(bflo(ov[i].w) * rms * silu_f(bflo(rr[i].w)), bfhi(ov[i].w) * rms * silu_f(bfhi(rr[i].w)));
                *(v4u*)((char*)aout + ob_ + vo_o + i * 16) = o;
            }
        }
    }
    __syncthreads();
#undef SC_LOAD
#undef SC_STORE
}
#ifndef P2_PARTS
#define P2_PARTS 3
#endif
__device__ __forceinline__ void f_scan_convert(Frame& F, int parts = 3) {
    constexpr int NITEM = NBATCH * GLA_H;
    const bool split = F.G >= 2 * NITEM;
    if ((parts & 1) && (!split || F.bid < NITEM)) for (int it = F.bid; it < NITEM; it += F.G) f_scan_item(F, it);
    if (!(parts & 2)) return;
    if (!split) f_convert_rest(F, F.bid * NWAVES + FWAVE, F.G * NWAVES);
    else if (F.bid >= NITEM) f_convert_rest(F, (F.bid - NITEM) * NWAVES + FWAVE, (F.G - NITEM) * NWAVES);
}
constexpr int MX_W = 0, MX_WSTR = 272;
constexpr int MX_V0 = 34816, MX_VSTR = 320, MX_VBYTES = 40960;
constexpr int MX_MU = 116736;
__device__ __forceinline__ void f_mix(Frame& F) {
    LAS unsigned char* L = F.lds;
    LAS float* mu = (LAS float*)(L + MX_MU); LAS float* rs = mu + 128; LAS float* m1 = rs + 128; LAS float* m0 = m1 + 128; LAS float* bsg = m0 + 128;
    bf16* u = WSP(bf16, WS_U); const bf16* v = WSP(bf16, WS_V); const float* st = WSP(float, WS_STATS);
    const int tid = FTID, lane = FLANE, w = FWAVE;
    const int r32 = lane & 31, hh = lane >> 5, blk = (lane >> 4) & 1, q4 = (lane & 15) >> 2, p4 = lane & 3;
    const int ct = w >> 1, th = w & 1;
    const float* lng = F.inp(I_SGU_LNG); const float* lnb = F.inp(I_SGU_LNB);
    for (int bn = F.bid; bn < T / SGU_BLK; bn += F.G) {
        const size_t t0 = (size_t)bn * SGU_BLK;
        __syncthreads();
        if (tid < 128) { float s = 0.f, q = 0.f;
            for (int p = 0; p < 32; ++p) { const pg8::f32x2 a = *(const pg8::f32x2*)(st + ((size_t)p * T + t0 + tid) * 2); s += a.x; q += a.y; }
            const float m = s * (1.f / SGU_HALF); mu[tid] = m; rs[tid] = 1.f / sqrtf(fmaxf(q * (1.f / SGU_HALF) - m * m, 0.f) + EPS); }
        v4u pre[4];
#define MX_LOAD(g_, cq_) do { size_t vb_ = (t0 * SGU_HALF + (g_) * SGU_GC + (cq_) * 128) * 2; asm volatile("" : "+s"(vb_)); \
        _Pragma("unroll") for (int i = 0; i < 4; ++i) pre[i] = *(const v4u*)((const char*)v + vb_ + (size_t)(i * 32 * SGU_HALF * 2) + (unsigned)(((tid >> 4) * SGU_HALF + (tid & 15) * 8) * 2)); } while (0)
#define MX_STORE(buf_) do { _Pragma("unroll") for (int i = 0; i < 4; ++i) *(LAS v4u*)(L + MX_V0 + (buf_) * MX_VBYTES + ((tid >> 4) + 32 * i) * MX_VSTR + (tid & 15) * 16) = pre[i]; } while (0)
        MX_LOAD(0, 0);
        for (int g = 0; g < 4; ++g) {
            __syncthreads();
            {
                const int t = tid >> 2, sq = tid & 3; const float* wsrc = F.inp(I_SGU_WS) + ((size_t)g * 128 + t) * 128 + sq * 32;
                float a1 = 0.f, a0 = 0.f;
#pragma unroll
                for (int i = 0; i < 4; ++i) {
                    const f32x4 x0 = *(const f32x4*)(wsrc + i * 8), x1 = *(const f32x4*)(wsrc + i * 8 + 4); float wv[8] = {x0[0], x0[1], x0[2], x0[3], x1[0], x1[1], x1[2], x1[3]}; unsigned short hb[8];
#pragma unroll
                    for (int j = 0; j < 8; ++j) { const int s = sq * 32 + i * 8 + j; const float wm = ((t >> 6) >= (s >> 6)) ? wv[j] : 0.f; a0 += wm; hb[j] = (unsigned short)f2bf(wm * rs[s]); a1 += bf2f(hb[j]) * mu[s]; }
                    v4u o; o.x = hb[0] | ((unsigned)hb[1] << 16); o.y = hb[2] | ((unsigned)hb[3] << 16); o.z = hb[4] | ((unsigned)hb[5] << 16); o.w = hb[6] | ((unsigned)hb[7] << 16);
                    *(LAS v4u*)(L + MX_W + t * MX_WSTR + (sq * 32 + i * 8) * 2) = o;
                }
                a1 += __shfl_xor(a1, 1); a1 += __shfl_xor(a1, 2); a0 += __shfl_xor(a0, 1); a0 += __shfl_xor(a0, 2);
                if (sq == 0) { m1[t] = a1; m0[t] = a0; }
                if (tid < 128) bsg[tid] = F.inp(I_SGU_BS)[g * 128 + tid];
            }
            for (int cq = 0; cq < 4; ++cq) {
                const int it = g * 4 + cq, buf = it & 1;
                MX_STORE(buf);
                __syncthreads();
                if (it + 1 < 16) MX_LOAD((it + 1) >> 2, (it + 1) & 3);
                f32x16 acc[2];
#pragma unroll
                for (int tt = 0; tt < 2; ++tt)
#pragma unroll
                    for (int j = 0; j < 16; ++j) acc[tt][j] = 0.f;
                LAS const unsigned char* Vb = L + MX_V0 + buf * MX_VBYTES;
                const int nks = th == 0 ? 4 : 8;
                for (int ks = 0; ks < nks; ++ks) {
                    const int srow = 16 * ks + 8 * hh + q4;
                    const s16x4 a0 = tr_read16(Vb + srow * MX_VSTR + (32 * ct + 16 * blk + 4 * p4) * 2), a1 = tr_read16(Vb + (srow + 4) * MX_VSTR + (32 * ct + 16 * blk + 4 * p4) * 2);
                    const bf16x8 Av = {a0[0], a0[1], a0[2], a0[3], a1[0], a1[1], a1[2], a1[3]};
#pragma unroll
                    for (int tt = 0; tt < 2; ++tt) {
                        const bf16x8 Bw = *(const LAS bf16x8*)(L + MX_W + (64 * th + 32 * tt + r32) * MX_WSTR + (16 * ks + 8 * hh) * 2);
                        acc[tt] = __builtin_amdgcn_mfma_f32_32x32x16_bf16(Av, Bw, acc[tt], 0, 0, 0);
                    }
                }
                const int cbase = g * SGU_GC + cq * 128 + 32 * ct + 4 * hh;
#pragma unroll
                for (int tt = 0; tt < 2; ++tt) {
                    const int t = 64 * th + 32 * tt + r32; const float tm1 = m1[t], tm0 = m0[t], tb = bsg[t];
                    bf16* up = u + (t0 + t) * SGU_HALF + cbase;
#pragma unroll
                    for (int g4 = 0; g4 < 4; ++g4) {
                        const v2u uu = *(const v2u*)(up + 8 * g4); const f32x4 lg = *(const f32x4*)(lng + cbase + 8 * g4), lb = *(const f32x4*)(lnb + cbase + 8 * g4);
                        const float o0 = bflo(uu.x) * (lg[0] * (acc[tt][4 * g4 + 0] - tm1) + lb[0] * tm0 + tb), o1 = bfhi(uu.x) * (lg[1] * (acc[tt][4 * g4 + 1] - tm1) + lb[1] * tm0 + tb);
                        const float o2 = bflo(uu.y) * (lg[2] * (acc[tt][4 * g4 + 2] - tm1) + lb[2] * tm0 + tb), o3 = bfhi(uu.y) * (lg[3] * (acc[tt][4 * g4 + 3] - tm1) + lb[3] * tm0 + tb);
                        v2u o; o.x = pk2(o0, o1); o.y = pk2(o2, o3); *(v2u*)(up + 8 * g4) = o;
                    }
                }
            }
        }
#undef MX_LOAD
#undef MX_STORE
    }
}
constexpr int RW_STR = 2064;
constexpr int RW_LG = 48 * RW_STR;
constexpr int RW_HIST = RW_LG + 8 * 16 * 48 * 4;
template <int MODE> __device__ __forceinline__ void f_rowgroup(Frame& F, int Lyr) {
    constexpr int NCT = MODE == 0 ? 1 : 3;
    LAS unsigned char* L = F.lds;
    const int tid = FTID, lane = FLANE, w = FWAVE, rw = lane & 15, q = lane >> 4;
    const float* xsrc = F.inp(I_X);
    bf16* xb = WSP(bf16, WS_XN); float* rsout = WSP(float, WS_RS);
    __syncthreads();
    for (int k = tid; k < D; k += NTHREADS) {
        if (MODE == 0) {
            const float gn = F.inp(I_GLA_NORM)[k]; const float* wr_ = F.inp(I_GLA_WIN) + (size_t)k * GLA_IN + NQKVR;
#pragma unroll
            for (int c4 = 0; c4 < 4; ++c4) { const f32x4 x = *(const f32x4*)(wr_ + 4 * c4);
#pragma unroll
                for (int j = 0; j < 4; ++j) *(LAS unsigned short*)(L + (4 * c4 + j) * RW_STR + k * 2) = (unsigned short)f2bf(x[j] * gn); }
        } else {
            const float gn = F.inp(I_MOE_NORM)[Lyr * D + k];
            const f32x4 xg = *(const f32x4*)(F.inp(I_MOE_WG) + ((size_t)Lyr * D + k) * 4);
#pragma unroll
            for (int j = 0; j < 4; ++j) *(LAS unsigned short*)(L + j * RW_STR + k * 2) = (unsigned short)f2bf(xg[j] * gn);
#pragma unroll
            for (int g = 0; g < 4; ++g) { const float* ws_ = F.inp(I_MOE_WSUB) + (((size_t)Lyr * 4 + g) * D + k) * EPG; const f32x4 a = *(const f32x4*)ws_, b = *(const f32x4*)(ws_ + 4);
#pragma unroll
                for (int j = 0; j < 4; ++j) { *(LAS unsigned short*)(L + (4 + 8 * g + j) * RW_STR + k * 2) = (unsigned short)f2bf(a[j] * gn); *(LAS unsigned short*)(L + (8 + 8 * g + j) * RW_STR + k * 2) = (unsigned short)f2bf(b[j] * gn); } }
#pragma unroll
            for (int c = 36; c < 48; ++c) *(LAS unsigned short*)(L + c * RW_STR + k * 2) = 0;
        }
    }
    LAS int* hist = (LAS int*)(L + RW_HIST); LAS int* hbase = hist + 32;
    if (MODE == 1 && tid < 32) hist[tid] = 0;
    __syncthreads();
    const int ngroups = T / 16, niter = (ngroups + F.G * NWAVES - 1) / (F.G * NWAVES);
    for (int iter = 0; iter < niter; ++iter) {
        const int grp = (iter * F.G + F.bid) * NWAVES + w; const bool valid = grp < ngroups;
        const size_t row = (size_t)grp * 16 + rw;
        float rstd = 0.f; pg8::f32x4 acc[NCT];
        if (valid) {
#pragma unroll
            for (int c = 0; c < NCT; ++c) acc[c] = (pg8::f32x4){0.f, 0.f, 0.f, 0.f};
            float ss = 0.f;
#pragma unroll 8
            for (int s = 0; s < 32; ++s) {
                v4u pa;
                if (MODE == 0) {
                    const float* xr = xsrc + row * D + 8 * q + 32 * s;
                    const f32x4 x0 = *(const f32x4*)xr, x1 = *(const f32x4*)(xr + 4);
                    ss += (x0[0] * x0[0] + x0[1] * x0[1]) + (x0[2] * x0[2] + x0[3] * x0[3]) + (x1[0] * x1[0] + x1[1] * x1[1]) + (x1[2] * x1[2] + x1[3] * x1[3]);
                    pa.x = pk2(x0[0], x0[1]); pa.y = pk2(x0[2], x0[3]); pa.z = pk2(x1[0], x1[1]); pa.w = pk2(x1[2], x1[3]);
                    *(v4u*)(xb + row * D + 8 * q + 32 * s) = pa;
                } else {
                    pa = *(const v4u*)(xb + row * D + 8 * q + 32 * s);
                    const float a0 = bflo(pa.x), a1 = bfhi(pa.x), a2 = bflo(pa.y), a3 = bfhi(pa.y), a4 = bflo(pa.z), a5 = bfhi(pa.z), a6 = bflo(pa.w), a7 = bfhi(pa.w);
                    ss += (a0 * a0 + a1 * a1) + (a2 * a2 + a3 * a3) + (a4 * a4 + a5 * a5) + (a6 * a6 + a7 * a7);
                }
                const bf16x8 A = __builtin_bit_cast(bf16x8, pa);
#pragma unroll
                for (int c = 0; c < NCT; ++c) { const bf16x8 B = *(const LAS bf16x8*)(L + (16 * c + rw) * RW_STR + (32 * s + 8 * q) * 2); acc[c] = __builtin_amdgcn_mfma_f32_16x16x32_bf16(A, B, acc[c], 0, 0, 0); }
            }
            ss += __shfl_xor(ss, 16); ss += __shfl_xor(ss, 32);
            rstd = __builtin_amdgcn_rsqf(ss * (1.f / D) + EPS);
            if (q == 0) rsout[row] = rstd;
        }
        float rs4[4];
#pragma unroll
        for (int i = 0; i < 4; ++i) rs4[i] = __shfl(rstd, 4 * q + i);
        int e1 = 0, e2 = 0, rk1 = 0, rk2 = 0; float gt1 = 0.f, gt2 = 0.f;
        if (MODE == 0) {
            if (valid) {
                float* glr = WSP(float, WS_GLR);
#pragma unroll
                for (int i = 0; i < 4; ++i) glr[((size_t)grp * 16 + 4 * q + i) * RANK + rw] = acc[0][i] * rs4[i];
            }
        } else {
            LAS float* lgw = (LAS float*)(L + RW_LG) + w * 16 * 48;
            if (valid) {
#pragma unroll
                for (int c = 0; c < NCT; ++c)
#pragma unroll
                    for (int i = 0; i < 4; ++i) lgw[(4 * q + i) * 48 + 16 * c + rw] = acc[c][i] * rs4[i];
            }
            LDS_WAIT(); asm volatile("" ::: "memory");
            if (valid && lane < 16) {
                const LAS float* lr = lgw + lane * 48; const float* bg = F.inp(I_MOE_BG) + Lyr * 4;
                float lg[4];
#pragma unroll
                for (int c = 0; c < 4; ++c) lg[c] = lr[c] + bg[c];
                int g = 0; float gm = lg[0];
#pragma unroll
                for (int c = 1; c < 4; ++c) if (lg[c] > gm) { gm = lg[c]; g = c; }
                float gs = 0.f;
#pragma unroll
                for (int c = 0; c < 4; ++c) gs += __expf(lg[c] - gm);
                const float g_w = 1.f / gs; const float* bs = F.inp(I_MOE_BSUB) + (Lyr * 4 + g) * EPG;
                int i1 = 0, i2 = 0; float m1v = -3.0e38f, m2v = -3.0e38f;
                for (int e = 0; e < EPG; ++e) { const float x = lr[4 + 8 * g + e] + bs[e];
                    if (x > m1v) { m2v = m1v; i2 = i1; m1v = x; i1 = e; } else if (x > m2v) { m2v = x; i2 = e; } }
                const float w1 = 1.f / (1.f + __expf(m2v - m1v));
                e1 = g * EPG + i1; e2 = g * EPG + i2; gt1 = g_w * w1; gt2 = g_w * (1.f - w1);
                rk1 = __hip_atomic_fetch_add(&hist[e1], 1, __ATOMIC_RELAXED, __HIP_MEMORY_SCOPE_WORKGROUP); rk2 = __hip_atomic_fetch_add(&hist[e2], 1, __ATOMIC_RELAXED, __HIP_MEMORY_SCOPE_WORKGROUP);
            }
            __syncthreads();
            if (tid < 32) { const int hcount = hist[tid]; hbase[tid] = hcount ? (int)atomicAdd(WSP(unsigned, WS_CTL) + CW_CNT + Lyr * 2048 + 64 * tid, (unsigned)hcount) : 0; hist[tid] = 0; }
            __syncthreads();
            if (valid && lane < 16) {
                const int tok = grp * 16 + lane; const int p1 = hbase[e1] + rk1, p2 = hbase[e2] + rk2;
                WSP(int, WS_LIST)[(size_t)e1 * T + p1] = tok * 2; WSP(int, WS_LIST)[(size_t)e2 * T + p2] = tok * 2 + 1;
                WSP(float, WS_GATE)[tok * 2] = gt1; WSP(float, WS_GATE)[tok * 2 + 1] = gt2;
            }
        }
    }
    __syncthreads();
}
template <bool FINAL> __device__ __forceinline__ void f_rowadd(Frame& F) {
    bf16* xb = WSP(bf16, WS_XN); const bf16* y = WSP(bf16, WS_Y); float* rsout = WSP(float, WS_RS);
    const int lane = FLANE, w = FWAVE;
    f32x4 gf[4];
    if (FINAL) {
#pragma unroll
        for (int j = 0; j < 2; ++j) { gf[2 * j] = *(const f32x4*)(F.inp(I_FINAL) + 8 * lane + 512 * j); gf[2 * j + 1] = *(const f32x4*)(F.inp(I_FINAL) + 8 * lane + 512 * j + 4); }
    }
    for (int r0 = (F.bid * NWAVES + w) * 2; r0 < T; r0 += F.G * NWAVES * 2) {
        v4u xa[2][2], ya[2][2], yb[2][2];
#pragma unroll
        for (int rr = 0; rr < 2; ++rr)
#pragma unroll
            for (int j = 0; j < 2; ++j) { const size_t o = (size_t)(r0 + rr) * D + 8 * lane + 512 * j;
                xa[rr][j] = *(const v4u*)(xb + o); ya[rr][j] = *(const v4u*)(y + o); yb[rr][j] = *(const v4u*)(y + (size_t)T * D + o); }
#pragma unroll
        for (int rr = 0; rr < 2; ++rr) {
            float v[16]; float ss = 0.f;
#pragma unroll
            for (int j = 0; j < 2; ++j) {
                const unsigned xw[4] = {xa[rr][j].x, xa[rr][j].y, xa[rr][j].z, xa[rr][j].w}, aw[4] = {ya[rr][j].x, ya[rr][j].y, ya[rr][j].z, ya[rr][j].w}, bw[4] = {yb[rr][j].x, yb[rr][j].y, yb[rr][j].z, yb[rr][j].w};
#pragma unroll
                for (int e = 0; e < 4; ++e) { const float lo = bflo(xw[e]) + bflo(aw[e]) + bflo(bw[e]), hi = bfhi(xw[e]) + bfhi(aw[e]) + bfhi(bw[e]); v[8 * j + 2 * e] = lo; v[8 * j + 2 * e + 1] = hi; ss += lo * lo + hi * hi; }
            }
            const float rstd = __builtin_amdgcn_rsqf(wave_sum(ss) * (1.f / D) + EPS);
            const size_t ro = (size_t)(r0 + rr) * D + 8 * lane;
            if (FINAL) {
#pragma unroll
                for (int j = 0; j < 2; ++j) {
                    f32x4 o0 = {v[8 * j] * rstd, v[8 * j + 1] * rstd, v[8 * j + 2] * rstd, v[8 * j + 3] * rstd}, o1 = {v[8 * j + 4] * rstd, v[8 * j + 5] * rstd, v[8 * j + 6] * rstd, v[8 * j + 7] * rstd};
                    *(f32x4*)(F.out + ro + 512 * j) = o0 * gf[2 * j]; *(f32x4*)(F.out + ro + 512 * j + 4) = o1 * gf[2 * j + 1]; }
            } else {
#pragma unroll
                for (int j = 0; j < 2; ++j) { v4u o; o.x = pk2(v[8 * j], v[8 * j + 1]); o.y = pk2(v[8 * j + 2], v[8 * j + 3]); o.z = pk2(v[8 * j + 4], v[8 * j + 5]); o.w = pk2(v[8 * j + 6], v[8 * j + 7]); *(v4u*)(xb + ro + 512 * j) = o; }
                if (lane == 0) rsout[r0 + rr] = rstd;
            }
        }
    }
}
__device__ __forceinline__ void f_prep0(Frame& F) { f_convert_gla(F); f_rowgroup<0>(F, 0); }
__device__ __forceinline__ void f_rowpass_router(Frame& F, int L) { f_rowgroup<1>(F, L); }
__device__ __forceinline__ void f_rowpass_add(Frame& F) { f_rowadd<false>(F); }
__device__ __forceinline__ void f_final(Frame& F) { f_rowadd<true>(F); }
constexpr int LDS_BYTES = 155648;
struct Args { const float* in[23]; float* out; unsigned char* ws; int ph_lo, ph_hi; };
#define NAIVE(k) ((NAIVE_MASK >> (k)) & 1u)
#ifndef DUP_MASK
#define DUP_MASK 0u
#endif
#define DUP(k) ((DUP_MASK >> (k)) & 1u)

struct EpiN1 { bf16* o; __device__ void operator()(int r, int c, float v) const { o[(size_t)r * NQKVR + c] = (bf16)f2bf(v); } };
struct EpiN3 { const float* res; float* o; __device__ void operator()(int r, int c, float v) const { o[(size_t)r * D + c] = res[(size_t)r * D + c] + v; } };
struct EpiN8 { bf16* u; bf16* v; __device__ void operator()(int r, int c, float x) const { const float z = gelu_erf(x); if (c < SGU_HALF) u[(size_t)r * SGU_HALF + c] = (bf16)f2bf(z); else v[(size_t)r * SGU_HALF + c - SGU_HALF] = (bf16)f2bf(z); } };

__global__ void __launch_bounds__(NTHREADS, 2) fwd(Args args) {
    extern __shared__ __attribute__((aligned(16))) unsigned char lds_raw[];
    Frame F;
    F.lds = (LAS unsigned char*)lds_raw;
    F.G = gridDim.x; F.bid = blockIdx.x;
    F.out = args.out; F.ws = args.ws;
    if (FTID == 0) {
        LAS unsigned long long* pt = (LAS unsigned long long*)(F.lds + LX_PTR);
#pragma unroll
        for (int i = 0; i < 23; ++i) pt[i] = (unsigned long long)args.in[i];
    }
    __syncthreads();
    const int lo = args.ph_lo, hi = args.ph_hi;
#if ONE_LAUNCH
    cg::grid_group grid = cg::this_grid();
    volatile LAS unsigned* bst = (volatile LAS unsigned*)(F.lds + LX_PTR + 192);
    if (FTID < 2) bst[FTID] = 0u;
    __syncthreads();
    const XcdBarrier xbar = xcd_barrier_post(WSP(unsigned, WS_CTL) + CW_BAR, bst);
#define GRID_BAR() xcd_barrier(xbar)
#define GRID_BAR_CG() grid.sync()
#else
#define GRID_BAR_CG() do { } while (0)
#define GRID_BAR() do { } while (0)
#endif
#define IN(k) (lo <= (k) && (k) < hi)
#define SEAM(k) do { if (IN(k) && IN((k) + 1)) GRID_BAR(); } while (0)

    if (IN(0)) {
        if (NAIVE(0)) { n_convert_gla(F); n_rowpass<0>(F, 0); } else { f_prep0(F); if (DUP(0)) { GRID_BAR(); f_prep0(F); } }
    }
    if (IN(0) && IN(1)) GRID_BAR_CG();
    if (IN(1)) {
        if (NAIVE(1)) n_gemm(F, WSP(bf16, WS_XN), D, WSP(bf16, WS_WIN), D, T, NQKVR, D, EpiN1{WSP(bf16, WS_QKVR)}); else { f_gemm_in(F); if (DUP(1)) { GRID_BAR(); f_gemm_in(F); } }
    }
    SEAM(1);
    if (IN(2)) {
        if (NAIVE(2)) { n_scan(F); n_convert_rest(F); } else { f_scan_convert(F); if (DUP(2)) { GRID_BAR(); f_scan_convert(F, P2_PARTS); } }
    }
    SEAM(2);
    if (IN(3)) {
        if (NAIVE(3)) n_gemm(F, WSP(bf16, WS_XN), D, WSP(bf16, WS_WOUT), D, T, D, HV, EpiN3{F.inp(I_X), F.out}); else { f_gemm_out(F); if (DUP(3)) { GRID_BAR(); f_gemm_out(F); } }
    }
    SEAM(3);
#define MOE_BLOCK(L, pb) do { \
        if (IN(pb)) { if (NAIVE(pb)) n_rowpass<1>(F, L); else f_rowpass_router(F, L); } \
        SEAM(pb); \
        if (IN((pb) + 1)) { if (NAIVE((pb) + 1)) n_moe(F, L); else { f_moe1(F, L); if (DUP((pb) + 1)) { GRID_BAR(); f_moe1(F, L); } } } \
        SEAM((pb) + 1); \
        if (IN((pb) + 2)) { if (!NAIVE((pb) + 1)) { f_moe2(F, L); if (DUP((pb) + 2)) { GRID_BAR(); f_moe2(F, L); } } } \
        SEAM((pb) + 2); } while (0)
    MOE_BLOCK(0, 4);
    if (IN(7)) { if (NAIVE(7)) n_rowpass<2>(F, 0); else f_rowpass_add(F); }
    SEAM(7);
    if (IN(8)) { if (NAIVE(8)) n_gemm(F, WSP(bf16, WS_XN), D, WSP(bf16, WS_WSIN), D, T, SGU_FFN, D, EpiN8{WSP(bf16, WS_U), WSP(bf16, WS_V)}); else { f_gemm_sgu_in(F); if (DUP(8)) { GRID_BAR(); f_gemm_sgu_in(F); } } }
    if (NAIVE(8)) { SEAM(8); if (IN(9)) n_stats(F); SEAM(9); } else { if (IN(8) && IN(10)) GRID_BAR(); }
    if (IN(10)) { if (NAIVE(10)) n_mix(F); else f_mix(F); }
    SEAM(10);
    if (IN(11)) { if (NAIVE(11)) n_gemm(F, WSP(bf16, WS_U), SGU_HALF, WSP(bf16, WS_WSOUT), SGU_HALF, T, D, SGU_HALF, EpiN3{F.out, F.out}); else f_gemm_sgu_out(F); }
    SEAM(11);
    MOE_BLOCK(1, 12);
    if (IN(15)) { if (NAIVE(15)) n_rowpass<3>(F, 0); else f_final(F); }
}

extern "C" void kernel_launch(void* const* d_in, const int* in_sizes, int n_in, void* d_out, int out_size, void* d_ws, size_t ws_size, hipStream_t stream) {
    static int grid = 0;
    if (grid == 0) {
        if (n_in != 23 || out_size != T * D || ws_size < WS_END) { fprintf(stderr, "kernel_launch: unexpected shapes (n_in %d out %d ws %zu)\n", n_in, out_size, ws_size); grid = -1; return; }
        int dev = 0, cus = 0, per_cu = 0;
        hipGetDevice(&dev); hipDeviceGetAttribute(&cus, hipDeviceAttributeMultiprocessorCount, dev);
        hipFuncSetAttribute((const void*)fwd, hipFuncAttributeMaxDynamicSharedMemorySize, LDS_BYTES);
        hipOccupancyMaxActiveBlocksPerMultiprocessor(&per_cu, (const void*)fwd, NTHREADS, LDS_BYTES);
        (void)hipGetLastError();
        if (per_cu < 1) { fprintf(stderr, "kernel_launch: occupancy query says %d blocks per CU\n", per_cu); per_cu = 1; }
        grid = cus;
    }
    if (grid < 0) return;
    hipMemsetAsync((char*)d_ws + WS_CTL, 0, CTL_ZERO_BYTES, stream);
    Args a{};
    for (int i = 0; i < 23; ++i) a.in[i] = (const float*)d_in[i];
    a.out = (float*)d_out; a.ws = (unsigned char*)d_ws;
#if ONE_LAUNCH
    a.ph_lo = 0; a.ph_hi = 16;
    void* kargs[] = {&a};
    hipError_t e = hipLaunchCooperativeKernel((const void*)fwd, dim3(grid), dim3(NTHREADS), kargs, LDS_BYTES, stream);
    if (e != hipSuccess) fprintf(stderr, "cooperative launch failed: %s (grid %d)\n", hipGetErrorString(e), grid);
#else
    for (int p = 0; p < 16; ++p) {
        if (p == 9 && !NAIVE(8)) continue;
        if ((p == 6 || p == 14) && NAIVE(p - 1)) continue;
        a.ph_lo = p; a.ph_hi = p + 1;
        hipLaunchKernelGGL(fwd, dim3(grid), dim3(NTHREADS), LDS_BYTES, stream, a);
    }
#endif
}
```

```cpp
#define NAIVE_MASK 0x0u
#define ONE_LAUNCH 1
#include <hip/hip_runtime.h>
#include <hip/hip_cooperative_groups.h>
#include <cstdio>
#include <cstdint>
namespace cg = cooperative_groups;

#ifndef NAIVE_MASK
#define NAIVE_MASK 0x0u
#endif
#ifndef ONE_LAUNCH
#define ONE_LAUNCH 1
#endif

constexpr int T = 32768, D = 1024, NBATCH = 16, SEQ = 2048;
constexpr int GLA_H = 4, DK = 128, DV = 256, HK = 512, HV = 1024, RANK = 16, GLA_IN = 3088, NQKVR = 3072, CHUNK = 64, NCHUNK = 32;
constexpr int SGU_FFN = 4096, SGU_HALF = 2048, SGU_BLK = 128, SGU_GC = 512;
constexpr int NE = 32, EPG = 8, FF = 512;
constexpr float EPS = 1e-6f;
constexpr int NTHREADS = 512, NWAVES = 8;
constexpr int NPHASE = 15;

constexpr size_t MiB = 1u << 20;
constexpr size_t WS_CTL = 0, CTL_ZERO_BYTES = 64 * 1024;
constexpr size_t WS_GLR = 1 * MiB;
constexpr size_t WS_GATE = 3 * MiB;
constexpr size_t WS_EID = 3 * MiB + 512 * 1024;
constexpr size_t WS_STATS = 4 * MiB;
constexpr size_t WS_LIST = 12 * MiB;
constexpr size_t WS_WIN = 16 * MiB;
constexpr size_t WS_WOUT = 22 * MiB;
constexpr size_t WS_WSIN = 24 * MiB;
constexpr size_t WS_WSOUT = 32 * MiB;
constexpr size_t WS_W13 = 36 * MiB;
constexpr size_t WS_W2 = 164 * MiB;
constexpr size_t WS_XN = 228 * MiB;
constexpr size_t WS_AOUT = 484 * MiB;
constexpr size_t WS_RS = 3 * MiB + 256 * 1024;
constexpr size_t WS_QKVR = 292 * MiB;
constexpr size_t WS_HID = 292 * MiB;
constexpr size_t WS_Y = 364 * MiB;
constexpr size_t WS_U = 292 * MiB;
constexpr size_t WS_V = 420 * MiB;
constexpr size_t WS_END = 548 * MiB;
constexpr int CW_BAR = 1024;
constexpr int CW_CNT = 8192;

#define GAS __attribute__((address_space(1)))
#define LAS __attribute__((address_space(3)))
typedef unsigned short bf16;
typedef unsigned v4u __attribute__((ext_vector_type(4)));
typedef unsigned v2u __attribute__((ext_vector_type(2)));
typedef float f32x4 __attribute__((ext_vector_type(4)));
typedef float f32x16 __attribute__((ext_vector_type(16)));
typedef short bf16x8 __attribute__((ext_vector_type(8)));
typedef short s16x4 __attribute__((ext_vector_type(4)));
#define LDS_WAIT() asm volatile("s_waitcnt lgkmcnt(0)" ::: "memory")
#define VM_WAIT() asm volatile("s_waitcnt vmcnt(0)" ::: "memory")
typedef float f32x2_t __attribute__((ext_vector_type(2))); typedef __bf16 bf16x2_t __attribute__((ext_vector_type(2)));
__device__ __forceinline__ unsigned pk2(float lo, float hi) { f32x2_t v = {lo, hi}; bf16x2_t b = __builtin_convertvector(v, bf16x2_t); return __builtin_bit_cast(unsigned, b); }
__device__ __forceinline__ unsigned f2bf(float f) { return pk2(f, 0.f) & 0xffffu; }
__device__ __forceinline__ float bf2f(unsigned short b) { return __builtin_bit_cast(float, (unsigned)b << 16); }
__device__ __forceinline__ float bflo(unsigned w) { return __builtin_bit_cast(float, w << 16); }
__device__ __forceinline__ float bfhi(unsigned w) { return __builtin_bit_cast(float, w & 0xffff0000u); }
__device__ __forceinline__ float wave_sum(float v) {
#pragma unroll
    for (int o = 1; o < 64; o <<= 1) v += __shfl_xor(v, o);
    return v;
}
__device__ __forceinline__ float silu_f(float x) { return x * __builtin_amdgcn_rcpf(1.f + __expf(-x)); }
__device__ __forceinline__ float gelu_erf(float x) { return 0.5f * x * (1.f + erff(x * 0.70710678118654752f)); }
__device__ __forceinline__ float logsigmoid_f(float x) { return fminf(x, 0.f) - log1pf(__expf(-fabsf(x))); }
namespace pg8 {
#define PG8_LAS __attribute__((address_space(3)))
typedef unsigned short bf16_t;
typedef short bf16x8 __attribute__((ext_vector_type(8)));
typedef float f32x4 __attribute__((ext_vector_type(4)));
typedef unsigned u32x4 __attribute__((ext_vector_type(4)));
constexpr int BM = 256, BK = 64, HALF = 128, HTB = HALF * BK * 2  , STAGE_BYTES = 8 * HTB, NXCD = 8, WGM = 8;

__host__ __device__ __forceinline__ int lds_byte(int r, int c) { const int st = (r >> 4) * 2 + (c >> 5), rr = r & 15, cc = c & 31, ob = rr * 64 + cc * 2; return st * 1024 + (ob ^ (((ob >> 9) & 1) << 5)); }
__host__ __device__ __forceinline__ void stage_rc(int b, int& R, int& C) { const int st = b / 1024, sb = b % 1024, swz = sb ^ (((sb >> 9) & 1) << 5); R = (st >> 1) * 16 + swz / 64; C = (st & 1) * 32 + (swz % 64) / 2; }
__host__ __device__ __forceinline__ int perm32(int rho) { const int n = rho >> 4, i = rho & 15; return 8 * (i >> 2) + 4 * n + (i & 3); }

struct Unit { int pm, pn, e, slot; };

struct DenseOrder {
    static constexpr bool GATHER = false;
    int nM, nN, nwg, G, c, K; const char* Bt;
    __device__ void init(int M, int N, int K_, const bf16_t* Bt_, int G_, int c_) { nM = M / BM; nN = N / BM; nwg = nM * nN; G = G_; c = c_; K = K_; Bt = (const char*)Bt_; }
    __device__ __forceinline__ bool next(int i, Unit& u) const {
        const long L = (long)i * G + c; if (L >= nwg) return false;
        int wgid = (int)L; { const int q = nwg / NXCD, r = nwg % NXCD, xcd = wgid % NXCD, off = wgid / NXCD; wgid = (xcd < r ? xcd * (q + 1) : r * (q + 1) + (xcd - r) * q) + off; }
        const int nig = WGM * nN, gid = wgid / nig, fm = gid * WGM, gsz = (nM - fm) < WGM ? (nM - fm) : WGM;
        u.pm = fm + ((wgid % nig) % gsz); u.pn = (wgid % nig) / gsz; u.e = 0; u.slot = 0; return true;
    }
    __device__ __forceinline__ const char* bptr(const Unit& u) const { return Bt + (size_t)u.pn * BM * K * 2; }
    __device__ __forceinline__ size_t abase(const Unit& u) const { return (size_t)u.pm * BM * K * 2; }
    __device__ __forceinline__ unsigned aoff(const Unit& u, int h, int R, int C) const { return (unsigned)(((u.pm * BM + h * HALF + R) * K + C) * 2); }
    __device__ __forceinline__ void a_ready(const Unit&) const {}
    __device__ __forceinline__ void done(const Unit&) const {}
};

__device__ __forceinline__ unsigned cvt_pk_bf16(float lo, float hi) { unsigned r; asm volatile("v_cvt_pk_bf16_f32 %0, %1, %2" : "=v"(r) : "v"(lo), "v"(hi)); return r; }
typedef float f32x2 __attribute__((ext_vector_type(2)));
__device__ __forceinline__ f32x2 gelu_pk(f32x2 v) {
    const f32x2 av = __builtin_elementwise_abs(v), d = av * 0.2316418882f + 1.0f;
    f32x2 t; t.x = __builtin_amdgcn_rcpf(d.x); t.y = __builtin_amdgcn_rcpf(d.y);
    f32x2 q = t * 0.5307027145f + (-0.7265760135f); q = q * t + 0.7107068705f; q = q * t + (-0.142248368f); q = q * t + 0.127414796f; q = q * t;
    const f32x2 s = (v * v) * (-0.72134752044f);
    f32x2 e; e.x = __builtin_amdgcn_exp2f(s.x); e.y = __builtin_amdgcn_exp2f(s.y);
    const f32x2 m = v * (q * e), r = v - m;
    f32x2 o; o.x = v.x < 0.f ? m.x : r.x; o.y = v.y < 0.f ? m.y : r.y; return o;
}

template <class Epi, class Sched>
__device__ __forceinline__ void gemm_phase(PG8_LAS unsigned char* lds, const bf16_t* Abase, const int K, const Sched& S, const Epi& E) {
    const int tid = threadIdx.x, wid = __builtin_amdgcn_readfirstlane(tid >> 6), lane = tid & 63, wr = wid >> 2, wc = wid & 3, fr = lane & 15, fq = lane >> 4;
    const int nt = K / BK;
    int sR[2], sC[2]; unsigned voffA[2], voffB[2];
#pragma unroll
    for (int i = 0; i < 2; ++i) { stage_rc(tid * 16 + i * 8192, sR[i], sC[i]); const int Rb = Epi::PERM ? ((sR[i] & ~31) + perm32(sR[i] & 31)) : sR[i];
        voffA[i] = (unsigned)(sR[i] * K + sC[i]) * 2u; voffB[i] = (unsigned)(Rb * K + sC[i]) * 2u; }
    const size_t kstep = (size_t)(BK * 2);
    const size_t hstep = (size_t)HALF * K * 2;
    const unsigned ldsw = (unsigned)wid * 1024u;
    const int aoff = lds_byte(wr * 64 + fr, fq * 8), boff = lds_byte(wc * 32 + fr, fq * 8);
    const char* const Ab = (const char*)Abase;
#define PG8_SA(b, h) (((b) * 2 + (h)) * HTB)
#define PG8_SB(b, h) ((4 + (b) * 2 + (h)) * HTB)
#define PG8_STAGE(bufoff, gbase, voff) do { _Pragma("unroll") for (int _i = 0; _i < 2; ++_i) \
        __builtin_amdgcn_global_load_lds((const unsigned*)((const char*)(gbase) + (voff)[_i]), (PG8_LAS unsigned*)(lds + (bufoff) + ldsw + _i * 8192), 16, 0, 0); } while (0)
#define PG8_STAGE_A(bufoff, nx, h, kt) do { if constexpr (Sched::GATHER) { PG8_STAGE(bufoff, Ab + (size_t)(kt) * kstep, gc[h]); } \
        else PG8_STAGE(bufoff, ((nx) ? xA : cA) + (size_t)(h) * hstep + (size_t)(kt) * kstep, voffA); } while (0)
#define PG8_LDA(dst, b, h) do { _Pragma("unroll") for (int m = 0; m < 4; ++m) _Pragma("unroll") for (int k = 0; k < 2; ++k) dst[m][k] = *(const PG8_LAS bf16x8*)(lds + PG8_SA(b, h) + aoff + m * 2048 + k * 1024); } while (0)
#define PG8_LDB(dst, b, h) do { _Pragma("unroll") for (int n = 0; n < 2; ++n) _Pragma("unroll") for (int k = 0; k < 2; ++k) dst[n][k] = *(const PG8_LAS bf16x8*)(lds + PG8_SB(b, h) + boff + n * 2048 + k * 1024); } while (0)
#define PG8_MMA(ai, bj, At, Bt) do { __builtin_amdgcn_s_setprio(1); _Pragma("unroll") for (int m = 0; m < 4; ++m) _Pragma("unroll") for (int n = 0; n < 2; ++n) _Pragma("unroll") for (int k = 0; k < 2; ++k) \
        acc[ai][bj][m][n] = __builtin_amdgcn_mfma_f32_16x16x32_bf16(Bt[n][k], At[m][k], acc[ai][bj][m][n], 0, 0, 0); __builtin_amdgcn_s_setprio(0); } while (0)
#define PG8_WAIT_V(n) asm volatile("s_waitcnt vmcnt(" #n ")" ::: "memory")
#define PG8_WAIT_L(n) asm volatile("s_waitcnt lgkmcnt(" #n ")" ::: "memory")
#define PG8_BAR __builtin_amdgcn_s_barrier()
#define PG8_SCHED __builtin_amdgcn_sched_barrier(0)
    Unit cur, nxt; int ui = 0;
    if (!S.next(0, cur)) return;
    f32x4 acc[2][2][4][2];
#pragma unroll
    for (int a = 0; a < 2; ++a)
#pragma unroll
        for (int b = 0; b < 2; ++b)
#pragma unroll
            for (int m = 0; m < 4; ++m)
#pragma unroll
                for (int n = 0; n < 2; ++n) acc[a][b][m][n] = (f32x4){0.f, 0.f, 0.f, 0.f};
    bf16x8 At[4][2], B0[2][2], B1[2][2];
    unsigned gc[2][2];
    const char* cA = Ab; const char* xA = Ab;
    if constexpr (Sched::GATHER) {
#pragma unroll
        for (int h = 0; h < 2; ++h)
#pragma unroll
            for (int i = 0; i < 2; ++i) gc[h][i] = S.aoff(cur, h, sR[i], sC[i]);
    } else { cA = Ab + S.abase(cur); xA = cA; }
    const char* cB = S.bptr(cur);
    S.a_ready(cur);
    if constexpr (Epi::RS_DMA) { if (wid == 0) __builtin_amdgcn_global_load_lds((const unsigned*)((const char*)E.rs + (size_t)cur.pm * 1024 + lane * 16), (PG8_LAS unsigned*)(lds + STAGE_BYTES + 512), 16, 0, 0); }
    PG8_STAGE(PG8_SB(0, 0), cB, voffB); PG8_STAGE(PG8_SB(0, 1), cB + hstep, voffB); PG8_STAGE_A(PG8_SA(0, 0), false, 0, 0); PG8_STAGE_A(PG8_SA(0, 1), false, 1, 0);
    if (wr == 1) PG8_BAR;
    PG8_WAIT_V(2); PG8_BAR;
    PG8_STAGE(PG8_SB(1, 0), cB + kstep, voffB); PG8_STAGE_A(PG8_SA(1, 0), false, 0, 1); PG8_STAGE(PG8_SB(1, 1), cB + hstep + kstep, voffB);
    PG8_WAIT_V(6); PG8_BAR;
    for (;;) {
        const bool has_next = S.next(ui + 1, nxt);
        const char* nB = has_next ? S.bptr(nxt) : cB;
        if constexpr (Epi::RS_DMA) { if (has_next && wid == 0) __builtin_amdgcn_global_load_lds((const unsigned*)((const char*)E.rs + (size_t)nxt.pm * 1024 + lane * 16), (PG8_LAS unsigned*)(lds + STAGE_BYTES + 512 + ((ui + 1) % 3) * 1024), 16, 0, 0); }
        for (int t = 0; t < nt; t += 2) {
            const bool last = (t == nt - 2);
            const int kt2 = last ? 0 : t + 2;
            const char* b2 = last ? nB : cB + (size_t)(t + 2) * kstep; const char* b3 = b2 + kstep;
            if (last && has_next) {
                if constexpr (!Sched::GATHER) xA = Ab + S.abase(nxt);
                S.a_ready(nxt);
            }
            PG8_LDB(B0, 0, 0); PG8_LDB(B1, 0, 1); PG8_SCHED; PG8_LDA(At, 0, 0); PG8_STAGE_A(PG8_SA(1, 1), false, 1, t + 1);
            if constexpr (Sched::GATHER) { if (last && has_next) {
#pragma unroll
                for (int h = 0; h < 2; ++h)
#pragma unroll
                    for (int i = 0; i < 2; ++i) gc[h][i] = S.aoff(nxt, h, sR[i], sC[i]); } }
            PG8_WAIT_V(8); PG8_WAIT_L(0); PG8_BAR; PG8_MMA(0, 0, At, B0); PG8_MMA(0, 1, At, B1); PG8_BAR; PG8_SCHED;
            PG8_LDA(At, 0, 1); PG8_STAGE(PG8_SB(0, 0), b2, voffB); PG8_STAGE(PG8_SB(0, 1), b2 + hstep, voffB); PG8_STAGE_A(PG8_SA(0, 0), last, 0, kt2);
            PG8_WAIT_V(8); PG8_WAIT_L(0); PG8_BAR; PG8_MMA(1, 0, At, B0); PG8_MMA(1, 1, At, B1); PG8_BAR; PG8_SCHED;
            PG8_LDB(B0, 1, 0); PG8_LDB(B1, 1, 1); PG8_SCHED; PG8_LDA(At, 1, 0); PG8_STAGE_A(PG8_SA(0, 1), last, 1, kt2);
            PG8_WAIT_V(8); PG8_WAIT_L(0); PG8_BAR; PG8_MMA(0, 0, At, B0); PG8_MMA(0, 1, At, B1); PG8_BAR; PG8_SCHED;
            PG8_LDA(At, 1, 1); PG8_STAGE(PG8_SB(1, 0), b3, voffB); PG8_STAGE(PG8_SB(1, 1), b3 + hstep, voffB); PG8_STAGE_A(PG8_SA(1, 0), last, 0, kt2 + 1);
            PG8_WAIT_V(8); PG8_WAIT_L(0); PG8_BAR; PG8_MMA(1, 0, At, B0); PG8_MMA(1, 1, At, B1); PG8_BAR; PG8_SCHED;
        }
        if (wr == 0) PG8_BAR;
        E(acc, cur, wr, wc, fr, fq, (const PG8_LAS float*)(lds + STAGE_BYTES + 512 + (ui % 3) * 1024)); S.done(cur);
        if (!has_next) break;
#pragma unroll
        for (int a = 0; a < 2; ++a)
#pragma unroll
            for (int b = 0; b < 2; ++b)
#pragma unroll
                for (int m = 0; m < 4; ++m)
#pragma unroll
                    for (int n = 0; n < 2; ++n) acc[a][b][m][n] = (f32x4){0.f, 0.f, 0.f, 0.f};
        cur = nxt; cB = nB; ++ui;
        if constexpr (!Sched::GATHER) cA = xA;
        if (wr == 1) PG8_BAR;
    }
    PG8_WAIT_V(0);
    PG8_BAR;
#undef PG8_STAGE_A
#undef PG8_SA
#undef PG8_SB
#undef PG8_STAGE
#undef PG8_LDA
#undef PG8_LDB
#undef PG8_MMA
#undef PG8_WAIT_V
#undef PG8_WAIT_L
#undef PG8_BAR
#undef PG8_SCHED
}
}
constexpr int LX_PTR = 155648 - 256;
#define FTID ((int)threadIdx.x)
#define FLANE ((int)threadIdx.x & 63)
#define FWAVE ((int)__builtin_amdgcn_readfirstlane((int)threadIdx.x >> 6))
struct Frame {
    LAS unsigned char* lds;
    int G, bid;
    float* out; unsigned char* ws;
    __device__ __forceinline__ const float* inp(int i) const {
        const LAS unsigned* p = (const LAS unsigned*)(lds + LX_PTR) + 2 * i;
        const unsigned lo = __builtin_amdgcn_readfirstlane(p[0]), hi = __builtin_amdgcn_readfirstlane(p[1]);
        return (const float*)(((unsigned long long)hi << 32) | lo);
    }
};
enum { I_X = 0, I_GLA_NORM, I_GLA_WIN, I_GLA_WGU, I_GLA_BG, I_GLA_HG, I_GLA_WOUT, I_SGU_NORM, I_SGU_WIN, I_SGU_LNG, I_SGU_LNB, I_SGU_WS, I_SGU_BS, I_SGU_WOUT,
       I_MOE_NORM, I_MOE_WG, I_MOE_BG, I_MOE_WSUB, I_MOE_BSUB, I_MOE_W1, I_MOE_W3, I_MOE_W2, I_FINAL };
#define WSP(type, off) ((type*)(F.ws + (off)))

__device__ __forceinline__ void n_convert(Frame& F, const float* W, int ldw, int K, int N, const float* kscale, int qcols, float qs, bf16* WT, int rowmap) {
    const size_t total = (size_t)N * K, stride = (size_t)F.G * NTHREADS;
    for (size_t idx = (size_t)F.bid * NTHREADS + FTID; idx < total; idx += stride) {
        const int n = (int)(idx / K), k = (int)(idx % K);
        float v = W[(size_t)k * ldw + n]; if (kscale) v *= kscale[k]; if (n < qcols) v *= qs;
        const int dr = rowmap == 0 ? n : ((n >> 7) * 256 + (n & 127) + (rowmap == 2 ? 128 : 0));
        WT[(size_t)dr * K + k] = (bf16)f2bf(v);
    }
}
__device__ __forceinline__ void n_convert_gla(Frame& F) {
    n_convert(F, F.inp(I_GLA_WIN), GLA_IN, D, NQKVR, F.inp(I_GLA_NORM), HK, 0.08838834764831845f, WSP(bf16, WS_WIN), 0);
    n_convert(F, F.inp(I_GLA_WOUT), D, HV, D, F.inp(I_GLA_HG), 0, 1.f, WSP(bf16, WS_WOUT), 0);
}
__device__ __forceinline__ void n_convert_rest(Frame& F) {
    n_convert(F, F.inp(I_SGU_WIN), SGU_FFN, D, SGU_FFN, F.inp(I_SGU_NORM), 0, 1.f, WSP(bf16, WS_WSIN), 0);
    n_convert(F, F.inp(I_SGU_WOUT), D, SGU_HALF, D, nullptr, 0, 1.f, WSP(bf16, WS_WSOUT), 0);
    for (int le = 0; le < 2 * NE; ++le) {
        const int L = le / NE;
        n_convert(F, F.inp(I_MOE_W1) + (size_t)le * D * FF, FF, D, FF, F.inp(I_MOE_NORM) + L * D, 0, 1.f, WSP(bf16, WS_W13) + (size_t)le * 1024 * 1024, 1);
        n_convert(F, F.inp(I_MOE_W3) + (size_t)le * D * FF, FF, D, FF, F.inp(I_MOE_NORM) + L * D, 0, 1.f, WSP(bf16, WS_W13) + (size_t)le * 1024 * 1024, 2);
        n_convert(F, F.inp(I_MOE_W2) + (size_t)le * FF * D, D, FF, D, nullptr, 0, 1.f, WSP(bf16, WS_W2) + (size_t)le * 1024 * 512, 0);
    }
}

template <int MODE> __device__ __forceinline__ void n_rowpass(Frame& F, int L) {
    const float* src = MODE == 0 ? F.inp(I_X) : F.out;
    bf16* xn = WSP(bf16, WS_XN);
    const bf16* y = WSP(bf16, WS_Y);
    unsigned* ctl = WSP(unsigned, WS_CTL);
    for (int row = F.bid * NWAVES + FWAVE; row < T; row += F.G * NWAVES) {
        f32x4 v[4]; float ss = 0.f;
#pragma unroll
        for (int j = 0; j < 4; ++j) {
            const int k = 4 * FLANE + 256 * j;
            v[j] = *(const f32x4*)(src + (size_t)row * D + k);
            if (MODE >= 2) {
                const v2u a = *(const v2u*)(y + (size_t)row * D + k), b = *(const v2u*)(y + ((size_t)T + row) * D + k);
                v[j].x += bflo(a.x) + bflo(b.x); v[j].y += bfhi(a.x) + bfhi(b.x); v[j].z += bflo(a.y) + bflo(b.y); v[j].w += bfhi(a.y) + bfhi(b.y);
            }
            ss += v[j].x * v[j].x + v[j].y * v[j].y + v[j].z * v[j].z + v[j].w * v[j].w;
        }
        const float rstd = 1.f / sqrtf(wave_sum(ss) * (1.f / D) + EPS);
        if (MODE == 0) {
            const float* gn = F.inp(I_GLA_NORM); const float* w = F.inp(I_GLA_WIN);
            for (int c = 0; c < RANK; ++c) {
                float p = 0.f;
#pragma unroll
                for (int j = 0; j < 4; ++j) { const int k = 4 * FLANE + 256 * j;
                    p += v[j].x * gn[k] * w[(size_t)k * GLA_IN + NQKVR + c] + v[j].y * gn[k + 1] * w[(size_t)(k + 1) * GLA_IN + NQKVR + c]
                       + v[j].z * gn[k + 2] * w[(size_t)(k + 2) * GLA_IN + NQKVR + c] + v[j].w * gn[k + 3] * w[(size_t)(k + 3) * GLA_IN + NQKVR + c]; }
                p = wave_sum(p) * rstd;
                if (FLANE == 0) WSP(float, WS_GLR)[(size_t)row * RANK + c] = p;
            }
        }
        if (MODE == 1) {
            const float* gn = F.inp(I_MOE_NORM) + L * D; const float* wg = F.inp(I_MOE_WG) + (size_t)L * D * 4; const float* wsb = F.inp(I_MOE_WSUB) + (size_t)L * 4 * D * EPG;
            float lg[4], ls[EPG];
            for (int c = 0; c < 4; ++c) { float p = 0.f;
#pragma unroll
                for (int j = 0; j < 4; ++j) { const int k = 4 * FLANE + 256 * j;
                    p += v[j].x * gn[k] * wg[(k) * 4 + c] + v[j].y * gn[k + 1] * wg[(k + 1) * 4 + c] + v[j].z * gn[k + 2] * wg[(k + 2) * 4 + c] + v[j].w * gn[k + 3] * wg[(k + 3) * 4 + c]; }
                lg[c] = wave_sum(p) * rstd + F.inp(I_MOE_BG)[L * 4 + c]; }
            int g = 0; float gm = lg[0];
            for (int c = 1; c < 4; ++c) if (lg[c] > gm) { gm = lg[c]; g = c; }
            float gs = 0.f; for (int c = 0; c < 4; ++c) gs += __expf(lg[c] - gm);
            const float g_w = 1.f / gs;
            for (int e = 0; e < EPG; ++e) { float p = 0.f;
#pragma unroll
                for (int j = 0; j < 4; ++j) { const int k = 4 * FLANE + 256 * j; const float* ww = wsb + ((size_t)g * D + k) * EPG + e;
                    p += v[j].x * gn[k] * ww[0] + v[j].y * gn[k + 1] * ww[EPG] + v[j].z * gn[k + 2] * ww[2 * EPG] + v[j].w * gn[k + 3] * ww[3 * EPG]; }
                ls[e] = wave_sum(p) * rstd + F.inp(I_MOE_BSUB)[(L * 4 + g) * EPG + e]; }
            int i1 = 0; float m1 = ls[0];
            for (int e = 1; e < EPG; ++e) if (ls[e] > m1) { m1 = ls[e]; i1 = e; }
            int i2 = -1; float m2 = -3.0e38f;
            for (int e = 0; e < EPG; ++e) if (e != i1 && ls[e] > m2) { m2 = ls[e]; i2 = e; }
            const float w1 = 1.f / (1.f + __expf(m2 - m1)), w2 = 1.f - w1;
            if (FLANE == 0) {
                const int e1 = g * EPG + i1, e2 = g * EPG + i2;
                WSP(int, WS_EID)[row * 2] = e1; WSP(int, WS_EID)[row * 2 + 1] = e2;
                WSP(float, WS_GATE)[row * 2] = g_w * w1; WSP(float, WS_GATE)[row * 2 + 1] = g_w * w2;
                const unsigned p1 = atomicAdd(&ctl[CW_CNT + L * 2048 + 64 * e1], 1u), p2 = atomicAdd(&ctl[CW_CNT + L * 2048 + 64 * e2], 1u);
                WSP(int, WS_LIST)[(size_t)e1 * T + p1] = row * 2; WSP(int, WS_LIST)[(size_t)e2 * T + p2] = row * 2 + 1;
            }
        }
#pragma unroll
        for (int j = 0; j < 4; ++j) {
            const int k = 4 * FLANE + 256 * j;
            if (MODE == 2) *(f32x4*)(F.out + (size_t)row * D + k) = v[j];
            if (MODE == 3) { const f32x4 g = *(const f32x4*)(F.inp(I_FINAL) + k); *(f32x4*)(F.out + (size_t)row * D + k) = v[j] * rstd * g; }
            else { v2u o; o.x = pk2(v[j].x * rstd, v[j].y * rstd); o.y = pk2(v[j].z * rstd, v[j].w * rstd); *(v2u*)(xn + (size_t)row * D + k) = o; }
        }
    }
}

template <class Fn> __device__ __forceinline__ void n_gemm(Frame& F, const bf16* A, int lda, const bf16* Bt, int ldb, int M, int N, int K, Fn f) {
    LAS float* As = (LAS float*)F.lds; LAS float* Bs = As + 64 * 33;
    const int ntn = N / 64, ntiles = (M / 64) * ntn, ty = FTID >> 4, tx = FTID & 15, lr = FTID >> 3, lc = (FTID & 7) * 4;
    for (int tile = F.bid; tile < ntiles; tile += F.G) {
        const int tm = tile / ntn, tn = tile % ntn;
        float acc[2][4] = {};
        for (int k0 = 0; k0 < K; k0 += 32) {
            const v2u a = *(const v2u*)(A + (size_t)(tm * 64 + lr) * lda + k0 + lc), b = *(const v2u*)(Bt + (size_t)(tn * 64 + lr) * ldb + k0 + lc);
            As[lr * 33 + lc] = bflo(a.x); As[lr * 33 + lc + 1] = bfhi(a.x); As[lr * 33 + lc + 2] = bflo(a.y); As[lr * 33 + lc + 3] = bfhi(a.y);
            Bs[lr * 33 + lc] = bflo(b.x); Bs[lr * 33 + lc + 1] = bfhi(b.x); Bs[lr * 33 + lc + 2] = bflo(b.y); Bs[lr * 33 + lc + 3] = bfhi(b.y);
            __syncthreads();
#pragma unroll 8
            for (int kk = 0; kk < 32; ++kk) {
                const float a0 = As[(2 * ty) * 33 + kk], a1 = As[(2 * ty + 1) * 33 + kk];
#pragma unroll
                for (int i = 0; i < 4; ++i) { const float bb = Bs[(4 * tx + i) * 33 + kk]; acc[0][i] += a0 * bb; acc[1][i] += a1 * bb; }
            }
            __syncthreads();
        }
#pragma unroll
        for (int r = 0; r < 2; ++r)
#pragma unroll
            for (int i = 0; i < 4; ++i) f(tm * 64 + 2 * ty + r, tn * 64 + 4 * tx + i, acc[r][i]);
    }
}

__device__ __forceinline__ void n_scan(Frame& F) {
    LAS float* gl = (LAS float*)F.lds;
    LAS float* kd = gl + 64 * 16;
    LAS float* qs = kd + 64 * 128;
    LAS float* os = qs + 64 * 128;
    LAS float* part = os + 64 * 256;
    LAS float* dec = part + 4 * 128;
    const bf16* qkvr = WSP(bf16, WS_QKVR); const float* glr = WSP(float, WS_GLR); bf16* aout = WSP(bf16, WS_XN);
    for (int item = F.bid; item < NBATCH * GLA_H; item += F.G) {
        const int b = item / GLA_H, h = item % GLA_H;
        float S[64];
#pragma unroll
        for (int i = 0; i < 64; ++i) S[i] = 0.f;
        const int dk = FTID & 127, tg = FTID >> 7, j = FTID & 255, hf = FTID >> 8;
        for (int c = 0; c < NCHUNK; ++c) {
            const size_t t0 = (size_t)b * SEQ + c * CHUNK;
            for (int i = FTID; i < 64 * 16; i += NTHREADS) gl[i] = glr[t0 * RANK + i];
            __syncthreads();
            float wgu[RANK];
#pragma unroll
            for (int r = 0; r < RANK; ++r) wgu[r] = F.inp(I_GLA_WGU)[r * HK + h * DK + dk];
            const float bgv = F.inp(I_GLA_BG)[h * DK + dk];
            float run = 0.f;
            for (int jj = 0; jj < 16; ++jj) {
                const int tok = tg * 16 + jj; float a = bgv;
#pragma unroll
                for (int r = 0; r < RANK; ++r) a += gl[tok * 16 + r] * wgu[r];
                run += logsigmoid_f(a) * (1.f / 16.f);
            }
            part[tg * 128 + dk] = run;
            __syncthreads();
            float off = 0.f, tot = 0.f;
#pragma unroll
            for (int g = 0; g < 4; ++g) { const float pv = part[g * 128 + dk]; if (g < tg) off += pv; tot += pv; }
            run = off;
            for (int jj = 0; jj < 16; ++jj) {
                const int tok = tg * 16 + jj; float a = bgv;
#pragma unroll
                for (int r = 0; r < RANK; ++r) a += gl[tok * 16 + r] * wgu[r];
                run += logsigmoid_f(a) * (1.f / 16.f);
                const float kv = bf2f(qkvr[(t0 + tok) * NQKVR + HK + h * DK + dk]);
                kd[tok * 128 + dk] = kv * __expf(tot - run);
                qs[tok * 128 + dk] = bf2f(qkvr[(t0 + tok) * NQKVR + h * DK + dk]);
            }
            if (tg == 0) dec[dk] = __expf(tot);
            __syncthreads();
#pragma unroll
            for (int ib = 0; ib < 4; ++ib) {
#pragma unroll
                for (int i = 0; i < 16; ++i) S[ib * 16 + i] *= dec[64 * hf + ib * 16 + i];
                asm volatile("" ::: "memory"); }
            for (int s = 0; s < CHUNK; ++s) {
                const float vv = bf2f(qkvr[(t0 + s) * NQKVR + 2 * HK + h * DV + j]);
#pragma unroll
                for (int ib = 0; ib < 4; ++ib) {
#pragma unroll
                    for (int i = 0; i < 16; ++i) S[ib * 16 + i] += kd[s * 128 + 64 * hf + ib * 16 + i] * vv;
                    asm volatile("" ::: "memory"); }
            }
            for (int ph = 0; ph < 2; ++ph) {
                if (hf == ph) {
                    for (int t = 0; t < CHUNK; ++t) {
                        float o = 0.f;
#pragma unroll
                        for (int ib = 0; ib < 4; ++ib) {
#pragma unroll
                            for (int i = 0; i < 16; ++i) o += qs[t * 128 + 64 * hf + ib * 16 + i] * S[ib * 16 + i];
                            asm volatile("" ::: "memory"); }
                        if (ph == 0) os[t * 256 + j] = o; else os[t * 256 + j] += o;
                    }
                }
                __syncthreads();
            }
            {
                const int tok = FTID >> 3, cc = FTID & 7; float ss = 0.f;
                for (int jj = 0; jj < 32; ++jj) { const float o = os[tok * 256 + cc * 32 + jj]; ss += o * o; }
                ss += __shfl_xor(ss, 1); ss += __shfl_xor(ss, 2); ss += __shfl_xor(ss, 4);
                const float rms = 1.f / sqrtf(ss * (1.f / DV) + EPS);
                for (int jj = 0; jj < 32; ++jj) {
                    const int col = h * DV + cc * 32 + jj;
                    const float rr = bf2f(qkvr[(t0 + tok) * NQKVR + 2 * HK + HV + col]);
                    aout[(t0 + tok) * D + col] = (bf16)f2bf(os[tok * 256 + cc * 32 + jj] * rms * silu_f(rr));
                }
            }
            __syncthreads();
        }
    }
}

__device__ __forceinline__ void n_moe(Frame& F, int L) {
    LAS float* xs = (LAS float*)F.lds; LAS float* hl = xs + D;
    const bf16* xn = WSP(bf16, WS_XN); bf16* y = WSP(bf16, WS_Y);
    const bf16* W13 = WSP(bf16, WS_W13) + (size_t)L * NE * 1024 * 1024; const bf16* W2 = WSP(bf16, WS_W2) + (size_t)L * NE * 1024 * 512;
    for (int a = F.bid; a < 2 * T; a += F.G) {
        const int tok = a >> 1, k = a & 1, e = WSP(int, WS_EID)[a]; const float gate = WSP(float, WS_GATE)[a];
        for (int i = FTID; i < D; i += NTHREADS) xs[i] = bf2f(xn[(size_t)tok * D + i]);
        __syncthreads();
        for (int jj = 0; jj < 64; ++jj) {
            const int j = FWAVE * 64 + jj; const bf16* r1 = W13 + ((size_t)e * 1024 + (j >> 7) * 256 + (j & 127)) * 1024; const bf16* r3 = r1 + 128 * 1024;
            float d1 = 0.f, d3 = 0.f;
#pragma unroll
            for (int i = 0; i < 2; ++i) { const int kk = FLANE * 8 + 512 * i; const v4u a1 = *(const v4u*)(r1 + kk), a3 = *(const v4u*)(r3 + kk);
                d1 += xs[kk] * bflo(a1.x) + xs[kk + 1] * bfhi(a1.x) + xs[kk + 2] * bflo(a1.y) + xs[kk + 3] * bfhi(a1.y) + xs[kk + 4] * bflo(a1.z) + xs[kk + 5] * bfhi(a1.z) + xs[kk + 6] * bflo(a1.w) + xs[kk + 7] * bfhi(a1.w);
                d3 += xs[kk] * bflo(a3.x) + xs[kk + 1] * bfhi(a3.x) + xs[kk + 2] * bflo(a3.y) + xs[kk + 3] * bfhi(a3.y) + xs[kk + 4] * bflo(a3.z) + xs[kk + 5] * bfhi(a3.z) + xs[kk + 6] * bflo(a3.w) + xs[kk + 7] * bfhi(a3.w); }
            d1 = wave_sum(d1); d3 = wave_sum(d3);
            if (FLANE == 0) hl[j] = bf2f((bf16)f2bf(silu_f(d1) * d3));
        }
        __syncthreads();
        for (int cc = 0; cc < 128; ++cc) {
            const int c = FWAVE * 128 + cc; const bf16* r2 = W2 + ((size_t)e * 1024 + c) * 512; const int kk = FLANE * 8; const v4u a2 = *(const v4u*)(r2 + kk);
            float d = hl[kk] * bflo(a2.x) + hl[kk + 1] * bfhi(a2.x) + hl[kk + 2] * bflo(a2.y) + hl[kk + 3] * bfhi(a2.y) + hl[kk + 4] * bflo(a2.z) + hl[kk + 5] * bfhi(a2.z) + hl[kk + 6] * bflo(a2.w) + hl[kk + 7] * bfhi(a2.w);
            d = wave_sum(d);
            if (FLANE == 0) y[((size_t)k * T + tok) * D + c] = (bf16)f2bf(gate * d);
        }
        __syncthreads();
    }
}

__device__ __forceinline__ void n_stats(Frame& F) {
    const bf16* v = WSP(bf16, WS_V); float* st = WSP(float, WS_STATS);
    for (size_t it = (size_t)F.bid * NTHREADS + FTID; it < (size_t)T * 32; it += (size_t)F.G * NTHREADS) {
        const int row = (int)(it >> 5), p = (int)(it & 31), pnv = p >> 2, wc = p & 3; float s = 0.f, q = 0.f;
        for (int bj = 0; bj < 2; ++bj) for (int j = 0; j < 32; ++j) { const float x = bf2f(v[(size_t)row * SGU_HALF + pnv * 256 + bj * 128 + wc * 32 + j]); s += x; q += x * x; }
        st[((size_t)p * T + row) * 2] = s; st[((size_t)p * T + row) * 2 + 1] = q;
    }
}
__device__ __forceinline__ void n_mix(Frame& F) {
    LAS float* wl = (LAS float*)F.lds;
    LAS float* vls = wl + 128 * 128;
    LAS float* mu = vls + 128 * 128; LAS float* rs = mu + 128; LAS float* red = rs + 128;
    bf16* u = WSP(bf16, WS_U); const bf16* v = WSP(bf16, WS_V);
    for (int bn = F.bid; bn < T / SGU_BLK; bn += F.G) {
        const size_t t0 = (size_t)bn * SGU_BLK;
        __syncthreads();
        { const int row = FTID >> 2, q4 = FTID & 3; float s = 0.f, q = 0.f;
          for (int i = 0; i < 512; ++i) { const float x = bf2f(v[(t0 + row) * SGU_HALF + q4 * 512 + i]); s += x; q += x * x; }
          red[(row * 4 + q4) * 2] = s; red[(row * 4 + q4) * 2 + 1] = q; }
        __syncthreads();
        if (FTID < 128) { float s = 0.f, q = 0.f; for (int p = 0; p < 4; ++p) { s += red[(FTID * 4 + p) * 2]; q += red[(FTID * 4 + p) * 2 + 1]; }
            const float m = s * (1.f / SGU_HALF); mu[FTID] = m; rs[FTID] = 1.f / sqrtf(q * (1.f / SGU_HALF) - m * m + EPS); }
        for (int g = 0; g < 4; ++g) {
            __syncthreads();
            for (int i = FTID; i < 128 * 128; i += NTHREADS) { const int t = i >> 7, s = i & 127; wl[i] = ((t >> 6) >= (s >> 6)) ? F.inp(I_SGU_WS)[(size_t)g * 128 * 128 + i] : 0.f; }
            for (int cb = 0; cb < 4; ++cb) {
                const int c0 = g * SGU_GC + cb * 128;
                __syncthreads();
                for (int i = FTID; i < 128 * 128; i += NTHREADS) { const int s = i >> 7, c = i & 127;
                    vls[i] = (bf2f(v[(t0 + s) * SGU_HALF + c0 + c]) - mu[s]) * rs[s] * F.inp(I_SGU_LNG)[c0 + c] + F.inp(I_SGU_LNB)[c0 + c]; }
                __syncthreads();
                const int c = FTID & 127, tq = FTID >> 7;
                for (int tt = 0; tt < 32; ++tt) {
                    const int t = tq * 32 + tt; float acc = 0.f;
                    for (int s = 0; s < 128; ++s) acc += wl[t * 128 + s] * vls[s * 128 + c];
                    const float mixed = acc + F.inp(I_SGU_BS)[g * 128 + t];
                    u[(t0 + t) * SGU_HALF + c0 + c] = (bf16)f2bf(bf2f(u[(t0 + t) * SGU_HALF + c0 + c]) * mixed);
                }
            }
        }
    }
}
#define XB_TMO      128
#define XB_XCNT(j)  (256  + 64 * (j))
#define XB_XSUB(j)  (1280 + 64 * (j))
#define XB_XGEN(j)  (2304 + 64 * (j))
#define XB_TOP      3328
#define XB_TOPGEN   3392
#define XCD_BAR_WORDS 3456
#define XB_SPIN_CAP (1u << 18)

__device__ __forceinline__ unsigned xb_ld(unsigned* p)              { return __hip_atomic_load(p, __ATOMIC_RELAXED, __HIP_MEMORY_SCOPE_AGENT); }
__device__ __forceinline__ unsigned xb_add(unsigned* p, unsigned v) { return __hip_atomic_fetch_add(p, v, __ATOMIC_RELAXED, __HIP_MEMORY_SCOPE_AGENT); }
__device__ __forceinline__ unsigned xb_xcc_id() { return (unsigned)__builtin_amdgcn_s_getreg((3 << 11) | 20) & 0xFu; }
#define XB_SPIN(cond, bar) do { unsigned _sp = 0; while (cond) { __builtin_amdgcn_s_sleep(1); \
    if ((++_sp & 255u) == 0u) { if (xb_ld(&(bar)[XB_TMO])) break; if (_sp > XB_SPIN_CAP) { atomicAdd(&(bar)[XB_TMO], 1u); break; } } } } while (0)

struct XcdBarrier {
    unsigned* bar; unsigned x;
    volatile LAS unsigned* st;
};

__device__ __forceinline__ XcdBarrier xcd_barrier_post(unsigned* bar, volatile LAS unsigned* st) {
    XcdBarrier b; b.bar = bar; b.x = xb_xcc_id(); b.st = st;
    if (threadIdx.x == 0) (void)xb_add(&bar[XB_XCNT(b.x)], 1u);
    return b;
}
__device__ __forceinline__ void xcd_barrier_complete(unsigned* bar, unsigned x, unsigned& nloc, unsigned& nx) {
    const unsigned G = gridDim.x * gridDim.y * gridDim.z;
    unsigned sum, cnt, mine, sp = 0u;
    for (;;) {
        sum = 0u; cnt = 0u; mine = 0u;
#pragma unroll
        for (unsigned j = 0; j < 16; ++j) { const unsigned c = xb_ld(&bar[XB_XCNT(j)]); sum += c; cnt += (c > 0u) ? 1u : 0u; mine = (j == x) ? c : mine; }
        if (sum == G) break;
        __builtin_amdgcn_s_sleep(1);
        if ((++sp & 255u) == 0u) { if (xb_ld(&bar[XB_TMO])) break; if (sp > XB_SPIN_CAP) { atomicAdd(&bar[XB_TMO], 1u); break; } }
    }
    nloc = mine > 0u ? mine : 1u; nx = cnt > 0u ? cnt : 1u;
}

__device__ __forceinline__ void xcd_barrier(const XcdBarrier& b) {
    asm volatile("s_waitcnt vmcnt(0)" ::: "memory");
    __syncthreads();
    if (threadIdx.x == 0) {
        unsigned* bar = b.bar;
        __builtin_amdgcn_s_waitcnt(0);
        unsigned nloc = b.st[0], nx = b.st[1];
        if (nloc == 0u) { xcd_barrier_complete(bar, b.x, nloc, nx); b.st[0] = nloc; b.st[1] = nx; }
        const unsigned old = xb_add(&bar[XB_XSUB(b.x)], 1u);
        const unsigned gen = old / nloc;
        if (old + 1u == (gen + 1u) * nloc) {
            __builtin_amdgcn_fence(__ATOMIC_RELEASE, "agent");
            asm volatile("s_waitcnt vmcnt(0)" ::: "memory");
            const unsigned og = xb_add(&bar[XB_TOP], 1u);
            const unsigned tg = og / nx;
            if (og + 1u == (tg + 1u) * nx) xb_add(&bar[XB_TOPGEN], 1u);
            else XB_SPIN(xb_ld(&bar[XB_TOPGEN]) == tg, bar);
            __builtin_amdgcn_fence(__ATOMIC_ACQUIRE, "agent");
            xb_add(&bar[XB_XGEN(b.x)], 1u);
            asm volatile("s_waitcnt vmcnt(0)" ::: "memory");
        } else {
            XB_SPIN(xb_ld(&bar[XB_XGEN(b.x)]) == gen, bar);
            __builtin_amdgcn_fence(__ATOMIC_ACQUIRE, "agent");
            asm volatile("s_waitcnt vmcnt(0)" ::: "memory");
        }
    }
    __syncthreads();
}
constexpr int RING_BYTES = 131072;
constexpr int LX_TST = RING_BYTES;
constexpr int MOE_MAXU = 6;
constexpr int LX_TAB = RING_BYTES + 512;
constexpr int LX_GT = LX_TAB + MOE_MAXU * 1024;

struct EpiStoreBf16 {
    static constexpr bool RS_DMA = true;
    static constexpr bool PERM = true;
    bf16* O; int ldc; const float* rs; int fold;
    __device__ __forceinline__ void operator()(const pg8::f32x4 (&acc)[2][2][4][2], const pg8::Unit& u, int wr, int wc, int fr, int fq, const LAS float* rsl) const {
        const int row0 = (fold ? (int)blockIdx.x : u.pm) * 256 + wr * 64 + fr, col0 = (fold ? 0 : u.pn * 256) + wc * 32 + 8 * fq;
        if (fold == 2) { float sm = 0.f;
#pragma unroll
            for (int ai = 0; ai < 2; ++ai)
#pragma unroll
                for (int bj = 0; bj < 2; ++bj)
#pragma unroll
                    for (int m = 0; m < 4; ++m)
#pragma unroll
                        for (int n = 0; n < 2; ++n) sm += acc[ai][bj][m][n][0] + acc[ai][bj][m][n][1] + acc[ai][bj][m][n][2] + acc[ai][bj][m][n][3];
            if (sm == 1.2345e30f) O[row0] = 1; return; }
#pragma unroll
        for (int ai = 0; ai < 2; ++ai)
#pragma unroll
            for (int m = 0; m < 4; ++m) { const int row = row0 + ai * 128 + m * 16; bf16* rowp = O + (size_t)row * ldc + col0; const float sc = rsl[ai * 128 + wr * 64 + m * 16 + fr];
#pragma unroll
                for (int bj = 0; bj < 2; ++bj) { const pg8::f32x4 v0 = acc[ai][bj][m][0] * sc, v1 = acc[ai][bj][m][1] * sc;
                    v4u w; w.x = pg8::cvt_pk_bf16(v0[0], v0[1]); w.y = pg8::cvt_pk_bf16(v0[2], v0[3]); w.z = pg8::cvt_pk_bf16(v1[0], v1[1]); w.w = pg8::cvt_pk_bf16(v1[2], v1[3]);
                    *(v4u*)(rowp + bj * 128) = w; } }
    }
};
struct EpiResBf16 {
    static constexpr bool RS_DMA = false;
    static constexpr bool PERM = true;
    bf16* X;
    __device__ __forceinline__ void operator()(const pg8::f32x4 (&acc)[2][2][4][2], const pg8::Unit& u, int wr, int wc, int fr, int fq, const LAS float* rsl) const {
        const int row0 = u.pm * 256 + wr * 64 + fr, col0 = u.pn * 256 + wc * 32 + 8 * fq;
#pragma unroll
        for (int ai = 0; ai < 2; ++ai)
#pragma unroll
            for (int m = 0; m < 4; ++m) { bf16* rowp = X + (size_t)(row0 + ai * 128 + m * 16) * D + col0;
#pragma unroll
                for (int bj = 0; bj < 2; ++bj) { const v4u r = *(const v4u*)(rowp + bj * 128); const pg8::f32x4 v0 = acc[ai][bj][m][0], v1 = acc[ai][bj][m][1];
                    v4u w; w.x = pg8::cvt_pk_bf16(bflo(r.x) + v0[0], bfhi(r.x) + v0[1]); w.y = pg8::cvt_pk_bf16(bflo(r.y) + v0[2], bfhi(r.y) + v0[3]);
                    w.z = pg8::cvt_pk_bf16(bflo(r.z) + v1[0], bfhi(r.z) + v1[1]); w.w = pg8::cvt_pk_bf16(bflo(r.w) + v1[2], bfhi(r.w) + v1[3]);
                    *(v4u*)(rowp + bj * 128) = w; } }
    }
};
struct EpiResF32 {
    static constexpr bool RS_DMA = false;
    static constexpr bool PERM = false;
    const float* res; float* out;
    __device__ __forceinline__ void operator()(const pg8::f32x4 (&acc)[2][2][4][2], const pg8::Unit& u, int wr, int wc, int fr, int fq, const LAS float* rsl) const {
        const int row0 = u.pm * 256 + wr * 64 + fr, col0 = u.pn * 256 + wc * 32 + 4 * fq;
#pragma unroll
        for (int ai = 0; ai < 2; ++ai)
#pragma unroll
            for (int m = 0; m < 4; ++m) { const size_t off = (size_t)(row0 + ai * 128 + m * 16) * D + col0;
#pragma unroll
                for (int bj = 0; bj < 2; ++bj)
#pragma unroll
                    for (int n = 0; n < 2; ++n) { const pg8::f32x4 r = *(const pg8::f32x4*)(res + off + bj * 128 + n * 16); *(pg8::f32x4*)(out + off + bj * 128 + n * 16) = r + acc[ai][bj][m][n]; } }
    }
};
struct EpiGeluSplit {
    static constexpr bool RS_DMA = true;
    static constexpr bool PERM = true;
    bf16* U; bf16* V; float* st; const float* rs;
    __device__ __forceinline__ void operator()(const pg8::f32x4 (&acc)[2][2][4][2], const pg8::Unit& u, int wr, int wc, int fr, int fq, const LAS float* rsl) const {
        const bool isv = u.pn >= 8; const int pnl = isv ? u.pn - 8 : u.pn;
        bf16* O = isv ? V : U;
        const int row0 = u.pm * 256 + wr * 64 + fr, col0 = pnl * 256 + wc * 32 + 8 * fq;
#pragma unroll
        for (int ai = 0; ai < 2; ++ai)
#pragma unroll
            for (int m = 0; m < 4; ++m) { const int row = row0 + ai * 128 + m * 16; bf16* rowp = O + (size_t)row * SGU_HALF + col0; float s = 0.f, q = 0.f; const float sc = rsl[ai * 128 + wr * 64 + m * 16 + fr];
#pragma unroll
                for (int bj = 0; bj < 2; ++bj) { const pg8::f32x4 v0 = acc[ai][bj][m][0] * sc, v1 = acc[ai][bj][m][1] * sc;
                    const pg8::f32x2 a = pg8::gelu_pk((pg8::f32x2){v0[0], v0[1]}), b = pg8::gelu_pk((pg8::f32x2){v0[2], v0[3]}), c = pg8::gelu_pk((pg8::f32x2){v1[0], v1[1]}), d = pg8::gelu_pk((pg8::f32x2){v1[2], v1[3]});
                    s += (a.x + a.y) + (b.x + b.y) + (c.x + c.y) + (d.x + d.y);
                    q += (a.x * a.x + a.y * a.y) + (b.x * b.x + b.y * b.y) + (c.x * c.x + c.y * c.y) + (d.x * d.x + d.y * d.y);
                    v4u w; w.x = pg8::cvt_pk_bf16(a.x, a.y); w.y = pg8::cvt_pk_bf16(b.x, b.y); w.z = pg8::cvt_pk_bf16(c.x, c.y); w.w = pg8::cvt_pk_bf16(d.x, d.y);
                    *(v4u*)(rowp + bj * 128) = w; }
                if (isv) { s += __shfl_xor(s, 16); s += __shfl_xor(s, 32); q += __shfl_xor(q, 16); q += __shfl_xor(q, 32);
                    if (fq == 0) { pg8::f32x2 o = {s, q}; *(pg8::f32x2*)(st + ((size_t)(pnl * 4 + wc) * T + row) * 2) = o; } } }
    }
};

__device__ __forceinline__ void f_gemm_in(Frame& F, int fold = 0) {
    pg8::DenseOrder S; S.init(T, NQKVR, D, WSP(bf16, WS_WIN), F.G, F.bid);
    EpiStoreBf16 E{fold ? WSP(bf16, WS_AOUT) : WSP(bf16, WS_QKVR), fold ? 256 : NQKVR, WSP(float, WS_RS), fold};
    pg8::gemm_phase(F.lds, WSP(bf16, WS_XN), D, S, E);
}
__device__ __forceinline__ void f_gemm_out(Frame& F) {
    pg8::DenseOrder S; S.init(T, D, HV, WSP(bf16, WS_WOUT), F.G, F.bid);
    EpiResBf16 E{WSP(bf16, WS_XN)};
    pg8::gemm_phase(F.lds, WSP(bf16, WS_AOUT), HV, S, E);
}
__device__ __forceinline__ void f_gemm_sgu_in(Frame& F) {
    pg8::DenseOrder S; S.init(T, SGU_FFN, D, WSP(bf16, WS_WSIN), F.G, F.bid);
    EpiGeluSplit E{WSP(bf16, WS_U), WSP(bf16, WS_V), WSP(float, WS_STATS), WSP(float, WS_RS)};
    pg8::gemm_phase(F.lds, WSP(bf16, WS_XN), D, S, E);
}
__device__ __forceinline__ void f_gemm_sgu_out(Frame& F) {
    pg8::DenseOrder S; S.init(T, D, SGU_HALF, WSP(bf16, WS_WSOUT), F.G, F.bid);
    EpiResBf16 E{WSP(bf16, WS_XN)};
    pg8::gemm_phase(F.lds, WSP(bf16, WS_U), SGU_HALF, S, E);
}

template <bool GATHER_> struct MoeOrder {
    static constexpr bool GATHER = GATHER_;
    int G, c, nunits, ibase, K, mode;
    const char* W; size_t estride;
    LAS const int* tst; LAS const int* tab;
    __device__ __forceinline__ bool next(int i, pg8::Unit& u) const {
        if (i >= MOE_MAXU) return false;
        const int Lu = (ibase + i) * G + c; if (Lu >= nunits) return false;
        const int rt = Lu >> 2; int e = 0;
        while (e < NE - 1 && tst[e + 1] <= rt) ++e;
        u.pm = rt; u.pn = Lu & 3; u.e = e; u.slot = i; return true;
    }
    __device__ __forceinline__ const char* bptr(const pg8::Unit& u) const { return W + (size_t)u.e * estride + (size_t)u.pn * 256 * K * 2; }
    __device__ __forceinline__ size_t abase(const pg8::Unit& u) const { return (size_t)u.pm * 256 * K * 2; }
    __device__ __forceinline__ unsigned aoff(const pg8::Unit& u, int h, int R, int C) const {
        if (mode == 0) { int ent = tab[u.slot * 256 + h * 128 + R]; ent = ent < 0 ? 0 : ent; return (unsigned)(((ent >> 1) * K + C) * 2); }
        return (unsigned)(((u.pm * 256 + h * 128 + R) * K + C) * 2);
    }
    __device__ __forceinline__ void a_ready(const pg8::Unit&) const {}
    __device__ __forceinline__ void done(const pg8::Unit&) const {}
};
struct EpiSwiglu {
    static constexpr bool RS_DMA = false;
    static constexpr bool PERM = true;
    bf16* H; LAS const float* gt;
    __device__ __forceinline__ void operator()(const pg8::f32x4 (&acc)[2][2][4][2], const pg8::Unit& u, int wr, int wc, int fr, int fq, const LAS float* rsl) const {
        const int row0 = u.pm * 256 + wr * 64 + fr, col0 = u.pn * 128 + wc * 32 + 8 * fq;
#pragma unroll
        for (int ai = 0; ai < 2; ++ai)
#pragma unroll
            for (int m = 0; m < 4; ++m) { bf16* rowp = H + (size_t)(row0 + ai * 128 + m * 16) * FF + col0; float h[8]; const float sc = gt[u.slot * 256 + ai * 128 + wr * 64 + m * 16 + fr];
#pragma unroll
                for (int n = 0; n < 2; ++n)
#pragma unroll
                    for (int i = 0; i < 4; ++i) { const float a = acc[ai][0][m][n][i] * sc, b = acc[ai][1][m][n][i] * sc; h[n * 4 + i] = a * __builtin_amdgcn_rcpf(1.f + __expf(-a)) * b; }
                v4u w; w.x = pg8::cvt_pk_bf16(h[0], h[1]); w.y = pg8::cvt_pk_bf16(h[2], h[3]); w.z = pg8::cvt_pk_bf16(h[4], h[5]); w.w = pg8::cvt_pk_bf16(h[6], h[7]);
                *(v4u*)rowp = w; }
    }
};
struct EpiScatterY {
    static constexpr bool RS_DMA = false;
    static constexpr bool PERM = true;
    bf16* Y; LAS const int* tab; LAS const float* gt;
    __device__ __forceinline__ void operator()(const pg8::f32x4 (&acc)[2][2][4][2], const pg8::Unit& u, int wr, int wc, int fr, int fq, const LAS float* rsl) const {
        const int col0 = u.pn * 256 + wc * 32 + 8 * fq;
#pragma unroll
        for (int ai = 0; ai < 2; ++ai)
#pragma unroll
            for (int m = 0; m < 4; ++m) { const int r = ai * 128 + wr * 64 + m * 16 + fr; const int ent = tab[u.slot * 256 + r]; const float g = gt[u.slot * 256 + r];
                if (ent >= 0) { bf16* rowp = Y + ((size_t)(ent & 1) * T + (ent >> 1)) * D + col0;
#pragma unroll
                    for (int bj = 0; bj < 2; ++bj) { const pg8::f32x4 v0 = acc[ai][bj][m][0] * g, v1 = acc[ai][bj][m][1] * g;
                        v4u w; w.x = pg8::cvt_pk_bf16(v0[0], v0[1]); w.y = pg8::cvt_pk_bf16(v0[2], v0[3]); w.z = pg8::cvt_pk_bf16(v1[0], v1[1]); w.w = pg8::cvt_pk_bf16(v1[2], v1[3]);
                        *(v4u*)(rowp + bj * 128) = w; } } }
    }
};
template <int MODE> __device__ __forceinline__ void f_moe_gemm(Frame& F, int L) {
    LAS int* tst = (LAS int*)(F.lds + LX_TST); LAS int* cntl = tst + 64; LAS int* tab = (LAS int*)(F.lds + LX_TAB); LAS float* gt = (LAS float*)(F.lds + LX_GT);
    unsigned* ctl = WSP(unsigned, WS_CTL);
    __syncthreads();
    if (FTID < NE) cntl[FTID] = (int)__hip_atomic_load(&ctl[CW_CNT + L * 2048 + 64 * FTID], __ATOMIC_RELAXED, __HIP_MEMORY_SCOPE_AGENT);
    __syncthreads();
    if (FTID == 0) { int s = 0; for (int e = 0; e < NE; ++e) { tst[e] = s; s += (cntl[e] + 255) >> 8; } tst[NE] = s; }
    __syncthreads();
    MoeOrder<MODE == 0> S; S.G = F.G; S.c = F.bid; S.nunits = 4 * tst[NE]; S.K = MODE == 0 ? D : FF; S.mode = MODE; S.tst = tst; S.tab = tab;
    S.W = MODE == 0 ? (const char*)(WSP(bf16, WS_W13) + (size_t)L * NE * 1024 * 1024) : (const char*)(WSP(bf16, WS_W2) + (size_t)L * NE * 1024 * 512);
    S.estride = MODE == 0 ? (size_t)1024 * 1024 * 2 : (size_t)1024 * 512 * 2;
    const int* list = WSP(int, WS_LIST); const float* gates = WSP(float, WS_GATE);
    for (int ibase = 0; ibase * F.G + F.bid < S.nunits; ibase += MOE_MAXU) {
        S.ibase = ibase;
        for (int i = 0; i < MOE_MAXU; ++i) {
            pg8::Unit u; if (!S.next(i, u)) break;
            const int tin = u.pm - tst[u.e];
            if (FTID < 256) { const int idx = tin * 256 + FTID; int ent = -1; float g = 0.f;
                if (idx < cntl[u.e]) { ent = list[(size_t)u.e * T + idx]; g = MODE == 0 ? WSP(float, WS_RS)[ent >> 1] : gates[ent]; }
                tab[i * 256 + FTID] = ent; gt[i * 256 + FTID] = g; }
        }
        __syncthreads();
        if (MODE == 0) { EpiSwiglu E{WSP(bf16, WS_HID), gt}; pg8::gemm_phase(F.lds, WSP(bf16, WS_XN), D, S, E); }
        else { EpiScatterY E{WSP(bf16, WS_Y), tab, gt}; pg8::gemm_phase(F.lds, WSP(bf16, WS_HID), FF, S, E); }
        __syncthreads();
    }
}
__device__ __forceinline__ void f_moe1(Frame& F, int L) { f_moe_gemm<0>(F, L); }
__device__ __forceinline__ void f_moe2(Frame& F, int L) { f_moe_gemm<1>(F, L); }
__device__ __forceinline__ void transpose_item(const float* W, int ldw, const float* kscale, float cs, bf16* WT, int K, int dst_row0, LAS float* scr, int k0, int n0, int lane) {
    f32x4 x[8]; float ks[8];
    const int kr = lane >> 3, n4 = (lane & 7) * 4;
#pragma unroll
    for (int i = 0; i < 8; ++i) { x[i] = *(const f32x4*)(W + (size_t)(k0 + 8 * i + kr) * ldw + n0 + n4); ks[i] = kscale ? kscale[k0 + 8 * i + kr] * cs : cs; }
#pragma unroll
    for (int i = 0; i < 8; ++i) { LAS float* d = scr + (8 * i + kr) * 33 + n4; d[0] = x[i][0] * ks[i]; d[1] = x[i][1] * ks[i]; d[2] = x[i][2] * ks[i]; d[3] = x[i][3] * ks[i]; }
    LDS_WAIT(); asm volatile("" ::: "memory");
    const int c = lane & 7;
#pragma unroll
    for (int j = 0; j < 4; ++j) { const int n = (lane >> 3) + 8 * j; const LAS float* s = scr + (8 * c) * 33 + n;
        v4u o; o.x = pk2(s[0 * 33], s[1 * 33]); o.y = pk2(s[2 * 33], s[3 * 33]); o.z = pk2(s[4 * 33], s[5 * 33]); o.w = pk2(s[6 * 33], s[7 * 33]);
        *(v4u*)(WT + (size_t)(dst_row0 + n) * K + k0 + 8 * c) = o; }
    LDS_WAIT(); asm volatile("" ::: "memory");
}
__device__ __forceinline__ void convert_job_item(const float* W, int ldw, int K, int N, const float* kscale, int qcols, float qs, bf16* WT, int rowmap, LAS float* scr, int item, int lane) {
    const int nblk = N / 32, kb = item / nblk, nb = item % nblk, k0 = 64 * kb, n0 = 32 * nb;
    const int dr = rowmap == 0 ? n0 : ((n0 >> 7) * 256 + (n0 & 127) + (rowmap == 2 ? 128 : 0));
    transpose_item(W, ldw, kscale, n0 < qcols ? qs : 1.f, WT, K, dr, scr, k0, n0, lane);
}
__device__ __forceinline__ void f_convert_gla(Frame& F) {
    LAS float* scr = (LAS float*)(F.lds + FWAVE * 8448);
    const int gw = F.bid * NWAVES + FWAVE, NGW = F.G * NWAVES;
    constexpr int I0 = (D / 64) * (NQKVR / 32), I1 = (HV / 64) * (D / 32);
    for (int it = gw; it < I0 + I1; it += NGW) {
        if (it < I0) convert_job_item(F.inp(I_GLA_WIN), GLA_IN, D, NQKVR, F.inp(I_GLA_NORM), HK, 0.08838834764831845f, WSP(bf16, WS_WIN), 0, scr, it, FLANE);
        else convert_job_item(F.inp(I_GLA_WOUT), D, HV, D, F.inp(I_GLA_HG), 0, 1.f, WSP(bf16, WS_WOUT), 0, scr, it - I0, FLANE);
    }
}
__device__ __forceinline__ void f_convert_rest(Frame& F, int cw, int NCW) {
    LAS float* scr = (LAS float*)(F.lds + FWAVE * 8448);
    constexpr int I0 = (D / 64) * (SGU_FFN / 32), I1 = (SGU_HALF / 64) * (D / 32), IE1 = (D / 64) * (FF / 32), IE2 = (FF / 64) * (D / 32);
    constexpr int IM = 2 * NE * IE1;
    static_assert(IE1 == IE2, "w1 / w2 item counts");
    for (int it = cw; it < I0 + I1 + 3 * IM; it += NCW) {
        int r = it;
        if (r < I0) { convert_job_item(F.inp(I_SGU_WIN), SGU_FFN, D, SGU_FFN, F.inp(I_SGU_NORM), 0, 1.f, WSP(bf16, WS_WSIN), 0, scr, r, FLANE); continue; } r -= I0;
        if (r < I1) { convert_job_item(F.inp(I_SGU_WOUT), D, SGU_HALF, D, nullptr, 0, 1.f, WSP(bf16, WS_WSOUT), 0, scr, r, FLANE); continue; } r -= I1;
        const int which = r / IM; r -= which * IM; const int le = r / IE1, li = r % IE1, L = le / NE;
        if (which == 0) convert_job_item(F.inp(I_MOE_W1) + (size_t)le * D * FF, FF, D, FF, F.inp(I_MOE_NORM) + L * D, 0, 1.f, WSP(bf16, WS_W13) + (size_t)le * 1024 * 1024, 1, scr, li, FLANE);
        else if (which == 1) convert_job_item(F.inp(I_MOE_W3) + (size_t)le * D * FF, FF, D, FF, F.inp(I_MOE_NORM) + L * D, 0, 1.f, WSP(bf16, WS_W13) + (size_t)le * 1024 * 1024, 2, scr, li, FLANE);
        else convert_job_item(F.inp(I_MOE_W2) + (size_t)le * FF * D, D, FF, D, nullptr, 0, 1.f, WSP(bf16, WS_W2) + (size_t)le * 1024 * 512, 0, scr, li, FLANE);
    }
}

#ifndef SCAN_DUP
#define SCAN_DUP 0
#endif
constexpr int SC_K = 0, SC_KSTR = 320;
constexpr int SC_V = 20480, SC_VSTR = 576;
constexpr int SC_Q = 57344, SC_QSTR = 272;
constexpr int SC_O = 74752, SC_OSTR = 528;
constexpr int SC_GL = 108544, SC_PART = 112640, SC_DEC = 114688, SC_WG = 115200;
__device__ __forceinline__ s16x4 tr_read16(LAS const unsigned char* p) {
    typedef short v4i16_t __attribute__((ext_vector_type(4)));
    return __builtin_bit_cast(s16x4, __builtin_amdgcn_ds_read_tr16_b64_v4i16((LAS v4i16_t*)p));
}
__device__ __forceinline__ void f_scan_item(Frame& F, int item) {
    const int b = item / GLA_H, h = item % GLA_H;
    const bf16* qkvr = WSP(bf16, WS_QKVR); const float* glr = WSP(float, WS_GLR); bf16* aout = WSP(bf16, WS_AOUT);
    LAS unsigned char* L = F.lds;
    LAS float* gl = (LAS float*)(L + SC_GL); LAS float* part = (LAS float*)(L + SC_PART); LAS float* dec = (LAS float*)(L + SC_DEC);
    const int tid = FTID, lane = FLANE, w = FWAVE;
    const int r32 = lane & 31, hh = lane >> 5, blk = (lane >> 4) & 1, q4 = (lane & 15) >> 2, p4 = lane & 3;
    const int dk = tid & 127, tg = tid >> 7;
    const int gq = lane >> 4, gcol = lane & 15, gdk = 16 * w + gcol;
    bf16x8 gBh, gBl;
    { unsigned ph[4], pl[4];
#pragma unroll
      for (int j = 0; j < 4; ++j) { const float x0 = gq < 2 ? F.inp(I_GLA_WGU)[(8 * gq + 2 * j) * HK + h * DK + gdk] : 0.f, x1 = gq < 2 ? F.inp(I_GLA_WGU)[(8 * gq + 2 * j + 1) * HK + h * DK + gdk] : 0.f;
          ph[j] = pk2(x0, x1); pl[j] = pk2(x0 - bflo(ph[j]), x1 - bfhi(ph[j])); }
      v4u vh = {ph[0], ph[1], ph[2], ph[3]}, vl = {pl[0], pl[1], pl[2], pl[3]};
      gBh = __builtin_bit_cast(bf16x8, vh); gBl = __builtin_bit_cast(bf16x8, vl); }
    const float gbias = F.inp(I_GLA_BG)[h * DK + gdk];
    __syncthreads();
    f32x16 st[4];
#pragma unroll
    for (int i = 0; i < 4; ++i)
#pragma unroll
        for (int j = 0; j < 16; ++j) st[i][j] = 0.f;
    v4u rk[2], rq[2], rv[4]; f32x4 rg;
    const size_t rowb = (size_t)b * SEQ;
    const unsigned vo_kq = (unsigned)(((tid >> 4) * NQKVR + (tid & 15) * 8) * 2), vo_v = (unsigned)(((tid >> 5) * NQKVR + (tid & 31) * 8) * 2), vo_g = (unsigned)(tid * 16);
    const unsigned lo_k = (unsigned)(SC_K + (tid >> 4) * SC_KSTR + (tid & 15) * 16), lo_q = (unsigned)(SC_Q + (tid >> 4) * SC_QSTR + (tid & 15) * 16), lo_v = (unsigned)(SC_V + (tid >> 5) * SC_VSTR + (tid & 31) * 16);
#define SC_LOAD(c) do { size_t cb_ = (rowb + (size_t)(c) * CHUNK) * NQKVR * 2; asm volatile("" : "+s"(cb_)); const char* gb_ = (const char*)qkvr + cb_ + (size_t)(h * DK * 2); \
        _Pragma("unroll") for (int i = 0; i < 2; ++i) { \
            rk[i] = *(const v4u*)(gb_ + (size_t)(HK * 2 + i * 32 * NQKVR * 2) + vo_kq); rq[i] = *(const v4u*)(gb_ + (size_t)(i * 32 * NQKVR * 2) + vo_kq); } \
        _Pragma("unroll") for (int i = 0; i < 4; ++i) rv[i] = *(const v4u*)(gb_ + (size_t)(2 * HK * 2 + h * (DV - DK) * 2 + i * 16 * NQKVR * 2) + vo_v); \
        if (tid < 256) rg = *(const f32x4*)((const char*)glr + (rowb + (size_t)(c) * CHUNK) * RANK * 4 + vo_g); } while (0)
#define SC_STORE() do { \
        _Pragma("unroll") for (int i = 0; i < 2; ++i) { *(LAS v4u*)(L + lo_k + i * 32 * SC_KSTR) = rk[i]; *(LAS v4u*)(L + lo_q + i * 32 * SC_QSTR) = rq[i]; } \
        _Pragma("unroll") for (int i = 0; i < 4; ++i) *(LAS v4u*)(L + lo_v + i * 16 * SC_VSTR) = rv[i]; \
        if (tid < 256) *(LAS f32x4*)(gl + tid * 4) = rg; } while (0)
    SC_LOAD(0);
    SC_STORE();
    for (int c = 0; c < NCHUNK; ++c) {
        const size_t t0 = rowb + (size_t)c * CHUNK;
        __syncthreads();
        if (c + 1 < NCHUNK) SC_LOAD(c + 1);
        {
            pg8::f32x4 g4[4]; float tsum[4], pre[4];
#pragma unroll
            for (int t = 0; t < 4; ++t) {
                v4u ah = {0u, 0u, 0u, 0u}, al = {0u, 0u, 0u, 0u};
                if (gq < 2) { const f32x4 x0 = *(const LAS f32x4*)(gl + (16 * t + gcol) * 16 + 8 * gq), x1 = *(const LAS f32x4*)(gl + (16 * t + gcol) * 16 + 8 * gq + 4);
                    ah.x = pk2(x0[0], x0[1]); ah.y = pk2(x0[2], x0[3]); ah.z = pk2(x1[0], x1[1]); ah.w = pk2(x1[2], x1[3]);
                    al.x = pk2(x0[0] - bflo(ah.x), x0[1] - bfhi(ah.x)); al.y = pk2(x0[2] - bflo(ah.y), x0[3] - bfhi(ah.y)); al.z = pk2(x1[0] - bflo(ah.z), x1[1] - bfhi(ah.z)); al.w = pk2(x1[2] - bflo(ah.w), x1[3] - bfhi(ah.w)); }
                pg8::f32x4 a4 = {gbias, gbias, gbias, gbias};
                a4 = __builtin_amdgcn_mfma_f32_16x16x32_bf16(__builtin_bit_cast(bf16x8, ah), gBh, a4, 0, 0, 0);
                a4 = __builtin_amdgcn_mfma_f32_16x16x32_bf16(__builtin_bit_cast(bf16x8, al), gBh, a4, 0, 0, 0);
                a4 = __builtin_amdgcn_mfma_f32_16x16x32_bf16(__builtin_bit_cast(bf16x8, ah), gBl, a4, 0, 0, 0);
#pragma unroll
                for (int i = 0; i < 4; ++i) { const float a = a4[i]; a4[i] = (fminf(a, 0.f) - __logf(1.f + __expf(-fabsf(a)))) * (1.f / 16.f); }
                a4[1] += a4[0]; a4[2] += a4[1]; a4[3] += a4[2];
                g4[t] = a4;
                const float s0 = a4[3], x1 = __shfl_xor(s0, 16), x2 = __shfl_xor(s0, 32), x3 = __shfl_xor(x1, 32);
                tsum[t] = (s0 + x1) + (x2 + x3);
                pre[t] = ((gq ^ 1) < gq ? x1 : 0.f) + ((gq ^ 2) < gq ? x2 : 0.f) + ((gq ^ 3) < gq ? x3 : 0.f);
            }
            const float tot = (tsum[0] + tsum[1]) + (tsum[2] + tsum[3]);
            float basep = 0.f;
#pragma unroll
            for (int t = 0; t < 4; ++t) {
#pragma unroll
                for (int i = 0; i < 4; ++i) {
                    LAS unsigned short* kp = (LAS unsigned short*)(L + SC_K + (16 * t + 4 * gq + i) * SC_KSTR + gdk * 2);
                    *kp = (unsigned short)f2bf(bf2f(*kp) * __expf(tot - (basep + pre[t] + g4[t][i])));
                }
                basep += tsum[t];
            }
            if (gq == 0) dec[gdk] = __expf(tot);
        }
        __syncthreads();
        const int etok = tid >> 3, ecc = tid & 7;
        v4u rr[4];
        { size_t eb_ = t0 * NQKVR * 2; asm volatile("" : "+s"(eb_));
          const char* rb_ = (const char*)qkvr + eb_ + (size_t)((2 * HK + HV + h * DV) * 2); const unsigned vo_r = (unsigned)((etok * NQKVR + ecc * 32) * 2);
#pragma unroll
          for (int i = 0; i < 4; ++i) rr[i] = *(const v4u*)(rb_ + vo_r + i * 16); }
#pragma unroll
        for (int i = 0; i < 4; ++i)
#pragma unroll
            for (int g4 = 0; g4 < 4; ++g4) { const f32x4 d4 = *(const LAS f32x4*)(dec + 32 * i + 8 * g4 + 4 * hh);
#pragma unroll
                for (int j = 0; j < 4; ++j) st[i][4 * g4 + j] *= d4[j]; }
#pragma unroll
        for (int s = 0; s < 4; ++s) {
            const int trow = 16 * s + 8 * hh + q4;
            const s16x4 v0 = tr_read16(L + SC_V + trow * SC_VSTR + (32 * w + 16 * blk + 4 * p4) * 2), v1 = tr_read16(L + SC_V + (trow + 4) * SC_VSTR + (32 * w + 16 * blk + 4 * p4) * 2);
            const bf16x8 Bv = {v0[0], v0[1], v0[2], v0[3], v1[0], v1[1], v1[2], v1[3]};
#pragma unroll
            for (int i = 0; i < 4; ++i) {
                const s16x4 k0 = tr_read16(L + SC_K + trow * SC_KSTR + (32 * i + 16 * blk + 4 * p4) * 2), k1 = tr_read16(L + SC_K + (trow + 4) * SC_KSTR + (32 * i + 16 * blk + 4 * p4) * 2);
                const bf16x8 Ak = {k0[0], k0[1], k0[2], k0[3], k1[0], k1[1], k1[2], k1[3]};
                st[i] = __builtin_amdgcn_mfma_f32_32x32x16_bf16(Ak, Bv, st[i], 0, 0, 0);
            }
            asm volatile("" ::: "memory");
        }
        for (int rep_ = 0; rep_ < ((SCAN_DUP & 1) ? 2 : 1); ++rep_) {
        f32x16 oacc[2];
#pragma unroll
        for (int ot = 0; ot < 2; ++ot)
#pragma unroll
            for (int j = 0; j < 16; ++j) oacc[ot][j] = 0.f;
#pragma unroll
        for (int i = 0; i < 4; ++i)
#pragma unroll
            for (int s2 = 0; s2 < 2; ++s2) {
                v4u pb; pb.x = pk2(st[i][8 * s2 + 0], st[i][8 * s2 + 1]); pb.y = pk2(st[i][8 * s2 + 2], st[i][8 * s2 + 3]); pb.z = pk2(st[i][8 * s2 + 4], st[i][8 * s2 + 5]); pb.w = pk2(st[i][8 * s2 + 6], st[i][8 * s2 + 7]);
                const bf16x8 Bs = __builtin_bit_cast(bf16x8, pb);
#pragma unroll
                for (int ot = 0; ot < 2; ++ot) {
                    LAS const unsigned char* qp = L + SC_Q + (32 * ot + r32) * SC_QSTR + (32 * i + 16 * s2 + 4 * hh) * 2;
                    const v2u a0 = *(const LAS v2u*)qp, a1 = *(const LAS v2u*)(qp + 16);
                    v4u pa; pa.x = a0.x; pa.y = a0.y; pa.z = a1.x; pa.w = a1.y;
                    oacc[ot] = __builtin_amdgcn_mfma_f32_32x32x16_bf16(__builtin_bit_cast(bf16x8, pa), Bs, oacc[ot], 0, 0, 0);
                }
                asm volatile("" ::: "memory");
            }
#pragma unroll
        for (int ot = 0; ot < 2; ++ot)
#pragma unroll
            for (int rg16 = 0; rg16 < 16; ++rg16) {
                const int tok = 32 * ot + (rg16 & 3) + 8 * (rg16 >> 2) + 4 * hh;
                *(LAS unsigned short*)(L + SC_O + tok * SC_OSTR + (32 * w + r32) * 2) = (unsigned short)f2bf(oacc[ot][rg16]);
            }
        }
        __syncthreads();
        if (c + 1 < NCHUNK) SC_STORE();
        for (int rep2_ = 0; rep2_ < ((SCAN_DUP & 2) ? 2 : 1); ++rep2_) {
        {
            const int tok = etok, cc = ecc;
            v4u ov[4]; float ss = 0.f;
#pragma unroll
            for (int i = 0; i < 4; ++i) ov[i] = *(const LAS v4u*)(L + SC_O + tok * SC_OSTR + cc * 64 + i * 16);
#pragma unroll
            for (int i = 0; i < 4; ++i) { const float a0 = bflo(ov[i].x), a1 = bfhi(ov[i].x), a2 = bflo(ov[i].y), a3 = bfhi(ov[i].y), a4 = bflo(ov[i].z), a5 = bfhi(ov[i].z), a6 = bflo(ov[i].w), a7 = bfhi(ov[i].w);
                ss += (a0 * a0 + a1 * a1) + (a2 * a2 + a3 * a3) + (a4 * a4 + a5 * a5) + (a6 * a6 + a7 * a7); }
            ss += __shfl_xor(ss, 1); ss += __shfl_xor(ss, 2); ss += __shfl_xor(ss, 4);
            const float rms = __builtin_amdgcn_rsqf(ss * (1.f / DV) + EPS);
            size_t ob_ = (t0 * D + h * DV) * 2; asm volatile("" : "+s"(ob_)); const unsigned vo_o = (unsigned)((tok * D + cc * 32) * 2);
#pragma unroll
            for (int i = 0; i < 4; ++i) {
                v4u o;
                o.x = pk2(bflo(ov[i].x) * rms * silu_f(bflo(rr[i].x)), bfhi(ov[i].x) * rms * silu_f(bfhi(rr[i].x)));
                o.y = pk2(bflo(ov[i].y) * rms * silu_f(bflo(rr[i].y)), bfhi(ov[i].y) * rms * silu_f(bfhi(rr[i].y)));
                o.z = pk2(bflo(ov[i].z) * rms * silu_f(bflo(rr[i].z)), bfhi(ov[i].z) * rms * silu_f(bfhi(rr[i].z)));
                o.w = pk2(bflo(ov[i].w) * rms * silu_f(bflo(rr[i].w)), bfhi(ov[i].w) * rms * silu_f(bfhi(rr[i].w)));
                *(v4u*)((char*)aout + ob_ + vo_o + i * 16) = o;
            }
        }
            }
    }
    __syncthreads();
#undef SC_LOAD
#undef SC_STORE
}
#ifndef P2_PARTS
#define P2_PARTS 3
#endif
__device__ __forceinline__ void f_scan_convert(Frame& F, int parts = 3) {
    constexpr int NITEM = NBATCH * GLA_H;
    const bool split = F.G >= 2 * NITEM;
    if ((parts & 1) && (!split || F.bid < NITEM)) for (int it = F.bid; it < NITEM; it += F.G) f_scan_item(F, it);
    if (!(parts & 2)) return;
    if (!split) f_convert_rest(F, F.bid * NWAVES + FWAVE, F.G * NWAVES);
    else if (F.bid >= NITEM) f_convert_rest(F, (F.bid - NITEM) * NWAVES + FWAVE, (F.G - NITEM) * NWAVES);
}
constexpr int MX_W = 0, MX_WSTR = 272;
constexpr int MX_V0 = 34816, MX_VSTR = 320, MX_VBYTES = 40960;
constexpr int MX_MU = 116736;
__device__ __forceinline__ void f_mix(Frame& F) {
    LAS unsigned char* L = F.lds;
    LAS float* mu = (LAS float*)(L + MX_MU); LAS float* rs = mu + 128; LAS float* m1 = rs + 128; LAS float* m0 = m1 + 128; LAS float* bsg = m0 + 128;
    bf16* u = WSP(bf16, WS_U); const bf16* v = WSP(bf16, WS_V); const float* st = WSP(float, WS_STATS);
    const int tid = FTID, lane = FLANE, w = FWAVE;
    const int r32 = lane & 31, hh = lane >> 5, blk = (lane >> 4) & 1, q4 = (lane & 15) >> 2, p4 = lane & 3;
    const int ct = w >> 1, th = w & 1;
    const float* lng = F.inp(I_SGU_LNG); const float* lnb = F.inp(I_SGU_LNB);
    for (int bn = F.bid; bn < T / SGU_BLK; bn += F.G) {
        const size_t t0 = (size_t)bn * SGU_BLK;
        __syncthreads();
        if (tid < 128) { float s = 0.f, q = 0.f;
            for (int p = 0; p < 32; ++p) { const pg8::f32x2 a = *(const pg8::f32x2*)(st + ((size_t)p * T + t0 + tid) * 2); s += a.x; q += a.y; }
            const float m = s * (1.f / SGU_HALF); mu[tid] = m; rs[tid] = 1.f / sqrtf(fmaxf(q * (1.f / SGU_HALF) - m * m, 0.f) + EPS); }
        v4u pre[4];
#define MX_LOAD(g_, cq_) do { size_t vb_ = (t0 * SGU_HALF + (g_) * SGU_GC + (cq_) * 128) * 2; asm volatile("" : "+s"(vb_)); \
        _Pragma("unroll") for (int i = 0; i < 4; ++i) pre[i] = *(const v4u*)((const char*)v + vb_ + (size_t)(i * 32 * SGU_HALF * 2) + (unsigned)(((tid >> 4) * SGU_HALF + (tid & 15) * 8) * 2)); } while (0)
#define MX_STORE(buf_) do { _Pragma("unroll") for (int i = 0; i < 4; ++i) *(LAS v4u*)(L + MX_V0 + (buf_) * MX_VBYTES + ((tid >> 4) + 32 * i) * MX_VSTR + (tid & 15) * 16) = pre[i]; } while (0)
        MX_LOAD(0, 0);
        for (int g = 0; g < 4; ++g) {
            __syncthreads();
            {
                const int t = tid >> 2, sq = tid & 3; const float* wsrc = F.inp(I_SGU_WS) + ((size_t)g * 128 + t) * 128 + sq * 32;
                float a1 = 0.f, a0 = 0.f;
#pragma unroll
                for (int i = 0; i < 4; ++i) {
                    const f32x4 x0 = *(const f32x4*)(wsrc + i * 8), x1 = *(const f32x4*)(wsrc + i * 8 + 4); float wv[8] = {x0[0], x0[1], x0[2], x0[3], x1[0], x1[1], x1[2], x1[3]}; unsigned short hb[8];
#pragma unroll
                    for (int j = 0; j < 8; ++j) { const int s = sq * 32 + i * 8 + j; const float wm = ((t >> 6) >= (s >> 6)) ? wv[j] : 0.f; a0 += wm; hb[j] = (unsigned short)f2bf(wm * rs[s]); a1 += bf2f(hb[j]) * mu[s]; }
                    v4u o; o.x = hb[0] | ((unsigned)hb[1] << 16); o.y = hb[2] | ((unsigned)hb[3] << 16); o.z = hb[4] | ((unsigned)hb[5] << 16); o.w = hb[6] | ((unsigned)hb[7] << 16);
                    *(LAS v4u*)(L + MX_W + t * MX_WSTR + (sq * 32 + i * 8) * 2) = o;
                }
                a1 += __shfl_xor(a1, 1); a1 += __shfl_xor(a1, 2); a0 += __shfl_xor(a0, 1); a0 += __shfl_xor(a0, 2);
                if (sq == 0) { m1[t] = a1; m0[t] = a0; }
                if (tid < 128) bsg[tid] = F.inp(I_SGU_BS)[g * 128 + tid];
            }
            for (int cq = 0; cq < 4; ++cq) {
                const int it = g * 4 + cq, buf = it & 1;
                MX_STORE(buf);
                __syncthreads();
                if (it + 1 < 16) MX_LOAD((it + 1) >> 2, (it + 1) & 3);
                f32x16 acc[2];
#pragma unroll
                for (int tt = 0; tt < 2; ++tt)
#pragma unroll
                    for (int j = 0; j < 16; ++j) acc[tt][j] = 0.f;
                LAS const unsigned char* Vb = L + MX_V0 + buf * MX_VBYTES;
                const int nks = th == 0 ? 4 : 8;
                for (int ks = 0; ks < nks; ++ks) {
                    const int srow = 16 * ks + 8 * hh + q4;
                    const s16x4 a0 = tr_read16(Vb + srow * MX_VSTR + (32 * ct + 16 * blk + 4 * p4) * 2), a1 = tr_read16(Vb + (srow + 4) * MX_VSTR + (32 * ct + 16 * blk + 4 * p4) * 2);
                    const bf16x8 Av = {a0[0], a0[1], a0[2], a0[3], a1[0], a1[1], a1[2], a1[3]};
#pragma unroll
                    for (int tt = 0; tt < 2; ++tt) {
                        const bf16x8 Bw = *(const LAS bf16x8*)(L + MX_W + (64 * th + 32 * tt + r32) * MX_WSTR + (16 * ks + 8 * hh) * 2);
                        acc[tt] = __builtin_amdgcn_mfma_f32_32x32x16_bf16(Av, Bw, acc[tt], 0, 0, 0);
                    }
                }
                const int cbase = g * SGU_GC + cq * 128 + 32 * ct + 4 * hh;
#pragma unroll
                for (int tt = 0; tt < 2; ++tt) {
                    const int t = 64 * th + 32 * tt + r32; const float tm1 = m1[t], tm0 = m0[t], tb = bsg[t];
                    bf16* up = u + (t0 + t) * SGU_HALF + cbase;
#pragma unroll
                    for (int g4 = 0; g4 < 4; ++g4) {
                        const v2u uu = *(const v2u*)(up + 8 * g4); const f32x4 lg = *(const f32x4*)(lng + cbase + 8 * g4), lb = *(const f32x4*)(lnb + cbase + 8 * g4);
                        const float o0 = bflo(uu.x) * (lg[0] * (acc[tt][4 * g4 + 0] - tm1) + lb[0] * tm0 + tb), o1 = bfhi(uu.x) * (lg[1] * (acc[tt][4 * g4 + 1] - tm1) + lb[1] * tm0 + tb);
                        const float o2 = bflo(uu.y) * (lg[2] * (acc[tt][4 * g4 + 2] - tm1) + lb[2] * tm0 + tb), o3 = bfhi(uu.y) * (lg[3] * (acc[tt][4 * g4 + 3] - tm1) + lb[3] * tm0 + tb);
                        v2u o; o.x = pk2(o0, o1); o.y = pk2(o2, o3); *(v2u*)(up + 8 * g4) = o;
                    }
                }
            }
        }
#undef MX_LOAD
#undef MX_STORE
    }
}
constexpr int RW_STR = 2064;
constexpr int RW_LG = 48 * RW_STR;
constexpr int RW_HIST = RW_LG + 8 * 16 * 48 * 4;
template <int MODE> __device__ __forceinline__ void f_rowgroup(Frame& F, int Lyr) {
    constexpr int NCT = MODE == 0 ? 1 : 3;
    LAS unsigned char* L = F.lds;
    const int tid = FTID, lane = FLANE, w = FWAVE, rw = lane & 15, q = lane >> 4;
    const float* xsrc = F.inp(I_X);
    bf16* xb = WSP(bf16, WS_XN); float* rsout = WSP(float, WS_RS);
    __syncthreads();
    for (int k = tid; k < D; k += NTHREADS) {
        if (MODE == 0) {
            const float gn = F.inp(I_GLA_NORM)[k]; const float* wr_ = F.inp(I_GLA_WIN) + (size_t)k * GLA_IN + NQKVR;
#pragma unroll
            for (int c4 = 0; c4 < 4; ++c4) { const f32x4 x = *(const f32x4*)(wr_ + 4 * c4);
#pragma unroll
                for (int j = 0; j < 4; ++j) *(LAS unsigned short*)(L + (4 * c4 + j) * RW_STR + k * 2) = (unsigned short)f2bf(x[j] * gn); }
        } else {
            const float gn = F.inp(I_MOE_NORM)[Lyr * D + k];
            const f32x4 xg = *(const f32x4*)(F.inp(I_MOE_WG) + ((size_t)Lyr * D + k) * 4);
#pragma unroll
            for (int j = 0; j < 4; ++j) *(LAS unsigned short*)(L + j * RW_STR + k * 2) = (unsigned short)f2bf(xg[j] * gn);
#pragma unroll
            for (int g = 0; g < 4; ++g) { const float* ws_ = F.inp(I_MOE_WSUB) + (((size_t)Lyr * 4 + g) * D + k) * EPG; const f32x4 a = *(const f32x4*)ws_, b = *(const f32x4*)(ws_ + 4);
#pragma unroll
                for (int j = 0; j < 4; ++j) { *(LAS unsigned short*)(L + (4 + 8 * g + j) * RW_STR + k * 2) = (unsigned short)f2bf(a[j] * gn); *(LAS unsigned short*)(L + (8 + 8 * g + j) * RW_STR + k * 2) = (unsigned short)f2bf(b[j] * gn); } }
#pragma unroll
            for (int c = 36; c < 48; ++c) *(LAS unsigned short*)(L + c * RW_STR + k * 2) = 0;
        }
    }
    LAS int* hist = (LAS int*)(L + RW_HIST); LAS int* hbase = hist + 32;
    if (MODE == 1 && tid < 32) hist[tid] = 0;
    __syncthreads();
    const int ngroups = T / 16, niter = (ngroups + F.G * NWAVES - 1) / (F.G * NWAVES);
    for (int iter = 0; iter < niter; ++iter) {
        const int grp = (iter * F.G + F.bid) * NWAVES + w; const bool valid = grp < ngroups;
        const size_t row = (size_t)grp * 16 + rw;
        float rstd = 0.f; pg8::f32x4 acc[NCT];
        if (valid) {
#pragma unroll
            for (int c = 0; c < NCT; ++c) acc[c] = (pg8::f32x4){0.f, 0.f, 0.f, 0.f};
            float ss = 0.f;
#pragma unroll 8
            for (int s = 0; s < 32; ++s) {
                v4u pa;
                if (MODE == 0) {
                    const float* xr = xsrc + row * D + 8 * q + 32 * s;
                    const f32x4 x0 = *(const f32x4*)xr, x1 = *(const f32x4*)(xr + 4);
                    ss += (x0[0] * x0[0] + x0[1] * x0[1]) + (x0[2] * x0[2] + x0[3] * x0[3]) + (x1[0] * x1[0] + x1[1] * x1[1]) + (x1[2] * x1[2] + x1[3] * x1[3]);
                    pa.x = pk2(x0[0], x0[1]); pa.y = pk2(x0[2], x0[3]); pa.z = pk2(x1[0], x1[1]); pa.w = pk2(x1[2], x1[3]);
                    *(v4u*)(xb + row * D + 8 * q + 32 * s) = pa;
                } else {
                    pa = *(const v4u*)(xb + row * D + 8 * q + 32 * s);
                    const float a0 = bflo(pa.x), a1 = bfhi(pa.x), a2 = bflo(pa.y), a3 = bfhi(pa.y), a4 = bflo(pa.z), a5 = bfhi(pa.z), a6 = bflo(pa.w), a7 = bfhi(pa.w);
                    ss += (a0 * a0 + a1 * a1) + (a2 * a2 + a3 * a3) + (a4 * a4 + a5 * a5) + (a6 * a6 + a7 * a7);
                }
                const bf16x8 A = __builtin_bit_cast(bf16x8, pa);
#pragma unroll
                for (int c = 0; c < NCT; ++c) { const bf16x8 B = *(const LAS bf16x8*)(L + (16 * c + rw) * RW_STR + (32 * s + 8 * q) * 2); acc[c] = __builtin_amdgcn_mfma_f32_16x16x32_bf16(A, B, acc[c], 0, 0, 0); }
            }
            ss += __shfl_xor(ss, 16); ss += __shfl_xor(ss, 32);
            rstd = __builtin_amdgcn_rsqf(ss * (1.f / D) + EPS);
            if (q == 0) rsout[row] = rstd;
        }
        float rs4[4];
#pragma unroll
        for (int i = 0; i < 4; ++i) rs4[i] = __shfl(rstd, 4 * q + i);
        int e1 = 0, e2 = 0, rk1 = 0, rk2 = 0; float gt1 = 0.f, gt2 = 0.f;
        if (MODE == 0) {
            if (valid) {
                float* glr = WSP(float, WS_GLR);
#pragma unroll
                for (int i = 0; i < 4; ++i) glr[((size_t)grp * 16 + 4 * q + i) * RANK + rw] = acc[0][i] * rs4[i];
            }
        } else {
            LAS float* lgw = (LAS float*)(L + RW_LG) + w * 16 * 48;
            if (valid) {
#pragma unroll
                for (int c = 0; c < NCT; ++c)
#pragma unroll
                    for (int i = 0; i < 4; ++i) lgw[(4 * q + i) * 48 + 16 * c + rw] = acc[c][i] * rs4[i];
            }
            LDS_WAIT(); asm volatile("" ::: "memory");
            if (valid && lane < 16) {
                const LAS float* lr = lgw + lane * 48; const float* bg = F.inp(I_MOE_BG) + Lyr * 4;
                float lg[4];
#pragma unroll
                for (int c = 0; c < 4; ++c) lg[c] = lr[c] + bg[c];
                int g = 0; float gm = lg[0];
#pragma unroll
                for (int c = 1; c < 4; ++c) if (lg[c] > gm) { gm = lg[c]; g = c; }
                float gs = 0.f;
#pragma unroll
                for (int c = 0; c < 4; ++c) gs += __expf(lg[c] - gm);
                const float g_w = 1.f / gs; const float* bs = F.inp(I_MOE_BSUB) + (Lyr * 4 + g) * EPG;
                int i1 = 0, i2 = 0; float m1v = -3.0e38f, m2v = -3.0e38f;
                for (int e = 0; e < EPG; ++e) { const float x = lr[4 + 8 * g + e] + bs[e];
                    if (x > m1v) { m2v = m1v; i2 = i1; m1v = x; i1 = e; } else if (x > m2v) { m2v = x; i2 = e; } }
                const float w1 = 1.f / (1.f + __expf(m2v - m1v));
                e1 = g * EPG + i1; e2 = g * EPG + i2; gt1 = g_w * w1; gt2 = g_w * (1.f - w1);
                rk1 = __hip_atomic_fetch_add(&hist[e1], 1, __ATOMIC_RELAXED, __HIP_MEMORY_SCOPE_WORKGROUP); rk2 = __hip_atomic_fetch_add(&hist[e2], 1, __ATOMIC_RELAXED, __HIP_MEMORY_SCOPE_WORKGROUP);
            }
            __syncthreads();
            if (tid < 32) { const int hcount = hist[tid]; hbase[tid] = hcount ? (int)atomicAdd(WSP(unsigned, WS_CTL) + CW_CNT + Lyr * 2048 + 64 * tid, (unsigned)hcount) : 0; hist[tid] = 0; }
            __syncthreads();
            if (valid && lane < 16) {
                const int tok = grp * 16 + lane; const int p1 = hbase[e1] + rk1, p2 = hbase[e2] + rk2;
                WSP(int, WS_LIST)[(size_t)e1 * T + p1] = tok * 2; WSP(int, WS_LIST)[(size_t)e2 * T + p2] = tok * 2 + 1;
                WSP(float, WS_GATE)[tok * 2] = gt1; WSP(float, WS_GATE)[tok * 2 + 1] = gt2;
            }
        }
    }
    __syncthreads();
}
template <bool FINAL> __device__ __forceinline__ void f_rowadd(Frame& F) {
    bf16* xb = WSP(bf16, WS_XN); const bf16* y = WSP(bf16, WS_Y); float* rsout = WSP(float, WS_RS);
    const int lane = FLANE, w = FWAVE;
    f32x4 gf[4];
    if (FINAL) {
#pragma unroll
        for (int j = 0; j < 2; ++j) { gf[2 * j] = *(const f32x4*)(F.inp(I_FINAL) + 8 * lane + 512 * j); gf[2 * j + 1] = *(const f32x4*)(F.inp(I_FINAL) + 8 * lane + 512 * j + 4); }
    }
    for (int r0 = (F.bid * NWAVES + w) * 2; r0 < T; r0 += F.G * NWAVES * 2) {
        v4u xa[2][2], ya[2][2], yb[2][2];
#pragma unroll
        for (int rr = 0; rr < 2; ++rr)
#pragma unroll
            for (int j = 0; j < 2; ++j) { const size_t o = (size_t)(r0 + rr) * D + 8 * lane + 512 * j;
                xa[rr][j] = *(const v4u*)(xb + o); ya[rr][j] = *(const v4u*)(y + o); yb[rr][j] = *(const v4u*)(y + (size_t)T * D + o); }
#pragma unroll
        for (int rr = 0; rr < 2; ++rr) {
            float v[16]; float ss = 0.f;
#pragma unroll
            for (int j = 0; j < 2; ++j) {
                const unsigned xw[4] = {xa[rr][j].x, xa[rr][j].y, xa[rr][j].z, xa[rr][j].w}, aw[4] = {ya[rr][j].x, ya[rr][j].y, ya[rr][j].z, ya[rr][j].w}, bw[4] = {yb[rr][j].x, yb[rr][j].y, yb[rr][j].z, yb[rr][j].w};
#pragma unroll
                for (int e = 0; e < 4; ++e) { const float lo = bflo(xw[e]) + bflo(aw[e]) + bflo(bw[e]), hi = bfhi(xw[e]) + bfhi(aw[e]) + bfhi(bw[e]); v[8 * j + 2 * e] = lo; v[8 * j + 2 * e + 1] = hi; ss += lo * lo + hi * hi; }
            }
            const float rstd = __builtin_amdgcn_rsqf(wave_sum(ss) * (1.f / D) + EPS);
            const size_t ro = (size_t)(r0 + rr) * D + 8 * lane;
            if (FINAL) {
#pragma unroll
                for (int j = 0; j < 2; ++j) {
                    f32x4 o0 = {v[8 * j] * rstd, v[8 * j + 1] * rstd, v[8 * j + 2] * rstd, v[8 * j + 3] * rstd}, o1 = {v[8 * j + 4] * rstd, v[8 * j + 5] * rstd, v[8 * j + 6] * rstd, v[8 * j + 7] * rstd};
                    *(f32x4*)(F.out + ro + 512 * j) = o0 * gf[2 * j]; *(f32x4*)(F.out + ro + 512 * j + 4) = o1 * gf[2 * j + 1]; }
            } else {
#pragma unroll
                for (int j = 0; j < 2; ++j) { v4u o; o.x = pk2(v[8 * j], v[8 * j + 1]); o.y = pk2(v[8 * j + 2], v[8 * j + 3]); o.z = pk2(v[8 * j + 4], v[8 * j + 5]); o.w = pk2(v[8 * j + 6], v[8 * j + 7]); *(v4u*)(xb + ro + 512 * j) = o; }
                if (lane == 0) rsout[r0 + rr] = rstd;
            }
        }
    }
}
__device__ __forceinline__ void f_prep0(Frame& F) { f_convert_gla(F); f_rowgroup<0>(F, 0); }
__device__ __forceinline__ void f_rowpass_router(Frame& F, int L) { f_rowgroup<1>(F, L); }
__device__ __forceinline__ void f_rowpass_add(Frame& F) { f_rowadd<false>(F); }
__device__ __forceinline__ void f_final(Frame& F) { f_rowadd<true>(F); }
constexpr int LDS_BYTES = 155648;
struct Args { const float* in[23]; float* out; unsigned char* ws; int ph_lo, ph_hi; };
#define NAIVE(k) ((NAIVE_MASK >> (k)) & 1u)
#ifndef P1_FOLD
#define P1_FOLD 0
#endif
#ifndef DUP_MASK
#define DUP_MASK 0u
#endif
#define DUP(k) ((DUP_MASK >> (k)) & 1u)

struct EpiN1 { bf16* o; __device__ void operator()(int r, int c, float v) const { o[(size_t)r * NQKVR + c] = (bf16)f2bf(v); } };
struct EpiN3 { const float* res; float* o; __device__ void operator()(int r, int c, float v) const { o[(size_t)r * D + c] = res[(size_t)r * D + c] + v; } };
struct EpiN8 { bf16* u; bf16* v; __device__ void operator()(int r, int c, float x) const { const float z = gelu_erf(x); if (c < SGU_HALF) u[(size_t)r * SGU_HALF + c] = (bf16)f2bf(z); else v[(size_t)r * SGU_HALF + c - SGU_HALF] = (bf16)f2bf(z); } };

__global__ void __launch_bounds__(NTHREADS, 2) fwd(Args args) {
    extern __shared__ __attribute__((aligned(16))) unsigned char lds_raw[];
    Frame F;
    F.lds = (LAS unsigned char*)lds_raw;
    F.G = gridDim.x; F.bid = blockIdx.x;
    F.out = args.out; F.ws = args.ws;
    if (FTID == 0) {
        LAS unsigned long long* pt = (LAS unsigned long long*)(F.lds + LX_PTR);
#pragma unroll
        for (int i = 0; i < 23; ++i) pt[i] = (unsigned long long)args.in[i];
    }
    __syncthreads();
    const int lo = args.ph_lo, hi = args.ph_hi;
#if ONE_LAUNCH
    cg::grid_group grid = cg::this_grid();
    volatile LAS unsigned* bst = (volatile LAS unsigned*)(F.lds + LX_PTR + 192);
    if (FTID < 2) bst[FTID] = 0u;
    __syncthreads();
    const XcdBarrier xbar = xcd_barrier_post(WSP(unsigned, WS_CTL) + CW_BAR, bst);
#define GRID_BAR() xcd_barrier(xbar)
#define GRID_BAR_CG() grid.sync()
#else
#define GRID_BAR_CG() do { } while (0)
#define GRID_BAR() do { } while (0)
#endif
#define IN(k) (lo <= (k) && (k) < hi)
#define SEAM(k) do { if (IN(k) && IN((k) + 1)) GRID_BAR(); } while (0)

    if (IN(0)) {
        if (NAIVE(0)) { n_convert_gla(F); n_rowpass<0>(F, 0); } else { f_prep0(F); if (DUP(0)) { GRID_BAR(); f_prep0(F); } }
    }
    if (IN(0) && IN(1)) GRID_BAR();
    if (lo > 1000) GRID_BAR_CG();
    if (IN(1)) {
        if (NAIVE(1)) n_gemm(F, WSP(bf16, WS_XN), D, WSP(bf16, WS_WIN), D, T, NQKVR, D, EpiN1{WSP(bf16, WS_QKVR)}); else { f_gemm_in(F); if (DUP(1)) { GRID_BAR(); f_gemm_in(F, P1_FOLD); } }
    }
    SEAM(1);
    if (IN(2)) {
        if (NAIVE(2)) { n_scan(F); n_convert_rest(F); } else { f_scan_convert(F); if (DUP(2)) { GRID_BAR(); f_scan_convert(F, P2_PARTS); } }
    }
    SEAM(2);
    if (IN(3)) {
        if (NAIVE(3)) n_gemm(F, WSP(bf16, WS_XN), D, WSP(bf16, WS_WOUT), D, T, D, HV, EpiN3{F.inp(I_X), F.out}); else { f_gemm_out(F); if (DUP(3)) { GRID_BAR(); f_gemm_out(F); } }
    }
    SEAM(3);
#define MOE_BLOCK(L, pb) do { \
        if (IN(pb)) { if (NAIVE(pb)) n_rowpass<1>(F, L); else f_rowpass_router(F, L); } \
        SEAM(pb); \
        if (IN((pb) + 1)) { if (NAIVE((pb) + 1)) n_moe(F, L); else { f_moe1(F, L); if (DUP((pb) + 1)) { GRID_BAR(); f_moe1(F, L); } } } \
        SEAM((pb) + 1); \
        if (IN((pb) + 2)) { if (!NAIVE((pb) + 1)) { f_moe2(F, L); if (DUP((pb) + 2)) { GRID_BAR(); f_moe2(F, L); } } } \
        SEAM((pb) + 2); } while (0)
    MOE_BLOCK(0, 4);
    if (IN(7)) { if (NAIVE(7)) n_rowpass<2>(F, 0); else f_rowpass_add(F); }
    SEAM(7);
    if (IN(8)) { if (NAIVE(8)) n_gemm(F, WSP(bf16, WS_XN), D, WSP(bf16, WS_WSIN), D, T, SGU_FFN, D, EpiN8{WSP(bf16, WS_U), WSP(bf16, WS_V)}); else { f_gemm_sgu_in(F); if (DUP(8)) { GRID_BAR(); f_gemm_sgu_in(F); } } }
    if (NAIVE(8)) { SEAM(8); if (IN(9)) n_stats(F); SEAM(9); } else { if (IN(8) && IN(10)) GRID_BAR(); }
    if (IN(10)) { if (NAIVE(10)) n_mix(F); else f_mix(F); }
    SEAM(10);
    if (IN(11)) { if (NAIVE(11)) n_gemm(F, WSP(bf16, WS_U), SGU_HALF, WSP(bf16, WS_WSOUT), SGU_HALF, T, D, SGU_HALF, EpiN3{F.out, F.out}); else f_gemm_sgu_out(F); }
    SEAM(11);
    MOE_BLOCK(1, 12);
    if (IN(15)) { if (NAIVE(15)) n_rowpass<3>(F, 0); else f_final(F); }
}

extern "C" void kernel_launch(void* const* d_in, const int* in_sizes, int n_in, void* d_out, int out_size, void* d_ws, size_t ws_size, hipStream_t stream) {
    static int grid = 0;
    if (grid == 0) {
        if (n_in != 23 || out_size != T * D || ws_size < WS_END) { fprintf(stderr, "kernel_launch: unexpected shapes (n_in %d out %d ws %zu)\n", n_in, out_size, ws_size); grid = -1; return; }
        int dev = 0, cus = 0, per_cu = 0;
        hipGetDevice(&dev); hipDeviceGetAttribute(&cus, hipDeviceAttributeMultiprocessorCount, dev);
        hipFuncSetAttribute((const void*)fwd, hipFuncAttributeMaxDynamicSharedMemorySize, LDS_BYTES);
        hipOccupancyMaxActiveBlocksPerMultiprocessor(&per_cu, (const void*)fwd, NTHREADS, LDS_BYTES);
        (void)hipGetLastError();
        if (per_cu < 1) { fprintf(stderr, "kernel_launch: occupancy query says %d blocks per CU\n", per_cu); per_cu = 1; }
        grid = cus;
    }
    if (grid < 0) return;
    hipMemsetAsync((char*)d_ws + WS_CTL, 0, CTL_ZERO_BYTES, stream);
    Args a{};
    for (int i = 0; i < 23; ++i) a.in[i] = (const float*)d_in[i];
    a.out = (float*)d_out; a.ws = (unsigned char*)d_ws;
#if ONE_LAUNCH
    a.ph_lo = 0; a.ph_hi = 16;
    void* kargs[] = {&a};
    hipError_t e = hipLaunchCooperativeKernel((const void*)fwd, dim3(grid), dim3(NTHREADS), kargs, LDS_BYTES, stream);
    if (e != hipSuccess) fprintf(stderr, "cooperative launch failed: %s (grid %d)\n", hipGetErrorString(e), grid);
#else
    for (int p = 0; p < 16; ++p) {
        if (p == 9 && !NAIVE(8)) continue;
        if ((p == 6 || p == 14) && NAIVE(p - 1)) continue;
        a.ph_lo = p; a.ph_hi = p + 1;
        hipLaunchKernelGGL(fwd, dim3(grid), dim3(NTHREADS), LDS_BYTES, stream, a);
    }
#endif
}
```

```cpp
#define NAIVE_MASK 0x0u
#define ONE_LAUNCH 1
#include <hip/hip_runtime.h>
#include <hip/hip_cooperative_groups.h>
#include <cstdio>
#include <cstdint>
namespace cg = cooperative_groups;

#ifndef NAIVE_MASK
#define NAIVE_MASK 0x0u
#endif
#ifndef ONE_LAUNCH
#define ONE_LAUNCH 1
#endif

constexpr int T = 32768, D = 1024, NBATCH = 16, SEQ = 2048;
constexpr int GLA_H = 4, DK = 128, DV = 256, HK = 512, HV = 1024, RANK = 16, GLA_IN = 3088, NQKVR = 3072, CHUNK = 64, NCHUNK = 32;
constexpr int SGU_FFN = 4096, SGU_HALF = 2048, SGU_BLK = 128, SGU_GC = 512;
constexpr int NE = 32, EPG = 8, FF = 512;
constexpr float EPS = 1e-6f;
constexpr int NTHREADS = 512, NWAVES = 8;
constexpr int NPHASE = 15;

constexpr size_t MiB = 1u << 20;
constexpr size_t WS_CTL = 0, CTL_ZERO_BYTES = 64 * 1024;
constexpr size_t WS_GLR = 1 * MiB;
constexpr size_t WS_GATE = 3 * MiB;
constexpr size_t WS_EID = 3 * MiB + 512 * 1024;
constexpr size_t WS_STATS = 4 * MiB;
constexpr size_t WS_LIST = 12 * MiB;
constexpr size_t WS_WIN = 16 * MiB;
constexpr size_t WS_WOUT = 22 * MiB;
constexpr size_t WS_WSIN = 24 * MiB;
constexpr size_t WS_WSOUT = 32 * MiB;
constexpr size_t WS_W13 = 36 * MiB;
constexpr size_t WS_W2 = 164 * MiB;
constexpr size_t WS_XN = 228 * MiB;
constexpr size_t WS_AOUT = 484 * MiB;
constexpr size_t WS_RS = 3 * MiB + 256 * 1024;
constexpr size_t WS_QKVR = 292 * MiB;
constexpr size_t WS_HID = 292 * MiB;
constexpr size_t WS_Y = 364 * MiB;
constexpr size_t WS_U = 292 * MiB;
constexpr size_t WS_V = 420 * MiB;
constexpr size_t WS_END = 548 * MiB;
constexpr int CW_BAR = 1024;
constexpr int CW_CNT = 8192;

#define GAS __attribute__((address_space(1)))
#define LAS __attribute__((address_space(3)))
typedef unsigned short bf16;
typedef unsigned v4u __attribute__((ext_vector_type(4)));
typedef unsigned v2u __attribute__((ext_vector_type(2)));
typedef float f32x4 __attribute__((ext_vector_type(4)));
typedef float f32x16 __attribute__((ext_vector_type(16)));
typedef short bf16x8 __attribute__((ext_vector_type(8)));
typedef short s16x4 __attribute__((ext_vector_type(4)));
#define LDS_WAIT() asm volatile("s_waitcnt lgkmcnt(0)" ::: "memory")
#define VM_WAIT() asm volatile("s_waitcnt vmcnt(0)" ::: "memory")
typedef float f32x2_t __attribute__((ext_vector_type(2))); typedef __bf16 bf16x2_t __attribute__((ext_vector_type(2)));
__device__ __forceinline__ unsigned pk2(float lo, float hi) { f32x2_t v = {lo, hi}; bf16x2_t b = __builtin_convertvector(v, bf16x2_t); return __builtin_bit_cast(unsigned, b); }
__device__ __forceinline__ unsigned f2bf(float f) { return pk2(f, 0.f) & 0xffffu; }
__device__ __forceinline__ float bf2f(unsigned short b) { return __builtin_bit_cast(float, (unsigned)b << 16); }
__device__ __forceinline__ float bflo(unsigned w) { return __builtin_bit_cast(float, w << 16); }
__device__ __forceinline__ float bfhi(unsigned w) { return __builtin_bit_cast(float, w & 0xffff0000u); }
__device__ __forceinline__ float wave_sum(float v) {
#pragma unroll
    for (int o = 1; o < 64; o <<= 1) v += __shfl_xor(v, o);
    return v;
}
__device__ __forceinline__ float silu_f(float x) { return x * __builtin_amdgcn_rcpf(1.f + __expf(-x)); }
__device__ __forceinline__ float gelu_erf(float x) { return 0.5f * x * (1.f + erff(x * 0.70710678118654752f)); }
__device__ __forceinline__ float logsigmoid_f(float x) { return fminf(x, 0.f) - log1pf(__expf(-fabsf(x))); }
namespace pg8 {
#define PG8_LAS __attribute__((address_space(3)))
typedef unsigned short bf16_t;
typedef short bf16x8 __attribute__((ext_vector_type(8)));
typedef float f32x4 __attribute__((ext_vector_type(4)));
typedef unsigned u32x4 __attribute__((ext_vector_type(4)));
constexpr int BM = 256, BK = 64, HALF = 128, HTB = HALF * BK * 2  , STAGE_BYTES = 8 * HTB, NXCD = 8, WGM = 8;

__host__ __device__ __forceinline__ int lds_byte(int r, int c) { const int st = (r >> 4) * 2 + (c >> 5), rr = r & 15, cc = c & 31, ob = rr * 64 + cc * 2; return st * 1024 + (ob ^ (((ob >> 9) & 1) << 5)); }
__host__ __device__ __forceinline__ void stage_rc(int b, int& R, int& C) { const int st = b / 1024, sb = b % 1024, swz = sb ^ (((sb >> 9) & 1) << 5); R = (st >> 1) * 16 + swz / 64; C = (st & 1) * 32 + (swz % 64) / 2; }
__host__ __device__ __forceinline__ int perm32(int rho) { const int n = rho >> 4, i = rho & 15; return 8 * (i >> 2) + 4 * n + (i & 3); }

struct Unit { int pm, pn, e, slot; };

struct DenseOrder {
    static constexpr bool GATHER = false;
    int nM, nN, nwg, G, c, K; const char* Bt;
    __device__ void init(int M, int N, int K_, const bf16_t* Bt_, int G_, int c_) { nM = M / BM; nN = N / BM; nwg = nM * nN; G = G_; c = c_; K = K_; Bt = (const char*)Bt_; }
    __device__ __forceinline__ bool next(int i, Unit& u) const {
        const long L = (long)i * G + c; if (L >= nwg) return false;
        int wgid = (int)L; { const int q = nwg / NXCD, r = nwg % NXCD, xcd = wgid % NXCD, off = wgid / NXCD; wgid = (xcd < r ? xcd * (q + 1) : r * (q + 1) + (xcd - r) * q) + off; }
        const int nig = WGM * nN, gid = wgid / nig, fm = gid * WGM, gsz = (nM - fm) < WGM ? (nM - fm) : WGM;
        u.pm = fm + ((wgid % nig) % gsz); u.pn = (wgid % nig) / gsz; u.e = 0; u.slot = 0; return true;
    }
    __device__ __forceinline__ const char* bptr(const Unit& u) const { return Bt + (size_t)u.pn * BM * K * 2; }
    __device__ __forceinline__ size_t abase(const Unit& u) const { return (size_t)u.pm * BM * K * 2; }
    __device__ __forceinline__ unsigned aoff(const Unit& u, int h, int R, int C) const { return (unsigned)(((u.pm * BM + h * HALF + R) * K + C) * 2); }
    __device__ __forceinline__ void a_ready(const Unit&) const {}
    __device__ __forceinline__ void done(const Unit&) const {}
};

__device__ __forceinline__ unsigned cvt_pk_bf16(float lo, float hi) { unsigned r; asm volatile("v_cvt_pk_bf16_f32 %0, %1, %2" : "=v"(r) : "v"(lo), "v"(hi)); return r; }
typedef float f32x2 __attribute__((ext_vector_type(2)));
__device__ __forceinline__ f32x2 gelu_pk(f32x2 v) {
    const f32x2 av = __builtin_elementwise_abs(v), d = av * 0.2316418882f + 1.0f;
    f32x2 t; t.x = __builtin_amdgcn_rcpf(d.x); t.y = __builtin_amdgcn_rcpf(d.y);
    f32x2 q = t * 0.5307027145f + (-0.7265760135f); q = q * t + 0.7107068705f; q = q * t + (-0.142248368f); q = q * t + 0.127414796f; q = q * t;
    const f32x2 s = (v * v) * (-0.72134752044f);
    f32x2 e; e.x = __builtin_amdgcn_exp2f(s.x); e.y = __builtin_amdgcn_exp2f(s.y);
    const f32x2 m = v * (q * e), r = v - m;
    f32x2 o; o.x = v.x < 0.f ? m.x : r.x; o.y = v.y < 0.f ? m.y : r.y; return o;
}

template <class Epi, class Sched>
__device__ __forceinline__ void gemm_phase(PG8_LAS unsigned char* lds, const bf16_t* Abase, const int K, const Sched& S, const Epi& E) {
    const int tid = threadIdx.x, wid = __builtin_amdgcn_readfirstlane(tid >> 6), lane = tid & 63, wr = wid >> 2, wc = wid & 3, fr = lane & 15, fq = lane >> 4;
    const int nt = K / BK;
    int sR[2], sC[2]; unsigned voffA[2], voffB[2];
#pragma unroll
    for (int i = 0; i < 2; ++i) { stage_rc(tid * 16 + i * 8192, sR[i], sC[i]); const int Rb = Epi::PERM ? ((sR[i] & ~31) + perm32(sR[i] & 31)) : sR[i];
        voffA[i] = (unsigned)(sR[i] * K + sC[i]) * 2u; voffB[i] = (unsigned)(Rb * K + sC[i]) * 2u; }
    const size_t kstep = (size_t)(BK * 2);
    const size_t hstep = (size_t)HALF * K * 2;
    const unsigned ldsw = (unsigned)wid * 1024u;
    const int aoff = lds_byte(wr * 64 + fr, fq * 8), boff = lds_byte(wc * 32 + fr, fq * 8);
    const char* const Ab = (const char*)Abase;
#define PG8_SA(b, h) (((b) * 2 + (h)) * HTB)
#define PG8_SB(b, h) ((4 + (b) * 2 + (h)) * HTB)
#define PG8_STAGE(bufoff, gbase, voff) do { _Pragma("unroll") for (int _i = 0; _i < 2; ++_i) \
        __builtin_amdgcn_global_load_lds((const unsigned*)((const char*)(gbase) + (voff)[_i]), (PG8_LAS unsigned*)(lds + (bufoff) + ldsw + _i * 8192), 16, 0, 0); } while (0)
#define PG8_STAGE_A(bufoff, nx, h, kt) do { if constexpr (Sched::GATHER) { PG8_STAGE(bufoff, Ab + (size_t)(kt) * kstep, gc[h]); } \
        else PG8_STAGE(bufoff, ((nx) ? xA : cA) + (size_t)(h) * hstep + (size_t)(kt) * kstep, voffA); } while (0)
#define PG8_LDA(dst, b, h) do { _Pragma("unroll") for (int m = 0; m < 4; ++m) _Pragma("unroll") for (int k = 0; k < 2; ++k) dst[m][k] = *(const PG8_LAS bf16x8*)(lds + PG8_SA(b, h) + aoff + m * 2048 + k * 1024); } while (0)
#define PG8_LDB(dst, b, h) do { _Pragma("unroll") for (int n = 0; n < 2; ++n) _Pragma("unroll") for (int k = 0; k < 2; ++k) dst[n][k] = *(const PG8_LAS bf16x8*)(lds + PG8_SB(b, h) + boff + n * 2048 + k * 1024); } while (0)
#define PG8_MMA(ai, bj, At, Bt) do { __builtin_amdgcn_s_setprio(1); _Pragma("unroll") for (int m = 0; m < 4; ++m) _Pragma("unroll") for (int n = 0; n < 2; ++n) _Pragma("unroll") for (int k = 0; k < 2; ++k) \
        acc[ai][bj][m][n] = __builtin_amdgcn_mfma_f32_16x16x32_bf16(Bt[n][k], At[m][k], acc[ai][bj][m][n], 0, 0, 0); __builtin_amdgcn_s_setprio(0); } while (0)
#define PG8_WAIT_V(n) asm volatile("s_waitcnt vmcnt(" #n ")" ::: "memory")
#define PG8_WAIT_L(n) asm volatile("s_waitcnt lgkmcnt(" #n ")" ::: "memory")
#define PG8_BAR __builtin_amdgcn_s_barrier()
#define PG8_SCHED __builtin_amdgcn_sched_barrier(0)
    Unit cur, nxt; int ui = 0;
    if (!S.next(0, cur)) return;
    f32x4 acc[2][2][4][2];
#pragma unroll
    for (int a = 0; a < 2; ++a)
#pragma unroll
        for (int b = 0; b < 2; ++b)
#pragma unroll
            for (int m = 0; m < 4; ++m)
#pragma unroll
                for (int n = 0; n < 2; ++n) acc[a][b][m][n] = (f32x4){0.f, 0.f, 0.f, 0.f};
    bf16x8 At[4][2], B0[2][2], B1[2][2];
    unsigned gc[2][2];
    const char* cA = Ab; const char* xA = Ab;
    if constexpr (Sched::GATHER) {
#pragma unroll
        for (int h = 0; h < 2; ++h)
#pragma unroll
            for (int i = 0; i < 2; ++i) gc[h][i] = S.aoff(cur, h, sR[i], sC[i]);
    } else { cA = Ab + S.abase(cur); xA = cA; }
    const char* cB = S.bptr(cur);
    S.a_ready(cur);
    if constexpr (Epi::RS_DMA) { if (wid == 0) __builtin_amdgcn_global_load_lds((const unsigned*)((const char*)E.rs + (size_t)cur.pm * 1024 + lane * 16), (PG8_LAS unsigned*)(lds + STAGE_BYTES + 512), 16, 0, 0); }
    PG8_STAGE(PG8_SB(0, 0), cB, voffB); PG8_STAGE(PG8_SB(0, 1), cB + hstep, voffB); PG8_STAGE_A(PG8_SA(0, 0), false, 0, 0); PG8_STAGE_A(PG8_SA(0, 1), false, 1, 0);
    if (wr == 1) PG8_BAR;
    PG8_WAIT_V(2); PG8_BAR;
    PG8_STAGE(PG8_SB(1, 0), cB + kstep, voffB); PG8_STAGE_A(PG8_SA(1, 0), false, 0, 1); PG8_STAGE(PG8_SB(1, 1), cB + hstep + kstep, voffB);
    PG8_WAIT_V(6); PG8_BAR;
    for (;;) {
        const bool has_next = S.next(ui + 1, nxt);
        const char* nB = has_next ? S.bptr(nxt) : cB;
        if constexpr (Epi::RS_DMA) { if (has_next && wid == 0) __builtin_amdgcn_global_load_lds((const unsigned*)((const char*)E.rs + (size_t)nxt.pm * 1024 + lane * 16), (PG8_LAS unsigned*)(lds + STAGE_BYTES + 512 + ((ui + 1) % 3) * 1024), 16, 0, 0); }
        for (int t = 0; t < nt; t += 2) {
            const bool last = (t == nt - 2);
            const int kt2 = last ? 0 : t + 2;
            const char* b2 = last ? nB : cB + (size_t)(t + 2) * kstep; const char* b3 = b2 + kstep;
            if (last && has_next) {
                if constexpr (!Sched::GATHER) xA = Ab + S.abase(nxt);
                S.a_ready(nxt);
            }
            PG8_LDB(B0, 0, 0); PG8_LDB(B1, 0, 1); PG8_SCHED; PG8_LDA(At, 0, 0); PG8_STAGE_A(PG8_SA(1, 1), false, 1, t + 1);
            if constexpr (Sched::GATHER) { if (last && has_next) {
#pragma unroll
                for (int h = 0; h < 2; ++h)
#pragma unroll
                    for (int i = 0; i < 2; ++i) gc[h][i] = S.aoff(nxt, h, sR[i], sC[i]); } }
            PG8_WAIT_V(8); PG8_WAIT_L(0); PG8_BAR; PG8_MMA(0, 0, At, B0); PG8_MMA(0, 1, At, B1); PG8_BAR; PG8_SCHED;
            PG8_LDA(At, 0, 1); PG8_STAGE(PG8_SB(0, 0), b2, voffB); PG8_STAGE(PG8_SB(0, 1), b2 + hstep, voffB); PG8_STAGE_A(PG8_SA(0, 0), last, 0, kt2);
            PG8_WAIT_V(8); PG8_WAIT_L(0); PG8_BAR; PG8_MMA(1, 0, At, B0); PG8_MMA(1, 1, At, B1); PG8_BAR; PG8_SCHED;
            PG8_LDB(B0, 1, 0); PG8_LDB(B1, 1, 1); PG8_SCHED; PG8_LDA(At, 1, 0); PG8_STAGE_A(PG8_SA(0, 1), last, 1, kt2);
            PG8_WAIT_V(8); PG8_WAIT_L(0); PG8_BAR; PG8_MMA(0, 0, At, B0); PG8_MMA(0, 1, At, B1); PG8_BAR; PG8_SCHED;
            PG8_LDA(At, 1, 1); PG8_STAGE(PG8_SB(1, 0), b3, voffB); PG8_STAGE(PG8_SB(1, 1), b3 + hstep, voffB); PG8_STAGE_A(PG8_SA(1, 0), last, 0, kt2 + 1);
            PG8_WAIT_V(8); PG8_WAIT_L(0); PG8_BAR; PG8_MMA(1, 0, At, B0); PG8_MMA(1, 1, At, B1); PG8_BAR; PG8_SCHED;
        }
        if (wr == 0) PG8_BAR;
        E(acc, cur, wr, wc, fr, fq, (const PG8_LAS float*)(lds + STAGE_BYTES + 512 + (ui % 3) * 1024)); S.done(cur);
        if (!has_next) break;
#pragma unroll
        for (int a = 0; a < 2; ++a)
#pragma unroll
            for (int b = 0; b < 2; ++b)
#pragma unroll
                for (int m = 0; m < 4; ++m)
#pragma unroll
                    for (int n = 0; n < 2; ++n) acc[a][b][m][n] = (f32x4){0.f, 0.f, 0.f, 0.f};
        cur = nxt; cB = nB; ++ui;
        if constexpr (!Sched::GATHER) cA = xA;
        if (wr == 1) PG8_BAR;
    }
    PG8_WAIT_V(0);
    PG8_BAR;
#undef PG8_STAGE_A
#undef PG8_SA
#undef PG8_SB
#undef PG8_STAGE
#undef PG8_LDA
#undef PG8_LDB
#undef PG8_MMA
#undef PG8_WAIT_V
#undef PG8_WAIT_L
#undef PG8_BAR
#undef PG8_SCHED
}
}
constexpr int LX_PTR = 155648 - 256;
#define FTID ((int)threadIdx.x)
#define FLANE ((int)threadIdx.x & 63)
#define FWAVE ((int)__builtin_amdgcn_readfirstlane((int)threadIdx.x >> 6))
struct Frame {
    LAS unsigned char* lds;
    int G, bid;
    float* out; unsigned char* ws;
    __device__ __forceinline__ const float* inp(int i) const {
        const LAS unsigned* p = (const LAS unsigned*)(lds + LX_PTR) + 2 * i;
        const unsigned lo = __builtin_amdgcn_readfirstlane(p[0]), hi = __builtin_amdgcn_readfirstlane(p[1]);
        return (const float*)(((unsigned long long)hi << 32) | lo);
    }
};
enum { I_X = 0, I_GLA_NORM, I_GLA_WIN, I_GLA_WGU, I_GLA_BG, I_GLA_HG, I_GLA_WOUT, I_SGU_NORM, I_SGU_WIN, I_SGU_LNG, I_SGU_LNB, I_SGU_WS, I_SGU_BS, I_SGU_WOUT,
       I_MOE_NORM, I_MOE_WG, I_MOE_BG, I_MOE_WSUB, I_MOE_BSUB, I_MOE_W1, I_MOE_W3, I_MOE_W2, I_FINAL };
#define WSP(type, off) ((type*)(F.ws + (off)))

__device__ __forceinline__ void n_convert(Frame& F, const float* W, int ldw, int K, int N, const float* kscale, int qcols, float qs, bf16* WT, int rowmap) {
    const size_t total = (size_t)N * K, stride = (size_t)F.G * NTHREADS;
    for (size_t idx = (size_t)F.bid * NTHREADS + FTID; idx < total; idx += stride) {
        const int n = (int)(idx / K), k = (int)(idx % K);
        float v = W[(size_t)k * ldw + n]; if (kscale) v *= kscale[k]; if (n < qcols) v *= qs;
        const int dr = rowmap == 0 ? n : ((n >> 7) * 256 + (n & 127) + (rowmap == 2 ? 128 : 0));
        WT[(size_t)dr * K + k] = (bf16)f2bf(v);
    }
}
__device__ __forceinline__ void n_convert_gla(Frame& F) {
    n_convert(F, F.inp(I_GLA_WIN), GLA_IN, D, NQKVR, F.inp(I_GLA_NORM), HK, 0.08838834764831845f, WSP(bf16, WS_WIN), 0);
    n_convert(F, F.inp(I_GLA_WOUT), D, HV, D, F.inp(I_GLA_HG), 0, 1.f, WSP(bf16, WS_WOUT), 0);
}
__device__ __forceinline__ void n_convert_rest(Frame& F) {
    n_convert(F, F.inp(I_SGU_WIN), SGU_FFN, D, SGU_FFN, F.inp(I_SGU_NORM), 0, 1.f, WSP(bf16, WS_WSIN), 0);
    n_convert(F, F.inp(I_SGU_WOUT), D, SGU_HALF, D, nullptr, 0, 1.f, WSP(bf16, WS_WSOUT), 0);
    for (int le = 0; le < 2 * NE; ++le) {
        const int L = le / NE;
        n_convert(F, F.inp(I_MOE_W1) + (size_t)le * D * FF, FF, D, FF, F.inp(I_MOE_NORM) + L * D, 0, 1.f, WSP(bf16, WS_W13) + (size_t)le * 1024 * 1024, 1);
        n_convert(F, F.inp(I_MOE_W3) + (size_t)le * D * FF, FF, D, FF, F.inp(I_MOE_NORM) + L * D, 0, 1.f, WSP(bf16, WS_W13) + (size_t)le * 1024 * 1024, 2);
        n_convert(F, F.inp(I_MOE_W2) + (size_t)le * FF * D, D, FF, D, nullptr, 0, 1.f, WSP(bf16, WS_W2) + (size_t)le * 1024 * 512, 0);
    }
}

template <int MODE> __device__ __forceinline__ void n_rowpass(Frame& F, int L) {
    const float* src = MODE == 0 ? F.inp(I_X) : F.out;
    bf16* xn = WSP(bf16, WS_XN);
    const bf16* y = WSP(bf16, WS_Y);
    unsigned* ctl = WSP(unsigned, WS_CTL);
    for (int row = F.bid * NWAVES + FWAVE; row < T; row += F.G * NWAVES) {
        f32x4 v[4]; float ss = 0.f;
#pragma unroll
        for (int j = 0; j < 4; ++j) {
            const int k = 4 * FLANE + 256 * j;
            v[j] = *(const f32x4*)(src + (size_t)row * D + k);
            if (MODE >= 2) {
                const v2u a = *(const v2u*)(y + (size_t)row * D + k), b = *(const v2u*)(y + ((size_t)T + row) * D + k);
                v[j].x += bflo(a.x) + bflo(b.x); v[j].y += bfhi(a.x) + bfhi(b.x); v[j].z += bflo(a.y) + bflo(b.y); v[j].w += bfhi(a.y) + bfhi(b.y);
            }
            ss += v[j].x * v[j].x + v[j].y * v[j].y + v[j].z * v[j].z + v[j].w * v[j].w;
        }
        const float rstd = 1.f / sqrtf(wave_sum(ss) * (1.f / D) + EPS);
        if (MODE == 0) {
            const float* gn = F.inp(I_GLA_NORM); const float* w = F.inp(I_GLA_WIN);
            for (int c = 0; c < RANK; ++c) {
                float p = 0.f;
#pragma unroll
                for (int j = 0; j < 4; ++j) { const int k = 4 * FLANE + 256 * j;
                    p += v[j].x * gn[k] * w[(size_t)k * GLA_IN + NQKVR + c] + v[j].y * gn[k + 1] * w[(size_t)(k + 1) * GLA_IN + NQKVR + c]
                       + v[j].z * gn[k + 2] * w[(size_t)(k + 2) * GLA_IN + NQKVR + c] + v[j].w * gn[k + 3] * w[(size_t)(k + 3) * GLA_IN + NQKVR + c]; }
                p = wave_sum(p) * rstd;
                if (FLANE == 0) WSP(float, WS_GLR)[(size_t)row * RANK + c] = p;
            }
        }
        if (MODE == 1) {
            const float* gn = F.inp(I_MOE_NORM) + L * D; const float* wg = F.inp(I_MOE_WG) + (size_t)L * D * 4; const float* wsb = F.inp(I_MOE_WSUB) + (size_t)L * 4 * D * EPG;
            float lg[4], ls[EPG];
            for (int c = 0; c < 4; ++c) { float p = 0.f;
#pragma unroll
                for (int j = 0; j < 4; ++j) { const int k = 4 * FLANE + 256 * j;
                    p += v[j].x * gn[k] * wg[(k) * 4 + c] + v[j].y * gn[k + 1] * wg[(k + 1) * 4 + c] + v[j].z * gn[k + 2] * wg[(k + 2) * 4 + c] + v[j].w * gn[k + 3] * wg[(k + 3) * 4 + c]; }
                lg[c] = wave_sum(p) * rstd + F.inp(I_MOE_BG)[L * 4 + c]; }
            int g = 0; float gm = lg[0];
            for (int c = 1; c < 4; ++c) if (lg[c] > gm) { gm = lg[c]; g = c; }
            float gs = 0.f; for (int c = 0; c < 4; ++c) gs += __expf(lg[c] - gm);
            const float g_w = 1.f / gs;
            for (int e = 0; e < EPG; ++e) { float p = 0.f;
#pragma unroll
                for (int j = 0; j < 4; ++j) { const int k = 4 * FLANE + 256 * j; const float* ww = wsb + ((size_t)g * D + k) * EPG + e;
                    p += v[j].x * gn[k] * ww[0] + v[j].y * gn[k + 1] * ww[EPG] + v[j].z * gn[k + 2] * ww[2 * EPG] + v[j].w * gn[k + 3] * ww[3 * EPG]; }
                ls[e] = wave_sum(p) * rstd + F.inp(I_MOE_BSUB)[(L * 4 + g) * EPG + e]; }
            int i1 = 0; float m1 = ls[0];
            for (int e = 1; e < EPG; ++e) if (ls[e] > m1) { m1 = ls[e]; i1 = e; }
            int i2 = -1; float m2 = -3.0e38f;
            for (int e = 0; e < EPG; ++e) if (e != i1 && ls[e] > m2) { m2 = ls[e]; i2 = e; }
            const float w1 = 1.f / (1.f + __expf(m2 - m1)), w2 = 1.f - w1;
            if (FLANE == 0) {
                const int e1 = g * EPG + i1, e2 = g * EPG + i2;
                WSP(int, WS_EID)[row * 2] = e1; WSP(int, WS_EID)[row * 2 + 1] = e2;
                WSP(float, WS_GATE)[row * 2] = g_w * w1; WSP(float, WS_GATE)[row * 2 + 1] = g_w * w2;
                const unsigned p1 = atomicAdd(&ctl[CW_CNT + L * 2048 + 64 * e1], 1u), p2 = atomicAdd(&ctl[CW_CNT + L * 2048 + 64 * e2], 1u);
                WSP(int, WS_LIST)[(size_t)e1 * T + p1] = row * 2; WSP(int, WS_LIST)[(size_t)e2 * T + p2] = row * 2 + 1;
            }
        }
#pragma unroll
        for (int j = 0; j < 4; ++j) {
            const int k = 4 * FLANE + 256 * j;
            if (MODE == 2) *(f32x4*)(F.out + (size_t)row * D + k) = v[j];
            if (MODE == 3) { const f32x4 g = *(const f32x4*)(F.inp(I_FINAL) + k); *(f32x4*)(F.out + (size_t)row * D + k) = v[j] * rstd * g; }
            else { v2u o; o.x = pk2(v[j].x * rstd, v[j].y * rstd); o.y = pk2(v[j].z * rstd, v[j].w * rstd); *(v2u*)(xn + (size_t)row * D + k) = o; }
        }
    }
}

template <class Fn> __device__ __forceinline__ void n_gemm(Frame& F, const bf16* A, int lda, const bf16* Bt, int ldb, int M, int N, int K, Fn f) {
    LAS float* As = (LAS float*)F.lds; LAS float* Bs = As + 64 * 33;
    const int ntn = N / 64, ntiles = (M / 64) * ntn, ty = FTID >> 4, tx = FTID & 15, lr = FTID >> 3, lc = (FTID & 7) * 4;
    for (int tile = F.bid; tile < ntiles; tile += F.G) {
        const int tm = tile / ntn, tn = tile % ntn;
        float acc[2][4] = {};
        for (int k0 = 0; k0 < K; k0 += 32) {
            const v2u a = *(const v2u*)(A + (size_t)(tm * 64 + lr) * lda + k0 + lc), b = *(const v2u*)(Bt + (size_t)(tn * 64 + lr) * ldb + k0 + lc);
            As[lr * 33 + lc] = bflo(a.x); As[lr * 33 + lc + 1] = bfhi(a.x); As[lr * 33 + lc + 2] = bflo(a.y); As[lr * 33 + lc + 3] = bfhi(a.y);
            Bs[lr * 33 + lc] = bflo(b.x); Bs[lr * 33 + lc + 1] = bfhi(b.x); Bs[lr * 33 + lc + 2] = bflo(b.y); Bs[lr * 33 + lc + 3] = bfhi(b.y);
            __syncthreads();
#pragma unroll 8
            for (int kk = 0; kk < 32; ++kk) {
                const float a0 = As[(2 * ty) * 33 + kk], a1 = As[(2 * ty + 1) * 33 + kk];
#pragma unroll
                for (int i = 0; i < 4; ++i) { const float bb = Bs[(4 * tx + i) * 33 + kk]; acc[0][i] += a0 * bb; acc[1][i] += a1 * bb; }
            }
            __syncthreads();
        }
#pragma unroll
        for (int r = 0; r < 2; ++r)
#pragma unroll
            for (int i = 0; i < 4; ++i) f(tm * 64 + 2 * ty + r, tn * 64 + 4 * tx + i, acc[r][i]);
    }
}

__device__ __forceinline__ void n_scan(Frame& F) {
    LAS float* gl = (LAS float*)F.lds;
    LAS float* kd = gl + 64 * 16;
    LAS float* qs = kd + 64 * 128;
    LAS float* os = qs + 64 * 128;
    LAS float* part = os + 64 * 256;
    LAS float* dec = part + 4 * 128;
    const bf16* qkvr = WSP(bf16, WS_QKVR); const float* glr = WSP(float, WS_GLR); bf16* aout = WSP(bf16, WS_XN);
    for (int item = F.bid; item < NBATCH * GLA_H; item += F.G) {
        const int b = item / GLA_H, h = item % GLA_H;
        float S[64];
#pragma unroll
        for (int i = 0; i < 64; ++i) S[i] = 0.f;
        const int dk = FTID & 127, tg = FTID >> 7, j = FTID & 255, hf = FTID >> 8;
        for (int c = 0; c < NCHUNK; ++c) {
            const size_t t0 = (size_t)b * SEQ + c * CHUNK;
            for (int i = FTID; i < 64 * 16; i += NTHREADS) gl[i] = glr[t0 * RANK + i];
            __syncthreads();
            float wgu[RANK];
#pragma unroll
            for (int r = 0; r < RANK; ++r) wgu[r] = F.inp(I_GLA_WGU)[r * HK + h * DK + dk];
            const float bgv = F.inp(I_GLA_BG)[h * DK + dk];
            float run = 0.f;
            for (int jj = 0; jj < 16; ++jj) {
                const int tok = tg * 16 + jj; float a = bgv;
#pragma unroll
                for (int r = 0; r < RANK; ++r) a += gl[tok * 16 + r] * wgu[r];
                run += logsigmoid_f(a) * (1.f / 16.f);
            }
            part[tg * 128 + dk] = run;
            __syncthreads();
            float off = 0.f, tot = 0.f;
#pragma unroll
            for (int g = 0; g < 4; ++g) { const float pv = part[g * 128 + dk]; if (g < tg) off += pv; tot += pv; }
            run = off;
            for (int jj = 0; jj < 16; ++jj) {
                const int tok = tg * 16 + jj; float a = bgv;
#pragma unroll
                for (int r = 0; r < RANK; ++r) a += gl[tok * 16 + r] * wgu[r];
                run += logsigmoid_f(a) * (1.f / 16.f);
                const float kv = bf2f(qkvr[(t0 + tok) * NQKVR + HK + h * DK + dk]);
                kd[tok * 128 + dk] = kv * __expf(tot - run);
                qs[tok * 128 + dk] = bf2f(qkvr[(t0 + tok) * NQKVR + h * DK + dk]);
            }
            if (tg == 0) dec[dk] = __expf(tot);
            __syncthreads();
#pragma unroll
            for (int ib = 0; ib < 4; ++ib) {
#pragma unroll
                for (int i = 0; i < 16; ++i) S[ib * 16 + i] *= dec[64 * hf + ib * 16 + i];
                asm volatile("" ::: "memory"); }
            for (int s = 0; s < CHUNK; ++s) {
                const float vv = bf2f(qkvr[(t0 + s) * NQKVR + 2 * HK + h * DV + j]);
#pragma unroll
                for (int ib = 0; ib < 4; ++ib) {
#pragma unroll
                    for (int i = 0; i < 16; ++i) S[ib * 16 + i] += kd[s * 128 + 64 * hf + ib * 16 + i] * vv;
                    asm volatile("" ::: "memory"); }
            }
            for (int ph = 0; ph < 2; ++ph) {
                if (hf == ph) {
                    for (int t = 0; t < CHUNK; ++t) {
                        float o = 0.f;
#pragma unroll
                        for (int ib = 0; ib < 4; ++ib) {
#pragma unroll
                            for (int i = 0; i < 16; ++i) o += qs[t * 128 + 64 * hf + ib * 16 + i] * S[ib * 16 + i];
                            asm volatile("" ::: "memory"); }
                        if (ph == 0) os[t * 256 + j] = o; else os[t * 256 + j] += o;
                    }
                }
                __syncthreads();
            }
            {
                const int tok = FTID >> 3, cc = FTID & 7; float ss = 0.f;
                for (int jj = 0; jj < 32; ++jj) { const float o = os[tok * 256 + cc * 32 + jj]; ss += o * o; }
                ss += __shfl_xor(ss, 1); ss += __shfl_xor(ss, 2); ss += __shfl_xor(ss, 4);
                const float rms = 1.f / sqrtf(ss * (1.f / DV) + EPS);
                for (int jj = 0; jj < 32; ++jj) {
                    const int col = h * DV + cc * 32 + jj;
                    const float rr = bf2f(qkvr[(t0 + tok) * NQKVR + 2 * HK + HV + col]);
                    aout[(t0 + tok) * D + col] = (bf16)f2bf(os[tok * 256 + cc * 32 + jj] * rms * silu_f(rr));
                }
            }
            __syncthreads();
        }
    }
}

__device__ __forceinline__ void n_moe(Frame& F, int L) {
    LAS float* xs = (LAS float*)F.lds; LAS float* hl = xs + D;
    const bf16* xn = WSP(bf16, WS_XN); bf16* y = WSP(bf16, WS_Y);
    const bf16* W13 = WSP(bf16, WS_W13) + (size_t)L * NE * 1024 * 1024; const bf16* W2 = WSP(bf16, WS_W2) + (size_t)L * NE * 1024 * 512;
    for (int a = F.bid; a < 2 * T; a += F.G) {
        const int tok = a >> 1, k = a & 1, e = WSP(int, WS_EID)[a]; const float gate = WSP(float, WS_GATE)[a];
        for (int i = FTID; i < D; i += NTHREADS) xs[i] = bf2f(xn[(size_t)tok * D + i]);
        __syncthreads();
        for (int jj = 0; jj < 64; ++jj) {
            const int j = FWAVE * 64 + jj; const bf16* r1 = W13 + ((size_t)e * 1024 + (j >> 7) * 256 + (j & 127)) * 1024; const bf16* r3 = r1 + 128 * 1024;
            float d1 = 0.f, d3 = 0.f;
#pragma unroll
            for (int i = 0; i < 2; ++i) { const int kk = FLANE * 8 + 512 * i; const v4u a1 = *(const v4u*)(r1 + kk), a3 = *(const v4u*)(r3 + kk);
                d1 += xs[kk] * bflo(a1.x) + xs[kk + 1] * bfhi(a1.x) + xs[kk + 2] * bflo(a1.y) + xs[kk + 3] * bfhi(a1.y) + xs[kk + 4] * bflo(a1.z) + xs[kk + 5] * bfhi(a1.z) + xs[kk + 6] * bflo(a1.w) + xs[kk + 7] * bfhi(a1.w);
                d3 += xs[kk] * bflo(a3.x) + xs[kk + 1] * bfhi(a3.x) + xs[kk + 2] * bflo(a3.y) + xs[kk + 3] * bfhi(a3.y) + xs[kk + 4] * bflo(a3.z) + xs[kk + 5] * bfhi(a3.z) + xs[kk + 6] * bflo(a3.w) + xs[kk + 7] * bfhi(a3.w); }
            d1 = wave_sum(d1); d3 = wave_sum(d3);
            if (FLANE == 0) hl[j] = bf2f((bf16)f2bf(silu_f(d1) * d3));
        }
        __syncthreads();
        for (int cc = 0; cc < 128; ++cc) {
            const int c = FWAVE * 128 + cc; const bf16* r2 = W2 + ((size_t)e * 1024 + c) * 512; const int kk = FLANE * 8; const v4u a2 = *(const v4u*)(r2 + kk);
            float d = hl[kk] * bflo(a2.x) + hl[kk + 1] * bfhi(a2.x) + hl[kk + 2] * bflo(a2.y) + hl[kk + 3] * bfhi(a2.y) + hl[kk + 4] * bflo(a2.z) + hl[kk + 5] * bfhi(a2.z) + hl[kk + 6] * bflo(a2.w) + hl[kk + 7] * bfhi(a2.w);
            d = wave_sum(d);
            if (FLANE == 0) y[((size_t)k * T + tok) * D + c] = (bf16)f2bf(gate * d);
        }
        __syncthreads();
    }
}

__device__ __forceinline__ void n_stats(Frame& F) {
    const bf16* v = WSP(bf16, WS_V); float* st = WSP(float, WS_STATS);
    for (size_t it = (size_t)F.bid * NTHREADS + FTID; it < (size_t)T * 32; it += (size_t)F.G * NTHREADS) {
        const int row = (int)(it >> 5), p = (int)(it & 31), pnv = p >> 2, wc = p & 3; float s = 0.f, q = 0.f;
        for (int bj = 0; bj < 2; ++bj) for (int j = 0; j < 32; ++j) { const float x = bf2f(v[(size_t)row * SGU_HALF + pnv * 256 + bj * 128 + wc * 32 + j]); s += x; q += x * x; }
        st[((size_t)p * T + row) * 2] = s; st[((size_t)p * T + row) * 2 + 1] = q;
    }
}
__device__ __forceinline__ void n_mix(Frame& F) {
    LAS float* wl = (LAS float*)F.lds;
    LAS float* vls = wl + 128 * 128;
    LAS float* mu = vls + 128 * 128; LAS float* rs = mu + 128; LAS float* red = rs + 128;
    bf16* u = WSP(bf16, WS_U); const bf16* v = WSP(bf16, WS_V);
    for (int bn = F.bid; bn < T / SGU_BLK; bn += F.G) {
        const size_t t0 = (size_t)bn * SGU_BLK;
        __syncthreads();
        { const int row = FTID >> 2, q4 = FTID & 3; float s = 0.f, q = 0.f;
          for (int i = 0; i < 512; ++i) { const float x = bf2f(v[(t0 + row) * SGU_HALF + q4 * 512 + i]); s += x; q += x * x; }
          red[(row * 4 + q4) * 2] = s; red[(row * 4 + q4) * 2 + 1] = q; }
        __syncthreads();
        if (FTID < 128) { float s = 0.f, q = 0.f; for (int p = 0; p < 4; ++p) { s += red[(FTID * 4 + p) * 2]; q += red[(FTID * 4 + p) * 2 + 1]; }
            const float m = s * (1.f / SGU_HALF); mu[FTID] = m; rs[FTID] = 1.f / sqrtf(q * (1.f / SGU_HALF) - m * m + EPS); }
        for (int g = 0; g < 4; ++g) {
            __syncthreads();
            for (int i = FTID; i < 128 * 128; i += NTHREADS) { const int t = i >> 7, s = i & 127; wl[i] = ((t >> 6) >= (s >> 6)) ? F.inp(I_SGU_WS)[(size_t)g * 128 * 128 + i] : 0.f; }
            for (int cb = 0; cb < 4; ++cb) {
                const int c0 = g * SGU_GC + cb * 128;
                __syncthreads();
                for (int i = FTID; i < 128 * 128; i += NTHREADS) { const int s = i >> 7, c = i & 127;
                    vls[i] = (bf2f(v[(t0 + s) * SGU_HALF + c0 + c]) - mu[s]) * rs[s] * F.inp(I_SGU_LNG)[c0 + c] + F.inp(I_SGU_LNB)[c0 + c]; }
                __syncthreads();
                const int c = FTID & 127, tq = FTID >> 7;
                for (int tt = 0; tt < 32; ++tt) {
                    const int t = tq * 32 + tt; float acc = 0.f;
                    for (int s = 0; s < 128; ++s) acc += wl[t * 128 + s] * vls[s * 128 + c];
                    const float mixed = acc + F.inp(I_SGU_BS)[g * 128 + t];
                    u[(t0 + t) * SGU_HALF + c0 + c] = (bf16)f2bf(bf2f(u[(t0 + t) * SGU_HALF + c0 + c]) * mixed);
                }
            }
        }
    }
}
#define XB_TMO      128
#define XB_XCNT(j)  (256  + 64 * (j))
#define XB_XSUB(j)  (1280 + 64 * (j))
#define XB_XGEN(j)  (2304 + 64 * (j))
#define XB_TOP      3328
#define XB_TOPGEN   3392
#define XCD_BAR_WORDS 3456
#define XB_SPIN_CAP (1u << 18)

__device__ __forceinline__ unsigned xb_ld(unsigned* p)              { return __hip_atomic_load(p, __ATOMIC_RELAXED, __HIP_MEMORY_SCOPE_AGENT); }
__device__ __forceinline__ unsigned xb_add(unsigned* p, unsigned v) { return __hip_atomic_fetch_add(p, v, __ATOMIC_RELAXED, __HIP_MEMORY_SCOPE_AGENT); }
__device__ __forceinline__ unsigned xb_xcc_id() { return (unsigned)__builtin_amdgcn_s_getreg((3 << 11) | 20) & 0xFu; }
#define XB_SPIN(cond, bar) do { unsigned _sp = 0; while (cond) { __builtin_amdgcn_s_sleep(1); \
    if ((++_sp & 255u) == 0u) { if (xb_ld(&(bar)[XB_TMO])) break; if (_sp > XB_SPIN_CAP) { atomicAdd(&(bar)[XB_TMO], 1u); break; } } } } while (0)

struct XcdBarrier {
    unsigned* bar; unsigned x;
    volatile LAS unsigned* st;
};

__device__ __forceinline__ XcdBarrier xcd_barrier_post(unsigned* bar, volatile LAS unsigned* st) {
    XcdBarrier b; b.bar = bar; b.x = xb_xcc_id(); b.st = st;
    if (threadIdx.x == 0) (void)xb_add(&bar[XB_XCNT(b.x)], 1u);
    return b;
}
__device__ __forceinline__ void xcd_barrier_complete(unsigned* bar, unsigned x, unsigned& nloc, unsigned& nx) {
    const unsigned G = gridDim.x * gridDim.y * gridDim.z;
    unsigned sum, cnt, mine, sp = 0u;
    for (;;) {
        sum = 0u; cnt = 0u; mine = 0u;
#pragma unroll
        for (unsigned j = 0; j < 16; ++j) { const unsigned c = xb_ld(&bar[XB_XCNT(j)]); sum += c; cnt += (c > 0u) ? 1u : 0u; mine = (j == x) ? c : mine; }
        if (sum == G) break;
        __builtin_amdgcn_s_sleep(1);
        if ((++sp & 255u) == 0u) { if (xb_ld(&bar[XB_TMO])) break; if (sp > XB_SPIN_CAP) { atomicAdd(&bar[XB_TMO], 1u); break; } }
    }
    nloc = mine > 0u ? mine : 1u; nx = cnt > 0u ? cnt : 1u;
}

__device__ __forceinline__ void xcd_barrier(const XcdBarrier& b) {
    asm volatile("s_waitcnt vmcnt(0)" ::: "memory");
    __syncthreads();
    if (threadIdx.x == 0) {
        unsigned* bar = b.bar;
        __builtin_amdgcn_s_waitcnt(0);
        unsigned nloc = b.st[0], nx = b.st[1];
        if (nloc == 0u) { xcd_barrier_complete(bar, b.x, nloc, nx); b.st[0] = nloc; b.st[1] = nx; }
        const unsigned old = xb_add(&bar[XB_XSUB(b.x)], 1u);
        const unsigned gen = old / nloc;
        if (old + 1u == (gen + 1u) * nloc) {
            __builtin_amdgcn_fence(__ATOMIC_RELEASE, "agent");
            asm volatile("s_waitcnt vmcnt(0)" ::: "memory");
            const unsigned og = xb_add(&bar[XB_TOP], 1u);
            const unsigned tg = og / nx;
            if (og + 1u == (tg + 1u) * nx) xb_add(&bar[XB_TOPGEN], 1u);
            else XB_SPIN(xb_ld(&bar[XB_TOPGEN]) == tg, bar);
            __builtin_amdgcn_fence(__ATOMIC_ACQUIRE, "agent");
            xb_add(&bar[XB_XGEN(b.x)], 1u);
            asm volatile("s_waitcnt vmcnt(0)" ::: "memory");
        } else {
            XB_SPIN(xb_ld(&bar[XB_XGEN(b.x)]) == gen, bar);
            __builtin_amdgcn_fence(__ATOMIC_ACQUIRE, "agent");
            asm volatile("s_waitcnt vmcnt(0)" ::: "memory");
        }
    }
    __syncthreads();
}
constexpr int RING_BYTES = 131072;
constexpr int LX_TST = RING_BYTES;
constexpr int MOE_MAXU = 6;
constexpr int LX_TAB = RING_BYTES + 512;
constexpr int LX_GT = LX_TAB + MOE_MAXU * 1024;

struct EpiStoreBf16 {
    static constexpr bool RS_DMA = true;
    static constexpr bool PERM = true;
    bf16* O; int ldc; const float* rs; int fold; int silu_from;
    __device__ __forceinline__ void operator()(const pg8::f32x4 (&acc)[2][2][4][2], const pg8::Unit& u, int wr, int wc, int fr, int fq, const LAS float* rsl) const {
        const int row0 = (fold ? (int)blockIdx.x : u.pm) * 256 + wr * 64 + fr, col0 = (fold ? 0 : u.pn * 256) + wc * 32 + 8 * fq;
        if (fold == 2) { float sm = 0.f;
#pragma unroll
            for (int ai = 0; ai < 2; ++ai)
#pragma unroll
                for (int bj = 0; bj < 2; ++bj)
#pragma unroll
                    for (int m = 0; m < 4; ++m)
#pragma unroll
                        for (int n = 0; n < 2; ++n) sm += acc[ai][bj][m][n][0] + acc[ai][bj][m][n][1] + acc[ai][bj][m][n][2] + acc[ai][bj][m][n][3];
            if (sm == 1.2345e30f) O[row0] = 1; return; }
#pragma unroll
        for (int ai = 0; ai < 2; ++ai)
#pragma unroll
            for (int m = 0; m < 4; ++m) { const int row = row0 + ai * 128 + m * 16; bf16* rowp = O + (size_t)row * ldc + col0; const float sc = rsl[ai * 128 + wr * 64 + m * 16 + fr];
#pragma unroll
                for (int bj = 0; bj < 2; ++bj) { pg8::f32x4 v0 = acc[ai][bj][m][0] * sc, v1 = acc[ai][bj][m][1] * sc;
                    if (silu_from >= 0 && u.pn >= silu_from) {
#pragma unroll
                        for (int i = 0; i < 4; ++i) { v0[i] = v0[i] * __builtin_amdgcn_rcpf(1.f + __expf(-v0[i])); v1[i] = v1[i] * __builtin_amdgcn_rcpf(1.f + __expf(-v1[i])); } }
                    v4u w; w.x = pg8::cvt_pk_bf16(v0[0], v0[1]); w.y = pg8::cvt_pk_bf16(v0[2], v0[3]); w.z = pg8::cvt_pk_bf16(v1[0], v1[1]); w.w = pg8::cvt_pk_bf16(v1[2], v1[3]);
                    *(v4u*)(rowp + bj * 128) = w; } }
    }
};
struct EpiResBf16 {
    static constexpr bool RS_DMA = false;
    static constexpr bool PERM = true;
    bf16* X; bf16* XO;
    __device__ __forceinline__ void operator()(const pg8::f32x4 (&acc)[2][2][4][2], const pg8::Unit& u, int wr, int wc, int fr, int fq, const LAS float* rsl) const {
        const int row0 = u.pm * 256 + wr * 64 + fr, col0 = u.pn * 256 + wc * 32 + 8 * fq;
#pragma unroll
        for (int ai = 0; ai < 2; ++ai)
#pragma unroll
            for (int m = 0; m < 4; ++m) { bf16* rowp = X + (size_t)(row0 + ai * 128 + m * 16) * D + col0; bf16* rowo = XO + (size_t)(row0 + ai * 128 + m * 16) * D + col0;
#pragma unroll
                for (int bj = 0; bj < 2; ++bj) { const v4u r = *(const v4u*)(rowp + bj * 128); const pg8::f32x4 v0 = acc[ai][bj][m][0], v1 = acc[ai][bj][m][1];
                    v4u w; w.x = pg8::cvt_pk_bf16(bflo(r.x) + v0[0], bfhi(r.x) + v0[1]); w.y = pg8::cvt_pk_bf16(bflo(r.y) + v0[2], bfhi(r.y) + v0[3]);
                    w.z = pg8::cvt_pk_bf16(bflo(r.z) + v1[0], bfhi(r.z) + v1[1]); w.w = pg8::cvt_pk_bf16(bflo(r.w) + v1[2], bfhi(r.w) + v1[3]);
                    *(v4u*)(rowo + bj * 128) = w; } }
    }
};
struct EpiResF32 {
    static constexpr bool RS_DMA = false;
    static constexpr bool PERM = false;
    const float* res; float* out;
    __device__ __forceinline__ void operator()(const pg8::f32x4 (&acc)[2][2][4][2], const pg8::Unit& u, int wr, int wc, int fr, int fq, const LAS float* rsl) const {
        const int row0 = u.pm * 256 + wr * 64 + fr, col0 = u.pn * 256 + wc * 32 + 4 * fq;
#pragma unroll
        for (int ai = 0; ai < 2; ++ai)
#pragma unroll
            for (int m = 0; m < 4; ++m) { const size_t off = (size_t)(row0 + ai * 128 + m * 16) * D + col0;
#pragma unroll
                for (int bj = 0; bj < 2; ++bj)
#pragma unroll
                    for (int n = 0; n < 2; ++n) { const pg8::f32x4 r = *(const pg8::f32x4*)(res + off + bj * 128 + n * 16); *(pg8::f32x4*)(out + off + bj * 128 + n * 16) = r + acc[ai][bj][m][n]; } }
    }
};
struct EpiGeluSplit {
    static constexpr bool RS_DMA = true;
    static constexpr bool PERM = true;
    bf16* U; bf16* V; float* st; const float* rs;
    __device__ __forceinline__ void operator()(const pg8::f32x4 (&acc)[2][2][4][2], const pg8::Unit& u, int wr, int wc, int fr, int fq, const LAS float* rsl) const {
        const bool isv = u.pn >= 8; const int pnl = isv ? u.pn - 8 : u.pn;
        bf16* O = isv ? V : U;
        const int row0 = u.pm * 256 + wr * 64 + fr, col0 = pnl * 256 + wc * 32 + 8 * fq;
#pragma unroll
        for (int ai = 0; ai < 2; ++ai)
#pragma unroll
            for (int m = 0; m < 4; ++m) { const int row = row0 + ai * 128 + m * 16; bf16* rowp = O + (size_t)row * SGU_HALF + col0; float s = 0.f, q = 0.f; const float sc = rsl[ai * 128 + wr * 64 + m * 16 + fr];
#pragma unroll
                for (int bj = 0; bj < 2; ++bj) { const pg8::f32x4 v0 = acc[ai][bj][m][0] * sc, v1 = acc[ai][bj][m][1] * sc;
                    const pg8::f32x2 a = pg8::gelu_pk((pg8::f32x2){v0[0], v0[1]}), b = pg8::gelu_pk((pg8::f32x2){v0[2], v0[3]}), c = pg8::gelu_pk((pg8::f32x2){v1[0], v1[1]}), d = pg8::gelu_pk((pg8::f32x2){v1[2], v1[3]});
                    s += (a.x + a.y) + (b.x + b.y) + (c.x + c.y) + (d.x + d.y);
                    q += (a.x * a.x + a.y * a.y) + (b.x * b.x + b.y * b.y) + (c.x * c.x + c.y * c.y) + (d.x * d.x + d.y * d.y);
                    v4u w; w.x = pg8::cvt_pk_bf16(a.x, a.y); w.y = pg8::cvt_pk_bf16(b.x, b.y); w.z = pg8::cvt_pk_bf16(c.x, c.y); w.w = pg8::cvt_pk_bf16(d.x, d.y);
                    *(v4u*)(rowp + bj * 128) = w; }
                if (isv) { s += __shfl_xor(s, 16); s += __shfl_xor(s, 32); q += __shfl_xor(q, 16); q += __shfl_xor(q, 32);
                    if (fq == 0) { pg8::f32x2 o = {s, q}; *(pg8::f32x2*)(st + ((size_t)(pnl * 4 + wc) * T + row) * 2) = o; } } }
    }
};

__device__ __forceinline__ void f_gemm_in(Frame& F, int fold = 0) {
    pg8::DenseOrder S; S.init(T, NQKVR, D, WSP(bf16, WS_WIN), F.G, F.bid);
    EpiStoreBf16 E{fold ? WSP(bf16, WS_AOUT) : WSP(bf16, WS_QKVR), fold ? 256 : NQKVR, WSP(float, WS_RS), fold, 8};
    pg8::gemm_phase(F.lds, WSP(bf16, WS_XN), D, S, E);
}
__device__ __forceinline__ void f_gemm_out(Frame& F, bf16* xo = nullptr) {
    pg8::DenseOrder S; S.init(T, D, HV, WSP(bf16, WS_WOUT), F.G, F.bid);
    EpiResBf16 E{WSP(bf16, WS_XN), xo ? xo : WSP(bf16, WS_XN)};
    pg8::gemm_phase(F.lds, WSP(bf16, WS_AOUT), HV, S, E);
}
struct RowSetOrder {
    static constexpr bool GATHER = false;
    int nb, c, j0, nunits, K; const char* Bt;
    __device__ __forceinline__ bool next(int i, pg8::Unit& u) const {
        if (c < 0) return false;
        const int q = i * nb + c; if (q >= nunits) return false;
        u.pm = ((q & 63) >> 2) * 8 + j0 + (q >> 6); u.pn = q & 3; u.e = 0; u.slot = 0; return true;
    }
    __device__ __forceinline__ const char* bptr(const pg8::Unit& u) const { return Bt + (size_t)u.pn * 256 * K * 2; }
    __device__ __forceinline__ size_t abase(const pg8::Unit& u) const { return (size_t)u.pm * 256 * K * 2; }
    __device__ __forceinline__ unsigned aoff(const pg8::Unit&, int, int, int) const { return 0u; }
    __device__ __forceinline__ void a_ready(const pg8::Unit&) const {}
    __device__ __forceinline__ void done(const pg8::Unit&) const {}
};
__device__ __forceinline__ void f_gemm_out_rows(Frame& F, int j0, int j1, int boff) {
    RowSetOrder S; S.nb = F.G - boff; S.c = F.bid - boff; S.j0 = j0; S.nunits = (j1 - j0) * 64; S.K = HV; S.Bt = (const char*)WSP(bf16, WS_WOUT);
    EpiResBf16 E{WSP(bf16, WS_XN), WSP(bf16, WS_XN)};
    pg8::gemm_phase(F.lds, WSP(bf16, WS_AOUT), HV, S, E);
}
__device__ __forceinline__ void f_gemm_sgu_in(Frame& F) {
    pg8::DenseOrder S; S.init(T, SGU_FFN, D, WSP(bf16, WS_WSIN), F.G, F.bid);
    EpiGeluSplit E{WSP(bf16, WS_U), WSP(bf16, WS_V), WSP(float, WS_STATS), WSP(float, WS_RS)};
    pg8::gemm_phase(F.lds, WSP(bf16, WS_XN), D, S, E);
}
__device__ __forceinline__ void f_gemm_sgu_out(Frame& F, bf16* xo = nullptr) {
    pg8::DenseOrder S; S.init(T, D, SGU_HALF, WSP(bf16, WS_WSOUT), F.G, F.bid);
    EpiResBf16 E{WSP(bf16, WS_XN), xo ? xo : WSP(bf16, WS_XN)};
    pg8::gemm_phase(F.lds, WSP(bf16, WS_U), SGU_HALF, S, E);
}

template <bool GATHER_> struct MoeOrder {
    static constexpr bool GATHER = GATHER_;
    int G, c, nunits, ibase, K, mode;
    const char* W; size_t estride;
    LAS const int* tst; LAS const int* tab;
    __device__ __forceinline__ bool next(int i, pg8::Unit& u) const {
        if (i >= MOE_MAXU) return false;
        const int Lu = (ibase + i) * G + c; if (Lu >= nunits) return false;
        const int rt = Lu >> 2; int e = 0;
        while (e < NE - 1 && tst[e + 1] <= rt) ++e;
        u.pm = rt; u.pn = Lu & 3; u.e = e; u.slot = i; return true;
    }
    __device__ __forceinline__ const char* bptr(const pg8::Unit& u) const { return W + (size_t)u.e * estride + (size_t)u.pn * 256 * K * 2; }
    __device__ __forceinline__ size_t abase(const pg8::Unit& u) const { return (size_t)u.pm * 256 * K * 2; }
    __device__ __forceinline__ unsigned aoff(const pg8::Unit& u, int h, int R, int C) const {
        if (mode == 0) { int ent = tab[u.slot * 256 + h * 128 + R]; ent = ent < 0 ? 0 : ent; return (unsigned)(((ent >> 1) * K + C) * 2); }
        return (unsigned)(((u.pm * 256 + h * 128 + R) * K + C) * 2);
    }
    __device__ __forceinline__ void a_ready(const pg8::Unit&) const {}
    __device__ __forceinline__ void done(const pg8::Unit&) const {}
};
struct EpiSwiglu {
    static constexpr bool RS_DMA = false;
    static constexpr bool PERM = true;
    bf16* H; LAS const float* gt;
    __device__ __forceinline__ void operator()(const pg8::f32x4 (&acc)[2][2][4][2], const pg8::Unit& u, int wr, int wc, int fr, int fq, const LAS float* rsl) const {
        const int row0 = u.pm * 256 + wr * 64 + fr, col0 = u.pn * 128 + wc * 32 + 8 * fq;
#pragma unroll
        for (int ai = 0; ai < 2; ++ai)
#pragma unroll
            for (int m = 0; m < 4; ++m) { bf16* rowp = H + (size_t)(row0 + ai * 128 + m * 16) * FF + col0; float h[8]; const float sc = gt[u.slot * 256 + ai * 128 + wr * 64 + m * 16 + fr];
#pragma unroll
                for (int n = 0; n < 2; ++n)
#pragma unroll
                    for (int i = 0; i < 4; ++i) { const float a = acc[ai][0][m][n][i] * sc, b = acc[ai][1][m][n][i] * sc; h[n * 4 + i] = a * __builtin_amdgcn_rcpf(1.f + __expf(-a)) * b; }
                v4u w; w.x = pg8::cvt_pk_bf16(h[0], h[1]); w.y = pg8::cvt_pk_bf16(h[2], h[3]); w.z = pg8::cvt_pk_bf16(h[4], h[5]); w.w = pg8::cvt_pk_bf16(h[6], h[7]);
                *(v4u*)rowp = w; }
    }
};
struct EpiScatterY {
    static constexpr bool RS_DMA = false;
    static constexpr bool PERM = true;
    bf16* Y; LAS const int* tab; LAS const float* gt;
    __device__ __forceinline__ void operator()(const pg8::f32x4 (&acc)[2][2][4][2], const pg8::Unit& u, int wr, int wc, int fr, int fq, const LAS float* rsl) const {
        const int col0 = u.pn * 256 + wc * 32 + 8 * fq;
#pragma unroll
        for (int ai = 0; ai < 2; ++ai)
#pragma unroll
            for (int m = 0; m < 4; ++m) { const int r = ai * 128 + wr * 64 + m * 16 + fr; const int ent = tab[u.slot * 256 + r]; const float g = gt[u.slot * 256 + r];
                if (ent >= 0) { bf16* rowp = Y + ((size_t)(ent & 1) * T + (ent >> 1)) * D + col0;
#pragma unroll
                    for (int bj = 0; bj < 2; ++bj) { const pg8::f32x4 v0 = acc[ai][bj][m][0] * g, v1 = acc[ai][bj][m][1] * g;
                        v4u w; w.x = pg8::cvt_pk_bf16(v0[0], v0[1]); w.y = pg8::cvt_pk_bf16(v0[2], v0[3]); w.z = pg8::cvt_pk_bf16(v1[0], v1[1]); w.w = pg8::cvt_pk_bf16(v1[2], v1[3]);
                        *(v4u*)(rowp + bj * 128) = w; } } }
    }
};
template <int MODE> __device__ __forceinline__ void f_moe_gemm(Frame& F, int L) {
    LAS int* tst = (LAS int*)(F.lds + LX_TST); LAS int* cntl = tst + 64; LAS int* tab = (LAS int*)(F.lds + LX_TAB); LAS float* gt = (LAS float*)(F.lds + LX_GT);
    unsigned* ctl = WSP(unsigned, WS_CTL);
    __syncthreads();
    if (FTID < NE) cntl[FTID] = (int)__hip_atomic_load(&ctl[CW_CNT + L * 2048 + 64 * FTID], __ATOMIC_RELAXED, __HIP_MEMORY_SCOPE_AGENT);
    __syncthreads();
    if (FTID == 0) { int s = 0; for (int e = 0; e < NE; ++e) { tst[e] = s; s += (cntl[e] + 255) >> 8; } tst[NE] = s; }
    __syncthreads();
    MoeOrder<MODE == 0> S; S.G = F.G; S.c = F.bid; S.nunits = 4 * tst[NE]; S.K = MODE == 0 ? D : FF; S.mode = MODE; S.tst = tst; S.tab = tab;
    S.W = MODE == 0 ? (const char*)(WSP(bf16, WS_W13) + (size_t)L * NE * 1024 * 1024) : (const char*)(WSP(bf16, WS_W2) + (size_t)L * NE * 1024 * 512);
    S.estride = MODE == 0 ? (size_t)1024 * 1024 * 2 : (size_t)1024 * 512 * 2;
    const int* list = WSP(int, WS_LIST); const float* gates = WSP(float, WS_GATE);
    for (int ibase = 0; ibase * F.G + F.bid < S.nunits; ibase += MOE_MAXU) {
        S.ibase = ibase;
        {
            static_assert(MOE_MAXU == 6, "three table slots per thread half");
            int ents[3]; float gsv[3]; const int r = FTID & 255, hsel = FTID >> 8;
#pragma unroll
            for (int k = 0; k < 3; ++k) { pg8::Unit u; ents[k] = -1;
                if (S.next(2 * k + hsel, u)) { const int idx = (u.pm - tst[u.e]) * 256 + r; if (idx < cntl[u.e]) ents[k] = list[(size_t)u.e * T + idx]; } }
#pragma unroll
            for (int k = 0; k < 3; ++k) gsv[k] = ents[k] >= 0 ? (MODE == 0 ? WSP(float, WS_RS)[ents[k] >> 1] : gates[ents[k]]) : 0.f;
#pragma unroll
            for (int k = 0; k < 3; ++k) { tab[(2 * k + hsel) * 256 + r] = ents[k]; gt[(2 * k + hsel) * 256 + r] = gsv[k]; }
        }
        __syncthreads();
        if (MODE == 0) { EpiSwiglu E{WSP(bf16, WS_HID), gt}; pg8::gemm_phase(F.lds, WSP(bf16, WS_XN), D, S, E); }
        else { EpiScatterY E{WSP(bf16, WS_Y), tab, gt}; pg8::gemm_phase(F.lds, WSP(bf16, WS_HID), FF, S, E); }
        __syncthreads();
    }
}
__device__ __forceinline__ void f_moe1(Frame& F, int L) { f_moe_gemm<0>(F, L); }
__device__ __forceinline__ void f_moe2(Frame& F, int L) { f_moe_gemm<1>(F, L); }
__device__ __forceinline__ void transpose_item(const float* W, int ldw, const float* kscale, float cs, bf16* WT, int K, int dst_row0, LAS float* scr, int k0, int n0, int lane) {
    f32x4 x[8]; float ks[8];
    const int kr = lane >> 3, n4 = (lane & 7) * 4;
#pragma unroll
    for (int i = 0; i < 8; ++i) { x[i] = *(const f32x4*)(W + (size_t)(k0 + 8 * i + kr) * ldw + n0 + n4); ks[i] = kscale ? kscale[k0 + 8 * i + kr] * cs : cs; }
#pragma unroll
    for (int i = 0; i < 8; ++i) { LAS float* d = scr + (8 * i + kr) * 33 + n4; d[0] = x[i][0] * ks[i]; d[1] = x[i][1] * ks[i]; d[2] = x[i][2] * ks[i]; d[3] = x[i][3] * ks[i]; }
    LDS_WAIT(); asm volatile("" ::: "memory");
    const int c = lane & 7;
#pragma unroll
    for (int j = 0; j < 4; ++j) { const int n = (lane >> 3) + 8 * j; const LAS float* s = scr + (8 * c) * 33 + n;
        v4u o; o.x = pk2(s[0 * 33], s[1 * 33]); o.y = pk2(s[2 * 33], s[3 * 33]); o.z = pk2(s[4 * 33], s[5 * 33]); o.w = pk2(s[6 * 33], s[7 * 33]);
        *(v4u*)(WT + (size_t)(dst_row0 + n) * K + k0 + 8 * c) = o; }
    LDS_WAIT(); asm volatile("" ::: "memory");
}
__device__ __forceinline__ void convert_job_item(const float* W, int ldw, int K, int N, const float* kscale, int qcols, float qs, bf16* WT, int rowmap, LAS float* scr, int item, int lane) {
    const int nblk = N / 32, kb = item / nblk, nb = item % nblk, k0 = 64 * kb, n0 = 32 * nb;
    const int dr = rowmap == 0 ? n0 : ((n0 >> 7) * 256 + (n0 & 127) + (rowmap == 2 ? 128 : 0));
    transpose_item(W, ldw, kscale, n0 < qcols ? qs : 1.f, WT, K, dr, scr, k0, n0, lane);
}
__device__ __forceinline__ void f_convert_gla(Frame& F) {
    LAS float* scr = (LAS float*)(F.lds + FWAVE * 8448);
    const int gw = F.bid * NWAVES + FWAVE, NGW = F.G * NWAVES;
    constexpr int I0 = (D / 64) * (NQKVR / 32), I1 = (HV / 64) * (D / 32);
    for (int it = gw; it < I0 + I1; it += NGW) {
        if (it < I0) convert_job_item(F.inp(I_GLA_WIN), GLA_IN, D, NQKVR, F.inp(I_GLA_NORM), HK, 0.08838834764831845f, WSP(bf16, WS_WIN), 0, scr, it, FLANE);
        else convert_job_item(F.inp(I_GLA_WOUT), D, HV, D, F.inp(I_GLA_HG), 0, 1.f, WSP(bf16, WS_WOUT), 0, scr, it - I0, FLANE);
    }
}
__device__ __forceinline__ void f_convert_rest(Frame& F, int cw, int NCW) {
    LAS float* scr = (LAS float*)(F.lds + FWAVE * 8448);
    constexpr int I0 = (D / 64) * (SGU_FFN / 32), I1 = (SGU_HALF / 64) * (D / 32), IE1 = (D / 64) * (FF / 32), IE2 = (FF / 64) * (D / 32);
    constexpr int IM = 2 * NE * IE1;
    static_assert(IE1 == IE2, "w1 / w2 item counts");
    for (int it = cw; it < I0 + I1 + 3 * IM; it += NCW) {
        int r = it;
        if (r < I0) { convert_job_item(F.inp(I_SGU_WIN), SGU_FFN, D, SGU_FFN, F.inp(I_SGU_NORM), 0, 1.f, WSP(bf16, WS_WSIN), 0, scr, r, FLANE); continue; } r -= I0;
        if (r < I1) { convert_job_item(F.inp(I_SGU_WOUT), D, SGU_HALF, D, nullptr, 0, 1.f, WSP(bf16, WS_WSOUT), 0, scr, r, FLANE); continue; } r -= I1;
        const int which = r / IM; r -= which * IM; const int le = r / IE1, li = r % IE1, L = le / NE;
        if (which == 0) convert_job_item(F.inp(I_MOE_W1) + (size_t)le * D * FF, FF, D, FF, F.inp(I_MOE_NORM) + L * D, 0, 1.f, WSP(bf16, WS_W13) + (size_t)le * 1024 * 1024, 1, scr, li, FLANE);
        else if (which == 1) convert_job_item(F.inp(I_MOE_W3) + (size_t)le * D * FF, FF, D, FF, F.inp(I_MOE_NORM) + L * D, 0, 1.f, WSP(bf16, WS_W13) + (size_t)le * 1024 * 1024, 2, scr, li, FLANE);
        else convert_job_item(F.inp(I_MOE_W2) + (size_t)le * FF * D, D, FF, D, nullptr, 0, 1.f, WSP(bf16, WS_W2) + (size_t)le * 1024 * 512, 0, scr, li, FLANE);
    }
}

#ifndef SCAN_DUP
#define SCAN_DUP 0
#endif
constexpr int SC_K = 0, SC_KSTR = 320;
constexpr int SC_V = 20480, SC_VSTR = 576;
constexpr int SC_Q = 57344, SC_QSTR = 272;
constexpr int SC_O = 74752, SC_OSTR = 528;
constexpr int SC_GL = 108544, SC_PART = 112640, SC_DEC = 114688, SC_WG = 115200;
__device__ __forceinline__ s16x4 tr_read16(LAS const unsigned char* p) {
    typedef short v4i16_t __attribute__((ext_vector_type(4)));
    return __builtin_bit_cast(s16x4, __builtin_amdgcn_ds_read_tr16_b64_v4i16((LAS v4i16_t*)p));
}
__device__ __forceinline__ void f_scan_item(Frame& F, int item, const XcdBarrier* xb_ = nullptr, int cbar = -1) {
    const int b = item / GLA_H, h = item % GLA_H;
    const bf16* qkvr = WSP(bf16, WS_QKVR); const float* glr = WSP(float, WS_GLR); bf16* aout = WSP(bf16, WS_AOUT);
    LAS unsigned char* L = F.lds;
    LAS float* gl = (LAS float*)(L + SC_GL); LAS float* part = (LAS float*)(L + SC_PART); LAS float* dec = (LAS float*)(L + SC_DEC);
    const int tid = FTID, lane = FLANE, w = FWAVE;
    const int r32 = lane & 31, hh = lane >> 5, blk = (lane >> 4) & 1, q4 = (lane & 15) >> 2, p4 = lane & 3;
    const int dk = tid & 127, tg = tid >> 7;
    const int gq = lane >> 4, gcol = lane & 15, gdk = 16 * w + gcol;
    bf16x8 gBh, gBl;
    { unsigned ph[4], pl[4];
#pragma unroll
      for (int j = 0; j < 4; ++j) { const float x0 = gq < 2 ? F.inp(I_GLA_WGU)[(8 * gq + 2 * j) * HK + h * DK + gdk] : 0.f, x1 = gq < 2 ? F.inp(I_GLA_WGU)[(8 * gq + 2 * j + 1) * HK + h * DK + gdk] : 0.f;
          ph[j] = pk2(x0, x1); pl[j] = pk2(x0 - bflo(ph[j]), x1 - bfhi(ph[j])); }
      v4u vh = {ph[0], ph[1], ph[2], ph[3]}, vl = {pl[0], pl[1], pl[2], pl[3]};
      gBh = __builtin_bit_cast(bf16x8, vh); gBl = __builtin_bit_cast(bf16x8, vl); }
    const float gbias = F.inp(I_GLA_BG)[h * DK + gdk];
    __syncthreads();
    f32x16 st[4];
#pragma unroll
    for (int i = 0; i < 4; ++i)
#pragma unroll
        for (int j = 0; j < 16; ++j) st[i][j] = 0.f;
    v4u rk[2], rq[2], rv[4]; f32x4 rg;
    const size_t rowb = (size_t)b * SEQ;
    const unsigned vo_kq = (unsigned)(((tid >> 4) * NQKVR + (tid & 15) * 8) * 2), vo_v = (unsigned)(((tid >> 5) * NQKVR + (tid & 31) * 8) * 2), vo_g = (unsigned)(tid * 16);
    const unsigned lo_k = (unsigned)(SC_K + (tid >> 4) * SC_KSTR + (tid & 15) * 16), lo_q = (unsigned)(SC_Q + (tid >> 4) * SC_QSTR + (tid & 15) * 16), lo_v = (unsigned)(SC_V + (tid >> 5) * SC_VSTR + (tid & 31) * 16);
#define SC_LOAD(c) do { size_t cb_ = (rowb + (size_t)(c) * CHUNK) * NQKVR * 2; asm volatile("" : "+s"(cb_)); const char* gb_ = (const char*)qkvr + cb_ + (size_t)(h * DK * 2); \
        _Pragma("unroll") for (int i = 0; i < 2; ++i) { \
            rk[i] = *(const v4u*)(gb_ + (size_t)(HK * 2 + i * 32 * NQKVR * 2) + vo_kq); rq[i] = *(const v4u*)(gb_ + (size_t)(i * 32 * NQKVR * 2) + vo_kq); } \
        _Pragma("unroll") for (int i = 0; i < 4; ++i) rv[i] = *(const v4u*)(gb_ + (size_t)(2 * HK * 2 + h * (DV - DK) * 2 + i * 16 * NQKVR * 2) + vo_v); \
        if (tid < 256) rg = *(const f32x4*)((const char*)glr + (rowb + (size_t)(c) * CHUNK) * RANK * 4 + vo_g); } while (0)
#define SC_STORE() do { \
        _Pragma("unroll") for (int i = 0; i < 2; ++i) { *(LAS v4u*)(L + lo_k + i * 32 * SC_KSTR) = rk[i]; *(LAS v4u*)(L + lo_q + i * 32 * SC_QSTR) = rq[i]; } \
        _Pragma("unroll") for (int i = 0; i < 4; ++i) *(LAS v4u*)(L + lo_v + i * 16 * SC_VSTR) = rv[i]; \
        if (tid < 256) *(LAS f32x4*)(gl + tid * 4) = rg; } while (0)
    SC_LOAD(0);
    SC_STORE();
    for (int c = 0; c < NCHUNK; ++c) {
        if (c == cbar) xcd_barrier(*xb_);
        const size_t t0 = rowb + (size_t)c * CHUNK;
        __syncthreads();
        if (c + 1 < NCHUNK) SC_LOAD(c + 1);
        {
            pg8::f32x4 g4[4]; float tsum[4], pre[4];
#pragma unroll
            for (int t = 0; t < 4; ++t) {
                v4u ah = {0u, 0u, 0u, 0u}, al = {0u, 0u, 0u, 0u};
                if (gq < 2) { const f32x4 x0 = *(const LAS f32x4*)(gl + (16 * t + gcol) * 16 + 8 * gq), x1 = *(const LAS f32x4*)(gl + (16 * t + gcol) * 16 + 8 * gq + 4);
                    ah.x = pk2(x0[0], x0[1]); ah.y = pk2(x0[2], x0[3]); ah.z = pk2(x1[0], x1[1]); ah.w = pk2(x1[2], x1[3]);
                    al.x = pk2(x0[0] - bflo(ah.x), x0[1] - bfhi(ah.x)); al.y = pk2(x0[2] - bflo(ah.y), x0[3] - bfhi(ah.y)); al.z = pk2(x1[0] - bflo(ah.z), x1[1] - bfhi(ah.z)); al.w = pk2(x1[2] - bflo(ah.w), x1[3] - bfhi(ah.w)); }
                pg8::f32x4 a4 = {gbias, gbias, gbias, gbias};
                a4 = __builtin_amdgcn_mfma_f32_16x16x32_bf16(__builtin_bit_cast(bf16x8, ah), gBh, a4, 0, 0, 0);
                a4 = __builtin_amdgcn_mfma_f32_16x16x32_bf16(__builtin_bit_cast(bf16x8, al), gBh, a4, 0, 0, 0);
                a4 = __builtin_amdgcn_mfma_f32_16x16x32_bf16(__builtin_bit_cast(bf16x8, ah), gBl, a4, 0, 0, 0);
#pragma unroll
                for (int i = 0; i < 4; ++i) { const float a = a4[i]; a4[i] = (fminf(a, 0.f) - __logf(1.f + __expf(-fabsf(a)))) * (1.f / 16.f); }
                a4[1] += a4[0]; a4[2] += a4[1]; a4[3] += a4[2];
                g4[t] = a4;
                const float s0 = a4[3], x1 = __shfl_xor(s0, 16), x2 = __shfl_xor(s0, 32), x3 = __shfl_xor(x1, 32);
                tsum[t] = (s0 + x1) + (x2 + x3);
                pre[t] = ((gq ^ 1) < gq ? x1 : 0.f) + ((gq ^ 2) < gq ? x2 : 0.f) + ((gq ^ 3) < gq ? x3 : 0.f);
            }
            const float tot = (tsum[0] + tsum[1]) + (tsum[2] + tsum[3]);
            float basep = 0.f;
#pragma unroll
            for (int t = 0; t < 4; ++t) {
#pragma unroll
                for (int i = 0; i < 4; ++i) {
                    LAS unsigned short* kp = (LAS unsigned short*)(L + SC_K + (16 * t + 4 * gq + i) * SC_KSTR + gdk * 2);
                    *kp = (unsigned short)f2bf(bf2f(*kp) * __expf(tot - (basep + pre[t] + g4[t][i])));
                }
                basep += tsum[t];
            }
            if (gq == 0) dec[gdk] = __expf(tot);
        }
        __syncthreads();
        const int etok = tid >> 3, ecc = tid & 7;
        v4u rr[4];
        { size_t eb_ = t0 * NQKVR * 2; asm volatile("" : "+s"(eb_));
          const char* rb_ = (const char*)qkvr + eb_ + (size_t)((2 * HK + HV + h * DV) * 2); const unsigned vo_r = (unsigned)((etok * NQKVR + ecc * 32) * 2);
#pragma unroll
          for (int i = 0; i < 4; ++i) rr[i] = *(const v4u*)(rb_ + vo_r + i * 16); }
#pragma unroll
        for (int i = 0; i < 4; ++i)
#pragma unroll
            for (int g4 = 0; g4 < 4; ++g4) { const f32x4 d4 = *(const LAS f32x4*)(dec + 32 * i + 8 * g4 + 4 * hh);
#pragma unroll
                for (int j = 0; j < 4; ++j) st[i][4 * g4 + j] *= d4[j]; }
#pragma unroll
        for (int s = 0; s < 4; ++s) {
            const int trow = 16 * s + 8 * hh + q4;
            const s16x4 v0 = tr_read16(L + SC_V + trow * SC_VSTR + (32 * w + 16 * blk + 4 * p4) * 2), v1 = tr_read16(L + SC_V + (trow + 4) * SC_VSTR + (32 * w + 16 * blk + 4 * p4) * 2);
            const bf16x8 Bv = {v0[0], v0[1], v0[2], v0[3], v1[0], v1[1], v1[2], v1[3]};
#pragma unroll
            for (int i = 0; i < 4; ++i) {
                const s16x4 k0 = tr_read16(L + SC_K + trow * SC_KSTR + (32 * i + 16 * blk + 4 * p4) * 2), k1 = tr_read16(L + SC_K + (trow + 4) * SC_KSTR + (32 * i + 16 * blk + 4 * p4) * 2);
                const bf16x8 Ak = {k0[0], k0[1], k0[2], k0[3], k1[0], k1[1], k1[2], k1[3]};
                st[i] = __builtin_amdgcn_mfma_f32_32x32x16_bf16(Ak, Bv, st[i], 0, 0, 0);
            }
            asm volatile("" ::: "memory");
        }
        for (int rep_ = 0; rep_ < ((SCAN_DUP & 1) ? 2 : 1); ++rep_) {
        f32x16 oacc[2];
#pragma unroll
        for (int ot = 0; ot < 2; ++ot)
#pragma unroll
            for (int j = 0; j < 16; ++j) oacc[ot][j] = 0.f;
#pragma unroll
        for (int i = 0; i < 4; ++i)
#pragma unroll
            for (int s2 = 0; s2 < 2; ++s2) {
                v4u pb; pb.x = pk2(st[i][8 * s2 + 0], st[i][8 * s2 + 1]); pb.y = pk2(st[i][8 * s2 + 2], st[i][8 * s2 + 3]); pb.z = pk2(st[i][8 * s2 + 4], st[i][8 * s2 + 5]); pb.w = pk2(st[i][8 * s2 + 6], st[i][8 * s2 + 7]);
                const bf16x8 Bs = __builtin_bit_cast(bf16x8, pb);
#pragma unroll
                for (int ot = 0; ot < 2; ++ot) {
                    LAS const unsigned char* qp = L + SC_Q + (32 * ot + r32) * SC_QSTR + (32 * i + 16 * s2 + 4 * hh) * 2;
                    const v2u a0 = *(const LAS v2u*)qp, a1 = *(const LAS v2u*)(qp + 16);
                    v4u pa; pa.x = a0.x; pa.y = a0.y; pa.z = a1.x; pa.w = a1.y;
                    oacc[ot] = __builtin_amdgcn_mfma_f32_32x32x16_bf16(__builtin_bit_cast(bf16x8, pa), Bs, oacc[ot], 0, 0, 0);
                }
                asm volatile("" ::: "memory");
            }
#pragma unroll
        for (int ot = 0; ot < 2; ++ot)
#pragma unroll
            for (int rg16 = 0; rg16 < 16; ++rg16) {
                const int tok = 32 * ot + (rg16 & 3) + 8 * (rg16 >> 2) + 4 * hh;
                *(LAS unsigned short*)(L + SC_O + tok * SC_OSTR + (32 * w + r32) * 2) = (unsigned short)f2bf(oacc[ot][rg16]);
            }
        }
        __syncthreads();
        if (c + 1 < NCHUNK) SC_STORE();
        for (int rep2_ = 0; rep2_ < ((SCAN_DUP & 2) ? 2 : 1); ++rep2_) {
        {
            const int tok = etok, cc = ecc;
            v4u ov[4]; float ss = 0.f;
#pragma unroll
            for (int i = 0; i < 4; ++i) ov[i] = *(const LAS v4u*)(L + SC_O + tok * SC_OSTR + cc * 64 + i * 16);
#pragma unroll
            for (int i = 0; i < 4; ++i) { const float a0 = bflo(ov[i].x), a1 = bfhi(ov[i].x), a2 = bflo(ov[i].y), a3 = bfhi(ov[i].y), a4 = bflo(ov[i].z), a5 = bfhi(ov[i].z), a6 = bflo(ov[i].w), a7 = bfhi(ov[i].w);
                ss += (a0 * a0 + a1 * a1) + (a2 * a2 + a3 * a3) + (a4 * a4 + a5 * a5) + (a6 * a6 + a7 * a7); }
            ss += __shfl_xor(ss, 1); ss += __shfl_xor(ss, 2); ss += __shfl_xor(ss, 4);
            const float rms = __builtin_amdgcn_rsqf(ss * (1.f / DV) + EPS);
            size_t ob_ = (t0 * D + h * DV) * 2; asm volatile("" : "+s"(ob_)); const unsigned vo_o = (unsigned)((tok * D + cc * 32) * 2);
#pragma unroll
            for (int i = 0; i < 4; ++i) {
                v4u o;
                o.x = pk2(bflo(ov[i].x) * rms * bflo(rr[i].x), bfhi(ov[i].x) * rms * bfhi(rr[i].x));
                o.y = pk2(bflo(ov[i].y) * rms * bflo(rr[i].y), bfhi(ov[i].y) * rms * bfhi(rr[i].y));
                o.z = pk2(bflo(ov[i].z) * rms * bflo(rr[i].z), bfhi(ov[i].z) * rms * bfhi(rr[i].z));
                o.w = pk2(bflo(ov[i].w) * rms * bflo(rr[i].w), bfhi(ov[i].w) * rms * bfhi(rr[i].w));
                *(v4u*)((char*)aout + ob_ + vo_o + i * 16) = o;
            }
        }
            }
    }
    __syncthreads();
#undef SC_LOAD
#undef SC_STORE
}
#ifndef P2_PARTS
#define P2_PARTS 3
#endif
__device__ __forceinline__ void f_scan_convert(Frame& F, int parts = 3) {
    constexpr int NITEM = NBATCH * GLA_H;
    const bool split = F.G >= 2 * NITEM;
    if ((parts & 1) && (!split || F.bid < NITEM)) for (int it = F.bid; it < NITEM; it += F.G) f_scan_item(F, it);
    if (!(parts & 2)) return;
    if (!split) f_convert_rest(F, F.bid * NWAVES + FWAVE, F.G * NWAVES);
    else if (F.bid >= NITEM) f_convert_rest(F, (F.bid - NITEM) * NWAVES + FWAVE, (F.G - NITEM) * NWAVES);
}

constexpr int SCAN_C1 = 20;
__device__ __forceinline__ void f_scan_outproj(Frame& F, const XcdBarrier& xbar) {
    constexpr int NITEM = NBATCH * GLA_H;
    if (F.bid < NITEM) f_scan_item(F, F.bid, &xbar, SCAN_C1);
    else { f_convert_rest(F, (F.bid - NITEM) * NWAVES + FWAVE, (F.G - NITEM) * NWAVES); xcd_barrier(xbar); f_gemm_out_rows(F, 0, SCAN_C1 / 4, NITEM); }
    xcd_barrier(xbar);
    f_gemm_out_rows(F, SCAN_C1 / 4, 8, 0);
}
constexpr int MX_W = 0, MX_WSTR = 272;
constexpr int MX_V0 = 34816, MX_VSTR = 320, MX_VBYTES = 40960;
constexpr int MX_MU = 116736;
__device__ __forceinline__ void f_mix(Frame& F, bf16* uout = nullptr) {
    LAS unsigned char* L = F.lds;
    LAS float* mu = (LAS float*)(L + MX_MU); LAS float* rs = mu + 128; LAS float* m1 = rs + 128; LAS float* m0 = m1 + 128; LAS float* bsg = m0 + 128;
    bf16* u = WSP(bf16, WS_U); const bf16* v = WSP(bf16, WS_V); if (!uout) uout = u; const float* st = WSP(float, WS_STATS);
    const int tid = FTID, lane = FLANE, w = FWAVE;
    const int r32 = lane & 31, hh = lane >> 5, blk = (lane >> 4) & 1, q4 = (lane & 15) >> 2, p4 = lane & 3;
    const int ct = w >> 1, th = w & 1;
    const float* lng = F.inp(I_SGU_LNG); const float* lnb = F.inp(I_SGU_LNB);
    for (int bn = F.bid; bn < T / SGU_BLK; bn += F.G) {
        const size_t t0 = (size_t)bn * SGU_BLK;
        __syncthreads();
        if (tid < 128) { float s = 0.f, q = 0.f;
            for (int p = 0; p < 32; ++p) { const pg8::f32x2 a = *(const pg8::f32x2*)(st + ((size_t)p * T + t0 + tid) * 2); s += a.x; q += a.y; }
            const float m = s * (1.f / SGU_HALF); mu[tid] = m; rs[tid] = 1.f / sqrtf(fmaxf(q * (1.f / SGU_HALF) - m * m, 0.f) + EPS); }
        v4u pre[4];
#define MX_LOAD(g_, cq_) do { size_t vb_ = (t0 * SGU_HALF + (g_) * SGU_GC + (cq_) * 128) * 2; asm volatile("" : "+s"(vb_)); \
        _Pragma("unroll") for (int i = 0; i < 4; ++i) pre[i] = *(const v4u*)((const char*)v + vb_ + (size_t)(i * 32 * SGU_HALF * 2) + (unsigned)(((tid >> 4) * SGU_HALF + (tid & 15) * 8) * 2)); } while (0)
#define MX_STORE(buf_) do { _Pragma("unroll") for (int i = 0; i < 4; ++i) *(LAS v4u*)(L + MX_V0 + (buf_) * MX_VBYTES + ((tid >> 4) + 32 * i) * MX_VSTR + (tid & 15) * 16) = pre[i]; } while (0)
        MX_LOAD(0, 0);
        for (int g = 0; g < 4; ++g) {
            __syncthreads();
            {
                const int t = tid >> 2, sq = tid & 3; const float* wsrc = F.inp(I_SGU_WS) + ((size_t)g * 128 + t) * 128 + sq * 32;
                float a1 = 0.f, a0 = 0.f;
#pragma unroll
                for (int i = 0; i < 4; ++i) {
                    const f32x4 x0 = *(const f32x4*)(wsrc + i * 8), x1 = *(const f32x4*)(wsrc + i * 8 + 4); float wv[8] = {x0[0], x0[1], x0[2], x0[3], x1[0], x1[1], x1[2], x1[3]}; unsigned short hb[8];
#pragma unroll
                    for (int j = 0; j < 8; ++j) { const int s = sq * 32 + i * 8 + j; const float wm = ((t >> 6) >= (s >> 6)) ? wv[j] : 0.f; a0 += wm; hb[j] = (unsigned short)f2bf(wm * rs[s]); a1 += bf2f(hb[j]) * mu[s]; }
                    v4u o; o.x = hb[0] | ((unsigned)hb[1] << 16); o.y = hb[2] | ((unsigned)hb[3] << 16); o.z = hb[4] | ((unsigned)hb[5] << 16); o.w = hb[6] | ((unsigned)hb[7] << 16);
                    *(LAS v4u*)(L + MX_W + t * MX_WSTR + (sq * 32 + i * 8) * 2) = o;
                }
                a1 += __shfl_xor(a1, 1); a1 += __shfl_xor(a1, 2); a0 += __shfl_xor(a0, 1); a0 += __shfl_xor(a0, 2);
                if (sq == 0) { m1[t] = a1; m0[t] = a0; }
                if (tid < 128) bsg[tid] = F.inp(I_SGU_BS)[g * 128 + tid];
            }
            for (int cq = 0; cq < 4; ++cq) {
                const int it = g * 4 + cq, buf = it & 1;
                MX_STORE(buf);
                __syncthreads();
                if (it + 1 < 16) MX_LOAD((it + 1) >> 2, (it + 1) & 3);
                f32x16 acc[2];
#pragma unroll
                for (int tt = 0; tt < 2; ++tt)
#pragma unroll
                    for (int j = 0; j < 16; ++j) acc[tt][j] = 0.f;
                const int cbase = g * SGU_GC + cq * 128 + 32 * ct + 4 * hh;
                v2u uu[2][4]; f32x4 lg4[4], lb4[4];
#pragma unroll
                for (int g4 = 0; g4 < 4; ++g4) { lg4[g4] = *(const f32x4*)(lng + cbase + 8 * g4); lb4[g4] = *(const f32x4*)(lnb + cbase + 8 * g4); }
#pragma unroll
                for (int tt = 0; tt < 2; ++tt)
#pragma unroll
                    for (int g4 = 0; g4 < 4; ++g4) uu[tt][g4] = *(const v2u*)(u + (t0 + 64 * th + 32 * tt + r32) * SGU_HALF + cbase + 8 * g4);
                LAS const unsigned char* Vb = L + MX_V0 + buf * MX_VBYTES;
                const int nks = th == 0 ? 4 : 8;
                for (int ks = 0; ks < nks; ++ks) {
                    const int srow = 16 * ks + 8 * hh + q4;
                    const s16x4 a0 = tr_read16(Vb + srow * MX_VSTR + (32 * ct + 16 * blk + 4 * p4) * 2), a1 = tr_read16(Vb + (srow + 4) * MX_VSTR + (32 * ct + 16 * blk + 4 * p4) * 2);
                    const bf16x8 Av = {a0[0], a0[1], a0[2], a0[3], a1[0], a1[1], a1[2], a1[3]};
#pragma unroll
                    for (int tt = 0; tt < 2; ++tt) {
                        const bf16x8 Bw = *(const LAS bf16x8*)(L + MX_W + (64 * th + 32 * tt + r32) * MX_WSTR + (16 * ks + 8 * hh) * 2);
                        acc[tt] = __builtin_amdgcn_mfma_f32_32x32x16_bf16(Av, Bw, acc[tt], 0, 0, 0);
                    }
                }
#pragma unroll
                for (int tt = 0; tt < 2; ++tt) {
                    const int t = 64 * th + 32 * tt + r32; const float tm1 = m1[t], tm0 = m0[t], tb = bsg[t];
                    bf16* up = uout + (t0 + t) * SGU_HALF + cbase;
#pragma unroll
                    for (int g4 = 0; g4 < 4; ++g4) {
                        const v2u ux = uu[tt][g4]; const f32x4 lg = lg4[g4], lb = lb4[g4];
                        const float o0 = bflo(ux.x) * (lg[0] * (acc[tt][4 * g4 + 0] - tm1) + lb[0] * tm0 + tb), o1 = bfhi(ux.x) * (lg[1] * (acc[tt][4 * g4 + 1] - tm1) + lb[1] * tm0 + tb);
                        const float o2 = bflo(ux.y) * (lg[2] * (acc[tt][4 * g4 + 2] - tm1) + lb[2] * tm0 + tb), o3 = bfhi(ux.y) * (lg[3] * (acc[tt][4 * g4 + 3] - tm1) + lb[3] * tm0 + tb);
                        v2u o; o.x = pk2(o0, o1); o.y = pk2(o2, o3); *(v2u*)(up + 8 * g4) = o;
                    }
                }
            }
        }
#undef MX_LOAD
#undef MX_STORE
    }
}
constexpr int RW_STR = 2064;
constexpr int RW_LG = 48 * RW_STR;
constexpr int RW_HIST = RW_LG + 8 * 16 * 48 * 4;
template <int MODE> __device__ __forceinline__ void f_rowgroup(Frame& F, int Lyr) {
    constexpr int NCT = MODE == 0 ? 1 : 3;
    LAS unsigned char* L = F.lds;
    const int tid = FTID, lane = FLANE, w = FWAVE, rw = lane & 15, q = lane >> 4;
    const float* xsrc = F.inp(I_X);
    bf16* xb = WSP(bf16, WS_XN); float* rsout = WSP(float, WS_RS);
    __syncthreads();
    for (int k = tid; k < D; k += NTHREADS) {
        if (MODE == 0) {
            const float gn = F.inp(I_GLA_NORM)[k]; const float* wr_ = F.inp(I_GLA_WIN) + (size_t)k * GLA_IN + NQKVR;
#pragma unroll
            for (int c4 = 0; c4 < 4; ++c4) { const f32x4 x = *(const f32x4*)(wr_ + 4 * c4);
#pragma unroll
                for (int j = 0; j < 4; ++j) *(LAS unsigned short*)(L + (4 * c4 + j) * RW_STR + k * 2) = (unsigned short)f2bf(x[j] * gn); }
        } else {
            const float gn = F.inp(I_MOE_NORM)[Lyr * D + k];
            const f32x4 xg = *(const f32x4*)(F.inp(I_MOE_WG) + ((size_t)Lyr * D + k) * 4);
#pragma unroll
            for (int j = 0; j < 4; ++j) *(LAS unsigned short*)(L + j * RW_STR + k * 2) = (unsigned short)f2bf(xg[j] * gn);
#pragma unroll
            for (int g = 0; g < 4; ++g) { const float* ws_ = F.inp(I_MOE_WSUB) + (((size_t)Lyr * 4 + g) * D + k) * EPG; const f32x4 a = *(const f32x4*)ws_, b = *(const f32x4*)(ws_ + 4);
#pragma unroll
                for (int j = 0; j < 4; ++j) { *(LAS unsigned short*)(L + (4 + 8 * g + j) * RW_STR + k * 2) = (unsigned short)f2bf(a[j] * gn); *(LAS unsigned short*)(L + (8 + 8 * g + j) * RW_STR + k * 2) = (unsigned short)f2bf(b[j] * gn); } }
#pragma unroll
            for (int c = 36; c < 48; ++c) *(LAS unsigned short*)(L + c * RW_STR + k * 2) = 0;
        }
    }
    LAS int* hist = (LAS int*)(L + RW_HIST); LAS int* hbase = hist + 32;
    if (MODE == 1 && tid < 32) hist[tid] = 0;
    __syncthreads();
    const int ngroups = T / 16, niter = (ngroups + F.G * NWAVES - 1) / (F.G * NWAVES);
    for (int iter = 0; iter < niter; ++iter) {
        const int grp = (iter * F.G + F.bid) * NWAVES + w; const bool valid = grp < ngroups;
        const size_t row = (size_t)grp * 16 + rw;
        float rstd = 0.f; pg8::f32x4 acc[NCT];
        if (valid) {
#pragma unroll
            for (int c = 0; c < NCT; ++c) acc[c] = (pg8::f32x4){0.f, 0.f, 0.f, 0.f};
            float ss = 0.f;
#pragma unroll 8
            for (int s = 0; s < 32; ++s) {
                v4u pa;
                if (MODE == 0) {
                    const float* xr = xsrc + row * D + 8 * q + 32 * s;
                    const f32x4 x0 = *(const f32x4*)xr, x1 = *(const f32x4*)(xr + 4);
                    ss += (x0[0] * x0[0] + x0[1] * x0[1]) + (x0[2] * x0[2] + x0[3] * x0[3]) + (x1[0] * x1[0] + x1[1] * x1[1]) + (x1[2] * x1[2] + x1[3] * x1[3]);
                    pa.x = pk2(x0[0], x0[1]); pa.y = pk2(x0[2], x0[3]); pa.z = pk2(x1[0], x1[1]); pa.w = pk2(x1[2], x1[3]);
                    *(v4u*)(xb + row * D + 8 * q + 32 * s) = pa;
                } else {
                    pa = *(const v4u*)(xb + row * D + 8 * q + 32 * s);
                    const float a0 = bflo(pa.x), a1 = bfhi(pa.x), a2 = bflo(pa.y), a3 = bfhi(pa.y), a4 = bflo(pa.z), a5 = bfhi(pa.z), a6 = bflo(pa.w), a7 = bfhi(pa.w);
                    ss += (a0 * a0 + a1 * a1) + (a2 * a2 + a3 * a3) + (a4 * a4 + a5 * a5) + (a6 * a6 + a7 * a7);
                }
                const bf16x8 A = __builtin_bit_cast(bf16x8, pa);
#pragma unroll
                for (int c = 0; c < NCT; ++c) { const bf16x8 B = *(const LAS bf16x8*)(L + (16 * c + rw) * RW_STR + (32 * s + 8 * q) * 2); acc[c] = __builtin_amdgcn_mfma_f32_16x16x32_bf16(A, B, acc[c], 0, 0, 0); }
            }
            ss += __shfl_xor(ss, 16); ss += __shfl_xor(ss, 32);
            rstd = __builtin_amdgcn_rsqf(ss * (1.f / D) + EPS);
            if (q == 0) rsout[row] = rstd;
        }
        float rs4[4];
#pragma unroll
        for (int i = 0; i < 4; ++i) rs4[i] = __shfl(rstd, 4 * q + i);
        int e1 = 0, e2 = 0, rk1 = 0, rk2 = 0; float gt1 = 0.f, gt2 = 0.f;
        if (MODE == 0) {
            if (valid) {
                float* glr = WSP(float, WS_GLR);
#pragma unroll
                for (int i = 0; i < 4; ++i) glr[((size_t)grp * 16 + 4 * q + i) * RANK + rw] = acc[0][i] * rs4[i];
            }
        } else {
            LAS float* lgw = (LAS float*)(L + RW_LG) + w * 16 * 48;
            if (valid) {
#pragma unroll
                for (int c = 0; c < NCT; ++c)
#pragma unroll
                    for (int i = 0; i < 4; ++i) lgw[(4 * q + i) * 48 + 16 * c + rw] = acc[c][i] * rs4[i];
            }
            LDS_WAIT(); asm volatile("" ::: "memory");
            if (valid && lane < 16) {
                const LAS float* lr = lgw + lane * 48; const float* bg = F.inp(I_MOE_BG) + Lyr * 4;
                float lg[4];
#pragma unroll
                for (int c = 0; c < 4; ++c) lg[c] = lr[c] + bg[c];
                int g = 0; float gm = lg[0];
#pragma unroll
                for (int c = 1; c < 4; ++c) if (lg[c] > gm) { gm = lg[c]; g = c; }
                float gs = 0.f;
#pragma unroll
                for (int c = 0; c < 4; ++c) gs += __expf(lg[c] - gm);
                const float g_w = 1.f / gs; const float* bs = F.inp(I_MOE_BSUB) + (Lyr * 4 + g) * EPG;
                int i1 = 0, i2 = 0; float m1v = -3.0e38f, m2v = -3.0e38f;
                for (int e = 0; e < EPG; ++e) { const float x = lr[4 + 8 * g + e] + bs[e];
                    if (x > m1v) { m2v = m1v; i2 = i1; m1v = x; i1 = e; } else if (x > m2v) { m2v = x; i2 = e; } }
                const float w1 = 1.f / (1.f + __expf(m2v - m1v));
                e1 = g * EPG + i1; e2 = g * EPG + i2; gt1 = g_w * w1; gt2 = g_w * (1.f - w1);
                rk1 = __hip_atomic_fetch_add(&hist[e1], 1, __ATOMIC_RELAXED, __HIP_MEMORY_SCOPE_WORKGROUP); rk2 = __hip_atomic_fetch_add(&hist[e2], 1, __ATOMIC_RELAXED, __HIP_MEMORY_SCOPE_WORKGROUP);
            }
            __syncthreads();
            if (tid < 32) { const int hcount = hist[tid]; hbase[tid] = hcount ? (int)atomicAdd(WSP(unsigned, WS_CTL) + CW_CNT + Lyr * 2048 + 64 * tid, (unsigned)hcount) : 0; hist[tid] = 0; }
            __syncthreads();
            if (valid && lane < 16) {
                const int tok = grp * 16 + lane; const int p1 = hbase[e1] + rk1, p2 = hbase[e2] + rk2;
                WSP(int, WS_LIST)[(size_t)e1 * T + p1] = tok * 2; WSP(int, WS_LIST)[(size_t)e2 * T + p2] = tok * 2 + 1;
                WSP(float, WS_GATE)[tok * 2] = gt1; WSP(float, WS_GATE)[tok * 2 + 1] = gt2;
            }
        }
    }
    __syncthreads();
}
template <bool FINAL> __device__ __forceinline__ void f_rowadd(Frame& F, bool scratch = false) {
    bf16* xb = WSP(bf16, WS_XN); const bf16* y = WSP(bf16, WS_Y); float* rsout = scratch ? (float*)F.out + (size_t)T * 600 : WSP(float, WS_RS); bf16* xo = scratch ? (bf16*)F.out : xb;
    const int lane = FLANE, w = FWAVE;
    f32x4 gf[4];
    if (FINAL) {
#pragma unroll
        for (int j = 0; j < 2; ++j) { gf[2 * j] = *(const f32x4*)(F.inp(I_FINAL) + 8 * lane + 512 * j); gf[2 * j + 1] = *(const f32x4*)(F.inp(I_FINAL) + 8 * lane + 512 * j + 4); }
    }
    for (int r0 = (F.bid * NWAVES + w) * 2; r0 < T; r0 += F.G * NWAVES * 2) {
        v4u xa[2][2], ya[2][2], yb[2][2];
#pragma unroll
        for (int rr = 0; rr < 2; ++rr)
#pragma unroll
            for (int j = 0; j < 2; ++j) { const size_t o = (size_t)(r0 + rr) * D + 8 * lane + 512 * j;
                xa[rr][j] = *(const v4u*)(xb + o); ya[rr][j] = *(const v4u*)(y + o); yb[rr][j] = *(const v4u*)(y + (size_t)T * D + o); }
#pragma unroll
        for (int rr = 0; rr < 2; ++rr) {
            float v[16]; float ss = 0.f;
#pragma unroll
            for (int j = 0; j < 2; ++j) {
                const unsigned xw[4] = {xa[rr][j].x, xa[rr][j].y, xa[rr][j].z, xa[rr][j].w}, aw[4] = {ya[rr][j].x, ya[rr][j].y, ya[rr][j].z, ya[rr][j].w}, bw[4] = {yb[rr][j].x, yb[rr][j].y, yb[rr][j].z, yb[rr][j].w};
#pragma unroll
                for (int e = 0; e < 4; ++e) { const float lo = bflo(xw[e]) + bflo(aw[e]) + bflo(bw[e]), hi = bfhi(xw[e]) + bfhi(aw[e]) + bfhi(bw[e]); v[8 * j + 2 * e] = lo; v[8 * j + 2 * e + 1] = hi; ss += lo * lo + hi * hi; }
            }
            const float rstd = __builtin_amdgcn_rsqf(wave_sum(ss) * (1.f / D) + EPS);
            const size_t ro = (size_t)(r0 + rr) * D + 8 * lane;
            if (FINAL) {
#pragma unroll
                for (int j = 0; j < 2; ++j) {
                    f32x4 o0 = {v[8 * j] * rstd, v[8 * j + 1] * rstd, v[8 * j + 2] * rstd, v[8 * j + 3] * rstd}, o1 = {v[8 * j + 4] * rstd, v[8 * j + 5] * rstd, v[8 * j + 6] * rstd, v[8 * j + 7] * rstd};
                    *(f32x4*)(F.out + ro + 512 * j) = o0 * gf[2 * j]; *(f32x4*)(F.out + ro + 512 * j + 4) = o1 * gf[2 * j + 1]; }
            } else {
#pragma unroll
                for (int j = 0; j < 2; ++j) { v4u o; o.x = pk2(v[8 * j], v[8 * j + 1]); o.y = pk2(v[8 * j + 2], v[8 * j + 3]); o.z = pk2(v[8 * j + 4], v[8 * j + 5]); o.w = pk2(v[8 * j + 6], v[8 * j + 7]); *(v4u*)(xo + ro + 512 * j) = o; }
                if (lane == 0) rsout[r0 + rr] = rstd;
            }
        }
    }
}
__device__ __forceinline__ void f_prep0(Frame& F) { f_convert_gla(F); f_rowgroup<0>(F, 0); }
__device__ __forceinline__ void f_rowpass_router(Frame& F, int L) { f_rowgroup<1>(F, L); }
__device__ __forceinline__ void f_rowpass_add(Frame& F, bool scratch = false) { f_rowadd<false>(F, scratch); }
__device__ __forceinline__ void f_final(Frame& F) { f_rowadd<true>(F); }
constexpr int LDS_BYTES = 155648;
struct Args { const float* in[23]; float* out; unsigned char* ws; int ph_lo, ph_hi; };
#define NAIVE(k) ((NAIVE_MASK >> (k)) & 1u)
#ifndef P1_FOLD
#define P1_FOLD 0
#endif
#ifndef DUP_MASK
#define DUP_MASK 0u
#endif
#define DUP(k) ((DUP_MASK >> (k)) & 1u)

struct EpiN1 { bf16* o; __device__ void operator()(int r, int c, float v) const { o[(size_t)r * NQKVR + c] = (bf16)f2bf(v); } };
struct EpiN3 { const float* res; float* o; __device__ void operator()(int r, int c, float v) const { o[(size_t)r * D + c] = res[(size_t)r * D + c] + v; } };
struct EpiN8 { bf16* u; bf16* v; __device__ void operator()(int r, int c, float x) const { const float z = gelu_erf(x); if (c < SGU_HALF) u[(size_t)r * SGU_HALF + c] = (bf16)f2bf(z); else v[(size_t)r * SGU_HALF + c - SGU_HALF] = (bf16)f2bf(z); } };

__global__ void __launch_bounds__(NTHREADS, 2) fwd(Args args) {
    extern __shared__ __attribute__((aligned(16))) unsigned char lds_raw[];
    Frame F;
    F.lds = (LAS unsigned char*)lds_raw;
    F.G = gridDim.x; F.bid = blockIdx.x;
    F.out = args.out; F.ws = args.ws;
    if (FTID == 0) {
        LAS unsigned long long* pt = (LAS unsigned long long*)(F.lds + LX_PTR);
#pragma unroll
        for (int i = 0; i < 23; ++i) pt[i] = (unsigned long long)args.in[i];
    }
    __syncthreads();
    const int lo = args.ph_lo, hi = args.ph_hi;
#if ONE_LAUNCH
    cg::grid_group grid = cg::this_grid();
    volatile LAS unsigned* bst = (volatile LAS unsigned*)(F.lds + LX_PTR + 192);
    if (FTID < 2) bst[FTID] = 0u;
    __syncthreads();
    const XcdBarrier xbar = xcd_barrier_post(WSP(unsigned, WS_CTL) + CW_BAR, bst);
#define GRID_BAR() xcd_barrier(xbar)
#define GRID_BAR_CG() grid.sync()
#else
#define GRID_BAR_CG() do { } while (0)
#define GRID_BAR() do { } while (0)
#endif
#define IN(k) (lo <= (k) && (k) < hi)
#define SEAM(k) do { if (IN(k) && IN((k) + 1)) GRID_BAR(); } while (0)

    if (IN(0)) {
        if (NAIVE(0)) { n_convert_gla(F); n_rowpass<0>(F, 0); } else { f_prep0(F); if (DUP(0)) { GRID_BAR(); f_prep0(F); } }
    }
    if (IN(0) && IN(1)) GRID_BAR();
    if (lo > 1000) GRID_BAR_CG();
    if (IN(1)) {
        if (NAIVE(1)) n_gemm(F, WSP(bf16, WS_XN), D, WSP(bf16, WS_WIN), D, T, NQKVR, D, EpiN1{WSP(bf16, WS_QKVR)}); else { f_gemm_in(F); if (DUP(1)) { GRID_BAR(); f_gemm_in(F, P1_FOLD); } }
    }
    SEAM(1);
#if ONE_LAUNCH
    if (!NAIVE(2) && !NAIVE(3) && F.G >= 128) { if (IN(2)) f_scan_outproj(F, xbar); }
    else
#endif
    {
    if (IN(2)) {
        if (NAIVE(2)) { n_scan(F); n_convert_rest(F); } else { f_scan_convert(F); if (DUP(2)) { GRID_BAR(); f_scan_convert(F, P2_PARTS); } }
    }
    SEAM(2);
    if (IN(3)) {
        if (NAIVE(3)) n_gemm(F, WSP(bf16, WS_XN), D, WSP(bf16, WS_WOUT), D, T, D, HV, EpiN3{F.inp(I_X), F.out}); else { if (DUP(3)) { f_gemm_out(F, (bf16*)F.out); GRID_BAR(); } f_gemm_out(F); }
    }
    }
    SEAM(3);
#define MOE_BLOCK(L, pb) do { \
        if (IN(pb)) { if (NAIVE(pb)) n_rowpass<1>(F, L); else f_rowpass_router(F, L); } \
        SEAM(pb); \
        if (IN((pb) + 1)) { if (NAIVE((pb) + 1)) n_moe(F, L); else { f_moe1(F, L); if (DUP((pb) + 1)) { GRID_BAR(); f_moe1(F, L); } } } \
        SEAM((pb) + 1); \
        if (IN((pb) + 2)) { if (!NAIVE((pb) + 1)) { f_moe2(F, L); if (DUP((pb) + 2)) { GRID_BAR(); f_moe2(F, L); } } } \
        SEAM((pb) + 2); } while (0)
    MOE_BLOCK(0, 4);
    if (IN(7)) { if (NAIVE(7)) n_rowpass<2>(F, 0); else { if (DUP(7)) { f_rowpass_add(F, true); GRID_BAR(); } f_rowpass_add(F); } }
    SEAM(7);
    if (IN(8)) { if (NAIVE(8)) n_gemm(F, WSP(bf16, WS_XN), D, WSP(bf16, WS_WSIN), D, T, SGU_FFN, D, EpiN8{WSP(bf16, WS_U), WSP(bf16, WS_V)}); else { f_gemm_sgu_in(F); if (DUP(8)) { GRID_BAR(); f_gemm_sgu_in(F); } } }
    if (NAIVE(8)) { SEAM(8); if (IN(9)) n_stats(F); SEAM(9); } else { if (IN(8) && IN(10)) GRID_BAR(); }
    if (IN(10)) { if (NAIVE(10)) n_mix(F); else { if (DUP(10)) { f_mix(F, (bf16*)F.out); GRID_BAR(); } f_mix(F); } }
    SEAM(10);
    if (IN(11)) { if (NAIVE(11)) n_gemm(F, WSP(bf16, WS_U), SGU_HALF, WSP(bf16, WS_WSOUT), SGU_HALF, T, D, SGU_HALF, EpiN3{F.out, F.out}); else { if (DUP(11)) { f_gemm_sgu_out(F, (bf16*)F.out); GRID_BAR(); } f_gemm_sgu_out(F); } }
    SEAM(11);
    MOE_BLOCK(1, 12);
    if (IN(15)) { if (NAIVE(15)) n_rowpass<3>(F, 0); else f_final(F); }
}

extern "C" void kernel_launch(void* const* d_in, const int* in_sizes, int n_in, void* d_out, int out_size, void* d_ws, size_t ws_size, hipStream_t stream) {
    static int grid = 0;
    if (grid == 0) {
        if (n_in != 23 || out_size != T * D || ws_size < WS_END) { fprintf(stderr, "kernel_launch: unexpected shapes (n_in %d out %d ws %zu)\n", n_in, out_size, ws_size); grid = -1; return; }
        int dev = 0, cus = 0, per_cu = 0;
        hipGetDevice(&dev); hipDeviceGetAttribute(&cus, hipDeviceAttributeMultiprocessorCount, dev);
        hipFuncSetAttribute((const void*)fwd, hipFuncAttributeMaxDynamicSharedMemorySize, LDS_BYTES);
        hipOccupancyMaxActiveBlocksPerMultiprocessor(&per_cu, (const void*)fwd, NTHREADS, LDS_BYTES);
        (void)hipGetLastError();
        if (per_cu < 1) { fprintf(stderr, "kernel_launch: occupancy query says %d blocks per CU\n", per_cu); per_cu = 1; }
        grid = cus;
    }
    if (grid < 0) return;
    hipMemsetAsync((char*)d_ws + WS_CTL, 0, CTL_ZERO_BYTES, stream);
    Args a{};
    for (int i = 0; i < 23; ++i) a.in[i] = (const float*)d_in[i];
    a.out = (float*)d_out; a.ws = (unsigned char*)d_ws;
#if ONE_LAUNCH
    a.ph_lo = 0; a.ph_hi = 16;
    void* kargs[] = {&a};
    hipError_t e = hipLaunchCooperativeKernel((const void*)fwd, dim3(grid), dim3(NTHREADS), kargs, LDS_BYTES, stream);
    if (e != hipSuccess) fprintf(stderr, "cooperative launch failed: %s (grid %d)\n", hipGetErrorString(e), grid);
#else
    for (int p = 0; p < 16; ++p) {
        if (p == 9 && !NAIVE(8)) continue;
        if ((p == 6 || p == 14) && NAIVE(p - 1)) continue;
        a.ph_lo = p; a.ph_hi = p + 1;
        hipLaunchKernelGGL(fwd, dim3(grid), dim3(NTHREADS), LDS_BYTES, stream, a);
    }
#endif
}
```

```cpp
#define NAIVE_MASK 0x0u
#define ONE_LAUNCH 1
#include <hip/hip_runtime.h>
#include <hip/hip_cooperative_groups.h>
#include <cstdio>
#include <cstdint>
namespace cg = cooperative_groups;

#ifndef NAIVE_MASK
#define NAIVE_MASK 0x0u
#endif
#ifndef ONE_LAUNCH
#define ONE_LAUNCH 1
#endif

constexpr int T = 32768, D = 1024, NBATCH = 16, SEQ = 2048;
constexpr int GLA_H = 4, DK = 128, DV = 256, HK = 512, HV = 1024, RANK = 16, GLA_IN = 3088, NQKVR = 3072, CHUNK = 64, NCHUNK = 32;
constexpr int SGU_FFN = 4096, SGU_HALF = 2048, SGU_BLK = 128, SGU_GC = 512;
constexpr int NE = 32, EPG = 8, FF = 512;
constexpr float EPS = 1e-6f;
constexpr int NTHREADS = 512, NWAVES = 8;
constexpr int NPHASE = 15;

constexpr size_t MiB = 1u << 20;
constexpr size_t WS_CTL = 0, CTL_ZERO_BYTES = 64 * 1024;
constexpr size_t WS_GLR = 1 * MiB;
constexpr size_t WS_GATE = 3 * MiB;
constexpr size_t WS_EID = 3 * MiB + 512 * 1024;
constexpr size_t WS_STATS = 4 * MiB;
constexpr size_t WS_LIST = 12 * MiB;
constexpr size_t WS_WIN = 16 * MiB;
constexpr size_t WS_WOUT = 22 * MiB;
constexpr size_t WS_WSIN = 24 * MiB;
constexpr size_t WS_WSOUT = 32 * MiB;
constexpr size_t WS_W13 = 36 * MiB;
constexpr size_t WS_W2 = 164 * MiB;
constexpr size_t WS_XN = 228 * MiB;
constexpr size_t WS_AOUT = 484 * MiB;
constexpr size_t WS_RS = 3 * MiB + 256 * 1024;
constexpr size_t WS_QKVR = 292 * MiB;
constexpr size_t WS_HID = 292 * MiB;
constexpr size_t WS_Y = 364 * MiB;
constexpr size_t WS_U = 292 * MiB;
constexpr size_t WS_V = 420 * MiB;
constexpr size_t WS_END = 548 * MiB;
constexpr int CW_BAR = 1024;
constexpr int CW_CNT = 8192;

#define GAS __attribute__((address_space(1)))
#define LAS __attribute__((address_space(3)))
typedef unsigned short bf16;
typedef unsigned v4u __attribute__((ext_vector_type(4)));
typedef unsigned v2u __attribute__((ext_vector_type(2)));
typedef float f32x4 __attribute__((ext_vector_type(4)));
typedef float f32x16 __attribute__((ext_vector_type(16)));
typedef short bf16x8 __attribute__((ext_vector_type(8)));
typedef short s16x4 __attribute__((ext_vector_type(4)));
#define LDS_WAIT() asm volatile("s_waitcnt lgkmcnt(0)" ::: "memory")
#define VM_WAIT() asm volatile("s_waitcnt vmcnt(0)" ::: "memory")
typedef float f32x2_t __attribute__((ext_vector_type(2))); typedef __bf16 bf16x2_t __attribute__((ext_vector_type(2)));
__device__ __forceinline__ unsigned pk2(float lo, float hi) { f32x2_t v = {lo, hi}; bf16x2_t b = __builtin_convertvector(v, bf16x2_t); return __builtin_bit_cast(unsigned, b); }
__device__ __forceinline__ unsigned f2bf(float f) { return pk2(f, 0.f) & 0xffffu; }
__device__ __forceinline__ float bf2f(unsigned short b) { return __builtin_bit_cast(float, (unsigned)b << 16); }
__device__ __forceinline__ float bflo(unsigned w) { return __builtin_bit_cast(float, w << 16); }
__device__ __forceinline__ float bfhi(unsigned w) { return __builtin_bit_cast(float, w & 0xffff0000u); }
__device__ __forceinline__ float wave_sum(float v) {
#pragma unroll
    for (int o = 1; o < 64; o <<= 1) v += __shfl_xor(v, o);
    return v;
}
__device__ __forceinline__ float silu_f(float x) { return x * __builtin_amdgcn_rcpf(1.f + __expf(-x)); }
__device__ __forceinline__ float gelu_erf(float x) { return 0.5f * x * (1.f + erff(x * 0.70710678118654752f)); }
__device__ __forceinline__ float logsigmoid_f(float x) { return fminf(x, 0.f) - log1pf(__expf(-fabsf(x))); }
namespace pg8 {
#define PG8_LAS __attribute__((address_space(3)))
typedef unsigned short bf16_t;
typedef short bf16x8 __attribute__((ext_vector_type(8)));
typedef float f32x4 __attribute__((ext_vector_type(4)));
typedef unsigned u32x4 __attribute__((ext_vector_type(4)));
constexpr int BM = 256, BK = 64, HALF = 128, HTB = HALF * BK * 2  , STAGE_BYTES = 8 * HTB, NXCD = 8, WGM = 8;

__host__ __device__ __forceinline__ int lds_byte(int r, int c) { const int st = (r >> 4) * 2 + (c >> 5), rr = r & 15, cc = c & 31, ob = rr * 64 + cc * 2; return st * 1024 + (ob ^ (((ob >> 9) & 1) << 5)); }
__host__ __device__ __forceinline__ void stage_rc(int b, int& R, int& C) { const int st = b / 1024, sb = b % 1024, swz = sb ^ (((sb >> 9) & 1) << 5); R = (st >> 1) * 16 + swz / 64; C = (st & 1) * 32 + (swz % 64) / 2; }
__host__ __device__ __forceinline__ int perm32(int rho) { const int n = rho >> 4, i = rho & 15; return 8 * (i >> 2) + 4 * n + (i & 3); }

struct Unit { int pm, pn, e, slot; };

struct DenseOrder {
    static constexpr bool GATHER = false;
    int nM, nN, nwg, G, c, K; const char* Bt;
    __device__ void init(int M, int N, int K_, const bf16_t* Bt_, int G_, int c_) { nM = M / BM; nN = N / BM; nwg = nM * nN; G = G_; c = c_; K = K_; Bt = (const char*)Bt_; }
    __device__ __forceinline__ bool next(int i, Unit& u) const {
        const long L = (long)i * G + c; if (L >= nwg) return false;
        int wgid = (int)L; { const int q = nwg / NXCD, r = nwg % NXCD, xcd = wgid % NXCD, off = wgid / NXCD; wgid = (xcd < r ? xcd * (q + 1) : r * (q + 1) + (xcd - r) * q) + off; }
        const int nig = WGM * nN, gid = wgid / nig, fm = gid * WGM, gsz = (nM - fm) < WGM ? (nM - fm) : WGM;
        u.pm = fm + ((wgid % nig) % gsz); u.pn = (wgid % nig) / gsz; u.e = 0; u.slot = 0; return true;
    }
    __device__ __forceinline__ const char* bptr(const Unit& u) const { return Bt + (size_t)u.pn * BM * K * 2; }
    __device__ __forceinline__ size_t abase(const Unit& u) const { return (size_t)u.pm * BM * K * 2; }
    __device__ __forceinline__ unsigned aoff(const Unit& u, int h, int R, int C) const { return (unsigned)(((u.pm * BM + h * HALF + R) * K + C) * 2); }
    __device__ __forceinline__ void a_ready(const Unit&) const {}
    __device__ __forceinline__ void done(const Unit&) const {}
};

__device__ __forceinline__ unsigned cvt_pk_bf16(float lo, float hi) { unsigned r; asm volatile("v_cvt_pk_bf16_f32 %0, %1, %2" : "=v"(r) : "v"(lo), "v"(hi)); return r; }
typedef float f32x2 __attribute__((ext_vector_type(2)));
__device__ __forceinline__ f32x2 gelu_pk(f32x2 v) {
    const f32x2 av = __builtin_elementwise_abs(v), d = av * 0.2316418882f + 1.0f;
    f32x2 t; t.x = __builtin_amdgcn_rcpf(d.x); t.y = __builtin_amdgcn_rcpf(d.y);
    f32x2 q = t * 0.5307027145f + (-0.7265760135f); q = q * t + 0.7107068705f; q = q * t + (-0.142248368f); q = q * t + 0.127414796f; q = q * t;
    const f32x2 s = (v * v) * (-0.72134752044f);
    f32x2 e; e.x = __builtin_amdgcn_exp2f(s.x); e.y = __builtin_amdgcn_exp2f(s.y);
    const f32x2 m = v * (q * e), r = v - m;
    f32x2 o; o.x = v.x < 0.f ? m.x : r.x; o.y = v.y < 0.f ? m.y : r.y; return o;
}

template <class Epi, class Sched>
__device__ __forceinline__ void gemm_phase(PG8_LAS unsigned char* lds, const bf16_t* Abase, const int K, const Sched& S, const Epi& E) {
    const int tid = threadIdx.x, wid = __builtin_amdgcn_readfirstlane(tid >> 6), lane = tid & 63, wr = wid >> 2, wc = wid & 3, fr = lane & 15, fq = lane >> 4;
    const int nt = K / BK;
    int sR[2], sC[2]; unsigned voffA[2], voffB[2];
#pragma unroll
    for (int i = 0; i < 2; ++i) { stage_rc(tid * 16 + i * 8192, sR[i], sC[i]); const int Rb = Epi::PERM ? ((sR[i] & ~31) + perm32(sR[i] & 31)) : sR[i];
        voffA[i] = (unsigned)(sR[i] * K + sC[i]) * 2u; voffB[i] = (unsigned)(Rb * K + sC[i]) * 2u; }
    const size_t kstep = (size_t)(BK * 2);
    const size_t hstep = (size_t)HALF * K * 2;
    const unsigned ldsw = (unsigned)wid * 1024u;
    const int aoff = lds_byte(wr * 64 + fr, fq * 8), boff = lds_byte(wc * 32 + fr, fq * 8);
    const char* const Ab = (const char*)Abase;
#define PG8_SA(b, h) (((b) * 2 + (h)) * HTB)
#define PG8_SB(b, h) ((4 + (b) * 2 + (h)) * HTB)
#define PG8_STAGE(bufoff, gbase, voff) do { _Pragma("unroll") for (int _i = 0; _i < 2; ++_i) \
        __builtin_amdgcn_global_load_lds((const unsigned*)((const char*)(gbase) + (voff)[_i]), (PG8_LAS unsigned*)(lds + (bufoff) + ldsw + _i * 8192), 16, 0, 0); } while (0)
#define PG8_STAGE_A(bufoff, nx, h, kt) do { if constexpr (Sched::GATHER) { PG8_STAGE(bufoff, Ab + (size_t)(kt) * kstep, gc[h]); } \
        else PG8_STAGE(bufoff, ((nx) ? xA : cA) + (size_t)(h) * hstep + (size_t)(kt) * kstep, voffA); } while (0)
#define PG8_LDA(dst, b, h) do { _Pragma("unroll") for (int m = 0; m < 4; ++m) _Pragma("unroll") for (int k = 0; k < 2; ++k) dst[m][k] = *(const PG8_LAS bf16x8*)(lds + PG8_SA(b, h) + aoff + m * 2048 + k * 1024); } while (0)
#define PG8_LDB(dst, b, h) do { _Pragma("unroll") for (int n = 0; n < 2; ++n) _Pragma("unroll") for (int k = 0; k < 2; ++k) dst[n][k] = *(const PG8_LAS bf16x8*)(lds + PG8_SB(b, h) + boff + n * 2048 + k * 1024); } while (0)
#define PG8_MMA(ai, bj, At, Bt) do { __builtin_amdgcn_s_setprio(1); _Pragma("unroll") for (int m = 0; m < 4; ++m) _Pragma("unroll") for (int n = 0; n < 2; ++n) _Pragma("unroll") for (int k = 0; k < 2; ++k) \
        acc[ai][bj][m][n] = __builtin_amdgcn_mfma_f32_16x16x32_bf16(Bt[n][k], At[m][k], acc[ai][bj][m][n], 0, 0, 0); __builtin_amdgcn_s_setprio(0); } while (0)
#define PG8_WAIT_V(n) asm volatile("s_waitcnt vmcnt(" #n ")" ::: "memory")
#define PG8_WAIT_L(n) asm volatile("s_waitcnt lgkmcnt(" #n ")" ::: "memory")
#define PG8_BAR __builtin_amdgcn_s_barrier()
#define PG8_SCHED __builtin_amdgcn_sched_barrier(0)
    Unit cur, nxt; int ui = 0;
    if (!S.next(0, cur)) return;
    f32x4 acc[2][2][4][2];
#pragma unroll
    for (int a = 0; a < 2; ++a)
#pragma unroll
        for (int b = 0; b < 2; ++b)
#pragma unroll
            for (int m = 0; m < 4; ++m)
#pragma unroll
                for (int n = 0; n < 2; ++n) acc[a][b][m][n] = (f32x4){0.f, 0.f, 0.f, 0.f};
    bf16x8 At[4][2], B0[2][2], B1[2][2];
    unsigned gc[2][2];
    const char* cA = Ab; const char* xA = Ab;
    if constexpr (Sched::GATHER) {
#pragma unroll
        for (int h = 0; h < 2; ++h)
#pragma unroll
            for (int i = 0; i < 2; ++i) gc[h][i] = S.aoff(cur, h, sR[i], sC[i]);
    } else { cA = Ab + S.abase(cur); xA = cA; }
    const char* cB = S.bptr(cur);
    S.a_ready(cur);
    if constexpr (Epi::RS_DMA) { if (wid == 0) __builtin_amdgcn_global_load_lds((const unsigned*)((const char*)E.rs + (size_t)cur.pm * 1024 + lane * 16), (PG8_LAS unsigned*)(lds + STAGE_BYTES + 512), 16, 0, 0); }
    PG8_STAGE(PG8_SB(0, 0), cB, voffB); PG8_STAGE(PG8_SB(0, 1), cB + hstep, voffB); PG8_STAGE_A(PG8_SA(0, 0), false, 0, 0); PG8_STAGE_A(PG8_SA(0, 1), false, 1, 0);
    if (wr == 1) PG8_BAR;
    PG8_WAIT_V(2); PG8_BAR;
    PG8_STAGE(PG8_SB(1, 0), cB + kstep, voffB); PG8_STAGE_A(PG8_SA(1, 0), false, 0, 1); PG8_STAGE(PG8_SB(1, 1), cB + hstep + kstep, voffB);
    PG8_WAIT_V(6); PG8_BAR;
    for (;;) {
        const bool has_next = S.next(ui + 1, nxt);
        const char* nB = has_next ? S.bptr(nxt) : cB;
        if constexpr (Epi::RS_DMA) { if (has_next && wid == 0) __builtin_amdgcn_global_load_lds((const unsigned*)((const char*)E.rs + (size_t)nxt.pm * 1024 + lane * 16), (PG8_LAS unsigned*)(lds + STAGE_BYTES + 512 + ((ui + 1) % 3) * 1024), 16, 0, 0); }
        for (int t = 0; t < nt; t += 2) {
            const bool last = (t == nt - 2);
            const int kt2 = last ? 0 : t + 2;
            const char* b2 = last ? nB : cB + (size_t)(t + 2) * kstep; const char* b3 = b2 + kstep;
            if (last && has_next) {
                if constexpr (!Sched::GATHER) xA = Ab + S.abase(nxt);
                S.a_ready(nxt);
            }
            PG8_LDB(B0, 0, 0); PG8_LDB(B1, 0, 1); PG8_SCHED; PG8_LDA(At, 0, 0); PG8_STAGE_A(PG8_SA(1, 1), false, 1, t + 1);
            if constexpr (Sched::GATHER) { if (last && has_next) {
#pragma unroll
                for (int h = 0; h < 2; ++h)
#pragma unroll
                    for (int i = 0; i < 2; ++i) gc[h][i] = S.aoff(nxt, h, sR[i], sC[i]); } }
            PG8_WAIT_V(8); PG8_WAIT_L(0); PG8_BAR; PG8_MMA(0, 0, At, B0); PG8_MMA(0, 1, At, B1); PG8_BAR; PG8_SCHED;
            PG8_LDA(At, 0, 1); PG8_STAGE(PG8_SB(0, 0), b2, voffB); PG8_STAGE(PG8_SB(0, 1), b2 + hstep, voffB); PG8_STAGE_A(PG8_SA(0, 0), last, 0, kt2);
            PG8_WAIT_V(8); PG8_WAIT_L(0); PG8_BAR; PG8_MMA(1, 0, At, B0); PG8_MMA(1, 1, At, B1); PG8_BAR; PG8_SCHED;
            PG8_LDB(B0, 1, 0); PG8_LDB(B1, 1, 1); PG8_SCHED; PG8_LDA(At, 1, 0); PG8_STAGE_A(PG8_SA(0, 1), last, 1, kt2);
            PG8_WAIT_V(8); PG8_WAIT_L(0); PG8_BAR; PG8_MMA(0, 0, At, B0); PG8_MMA(0, 1, At, B1); PG8_BAR; PG8_SCHED;
            PG8_LDA(At, 1, 1); PG8_STAGE(PG8_SB(1, 0), b3, voffB); PG8_STAGE(PG8_SB(1, 1), b3 + hstep, voffB); PG8_STAGE_A(PG8_SA(1, 0), last, 0, kt2 + 1);
            PG8_WAIT_V(8); PG8_WAIT_L(0); PG8_BAR; PG8_MMA(1, 0, At, B0); PG8_MMA(1, 1, At, B1); PG8_BAR; PG8_SCHED;
        }
        if (wr == 0) PG8_BAR;
        E(acc, cur, wr, wc, fr, fq, (const PG8_LAS float*)(lds + STAGE_BYTES + 512 + (ui % 3) * 1024)); S.done(cur);
        if (!has_next) break;
#pragma unroll
        for (int a = 0; a < 2; ++a)
#pragma unroll
            for (int b = 0; b < 2; ++b)
#pragma unroll
                for (int m = 0; m < 4; ++m)
#pragma unroll
                    for (int n = 0; n < 2; ++n) acc[a][b][m][n] = (f32x4){0.f, 0.f, 0.f, 0.f};
        cur = nxt; cB = nB; ++ui;
        if constexpr (!Sched::GATHER) cA = xA;
        if (wr == 1) PG8_BAR;
    }
    PG8_WAIT_V(0);
    PG8_BAR;
#undef PG8_STAGE_A
#undef PG8_SA
#undef PG8_SB
#undef PG8_STAGE
#undef PG8_LDA
#undef PG8_LDB
#undef PG8_MMA
#undef PG8_WAIT_V
#undef PG8_WAIT_L
#undef PG8_BAR
#undef PG8_SCHED
}
}
constexpr int LX_PTR = 155648 - 256;
#define FTID ((int)threadIdx.x)
#define FLANE ((int)threadIdx.x & 63)
#define FWAVE ((int)__builtin_amdgcn_readfirstlane((int)threadIdx.x >> 6))
struct Frame {
    LAS unsigned char* lds;
    int G, bid;
    float* out; unsigned char* ws;
    __device__ __forceinline__ const float* inp(int i) const {
        const LAS unsigned* p = (const LAS unsigned*)(lds + LX_PTR) + 2 * i;
        const unsigned lo = __builtin_amdgcn_readfirstlane(p[0]), hi = __builtin_amdgcn_readfirstlane(p[1]);
        return (const float*)(((unsigned long long)hi << 32) | lo);
    }
};
enum { I_X = 0, I_GLA_NORM, I_GLA_WIN, I_GLA_WGU, I_GLA_BG, I_GLA_HG, I_GLA_WOUT, I_SGU_NORM, I_SGU_WIN, I_SGU_LNG, I_SGU_LNB, I_SGU_WS, I_SGU_BS, I_SGU_WOUT,
       I_MOE_NORM, I_MOE_WG, I_MOE_BG, I_MOE_WSUB, I_MOE_BSUB, I_MOE_W1, I_MOE_W3, I_MOE_W2, I_FINAL };
#define WSP(type, off) ((type*)(F.ws + (off)))

__device__ __forceinline__ void n_convert(Frame& F, const float* W, int ldw, int K, int N, const float* kscale, int qcols, float qs, bf16* WT, int rowmap) {
    const size_t total = (size_t)N * K, stride = (size_t)F.G * NTHREADS;
    for (size_t idx = (size_t)F.bid * NTHREADS + FTID; idx < total; idx += stride) {
        const int n = (int)(idx / K), k = (int)(idx % K);
        float v = W[(size_t)k * ldw + n]; if (kscale) v *= kscale[k]; if (n < qcols) v *= qs;
        const int dr = rowmap == 0 ? n : ((n >> 7) * 256 + (n & 127) + (rowmap == 2 ? 128 : 0));
        WT[(size_t)dr * K + k] = (bf16)f2bf(v);
    }
}
__device__ __forceinline__ void n_convert_gla(Frame& F) {
    n_convert(F, F.inp(I_GLA_WIN), GLA_IN, D, NQKVR, F.inp(I_GLA_NORM), HK, 0.08838834764831845f, WSP(bf16, WS_WIN), 0);
    n_convert(F, F.inp(I_GLA_WOUT), D, HV, D, F.inp(I_GLA_HG), 0, 1.f, WSP(bf16, WS_WOUT), 0);
}
__device__ __forceinline__ void n_convert_rest(Frame& F) {
    n_convert(F, F.inp(I_SGU_WIN), SGU_FFN, D, SGU_FFN, F.inp(I_SGU_NORM), 0, 1.f, WSP(bf16, WS_WSIN), 0);
    n_convert(F, F.inp(I_SGU_WOUT), D, SGU_HALF, D, nullptr, 0, 1.f, WSP(bf16, WS_WSOUT), 0);
    for (int le = 0; le < 2 * NE; ++le) {
        const int L = le / NE;
        n_convert(F, F.inp(I_MOE_W1) + (size_t)le * D * FF, FF, D, FF, F.inp(I_MOE_NORM) + L * D, 0, 1.f, WSP(bf16, WS_W13) + (size_t)le * 1024 * 1024, 1);
        n_convert(F, F.inp(I_MOE_W3) + (size_t)le * D * FF, FF, D, FF, F.inp(I_MOE_NORM) + L * D, 0, 1.f, WSP(bf16, WS_W13) + (size_t)le * 1024 * 1024, 2);
        n_convert(F, F.inp(I_MOE_W2) + (size_t)le * FF * D, D, FF, D, nullptr, 0, 1.f, WSP(bf16, WS_W2) + (size_t)le * 1024 * 512, 0);
    }
}

template <int MODE> __device__ __forceinline__ void n_rowpass(Frame& F, int L) {
    const float* src = MODE == 0 ? F.inp(I_X) : F.out;
    bf16* xn = WSP(bf16, WS_XN);
    const bf16* y = WSP(bf16, WS_Y);
    unsigned* ctl = WSP(unsigned, WS_CTL);
    for (int row = F.bid * NWAVES + FWAVE; row < T; row += F.G * NWAVES) {
        f32x4 v[4]; float ss = 0.f;
#pragma unroll
        for (int j = 0; j < 4; ++j) {
            const int k = 4 * FLANE + 256 * j;
            v[j] = *(const f32x4*)(src + (size_t)row * D + k);
            if (MODE >= 2) {
                const v2u a = *(const v2u*)(y + (size_t)row * D + k), b = *(const v2u*)(y + ((size_t)T + row) * D + k);
                v[j].x += bflo(a.x) + bflo(b.x); v[j].y += bfhi(a.x) + bfhi(b.x); v[j].z += bflo(a.y) + bflo(b.y); v[j].w += bfhi(a.y) + bfhi(b.y);
            }
            ss += v[j].x * v[j].x + v[j].y * v[j].y + v[j].z * v[j].z + v[j].w * v[j].w;
        }
        const float rstd = 1.f / sqrtf(wave_sum(ss) * (1.f / D) + EPS);
        if (MODE == 0) {
            const float* gn = F.inp(I_GLA_NORM); const float* w = F.inp(I_GLA_WIN);
            for (int c = 0; c < RANK; ++c) {
                float p = 0.f;
#pragma unroll
                for (int j = 0; j < 4; ++j) { const int k = 4 * FLANE + 256 * j;
                    p += v[j].x * gn[k] * w[(size_t)k * GLA_IN + NQKVR + c] + v[j].y * gn[k + 1] * w[(size_t)(k + 1) * GLA_IN + NQKVR + c]
                       + v[j].z * gn[k + 2] * w[(size_t)(k + 2) * GLA_IN + NQKVR + c] + v[j].w * gn[k + 3] * w[(size_t)(k + 3) * GLA_IN + NQKVR + c]; }
                p = wave_sum(p) * rstd;
                if (FLANE == 0) WSP(float, WS_GLR)[(size_t)row * RANK + c] = p;
            }
        }
        if (MODE == 1) {
            const float* gn = F.inp(I_MOE_NORM) + L * D; const float* wg = F.inp(I_MOE_WG) + (size_t)L * D * 4; const float* wsb = F.inp(I_MOE_WSUB) + (size_t)L * 4 * D * EPG;
            float lg[4], ls[EPG];
            for (int c = 0; c < 4; ++c) { float p = 0.f;
#pragma unroll
                for (int j = 0; j < 4; ++j) { const int k = 4 * FLANE + 256 * j;
                    p += v[j].x * gn[k] * wg[(k) * 4 + c] + v[j].y * gn[k + 1] * wg[(k + 1) * 4 + c] + v[j].z * gn[k + 2] * wg[(k + 2) * 4 + c] + v[j].w * gn[k + 3] * wg[(k + 3) * 4 + c]; }
                lg[c] = wave_sum(p) * rstd + F.inp(I_MOE_BG)[L * 4 + c]; }
            int g = 0; float gm = lg[0];
            for (int c = 1; c < 4; ++c) if (lg[c] > gm) { gm = lg[c]; g = c; }
            float gs = 0.f; for (int c = 0; c < 4; ++c) gs += __expf(lg[c] - gm);
            const float g_w = 1.f / gs;
            for (int e = 0; e < EPG; ++e) { float p = 0.f;
#pragma unroll
                for (int j = 0; j < 4; ++j) { const int k = 4 * FLANE + 256 * j; const float* ww = wsb + ((size_t)g * D + k) * EPG + e;
                    p += v[j].x * gn[k] * ww[0] + v[j].y * gn[k + 1] * ww[EPG] + v[j].z * gn[k + 2] * ww[2 * EPG] + v[j].w * gn[k + 3] * ww[3 * EPG]; }
                ls[e] = wave_sum(p) * rstd + F.inp(I_MOE_BSUB)[(L * 4 + g) * EPG + e]; }
            int i1 = 0; float m1 = ls[0];
            for (int e = 1; e < EPG; ++e) if (ls[e] > m1) { m1 = ls[e]; i1 = e; }
            int i2 = -1; float m2 = -3.0e38f;
            for (int e = 0; e < EPG; ++e) if (e != i1 && ls[e] > m2) { m2 = ls[e]; i2 = e; }
            const float w1 = 1.f / (1.f + __expf(m2 - m1)), w2 = 1.f - w1;
            if (FLANE == 0) {
                const int e1 = g * EPG + i1, e2 = g * EPG + i2;
                WSP(int, WS_EID)[row * 2] = e1; WSP(int, WS_EID)[row * 2 + 1] = e2;
                WSP(float, WS_GATE)[row * 2] = g_w * w1; WSP(float, WS_GATE)[row * 2 + 1] = g_w * w2;
                const unsigned p1 = atomicAdd(&ctl[CW_CNT + L * 2048 + 64 * e1], 1u), p2 = atomicAdd(&ctl[CW_CNT + L * 2048 + 64 * e2], 1u);
                WSP(int, WS_LIST)[(size_t)e1 * T + p1] = row * 2; WSP(int, WS_LIST)[(size_t)e2 * T + p2] = row * 2 + 1;
            }
        }
#pragma unroll
        for (int j = 0; j < 4; ++j) {
            const int k = 4 * FLANE + 256 * j;
            if (MODE == 2) *(f32x4*)(F.out + (size_t)row * D + k) = v[j];
            if (MODE == 3) { const f32x4 g = *(const f32x4*)(F.inp(I_FINAL) + k); *(f32x4*)(F.out + (size_t)row * D + k) = v[j] * rstd * g; }
            else { v2u o; o.x = pk2(v[j].x * rstd, v[j].y * rstd); o.y = pk2(v[j].z * rstd, v[j].w * rstd); *(v2u*)(xn + (size_t)row * D + k) = o; }
        }
    }
}

template <class Fn> __device__ __forceinline__ void n_gemm(Frame& F, const bf16* A, int lda, const bf16* Bt, int ldb, int M, int N, int K, Fn f) {
    LAS float* As = (LAS float*)F.lds; LAS float* Bs = As + 64 * 33;
    const int ntn = N / 64, ntiles = (M / 64) * ntn, ty = FTID >> 4, tx = FTID & 15, lr = FTID >> 3, lc = (FTID & 7) * 4;
    for (int tile = F.bid; tile < ntiles; tile += F.G) {
        const int tm = tile / ntn, tn = tile % ntn;
        float acc[2][4] = {};
        for (int k0 = 0; k0 < K; k0 += 32) {
            const v2u a = *(const v2u*)(A + (size_t)(tm * 64 + lr) * lda + k0 + lc), b = *(const v2u*)(Bt + (size_t)(tn * 64 + lr) * ldb + k0 + lc);
            As[lr * 33 + lc] = bflo(a.x); As[lr * 33 + lc + 1] = bfhi(a.x); As[lr * 33 + lc + 2] = bflo(a.y); As[lr * 33 + lc + 3] = bfhi(a.y);
            Bs[lr * 33 + lc] = bflo(b.x); Bs[lr * 33 + lc + 1] = bfhi(b.x); Bs[lr * 33 + lc + 2] = bflo(b.y); Bs[lr * 33 + lc + 3] = bfhi(b.y);
            __syncthreads();
#pragma unroll 8
            for (int kk = 0; kk < 32; ++kk) {
                const float a0 = As[(2 * ty) * 33 + kk], a1 = As[(2 * ty + 1) * 33 + kk];
#pragma unroll
                for (int i = 0; i < 4; ++i) { const float bb = Bs[(4 * tx + i) * 33 + kk]; acc[0][i] += a0 * bb; acc[1][i] += a1 * bb; }
            }
            __syncthreads();
        }
#pragma unroll
        for (int r = 0; r < 2; ++r)
#pragma unroll
            for (int i = 0; i < 4; ++i) f(tm * 64 + 2 * ty + r, tn * 64 + 4 * tx + i, acc[r][i]);
    }
}

__device__ __forceinline__ void n_scan(Frame& F) {
    LAS float* gl = (LAS float*)F.lds;
    LAS float* kd = gl + 64 * 16;
    LAS float* qs = kd + 64 * 128;
    LAS float* os = qs + 64 * 128;
    LAS float* part = os + 64 * 256;
    LAS float* dec = part + 4 * 128;
    const bf16* qkvr = WSP(bf16, WS_QKVR); const float* glr = WSP(float, WS_GLR); bf16* aout = WSP(bf16, WS_XN);
    for (int item = F.bid; item < NBATCH * GLA_H; item += F.G) {
        const int b = item / GLA_H, h = item % GLA_H;
        float S[64];
#pragma unroll
        for (int i = 0; i < 64; ++i) S[i] = 0.f;
        const int dk = FTID & 127, tg = FTID >> 7, j = FTID & 255, hf = FTID >> 8;
        for (int c = 0; c < NCHUNK; ++c) {
            const size_t t0 = (size_t)b * SEQ + c * CHUNK;
            for (int i = FTID; i < 64 * 16; i += NTHREADS) gl[i] = glr[t0 * RANK + i];
            __syncthreads();
            float wgu[RANK];
#pragma unroll
            for (int r = 0; r < RANK; ++r) wgu[r] = F.inp(I_GLA_WGU)[r * HK + h * DK + dk];
            const float bgv = F.inp(I_GLA_BG)[h * DK + dk];
            float run = 0.f;
            for (int jj = 0; jj < 16; ++jj) {
                const int tok = tg * 16 + jj; float a = bgv;
#pragma unroll
                for (int r = 0; r < RANK; ++r) a += gl[tok * 16 + r] * wgu[r];
                run += logsigmoid_f(a) * (1.f / 16.f);
            }
            part[tg * 128 + dk] = run;
            __syncthreads();
            float off = 0.f, tot = 0.f;
#pragma unroll
            for (int g = 0; g < 4; ++g) { const float pv = part[g * 128 + dk]; if (g < tg) off += pv; tot += pv; }
            run = off;
            for (int jj = 0; jj < 16; ++jj) {
                const int tok = tg * 16 + jj; float a = bgv;
#pragma unroll
                for (int r = 0; r < RANK; ++r) a += gl[tok * 16 + r] * wgu[r];
                run += logsigmoid_f(a) * (1.f / 16.f);
                const float kv = bf2f(qkvr[(t0 + tok) * NQKVR + HK + h * DK + dk]);
                kd[tok * 128 + dk] = kv * __expf(tot - run);
                qs[tok * 128 + dk] = bf2f(qkvr[(t0 + tok) * NQKVR + h * DK + dk]);
            }
            if (tg == 0) dec[dk] = __expf(tot);
            __syncthreads();
#pragma unroll
            for (int ib = 0; ib < 4; ++ib) {
#pragma unroll
                for (int i = 0; i < 16; ++i) S[ib * 16 + i] *= dec[64 * hf + ib * 16 + i];
                asm volatile("" ::: "memory"); }
            for (int s = 0; s < CHUNK; ++s) {
                const float vv = bf2f(qkvr[(t0 + s) * NQKVR + 2 * HK + h * DV + j]);
#pragma unroll
                for (int ib = 0; ib < 4; ++ib) {
#pragma unroll
                    for (int i = 0; i < 16; ++i) S[ib * 16 + i] += kd[s * 128 + 64 * hf + ib * 16 + i] * vv;
                    asm volatile("" ::: "memory"); }
            }
            for (int ph = 0; ph < 2; ++ph) {
                if (hf == ph) {
                    for (int t = 0; t < CHUNK; ++t) {
                        float o = 0.f;
#pragma unroll
                        for (int ib = 0; ib < 4; ++ib) {
#pragma unroll
                            for (int i = 0; i < 16; ++i) o += qs[t * 128 + 64 * hf + ib * 16 + i] * S[ib * 16 + i];
                            asm volatile("" ::: "memory"); }
                        if (ph == 0) os[t * 256 + j] = o; else os[t * 256 + j] += o;
                    }
                }
                __syncthreads();
            }
            {
                const int tok = FTID >> 3, cc = FTID & 7; float ss = 0.f;
                for (int jj = 0; jj < 32; ++jj) { const float o = os[tok * 256 + cc * 32 + jj]; ss += o * o; }
                ss += __shfl_xor(ss, 1); ss += __shfl_xor(ss, 2); ss += __shfl_xor(ss, 4);
                const float rms = 1.f / sqrtf(ss * (1.f / DV) + EPS);
                for (int jj = 0; jj < 32; ++jj) {
                    const int col = h * DV + cc * 32 + jj;
                    const float rr = bf2f(qkvr[(t0 + tok) * NQKVR + 2 * HK + HV + col]);
                    aout[(t0 + tok) * D + col] = (bf16)f2bf(os[tok * 256 + cc * 32 + jj] * rms * silu_f(rr));
                }
            }
            __syncthreads();
        }
    }
}

__device__ __forceinline__ void n_moe(Frame& F, int L) {
    LAS float* xs = (LAS float*)F.lds; LAS float* hl = xs + D;
    const bf16* xn = WSP(bf16, WS_XN); bf16* y = WSP(bf16, WS_Y);
    const bf16* W13 = WSP(bf16, WS_W13) + (size_t)L * NE * 1024 * 1024; const bf16* W2 = WSP(bf16, WS_W2) + (size_t)L * NE * 1024 * 512;
    for (int a = F.bid; a < 2 * T; a += F.G) {
        const int tok = a >> 1, k = a & 1, e = WSP(int, WS_EID)[a]; const float gate = WSP(float, WS_GATE)[a];
        for (int i = FTID; i < D; i += NTHREADS) xs[i] = bf2f(xn[(size_t)tok * D + i]);
        __syncthreads();
        for (int jj = 0; jj < 64; ++jj) {
            const int j = FWAVE * 64 + jj; const bf16* r1 = W13 + ((size_t)e * 1024 + (j >> 7) * 256 + (j & 127)) * 1024; const bf16* r3 = r1 + 128 * 1024;
            float d1 = 0.f, d3 = 0.f;
#pragma unroll
            for (int i = 0; i < 2; ++i) { const int kk = FLANE * 8 + 512 * i; const v4u a1 = *(const v4u*)(r1 + kk), a3 = *(const v4u*)(r3 + kk);
                d1 += xs[kk] * bflo(a1.x) + xs[kk + 1] * bfhi(a1.x) + xs[kk + 2] * bflo(a1.y) + xs[kk + 3] * bfhi(a1.y) + xs[kk + 4] * bflo(a1.z) + xs[kk + 5] * bfhi(a1.z) + xs[kk + 6] * bflo(a1.w) + xs[kk + 7] * bfhi(a1.w);
                d3 += xs[kk] * bflo(a3.x) + xs[kk + 1] * bfhi(a3.x) + xs[kk + 2] * bflo(a3.y) + xs[kk + 3] * bfhi(a3.y) + xs[kk + 4] * bflo(a3.z) + xs[kk + 5] * bfhi(a3.z) + xs[kk + 6] * bflo(a3.w) + xs[kk + 7] * bfhi(a3.w); }
            d1 = wave_sum(d1); d3 = wave_sum(d3);
            if (FLANE == 0) hl[j] = bf2f((bf16)f2bf(silu_f(d1) * d3));
        }
        __syncthreads();
        for (int cc = 0; cc < 128; ++cc) {
            const int c = FWAVE * 128 + cc; const bf16* r2 = W2 + ((size_t)e * 1024 + c) * 512; const int kk = FLANE * 8; const v4u a2 = *(const v4u*)(r2 + kk);
            float d = hl[kk] * bflo(a2.x) + hl[kk + 1] * bfhi(a2.x) + hl[kk + 2] * bflo(a2.y) + hl[kk + 3] * bfhi(a2.y) + hl[kk + 4] * bflo(a2.z) + hl[kk + 5] * bfhi(a2.z) + hl[kk + 6] * bflo(a2.w) + hl[kk + 7] * bfhi(a2.w);
            d = wave_sum(d);
            if (FLANE == 0) y[((size_t)k * T + tok) * D + c] = (bf16)f2bf(gate * d);
        }
        __syncthreads();
    }
}

__device__ __forceinline__ void n_stats(Frame& F) {
    const bf16* v = WSP(bf16, WS_V); float* st = WSP(float, WS_STATS);
    for (size_t it = (size_t)F.bid * NTHREADS + FTID; it < (size_t)T * 32; it += (size_t)F.G * NTHREADS) {
        const int row = (int)(it >> 5), p = (int)(it & 31), pnv = p >> 2, wc = p & 3; float s = 0.f, q = 0.f;
        for (int bj = 0; bj < 2; ++bj) for (int j = 0; j < 32; ++j) { const float x = bf2f(v[(size_t)row * SGU_HALF + pnv * 256 + bj * 128 + wc * 32 + j]); s += x; q += x * x; }
        st[((size_t)p * T + row) * 2] = s; st[((size_t)p * T + row) * 2 + 1] = q;
    }
}
__device__ __forceinline__ void n_mix(Frame& F) {
    LAS float* wl = (LAS float*)F.lds;
    LAS float* vls = wl + 128 * 128;
    LAS float* mu = vls + 128 * 128; LAS float* rs = mu + 128; LAS float* red = rs + 128;
    bf16* u = WSP(bf16, WS_U); const bf16* v = WSP(bf16, WS_V);
    for (int bn = F.bid; bn < T / SGU_BLK; bn += F.G) {
        const size_t t0 = (size_t)bn * SGU_BLK;
        __syncthreads();
        { const int row = FTID >> 2, q4 = FTID & 3; float s = 0.f, q = 0.f;
          for (int i = 0; i < 512; ++i) { const float x = bf2f(v[(t0 + row) * SGU_HALF + q4 * 512 + i]); s += x; q += x * x; }
          red[(row * 4 + q4) * 2] = s; red[(row * 4 + q4) * 2 + 1] = q; }
        __syncthreads();
        if (FTID < 128) { float s = 0.f, q = 0.f; for (int p = 0; p < 4; ++p) { s += red[(FTID * 4 + p) * 2]; q += red[(FTID * 4 + p) * 2 + 1]; }
            const float m = s * (1.f / SGU_HALF); mu[FTID] = m; rs[FTID] = 1.f / sqrtf(q * (1.f / SGU_HALF) - m * m + EPS); }
        for (int g = 0; g < 4; ++g) {
            __syncthreads();
            for (int i = FTID; i < 128 * 128; i += NTHREADS) { const int t = i >> 7, s = i & 127; wl[i] = ((t >> 6) >= (s >> 6)) ? F.inp(I_SGU_WS)[(size_t)g * 128 * 128 + i] : 0.f; }
            for (int cb = 0; cb < 4; ++cb) {
                const int c0 = g * SGU_GC + cb * 128;
                __syncthreads();
                for (int i = FTID; i < 128 * 128; i += NTHREADS) { const int s = i >> 7, c = i & 127;
                    vls[i] = (bf2f(v[(t0 + s) * SGU_HALF + c0 + c]) - mu[s]) * rs[s] * F.inp(I_SGU_LNG)[c0 + c] + F.inp(I_SGU_LNB)[c0 + c]; }
                __syncthreads();
                const int c = FTID & 127, tq = FTID >> 7;
                for (int tt = 0; tt < 32; ++tt) {
                    const int t = tq * 32 + tt; float acc = 0.f;
                    for (int s = 0; s < 128; ++s) acc += wl[t * 128 + s] * vls[s * 128 + c];
                    const float mixed = acc + F.inp(I_SGU_BS)[g * 128 + t];
                    u[(t0 + t) * SGU_HALF + c0 + c] = (bf16)f2bf(bf2f(u[(t0 + t) * SGU_HALF + c0 + c]) * mixed);
                }
            }
        }
    }
}
#define XB_TMO      128
#define XB_XCNT(j)  (256  + 64 * (j))
#define XB_XSUB(j)  (1280 + 64 * (j))
#define XB_XGEN(j)  (2304 + 64 * (j))
#define XB_TOP      3328
#define XB_TOPGEN   3392
#define XCD_BAR_WORDS 3456
#define XB_SPIN_CAP (1u << 18)

__device__ __forceinline__ unsigned xb_ld(unsigned* p)              { return __hip_atomic_load(p, __ATOMIC_RELAXED, __HIP_MEMORY_SCOPE_AGENT); }
__device__ __forceinline__ unsigned xb_add(unsigned* p, unsigned v) { return __hip_atomic_fetch_add(p, v, __ATOMIC_RELAXED, __HIP_MEMORY_SCOPE_AGENT); }
__device__ __forceinline__ unsigned xb_xcc_id() { return (unsigned)__builtin_amdgcn_s_getreg((3 << 11) | 20) & 0xFu; }
#define XB_SPIN(cond, bar) do { unsigned _sp = 0; while (cond) { __builtin_amdgcn_s_sleep(1); \
    if ((++_sp & 255u) == 0u) { if (xb_ld(&(bar)[XB_TMO])) break; if (_sp > XB_SPIN_CAP) { atomicAdd(&(bar)[XB_TMO], 1u); break; } } } } while (0)

struct XcdBarrier {
    unsigned* bar; unsigned x;
    volatile LAS unsigned* st;
};

__device__ __forceinline__ XcdBarrier xcd_barrier_post(unsigned* bar, volatile LAS unsigned* st) {
    XcdBarrier b; b.bar = bar; b.x = xb_xcc_id(); b.st = st;
    if (threadIdx.x == 0) (void)xb_add(&bar[XB_XCNT(b.x)], 1u);
    return b;
}
__device__ __forceinline__ void xcd_barrier_complete(unsigned* bar, unsigned x, unsigned& nloc, unsigned& nx) {
    const unsigned G = gridDim.x * gridDim.y * gridDim.z;
    unsigned sum, cnt, mine, sp = 0u;
    for (;;) {
        sum = 0u; cnt = 0u; mine = 0u;
#pragma unroll
        for (unsigned j = 0; j < 16; ++j) { const unsigned c = xb_ld(&bar[XB_XCNT(j)]); sum += c; cnt += (c > 0u) ? 1u : 0u; mine = (j == x) ? c : mine; }
        if (sum == G) break;
        __builtin_amdgcn_s_sleep(1);
        if ((++sp & 255u) == 0u) { if (xb_ld(&bar[XB_TMO])) break; if (sp > XB_SPIN_CAP) { atomicAdd(&bar[XB_TMO], 1u); break; } }
    }
    nloc = mine > 0u ? mine : 1u; nx = cnt > 0u ? cnt : 1u;
}

__device__ __forceinline__ void xcd_barrier(const XcdBarrier& b) {
    asm volatile("s_waitcnt vmcnt(0)" ::: "memory");
    __syncthreads();
    if (threadIdx.x == 0) {
        unsigned* bar = b.bar;
        __builtin_amdgcn_s_waitcnt(0);
        unsigned nloc = b.st[0], nx = b.st[1];
        if (nloc == 0u) { xcd_barrier_complete(bar, b.x, nloc, nx); b.st[0] = nloc; b.st[1] = nx; }
        const unsigned old = xb_add(&bar[XB_XSUB(b.x)], 1u);
        const unsigned gen = old / nloc;
        if (old + 1u == (gen + 1u) * nloc) {
            __builtin_amdgcn_fence(__ATOMIC_RELEASE, "agent");
            asm volatile("s_waitcnt vmcnt(0)" ::: "memory");
            const unsigned og = xb_add(&bar[XB_TOP], 1u);
            const unsigned tg = og / nx;
            if (og + 1u == (tg + 1u) * nx) xb_add(&bar[XB_TOPGEN], 1u);
            else XB_SPIN(xb_ld(&bar[XB_TOPGEN]) == tg, bar);
            __builtin_amdgcn_fence(__ATOMIC_ACQUIRE, "agent");
            xb_add(&bar[XB_XGEN(b.x)], 1u);
            asm volatile("s_waitcnt vmcnt(0)" ::: "memory");
        } else {
            XB_SPIN(xb_ld(&bar[XB_XGEN(b.x)]) == gen, bar);
            __builtin_amdgcn_fence(__ATOMIC_ACQUIRE, "agent");
            asm volatile("s_waitcnt vmcnt(0)" ::: "memory");
        }
    }
    __syncthreads();
}
constexpr int RING_BYTES = 131072;
constexpr int LX_TST = RING_BYTES;
constexpr int MOE_MAXU = 6;
constexpr int LX_TAB = RING_BYTES + 512;
constexpr int LX_GT = LX_TAB + MOE_MAXU * 1024;

struct EpiStoreBf16 {
    static constexpr bool RS_DMA = true;
    static constexpr bool PERM = true;
    bf16* O; int ldc; const float* rs; int fold; int silu_from;
    __device__ __forceinline__ void operator()(const pg8::f32x4 (&acc)[2][2][4][2], const pg8::Unit& u, int wr, int wc, int fr, int fq, const LAS float* rsl) const {
        const int row0 = (fold ? (int)blockIdx.x : u.pm) * 256 + wr * 64 + fr, col0 = (fold ? 0 : u.pn * 256) + wc * 32 + 8 * fq;
        if (fold == 2) { float sm = 0.f;
#pragma unroll
            for (int ai = 0; ai < 2; ++ai)
#pragma unroll
                for (int bj = 0; bj < 2; ++bj)
#pragma unroll
                    for (int m = 0; m < 4; ++m)
#pragma unroll
                        for (int n = 0; n < 2; ++n) sm += acc[ai][bj][m][n][0] + acc[ai][bj][m][n][1] + acc[ai][bj][m][n][2] + acc[ai][bj][m][n][3];
            if (sm == 1.2345e30f) O[row0] = 1; return; }
#pragma unroll
        for (int ai = 0; ai < 2; ++ai)
#pragma unroll
            for (int m = 0; m < 4; ++m) { const int row = row0 + ai * 128 + m * 16; bf16* rowp = O + (size_t)row * ldc + col0; const float sc = rsl[ai * 128 + wr * 64 + m * 16 + fr];
#pragma unroll
                for (int bj = 0; bj < 2; ++bj) { pg8::f32x4 v0 = acc[ai][bj][m][0] * sc, v1 = acc[ai][bj][m][1] * sc;
                    if (silu_from >= 0 && u.pn >= silu_from) {
#pragma unroll
                        for (int i = 0; i < 4; ++i) { v0[i] = v0[i] * __builtin_amdgcn_rcpf(1.f + __expf(-v0[i])); v1[i] = v1[i] * __builtin_amdgcn_rcpf(1.f + __expf(-v1[i])); } }
                    v4u w; w.x = pg8::cvt_pk_bf16(v0[0], v0[1]); w.y = pg8::cvt_pk_bf16(v0[2], v0[3]); w.z = pg8::cvt_pk_bf16(v1[0], v1[1]); w.w = pg8::cvt_pk_bf16(v1[2], v1[3]);
                    *(v4u*)(rowp + bj * 128) = w; } }
    }
};
struct EpiResBf16 {
    static constexpr bool RS_DMA = false;
    static constexpr bool PERM = true;
    bf16* X; bf16* XO;
    __device__ __forceinline__ void operator()(const pg8::f32x4 (&acc)[2][2][4][2], const pg8::Unit& u, int wr, int wc, int fr, int fq, const LAS float* rsl) const {
        const int row0 = u.pm * 256 + wr * 64 + fr, col0 = u.pn * 256 + wc * 32 + 8 * fq;
#pragma unroll
        for (int ai = 0; ai < 2; ++ai)
#pragma unroll
            for (int m = 0; m < 4; ++m) { bf16* rowp = X + (size_t)(row0 + ai * 128 + m * 16) * D + col0; bf16* rowo = XO + (size_t)(row0 + ai * 128 + m * 16) * D + col0;
#pragma unroll
                for (int bj = 0; bj < 2; ++bj) { const v4u r = *(const v4u*)(rowp + bj * 128); const pg8::f32x4 v0 = acc[ai][bj][m][0], v1 = acc[ai][bj][m][1];
                    v4u w; w.x = pg8::cvt_pk_bf16(bflo(r.x) + v0[0], bfhi(r.x) + v0[1]); w.y = pg8::cvt_pk_bf16(bflo(r.y) + v0[2], bfhi(r.y) + v0[3]);
                    w.z = pg8::cvt_pk_bf16(bflo(r.z) + v1[0], bfhi(r.z) + v1[1]); w.w = pg8::cvt_pk_bf16(bflo(r.w) + v1[2], bfhi(r.w) + v1[3]);
                    *(v4u*)(rowo + bj * 128) = w; } }
    }
};
struct EpiResF32 {
    static constexpr bool RS_DMA = false;
    static constexpr bool PERM = false;
    const float* res; float* out;
    __device__ __forceinline__ void operator()(const pg8::f32x4 (&acc)[2][2][4][2], const pg8::Unit& u, int wr, int wc, int fr, int fq, const LAS float* rsl) const {
        const int row0 = u.pm * 256 + wr * 64 + fr, col0 = u.pn * 256 + wc * 32 + 4 * fq;
#pragma unroll
        for (int ai = 0; ai < 2; ++ai)
#pragma unroll
            for (int m = 0; m < 4; ++m) { const size_t off = (size_t)(row0 + ai * 128 + m * 16) * D + col0;
#pragma unroll
                for (int bj = 0; bj < 2; ++bj)
#pragma unroll
                    for (int n = 0; n < 2; ++n) { const pg8::f32x4 r = *(const pg8::f32x4*)(res + off + bj * 128 + n * 16); *(pg8::f32x4*)(out + off + bj * 128 + n * 16) = r + acc[ai][bj][m][n]; } }
    }
};
struct EpiGeluSplit {
    static constexpr bool RS_DMA = true;
    static constexpr bool PERM = true;
    bf16* U; bf16* V; float* st; const float* rs;
    __device__ __forceinline__ void operator()(const pg8::f32x4 (&acc)[2][2][4][2], const pg8::Unit& u, int wr, int wc, int fr, int fq, const LAS float* rsl) const {
        const bool isv = u.pn >= 8; const int pnl = isv ? u.pn - 8 : u.pn;
        bf16* O = isv ? V : U;
        const int row0 = u.pm * 256 + wr * 64 + fr, col0 = pnl * 256 + wc * 32 + 8 * fq;
#pragma unroll
        for (int ai = 0; ai < 2; ++ai)
#pragma unroll
            for (int m = 0; m < 4; ++m) { const int row = row0 + ai * 128 + m * 16; bf16* rowp = O + (size_t)row * SGU_HALF + col0; float s = 0.f, q = 0.f; const float sc = rsl[ai * 128 + wr * 64 + m * 16 + fr];
#pragma unroll
                for (int bj = 0; bj < 2; ++bj) { const pg8::f32x4 v0 = acc[ai][bj][m][0] * sc, v1 = acc[ai][bj][m][1] * sc;
                    const pg8::f32x2 a = pg8::gelu_pk((pg8::f32x2){v0[0], v0[1]}), b = pg8::gelu_pk((pg8::f32x2){v0[2], v0[3]}), c = pg8::gelu_pk((pg8::f32x2){v1[0], v1[1]}), d = pg8::gelu_pk((pg8::f32x2){v1[2], v1[3]});
                    s += (a.x + a.y) + (b.x + b.y) + (c.x + c.y) + (d.x + d.y);
                    q += (a.x * a.x + a.y * a.y) + (b.x * b.x + b.y * b.y) + (c.x * c.x + c.y * c.y) + (d.x * d.x + d.y * d.y);
                    v4u w; w.x = pg8::cvt_pk_bf16(a.x, a.y); w.y = pg8::cvt_pk_bf16(b.x, b.y); w.z = pg8::cvt_pk_bf16(c.x, c.y); w.w = pg8::cvt_pk_bf16(d.x, d.y);
                    *(v4u*)(rowp + bj * 128) = w; }
                if (isv) { s += __shfl_xor(s, 16); s += __shfl_xor(s, 32); q += __shfl_xor(q, 16); q += __shfl_xor(q, 32);
                    if (fq == 0) { pg8::f32x2 o = {s, q}; *(pg8::f32x2*)(st + ((size_t)(pnl * 4 + wc) * T + row) * 2) = o; } } }
    }
};

__device__ __forceinline__ void f_gemm_in(Frame& F, int fold = 0) {
    pg8::DenseOrder S; S.init(T, NQKVR, D, WSP(bf16, WS_WIN), F.G, F.bid);
    EpiStoreBf16 E{fold ? WSP(bf16, WS_AOUT) : WSP(bf16, WS_QKVR), fold ? 256 : NQKVR, WSP(float, WS_RS), fold, 8};
    pg8::gemm_phase(F.lds, WSP(bf16, WS_XN), D, S, E);
}
__device__ __forceinline__ void f_gemm_out(Frame& F, bf16* xo = nullptr) {
    pg8::DenseOrder S; S.init(T, D, HV, WSP(bf16, WS_WOUT), F.G, F.bid);
    EpiResBf16 E{WSP(bf16, WS_XN), xo ? xo : WSP(bf16, WS_XN)};
    pg8::gemm_phase(F.lds, WSP(bf16, WS_AOUT), HV, S, E);
}
struct RowSetOrder {
    static constexpr bool GATHER = false;
    int nb, c, j0, nunits, K; const char* Bt;
    __device__ __forceinline__ bool next(int i, pg8::Unit& u) const {
        if (c < 0) return false;
        const int q = i * nb + c; if (q >= nunits) return false;
        u.pm = ((q & 63) >> 2) * 8 + j0 + (q >> 6); u.pn = q & 3; u.e = 0; u.slot = 0; return true;
    }
    __device__ __forceinline__ const char* bptr(const pg8::Unit& u) const { return Bt + (size_t)u.pn * 256 * K * 2; }
    __device__ __forceinline__ size_t abase(const pg8::Unit& u) const { return (size_t)u.pm * 256 * K * 2; }
    __device__ __forceinline__ unsigned aoff(const pg8::Unit&, int, int, int) const { return 0u; }
    __device__ __forceinline__ void a_ready(const pg8::Unit&) const {}
    __device__ __forceinline__ void done(const pg8::Unit&) const {}
};
__device__ __forceinline__ void f_gemm_out_rows(Frame& F, int j0, int j1, int boff) {
    RowSetOrder S; S.nb = F.G - boff; S.c = F.bid - boff; S.j0 = j0; S.nunits = (j1 - j0) * 64; S.K = HV; S.Bt = (const char*)WSP(bf16, WS_WOUT);
    EpiResBf16 E{WSP(bf16, WS_XN), WSP(bf16, WS_XN)};
    pg8::gemm_phase(F.lds, WSP(bf16, WS_AOUT), HV, S, E);
}
__device__ __forceinline__ void f_gemm_sgu_in(Frame& F) {
    pg8::DenseOrder S; S.init(T, SGU_FFN, D, WSP(bf16, WS_WSIN), F.G, F.bid);
    EpiGeluSplit E{WSP(bf16, WS_U), WSP(bf16, WS_V), WSP(float, WS_STATS), WSP(float, WS_RS)};
    pg8::gemm_phase(F.lds, WSP(bf16, WS_XN), D, S, E);
}
__device__ __forceinline__ void f_gemm_sgu_out(Frame& F, bf16* xo = nullptr) {
    pg8::DenseOrder S; S.init(T, D, SGU_HALF, WSP(bf16, WS_WSOUT), F.G, F.bid);
    EpiResBf16 E{WSP(bf16, WS_XN), xo ? xo : WSP(bf16, WS_XN)};
    pg8::gemm_phase(F.lds, WSP(bf16, WS_U), SGU_HALF, S, E);
}

template <bool GATHER_> struct MoeOrder {
    static constexpr bool GATHER = GATHER_;
    int G, c, nunits, ibase, K, mode;
    const char* W; size_t estride;
    LAS const int* tst; LAS const int* tab;
    __device__ __forceinline__ bool next(int i, pg8::Unit& u) const {
        if (i >= MOE_MAXU) return false;
        const int Lu = (ibase + i) * G + c; if (Lu >= nunits) return false;
        const int rt = Lu >> 2; int e = 0;
        while (e < NE - 1 && tst[e + 1] <= rt) ++e;
        u.pm = rt; u.pn = Lu & 3; u.e = e; u.slot = i; return true;
    }
    __device__ __forceinline__ const char* bptr(const pg8::Unit& u) const { return W + (size_t)u.e * estride + (size_t)u.pn * 256 * K * 2; }
    __device__ __forceinline__ size_t abase(const pg8::Unit& u) const { return (size_t)u.pm * 256 * K * 2; }
    __device__ __forceinline__ unsigned aoff(const pg8::Unit& u, int h, int R, int C) const {
        if (mode == 0) { int ent = tab[u.slot * 256 + h * 128 + R]; ent = ent < 0 ? 0 : ent; return (unsigned)(((ent >> 1) * K + C) * 2); }
        return (unsigned)(((u.pm * 256 + h * 128 + R) * K + C) * 2);
    }
    __device__ __forceinline__ void a_ready(const pg8::Unit&) const {}
    __device__ __forceinline__ void done(const pg8::Unit&) const {}
};
struct EpiSwiglu {
    static constexpr bool RS_DMA = false;
    static constexpr bool PERM = true;
    bf16* H; LAS const float* gt;
    __device__ __forceinline__ void operator()(const pg8::f32x4 (&acc)[2][2][4][2], const pg8::Unit& u, int wr, int wc, int fr, int fq, const LAS float* rsl) const {
        const int row0 = u.pm * 256 + wr * 64 + fr, col0 = u.pn * 128 + wc * 32 + 8 * fq;
#pragma unroll
        for (int ai = 0; ai < 2; ++ai)
#pragma unroll
            for (int m = 0; m < 4; ++m) { bf16* rowp = H + (size_t)(row0 + ai * 128 + m * 16) * FF + col0; float h[8]; const float sc = gt[u.slot * 256 + ai * 128 + wr * 64 + m * 16 + fr];
#pragma unroll
                for (int n = 0; n < 2; ++n)
#pragma unroll
                    for (int i = 0; i < 4; ++i) { const float a = acc[ai][0][m][n][i] * sc, b = acc[ai][1][m][n][i] * sc; h[n * 4 + i] = a * __builtin_amdgcn_rcpf(1.f + __expf(-a)) * b; }
                v4u w; w.x = pg8::cvt_pk_bf16(h[0], h[1]); w.y = pg8::cvt_pk_bf16(h[2], h[3]); w.z = pg8::cvt_pk_bf16(h[4], h[5]); w.w = pg8::cvt_pk_bf16(h[6], h[7]);
                *(v4u*)rowp = w; }
    }
};
struct EpiScatterY {
    static constexpr bool RS_DMA = false;
    static constexpr bool PERM = true;
    bf16* Y; LAS const int* tab; LAS const float* gt;
    __device__ __forceinline__ void operator()(const pg8::f32x4 (&acc)[2][2][4][2], const pg8::Unit& u, int wr, int wc, int fr, int fq, const LAS float* rsl) const {
        const int col0 = u.pn * 256 + wc * 32 + 8 * fq;
#pragma unroll
        for (int ai = 0; ai < 2; ++ai)
#pragma unroll
            for (int m = 0; m < 4; ++m) { const int r = ai * 128 + wr * 64 + m * 16 + fr; const int ent = tab[u.slot * 256 + r]; const float g = gt[u.slot * 256 + r];
                if (ent >= 0) { bf16* rowp = Y + ((size_t)(ent & 1) * T + (ent >> 1)) * D + col0;
#pragma unroll
                    for (int bj = 0; bj < 2; ++bj) { const pg8::f32x4 v0 = acc[ai][bj][m][0] * g, v1 = acc[ai][bj][m][1] * g;
                        v4u w; w.x = pg8::cvt_pk_bf16(v0[0], v0[1]); w.y = pg8::cvt_pk_bf16(v0[2], v0[3]); w.z = pg8::cvt_pk_bf16(v1[0], v1[1]); w.w = pg8::cvt_pk_bf16(v1[2], v1[3]);
                        *(v4u*)(rowp + bj * 128) = w; } } }
    }
};
template <int MODE> __device__ __forceinline__ void f_moe_gemm(Frame& F, int L) {
    LAS int* tst = (LAS int*)(F.lds + LX_TST); LAS int* cntl = tst + 64; LAS int* tab = (LAS int*)(F.lds + LX_TAB); LAS float* gt = (LAS float*)(F.lds + LX_GT);
    unsigned* ctl = WSP(unsigned, WS_CTL);
    __syncthreads();
    if (FTID < NE) cntl[FTID] = (int)__hip_atomic_load(&ctl[CW_CNT + L * 2048 + 64 * FTID], __ATOMIC_RELAXED, __HIP_MEMORY_SCOPE_AGENT);
    __syncthreads();
    if (FTID == 0) { int s = 0; for (int e = 0; e < NE; ++e) { tst[e] = s; s += (cntl[e] + 255) >> 8; } tst[NE] = s; }
    __syncthreads();
    MoeOrder<MODE == 0> S; S.G = F.G; S.c = F.bid; S.nunits = 4 * tst[NE]; S.K = MODE == 0 ? D : FF; S.mode = MODE; S.tst = tst; S.tab = tab;
    S.W = MODE == 0 ? (const char*)(WSP(bf16, WS_W13) + (size_t)L * NE * 1024 * 1024) : (const char*)(WSP(bf16, WS_W2) + (size_t)L * NE * 1024 * 512);
    S.estride = MODE == 0 ? (size_t)1024 * 1024 * 2 : (size_t)1024 * 512 * 2;
    const int* list = WSP(int, WS_LIST); const float* gates = WSP(float, WS_GATE);
    for (int ibase = 0; ibase * F.G + F.bid < S.nunits; ibase += MOE_MAXU) {
        S.ibase = ibase;
        {
            static_assert(MOE_MAXU == 6, "three table slots per thread half");
            int ents[3]; float gsv[3]; const int r = FTID & 255, hsel = FTID >> 8;
#pragma unroll
            for (int k = 0; k < 3; ++k) { pg8::Unit u; ents[k] = -1;
                if (S.next(2 * k + hsel, u)) { const int idx = (u.pm - tst[u.e]) * 256 + r; if (idx < cntl[u.e]) ents[k] = list[(size_t)u.e * T + idx]; } }
#pragma unroll
            for (int k = 0; k < 3; ++k) gsv[k] = ents[k] >= 0 ? (MODE == 0 ? WSP(float, WS_RS)[ents[k] >> 1] : gates[ents[k]]) : 0.f;
#pragma unroll
            for (int k = 0; k < 3; ++k) { tab[(2 * k + hsel) * 256 + r] = ents[k]; gt[(2 * k + hsel) * 256 + r] = gsv[k]; }
        }
        __syncthreads();
        if (MODE == 0) { EpiSwiglu E{WSP(bf16, WS_HID), gt}; pg8::gemm_phase(F.lds, WSP(bf16, WS_XN), D, S, E); }
        else { EpiScatterY E{WSP(bf16, WS_Y), tab, gt}; pg8::gemm_phase(F.lds, WSP(bf16, WS_HID), FF, S, E); }
        __syncthreads();
    }
}
__device__ __forceinline__ void f_moe1(Frame& F, int L) { f_moe_gemm<0>(F, L); }
__device__ __forceinline__ void f_moe2(Frame& F, int L) { f_moe_gemm<1>(F, L); }
__device__ __forceinline__ void transpose_item(const float* W, int ldw, const float* kscale, float cs, bf16* WT, int K, int dst_row0, LAS float* scr, int k0, int n0, int lane) {
    f32x4 x[8]; float ks[8];
    const int kr = lane >> 3, n4 = (lane & 7) * 4;
#pragma unroll
    for (int i = 0; i < 8; ++i) { x[i] = *(const f32x4*)(W + (size_t)(k0 + 8 * i + kr) * ldw + n0 + n4); ks[i] = kscale ? kscale[k0 + 8 * i + kr] * cs : cs; }
#pragma unroll
    for (int i = 0; i < 8; ++i) { LAS float* d = scr + (8 * i + kr) * 33 + n4; d[0] = x[i][0] * ks[i]; d[1] = x[i][1] * ks[i]; d[2] = x[i][2] * ks[i]; d[3] = x[i][3] * ks[i]; }
    LDS_WAIT(); asm volatile("" ::: "memory");
    const int c = lane & 7;
#pragma unroll
    for (int j = 0; j < 4; ++j) { const int n = (lane >> 3) + 8 * j; const LAS float* s = scr + (8 * c) * 33 + n;
        v4u o; o.x = pk2(s[0 * 33], s[1 * 33]); o.y = pk2(s[2 * 33], s[3 * 33]); o.z = pk2(s[4 * 33], s[5 * 33]); o.w = pk2(s[6 * 33], s[7 * 33]);
        *(v4u*)(WT + (size_t)(dst_row0 + n) * K + k0 + 8 * c) = o; }
    LDS_WAIT(); asm volatile("" ::: "memory");
}
__device__ __forceinline__ void convert_job_item(const float* W, int ldw, int K, int N, const float* kscale, int qcols, float qs, bf16* WT, int rowmap, LAS float* scr, int item, int lane) {
    const int nblk = N / 32, kb = item / nblk, nb = item % nblk, k0 = 64 * kb, n0 = 32 * nb;
    const int dr = rowmap == 0 ? n0 : ((n0 >> 7) * 256 + (n0 & 127) + (rowmap == 2 ? 128 : 0));
    transpose_item(W, ldw, kscale, n0 < qcols ? qs : 1.f, WT, K, dr, scr, k0, n0, lane);
}
__device__ __forceinline__ void f_convert_gla(Frame& F) {
    LAS float* scr = (LAS float*)(F.lds + FWAVE * 8448);
    const int gw = F.bid * NWAVES + FWAVE, NGW = F.G * NWAVES;
    constexpr int I0 = (D / 64) * (NQKVR / 32), I1 = (HV / 64) * (D / 32);
    for (int it = gw; it < I0 + I1; it += NGW) {
        if (it < I0) convert_job_item(F.inp(I_GLA_WIN), GLA_IN, D, NQKVR, F.inp(I_GLA_NORM), HK, 0.08838834764831845f, WSP(bf16, WS_WIN), 0, scr, it, FLANE);
        else convert_job_item(F.inp(I_GLA_WOUT), D, HV, D, F.inp(I_GLA_HG), 0, 1.f, WSP(bf16, WS_WOUT), 0, scr, it - I0, FLANE);
    }
}
__device__ __forceinline__ void f_convert_rest(Frame& F, int cw, int NCW) {
    LAS float* scr = (LAS float*)(F.lds + FWAVE * 8448);
    constexpr int I0 = (D / 64) * (SGU_FFN / 32), I1 = (SGU_HALF / 64) * (D / 32), IE1 = (D / 64) * (FF / 32), IE2 = (FF / 64) * (D / 32);
    constexpr int IM = 2 * NE * IE1;
    static_assert(IE1 == IE2, "w1 / w2 item counts");
    for (int it = cw; it < I0 + I1 + 3 * IM; it += NCW) {
        int r = it;
        if (r < I0) { convert_job_item(F.inp(I_SGU_WIN), SGU_FFN, D, SGU_FFN, F.inp(I_SGU_NORM), 0, 1.f, WSP(bf16, WS_WSIN), 0, scr, r, FLANE); continue; } r -= I0;
        if (r < I1) { convert_job_item(F.inp(I_SGU_WOUT), D, SGU_HALF, D, nullptr, 0, 1.f, WSP(bf16, WS_WSOUT), 0, scr, r, FLANE); continue; } r -= I1;
        const int which = r / IM; r -= which * IM; const int le = r / IE1, li = r % IE1, L = le / NE;
        if (which == 0) convert_job_item(F.inp(I_MOE_W1) + (size_t)le * D * FF, FF, D, FF, F.inp(I_MOE_NORM) + L * D, 0, 1.f, WSP(bf16, WS_W13) + (size_t)le * 1024 * 1024, 1, scr, li, FLANE);
        else if (which == 1) convert_job_item(F.inp(I_MOE_W3) + (size_t)le * D * FF, FF, D, FF, F.inp(I_MOE_NORM) + L * D, 0, 1.f, WSP(bf16, WS_W13) + (size_t)le * 1024 * 1024, 2, scr, li, FLANE);
        else convert_job_item(F.inp(I_MOE_W2) + (size_t)le * FF * D, D, FF, D, nullptr, 0, 1.f, WSP(bf16, WS_W2) + (size_t)le * 1024 * 512, 0, scr, li, FLANE);
    }
}

#ifndef SCAN_DUP
#define SCAN_DUP 0
#endif
constexpr int SC_K = 0, SC_KSTR = 320;
constexpr int SC_V = 20480, SC_VSTR = 576;
constexpr int SC_Q = 57344, SC_QSTR = 272;
constexpr int SC_O = 74752, SC_OSTR = 528;
constexpr int SC_GL = 108544, SC_PART = 112640, SC_DEC = 114688, SC_WG = 115200;
__device__ __forceinline__ s16x4 tr_read16(LAS const unsigned char* p) {
    typedef short v4i16_t __attribute__((ext_vector_type(4)));
    return __builtin_bit_cast(s16x4, __builtin_amdgcn_ds_read_tr16_b64_v4i16((LAS v4i16_t*)p));
}
__device__ __forceinline__ void f_scan_item(Frame& F, int item, const XcdBarrier* xb_ = nullptr, int cbar = -1) {
    const int b = item / GLA_H, h = item % GLA_H;
    const bf16* qkvr = WSP(bf16, WS_QKVR); const float* glr = WSP(float, WS_GLR); bf16* aout = WSP(bf16, WS_AOUT);
    LAS unsigned char* L = F.lds;
    LAS float* gl = (LAS float*)(L + SC_GL); LAS float* part = (LAS float*)(L + SC_PART); LAS float* dec = (LAS float*)(L + SC_DEC);
    const int tid = FTID, lane = FLANE, w = FWAVE;
    const int r32 = lane & 31, hh = lane >> 5, blk = (lane >> 4) & 1, q4 = (lane & 15) >> 2, p4 = lane & 3;
    const int dk = tid & 127, tg = tid >> 7;
    const int gq = lane >> 4, gcol = lane & 15, gdk = 16 * w + gcol;
    bf16x8 gBh, gBl;
    { unsigned ph[4], pl[4];
#pragma unroll
      for (int j = 0; j < 4; ++j) { const float x0 = gq < 2 ? F.inp(I_GLA_WGU)[(8 * gq + 2 * j) * HK + h * DK + gdk] : 0.f, x1 = gq < 2 ? F.inp(I_GLA_WGU)[(8 * gq + 2 * j + 1) * HK + h * DK + gdk] : 0.f;
          ph[j] = pk2(x0, x1); pl[j] = pk2(x0 - bflo(ph[j]), x1 - bfhi(ph[j])); }
      v4u vh = {ph[0], ph[1], ph[2], ph[3]}, vl = {pl[0], pl[1], pl[2], pl[3]};
      gBh = __builtin_bit_cast(bf16x8, vh); gBl = __builtin_bit_cast(bf16x8, vl); }
    const float gbias = F.inp(I_GLA_BG)[h * DK + gdk];
    __syncthreads();
    f32x16 st[4];
#pragma unroll
    for (int i = 0; i < 4; ++i)
#pragma unroll
        for (int j = 0; j < 16; ++j) st[i][j] = 0.f;
    v4u rk[2], rq[2], rv[4]; f32x4 rg;
    const size_t rowb = (size_t)b * SEQ;
    const unsigned vo_kq = (unsigned)(((tid >> 4) * NQKVR + (tid & 15) * 8) * 2), vo_v = (unsigned)(((tid >> 5) * NQKVR + (tid & 31) * 8) * 2), vo_g = (unsigned)(tid * 16);
    const unsigned lo_k = (unsigned)(SC_K + (tid >> 4) * SC_KSTR + (tid & 15) * 16), lo_q = (unsigned)(SC_Q + (tid >> 4) * SC_QSTR + (tid & 15) * 16), lo_v = (unsigned)(SC_V + (tid >> 5) * SC_VSTR + (tid & 31) * 16);
#define SC_LOAD(c) do { size_t cb_ = (rowb + (size_t)(c) * CHUNK) * NQKVR * 2; asm volatile("" : "+s"(cb_)); const char* gb_ = (const char*)qkvr + cb_ + (size_t)(h * DK * 2); \
        _Pragma("unroll") for (int i = 0; i < 2; ++i) { \
            rk[i] = *(const v4u*)(gb_ + (size_t)(HK * 2 + i * 32 * NQKVR * 2) + vo_kq); rq[i] = *(const v4u*)(gb_ + (size_t)(i * 32 * NQKVR * 2) + vo_kq); } \
        _Pragma("unroll") for (int i = 0; i < 4; ++i) rv[i] = *(const v4u*)(gb_ + (size_t)(2 * HK * 2 + h * (DV - DK) * 2 + i * 16 * NQKVR * 2) + vo_v); \
        if (tid < 256) rg = *(const f32x4*)((const char*)glr + (rowb + (size_t)(c) * CHUNK) * RANK * 4 + vo_g); } while (0)
#define SC_STORE() do { \
        _Pragma("unroll") for (int i = 0; i < 2; ++i) { *(LAS v4u*)(L + lo_k + i * 32 * SC_KSTR) = rk[i]; *(LAS v4u*)(L + lo_q + i * 32 * SC_QSTR) = rq[i]; } \
        _Pragma("unroll") for (int i = 0; i < 4; ++i) *(LAS v4u*)(L + lo_v + i * 16 * SC_VSTR) = rv[i]; \
        if (tid < 256) *(LAS f32x4*)(gl + tid * 4) = rg; } while (0)
    SC_LOAD(0);
    SC_STORE();
    for (int c = 0; c < NCHUNK; ++c) {
        if (c == cbar) xcd_barrier(*xb_);
        const size_t t0 = rowb + (size_t)c * CHUNK;
        __syncthreads();
        if (c + 1 < NCHUNK) SC_LOAD(c + 1);
        {
            pg8::f32x4 g4[4]; float tsum[4], pre[4];
#pragma unroll
            for (int t = 0; t < 4; ++t) {
                v4u ah = {0u, 0u, 0u, 0u}, al = {0u, 0u, 0u, 0u};
                if (gq < 2) { const f32x4 x0 = *(const LAS f32x4*)(gl + (16 * t + gcol) * 16 + 8 * gq), x1 = *(const LAS f32x4*)(gl + (16 * t + gcol) * 16 + 8 * gq + 4);
                    ah.x = pk2(x0[0], x0[1]); ah.y = pk2(x0[2], x0[3]); ah.z = pk2(x1[0], x1[1]); ah.w = pk2(x1[2], x1[3]);
                    al.x = pk2(x0[0] - bflo(ah.x), x0[1] - bfhi(ah.x)); al.y = pk2(x0[2] - bflo(ah.y), x0[3] - bfhi(ah.y)); al.z = pk2(x1[0] - bflo(ah.z), x1[1] - bfhi(ah.z)); al.w = pk2(x1[2] - bflo(ah.w), x1[3] - bfhi(ah.w)); }
                pg8::f32x4 a4 = {gbias, gbias, gbias, gbias};
                a4 = __builtin_amdgcn_mfma_f32_16x16x32_bf16(__builtin_bit_cast(bf16x8, ah), gBh, a4, 0, 0, 0);
                a4 = __builtin_amdgcn_mfma_f32_16x16x32_bf16(__builtin_bit_cast(bf16x8, al), gBh, a4, 0, 0, 0);
                a4 = __builtin_amdgcn_mfma_f32_16x16x32_bf16(__builtin_bit_cast(bf16x8, ah), gBl, a4, 0, 0, 0);
#pragma unroll
                for (int i = 0; i < 4; ++i) { const float a = a4[i]; a4[i] = (fminf(a, 0.f) - __logf(1.f + __expf(-fabsf(a)))) * (1.f / 16.f); }
                a4[1] += a4[0]; a4[2] += a4[1]; a4[3] += a4[2];
                g4[t] = a4;
                const float s0 = a4[3], x1 = __shfl_xor(s0, 16), x2 = __shfl_xor(s0, 32), x3 = __shfl_xor(x1, 32);
                tsum[t] = (s0 + x1) + (x2 + x3);
                pre[t] = ((gq ^ 1) < gq ? x1 : 0.f) + ((gq ^ 2) < gq ? x2 : 0.f) + ((gq ^ 3) < gq ? x3 : 0.f);
            }
            const float tot = (tsum[0] + tsum[1]) + (tsum[2] + tsum[3]);
            float basep = 0.f;
#pragma unroll
            for (int t = 0; t < 4; ++t) {
#pragma unroll
                for (int i = 0; i < 4; ++i) {
                    LAS unsigned short* kp = (LAS unsigned short*)(L + SC_K + (16 * t + 4 * gq + i) * SC_KSTR + gdk * 2);
                    *kp = (unsigned short)f2bf(bf2f(*kp) * __expf(tot - (basep + pre[t] + g4[t][i])));
                }
                basep += tsum[t];
            }
            if (gq == 0) dec[gdk] = __expf(tot);
        }
        __syncthreads();
        const int etok = tid >> 3, ecc = tid & 7;
        v4u rr[4];
        { size_t eb_ = t0 * NQKVR * 2; asm volatile("" : "+s"(eb_));
          const char* rb_ = (const char*)qkvr + eb_ + (size_t)((2 * HK + HV + h * DV) * 2); const unsigned vo_r = (unsigned)(etok * NQKVR * 2 + ecc * 16);
#pragma unroll
          for (int i = 0; i < 4; ++i) rr[i] = *(const v4u*)(rb_ + vo_r + i * 128); }
#pragma unroll
        for (int i = 0; i < 4; ++i)
#pragma unroll
            for (int g4 = 0; g4 < 4; ++g4) { const f32x4 d4 = *(const LAS f32x4*)(dec + 32 * i + 8 * g4 + 4 * hh);
#pragma unroll
                for (int j = 0; j < 4; ++j) st[i][4 * g4 + j] *= d4[j]; }
#pragma unroll
        for (int s = 0; s < 4; ++s) {
            const int trow = 16 * s + 8 * hh + q4;
            const s16x4 v0 = tr_read16(L + SC_V + trow * SC_VSTR + (32 * w + 16 * blk + 4 * p4) * 2), v1 = tr_read16(L + SC_V + (trow + 4) * SC_VSTR + (32 * w + 16 * blk + 4 * p4) * 2);
            const bf16x8 Bv = {v0[0], v0[1], v0[2], v0[3], v1[0], v1[1], v1[2], v1[3]};
#pragma unroll
            for (int i = 0; i < 4; ++i) {
                const s16x4 k0 = tr_read16(L + SC_K + trow * SC_KSTR + (32 * i + 16 * blk + 4 * p4) * 2), k1 = tr_read16(L + SC_K + (trow + 4) * SC_KSTR + (32 * i + 16 * blk + 4 * p4) * 2);
                const bf16x8 Ak = {k0[0], k0[1], k0[2], k0[3], k1[0], k1[1], k1[2], k1[3]};
                st[i] = __builtin_amdgcn_mfma_f32_32x32x16_bf16(Ak, Bv, st[i], 0, 0, 0);
            }
        }
        if (SCAN_DUP & 8) {
            f32x16 dum[2]; dum[0] = st[0]; dum[1] = st[1];
#pragma unroll
            for (int s = 0; s < 4; ++s) {
                const int trow = 16 * s + 8 * hh + q4;
                const s16x4 v0 = tr_read16(L + SC_V + trow * SC_VSTR + (32 * w + 16 * blk + 4 * p4) * 2), v1 = tr_read16(L + SC_V + (trow + 4) * SC_VSTR + (32 * w + 16 * blk + 4 * p4) * 2);
                const bf16x8 Bv = {v0[0], v0[1], v0[2], v0[3], v1[0], v1[1], v1[2], v1[3]};
#pragma unroll
                for (int i = 0; i < 4; ++i) {
                    const s16x4 k0 = tr_read16(L + SC_K + trow * SC_KSTR + (32 * i + 16 * blk + 4 * p4) * 2), k1 = tr_read16(L + SC_K + (trow + 4) * SC_KSTR + (32 * i + 16 * blk + 4 * p4) * 2);
                    const bf16x8 Ak = {k0[0], k0[1], k0[2], k0[3], k1[0], k1[1], k1[2], k1[3]};
                    dum[i & 1] = __builtin_amdgcn_mfma_f32_32x32x16_bf16(Ak, Bv, dum[i & 1], 0, 0, 0);
                }
            }
            asm volatile("" :: "v"(dum[0]), "v"(dum[1]));
        }
        for (int rep_ = 0; rep_ < ((SCAN_DUP & 1) ? 2 : 1); ++rep_) {
        f32x16 oacc[2];
#pragma unroll
        for (int ot = 0; ot < 2; ++ot)
#pragma unroll
            for (int j = 0; j < 16; ++j) oacc[ot][j] = 0.f;
#pragma unroll
        for (int i = 0; i < 4; ++i)
#pragma unroll
            for (int s2 = 0; s2 < 2; ++s2) {
                v4u pb; pb.x = pk2(st[i][8 * s2 + 0], st[i][8 * s2 + 1]); pb.y = pk2(st[i][8 * s2 + 2], st[i][8 * s2 + 3]); pb.z = pk2(st[i][8 * s2 + 4], st[i][8 * s2 + 5]); pb.w = pk2(st[i][8 * s2 + 6], st[i][8 * s2 + 7]);
                const bf16x8 Bs = __builtin_bit_cast(bf16x8, pb);
#pragma unroll
                for (int ot = 0; ot < 2; ++ot) {
                    LAS const unsigned char* qp = L + SC_Q + (32 * ot + r32) * SC_QSTR + (32 * i + 16 * s2 + 4 * hh) * 2;
                    const v2u a0 = *(const LAS v2u*)qp, a1 = *(const LAS v2u*)(qp + 16);
                    v4u pa; pa.x = a0.x; pa.y = a0.y; pa.z = a1.x; pa.w = a1.y;
                    oacc[ot] = __builtin_amdgcn_mfma_f32_32x32x16_bf16(__builtin_bit_cast(bf16x8, pa), Bs, oacc[ot], 0, 0, 0);
                }
            }
#pragma unroll
        for (int ot = 0; ot < 2; ++ot)
#pragma unroll
            for (int rg16 = 0; rg16 < 16; ++rg16) {
                const int tok = 32 * ot + (rg16 & 3) + 8 * (rg16 >> 2) + 4 * hh;
                *(LAS unsigned short*)(L + SC_O + tok * SC_OSTR + (32 * w + r32) * 2) = (unsigned short)f2bf(oacc[ot][rg16]);
            }
        }
        __syncthreads();
        if (c + 1 < NCHUNK) { SC_STORE(); if (SCAN_DUP & 16) { asm volatile("" ::: "memory"); SC_STORE(); } }
        for (int rep2_ = 0; rep2_ < ((SCAN_DUP & 2) ? 2 : 1); ++rep2_) {
        {
            const int tok = etok, cc = ecc;
            v4u ov[4]; float ss = 0.f;
#pragma unroll
            for (int i = 0; i < 4; ++i) ov[i] = *(const LAS v4u*)(L + SC_O + tok * SC_OSTR + cc * 16 + i * 128);
#pragma unroll
            for (int i = 0; i < 4; ++i) { const float a0 = bflo(ov[i].x), a1 = bfhi(ov[i].x), a2 = bflo(ov[i].y), a3 = bfhi(ov[i].y), a4 = bflo(ov[i].z), a5 = bfhi(ov[i].z), a6 = bflo(ov[i].w), a7 = bfhi(ov[i].w);
                ss += (a0 * a0 + a1 * a1) + (a2 * a2 + a3 * a3) + (a4 * a4 + a5 * a5) + (a6 * a6 + a7 * a7); }
            ss += __shfl_xor(ss, 1); ss += __shfl_xor(ss, 2); ss += __shfl_xor(ss, 4);
            const float rms = __builtin_amdgcn_rsqf(ss * (1.f / DV) + EPS);
            size_t ob_ = (t0 * D + h * DV) * 2; asm volatile("" : "+s"(ob_)); const unsigned vo_o = (unsigned)(tok * D * 2 + cc * 16);
#pragma unroll
            for (int i = 0; i < 4; ++i) {
                v4u o;
                o.x = pk2(bflo(ov[i].x) * rms * bflo(rr[i].x), bfhi(ov[i].x) * rms * bfhi(rr[i].x));
                o.y = pk2(bflo(ov[i].y) * rms * bflo(rr[i].y), bfhi(ov[i].y) * rms * bfhi(rr[i].y));
                o.z = pk2(bflo(ov[i].z) * rms * bflo(rr[i].z), bfhi(ov[i].z) * rms * bfhi(rr[i].z));
                o.w = pk2(bflo(ov[i].w) * rms * bflo(rr[i].w), bfhi(ov[i].w) * rms * bfhi(rr[i].w));
                *(v4u*)((char*)aout + ob_ + vo_o + i * 128) = o;
            }
        }
            }
    }
    __syncthreads();
#undef SC_LOAD
#undef SC_STORE
}
#ifndef P2_PARTS
#define P2_PARTS 3
#endif
__device__ __forceinline__ void f_scan_convert(Frame& F, int parts = 3) {
    constexpr int NITEM = NBATCH * GLA_H;
    const bool split = F.G >= 2 * NITEM;
    if ((parts & 1) && (!split || F.bid < NITEM)) for (int it = F.bid; it < NITEM; it += F.G) f_scan_item(F, it);
    if (!(parts & 2)) return;
    if (!split) f_convert_rest(F, F.bid * NWAVES + FWAVE, F.G * NWAVES);
    else if (F.bid >= NITEM) f_convert_rest(F, (F.bid - NITEM) * NWAVES + FWAVE, (F.G - NITEM) * NWAVES);
}

constexpr int SCAN_C1 = 20;
__device__ __forceinline__ void f_scan_outproj(Frame& F, const XcdBarrier& xbar) {
    constexpr int NITEM = NBATCH * GLA_H;
    if (F.bid < NITEM) f_scan_item(F, F.bid, &xbar, SCAN_C1);
    else { f_convert_rest(F, (F.bid - NITEM) * NWAVES + FWAVE, (F.G - NITEM) * NWAVES); xcd_barrier(xbar); f_gemm_out_rows(F, 0, SCAN_C1 / 4, NITEM); }
    xcd_barrier(xbar);
    f_gemm_out_rows(F, SCAN_C1 / 4, 8, 0);
}
constexpr int MX_W = 0, MX_WSTR = 272;
constexpr int MX_V0 = 34816, MX_VSTR = 320, MX_VBYTES = 40960;
constexpr int MX_MU = 116736;
constexpr int MX_LN = MX_MU + 2560;
__device__ __forceinline__ void f_mix(Frame& F, bf16* uout = nullptr) {
    LAS unsigned char* L = F.lds;
    LAS float* mu = (LAS float*)(L + MX_MU); LAS float* rs = mu + 128; LAS float* m1 = rs + 128; LAS float* m0 = m1 + 128; LAS float* bsg = m0 + 128;
    LAS float* lgs = (LAS float*)(L + MX_LN); LAS float* lbs = lgs + 512;
    bf16* u = WSP(bf16, WS_U); const bf16* v = WSP(bf16, WS_V); const float* st = WSP(float, WS_STATS); if (!uout) uout = u;
    const int tid = FTID, lane = FLANE, w = FWAVE;
    const int r32 = lane & 31, hh = lane >> 5, blk = (lane >> 4) & 1, q4 = (lane & 15) >> 2, p4 = lane & 3;
    const int ct = w >> 1, th = w & 1;
    const unsigned vo_v = (unsigned)(((tid >> 4) * SGU_HALF + (tid & 15) * 8) * 2), lo_v = (unsigned)(MX_V0 + (tid >> 4) * MX_VSTR + (tid & 15) * 16);
    constexpr int MX_MSTR = 272;
    for (int bn = F.bid; bn < T / SGU_BLK; bn += F.G) {
        const size_t t0 = (size_t)bn * SGU_BLK;
        __syncthreads();
        if (tid < 128) { float s = 0.f, q = 0.f;
            for (int p = 0; p < 32; ++p) { const pg8::f32x2 a = *(const pg8::f32x2*)(st + ((size_t)p * T + t0 + tid) * 2); s += a.x; q += a.y; }
            const float m = s * (1.f / SGU_HALF); mu[tid] = m; rs[tid] = __builtin_amdgcn_rsqf(fmaxf(q * (1.f / SGU_HALF) - m * m, 0.f) + EPS); }
        v4u preA[4], preB[4]; v4u uuA[4], uuB[4];
#define MX_LOAD(pre_, it_) do { size_t vb_ = (t0 * SGU_HALF + (size_t)(it_) * 128) * 2; asm volatile("" : "+s"(vb_)); \
        _Pragma("unroll") for (int i = 0; i < 4; ++i) pre_[i] = *(const v4u*)((const char*)v + vb_ + (size_t)(i * 32 * SGU_HALF * 2) + vo_v); } while (0)
#define MX_STORE(buf_, pre_) do { _Pragma("unroll") for (int i = 0; i < 4; ++i) *(LAS v4u*)(L + lo_v + (buf_) * MX_VBYTES + 32 * i * MX_VSTR) = pre_[i]; } while (0)
#define MX_ULOAD(uu_, it_) do { size_t ub_ = (t0 * SGU_HALF + (size_t)(it_) * 128) * 2; asm volatile("" : "+s"(ub_)); \
        _Pragma("unroll") for (int i = 0; i < 4; ++i) uu_[i] = *(const v4u*)((const char*)u + ub_ + (size_t)(i * 32 * SGU_HALF * 2) + vo_v); } while (0)
#define MX_TILE(it_, buf_, uu_) do { \
        f32x16 acc[2]; \
        _Pragma("unroll") for (int tt = 0; tt < 2; ++tt) _Pragma("unroll") for (int j = 0; j < 16; ++j) acc[tt][j] = 0.f; \
        LAS unsigned char* Vb = L + MX_V0 + (buf_) * MX_VBYTES; \
        const int nks = th == 0 ? 4 : 8; \
        for (int ks = 0; ks < nks; ++ks) { \
            const int srow = 16 * ks + 8 * hh + q4; \
            const s16x4 a0 = tr_read16(Vb + srow * MX_VSTR + (32 * ct + 16 * blk + 4 * p4) * 2), a1 = tr_read16(Vb + (srow + 4) * MX_VSTR + (32 * ct + 16 * blk + 4 * p4) * 2); \
            const bf16x8 Av = {a0[0], a0[1], a0[2], a0[3], a1[0], a1[1], a1[2], a1[3]}; \
            _Pragma("unroll") for (int tt = 0; tt < 2; ++tt) { \
                const bf16x8 Bw = *(const LAS bf16x8*)(L + MX_W + (64 * th + 32 * tt + r32) * MX_WSTR + (16 * ks + 8 * hh) * 2); \
                acc[tt] = __builtin_amdgcn_mfma_f32_32x32x16_bf16(Av, Bw, acc[tt], 0, 0, 0); } } \
        const int cl = ((it_) & 3) * 128 + 32 * ct + 4 * hh;                    \
        __syncthreads();                                                         \
        _Pragma("unroll") for (int tt = 0; tt < 2; ++tt) { \
            const int t = 64 * th + 32 * tt + r32; const float tm1 = m1[t], tm0 = m0[t], tb = bsg[t]; \
            _Pragma("unroll") for (int g4 = 0; g4 < 4; ++g4) { \
                const f32x4 lg = *(const LAS f32x4*)(lgs + cl + 8 * g4), lb = *(const LAS f32x4*)(lbs + cl + 8 * g4); \
                v2u o; o.x = pk2(lg[0] * (acc[tt][4 * g4 + 0] - tm1) + lb[0] * tm0 + tb, lg[1] * (acc[tt][4 * g4 + 1] - tm1) + lb[1] * tm0 + tb); \
                o.y = pk2(lg[2] * (acc[tt][4 * g4 + 2] - tm1) + lb[2] * tm0 + tb, lg[3] * (acc[tt][4 * g4 + 3] - tm1) + lb[3] * tm0 + tb); \
                *(LAS v2u*)(Vb + t * MX_MSTR + (32 * ct + 8 * g4 + 4 * hh) * 2) = o; } } \
        __syncthreads();                                                         \
        size_t ob_ = (t0 * SGU_HALF + (size_t)(it_) * 128) * 2; asm volatile("" : "+s"(ob_)); \
        _Pragma("unroll") for (int i = 0; i < 4; ++i) { \
            const v4u mx = *(const LAS v4u*)(Vb + ((tid >> 4) + 32 * i) * MX_MSTR + (tid & 15) * 16); const v4u ux = uu_[i]; v4u o; \
            o.x = pk2(bflo(ux.x) * bflo(mx.x), bfhi(ux.x) * bfhi(mx.x)); o.y = pk2(bflo(ux.y) * bflo(mx.y), bfhi(ux.y) * bfhi(mx.y)); \
            o.z = pk2(bflo(ux.z) * bflo(mx.z), bfhi(ux.z) * bfhi(mx.z)); o.w = pk2(bflo(ux.w) * bflo(mx.w), bfhi(ux.w) * bfhi(mx.w)); \
            *(v4u*)((char*)uout + ob_ + (size_t)(i * 32 * SGU_HALF * 2) + vo_v) = o; } } while (0)
        MX_LOAD(preA, 0); MX_LOAD(preB, 1); MX_ULOAD(uuA, 0);
        for (int it = 0; it < 16; it += 2) {
            if ((it & 3) == 0) {
                const int g = it >> 2;
                __syncthreads();
                const int t = tid >> 2, sq = tid & 3; const float* wsrc = F.inp(I_SGU_WS) + ((size_t)g * 128 + t) * 128 + sq * 32;
                float a1 = 0.f, a0 = 0.f;
#pragma unroll
                for (int i = 0; i < 4; ++i) {
                    const f32x4 x0 = *(const f32x4*)(wsrc + i * 8), x1 = *(const f32x4*)(wsrc + i * 8 + 4); float wv[8] = {x0[0], x0[1], x0[2], x0[3], x1[0], x1[1], x1[2], x1[3]}; float hv[8];
#pragma unroll
                    for (int j = 0; j < 8; ++j) { const int s = sq * 32 + i * 8 + j; const float wm = ((t >> 6) >= (s >> 6)) ? wv[j] : 0.f; a0 += wm; hv[j] = wm * rs[s]; }
                    v4u o; o.x = pk2(hv[0], hv[1]); o.y = pk2(hv[2], hv[3]); o.z = pk2(hv[4], hv[5]); o.w = pk2(hv[6], hv[7]);
                    const unsigned ow[4] = {o.x, o.y, o.z, o.w};
#pragma unroll
                    for (int j = 0; j < 4; ++j) a1 += bflo(ow[j]) * mu[sq * 32 + i * 8 + 2 * j] + bfhi(ow[j]) * mu[sq * 32 + i * 8 + 2 * j + 1];
                    *(LAS v4u*)(L + MX_W + t * MX_WSTR + (sq * 32 + i * 8) * 2) = o;
                }
                a1 += __shfl_xor(a1, 1); a1 += __shfl_xor(a1, 2); a0 += __shfl_xor(a0, 1); a0 += __shfl_xor(a0, 2);
                if (sq == 0) { m1[t] = a1; m0[t] = a0; }
                if (tid < 128) bsg[tid] = F.inp(I_SGU_BS)[g * 128 + tid];
                lgs[tid] = F.inp(I_SGU_LNG)[g * SGU_GC + tid]; lbs[tid] = F.inp(I_SGU_LNB)[g * SGU_GC + tid];
            }
            MX_STORE(0, preA);
            __syncthreads();
            if (it + 2 < 16) MX_LOAD(preA, it + 2);
            MX_ULOAD(uuB, it + 1);
            MX_TILE(it, 0, uuA);
            MX_STORE(1, preB);
            __syncthreads();
            if (it + 3 < 16) MX_LOAD(preB, it + 3);
            if (it + 2 < 16) MX_ULOAD(uuA, it + 2);
            MX_TILE(it + 1, 1, uuB);
        }
#undef MX_LOAD
#undef MX_STORE
#undef MX_ULOAD
#undef MX_TILE
    }
}
constexpr int RW_STR = 2064;
constexpr int RW_LG = 48 * RW_STR;
constexpr int RW_HIST = RW_LG + 8 * 16 * 48 * 4;
template <int MODE> __device__ __forceinline__ void f_rowgroup(Frame& F, int Lyr) {
    constexpr int NCT = MODE == 0 ? 1 : 3;
    LAS unsigned char* L = F.lds;
    const int tid = FTID, lane = FLANE, w = FWAVE, rw = lane & 15, q = lane >> 4;
    const float* xsrc = F.inp(I_X);
    bf16* xb = WSP(bf16, WS_XN); float* rsout = WSP(float, WS_RS);
    __syncthreads();
    for (int k = tid; k < D; k += NTHREADS) {
        if (MODE == 0) {
            const float gn = F.inp(I_GLA_NORM)[k]; const float* wr_ = F.inp(I_GLA_WIN) + (size_t)k * GLA_IN + NQKVR;
#pragma unroll
            for (int c4 = 0; c4 < 4; ++c4) { const f32x4 x = *(const f32x4*)(wr_ + 4 * c4);
#pragma unroll
                for (int j = 0; j < 4; ++j) *(LAS unsigned short*)(L + (4 * c4 + j) * RW_STR + k * 2) = (unsigned short)f2bf(x[j] * gn); }
        } else {
            const float gn = F.inp(I_MOE_NORM)[Lyr * D + k];
            const f32x4 xg = *(const f32x4*)(F.inp(I_MOE_WG) + ((size_t)Lyr * D + k) * 4);
#pragma unroll
            for (int j = 0; j < 4; ++j) *(LAS unsigned short*)(L + j * RW_STR + k * 2) = (unsigned short)f2bf(xg[j] * gn);
#pragma unroll
            for (int g = 0; g < 4; ++g) { const float* ws_ = F.inp(I_MOE_WSUB) + (((size_t)Lyr * 4 + g) * D + k) * EPG; const f32x4 a = *(const f32x4*)ws_, b = *(const f32x4*)(ws_ + 4);
#pragma unroll
                for (int j = 0; j < 4; ++j) { *(LAS unsigned short*)(L + (4 + 8 * g + j) * RW_STR + k * 2) = (unsigned short)f2bf(a[j] * gn); *(LAS unsigned short*)(L + (8 + 8 * g + j) * RW_STR + k * 2) = (unsigned short)f2bf(b[j] * gn); } }
#pragma unroll
            for (int c = 36; c < 48; ++c) *(LAS unsigned short*)(L + c * RW_STR + k * 2) = 0;
        }
    }
    LAS int* hist = (LAS int*)(L + RW_HIST); LAS int* hbase = hist + 32;
    if (MODE == 1 && tid < 32) hist[tid] = 0;
    __syncthreads();
    const int ngroups = T / 16, niter = (ngroups + F.G * NWAVES - 1) / (F.G * NWAVES);
    for (int iter = 0; iter < niter; ++iter) {
        const int grp = (iter * F.G + F.bid) * NWAVES + w; const bool valid = grp < ngroups;
        const size_t row = (size_t)grp * 16 + rw;
        float rstd = 0.f; pg8::f32x4 acc[NCT];
        if (valid) {
#pragma unroll
            for (int c = 0; c < NCT; ++c) acc[c] = (pg8::f32x4){0.f, 0.f, 0.f, 0.f};
            float ss = 0.f;
#pragma unroll 8
            for (int s = 0; s < 32; ++s) {
                v4u pa;
                if (MODE == 0) {
                    const float* xr = xsrc + row * D + 8 * q + 32 * s;
                    const f32x4 x0 = *(const f32x4*)xr, x1 = *(const f32x4*)(xr + 4);
                    ss += (x0[0] * x0[0] + x0[1] * x0[1]) + (x0[2] * x0[2] + x0[3] * x0[3]) + (x1[0] * x1[0] + x1[1] * x1[1]) + (x1[2] * x1[2] + x1[3] * x1[3]);
                    pa.x = pk2(x0[0], x0[1]); pa.y = pk2(x0[2], x0[3]); pa.z = pk2(x1[0], x1[1]); pa.w = pk2(x1[2], x1[3]);
                    *(v4u*)(xb + row * D + 8 * q + 32 * s) = pa;
                } else {
                    pa = *(const v4u*)(xb + row * D + 8 * q + 32 * s);
                    const float a0 = bflo(pa.x), a1 = bfhi(pa.x), a2 = bflo(pa.y), a3 = bfhi(pa.y), a4 = bflo(pa.z), a5 = bfhi(pa.z), a6 = bflo(pa.w), a7 = bfhi(pa.w);
                    ss += (a0 * a0 + a1 * a1) + (a2 * a2 + a3 * a3) + (a4 * a4 + a5 * a5) + (a6 * a6 + a7 * a7);
                }
                const bf16x8 A = __builtin_bit_cast(bf16x8, pa);
#pragma unroll
                for (int c = 0; c < NCT; ++c) { const bf16x8 B = *(const LAS bf16x8*)(L + (16 * c + rw) * RW_STR + (32 * s + 8 * q) * 2); acc[c] = __builtin_amdgcn_mfma_f32_16x16x32_bf16(A, B, acc[c], 0, 0, 0); }
            }
            ss += __shfl_xor(ss, 16); ss += __shfl_xor(ss, 32);
            rstd = __builtin_amdgcn_rsqf(ss * (1.f / D) + EPS);
            if (q == 0) rsout[row] = rstd;
        }
        float rs4[4];
#pragma unroll
        for (int i = 0; i < 4; ++i) rs4[i] = __shfl(rstd, 4 * q + i);
        int e1 = 0, e2 = 0, rk1 = 0, rk2 = 0; float gt1 = 0.f, gt2 = 0.f;
        if (MODE == 0) {
            if (valid) {
                float* glr = WSP(float, WS_GLR);
#pragma unroll
                for (int i = 0; i < 4; ++i) glr[((size_t)grp * 16 + 4 * q + i) * RANK + rw] = acc[0][i] * rs4[i];
            }
        } else {
            LAS float* lgw = (LAS float*)(L + RW_LG) + w * 16 * 48;
            if (valid) {
#pragma unroll
                for (int c = 0; c < NCT; ++c)
#pragma unroll
                    for (int i = 0; i < 4; ++i) lgw[(4 * q + i) * 48 + 16 * c + rw] = acc[c][i] * rs4[i];
            }
            LDS_WAIT(); asm volatile("" ::: "memory");
            if (valid && lane < 16) {
                const LAS float* lr = lgw + lane * 48; const float* bg = F.inp(I_MOE_BG) + Lyr * 4;
                float lg[4];
#pragma unroll
                for (int c = 0; c < 4; ++c) lg[c] = lr[c] + bg[c];
                int g = 0; float gm = lg[0];
#pragma unroll
                for (int c = 1; c < 4; ++c) if (lg[c] > gm) { gm = lg[c]; g = c; }
                float gs = 0.f;
#pragma unroll
                for (int c = 0; c < 4; ++c) gs += __expf(lg[c] - gm);
                const float g_w = 1.f / gs; const float* bs = F.inp(I_MOE_BSUB) + (Lyr * 4 + g) * EPG;
                int i1 = 0, i2 = 0; float m1v = -3.0e38f, m2v = -3.0e38f;
                for (int e = 0; e < EPG; ++e) { const float x = lr[4 + 8 * g + e] + bs[e];
                    if (x > m1v) { m2v = m1v; i2 = i1; m1v = x; i1 = e; } else if (x > m2v) { m2v = x; i2 = e; } }
                const float w1 = 1.f / (1.f + __expf(m2v - m1v));
                e1 = g * EPG + i1; e2 = g * EPG + i2; gt1 = g_w * w1; gt2 = g_w * (1.f - w1);
                rk1 = __hip_atomic_fetch_add(&hist[e1], 1, __ATOMIC_RELAXED, __HIP_MEMORY_SCOPE_WORKGROUP); rk2 = __hip_atomic_fetch_add(&hist[e2], 1, __ATOMIC_RELAXED, __HIP_MEMORY_SCOPE_WORKGROUP);
            }
            __syncthreads();
            if (tid < 32) { const int hcount = hist[tid]; hbase[tid] = hcount ? (int)atomicAdd(WSP(unsigned, WS_CTL) + CW_CNT + Lyr * 2048 + 64 * tid, (unsigned)hcount) : 0; hist[tid] = 0; }
            __syncthreads();
            if (valid && lane < 16) {
                const int tok = grp * 16 + lane; const int p1 = hbase[e1] + rk1, p2 = hbase[e2] + rk2;
                WSP(int, WS_LIST)[(size_t)e1 * T + p1] = tok * 2; WSP(int, WS_LIST)[(size_t)e2 * T + p2] = tok * 2 + 1;
                WSP(float, WS_GATE)[tok * 2] = gt1; WSP(float, WS_GATE)[tok * 2 + 1] = gt2;
            }
        }
    }
    __syncthreads();
}
template <bool FINAL> __device__ __forceinline__ void f_rowadd(Frame& F, bool scratch = false) {
    bf16* xb = WSP(bf16, WS_XN); const bf16* y = WSP(bf16, WS_Y); float* rsout = scratch ? (float*)F.out + (size_t)T * 600 : WSP(float, WS_RS); bf16* xo = scratch ? (bf16*)F.out : xb;
    const int lane = FLANE, w = FWAVE;
    f32x4 gf[4];
    if (FINAL) {
#pragma unroll
        for (int j = 0; j < 2; ++j) { gf[2 * j] = *(const f32x4*)(F.inp(I_FINAL) + 8 * lane + 512 * j); gf[2 * j + 1] = *(const f32x4*)(F.inp(I_FINAL) + 8 * lane + 512 * j + 4); }
    }
    for (int r0 = (F.bid * NWAVES + w) * 2; r0 < T; r0 += F.G * NWAVES * 2) {
        v4u xa[2][2], ya[2][2], yb[2][2];
#pragma unroll
        for (int rr = 0; rr < 2; ++rr)
#pragma unroll
            for (int j = 0; j < 2; ++j) { const size_t o = (size_t)(r0 + rr) * D + 8 * lane + 512 * j;
                xa[rr][j] = *(const v4u*)(xb + o); ya[rr][j] = *(const v4u*)(y + o); yb[rr][j] = *(const v4u*)(y + (size_t)T * D + o); }
#pragma unroll
        for (int rr = 0; rr < 2; ++rr) {
            float v[16]; float ss = 0.f;
#pragma unroll
            for (int j = 0; j < 2; ++j) {
                const unsigned xw[4] = {xa[rr][j].x, xa[rr][j].y, xa[rr][j].z, xa[rr][j].w}, aw[4] = {ya[rr][j].x, ya[rr][j].y, ya[rr][j].z, ya[rr][j].w}, bw[4] = {yb[rr][j].x, yb[rr][j].y, yb[rr][j].z, yb[rr][j].w};
#pragma unroll
                for (int e = 0; e < 4; ++e) { const float lo = bflo(xw[e]) + bflo(aw[e]) + bflo(bw[e]), hi = bfhi(xw[e]) + bfhi(aw[e]) + bfhi(bw[e]); v[8 * j + 2 * e] = lo; v[8 * j + 2 * e + 1] = hi; ss += lo * lo + hi * hi; }
            }
            const float rstd = __builtin_amdgcn_rsqf(wave_sum(ss) * (1.f / D) + EPS);
            const size_t ro = (size_t)(r0 + rr) * D + 8 * lane;
            if (FINAL) {
#pragma unroll
                for (int j = 0; j < 2; ++j) {
                    f32x4 o0 = {v[8 * j] * rstd, v[8 * j + 1] * rstd, v[8 * j + 2] * rstd, v[8 * j + 3] * rstd}, o1 = {v[8 * j + 4] * rstd, v[8 * j + 5] * rstd, v[8 * j + 6] * rstd, v[8 * j + 7] * rstd};
                    *(f32x4*)(F.out + ro + 512 * j) = o0 * gf[2 * j]; *(f32x4*)(F.out + ro + 512 * j + 4) = o1 * gf[2 * j + 1]; }
            } else {
#pragma unroll
                for (int j = 0; j < 2; ++j) { v4u o; o.x = pk2(v[8 * j], v[8 * j + 1]); o.y = pk2(v[8 * j + 2], v[8 * j + 3]); o.z = pk2(v[8 * j + 4], v[8 * j + 5]); o.w = pk2(v[8 * j + 6], v[8 * j + 7]); *(v4u*)(xo + ro + 512 * j) = o; }
                if (lane == 0) rsout[r0 + rr] = rstd;
            }
        }
    }
}
__device__ __forceinline__ void f_prep0(Frame& F) { f_convert_gla(F); f_rowgroup<0>(F, 0); }
__device__ __forceinline__ void f_rowpass_router(Frame& F, int L) { f_rowgroup<1>(F, L); }
__device__ __forceinline__ void f_rowpass_add(Frame& F, bool scratch = false) { f_rowadd<false>(F, scratch); }
__device__ __forceinline__ void f_final(Frame& F) { f_rowadd<true>(F); }
constexpr int LDS_BYTES = 155648;
struct Args { const float* in[23]; float* out; unsigned char* ws; int ph_lo, ph_hi; };
#define NAIVE(k) ((NAIVE_MASK >> (k)) & 1u)
#ifndef P1_FOLD
#define P1_FOLD 0
#endif
#ifndef DUP_MASK
#define DUP_MASK 0u
#endif
#define DUP(k) ((DUP_MASK >> (k)) & 1u)

struct EpiN1 { bf16* o; __device__ void operator()(int r, int c, float v) const { o[(size_t)r * NQKVR + c] = (bf16)f2bf(v); } };
struct EpiN3 { const float* res; float* o; __device__ void operator()(int r, int c, float v) const { o[(size_t)r * D + c] = res[(size_t)r * D + c] + v; } };
struct EpiN8 { bf16* u; bf16* v; __device__ void operator()(int r, int c, float x) const { const float z = gelu_erf(x); if (c < SGU_HALF) u[(size_t)r * SGU_HALF + c] = (bf16)f2bf(z); else v[(size_t)r * SGU_HALF + c - SGU_HALF] = (bf16)f2bf(z); } };

__global__ void __launch_bounds__(NTHREADS, 2) fwd(Args args) {
    extern __shared__ __attribute__((aligned(16))) unsigned char lds_raw[];
    Frame F;
    F.lds = (LAS unsigned char*)lds_raw;
    F.G = gridDim.x; F.bid = blockIdx.x;
    F.out = args.out; F.ws = args.ws;
    if (FTID == 0) {
        LAS unsigned long long* pt = (LAS unsigned long long*)(F.lds + LX_PTR);
#pragma unroll
        for (int i = 0; i < 23; ++i) pt[i] = (unsigned long long)args.in[i];
    }
    __syncthreads();
    const int lo = args.ph_lo, hi = args.ph_hi;
#if ONE_LAUNCH
    cg::grid_group grid = cg::this_grid();
    volatile LAS unsigned* bst = (volatile LAS unsigned*)(F.lds + LX_PTR + 192);
    if (FTID < 2) bst[FTID] = 0u;
    __syncthreads();
    const XcdBarrier xbar = xcd_barrier_post(WSP(unsigned, WS_CTL) + CW_BAR, bst);
#define GRID_BAR() xcd_barrier(xbar)
#define GRID_BAR_CG() grid.sync()
#else
#define GRID_BAR_CG() do { } while (0)
#define GRID_BAR() do { } while (0)
#endif
#define IN(k) (lo <= (k) && (k) < hi)
#define SEAM(k) do { if (IN(k) && IN((k) + 1)) GRID_BAR(); } while (0)

    if (IN(0)) {
        if (NAIVE(0)) { n_convert_gla(F); n_rowpass<0>(F, 0); } else { f_prep0(F); if (DUP(0)) { GRID_BAR(); f_prep0(F); } }
    }
    if (IN(0) && IN(1)) GRID_BAR();
    if (lo > 1000) GRID_BAR_CG();
    if (IN(1)) {
        if (NAIVE(1)) n_gemm(F, WSP(bf16, WS_XN), D, WSP(bf16, WS_WIN), D, T, NQKVR, D, EpiN1{WSP(bf16, WS_QKVR)}); else { f_gemm_in(F); if (DUP(1)) { GRID_BAR(); f_gemm_in(F, P1_FOLD); } }
    }
    SEAM(1);
#if ONE_LAUNCH
    if (!NAIVE(2) && !NAIVE(3) && F.G >= 128) { if (IN(2)) f_scan_outproj(F, xbar); }
    else
#endif
    {
    if (IN(2)) {
        if (NAIVE(2)) { n_scan(F); n_convert_rest(F); } else { f_scan_convert(F); if (DUP(2)) { GRID_BAR(); f_scan_convert(F, P2_PARTS); } }
    }
    SEAM(2);
    if (IN(3)) {
        if (NAIVE(3)) n_gemm(F, WSP(bf16, WS_XN), D, WSP(bf16, WS_WOUT), D, T, D, HV, EpiN3{F.inp(I_X), F.out}); else { if (DUP(3)) { f_gemm_out(F, (bf16*)F.out); GRID_BAR(); } f_gemm_out(F); }
    }
    }
    SEAM(3);
#define MOE_BLOCK(L, pb) do { \
        if (IN(pb)) { if (NAIVE(pb)) n_rowpass<1>(F, L); else f_rowpass_router(F, L); } \
        SEAM(pb); \
        if (IN((pb) + 1)) { if (NAIVE((pb) + 1)) n_moe(F, L); else { f_moe1(F, L); if (DUP((pb) + 1)) { GRID_BAR(); f_moe1(F, L); } } } \
        SEAM((pb) + 1); \
        if (IN((pb) + 2)) { if (!NAIVE((pb) + 1)) { f_moe2(F, L); if (DUP((pb) + 2)) { GRID_BAR(); f_moe2(F, L); } } } \
        SEAM((pb) + 2); } while (0)
    MOE_BLOCK(0, 4);
    if (IN(7)) { if (NAIVE(7)) n_rowpass<2>(F, 0); else { if (DUP(7)) { f_rowpass_add(F, true); GRID_BAR(); } f_rowpass_add(F); } }
    SEAM(7);
    if (IN(8)) { if (NAIVE(8)) n_gemm(F, WSP(bf16, WS_XN), D, WSP(bf16, WS_WSIN), D, T, SGU_FFN, D, EpiN8{WSP(bf16, WS_U), WSP(bf16, WS_V)}); else { f_gemm_sgu_in(F); if (DUP(8)) { GRID_BAR(); f_gemm_sgu_in(F); } } }
    if (NAIVE(8)) { SEAM(8); if (IN(9)) n_stats(F); SEAM(9); } else { if (IN(8) && IN(10)) GRID_BAR(); }
    if (IN(10)) { if (NAIVE(10)) n_mix(F); else { if (DUP(10)) { f_mix(F, (bf16*)F.out); GRID_BAR(); } f_mix(F); } }
    SEAM(10);
    if (IN(11)) { if (NAIVE(11)) n_gemm(F, WSP(bf16, WS_U), SGU_HALF, WSP(bf16, WS_WSOUT), SGU_HALF, T, D, SGU_HALF, EpiN3{F.out, F.out}); else { if (DUP(11)) { f_gemm_sgu_out(F, (bf16*)F.out); GRID_BAR(); } f_gemm_sgu_out(F); } }
    SEAM(11);
    MOE_BLOCK(1, 12);
    if (IN(15)) { if (NAIVE(15)) n_rowpass<3>(F, 0); else f_final(F); }
}

extern "C" void kernel_launch(void* const* d_in, const int* in_sizes, int n_in, void* d_out, int out_size, void* d_ws, size_t ws_size, hipStream_t stream) {
    static int grid = 0;
    if (grid == 0) {
        if (n_in != 23 || out_size != T * D || ws_size < WS_END) { fprintf(stderr, "kernel_launch: unexpected shapes (n_in %d out %d ws %zu)\n", n_in, out_size, ws_size); grid = -1; return; }
        int dev = 0, cus = 0, per_cu = 0;
        hipGetDevice(&dev); hipDeviceGetAttribute(&cus, hipDeviceAttributeMultiprocessorCount, dev);
        hipFuncSetAttribute((const void*)fwd, hipFuncAttributeMaxDynamicSharedMemorySize, LDS_BYTES);
        hipOccupancyMaxActiveBlocksPerMultiprocessor(&per_cu, (const void*)fwd, NTHREADS, LDS_BYTES);
        (void)hipGetLastError();
        if (per_cu < 1) { fprintf(stderr, "kernel_launch: occupancy query says %d blocks per CU\n", per_cu); per_cu = 1; }
        grid = cus;
    }
    if (grid < 0) return;
    hipMemsetAsync((char*)d_ws + WS_CTL, 0, CTL_ZERO_BYTES, stream);
    Args a{};
    for (int i = 0; i < 23; ++i) a.in[i] = (const float*)d_in[i];
    a.out = (float*)d_out; a.ws = (unsigned char*)d_ws;
#if ONE_LAUNCH
    a.ph_lo = 0; a.ph_hi = 16;
    void* kargs[] = {&a};
    hipError_t e = hipLaunchCooperativeKernel((const void*)fwd, dim3(grid), dim3(NTHREADS), kargs, LDS_BYTES, stream);
    if (e != hipSuccess) fprintf(stderr, "cooperative launch failed: %s (grid %d)\n", hipGetErrorString(e), grid);
#else
    for (int p = 0; p < 16; ++p) {
        if (p == 9 && !NAIVE(8)) continue;
        if ((p == 6 || p == 14) && NAIVE(p - 1)) continue;
        a.ph_lo = p; a.ph_hi = p + 1;
        hipLaunchKernelGGL(fwd, dim3(grid), dim3(NTHREADS), LDS_BYTES, stream, a);
    }
#endif
}
```

```cpp
#define NAIVE_MASK 0x0u
#define ONE_LAUNCH 1
#include <hip/hip_runtime.h>
#include <hip/hip_cooperative_groups.h>
#include <cstdio>
#include <cstdint>
namespace cg = cooperative_groups;

#ifndef NAIVE_MASK
#define NAIVE_MASK 0x0u
#endif
#ifndef ONE_LAUNCH
#define ONE_LAUNCH 1
#endif

constexpr int T = 32768, D = 1024, NBATCH = 16, SEQ = 2048;
constexpr int GLA_H = 4, DK = 128, DV = 256, HK = 512, HV = 1024, RANK = 16, GLA_IN = 3088, NQKVR = 3072, CHUNK = 64, NCHUNK = 32;
constexpr int SGU_FFN = 4096, SGU_HALF = 2048, SGU_BLK = 128, SGU_GC = 512;
constexpr int NE = 32, EPG = 8, FF = 512;
constexpr float EPS = 1e-6f;
constexpr int NTHREADS = 512, NWAVES = 8;
constexpr int NPHASE = 15;

constexpr size_t MiB = 1u << 20;
constexpr size_t WS_CTL = 0, CTL_ZERO_BYTES = 128 * 1024;
constexpr size_t WS_GLR = 1 * MiB;
constexpr size_t WS_GATE = 3 * MiB;
constexpr size_t WS_EID = 3 * MiB + 512 * 1024;
constexpr size_t WS_STATS = 4 * MiB;
constexpr size_t WS_LIST = 12 * MiB;
constexpr size_t WS_WIN = 16 * MiB;
constexpr size_t WS_WOUT = 22 * MiB;
constexpr size_t WS_WSIN = 24 * MiB;
constexpr size_t WS_WSOUT = 32 * MiB;
constexpr size_t WS_W13 = 36 * MiB;
constexpr size_t WS_W2 = 164 * MiB;
constexpr size_t WS_XN = 228 * MiB;
constexpr size_t WS_AOUT = 484 * MiB;
constexpr size_t WS_RS = 3 * MiB + 256 * 1024;
constexpr size_t WS_QKVR = 292 * MiB;
constexpr size_t WS_HID = 292 * MiB;
constexpr size_t WS_Y = 364 * MiB;
constexpr size_t WS_U = 292 * MiB;
constexpr size_t WS_V = 420 * MiB;
constexpr size_t WS_END = 548 * MiB;
constexpr int CW_BAR = 1024;
constexpr int CW_HID = 16384;
constexpr int CW_CNT = 8192;

#define GAS __attribute__((address_space(1)))
#define LAS __attribute__((address_space(3)))
typedef unsigned short bf16;
typedef unsigned v4u __attribute__((ext_vector_type(4)));
typedef unsigned v2u __attribute__((ext_vector_type(2)));
typedef float f32x4 __attribute__((ext_vector_type(4)));
typedef float f32x16 __attribute__((ext_vector_type(16)));
typedef short bf16x8 __attribute__((ext_vector_type(8)));
typedef short s16x4 __attribute__((ext_vector_type(4)));
#define LDS_WAIT() asm volatile("s_waitcnt lgkmcnt(0)" ::: "memory")
#define VM_WAIT() asm volatile("s_waitcnt vmcnt(0)" ::: "memory")
typedef float f32x2_t __attribute__((ext_vector_type(2))); typedef __bf16 bf16x2_t __attribute__((ext_vector_type(2)));
__device__ __forceinline__ unsigned pk2(float lo, float hi) { f32x2_t v = {lo, hi}; bf16x2_t b = __builtin_convertvector(v, bf16x2_t); return __builtin_bit_cast(unsigned, b); }
__device__ __forceinline__ unsigned f2bf(float f) { return pk2(f, 0.f) & 0xffffu; }
__device__ __forceinline__ float bf2f(unsigned short b) { return __builtin_bit_cast(float, (unsigned)b << 16); }
__device__ __forceinline__ float bflo(unsigned w) { return __builtin_bit_cast(float, w << 16); }
__device__ __forceinline__ float bfhi(unsigned w) { return __builtin_bit_cast(float, w & 0xffff0000u); }
__device__ __forceinline__ float wave_sum(float v) {
#pragma unroll
    for (int o = 1; o < 64; o <<= 1) v += __shfl_xor(v, o);
    return v;
}
__device__ __forceinline__ float silu_f(float x) { return x * __builtin_amdgcn_rcpf(1.f + __expf(-x)); }
__device__ __forceinline__ float gelu_erf(float x) { return 0.5f * x * (1.f + erff(x * 0.70710678118654752f)); }
__device__ __forceinline__ float logsigmoid_f(float x) { return fminf(x, 0.f) - log1pf(__expf(-fabsf(x))); }
namespace pg8 {
#define PG8_LAS __attribute__((address_space(3)))
typedef unsigned short bf16_t;
typedef short bf16x8 __attribute__((ext_vector_type(8)));
typedef float f32x4 __attribute__((ext_vector_type(4)));
typedef unsigned u32x4 __attribute__((ext_vector_type(4)));
constexpr int BM = 256, BK = 64, HALF = 128, HTB = HALF * BK * 2  , STAGE_BYTES = 8 * HTB, NXCD = 8, WGM = 8;

__host__ __device__ __forceinline__ int lds_byte(int r, int c) { const int st = (r >> 4) * 2 + (c >> 5), rr = r & 15, cc = c & 31, ob = rr * 64 + cc * 2; return st * 1024 + (ob ^ (((ob >> 9) & 1) << 5)); }
__host__ __device__ __forceinline__ void stage_rc(int b, int& R, int& C) { const int st = b / 1024, sb = b % 1024, swz = sb ^ (((sb >> 9) & 1) << 5); R = (st >> 1) * 16 + swz / 64; C = (st & 1) * 32 + (swz % 64) / 2; }
__host__ __device__ __forceinline__ int perm32(int rho) { const int n = rho >> 4, i = rho & 15; return 8 * (i >> 2) + 4 * n + (i & 3); }

struct Unit { int pm, pn, e, slot; };

struct DenseOrder {
    static constexpr bool GATHER = false;
    int nM, nN, nwg, G, c, K; const char* Bt;
    __device__ void init(int M, int N, int K_, const bf16_t* Bt_, int G_, int c_) { nM = M / BM; nN = N / BM; nwg = nM * nN; G = G_; c = c_; K = K_; Bt = (const char*)Bt_; }
    __device__ __forceinline__ bool next(int i, Unit& u) const {
        const long L = (long)i * G + c; if (L >= nwg) return false;
        int wgid = (int)L; { const int q = nwg / NXCD, r = nwg % NXCD, xcd = wgid % NXCD, off = wgid / NXCD; wgid = (xcd < r ? xcd * (q + 1) : r * (q + 1) + (xcd - r) * q) + off; }
        const int nig = WGM * nN, gid = wgid / nig, fm = gid * WGM, gsz = (nM - fm) < WGM ? (nM - fm) : WGM;
        u.pm = fm + ((wgid % nig) % gsz); u.pn = (wgid % nig) / gsz; u.e = 0; u.slot = 0; return true;
    }
    __device__ __forceinline__ const char* bptr(const Unit& u) const { return Bt + (size_t)u.pn * BM * K * 2; }
    __device__ __forceinline__ size_t abase(const Unit& u) const { return (size_t)u.pm * BM * K * 2; }
    __device__ __forceinline__ unsigned aoff(const Unit& u, int h, int R, int C) const { return (unsigned)(((u.pm * BM + h * HALF + R) * K + C) * 2); }
    __device__ __forceinline__ void a_ready(const Unit&) const {}
    __device__ __forceinline__ void done(const Unit&) const {}
};

__device__ __forceinline__ unsigned cvt_pk_bf16(float lo, float hi) { unsigned r; asm volatile("v_cvt_pk_bf16_f32 %0, %1, %2" : "=v"(r) : "v"(lo), "v"(hi)); return r; }
typedef float f32x2 __attribute__((ext_vector_type(2)));
__device__ __forceinline__ f32x2 gelu_pk(f32x2 v) {
    const f32x2 av = __builtin_elementwise_abs(v), d = av * 0.2316418882f + 1.0f;
    f32x2 t; t.x = __builtin_amdgcn_rcpf(d.x); t.y = __builtin_amdgcn_rcpf(d.y);
    f32x2 q = t * 0.5307027145f + (-0.7265760135f); q = q * t + 0.7107068705f; q = q * t + (-0.142248368f); q = q * t + 0.127414796f; q = q * t;
    const f32x2 s = (v * v) * (-0.72134752044f);
    f32x2 e; e.x = __builtin_amdgcn_exp2f(s.x); e.y = __builtin_amdgcn_exp2f(s.y);
    const f32x2 m = v * (q * e), r = v - m;
    f32x2 o; o.x = v.x < 0.f ? m.x : r.x; o.y = v.y < 0.f ? m.y : r.y; return o;
}

template <class Epi, class Sched>
__device__ __forceinline__ void gemm_phase(PG8_LAS unsigned char* lds, const bf16_t* Abase, const int K, const Sched& S, const Epi& E) {
    const int tid = threadIdx.x, wid = __builtin_amdgcn_readfirstlane(tid >> 6), lane = tid & 63, wr = wid >> 2, wc = wid & 3, fr = lane & 15, fq = lane >> 4;
    const int nt = K / BK;
    int sR[2], sC[2]; unsigned voffA[2], voffB[2];
#pragma unroll
    for (int i = 0; i < 2; ++i) { stage_rc(tid * 16 + i * 8192, sR[i], sC[i]); const int Rb = Epi::PERM ? ((sR[i] & ~31) + perm32(sR[i] & 31)) : sR[i];
        voffA[i] = (unsigned)(sR[i] * K + sC[i]) * 2u; voffB[i] = (unsigned)(Rb * K + sC[i]) * 2u; }
    const size_t kstep = (size_t)(BK * 2);
    const size_t hstep = (size_t)HALF * K * 2;
    const unsigned ldsw = (unsigned)wid * 1024u;
    const int aoff = lds_byte(wr * 64 + fr, fq * 8), boff = lds_byte(wc * 32 + fr, fq * 8);
    const char* const Ab = (const char*)Abase;
#define PG8_SA(b, h) (((b) * 2 + (h)) * HTB)
#define PG8_SB(b, h) ((4 + (b) * 2 + (h)) * HTB)
#define PG8_STAGE(bufoff, gbase, voff) do { _Pragma("unroll") for (int _i = 0; _i < 2; ++_i) \
        __builtin_amdgcn_global_load_lds((const unsigned*)((const char*)(gbase) + (voff)[_i]), (PG8_LAS unsigned*)(lds + (bufoff) + ldsw + _i * 8192), 16, 0, 0); } while (0)
#define PG8_STAGE_A(bufoff, nx, h, kt) do { if constexpr (Sched::GATHER) { PG8_STAGE(bufoff, Ab + (size_t)(kt) * kstep, gc[h]); } \
        else PG8_STAGE(bufoff, ((nx) ? xA : cA) + (size_t)(h) * hstep + (size_t)(kt) * kstep, voffA); } while (0)
#define PG8_LDA(dst, b, h) do { _Pragma("unroll") for (int m = 0; m < 4; ++m) _Pragma("unroll") for (int k = 0; k < 2; ++k) dst[m][k] = *(const PG8_LAS bf16x8*)(lds + PG8_SA(b, h) + aoff + m * 2048 + k * 1024); } while (0)
#define PG8_LDB(dst, b, h) do { _Pragma("unroll") for (int n = 0; n < 2; ++n) _Pragma("unroll") for (int k = 0; k < 2; ++k) dst[n][k] = *(const PG8_LAS bf16x8*)(lds + PG8_SB(b, h) + boff + n * 2048 + k * 1024); } while (0)
#define PG8_MMA(ai, bj, At, Bt) do { __builtin_amdgcn_s_setprio(1); _Pragma("unroll") for (int m = 0; m < 4; ++m) _Pragma("unroll") for (int n = 0; n < 2; ++n) _Pragma("unroll") for (int k = 0; k < 2; ++k) \
        acc[ai][bj][m][n] = __builtin_amdgcn_mfma_f32_16x16x32_bf16(Bt[n][k], At[m][k], acc[ai][bj][m][n], 0, 0, 0); __builtin_amdgcn_s_setprio(0); } while (0)
#define PG8_WAIT_V(n) asm volatile("s_waitcnt vmcnt(" #n ")" ::: "memory")
#define PG8_WAIT_L(n) asm volatile("s_waitcnt lgkmcnt(" #n ")" ::: "memory")
#define PG8_BAR __builtin_amdgcn_s_barrier()
#define PG8_SCHED __builtin_amdgcn_sched_barrier(0)
    Unit cur, nxt, prv; int ui = 0; bool have_prv = false;
    if (!S.next(0, cur)) return;
    f32x4 acc[2][2][4][2];
#pragma unroll
    for (int a = 0; a < 2; ++a)
#pragma unroll
        for (int b = 0; b < 2; ++b)
#pragma unroll
            for (int m = 0; m < 4; ++m)
#pragma unroll
                for (int n = 0; n < 2; ++n) acc[a][b][m][n] = (f32x4){0.f, 0.f, 0.f, 0.f};
    bf16x8 At[4][2], B0[2][2], B1[2][2];
    unsigned gc[2][2];
    const char* cA = Ab; const char* xA = Ab;
    if constexpr (Sched::GATHER) {
#pragma unroll
        for (int h = 0; h < 2; ++h)
#pragma unroll
            for (int i = 0; i < 2; ++i) gc[h][i] = S.aoff(cur, h, sR[i], sC[i]);
    } else { cA = Ab + S.abase(cur); xA = cA; }
    const char* cB = S.bptr(cur);
    S.a_ready(cur);
    if constexpr (Epi::RS_DMA) { if (wid == 0) __builtin_amdgcn_global_load_lds((const unsigned*)((const char*)E.rs + (size_t)cur.pm * 1024 + lane * 16), (PG8_LAS unsigned*)(lds + STAGE_BYTES + 512), 16, 0, 0); }
    PG8_STAGE(PG8_SB(0, 0), cB, voffB); PG8_STAGE(PG8_SB(0, 1), cB + hstep, voffB); PG8_STAGE_A(PG8_SA(0, 0), false, 0, 0); PG8_STAGE_A(PG8_SA(0, 1), false, 1, 0);
    if (wr == 1) PG8_BAR;
    PG8_WAIT_V(2); PG8_BAR;
    PG8_STAGE(PG8_SB(1, 0), cB + kstep, voffB); PG8_STAGE_A(PG8_SA(1, 0), false, 0, 1); PG8_STAGE(PG8_SB(1, 1), cB + hstep + kstep, voffB);
    PG8_WAIT_V(6); PG8_BAR;
    for (;;) {
        const bool has_next = S.next(ui + 1, nxt);
        const char* nB = has_next ? S.bptr(nxt) : cB;
        if constexpr (Epi::RS_DMA) { if (has_next && wid == 0) __builtin_amdgcn_global_load_lds((const unsigned*)((const char*)E.rs + (size_t)nxt.pm * 1024 + lane * 16), (PG8_LAS unsigned*)(lds + STAGE_BYTES + 512 + ((ui + 1) % 3) * 1024), 16, 0, 0); }
        for (int t = 0; t < nt; t += 2) {
            const bool last = (t == nt - 2);
            const int kt2 = last ? 0 : t + 2;
            const char* b2 = last ? nB : cB + (size_t)(t + 2) * kstep; const char* b3 = b2 + kstep;
            if (last && has_next) {
                if constexpr (!Sched::GATHER) xA = Ab + S.abase(nxt);
                S.a_ready(nxt);
            }
            PG8_LDB(B0, 0, 0); PG8_LDB(B1, 0, 1); PG8_SCHED; PG8_LDA(At, 0, 0); PG8_STAGE_A(PG8_SA(1, 1), false, 1, t + 1);
            if constexpr (Sched::GATHER) { if (last && has_next) {
#pragma unroll
                for (int h = 0; h < 2; ++h)
#pragma unroll
                    for (int i = 0; i < 2; ++i) gc[h][i] = S.aoff(nxt, h, sR[i], sC[i]); } }
            PG8_WAIT_V(8); PG8_WAIT_L(0); PG8_BAR; PG8_MMA(0, 0, At, B0); PG8_MMA(0, 1, At, B1); PG8_BAR; PG8_SCHED;
            PG8_LDA(At, 0, 1); PG8_STAGE(PG8_SB(0, 0), b2, voffB); PG8_STAGE(PG8_SB(0, 1), b2 + hstep, voffB); PG8_STAGE_A(PG8_SA(0, 0), last, 0, kt2);
            PG8_WAIT_V(8); PG8_WAIT_L(0); PG8_BAR; PG8_MMA(1, 0, At, B0); PG8_MMA(1, 1, At, B1); PG8_BAR; PG8_SCHED;
            PG8_LDB(B0, 1, 0); PG8_LDB(B1, 1, 1); PG8_SCHED; PG8_LDA(At, 1, 0); PG8_STAGE_A(PG8_SA(0, 1), last, 1, kt2);
            PG8_WAIT_V(8); PG8_WAIT_L(0);
            if (have_prv) { S.done(prv); have_prv = false; }
            PG8_BAR; PG8_MMA(0, 0, At, B0); PG8_MMA(0, 1, At, B1); PG8_BAR; PG8_SCHED;
            PG8_LDA(At, 1, 1); PG8_STAGE(PG8_SB(1, 0), b3, voffB); PG8_STAGE(PG8_SB(1, 1), b3 + hstep, voffB); PG8_STAGE_A(PG8_SA(1, 0), last, 0, kt2 + 1);
            PG8_WAIT_V(8); PG8_WAIT_L(0); PG8_BAR; PG8_MMA(1, 0, At, B0); PG8_MMA(1, 1, At, B1); PG8_BAR; PG8_SCHED;
        }
        if (wr == 0) PG8_BAR;
        E(acc, cur, wr, wc, fr, fq, (const PG8_LAS float*)(lds + STAGE_BYTES + 512 + (ui % 3) * 1024)); prv = cur; have_prv = true;
        if (!has_next) break;
#pragma unroll
        for (int a = 0; a < 2; ++a)
#pragma unroll
            for (int b = 0; b < 2; ++b)
#pragma unroll
                for (int m = 0; m < 4; ++m)
#pragma unroll
                    for (int n = 0; n < 2; ++n) acc[a][b][m][n] = (f32x4){0.f, 0.f, 0.f, 0.f};
        cur = nxt; cB = nB; ++ui;
        if constexpr (!Sched::GATHER) cA = xA;
        if (wr == 1) PG8_BAR;
    }
    PG8_WAIT_V(0);
    if (have_prv) S.done(prv);
    PG8_BAR;
#undef PG8_STAGE_A
#undef PG8_SA
#undef PG8_SB
#undef PG8_STAGE
#undef PG8_LDA
#undef PG8_LDB
#undef PG8_MMA
#undef PG8_WAIT_V
#undef PG8_WAIT_L
#undef PG8_BAR
#undef PG8_SCHED
}
}
constexpr int LX_PTR = 155648 - 256;
#define FTID ((int)threadIdx.x)
#define FLANE ((int)threadIdx.x & 63)
#define FWAVE ((int)__builtin_amdgcn_readfirstlane((int)threadIdx.x >> 6))
struct Frame {
    LAS unsigned char* lds;
    int G, bid;
    float* out; unsigned char* ws;
    __device__ __forceinline__ const float* inp(int i) const {
        const LAS unsigned* p = (const LAS unsigned*)(lds + LX_PTR) + 2 * i;
        const unsigned lo = __builtin_amdgcn_readfirstlane(p[0]), hi = __builtin_amdgcn_readfirstlane(p[1]);
        return (const float*)(((unsigned long long)hi << 32) | lo);
    }
};
enum { I_X = 0, I_GLA_NORM, I_GLA_WIN, I_GLA_WGU, I_GLA_BG, I_GLA_HG, I_GLA_WOUT, I_SGU_NORM, I_SGU_WIN, I_SGU_LNG, I_SGU_LNB, I_SGU_WS, I_SGU_BS, I_SGU_WOUT,
       I_MOE_NORM, I_MOE_WG, I_MOE_BG, I_MOE_WSUB, I_MOE_BSUB, I_MOE_W1, I_MOE_W3, I_MOE_W2, I_FINAL };
#define WSP(type, off) ((type*)(F.ws + (off)))

__device__ __forceinline__ void n_convert(Frame& F, const float* W, int ldw, int K, int N, const float* kscale, int qcols, float qs, bf16* WT, int rowmap) {
    const size_t total = (size_t)N * K, stride = (size_t)F.G * NTHREADS;
    for (size_t idx = (size_t)F.bid * NTHREADS + FTID; idx < total; idx += stride) {
        const int n = (int)(idx / K), k = (int)(idx % K);
        float v = W[(size_t)k * ldw + n]; if (kscale) v *= kscale[k]; if (n < qcols) v *= qs;
        const int dr = rowmap == 0 ? n : ((n >> 7) * 256 + (n & 127) + (rowmap == 2 ? 128 : 0));
        WT[(size_t)dr * K + k] = (bf16)f2bf(v);
    }
}
__device__ __forceinline__ void n_convert_gla(Frame& F) {
    n_convert(F, F.inp(I_GLA_WIN), GLA_IN, D, NQKVR, F.inp(I_GLA_NORM), HK, 0.08838834764831845f, WSP(bf16, WS_WIN), 0);
    n_convert(F, F.inp(I_GLA_WOUT), D, HV, D, F.inp(I_GLA_HG), 0, 1.f, WSP(bf16, WS_WOUT), 0);
}
__device__ __forceinline__ void n_convert_rest(Frame& F) {
    n_convert(F, F.inp(I_SGU_WIN), SGU_FFN, D, SGU_FFN, F.inp(I_SGU_NORM), 0, 1.f, WSP(bf16, WS_WSIN), 0);
    n_convert(F, F.inp(I_SGU_WOUT), D, SGU_HALF, D, nullptr, 0, 1.f, WSP(bf16, WS_WSOUT), 0);
    for (int le = 0; le < 2 * NE; ++le) {
        const int L = le / NE;
        n_convert(F, F.inp(I_MOE_W1) + (size_t)le * D * FF, FF, D, FF, F.inp(I_MOE_NORM) + L * D, 0, 1.f, WSP(bf16, WS_W13) + (size_t)le * 1024 * 1024, 1);
        n_convert(F, F.inp(I_MOE_W3) + (size_t)le * D * FF, FF, D, FF, F.inp(I_MOE_NORM) + L * D, 0, 1.f, WSP(bf16, WS_W13) + (size_t)le * 1024 * 1024, 2);
        n_convert(F, F.inp(I_MOE_W2) + (size_t)le * FF * D, D, FF, D, nullptr, 0, 1.f, WSP(bf16, WS_W2) + (size_t)le * 1024 * 512, 0);
    }
}

template <int MODE> __device__ __forceinline__ void n_rowpass(Frame& F, int L) {
    const float* src = MODE == 0 ? F.inp(I_X) : F.out;
    bf16* xn = WSP(bf16, WS_XN);
    const bf16* y = WSP(bf16, WS_Y);
    unsigned* ctl = WSP(unsigned, WS_CTL);
    for (int row = F.bid * NWAVES + FWAVE; row < T; row += F.G * NWAVES) {
        f32x4 v[4]; float ss = 0.f;
#pragma unroll
        for (int j = 0; j < 4; ++j) {
            const int k = 4 * FLANE + 256 * j;
            v[j] = *(const f32x4*)(src + (size_t)row * D + k);
            if (MODE >= 2) {
                const v2u a = *(const v2u*)(y + (size_t)row * D + k), b = *(const v2u*)(y + ((size_t)T + row) * D + k);
                v[j].x += bflo(a.x) + bflo(b.x); v[j].y += bfhi(a.x) + bfhi(b.x); v[j].z += bflo(a.y) + bflo(b.y); v[j].w += bfhi(a.y) + bfhi(b.y);
            }
            ss += v[j].x * v[j].x + v[j].y * v[j].y + v[j].z * v[j].z + v[j].w * v[j].w;
        }
        const float rstd = 1.f / sqrtf(wave_sum(ss) * (1.f / D) + EPS);
        if (MODE == 0) {
            const float* gn = F.inp(I_GLA_NORM); const float* w = F.inp(I_GLA_WIN);
            for (int c = 0; c < RANK; ++c) {
                float p = 0.f;
#pragma unroll
                for (int j = 0; j < 4; ++j) { const int k = 4 * FLANE + 256 * j;
                    p += v[j].x * gn[k] * w[(size_t)k * GLA_IN + NQKVR + c] + v[j].y * gn[k + 1] * w[(size_t)(k + 1) * GLA_IN + NQKVR + c]
                       + v[j].z * gn[k + 2] * w[(size_t)(k + 2) * GLA_IN + NQKVR + c] + v[j].w * gn[k + 3] * w[(size_t)(k + 3) * GLA_IN + NQKVR + c]; }
                p = wave_sum(p) * rstd;
                if (FLANE == 0) WSP(float, WS_GLR)[(size_t)row * RANK + c] = p;
            }
        }
        if (MODE == 1) {
            const float* gn = F.inp(I_MOE_NORM) + L * D; const float* wg = F.inp(I_MOE_WG) + (size_t)L * D * 4; const float* wsb = F.inp(I_MOE_WSUB) + (size_t)L * 4 * D * EPG;
            float lg[4], ls[EPG];
            for (int c = 0; c < 4; ++c) { float p = 0.f;
#pragma unroll
                for (int j = 0; j < 4; ++j) { const int k = 4 * FLANE + 256 * j;
                    p += v[j].x * gn[k] * wg[(k) * 4 + c] + v[j].y * gn[k + 1] * wg[(k + 1) * 4 + c] + v[j].z * gn[k + 2] * wg[(k + 2) * 4 + c] + v[j].w * gn[k + 3] * wg[(k + 3) * 4 + c]; }
                lg[c] = wave_sum(p) * rstd + F.inp(I_MOE_BG)[L * 4 + c]; }
            int g = 0; float gm = lg[0];
            for (int c = 1; c < 4; ++c) if (lg[c] > gm) { gm = lg[c]; g = c; }
            float gs = 0.f; for (int c = 0; c < 4; ++c) gs += __expf(lg[c] - gm);
            const float g_w = 1.f / gs;
            for (int e = 0; e < EPG; ++e) { float p = 0.f;
#pragma unroll
                for (int j = 0; j < 4; ++j) { const int k = 4 * FLANE + 256 * j; const float* ww = wsb + ((size_t)g * D + k) * EPG + e;
                    p += v[j].x * gn[k] * ww[0] + v[j].y * gn[k + 1] * ww[EPG] + v[j].z * gn[k + 2] * ww[2 * EPG] + v[j].w * gn[k + 3] * ww[3 * EPG]; }
                ls[e] = wave_sum(p) * rstd + F.inp(I_MOE_BSUB)[(L * 4 + g) * EPG + e]; }
            int i1 = 0; float m1 = ls[0];
            for (int e = 1; e < EPG; ++e) if (ls[e] > m1) { m1 = ls[e]; i1 = e; }
            int i2 = -1; float m2 = -3.0e38f;
            for (int e = 0; e < EPG; ++e) if (e != i1 && ls[e] > m2) { m2 = ls[e]; i2 = e; }
            const float w1 = 1.f / (1.f + __expf(m2 - m1)), w2 = 1.f - w1;
            if (FLANE == 0) {
                const int e1 = g * EPG + i1, e2 = g * EPG + i2;
                WSP(int, WS_EID)[row * 2] = e1; WSP(int, WS_EID)[row * 2 + 1] = e2;
                WSP(float, WS_GATE)[row * 2] = g_w * w1; WSP(float, WS_GATE)[row * 2 + 1] = g_w * w2;
                const unsigned p1 = atomicAdd(&ctl[CW_CNT + L * 2048 + 64 * e1], 1u), p2 = atomicAdd(&ctl[CW_CNT + L * 2048 + 64 * e2], 1u);
                WSP(int, WS_LIST)[(size_t)e1 * T + p1] = row * 2; WSP(int, WS_LIST)[(size_t)e2 * T + p2] = row * 2 + 1;
            }
        }
#pragma unroll
        for (int j = 0; j < 4; ++j) {
            const int k = 4 * FLANE + 256 * j;
            if (MODE == 2) *(f32x4*)(F.out + (size_t)row * D + k) = v[j];
            if (MODE == 3) { const f32x4 g = *(const f32x4*)(F.inp(I_FINAL) + k); *(f32x4*)(F.out + (size_t)row * D + k) = v[j] * rstd * g; }
            else { v2u o; o.x = pk2(v[j].x * rstd, v[j].y * rstd); o.y = pk2(v[j].z * rstd, v[j].w * rstd); *(v2u*)(xn + (size_t)row * D + k) = o; }
        }
    }
}

template <class Fn> __device__ __forceinline__ void n_gemm(Frame& F, const bf16* A, int lda, const bf16* Bt, int ldb, int M, int N, int K, Fn f) {
    LAS float* As = (LAS float*)F.lds; LAS float* Bs = As + 64 * 33;
    const int ntn = N / 64, ntiles = (M / 64) * ntn, ty = FTID >> 4, tx = FTID & 15, lr = FTID >> 3, lc = (FTID & 7) * 4;
    for (int tile = F.bid; tile < ntiles; tile += F.G) {
        const int tm = tile / ntn, tn = tile % ntn;
        float acc[2][4] = {};
        for (int k0 = 0; k0 < K; k0 += 32) {
            const v2u a = *(const v2u*)(A + (size_t)(tm * 64 + lr) * lda + k0 + lc), b = *(const v2u*)(Bt + (size_t)(tn * 64 + lr) * ldb + k0 + lc);
            As[lr * 33 + lc] = bflo(a.x); As[lr * 33 + lc + 1] = bfhi(a.x); As[lr * 33 + lc + 2] = bflo(a.y); As[lr * 33 + lc + 3] = bfhi(a.y);
            Bs[lr * 33 + lc] = bflo(b.x); Bs[lr * 33 + lc + 1] = bfhi(b.x); Bs[lr * 33 + lc + 2] = bflo(b.y); Bs[lr * 33 + lc + 3] = bfhi(b.y);
            __syncthreads();
#pragma unroll 8
            for (int kk = 0; kk < 32; ++kk) {
                const float a0 = As[(2 * ty) * 33 + kk], a1 = As[(2 * ty + 1) * 33 + kk];
#pragma unroll
                for (int i = 0; i < 4; ++i) { const float bb = Bs[(4 * tx + i) * 33 + kk]; acc[0][i] += a0 * bb; acc[1][i] += a1 * bb; }
            }
            __syncthreads();
        }
#pragma unroll
        for (int r = 0; r < 2; ++r)
#pragma unroll
            for (int i = 0; i < 4; ++i) f(tm * 64 + 2 * ty + r, tn * 64 + 4 * tx + i, acc[r][i]);
    }
}

__device__ __forceinline__ void n_scan(Frame& F) {
    LAS float* gl = (LAS float*)F.lds;
    LAS float* kd = gl + 64 * 16;
    LAS float* qs = kd + 64 * 128;
    LAS float* os = qs + 64 * 128;
    LAS float* part = os + 64 * 256;
    LAS float* dec = part + 4 * 128;
    const bf16* qkvr = WSP(bf16, WS_QKVR); const float* glr = WSP(float, WS_GLR); bf16* aout = WSP(bf16, WS_XN);
    for (int item = F.bid; item < NBATCH * GLA_H; item += F.G) {
        const int b = item / GLA_H, h = item % GLA_H;
        float S[64];
#pragma unroll
        for (int i = 0; i < 64; ++i) S[i] = 0.f;
        const int dk = FTID & 127, tg = FTID >> 7, j = FTID & 255, hf = FTID >> 8;
        for (int c = 0; c < NCHUNK; ++c) {
            const size_t t0 = (size_t)b * SEQ + c * CHUNK;
            for (int i = FTID; i < 64 * 16; i += NTHREADS) gl[i] = glr[t0 * RANK + i];
            __syncthreads();
            float wgu[RANK];
#pragma unroll
            for (int r = 0; r < RANK; ++r) wgu[r] = F.inp(I_GLA_WGU)[r * HK + h * DK + dk];
            const float bgv = F.inp(I_GLA_BG)[h * DK + dk];
            float run = 0.f;
            for (int jj = 0; jj < 16; ++jj) {
                const int tok = tg * 16 + jj; float a = bgv;
#pragma unroll
                for (int r = 0; r < RANK; ++r) a += gl[tok * 16 + r] * wgu[r];
                run += logsigmoid_f(a) * (1.f / 16.f);
            }
            part[tg * 128 + dk] = run;
            __syncthreads();
            float off = 0.f, tot = 0.f;
#pragma unroll
            for (int g = 0; g < 4; ++g) { const float pv = part[g * 128 + dk]; if (g < tg) off += pv; tot += pv; }
            run = off;
            for (int jj = 0; jj < 16; ++jj) {
                const int tok = tg * 16 + jj; float a = bgv;
#pragma unroll
                for (int r = 0; r < RANK; ++r) a += gl[tok * 16 + r] * wgu[r];
                run += logsigmoid_f(a) * (1.f / 16.f);
                const float kv = bf2f(qkvr[(t0 + tok) * NQKVR + HK + h * DK + dk]);
                kd[tok * 128 + dk] = kv * __expf(tot - run);
                qs[tok * 128 + dk] = bf2f(qkvr[(t0 + tok) * NQKVR + h * DK + dk]);
            }
            if (tg == 0) dec[dk] = __expf(tot);
            __syncthreads();
#pragma unroll
            for (int ib = 0; ib < 4; ++ib) {
#pragma unroll
                for (int i = 0; i < 16; ++i) S[ib * 16 + i] *= dec[64 * hf + ib * 16 + i];
                asm volatile("" ::: "memory"); }
            for (int s = 0; s < CHUNK; ++s) {
                const float vv = bf2f(qkvr[(t0 + s) * NQKVR + 2 * HK + h * DV + j]);
#pragma unroll
                for (int ib = 0; ib < 4; ++ib) {
#pragma unroll
                    for (int i = 0; i < 16; ++i) S[ib * 16 + i] += kd[s * 128 + 64 * hf + ib * 16 + i] * vv;
                    asm volatile("" ::: "memory"); }
            }
            for (int ph = 0; ph < 2; ++ph) {
                if (hf == ph) {
                    for (int t = 0; t < CHUNK; ++t) {
                        float o = 0.f;
#pragma unroll
                        for (int ib = 0; ib < 4; ++ib) {
#pragma unroll
                            for (int i = 0; i < 16; ++i) o += qs[t * 128 + 64 * hf + ib * 16 + i] * S[ib * 16 + i];
                            asm volatile("" ::: "memory"); }
                        if (ph == 0) os[t * 256 + j] = o; else os[t * 256 + j] += o;
                    }
                }
                __syncthreads();
            }
            {
                const int tok = FTID >> 3, cc = FTID & 7; float ss = 0.f;
                for (int jj = 0; jj < 32; ++jj) { const float o = os[tok * 256 + cc * 32 + jj]; ss += o * o; }
                ss += __shfl_xor(ss, 1); ss += __shfl_xor(ss, 2); ss += __shfl_xor(ss, 4);
                const float rms = 1.f / sqrtf(ss * (1.f / DV) + EPS);
                for (int jj = 0; jj < 32; ++jj) {
                    const int col = h * DV + cc * 32 + jj;
                    const float rr = bf2f(qkvr[(t0 + tok) * NQKVR + 2 * HK + HV + col]);
                    aout[(t0 + tok) * D + col] = (bf16)f2bf(os[tok * 256 + cc * 32 + jj] * rms * silu_f(rr));
                }
            }
            __syncthreads();
        }
    }
}

__device__ __forceinline__ void n_moe(Frame& F, int L) {
    LAS float* xs = (LAS float*)F.lds; LAS float* hl = xs + D;
    const bf16* xn = WSP(bf16, WS_XN); bf16* y = WSP(bf16, WS_Y);
    const bf16* W13 = WSP(bf16, WS_W13) + (size_t)L * NE * 1024 * 1024; const bf16* W2 = WSP(bf16, WS_W2) + (size_t)L * NE * 1024 * 512;
    for (int a = F.bid; a < 2 * T; a += F.G) {
        const int tok = a >> 1, k = a & 1, e = WSP(int, WS_EID)[a]; const float gate = WSP(float, WS_GATE)[a];
        for (int i = FTID; i < D; i += NTHREADS) xs[i] = bf2f(xn[(size_t)tok * D + i]);
        __syncthreads();
        for (int jj = 0; jj < 64; ++jj) {
            const int j = FWAVE * 64 + jj; const bf16* r1 = W13 + ((size_t)e * 1024 + (j >> 7) * 256 + (j & 127)) * 1024; const bf16* r3 = r1 + 128 * 1024;
            float d1 = 0.f, d3 = 0.f;
#pragma unroll
            for (int i = 0; i < 2; ++i) { const int kk = FLANE * 8 + 512 * i; const v4u a1 = *(const v4u*)(r1 + kk), a3 = *(const v4u*)(r3 + kk);
                d1 += xs[kk] * bflo(a1.x) + xs[kk + 1] * bfhi(a1.x) + xs[kk + 2] * bflo(a1.y) + xs[kk + 3] * bfhi(a1.y) + xs[kk + 4] * bflo(a1.z) + xs[kk + 5] * bfhi(a1.z) + xs[kk + 6] * bflo(a1.w) + xs[kk + 7] * bfhi(a1.w);
                d3 += xs[kk] * bflo(a3.x) + xs[kk + 1] * bfhi(a3.x) + xs[kk + 2] * bflo(a3.y) + xs[kk + 3] * bfhi(a3.y) + xs[kk + 4] * bflo(a3.z) + xs[kk + 5] * bfhi(a3.z) + xs[kk + 6] * bflo(a3.w) + xs[kk + 7] * bfhi(a3.w); }
            d1 = wave_sum(d1); d3 = wave_sum(d3);
            if (FLANE == 0) hl[j] = bf2f((bf16)f2bf(silu_f(d1) * d3));
        }
        __syncthreads();
        for (int cc = 0; cc < 128; ++cc) {
            const int c = FWAVE * 128 + cc; const bf16* r2 = W2 + ((size_t)e * 1024 + c) * 512; const int kk = FLANE * 8; const v4u a2 = *(const v4u*)(r2 + kk);
            float d = hl[kk] * bflo(a2.x) + hl[kk + 1] * bfhi(a2.x) + hl[kk + 2] * bflo(a2.y) + hl[kk + 3] * bfhi(a2.y) + hl[kk + 4] * bflo(a2.z) + hl[kk + 5] * bfhi(a2.z) + hl[kk + 6] * bflo(a2.w) + hl[kk + 7] * bfhi(a2.w);
            d = wave_sum(d);
            if (FLANE == 0) y[((size_t)k * T + tok) * D + c] = (bf16)f2bf(gate * d);
        }
        __syncthreads();
    }
}

__device__ __forceinline__ void n_stats(Frame& F) {
    const bf16* v = WSP(bf16, WS_V); float* st = WSP(float, WS_STATS);
    for (size_t it = (size_t)F.bid * NTHREADS + FTID; it < (size_t)T * 32; it += (size_t)F.G * NTHREADS) {
        const int row = (int)(it >> 5), p = (int)(it & 31), pnv = p >> 2, wc = p & 3; float s = 0.f, q = 0.f;
        for (int bj = 0; bj < 2; ++bj) for (int j = 0; j < 32; ++j) { const float x = bf2f(v[(size_t)row * SGU_HALF + pnv * 256 + bj * 128 + wc * 32 + j]); s += x; q += x * x; }
        st[((size_t)p * T + row) * 2] = s; st[((size_t)p * T + row) * 2 + 1] = q;
    }
}
__device__ __forceinline__ void n_mix(Frame& F) {
    LAS float* wl = (LAS float*)F.lds;
    LAS float* vls = wl + 128 * 128;
    LAS float* mu = vls + 128 * 128; LAS float* rs = mu + 128; LAS float* red = rs + 128;
    bf16* u = WSP(bf16, WS_U); const bf16* v = WSP(bf16, WS_V);
    for (int bn = F.bid; bn < T / SGU_BLK; bn += F.G) {
        const size_t t0 = (size_t)bn * SGU_BLK;
        __syncthreads();
        { const int row = FTID >> 2, q4 = FTID & 3; float s = 0.f, q = 0.f;
          for (int i = 0; i < 512; ++i) { const float x = bf2f(v[(t0 + row) * SGU_HALF + q4 * 512 + i]); s += x; q += x * x; }
          red[(row * 4 + q4) * 2] = s; red[(row * 4 + q4) * 2 + 1] = q; }
        __syncthreads();
        if (FTID < 128) { float s = 0.f, q = 0.f; for (int p = 0; p < 4; ++p) { s += red[(FTID * 4 + p) * 2]; q += red[(FTID * 4 + p) * 2 + 1]; }
            const float m = s * (1.f / SGU_HALF); mu[FTID] = m; rs[FTID] = 1.f / sqrtf(q * (1.f / SGU_HALF) - m * m + EPS); }
        for (int g = 0; g < 4; ++g) {
            __syncthreads();
            for (int i = FTID; i < 128 * 128; i += NTHREADS) { const int t = i >> 7, s = i & 127; wl[i] = ((t >> 6) >= (s >> 6)) ? F.inp(I_SGU_WS)[(size_t)g * 128 * 128 + i] : 0.f; }
            for (int cb = 0; cb < 4; ++cb) {
                const int c0 = g * SGU_GC + cb * 128;
                __syncthreads();
                for (int i = FTID; i < 128 * 128; i += NTHREADS) { const int s = i >> 7, c = i & 127;
                    vls[i] = (bf2f(v[(t0 + s) * SGU_HALF + c0 + c]) - mu[s]) * rs[s] * F.inp(I_SGU_LNG)[c0 + c] + F.inp(I_SGU_LNB)[c0 + c]; }
                __syncthreads();
                const int c = FTID & 127, tq = FTID >> 7;
                for (int tt = 0; tt < 32; ++tt) {
                    const int t = tq * 32 + tt; float acc = 0.f;
                    for (int s = 0; s < 128; ++s) acc += wl[t * 128 + s] * vls[s * 128 + c];
                    const float mixed = acc + F.inp(I_SGU_BS)[g * 128 + t];
                    u[(t0 + t) * SGU_HALF + c0 + c] = (bf16)f2bf(bf2f(u[(t0 + t) * SGU_HALF + c0 + c]) * mixed);
                }
            }
        }
    }
}
#define XB_TMO      128
#define XB_XCNT(j)  (256  + 64 * (j))
#define XB_XSUB(j)  (1280 + 64 * (j))
#define XB_XGEN(j)  (2304 + 64 * (j))
#define XB_TOP      3328
#define XB_TOPGEN   3392
#define XCD_BAR_WORDS 3456
#define XB_SPIN_CAP (1u << 18)

__device__ __forceinline__ unsigned xb_ld(unsigned* p)              { return __hip_atomic_load(p, __ATOMIC_RELAXED, __HIP_MEMORY_SCOPE_AGENT); }
__device__ __forceinline__ unsigned xb_add(unsigned* p, unsigned v) { return __hip_atomic_fetch_add(p, v, __ATOMIC_RELAXED, __HIP_MEMORY_SCOPE_AGENT); }
__device__ __forceinline__ unsigned xb_xcc_id() { return (unsigned)__builtin_amdgcn_s_getreg((3 << 11) | 20) & 0xFu; }
#define XB_SPIN(cond, bar) do { unsigned _sp = 0; while (cond) { __builtin_amdgcn_s_sleep(1); \
    if ((++_sp & 255u) == 0u) { if (xb_ld(&(bar)[XB_TMO])) break; if (_sp > XB_SPIN_CAP) { atomicAdd(&(bar)[XB_TMO], 1u); break; } } } } while (0)

struct XcdBarrier {
    unsigned* bar; unsigned x;
    volatile LAS unsigned* st;
};

__device__ __forceinline__ XcdBarrier xcd_barrier_post(unsigned* bar, volatile LAS unsigned* st) {
    XcdBarrier b; b.bar = bar; b.x = xb_xcc_id(); b.st = st;
    if (threadIdx.x == 0) (void)xb_add(&bar[XB_XCNT(b.x)], 1u);
    return b;
}
__device__ __forceinline__ void xcd_barrier_complete(unsigned* bar, unsigned x, unsigned& nloc, unsigned& nx) {
    const unsigned G = gridDim.x * gridDim.y * gridDim.z;
    unsigned sum, cnt, mine, sp = 0u;
    for (;;) {
        sum = 0u; cnt = 0u; mine = 0u;
#pragma unroll
        for (unsigned j = 0; j < 16; ++j) { const unsigned c = xb_ld(&bar[XB_XCNT(j)]); sum += c; cnt += (c > 0u) ? 1u : 0u; mine = (j == x) ? c : mine; }
        if (sum == G) break;
        __builtin_amdgcn_s_sleep(1);
        if ((++sp & 255u) == 0u) { if (xb_ld(&bar[XB_TMO])) break; if (sp > XB_SPIN_CAP) { atomicAdd(&bar[XB_TMO], 1u); break; } }
    }
    nloc = mine > 0u ? mine : 1u; nx = cnt > 0u ? cnt : 1u;
}

__device__ __forceinline__ void xcd_barrier(const XcdBarrier& b) {
    asm volatile("s_waitcnt vmcnt(0)" ::: "memory");
    __syncthreads();
    if (threadIdx.x == 0) {
        unsigned* bar = b.bar;
        __builtin_amdgcn_s_waitcnt(0);
        unsigned nloc = b.st[0], nx = b.st[1];
        if (nloc == 0u) { xcd_barrier_complete(bar, b.x, nloc, nx); b.st[0] = nloc; b.st[1] = nx; }
        const unsigned old = xb_add(&bar[XB_XSUB(b.x)], 1u);
        const unsigned gen = old / nloc;
        if (old + 1u == (gen + 1u) * nloc) {
            __builtin_amdgcn_fence(__ATOMIC_RELEASE, "agent");
            asm volatile("s_waitcnt vmcnt(0)" ::: "memory");
            const unsigned og = xb_add(&bar[XB_TOP], 1u);
            const unsigned tg = og / nx;
            if (og + 1u == (tg + 1u) * nx) xb_add(&bar[XB_TOPGEN], 1u);
            else XB_SPIN(xb_ld(&bar[XB_TOPGEN]) == tg, bar);
            __builtin_amdgcn_fence(__ATOMIC_ACQUIRE, "agent");
            xb_add(&bar[XB_XGEN(b.x)], 1u);
            asm volatile("s_waitcnt vmcnt(0)" ::: "memory");
        } else {
            XB_SPIN(xb_ld(&bar[XB_XGEN(b.x)]) == gen, bar);
            __builtin_amdgcn_fence(__ATOMIC_ACQUIRE, "agent");
            asm volatile("s_waitcnt vmcnt(0)" ::: "memory");
        }
    }
    __syncthreads();
}
constexpr int RING_BYTES = 131072;
constexpr int LX_TST = RING_BYTES;
constexpr int MOE_MAXU = 6;
constexpr int LX_TAB = RING_BYTES + 512;
constexpr int LX_GT = LX_TAB + MOE_MAXU * 1024;

struct EpiStoreBf16 {
    static constexpr bool RS_DMA = true;
    static constexpr bool PERM = true;
    bf16* O; int ldc; const float* rs; int fold; int silu_from;
    __device__ __forceinline__ void operator()(const pg8::f32x4 (&acc)[2][2][4][2], const pg8::Unit& u, int wr, int wc, int fr, int fq, const LAS float* rsl) const {
        const int row0 = (fold ? (int)blockIdx.x : u.pm) * 256 + wr * 64 + fr, col0 = (fold ? 0 : u.pn * 256) + wc * 32 + 8 * fq;
        if (fold == 2) { float sm = 0.f;
#pragma unroll
            for (int ai = 0; ai < 2; ++ai)
#pragma unroll
                for (int bj = 0; bj < 2; ++bj)
#pragma unroll
                    for (int m = 0; m < 4; ++m)
#pragma unroll
                        for (int n = 0; n < 2; ++n) sm += acc[ai][bj][m][n][0] + acc[ai][bj][m][n][1] + acc[ai][bj][m][n][2] + acc[ai][bj][m][n][3];
            if (sm == 1.2345e30f) O[row0] = 1; return; }
#pragma unroll
        for (int ai = 0; ai < 2; ++ai)
#pragma unroll
            for (int m = 0; m < 4; ++m) { const int row = row0 + ai * 128 + m * 16; bf16* rowp = O + (size_t)row * ldc + col0; const float sc = rsl[ai * 128 + wr * 64 + m * 16 + fr];
#pragma unroll
                for (int bj = 0; bj < 2; ++bj) { pg8::f32x4 v0 = acc[ai][bj][m][0] * sc, v1 = acc[ai][bj][m][1] * sc;
                    if (silu_from >= 0 && u.pn >= silu_from) {
#pragma unroll
                        for (int i = 0; i < 4; ++i) { v0[i] = v0[i] * __builtin_amdgcn_rcpf(1.f + __expf(-v0[i])); v1[i] = v1[i] * __builtin_amdgcn_rcpf(1.f + __expf(-v1[i])); } }
                    v4u w; w.x = pg8::cvt_pk_bf16(v0[0], v0[1]); w.y = pg8::cvt_pk_bf16(v0[2], v0[3]); w.z = pg8::cvt_pk_bf16(v1[0], v1[1]); w.w = pg8::cvt_pk_bf16(v1[2], v1[3]);
                    *(v4u*)(rowp + bj * 128) = w; } }
    }
};
struct EpiResBf16 {
    static constexpr bool RS_DMA = false;
    static constexpr bool PERM = true;
    bf16* X; bf16* XO;
    __device__ __forceinline__ void operator()(const pg8::f32x4 (&acc)[2][2][4][2], const pg8::Unit& u, int wr, int wc, int fr, int fq, const LAS float* rsl) const {
        const int row0 = u.pm * 256 + wr * 64 + fr, col0 = u.pn * 256 + wc * 32 + 8 * fq;
#pragma unroll
        for (int ai = 0; ai < 2; ++ai)
#pragma unroll
            for (int m = 0; m < 4; ++m) { bf16* rowp = X + (size_t)(row0 + ai * 128 + m * 16) * D + col0; bf16* rowo = XO + (size_t)(row0 + ai * 128 + m * 16) * D + col0;
#pragma unroll
                for (int bj = 0; bj < 2; ++bj) { const v4u r = *(const v4u*)(rowp + bj * 128); const pg8::f32x4 v0 = acc[ai][bj][m][0], v1 = acc[ai][bj][m][1];
                    v4u w; w.x = pg8::cvt_pk_bf16(bflo(r.x) + v0[0], bfhi(r.x) + v0[1]); w.y = pg8::cvt_pk_bf16(bflo(r.y) + v0[2], bfhi(r.y) + v0[3]);
                    w.z = pg8::cvt_pk_bf16(bflo(r.z) + v1[0], bfhi(r.z) + v1[1]); w.w = pg8::cvt_pk_bf16(bflo(r.w) + v1[2], bfhi(r.w) + v1[3]);
                    *(v4u*)(rowo + bj * 128) = w; } }
    }
};
struct EpiResF32 {
    static constexpr bool RS_DMA = false;
    static constexpr bool PERM = false;
    const float* res; float* out;
    __device__ __forceinline__ void operator()(const pg8::f32x4 (&acc)[2][2][4][2], const pg8::Unit& u, int wr, int wc, int fr, int fq, const LAS float* rsl) const {
        const int row0 = u.pm * 256 + wr * 64 + fr, col0 = u.pn * 256 + wc * 32 + 4 * fq;
#pragma unroll
        for (int ai = 0; ai < 2; ++ai)
#pragma unroll
            for (int m = 0; m < 4; ++m) { const size_t off = (size_t)(row0 + ai * 128 + m * 16) * D + col0;
#pragma unroll
                for (int bj = 0; bj < 2; ++bj)
#pragma unroll
                    for (int n = 0; n < 2; ++n) { const pg8::f32x4 r = *(const pg8::f32x4*)(res + off + bj * 128 + n * 16); *(pg8::f32x4*)(out + off + bj * 128 + n * 16) = r + acc[ai][bj][m][n]; } }
    }
};
struct EpiGeluSplit {
    static constexpr bool RS_DMA = true;
    static constexpr bool PERM = true;
    bf16* U; bf16* V; float* st; const float* rs;
    __device__ __forceinline__ void operator()(const pg8::f32x4 (&acc)[2][2][4][2], const pg8::Unit& u, int wr, int wc, int fr, int fq, const LAS float* rsl) const {
        const bool isv = u.pn >= 8; const int pnl = isv ? u.pn - 8 : u.pn;
        bf16* O = isv ? V : U;
        const int row0 = u.pm * 256 + wr * 64 + fr, col0 = pnl * 256 + wc * 32 + 8 * fq;
#pragma unroll
        for (int ai = 0; ai < 2; ++ai)
#pragma unroll
            for (int m = 0; m < 4; ++m) { const int row = row0 + ai * 128 + m * 16; bf16* rowp = O + (size_t)row * SGU_HALF + col0; float s = 0.f, q = 0.f; const float sc = rsl[ai * 128 + wr * 64 + m * 16 + fr];
#pragma unroll
                for (int bj = 0; bj < 2; ++bj) { const pg8::f32x4 v0 = acc[ai][bj][m][0] * sc, v1 = acc[ai][bj][m][1] * sc;
                    const pg8::f32x2 a = pg8::gelu_pk((pg8::f32x2){v0[0], v0[1]}), b = pg8::gelu_pk((pg8::f32x2){v0[2], v0[3]}), c = pg8::gelu_pk((pg8::f32x2){v1[0], v1[1]}), d = pg8::gelu_pk((pg8::f32x2){v1[2], v1[3]});
                    s += (a.x + a.y) + (b.x + b.y) + (c.x + c.y) + (d.x + d.y);
                    q += (a.x * a.x + a.y * a.y) + (b.x * b.x + b.y * b.y) + (c.x * c.x + c.y * c.y) + (d.x * d.x + d.y * d.y);
                    v4u w; w.x = pg8::cvt_pk_bf16(a.x, a.y); w.y = pg8::cvt_pk_bf16(b.x, b.y); w.z = pg8::cvt_pk_bf16(c.x, c.y); w.w = pg8::cvt_pk_bf16(d.x, d.y);
                    *(v4u*)(rowp + bj * 128) = w; }
                if (isv) { s += __shfl_xor(s, 16); s += __shfl_xor(s, 32); q += __shfl_xor(q, 16); q += __shfl_xor(q, 32);
                    if (fq == 0) { pg8::f32x2 o = {s, q}; *(pg8::f32x2*)(st + ((size_t)(pnl * 4 + wc) * T + row) * 2) = o; } } }
    }
};

__device__ __forceinline__ void f_gemm_in(Frame& F, int fold = 0) {
    pg8::DenseOrder S; S.init(T, NQKVR, D, WSP(bf16, WS_WIN), F.G, F.bid);
    EpiStoreBf16 E{fold ? WSP(bf16, WS_AOUT) : WSP(bf16, WS_QKVR), fold ? 256 : NQKVR, WSP(float, WS_RS), fold, 8};
    pg8::gemm_phase(F.lds, WSP(bf16, WS_XN), D, S, E);
}
__device__ __forceinline__ void f_gemm_out(Frame& F, bf16* xo = nullptr) {
    pg8::DenseOrder S; S.init(T, D, HV, WSP(bf16, WS_WOUT), F.G, F.bid);
    EpiResBf16 E{WSP(bf16, WS_XN), xo ? xo : WSP(bf16, WS_XN)};
    pg8::gemm_phase(F.lds, WSP(bf16, WS_AOUT), HV, S, E);
}
struct RowSetOrder {
    static constexpr bool GATHER = false;
    int nb, c, j0, nunits, K; const char* Bt;
    __device__ __forceinline__ bool next(int i, pg8::Unit& u) const {
        if (c < 0) return false;
        const int q = i * nb + c; if (q >= nunits) return false;
        u.pm = ((q & 63) >> 2) * 8 + j0 + (q >> 6); u.pn = q & 3; u.e = 0; u.slot = 0; return true;
    }
    __device__ __forceinline__ const char* bptr(const pg8::Unit& u) const { return Bt + (size_t)u.pn * 256 * K * 2; }
    __device__ __forceinline__ size_t abase(const pg8::Unit& u) const { return (size_t)u.pm * 256 * K * 2; }
    __device__ __forceinline__ unsigned aoff(const pg8::Unit&, int, int, int) const { return 0u; }
    __device__ __forceinline__ void a_ready(const pg8::Unit&) const {}
    __device__ __forceinline__ void done(const pg8::Unit&) const {}
};
__device__ __forceinline__ void f_gemm_out_rows(Frame& F, int j0, int j1, int boff) {
    RowSetOrder S; S.nb = F.G - boff; S.c = F.bid - boff; S.j0 = j0; S.nunits = (j1 - j0) * 64; S.K = HV; S.Bt = (const char*)WSP(bf16, WS_WOUT);
    EpiResBf16 E{WSP(bf16, WS_XN), WSP(bf16, WS_XN)};
    pg8::gemm_phase(F.lds, WSP(bf16, WS_AOUT), HV, S, E);
}
__device__ __forceinline__ void f_gemm_sgu_in(Frame& F) {
    pg8::DenseOrder S; S.init(T, SGU_FFN, D, WSP(bf16, WS_WSIN), F.G, F.bid);
    EpiGeluSplit E{WSP(bf16, WS_U), WSP(bf16, WS_V), WSP(float, WS_STATS), WSP(float, WS_RS)};
    pg8::gemm_phase(F.lds, WSP(bf16, WS_XN), D, S, E);
}
__device__ __forceinline__ void f_gemm_sgu_out(Frame& F, bf16* xo = nullptr) {
    pg8::DenseOrder S; S.init(T, D, SGU_HALF, WSP(bf16, WS_WSOUT), F.G, F.bid);
    EpiResBf16 E{WSP(bf16, WS_XN), xo ? xo : WSP(bf16, WS_XN)};
    pg8::gemm_phase(F.lds, WSP(bf16, WS_U), SGU_HALF, S, E);
}

template <bool GATHER_> struct MoeOrder {
    static constexpr bool GATHER = GATHER_;
    int G, c, nunits, ibase, K, mode;
    const char* W; size_t estride;
    LAS const int* tst; LAS const int* tab; unsigned* hcnt; unsigned rdy;
    __device__ __forceinline__ bool next(int i, pg8::Unit& u) const {
        if (i >= MOE_MAXU) return false;
        const int Lu = (ibase + i) * G + c; if (Lu >= nunits) return false;
        const int rt = Lu >> 2; int e = 0;
        while (e < NE - 1 && tst[e + 1] <= rt) ++e;
        u.pm = rt; u.pn = Lu & 3; u.e = e; u.slot = i; return true;
    }
    __device__ __forceinline__ const char* bptr(const pg8::Unit& u) const { return W + (size_t)u.e * estride + (size_t)u.pn * 256 * K * 2; }
    __device__ __forceinline__ size_t abase(const pg8::Unit& u) const { return (size_t)u.pm * 256 * K * 2; }
    __device__ __forceinline__ unsigned aoff(const pg8::Unit& u, int h, int R, int C) const {
        if (mode == 0) { int ent = tab[u.slot * 256 + h * 128 + R]; ent = ent < 0 ? 0 : ent; return (unsigned)(((ent >> 1) * K + C) * 2); }
        return (unsigned)(((u.pm * 256 + h * 128 + R) * K + C) * 2);
    }
    __device__ __forceinline__ void a_ready(const pg8::Unit& u) const {
        if (GATHER || ((rdy >> u.slot) & 1u)) return;
        if (threadIdx.x < 64) {
            unsigned spins = 0;
            while ((unsigned)__builtin_amdgcn_readfirstlane(__hip_atomic_load(hcnt + 16 * u.pm, __ATOMIC_RELAXED, __HIP_MEMORY_SCOPE_AGENT)) < 32u) { __builtin_amdgcn_s_sleep(2); if (++spins > (1u << 20)) break; }
            __builtin_amdgcn_fence(__ATOMIC_ACQUIRE, "agent");
            asm volatile("s_waitcnt vmcnt(0)" ::: "memory");
        }
        asm volatile("" ::: "memory"); __builtin_amdgcn_s_barrier(); asm volatile("" ::: "memory");
    }
    __device__ __forceinline__ void done(const pg8::Unit& u) const {
        if (!GATHER) return;
        if ((threadIdx.x & 63) == 0) __hip_atomic_fetch_add(hcnt + 16 * u.pm, 1u, __ATOMIC_RELAXED, __HIP_MEMORY_SCOPE_AGENT);
    }
};
struct EpiSwiglu {
    static constexpr bool RS_DMA = false;
    static constexpr bool PERM = true;
    bf16* H; LAS const float* gt;
    __device__ __forceinline__ void operator()(const pg8::f32x4 (&acc)[2][2][4][2], const pg8::Unit& u, int wr, int wc, int fr, int fq, const LAS float* rsl) const {
        const __amdgpu_buffer_rsrc_t hrs = __builtin_amdgcn_make_buffer_rsrc((void*)H, (short)0, 73728 * FF * 2, 0x00020000);
        const int row0 = u.pm * 256 + wr * 64 + fr, col0 = u.pn * 128 + wc * 32 + 8 * fq;
#pragma unroll
        for (int ai = 0; ai < 2; ++ai)
#pragma unroll
            for (int m = 0; m < 4; ++m) { bf16* rowp = H + (size_t)(row0 + ai * 128 + m * 16) * FF + col0; float h[8]; const float sc = gt[u.slot * 256 + ai * 128 + wr * 64 + m * 16 + fr];
#pragma unroll
                for (int n = 0; n < 2; ++n)
#pragma unroll
                    for (int i = 0; i < 4; ++i) { const float a = acc[ai][0][m][n][i] * sc, b = acc[ai][1][m][n][i] * sc; h[n * 4 + i] = a * __builtin_amdgcn_rcpf(1.f + __expf(-a)) * b; }
                v4u w; w.x = pg8::cvt_pk_bf16(h[0], h[1]); w.y = pg8::cvt_pk_bf16(h[2], h[3]); w.z = pg8::cvt_pk_bf16(h[4], h[5]); w.w = pg8::cvt_pk_bf16(h[6], h[7]);
                __builtin_amdgcn_raw_buffer_store_b128(w, hrs, (int)((size_t)((const char*)rowp - (const char*)H)), 0, 16); }
    }
};
struct EpiScatterY {
    static constexpr bool RS_DMA = false;
    static constexpr bool PERM = true;
    bf16* Y; LAS const int* tab; LAS const float* gt;
    __device__ __forceinline__ void operator()(const pg8::f32x4 (&acc)[2][2][4][2], const pg8::Unit& u, int wr, int wc, int fr, int fq, const LAS float* rsl) const {
        const int col0 = u.pn * 256 + wc * 32 + 8 * fq;
#pragma unroll
        for (int ai = 0; ai < 2; ++ai)
#pragma unroll
            for (int m = 0; m < 4; ++m) { const int r = ai * 128 + wr * 64 + m * 16 + fr; const int ent = tab[u.slot * 256 + r]; const float g = gt[u.slot * 256 + r];
                if (ent >= 0) { bf16* rowp = Y + ((size_t)(ent & 1) * T + (ent >> 1)) * D + col0;
#pragma unroll
                    for (int bj = 0; bj < 2; ++bj) { const pg8::f32x4 v0 = acc[ai][bj][m][0] * g, v1 = acc[ai][bj][m][1] * g;
                        v4u w; w.x = pg8::cvt_pk_bf16(v0[0], v0[1]); w.y = pg8::cvt_pk_bf16(v0[2], v0[3]); w.z = pg8::cvt_pk_bf16(v1[0], v1[1]); w.w = pg8::cvt_pk_bf16(v1[2], v1[3]);
                        *(v4u*)(rowp + bj * 128) = w; } } }
    }
};
template <int MODE> __device__ __forceinline__ void f_moe_gemm(Frame& F, int L, LAS int* tst, LAS int* cntl) {
    LAS int* tab = (LAS int*)(F.lds + LX_TAB); LAS float* gt = (LAS float*)(F.lds + LX_GT);
    MoeOrder<MODE == 0> S; S.G = F.G; S.c = MODE == 0 ? F.bid : F.G - 1 - F.bid; S.nunits = 4 * tst[NE]; S.K = MODE == 0 ? D : FF; S.mode = MODE; S.tst = tst; S.tab = tab;
    S.hcnt = WSP(unsigned, WS_CTL) + CW_HID + L * 4608;
    S.W = MODE == 0 ? (const char*)(WSP(bf16, WS_W13) + (size_t)L * NE * 1024 * 1024) : (const char*)(WSP(bf16, WS_W2) + (size_t)L * NE * 1024 * 512);
    S.estride = MODE == 0 ? (size_t)1024 * 1024 * 2 : (size_t)1024 * 512 * 2;
    const int* list = WSP(int, WS_LIST); const float* gates = WSP(float, WS_GATE);
    for (int ibase = 0; ibase * F.G + S.c < S.nunits; ibase += MOE_MAXU) {
        S.ibase = ibase;
        {
            static_assert(MOE_MAXU == 6, "three table slots per thread half");
            int ents[3]; float gsv[3]; const int r = FTID & 255, hsel = FTID >> 8;
#pragma unroll
            for (int k = 0; k < 3; ++k) { pg8::Unit u; ents[k] = -1;
                if (S.next(2 * k + hsel, u)) { const int idx = (u.pm - tst[u.e]) * 256 + r; if (idx < cntl[u.e]) ents[k] = list[(size_t)u.e * T + idx]; } }
#pragma unroll
            for (int k = 0; k < 3; ++k) gsv[k] = ents[k] >= 0 ? (MODE == 0 ? WSP(float, WS_RS)[ents[k] >> 1] : gates[ents[k]]) : 0.f;
#pragma unroll
            for (int k = 0; k < 3; ++k) { tab[(2 * k + hsel) * 256 + r] = ents[k]; gt[(2 * k + hsel) * 256 + r] = gsv[k]; }
        }
        S.rdy = 0u;
        if (MODE == 1) {
            LAS unsigned* rdyw = (LAS unsigned*)(F.lds + LX_TST + 448);
            if (FTID < 64) { unsigned m = 0u;
                for (int i = 0; i < MOE_MAXU; ++i) { pg8::Unit u; if (S.next(i, u) && (unsigned)__builtin_amdgcn_readfirstlane(__hip_atomic_load(S.hcnt + 16 * u.pm, __ATOMIC_RELAXED, __HIP_MEMORY_SCOPE_AGENT)) >= 32u) m |= 1u << i; }
                __builtin_amdgcn_fence(__ATOMIC_ACQUIRE, "agent"); asm volatile("s_waitcnt vmcnt(0)" ::: "memory");
                if (FTID == 0) *rdyw = m; }
            __syncthreads();
            S.rdy = *rdyw;
        }
        __syncthreads();
        if (MODE == 0) { EpiSwiglu E{WSP(bf16, WS_HID), gt}; pg8::gemm_phase(F.lds, WSP(bf16, WS_XN), D, S, E); }
        else { EpiScatterY E{WSP(bf16, WS_Y), tab, gt}; pg8::gemm_phase(F.lds, WSP(bf16, WS_HID), FF, S, E); }
        __syncthreads();
    }
}
__device__ __forceinline__ void f_moe(Frame& F, int L) {
    LAS int* tst = (LAS int*)(F.lds + LX_TST); LAS int* cntl = tst + 64;
    unsigned* ctl = WSP(unsigned, WS_CTL);
    __syncthreads();
    if (FTID < NE) cntl[FTID] = (int)__hip_atomic_load(&ctl[CW_CNT + L * 2048 + 64 * FTID], __ATOMIC_RELAXED, __HIP_MEMORY_SCOPE_AGENT);
    __syncthreads();
    if (FTID == 0) { int s = 0; for (int e = 0; e < NE; ++e) { tst[e] = s; s += (cntl[e] + 255) >> 8; } tst[NE] = s; }
    __syncthreads();
    f_moe_gemm<0>(F, L, tst, cntl);
    f_moe_gemm<1>(F, L, tst, cntl);
}
__device__ __forceinline__ void f_moe1(Frame& F, int L) { f_moe(F, L); }
__device__ __forceinline__ void f_moe2(Frame&, int) {}
__device__ __forceinline__ void transpose_item(const float* W, int ldw, const float* kscale, float cs, bf16* WT, int K, int dst_row0, LAS float* scr, int k0, int n0, int lane) {
    f32x4 x[8]; float ks[8];
    const int kr = lane >> 3, n4 = (lane & 7) * 4;
#pragma unroll
    for (int i = 0; i < 8; ++i) { x[i] = *(const f32x4*)(W + (size_t)(k0 + 8 * i + kr) * ldw + n0 + n4); ks[i] = kscale ? kscale[k0 + 8 * i + kr] * cs : cs; }
#pragma unroll
    for (int i = 0; i < 8; ++i) { LAS float* d = scr + (8 * i + kr) * 33 + n4; d[0] = x[i][0] * ks[i]; d[1] = x[i][1] * ks[i]; d[2] = x[i][2] * ks[i]; d[3] = x[i][3] * ks[i]; }
    LDS_WAIT(); asm volatile("" ::: "memory");
    const int c = lane & 7;
#pragma unroll
    for (int j = 0; j < 4; ++j) { const int n = (lane >> 3) + 8 * j; const LAS float* s = scr + (8 * c) * 33 + n;
        v4u o; o.x = pk2(s[0 * 33], s[1 * 33]); o.y = pk2(s[2 * 33], s[3 * 33]); o.z = pk2(s[4 * 33], s[5 * 33]); o.w = pk2(s[6 * 33], s[7 * 33]);
        *(v4u*)(WT + (size_t)(dst_row0 + n) * K + k0 + 8 * c) = o; }
    LDS_WAIT(); asm volatile("" ::: "memory");
}
__device__ __forceinline__ void convert_job_item(const float* W, int ldw, int K, int N, const float* kscale, int qcols, float qs, bf16* WT, int rowmap, LAS float* scr, int item, int lane) {
    const int nblk = N / 32, kb = item / nblk, nb = item % nblk, k0 = 64 * kb, n0 = 32 * nb;
    const int dr = rowmap == 0 ? n0 : ((n0 >> 7) * 256 + (n0 & 127) + (rowmap == 2 ? 128 : 0));
    transpose_item(W, ldw, kscale, n0 < qcols ? qs : 1.f, WT, K, dr, scr, k0, n0, lane);
}
__device__ __forceinline__ void f_convert_gla(Frame& F) {
    LAS float* scr = (LAS float*)(F.lds + FWAVE * 8448);
    const int gw = F.bid * NWAVES + FWAVE, NGW = F.G * NWAVES;
    constexpr int I0 = (D / 64) * (NQKVR / 32), I1 = (HV / 64) * (D / 32);
    for (int it = gw; it < I0 + I1; it += NGW) {
        if (it < I0) convert_job_item(F.inp(I_GLA_WIN), GLA_IN, D, NQKVR, F.inp(I_GLA_NORM), HK, 0.08838834764831845f, WSP(bf16, WS_WIN), 0, scr, it, FLANE);
        else convert_job_item(F.inp(I_GLA_WOUT), D, HV, D, F.inp(I_GLA_HG), 0, 1.f, WSP(bf16, WS_WOUT), 0, scr, it - I0, FLANE);
    }
}
__device__ __forceinline__ void f_convert_rest(Frame& F, int cw, int NCW, int pct0 = 0, int pct1 = 1000) {
    LAS float* scr = (LAS float*)(F.lds + FWAVE * 8448);
    constexpr int I0 = (D / 64) * (SGU_FFN / 32), I1 = (SGU_HALF / 64) * (D / 32), IE1 = (D / 64) * (FF / 32), IE2 = (FF / 64) * (D / 32);
    constexpr int IM = 2 * NE * IE1;
    static_assert(IE1 == IE2, "w1 / w2 item counts");
    constexpr int NIT = I0 + I1 + 3 * IM; const int it_lo = (int)((long)NIT * pct0 / 1000), it_hi = (int)((long)NIT * pct1 / 1000);
    for (int it = it_lo + cw; it < it_hi; it += NCW) {
        int r = it;
        if (r < I0) { convert_job_item(F.inp(I_SGU_WIN), SGU_FFN, D, SGU_FFN, F.inp(I_SGU_NORM), 0, 1.f, WSP(bf16, WS_WSIN), 0, scr, r, FLANE); continue; } r -= I0;
        if (r < I1) { convert_job_item(F.inp(I_SGU_WOUT), D, SGU_HALF, D, nullptr, 0, 1.f, WSP(bf16, WS_WSOUT), 0, scr, r, FLANE); continue; } r -= I1;
        const int which = r / IM; r -= which * IM; const int le = r / IE1, li = r % IE1, L = le / NE;
        if (which == 0) convert_job_item(F.inp(I_MOE_W1) + (size_t)le * D * FF, FF, D, FF, F.inp(I_MOE_NORM) + L * D, 0, 1.f, WSP(bf16, WS_W13) + (size_t)le * 1024 * 1024, 1, scr, li, FLANE);
        else if (which == 1) convert_job_item(F.inp(I_MOE_W3) + (size_t)le * D * FF, FF, D, FF, F.inp(I_MOE_NORM) + L * D, 0, 1.f, WSP(bf16, WS_W13) + (size_t)le * 1024 * 1024, 2, scr, li, FLANE);
        else convert_job_item(F.inp(I_MOE_W2) + (size_t)le * FF * D, D, FF, D, nullptr, 0, 1.f, WSP(bf16, WS_W2) + (size_t)le * 1024 * 512, 0, scr, li, FLANE);
    }
}

#ifndef SCAN_DUP
#define SCAN_DUP 0
#endif
constexpr int SC_K = 0, SC_KSTR = 320;
constexpr int SC_V = 20480, SC_VSTR = 576;
constexpr int SC_Q = 57344, SC_QSTR = 272;
constexpr int SC_O = 74752, SC_OSTR = 528;
constexpr int SC_GL = 108544, SC_PART = 112640, SC_DEC = 114688, SC_WG = 115200;
__device__ __forceinline__ s16x4 tr_read16(LAS const unsigned char* p) {
    typedef short v4i16_t __attribute__((ext_vector_type(4)));
    return __builtin_bit_cast(s16x4, __builtin_amdgcn_ds_read_tr16_b64_v4i16((LAS v4i16_t*)p));
}
__device__ __forceinline__ void f_scan_item(Frame& F, int item, const XcdBarrier* xb_ = nullptr, int cbar = -1) {
    const int b = item / GLA_H, h = item % GLA_H;
    const bf16* qkvr = WSP(bf16, WS_QKVR); const float* glr = WSP(float, WS_GLR); bf16* aout = WSP(bf16, WS_AOUT);
    LAS unsigned char* L = F.lds;
    LAS float* gl = (LAS float*)(L + SC_GL); LAS float* part = (LAS float*)(L + SC_PART); LAS float* dec = (LAS float*)(L + SC_DEC);
    const int tid = FTID, lane = FLANE, w = FWAVE;
    const int r32 = lane & 31, hh = lane >> 5, blk = (lane >> 4) & 1, q4 = (lane & 15) >> 2, p4 = lane & 3;
    const int dk = tid & 127, tg = tid >> 7;
    const int gq = lane >> 4, gcol = lane & 15, gdk = 16 * w + gcol;
    bf16x8 gBh, gBl;
    { unsigned ph[4], pl[4];
#pragma unroll
      for (int j = 0; j < 4; ++j) { const float x0 = gq < 2 ? F.inp(I_GLA_WGU)[(8 * gq + 2 * j) * HK + h * DK + gdk] : 0.f, x1 = gq < 2 ? F.inp(I_GLA_WGU)[(8 * gq + 2 * j + 1) * HK + h * DK + gdk] : 0.f;
          ph[j] = pk2(x0, x1); pl[j] = pk2(x0 - bflo(ph[j]), x1 - bfhi(ph[j])); }
      v4u vh = {ph[0], ph[1], ph[2], ph[3]}, vl = {pl[0], pl[1], pl[2], pl[3]};
      gBh = __builtin_bit_cast(bf16x8, vh); gBl = __builtin_bit_cast(bf16x8, vl); }
    const float gbias = F.inp(I_GLA_BG)[h * DK + gdk];
    __syncthreads();
    f32x16 st[4];
#pragma unroll
    for (int i = 0; i < 4; ++i)
#pragma unroll
        for (int j = 0; j < 16; ++j) st[i][j] = 0.f;
    v4u rk[2], rq[2], rv[4]; f32x4 rg;
    const size_t rowb = (size_t)b * SEQ;
    const unsigned vo_kq = (unsigned)(((tid >> 4) * NQKVR + (tid & 15) * 8) * 2), vo_v = (unsigned)(((tid >> 5) * NQKVR + (tid & 31) * 8) * 2), vo_g = (unsigned)(tid * 16);
    const unsigned lo_k = (unsigned)(SC_K + (tid >> 4) * SC_KSTR + (tid & 15) * 16), lo_q = (unsigned)(SC_Q + (tid >> 4) * SC_QSTR + (tid & 15) * 16), lo_v = (unsigned)(SC_V + (tid >> 5) * SC_VSTR + (tid & 31) * 16);
#define SC_LOAD(c) do { size_t cb_ = (rowb + (size_t)(c) * CHUNK) * NQKVR * 2; asm volatile("" : "+s"(cb_)); const char* gb_ = (const char*)qkvr + cb_ + (size_t)(h * DK * 2); \
        _Pragma("unroll") for (int i = 0; i < 2; ++i) { \
            rk[i] = *(const v4u*)(gb_ + (size_t)(HK * 2 + i * 32 * NQKVR * 2) + vo_kq); rq[i] = *(const v4u*)(gb_ + (size_t)(i * 32 * NQKVR * 2) + vo_kq); } \
        _Pragma("unroll") for (int i = 0; i < 4; ++i) rv[i] = *(const v4u*)(gb_ + (size_t)(2 * HK * 2 + h * (DV - DK) * 2 + i * 16 * NQKVR * 2) + vo_v); \
        if (tid < 256) rg = *(const f32x4*)((const char*)glr + (rowb + (size_t)(c) * CHUNK) * RANK * 4 + vo_g); } while (0)
#define SC_STORE() do { \
        _Pragma("unroll") for (int i = 0; i < 2; ++i) { *(LAS v4u*)(L + lo_k + i * 32 * SC_KSTR) = rk[i]; *(LAS v4u*)(L + lo_q + i * 32 * SC_QSTR) = rq[i]; } \
        _Pragma("unroll") for (int i = 0; i < 4; ++i) *(LAS v4u*)(L + lo_v + i * 16 * SC_VSTR) = rv[i]; \
        if (tid < 256) *(LAS f32x4*)(gl + tid * 4) = rg; } while (0)
    SC_LOAD(0);
    SC_STORE();
    for (int c = 0; c < NCHUNK; ++c) {
        if (c == cbar) xcd_barrier(*xb_);
        const size_t t0 = rowb + (size_t)c * CHUNK;
        __syncthreads();
        if (c + 1 < NCHUNK) SC_LOAD(c + 1);
        {
            pg8::f32x4 g4[4]; float tsum[4], pre[4];
#pragma unroll
            for (int t = 0; t < 4; ++t) {
                v4u ah = {0u, 0u, 0u, 0u}, al = {0u, 0u, 0u, 0u};
                if (gq < 2) { const f32x4 x0 = *(const LAS f32x4*)(gl + (16 * t + gcol) * 16 + 8 * gq), x1 = *(const LAS f32x4*)(gl + (16 * t + gcol) * 16 + 8 * gq + 4);
                    ah.x = pk2(x0[0], x0[1]); ah.y = pk2(x0[2], x0[3]); ah.z = pk2(x1[0], x1[1]); ah.w = pk2(x1[2], x1[3]);
                    al.x = pk2(x0[0] - bflo(ah.x), x0[1] - bfhi(ah.x)); al.y = pk2(x0[2] - bflo(ah.y), x0[3] - bfhi(ah.y)); al.z = pk2(x1[0] - bflo(ah.z), x1[1] - bfhi(ah.z)); al.w = pk2(x1[2] - bflo(ah.w), x1[3] - bfhi(ah.w)); }
                pg8::f32x4 a4 = {gbias, gbias, gbias, gbias};
                a4 = __builtin_amdgcn_mfma_f32_16x16x32_bf16(__builtin_bit_cast(bf16x8, ah), gBh, a4, 0, 0, 0);
                a4 = __builtin_amdgcn_mfma_f32_16x16x32_bf16(__builtin_bit_cast(bf16x8, al), gBh, a4, 0, 0, 0);
                a4 = __builtin_amdgcn_mfma_f32_16x16x32_bf16(__builtin_bit_cast(bf16x8, ah), gBl, a4, 0, 0, 0);
#pragma unroll
                for (int i = 0; i < 4; ++i) { const float a = a4[i]; a4[i] = (fminf(a, 0.f) - __logf(1.f + __expf(-fabsf(a)))) * (1.f / 16.f); }
                a4[1] += a4[0]; a4[2] += a4[1]; a4[3] += a4[2];
                g4[t] = a4;
                const float s0 = a4[3], x1 = __shfl_xor(s0, 16), x2 = __shfl_xor(s0, 32), x3 = __shfl_xor(x1, 32);
                tsum[t] = (s0 + x1) + (x2 + x3);
                pre[t] = ((gq ^ 1) < gq ? x1 : 0.f) + ((gq ^ 2) < gq ? x2 : 0.f) + ((gq ^ 3) < gq ? x3 : 0.f);
            }
            const float tot = (tsum[0] + tsum[1]) + (tsum[2] + tsum[3]);
            float basep = 0.f;
#pragma unroll
            for (int t = 0; t < 4; ++t) {
#pragma unroll
                for (int i = 0; i < 4; ++i) {
                    LAS unsigned short* kp = (LAS unsigned short*)(L + SC_K + (16 * t + 4 * gq + i) * SC_KSTR + gdk * 2);
                    *kp = (unsigned short)f2bf(bf2f(*kp) * __expf(tot - (basep + pre[t] + g4[t][i])));
                }
                basep += tsum[t];
            }
            if (gq == 0) dec[gdk] = __expf(tot);
        }
        __syncthreads();
        const int etok = tid >> 3, ecc = tid & 7;
        v4u rr[4];
        { size_t eb_ = t0 * NQKVR * 2; asm volatile("" : "+s"(eb_));
          const char* rb_ = (const char*)qkvr + eb_ + (size_t)((2 * HK + HV + h * DV) * 2); const unsigned vo_r = (unsigned)(etok * NQKVR * 2 + ecc * 16);
#pragma unroll
          for (int i = 0; i < 4; ++i) rr[i] = *(const v4u*)(rb_ + vo_r + i * 128); }
#pragma unroll
        for (int i = 0; i < 4; ++i)
#pragma unroll
            for (int g4 = 0; g4 < 4; ++g4) { const f32x4 d4 = *(const LAS f32x4*)(dec + 32 * i + 8 * g4 + 4 * hh);
#pragma unroll
                for (int j = 0; j < 4; ++j) st[i][4 * g4 + j] *= d4[j]; }
#pragma unroll
        for (int s = 0; s < 4; ++s) {
            const int trow = 16 * s + 8 * hh + q4;
            const s16x4 v0 = tr_read16(L + SC_V + trow * SC_VSTR + (32 * w + 16 * blk + 4 * p4) * 2), v1 = tr_read16(L + SC_V + (trow + 4) * SC_VSTR + (32 * w + 16 * blk + 4 * p4) * 2);
            const bf16x8 Bv = {v0[0], v0[1], v0[2], v0[3], v1[0], v1[1], v1[2], v1[3]};
#pragma unroll
            for (int i = 0; i < 4; ++i) {
                const s16x4 k0 = tr_read16(L + SC_K + trow * SC_KSTR + (32 * i + 16 * blk + 4 * p4) * 2), k1 = tr_read16(L + SC_K + (trow + 4) * SC_KSTR + (32 * i + 16 * blk + 4 * p4) * 2);
                const bf16x8 Ak = {k0[0], k0[1], k0[2], k0[3], k1[0], k1[1], k1[2], k1[3]};
                st[i] = __builtin_amdgcn_mfma_f32_32x32x16_bf16(Ak, Bv, st[i], 0, 0, 0);
            }
        }
        if (SCAN_DUP & 8) {
            f32x16 dum[2]; dum[0] = st[0]; dum[1] = st[1];
#pragma unroll
            for (int s = 0; s < 4; ++s) {
                const int trow = 16 * s + 8 * hh + q4;
                const s16x4 v0 = tr_read16(L + SC_V + trow * SC_VSTR + (32 * w + 16 * blk + 4 * p4) * 2), v1 = tr_read16(L + SC_V + (trow + 4) * SC_VSTR + (32 * w + 16 * blk + 4 * p4) * 2);
                const bf16x8 Bv = {v0[0], v0[1], v0[2], v0[3], v1[0], v1[1], v1[2], v1[3]};
#pragma unroll
                for (int i = 0; i < 4; ++i) {
                    const s16x4 k0 = tr_read16(L + SC_K + trow * SC_KSTR + (32 * i + 16 * blk + 4 * p4) * 2), k1 = tr_read16(L + SC_K + (trow + 4) * SC_KSTR + (32 * i + 16 * blk + 4 * p4) * 2);
                    const bf16x8 Ak = {k0[0], k0[1], k0[2], k0[3], k1[0], k1[1], k1[2], k1[3]};
                    dum[i & 1] = __builtin_amdgcn_mfma_f32_32x32x16_bf16(Ak, Bv, dum[i & 1], 0, 0, 0);
                }
            }
            asm volatile("" :: "v"(dum[0]), "v"(dum[1]));
        }
        for (int rep_ = 0; rep_ < ((SCAN_DUP & 1) ? 2 : 1); ++rep_) {
        f32x16 oacc[2];
#pragma unroll
        for (int ot = 0; ot < 2; ++ot)
#pragma unroll
            for (int j = 0; j < 16; ++j) oacc[ot][j] = 0.f;
#pragma unroll
        for (int i = 0; i < 4; ++i)
#pragma unroll
            for (int s2 = 0; s2 < 2; ++s2) {
                v4u pb; pb.x = pk2(st[i][8 * s2 + 0], st[i][8 * s2 + 1]); pb.y = pk2(st[i][8 * s2 + 2], st[i][8 * s2 + 3]); pb.z = pk2(st[i][8 * s2 + 4], st[i][8 * s2 + 5]); pb.w = pk2(st[i][8 * s2 + 6], st[i][8 * s2 + 7]);
                const bf16x8 Bs = __builtin_bit_cast(bf16x8, pb);
#pragma unroll
                for (int ot = 0; ot < 2; ++ot) {
                    LAS const unsigned char* qp = L + SC_Q + (32 * ot + r32) * SC_QSTR + (32 * i + 16 * s2 + 4 * hh) * 2;
                    const v2u a0 = *(const LAS v2u*)qp, a1 = *(const LAS v2u*)(qp + 16);
                    v4u pa; pa.x = a0.x; pa.y = a0.y; pa.z = a1.x; pa.w = a1.y;
                    oacc[ot] = __builtin_amdgcn_mfma_f32_32x32x16_bf16(__builtin_bit_cast(bf16x8, pa), Bs, oacc[ot], 0, 0, 0);
                }
            }
#pragma unroll
        for (int ot = 0; ot < 2; ++ot)
#pragma unroll
            for (int rg16 = 0; rg16 < 16; ++rg16) {
                const int tok = 32 * ot + (rg16 & 3) + 8 * (rg16 >> 2) + 4 * hh;
                *(LAS unsigned short*)(L + SC_O + tok * SC_OSTR + (32 * w + r32) * 2) = (unsigned short)f2bf(oacc[ot][rg16]);
            }
        }
        __syncthreads();
        if (c + 1 < NCHUNK) { SC_STORE(); if (SCAN_DUP & 16) { asm volatile("" ::: "memory"); SC_STORE(); } }
        for (int rep2_ = 0; rep2_ < ((SCAN_DUP & 2) ? 2 : 1); ++rep2_) {
        {
            const int tok = etok, cc = ecc;
            v4u ov[4]; float ss = 0.f;
#pragma unroll
            for (int i = 0; i < 4; ++i) ov[i] = *(const LAS v4u*)(L + SC_O + tok * SC_OSTR + cc * 16 + i * 128);
#pragma unroll
            for (int i = 0; i < 4; ++i) { const float a0 = bflo(ov[i].x), a1 = bfhi(ov[i].x), a2 = bflo(ov[i].y), a3 = bfhi(ov[i].y), a4 = bflo(ov[i].z), a5 = bfhi(ov[i].z), a6 = bflo(ov[i].w), a7 = bfhi(ov[i].w);
                ss += (a0 * a0 + a1 * a1) + (a2 * a2 + a3 * a3) + (a4 * a4 + a5 * a5) + (a6 * a6 + a7 * a7); }
            ss += __shfl_xor(ss, 1); ss += __shfl_xor(ss, 2); ss += __shfl_xor(ss, 4);
            const float rms = __builtin_amdgcn_rsqf(ss * (1.f / DV) + EPS);
            size_t ob_ = (t0 * D + h * DV) * 2; asm volatile("" : "+s"(ob_)); const unsigned vo_o = (unsigned)(tok * D * 2 + cc * 16);
#pragma unroll
            for (int i = 0; i < 4; ++i) {
                v4u o;
                o.x = pk2(bflo(ov[i].x) * rms * bflo(rr[i].x), bfhi(ov[i].x) * rms * bfhi(rr[i].x));
                o.y = pk2(bflo(ov[i].y) * rms * bflo(rr[i].y), bfhi(ov[i].y) * rms * bfhi(rr[i].y));
                o.z = pk2(bflo(ov[i].z) * rms * bflo(rr[i].z), bfhi(ov[i].z) * rms * bfhi(rr[i].z));
                o.w = pk2(bflo(ov[i].w) * rms * bflo(rr[i].w), bfhi(ov[i].w) * rms * bfhi(rr[i].w));
                *(v4u*)((char*)aout + ob_ + vo_o + i * 128) = o;
            }
        }
            }
    }
    __syncthreads();
#undef SC_LOAD
#undef SC_STORE
}
#ifndef P2_PARTS
#define P2_PARTS 3
#endif
__device__ __forceinline__ void f_scan_convert(Frame& F, int parts = 3) {
    constexpr int NITEM = NBATCH * GLA_H;
    const bool split = F.G >= 2 * NITEM;
    if ((parts & 1) && (!split || F.bid < NITEM)) for (int it = F.bid; it < NITEM; it += F.G) f_scan_item(F, it);
    if (!(parts & 2)) return;
    if (!split) f_convert_rest(F, F.bid * NWAVES + FWAVE, F.G * NWAVES);
    else if (F.bid >= NITEM) f_convert_rest(F, (F.bid - NITEM) * NWAVES + FWAVE, (F.G - NITEM) * NWAVES);
}

constexpr int SCAN_C1 = 20;
__device__ __forceinline__ void f_scan_outproj(Frame& F, const XcdBarrier& xbar) {
    constexpr int NITEM = NBATCH * GLA_H;
    if (F.bid < NITEM) f_scan_item(F, F.bid, &xbar, SCAN_C1);
    else { f_convert_rest(F, (F.bid - NITEM) * NWAVES + FWAVE, (F.G - NITEM) * NWAVES); xcd_barrier(xbar); f_gemm_out_rows(F, 0, SCAN_C1 / 4, NITEM); }
    xcd_barrier(xbar);
    f_gemm_out_rows(F, SCAN_C1 / 4, 8, 0);
}
constexpr int MX_W = 0, MX_WSTR = 272;
constexpr int MX_V0 = 34816, MX_VSTR = 320, MX_VBYTES = 40960;
constexpr int MX_MU = 116736;
constexpr int MX_LN = MX_MU + 2560;
__device__ __forceinline__ void f_mix(Frame& F, bf16* uout = nullptr) {
    LAS unsigned char* L = F.lds;
    LAS float* mu = (LAS float*)(L + MX_MU); LAS float* rs = mu + 128; LAS float* m1 = rs + 128; LAS float* m0 = m1 + 128; LAS float* bsg = m0 + 128;
    LAS float* lgs = (LAS float*)(L + MX_LN); LAS float* lbs = lgs + 512;
    bf16* u = WSP(bf16, WS_U); const bf16* v = WSP(bf16, WS_V); const float* st = WSP(float, WS_STATS); if (!uout) uout = u;
    const int tid = FTID, lane = FLANE, w = FWAVE;
    const int r32 = lane & 31, hh = lane >> 5, blk = (lane >> 4) & 1, q4 = (lane & 15) >> 2, p4 = lane & 3;
    const int ct = w >> 1, th = w & 1;
    const unsigned vo_v = (unsigned)(((tid >> 4) * SGU_HALF + (tid & 15) * 8) * 2), lo_v = (unsigned)(MX_V0 + (tid >> 4) * MX_VSTR + (tid & 15) * 16);
    constexpr int MX_MSTR = 272;
    for (int bn = F.bid; bn < T / SGU_BLK; bn += F.G) {
        const size_t t0 = (size_t)bn * SGU_BLK;
        __syncthreads();
        if (tid < 128) { float s = 0.f, q = 0.f;
            for (int p = 0; p < 32; ++p) { const pg8::f32x2 a = *(const pg8::f32x2*)(st + ((size_t)p * T + t0 + tid) * 2); s += a.x; q += a.y; }
            const float m = s * (1.f / SGU_HALF); mu[tid] = m; rs[tid] = __builtin_amdgcn_rsqf(fmaxf(q * (1.f / SGU_HALF) - m * m, 0.f) + EPS); }
        v4u preA[4], preB[4]; v4u uuA[4], uuB[4];
#define MX_LOAD(pre_, it_) do { size_t vb_ = (t0 * SGU_HALF + (size_t)(it_) * 128) * 2; asm volatile("" : "+s"(vb_)); \
        _Pragma("unroll") for (int i = 0; i < 4; ++i) pre_[i] = *(const v4u*)((const char*)v + vb_ + (size_t)(i * 32 * SGU_HALF * 2) + vo_v); } while (0)
#define MX_STORE(buf_, pre_) do { _Pragma("unroll") for (int i = 0; i < 4; ++i) *(LAS v4u*)(L + lo_v + (buf_) * MX_VBYTES + 32 * i * MX_VSTR) = pre_[i]; } while (0)
#define MX_ULOAD(uu_, it_) do { size_t ub_ = (t0 * SGU_HALF + (size_t)(it_) * 128) * 2; asm volatile("" : "+s"(ub_)); \
        _Pragma("unroll") for (int i = 0; i < 4; ++i) uu_[i] = *(const v4u*)((const char*)u + ub_ + (size_t)(i * 32 * SGU_HALF * 2) + vo_v); } while (0)
#define MX_TILE(it_, buf_, uu_) do { \
        f32x16 acc[2]; \
        _Pragma("unroll") for (int tt = 0; tt < 2; ++tt) _Pragma("unroll") for (int j = 0; j < 16; ++j) acc[tt][j] = 0.f; \
        LAS unsigned char* Vb = L + MX_V0 + (buf_) * MX_VBYTES; \
        const int nks = th == 0 ? 4 : 8; \
        for (int ks = 0; ks < nks; ++ks) { \
            const int srow = 16 * ks + 8 * hh + q4; \
            const s16x4 a0 = tr_read16(Vb + srow * MX_VSTR + (32 * ct + 16 * blk + 4 * p4) * 2), a1 = tr_read16(Vb + (srow + 4) * MX_VSTR + (32 * ct + 16 * blk + 4 * p4) * 2); \
            const bf16x8 Av = {a0[0], a0[1], a0[2], a0[3], a1[0], a1[1], a1[2], a1[3]}; \
            _Pragma("unroll") for (int tt = 0; tt < 2; ++tt) { \
                const bf16x8 Bw = *(const LAS bf16x8*)(L + MX_W + (64 * th + 32 * tt + r32) * MX_WSTR + (16 * ks + 8 * hh) * 2); \
                acc[tt] = __builtin_amdgcn_mfma_f32_32x32x16_bf16(Av, Bw, acc[tt], 0, 0, 0); } } \
        const int cl = ((it_) & 3) * 128 + 32 * ct + 4 * hh;                    \
        __syncthreads();                                                         \
        _Pragma("unroll") for (int tt = 0; tt < 2; ++tt) { \
            const int t = 64 * th + 32 * tt + r32; const float tm1 = m1[t], tm0 = m0[t], tb = bsg[t]; \
            _Pragma("unroll") for (int g4 = 0; g4 < 4; ++g4) { \
                const f32x4 lg = *(const LAS f32x4*)(lgs + cl + 8 * g4), lb = *(const LAS f32x4*)(lbs + cl + 8 * g4); \
                v2u o; o.x = pk2(lg[0] * (acc[tt][4 * g4 + 0] - tm1) + lb[0] * tm0 + tb, lg[1] * (acc[tt][4 * g4 + 1] - tm1) + lb[1] * tm0 + tb); \
                o.y = pk2(lg[2] * (acc[tt][4 * g4 + 2] - tm1) + lb[2] * tm0 + tb, lg[3] * (acc[tt][4 * g4 + 3] - tm1) + lb[3] * tm0 + tb); \
                *(LAS v2u*)(Vb + t * MX_MSTR + (32 * ct + 8 * g4 + 4 * hh) * 2) = o; } } \
        __syncthreads();                                                         \
        size_t ob_ = (t0 * SGU_HALF + (size_t)(it_) * 128) * 2; asm volatile("" : "+s"(ob_)); \
        _Pragma("unroll") for (int i = 0; i < 4; ++i) { \
            const v4u mx = *(const LAS v4u*)(Vb + ((tid >> 4) + 32 * i) * MX_MSTR + (tid & 15) * 16); const v4u ux = uu_[i]; v4u o; \
            o.x = pk2(bflo(ux.x) * bflo(mx.x), bfhi(ux.x) * bfhi(mx.x)); o.y = pk2(bflo(ux.y) * bflo(mx.y), bfhi(ux.y) * bfhi(mx.y)); \
            o.z = pk2(bflo(ux.z) * bflo(mx.z), bfhi(ux.z) * bfhi(mx.z)); o.w = pk2(bflo(ux.w) * bflo(mx.w), bfhi(ux.w) * bfhi(mx.w)); \
            *(v4u*)((char*)uout + ob_ + (size_t)(i * 32 * SGU_HALF * 2) + vo_v) = o; } } while (0)
        MX_LOAD(preA, 0); MX_LOAD(preB, 1); MX_ULOAD(uuA, 0);
        for (int it = 0; it < 16; it += 2) {
            if ((it & 3) == 0) {
                const int g = it >> 2;
                __syncthreads();
                const int t = tid >> 2, sq = tid & 3; const float* wsrc = F.inp(I_SGU_WS) + ((size_t)g * 128 + t) * 128 + sq * 8;
                float a1 = 0.f, a0 = 0.f;
#pragma unroll
                for (int i = 0; i < 4; ++i) {
                    const f32x4 x0 = *(const f32x4*)(wsrc + i * 32), x1 = *(const f32x4*)(wsrc + i * 32 + 4); float wv[8] = {x0[0], x0[1], x0[2], x0[3], x1[0], x1[1], x1[2], x1[3]}; float hv[8];
#pragma unroll
                    for (int j = 0; j < 8; ++j) { const int s = i * 32 + sq * 8 + j; const float wm = ((t >> 6) >= (s >> 6)) ? wv[j] : 0.f; a0 += wm; hv[j] = wm * rs[s]; }
                    v4u o; o.x = pk2(hv[0], hv[1]); o.y = pk2(hv[2], hv[3]); o.z = pk2(hv[4], hv[5]); o.w = pk2(hv[6], hv[7]);
                    const unsigned ow[4] = {o.x, o.y, o.z, o.w};
#pragma unroll
                    for (int j = 0; j < 4; ++j) a1 += bflo(ow[j]) * mu[i * 32 + sq * 8 + 2 * j] + bfhi(ow[j]) * mu[i * 32 + sq * 8 + 2 * j + 1];
                    *(LAS v4u*)(L + MX_W + t * MX_WSTR + (i * 32 + sq * 8) * 2) = o;
                }
                a1 += __shfl_xor(a1, 1); a1 += __shfl_xor(a1, 2); a0 += __shfl_xor(a0, 1); a0 += __shfl_xor(a0, 2);
                if (sq == 0) { m1[t] = a1; m0[t] = a0; }
                if (tid < 128) bsg[tid] = F.inp(I_SGU_BS)[g * 128 + tid];
                lgs[tid] = F.inp(I_SGU_LNG)[g * SGU_GC + tid]; lbs[tid] = F.inp(I_SGU_LNB)[g * SGU_GC + tid];
            }
            MX_STORE(0, preA);
            __syncthreads();
            if (it + 2 < 16) MX_LOAD(preA, it + 2);
            MX_ULOAD(uuB, it + 1);
            MX_TILE(it, 0, uuA);
            MX_STORE(1, preB);
            __syncthreads();
            if (it + 3 < 16) MX_LOAD(preB, it + 3);
            if (it + 2 < 16) MX_ULOAD(uuA, it + 2);
            MX_TILE(it + 1, 1, uuB);
        }
#undef MX_LOAD
#undef MX_STORE
#undef MX_ULOAD
#undef MX_TILE
    }
}
constexpr int RW_STR = 2064;
constexpr int RW_LG = 48 * RW_STR;
constexpr int RW_HIST = RW_LG + 8 * 16 * 48 * 4;
template <int MODE> __device__ __forceinline__ void f_rowgroup(Frame& F, int Lyr) {
    constexpr int NCT = MODE == 0 ? 1 : 3;
    LAS unsigned char* L = F.lds;
    const int tid = FTID, lane = FLANE, w = FWAVE, rw = lane & 15, q = lane >> 4;
    const float* xsrc = F.inp(I_X);
    bf16* xb = WSP(bf16, WS_XN); float* rsout = WSP(float, WS_RS);
    __syncthreads();
    for (int k = tid; k < D; k += NTHREADS) {
        if (MODE == 0) {
            const float gn = F.inp(I_GLA_NORM)[k]; const float* wr_ = F.inp(I_GLA_WIN) + (size_t)k * GLA_IN + NQKVR;
#pragma unroll
            for (int c4 = 0; c4 < 4; ++c4) { const f32x4 x = *(const f32x4*)(wr_ + 4 * c4);
#pragma unroll
                for (int j = 0; j < 4; ++j) *(LAS unsigned short*)(L + (4 * c4 + j) * RW_STR + k * 2) = (unsigned short)f2bf(x[j] * gn); }
        } else {
            const float gn = F.inp(I_MOE_NORM)[Lyr * D + k];
            const f32x4 xg = *(const f32x4*)(F.inp(I_MOE_WG) + ((size_t)Lyr * D + k) * 4);
#pragma unroll
            for (int j = 0; j < 4; ++j) *(LAS unsigned short*)(L + j * RW_STR + k * 2) = (unsigned short)f2bf(xg[j] * gn);
#pragma unroll
            for (int g = 0; g < 4; ++g) { const float* ws_ = F.inp(I_MOE_WSUB) + (((size_t)Lyr * 4 + g) * D + k) * EPG; const f32x4 a = *(const f32x4*)ws_, b = *(const f32x4*)(ws_ + 4);
#pragma unroll
                for (int j = 0; j < 4; ++j) { *(LAS unsigned short*)(L + (4 + 8 * g + j) * RW_STR + k * 2) = (unsigned short)f2bf(a[j] * gn); *(LAS unsigned short*)(L + (8 + 8 * g + j) * RW_STR + k * 2) = (unsigned short)f2bf(b[j] * gn); } }
#pragma unroll
            for (int c = 36; c < 48; ++c) *(LAS unsigned short*)(L + c * RW_STR + k * 2) = 0;
        }
    }
    LAS int* hist = (LAS int*)(L + RW_HIST); LAS int* hbase = hist + 32;
    if (MODE == 1 && tid < 32) hist[tid] = 0;
    __syncthreads();
    const int ngroups = T / 16, niter = (ngroups + F.G * NWAVES - 1) / (F.G * NWAVES);
    for (int iter = 0; iter < niter; ++iter) {
        const int grp = (iter * F.G + F.bid) * NWAVES + w; const bool valid = grp < ngroups;
        const size_t row = (size_t)grp * 16 + rw;
        float rstd = 0.f; pg8::f32x4 acc[NCT];
        if (valid) {
#pragma unroll
            for (int c = 0; c < NCT; ++c) acc[c] = (pg8::f32x4){0.f, 0.f, 0.f, 0.f};
            float ss = 0.f;
#pragma unroll 8
            for (int s = 0; s < 32; ++s) {
                v4u pa;
                if (MODE == 0) {
                    const float* xr = xsrc + row * D + 8 * q + 32 * s;
                    const f32x4 x0 = *(const f32x4*)xr, x1 = *(const f32x4*)(xr + 4);
                    ss += (x0[0] * x0[0] + x0[1] * x0[1]) + (x0[2] * x0[2] + x0[3] * x0[3]) + (x1[0] * x1[0] + x1[1] * x1[1]) + (x1[2] * x1[2] + x1[3] * x1[3]);
                    pa.x = pk2(x0[0], x0[1]); pa.y = pk2(x0[2], x0[3]); pa.z = pk2(x1[0], x1[1]); pa.w = pk2(x1[2], x1[3]);
                    *(v4u*)(xb + row * D + 8 * q + 32 * s) = pa;
                } else {
                    pa = *(const v4u*)(xb + row * D + 8 * q + 32 * s);
                    const float a0 = bflo(pa.x), a1 = bfhi(pa.x), a2 = bflo(pa.y), a3 = bfhi(pa.y), a4 = bflo(pa.z), a5 = bfhi(pa.z), a6 = bflo(pa.w), a7 = bfhi(pa.w);
                    ss += (a0 * a0 + a1 * a1) + (a2 * a2 + a3 * a3) + (a4 * a4 + a5 * a5) + (a6 * a6 + a7 * a7);
                }
                const bf16x8 A = __builtin_bit_cast(bf16x8, pa);
#pragma unroll
                for (int c = 0; c < NCT; ++c) { const bf16x8 B = *(const LAS bf16x8*)(L + (16 * c + rw) * RW_STR + (32 * s + 8 * q) * 2); acc[c] = __builtin_amdgcn_mfma_f32_16x16x32_bf16(A, B, acc[c], 0, 0, 0); }
            }
            ss += __shfl_xor(ss, 16); ss += __shfl_xor(ss, 32);
            rstd = __builtin_amdgcn_rsqf(ss * (1.f / D) + EPS);
            if (q == 0) rsout[row] = rstd;
        }
        float rs4[4];
#pragma unroll
        for (int i = 0; i < 4; ++i) rs4[i] = __shfl(rstd, 4 * q + i);
        int e1 = 0, e2 = 0, rk1 = 0, rk2 = 0; float gt1 = 0.f, gt2 = 0.f;
        if (MODE == 0) {
            if (valid) {
                float* glr = WSP(float, WS_GLR);
#pragma unroll
                for (int i = 0; i < 4; ++i) glr[((size_t)grp * 16 + 4 * q + i) * RANK + rw] = acc[0][i] * rs4[i];
            }
        } else {
            LAS float* lgw = (LAS float*)(L + RW_LG) + w * 16 * 48;
            if (valid) {
#pragma unroll
                for (int c = 0; c < NCT; ++c)
#pragma unroll
                    for (int i = 0; i < 4; ++i) lgw[(4 * q + i) * 48 + 16 * c + rw] = acc[c][i] * rs4[i];
            }
            LDS_WAIT(); asm volatile("" ::: "memory");
            if (valid && lane < 16) {
                const LAS float* lr = lgw + lane * 48; const float* bg = F.inp(I_MOE_BG) + Lyr * 4;
                float lg[4];
#pragma unroll
                for (int c = 0; c < 4; ++c) lg[c] = lr[c] + bg[c];
                int g = 0; float gm = lg[0];
#pragma unroll
                for (int c = 1; c < 4; ++c) if (lg[c] > gm) { gm = lg[c]; g = c; }
                float gs = 0.f;
#pragma unroll
                for (int c = 0; c < 4; ++c) gs += __expf(lg[c] - gm);
                const float g_w = 1.f / gs; const float* bs = F.inp(I_MOE_BSUB) + (Lyr * 4 + g) * EPG;
                int i1 = 0, i2 = 0; float m1v = -3.0e38f, m2v = -3.0e38f;
                for (int e = 0; e < EPG; ++e) { const float x = lr[4 + 8 * g + e] + bs[e];
                    if (x > m1v) { m2v = m1v; i2 = i1; m1v = x; i1 = e; } else if (x > m2v) { m2v = x; i2 = e; } }
                const float w1 = 1.f / (1.f + __expf(m2v - m1v));
                e1 = g * EPG + i1; e2 = g * EPG + i2; gt1 = g_w * w1; gt2 = g_w * (1.f - w1);
                rk1 = __hip_atomic_fetch_add(&hist[e1], 1, __ATOMIC_RELAXED, __HIP_MEMORY_SCOPE_WORKGROUP); rk2 = __hip_atomic_fetch_add(&hist[e2], 1, __ATOMIC_RELAXED, __HIP_MEMORY_SCOPE_WORKGROUP);
            }
            __syncthreads();
            if (tid < 32) { const int hcount = hist[tid]; hbase[tid] = hcount ? (int)atomicAdd(WSP(unsigned, WS_CTL) + CW_CNT + Lyr * 2048 + 64 * tid, (unsigned)hcount) : 0; hist[tid] = 0; }
            __syncthreads();
            if (valid && lane < 16) {
                const int tok = grp * 16 + lane; const int p1 = hbase[e1] + rk1, p2 = hbase[e2] + rk2;
                WSP(int, WS_LIST)[(size_t)e1 * T + p1] = tok * 2; WSP(int, WS_LIST)[(size_t)e2 * T + p2] = tok * 2 + 1;
                WSP(float, WS_GATE)[tok * 2] = gt1; WSP(float, WS_GATE)[tok * 2 + 1] = gt2;
            }
        }
    }
    __syncthreads();
}
template <bool FINAL> __device__ __forceinline__ void f_rowadd(Frame& F, bool scratch = false) {
    bf16* xb = WSP(bf16, WS_XN); const bf16* y = WSP(bf16, WS_Y); float* rsout = scratch ? (float*)F.out + (size_t)T * 600 : WSP(float, WS_RS); bf16* xo = scratch ? (bf16*)F.out : xb;
    const int lane = FLANE, w = FWAVE;
    f32x4 gf[4];
    if (FINAL) {
#pragma unroll
        for (int j = 0; j < 2; ++j) { gf[2 * j] = *(const f32x4*)(F.inp(I_FINAL) + 8 * lane + 512 * j); gf[2 * j + 1] = *(const f32x4*)(F.inp(I_FINAL) + 8 * lane + 512 * j + 4); }
    }
    for (int r0 = (F.bid * NWAVES + w) * 2; r0 < T; r0 += F.G * NWAVES * 2) {
        v4u xa[2][2], ya[2][2], yb[2][2];
#pragma unroll
        for (int rr = 0; rr < 2; ++rr)
#pragma unroll
            for (int j = 0; j < 2; ++j) { const size_t o = (size_t)(r0 + rr) * D + 8 * lane + 512 * j;
                xa[rr][j] = *(const v4u*)(xb + o); ya[rr][j] = *(const v4u*)(y + o); yb[rr][j] = *(const v4u*)(y + (size_t)T * D + o); }
#pragma unroll
        for (int rr = 0; rr < 2; ++rr) {
            float v[16]; float ss = 0.f;
#pragma unroll
            for (int j = 0; j < 2; ++j) {
                const unsigned xw[4] = {xa[rr][j].x, xa[rr][j].y, xa[rr][j].z, xa[rr][j].w}, aw[4] = {ya[rr][j].x, ya[rr][j].y, ya[rr][j].z, ya[rr][j].w}, bw[4] = {yb[rr][j].x, yb[rr][j].y, yb[rr][j].z, yb[rr][j].w};
#pragma unroll
                for (int e = 0; e < 4; ++e) { const float lo = bflo(xw[e]) + bflo(aw[e]) + bflo(bw[e]), hi = bfhi(xw[e]) + bfhi(aw[e]) + bfhi(bw[e]); v[8 * j + 2 * e] = lo; v[8 * j + 2 * e + 1] = hi; ss += lo * lo + hi * hi; }
            }
            const float rstd = __builtin_amdgcn_rsqf(wave_sum(ss) * (1.f / D) + EPS);
            const size_t ro = (size_t)(r0 + rr) * D + 8 * lane;
            if (FINAL) {
#pragma unroll
                for (int j = 0; j < 2; ++j) {
                    f32x4 o0 = {v[8 * j] * rstd, v[8 * j + 1] * rstd, v[8 * j + 2] * rstd, v[8 * j + 3] * rstd}, o1 = {v[8 * j + 4] * rstd, v[8 * j + 5] * rstd, v[8 * j + 6] * rstd, v[8 * j + 7] * rstd};
                    *(f32x4*)(F.out + ro + 512 * j) = o0 * gf[2 * j]; *(f32x4*)(F.out + ro + 512 * j + 4) = o1 * gf[2 * j + 1]; }
            } else {
#pragma unroll
                for (int j = 0; j < 2; ++j) { v4u o; o.x = pk2(v[8 * j], v[8 * j + 1]); o.y = pk2(v[8 * j + 2], v[8 * j + 3]); o.z = pk2(v[8 * j + 4], v[8 * j + 5]); o.w = pk2(v[8 * j + 6], v[8 * j + 7]); *(v4u*)(xo + ro + 512 * j) = o; }
                if (lane == 0) rsout[r0 + rr] = rstd;
            }
        }
    }
}
__device__ __forceinline__ void f_prep0(Frame& F) { f_convert_gla(F); f_rowgroup<0>(F, 0); }
__device__ __forceinline__ void f_rowpass_router(Frame& F, int L) { f_rowgroup<1>(F, L); }
__device__ __forceinline__ void f_rowpass_add(Frame& F, bool scratch = false) { f_rowadd<false>(F, scratch); }
__device__ __forceinline__ void f_final(Frame& F) { f_rowadd<true>(F); }
constexpr int LDS_BYTES = 155648;
struct Args { const float* in[23]; float* out; unsigned char* ws; int ph_lo, ph_hi; };
#define NAIVE(k) ((NAIVE_MASK >> (k)) & 1u)
#ifndef P1_FOLD
#define P1_FOLD 0
#endif
#ifndef DUP_MASK
#define DUP_MASK 0u
#endif
#define DUP(k) ((DUP_MASK >> (k)) & 1u)

struct EpiN1 { bf16* o; __device__ void operator()(int r, int c, float v) const { o[(size_t)r * NQKVR + c] = (bf16)f2bf(v); } };
struct EpiN3 { const float* res; float* o; __device__ void operator()(int r, int c, float v) const { o[(size_t)r * D + c] = res[(size_t)r * D + c] + v; } };
struct EpiN8 { bf16* u; bf16* v; __device__ void operator()(int r, int c, float x) const { const float z = gelu_erf(x); if (c < SGU_HALF) u[(size_t)r * SGU_HALF + c] = (bf16)f2bf(z); else v[(size_t)r * SGU_HALF + c - SGU_HALF] = (bf16)f2bf(z); } };

__global__ void __launch_bounds__(NTHREADS, 2) fwd(Args args) {
    extern __shared__ __attribute__((aligned(16))) unsigned char lds_raw[];
    Frame F;
    F.lds = (LAS unsigned char*)lds_raw;
    F.G = gridDim.x; F.bid = blockIdx.x;
    F.out = args.out; F.ws = args.ws;
    if (FTID == 0) {
        LAS unsigned long long* pt = (LAS unsigned long long*)(F.lds + LX_PTR);
#pragma unroll
        for (int i = 0; i < 23; ++i) pt[i] = (unsigned long long)args.in[i];
    }
    __syncthreads();
    const int lo = args.ph_lo, hi = args.ph_hi;
#if ONE_LAUNCH
    cg::grid_group grid = cg::this_grid();
    volatile LAS unsigned* bst = (volatile LAS unsigned*)(F.lds + LX_PTR + 192);
    if (FTID < 2) bst[FTID] = 0u;
    __syncthreads();
    const XcdBarrier xbar = xcd_barrier_post(WSP(unsigned, WS_CTL) + CW_BAR, bst);
#define GRID_BAR() xcd_barrier(xbar)
#define GRID_BAR_CG() grid.sync()
#else
#define GRID_BAR_CG() do { } while (0)
#define GRID_BAR() do { } while (0)
#endif
#define IN(k) (lo <= (k) && (k) < hi)
#define SEAM(k) do { if (IN(k) && IN((k) + 1)) GRID_BAR(); } while (0)

    if (IN(0)) {
        if (NAIVE(0)) { n_convert_gla(F); n_rowpass<0>(F, 0); } else { f_prep0(F); if (DUP(0)) { GRID_BAR(); f_prep0(F); } }
    }
    if (IN(0) && IN(1)) GRID_BAR();
    if (lo > 1000) GRID_BAR_CG();
    if (IN(1)) {
        if (NAIVE(1)) n_gemm(F, WSP(bf16, WS_XN), D, WSP(bf16, WS_WIN), D, T, NQKVR, D, EpiN1{WSP(bf16, WS_QKVR)}); else { f_gemm_in(F); if (DUP(1)) { GRID_BAR(); f_gemm_in(F, P1_FOLD); } }
    }
    SEAM(1);
#if ONE_LAUNCH
    if (!NAIVE(2) && !NAIVE(3) && F.G >= 128) { if (IN(2)) f_scan_outproj(F, xbar); }
    else
#endif
    {
    if (IN(2)) {
        if (NAIVE(2)) { n_scan(F); n_convert_rest(F); } else { f_scan_convert(F); if (DUP(2)) { GRID_BAR(); f_scan_convert(F, P2_PARTS); } }
    }
    SEAM(2);
    if (IN(3)) {
        if (NAIVE(3)) n_gemm(F, WSP(bf16, WS_XN), D, WSP(bf16, WS_WOUT), D, T, D, HV, EpiN3{F.inp(I_X), F.out}); else { if (DUP(3)) { f_gemm_out(F, (bf16*)F.out); GRID_BAR(); } f_gemm_out(F); }
    }
    }
    SEAM(3);
#define MOE_BLOCK(L, pb) do { \
        if (IN(pb)) { if (NAIVE(pb)) n_rowpass<1>(F, L); else { if (DUP(pb)) { f_rowpass_router(F, L); GRID_BAR(); if (F.bid == 0 && FTID < 32) WSP(unsigned, WS_CTL)[CW_CNT + (L) * 2048 + 64 * FTID] = 0u; GRID_BAR(); } f_rowpass_router(F, L); } } \
        SEAM(pb); \
        if (IN((pb) + 1)) { if (NAIVE((pb) + 1)) n_moe(F, L); else { f_moe1(F, L); if (DUP((pb) + 1)) { GRID_BAR(); f_moe1(F, L); } } } \
        if (NAIVE((pb) + 1)) SEAM((pb) + 1); \
        SEAM((pb) + 2); } while (0)
    MOE_BLOCK(0, 4);
    if (IN(7)) { if (NAIVE(7)) n_rowpass<2>(F, 0); else { if (DUP(7)) { f_rowpass_add(F, true); GRID_BAR(); } f_rowpass_add(F); } }
    SEAM(7);
    if (IN(8)) { if (NAIVE(8)) n_gemm(F, WSP(bf16, WS_XN), D, WSP(bf16, WS_WSIN), D, T, SGU_FFN, D, EpiN8{WSP(bf16, WS_U), WSP(bf16, WS_V)}); else { f_gemm_sgu_in(F); if (DUP(8)) { GRID_BAR(); f_gemm_sgu_in(F); } } }
    if (NAIVE(8)) { SEAM(8); if (IN(9)) n_stats(F); SEAM(9); } else { if (IN(8) && IN(10)) GRID_BAR(); }
    if (IN(10)) { if (NAIVE(10)) n_mix(F); else { if (DUP(10)) { f_mix(F, (bf16*)F.out); GRID_BAR(); } f_mix(F); } }
    SEAM(10);
    if (IN(11)) { if (NAIVE(11)) n_gemm(F, WSP(bf16, WS_U), SGU_HALF, WSP(bf16, WS_WSOUT), SGU_HALF, T, D, SGU_HALF, EpiN3{F.out, F.out}); else { if (DUP(11)) { f_gemm_sgu_out(F, (bf16*)F.out); GRID_BAR(); } f_gemm_sgu_out(F); } }
    SEAM(11);
    MOE_BLOCK(1, 12);
    if (IN(15)) { if (NAIVE(15)) n_rowpass<3>(F, 0); else f_final(F); }
}

extern "C" void kernel_launch(void* const* d_in, const int* in_sizes, int n_in, void* d_out, int out_size, void* d_ws, size_t ws_size, hipStream_t stream) {
    static int grid = 0;
    if (grid == 0) {
        if (n_in != 23 || out_size != T * D || ws_size < WS_END) { fprintf(stderr, "kernel_launch: unexpected shapes (n_in %d out %d ws %zu)\n", n_in, out_size, ws_size); grid = -1; return; }
        int dev = 0, cus = 0, per_cu = 0;
        hipGetDevice(&dev); hipDeviceGetAttribute(&cus, hipDeviceAttributeMultiprocessorCount, dev);
        hipFuncSetAttribute((const void*)fwd, hipFuncAttributeMaxDynamicSharedMemorySize, LDS_BYTES);
        hipOccupancyMaxActiveBlocksPerMultiprocessor(&per_cu, (const void*)fwd, NTHREADS, LDS_BYTES);
        (void)hipGetLastError();
        if (per_cu < 1) { fprintf(stderr, "kernel_launch: occupancy query says %d blocks per CU\n", per_cu); per_cu = 1; }
        grid = cus;
    }
    if (grid < 0) return;
    hipMemsetAsync((char*)d_ws + WS_CTL, 0, CTL_ZERO_BYTES, stream);
    Args a{};
    for (int i = 0; i < 23; ++i) a.in[i] = (const float*)d_in[i];
    a.out = (float*)d_out; a.ws = (unsigned char*)d_ws;
#if ONE_LAUNCH
    a.ph_lo = 0; a.ph_hi = 16;
    void* kargs[] = {&a};
    hipError_t e = hipLaunchCooperativeKernel((const void*)fwd, dim3(grid), dim3(NTHREADS), kargs, LDS_BYTES, stream);
    if (e != hipSuccess) fprintf(stderr, "cooperative launch failed: %s (grid %d)\n", hipGetErrorString(e), grid);
#else
    for (int p = 0; p < 16; ++p) {
        if (p == 9 && !NAIVE(8)) continue;
        if ((p == 6 || p == 14) && NAIVE(p - 1)) continue;
        a.ph_lo = p; a.ph_hi = p + 1;
        hipLaunchKernelGGL(fwd, dim3(grid), dim3(NTHREADS), LDS_BYTES, stream, a);
    }
#endif
}
```

```cpp
#include <hip/hip_runtime.h>
#include <hip/hip_cooperative_groups.h>
#include <cstdio>
#include <cstdint>
namespace cg = cooperative_groups;


constexpr int T = 32768, D = 1024, NBATCH = 16, SEQ = 2048;
constexpr int GLA_H = 4, DK = 128, DV = 256, HK = 512, HV = 1024, RANK = 16, GLA_IN = 3088, NQKVR = 3072, CHUNK = 64, NCHUNK = 32;
constexpr int SGU_FFN = 4096, SGU_HALF = 2048, SGU_BLK = 128, SGU_GC = 512;
constexpr int NE = 32, EPG = 8, FF = 512;
constexpr float EPS = 1e-6f;
constexpr int NTHREADS = 512, NWAVES = 8;

constexpr size_t MiB = 1u << 20;
constexpr size_t WS_CTL = 0, CTL_ZERO_BYTES = 128 * 1024;
constexpr size_t WS_GLR = 1 * MiB;
constexpr size_t WS_GATE = 3 * MiB;
constexpr size_t WS_STATS = 4 * MiB;
constexpr size_t WS_LIST = 12 * MiB;
constexpr size_t WS_WIN = 16 * MiB;
constexpr size_t WS_WOUT = 22 * MiB;
constexpr size_t WS_WSIN = 24 * MiB;
constexpr size_t WS_WSOUT = 32 * MiB;
constexpr size_t WS_W13 = 36 * MiB;
constexpr size_t WS_W2 = 164 * MiB;
constexpr size_t WS_XN = 228 * MiB;
constexpr size_t WS_AOUT = 484 * MiB;
constexpr size_t WS_RS = 3 * MiB + 256 * 1024;
constexpr size_t WS_QKVR = 292 * MiB;
constexpr size_t WS_HID = 292 * MiB;
constexpr size_t WS_Y = 364 * MiB;
constexpr size_t WS_U = 292 * MiB;
constexpr size_t WS_V = 420 * MiB;
constexpr size_t WS_END = 548 * MiB;
constexpr int CW_BAR = 1024;
constexpr int CW_HID = 16384;
constexpr int CW_CNT = 8192;

#define GAS __attribute__((address_space(1)))
#define LAS __attribute__((address_space(3)))
typedef unsigned short bf16;
typedef unsigned v4u __attribute__((ext_vector_type(4)));
typedef unsigned v2u __attribute__((ext_vector_type(2)));
typedef float f32x4 __attribute__((ext_vector_type(4)));
typedef float f32x16 __attribute__((ext_vector_type(16)));
typedef short bf16x8 __attribute__((ext_vector_type(8)));
typedef short s16x4 __attribute__((ext_vector_type(4)));
#define LDS_WAIT() asm volatile("s_waitcnt lgkmcnt(0)" ::: "memory")
#define VM_WAIT() asm volatile("s_waitcnt vmcnt(0)" ::: "memory")
typedef float f32x2_t __attribute__((ext_vector_type(2))); typedef __bf16 bf16x2_t __attribute__((ext_vector_type(2)));
__device__ __forceinline__ unsigned pk2(float lo, float hi) { f32x2_t v = {lo, hi}; bf16x2_t b = __builtin_convertvector(v, bf16x2_t); return __builtin_bit_cast(unsigned, b); }
__device__ __forceinline__ unsigned f2bf(float f) { return pk2(f, 0.f) & 0xffffu; }
__device__ __forceinline__ float bf2f(unsigned short b) { return __builtin_bit_cast(float, (unsigned)b << 16); }
__device__ __forceinline__ float bflo(unsigned w) { return __builtin_bit_cast(float, w << 16); }
__device__ __forceinline__ float bfhi(unsigned w) { return __builtin_bit_cast(float, w & 0xffff0000u); }
__device__ __forceinline__ float wave_sum(float v) {
#pragma unroll
    for (int o = 1; o < 64; o <<= 1) v += __shfl_xor(v, o);
    return v;
}
__device__ __forceinline__ float silu_f(float x) { return x * __builtin_amdgcn_rcpf(1.f + __expf(-x)); }
namespace pg8 {
#define PG8_LAS __attribute__((address_space(3)))
typedef unsigned short bf16_t;
typedef short bf16x8 __attribute__((ext_vector_type(8)));
typedef float f32x4 __attribute__((ext_vector_type(4)));
typedef unsigned u32x4 __attribute__((ext_vector_type(4)));
constexpr int BM = 256, BK = 64, HALF = 128, HTB = HALF * BK * 2  , STAGE_BYTES = 8 * HTB, NXCD = 8, WGM = 8;

__host__ __device__ __forceinline__ int lds_byte(int r, int c) { const int st = (r >> 4) * 2 + (c >> 5), rr = r & 15, cc = c & 31, ob = rr * 64 + cc * 2; return st * 1024 + (ob ^ (((ob >> 9) & 1) << 5)); }
__host__ __device__ __forceinline__ void stage_rc(int b, int& R, int& C) { const int st = b / 1024, sb = b % 1024, swz = sb ^ (((sb >> 9) & 1) << 5); R = (st >> 1) * 16 + swz / 64; C = (st & 1) * 32 + (swz % 64) / 2; }
__host__ __device__ __forceinline__ int perm32(int rho) { const int n = rho >> 4, i = rho & 15; return 8 * (i >> 2) + 4 * n + (i & 3); }

struct Unit { int pm, pn, e, slot; };

struct DenseOrder {
    static constexpr bool GATHER = false;
    int nM, nN, nwg, G, c, K; const char* Bt;
    __device__ void init(int M, int N, int K_, const bf16_t* Bt_, int G_, int c_) { nM = M / BM; nN = N / BM; nwg = nM * nN; G = G_; c = c_; K = K_; Bt = (const char*)Bt_; }
    __device__ __forceinline__ bool next(int i, Unit& u) const {
        const long L = (long)i * G + c; if (L >= nwg) return false;
        int wgid = (int)L; { const int q = nwg / NXCD, r = nwg % NXCD, xcd = wgid % NXCD, off = wgid / NXCD; wgid = (xcd < r ? xcd * (q + 1) : r * (q + 1) + (xcd - r) * q) + off; }
        const int nig = WGM * nN, gid = wgid / nig, fm = gid * WGM, gsz = (nM - fm) < WGM ? (nM - fm) : WGM;
        u.pm = fm + ((wgid % nig) % gsz); u.pn = (wgid % nig) / gsz; u.e = 0; u.slot = 0; return true;
    }
    __device__ __forceinline__ const char* bptr(const Unit& u) const { return Bt + (size_t)u.pn * BM * K * 2; }
    __device__ __forceinline__ size_t abase(const Unit& u) const { return (size_t)u.pm * BM * K * 2; }
    __device__ __forceinline__ unsigned aoff(const Unit& u, int h, int R, int C) const { return (unsigned)(((u.pm * BM + h * HALF + R) * K + C) * 2); }
    __device__ __forceinline__ void a_ready(const Unit&) const {}
    __device__ __forceinline__ void done(const Unit&) const {}
};

__device__ __forceinline__ unsigned cvt_pk_bf16(float lo, float hi) { unsigned r; asm volatile("v_cvt_pk_bf16_f32 %0, %1, %2" : "=v"(r) : "v"(lo), "v"(hi)); return r; }
typedef float f32x2 __attribute__((ext_vector_type(2)));
__device__ __forceinline__ f32x2 gelu_pk(f32x2 v) {
    const f32x2 av = __builtin_elementwise_abs(v), d = av * 0.2316418882f + 1.0f;
    f32x2 t; t.x = __builtin_amdgcn_rcpf(d.x); t.y = __builtin_amdgcn_rcpf(d.y);
    f32x2 q = t * 0.5307027145f + (-0.7265760135f); q = q * t + 0.7107068705f; q = q * t + (-0.142248368f); q = q * t + 0.127414796f; q = q * t;
    const f32x2 s = (v * v) * (-0.72134752044f);
    f32x2 e; e.x = __builtin_amdgcn_exp2f(s.x); e.y = __builtin_amdgcn_exp2f(s.y);
    const f32x2 m = v * (q * e), r = v - m;
    f32x2 o; o.x = v.x < 0.f ? m.x : r.x; o.y = v.y < 0.f ? m.y : r.y; return o;
}

template <class Epi, class Sched>
__device__ __forceinline__ void gemm_phase(PG8_LAS unsigned char* lds, const bf16_t* Abase, const int K, const Sched& S, const Epi& E) {
    const int tid = threadIdx.x, wid = __builtin_amdgcn_readfirstlane(tid >> 6), lane = tid & 63, wr = wid >> 2, wc = wid & 3, fr = lane & 15, fq = lane >> 4;
    const int nt = K / BK;
    int sR[2], sC[2]; unsigned voffA[2], voffB[2];
#pragma unroll
    for (int i = 0; i < 2; ++i) { stage_rc(tid * 16 + i * 8192, sR[i], sC[i]); const int Rb = Epi::PERM ? ((sR[i] & ~31) + perm32(sR[i] & 31)) : sR[i];
        voffA[i] = (unsigned)(sR[i] * K + sC[i]) * 2u; voffB[i] = (unsigned)(Rb * K + sC[i]) * 2u; }
    const size_t kstep = (size_t)(BK * 2);
    const size_t hstep = (size_t)HALF * K * 2;
    const unsigned ldsw = (unsigned)wid * 1024u;
    const int aoff = lds_byte(wr * 64 + fr, fq * 8), boff = lds_byte(wc * 32 + fr, fq * 8);
    const char* const Ab = (const char*)Abase;
#define PG8_SA(b, h) (((b) * 2 + (h)) * HTB)
#define PG8_SB(b, h) ((4 + (b) * 2 + (h)) * HTB)
#define PG8_STAGE(bufoff, gbase, voff) do { _Pragma("unroll") for (int _i = 0; _i < 2; ++_i) \
        __builtin_amdgcn_global_load_lds((const unsigned*)((const char*)(gbase) + (voff)[_i]), (PG8_LAS unsigned*)(lds + (bufoff) + ldsw + _i * 8192), 16, 0, 0); } while (0)
#define PG8_STAGE_A(bufoff, nx, h, kt) do { if constexpr (Sched::GATHER) { PG8_STAGE(bufoff, Ab + (size_t)(kt) * kstep, gc[h]); } \
        else PG8_STAGE(bufoff, ((nx) ? xA : cA) + (size_t)(h) * hstep + (size_t)(kt) * kstep, voffA); } while (0)
#define PG8_LDA(dst, b, h) do { _Pragma("unroll") for (int m = 0; m < 4; ++m) _Pragma("unroll") for (int k = 0; k < 2; ++k) dst[m][k] = *(const PG8_LAS bf16x8*)(lds + PG8_SA(b, h) + aoff + m * 2048 + k * 1024); } while (0)
#define PG8_LDB(dst, b, h) do { _Pragma("unroll") for (int n = 0; n < 2; ++n) _Pragma("unroll") for (int k = 0; k < 2; ++k) dst[n][k] = *(const PG8_LAS bf16x8*)(lds + PG8_SB(b, h) + boff + n * 2048 + k * 1024); } while (0)
#define PG8_MMA(ai, bj, At, Bt) do { __builtin_amdgcn_s_setprio(1); _Pragma("unroll") for (int m = 0; m < 4; ++m) _Pragma("unroll") for (int n = 0; n < 2; ++n) _Pragma("unroll") for (int k = 0; k < 2; ++k) \
        acc[ai][bj][m][n] = __builtin_amdgcn_mfma_f32_16x16x32_bf16(Bt[n][k], At[m][k], acc[ai][bj][m][n], 0, 0, 0); __builtin_amdgcn_s_setprio(0); } while (0)
#define PG8_WAIT_V(n) asm volatile("s_waitcnt vmcnt(" #n ")" ::: "memory")
#define PG8_WAIT_L(n) asm volatile("s_waitcnt lgkmcnt(" #n ")" ::: "memory")
#define PG8_BAR __builtin_amdgcn_s_barrier()
#define PG8_SCHED __builtin_amdgcn_sched_barrier(0)
    Unit cur, nxt, prv; int ui = 0; bool have_prv = false;
    if (!S.next(0, cur)) return;
    f32x4 acc[2][2][4][2];
#pragma unroll
    for (int a = 0; a < 2; ++a)
#pragma unroll
        for (int b = 0; b < 2; ++b)
#pragma unroll
            for (int m = 0; m < 4; ++m)
#pragma unroll
                for (int n = 0; n < 2; ++n) acc[a][b][m][n] = (f32x4){0.f, 0.f, 0.f, 0.f};
    bf16x8 At[4][2], B0[2][2], B1[2][2];
    unsigned gc[2][2];
    const char* cA = Ab; const char* xA = Ab;
    if constexpr (Sched::GATHER) {
#pragma unroll
        for (int h = 0; h < 2; ++h)
#pragma unroll
            for (int i = 0; i < 2; ++i) gc[h][i] = S.aoff(cur, h, sR[i], sC[i]);
    } else { cA = Ab + S.abase(cur); xA = cA; }
    const char* cB = S.bptr(cur);
    S.a_ready(cur);
    if constexpr (Epi::RS_DMA) { if (wid == 0) __builtin_amdgcn_global_load_lds((const unsigned*)((const char*)E.rs + (size_t)cur.pm * 1024 + lane * 16), (PG8_LAS unsigned*)(lds + STAGE_BYTES + 512), 16, 0, 0); }
    PG8_STAGE(PG8_SB(0, 0), cB, voffB); PG8_STAGE(PG8_SB(0, 1), cB + hstep, voffB); PG8_STAGE_A(PG8_SA(0, 0), false, 0, 0); PG8_STAGE_A(PG8_SA(0, 1), false, 1, 0);
    if (wr == 1) PG8_BAR;
    PG8_WAIT_V(2); PG8_BAR;
    PG8_STAGE(PG8_SB(1, 0), cB + kstep, voffB); PG8_STAGE_A(PG8_SA(1, 0), false, 0, 1); PG8_STAGE(PG8_SB(1, 1), cB + hstep + kstep, voffB);
    PG8_WAIT_V(6); PG8_BAR;
    for (;;) {
        const bool has_next = S.next(ui + 1, nxt);
        const char* nB = has_next ? S.bptr(nxt) : cB;
        if constexpr (Epi::RS_DMA) { if (has_next && wid == 0) __builtin_amdgcn_global_load_lds((const unsigned*)((const char*)E.rs + (size_t)nxt.pm * 1024 + lane * 16), (PG8_LAS unsigned*)(lds + STAGE_BYTES + 512 + ((ui + 1) % 3) * 1024), 16, 0, 0); }
        for (int t = 0; t < nt; t += 2) {
            const bool last = (t == nt - 2);
            const int kt2 = last ? 0 : t + 2;
            const char* b2 = last ? nB : cB + (size_t)(t + 2) * kstep; const char* b3 = b2 + kstep;
            if (last && has_next) {
                if constexpr (!Sched::GATHER) xA = Ab + S.abase(nxt);
                S.a_ready(nxt);
            }
            PG8_LDB(B0, 0, 0); PG8_LDB(B1, 0, 1); PG8_SCHED; PG8_LDA(At, 0, 0); PG8_STAGE_A(PG8_SA(1, 1), false, 1, t + 1);
            if constexpr (Sched::GATHER) { if (last && has_next) {
#pragma unroll
                for (int h = 0; h < 2; ++h)
#pragma unroll
                    for (int i = 0; i < 2; ++i) gc[h][i] = S.aoff(nxt, h, sR[i], sC[i]); } }
            PG8_WAIT_V(8); PG8_WAIT_L(0); PG8_BAR; PG8_MMA(0, 0, At, B0); PG8_MMA(0, 1, At, B1); PG8_BAR; PG8_SCHED;
            PG8_LDA(At, 0, 1); PG8_STAGE(PG8_SB(0, 0), b2, voffB); PG8_STAGE(PG8_SB(0, 1), b2 + hstep, voffB); PG8_STAGE_A(PG8_SA(0, 0), last, 0, kt2);
            PG8_WAIT_V(8); PG8_WAIT_L(0); PG8_BAR; PG8_MMA(1, 0, At, B0); PG8_MMA(1, 1, At, B1); PG8_BAR; PG8_SCHED;
            PG8_LDB(B0, 1, 0); PG8_LDB(B1, 1, 1); PG8_SCHED; PG8_LDA(At, 1, 0); PG8_STAGE_A(PG8_SA(0, 1), last, 1, kt2);
            PG8_WAIT_V(8); PG8_WAIT_L(0);
            if (have_prv) { S.done(prv); have_prv = false; }
            PG8_BAR; PG8_MMA(0, 0, At, B0); PG8_MMA(0, 1, At, B1); PG8_BAR; PG8_SCHED;
            PG8_LDA(At, 1, 1); PG8_STAGE(PG8_SB(1, 0), b3, voffB); PG8_STAGE(PG8_SB(1, 1), b3 + hstep, voffB); PG8_STAGE_A(PG8_SA(1, 0), last, 0, kt2 + 1);
            PG8_WAIT_V(8); PG8_WAIT_L(0); PG8_BAR; PG8_MMA(1, 0, At, B0); PG8_MMA(1, 1, At, B1); PG8_BAR; PG8_SCHED;
        }
        if (wr == 0) PG8_BAR;
        E(acc, cur, wr, wc, fr, fq, (const PG8_LAS float*)(lds + STAGE_BYTES + 512 + (ui % 3) * 1024)); prv = cur; have_prv = true;
        if (!has_next) break;
#pragma unroll
        for (int a = 0; a < 2; ++a)
#pragma unroll
            for (int b = 0; b < 2; ++b)
#pragma unroll
                for (int m = 0; m < 4; ++m)
#pragma unroll
                    for (int n = 0; n < 2; ++n) acc[a][b][m][n] = (f32x4){0.f, 0.f, 0.f, 0.f};
        cur = nxt; cB = nB; ++ui;
        if constexpr (!Sched::GATHER) cA = xA;
        if (wr == 1) PG8_BAR;
    }
    PG8_WAIT_V(0);
    if (have_prv) S.done(prv);
    PG8_BAR;
#undef PG8_STAGE_A
#undef PG8_SA
#undef PG8_SB
#undef PG8_STAGE
#undef PG8_LDA
#undef PG8_LDB
#undef PG8_MMA
#undef PG8_WAIT_V
#undef PG8_WAIT_L
#undef PG8_BAR
#undef PG8_SCHED
}
}
constexpr int LX_PTR = 155648 - 256;
#define FTID ((int)threadIdx.x)
#define FLANE ((int)threadIdx.x & 63)
#define FWAVE ((int)__builtin_amdgcn_readfirstlane((int)threadIdx.x >> 6))
struct Frame {
    LAS unsigned char* lds;
    int G, bid;
    float* out; unsigned char* ws;
    __device__ __forceinline__ const float* inp(int i) const {
        const LAS unsigned* p = (const LAS unsigned*)(lds + LX_PTR) + 2 * i;
        const unsigned lo = __builtin_amdgcn_readfirstlane(p[0]), hi = __builtin_amdgcn_readfirstlane(p[1]);
        return (const float*)(((unsigned long long)hi << 32) | lo);
    }
};
enum { I_X = 0, I_GLA_NORM, I_GLA_WIN, I_GLA_WGU, I_GLA_BG, I_GLA_HG, I_GLA_WOUT, I_SGU_NORM, I_SGU_WIN, I_SGU_LNG, I_SGU_LNB, I_SGU_WS, I_SGU_BS, I_SGU_WOUT,
       I_MOE_NORM, I_MOE_WG, I_MOE_BG, I_MOE_WSUB, I_MOE_BSUB, I_MOE_W1, I_MOE_W3, I_MOE_W2, I_FINAL };
#define WSP(type, off) ((type*)(F.ws + (off)))

#define XB_TMO      128
#define XB_XCNT(j)  (256  + 64 * (j))
#define XB_XSUB(j)  (1280 + 64 * (j))
#define XB_XGEN(j)  (2304 + 64 * (j))
#define XB_TOP      3328
#define XB_TOPGEN   3392
#define XCD_BAR_WORDS 3456
#define XB_SPIN_CAP (1u << 18)

__device__ __forceinline__ unsigned xb_ld(unsigned* p)              { return __hip_atomic_load(p, __ATOMIC_RELAXED, __HIP_MEMORY_SCOPE_AGENT); }
__device__ __forceinline__ unsigned xb_add(unsigned* p, unsigned v) { return __hip_atomic_fetch_add(p, v, __ATOMIC_RELAXED, __HIP_MEMORY_SCOPE_AGENT); }
__device__ __forceinline__ unsigned xb_xcc_id() { return (unsigned)__builtin_amdgcn_s_getreg((3 << 11) | 20) & 0xFu; }
#define XB_SPIN(cond, bar) do { unsigned _sp = 0; while (cond) { __builtin_amdgcn_s_sleep(1); \
    if ((++_sp & 255u) == 0u) { if (xb_ld(&(bar)[XB_TMO])) break; if (_sp > XB_SPIN_CAP) { atomicAdd(&(bar)[XB_TMO], 1u); break; } } } } while (0)

struct XcdBarrier {
    unsigned* bar; unsigned x;
    volatile LAS unsigned* st;
};

__device__ __forceinline__ XcdBarrier xcd_barrier_post(unsigned* bar, volatile LAS unsigned* st) {
    XcdBarrier b; b.bar = bar; b.x = xb_xcc_id(); b.st = st;
    if (threadIdx.x == 0) (void)xb_add(&bar[XB_XCNT(b.x)], 1u);
    return b;
}
__device__ __forceinline__ void xcd_barrier_complete(unsigned* bar, unsigned x, unsigned& nloc, unsigned& nx) {
    const unsigned G = gridDim.x * gridDim.y * gridDim.z;
    unsigned sum, cnt, mine, sp = 0u;
    for (;;) {
        sum = 0u; cnt = 0u; mine = 0u;
#pragma unroll
        for (unsigned j = 0; j < 16; ++j) { const unsigned c = xb_ld(&bar[XB_XCNT(j)]); sum += c; cnt += (c > 0u) ? 1u : 0u; mine = (j == x) ? c : mine; }
        if (sum == G) break;
        __builtin_amdgcn_s_sleep(1);
        if ((++sp & 255u) == 0u) { if (xb_ld(&bar[XB_TMO])) break; if (sp > XB_SPIN_CAP) { atomicAdd(&bar[XB_TMO], 1u); break; } }
    }
    nloc = mine > 0u ? mine : 1u; nx = cnt > 0u ? cnt : 1u;
}

__device__ __forceinline__ void xcd_barrier(const XcdBarrier& b) {
    asm volatile("s_waitcnt vmcnt(0)" ::: "memory");
    __syncthreads();
    if (threadIdx.x == 0) {
        unsigned* bar = b.bar;
        __builtin_amdgcn_s_waitcnt(0);
        unsigned nloc = b.st[0], nx = b.st[1];
        if (nloc == 0u) { xcd_barrier_complete(bar, b.x, nloc, nx); b.st[0] = nloc; b.st[1] = nx; }
        const unsigned old = xb_add(&bar[XB_XSUB(b.x)], 1u);
        const unsigned gen = old / nloc;
        if (old + 1u == (gen + 1u) * nloc) {
            __builtin_amdgcn_fence(__ATOMIC_RELEASE, "agent");
            asm volatile("s_waitcnt vmcnt(0)" ::: "memory");
            const unsigned og = xb_add(&bar[XB_TOP], 1u);
            const unsigned tg = og / nx;
            if (og + 1u == (tg + 1u) * nx) xb_add(&bar[XB_TOPGEN], 1u);
            else XB_SPIN(xb_ld(&bar[XB_TOPGEN]) == tg, bar);
            __builtin_amdgcn_fence(__ATOMIC_ACQUIRE, "agent");
            xb_add(&bar[XB_XGEN(b.x)], 1u);
            asm volatile("s_waitcnt vmcnt(0)" ::: "memory");
        } else {
            XB_SPIN(xb_ld(&bar[XB_XGEN(b.x)]) == gen, bar);
            __builtin_amdgcn_fence(__ATOMIC_ACQUIRE, "agent");
            asm volatile("s_waitcnt vmcnt(0)" ::: "memory");
        }
    }
    __syncthreads();
}
constexpr int RING_BYTES = 131072;
constexpr int LX_TST = RING_BYTES;
constexpr int MOE_MAXU = 6;
constexpr int LX_TAB = RING_BYTES + 512;
constexpr int LX_GT = LX_TAB + MOE_MAXU * 1024;

struct EpiStoreBf16 {
    static constexpr bool RS_DMA = true;
    static constexpr bool PERM = true;
    bf16* O; int ldc; const float* rs; int silu_from;
    __device__ __forceinline__ void operator()(const pg8::f32x4 (&acc)[2][2][4][2], const pg8::Unit& u, int wr, int wc, int fr, int fq, const LAS float* rsl) const {
        const int row0 = u.pm * 256 + wr * 64 + fr, col0 = u.pn * 256 + wc * 32 + 8 * fq;
#pragma unroll
        for (int ai = 0; ai < 2; ++ai)
#pragma unroll
            for (int m = 0; m < 4; ++m) { const int row = row0 + ai * 128 + m * 16; bf16* rowp = O + (size_t)row * ldc + col0; const float sc = rsl[ai * 128 + wr * 64 + m * 16 + fr];
#pragma unroll
                for (int bj = 0; bj < 2; ++bj) { pg8::f32x4 v0 = acc[ai][bj][m][0] * sc, v1 = acc[ai][bj][m][1] * sc;
                    if (silu_from >= 0 && u.pn >= silu_from) {
#pragma unroll
                        for (int i = 0; i < 4; ++i) { v0[i] = v0[i] * __builtin_amdgcn_rcpf(1.f + __expf(-v0[i])); v1[i] = v1[i] * __builtin_amdgcn_rcpf(1.f + __expf(-v1[i])); } }
                    v4u w; w.x = pg8::cvt_pk_bf16(v0[0], v0[1]); w.y = pg8::cvt_pk_bf16(v0[2], v0[3]); w.z = pg8::cvt_pk_bf16(v1[0], v1[1]); w.w = pg8::cvt_pk_bf16(v1[2], v1[3]);
                    *(v4u*)(rowp + bj * 128) = w; } }
    }
};
struct EpiResBf16 {
    static constexpr bool RS_DMA = false;
    static constexpr bool PERM = true;
    bf16* X;
    __device__ __forceinline__ void operator()(const pg8::f32x4 (&acc)[2][2][4][2], const pg8::Unit& u, int wr, int wc, int fr, int fq, const LAS float* rsl) const {
        const int row0 = u.pm * 256 + wr * 64 + fr, col0 = u.pn * 256 + wc * 32 + 8 * fq;
#pragma unroll
        for (int ai = 0; ai < 2; ++ai)
#pragma unroll
            for (int m = 0; m < 4; ++m) { bf16* rowp = X + (size_t)(row0 + ai * 128 + m * 16) * D + col0;
#pragma unroll
                for (int bj = 0; bj < 2; ++bj) { const v4u r = *(const v4u*)(rowp + bj * 128); const pg8::f32x4 v0 = acc[ai][bj][m][0], v1 = acc[ai][bj][m][1];
                    v4u w; w.x = pg8::cvt_pk_bf16(bflo(r.x) + v0[0], bfhi(r.x) + v0[1]); w.y = pg8::cvt_pk_bf16(bflo(r.y) + v0[2], bfhi(r.y) + v0[3]);
                    w.z = pg8::cvt_pk_bf16(bflo(r.z) + v1[0], bfhi(r.z) + v1[1]); w.w = pg8::cvt_pk_bf16(bflo(r.w) + v1[2], bfhi(r.w) + v1[3]);
                    *(v4u*)(rowp + bj * 128) = w; } }
    }
};
struct EpiGeluSplit {
    static constexpr bool RS_DMA = true;
    static constexpr bool PERM = true;
    bf16* U; bf16* V; float* st; const float* rs;
    __device__ __forceinline__ void operator()(const pg8::f32x4 (&acc)[2][2][4][2], const pg8::Unit& u, int wr, int wc, int fr, int fq, const LAS float* rsl) const {
        const bool isv = u.pn >= 8; const int pnl = isv ? u.pn - 8 : u.pn;
        bf16* O = isv ? V : U;
        const int row0 = u.pm * 256 + wr * 64 + fr, col0 = pnl * 256 + wc * 32 + 8 * fq;
#pragma unroll
        for (int ai = 0; ai < 2; ++ai)
#pragma unroll
            for (int m = 0; m < 4; ++m) { const int row = row0 + ai * 128 + m * 16; bf16* rowp = O + (size_t)row * SGU_HALF + col0; float s = 0.f, q = 0.f; const float sc = rsl[ai * 128 + wr * 64 + m * 16 + fr];
#pragma unroll
                for (int bj = 0; bj < 2; ++bj) { const pg8::f32x4 v0 = acc[ai][bj][m][0] * sc, v1 = acc[ai][bj][m][1] * sc;
                    const pg8::f32x2 a = pg8::gelu_pk((pg8::f32x2){v0[0], v0[1]}), b = pg8::gelu_pk((pg8::f32x2){v0[2], v0[3]}), c = pg8::gelu_pk((pg8::f32x2){v1[0], v1[1]}), d = pg8::gelu_pk((pg8::f32x2){v1[2], v1[3]});
                    s += (a.x + a.y) + (b.x + b.y) + (c.x + c.y) + (d.x + d.y);
                    q += (a.x * a.x + a.y * a.y) + (b.x * b.x + b.y * b.y) + (c.x * c.x + c.y * c.y) + (d.x * d.x + d.y * d.y);
                    v4u w; w.x = pg8::cvt_pk_bf16(a.x, a.y); w.y = pg8::cvt_pk_bf16(b.x, b.y); w.z = pg8::cvt_pk_bf16(c.x, c.y); w.w = pg8::cvt_pk_bf16(d.x, d.y);
                    *(v4u*)(rowp + bj * 128) = w; }
                if (isv) { s += __shfl_xor(s, 16); s += __shfl_xor(s, 32); q += __shfl_xor(q, 16); q += __shfl_xor(q, 32);
                    if (fq == 0) { pg8::f32x2 o = {s, q}; *(pg8::f32x2*)(st + ((size_t)(pnl * 4 + wc) * T + row) * 2) = o; } } }
    }
};

__device__ __forceinline__ void f_gemm_in(Frame& F) {
    pg8::DenseOrder S; S.init(T, NQKVR, D, WSP(bf16, WS_WIN), F.G, F.bid);
    EpiStoreBf16 E{WSP(bf16, WS_QKVR), NQKVR, WSP(float, WS_RS), 8};
    pg8::gemm_phase(F.lds, WSP(bf16, WS_XN), D, S, E);
}
struct RowSetOrder {
    static constexpr bool GATHER = false;
    int nb, c, j0, nunits, K; const char* Bt;
    __device__ __forceinline__ bool next(int i, pg8::Unit& u) const {
        if (c < 0) return false;
        const int q = i * nb + c; if (q >= nunits) return false;
        u.pm = ((q & 63) >> 2) * 8 + j0 + (q >> 6); u.pn = q & 3; u.e = 0; u.slot = 0; return true;
    }
    __device__ __forceinline__ const char* bptr(const pg8::Unit& u) const { return Bt + (size_t)u.pn * 256 * K * 2; }
    __device__ __forceinline__ size_t abase(const pg8::Unit& u) const { return (size_t)u.pm * 256 * K * 2; }
    __device__ __forceinline__ unsigned aoff(const pg8::Unit&, int, int, int) const { return 0u; }
    __device__ __forceinline__ void a_ready(const pg8::Unit&) const {}
    __device__ __forceinline__ void done(const pg8::Unit&) const {}
};
__device__ __forceinline__ void f_gemm_out_rows(Frame& F, int j0, int j1, int boff) {
    RowSetOrder S; S.nb = F.G - boff; S.c = F.bid - boff; S.j0 = j0; S.nunits = (j1 - j0) * 64; S.K = HV; S.Bt = (const char*)WSP(bf16, WS_WOUT);
    EpiResBf16 E{WSP(bf16, WS_XN)};
    pg8::gemm_phase(F.lds, WSP(bf16, WS_AOUT), HV, S, E);
}
__device__ __forceinline__ void f_gemm_sgu_in(Frame& F) {
    pg8::DenseOrder S; S.init(T, SGU_FFN, D, WSP(bf16, WS_WSIN), F.G, F.bid);
    EpiGeluSplit E{WSP(bf16, WS_U), WSP(bf16, WS_V), WSP(float, WS_STATS), WSP(float, WS_RS)};
    pg8::gemm_phase(F.lds, WSP(bf16, WS_XN), D, S, E);
}
__device__ __forceinline__ void f_gemm_sgu_out(Frame& F) {
    pg8::DenseOrder S; S.init(T, D, SGU_HALF, WSP(bf16, WS_WSOUT), F.G, F.bid);
    EpiResBf16 E{WSP(bf16, WS_XN)};
    pg8::gemm_phase(F.lds, WSP(bf16, WS_U), SGU_HALF, S, E);
}

template <bool GATHER_> struct MoeOrder {
    static constexpr bool GATHER = GATHER_;
    int G, c, nunits, ibase, K, mode;
    const char* W; size_t estride;
    LAS const int* tst; LAS const int* tab; unsigned* hcnt; unsigned rdy;
    int n5, rb;
    __device__ __forceinline__ bool next(int i, pg8::Unit& u) const {
        if (i >= MOE_MAXU) return false;
        const int ii = ibase + i; int Lu;
        if (GATHER || n5 <= 0 || ii < rb) Lu = ii * G + c;
        else { if (c < n5) return false; Lu = rb * G + (ii - rb) * (G - n5) + (c - n5); }
        if (Lu >= nunits) return false;
        const int rt = Lu >> 2; int e = 0;
        while (e < NE - 1 && tst[e + 1] <= rt) ++e;
        u.pm = rt; u.pn = Lu & 3; u.e = e; u.slot = i; return true;
    }
    __device__ __forceinline__ const char* bptr(const pg8::Unit& u) const { return W + (size_t)u.e * estride + (size_t)u.pn * 256 * K * 2; }
    __device__ __forceinline__ size_t abase(const pg8::Unit& u) const { return (size_t)u.pm * 256 * K * 2; }
    __device__ __forceinline__ unsigned aoff(const pg8::Unit& u, int h, int R, int C) const {
        if (mode == 0) { int ent = tab[u.slot * 256 + h * 128 + R]; ent = ent < 0 ? 0 : ent; return (unsigned)(((ent >> 1) * K + C) * 2); }
        return (unsigned)(((u.pm * 256 + h * 128 + R) * K + C) * 2);
    }
    __device__ __forceinline__ void a_ready(const pg8::Unit& u) const {
        if (GATHER || ((rdy >> u.slot) & 1u)) return;
        if (threadIdx.x < 64) {
            unsigned spins = 0;
            while ((unsigned)__builtin_amdgcn_readfirstlane(__hip_atomic_load(hcnt + 16 * u.pm, __ATOMIC_RELAXED, __HIP_MEMORY_SCOPE_AGENT)) < 32u) { __builtin_amdgcn_s_sleep(2); if (++spins > (1u << 20)) break; }
            __builtin_amdgcn_fence(__ATOMIC_ACQUIRE, "agent");
            asm volatile("s_waitcnt vmcnt(0)" ::: "memory");
        }
        asm volatile("" ::: "memory"); __builtin_amdgcn_s_barrier(); asm volatile("" ::: "memory");
    }
    __device__ __forceinline__ void done(const pg8::Unit& u) const {
        if (!GATHER) return;
        if ((threadIdx.x & 63) == 0) __hip_atomic_fetch_add(hcnt + 16 * u.pm, 1u, __ATOMIC_RELAXED, __HIP_MEMORY_SCOPE_AGENT);
    }
};
struct EpiSwiglu {
    static constexpr bool RS_DMA = false;
    static constexpr bool PERM = true;
    bf16* H; LAS const float* gt;
    __device__ __forceinline__ void operator()(const pg8::f32x4 (&acc)[2][2][4][2], const pg8::Unit& u, int wr, int wc, int fr, int fq, const LAS float* rsl) const {
        const __amdgpu_buffer_rsrc_t hrs = __builtin_amdgcn_make_buffer_rsrc((void*)H, (short)0, 73728 * FF * 2, 0x00020000);
        const int row0 = u.pm * 256 + wr * 64 + fr, col0 = u.pn * 128 + wc * 32 + 8 * fq;
#pragma unroll
        for (int ai = 0; ai < 2; ++ai)
#pragma unroll
            for (int m = 0; m < 4; ++m) { bf16* rowp = H + (size_t)(row0 + ai * 128 + m * 16) * FF + col0; float h[8]; const float sc = gt[u.slot * 256 + ai * 128 + wr * 64 + m * 16 + fr];
#pragma unroll
                for (int n = 0; n < 2; ++n)
#pragma unroll
                    for (int i = 0; i < 4; ++i) { const float a = acc[ai][0][m][n][i] * sc, b = acc[ai][1][m][n][i] * sc; h[n * 4 + i] = a * __builtin_amdgcn_rcpf(1.f + __expf(-a)) * b; }
                v4u w; w.x = pg8::cvt_pk_bf16(h[0], h[1]); w.y = pg8::cvt_pk_bf16(h[2], h[3]); w.z = pg8::cvt_pk_bf16(h[4], h[5]); w.w = pg8::cvt_pk_bf16(h[6], h[7]);
                __builtin_amdgcn_raw_buffer_store_b128(w, hrs, (int)((size_t)((const char*)rowp - (const char*)H)), 0, 16); }
    }
};
struct EpiScatterY {
    static constexpr bool RS_DMA = false;
    static constexpr bool PERM = true;
    bf16* Y; LAS const int* tab; LAS const float* gt;
    __device__ __forceinline__ void operator()(const pg8::f32x4 (&acc)[2][2][4][2], const pg8::Unit& u, int wr, int wc, int fr, int fq, const LAS float* rsl) const {
        const int col0 = u.pn * 256 + wc * 32 + 8 * fq;
#pragma unroll
        for (int ai = 0; ai < 2; ++ai)
#pragma unroll
            for (int m = 0; m < 4; ++m) { const int r = ai * 128 + wr * 64 + m * 16 + fr; const int ent = tab[u.slot * 256 + r]; const float g = gt[u.slot * 256 + r];
                if (ent >= 0) { bf16* rowp = Y + ((size_t)(ent & 1) * T + (ent >> 1)) * D + col0;
#pragma unroll
                    for (int bj = 0; bj < 2; ++bj) { const pg8::f32x4 v0 = acc[ai][bj][m][0] * g, v1 = acc[ai][bj][m][1] * g;
                        v4u w; w.x = pg8::cvt_pk_bf16(v0[0], v0[1]); w.y = pg8::cvt_pk_bf16(v0[2], v0[3]); w.z = pg8::cvt_pk_bf16(v1[0], v1[1]); w.w = pg8::cvt_pk_bf16(v1[2], v1[3]);
                        *(v4u*)(rowp + bj * 128) = w; } } }
    }
};
template <int MODE> __device__ __forceinline__ void f_moe_gemm(Frame& F, int L, LAS int* tst, LAS int* cntl) {
    LAS int* tab = (LAS int*)(F.lds + LX_TAB); LAS float* gt = (LAS float*)(F.lds + LX_GT);
    MoeOrder<MODE == 0> S; S.G = F.G; S.c = F.bid; S.nunits = 4 * tst[NE]; S.K = MODE == 0 ? D : FF; S.mode = MODE; S.tst = tst; S.tab = tab;
    S.hcnt = WSP(unsigned, WS_CTL) + CW_HID + L * 4608;
    { const int r1 = (S.nunits + F.G - 1) / F.G, nlast = S.nunits - (r1 - 1) * F.G;
      S.n5 = (MODE == 1 && r1 >= 3 && nlast < F.G) ? nlast : 0; S.rb = r1 - 2; }
    S.W = MODE == 0 ? (const char*)(WSP(bf16, WS_W13) + (size_t)L * NE * 1024 * 1024) : (const char*)(WSP(bf16, WS_W2) + (size_t)L * NE * 1024 * 512);
    S.estride = MODE == 0 ? (size_t)1024 * 1024 * 2 : (size_t)1024 * 512 * 2;
    const int* list = WSP(int, WS_LIST); const float* gates = WSP(float, WS_GATE);
    for (int ibase = 0; ibase * (S.n5 > 0 ? F.G - S.n5 : F.G) < S.nunits; ibase += MOE_MAXU) {
        S.ibase = ibase;
        {
            static_assert(MOE_MAXU == 6, "three table slots per thread half");
            int ents[3]; float gsv[3]; const int r = FTID & 255, hsel = FTID >> 8;
#pragma unroll
            for (int k = 0; k < 3; ++k) { pg8::Unit u; ents[k] = -1;
                if (S.next(2 * k + hsel, u)) { const int idx = (u.pm - tst[u.e]) * 256 + r; if (idx < cntl[u.e]) ents[k] = list[(size_t)u.e * T + idx]; } }
#pragma unroll
            for (int k = 0; k < 3; ++k) gsv[k] = ents[k] >= 0 ? (MODE == 0 ? WSP(float, WS_RS)[ents[k] >> 1] : gates[ents[k]]) : 0.f;
#pragma unroll
            for (int k = 0; k < 3; ++k) { tab[(2 * k + hsel) * 256 + r] = ents[k]; gt[(2 * k + hsel) * 256 + r] = gsv[k]; }
        }
        S.rdy = 0u;
        if (MODE == 1) {
            LAS unsigned* rdyw = (LAS unsigned*)(F.lds + LX_TST + 448);
            if (FTID < 64) { unsigned m = 0u;
                for (int i = 0; i < MOE_MAXU; ++i) { pg8::Unit u; if (S.next(i, u) && (unsigned)__builtin_amdgcn_readfirstlane(__hip_atomic_load(S.hcnt + 16 * u.pm, __ATOMIC_RELAXED, __HIP_MEMORY_SCOPE_AGENT)) >= 32u) m |= 1u << i; }
                __builtin_amdgcn_fence(__ATOMIC_ACQUIRE, "agent"); asm volatile("s_waitcnt vmcnt(0)" ::: "memory");
                if (FTID == 0) *rdyw = m; }
            __syncthreads();
            S.rdy = *rdyw;
        }
        __syncthreads();
        if (MODE == 0) { EpiSwiglu E{WSP(bf16, WS_HID), gt}; pg8::gemm_phase(F.lds, WSP(bf16, WS_XN), D, S, E); }
        else { EpiScatterY E{WSP(bf16, WS_Y), tab, gt}; pg8::gemm_phase(F.lds, WSP(bf16, WS_HID), FF, S, E); }
        __syncthreads();
    }
}
__device__ __forceinline__ void f_moe(Frame& F, int L) {
    LAS int* tst = (LAS int*)(F.lds + LX_TST); LAS int* cntl = tst + 64;
    unsigned* ctl = WSP(unsigned, WS_CTL);
    __syncthreads();
    if (FTID < NE) cntl[FTID] = (int)__hip_atomic_load(&ctl[CW_CNT + L * 2048 + 64 * FTID], __ATOMIC_RELAXED, __HIP_MEMORY_SCOPE_AGENT);
    __syncthreads();
    if (FTID == 0) { int s = 0; for (int e = 0; e < NE; ++e) { tst[e] = s; s += (cntl[e] + 255) >> 8; } tst[NE] = s; }
    __syncthreads();
    f_moe_gemm<0>(F, L, tst, cntl);
    f_moe_gemm<1>(F, L, tst, cntl);
}
__device__ __forceinline__ void transpose_item(const float* W, int ldw, const float* kscale, float cs, bf16* WT, int K, int dst_row0, LAS float* scr, int k0, int n0, int lane) {
    f32x4 x[8]; float ks[8];
    const int kr = lane >> 3, n4 = (lane & 7) * 4;
#pragma unroll
    for (int i = 0; i < 8; ++i) { x[i] = *(const f32x4*)(W + (size_t)(k0 + 8 * i + kr) * ldw + n0 + n4); ks[i] = kscale ? kscale[k0 + 8 * i + kr] * cs : cs; }
#pragma unroll
    for (int i = 0; i < 8; ++i) { LAS float* d = scr + (8 * i + kr) * 33 + n4; d[0] = x[i][0] * ks[i]; d[1] = x[i][1] * ks[i]; d[2] = x[i][2] * ks[i]; d[3] = x[i][3] * ks[i]; }
    LDS_WAIT(); asm volatile("" ::: "memory");
    const int c = lane & 7;
#pragma unroll
    for (int j = 0; j < 4; ++j) { const int n = (lane >> 3) + 8 * j; const LAS float* s = scr + (8 * c) * 33 + n;
        v4u o; o.x = pk2(s[0 * 33], s[1 * 33]); o.y = pk2(s[2 * 33], s[3 * 33]); o.z = pk2(s[4 * 33], s[5 * 33]); o.w = pk2(s[6 * 33], s[7 * 33]);
        *(v4u*)(WT + (size_t)(dst_row0 + n) * K + k0 + 8 * c) = o; }
    LDS_WAIT(); asm volatile("" ::: "memory");
}
__device__ __forceinline__ void convert_job_item(const float* W, int ldw, int K, int N, const float* kscale, int qcols, float qs, bf16* WT, int rowmap, LAS float* scr, int item, int lane) {
    const int nblk = N / 32, kb = item / nblk, nb = item % nblk, k0 = 64 * kb, n0 = 32 * nb;
    const int dr = rowmap == 0 ? n0 : ((n0 >> 7) * 256 + (n0 & 127) + (rowmap == 2 ? 128 : 0));
    transpose_item(W, ldw, kscale, n0 < qcols ? qs : 1.f, WT, K, dr, scr, k0, n0, lane);
}
__device__ __forceinline__ void f_convert_gla(Frame& F) {
    LAS float* scr = (LAS float*)(F.lds + FWAVE * 8448);
    const int gw = F.bid * NWAVES + FWAVE, NGW = F.G * NWAVES;
    constexpr int I0 = (D / 64) * (NQKVR / 32), I1 = (HV / 64) * (D / 32);
    for (int it = gw; it < I0 + I1; it += NGW) {
        if (it < I0) convert_job_item(F.inp(I_GLA_WIN), GLA_IN, D, NQKVR, F.inp(I_GLA_NORM), HK, 0.08838834764831845f, WSP(bf16, WS_WIN), 0, scr, it, FLANE);
        else convert_job_item(F.inp(I_GLA_WOUT), D, HV, D, F.inp(I_GLA_HG), 0, 1.f, WSP(bf16, WS_WOUT), 0, scr, it - I0, FLANE);
    }
}
__device__ __forceinline__ void f_convert_rest(Frame& F, int cw, int NCW, int pct0 = 0, int pct1 = 1000) {
    LAS float* scr = (LAS float*)(F.lds + FWAVE * 8448);
    constexpr int I0 = (D / 64) * (SGU_FFN / 32), I1 = (SGU_HALF / 64) * (D / 32), IE1 = (D / 64) * (FF / 32), IE2 = (FF / 64) * (D / 32);
    constexpr int IM = 2 * NE * IE1;
    static_assert(IE1 == IE2, "w1 / w2 item counts");
    constexpr int NIT = I0 + I1 + 3 * IM; const int it_lo = (int)((long)NIT * pct0 / 1000), it_hi = (int)((long)NIT * pct1 / 1000);
    for (int it = it_lo + cw; it < it_hi; it += NCW) {
        int r = it;
        if (r < I0) { convert_job_item(F.inp(I_SGU_WIN), SGU_FFN, D, SGU_FFN, F.inp(I_SGU_NORM), 0, 1.f, WSP(bf16, WS_WSIN), 0, scr, r, FLANE); continue; } r -= I0;
        if (r < I1) { convert_job_item(F.inp(I_SGU_WOUT), D, SGU_HALF, D, nullptr, 0, 1.f, WSP(bf16, WS_WSOUT), 0, scr, r, FLANE); continue; } r -= I1;
        const int which = r / IM; r -= which * IM; const int le = r / IE1, li = r % IE1, L = le / NE;
        if (which == 0) convert_job_item(F.inp(I_MOE_W1) + (size_t)le * D * FF, FF, D, FF, F.inp(I_MOE_NORM) + L * D, 0, 1.f, WSP(bf16, WS_W13) + (size_t)le * 1024 * 1024, 1, scr, li, FLANE);
        else if (which == 1) convert_job_item(F.inp(I_MOE_W3) + (size_t)le * D * FF, FF, D, FF, F.inp(I_MOE_NORM) + L * D, 0, 1.f, WSP(bf16, WS_W13) + (size_t)le * 1024 * 1024, 2, scr, li, FLANE);
        else convert_job_item(F.inp(I_MOE_W2) + (size_t)le * FF * D, D, FF, D, nullptr, 0, 1.f, WSP(bf16, WS_W2) + (size_t)le * 1024 * 512, 0, scr, li, FLANE);
    }
}

constexpr int SC_K = 0, SC_KSTR = 320;
constexpr int SC_V = 20480, SC_VSTR = 576;
constexpr int SC_Q = 57344, SC_QSTR = 272;
constexpr int SC_O = 74752, SC_OSTR = 528;
constexpr int SC_GL = 108544, SC_PART = 112640, SC_DEC = 114688, SC_WG = 115200;
__device__ __forceinline__ s16x4 tr_read16(LAS const unsigned char* p) {
    typedef short v4i16_t __attribute__((ext_vector_type(4)));
    return __builtin_bit_cast(s16x4, __builtin_amdgcn_ds_read_tr16_b64_v4i16((LAS v4i16_t*)p));
}
__device__ __forceinline__ void f_scan_item(Frame& F, int item, const XcdBarrier* xb_ = nullptr, int cbar = -1) {
    const int b = item / GLA_H, h = item % GLA_H;
    const bf16* qkvr = WSP(bf16, WS_QKVR); const float* glr = WSP(float, WS_GLR); bf16* aout = WSP(bf16, WS_AOUT);
    LAS unsigned char* L = F.lds;
    LAS float* gl = (LAS float*)(L + SC_GL); LAS float* part = (LAS float*)(L + SC_PART); LAS float* dec = (LAS float*)(L + SC_DEC);
    const int tid = FTID, lane = FLANE, w = FWAVE;
    const int r32 = lane & 31, hh = lane >> 5, blk = (lane >> 4) & 1, q4 = (lane & 15) >> 2, p4 = lane & 3;
    const int dk = tid & 127, tg = tid >> 7;
    const int gq = lane >> 4, gcol = lane & 15, gdk = 16 * w + gcol;
    bf16x8 gBh, gBl;
    { unsigned ph[4], pl[4];
#pragma unroll
      for (int j = 0; j < 4; ++j) { const float x0 = gq < 2 ? F.inp(I_GLA_WGU)[(8 * gq + 2 * j) * HK + h * DK + gdk] : 0.f, x1 = gq < 2 ? F.inp(I_GLA_WGU)[(8 * gq + 2 * j + 1) * HK + h * DK + gdk] : 0.f;
          ph[j] = pk2(x0, x1); pl[j] = pk2(x0 - bflo(ph[j]), x1 - bfhi(ph[j])); }
      v4u vh = {ph[0], ph[1], ph[2], ph[3]}, vl = {pl[0], pl[1], pl[2], pl[3]};
      gBh = __builtin_bit_cast(bf16x8, vh); gBl = __builtin_bit_cast(bf16x8, vl); }
    const float gbias = F.inp(I_GLA_BG)[h * DK + gdk];
    __syncthreads();
    f32x16 st[4];
#pragma unroll
    for (int i = 0; i < 4; ++i)
#pragma unroll
        for (int j = 0; j < 16; ++j) st[i][j] = 0.f;
    v4u rk[2], rq[2], rv[4]; f32x4 rg;
    const size_t rowb = (size_t)b * SEQ;
    const unsigned vo_kq = (unsigned)(((tid >> 4) * NQKVR + (tid & 15) * 8) * 2), vo_v = (unsigned)(((tid >> 5) * NQKVR + (tid & 31) * 8) * 2), vo_g = (unsigned)(tid * 16);
    const unsigned lo_k = (unsigned)(SC_K + (tid >> 4) * SC_KSTR + (tid & 15) * 16), lo_q = (unsigned)(SC_Q + (tid >> 4) * SC_QSTR + (tid & 15) * 16), lo_v = (unsigned)(SC_V + (tid >> 5) * SC_VSTR + (tid & 31) * 16);
#define SC_LOAD(c) do { size_t cb_ = (rowb + (size_t)(c) * CHUNK) * NQKVR * 2; asm volatile("" : "+s"(cb_)); const char* gb_ = (const char*)qkvr + cb_ + (size_t)(h * DK * 2); \
        _Pragma("unroll") for (int i = 0; i < 2; ++i) { \
            rk[i] = *(const v4u*)(gb_ + (size_t)(HK * 2 + i * 32 * NQKVR * 2) + vo_kq); rq[i] = *(const v4u*)(gb_ + (size_t)(i * 32 * NQKVR * 2) + vo_kq); } \
        _Pragma("unroll") for (int i = 0; i < 4; ++i) rv[i] = *(const v4u*)(gb_ + (size_t)(2 * HK * 2 + h * (DV - DK) * 2 + i * 16 * NQKVR * 2) + vo_v); \
        if (tid < 256) rg = *(const f32x4*)((const char*)glr + (rowb + (size_t)(c) * CHUNK) * RANK * 4 + vo_g); } while (0)
#define SC_STORE() do { \
        _Pragma("unroll") for (int i = 0; i < 2; ++i) { *(LAS v4u*)(L + lo_k + i * 32 * SC_KSTR) = rk[i]; *(LAS v4u*)(L + lo_q + i * 32 * SC_QSTR) = rq[i]; } \
        _Pragma("unroll") for (int i = 0; i < 4; ++i) *(LAS v4u*)(L + lo_v + i * 16 * SC_VSTR) = rv[i]; \
        if (tid < 256) *(LAS f32x4*)(gl + tid * 4) = rg; } while (0)
    SC_LOAD(0);
    SC_STORE();
    for (int c = 0; c < NCHUNK; ++c) {
        if (c == cbar) xcd_barrier(*xb_);
        const size_t t0 = rowb + (size_t)c * CHUNK;
        __syncthreads();
        if (c + 1 < NCHUNK) SC_LOAD(c + 1);
        {
            pg8::f32x4 g4[4]; float tsum[4], pre[4];
#pragma unroll
            for (int t = 0; t < 4; ++t) {
                v4u ah = {0u, 0u, 0u, 0u}, al = {0u, 0u, 0u, 0u};
                if (gq < 2) { const f32x4 x0 = *(const LAS f32x4*)(gl + (16 * t + gcol) * 16 + 8 * gq), x1 = *(const LAS f32x4*)(gl + (16 * t + gcol) * 16 + 8 * gq + 4);
                    ah.x = pk2(x0[0], x0[1]); ah.y = pk2(x0[2], x0[3]); ah.z = pk2(x1[0], x1[1]); ah.w = pk2(x1[2], x1[3]);
                    al.x = pk2(x0[0] - bflo(ah.x), x0[1] - bfhi(ah.x)); al.y = pk2(x0[2] - bflo(ah.y), x0[3] - bfhi(ah.y)); al.z = pk2(x1[0] - bflo(ah.z), x1[1] - bfhi(ah.z)); al.w = pk2(x1[2] - bflo(ah.w), x1[3] - bfhi(ah.w)); }
                pg8::f32x4 a4 = {gbias, gbias, gbias, gbias};
                a4 = __builtin_amdgcn_mfma_f32_16x16x32_bf16(__builtin_bit_cast(bf16x8, ah), gBh, a4, 0, 0, 0);
                a4 = __builtin_amdgcn_mfma_f32_16x16x32_bf16(__builtin_bit_cast(bf16x8, al), gBh, a4, 0, 0, 0);
                a4 = __builtin_amdgcn_mfma_f32_16x16x32_bf16(__builtin_bit_cast(bf16x8, ah), gBl, a4, 0, 0, 0);
#pragma unroll
                for (int i = 0; i < 4; ++i) { const float a = a4[i]; a4[i] = (fminf(a, 0.f) - __logf(1.f + __expf(-fabsf(a)))) * (1.f / 16.f); }
                a4[1] += a4[0]; a4[2] += a4[1]; a4[3] += a4[2];
                g4[t] = a4;
                const float s0 = a4[3], x1 = __shfl_xor(s0, 16), x2 = __shfl_xor(s0, 32), x3 = __shfl_xor(x1, 32);
                tsum[t] = (s0 + x1) + (x2 + x3);
                pre[t] = ((gq ^ 1) < gq ? x1 : 0.f) + ((gq ^ 2) < gq ? x2 : 0.f) + ((gq ^ 3) < gq ? x3 : 0.f);
            }
            const float tot = (tsum[0] + tsum[1]) + (tsum[2] + tsum[3]);
            float basep = 0.f;
#pragma unroll
            for (int t = 0; t < 4; ++t) {
#pragma unroll
                for (int i = 0; i < 4; ++i) {
                    LAS unsigned short* kp = (LAS unsigned short*)(L + SC_K + (16 * t + 4 * gq + i) * SC_KSTR + gdk * 2);
                    *kp = (unsigned short)f2bf(bf2f(*kp) * __expf(tot - (basep + pre[t] + g4[t][i])));
                }
                basep += tsum[t];
            }
            if (gq == 0) dec[gdk] = __expf(tot);
        }
        __syncthreads();
        const int etok = tid >> 3, ecc = tid & 7;
        v4u rr[4];
        { size_t eb_ = t0 * NQKVR * 2; asm volatile("" : "+s"(eb_));
          const char* rb_ = (const char*)qkvr + eb_ + (size_t)((2 * HK + HV + h * DV) * 2); const unsigned vo_r = (unsigned)(etok * NQKVR * 2 + ecc * 16);
#pragma unroll
          for (int i = 0; i < 4; ++i) rr[i] = *(const v4u*)(rb_ + vo_r + i * 128); }
#pragma unroll
        for (int i = 0; i < 4; ++i)
#pragma unroll
            for (int g4 = 0; g4 < 4; ++g4) { const f32x4 d4 = *(const LAS f32x4*)(dec + 32 * i + 8 * g4 + 4 * hh);
#pragma unroll
                for (int j = 0; j < 4; ++j) st[i][4 * g4 + j] *= d4[j]; }
#pragma unroll
        for (int s = 0; s < 4; ++s) {
            const int trow = 16 * s + 8 * hh + q4;
            const s16x4 v0 = tr_read16(L + SC_V + trow * SC_VSTR + (32 * w + 16 * blk + 4 * p4) * 2), v1 = tr_read16(L + SC_V + (trow + 4) * SC_VSTR + (32 * w + 16 * blk + 4 * p4) * 2);
            const bf16x8 Bv = {v0[0], v0[1], v0[2], v0[3], v1[0], v1[1], v1[2], v1[3]};
#pragma unroll
            for (int i = 0; i < 4; ++i) {
                const s16x4 k0 = tr_read16(L + SC_K + trow * SC_KSTR + (32 * i + 16 * blk + 4 * p4) * 2), k1 = tr_read16(L + SC_K + (trow + 4) * SC_KSTR + (32 * i + 16 * blk + 4 * p4) * 2);
                const bf16x8 Ak = {k0[0], k0[1], k0[2], k0[3], k1[0], k1[1], k1[2], k1[3]};
                st[i] = __builtin_amdgcn_mfma_f32_32x32x16_bf16(Ak, Bv, st[i], 0, 0, 0);
            }
        }
        {
        f32x16 oacc[2];
#pragma unroll
        for (int ot = 0; ot < 2; ++ot)
#pragma unroll
            for (int j = 0; j < 16; ++j) oacc[ot][j] = 0.f;
#pragma unroll
        for (int i = 0; i < 4; ++i)
#pragma unroll
            for (int s2 = 0; s2 < 2; ++s2) {
                v4u pb; pb.x = pk2(st[i][8 * s2 + 0], st[i][8 * s2 + 1]); pb.y = pk2(st[i][8 * s2 + 2], st[i][8 * s2 + 3]); pb.z = pk2(st[i][8 * s2 + 4], st[i][8 * s2 + 5]); pb.w = pk2(st[i][8 * s2 + 6], st[i][8 * s2 + 7]);
                const bf16x8 Bs = __builtin_bit_cast(bf16x8, pb);
#pragma unroll
                for (int ot = 0; ot < 2; ++ot) {
                    LAS const unsigned char* qp = L + SC_Q + (32 * ot + r32) * SC_QSTR + (32 * i + 16 * s2 + 4 * hh) * 2;
                    const v2u a0 = *(const LAS v2u*)qp, a1 = *(const LAS v2u*)(qp + 16);
                    v4u pa; pa.x = a0.x; pa.y = a0.y; pa.z = a1.x; pa.w = a1.y;
                    oacc[ot] = __builtin_amdgcn_mfma_f32_32x32x16_bf16(__builtin_bit_cast(bf16x8, pa), Bs, oacc[ot], 0, 0, 0);
                }
            }
#pragma unroll
        for (int ot = 0; ot < 2; ++ot)
#pragma unroll
            for (int rg16 = 0; rg16 < 16; ++rg16) {
                const int tok = 32 * ot + (rg16 & 3) + 8 * (rg16 >> 2) + 4 * hh;
                *(LAS unsigned short*)(L + SC_O + tok * SC_OSTR + (32 * w + r32) * 2) = (unsigned short)f2bf(oacc[ot][rg16]);
            }
        }
        __syncthreads();
        if (c + 1 < NCHUNK) SC_STORE();
        {
        {
            const int tok = etok, cc = ecc;
            v4u ov[4]; float ss = 0.f;
#pragma unroll
            for (int i = 0; i < 4; ++i) ov[i] = *(const LAS v4u*)(L + SC_O + tok * SC_OSTR + cc * 16 + i * 128);
#pragma unroll
            for (int i = 0; i < 4; ++i) { const float a0 = bflo(ov[i].x), a1 = bfhi(ov[i].x), a2 = bflo(ov[i].y), a3 = bfhi(ov[i].y), a4 = bflo(ov[i].z), a5 = bfhi(ov[i].z), a6 = bflo(ov[i].w), a7 = bfhi(ov[i].w);
                ss += (a0 * a0 + a1 * a1) + (a2 * a2 + a3 * a3) + (a4 * a4 + a5 * a5) + (a6 * a6 + a7 * a7); }
            ss += __shfl_xor(ss, 1); ss += __shfl_xor(ss, 2); ss += __shfl_xor(ss, 4);
            const float rms = __builtin_amdgcn_rsqf(ss * (1.f / DV) + EPS);
            size_t ob_ = (t0 * D + h * DV) * 2; asm volatile("" : "+s"(ob_)); const unsigned vo_o = (unsigned)(tok * D * 2 + cc * 16);
#pragma unroll
            for (int i = 0; i < 4; ++i) {
                v4u o;
                o.x = pk2(bflo(ov[i].x) * rms * bflo(rr[i].x), bfhi(ov[i].x) * rms * bfhi(rr[i].x));
                o.y = pk2(bflo(ov[i].y) * rms * bflo(rr[i].y), bfhi(ov[i].y) * rms * bfhi(rr[i].y));
                o.z = pk2(bflo(ov[i].z) * rms * bflo(rr[i].z), bfhi(ov[i].z) * rms * bfhi(rr[i].z));
                o.w = pk2(bflo(ov[i].w) * rms * bflo(rr[i].w), bfhi(ov[i].w) * rms * bfhi(rr[i].w));
                *(v4u*)((char*)aout + ob_ + vo_o + i * 128) = o;
            }
        }
            }
    }
    __syncthreads();
#undef SC_LOAD
#undef SC_STORE
}
constexpr int SCAN_C1 = 20;
__device__ __forceinline__ void f_scan_outproj(Frame& F, const XcdBarrier& xbar) {
    constexpr int NITEM = NBATCH * GLA_H;
    if (F.bid < NITEM) f_scan_item(F, F.bid, &xbar, SCAN_C1);
    else { f_convert_rest(F, (F.bid - NITEM) * NWAVES + FWAVE, (F.G - NITEM) * NWAVES); xcd_barrier(xbar); f_gemm_out_rows(F, 0, SCAN_C1 / 4, NITEM); }
    xcd_barrier(xbar);
    f_gemm_out_rows(F, SCAN_C1 / 4, 8, 0);
}
constexpr int MX_W = 0, MX_WSTR = 272;
constexpr int MX_V0 = 34816, MX_VSTR = 320, MX_VBYTES = 40960;
constexpr int MX_MU = 116736;
constexpr int MX_LN = MX_MU + 2560;
__device__ __forceinline__ void f_mix(Frame& F) {
    LAS unsigned char* L = F.lds;
    LAS float* mu = (LAS float*)(L + MX_MU); LAS float* rs = mu + 128; LAS float* m1 = rs + 128; LAS float* m0 = m1 + 128; LAS float* bsg = m0 + 128;
    LAS float* lgs = (LAS float*)(L + MX_LN); LAS float* lbs = lgs + 512;
    bf16* u = WSP(bf16, WS_U); const bf16* v = WSP(bf16, WS_V); const float* st = WSP(float, WS_STATS); bf16* uout = u;
    const int tid = FTID, lane = FLANE, w = FWAVE;
    const int r32 = lane & 31, hh = lane >> 5, blk = (lane >> 4) & 1, q4 = (lane & 15) >> 2, p4 = lane & 3;
    const int ct = w >> 1, th = w & 1;
    const unsigned vo_v = (unsigned)(((tid >> 4) * SGU_HALF + (tid & 15) * 8) * 2), lo_v = (unsigned)(MX_V0 + (tid >> 4) * MX_VSTR + (tid & 15) * 16);
    constexpr int MX_MSTR = 272;
    for (int bn = F.bid; bn < T / SGU_BLK; bn += F.G) {
        const size_t t0 = (size_t)bn * SGU_BLK;
        __syncthreads();
        {
            const int row = tid & 127, pq = tid >> 7; float s = 0.f, q = 0.f;
#pragma unroll
            for (int p = 0; p < 8; ++p) { const pg8::f32x2 a = *(const pg8::f32x2*)(st + ((size_t)(pq * 8 + p) * T + t0 + row) * 2); s += a.x; q += a.y; }
            LAS float* red = (LAS float*)(L + MX_V0);
            red[(pq * 128 + row) * 2] = s; red[(pq * 128 + row) * 2 + 1] = q;
            __syncthreads();
            if (tid < 128) { float s4 = 0.f, q4 = 0.f;
#pragma unroll
                for (int p = 0; p < 4; ++p) { s4 += red[(p * 128 + tid) * 2]; q4 += red[(p * 128 + tid) * 2 + 1]; }
                const float m = s4 * (1.f / SGU_HALF); mu[tid] = m; rs[tid] = __builtin_amdgcn_rsqf(fmaxf(q4 * (1.f / SGU_HALF) - m * m, 0.f) + EPS); }
            __syncthreads();
        }
        v4u preA[4], preB[4]; v4u uuA[4], uuB[4];
#define MX_LOAD(pre_, it_) do { size_t vb_ = (t0 * SGU_HALF + (size_t)(it_) * 128) * 2; asm volatile("" : "+s"(vb_)); \
        _Pragma("unroll") for (int i = 0; i < 4; ++i) pre_[i] = *(const v4u*)((const char*)v + vb_ + (size_t)(i * 32 * SGU_HALF * 2) + vo_v); } while (0)
#define MX_STORE(buf_, pre_) do { _Pragma("unroll") for (int i = 0; i < 4; ++i) *(LAS v4u*)(L + lo_v + (buf_) * MX_VBYTES + 32 * i * MX_VSTR) = pre_[i]; } while (0)
#define MX_ULOAD(uu_, it_) do { size_t ub_ = (t0 * SGU_HALF + (size_t)(it_) * 128) * 2; asm volatile("" : "+s"(ub_)); \
        _Pragma("unroll") for (int i = 0; i < 4; ++i) uu_[i] = *(const v4u*)((const char*)u + ub_ + (size_t)(i * 32 * SGU_HALF * 2) + vo_v); } while (0)
#define MX_TILE(it_, buf_, uu_) do { \
        f32x16 acc[2]; \
        _Pragma("unroll") for (int tt = 0; tt < 2; ++tt) _Pragma("unroll") for (int j = 0; j < 16; ++j) acc[tt][j] = 0.f; \
        LAS unsigned char* Vb = L + MX_V0 + (buf_) * MX_VBYTES; \
        const int nks = th == 0 ? 4 : 8; \
        for (int ks = 0; ks < nks; ++ks) { \
            const int srow = 16 * ks + 8 * hh + q4; \
            const s16x4 a0 = tr_read16(Vb + srow * MX_VSTR + (32 * ct + 16 * blk + 4 * p4) * 2), a1 = tr_read16(Vb + (srow + 4) * MX_VSTR + (32 * ct + 16 * blk + 4 * p4) * 2); \
            const bf16x8 Av = {a0[0], a0[1], a0[2], a0[3], a1[0], a1[1], a1[2], a1[3]}; \
            _Pragma("unroll") for (int tt = 0; tt < 2; ++tt) { \
                const bf16x8 Bw = *(const LAS bf16x8*)(L + MX_W + (64 * th + 32 * tt + r32) * MX_WSTR + (16 * ks + 8 * hh) * 2); \
                acc[tt] = __builtin_amdgcn_mfma_f32_32x32x16_bf16(Av, Bw, acc[tt], 0, 0, 0); } } \
        const int cl = ((it_) & 3) * 128 + 32 * ct + 4 * hh;                    \
        __syncthreads();                                                         \
        _Pragma("unroll") for (int tt = 0; tt < 2; ++tt) { \
            const int t = 64 * th + 32 * tt + r32; const float tm1 = m1[t], tm0 = m0[t], tb = bsg[t]; \
            _Pragma("unroll") for (int g4 = 0; g4 < 4; ++g4) { \
                const f32x4 lg = *(const LAS f32x4*)(lgs + cl + 8 * g4), lb = *(const LAS f32x4*)(lbs + cl + 8 * g4); \
                v2u o; o.x = pk2(lg[0] * (acc[tt][4 * g4 + 0] - tm1) + lb[0] * tm0 + tb, lg[1] * (acc[tt][4 * g4 + 1] - tm1) + lb[1] * tm0 + tb); \
                o.y = pk2(lg[2] * (acc[tt][4 * g4 + 2] - tm1) + lb[2] * tm0 + tb, lg[3] * (acc[tt][4 * g4 + 3] - tm1) + lb[3] * tm0 + tb); \
                *(LAS v2u*)(Vb + t * MX_MSTR + (32 * ct + 8 * g4 + 4 * hh) * 2) = o; } } \
        __syncthreads();                                                         \
        size_t ob_ = (t0 * SGU_HALF + (size_t)(it_) * 128) * 2; asm volatile("" : "+s"(ob_)); \
        _Pragma("unroll") for (int i = 0; i < 4; ++i) { \
            const v4u mx = *(const LAS v4u*)(Vb + ((tid >> 4) + 32 * i) * MX_MSTR + (tid & 15) * 16); const v4u ux = uu_[i]; v4u o; \
            o.x = pk2(bflo(ux.x) * bflo(mx.x), bfhi(ux.x) * bfhi(mx.x)); o.y = pk2(bflo(ux.y) * bflo(mx.y), bfhi(ux.y) * bfhi(mx.y)); \
            o.z = pk2(bflo(ux.z) * bflo(mx.z), bfhi(ux.z) * bfhi(mx.z)); o.w = pk2(bflo(ux.w) * bflo(mx.w), bfhi(ux.w) * bfhi(mx.w)); \
            *(v4u*)((char*)uout + ob_ + (size_t)(i * 32 * SGU_HALF * 2) + vo_v) = o; } } while (0)
        MX_LOAD(preA, 0); MX_LOAD(preB, 1); MX_ULOAD(uuA, 0);
        for (int it = 0; it < 16; it += 2) {
            if ((it & 3) == 0) {
                const int g = it >> 2;
                __syncthreads();
                const int t = tid >> 2, sq = tid & 3; const float* wsrc = F.inp(I_SGU_WS) + ((size_t)g * 128 + t) * 128 + sq * 8;
                float a1 = 0.f, a0 = 0.f;
#pragma unroll
                for (int i = 0; i < 4; ++i) {
                    const f32x4 x0 = *(const f32x4*)(wsrc + i * 32), x1 = *(const f32x4*)(wsrc + i * 32 + 4); float wv[8] = {x0[0], x0[1], x0[2], x0[3], x1[0], x1[1], x1[2], x1[3]}; float hv[8];
#pragma unroll
                    for (int j = 0; j < 8; ++j) { const int s = i * 32 + sq * 8 + j; const float wm = ((t >> 6) >= (s >> 6)) ? wv[j] : 0.f; a0 += wm; hv[j] = wm * rs[s]; }
                    v4u o; o.x = pk2(hv[0], hv[1]); o.y = pk2(hv[2], hv[3]); o.z = pk2(hv[4], hv[5]); o.w = pk2(hv[6], hv[7]);
                    const unsigned ow[4] = {o.x, o.y, o.z, o.w};
#pragma unroll
                    for (int j = 0; j < 4; ++j) a1 += bflo(ow[j]) * mu[i * 32 + sq * 8 + 2 * j] + bfhi(ow[j]) * mu[i * 32 + sq * 8 + 2 * j + 1];
                    *(LAS v4u*)(L + MX_W + t * MX_WSTR + (i * 32 + sq * 8) * 2) = o;
                }
                a1 += __shfl_xor(a1, 1); a1 += __shfl_xor(a1, 2); a0 += __shfl_xor(a0, 1); a0 += __shfl_xor(a0, 2);
                if (sq == 0) { m1[t] = a1; m0[t] = a0; }
                if (tid < 128) bsg[tid] = F.inp(I_SGU_BS)[g * 128 + tid];
                lgs[tid] = F.inp(I_SGU_LNG)[g * SGU_GC + tid]; lbs[tid] = F.inp(I_SGU_LNB)[g * SGU_GC + tid];
            }
            MX_STORE(0, preA);
            __syncthreads();
            if (it + 2 < 16) MX_LOAD(preA, it + 2);
            MX_ULOAD(uuB, it + 1);
            MX_TILE(it, 0, uuA);
            MX_STORE(1, preB);
            __syncthreads();
            if (it + 3 < 16) MX_LOAD(preB, it + 3);
            if (it + 2 < 16) MX_ULOAD(uuA, it + 2);
            MX_TILE(it + 1, 1, uuB);
        }
#undef MX_LOAD
#undef MX_STORE
#undef MX_ULOAD
#undef MX_TILE
    }
}
constexpr int RW_STR = 2064;
constexpr int RW_LG = 48 * RW_STR;
constexpr int RW_HIST = RW_LG + 8 * 16 * 48 * 4;
template <int MODE> __device__ __forceinline__ void f_rowgroup(Frame& F, int Lyr) {
    constexpr int NCT = MODE == 0 ? 1 : 3;
    LAS unsigned char* L = F.lds;
    const int tid = FTID, lane = FLANE, w = FWAVE, rw = lane & 15, q = lane >> 4;
    const float* xsrc = F.inp(I_X);
    bf16* xb = WSP(bf16, WS_XN); float* rsout = WSP(float, WS_RS);
    __syncthreads();
    for (int k = tid; k < D; k += NTHREADS) {
        if (MODE == 0) {
            const float gn = F.inp(I_GLA_NORM)[k]; const float* wr_ = F.inp(I_GLA_WIN) + (size_t)k * GLA_IN + NQKVR;
#pragma unroll
            for (int c4 = 0; c4 < 4; ++c4) { const f32x4 x = *(const f32x4*)(wr_ + 4 * c4);
#pragma unroll
                for (int j = 0; j < 4; ++j) *(LAS unsigned short*)(L + (4 * c4 + j) * RW_STR + k * 2) = (unsigned short)f2bf(x[j] * gn); }
        } else {
            const float gn = F.inp(I_MOE_NORM)[Lyr * D + k];
            const f32x4 xg = *(const f32x4*)(F.inp(I_MOE_WG) + ((size_t)Lyr * D + k) * 4);
#pragma unroll
            for (int j = 0; j < 4; ++j) *(LAS unsigned short*)(L + j * RW_STR + k * 2) = (unsigned short)f2bf(xg[j] * gn);
#pragma unroll
            for (int g = 0; g < 4; ++g) { const float* ws_ = F.inp(I_MOE_WSUB) + (((size_t)Lyr * 4 + g) * D + k) * EPG; const f32x4 a = *(const f32x4*)ws_, b = *(const f32x4*)(ws_ + 4);
#pragma unroll
                for (int j = 0; j < 4; ++j) { *(LAS unsigned short*)(L + (4 + 8 * g + j) * RW_STR + k * 2) = (unsigned short)f2bf(a[j] * gn); *(LAS unsigned short*)(L + (8 + 8 * g + j) * RW_STR + k * 2) = (unsigned short)f2bf(b[j] * gn); } }
#pragma unroll
            for (int c = 36; c < 48; ++c) *(LAS unsigned short*)(L + c * RW_STR + k * 2) = 0;
        }
    }
    LAS int* hist = (LAS int*)(L + RW_HIST); LAS int* hbase = hist + 32;
    if (MODE == 1 && tid < 32) hist[tid] = 0;
    __syncthreads();
    const int ngroups = T / 16, niter = (ngroups + F.G * NWAVES - 1) / (F.G * NWAVES);
    for (int iter = 0; iter < niter; ++iter) {
        const int grp = (iter * F.G + F.bid) * NWAVES + w; const bool valid = grp < ngroups;
        const size_t row = (size_t)grp * 16 + rw;
        float rstd = 0.f; pg8::f32x4 acc[NCT];
        if (valid) {
#pragma unroll
            for (int c = 0; c < NCT; ++c) acc[c] = (pg8::f32x4){0.f, 0.f, 0.f, 0.f};
            float ss = 0.f;
#pragma unroll 8
            for (int s = 0; s < 32; ++s) {
                v4u pa;
                if (MODE == 0) {
                    const float* xr = xsrc + row * D + 8 * q + 32 * s;
                    const f32x4 x0 = *(const f32x4*)xr, x1 = *(const f32x4*)(xr + 4);
                    ss += (x0[0] * x0[0] + x0[1] * x0[1]) + (x0[2] * x0[2] + x0[3] * x0[3]) + (x1[0] * x1[0] + x1[1] * x1[1]) + (x1[2] * x1[2] + x1[3] * x1[3]);
                    pa.x = pk2(x0[0], x0[1]); pa.y = pk2(x0[2], x0[3]); pa.z = pk2(x1[0], x1[1]); pa.w = pk2(x1[2], x1[3]);
                    *(v4u*)(xb + row * D + 8 * q + 32 * s) = pa;
                } else {
                    pa = *(const v4u*)(xb + row * D + 8 * q + 32 * s);
                    const float a0 = bflo(pa.x), a1 = bfhi(pa.x), a2 = bflo(pa.y), a3 = bfhi(pa.y), a4 = bflo(pa.z), a5 = bfhi(pa.z), a6 = bflo(pa.w), a7 = bfhi(pa.w);
                    ss += (a0 * a0 + a1 * a1) + (a2 * a2 + a3 * a3) + (a4 * a4 + a5 * a5) + (a6 * a6 + a7 * a7);
                }
                const bf16x8 A = __builtin_bit_cast(bf16x8, pa);
#pragma unroll
                for (int c = 0; c < NCT; ++c) { const bf16x8 B = *(const LAS bf16x8*)(L + (16 * c + rw) * RW_STR + (32 * s + 8 * q) * 2); acc[c] = __builtin_amdgcn_mfma_f32_16x16x32_bf16(A, B, acc[c], 0, 0, 0); }
            }
            ss += __shfl_xor(ss, 16); ss += __shfl_xor(ss, 32);
            rstd = __builtin_amdgcn_rsqf(ss * (1.f / D) + EPS);
            if (q == 0) rsout[row] = rstd;
        }
        float rs4[4];
#pragma unroll
        for (int i = 0; i < 4; ++i) rs4[i] = __shfl(rstd, 4 * q + i);
        int e1 = 0, e2 = 0, rk1 = 0, rk2 = 0; float gt1 = 0.f, gt2 = 0.f;
        if (MODE == 0) {
            if (valid) {
                float* glr = WSP(float, WS_GLR);
#pragma unroll
                for (int i = 0; i < 4; ++i) glr[((size_t)grp * 16 + 4 * q + i) * RANK + rw] = acc[0][i] * rs4[i];
            }
        } else {
            LAS float* lgw = (LAS float*)(L + RW_LG) + w * 16 * 48;
            if (valid) {
#pragma unroll
                for (int c = 0; c < NCT; ++c)
#pragma unroll
                    for (int i = 0; i < 4; ++i) lgw[(4 * q + i) * 48 + 16 * c + rw] = acc[c][i] * rs4[i];
            }
            LDS_WAIT(); asm volatile("" ::: "memory");
            if (valid && lane < 16) {
                const LAS float* lr = lgw + lane * 48; const float* bg = F.inp(I_MOE_BG) + Lyr * 4;
                float lg[4];
#pragma unroll
                for (int c = 0; c < 4; ++c) lg[c] = lr[c] + bg[c];
                int g = 0; float gm = lg[0];
#pragma unroll
                for (int c = 1; c < 4; ++c) if (lg[c] > gm) { gm = lg[c]; g = c; }
                float gs = 0.f;
#pragma unroll
                for (int c = 0; c < 4; ++c) gs += __expf(lg[c] - gm);
                const float g_w = 1.f / gs; const float* bs = F.inp(I_MOE_BSUB) + (Lyr * 4 + g) * EPG;
                int i1 = 0, i2 = 0; float m1v = -3.0e38f, m2v = -3.0e38f;
                for (int e = 0; e < EPG; ++e) { const float x = lr[4 + 8 * g + e] + bs[e];
                    if (x > m1v) { m2v = m1v; i2 = i1; m1v = x; i1 = e; } else if (x > m2v) { m2v = x; i2 = e; } }
                const float w1 = 1.f / (1.f + __expf(m2v - m1v));
                e1 = g * EPG + i1; e2 = g * EPG + i2; gt1 = g_w * w1; gt2 = g_w * (1.f - w1);
                rk1 = __hip_atomic_fetch_add(&hist[e1], 1, __ATOMIC_RELAXED, __HIP_MEMORY_SCOPE_WORKGROUP); rk2 = __hip_atomic_fetch_add(&hist[e2], 1, __ATOMIC_RELAXED, __HIP_MEMORY_SCOPE_WORKGROUP);
            }
            __syncthreads();
            if (tid < 32) { const int hcount = hist[tid]; hbase[tid] = hcount ? (int)atomicAdd(WSP(unsigned, WS_CTL) + CW_CNT + Lyr * 2048 + 64 * tid, (unsigned)hcount) : 0; hist[tid] = 0; }
            __syncthreads();
            if (valid && lane < 16) {
                const int tok = grp * 16 + lane; const int p1 = hbase[e1] + rk1, p2 = hbase[e2] + rk2;
                WSP(int, WS_LIST)[(size_t)e1 * T + p1] = tok * 2; WSP(int, WS_LIST)[(size_t)e2 * T + p2] = tok * 2 + 1;
                WSP(float, WS_GATE)[tok * 2] = gt1; WSP(float, WS_GATE)[tok * 2 + 1] = gt2;
            }
        }
    }
    __syncthreads();
}
template <bool FINAL> __device__ __forceinline__ void f_rowadd(Frame& F) {
    bf16* xb = WSP(bf16, WS_XN); const bf16* y = WSP(bf16, WS_Y); float* rsout = WSP(float, WS_RS); bf16* xo = xb;
    const int lane = FLANE, w = FWAVE;
    f32x4 gf[4];
    if (FINAL) {
#pragma unroll
        for (int j = 0; j < 2; ++j) { gf[2 * j] = *(const f32x4*)(F.inp(I_FINAL) + 8 * lane + 512 * j); gf[2 * j + 1] = *(const f32x4*)(F.inp(I_FINAL) + 8 * lane + 512 * j + 4); }
    }
    for (int r0 = (F.bid * NWAVES + w) * 2; r0 < T; r0 += F.G * NWAVES * 2) {
        v4u xa[2][2], ya[2][2], yb[2][2];
#pragma unroll
        for (int rr = 0; rr < 2; ++rr)
#pragma unroll
            for (int j = 0; j < 2; ++j) { const size_t o = (size_t)(r0 + rr) * D + 8 * lane + 512 * j;
                xa[rr][j] = *(const v4u*)(xb + o); ya[rr][j] = *(const v4u*)(y + o); yb[rr][j] = *(const v4u*)(y + (size_t)T * D + o); }
#pragma unroll
        for (int rr = 0; rr < 2; ++rr) {
            float v[16]; float ss = 0.f;
#pragma unroll
            for (int j = 0; j < 2; ++j) {
                const unsigned xw[4] = {xa[rr][j].x, xa[rr][j].y, xa[rr][j].z, xa[rr][j].w}, aw[4] = {ya[rr][j].x, ya[rr][j].y, ya[rr][j].z, ya[rr][j].w}, bw[4] = {yb[rr][j].x, yb[rr][j].y, yb[rr][j].z, yb[rr][j].w};
#pragma unroll
                for (int e = 0; e < 4; ++e) { const float lo = bflo(xw[e]) + bflo(aw[e]) + bflo(bw[e]), hi = bfhi(xw[e]) + bfhi(aw[e]) + bfhi(bw[e]); v[8 * j + 2 * e] = lo; v[8 * j + 2 * e + 1] = hi; ss += lo * lo + hi * hi; }
            }
            const float rstd = __builtin_amdgcn_rsqf(wave_sum(ss) * (1.f / D) + EPS);
            const size_t ro = (size_t)(r0 + rr) * D + 8 * lane;
            if (FINAL) {
#pragma unroll
                for (int j = 0; j < 2; ++j) {
                    f32x4 o0 = {v[8 * j] * rstd, v[8 * j + 1] * rstd, v[8 * j + 2] * rstd, v[8 * j + 3] * rstd}, o1 = {v[8 * j + 4] * rstd, v[8 * j + 5] * rstd, v[8 * j + 6] * rstd, v[8 * j + 7] * rstd};
                    *(f32x4*)(F.out + ro + 512 * j) = o0 * gf[2 * j]; *(f32x4*)(F.out + ro + 512 * j + 4) = o1 * gf[2 * j + 1]; }
            } else {
#pragma unroll
                for (int j = 0; j < 2; ++j) { v4u o; o.x = pk2(v[8 * j], v[8 * j + 1]); o.y = pk2(v[8 * j + 2], v[8 * j + 3]); o.z = pk2(v[8 * j + 4], v[8 * j + 5]); o.w = pk2(v[8 * j + 6], v[8 * j + 7]); *(v4u*)(xo + ro + 512 * j) = o; }
                if (lane == 0) rsout[r0 + rr] = rstd;
            }
        }
    }
}
__device__ __forceinline__ void f_prep0(Frame& F) { f_convert_gla(F); f_rowgroup<0>(F, 0); }
__device__ __forceinline__ void f_rowpass_router(Frame& F, int L) { f_rowgroup<1>(F, L); }
__device__ __forceinline__ void f_rowpass_add(Frame& F) { f_rowadd<false>(F); }
__device__ __forceinline__ void f_final(Frame& F) { f_rowadd<true>(F); }
constexpr int LDS_BYTES = 155648;
struct Args { const float* in[23]; float* out; unsigned char* ws; int ph_lo, ph_hi; };

__global__ void __launch_bounds__(NTHREADS, 2) fwd(Args args) {
    extern __shared__ __attribute__((aligned(16))) unsigned char lds_raw[];
    Frame F;
    F.lds = (LAS unsigned char*)lds_raw;
    F.G = gridDim.x; F.bid = blockIdx.x;
    F.out = args.out; F.ws = args.ws;
    volatile LAS unsigned* bst = (volatile LAS unsigned*)(F.lds + LX_PTR + 192);
    if (FTID == 0) {
        LAS unsigned long long* pt = (LAS unsigned long long*)(F.lds + LX_PTR);
#pragma unroll
        for (int i = 0; i < 23; ++i) pt[i] = (unsigned long long)args.in[i];
    }
    if (FTID < 2) bst[FTID] = 0u;
    __syncthreads();
    cg::grid_group grid = cg::this_grid();
    const XcdBarrier xbar = xcd_barrier_post(WSP(unsigned, WS_CTL) + CW_BAR, bst);
    const int lo = args.ph_lo, hi = args.ph_hi;
    if (lo > 1000) grid.sync();
#define IN(k) (lo <= (k) && (k) < hi)
#define SEAM() xcd_barrier(xbar)

    if (IN(0)) f_prep0(F);                 SEAM();
    if (IN(1)) f_gemm_in(F);               SEAM();
    if (IN(2)) f_scan_outproj(F, xbar);    SEAM();
    if (IN(3)) f_rowpass_router(F, 0);     SEAM();
    if (IN(4)) f_moe(F, 0);                SEAM();
    if (IN(5)) f_rowpass_add(F);           SEAM();
    if (IN(6)) f_gemm_sgu_in(F);           SEAM();
    if (IN(7)) f_mix(F);                   SEAM();
    if (IN(8)) f_gemm_sgu_out(F);          SEAM();
    if (IN(9)) f_rowpass_router(F, 1);     SEAM();
    if (IN(10)) f_moe(F, 1);               SEAM();
    if (IN(11)) f_final(F);
#undef IN
#undef SEAM
}

extern "C" void kernel_launch(void* const* d_in, const int* in_sizes, int n_in, void* d_out, int out_size, void* d_ws, size_t ws_size, hipStream_t stream) {
    static int grid = 0;
    if (grid == 0) {
        if (n_in != 23 || out_size != T * D || in_sizes[0] != T * D || ws_size < WS_END) { fprintf(stderr, "kernel_launch: unexpected shapes (n_in %d out %d ws %zu): nothing launched\n", n_in, out_size, ws_size); grid = -1; return; }
        int dev = 0, cus = 0, per_cu = 0;
        if (hipGetDevice(&dev) != hipSuccess || hipDeviceGetAttribute(&cus, hipDeviceAttributeMultiprocessorCount, dev) != hipSuccess) { grid = -1; return; }
        if (hipFuncSetAttribute((const void*)fwd, hipFuncAttributeMaxDynamicSharedMemorySize, LDS_BYTES) != hipSuccess) { fprintf(stderr, "kernel_launch: cannot get %d bytes of dynamic LDS\n", LDS_BYTES); grid = -1; return; }
        if (hipOccupancyMaxActiveBlocksPerMultiprocessor(&per_cu, (const void*)fwd, NTHREADS, LDS_BYTES) != hipSuccess || per_cu < 1) { fprintf(stderr, "kernel_launch: occupancy query admits %d workgroups per CU: nothing launched\n", per_cu); grid = -1; (void)hipGetLastError(); return; }
        grid = cus;
        if (grid < 128) { fprintf(stderr, "kernel_launch: %d CUs; this kernel's phase program needs at least 128 workgroups\n", grid); grid = -1; return; }
    }
    if (grid < 0) return;
    (void)hipMemsetAsync((char*)d_ws + WS_CTL, 0, CTL_ZERO_BYTES, stream);
    Args a{};
    for (int i = 0; i < 23; ++i) a.in[i] = (const float*)d_in[i];
    a.out = (float*)d_out; a.ws = (unsigned char*)d_ws; a.ph_lo = 0; a.ph_hi = 12;
    void* kargs[] = {&a};
    const hipError_t e = hipLaunchCooperativeKernel((const void*)fwd, dim3(grid), dim3(NTHREADS), kargs, LDS_BYTES, stream);
    if (e != hipSuccess) fprintf(stderr, "cooperative launch failed: %s (grid %d)\n", hipGetErrorString(e), grid);
}
```

```cpp
#include <hip/hip_runtime.h>
#include <hip/hip_cooperative_groups.h>
#include <cstdio>
#include <cstdint>
namespace cg = cooperative_groups;


constexpr int T = 32768, D = 1024, NBATCH = 16, SEQ = 2048;
constexpr int GLA_H = 4, DK = 128, DV = 256, HK = 512, HV = 1024, RANK = 16, GLA_IN = 3088, NQKVR = 3072, CHUNK = 64, NCHUNK = 32;
constexpr int SGU_FFN = 4096, SGU_HALF = 2048, SGU_BLK = 128, SGU_GC = 512;
constexpr int NE = 32, EPG = 8, FF = 512;
constexpr float EPS = 1e-6f;
constexpr int NTHREADS = 512, NWAVES = 8;

constexpr size_t MiB = 1u << 20;
constexpr size_t WS_CTL = 0, CTL_ZERO_BYTES = 128 * 1024;
constexpr size_t WS_GLR = 1 * MiB;
constexpr size_t WS_GATE = 3 * MiB;
constexpr size_t WS_STATS = 4 * MiB;
constexpr size_t WS_LIST = 12 * MiB;
constexpr size_t WS_WIN = 16 * MiB;
constexpr size_t WS_WOUT = 22 * MiB;
constexpr size_t WS_WSIN = 24 * MiB;
constexpr size_t WS_WSOUT = 32 * MiB;
constexpr size_t WS_W13 = 36 * MiB;
constexpr size_t WS_W2 = 164 * MiB;
constexpr size_t WS_XN = 228 * MiB;
constexpr size_t WS_AOUT = 484 * MiB;
constexpr size_t WS_RS = 3 * MiB + 256 * 1024;
constexpr size_t WS_QKVR = 292 * MiB;
constexpr size_t WS_HID = 292 * MiB;
constexpr size_t WS_Y = 364 * MiB;
constexpr size_t WS_U = 292 * MiB;
constexpr size_t WS_V = 420 * MiB;
constexpr size_t WS_END = 548 * MiB;
constexpr int CW_BAR = 1024;
constexpr int CW_HID = 16384;
constexpr int CW_CNT = 8192;

#define GAS __attribute__((address_space(1)))
#define LAS __attribute__((address_space(3)))
typedef unsigned short bf16;
typedef unsigned v4u __attribute__((ext_vector_type(4)));
typedef unsigned v2u __attribute__((ext_vector_type(2)));
typedef float f32x4 __attribute__((ext_vector_type(4)));
typedef float f32x16 __attribute__((ext_vector_type(16)));
typedef short bf16x8 __attribute__((ext_vector_type(8)));
typedef short s16x4 __attribute__((ext_vector_type(4)));
#define LDS_WAIT() asm volatile("s_waitcnt lgkmcnt(0)" ::: "memory")
#define VM_WAIT() asm volatile("s_waitcnt vmcnt(0)" ::: "memory")
typedef float f32x2_t __attribute__((ext_vector_type(2))); typedef __bf16 bf16x2_t __attribute__((ext_vector_type(2)));
__device__ __forceinline__ unsigned pk2(float lo, float hi) { f32x2_t v = {lo, hi}; bf16x2_t b = __builtin_convertvector(v, bf16x2_t); return __builtin_bit_cast(unsigned, b); }
__device__ __forceinline__ unsigned f2bf(float f) { return pk2(f, 0.f) & 0xffffu; }
__device__ __forceinline__ float bf2f(unsigned short b) { return __builtin_bit_cast(float, (unsigned)b << 16); }
__device__ __forceinline__ float bflo(unsigned w) { return __builtin_bit_cast(float, w << 16); }
__device__ __forceinline__ float bfhi(unsigned w) { return __builtin_bit_cast(float, w & 0xffff0000u); }
__device__ __forceinline__ float wave_sum(float v) {
#pragma unroll
    for (int o = 1; o < 64; o <<= 1) v += __shfl_xor(v, o);
    return v;
}
__device__ __forceinline__ float silu_f(float x) { return x * __builtin_amdgcn_rcpf(1.f + __expf(-x)); }
namespace pg8 {
#define PG8_LAS __attribute__((address_space(3)))
typedef unsigned short bf16_t;
typedef short bf16x8 __attribute__((ext_vector_type(8)));
typedef float f32x4 __attribute__((ext_vector_type(4)));
typedef unsigned u32x4 __attribute__((ext_vector_type(4)));
constexpr int BM = 256, BK = 64, HALF = 128, HTB = HALF * BK * 2  , STAGE_BYTES = 8 * HTB, NXCD = 8, WGM = 8;

__host__ __device__ __forceinline__ int lds_byte(int r, int c) { const int st = (r >> 4) * 2 + (c >> 5), rr = r & 15, cc = c & 31, ob = rr * 64 + cc * 2; return st * 1024 + (ob ^ (((ob >> 9) & 1) << 5)); }
__host__ __device__ __forceinline__ void stage_rc(int b, int& R, int& C) { const int st = b / 1024, sb = b % 1024, swz = sb ^ (((sb >> 9) & 1) << 5); R = (st >> 1) * 16 + swz / 64; C = (st & 1) * 32 + (swz % 64) / 2; }
__host__ __device__ __forceinline__ int perm32(int rho) { const int n = rho >> 4, i = rho & 15; return 8 * (i >> 2) + 4 * n + (i & 3); }

struct Unit { int pm, pn, e, slot; };

struct DenseOrder {
    static constexpr bool GATHER = false;
    int nM, nN, nwg, G, c, K; const char* Bt;
    __device__ void init(int M, int N, int K_, const bf16_t* Bt_, int G_, int c_) { nM = M / BM; nN = N / BM; nwg = nM * nN; G = G_; c = c_; K = K_; Bt = (const char*)Bt_; }
    __device__ __forceinline__ bool next(int i, Unit& u) const {
        const long L = (long)i * G + c; if (L >= nwg) return false;
        int wgid = (int)L; { const int q = nwg / NXCD, r = nwg % NXCD, xcd = wgid % NXCD, off = wgid / NXCD; wgid = (xcd < r ? xcd * (q + 1) : r * (q + 1) + (xcd - r) * q) + off; }
        const int nig = WGM * nN, gid = wgid / nig, fm = gid * WGM, gsz = (nM - fm) < WGM ? (nM - fm) : WGM;
        u.pm = fm + ((wgid % nig) % gsz); u.pn = (wgid % nig) / gsz; u.e = 0; u.slot = 0; return true;
    }
    __device__ __forceinline__ const char* bptr(const Unit& u) const { return Bt + (size_t)u.pn * BM * K * 2; }
    __device__ __forceinline__ size_t abase(const Unit& u) const { return (size_t)u.pm * BM * K * 2; }
    __device__ __forceinline__ unsigned aoff(const Unit& u, int h, int R, int C) const { return (unsigned)(((u.pm * BM + h * HALF + R) * K + C) * 2); }
    __device__ __forceinline__ void a_ready(const Unit&) const {}
    __device__ __forceinline__ void done(const Unit&) const {}
};

__device__ __forceinline__ unsigned cvt_pk_bf16(float lo, float hi) { unsigned r; asm volatile("v_cvt_pk_bf16_f32 %0, %1, %2" : "=v"(r) : "v"(lo), "v"(hi)); return r; }
typedef float f32x2 __attribute__((ext_vector_type(2)));
__device__ __forceinline__ f32x2 gelu_pk(f32x2 v) {
    const f32x2 av = __builtin_elementwise_abs(v), d = av * 0.2316418882f + 1.0f;
    f32x2 t; t.x = __builtin_amdgcn_rcpf(d.x); t.y = __builtin_amdgcn_rcpf(d.y);
    f32x2 q = t * 0.5307027145f + (-0.7265760135f); q = q * t + 0.7107068705f; q = q * t + (-0.142248368f); q = q * t + 0.127414796f; q = q * t;
    const f32x2 s = (v * v) * (-0.72134752044f);
    f32x2 e; e.x = __builtin_amdgcn_exp2f(s.x); e.y = __builtin_amdgcn_exp2f(s.y);
    const f32x2 m = v * (q * e), r = v - m;
    f32x2 o; o.x = v.x < 0.f ? m.x : r.x; o.y = v.y < 0.f ? m.y : r.y; return o;
}

template <class Epi, class Sched>
__device__ __forceinline__ void gemm_phase(PG8_LAS unsigned char* lds, const bf16_t* Abase, const int K, const Sched& S, const Epi& E) {
    const int tid = threadIdx.x, wid = __builtin_amdgcn_readfirstlane(tid >> 6), lane = tid & 63, wr = wid >> 2, wc = wid & 3, fr = lane & 15, fq = lane >> 4;
    const int nt = K / BK;
    int sR[2], sC[2]; unsigned voffA[2], voffB[2];
#pragma unroll
    for (int i = 0; i < 2; ++i) { stage_rc(tid * 16 + i * 8192, sR[i], sC[i]); const int Rb = Epi::PERM ? ((sR[i] & ~31) + perm32(sR[i] & 31)) : sR[i];
        voffA[i] = (unsigned)(sR[i] * K + sC[i]) * 2u; voffB[i] = (unsigned)(Rb * K + sC[i]) * 2u; }
    const size_t kstep = (size_t)(BK * 2);
    const size_t hstep = (size_t)HALF * K * 2;
    const unsigned ldsw = (unsigned)wid * 1024u;
    const int aoff = lds_byte(wr * 64 + fr, fq * 8), boff = lds_byte(wc * 32 + fr, fq * 8);
    const char* const Ab = (const char*)Abase;
#define PG8_SA(b, h) (((b) * 2 + (h)) * HTB)
#define PG8_SB(b, h) ((4 + (b) * 2 + (h)) * HTB)
#define PG8_STAGE(bufoff, gbase, voff) do { _Pragma("unroll") for (int _i = 0; _i < 2; ++_i) \
        __builtin_amdgcn_global_load_lds((const unsigned*)((const char*)(gbase) + (voff)[_i]), (PG8_LAS unsigned*)(lds + (bufoff) + ldsw + _i * 8192), 16, 0, 0); } while (0)
#define PG8_STAGE_A(bufoff, nx, h, kt) do { if constexpr (Sched::GATHER) { PG8_STAGE(bufoff, Ab + (size_t)(kt) * kstep, gc[h]); } \
        else PG8_STAGE(bufoff, ((nx) ? xA : cA) + (size_t)(h) * hstep + (size_t)(kt) * kstep, voffA); } while (0)
#define PG8_LDA(dst, b, h) do { _Pragma("unroll") for (int m = 0; m < 4; ++m) _Pragma("unroll") for (int k = 0; k < 2; ++k) dst[m][k] = *(const PG8_LAS bf16x8*)(lds + PG8_SA(b, h) + aoff + m * 2048 + k * 1024); } while (0)
#define PG8_LDB(dst, b, h) do { _Pragma("unroll") for (int n = 0; n < 2; ++n) _Pragma("unroll") for (int k = 0; k < 2; ++k) dst[n][k] = *(const PG8_LAS bf16x8*)(lds + PG8_SB(b, h) + boff + n * 2048 + k * 1024); } while (0)
#define PG8_MMA(ai, bj, At, Bt) do { __builtin_amdgcn_s_setprio(1); _Pragma("unroll") for (int m = 0; m < 4; ++m) _Pragma("unroll") for (int n = 0; n < 2; ++n) _Pragma("unroll") for (int k = 0; k < 2; ++k) \
        acc[ai][bj][m][n] = __builtin_amdgcn_mfma_f32_16x16x32_bf16(Bt[n][k], At[m][k], acc[ai][bj][m][n], 0, 0, 0); __builtin_amdgcn_s_setprio(0); } while (0)
#define PG8_WAIT_V(n) asm volatile("s_waitcnt vmcnt(" #n ")" ::: "memory")
#define PG8_WAIT_L(n) asm volatile("s_waitcnt lgkmcnt(" #n ")" ::: "memory")
#define PG8_BAR __builtin_amdgcn_s_barrier()
#define PG8_SCHED __builtin_amdgcn_sched_barrier(0)
    Unit cur, nxt, prv; int ui = 0; bool have_prv = false;
    if (!S.next(0, cur)) return;
    f32x4 acc[2][2][4][2];
#pragma unroll
    for (int a = 0; a < 2; ++a)
#pragma unroll
        for (int b = 0; b < 2; ++b)
#pragma unroll
            for (int m = 0; m < 4; ++m)
#pragma unroll
                for (int n = 0; n < 2; ++n) acc[a][b][m][n] = (f32x4){0.f, 0.f, 0.f, 0.f};
    bf16x8 At[4][2], B0[2][2], B1[2][2];
    unsigned gc[2][2];
    const char* cA = Ab; const char* xA = Ab;
    if constexpr (Sched::GATHER) {
#pragma unroll
        for (int h = 0; h < 2; ++h)
#pragma unroll
            for (int i = 0; i < 2; ++i) gc[h][i] = S.aoff(cur, h, sR[i], sC[i]);
    } else { cA = Ab + S.abase(cur); xA = cA; }
    const char* cB = S.bptr(cur);
    S.a_ready(cur);
    if constexpr (Epi::RS_DMA) { if (wid == 0) __builtin_amdgcn_global_load_lds((const unsigned*)((const char*)E.rs + (size_t)cur.pm * 1024 + lane * 16), (PG8_LAS unsigned*)(lds + STAGE_BYTES + 512), 16, 0, 0); }
    PG8_STAGE(PG8_SB(0, 0), cB, voffB); PG8_STAGE(PG8_SB(0, 1), cB + hstep, voffB); PG8_STAGE_A(PG8_SA(0, 0), false, 0, 0); PG8_STAGE_A(PG8_SA(0, 1), false, 1, 0);
    if (wr == 1) PG8_BAR;
    PG8_WAIT_V(2); PG8_BAR;
    PG8_STAGE(PG8_SB(1, 0), cB + kstep, voffB); PG8_STAGE_A(PG8_SA(1, 0), false, 0, 1); PG8_STAGE(PG8_SB(1, 1), cB + hstep + kstep, voffB);
    PG8_WAIT_V(6); PG8_BAR;
    for (;;) {
        const bool has_next = S.next(ui + 1, nxt);
        const char* nB = has_next ? S.bptr(nxt) : cB;
        if constexpr (Epi::RS_DMA) { if (has_next && wid == 0) __builtin_amdgcn_global_load_lds((const unsigned*)((const char*)E.rs + (size_t)nxt.pm * 1024 + lane * 16), (PG8_LAS unsigned*)(lds + STAGE_BYTES + 512 + ((ui + 1) % 3) * 1024), 16, 0, 0); }
        for (int t = 0; t < nt; t += 2) {
            const bool last = (t == nt - 2);
            const int kt2 = last ? 0 : t + 2;
            const char* b2 = last ? nB : cB + (size_t)(t + 2) * kstep; const char* b3 = b2 + kstep;
            if (last && has_next) {
                if constexpr (!Sched::GATHER) xA = Ab + S.abase(nxt);
                S.a_ready(nxt);
            }
            PG8_LDB(B0, 0, 0); PG8_LDB(B1, 0, 1); PG8_SCHED; PG8_LDA(At, 0, 0); PG8_STAGE_A(PG8_SA(1, 1), false, 1, t + 1);
            if constexpr (Sched::GATHER) { if (last && has_next) {
#pragma unroll
                for (int h = 0; h < 2; ++h)
#pragma unroll
                    for (int i = 0; i < 2; ++i) gc[h][i] = S.aoff(nxt, h, sR[i], sC[i]); } }
            PG8_WAIT_V(8); PG8_WAIT_L(0); PG8_BAR; PG8_MMA(0, 0, At, B0); PG8_MMA(0, 1, At, B1); PG8_BAR; PG8_SCHED;
            PG8_LDA(At, 0, 1); PG8_STAGE(PG8_SB(0, 0), b2, voffB); PG8_STAGE(PG8_SB(0, 1), b2 + hstep, voffB); PG8_STAGE_A(PG8_SA(0, 0), last, 0, kt2);
            PG8_WAIT_V(8); PG8_WAIT_L(0); PG8_BAR; PG8_MMA(1, 0, At, B0); PG8_MMA(1, 1, At, B1); PG8_BAR; PG8_SCHED;
            PG8_LDB(B0, 1, 0); PG8_LDB(B1, 1, 1); PG8_SCHED; PG8_LDA(At, 1, 0); PG8_STAGE_A(PG8_SA(0, 1), last, 1, kt2);
            PG8_WAIT_V(8); PG8_WAIT_L(0);
            if (have_prv) { S.done(prv); have_prv = false; }
            PG8_BAR; PG8_MMA(0, 0, At, B0); PG8_MMA(0, 1, At, B1); PG8_BAR; PG8_SCHED;
            PG8_LDA(At, 1, 1); PG8_STAGE(PG8_SB(1, 0), b3, voffB); PG8_STAGE(PG8_SB(1, 1), b3 + hstep, voffB); PG8_STAGE_A(PG8_SA(1, 0), last, 0, kt2 + 1);
            PG8_WAIT_V(8); PG8_WAIT_L(0); PG8_BAR; PG8_MMA(1, 0, At, B0); PG8_MMA(1, 1, At, B1); PG8_BAR; PG8_SCHED;
        }
        if (wr == 0) PG8_BAR;
        E(acc, cur, wr, wc, fr, fq, (const PG8_LAS float*)(lds + STAGE_BYTES + 512 + (ui % 3) * 1024)); prv = cur; have_prv = true;
        if (!has_next) break;
#pragma unroll
        for (int a = 0; a < 2; ++a)
#pragma unroll
            for (int b = 0; b < 2; ++b)
#pragma unroll
                for (int m = 0; m < 4; ++m)
#pragma unroll
                    for (int n = 0; n < 2; ++n) acc[a][b][m][n] = (f32x4){0.f, 0.f, 0.f, 0.f};
        cur = nxt; cB = nB; ++ui;
        if constexpr (!Sched::GATHER) cA = xA;
        if (wr == 1) PG8_BAR;
    }
    PG8_WAIT_V(0);
    if (have_prv) S.done(prv);
    PG8_BAR;
#undef PG8_STAGE_A
#undef PG8_SA
#undef PG8_SB
#undef PG8_STAGE
#undef PG8_LDA
#undef PG8_LDB
#undef PG8_MMA
#undef PG8_WAIT_V
#undef PG8_WAIT_L
#undef PG8_BAR
#undef PG8_SCHED
}
}
constexpr int LX_PTR = 155648 - 256;
#define FTID ((int)threadIdx.x)
#define FLANE ((int)threadIdx.x & 63)
#define FWAVE ((int)__builtin_amdgcn_readfirstlane((int)threadIdx.x >> 6))
struct Frame {
    LAS unsigned char* lds;
    int G, bid;
    float* out; unsigned char* ws;
    __device__ __forceinline__ const float* inp(int i) const {
        const LAS unsigned* p = (const LAS unsigned*)(lds + LX_PTR) + 2 * i;
        const unsigned lo = __builtin_amdgcn_readfirstlane(p[0]), hi = __builtin_amdgcn_readfirstlane(p[1]);
        return (const float*)(((unsigned long long)hi << 32) | lo);
    }
};
enum { I_X = 0, I_GLA_NORM, I_GLA_WIN, I_GLA_WGU, I_GLA_BG, I_GLA_HG, I_GLA_WOUT, I_SGU_NORM, I_SGU_WIN, I_SGU_LNG, I_SGU_LNB, I_SGU_WS, I_SGU_BS, I_SGU_WOUT,
       I_MOE_NORM, I_MOE_WG, I_MOE_BG, I_MOE_WSUB, I_MOE_BSUB, I_MOE_W1, I_MOE_W3, I_MOE_W2, I_FINAL };
#define WSP(type, off) ((type*)(F.ws + (off)))

#define XB_TMO      128
#define XB_XCNT(j)  (256  + 64 * (j))
#define XB_XSUB(j)  (1280 + 64 * (j))
#define XB_XGEN(j)  (2304 + 64 * (j))
#define XB_TOP      3328
#define XB_TOPGEN   3392
#define XCD_BAR_WORDS 3456
#define XB_SPIN_CAP (1u << 18)

__device__ __forceinline__ unsigned xb_ld(unsigned* p)              { return __hip_atomic_load(p, __ATOMIC_RELAXED, __HIP_MEMORY_SCOPE_AGENT); }
__device__ __forceinline__ unsigned xb_add(unsigned* p, unsigned v) { return __hip_atomic_fetch_add(p, v, __ATOMIC_RELAXED, __HIP_MEMORY_SCOPE_AGENT); }
__device__ __forceinline__ unsigned xb_xcc_id() { return (unsigned)__builtin_amdgcn_s_getreg((3 << 11) | 20) & 0xFu; }
#define XB_SPIN(cond, bar) do { unsigned _sp = 0; while (cond) { __builtin_amdgcn_s_sleep(1); \
    if ((++_sp & 255u) == 0u) { if (xb_ld(&(bar)[XB_TMO])) break; if (_sp > XB_SPIN_CAP) { atomicAdd(&(bar)[XB_TMO], 1u); break; } } } } while (0)

struct XcdBarrier {
    unsigned* bar; unsigned x;
    volatile LAS unsigned* st;
};

__device__ __forceinline__ XcdBarrier xcd_barrier_post(unsigned* bar, volatile LAS unsigned* st) {
    XcdBarrier b; b.bar = bar; b.x = xb_xcc_id(); b.st = st;
    if (threadIdx.x == 0) (void)xb_add(&bar[XB_XCNT(b.x)], 1u);
    return b;
}
__device__ __forceinline__ void xcd_barrier_complete(unsigned* bar, unsigned x, unsigned& nloc, unsigned& nx) {
    const unsigned G = gridDim.x * gridDim.y * gridDim.z;
    unsigned sum, cnt, mine, sp = 0u;
    for (;;) {
        sum = 0u; cnt = 0u; mine = 0u;
#pragma unroll
        for (unsigned j = 0; j < 16; ++j) { const unsigned c = xb_ld(&bar[XB_XCNT(j)]); sum += c; cnt += (c > 0u) ? 1u : 0u; mine = (j == x) ? c : mine; }
        if (sum == G) break;
        __builtin_amdgcn_s_sleep(1);
        if ((++sp & 255u) == 0u) { if (xb_ld(&bar[XB_TMO])) break; if (sp > XB_SPIN_CAP) { atomicAdd(&bar[XB_TMO], 1u); break; } }
    }
    nloc = mine > 0u ? mine : 1u; nx = cnt > 0u ? cnt : 1u;
}

__device__ __forceinline__ void xcd_barrier(const XcdBarrier& b) {
    asm volatile("s_waitcnt vmcnt(0)" ::: "memory");
    __syncthreads();
    if (threadIdx.x == 0) {
        unsigned* bar = b.bar;
        __builtin_amdgcn_s_waitcnt(0);
        unsigned nloc = b.st[0], nx = b.st[1];
        if (nloc == 0u) { xcd_barrier_complete(bar, b.x, nloc, nx); b.st[0] = nloc; b.st[1] = nx; }
        const unsigned old = xb_add(&bar[XB_XSUB(b.x)], 1u);
        const unsigned gen = old / nloc;
        if (old + 1u == (gen + 1u) * nloc) {
            __builtin_amdgcn_fence(__ATOMIC_RELEASE, "agent");
            asm volatile("s_waitcnt vmcnt(0)" ::: "memory");
            const unsigned og = xb_add(&bar[XB_TOP], 1u);
            const unsigned tg = og / nx;
            if (og + 1u == (tg + 1u) * nx) xb_add(&bar[XB_TOPGEN], 1u);
            else XB_SPIN(xb_ld(&bar[XB_TOPGEN]) == tg, bar);
            __builtin_amdgcn_fence(__ATOMIC_ACQUIRE, "agent");
            xb_add(&bar[XB_XGEN(b.x)], 1u);
            asm volatile("s_waitcnt vmcnt(0)" ::: "memory");
        } else {
            XB_SPIN(xb_ld(&bar[XB_XGEN(b.x)]) == gen, bar);
            __builtin_amdgcn_fence(__ATOMIC_ACQUIRE, "agent");
            asm volatile("s_waitcnt vmcnt(0)" ::: "memory");
        }
    }
    __syncthreads();
}
constexpr int RING_BYTES = 131072;
constexpr int LX_TST = RING_BYTES;
constexpr int MOE_MAXU = 6;
constexpr int LX_TAB = RING_BYTES + 512;
constexpr int LX_GT = LX_TAB + MOE_MAXU * 1024;

struct EpiStoreBf16 {
    static constexpr bool RS_DMA = true;
    static constexpr bool PERM = true;
    bf16* O; int ldc; const float* rs; int silu_from;
    __device__ __forceinline__ void operator()(const pg8::f32x4 (&acc)[2][2][4][2], const pg8::Unit& u, int wr, int wc, int fr, int fq, const LAS float* rsl) const {
        const int row0 = u.pm * 256 + wr * 64 + fr, col0 = u.pn * 256 + wc * 32 + 8 * fq;
#pragma unroll
        for (int ai = 0; ai < 2; ++ai)
#pragma unroll
            for (int m = 0; m < 4; ++m) { const int row = row0 + ai * 128 + m * 16; bf16* rowp = O + (size_t)row * ldc + col0; const float sc = rsl[ai * 128 + wr * 64 + m * 16 + fr];
#pragma unroll
                for (int bj = 0; bj < 2; ++bj) { pg8::f32x4 v0 = acc[ai][bj][m][0] * sc, v1 = acc[ai][bj][m][1] * sc;
                    if (silu_from >= 0 && u.pn >= silu_from) {
#pragma unroll
                        for (int i = 0; i < 4; ++i) { v0[i] = v0[i] * __builtin_amdgcn_rcpf(1.f + __expf(-v0[i])); v1[i] = v1[i] * __builtin_amdgcn_rcpf(1.f + __expf(-v1[i])); } }
                    v4u w; w.x = pg8::cvt_pk_bf16(v0[0], v0[1]); w.y = pg8::cvt_pk_bf16(v0[2], v0[3]); w.z = pg8::cvt_pk_bf16(v1[0], v1[1]); w.w = pg8::cvt_pk_bf16(v1[2], v1[3]);
                    *(v4u*)(rowp + bj * 128) = w; } }
    }
};
struct EpiResBf16 {
    static constexpr bool RS_DMA = false;
    static constexpr bool PERM = true;
    bf16* X;
    __device__ __forceinline__ void operator()(const pg8::f32x4 (&acc)[2][2][4][2], const pg8::Unit& u, int wr, int wc, int fr, int fq, const LAS float* rsl) const {
        const int row0 = u.pm * 256 + wr * 64 + fr, col0 = u.pn * 256 + wc * 32 + 8 * fq;
#pragma unroll
        for (int ai = 0; ai < 2; ++ai)
#pragma unroll
            for (int m = 0; m < 4; ++m) { bf16* rowp = X + (size_t)(row0 + ai * 128 + m * 16) * D + col0;
#pragma unroll
                for (int bj = 0; bj < 2; ++bj) { const v4u r = *(const v4u*)(rowp + bj * 128); const pg8::f32x4 v0 = acc[ai][bj][m][0], v1 = acc[ai][bj][m][1];
                    v4u w; w.x = pg8::cvt_pk_bf16(bflo(r.x) + v0[0], bfhi(r.x) + v0[1]); w.y = pg8::cvt_pk_bf16(bflo(r.y) + v0[2], bfhi(r.y) + v0[3]);
                    w.z = pg8::cvt_pk_bf16(bflo(r.z) + v1[0], bfhi(r.z) + v1[1]); w.w = pg8::cvt_pk_bf16(bflo(r.w) + v1[2], bfhi(r.w) + v1[3]);
                    *(v4u*)(rowp + bj * 128) = w; } }
    }
};
struct EpiGeluSplit {
    static constexpr bool RS_DMA = true;
    static constexpr bool PERM = true;
    bf16* U; bf16* V; float* st; const float* rs;
    __device__ __forceinline__ void operator()(const pg8::f32x4 (&acc)[2][2][4][2], const pg8::Unit& u, int wr, int wc, int fr, int fq, const LAS float* rsl) const {
        const bool isv = u.pn >= 8; const int pnl = isv ? u.pn - 8 : u.pn;
        bf16* O = isv ? V : U;
        const int row0 = u.pm * 256 + wr * 64 + fr, col0 = pnl * 256 + wc * 32 + 8 * fq;
#pragma unroll
        for (int ai = 0; ai < 2; ++ai)
#pragma unroll
            for (int m = 0; m < 4; ++m) { const int row = row0 + ai * 128 + m * 16; bf16* rowp = O + (size_t)row * SGU_HALF + col0; float s = 0.f, q = 0.f; const float sc = rsl[ai * 128 + wr * 64 + m * 16 + fr];
#pragma unroll
                for (int bj = 0; bj < 2; ++bj) { const pg8::f32x4 v0 = acc[ai][bj][m][0] * sc, v1 = acc[ai][bj][m][1] * sc;
                    const pg8::f32x2 a = pg8::gelu_pk((pg8::f32x2){v0[0], v0[1]}), b = pg8::gelu_pk((pg8::f32x2){v0[2], v0[3]}), c = pg8::gelu_pk((pg8::f32x2){v1[0], v1[1]}), d = pg8::gelu_pk((pg8::f32x2){v1[2], v1[3]});
                    s += (a.x + a.y) + (b.x + b.y) + (c.x + c.y) + (d.x + d.y);
                    q += (a.x * a.x + a.y * a.y) + (b.x * b.x + b.y * b.y) + (c.x * c.x + c.y * c.y) + (d.x * d.x + d.y * d.y);
                    v4u w; w.x = pg8::cvt_pk_bf16(a.x, a.y); w.y = pg8::cvt_pk_bf16(b.x, b.y); w.z = pg8::cvt_pk_bf16(c.x, c.y); w.w = pg8::cvt_pk_bf16(d.x, d.y);
                    *(v4u*)(rowp + bj * 128) = w; }
                if (isv) { s += __shfl_xor(s, 16); s += __shfl_xor(s, 32); q += __shfl_xor(q, 16); q += __shfl_xor(q, 32);
                    if (fq == 0) { pg8::f32x2 o = {s, q}; *(pg8::f32x2*)(st + ((size_t)(pnl * 4 + wc) * T + row) * 2) = o; } } }
    }
};

__device__ __forceinline__ void f_gemm_in(Frame& F) {
    pg8::DenseOrder S; S.init(T, NQKVR, D, WSP(bf16, WS_WIN), F.G, F.bid);
    EpiStoreBf16 E{WSP(bf16, WS_QKVR), NQKVR, WSP(float, WS_RS), 8};
    pg8::gemm_phase(F.lds, WSP(bf16, WS_XN), D, S, E);
}
struct RowSetOrder {
    static constexpr bool GATHER = false;
    int nb, c, j0, nunits, K; const char* Bt;
    __device__ __forceinline__ bool next(int i, pg8::Unit& u) const {
        if (c < 0) return false;
        const int q = i * nb + c; if (q >= nunits) return false;
        u.pm = ((q & 63) >> 2) * 8 + j0 + (q >> 6); u.pn = q & 3; u.e = 0; u.slot = 0; return true;
    }
    __device__ __forceinline__ const char* bptr(const pg8::Unit& u) const { return Bt + (size_t)u.pn * 256 * K * 2; }
    __device__ __forceinline__ size_t abase(const pg8::Unit& u) const { return (size_t)u.pm * 256 * K * 2; }
    __device__ __forceinline__ unsigned aoff(const pg8::Unit&, int, int, int) const { return 0u; }
    __device__ __forceinline__ void a_ready(const pg8::Unit&) const {}
    __device__ __forceinline__ void done(const pg8::Unit&) const {}
};
__device__ __forceinline__ void f_gemm_out_rows(Frame& F, int j0, int j1, int boff) {
    RowSetOrder S; S.nb = F.G - boff; S.c = F.bid - boff; S.j0 = j0; S.nunits = (j1 - j0) * 64; S.K = HV; S.Bt = (const char*)WSP(bf16, WS_WOUT);
    EpiResBf16 E{WSP(bf16, WS_XN)};
    pg8::gemm_phase(F.lds, WSP(bf16, WS_AOUT), HV, S, E);
}
__device__ __forceinline__ void f_gemm_sgu_in(Frame& F) {
    pg8::DenseOrder S; S.init(T, SGU_FFN, D, WSP(bf16, WS_WSIN), F.G, F.bid);
    EpiGeluSplit E{WSP(bf16, WS_U), WSP(bf16, WS_V), WSP(float, WS_STATS), WSP(float, WS_RS)};
    pg8::gemm_phase(F.lds, WSP(bf16, WS_XN), D, S, E);
}
__device__ __forceinline__ void f_gemm_sgu_out(Frame& F) {
    pg8::DenseOrder S; S.init(T, D, SGU_HALF, WSP(bf16, WS_WSOUT), F.G, F.bid);
    EpiResBf16 E{WSP(bf16, WS_XN)};
    pg8::gemm_phase(F.lds, WSP(bf16, WS_U), SGU_HALF, S, E);
}

template <bool GATHER_> struct MoeOrder {
    static constexpr bool GATHER = GATHER_;
    int G, c, nunits, ibase, K, mode;
    const char* W; size_t estride;
    LAS const int* tst; LAS const int* tab; unsigned* hcnt; unsigned rdy;
    int n5, rb;
    __device__ __forceinline__ bool next(int i, pg8::Unit& u) const {
        if (i >= MOE_MAXU) return false;
        const int ii = ibase + i; int Lu;
        if (GATHER || n5 <= 0 || ii < rb) Lu = ii * G + c;
        else { if (c < n5) return false; Lu = rb * G + (ii - rb) * (G - n5) + (c - n5); }
        if (Lu >= nunits) return false;
        const int rt = Lu >> 2; int e = 0;
        while (e < NE - 1 && tst[e + 1] <= rt) ++e;
        u.pm = rt; u.pn = Lu & 3; u.e = e; u.slot = i; return true;
    }
    __device__ __forceinline__ const char* bptr(const pg8::Unit& u) const { return W + (size_t)u.e * estride + (size_t)u.pn * 256 * K * 2; }
    __device__ __forceinline__ size_t abase(const pg8::Unit& u) const { return (size_t)u.pm * 256 * K * 2; }
    __device__ __forceinline__ unsigned aoff(const pg8::Unit& u, int h, int R, int C) const {
        if (mode == 0) { int ent = tab[u.slot * 256 + h * 128 + R]; ent = ent < 0 ? 0 : ent; return (unsigned)(((ent >> 1) * K + C) * 2); }
        return (unsigned)(((u.pm * 256 + h * 128 + R) * K + C) * 2);
    }
    __device__ __forceinline__ void a_ready(const pg8::Unit& u) const {
        if (GATHER || ((rdy >> u.slot) & 1u)) return;
        if (threadIdx.x < 64) {
            unsigned spins = 0;
            while ((unsigned)__builtin_amdgcn_readfirstlane(__hip_atomic_load(hcnt + 16 * u.pm, __ATOMIC_RELAXED, __HIP_MEMORY_SCOPE_AGENT)) < 32u) { __builtin_amdgcn_s_sleep(2); if (++spins > (1u << 20)) break; }
            __builtin_amdgcn_fence(__ATOMIC_ACQUIRE, "agent");
            asm volatile("s_waitcnt vmcnt(0)" ::: "memory");
        }
        asm volatile("" ::: "memory"); __builtin_amdgcn_s_barrier(); asm volatile("" ::: "memory");
    }
    __device__ __forceinline__ void done(const pg8::Unit& u) const {
        if (!GATHER) return;
        if ((threadIdx.x & 63) == 0) __hip_atomic_fetch_add(hcnt + 16 * u.pm, 1u, __ATOMIC_RELAXED, __HIP_MEMORY_SCOPE_AGENT);
    }
};
struct EpiSwiglu {
    static constexpr bool RS_DMA = false;
    static constexpr bool PERM = true;
    bf16* H; LAS const float* gt;
    __device__ __forceinline__ void operator()(const pg8::f32x4 (&acc)[2][2][4][2], const pg8::Unit& u, int wr, int wc, int fr, int fq, const LAS float* rsl) const {
        const __amdgpu_buffer_rsrc_t hrs = __builtin_amdgcn_make_buffer_rsrc((void*)H, (short)0, 73728 * FF * 2, 0x00020000);
        const int row0 = u.pm * 256 + wr * 64 + fr, col0 = u.pn * 128 + wc * 32 + 8 * fq;
#pragma unroll
        for (int ai = 0; ai < 2; ++ai)
#pragma unroll
            for (int m = 0; m < 4; ++m) { bf16* rowp = H + (size_t)(row0 + ai * 128 + m * 16) * FF + col0; float h[8]; const float sc = gt[u.slot * 256 + ai * 128 + wr * 64 + m * 16 + fr];
#pragma unroll
                for (int n = 0; n < 2; ++n)
#pragma unroll
                    for (int i = 0; i < 4; ++i) { const float a = acc[ai][0][m][n][i] * sc, b = acc[ai][1][m][n][i] * sc; h[n * 4 + i] = a * __builtin_amdgcn_rcpf(1.f + __expf(-a)) * b; }
                v4u w; w.x = pg8::cvt_pk_bf16(h[0], h[1]); w.y = pg8::cvt_pk_bf16(h[2], h[3]); w.z = pg8::cvt_pk_bf16(h[4], h[5]); w.w = pg8::cvt_pk_bf16(h[6], h[7]);
                __builtin_amdgcn_raw_buffer_store_b128(w, hrs, (int)((size_t)((const char*)rowp - (const char*)H)), 0, 16); }
    }
};
struct EpiScatterY {
    static constexpr bool RS_DMA = false;
    static constexpr bool PERM = true;
    unsigned char* Y; LAS const int* tab; LAS const float* gt;
    __device__ __forceinline__ void operator()(const pg8::f32x4 (&acc)[2][2][4][2], const pg8::Unit& u, int wr, int wc, int fr, int fq, const LAS float* rsl) const {
        const int col0 = u.pn * 256 + wc * 32 + 8 * fq;
#pragma unroll
        for (int ai = 0; ai < 2; ++ai)
#pragma unroll
            for (int m = 0; m < 4; ++m) { const int r = ai * 128 + wr * 64 + m * 16 + fr; const int ent = tab[u.slot * 256 + r]; const float g = gt[u.slot * 256 + r];
                if (ent >= 0) { unsigned char* rowp = Y + ((size_t)(ent & 1) * T + (ent >> 1)) * D + col0;
#pragma unroll
                    for (int bj = 0; bj < 2; ++bj) { const pg8::f32x4 v0 = acc[ai][bj][m][0] * g, v1 = acc[ai][bj][m][1] * g;
                        int w0 = __builtin_amdgcn_cvt_pk_fp8_f32(v0[0], v0[1], 0, false); w0 = __builtin_amdgcn_cvt_pk_fp8_f32(v0[2], v0[3], w0, true);
                        int w1 = __builtin_amdgcn_cvt_pk_fp8_f32(v1[0], v1[1], 0, false); w1 = __builtin_amdgcn_cvt_pk_fp8_f32(v1[2], v1[3], w1, true);
                        v2u w; w.x = (unsigned)w0; w.y = (unsigned)w1; *(v2u*)(rowp + bj * 128) = w; } } }
    }
};
template <int MODE> __device__ __forceinline__ void f_moe_gemm(Frame& F, int L, LAS int* tst, LAS int* cntl) {
    LAS int* tab = (LAS int*)(F.lds + LX_TAB); LAS float* gt = (LAS float*)(F.lds + LX_GT);
    MoeOrder<MODE == 0> S; S.G = F.G; S.c = F.bid; S.nunits = 4 * tst[NE]; S.K = MODE == 0 ? D : FF; S.mode = MODE; S.tst = tst; S.tab = tab;
    S.hcnt = WSP(unsigned, WS_CTL) + CW_HID + L * 4608;
    { const int r1 = (S.nunits + F.G - 1) / F.G, nlast = S.nunits - (r1 - 1) * F.G;
      S.n5 = (MODE == 1 && r1 >= 3 && nlast < F.G) ? nlast : 0; S.rb = r1 - 2; }
    S.W = MODE == 0 ? (const char*)(WSP(bf16, WS_W13) + (size_t)L * NE * 1024 * 1024) : (const char*)(WSP(bf16, WS_W2) + (size_t)L * NE * 1024 * 512);
    S.estride = MODE == 0 ? (size_t)1024 * 1024 * 2 : (size_t)1024 * 512 * 2;
    const int* list = WSP(int, WS_LIST); const float* gates = WSP(float, WS_GATE);
    for (int ibase = 0; ibase * (S.n5 > 0 ? F.G - S.n5 : F.G) < S.nunits; ibase += MOE_MAXU) {
        S.ibase = ibase;
        {
            static_assert(MOE_MAXU == 6, "three table slots per thread half");
            int ents[3]; float gsv[3]; const int r = FTID & 255, hsel = FTID >> 8;
#pragma unroll
            for (int k = 0; k < 3; ++k) { pg8::Unit u; ents[k] = -1;
                if (S.next(2 * k + hsel, u)) { const int idx = (u.pm - tst[u.e]) * 256 + r; if (idx < cntl[u.e]) ents[k] = list[(size_t)u.e * T + idx]; } }
#pragma unroll
            for (int k = 0; k < 3; ++k) gsv[k] = ents[k] >= 0 ? (MODE == 0 ? WSP(float, WS_RS)[ents[k] >> 1] : gates[ents[k]]) : 0.f;
#pragma unroll
            for (int k = 0; k < 3; ++k) { tab[(2 * k + hsel) * 256 + r] = ents[k]; gt[(2 * k + hsel) * 256 + r] = gsv[k]; }
        }
        S.rdy = 0u;
        if (MODE == 1) {
            LAS unsigned* rdyw = (LAS unsigned*)(F.lds + LX_TST + 448);
            if (FTID < 64) { unsigned m = 0u;
                for (int i = 0; i < MOE_MAXU; ++i) { pg8::Unit u; if (S.next(i, u) && (unsigned)__builtin_amdgcn_readfirstlane(__hip_atomic_load(S.hcnt + 16 * u.pm, __ATOMIC_RELAXED, __HIP_MEMORY_SCOPE_AGENT)) >= 32u) m |= 1u << i; }
                __builtin_amdgcn_fence(__ATOMIC_ACQUIRE, "agent"); asm volatile("s_waitcnt vmcnt(0)" ::: "memory");
                if (FTID == 0) *rdyw = m; }
            __syncthreads();
            S.rdy = *rdyw;
        }
        __syncthreads();
        if (MODE == 0) { EpiSwiglu E{WSP(bf16, WS_HID), gt}; pg8::gemm_phase(F.lds, WSP(bf16, WS_XN), D, S, E); }
        else { EpiScatterY E{WSP(unsigned char, WS_Y), tab, gt}; pg8::gemm_phase(F.lds, WSP(bf16, WS_HID), FF, S, E); }
        __syncthreads();
    }
}
__device__ __forceinline__ void f_moe(Frame& F, int L) {
    LAS int* tst = (LAS int*)(F.lds + LX_TST); LAS int* cntl = tst + 64;
    unsigned* ctl = WSP(unsigned, WS_CTL);
    __syncthreads();
    if (FTID < NE) cntl[FTID] = (int)__hip_atomic_load(&ctl[CW_CNT + L * 2048 + 64 * FTID], __ATOMIC_RELAXED, __HIP_MEMORY_SCOPE_AGENT);
    __syncthreads();
    if (FTID == 0) { int s = 0; for (int e = 0; e < NE; ++e) { tst[e] = s; s += (cntl[e] + 255) >> 8; } tst[NE] = s; }
    __syncthreads();
    f_moe_gemm<0>(F, L, tst, cntl);
    f_moe_gemm<1>(F, L, tst, cntl);
}
__device__ __forceinline__ void transpose_item(const float* W, int ldw, const float* kscale, float cs, bf16* WT, int K, int dst_row0, LAS float* scr, int k0, int n0, int lane) {
    f32x4 x[8]; float ks[8];
    const int kr = lane >> 3, n4 = (lane & 7) * 4;
#pragma unroll
    for (int i = 0; i < 8; ++i) { x[i] = *(const f32x4*)(W + (size_t)(k0 + 8 * i + kr) * ldw + n0 + n4); ks[i] = kscale ? kscale[k0 + 8 * i + kr] * cs : cs; }
#pragma unroll
    for (int i = 0; i < 8; ++i) { LAS float* d = scr + (8 * i + kr) * 33 + n4; d[0] = x[i][0] * ks[i]; d[1] = x[i][1] * ks[i]; d[2] = x[i][2] * ks[i]; d[3] = x[i][3] * ks[i]; }
    LDS_WAIT(); asm volatile("" ::: "memory");
    const int c = lane & 7;
#pragma unroll
    for (int j = 0; j < 4; ++j) { const int n = (lane >> 3) + 8 * j; const LAS float* s = scr + (8 * c) * 33 + n;
        v4u o; o.x = pk2(s[0 * 33], s[1 * 33]); o.y = pk2(s[2 * 33], s[3 * 33]); o.z = pk2(s[4 * 33], s[5 * 33]); o.w = pk2(s[6 * 33], s[7 * 33]);
        *(v4u*)(WT + (size_t)(dst_row0 + n) * K + k0 + 8 * c) = o; }
    LDS_WAIT(); asm volatile("" ::: "memory");
}
__device__ __forceinline__ void convert_job_item(const float* W, int ldw, int K, int N, const float* kscale, int qcols, float qs, bf16* WT, int rowmap, LAS float* scr, int item, int lane) {
    const int nblk = N / 32, kb = item / nblk, nb = item % nblk, k0 = 64 * kb, n0 = 32 * nb;
    const int dr = rowmap == 0 ? n0 : ((n0 >> 7) * 256 + (n0 & 127) + (rowmap == 2 ? 128 : 0));
    transpose_item(W, ldw, kscale, n0 < qcols ? qs : 1.f, WT, K, dr, scr, k0, n0, lane);
}
__device__ __forceinline__ void f_convert_gla(Frame& F) {
    LAS float* scr = (LAS float*)(F.lds + FWAVE * 8448);
    const int gw = F.bid * NWAVES + FWAVE, NGW = F.G * NWAVES;
    constexpr int I0 = (D / 64) * (NQKVR / 32), I1 = (HV / 64) * (D / 32);
    for (int it = gw; it < I0 + I1; it += NGW) {
        if (it < I0) convert_job_item(F.inp(I_GLA_WIN), GLA_IN, D, NQKVR, F.inp(I_GLA_NORM), HK, 0.08838834764831845f, WSP(bf16, WS_WIN), 0, scr, it, FLANE);
        else convert_job_item(F.inp(I_GLA_WOUT), D, HV, D, F.inp(I_GLA_HG), 0, 1.f, WSP(bf16, WS_WOUT), 0, scr, it - I0, FLANE);
    }
}
__device__ __forceinline__ void f_convert_rest(Frame& F, int cw, int NCW, int pct0 = 0, int pct1 = 1000) {
    LAS float* scr = (LAS float*)(F.lds + FWAVE * 8448);
    constexpr int I0 = (D / 64) * (SGU_FFN / 32), I1 = (SGU_HALF / 64) * (D / 32), IE1 = (D / 64) * (FF / 32), IE2 = (FF / 64) * (D / 32);
    constexpr int IM = 2 * NE * IE1;
    static_assert(IE1 == IE2, "w1 / w2 item counts");
    constexpr int NIT = I0 + I1 + 3 * IM; const int it_lo = (int)((long)NIT * pct0 / 1000), it_hi = (int)((long)NIT * pct1 / 1000);
    for (int it = it_lo + cw; it < it_hi; it += NCW) {
        int r = it;
        if (r < I0) { convert_job_item(F.inp(I_SGU_WIN), SGU_FFN, D, SGU_FFN, F.inp(I_SGU_NORM), 0, 1.f, WSP(bf16, WS_WSIN), 0, scr, r, FLANE); continue; } r -= I0;
        if (r < I1) { convert_job_item(F.inp(I_SGU_WOUT), D, SGU_HALF, D, nullptr, 0, 1.f, WSP(bf16, WS_WSOUT), 0, scr, r, FLANE); continue; } r -= I1;
        const int which = r / IM; r -= which * IM; const int le = r / IE1, li = r % IE1, L = le / NE;
        if (which == 0) convert_job_item(F.inp(I_MOE_W1) + (size_t)le * D * FF, FF, D, FF, F.inp(I_MOE_NORM) + L * D, 0, 1.f, WSP(bf16, WS_W13) + (size_t)le * 1024 * 1024, 1, scr, li, FLANE);
        else if (which == 1) convert_job_item(F.inp(I_MOE_W3) + (size_t)le * D * FF, FF, D, FF, F.inp(I_MOE_NORM) + L * D, 0, 1.f, WSP(bf16, WS_W13) + (size_t)le * 1024 * 1024, 2, scr, li, FLANE);
        else convert_job_item(F.inp(I_MOE_W2) + (size_t)le * FF * D, D, FF, D, nullptr, 0, 1.f, WSP(bf16, WS_W2) + (size_t)le * 1024 * 512, 0, scr, li, FLANE);
    }
}

constexpr int SC_K = 0, SC_KSTR = 320;
constexpr int SC_V = 20480, SC_VSTR = 576;
constexpr int SC_Q = 57344, SC_QSTR = 272;
constexpr int SC_O = 74752, SC_OSTR = 528;
constexpr int SC_GL = 108544, SC_PART = 112640, SC_DEC = 114688, SC_WG = 115200;
__device__ __forceinline__ s16x4 tr_read16(LAS const unsigned char* p) {
    typedef short v4i16_t __attribute__((ext_vector_type(4)));
    return __builtin_bit_cast(s16x4, __builtin_amdgcn_ds_read_tr16_b64_v4i16((LAS v4i16_t*)p));
}
__device__ __forceinline__ void f_scan_item(Frame& F, int item, const XcdBarrier* xb_ = nullptr, int cbar = -1) {
    const int b = item / GLA_H, h = item % GLA_H;
    const bf16* qkvr = WSP(bf16, WS_QKVR); const float* glr = WSP(float, WS_GLR); bf16* aout = WSP(bf16, WS_AOUT);
    LAS unsigned char* L = F.lds;
    LAS float* gl = (LAS float*)(L + SC_GL); LAS float* part = (LAS float*)(L + SC_PART); LAS float* dec = (LAS float*)(L + SC_DEC);
    const int tid = FTID, lane = FLANE, w = FWAVE;
    const int r32 = lane & 31, hh = lane >> 5, blk = (lane >> 4) & 1, q4 = (lane & 15) >> 2, p4 = lane & 3;
    const int dk = tid & 127, tg = tid >> 7;
    const int gq = lane >> 4, gcol = lane & 15, gdk = 16 * w + gcol;
    bf16x8 gBh, gBl;
    { unsigned ph[4], pl[4];
#pragma unroll
      for (int j = 0; j < 4; ++j) { const float x0 = gq < 2 ? F.inp(I_GLA_WGU)[(8 * gq + 2 * j) * HK + h * DK + gdk] : 0.f, x1 = gq < 2 ? F.inp(I_GLA_WGU)[(8 * gq + 2 * j + 1) * HK + h * DK + gdk] : 0.f;
          ph[j] = pk2(x0, x1); pl[j] = pk2(x0 - bflo(ph[j]), x1 - bfhi(ph[j])); }
      v4u vh = {ph[0], ph[1], ph[2], ph[3]}, vl = {pl[0], pl[1], pl[2], pl[3]};
      gBh = __builtin_bit_cast(bf16x8, vh); gBl = __builtin_bit_cast(bf16x8, vl); }
    const float gbias = F.inp(I_GLA_BG)[h * DK + gdk];
    __syncthreads();
    f32x16 st[4];
#pragma unroll
    for (int i = 0; i < 4; ++i)
#pragma unroll
        for (int j = 0; j < 16; ++j) st[i][j] = 0.f;
    v4u rk[2], rq[2], rv[4]; f32x4 rg;
    const size_t rowb = (size_t)b * SEQ;
    const unsigned vo_kq = (unsigned)(((tid >> 4) * NQKVR + (tid & 15) * 8) * 2), vo_v = (unsigned)(((tid >> 5) * NQKVR + (tid & 31) * 8) * 2), vo_g = (unsigned)(tid * 16);
    const unsigned lo_k = (unsigned)(SC_K + (tid >> 4) * SC_KSTR + (tid & 15) * 16), lo_q = (unsigned)(SC_Q + (tid >> 4) * SC_QSTR + (tid & 15) * 16), lo_v = (unsigned)(SC_V + (tid >> 5) * SC_VSTR + (tid & 31) * 16);
#define SC_LOAD(c) do { size_t cb_ = (rowb + (size_t)(c) * CHUNK) * NQKVR * 2; asm volatile("" : "+s"(cb_)); const char* gb_ = (const char*)qkvr + cb_ + (size_t)(h * DK * 2); \
        _Pragma("unroll") for (int i = 0; i < 2; ++i) { \
            rk[i] = *(const v4u*)(gb_ + (size_t)(HK * 2 + i * 32 * NQKVR * 2) + vo_kq); rq[i] = *(const v4u*)(gb_ + (size_t)(i * 32 * NQKVR * 2) + vo_kq); } \
        _Pragma("unroll") for (int i = 0; i < 4; ++i) rv[i] = *(const v4u*)(gb_ + (size_t)(2 * HK * 2 + h * (DV - DK) * 2 + i * 16 * NQKVR * 2) + vo_v); \
        if (tid < 256) rg = *(const f32x4*)((const char*)glr + (rowb + (size_t)(c) * CHUNK) * RANK * 4 + vo_g); } while (0)
#define SC_STORE() do { \
        _Pragma("unroll") for (int i = 0; i < 2; ++i) { *(LAS v4u*)(L + lo_k + i * 32 * SC_KSTR) = rk[i]; *(LAS v4u*)(L + lo_q + i * 32 * SC_QSTR) = rq[i]; } \
        _Pragma("unroll") for (int i = 0; i < 4; ++i) *(LAS v4u*)(L + lo_v + i * 16 * SC_VSTR) = rv[i]; \
        if (tid < 256) *(LAS f32x4*)(gl + tid * 4) = rg; } while (0)
    SC_LOAD(0);
    SC_STORE();
    for (int c = 0; c < NCHUNK; ++c) {
        if (c == cbar) xcd_barrier(*xb_);
        const size_t t0 = rowb + (size_t)c * CHUNK;
        __syncthreads();
        if (c + 1 < NCHUNK) SC_LOAD(c + 1);
        {
            pg8::f32x4 g4[4]; float tsum[4], pre[4];
#pragma unroll
            for (int t = 0; t < 4; ++t) {
                v4u ah = {0u, 0u, 0u, 0u}, al = {0u, 0u, 0u, 0u};
                if (gq < 2) { const f32x4 x0 = *(const LAS f32x4*)(gl + (16 * t + gcol) * 16 + 8 * gq), x1 = *(const LAS f32x4*)(gl + (16 * t + gcol) * 16 + 8 * gq + 4);
                    ah.x = pk2(x0[0], x0[1]); ah.y = pk2(x0[2], x0[3]); ah.z = pk2(x1[0], x1[1]); ah.w = pk2(x1[2], x1[3]);
                    al.x = pk2(x0[0] - bflo(ah.x), x0[1] - bfhi(ah.x)); al.y = pk2(x0[2] - bflo(ah.y), x0[3] - bfhi(ah.y)); al.z = pk2(x1[0] - bflo(ah.z), x1[1] - bfhi(ah.z)); al.w = pk2(x1[2] - bflo(ah.w), x1[3] - bfhi(ah.w)); }
                pg8::f32x4 a4 = {gbias, gbias, gbias, gbias};
                a4 = __builtin_amdgcn_mfma_f32_16x16x32_bf16(__builtin_bit_cast(bf16x8, ah), gBh, a4, 0, 0, 0);
                a4 = __builtin_amdgcn_mfma_f32_16x16x32_bf16(__builtin_bit_cast(bf16x8, al), gBh, a4, 0, 0, 0);
                a4 = __builtin_amdgcn_mfma_f32_16x16x32_bf16(__builtin_bit_cast(bf16x8, ah), gBl, a4, 0, 0, 0);
#pragma unroll
                for (int i = 0; i < 4; ++i) { const float a = a4[i]; a4[i] = (fminf(a, 0.f) - __logf(1.f + __expf(-fabsf(a)))) * (1.f / 16.f); }
                a4[1] += a4[0]; a4[2] += a4[1]; a4[3] += a4[2];
                g4[t] = a4;
                const float s0 = a4[3], x1 = __shfl_xor(s0, 16), x2 = __shfl_xor(s0, 32), x3 = __shfl_xor(x1, 32);
                tsum[t] = (s0 + x1) + (x2 + x3);
                pre[t] = ((gq ^ 1) < gq ? x1 : 0.f) + ((gq ^ 2) < gq ? x2 : 0.f) + ((gq ^ 3) < gq ? x3 : 0.f);
            }
            const float tot = (tsum[0] + tsum[1]) + (tsum[2] + tsum[3]);
            float basep = 0.f;
#pragma unroll
            for (int t = 0; t < 4; ++t) {
#pragma unroll
                for (int i = 0; i < 4; ++i) {
                    LAS unsigned short* kp = (LAS unsigned short*)(L + SC_K + (16 * t + 4 * gq + i) * SC_KSTR + gdk * 2);
                    *kp = (unsigned short)f2bf(bf2f(*kp) * __expf(tot - (basep + pre[t] + g4[t][i])));
                }
                basep += tsum[t];
            }
            if (gq == 0) dec[gdk] = __expf(tot);
        }
        __syncthreads();
        const int etok = tid >> 3, ecc = tid & 7;
        v4u rr[4];
        { size_t eb_ = t0 * NQKVR * 2; asm volatile("" : "+s"(eb_));
          const char* rb_ = (const char*)qkvr + eb_ + (size_t)((2 * HK + HV + h * DV) * 2); const unsigned vo_r = (unsigned)(etok * NQKVR * 2 + ecc * 16);
#pragma unroll
          for (int i = 0; i < 4; ++i) rr[i] = *(const v4u*)(rb_ + vo_r + i * 128); }
#pragma unroll
        for (int i = 0; i < 4; ++i)
#pragma unroll
            for (int g4 = 0; g4 < 4; ++g4) { const f32x4 d4 = *(const LAS f32x4*)(dec + 32 * i + 8 * g4 + 4 * hh);
#pragma unroll
                for (int j = 0; j < 4; ++j) st[i][4 * g4 + j] *= d4[j]; }
#pragma unroll
        for (int s = 0; s < 4; ++s) {
            const int trow = 16 * s + 8 * hh + q4;
            const s16x4 v0 = tr_read16(L + SC_V + trow * SC_VSTR + (32 * w + 16 * blk + 4 * p4) * 2), v1 = tr_read16(L + SC_V + (trow + 4) * SC_VSTR + (32 * w + 16 * blk + 4 * p4) * 2);
            const bf16x8 Bv = {v0[0], v0[1], v0[2], v0[3], v1[0], v1[1], v1[2], v1[3]};
#pragma unroll
            for (int i = 0; i < 4; ++i) {
                const s16x4 k0 = tr_read16(L + SC_K + trow * SC_KSTR + (32 * i + 16 * blk + 4 * p4) * 2), k1 = tr_read16(L + SC_K + (trow + 4) * SC_KSTR + (32 * i + 16 * blk + 4 * p4) * 2);
                const bf16x8 Ak = {k0[0], k0[1], k0[2], k0[3], k1[0], k1[1], k1[2], k1[3]};
                st[i] = __builtin_amdgcn_mfma_f32_32x32x16_bf16(Ak, Bv, st[i], 0, 0, 0);
            }
        }
        {
        f32x16 oacc[2];
#pragma unroll
        for (int ot = 0; ot < 2; ++ot)
#pragma unroll
            for (int j = 0; j < 16; ++j) oacc[ot][j] = 0.f;
#pragma unroll
        for (int i = 0; i < 4; ++i)
#pragma unroll
            for (int s2 = 0; s2 < 2; ++s2) {
                v4u pb; pb.x = pk2(st[i][8 * s2 + 0], st[i][8 * s2 + 1]); pb.y = pk2(st[i][8 * s2 + 2], st[i][8 * s2 + 3]); pb.z = pk2(st[i][8 * s2 + 4], st[i][8 * s2 + 5]); pb.w = pk2(st[i][8 * s2 + 6], st[i][8 * s2 + 7]);
                const bf16x8 Bs = __builtin_bit_cast(bf16x8, pb);
#pragma unroll
                for (int ot = 0; ot < 2; ++ot) {
                    LAS const unsigned char* qp = L + SC_Q + (32 * ot + r32) * SC_QSTR + (32 * i + 16 * s2 + 4 * hh) * 2;
                    const v2u a0 = *(const LAS v2u*)qp, a1 = *(const LAS v2u*)(qp + 16);
                    v4u pa; pa.x = a0.x; pa.y = a0.y; pa.z = a1.x; pa.w = a1.y;
                    oacc[ot] = __builtin_amdgcn_mfma_f32_32x32x16_bf16(__builtin_bit_cast(bf16x8, pa), Bs, oacc[ot], 0, 0, 0);
                }
            }
#pragma unroll
        for (int ot = 0; ot < 2; ++ot)
#pragma unroll
            for (int rg16 = 0; rg16 < 16; ++rg16) {
                const int tok = 32 * ot + (rg16 & 3) + 8 * (rg16 >> 2) + 4 * hh;
                *(LAS unsigned short*)(L + SC_O + tok * SC_OSTR + (32 * w + r32) * 2) = (unsigned short)f2bf(oacc[ot][rg16]);
            }
        }
        __syncthreads();
        if (c + 1 < NCHUNK) SC_STORE();
        {
        {
            const int tok = etok, cc = ecc;
            v4u ov[4]; float ss = 0.f;
#pragma unroll
            for (int i = 0; i < 4; ++i) ov[i] = *(const LAS v4u*)(L + SC_O + tok * SC_OSTR + cc * 16 + i * 128);
#pragma unroll
            for (int i = 0; i < 4; ++i) { const float a0 = bflo(ov[i].x), a1 = bfhi(ov[i].x), a2 = bflo(ov[i].y), a3 = bfhi(ov[i].y), a4 = bflo(ov[i].z), a5 = bfhi(ov[i].z), a6 = bflo(ov[i].w), a7 = bfhi(ov[i].w);
                ss += (a0 * a0 + a1 * a1) + (a2 * a2 + a3 * a3) + (a4 * a4 + a5 * a5) + (a6 * a6 + a7 * a7); }
            ss += __shfl_xor(ss, 1); ss += __shfl_xor(ss, 2); ss += __shfl_xor(ss, 4);
            const float rms = __builtin_amdgcn_rsqf(ss * (1.f / DV) + EPS);
            size_t ob_ = (t0 * D + h * DV) * 2; asm volatile("" : "+s"(ob_)); const unsigned vo_o = (unsigned)(tok * D * 2 + cc * 16);
#pragma unroll
            for (int i = 0; i < 4; ++i) {
                v4u o;
                o.x = pk2(bflo(ov[i].x) * rms * bflo(rr[i].x), bfhi(ov[i].x) * rms * bfhi(rr[i].x));
                o.y = pk2(bflo(ov[i].y) * rms * bflo(rr[i].y), bfhi(ov[i].y) * rms * bfhi(rr[i].y));
                o.z = pk2(bflo(ov[i].z) * rms * bflo(rr[i].z), bfhi(ov[i].z) * rms * bfhi(rr[i].z));
                o.w = pk2(bflo(ov[i].w) * rms * bflo(rr[i].w), bfhi(ov[i].w) * rms * bfhi(rr[i].w));
                *(v4u*)((char*)aout + ob_ + vo_o + i * 128) = o;
            }
        }
            }
    }
    __syncthreads();
#undef SC_LOAD
#undef SC_STORE
}
constexpr int SCAN_C1 = 20;
__device__ __forceinline__ void f_scan_outproj(Frame& F, const XcdBarrier& xbar) {
    constexpr int NITEM = NBATCH * GLA_H;
    if (F.bid < NITEM) f_scan_item(F, F.bid, &xbar, SCAN_C1);
    else { f_convert_rest(F, (F.bid - NITEM) * NWAVES + FWAVE, (F.G - NITEM) * NWAVES); xcd_barrier(xbar); f_gemm_out_rows(F, 0, SCAN_C1 / 4, NITEM); }
    xcd_barrier(xbar);
    f_gemm_out_rows(F, SCAN_C1 / 4, 8, 0);
}
constexpr int MX_W = 0, MX_WSTR = 272;
constexpr int MX_V0 = 34816, MX_VSTR = 320, MX_VBYTES = 40960;
constexpr int MX_MU = 116736;
constexpr int MX_LN = MX_MU + 2560;
__device__ __forceinline__ void f_mix(Frame& F) {
    LAS unsigned char* L = F.lds;
    LAS float* mu = (LAS float*)(L + MX_MU); LAS float* rs = mu + 128; LAS float* m1 = rs + 128; LAS float* m0 = m1 + 128; LAS float* bsg = m0 + 128;
    LAS float* lgs = (LAS float*)(L + MX_LN); LAS float* lbs = lgs + 512;
    bf16* u = WSP(bf16, WS_U); const bf16* v = WSP(bf16, WS_V); const float* st = WSP(float, WS_STATS); bf16* uout = u;
    const int tid = FTID, lane = FLANE, w = FWAVE;
    const int r32 = lane & 31, hh = lane >> 5, blk = (lane >> 4) & 1, q4 = (lane & 15) >> 2, p4 = lane & 3;
    const int ct = w >> 1, th = w & 1;
    const unsigned vo_v = (unsigned)(((tid >> 4) * SGU_HALF + (tid & 15) * 8) * 2), lo_v = (unsigned)(MX_V0 + (tid >> 4) * MX_VSTR + (tid & 15) * 16);
    constexpr int MX_MSTR = 272;
    for (int bn = F.bid; bn < T / SGU_BLK; bn += F.G) {
        const size_t t0 = (size_t)bn * SGU_BLK;
        __syncthreads();
        {
            const int row = tid & 127, pq = tid >> 7; float s = 0.f, q = 0.f;
#pragma unroll
            for (int p = 0; p < 8; ++p) { const pg8::f32x2 a = *(const pg8::f32x2*)(st + ((size_t)(pq * 8 + p) * T + t0 + row) * 2); s += a.x; q += a.y; }
            LAS float* red = (LAS float*)(L + MX_V0);
            red[(pq * 128 + row) * 2] = s; red[(pq * 128 + row) * 2 + 1] = q;
            __syncthreads();
            if (tid < 128) { float s4 = 0.f, q4 = 0.f;
#pragma unroll
                for (int p = 0; p < 4; ++p) { s4 += red[(p * 128 + tid) * 2]; q4 += red[(p * 128 + tid) * 2 + 1]; }
                const float m = s4 * (1.f / SGU_HALF); mu[tid] = m; rs[tid] = __builtin_amdgcn_rsqf(fmaxf(q4 * (1.f / SGU_HALF) - m * m, 0.f) + EPS); }
            __syncthreads();
        }
        v4u preA[4], preB[4]; v4u uuA[4], uuB[4];
#define MX_LOAD(pre_, it_) do { size_t vb_ = (t0 * SGU_HALF + (size_t)(it_) * 128) * 2; asm volatile("" : "+s"(vb_)); \
        _Pragma("unroll") for (int i = 0; i < 4; ++i) pre_[i] = *(const v4u*)((const char*)v + vb_ + (size_t)(i * 32 * SGU_HALF * 2) + vo_v); } while (0)
#define MX_STORE(buf_, pre_) do { _Pragma("unroll") for (int i = 0; i < 4; ++i) *(LAS v4u*)(L + lo_v + (buf_) * MX_VBYTES + 32 * i * MX_VSTR) = pre_[i]; } while (0)
#define MX_ULOAD(uu_, it_) do { size_t ub_ = (t0 * SGU_HALF + (size_t)(it_) * 128) * 2; asm volatile("" : "+s"(ub_)); \
        _Pragma("unroll") for (int i = 0; i < 4; ++i) uu_[i] = *(const v4u*)((const char*)u + ub_ + (size_t)(i * 32 * SGU_HALF * 2) + vo_v); } while (0)
#define MX_TILE(it_, buf_, uu_) do { \
        f32x16 acc[2]; \
        _Pragma("unroll") for (int tt = 0; tt < 2; ++tt) _Pragma("unroll") for (int j = 0; j < 16; ++j) acc[tt][j] = 0.f; \
        LAS unsigned char* Vb = L + MX_V0 + (buf_) * MX_VBYTES; \
        const int nks = th == 0 ? 4 : 8; \
        for (int ks = 0; ks < nks; ++ks) { \
            const int srow = 16 * ks + 8 * hh + q4; \
            const s16x4 a0 = tr_read16(Vb + srow * MX_VSTR + (32 * ct + 16 * blk + 4 * p4) * 2), a1 = tr_read16(Vb + (srow + 4) * MX_VSTR + (32 * ct + 16 * blk + 4 * p4) * 2); \
            const bf16x8 Av = {a0[0], a0[1], a0[2], a0[3], a1[0], a1[1], a1[2], a1[3]}; \
            _Pragma("unroll") for (int tt = 0; tt < 2; ++tt) { \
                const bf16x8 Bw = *(const LAS bf16x8*)(L + MX_W + (64 * th + 32 * tt + r32) * MX_WSTR + (16 * ks + 8 * hh) * 2); \
                acc[tt] = __builtin_amdgcn_mfma_f32_32x32x16_bf16(Av, Bw, acc[tt], 0, 0, 0); } } \
        const int cl = ((it_) & 3) * 128 + 32 * ct + 4 * hh;                    \
        __syncthreads();                                                         \
        _Pragma("unroll") for (int tt = 0; tt < 2; ++tt) { \
            const int t = 64 * th + 32 * tt + r32; const float tm1 = m1[t], tm0 = m0[t], tb = bsg[t]; \
            _Pragma("unroll") for (int g4 = 0; g4 < 4; ++g4) { \
                const f32x4 lg = *(const LAS f32x4*)(lgs + cl + 8 * g4), lb = *(const LAS f32x4*)(lbs + cl + 8 * g4); \
                v2u o; o.x = pk2(lg[0] * (acc[tt][4 * g4 + 0] - tm1) + lb[0] * tm0 + tb, lg[1] * (acc[tt][4 * g4 + 1] - tm1) + lb[1] * tm0 + tb); \
                o.y = pk2(lg[2] * (acc[tt][4 * g4 + 2] - tm1) + lb[2] * tm0 + tb, lg[3] * (acc[tt][4 * g4 + 3] - tm1) + lb[3] * tm0 + tb); \
                *(LAS v2u*)(Vb + t * MX_MSTR + (32 * ct + 8 * g4 + 4 * hh) * 2) = o; } } \
        __syncthreads();                                                         \
        size_t ob_ = (t0 * SGU_HALF + (size_t)(it_) * 128) * 2; asm volatile("" : "+s"(ob_)); \
        _Pragma("unroll") for (int i = 0; i < 4; ++i) { \
            const v4u mx = *(const LAS v4u*)(Vb + ((tid >> 4) + 32 * i) * MX_MSTR + (tid & 15) * 16); const v4u ux = uu_[i]; v4u o; \
            o.x = pk2(bflo(ux.x) * bflo(mx.x), bfhi(ux.x) * bfhi(mx.x)); o.y = pk2(bflo(ux.y) * bflo(mx.y), bfhi(ux.y) * bfhi(mx.y)); \
            o.z = pk2(bflo(ux.z) * bflo(mx.z), bfhi(ux.z) * bfhi(mx.z)); o.w = pk2(bflo(ux.w) * bflo(mx.w), bfhi(ux.w) * bfhi(mx.w)); \
            *(v4u*)((char*)uout + ob_ + (size_t)(i * 32 * SGU_HALF * 2) + vo_v) = o; } } while (0)
        MX_LOAD(preA, 0); MX_LOAD(preB, 1); MX_ULOAD(uuA, 0);
        for (int it = 0; it < 16; it += 2) {
            if ((it & 3) == 0) {
                const int g = it >> 2;
                __syncthreads();
                const int t = tid >> 2, sq = tid & 3; const float* wsrc = F.inp(I_SGU_WS) + ((size_t)g * 128 + t) * 128 + sq * 8;
                float a1 = 0.f, a0 = 0.f;
#pragma unroll
                for (int i = 0; i < 4; ++i) {
                    const f32x4 x0 = *(const f32x4*)(wsrc + i * 32), x1 = *(const f32x4*)(wsrc + i * 32 + 4); float wv[8] = {x0[0], x0[1], x0[2], x0[3], x1[0], x1[1], x1[2], x1[3]}; float hv[8];
#pragma unroll
                    for (int j = 0; j < 8; ++j) { const int s = i * 32 + sq * 8 + j; const float wm = ((t >> 6) >= (s >> 6)) ? wv[j] : 0.f; a0 += wm; hv[j] = wm * rs[s]; }
                    v4u o; o.x = pk2(hv[0], hv[1]); o.y = pk2(hv[2], hv[3]); o.z = pk2(hv[4], hv[5]); o.w = pk2(hv[6], hv[7]);
                    const unsigned ow[4] = {o.x, o.y, o.z, o.w};
#pragma unroll
                    for (int j = 0; j < 4; ++j) a1 += bflo(ow[j]) * mu[i * 32 + sq * 8 + 2 * j] + bfhi(ow[j]) * mu[i * 32 + sq * 8 + 2 * j + 1];
                    *(LAS v4u*)(L + MX_W + t * MX_WSTR + (i * 32 + sq * 8) * 2) = o;
                }
                a1 += __shfl_xor(a1, 1); a1 += __shfl_xor(a1, 2); a0 += __shfl_xor(a0, 1); a0 += __shfl_xor(a0, 2);
                if (sq == 0) { m1[t] = a1; m0[t] = a0; }
                if (tid < 128) bsg[tid] = F.inp(I_SGU_BS)[g * 128 + tid];
                lgs[tid] = F.inp(I_SGU_LNG)[g * SGU_GC + tid]; lbs[tid] = F.inp(I_SGU_LNB)[g * SGU_GC + tid];
            }
            MX_STORE(0, preA);
            __syncthreads();
            if (it + 2 < 16) MX_LOAD(preA, it + 2);
            MX_ULOAD(uuB, it + 1);
            MX_TILE(it, 0, uuA);
            MX_STORE(1, preB);
            __syncthreads();
            if (it + 3 < 16) MX_LOAD(preB, it + 3);
            if (it + 2 < 16) MX_ULOAD(uuA, it + 2);
            MX_TILE(it + 1, 1, uuB);
        }
#undef MX_LOAD
#undef MX_STORE
#undef MX_ULOAD
#undef MX_TILE
    }
}
constexpr int RW_STR = 2064;
constexpr int RW_LG = 48 * RW_STR;
constexpr int RW_HIST = RW_LG + 8 * 16 * 48 * 4;
template <int MODE> __device__ __forceinline__ void f_rowgroup(Frame& F, int Lyr) {
    constexpr int NCT = MODE == 0 ? 1 : 3;
    LAS unsigned char* L = F.lds;
    const int tid = FTID, lane = FLANE, w = FWAVE, rw = lane & 15, q = lane >> 4;
    const float* xsrc = F.inp(I_X);
    bf16* xb = WSP(bf16, WS_XN); float* rsout = WSP(float, WS_RS);
    __syncthreads();
    for (int k = tid; k < D; k += NTHREADS) {
        if (MODE == 0) {
            const float gn = F.inp(I_GLA_NORM)[k]; const float* wr_ = F.inp(I_GLA_WIN) + (size_t)k * GLA_IN + NQKVR;
#pragma unroll
            for (int c4 = 0; c4 < 4; ++c4) { const f32x4 x = *(const f32x4*)(wr_ + 4 * c4);
#pragma unroll
                for (int j = 0; j < 4; ++j) *(LAS unsigned short*)(L + (4 * c4 + j) * RW_STR + k * 2) = (unsigned short)f2bf(x[j] * gn); }
        } else {
            const float gn = F.inp(I_MOE_NORM)[Lyr * D + k];
            const f32x4 xg = *(const f32x4*)(F.inp(I_MOE_WG) + ((size_t)Lyr * D + k) * 4);
#pragma unroll
            for (int j = 0; j < 4; ++j) *(LAS unsigned short*)(L + j * RW_STR + k * 2) = (unsigned short)f2bf(xg[j] * gn);
#pragma unroll
            for (int g = 0; g < 4; ++g) { const float* ws_ = F.inp(I_MOE_WSUB) + (((size_t)Lyr * 4 + g) * D + k) * EPG; const f32x4 a = *(const f32x4*)ws_, b = *(const f32x4*)(ws_ + 4);
#pragma unroll
                for (int j = 0; j < 4; ++j) { *(LAS unsigned short*)(L + (4 + 8 * g + j) * RW_STR + k * 2) = (unsigned short)f2bf(a[j] * gn); *(LAS unsigned short*)(L + (8 + 8 * g + j) * RW_STR + k * 2) = (unsigned short)f2bf(b[j] * gn); } }
#pragma unroll
            for (int c = 36; c < 48; ++c) *(LAS unsigned short*)(L + c * RW_STR + k * 2) = 0;
        }
    }
    LAS int* hist = (LAS int*)(L + RW_HIST); LAS int* hbase = hist + 32;
    if (MODE == 1 && tid < 32) hist[tid] = 0;
    __syncthreads();
    const int ngroups = T / 16, niter = (ngroups + F.G * NWAVES - 1) / (F.G * NWAVES);
    for (int iter = 0; iter < niter; ++iter) {
        const int grp = (iter * F.G + F.bid) * NWAVES + w; const bool valid = grp < ngroups;
        const size_t row = (size_t)grp * 16 + rw;
        float rstd = 0.f; pg8::f32x4 acc[NCT];
        if (valid) {
#pragma unroll
            for (int c = 0; c < NCT; ++c) acc[c] = (pg8::f32x4){0.f, 0.f, 0.f, 0.f};
            float ss = 0.f;
#pragma unroll 8
            for (int s = 0; s < 32; ++s) {
                v4u pa;
                if (MODE == 0) {
                    const float* xr = xsrc + row * D + 8 * q + 32 * s;
                    const f32x4 x0 = *(const f32x4*)xr, x1 = *(const f32x4*)(xr + 4);
                    ss += (x0[0] * x0[0] + x0[1] * x0[1]) + (x0[2] * x0[2] + x0[3] * x0[3]) + (x1[0] * x1[0] + x1[1] * x1[1]) + (x1[2] * x1[2] + x1[3] * x1[3]);
                    pa.x = pk2(x0[0], x0[1]); pa.y = pk2(x0[2], x0[3]); pa.z = pk2(x1[0], x1[1]); pa.w = pk2(x1[2], x1[3]);
                    *(v4u*)(xb + row * D + 8 * q + 32 * s) = pa;
                } else {
                    pa = *(const v4u*)(xb + row * D + 8 * q + 32 * s);
                    const float a0 = bflo(pa.x), a1 = bfhi(pa.x), a2 = bflo(pa.y), a3 = bfhi(pa.y), a4 = bflo(pa.z), a5 = bfhi(pa.z), a6 = bflo(pa.w), a7 = bfhi(pa.w);
                    ss += (a0 * a0 + a1 * a1) + (a2 * a2 + a3 * a3) + (a4 * a4 + a5 * a5) + (a6 * a6 + a7 * a7);
                }
                const bf16x8 A = __builtin_bit_cast(bf16x8, pa);
#pragma unroll
                for (int c = 0; c < NCT; ++c) { const bf16x8 B = *(const LAS bf16x8*)(L + (16 * c + rw) * RW_STR + (32 * s + 8 * q) * 2); acc[c] = __builtin_amdgcn_mfma_f32_16x16x32_bf16(A, B, acc[c], 0, 0, 0); }
            }
            ss += __shfl_xor(ss, 16); ss += __shfl_xor(ss, 32);
            rstd = __builtin_amdgcn_rsqf(ss * (1.f / D) + EPS);
            if (q == 0) rsout[row] = rstd;
        }
        float rs4[4];
#pragma unroll
        for (int i = 0; i < 4; ++i) rs4[i] = __shfl(rstd, 4 * q + i);
        int e1 = 0, e2 = 0, rk1 = 0, rk2 = 0; float gt1 = 0.f, gt2 = 0.f;
        if (MODE == 0) {
            if (valid) {
                float* glr = WSP(float, WS_GLR);
#pragma unroll
                for (int i = 0; i < 4; ++i) glr[((size_t)grp * 16 + 4 * q + i) * RANK + rw] = acc[0][i] * rs4[i];
            }
        } else {
            LAS float* lgw = (LAS float*)(L + RW_LG) + w * 16 * 48;
            if (valid) {
#pragma unroll
                for (int c = 0; c < NCT; ++c)
#pragma unroll
                    for (int i = 0; i < 4; ++i) lgw[(4 * q + i) * 48 + 16 * c + rw] = acc[c][i] * rs4[i];
            }
            LDS_WAIT(); asm volatile("" ::: "memory");
            if (valid && lane < 16) {
                const LAS float* lr = lgw + lane * 48; const float* bg = F.inp(I_MOE_BG) + Lyr * 4;
                float lg[4];
#pragma unroll
                for (int c = 0; c < 4; ++c) lg[c] = lr[c] + bg[c];
                int g = 0; float gm = lg[0];
#pragma unroll
                for (int c = 1; c < 4; ++c) if (lg[c] > gm) { gm = lg[c]; g = c; }
                float gs = 0.f;
#pragma unroll
                for (int c = 0; c < 4; ++c) gs += __expf(lg[c] - gm);
                const float g_w = 1.f / gs; const float* bs = F.inp(I_MOE_BSUB) + (Lyr * 4 + g) * EPG;
                int i1 = 0, i2 = 0; float m1v = -3.0e38f, m2v = -3.0e38f;
                for (int e = 0; e < EPG; ++e) { const float x = lr[4 + 8 * g + e] + bs[e];
                    if (x > m1v) { m2v = m1v; i2 = i1; m1v = x; i1 = e; } else if (x > m2v) { m2v = x; i2 = e; } }
                const float w1 = 1.f / (1.f + __expf(m2v - m1v));
                e1 = g * EPG + i1; e2 = g * EPG + i2; gt1 = g_w * w1; gt2 = g_w * (1.f - w1);
                rk1 = __hip_atomic_fetch_add(&hist[e1], 1, __ATOMIC_RELAXED, __HIP_MEMORY_SCOPE_WORKGROUP); rk2 = __hip_atomic_fetch_add(&hist[e2], 1, __ATOMIC_RELAXED, __HIP_MEMORY_SCOPE_WORKGROUP);
            }
            __syncthreads();
            if (tid < 32) { const int hcount = hist[tid]; hbase[tid] = hcount ? (int)atomicAdd(WSP(unsigned, WS_CTL) + CW_CNT + Lyr * 2048 + 64 * tid, (unsigned)hcount) : 0; hist[tid] = 0; }
            __syncthreads();
            if (valid && lane < 16) {
                const int tok = grp * 16 + lane; const int p1 = hbase[e1] + rk1, p2 = hbase[e2] + rk2;
                WSP(int, WS_LIST)[(size_t)e1 * T + p1] = tok * 2; WSP(int, WS_LIST)[(size_t)e2 * T + p2] = tok * 2 + 1;
                WSP(float, WS_GATE)[tok * 2] = gt1; WSP(float, WS_GATE)[tok * 2 + 1] = gt2;
            }
        }
    }
    __syncthreads();
}
template <bool FINAL> __device__ __forceinline__ void f_rowadd(Frame& F) {
    bf16* xb = WSP(bf16, WS_XN); const unsigned char* y = WSP(unsigned char, WS_Y); float* rsout = WSP(float, WS_RS); bf16* xo = xb;
    const int lane = FLANE, w = FWAVE;
    f32x4 gf[4];
    if (FINAL) {
#pragma unroll
        for (int j = 0; j < 2; ++j) { gf[2 * j] = *(const f32x4*)(F.inp(I_FINAL) + 8 * lane + 512 * j); gf[2 * j + 1] = *(const f32x4*)(F.inp(I_FINAL) + 8 * lane + 512 * j + 4); }
    }
    for (int r0 = (F.bid * NWAVES + w) * 2; r0 < T; r0 += F.G * NWAVES * 2) {
        v4u xa[2][2]; v2u ya[2][2], yb[2][2];
#pragma unroll
        for (int rr = 0; rr < 2; ++rr)
#pragma unroll
            for (int j = 0; j < 2; ++j) { const size_t o = (size_t)(r0 + rr) * D + 8 * lane + 512 * j;
                xa[rr][j] = *(const v4u*)(xb + o); ya[rr][j] = *(const v2u*)(y + o); yb[rr][j] = *(const v2u*)(y + (size_t)T * D + o); }
#pragma unroll
        for (int rr = 0; rr < 2; ++rr) {
            float v[16]; float ss = 0.f;
#pragma unroll
            for (int j = 0; j < 2; ++j) {
                const unsigned xw[4] = {xa[rr][j].x, xa[rr][j].y, xa[rr][j].z, xa[rr][j].w};
                const pg8::f32x2 a0 = __builtin_amdgcn_cvt_pk_f32_fp8((int)ya[rr][j].x, false), a1 = __builtin_amdgcn_cvt_pk_f32_fp8((int)ya[rr][j].x, true), a2 = __builtin_amdgcn_cvt_pk_f32_fp8((int)ya[rr][j].y, false), a3 = __builtin_amdgcn_cvt_pk_f32_fp8((int)ya[rr][j].y, true);
                const pg8::f32x2 b0 = __builtin_amdgcn_cvt_pk_f32_fp8((int)yb[rr][j].x, false), b1 = __builtin_amdgcn_cvt_pk_f32_fp8((int)yb[rr][j].x, true), b2 = __builtin_amdgcn_cvt_pk_f32_fp8((int)yb[rr][j].y, false), b3 = __builtin_amdgcn_cvt_pk_f32_fp8((int)yb[rr][j].y, true);
                const float ysum[8] = {a0.x + b0.x, a0.y + b0.y, a1.x + b1.x, a1.y + b1.y, a2.x + b2.x, a2.y + b2.y, a3.x + b3.x, a3.y + b3.y};
#pragma unroll
                for (int e = 0; e < 4; ++e) { const float lo = bflo(xw[e]) + ysum[2 * e], hi = bfhi(xw[e]) + ysum[2 * e + 1]; v[8 * j + 2 * e] = lo; v[8 * j + 2 * e + 1] = hi; ss += lo * lo + hi * hi; }
            }
            const float rstd = __builtin_amdgcn_rsqf(wave_sum(ss) * (1.f / D) + EPS);
            const size_t ro = (size_t)(r0 + rr) * D + 8 * lane;
            if (FINAL) {
#pragma unroll
                for (int j = 0; j < 2; ++j) {
                    f32x4 o0 = {v[8 * j] * rstd, v[8 * j + 1] * rstd, v[8 * j + 2] * rstd, v[8 * j + 3] * rstd}, o1 = {v[8 * j + 4] * rstd, v[8 * j + 5] * rstd, v[8 * j + 6] * rstd, v[8 * j + 7] * rstd};
                    *(f32x4*)(F.out + ro + 512 * j) = o0 * gf[2 * j]; *(f32x4*)(F.out + ro + 512 * j + 4) = o1 * gf[2 * j + 1]; }
            } else {
#pragma unroll
                for (int j = 0; j < 2; ++j) { v4u o; o.x = pk2(v[8 * j], v[8 * j + 1]); o.y = pk2(v[8 * j + 2], v[8 * j + 3]); o.z = pk2(v[8 * j + 4], v[8 * j + 5]); o.w = pk2(v[8 * j + 6], v[8 * j + 7]); *(v4u*)(xo + ro + 512 * j) = o; }
                if (lane == 0) rsout[r0 + rr] = rstd;
            }
        }
    }
}
__device__ __forceinline__ void f_prep0(Frame& F) { f_convert_gla(F); f_rowgroup<0>(F, 0); }
__device__ __forceinline__ void f_rowpass_router(Frame& F, int L) { f_rowgroup<1>(F, L); }
__device__ __forceinline__ void f_rowpass_add(Frame& F) { f_rowadd<false>(F); }
__device__ __forceinline__ void f_final(Frame& F) { f_rowadd<true>(F); }
constexpr int LDS_BYTES = 155648;
struct Args { const float* in[23]; float* out; unsigned char* ws; int ph_lo, ph_hi; };

__global__ void __launch_bounds__(NTHREADS, 2) fwd(Args args) {
    extern __shared__ __attribute__((aligned(16))) unsigned char lds_raw[];
    Frame F;
    F.lds = (LAS unsigned char*)lds_raw;
    F.G = gridDim.x; F.bid = blockIdx.x;
    F.out = args.out; F.ws = args.ws;
    volatile LAS unsigned* bst = (volatile LAS unsigned*)(F.lds + LX_PTR + 192);
    if (FTID == 0) {
        LAS unsigned long long* pt = (LAS unsigned long long*)(F.lds + LX_PTR);
#pragma unroll
        for (int i = 0; i < 23; ++i) pt[i] = (unsigned long long)args.in[i];
    }
    if (FTID < 2) bst[FTID] = 0u;
    __syncthreads();
    cg::grid_group grid = cg::this_grid();
    const XcdBarrier xbar = xcd_barrier_post(WSP(unsigned, WS_CTL) + CW_BAR, bst);
    const int lo = args.ph_lo, hi = args.ph_hi;
    if (lo > 1000) grid.sync();
#define IN(k) (lo <= (k) && (k) < hi)
#define SEAM() xcd_barrier(xbar)

    if (IN(0)) f_prep0(F);                 SEAM();
    if (IN(1)) f_gemm_in(F);               SEAM();
    if (IN(2)) f_scan_outproj(F, xbar);    SEAM();
    if (IN(3)) f_rowpass_router(F, 0);     SEAM();
    if (IN(4)) f_moe(F, 0);                SEAM();
    if (IN(5)) f_rowpass_add(F);           SEAM();
    if (IN(6)) f_gemm_sgu_in(F);           SEAM();
    if (IN(7)) f_mix(F);                   SEAM();
    if (IN(8)) f_gemm_sgu_out(F);          SEAM();
    if (IN(9)) f_rowpass_router(F, 1);     SEAM();
    if (IN(10)) f_moe(F, 1);               SEAM();
    if (IN(11)) f_final(F);
#undef IN
#undef SEAM
}

extern "C" void kernel_launch(void* const* d_in, const int* in_sizes, int n_in, void* d_out, int out_size, void* d_ws, size_t ws_size, hipStream_t stream) {
    static int grid = 0;
    if (grid == 0) {
        if (n_in != 23 || out_size != T * D || in_sizes[0] != T * D || ws_size < WS_END) { fprintf(stderr, "kernel_launch: unexpected shapes (n_in %d out %d ws %zu): nothing launched\n", n_in, out_size, ws_size); grid = -1; return; }
        int dev = 0, cus = 0, per_cu = 0;
        if (hipGetDevice(&dev) != hipSuccess || hipDeviceGetAttribute(&cus, hipDeviceAttributeMultiprocessorCount, dev) != hipSuccess) { grid = -1; return; }
        if (hipFuncSetAttribute((const void*)fwd, hipFuncAttributeMaxDynamicSharedMemorySize, LDS_BYTES) != hipSuccess) { fprintf(stderr, "kernel_launch: cannot get %d bytes of dynamic LDS\n", LDS_BYTES); grid = -1; return; }
        if (hipOccupancyMaxActiveBlocksPerMultiprocessor(&per_cu, (const void*)fwd, NTHREADS, LDS_BYTES) != hipSuccess || per_cu < 1) { fprintf(stderr, "kernel_launch: occupancy query admits %d workgroups per CU: nothing launched\n", per_cu); grid = -1; (void)hipGetLastError(); return; }
        grid = cus;
        if (grid < 128) { fprintf(stderr, "kernel_launch: %d CUs; this kernel's phase program needs at least 128 workgroups\n", grid); grid = -1; return; }
    }
    if (grid < 0) return;
    (void)hipMemsetAsync((char*)d_ws + WS_CTL, 0, CTL_ZERO_BYTES, stream);
    Args a{};
    for (int i = 0; i < 23; ++i) a.in[i] = (const float*)d_in[i];
    a.out = (float*)d_out; a.ws = (unsigned char*)d_ws; a.ph_lo = 0; a.ph_hi = 12;
    void* kargs[] = {&a};
    const hipError_t e = hipLaunchCooperativeKernel((const void*)fwd, dim3(grid), dim3(NTHREADS), kargs, LDS_BYTES, stream);
    if (e != hipSuccess) fprintf(stderr, "cooperative launch failed: %s (grid %d)\n", hipGetErrorString(e), grid);
}
```

```cpp
#include <hip/hip_runtime.h>
#include <hip/hip_cooperative_groups.h>
#include <cstdio>
#include <cstdint>
namespace cg = cooperative_groups;


constexpr int T = 32768, D = 1024, NBATCH = 16, SEQ = 2048;
constexpr int GLA_H = 4, DK = 128, DV = 256, HK = 512, HV = 1024, RANK = 16, GLA_IN = 3088, NQKVR = 3072, CHUNK = 64, NCHUNK = 32;
constexpr int SGU_FFN = 4096, SGU_HALF = 2048, SGU_BLK = 128, SGU_GC = 512;
constexpr int NE = 32, EPG = 8, FF = 512;
constexpr float EPS = 1e-6f;
constexpr int NTHREADS = 512, NWAVES = 8;

constexpr size_t MiB = 1u << 20;
constexpr size_t WS_CTL = 0, CTL_ZERO_BYTES = 128 * 1024;
constexpr size_t WS_GLR = 1 * MiB;
constexpr size_t WS_GATE = 3 * MiB;
constexpr size_t WS_STATS = 4 * MiB;
constexpr size_t WS_LIST = 12 * MiB;
constexpr size_t WS_WIN = 16 * MiB;
constexpr size_t WS_WOUT = 22 * MiB;
constexpr size_t WS_WSIN = 24 * MiB;
constexpr size_t WS_WSOUT = 32 * MiB;
constexpr size_t WS_W13 = 36 * MiB;
constexpr size_t WS_W2 = 164 * MiB;
constexpr float MOE_WSCALE = 32.f;
constexpr size_t WS_XN = 228 * MiB;
constexpr size_t WS_AOUT = 484 * MiB;
constexpr size_t WS_RS = 3 * MiB + 256 * 1024;
constexpr size_t WS_QKVR = 292 * MiB;
constexpr size_t WS_HID = 292 * MiB;
constexpr size_t WS_XB8 = 328 * MiB;
constexpr size_t WS_Y = 364 * MiB;
constexpr size_t WS_U = 292 * MiB;
constexpr size_t WS_V = 420 * MiB;
constexpr size_t WS_END = 548 * MiB;
constexpr int CW_BAR = 1024;
constexpr int CW_HID = 16384;
constexpr int CW_CNT = 8192;

#define GAS __attribute__((address_space(1)))
#define LAS __attribute__((address_space(3)))
typedef unsigned short bf16;
typedef unsigned v4u __attribute__((ext_vector_type(4)));
typedef unsigned v2u __attribute__((ext_vector_type(2)));
typedef float f32x4 __attribute__((ext_vector_type(4)));
typedef float f32x16 __attribute__((ext_vector_type(16)));
typedef short bf16x8 __attribute__((ext_vector_type(8)));
typedef short s16x4 __attribute__((ext_vector_type(4)));
#define LDS_WAIT() asm volatile("s_waitcnt lgkmcnt(0)" ::: "memory")
#define VM_WAIT() asm volatile("s_waitcnt vmcnt(0)" ::: "memory")
typedef float f32x2_t __attribute__((ext_vector_type(2))); typedef __bf16 bf16x2_t __attribute__((ext_vector_type(2)));
__device__ __forceinline__ unsigned pk2(float lo, float hi) { f32x2_t v = {lo, hi}; bf16x2_t b = __builtin_convertvector(v, bf16x2_t); return __builtin_bit_cast(unsigned, b); }
__device__ __forceinline__ unsigned f2bf(float f) { return pk2(f, 0.f) & 0xffffu; }
__device__ __forceinline__ float bf2f(unsigned short b) { return __builtin_bit_cast(float, (unsigned)b << 16); }
__device__ __forceinline__ float bflo(unsigned w) { return __builtin_bit_cast(float, w << 16); }
__device__ __forceinline__ float bfhi(unsigned w) { return __builtin_bit_cast(float, w & 0xffff0000u); }
__device__ __forceinline__ float wave_sum(float v) {
#pragma unroll
    for (int o = 1; o < 64; o <<= 1) v += __shfl_xor(v, o);
    return v;
}
__device__ __forceinline__ float silu_f(float x) { return x * __builtin_amdgcn_rcpf(1.f + __expf(-x)); }
namespace pg8 {
#define PG8_LAS __attribute__((address_space(3)))
typedef unsigned short bf16_t;
typedef short bf16x8 __attribute__((ext_vector_type(8)));
typedef float f32x4 __attribute__((ext_vector_type(4)));
typedef unsigned u32x4 __attribute__((ext_vector_type(4)));
constexpr int BM = 256, BK = 64, HALF = 128, HTB = HALF * BK * 2  , STAGE_BYTES = 8 * HTB, NXCD = 8, WGM = 8;

__host__ __device__ __forceinline__ int lds_byte(int r, int c) { const int st = (r >> 4) * 2 + (c >> 5), rr = r & 15, cc = c & 31, ob = rr * 64 + cc * 2; return st * 1024 + (ob ^ (((ob >> 9) & 1) << 5)); }
__host__ __device__ __forceinline__ void stage_rc(int b, int& R, int& C) { const int st = b / 1024, sb = b % 1024, swz = sb ^ (((sb >> 9) & 1) << 5); R = (st >> 1) * 16 + swz / 64; C = (st & 1) * 32 + (swz % 64) / 2; }
__host__ __device__ __forceinline__ int perm32(int rho) { const int n = rho >> 4, i = rho & 15; return 8 * (i >> 2) + 4 * n + (i & 3); }

struct Unit { int pm, pn, e, slot; };

struct DenseOrder {
    static constexpr bool GATHER = false;
    int nM, nN, nwg, G, c, K; const char* Bt;
    __device__ void init(int M, int N, int K_, const bf16_t* Bt_, int G_, int c_) { nM = M / BM; nN = N / BM; nwg = nM * nN; G = G_; c = c_; K = K_; Bt = (const char*)Bt_; }
    __device__ __forceinline__ bool next(int i, Unit& u) const {
        const long L = (long)i * G + c; if (L >= nwg) return false;
        int wgid = (int)L; { const int q = nwg / NXCD, r = nwg % NXCD, xcd = wgid % NXCD, off = wgid / NXCD; wgid = (xcd < r ? xcd * (q + 1) : r * (q + 1) + (xcd - r) * q) + off; }
        const int nig = WGM * nN, gid = wgid / nig, fm = gid * WGM, gsz = (nM - fm) < WGM ? (nM - fm) : WGM;
        u.pm = fm + ((wgid % nig) % gsz); u.pn = (wgid % nig) / gsz; u.e = 0; u.slot = 0; return true;
    }
    __device__ __forceinline__ const char* bptr(const Unit& u) const { return Bt + (size_t)u.pn * BM * K * 2; }
    __device__ __forceinline__ size_t abase(const Unit& u) const { return (size_t)u.pm * BM * K * 2; }
    __device__ __forceinline__ unsigned aoff(const Unit& u, int h, int R, int C) const { return (unsigned)(((u.pm * BM + h * HALF + R) * K + C) * 2); }
    __device__ __forceinline__ void a_ready(const Unit&) const {}
    __device__ __forceinline__ void done(const Unit&) const {}
};

__device__ __forceinline__ unsigned cvt_pk_bf16(float lo, float hi) { unsigned r; asm volatile("v_cvt_pk_bf16_f32 %0, %1, %2" : "=v"(r) : "v"(lo), "v"(hi)); return r; }
typedef float f32x2 __attribute__((ext_vector_type(2)));
__device__ __forceinline__ f32x2 gelu_pk(f32x2 v) {
    const f32x2 av = __builtin_elementwise_abs(v), d = av * 0.2316418882f + 1.0f;
    f32x2 t; t.x = __builtin_amdgcn_rcpf(d.x); t.y = __builtin_amdgcn_rcpf(d.y);
    f32x2 q = t * 0.5307027145f + (-0.7265760135f); q = q * t + 0.7107068705f; q = q * t + (-0.142248368f); q = q * t + 0.127414796f; q = q * t;
    const f32x2 s = (v * v) * (-0.72134752044f);
    f32x2 e; e.x = __builtin_amdgcn_exp2f(s.x); e.y = __builtin_amdgcn_exp2f(s.y);
    const f32x2 m = v * (q * e), r = v - m;
    f32x2 o; o.x = v.x < 0.f ? m.x : r.x; o.y = v.y < 0.f ? m.y : r.y; return o;
}

typedef int v8i __attribute__((ext_vector_type(8)));
typedef int v4i __attribute__((ext_vector_type(4)));
template <int ES, class Epi, class Sched>
__device__ __forceinline__ void gemm_phase_es(PG8_LAS unsigned char* lds, const void* Abase, const int K, const Sched& S, const Epi& E) {
    const int tid = threadIdx.x, wid = __builtin_amdgcn_readfirstlane(tid >> 6), lane = tid & 63, wr = wid >> 2, wc = wid & 3, fr = lane & 15, fq = lane >> 4;
    const int nt = K * ES / 128;
    int sR[2], sC[2]; unsigned voffA[2], voffB[2];
#pragma unroll
    for (int i = 0; i < 2; ++i) { stage_rc(tid * 16 + i * 8192, sR[i], sC[i]); const int Rb = Epi::PERM ? ((sR[i] & ~31) + perm32(sR[i] & 31)) : sR[i];
        voffA[i] = (unsigned)(sR[i] * K * ES + sC[i] * 2); voffB[i] = (unsigned)(Rb * K * ES + sC[i] * 2); }
    const size_t kstep = (size_t)(BK * 2);
    const size_t hstep = (size_t)HALF * K * ES;
    const unsigned ldsw = (unsigned)wid * 1024u;
    const int aoff = lds_byte(wr * 64 + fr, fq * (ES == 2 ? 8 : 16)), boff = lds_byte(wc * 32 + fr, fq * (ES == 2 ? 8 : 16));
    const char* const Ab = (const char*)Abase;
#define PG8_SA(b, h) (((b) * 2 + (h)) * HTB)
#define PG8_SB(b, h) ((4 + (b) * 2 + (h)) * HTB)
#define PG8_STAGE(bufoff, gbase, voff) do { _Pragma("unroll") for (int _i = 0; _i < 2; ++_i) \
        __builtin_amdgcn_global_load_lds((const unsigned*)((const char*)(gbase) + (voff)[_i]), (PG8_LAS unsigned*)(lds + (bufoff) + ldsw + _i * 8192), 16, 0, 0); } while (0)
#define PG8_STAGE_A(bufoff, nx, h, kt) do { if constexpr (Sched::GATHER) { PG8_STAGE(bufoff, Ab + (size_t)(kt) * kstep, gc[h]); } \
        else PG8_STAGE(bufoff, ((nx) ? xA : cA) + (size_t)(h) * hstep + (size_t)(kt) * kstep, voffA); } while (0)
#define PG8_LDA(dst, b, h) do { if constexpr (ES == 2) { _Pragma("unroll") for (int m = 0; m < 4; ++m) _Pragma("unroll") for (int k = 0; k < 2; ++k) dst[m][k] = *(const PG8_LAS bf16x8*)(lds + PG8_SA(b, h) + aoff + m * 2048 + k * 1024); } \
        else { _Pragma("unroll") for (int m = 0; m < 4; ++m) { const v4i lo_ = *(const PG8_LAS v4i*)(lds + PG8_SA(b, h) + aoff + m * 2048), hi_ = *(const PG8_LAS v4i*)(lds + PG8_SA(b, h) + aoff + m * 2048 + 16); dst##8[m] = __builtin_shufflevector(lo_, hi_, 0, 1, 2, 3, 4, 5, 6, 7); } } } while (0)
#define PG8_LDB(dst, b, h) do { if constexpr (ES == 2) { _Pragma("unroll") for (int n = 0; n < 2; ++n) _Pragma("unroll") for (int k = 0; k < 2; ++k) dst[n][k] = *(const PG8_LAS bf16x8*)(lds + PG8_SB(b, h) + boff + n * 2048 + k * 1024); } \
        else { _Pragma("unroll") for (int n = 0; n < 2; ++n) { const v4i lo_ = *(const PG8_LAS v4i*)(lds + PG8_SB(b, h) + boff + n * 2048), hi_ = *(const PG8_LAS v4i*)(lds + PG8_SB(b, h) + boff + n * 2048 + 16); dst##8[n] = __builtin_shufflevector(lo_, hi_, 0, 1, 2, 3, 4, 5, 6, 7); } } } while (0)
#define PG8_MMA(ai, bj, At, Bt) do { __builtin_amdgcn_s_setprio(1); if constexpr (ES == 2) { _Pragma("unroll") for (int m = 0; m < 4; ++m) _Pragma("unroll") for (int n = 0; n < 2; ++n) _Pragma("unroll") for (int k = 0; k < 2; ++k) \
        acc[ai][bj][m][n] = __builtin_amdgcn_mfma_f32_16x16x32_bf16(Bt[n][k], At[m][k], acc[ai][bj][m][n], 0, 0, 0); } \
        else { _Pragma("unroll") for (int m = 0; m < 4; ++m) _Pragma("unroll") for (int n = 0; n < 2; ++n) \
        asm volatile("s_nop 1\n\tv_mfma_f32_16x16x128_f8f6f4 %0, %1, %2, %0" : "+v"(acc[ai][bj][m][n]) : "v"(Bt##8[n]), "v"(At##8[m])); }   \
        __builtin_amdgcn_s_setprio(0); } while (0)
#define PG8_WAIT_V(n) asm volatile("s_waitcnt vmcnt(" #n ")" ::: "memory")
#define PG8_WAIT_L(n) asm volatile("s_waitcnt lgkmcnt(" #n ")" ::: "memory")
#define PG8_BAR __builtin_amdgcn_s_barrier()
#define PG8_SCHED __builtin_amdgcn_sched_barrier(0)
    Unit cur, nxt, prv; int ui = 0; bool have_prv = false;
    if (!S.next(0, cur)) return;
    f32x4 acc[2][2][4][2];
#pragma unroll
    for (int a = 0; a < 2; ++a)
#pragma unroll
        for (int b = 0; b < 2; ++b)
#pragma unroll
            for (int m = 0; m < 4; ++m)
#pragma unroll
                for (int n = 0; n < 2; ++n) acc[a][b][m][n] = (f32x4){0.f, 0.f, 0.f, 0.f};
    bf16x8 At[4][2], B0[2][2], B1[2][2]; v8i At8[4], B08[2], B18[2];
    unsigned gc[2][2];
    const char* cA = Ab; const char* xA = Ab;
    if constexpr (Sched::GATHER) {
#pragma unroll
        for (int h = 0; h < 2; ++h)
#pragma unroll
            for (int i = 0; i < 2; ++i) gc[h][i] = S.aoff(cur, h, sR[i], sC[i]);
    } else { cA = Ab + S.abase(cur); xA = cA; }
    const char* cB = S.bptr(cur);
    S.a_ready(cur);
    if constexpr (Epi::RS_DMA) { if (wid == 0) __builtin_amdgcn_global_load_lds((const unsigned*)((const char*)E.rs + (size_t)cur.pm * 1024 + lane * 16), (PG8_LAS unsigned*)(lds + STAGE_BYTES + 512), 16, 0, 0); }
    PG8_STAGE(PG8_SB(0, 0), cB, voffB); PG8_STAGE(PG8_SB(0, 1), cB + hstep, voffB); PG8_STAGE_A(PG8_SA(0, 0), false, 0, 0); PG8_STAGE_A(PG8_SA(0, 1), false, 1, 0);
    if (wr == 1) PG8_BAR;
    PG8_WAIT_V(2); PG8_BAR;
    PG8_STAGE(PG8_SB(1, 0), cB + kstep, voffB); PG8_STAGE_A(PG8_SA(1, 0), false, 0, 1); PG8_STAGE(PG8_SB(1, 1), cB + hstep + kstep, voffB);
    PG8_WAIT_V(6); PG8_BAR;
    for (;;) {
        const bool has_next = S.next(ui + 1, nxt);
        const char* nB = has_next ? S.bptr(nxt) : cB;
        if constexpr (Epi::RS_DMA) { if (has_next && wid == 0) __builtin_amdgcn_global_load_lds((const unsigned*)((const char*)E.rs + (size_t)nxt.pm * 1024 + lane * 16), (PG8_LAS unsigned*)(lds + STAGE_BYTES + 512 + ((ui + 1) % 3) * 1024), 16, 0, 0); }
        for (int t = 0; t < nt; t += 2) {
            const bool last = (t == nt - 2);
            const int kt2 = last ? 0 : t + 2;
            const char* b2 = last ? nB : cB + (size_t)(t + 2) * kstep; const char* b3 = b2 + kstep;
            if (last && has_next) {
                if constexpr (!Sched::GATHER) xA = Ab + S.abase(nxt);
                S.a_ready(nxt);
            }
            PG8_LDB(B0, 0, 0); PG8_LDB(B1, 0, 1); PG8_SCHED; PG8_LDA(At, 0, 0); PG8_STAGE_A(PG8_SA(1, 1), false, 1, t + 1);
            if constexpr (Sched::GATHER) { if (last && has_next) {
#pragma unroll
                for (int h = 0; h < 2; ++h)
#pragma unroll
                    for (int i = 0; i < 2; ++i) gc[h][i] = S.aoff(nxt, h, sR[i], sC[i]); } }
            PG8_WAIT_V(8); PG8_WAIT_L(0); PG8_BAR; PG8_MMA(0, 0, At, B0); PG8_MMA(0, 1, At, B1); PG8_BAR; PG8_SCHED;
            PG8_LDA(At, 0, 1); PG8_STAGE(PG8_SB(0, 0), b2, voffB); PG8_STAGE(PG8_SB(0, 1), b2 + hstep, voffB); PG8_STAGE_A(PG8_SA(0, 0), last, 0, kt2);
            PG8_WAIT_V(8); PG8_WAIT_L(0); PG8_BAR; PG8_MMA(1, 0, At, B0); PG8_MMA(1, 1, At, B1); PG8_BAR; PG8_SCHED;
            PG8_LDB(B0, 1, 0); PG8_LDB(B1, 1, 1); PG8_SCHED; PG8_LDA(At, 1, 0); PG8_STAGE_A(PG8_SA(0, 1), last, 1, kt2);
            PG8_WAIT_V(8); PG8_WAIT_L(0);
            if (have_prv) { S.done(prv); have_prv = false; }
            PG8_BAR; PG8_MMA(0, 0, At, B0); PG8_MMA(0, 1, At, B1); PG8_BAR; PG8_SCHED;
            PG8_LDA(At, 1, 1); PG8_STAGE(PG8_SB(1, 0), b3, voffB); PG8_STAGE(PG8_SB(1, 1), b3 + hstep, voffB); PG8_STAGE_A(PG8_SA(1, 0), last, 0, kt2 + 1);
            PG8_WAIT_V(8); PG8_WAIT_L(0); PG8_BAR; PG8_MMA(1, 0, At, B0); PG8_MMA(1, 1, At, B1); PG8_BAR; PG8_SCHED;
        }
        if (wr == 0) PG8_BAR;
        if constexpr (ES == 1) asm volatile("s_nop 15\n\ts_nop 15" ::: "memory");
        E(acc, cur, wr, wc, fr, fq, (const PG8_LAS float*)(lds + STAGE_BYTES + 512 + (ui % 3) * 1024)); prv = cur; have_prv = true;
        if (!has_next) break;
#pragma unroll
        for (int a = 0; a < 2; ++a)
#pragma unroll
            for (int b = 0; b < 2; ++b)
#pragma unroll
                for (int m = 0; m < 4; ++m)
#pragma unroll
                    for (int n = 0; n < 2; ++n) acc[a][b][m][n] = (f32x4){0.f, 0.f, 0.f, 0.f};
        cur = nxt; cB = nB; ++ui;
        if constexpr (!Sched::GATHER) cA = xA;
        if (wr == 1) PG8_BAR;
    }
    PG8_WAIT_V(0);
    if (have_prv) S.done(prv);
    PG8_BAR;
#undef PG8_STAGE_A
#undef PG8_SA
#undef PG8_SB
#undef PG8_STAGE
#undef PG8_LDA
#undef PG8_LDB
#undef PG8_MMA
#undef PG8_WAIT_V
#undef PG8_WAIT_L
#undef PG8_BAR
#undef PG8_SCHED
}
template <class Epi, class Sched>
__device__ __forceinline__ void gemm_phase(PG8_LAS unsigned char* lds, const bf16_t* Abase, const int K, const Sched& S, const Epi& E) { gemm_phase_es<2>(lds, Abase, K, S, E); }
}
constexpr int LX_PTR = 155648 - 256;
#define FTID ((int)threadIdx.x)
#define FLANE ((int)threadIdx.x & 63)
#define FWAVE ((int)__builtin_amdgcn_readfirstlane((int)threadIdx.x >> 6))
struct Frame {
    LAS unsigned char* lds;
    int G, bid;
    float* out; unsigned char* ws;
    __device__ __forceinline__ const float* inp(int i) const {
        const LAS unsigned* p = (const LAS unsigned*)(lds + LX_PTR) + 2 * i;
        const unsigned lo = __builtin_amdgcn_readfirstlane(p[0]), hi = __builtin_amdgcn_readfirstlane(p[1]);
        return (const float*)(((unsigned long long)hi << 32) | lo);
    }
};
enum { I_X = 0, I_GLA_NORM, I_GLA_WIN, I_GLA_WGU, I_GLA_BG, I_GLA_HG, I_GLA_WOUT, I_SGU_NORM, I_SGU_WIN, I_SGU_LNG, I_SGU_LNB, I_SGU_WS, I_SGU_BS, I_SGU_WOUT,
       I_MOE_NORM, I_MOE_WG, I_MOE_BG, I_MOE_WSUB, I_MOE_BSUB, I_MOE_W1, I_MOE_W3, I_MOE_W2, I_FINAL };
#define WSP(type, off) ((type*)(F.ws + (off)))

#define XB_TMO      128
#define XB_XCNT(j)  (256  + 64 * (j))
#define XB_XSUB(j)  (1280 + 64 * (j))
#define XB_XGEN(j)  (2304 + 64 * (j))
#define XB_TOP      3328
#define XB_TOPGEN   3392
#define XCD_BAR_WORDS 3456
#define XB_SPIN_CAP (1u << 18)

__device__ __forceinline__ unsigned xb_ld(unsigned* p)              { return __hip_atomic_load(p, __ATOMIC_RELAXED, __HIP_MEMORY_SCOPE_AGENT); }
__device__ __forceinline__ unsigned xb_add(unsigned* p, unsigned v) { return __hip_atomic_fetch_add(p, v, __ATOMIC_RELAXED, __HIP_MEMORY_SCOPE_AGENT); }
__device__ __forceinline__ unsigned xb_xcc_id() { return (unsigned)__builtin_amdgcn_s_getreg((3 << 11) | 20) & 0xFu; }
#define XB_SPIN(cond, bar) do { unsigned _sp = 0; while (cond) { __builtin_amdgcn_s_sleep(1); \
    if ((++_sp & 255u) == 0u) { if (xb_ld(&(bar)[XB_TMO])) break; if (_sp > XB_SPIN_CAP) { atomicAdd(&(bar)[XB_TMO], 1u); break; } } } } while (0)

struct XcdBarrier {
    unsigned* bar; unsigned x;
    volatile LAS unsigned* st;
};

__device__ __forceinline__ XcdBarrier xcd_barrier_post(unsigned* bar, volatile LAS unsigned* st) {
    XcdBarrier b; b.bar = bar; b.x = xb_xcc_id(); b.st = st;
    if (threadIdx.x == 0) (void)xb_add(&bar[XB_XCNT(b.x)], 1u);
    return b;
}
__device__ __forceinline__ void xcd_barrier_complete(unsigned* bar, unsigned x, unsigned& nloc, unsigned& nx) {
    const unsigned G = gridDim.x * gridDim.y * gridDim.z;
    unsigned sum, cnt, mine, sp = 0u;
    for (;;) {
        sum = 0u; cnt = 0u; mine = 0u;
#pragma unroll
        for (unsigned j = 0; j < 16; ++j) { const unsigned c = xb_ld(&bar[XB_XCNT(j)]); sum += c; cnt += (c > 0u) ? 1u : 0u; mine = (j == x) ? c : mine; }
        if (sum == G) break;
        __builtin_amdgcn_s_sleep(1);
        if ((++sp & 255u) == 0u) { if (xb_ld(&bar[XB_TMO])) break; if (sp > XB_SPIN_CAP) { atomicAdd(&bar[XB_TMO], 1u); break; } }
    }
    nloc = mine > 0u ? mine : 1u; nx = cnt > 0u ? cnt : 1u;
}

__device__ __forceinline__ void xcd_barrier(const XcdBarrier& b) {
    asm volatile("s_waitcnt vmcnt(0)" ::: "memory");
    __syncthreads();
    if (threadIdx.x == 0) {
        unsigned* bar = b.bar;
        __builtin_amdgcn_s_waitcnt(0);
        unsigned nloc = b.st[0], nx = b.st[1];
        if (nloc == 0u) { xcd_barrier_complete(bar, b.x, nloc, nx); b.st[0] = nloc; b.st[1] = nx; }
        const unsigned old = xb_add(&bar[XB_XSUB(b.x)], 1u);
        const unsigned gen = old / nloc;
        if (old + 1u == (gen + 1u) * nloc) {
            __builtin_amdgcn_fence(__ATOMIC_RELEASE, "agent");
            asm volatile("s_waitcnt vmcnt(0)" ::: "memory");
            const unsigned og = xb_add(&bar[XB_TOP], 1u);
            const unsigned tg = og / nx;
            if (og + 1u == (tg + 1u) * nx) xb_add(&bar[XB_TOPGEN], 1u);
            else XB_SPIN(xb_ld(&bar[XB_TOPGEN]) == tg, bar);
            __builtin_amdgcn_fence(__ATOMIC_ACQUIRE, "agent");
            xb_add(&bar[XB_XGEN(b.x)], 1u);
            asm volatile("s_waitcnt vmcnt(0)" ::: "memory");
        } else {
            XB_SPIN(xb_ld(&bar[XB_XGEN(b.x)]) == gen, bar);
            __builtin_amdgcn_fence(__ATOMIC_ACQUIRE, "agent");
            asm volatile("s_waitcnt vmcnt(0)" ::: "memory");
        }
    }
    __syncthreads();
}
constexpr int RING_BYTES = 131072;
constexpr int LX_TST = RING_BYTES;
constexpr int MOE_MAXU = 6;
constexpr int LX_TAB = RING_BYTES + 512;
constexpr int LX_GT = LX_TAB + MOE_MAXU * 1024;

struct EpiStoreBf16 {
    static constexpr bool RS_DMA = true;
    static constexpr bool PERM = true;
    bf16* O; int ldc; const float* rs; int silu_from;
    __device__ __forceinline__ void operator()(const pg8::f32x4 (&acc)[2][2][4][2], const pg8::Unit& u, int wr, int wc, int fr, int fq, const LAS float* rsl) const {
        const int row0 = u.pm * 256 + wr * 64 + fr, col0 = u.pn * 256 + wc * 32 + 8 * fq;
#pragma unroll
        for (int ai = 0; ai < 2; ++ai)
#pragma unroll
            for (int m = 0; m < 4; ++m) { const int row = row0 + ai * 128 + m * 16; bf16* rowp = O + (size_t)row * ldc + col0; const float sc = rsl[ai * 128 + wr * 64 + m * 16 + fr];
#pragma unroll
                for (int bj = 0; bj < 2; ++bj) { pg8::f32x4 v0 = acc[ai][bj][m][0] * sc, v1 = acc[ai][bj][m][1] * sc;
                    if (silu_from >= 0 && u.pn >= silu_from) {
#pragma unroll
                        for (int i = 0; i < 4; ++i) { v0[i] = v0[i] * __builtin_amdgcn_rcpf(1.f + __expf(-v0[i])); v1[i] = v1[i] * __builtin_amdgcn_rcpf(1.f + __expf(-v1[i])); } }
                    v4u w; w.x = pg8::cvt_pk_bf16(v0[0], v0[1]); w.y = pg8::cvt_pk_bf16(v0[2], v0[3]); w.z = pg8::cvt_pk_bf16(v1[0], v1[1]); w.w = pg8::cvt_pk_bf16(v1[2], v1[3]);
                    *(v4u*)(rowp + bj * 128) = w; } }
    }
};
struct EpiResBf16 {
    static constexpr bool RS_DMA = false;
    static constexpr bool PERM = true;
    bf16* X;
    __device__ __forceinline__ void operator()(const pg8::f32x4 (&acc)[2][2][4][2], const pg8::Unit& u, int wr, int wc, int fr, int fq, const LAS float* rsl) const {
        const int row0 = u.pm * 256 + wr * 64 + fr, col0 = u.pn * 256 + wc * 32 + 8 * fq;
#pragma unroll
        for (int ai = 0; ai < 2; ++ai)
#pragma unroll
            for (int m = 0; m < 4; ++m) { bf16* rowp = X + (size_t)(row0 + ai * 128 + m * 16) * D + col0;
#pragma unroll
                for (int bj = 0; bj < 2; ++bj) { const v4u r = *(const v4u*)(rowp + bj * 128); const pg8::f32x4 v0 = acc[ai][bj][m][0], v1 = acc[ai][bj][m][1];
                    v4u w; w.x = pg8::cvt_pk_bf16(bflo(r.x) + v0[0], bfhi(r.x) + v0[1]); w.y = pg8::cvt_pk_bf16(bflo(r.y) + v0[2], bfhi(r.y) + v0[3]);
                    w.z = pg8::cvt_pk_bf16(bflo(r.z) + v1[0], bfhi(r.z) + v1[1]); w.w = pg8::cvt_pk_bf16(bflo(r.w) + v1[2], bfhi(r.w) + v1[3]);
                    *(v4u*)(rowp + bj * 128) = w; } }
    }
};
struct EpiGeluSplit {
    static constexpr bool RS_DMA = true;
    static constexpr bool PERM = true;
    bf16* U; bf16* V; float* st; const float* rs;
    __device__ __forceinline__ void operator()(const pg8::f32x4 (&acc)[2][2][4][2], const pg8::Unit& u, int wr, int wc, int fr, int fq, const LAS float* rsl) const {
        const bool isv = u.pn >= 8; const int pnl = isv ? u.pn - 8 : u.pn;
        bf16* O = isv ? V : U;
        const int row0 = u.pm * 256 + wr * 64 + fr, col0 = pnl * 256 + wc * 32 + 8 * fq;
#pragma unroll
        for (int ai = 0; ai < 2; ++ai)
#pragma unroll
            for (int m = 0; m < 4; ++m) { const int row = row0 + ai * 128 + m * 16; bf16* rowp = O + (size_t)row * SGU_HALF + col0; float s = 0.f, q = 0.f; const float sc = rsl[ai * 128 + wr * 64 + m * 16 + fr];
#pragma unroll
                for (int bj = 0; bj < 2; ++bj) { const pg8::f32x4 v0 = acc[ai][bj][m][0] * sc, v1 = acc[ai][bj][m][1] * sc;
                    const pg8::f32x2 a = pg8::gelu_pk((pg8::f32x2){v0[0], v0[1]}), b = pg8::gelu_pk((pg8::f32x2){v0[2], v0[3]}), c = pg8::gelu_pk((pg8::f32x2){v1[0], v1[1]}), d = pg8::gelu_pk((pg8::f32x2){v1[2], v1[3]});
                    s += (a.x + a.y) + (b.x + b.y) + (c.x + c.y) + (d.x + d.y);
                    q += (a.x * a.x + a.y * a.y) + (b.x * b.x + b.y * b.y) + (c.x * c.x + c.y * c.y) + (d.x * d.x + d.y * d.y);
                    v4u w; w.x = pg8::cvt_pk_bf16(a.x, a.y); w.y = pg8::cvt_pk_bf16(b.x, b.y); w.z = pg8::cvt_pk_bf16(c.x, c.y); w.w = pg8::cvt_pk_bf16(d.x, d.y);
                    *(v4u*)(rowp + bj * 128) = w; }
                if (isv) { s += __shfl_xor(s, 16); s += __shfl_xor(s, 32); q += __shfl_xor(q, 16); q += __shfl_xor(q, 32);
                    if (fq == 0) { pg8::f32x2 o = {s, q}; *(pg8::f32x2*)(st + ((size_t)(pnl * 4 + wc) * T + row) * 2) = o; } } }
    }
};

__device__ __forceinline__ void f_gemm_in(Frame& F) {
    pg8::DenseOrder S; S.init(T, NQKVR, D, WSP(bf16, WS_WIN), F.G, F.bid);
    EpiStoreBf16 E{WSP(bf16, WS_QKVR), NQKVR, WSP(float, WS_RS), 8};
    pg8::gemm_phase(F.lds, WSP(bf16, WS_XN), D, S, E);
}
struct RowSetOrder {
    static constexpr bool GATHER = false;
    int nb, c, j0, nunits, K; const char* Bt;
    __device__ __forceinline__ bool next(int i, pg8::Unit& u) const {
        if (c < 0) return false;
        const int q = i * nb + c; if (q >= nunits) return false;
        u.pm = ((q & 63) >> 2) * 8 + j0 + (q >> 6); u.pn = q & 3; u.e = 0; u.slot = 0; return true;
    }
    __device__ __forceinline__ const char* bptr(const pg8::Unit& u) const { return Bt + (size_t)u.pn * 256 * K * 2; }
    __device__ __forceinline__ size_t abase(const pg8::Unit& u) const { return (size_t)u.pm * 256 * K * 2; }
    __device__ __forceinline__ unsigned aoff(const pg8::Unit&, int, int, int) const { return 0u; }
    __device__ __forceinline__ void a_ready(const pg8::Unit&) const {}
    __device__ __forceinline__ void done(const pg8::Unit&) const {}
};
__device__ __forceinline__ void f_gemm_out_rows(Frame& F, int j0, int j1, int boff) {
    RowSetOrder S; S.nb = F.G - boff; S.c = F.bid - boff; S.j0 = j0; S.nunits = (j1 - j0) * 64; S.K = HV; S.Bt = (const char*)WSP(bf16, WS_WOUT);
    EpiResBf16 E{WSP(bf16, WS_XN)};
    pg8::gemm_phase(F.lds, WSP(bf16, WS_AOUT), HV, S, E);
}
__device__ __forceinline__ void f_gemm_sgu_in(Frame& F) {
    pg8::DenseOrder S; S.init(T, SGU_FFN, D, WSP(bf16, WS_WSIN), F.G, F.bid);
    EpiGeluSplit E{WSP(bf16, WS_U), WSP(bf16, WS_V), WSP(float, WS_STATS), WSP(float, WS_RS)};
    pg8::gemm_phase(F.lds, WSP(bf16, WS_XN), D, S, E);
}
__device__ __forceinline__ void f_gemm_sgu_out(Frame& F) {
    pg8::DenseOrder S; S.init(T, D, SGU_HALF, WSP(bf16, WS_WSOUT), F.G, F.bid);
    EpiResBf16 E{WSP(bf16, WS_XN)};
    pg8::gemm_phase(F.lds, WSP(bf16, WS_U), SGU_HALF, S, E);
}

template <bool GATHER_> struct MoeOrder {
    static constexpr bool GATHER = GATHER_;
    int G, c, nunits, ibase, K, rowb, mode;
    const char* W; size_t estride;
    LAS const int* tst; LAS const int* tab; unsigned* hcnt; unsigned rdy;
    int n5, rb;
    __device__ __forceinline__ bool next(int i, pg8::Unit& u) const {
        if (i >= MOE_MAXU) return false;
        const int ii = ibase + i; int Lu;
        if (GATHER || n5 <= 0 || ii < rb) Lu = ii * G + c;
        else { if (c < n5) return false; Lu = rb * G + (ii - rb) * (G - n5) + (c - n5); }
        if (Lu >= nunits) return false;
        const int rt = Lu >> 2; int e = 0;
        while (e < NE - 1 && tst[e + 1] <= rt) ++e;
        u.pm = rt; u.pn = Lu & 3; u.e = e; u.slot = i; return true;
    }
    __device__ __forceinline__ const char* bptr(const pg8::Unit& u) const { return W + (size_t)u.e * estride + (size_t)u.pn * 256 * rowb; }
    __device__ __forceinline__ size_t abase(const pg8::Unit& u) const { return (size_t)u.pm * 256 * rowb; }
    __device__ __forceinline__ unsigned aoff(const pg8::Unit& u, int h, int R, int C) const {
        if (mode == 0) { int ent = tab[u.slot * 256 + h * 128 + R]; ent = ent < 0 ? 0 : ent; return (unsigned)((ent >> 1) * rowb + C * 2); }
        return (unsigned)((u.pm * 256 + h * 128 + R) * rowb + C * 2);
    }
    __device__ __forceinline__ void a_ready(const pg8::Unit& u) const {
        if (GATHER || ((rdy >> u.slot) & 1u)) return;
        if (threadIdx.x < 64) {
            unsigned spins = 0;
            while ((unsigned)__builtin_amdgcn_readfirstlane(__hip_atomic_load(hcnt + 16 * u.pm, __ATOMIC_RELAXED, __HIP_MEMORY_SCOPE_AGENT)) < 32u) { __builtin_amdgcn_s_sleep(2); if (++spins > (1u << 20)) break; }
            __builtin_amdgcn_fence(__ATOMIC_ACQUIRE, "agent");
            asm volatile("s_waitcnt vmcnt(0)" ::: "memory");
        }
        asm volatile("" ::: "memory"); __builtin_amdgcn_s_barrier(); asm volatile("" ::: "memory");
    }
    __device__ __forceinline__ void done(const pg8::Unit& u) const {
        if (!GATHER) return;
        if ((threadIdx.x & 63) == 0) __hip_atomic_fetch_add(hcnt + 16 * u.pm, 1u, __ATOMIC_RELAXED, __HIP_MEMORY_SCOPE_AGENT);
    }
};
struct EpiSwiglu {
    static constexpr bool RS_DMA = false;
    static constexpr bool PERM = true;
    unsigned char* H; LAS const float* gt;
    __device__ __forceinline__ void operator()(const pg8::f32x4 (&acc)[2][2][4][2], const pg8::Unit& u, int wr, int wc, int fr, int fq, const LAS float* rsl) const {
        const __amdgpu_buffer_rsrc_t hrs = __builtin_amdgcn_make_buffer_rsrc((void*)H, (short)0, 73728 * FF, 0x00020000);
        const int row0 = u.pm * 256 + wr * 64 + fr, col0 = u.pn * 128 + wc * 32 + 8 * fq;
#pragma unroll
        for (int ai = 0; ai < 2; ++ai)
#pragma unroll
            for (int m = 0; m < 4; ++m) { float h[8]; const float sc = gt[u.slot * 256 + ai * 128 + wr * 64 + m * 16 + fr] * (1.f / MOE_WSCALE);
#pragma unroll
                for (int n = 0; n < 2; ++n)
#pragma unroll
                    for (int i = 0; i < 4; ++i) { const float a = acc[ai][0][m][n][i] * sc, b = acc[ai][1][m][n][i] * sc; h[n * 4 + i] = a * __builtin_amdgcn_rcpf(1.f + __expf(-a)) * b; }
                int w0 = __builtin_amdgcn_cvt_pk_fp8_f32(h[0], h[1], 0, false); w0 = __builtin_amdgcn_cvt_pk_fp8_f32(h[2], h[3], w0, true);
                int w1 = __builtin_amdgcn_cvt_pk_fp8_f32(h[4], h[5], 0, false); w1 = __builtin_amdgcn_cvt_pk_fp8_f32(h[6], h[7], w1, true);
                v2u w; w.x = (unsigned)w0; w.y = (unsigned)w1;
                __builtin_amdgcn_raw_buffer_store_b64(w, hrs, (row0 + ai * 128 + m * 16) * FF + col0, 0, 16); }
    }
};
struct EpiScatterY {
    static constexpr bool RS_DMA = false;
    static constexpr bool PERM = true;
    unsigned char* Y; LAS const int* tab; LAS const float* gt;
    __device__ __forceinline__ void operator()(const pg8::f32x4 (&acc)[2][2][4][2], const pg8::Unit& u, int wr, int wc, int fr, int fq, const LAS float* rsl) const {
        const int col0 = u.pn * 256 + wc * 32 + 8 * fq;
#pragma unroll
        for (int ai = 0; ai < 2; ++ai)
#pragma unroll
            for (int m = 0; m < 4; ++m) { const int r = ai * 128 + wr * 64 + m * 16 + fr; const int ent = tab[u.slot * 256 + r]; const float g = gt[u.slot * 256 + r] * (1.f / MOE_WSCALE);
                if (ent >= 0) { unsigned char* rowp = Y + ((size_t)(ent & 1) * T + (ent >> 1)) * D + col0;
#pragma unroll
                    for (int bj = 0; bj < 2; ++bj) { const pg8::f32x4 v0 = acc[ai][bj][m][0] * g, v1 = acc[ai][bj][m][1] * g;
                        int w0 = __builtin_amdgcn_cvt_pk_fp8_f32(v0[0], v0[1], 0, false); w0 = __builtin_amdgcn_cvt_pk_fp8_f32(v0[2], v0[3], w0, true);
                        int w1 = __builtin_amdgcn_cvt_pk_fp8_f32(v1[0], v1[1], 0, false); w1 = __builtin_amdgcn_cvt_pk_fp8_f32(v1[2], v1[3], w1, true);
                        v2u w; w.x = (unsigned)w0; w.y = (unsigned)w1; *(v2u*)(rowp + bj * 128) = w; } } }
    }
};
template <int MODE> __device__ __forceinline__ void f_moe_gemm(Frame& F, int L, LAS int* tst, LAS int* cntl) {
    LAS int* tab = (LAS int*)(F.lds + LX_TAB); LAS float* gt = (LAS float*)(F.lds + LX_GT);
    MoeOrder<MODE == 0> S; S.G = F.G; S.c = F.bid; S.nunits = 4 * tst[NE]; S.K = MODE == 0 ? D : FF; S.rowb = S.K; S.mode = MODE; S.tst = tst; S.tab = tab;
    S.hcnt = WSP(unsigned, WS_CTL) + CW_HID + L * 4608;
    { const int r1 = (S.nunits + F.G - 1) / F.G, nlast = S.nunits - (r1 - 1) * F.G;
      S.n5 = (MODE == 1 && r1 >= 3 && nlast < F.G) ? nlast : 0; S.rb = r1 - 2; }
    S.W = MODE == 0 ? (const char*)(WSP(unsigned char, WS_W13) + (size_t)L * NE * 1024 * 1024) : (const char*)(WSP(unsigned char, WS_W2) + (size_t)L * NE * 1024 * 512);
    S.estride = MODE == 0 ? (size_t)1024 * 1024 : (size_t)1024 * 512;
    const int* list = WSP(int, WS_LIST); const float* gates = WSP(float, WS_GATE);
    for (int ibase = 0; ibase * (S.n5 > 0 ? F.G - S.n5 : F.G) < S.nunits; ibase += MOE_MAXU) {
        S.ibase = ibase;
        {
            static_assert(MOE_MAXU == 6, "three table slots per thread half");
            int ents[3]; float gsv[3]; const int r = FTID & 255, hsel = FTID >> 8;
#pragma unroll
            for (int k = 0; k < 3; ++k) { pg8::Unit u; ents[k] = -1;
                if (S.next(2 * k + hsel, u)) { const int idx = (u.pm - tst[u.e]) * 256 + r; if (idx < cntl[u.e]) ents[k] = list[(size_t)u.e * T + idx]; } }
#pragma unroll
            for (int k = 0; k < 3; ++k) gsv[k] = ents[k] >= 0 ? (MODE == 0 ? WSP(float, WS_RS)[ents[k] >> 1] : gates[ents[k]]) : 0.f;
#pragma unroll
            for (int k = 0; k < 3; ++k) { tab[(2 * k + hsel) * 256 + r] = ents[k]; gt[(2 * k + hsel) * 256 + r] = gsv[k]; }
        }
        S.rdy = 0u;
        if (MODE == 1) {
            LAS unsigned* rdyw = (LAS unsigned*)(F.lds + LX_TST + 448);
            if (FTID < 64) { unsigned m = 0u;
                for (int i = 0; i < MOE_MAXU; ++i) { pg8::Unit u; if (S.next(i, u) && (unsigned)__builtin_amdgcn_readfirstlane(__hip_atomic_load(S.hcnt + 16 * u.pm, __ATOMIC_RELAXED, __HIP_MEMORY_SCOPE_AGENT)) >= 32u) m |= 1u << i; }
                __builtin_amdgcn_fence(__ATOMIC_ACQUIRE, "agent"); asm volatile("s_waitcnt vmcnt(0)" ::: "memory");
                if (FTID == 0) *rdyw = m; }
            __syncthreads();
            S.rdy = *rdyw;
        }
        __syncthreads();
        if (MODE == 0) { EpiSwiglu E{WSP(unsigned char, WS_HID), gt}; pg8::gemm_phase_es<1>(F.lds, WSP(unsigned char, WS_XB8), D, S, E); }
        else { EpiScatterY E{WSP(unsigned char, WS_Y), tab, gt}; pg8::gemm_phase_es<1>(F.lds, WSP(unsigned char, WS_HID), FF, S, E); }
        __syncthreads();
    }
}
__device__ __forceinline__ void f_moe(Frame& F, int L) {
    LAS int* tst = (LAS int*)(F.lds + LX_TST); LAS int* cntl = tst + 64;
    unsigned* ctl = WSP(unsigned, WS_CTL);
    __syncthreads();
    if (FTID < NE) cntl[FTID] = (int)__hip_atomic_load(&ctl[CW_CNT + L * 2048 + 64 * FTID], __ATOMIC_RELAXED, __HIP_MEMORY_SCOPE_AGENT);
    __syncthreads();
    if (FTID == 0) { int s = 0; for (int e = 0; e < NE; ++e) { tst[e] = s; s += (cntl[e] + 255) >> 8; } tst[NE] = s; }
    __syncthreads();
    f_moe_gemm<0>(F, L, tst, cntl);
    f_moe_gemm<1>(F, L, tst, cntl);
}
__device__ __forceinline__ void transpose_item(const float* W, int ldw, const float* kscale, float cs, bf16* WT, int K, int dst_row0, LAS float* scr, int k0, int n0, int lane) {
    f32x4 x[8]; float ks[8];
    const int kr = lane >> 3, n4 = (lane & 7) * 4;
#pragma unroll
    for (int i = 0; i < 8; ++i) { x[i] = *(const f32x4*)(W + (size_t)(k0 + 8 * i + kr) * ldw + n0 + n4); ks[i] = kscale ? kscale[k0 + 8 * i + kr] * cs : cs; }
#pragma unroll
    for (int i = 0; i < 8; ++i) { LAS float* d = scr + (8 * i + kr) * 33 + n4; d[0] = x[i][0] * ks[i]; d[1] = x[i][1] * ks[i]; d[2] = x[i][2] * ks[i]; d[3] = x[i][3] * ks[i]; }
    LDS_WAIT(); asm volatile("" ::: "memory");
    const int c = lane & 7;
#pragma unroll
    for (int j = 0; j < 4; ++j) { const int n = (lane >> 3) + 8 * j; const LAS float* s = scr + (8 * c) * 33 + n;
        v4u o; o.x = pk2(s[0 * 33], s[1 * 33]); o.y = pk2(s[2 * 33], s[3 * 33]); o.z = pk2(s[4 * 33], s[5 * 33]); o.w = pk2(s[6 * 33], s[7 * 33]);
        *(v4u*)(WT + (size_t)(dst_row0 + n) * K + k0 + 8 * c) = o; }
    LDS_WAIT(); asm volatile("" ::: "memory");
}
__device__ __forceinline__ void transpose_item8(const float* W, int ldw, const float* kscale, float cs, unsigned char* WT, int K, int dst_row0, LAS float* scr, int k0, int n0, int lane) {
    f32x4 x[8]; float ks[8];
    const int kr = lane >> 3, n4 = (lane & 7) * 4;
#pragma unroll
    for (int i = 0; i < 8; ++i) { x[i] = *(const f32x4*)(W + (size_t)(k0 + 8 * i + kr) * ldw + n0 + n4); ks[i] = kscale ? kscale[k0 + 8 * i + kr] * cs : cs; }
#pragma unroll
    for (int i = 0; i < 8; ++i) { LAS float* d = scr + (8 * i + kr) * 33 + n4; d[0] = x[i][0] * ks[i]; d[1] = x[i][1] * ks[i]; d[2] = x[i][2] * ks[i]; d[3] = x[i][3] * ks[i]; }
    LDS_WAIT(); asm volatile("" ::: "memory");
    const int c = lane & 7;
#pragma unroll
    for (int j = 0; j < 4; ++j) { const int n = (lane >> 3) + 8 * j; const LAS float* s = scr + (8 * c) * 33 + n;
        int w0 = __builtin_amdgcn_cvt_pk_fp8_f32(s[0 * 33], s[1 * 33], 0, false); w0 = __builtin_amdgcn_cvt_pk_fp8_f32(s[2 * 33], s[3 * 33], w0, true);
        int w1 = __builtin_amdgcn_cvt_pk_fp8_f32(s[4 * 33], s[5 * 33], 0, false); w1 = __builtin_amdgcn_cvt_pk_fp8_f32(s[6 * 33], s[7 * 33], w1, true);
        v2u o; o.x = (unsigned)w0; o.y = (unsigned)w1; *(v2u*)(WT + (size_t)(dst_row0 + n) * K + k0 + 8 * c) = o; }
    LDS_WAIT(); asm volatile("" ::: "memory");
}
__device__ __forceinline__ void convert_job_item8(const float* W, int ldw, int K, int N, const float* kscale, float cs, unsigned char* WT, int rowmap, LAS float* scr, int item, int lane) {
    const int nblk = N / 32, kb = item / nblk, nb = item % nblk, k0 = 64 * kb, n0 = 32 * nb;
    const int dr = rowmap == 0 ? n0 : ((n0 >> 7) * 256 + (n0 & 127) + (rowmap == 2 ? 128 : 0));
    transpose_item8(W, ldw, kscale, cs, WT, K, dr, scr, k0, n0, lane);
}
__device__ __forceinline__ void convert_job_item(const float* W, int ldw, int K, int N, const float* kscale, int qcols, float qs, bf16* WT, int rowmap, LAS float* scr, int item, int lane) {
    const int nblk = N / 32, kb = item / nblk, nb = item % nblk, k0 = 64 * kb, n0 = 32 * nb;
    const int dr = rowmap == 0 ? n0 : ((n0 >> 7) * 256 + (n0 & 127) + (rowmap == 2 ? 128 : 0));
    transpose_item(W, ldw, kscale, n0 < qcols ? qs : 1.f, WT, K, dr, scr, k0, n0, lane);
}
__device__ __forceinline__ void f_convert_gla(Frame& F) {
    LAS float* scr = (LAS float*)(F.lds + FWAVE * 8448);
    const int gw = F.bid * NWAVES + FWAVE, NGW = F.G * NWAVES;
    constexpr int I0 = (D / 64) * (NQKVR / 32), I1 = (HV / 64) * (D / 32);
    for (int it = gw; it < I0 + I1; it += NGW) {
        if (it < I0) convert_job_item(F.inp(I_GLA_WIN), GLA_IN, D, NQKVR, F.inp(I_GLA_NORM), HK, 0.08838834764831845f, WSP(bf16, WS_WIN), 0, scr, it, FLANE);
        else convert_job_item(F.inp(I_GLA_WOUT), D, HV, D, F.inp(I_GLA_HG), 0, 1.f, WSP(bf16, WS_WOUT), 0, scr, it - I0, FLANE);
    }
}
__device__ __forceinline__ void f_convert_rest(Frame& F, int cw, int NCW, int pct0 = 0, int pct1 = 1000) {
    LAS float* scr = (LAS float*)(F.lds + FWAVE * 8448);
    constexpr int I0 = (D / 64) * (SGU_FFN / 32), I1 = (SGU_HALF / 64) * (D / 32), IE1 = (D / 64) * (FF / 32), IE2 = (FF / 64) * (D / 32);
    constexpr int IM = 2 * NE * IE1;
    static_assert(IE1 == IE2, "w1 / w2 item counts");
    constexpr int NIT = I0 + I1 + 3 * IM; const int it_lo = (int)((long)NIT * pct0 / 1000), it_hi = (int)((long)NIT * pct1 / 1000);
    for (int it = it_lo + cw; it < it_hi; it += NCW) {
        int r = it;
        if (r < I0) { convert_job_item(F.inp(I_SGU_WIN), SGU_FFN, D, SGU_FFN, F.inp(I_SGU_NORM), 0, 1.f, WSP(bf16, WS_WSIN), 0, scr, r, FLANE); continue; } r -= I0;
        if (r < I1) { convert_job_item(F.inp(I_SGU_WOUT), D, SGU_HALF, D, nullptr, 0, 1.f, WSP(bf16, WS_WSOUT), 0, scr, r, FLANE); continue; } r -= I1;
        const int which = r / IM; r -= which * IM; const int le = r / IE1, li = r % IE1, L = le / NE;
        if (which == 0) convert_job_item8(F.inp(I_MOE_W1) + (size_t)le * D * FF, FF, D, FF, F.inp(I_MOE_NORM) + L * D, MOE_WSCALE, WSP(unsigned char, WS_W13) + (size_t)le * 1024 * 1024, 1, scr, li, FLANE);
        else if (which == 1) convert_job_item8(F.inp(I_MOE_W3) + (size_t)le * D * FF, FF, D, FF, F.inp(I_MOE_NORM) + L * D, MOE_WSCALE, WSP(unsigned char, WS_W13) + (size_t)le * 1024 * 1024, 2, scr, li, FLANE);
        else convert_job_item8(F.inp(I_MOE_W2) + (size_t)le * FF * D, D, FF, D, nullptr, MOE_WSCALE, WSP(unsigned char, WS_W2) + (size_t)le * 1024 * 512, 0, scr, li, FLANE);
    }
}

constexpr int SC_K = 0, SC_KSTR = 320;
constexpr int SC_V = 20480, SC_VSTR = 576;
constexpr int SC_Q = 57344, SC_QSTR = 272;
constexpr int SC_O = 74752, SC_OSTR = 528;
constexpr int SC_GL = 108544, SC_PART = 112640, SC_DEC = 114688, SC_WG = 115200;
__device__ __forceinline__ s16x4 tr_read16(LAS const unsigned char* p) {
    typedef short v4i16_t __attribute__((ext_vector_type(4)));
    return __builtin_bit_cast(s16x4, __builtin_amdgcn_ds_read_tr16_b64_v4i16((LAS v4i16_t*)p));
}
__device__ __forceinline__ void f_scan_item(Frame& F, int item, const XcdBarrier* xb_ = nullptr, int cbar = -1) {
    const int b = item / GLA_H, h = item % GLA_H;
    const bf16* qkvr = WSP(bf16, WS_QKVR); const float* glr = WSP(float, WS_GLR); bf16* aout = WSP(bf16, WS_AOUT);
    LAS unsigned char* L = F.lds;
    LAS float* gl = (LAS float*)(L + SC_GL); LAS float* part = (LAS float*)(L + SC_PART); LAS float* dec = (LAS float*)(L + SC_DEC);
    const int tid = FTID, lane = FLANE, w = FWAVE;
    const int r32 = lane & 31, hh = lane >> 5, blk = (lane >> 4) & 1, q4 = (lane & 15) >> 2, p4 = lane & 3;
    const int dk = tid & 127, tg = tid >> 7;
    const int gq = lane >> 4, gcol = lane & 15, gdk = 16 * w + gcol;
    bf16x8 gBh, gBl;
    { unsigned ph[4], pl[4];
#pragma unroll
      for (int j = 0; j < 4; ++j) { const float x0 = gq < 2 ? F.inp(I_GLA_WGU)[(8 * gq + 2 * j) * HK + h * DK + gdk] : 0.f, x1 = gq < 2 ? F.inp(I_GLA_WGU)[(8 * gq + 2 * j + 1) * HK + h * DK + gdk] : 0.f;
          ph[j] = pk2(x0, x1); pl[j] = pk2(x0 - bflo(ph[j]), x1 - bfhi(ph[j])); }
      v4u vh = {ph[0], ph[1], ph[2], ph[3]}, vl = {pl[0], pl[1], pl[2], pl[3]};
      gBh = __builtin_bit_cast(bf16x8, vh); gBl = __builtin_bit_cast(bf16x8, vl); }
    const float gbias = F.inp(I_GLA_BG)[h * DK + gdk];
    __syncthreads();
    f32x16 st[4];
#pragma unroll
    for (int i = 0; i < 4; ++i)
#pragma unroll
        for (int j = 0; j < 16; ++j) st[i][j] = 0.f;
    v4u rk[2], rq[2], rv[4]; f32x4 rg;
    const size_t rowb = (size_t)b * SEQ;
    const unsigned vo_kq = (unsigned)(((tid >> 4) * NQKVR + (tid & 15) * 8) * 2), vo_v = (unsigned)(((tid >> 5) * NQKVR + (tid & 31) * 8) * 2), vo_g = (unsigned)(tid * 16);
    const unsigned lo_k = (unsigned)(SC_K + (tid >> 4) * SC_KSTR + (tid & 15) * 16), lo_q = (unsigned)(SC_Q + (tid >> 4) * SC_QSTR + (tid & 15) * 16), lo_v = (unsigned)(SC_V + (tid >> 5) * SC_VSTR + (tid & 31) * 16);
#define SC_LOAD(c) do { size_t cb_ = (rowb + (size_t)(c) * CHUNK) * NQKVR * 2; asm volatile("" : "+s"(cb_)); const char* gb_ = (const char*)qkvr + cb_ + (size_t)(h * DK * 2); \
        _Pragma("unroll") for (int i = 0; i < 2; ++i) { \
            rk[i] = *(const v4u*)(gb_ + (size_t)(HK * 2 + i * 32 * NQKVR * 2) + vo_kq); rq[i] = *(const v4u*)(gb_ + (size_t)(i * 32 * NQKVR * 2) + vo_kq); } \
        _Pragma("unroll") for (int i = 0; i < 4; ++i) rv[i] = *(const v4u*)(gb_ + (size_t)(2 * HK * 2 + h * (DV - DK) * 2 + i * 16 * NQKVR * 2) + vo_v); \
        if (tid < 256) rg = *(const f32x4*)((const char*)glr + (rowb + (size_t)(c) * CHUNK) * RANK * 4 + vo_g); } while (0)
#define SC_STORE() do { \
        _Pragma("unroll") for (int i = 0; i < 2; ++i) { *(LAS v4u*)(L + lo_k + i * 32 * SC_KSTR) = rk[i]; *(LAS v4u*)(L + lo_q + i * 32 * SC_QSTR) = rq[i]; } \
        _Pragma("unroll") for (int i = 0; i < 4; ++i) *(LAS v4u*)(L + lo_v + i * 16 * SC_VSTR) = rv[i]; \
        if (tid < 256) *(LAS f32x4*)(gl + tid * 4) = rg; } while (0)
    SC_LOAD(0);
    SC_STORE();
    for (int c = 0; c < NCHUNK; ++c) {
        if (c == cbar) xcd_barrier(*xb_);
        const size_t t0 = rowb + (size_t)c * CHUNK;
        __syncthreads();
        if (c + 1 < NCHUNK) SC_LOAD(c + 1);
        {
            pg8::f32x4 g4[4]; float tsum[4], pre[4];
#pragma unroll
            for (int t = 0; t < 4; ++t) {
                v4u ah = {0u, 0u, 0u, 0u}, al = {0u, 0u, 0u, 0u};
                if (gq < 2) { const f32x4 x0 = *(const LAS f32x4*)(gl + (16 * t + gcol) * 16 + 8 * gq), x1 = *(const LAS f32x4*)(gl + (16 * t + gcol) * 16 + 8 * gq + 4);
                    ah.x = pk2(x0[0], x0[1]); ah.y = pk2(x0[2], x0[3]); ah.z = pk2(x1[0], x1[1]); ah.w = pk2(x1[2], x1[3]);
                    al.x = pk2(x0[0] - bflo(ah.x), x0[1] - bfhi(ah.x)); al.y = pk2(x0[2] - bflo(ah.y), x0[3] - bfhi(ah.y)); al.z = pk2(x1[0] - bflo(ah.z), x1[1] - bfhi(ah.z)); al.w = pk2(x1[2] - bflo(ah.w), x1[3] - bfhi(ah.w)); }
                pg8::f32x4 a4 = {gbias, gbias, gbias, gbias};
                a4 = __builtin_amdgcn_mfma_f32_16x16x32_bf16(__builtin_bit_cast(bf16x8, ah), gBh, a4, 0, 0, 0);
                a4 = __builtin_amdgcn_mfma_f32_16x16x32_bf16(__builtin_bit_cast(bf16x8, al), gBh, a4, 0, 0, 0);
                a4 = __builtin_amdgcn_mfma_f32_16x16x32_bf16(__builtin_bit_cast(bf16x8, ah), gBl, a4, 0, 0, 0);
#pragma unroll
                for (int i = 0; i < 4; ++i) { const float a = a4[i]; a4[i] = (fminf(a, 0.f) - __logf(1.f + __expf(-fabsf(a)))) * (1.f / 16.f); }
                a4[1] += a4[0]; a4[2] += a4[1]; a4[3] += a4[2];
                g4[t] = a4;
                const float s0 = a4[3], x1 = __shfl_xor(s0, 16), x2 = __shfl_xor(s0, 32), x3 = __shfl_xor(x1, 32);
                tsum[t] = (s0 + x1) + (x2 + x3);
                pre[t] = ((gq ^ 1) < gq ? x1 : 0.f) + ((gq ^ 2) < gq ? x2 : 0.f) + ((gq ^ 3) < gq ? x3 : 0.f);
            }
            const float tot = (tsum[0] + tsum[1]) + (tsum[2] + tsum[3]);
            float basep = 0.f;
#pragma unroll
            for (int t = 0; t < 4; ++t) {
#pragma unroll
                for (int i = 0; i < 4; ++i) {
                    LAS unsigned short* kp = (LAS unsigned short*)(L + SC_K + (16 * t + 4 * gq + i) * SC_KSTR + gdk * 2);
                    *kp = (unsigned short)f2bf(bf2f(*kp) * __expf(tot - (basep + pre[t] + g4[t][i])));
                }
                basep += tsum[t];
            }
            if (gq == 0) dec[gdk] = __expf(tot);
        }
        __syncthreads();
        const int etok = tid >> 3, ecc = tid & 7;
        v4u rr[4];
        { size_t eb_ = t0 * NQKVR * 2; asm volatile("" : "+s"(eb_));
          const char* rb_ = (const char*)qkvr + eb_ + (size_t)((2 * HK + HV + h * DV) * 2); const unsigned vo_r = (unsigned)(etok * NQKVR * 2 + ecc * 16);
#pragma unroll
          for (int i = 0; i < 4; ++i) rr[i] = *(const v4u*)(rb_ + vo_r + i * 128); }
#pragma unroll
        for (int i = 0; i < 4; ++i)
#pragma unroll
            for (int g4 = 0; g4 < 4; ++g4) { const f32x4 d4 = *(const LAS f32x4*)(dec + 32 * i + 8 * g4 + 4 * hh);
#pragma unroll
                for (int j = 0; j < 4; ++j) st[i][4 * g4 + j] *= d4[j]; }
#pragma unroll
        for (int s = 0; s < 4; ++s) {
            const int trow = 16 * s + 8 * hh + q4;
            const s16x4 v0 = tr_read16(L + SC_V + trow * SC_VSTR + (32 * w + 16 * blk + 4 * p4) * 2), v1 = tr_read16(L + SC_V + (trow + 4) * SC_VSTR + (32 * w + 16 * blk + 4 * p4) * 2);
            const bf16x8 Bv = {v0[0], v0[1], v0[2], v0[3], v1[0], v1[1], v1[2], v1[3]};
#pragma unroll
            for (int i = 0; i < 4; ++i) {
                const s16x4 k0 = tr_read16(L + SC_K + trow * SC_KSTR + (32 * i + 16 * blk + 4 * p4) * 2), k1 = tr_read16(L + SC_K + (trow + 4) * SC_KSTR + (32 * i + 16 * blk + 4 * p4) * 2);
                const bf16x8 Ak = {k0[0], k0[1], k0[2], k0[3], k1[0], k1[1], k1[2], k1[3]};
                st[i] = __builtin_amdgcn_mfma_f32_32x32x16_bf16(Ak, Bv, st[i], 0, 0, 0);
            }
        }
        {
        f32x16 oacc[2];
#pragma unroll
        for (int ot = 0; ot < 2; ++ot)
#pragma unroll
            for (int j = 0; j < 16; ++j) oacc[ot][j] = 0.f;
#pragma unroll
        for (int i = 0; i < 4; ++i)
#pragma unroll
            for (int s2 = 0; s2 < 2; ++s2) {
                v4u pb; pb.x = pk2(st[i][8 * s2 + 0], st[i][8 * s2 + 1]); pb.y = pk2(st[i][8 * s2 + 2], st[i][8 * s2 + 3]); pb.z = pk2(st[i][8 * s2 + 4], st[i][8 * s2 + 5]); pb.w = pk2(st[i][8 * s2 + 6], st[i][8 * s2 + 7]);
                const bf16x8 Bs = __builtin_bit_cast(bf16x8, pb);
#pragma unroll
                for (int ot = 0; ot < 2; ++ot) {
                    LAS const unsigned char* qp = L + SC_Q + (32 * ot + r32) * SC_QSTR + (32 * i + 16 * s2 + 4 * hh) * 2;
                    const v2u a0 = *(const LAS v2u*)qp, a1 = *(const LAS v2u*)(qp + 16);
                    v4u pa; pa.x = a0.x; pa.y = a0.y; pa.z = a1.x; pa.w = a1.y;
                    oacc[ot] = __builtin_amdgcn_mfma_f32_32x32x16_bf16(__builtin_bit_cast(bf16x8, pa), Bs, oacc[ot], 0, 0, 0);
                }
            }
#pragma unroll
        for (int ot = 0; ot < 2; ++ot)
#pragma unroll
            for (int rg16 = 0; rg16 < 16; ++rg16) {
                const int tok = 32 * ot + (rg16 & 3) + 8 * (rg16 >> 2) + 4 * hh;
                *(LAS unsigned short*)(L + SC_O + tok * SC_OSTR + (32 * w + r32) * 2) = (unsigned short)f2bf(oacc[ot][rg16]);
            }
        }
        __syncthreads();
        if (c + 1 < NCHUNK) SC_STORE();
        {
        {
            const int tok = etok, cc = ecc;
            v4u ov[4]; float ss = 0.f;
#pragma unroll
            for (int i = 0; i < 4; ++i) ov[i] = *(const LAS v4u*)(L + SC_O + tok * SC_OSTR + cc * 16 + i * 128);
#pragma unroll
            for (int i = 0; i < 4; ++i) { const float a0 = bflo(ov[i].x), a1 = bfhi(ov[i].x), a2 = bflo(ov[i].y), a3 = bfhi(ov[i].y), a4 = bflo(ov[i].z), a5 = bfhi(ov[i].z), a6 = bflo(ov[i].w), a7 = bfhi(ov[i].w);
                ss += (a0 * a0 + a1 * a1) + (a2 * a2 + a3 * a3) + (a4 * a4 + a5 * a5) + (a6 * a6 + a7 * a7); }
            ss += __shfl_xor(ss, 1); ss += __shfl_xor(ss, 2); ss += __shfl_xor(ss, 4);
            const float rms = __builtin_amdgcn_rsqf(ss * (1.f / DV) + EPS);
            size_t ob_ = (t0 * D + h * DV) * 2; asm volatile("" : "+s"(ob_)); const unsigned vo_o = (unsigned)(tok * D * 2 + cc * 16);
#pragma unroll
            for (int i = 0; i < 4; ++i) {
                v4u o;
                o.x = pk2(bflo(ov[i].x) * rms * bflo(rr[i].x), bfhi(ov[i].x) * rms * bfhi(rr[i].x));
                o.y = pk2(bflo(ov[i].y) * rms * bflo(rr[i].y), bfhi(ov[i].y) * rms * bfhi(rr[i].y));
                o.z = pk2(bflo(ov[i].z) * rms * bflo(rr[i].z), bfhi(ov[i].z) * rms * bfhi(rr[i].z));
                o.w = pk2(bflo(ov[i].w) * rms * bflo(rr[i].w), bfhi(ov[i].w) * rms * bfhi(rr[i].w));
                *(v4u*)((char*)aout + ob_ + vo_o + i * 128) = o;
            }
        }
            }
    }
    __syncthreads();
#undef SC_LOAD
#undef SC_STORE
}
constexpr int SCAN_C1 = 20;
__device__ __forceinline__ void f_scan_outproj(Frame& F, const XcdBarrier& xbar) {
    constexpr int NITEM = NBATCH * GLA_H;
    if (F.bid < NITEM) f_scan_item(F, F.bid, &xbar, SCAN_C1);
    else { f_convert_rest(F, (F.bid - NITEM) * NWAVES + FWAVE, (F.G - NITEM) * NWAVES); xcd_barrier(xbar); f_gemm_out_rows(F, 0, SCAN_C1 / 4, NITEM); }
    xcd_barrier(xbar);
    f_gemm_out_rows(F, SCAN_C1 / 4, 8, 0);
}
constexpr int MX_W = 0, MX_WSTR = 272;
constexpr int MX_V0 = 34816, MX_VSTR = 320, MX_VBYTES = 40960;
constexpr int MX_MU = 116736;
constexpr int MX_LN = MX_MU + 2560;
__device__ __forceinline__ void f_mix(Frame& F) {
    LAS unsigned char* L = F.lds;
    LAS float* mu = (LAS float*)(L + MX_MU); LAS float* rs = mu + 128; LAS float* m1 = rs + 128; LAS float* m0 = m1 + 128; LAS float* bsg = m0 + 128;
    LAS float* lgs = (LAS float*)(L + MX_LN); LAS float* lbs = lgs + 512;
    bf16* u = WSP(bf16, WS_U); const bf16* v = WSP(bf16, WS_V); const float* st = WSP(float, WS_STATS); bf16* uout = u;
    const int tid = FTID, lane = FLANE, w = FWAVE;
    const int r32 = lane & 31, hh = lane >> 5, blk = (lane >> 4) & 1, q4 = (lane & 15) >> 2, p4 = lane & 3;
    const int ct = w >> 1, th = w & 1;
    const unsigned vo_v = (unsigned)(((tid >> 4) * SGU_HALF + (tid & 15) * 8) * 2), lo_v = (unsigned)(MX_V0 + (tid >> 4) * MX_VSTR + (tid & 15) * 16);
    constexpr int MX_MSTR = 272;
    for (int bn = F.bid; bn < T / SGU_BLK; bn += F.G) {
        const size_t t0 = (size_t)bn * SGU_BLK;
        __syncthreads();
        {
            const int row = tid & 127, pq = tid >> 7; float s = 0.f, q = 0.f;
#pragma unroll
            for (int p = 0; p < 8; ++p) { const pg8::f32x2 a = *(const pg8::f32x2*)(st + ((size_t)(pq * 8 + p) * T + t0 + row) * 2); s += a.x; q += a.y; }
            LAS float* red = (LAS float*)(L + MX_V0);
            red[(pq * 128 + row) * 2] = s; red[(pq * 128 + row) * 2 + 1] = q;
            __syncthreads();
            if (tid < 128) { float s4 = 0.f, q4 = 0.f;
#pragma unroll
                for (int p = 0; p < 4; ++p) { s4 += red[(p * 128 + tid) * 2]; q4 += red[(p * 128 + tid) * 2 + 1]; }
                const float m = s4 * (1.f / SGU_HALF); mu[tid] = m; rs[tid] = __builtin_amdgcn_rsqf(fmaxf(q4 * (1.f / SGU_HALF) - m * m, 0.f) + EPS); }
            __syncthreads();
        }
        v4u preA[4], preB[4]; v4u uuA[4], uuB[4];
#define MX_LOAD(pre_, it_) do { size_t vb_ = (t0 * SGU_HALF + (size_t)(it_) * 128) * 2; asm volatile("" : "+s"(vb_)); \
        _Pragma("unroll") for (int i = 0; i < 4; ++i) pre_[i] = *(const v4u*)((const char*)v + vb_ + (size_t)(i * 32 * SGU_HALF * 2) + vo_v); } while (0)
#define MX_STORE(buf_, pre_) do { _Pragma("unroll") for (int i = 0; i < 4; ++i) *(LAS v4u*)(L + lo_v + (buf_) * MX_VBYTES + 32 * i * MX_VSTR) = pre_[i]; } while (0)
#define MX_ULOAD(uu_, it_) do { size_t ub_ = (t0 * SGU_HALF + (size_t)(it_) * 128) * 2; asm volatile("" : "+s"(ub_)); \
        _Pragma("unroll") for (int i = 0; i < 4; ++i) uu_[i] = *(const v4u*)((const char*)u + ub_ + (size_t)(i * 32 * SGU_HALF * 2) + vo_v); } while (0)
#define MX_TILE(it_, buf_, uu_) do { \
        f32x16 acc[2]; \
        _Pragma("unroll") for (int tt = 0; tt < 2; ++tt) _Pragma("unroll") for (int j = 0; j < 16; ++j) acc[tt][j] = 0.f; \
        LAS unsigned char* Vb = L + MX_V0 + (buf_) * MX_VBYTES; \
        const int nks = th == 0 ? 4 : 8; \
        for (int ks = 0; ks < nks; ++ks) { \
            const int srow = 16 * ks + 8 * hh + q4; \
            const s16x4 a0 = tr_read16(Vb + srow * MX_VSTR + (32 * ct + 16 * blk + 4 * p4) * 2), a1 = tr_read16(Vb + (srow + 4) * MX_VSTR + (32 * ct + 16 * blk + 4 * p4) * 2); \
            const bf16x8 Av = {a0[0], a0[1], a0[2], a0[3], a1[0], a1[1], a1[2], a1[3]}; \
            _Pragma("unroll") for (int tt = 0; tt < 2; ++tt) { \
                const bf16x8 Bw = *(const LAS bf16x8*)(L + MX_W + (64 * th + 32 * tt + r32) * MX_WSTR + (16 * ks + 8 * hh) * 2); \
                acc[tt] = __builtin_amdgcn_mfma_f32_32x32x16_bf16(Av, Bw, acc[tt], 0, 0, 0); } } \
        const int cl = ((it_) & 3) * 128 + 32 * ct + 4 * hh;                    \
        __syncthreads();                                                         \
        _Pragma("unroll") for (int tt = 0; tt < 2; ++tt) { \
            const int t = 64 * th + 32 * tt + r32; const float tm1 = m1[t], tm0 = m0[t], tb = bsg[t]; \
            _Pragma("unroll") for (int g4 = 0; g4 < 4; ++g4) { \
                const f32x4 lg = *(const LAS f32x4*)(lgs + cl + 8 * g4), lb = *(const LAS f32x4*)(lbs + cl + 8 * g4); \
                v2u o; o.x = pk2(lg[0] * (acc[tt][4 * g4 + 0] - tm1) + lb[0] * tm0 + tb, lg[1] * (acc[tt][4 * g4 + 1] - tm1) + lb[1] * tm0 + tb); \
                o.y = pk2(lg[2] * (acc[tt][4 * g4 + 2] - tm1) + lb[2] * tm0 + tb, lg[3] * (acc[tt][4 * g4 + 3] - tm1) + lb[3] * tm0 + tb); \
                *(LAS v2u*)(Vb + t * MX_MSTR + (32 * ct + 8 * g4 + 4 * hh) * 2) = o; } } \
        __syncthreads();                                                         \
        size_t ob_ = (t0 * SGU_HALF + (size_t)(it_) * 128) * 2; asm volatile("" : "+s"(ob_)); \
        _Pragma("unroll") for (int i = 0; i < 4; ++i) { \
            const v4u mx = *(const LAS v4u*)(Vb + ((tid >> 4) + 32 * i) * MX_MSTR + (tid & 15) * 16); const v4u ux = uu_[i]; v4u o; \
            o.x = pk2(bflo(ux.x) * bflo(mx.x), bfhi(ux.x) * bfhi(mx.x)); o.y = pk2(bflo(ux.y) * bflo(mx.y), bfhi(ux.y) * bfhi(mx.y)); \
            o.z = pk2(bflo(ux.z) * bflo(mx.z), bfhi(ux.z) * bfhi(mx.z)); o.w = pk2(bflo(ux.w) * bflo(mx.w), bfhi(ux.w) * bfhi(mx.w)); \
            *(v4u*)((char*)uout + ob_ + (size_t)(i * 32 * SGU_HALF * 2) + vo_v) = o; } } while (0)
        MX_LOAD(preA, 0); MX_LOAD(preB, 1); MX_ULOAD(uuA, 0);
        for (int it = 0; it < 16; it += 2) {
            if ((it & 3) == 0) {
                const int g = it >> 2;
                __syncthreads();
                const int t = tid >> 2, sq = tid & 3; const float* wsrc = F.inp(I_SGU_WS) + ((size_t)g * 128 + t) * 128 + sq * 8;
                float a1 = 0.f, a0 = 0.f;
#pragma unroll
                for (int i = 0; i < 4; ++i) {
                    const f32x4 x0 = *(const f32x4*)(wsrc + i * 32), x1 = *(const f32x4*)(wsrc + i * 32 + 4); float wv[8] = {x0[0], x0[1], x0[2], x0[3], x1[0], x1[1], x1[2], x1[3]}; float hv[8];
#pragma unroll
                    for (int j = 0; j < 8; ++j) { const int s = i * 32 + sq * 8 + j; const float wm = ((t >> 6) >= (s >> 6)) ? wv[j] : 0.f; a0 += wm; hv[j] = wm * rs[s]; }
                    v4u o; o.x = pk2(hv[0], hv[1]); o.y = pk2(hv[2], hv[3]); o.z = pk2(hv[4], hv[5]); o.w = pk2(hv[6], hv[7]);
                    const unsigned ow[4] = {o.x, o.y, o.z, o.w};
#pragma unroll
                    for (int j = 0; j < 4; ++j) a1 += bflo(ow[j]) * mu[i * 32 + sq * 8 + 2 * j] + bfhi(ow[j]) * mu[i * 32 + sq * 8 + 2 * j + 1];
                    *(LAS v4u*)(L + MX_W + t * MX_WSTR + (i * 32 + sq * 8) * 2) = o;
                }
                a1 += __shfl_xor(a1, 1); a1 += __shfl_xor(a1, 2); a0 += __shfl_xor(a0, 1); a0 += __shfl_xor(a0, 2);
                if (sq == 0) { m1[t] = a1; m0[t] = a0; }
                if (tid < 128) bsg[tid] = F.inp(I_SGU_BS)[g * 128 + tid];
                lgs[tid] = F.inp(I_SGU_LNG)[g * SGU_GC + tid]; lbs[tid] = F.inp(I_SGU_LNB)[g * SGU_GC + tid];
            }
            MX_STORE(0, preA);
            __syncthreads();
            if (it + 2 < 16) MX_LOAD(preA, it + 2);
            MX_ULOAD(uuB, it + 1);
            MX_TILE(it, 0, uuA);
            MX_STORE(1, preB);
            __syncthreads();
            if (it + 3 < 16) MX_LOAD(preB, it + 3);
            if (it + 2 < 16) MX_ULOAD(uuA, it + 2);
            MX_TILE(it + 1, 1, uuB);
        }
#undef MX_LOAD
#undef MX_STORE
#undef MX_ULOAD
#undef MX_TILE
    }
}
constexpr int RW_STR = 2064;
constexpr int RW_LG = 48 * RW_STR;
constexpr int RW_HIST = RW_LG + 8 * 16 * 48 * 4;
template <int MODE> __device__ __forceinline__ void f_rowgroup(Frame& F, int Lyr) {
    constexpr int NCT = MODE == 0 ? 1 : 3;
    LAS unsigned char* L = F.lds;
    const int tid = FTID, lane = FLANE, w = FWAVE, rw = lane & 15, q = lane >> 4;
    const float* xsrc = F.inp(I_X);
    bf16* xb = WSP(bf16, WS_XN); float* rsout = WSP(float, WS_RS);
    __syncthreads();
    for (int k = tid; k < D; k += NTHREADS) {
        if (MODE == 0) {
            const float gn = F.inp(I_GLA_NORM)[k]; const float* wr_ = F.inp(I_GLA_WIN) + (size_t)k * GLA_IN + NQKVR;
#pragma unroll
            for (int c4 = 0; c4 < 4; ++c4) { const f32x4 x = *(const f32x4*)(wr_ + 4 * c4);
#pragma unroll
                for (int j = 0; j < 4; ++j) *(LAS unsigned short*)(L + (4 * c4 + j) * RW_STR + k * 2) = (unsigned short)f2bf(x[j] * gn); }
        } else {
            const float gn = F.inp(I_MOE_NORM)[Lyr * D + k];
            const f32x4 xg = *(const f32x4*)(F.inp(I_MOE_WG) + ((size_t)Lyr * D + k) * 4);
#pragma unroll
            for (int j = 0; j < 4; ++j) *(LAS unsigned short*)(L + j * RW_STR + k * 2) = (unsigned short)f2bf(xg[j] * gn);
#pragma unroll
            for (int g = 0; g < 4; ++g) { const float* ws_ = F.inp(I_MOE_WSUB) + (((size_t)Lyr * 4 + g) * D + k) * EPG; const f32x4 a = *(const f32x4*)ws_, b = *(const f32x4*)(ws_ + 4);
#pragma unroll
                for (int j = 0; j < 4; ++j) { *(LAS unsigned short*)(L + (4 + 8 * g + j) * RW_STR + k * 2) = (unsigned short)f2bf(a[j] * gn); *(LAS unsigned short*)(L + (8 + 8 * g + j) * RW_STR + k * 2) = (unsigned short)f2bf(b[j] * gn); } }
#pragma unroll
            for (int c = 36; c < 48; ++c) *(LAS unsigned short*)(L + c * RW_STR + k * 2) = 0;
        }
    }
    LAS int* hist = (LAS int*)(L + RW_HIST); LAS int* hbase = hist + 32;
    if (MODE == 1 && tid < 32) hist[tid] = 0;
    __syncthreads();
    const int ngroups = T / 16, niter = (ngroups + F.G * NWAVES - 1) / (F.G * NWAVES);
    for (int iter = 0; iter < niter; ++iter) {
        const int grp = (iter * F.G + F.bid) * NWAVES + w; const bool valid = grp < ngroups;
        const size_t row = (size_t)grp * 16 + rw;
        float rstd = 0.f; pg8::f32x4 acc[NCT];
        if (valid) {
#pragma unroll
            for (int c = 0; c < NCT; ++c) acc[c] = (pg8::f32x4){0.f, 0.f, 0.f, 0.f};
            float ss = 0.f;
#pragma unroll 8
            for (int s = 0; s < 32; ++s) {
                v4u pa;
                if (MODE == 0) {
                    const float* xr = xsrc + row * D + 8 * q + 32 * s;
                    const f32x4 x0 = *(const f32x4*)xr, x1 = *(const f32x4*)(xr + 4);
                    ss += (x0[0] * x0[0] + x0[1] * x0[1]) + (x0[2] * x0[2] + x0[3] * x0[3]) + (x1[0] * x1[0] + x1[1] * x1[1]) + (x1[2] * x1[2] + x1[3] * x1[3]);
                    pa.x = pk2(x0[0], x0[1]); pa.y = pk2(x0[2], x0[3]); pa.z = pk2(x1[0], x1[1]); pa.w = pk2(x1[2], x1[3]);
                    *(v4u*)(xb + row * D + 8 * q + 32 * s) = pa;
                } else {
                    pa = *(const v4u*)(xb + row * D + 8 * q + 32 * s);
                    const float a0 = bflo(pa.x), a1 = bfhi(pa.x), a2 = bflo(pa.y), a3 = bfhi(pa.y), a4 = bflo(pa.z), a5 = bfhi(pa.z), a6 = bflo(pa.w), a7 = bfhi(pa.w);
                    ss += (a0 * a0 + a1 * a1) + (a2 * a2 + a3 * a3) + (a4 * a4 + a5 * a5) + (a6 * a6 + a7 * a7);
                    int w0 = __builtin_amdgcn_cvt_pk_fp8_f32(a0, a1, 0, false); w0 = __builtin_amdgcn_cvt_pk_fp8_f32(a2, a3, w0, true);
                    int w1 = __builtin_amdgcn_cvt_pk_fp8_f32(a4, a5, 0, false); w1 = __builtin_amdgcn_cvt_pk_fp8_f32(a6, a7, w1, true);
                    v2u o8; o8.x = (unsigned)w0; o8.y = (unsigned)w1; *(v2u*)(WSP(unsigned char, WS_XB8) + row * D + 8 * q + 32 * s) = o8;
                }
                const bf16x8 A = __builtin_bit_cast(bf16x8, pa);
#pragma unroll
                for (int c = 0; c < NCT; ++c) { const bf16x8 B = *(const LAS bf16x8*)(L + (16 * c + rw) * RW_STR + (32 * s + 8 * q) * 2); acc[c] = __builtin_amdgcn_mfma_f32_16x16x32_bf16(A, B, acc[c], 0, 0, 0); }
            }
            ss += __shfl_xor(ss, 16); ss += __shfl_xor(ss, 32);
            rstd = __builtin_amdgcn_rsqf(ss * (1.f / D) + EPS);
            if (q == 0) rsout[row] = rstd;
        }
        float rs4[4];
#pragma unroll
        for (int i = 0; i < 4; ++i) rs4[i] = __shfl(rstd, 4 * q + i);
        int e1 = 0, e2 = 0, rk1 = 0, rk2 = 0; float gt1 = 0.f, gt2 = 0.f;
        if (MODE == 0) {
            if (valid) {
                float* glr = WSP(float, WS_GLR);
#pragma unroll
                for (int i = 0; i < 4; ++i) glr[((size_t)grp * 16 + 4 * q + i) * RANK + rw] = acc[0][i] * rs4[i];
            }
        } else {
            LAS float* lgw = (LAS float*)(L + RW_LG) + w * 16 * 48;
            if (valid) {
#pragma unroll
                for (int c = 0; c < NCT; ++c)
#pragma unroll
                    for (int i = 0; i < 4; ++i) lgw[(4 * q + i) * 48 + 16 * c + rw] = acc[c][i] * rs4[i];
            }
            LDS_WAIT(); asm volatile("" ::: "memory");
            if (valid && lane < 16) {
                const LAS float* lr = lgw + lane * 48; const float* bg = F.inp(I_MOE_BG) + Lyr * 4;
                float lg[4];
#pragma unroll
                for (int c = 0; c < 4; ++c) lg[c] = lr[c] + bg[c];
                int g = 0; float gm = lg[0];
#pragma unroll
                for (int c = 1; c < 4; ++c) if (lg[c] > gm) { gm = lg[c]; g = c; }
                float gs = 0.f;
#pragma unroll
                for (int c = 0; c < 4; ++c) gs += __expf(lg[c] - gm);
                const float g_w = 1.f / gs; const float* bs = F.inp(I_MOE_BSUB) + (Lyr * 4 + g) * EPG;
                int i1 = 0, i2 = 0; float m1v = -3.0e38f, m2v = -3.0e38f;
                for (int e = 0; e < EPG; ++e) { const float x = lr[4 + 8 * g + e] + bs[e];
                    if (x > m1v) { m2v = m1v; i2 = i1; m1v = x; i1 = e; } else if (x > m2v) { m2v = x; i2 = e; } }
                const float w1 = 1.f / (1.f + __expf(m2v - m1v));
                e1 = g * EPG + i1; e2 = g * EPG + i2; gt1 = g_w * w1; gt2 = g_w * (1.f - w1);
                rk1 = __hip_atomic_fetch_add(&hist[e1], 1, __ATOMIC_RELAXED, __HIP_MEMORY_SCOPE_WORKGROUP); rk2 = __hip_atomic_fetch_add(&hist[e2], 1, __ATOMIC_RELAXED, __HIP_MEMORY_SCOPE_WORKGROUP);
            }
            __syncthreads();
            if (tid < 32) { const int hcount = hist[tid]; hbase[tid] = hcount ? (int)atomicAdd(WSP(unsigned, WS_CTL) + CW_CNT + Lyr * 2048 + 64 * tid, (unsigned)hcount) : 0; hist[tid] = 0; }
            __syncthreads();
            if (valid && lane < 16) {
                const int tok = grp * 16 + lane; const int p1 = hbase[e1] + rk1, p2 = hbase[e2] + rk2;
                WSP(int, WS_LIST)[(size_t)e1 * T + p1] = tok * 2; WSP(int, WS_LIST)[(size_t)e2 * T + p2] = tok * 2 + 1;
                WSP(float, WS_GATE)[tok * 2] = gt1; WSP(float, WS_GATE)[tok * 2 + 1] = gt2;
            }
        }
    }
    __syncthreads();
}
template <bool FINAL> __device__ __forceinline__ void f_rowadd(Frame& F) {
    bf16* xb = WSP(bf16, WS_XN); const unsigned char* y = WSP(unsigned char, WS_Y); float* rsout = WSP(float, WS_RS); bf16* xo = xb;
    const int lane = FLANE, w = FWAVE;
    f32x4 gf[4];
    if (FINAL) {
#pragma unroll
        for (int j = 0; j < 2; ++j) { gf[2 * j] = *(const f32x4*)(F.inp(I_FINAL) + 8 * lane + 512 * j); gf[2 * j + 1] = *(const f32x4*)(F.inp(I_FINAL) + 8 * lane + 512 * j + 4); }
    }
    for (int r0 = (F.bid * NWAVES + w) * 2; r0 < T; r0 += F.G * NWAVES * 2) {
        v4u xa[2][2]; v2u ya[2][2], yb[2][2];
#pragma unroll
        for (int rr = 0; rr < 2; ++rr)
#pragma unroll
            for (int j = 0; j < 2; ++j) { const size_t o = (size_t)(r0 + rr) * D + 8 * lane + 512 * j;
                xa[rr][j] = *(const v4u*)(xb + o); ya[rr][j] = *(const v2u*)(y + o); yb[rr][j] = *(const v2u*)(y + (size_t)T * D + o); }
#pragma unroll
        for (int rr = 0; rr < 2; ++rr) {
            float v[16]; float ss = 0.f;
#pragma unroll
            for (int j = 0; j < 2; ++j) {
                const unsigned xw[4] = {xa[rr][j].x, xa[rr][j].y, xa[rr][j].z, xa[rr][j].w};
                const pg8::f32x2 a0 = __builtin_amdgcn_cvt_pk_f32_fp8((int)ya[rr][j].x, false), a1 = __builtin_amdgcn_cvt_pk_f32_fp8((int)ya[rr][j].x, true), a2 = __builtin_amdgcn_cvt_pk_f32_fp8((int)ya[rr][j].y, false), a3 = __builtin_amdgcn_cvt_pk_f32_fp8((int)ya[rr][j].y, true);
                const pg8::f32x2 b0 = __builtin_amdgcn_cvt_pk_f32_fp8((int)yb[rr][j].x, false), b1 = __builtin_amdgcn_cvt_pk_f32_fp8((int)yb[rr][j].x, true), b2 = __builtin_amdgcn_cvt_pk_f32_fp8((int)yb[rr][j].y, false), b3 = __builtin_amdgcn_cvt_pk_f32_fp8((int)yb[rr][j].y, true);
                const float ysum[8] = {a0.x + b0.x, a0.y + b0.y, a1.x + b1.x, a1.y + b1.y, a2.x + b2.x, a2.y + b2.y, a3.x + b3.x, a3.y + b3.y};
#pragma unroll
                for (int e = 0; e < 4; ++e) { const float lo = bflo(xw[e]) + ysum[2 * e], hi = bfhi(xw[e]) + ysum[2 * e + 1]; v[8 * j + 2 * e] = lo; v[8 * j + 2 * e + 1] = hi; ss += lo * lo + hi * hi; }
            }
            const float rstd = __builtin_amdgcn_rsqf(wave_sum(ss) * (1.f / D) + EPS);
            const size_t ro = (size_t)(r0 + rr) * D + 8 * lane;
            if (FINAL) {
#pragma unroll
                for (int j = 0; j < 2; ++j) {
                    f32x4 o0 = {v[8 * j] * rstd, v[8 * j + 1] * rstd, v[8 * j + 2] * rstd, v[8 * j + 3] * rstd}, o1 = {v[8 * j + 4] * rstd, v[8 * j + 5] * rstd, v[8 * j + 6] * rstd, v[8 * j + 7] * rstd};
                    *(f32x4*)(F.out + ro + 512 * j) = o0 * gf[2 * j]; *(f32x4*)(F.out + ro + 512 * j + 4) = o1 * gf[2 * j + 1]; }
            } else {
#pragma unroll
                for (int j = 0; j < 2; ++j) { v4u o; o.x = pk2(v[8 * j], v[8 * j + 1]); o.y = pk2(v[8 * j + 2], v[8 * j + 3]); o.z = pk2(v[8 * j + 4], v[8 * j + 5]); o.w = pk2(v[8 * j + 6], v[8 * j + 7]); *(v4u*)(xo + ro + 512 * j) = o; }
                if (lane == 0) rsout[r0 + rr] = rstd;
            }
        }
    }
}
__device__ __forceinline__ void f_prep0(Frame& F) { f_convert_gla(F); f_rowgroup<0>(F, 0); }
__device__ __forceinline__ void f_rowpass_router(Frame& F, int L) { f_rowgroup<1>(F, L); }
__device__ __forceinline__ void f_rowpass_add(Frame& F) { f_rowadd<false>(F); }
__device__ __forceinline__ void f_final(Frame& F) { f_rowadd<true>(F); }
constexpr int LDS_BYTES = 155648;
struct Args { const float* in[23]; float* out; unsigned char* ws; int ph_lo, ph_hi; };

__global__ void __launch_bounds__(NTHREADS, 2) fwd(Args args) {
    extern __shared__ __attribute__((aligned(16))) unsigned char lds_raw[];
    Frame F;
    F.lds = (LAS unsigned char*)lds_raw;
    F.G = gridDim.x; F.bid = blockIdx.x;
    F.out = args.out; F.ws = args.ws;
    volatile LAS unsigned* bst = (volatile LAS unsigned*)(F.lds + LX_PTR + 192);
    if (FTID == 0) {
        LAS unsigned long long* pt = (LAS unsigned long long*)(F.lds + LX_PTR);
#pragma unroll
        for (int i = 0; i < 23; ++i) pt[i] = (unsigned long long)args.in[i];
    }
    if (FTID < 2) bst[FTID] = 0u;
    __syncthreads();
    cg::grid_group grid = cg::this_grid();
    const XcdBarrier xbar = xcd_barrier_post(WSP(unsigned, WS_CTL) + CW_BAR, bst);
    const int lo = args.ph_lo, hi = args.ph_hi;
    if (lo > 1000) grid.sync();
#define IN(k) (lo <= (k) && (k) < hi)
#define SEAM() xcd_barrier(xbar)

    if (IN(0)) f_prep0(F);                 SEAM();
    if (IN(1)) f_gemm_in(F);               SEAM();
    if (IN(2)) f_scan_outproj(F, xbar);    SEAM();
    if (IN(3)) f_rowpass_router(F, 0);     SEAM();
    if (IN(4)) f_moe(F, 0);                SEAM();
    if (IN(5)) f_rowpass_add(F);           SEAM();
    if (IN(6)) f_gemm_sgu_in(F);           SEAM();
    if (IN(7)) f_mix(F);                   SEAM();
    if (IN(8)) f_gemm_sgu_out(F);          SEAM();
    if (IN(9)) f_rowpass_router(F, 1);     SEAM();
    if (IN(10)) f_moe(F, 1);               SEAM();
    if (IN(11)) f_final(F);
#undef IN
#undef SEAM
}

extern "C" void kernel_launch(void* const* d_in, const int* in_sizes, int n_in, void* d_out, int out_size, void* d_ws, size_t ws_size, hipStream_t stream) {
    static int grid = 0;
    if (grid == 0) {
        if (n_in != 23 || out_size != T * D || in_sizes[0] != T * D || ws_size < WS_END) { fprintf(stderr, "kernel_launch: unexpected shapes (n_in %d out %d ws %zu): nothing launched\n", n_in, out_size, ws_size); grid = -1; return; }
        int dev = 0, cus = 0, per_cu = 0;
        if (hipGetDevice(&dev) != hipSuccess || hipDeviceGetAttribute(&cus, hipDeviceAttributeMultiprocessorCount, dev) != hipSuccess) { grid = -1; return; }
        if (hipFuncSetAttribute((const void*)fwd, hipFuncAttributeMaxDynamicSharedMemorySize, LDS_BYTES) != hipSuccess) { fprintf(stderr, "kernel_launch: cannot get %d bytes of dynamic LDS\n", LDS_BYTES); grid = -1; return; }
        if (hipOccupancyMaxActiveBlocksPerMultiprocessor(&per_cu, (const void*)fwd, NTHREADS, LDS_BYTES) != hipSuccess || per_cu < 1) { fprintf(stderr, "kernel_launch: occupancy query admits %d workgroups per CU: nothing launched\n", per_cu); grid = -1; (void)hipGetLastError(); return; }
        grid = cus;
        if (grid < 128) { fprintf(stderr, "kernel_launch: %d CUs; this kernel's phase program needs at least 128 workgroups\n", grid); grid = -1; return; }
    }
    if (grid < 0) return;
    (void)hipMemsetAsync((char*)d_ws + WS_CTL, 0, CTL_ZERO_BYTES, stream);
    Args a{};
    for (int i = 0; i < 23; ++i) a.in[i] = (const float*)d_in[i];
    a.out = (float*)d_out; a.ws = (unsigned char*)d_ws; a.ph_lo = 0; a.ph_hi = 12;
    void* kargs[] = {&a};
    const hipError_t e = hipLaunchCooperativeKernel((const void*)fwd, dim3(grid), dim3(NTHREADS), kargs, LDS_BYTES, stream);
    if (e != hipSuccess) fprintf(stderr, "cooperative launch failed: %s (grid %d)\n", hipGetErrorString(e), grid);
}
```

```cpp
#include <hip/hip_runtime.h>
#include <hip/hip_cooperative_groups.h>
#include <cstdio>
#include <cstdint>
namespace cg = cooperative_groups;


constexpr int T = 32768, D = 1024, NBATCH = 16, SEQ = 2048;
constexpr int GLA_H = 4, DK = 128, DV = 256, HK = 512, HV = 1024, RANK = 16, GLA_IN = 3088, NQKVR = 3072, CHUNK = 64, NCHUNK = 32;
constexpr int SGU_FFN = 4096, SGU_HALF = 2048, SGU_BLK = 128, SGU_GC = 512;
constexpr int NE = 32, EPG = 8, FF = 512;
constexpr float EPS = 1e-6f;
constexpr int NTHREADS = 512, NWAVES = 8;

constexpr size_t MiB = 1u << 20;
constexpr size_t WS_CTL = 0, CTL_ZERO_BYTES = 128 * 1024;
constexpr size_t WS_GLR = 1 * MiB;
constexpr size_t WS_GATE = 3 * MiB;
constexpr size_t WS_STATS = 4 * MiB;
constexpr size_t WS_LIST = 12 * MiB;
constexpr size_t WS_WIN = 16 * MiB;
constexpr size_t WS_WOUT = 22 * MiB;
constexpr size_t WS_WSIN = 24 * MiB;
constexpr size_t WS_WSOUT = 32 * MiB;
constexpr size_t WS_W13 = 36 * MiB;
constexpr size_t WS_W2 = 164 * MiB;
constexpr float MOE_WSCALE = 32.f;
constexpr size_t WS_XN = 228 * MiB;
constexpr size_t WS_AOUT = 484 * MiB;
constexpr size_t WS_RS = 3 * MiB + 256 * 1024;
constexpr size_t WS_QKVR = 292 * MiB;
constexpr size_t WS_HID = 292 * MiB;
constexpr size_t WS_XB8 = 328 * MiB;
constexpr size_t WS_Y = 364 * MiB;
constexpr size_t WS_U = 292 * MiB;
constexpr size_t WS_V = 420 * MiB;
constexpr size_t WS_END = 548 * MiB;
constexpr int CW_BAR = 1024;
constexpr int CW_HID = 16384;
constexpr int CW_CNT = 8192;

#define GAS __attribute__((address_space(1)))
#define LAS __attribute__((address_space(3)))
typedef unsigned short bf16;
typedef unsigned v4u __attribute__((ext_vector_type(4)));
typedef unsigned v2u __attribute__((ext_vector_type(2)));
typedef float f32x4 __attribute__((ext_vector_type(4)));
typedef float f32x16 __attribute__((ext_vector_type(16)));
typedef short bf16x8 __attribute__((ext_vector_type(8)));
typedef short s16x4 __attribute__((ext_vector_type(4)));
#define LDS_WAIT() asm volatile("s_waitcnt lgkmcnt(0)" ::: "memory")
#define VM_WAIT() asm volatile("s_waitcnt vmcnt(0)" ::: "memory")
typedef float f32x2_t __attribute__((ext_vector_type(2))); typedef __bf16 bf16x2_t __attribute__((ext_vector_type(2)));
__device__ __forceinline__ unsigned pk2(float lo, float hi) { f32x2_t v = {lo, hi}; bf16x2_t b = __builtin_convertvector(v, bf16x2_t); return __builtin_bit_cast(unsigned, b); }
__device__ __forceinline__ unsigned f2bf(float f) { return pk2(f, 0.f) & 0xffffu; }
__device__ __forceinline__ float bf2f(unsigned short b) { return __builtin_bit_cast(float, (unsigned)b << 16); }
__device__ __forceinline__ float bflo(unsigned w) { return __builtin_bit_cast(float, w << 16); }
__device__ __forceinline__ float bfhi(unsigned w) { return __builtin_bit_cast(float, w & 0xffff0000u); }
__device__ __forceinline__ float wave_sum(float v) {
#pragma unroll
    for (int o = 1; o < 64; o <<= 1) v += __shfl_xor(v, o);
    return v;
}
__device__ __forceinline__ float silu_f(float x) { return x * __builtin_amdgcn_rcpf(1.f + __expf(-x)); }
namespace pg8 {
#define PG8_LAS __attribute__((address_space(3)))
typedef unsigned short bf16_t;
typedef short bf16x8 __attribute__((ext_vector_type(8)));
typedef float f32x4 __attribute__((ext_vector_type(4)));
typedef unsigned u32x4 __attribute__((ext_vector_type(4)));
constexpr int BM = 256, BK = 64, HALF = 128, HTB = HALF * BK * 2  , STAGE_BYTES = 8 * HTB, NXCD = 8, WGM = 2;

__host__ __device__ __forceinline__ int lds_byte(int r, int c) { const int st = (r >> 4) * 2 + (c >> 5), rr = r & 15, cc = c & 31, ob = rr * 64 + cc * 2; return st * 1024 + (ob ^ (((ob >> 9) & 1) << 5)); }
__host__ __device__ __forceinline__ void stage_rc(int b, int& R, int& C) { const int st = b / 1024, sb = b % 1024, swz = sb ^ (((sb >> 9) & 1) << 5); R = (st >> 1) * 16 + swz / 64; C = (st & 1) * 32 + (swz % 64) / 2; }
__host__ __device__ __forceinline__ int perm32(int rho) { const int n = rho >> 4, i = rho & 15; return 8 * (i >> 2) + 4 * n + (i & 3); }

struct Unit { int pm, pn, e, slot; };

struct DenseOrder {
    static constexpr bool GATHER = false;
    int nM, nN, nwg, G, c, K; const char* Bt;
    __device__ void init(int M, int N, int K_, const bf16_t* Bt_, int G_, int c_) { nM = M / BM; nN = N / BM; nwg = nM * nN; G = G_; c = c_; K = K_; Bt = (const char*)Bt_; }
    __device__ __forceinline__ bool next(int i, Unit& u) const {
        const long L = (long)i * G + c; if (L >= nwg) return false;
        int wgid = (int)L; { const int q = nwg / NXCD, r = nwg % NXCD, xcd = wgid % NXCD, off = wgid / NXCD; wgid = (xcd < r ? xcd * (q + 1) : r * (q + 1) + (xcd - r) * q) + off; }
        const int nig = WGM * nN, gid = wgid / nig, fm = gid * WGM, gsz = (nM - fm) < WGM ? (nM - fm) : WGM;
        u.pm = fm + ((wgid % nig) % gsz); u.pn = (wgid % nig) / gsz; u.e = 0; u.slot = 0; return true;
    }
    __device__ __forceinline__ const char* bptr(const Unit& u) const { return Bt + (size_t)u.pn * BM * K * 2; }
    __device__ __forceinline__ size_t abase(const Unit& u) const { return (size_t)u.pm * BM * K * 2; }
    __device__ __forceinline__ unsigned aoff(const Unit& u, int h, int R, int C) const { return (unsigned)(((u.pm * BM + h * HALF + R) * K + C) * 2); }
    __device__ __forceinline__ void a_ready(const Unit&) const {}
    __device__ __forceinline__ void done(const Unit&) const {}
};

__device__ __forceinline__ unsigned cvt_pk_bf16(float lo, float hi) { unsigned r; asm volatile("v_cvt_pk_bf16_f32 %0, %1, %2" : "=v"(r) : "v"(lo), "v"(hi)); return r; }
typedef float f32x2 __attribute__((ext_vector_type(2)));
__device__ __forceinline__ f32x2 gelu_pk(f32x2 v) {
    const f32x2 av = __builtin_elementwise_abs(v), d = av * 0.2316418882f + 1.0f;
    f32x2 t; t.x = __builtin_amdgcn_rcpf(d.x); t.y = __builtin_amdgcn_rcpf(d.y);
    f32x2 q = t * 0.5307027145f + (-0.7265760135f); q = q * t + 0.7107068705f; q = q * t + (-0.142248368f); q = q * t + 0.127414796f; q = q * t;
    const f32x2 s = (v * v) * (-0.72134752044f);
    f32x2 e; e.x = __builtin_amdgcn_exp2f(s.x); e.y = __builtin_amdgcn_exp2f(s.y);
    const f32x2 m = v * (q * e), r = v - m;
    f32x2 o; o.x = v.x < 0.f ? m.x : r.x; o.y = v.y < 0.f ? m.y : r.y; return o;
}

typedef int v8i __attribute__((ext_vector_type(8)));
typedef int v4i __attribute__((ext_vector_type(4)));
template <int ES, class Epi, class Sched>
__device__ __forceinline__ void gemm_phase_es(PG8_LAS unsigned char* lds, const void* Abase, const int K, const Sched& S, const Epi& E) {
    const int tid = threadIdx.x, wid = __builtin_amdgcn_readfirstlane(tid >> 6), lane = tid & 63, wr = wid >> 2, wc = wid & 3, fr = lane & 15, fq = lane >> 4;
    const int nt = K * ES / 128;
    int sR[2], sC[2]; unsigned voffA[2], voffB[2];
#pragma unroll
    for (int i = 0; i < 2; ++i) { stage_rc(tid * 16 + i * 8192, sR[i], sC[i]); const int Rb = Epi::PERM ? ((sR[i] & ~31) + perm32(sR[i] & 31)) : sR[i];
        voffA[i] = (unsigned)(sR[i] * K * ES + sC[i] * 2); voffB[i] = (unsigned)(Rb * K * ES + sC[i] * 2); }
    const size_t kstep = (size_t)(BK * 2);
    const size_t hstep = (size_t)HALF * K * ES;
    const unsigned ldsw = (unsigned)wid * 1024u;
    const int aoff = lds_byte(wr * 64 + fr, fq * (ES == 2 ? 8 : 16)), boff = lds_byte(wc * 32 + fr, fq * (ES == 2 ? 8 : 16));
    const char* const Ab = (const char*)Abase;
#define PG8_SA(b, h) (((b) * 2 + (h)) * HTB)
#define PG8_SB(b, h) ((4 + (b) * 2 + (h)) * HTB)
#define PG8_STAGE(bufoff, gbase, voff) do { _Pragma("unroll") for (int _i = 0; _i < 2; ++_i) \
        __builtin_amdgcn_global_load_lds((const unsigned*)((const char*)(gbase) + (voff)[_i]), (PG8_LAS unsigned*)(lds + (bufoff) + ldsw + _i * 8192), 16, 0, 0); } while (0)
#define PG8_STAGE_A(bufoff, nx, h, kt) do { if constexpr (Sched::GATHER) { PG8_STAGE(bufoff, Ab + (size_t)(kt) * kstep, gc[h]); } \
        else PG8_STAGE(bufoff, ((nx) ? xA : cA) + (size_t)(h) * hstep + (size_t)(kt) * kstep, voffA); } while (0)
#define PG8_LDA(dst, b, h) do { if constexpr (ES == 2) { _Pragma("unroll") for (int m = 0; m < 4; ++m) _Pragma("unroll") for (int k = 0; k < 2; ++k) dst[m][k] = *(const PG8_LAS bf16x8*)(lds + PG8_SA(b, h) + aoff + m * 2048 + k * 1024); } \
        else { _Pragma("unroll") for (int m = 0; m < 4; ++m) { const v4i lo_ = *(const PG8_LAS v4i*)(lds + PG8_SA(b, h) + aoff + m * 2048), hi_ = *(const PG8_LAS v4i*)(lds + PG8_SA(b, h) + aoff + m * 2048 + 16); dst##8[m] = __builtin_shufflevector(lo_, hi_, 0, 1, 2, 3, 4, 5, 6, 7); } } } while (0)
#define PG8_LDB(dst, b, h) do { if constexpr (ES == 2) { _Pragma("unroll") for (int n = 0; n < 2; ++n) _Pragma("unroll") for (int k = 0; k < 2; ++k) dst[n][k] = *(const PG8_LAS bf16x8*)(lds + PG8_SB(b, h) + boff + n * 2048 + k * 1024); } \
        else { _Pragma("unroll") for (int n = 0; n < 2; ++n) { const v4i lo_ = *(const PG8_LAS v4i*)(lds + PG8_SB(b, h) + boff + n * 2048), hi_ = *(const PG8_LAS v4i*)(lds + PG8_SB(b, h) + boff + n * 2048 + 16); dst##8[n] = __builtin_shufflevector(lo_, hi_, 0, 1, 2, 3, 4, 5, 6, 7); } } } while (0)
#define PG8_MMA(ai, bj, At, Bt) do { __builtin_amdgcn_s_setprio(1); if constexpr (ES == 2) { _Pragma("unroll") for (int m = 0; m < 4; ++m) _Pragma("unroll") for (int n = 0; n < 2; ++n) _Pragma("unroll") for (int k = 0; k < 2; ++k) \
        acc[ai][bj][m][n] = __builtin_amdgcn_mfma_f32_16x16x32_bf16(Bt[n][k], At[m][k], acc[ai][bj][m][n], 0, 0, 0); } \
        else { _Pragma("unroll") for (int m = 0; m < 4; ++m) _Pragma("unroll") for (int n = 0; n < 2; ++n) \
        asm volatile("s_nop 1\n\tv_mfma_f32_16x16x128_f8f6f4 %0, %1, %2, %0" : "+v"(acc[ai][bj][m][n]) : "v"(Bt##8[n]), "v"(At##8[m])); }   \
        __builtin_amdgcn_s_setprio(0); } while (0)
#define PG8_WAIT_V(n) asm volatile("s_waitcnt vmcnt(" #n ")" ::: "memory")
#define PG8_WAIT_L(n) asm volatile("s_waitcnt lgkmcnt(" #n ")" ::: "memory")
#define PG8_BAR __builtin_amdgcn_s_barrier()
#define PG8_SCHED __builtin_amdgcn_sched_barrier(0)
    Unit cur, nxt, prv; int ui = 0; bool have_prv = false;
    if (!S.next(0, cur)) return;
    f32x4 acc[2][2][4][2];
#pragma unroll
    for (int a = 0; a < 2; ++a)
#pragma unroll
        for (int b = 0; b < 2; ++b)
#pragma unroll
            for (int m = 0; m < 4; ++m)
#pragma unroll
                for (int n = 0; n < 2; ++n) acc[a][b][m][n] = (f32x4){0.f, 0.f, 0.f, 0.f};
    bf16x8 At[4][2], B0[2][2], B1[2][2]; v8i At8[4], B08[2], B18[2];
    unsigned gc[2][2];
    const char* cA = Ab; const char* xA = Ab;
    if constexpr (Sched::GATHER) {
#pragma unroll
        for (int h = 0; h < 2; ++h)
#pragma unroll
            for (int i = 0; i < 2; ++i) gc[h][i] = S.aoff(cur, h, sR[i], sC[i]);
    } else { cA = Ab + S.abase(cur); xA = cA; }
    const char* cB = S.bptr(cur);
    S.a_ready(cur);
    if constexpr (Epi::RS_DMA) { if (wid == 0) __builtin_amdgcn_global_load_lds((const unsigned*)((const char*)E.rs + (size_t)cur.pm * 1024 + lane * 16), (PG8_LAS unsigned*)(lds + STAGE_BYTES + 512), 16, 0, 0); }
    PG8_STAGE(PG8_SB(0, 0), cB, voffB); PG8_STAGE(PG8_SB(0, 1), cB + hstep, voffB); PG8_STAGE_A(PG8_SA(0, 0), false, 0, 0); PG8_STAGE_A(PG8_SA(0, 1), false, 1, 0);
    if (wr == 1) PG8_BAR;
    PG8_WAIT_V(2); PG8_BAR;
    PG8_STAGE(PG8_SB(1, 0), cB + kstep, voffB); PG8_STAGE_A(PG8_SA(1, 0), false, 0, 1); PG8_STAGE(PG8_SB(1, 1), cB + hstep + kstep, voffB);
    PG8_WAIT_V(6); PG8_BAR;
    for (;;) {
        const bool has_next = S.next(ui + 1, nxt);
        const char* nB = has_next ? S.bptr(nxt) : cB;
        if constexpr (Epi::RS_DMA) { if (has_next && wid == 0) __builtin_amdgcn_global_load_lds((const unsigned*)((const char*)E.rs + (size_t)nxt.pm * 1024 + lane * 16), (PG8_LAS unsigned*)(lds + STAGE_BYTES + 512 + ((ui + 1) % 3) * 1024), 16, 0, 0); }
        for (int t = 0; t < nt; t += 2) {
            const bool last = (t == nt - 2);
            const int kt2 = last ? 0 : t + 2;
            const char* b2 = last ? nB : cB + (size_t)(t + 2) * kstep; const char* b3 = b2 + kstep;
            if (last && has_next) {
                if constexpr (!Sched::GATHER) xA = Ab + S.abase(nxt);
                S.a_ready(nxt);
            }
            PG8_LDB(B0, 0, 0); PG8_LDB(B1, 0, 1); PG8_SCHED; PG8_LDA(At, 0, 0); PG8_STAGE_A(PG8_SA(1, 1), false, 1, t + 1);
            if constexpr (Sched::GATHER) { if (last && has_next) {
#pragma unroll
                for (int h = 0; h < 2; ++h)
#pragma unroll
                    for (int i = 0; i < 2; ++i) gc[h][i] = S.aoff(nxt, h, sR[i], sC[i]); } }
            PG8_WAIT_V(8); PG8_WAIT_L(0); PG8_BAR; PG8_MMA(0, 0, At, B0); PG8_MMA(0, 1, At, B1); PG8_BAR; PG8_SCHED;
            PG8_LDA(At, 0, 1); PG8_STAGE(PG8_SB(0, 0), b2, voffB); PG8_STAGE(PG8_SB(0, 1), b2 + hstep, voffB); PG8_STAGE_A(PG8_SA(0, 0), last, 0, kt2);
            PG8_WAIT_V(8); PG8_WAIT_L(0); PG8_BAR; PG8_MMA(1, 0, At, B0); PG8_MMA(1, 1, At, B1); PG8_BAR; PG8_SCHED;
            PG8_LDB(B0, 1, 0); PG8_LDB(B1, 1, 1); PG8_SCHED; PG8_LDA(At, 1, 0); PG8_STAGE_A(PG8_SA(0, 1), last, 1, kt2);
            PG8_WAIT_V(8); PG8_WAIT_L(0);
            if (have_prv) { S.done(prv); have_prv = false; }
            PG8_BAR; PG8_MMA(0, 0, At, B0); PG8_MMA(0, 1, At, B1); PG8_BAR; PG8_SCHED;
            PG8_LDA(At, 1, 1); PG8_STAGE(PG8_SB(1, 0), b3, voffB); PG8_STAGE(PG8_SB(1, 1), b3 + hstep, voffB); PG8_STAGE_A(PG8_SA(1, 0), last, 0, kt2 + 1);
            PG8_WAIT_V(8); PG8_WAIT_L(0); PG8_BAR; PG8_MMA(1, 0, At, B0); PG8_MMA(1, 1, At, B1); PG8_BAR; PG8_SCHED;
        }
        if (wr == 0) PG8_BAR;
        if constexpr (ES == 1) asm volatile("s_nop 15\n\ts_nop 15" ::: "memory");
        E(acc, cur, wr, wc, fr, fq, (const PG8_LAS float*)(lds + STAGE_BYTES + 512 + (ui % 3) * 1024)); prv = cur; have_prv = true;
        if (!has_next) break;
#pragma unroll
        for (int a = 0; a < 2; ++a)
#pragma unroll
            for (int b = 0; b < 2; ++b)
#pragma unroll
                for (int m = 0; m < 4; ++m)
#pragma unroll
                    for (int n = 0; n < 2; ++n) acc[a][b][m][n] = (f32x4){0.f, 0.f, 0.f, 0.f};
        cur = nxt; cB = nB; ++ui;
        if constexpr (!Sched::GATHER) cA = xA;
        if (wr == 1) PG8_BAR;
    }
    PG8_WAIT_V(0);
    if (have_prv) S.done(prv);
    PG8_BAR;
#undef PG8_STAGE_A
#undef PG8_SA
#undef PG8_SB
#undef PG8_STAGE
#undef PG8_LDA
#undef PG8_LDB
#undef PG8_MMA
#undef PG8_WAIT_V
#undef PG8_WAIT_L
#undef PG8_BAR
#undef PG8_SCHED
}
template <class Epi, class Sched>
__device__ __forceinline__ void gemm_phase(PG8_LAS unsigned char* lds, const bf16_t* Abase, const int K, const Sched& S, const Epi& E) { gemm_phase_es<2>(lds, Abase, K, S, E); }
}
constexpr int LX_PTR = 155648 - 256;
#define FTID ((int)threadIdx.x)
#define FLANE ((int)threadIdx.x & 63)
#define FWAVE ((int)__builtin_amdgcn_readfirstlane((int)threadIdx.x >> 6))
struct Frame {
    LAS unsigned char* lds;
    int G, bid;
    float* out; unsigned char* ws;
    __device__ __forceinline__ const float* inp(int i) const {
        const LAS unsigned* p = (const LAS unsigned*)(lds + LX_PTR) + 2 * i;
        const unsigned lo = __builtin_amdgcn_readfirstlane(p[0]), hi = __builtin_amdgcn_readfirstlane(p[1]);
        return (const float*)(((unsigned long long)hi << 32) | lo);
    }
};
enum { I_X = 0, I_GLA_NORM, I_GLA_WIN, I_GLA_WGU, I_GLA_BG, I_GLA_HG, I_GLA_WOUT, I_SGU_NORM, I_SGU_WIN, I_SGU_LNG, I_SGU_LNB, I_SGU_WS, I_SGU_BS, I_SGU_WOUT,
       I_MOE_NORM, I_MOE_WG, I_MOE_BG, I_MOE_WSUB, I_MOE_BSUB, I_MOE_W1, I_MOE_W3, I_MOE_W2, I_FINAL };
#define WSP(type, off) ((type*)(F.ws + (off)))

#define XB_TMO      128
#define XB_XCNT(j)  (256  + 64 * (j))
#define XB_XSUB(j)  (1280 + 64 * (j))
#define XB_XGEN(j)  (2304 + 64 * (j))
#define XB_TOP      3328
#define XB_TOPGEN   3392
#define XCD_BAR_WORDS 3456
#define XB_SPIN_CAP (1u << 18)

__device__ __forceinline__ unsigned xb_ld(unsigned* p)              { return __hip_atomic_load(p, __ATOMIC_RELAXED, __HIP_MEMORY_SCOPE_AGENT); }
__device__ __forceinline__ unsigned xb_add(unsigned* p, unsigned v) { return __hip_atomic_fetch_add(p, v, __ATOMIC_RELAXED, __HIP_MEMORY_SCOPE_AGENT); }
__device__ __forceinline__ unsigned xb_xcc_id() { return (unsigned)__builtin_amdgcn_s_getreg((3 << 11) | 20) & 0xFu; }
#define XB_SPIN(cond, bar) do { unsigned _sp = 0; while (cond) { __builtin_amdgcn_s_sleep(1); \
    if ((++_sp & 255u) == 0u) { if (xb_ld(&(bar)[XB_TMO])) break; if (_sp > XB_SPIN_CAP) { atomicAdd(&(bar)[XB_TMO], 1u); break; } } } } while (0)

struct XcdBarrier {
    unsigned* bar; unsigned x;
    volatile LAS unsigned* st;
};

__device__ __forceinline__ XcdBarrier xcd_barrier_post(unsigned* bar, volatile LAS unsigned* st) {
    XcdBarrier b; b.bar = bar; b.x = xb_xcc_id(); b.st = st;
    if (threadIdx.x == 0) (void)xb_add(&bar[XB_XCNT(b.x)], 1u);
    return b;
}
__device__ __forceinline__ void xcd_barrier_complete(unsigned* bar, unsigned x, unsigned& nloc, unsigned& nx) {
    const unsigned G = gridDim.x * gridDim.y * gridDim.z;
    unsigned sum, cnt, mine, sp = 0u;
    for (;;) {
        sum = 0u; cnt = 0u; mine = 0u;
#pragma unroll
        for (unsigned j = 0; j < 16; ++j) { const unsigned c = xb_ld(&bar[XB_XCNT(j)]); sum += c; cnt += (c > 0u) ? 1u : 0u; mine = (j == x) ? c : mine; }
        if (sum == G) break;
        __builtin_amdgcn_s_sleep(1);
        if ((++sp & 255u) == 0u) { if (xb_ld(&bar[XB_TMO])) break; if (sp > XB_SPIN_CAP) { atomicAdd(&bar[XB_TMO], 1u); break; } }
    }
    nloc = mine > 0u ? mine : 1u; nx = cnt > 0u ? cnt : 1u;
}

__device__ __forceinline__ void xcd_barrier(const XcdBarrier& b) {
    asm volatile("s_waitcnt vmcnt(0)" ::: "memory");
    __syncthreads();
    if (threadIdx.x == 0) {
        unsigned* bar = b.bar;
        __builtin_amdgcn_s_waitcnt(0);
        unsigned nloc = b.st[0], nx = b.st[1];
        if (nloc == 0u) { xcd_barrier_complete(bar, b.x, nloc, nx); b.st[0] = nloc; b.st[1] = nx; }
        const unsigned old = xb_add(&bar[XB_XSUB(b.x)], 1u);
        const unsigned gen = old / nloc;
        if (old + 1u == (gen + 1u) * nloc) {
            __builtin_amdgcn_fence(__ATOMIC_RELEASE, "agent");
            asm volatile("s_waitcnt vmcnt(0)" ::: "memory");
            const unsigned og = xb_add(&bar[XB_TOP], 1u);
            const unsigned tg = og / nx;
            if (og + 1u == (tg + 1u) * nx) xb_add(&bar[XB_TOPGEN], 1u);
            else XB_SPIN(xb_ld(&bar[XB_TOPGEN]) == tg, bar);
            __builtin_amdgcn_fence(__ATOMIC_ACQUIRE, "agent");
            xb_add(&bar[XB_XGEN(b.x)], 1u);
            asm volatile("s_waitcnt vmcnt(0)" ::: "memory");
        } else {
            XB_SPIN(xb_ld(&bar[XB_XGEN(b.x)]) == gen, bar);
            __builtin_amdgcn_fence(__ATOMIC_ACQUIRE, "agent");
            asm volatile("s_waitcnt vmcnt(0)" ::: "memory");
        }
    }
    __syncthreads();
}
constexpr int RING_BYTES = 131072;
constexpr int LX_TST = RING_BYTES;
constexpr int MOE_MAXU = 6;
constexpr int LX_TAB = RING_BYTES + 512;
constexpr int LX_GT = LX_TAB + MOE_MAXU * 1024;

struct EpiStoreBf16 {
    static constexpr bool RS_DMA = true;
    static constexpr bool PERM = true;
    bf16* O; int ldc; const float* rs; int silu_from;
    __device__ __forceinline__ void operator()(const pg8::f32x4 (&acc)[2][2][4][2], const pg8::Unit& u, int wr, int wc, int fr, int fq, const LAS float* rsl) const {
        const int row0 = u.pm * 256 + wr * 64 + fr, col0 = u.pn * 256 + wc * 32 + 8 * fq;
#pragma unroll
        for (int ai = 0; ai < 2; ++ai)
#pragma unroll
            for (int m = 0; m < 4; ++m) { const int row = row0 + ai * 128 + m * 16; bf16* rowp = O + (size_t)row * ldc + col0; const float sc = rsl[ai * 128 + wr * 64 + m * 16 + fr];
#pragma unroll
                for (int bj = 0; bj < 2; ++bj) { pg8::f32x4 v0 = acc[ai][bj][m][0] * sc, v1 = acc[ai][bj][m][1] * sc;
                    if (silu_from >= 0 && u.pn >= silu_from) {
#pragma unroll
                        for (int i = 0; i < 4; ++i) { v0[i] = v0[i] * __builtin_amdgcn_rcpf(1.f + __expf(-v0[i])); v1[i] = v1[i] * __builtin_amdgcn_rcpf(1.f + __expf(-v1[i])); } }
                    v4u w; w.x = pg8::cvt_pk_bf16(v0[0], v0[1]); w.y = pg8::cvt_pk_bf16(v0[2], v0[3]); w.z = pg8::cvt_pk_bf16(v1[0], v1[1]); w.w = pg8::cvt_pk_bf16(v1[2], v1[3]);
                    *(v4u*)(rowp + bj * 128) = w; } }
    }
};
struct EpiResBf16 {
    static constexpr bool RS_DMA = false;
    static constexpr bool PERM = true;
    bf16* X;
    __device__ __forceinline__ void operator()(const pg8::f32x4 (&acc)[2][2][4][2], const pg8::Unit& u, int wr, int wc, int fr, int fq, const LAS float* rsl) const {
        const int row0 = u.pm * 256 + wr * 64 + fr, col0 = u.pn * 256 + wc * 32 + 8 * fq;
#pragma unroll
        for (int ai = 0; ai < 2; ++ai)
#pragma unroll
            for (int m = 0; m < 4; ++m) { bf16* rowp = X + (size_t)(row0 + ai * 128 + m * 16) * D + col0;
#pragma unroll
                for (int bj = 0; bj < 2; ++bj) { const v4u r = *(const v4u*)(rowp + bj * 128); const pg8::f32x4 v0 = acc[ai][bj][m][0], v1 = acc[ai][bj][m][1];
                    v4u w; w.x = pg8::cvt_pk_bf16(bflo(r.x) + v0[0], bfhi(r.x) + v0[1]); w.y = pg8::cvt_pk_bf16(bflo(r.y) + v0[2], bfhi(r.y) + v0[3]);
                    w.z = pg8::cvt_pk_bf16(bflo(r.z) + v1[0], bfhi(r.z) + v1[1]); w.w = pg8::cvt_pk_bf16(bflo(r.w) + v1[2], bfhi(r.w) + v1[3]);
                    *(v4u*)(rowp + bj * 128) = w; } }
    }
};
struct EpiGeluSplit {
    static constexpr bool RS_DMA = true;
    static constexpr bool PERM = true;
    bf16* U; bf16* V; float* st; const float* rs;
    __device__ __forceinline__ void operator()(const pg8::f32x4 (&acc)[2][2][4][2], const pg8::Unit& u, int wr, int wc, int fr, int fq, const LAS float* rsl) const {
        const bool isv = u.pn >= 8; const int pnl = isv ? u.pn - 8 : u.pn;
        bf16* O = isv ? V : U;
        const int row0 = u.pm * 256 + wr * 64 + fr, col0 = pnl * 256 + wc * 32 + 8 * fq;
#pragma unroll
        for (int ai = 0; ai < 2; ++ai)
#pragma unroll
            for (int m = 0; m < 4; ++m) { const int row = row0 + ai * 128 + m * 16; bf16* rowp = O + (size_t)row * SGU_HALF + col0; float s = 0.f, q = 0.f; const float sc = rsl[ai * 128 + wr * 64 + m * 16 + fr];
#pragma unroll
                for (int bj = 0; bj < 2; ++bj) { const pg8::f32x4 v0 = acc[ai][bj][m][0] * sc, v1 = acc[ai][bj][m][1] * sc;
                    const pg8::f32x2 a = pg8::gelu_pk((pg8::f32x2){v0[0], v0[1]}), b = pg8::gelu_pk((pg8::f32x2){v0[2], v0[3]}), c = pg8::gelu_pk((pg8::f32x2){v1[0], v1[1]}), d = pg8::gelu_pk((pg8::f32x2){v1[2], v1[3]});
                    s += (a.x + a.y) + (b.x + b.y) + (c.x + c.y) + (d.x + d.y);
                    q += (a.x * a.x + a.y * a.y) + (b.x * b.x + b.y * b.y) + (c.x * c.x + c.y * c.y) + (d.x * d.x + d.y * d.y);
                    v4u w; w.x = pg8::cvt_pk_bf16(a.x, a.y); w.y = pg8::cvt_pk_bf16(b.x, b.y); w.z = pg8::cvt_pk_bf16(c.x, c.y); w.w = pg8::cvt_pk_bf16(d.x, d.y);
                    *(v4u*)(rowp + bj * 128) = w; }
                if (isv) { s += __shfl_xor(s, 16); s += __shfl_xor(s, 32); q += __shfl_xor(q, 16); q += __shfl_xor(q, 32);
                    if (fq == 0) { pg8::f32x2 o = {s, q}; *(pg8::f32x2*)(st + ((size_t)(pnl * 4 + wc) * T + row) * 2) = o; } } }
    }
};

__device__ __forceinline__ void f_gemm_in(Frame& F) {
    pg8::DenseOrder S; S.init(T, NQKVR, D, WSP(bf16, WS_WIN), F.G, F.bid);
    EpiStoreBf16 E{WSP(bf16, WS_QKVR), NQKVR, WSP(float, WS_RS), 8};
    pg8::gemm_phase(F.lds, WSP(bf16, WS_XN), D, S, E);
}
struct RowSetOrder {
    static constexpr bool GATHER = false;
    int nb, c, j0, nunits, K; const char* Bt;
    __device__ __forceinline__ bool next(int i, pg8::Unit& u) const {
        if (c < 0) return false;
        const int q = i * nb + c; if (q >= nunits) return false;
        u.pm = ((q & 63) >> 2) * 8 + j0 + (q >> 6); u.pn = q & 3; u.e = 0; u.slot = 0; return true;
    }
    __device__ __forceinline__ const char* bptr(const pg8::Unit& u) const { return Bt + (size_t)u.pn * 256 * K * 2; }
    __device__ __forceinline__ size_t abase(const pg8::Unit& u) const { return (size_t)u.pm * 256 * K * 2; }
    __device__ __forceinline__ unsigned aoff(const pg8::Unit&, int, int, int) const { return 0u; }
    __device__ __forceinline__ void a_ready(const pg8::Unit&) const {}
    __device__ __forceinline__ void done(const pg8::Unit&) const {}
};
__device__ __forceinline__ void f_gemm_out_rows(Frame& F, int j0, int j1, int boff) {
    RowSetOrder S; S.nb = F.G - boff; S.c = F.bid - boff; S.j0 = j0; S.nunits = (j1 - j0) * 64; S.K = HV; S.Bt = (const char*)WSP(bf16, WS_WOUT);
    EpiResBf16 E{WSP(bf16, WS_XN)};
    pg8::gemm_phase(F.lds, WSP(bf16, WS_AOUT), HV, S, E);
}
__device__ __forceinline__ void f_gemm_sgu_in(Frame& F) {
    pg8::DenseOrder S; S.init(T, SGU_FFN, D, WSP(bf16, WS_WSIN), F.G, F.bid);
    EpiGeluSplit E{WSP(bf16, WS_U), WSP(bf16, WS_V), WSP(float, WS_STATS), WSP(float, WS_RS)};
    pg8::gemm_phase(F.lds, WSP(bf16, WS_XN), D, S, E);
}
__device__ __forceinline__ void f_gemm_sgu_out(Frame& F) {
    pg8::DenseOrder S; S.init(T, D, SGU_HALF, WSP(bf16, WS_WSOUT), F.G, F.bid);
    EpiResBf16 E{WSP(bf16, WS_XN)};
    pg8::gemm_phase(F.lds, WSP(bf16, WS_U), SGU_HALF, S, E);
}

template <bool GATHER_> struct MoeOrder {
    static constexpr bool GATHER = GATHER_;
    int G, c, nunits, ibase, K, rowb, mode;
    const char* W; size_t estride;
    LAS const int* tst; LAS const int* tab; unsigned* hcnt; unsigned rdy;
    int n5, rb;
    __device__ __forceinline__ bool next(int i, pg8::Unit& u) const {
        if (i >= MOE_MAXU) return false;
        const int ii = ibase + i; int Lu;
        if (GATHER || n5 <= 0 || ii < rb) Lu = ii * G + c;
        else { if (c < n5) return false; Lu = rb * G + (ii - rb) * (G - n5) + (c - n5); }
        if (Lu >= nunits) return false;
        const int rt = Lu >> 2; int e = 0;
        while (e < NE - 1 && tst[e + 1] <= rt) ++e;
        u.pm = rt; u.pn = Lu & 3; u.e = e; u.slot = i; return true;
    }
    __device__ __forceinline__ const char* bptr(const pg8::Unit& u) const { return W + (size_t)u.e * estride + (size_t)u.pn * 256 * rowb; }
    __device__ __forceinline__ size_t abase(const pg8::Unit& u) const { return (size_t)u.pm * 256 * rowb; }
    __device__ __forceinline__ unsigned aoff(const pg8::Unit& u, int h, int R, int C) const {
        if (mode == 0) { int ent = tab[u.slot * 256 + h * 128 + R]; ent = ent < 0 ? 0 : ent; return (unsigned)((ent >> 1) * rowb + C * 2); }
        return (unsigned)((u.pm * 256 + h * 128 + R) * rowb + C * 2);
    }
    __device__ __forceinline__ void a_ready(const pg8::Unit& u) const {
        if (GATHER || ((rdy >> u.slot) & 1u)) return;
        if (threadIdx.x < 64) {
            unsigned spins = 0;
            while ((unsigned)__builtin_amdgcn_readfirstlane(__hip_atomic_load(hcnt + 16 * u.pm, __ATOMIC_RELAXED, __HIP_MEMORY_SCOPE_AGENT)) < 32u) { __builtin_amdgcn_s_sleep(2); if (++spins > (1u << 20)) break; }
            __builtin_amdgcn_fence(__ATOMIC_ACQUIRE, "agent");
            asm volatile("s_waitcnt vmcnt(0)" ::: "memory");
        }
        asm volatile("" ::: "memory"); __builtin_amdgcn_s_barrier(); asm volatile("" ::: "memory");
    }
    __device__ __forceinline__ void done(const pg8::Unit& u) const {
        if (!GATHER) return;
        if ((threadIdx.x & 63) == 0) __hip_atomic_fetch_add(hcnt + 16 * u.pm, 1u, __ATOMIC_RELAXED, __HIP_MEMORY_SCOPE_AGENT);
    }
};
struct EpiSwiglu {
    static constexpr bool RS_DMA = false;
    static constexpr bool PERM = true;
    unsigned char* H; LAS const float* gt;
    __device__ __forceinline__ void operator()(const pg8::f32x4 (&acc)[2][2][4][2], const pg8::Unit& u, int wr, int wc, int fr, int fq, const LAS float* rsl) const {
        const __amdgpu_buffer_rsrc_t hrs = __builtin_amdgcn_make_buffer_rsrc((void*)H, (short)0, 73728 * FF, 0x00020000);
        const int row0 = u.pm * 256 + wr * 64 + fr, col0 = u.pn * 128 + wc * 32 + 8 * fq;
#pragma unroll
        for (int ai = 0; ai < 2; ++ai)
#pragma unroll
            for (int m = 0; m < 4; ++m) { float h[8]; const float sc = gt[u.slot * 256 + ai * 128 + wr * 64 + m * 16 + fr] * (1.f / MOE_WSCALE);
#pragma unroll
                for (int n = 0; n < 2; ++n)
#pragma unroll
                    for (int i = 0; i < 4; ++i) { const float a = acc[ai][0][m][n][i] * sc, b = acc[ai][1][m][n][i] * sc; h[n * 4 + i] = a * __builtin_amdgcn_rcpf(1.f + __expf(-a)) * b; }
                int w0 = __builtin_amdgcn_cvt_pk_fp8_f32(h[0], h[1], 0, false); w0 = __builtin_amdgcn_cvt_pk_fp8_f32(h[2], h[3], w0, true);
                int w1 = __builtin_amdgcn_cvt_pk_fp8_f32(h[4], h[5], 0, false); w1 = __builtin_amdgcn_cvt_pk_fp8_f32(h[6], h[7], w1, true);
                v2u w; w.x = (unsigned)w0; w.y = (unsigned)w1;
                __builtin_amdgcn_raw_buffer_store_b64(w, hrs, (row0 + ai * 128 + m * 16) * FF + col0, 0, 16); }
    }
};
struct EpiScatterY {
    static constexpr bool RS_DMA = false;
    static constexpr bool PERM = true;
    unsigned char* Y; LAS const int* tab; LAS const float* gt;
    __device__ __forceinline__ void operator()(const pg8::f32x4 (&acc)[2][2][4][2], const pg8::Unit& u, int wr, int wc, int fr, int fq, const LAS float* rsl) const {
        const int col0 = u.pn * 256 + wc * 32 + 8 * fq;
#pragma unroll
        for (int ai = 0; ai < 2; ++ai)
#pragma unroll
            for (int m = 0; m < 4; ++m) { const int r = ai * 128 + wr * 64 + m * 16 + fr; const int ent = tab[u.slot * 256 + r]; const float g = gt[u.slot * 256 + r] * (1.f / MOE_WSCALE);
                if (ent >= 0) { unsigned char* rowp = Y + ((size_t)(ent & 1) * T + (ent >> 1)) * D + col0;
#pragma unroll
                    for (int bj = 0; bj < 2; ++bj) { const pg8::f32x4 v0 = acc[ai][bj][m][0] * g, v1 = acc[ai][bj][m][1] * g;
                        int w0 = __builtin_amdgcn_cvt_pk_fp8_f32(v0[0], v0[1], 0, false); w0 = __builtin_amdgcn_cvt_pk_fp8_f32(v0[2], v0[3], w0, true);
                        int w1 = __builtin_amdgcn_cvt_pk_fp8_f32(v1[0], v1[1], 0, false); w1 = __builtin_amdgcn_cvt_pk_fp8_f32(v1[2], v1[3], w1, true);
                        v2u w; w.x = (unsigned)w0; w.y = (unsigned)w1; *(v2u*)(rowp + bj * 128) = w; } } }
    }
};
template <int MODE> __device__ __forceinline__ void f_moe_gemm(Frame& F, int L, LAS int* tst, LAS int* cntl) {
    LAS int* tab = (LAS int*)(F.lds + LX_TAB); LAS float* gt = (LAS float*)(F.lds + LX_GT);
    MoeOrder<MODE == 0> S; S.G = F.G; S.c = F.bid; S.nunits = 4 * tst[NE]; S.K = MODE == 0 ? D : FF; S.rowb = S.K; S.mode = MODE; S.tst = tst; S.tab = tab;
    S.hcnt = WSP(unsigned, WS_CTL) + CW_HID + L * 4608;
    { const int r1 = (S.nunits + F.G - 1) / F.G, nlast = S.nunits - (r1 - 1) * F.G;
      S.n5 = (MODE == 1 && r1 >= 3 && nlast < F.G) ? nlast : 0; S.rb = r1 - 2; }
    S.W = MODE == 0 ? (const char*)(WSP(unsigned char, WS_W13) + (size_t)L * NE * 1024 * 1024) : (const char*)(WSP(unsigned char, WS_W2) + (size_t)L * NE * 1024 * 512);
    S.estride = MODE == 0 ? (size_t)1024 * 1024 : (size_t)1024 * 512;
    const int* list = WSP(int, WS_LIST); const float* gates = WSP(float, WS_GATE);
    for (int ibase = 0; ibase * (S.n5 > 0 ? F.G - S.n5 : F.G) < S.nunits; ibase += MOE_MAXU) {
        S.ibase = ibase;
        {
            static_assert(MOE_MAXU == 6, "three table slots per thread half");
            int ents[3]; float gsv[3]; const int r = FTID & 255, hsel = FTID >> 8;
#pragma unroll
            for (int k = 0; k < 3; ++k) { pg8::Unit u; ents[k] = -1;
                if (S.next(2 * k + hsel, u)) { const int idx = (u.pm - tst[u.e]) * 256 + r; if (idx < cntl[u.e]) ents[k] = list[(size_t)u.e * T + idx]; } }
#pragma unroll
            for (int k = 0; k < 3; ++k) gsv[k] = ents[k] >= 0 ? (MODE == 0 ? WSP(float, WS_RS)[ents[k] >> 1] : gates[ents[k]]) : 0.f;
#pragma unroll
            for (int k = 0; k < 3; ++k) { tab[(2 * k + hsel) * 256 + r] = ents[k]; gt[(2 * k + hsel) * 256 + r] = gsv[k]; }
        }
        S.rdy = 0u;
        if (MODE == 1) {
            LAS unsigned* rdyw = (LAS unsigned*)(F.lds + LX_TST + 448);
            if (FTID < 64) { unsigned m = 0u;
                for (int i = 0; i < MOE_MAXU; ++i) { pg8::Unit u; if (S.next(i, u) && (unsigned)__builtin_amdgcn_readfirstlane(__hip_atomic_load(S.hcnt + 16 * u.pm, __ATOMIC_RELAXED, __HIP_MEMORY_SCOPE_AGENT)) >= 32u) m |= 1u << i; }
                __builtin_amdgcn_fence(__ATOMIC_ACQUIRE, "agent"); asm volatile("s_waitcnt vmcnt(0)" ::: "memory");
                if (FTID == 0) *rdyw = m; }
            __syncthreads();
            S.rdy = *rdyw;
        }
        __syncthreads();
        if (MODE == 0) { EpiSwiglu E{WSP(unsigned char, WS_HID), gt}; pg8::gemm_phase_es<1>(F.lds, WSP(unsigned char, WS_XB8), D, S, E); }
        else { EpiScatterY E{WSP(unsigned char, WS_Y), tab, gt}; pg8::gemm_phase_es<1>(F.lds, WSP(unsigned char, WS_HID), FF, S, E); }
        __syncthreads();
    }
}
__device__ __forceinline__ void f_moe(Frame& F, int L) {
    LAS int* tst = (LAS int*)(F.lds + LX_TST); LAS int* cntl = tst + 64;
    unsigned* ctl = WSP(unsigned, WS_CTL);
    __syncthreads();
    if (FTID < NE) cntl[FTID] = (int)__hip_atomic_load(&ctl[CW_CNT + L * 2048 + 64 * FTID], __ATOMIC_RELAXED, __HIP_MEMORY_SCOPE_AGENT);
    __syncthreads();
    if (FTID == 0) { int s = 0; for (int e = 0; e < NE; ++e) { tst[e] = s; s += (cntl[e] + 255) >> 8; } tst[NE] = s; }
    __syncthreads();
    f_moe_gemm<0>(F, L, tst, cntl);
    f_moe_gemm<1>(F, L, tst, cntl);
}
__device__ __forceinline__ void transpose_item(const float* W, int ldw, const float* kscale, float cs, bf16* WT, int K, int dst_row0, LAS float* scr, int k0, int n0, int lane) {
    f32x4 x[8]; float ks[8];
    const int kr = lane >> 3, n4 = (lane & 7) * 4;
#pragma unroll
    for (int i = 0; i < 8; ++i) { x[i] = *(const f32x4*)(W + (size_t)(k0 + 8 * i + kr) * ldw + n0 + n4); ks[i] = kscale ? kscale[k0 + 8 * i + kr] * cs : cs; }
#pragma unroll
    for (int i = 0; i < 8; ++i) { LAS float* d = scr + (8 * i + kr) * 33 + n4; d[0] = x[i][0] * ks[i]; d[1] = x[i][1] * ks[i]; d[2] = x[i][2] * ks[i]; d[3] = x[i][3] * ks[i]; }
    LDS_WAIT(); asm volatile("" ::: "memory");
    const int c = lane & 7;
#pragma unroll
    for (int j = 0; j < 4; ++j) { const int n = (lane >> 3) + 8 * j; const LAS float* s = scr + (8 * c) * 33 + n;
        v4u o; o.x = pk2(s[0 * 33], s[1 * 33]); o.y = pk2(s[2 * 33], s[3 * 33]); o.z = pk2(s[4 * 33], s[5 * 33]); o.w = pk2(s[6 * 33], s[7 * 33]);
        *(v4u*)(WT + (size_t)(dst_row0 + n) * K + k0 + 8 * c) = o; }
    LDS_WAIT(); asm volatile("" ::: "memory");
}
__device__ __forceinline__ void transpose_item8(const float* W, int ldw, const float* kscale, float cs, unsigned char* WT, int K, int dst_row0, LAS float* scr, int k0, int n0, int lane) {
    f32x4 x[8]; float ks[8];
    const int kr = lane >> 3, n4 = (lane & 7) * 4;
#pragma unroll
    for (int i = 0; i < 8; ++i) { x[i] = *(const f32x4*)(W + (size_t)(k0 + 8 * i + kr) * ldw + n0 + n4); ks[i] = kscale ? kscale[k0 + 8 * i + kr] * cs : cs; }
#pragma unroll
    for (int i = 0; i < 8; ++i) { LAS float* d = scr + (8 * i + kr) * 33 + n4; d[0] = x[i][0] * ks[i]; d[1] = x[i][1] * ks[i]; d[2] = x[i][2] * ks[i]; d[3] = x[i][3] * ks[i]; }
    LDS_WAIT(); asm volatile("" ::: "memory");
    const int c = lane & 7;
#pragma unroll
    for (int j = 0; j < 4; ++j) { const int n = (lane >> 3) + 8 * j; const LAS float* s = scr + (8 * c) * 33 + n;
        int w0 = __builtin_amdgcn_cvt_pk_fp8_f32(s[0 * 33], s[1 * 33], 0, false); w0 = __builtin_amdgcn_cvt_pk_fp8_f32(s[2 * 33], s[3 * 33], w0, true);
        int w1 = __builtin_amdgcn_cvt_pk_fp8_f32(s[4 * 33], s[5 * 33], 0, false); w1 = __builtin_amdgcn_cvt_pk_fp8_f32(s[6 * 33], s[7 * 33], w1, true);
        v2u o; o.x = (unsigned)w0; o.y = (unsigned)w1; *(v2u*)(WT + (size_t)(dst_row0 + n) * K + k0 + 8 * c) = o; }
    LDS_WAIT(); asm volatile("" ::: "memory");
}
__device__ __forceinline__ void convert_job_item8(const float* W, int ldw, int K, int N, const float* kscale, float cs, unsigned char* WT, int rowmap, LAS float* scr, int item, int lane) {
    const int nblk = N / 32, kb = item / nblk, nb = item % nblk, k0 = 64 * kb, n0 = 32 * nb;
    const int dr = rowmap == 0 ? n0 : ((n0 >> 7) * 256 + (n0 & 127) + (rowmap == 2 ? 128 : 0));
    transpose_item8(W, ldw, kscale, cs, WT, K, dr, scr, k0, n0, lane);
}
__device__ __forceinline__ void convert_job_item(const float* W, int ldw, int K, int N, const float* kscale, int qcols, float qs, bf16* WT, int rowmap, LAS float* scr, int item, int lane) {
    const int nblk = N / 32, kb = item / nblk, nb = item % nblk, k0 = 64 * kb, n0 = 32 * nb;
    const int dr = rowmap == 0 ? n0 : ((n0 >> 7) * 256 + (n0 & 127) + (rowmap == 2 ? 128 : 0));
    transpose_item(W, ldw, kscale, n0 < qcols ? qs : 1.f, WT, K, dr, scr, k0, n0, lane);
}
__device__ __forceinline__ void f_convert_gla(Frame& F) {
    LAS float* scr = (LAS float*)(F.lds + FWAVE * 8448);
    const int gw = F.bid * NWAVES + FWAVE, NGW = F.G * NWAVES;
    constexpr int I0 = (D / 64) * (NQKVR / 32), I1 = (HV / 64) * (D / 32);
    for (int it = gw; it < I0 + I1; it += NGW) {
        if (it < I0) convert_job_item(F.inp(I_GLA_WIN), GLA_IN, D, NQKVR, F.inp(I_GLA_NORM), HK, 0.08838834764831845f, WSP(bf16, WS_WIN), 0, scr, it, FLANE);
        else convert_job_item(F.inp(I_GLA_WOUT), D, HV, D, F.inp(I_GLA_HG), 0, 1.f, WSP(bf16, WS_WOUT), 0, scr, it - I0, FLANE);
    }
}
__device__ __forceinline__ void f_convert_rest(Frame& F, int cw, int NCW, int pct0 = 0, int pct1 = 1000) {
    LAS float* scr = (LAS float*)(F.lds + FWAVE * 8448);
    constexpr int I0 = (D / 64) * (SGU_FFN / 32), I1 = (SGU_HALF / 64) * (D / 32), IE1 = (D / 64) * (FF / 32), IE2 = (FF / 64) * (D / 32);
    constexpr int IM = 2 * NE * IE1;
    static_assert(IE1 == IE2, "w1 / w2 item counts");
    constexpr int NIT = I0 + I1 + 3 * IM; const int it_lo = (int)((long)NIT * pct0 / 1000), it_hi = (int)((long)NIT * pct1 / 1000);
    for (int it = it_lo + cw; it < it_hi; it += NCW) {
        int r = it;
        if (r < I0) { convert_job_item(F.inp(I_SGU_WIN), SGU_FFN, D, SGU_FFN, F.inp(I_SGU_NORM), 0, 1.f, WSP(bf16, WS_WSIN), 0, scr, r, FLANE); continue; } r -= I0;
        if (r < I1) { convert_job_item(F.inp(I_SGU_WOUT), D, SGU_HALF, D, nullptr, 0, 1.f, WSP(bf16, WS_WSOUT), 0, scr, r, FLANE); continue; } r -= I1;
        const int which = r / IM; r -= which * IM; const int le = r / IE1, li = r % IE1, L = le / NE;
        if (which == 0) convert_job_item8(F.inp(I_MOE_W1) + (size_t)le * D * FF, FF, D, FF, F.inp(I_MOE_NORM) + L * D, MOE_WSCALE, WSP(unsigned char, WS_W13) + (size_t)le * 1024 * 1024, 1, scr, li, FLANE);
        else if (which == 1) convert_job_item8(F.inp(I_MOE_W3) + (size_t)le * D * FF, FF, D, FF, F.inp(I_MOE_NORM) + L * D, MOE_WSCALE, WSP(unsigned char, WS_W13) + (size_t)le * 1024 * 1024, 2, scr, li, FLANE);
        else convert_job_item8(F.inp(I_MOE_W2) + (size_t)le * FF * D, D, FF, D, nullptr, MOE_WSCALE, WSP(unsigned char, WS_W2) + (size_t)le * 1024 * 512, 0, scr, li, FLANE);
    }
}

constexpr int SC_K = 0, SC_KSTR = 320;
constexpr int SC_V = 20480, SC_VSTR = 576;
constexpr int SC_Q = 57344, SC_QSTR = 272;
constexpr int SC_O = 74752, SC_OSTR = 528;
constexpr int SC_GL = 108544, SC_PART = 112640, SC_DEC = 114688, SC_WG = 115200;
__device__ __forceinline__ s16x4 tr_read16(LAS const unsigned char* p) {
    typedef short v4i16_t __attribute__((ext_vector_type(4)));
    return __builtin_bit_cast(s16x4, __builtin_amdgcn_ds_read_tr16_b64_v4i16((LAS v4i16_t*)p));
}
__device__ __forceinline__ void f_scan_item(Frame& F, int item, const XcdBarrier* xb_ = nullptr, int cbar = -1) {
    const int b = item / GLA_H, h = item % GLA_H;
    const bf16* qkvr = WSP(bf16, WS_QKVR); const float* glr = WSP(float, WS_GLR); bf16* aout = WSP(bf16, WS_AOUT);
    LAS unsigned char* L = F.lds;
    LAS float* gl = (LAS float*)(L + SC_GL); LAS float* part = (LAS float*)(L + SC_PART); LAS float* dec = (LAS float*)(L + SC_DEC);
    const int tid = FTID, lane = FLANE, w = FWAVE;
    const int r32 = lane & 31, hh = lane >> 5, blk = (lane >> 4) & 1, q4 = (lane & 15) >> 2, p4 = lane & 3;
    const int dk = tid & 127, tg = tid >> 7;
    const int gq = lane >> 4, gcol = lane & 15, gdk = 16 * w + gcol;
    bf16x8 gBh, gBl;
    { unsigned ph[4], pl[4];
#pragma unroll
      for (int j = 0; j < 4; ++j) { const float x0 = gq < 2 ? F.inp(I_GLA_WGU)[(8 * gq + 2 * j) * HK + h * DK + gdk] : 0.f, x1 = gq < 2 ? F.inp(I_GLA_WGU)[(8 * gq + 2 * j + 1) * HK + h * DK + gdk] : 0.f;
          ph[j] = pk2(x0, x1); pl[j] = pk2(x0 - bflo(ph[j]), x1 - bfhi(ph[j])); }
      v4u vh = {ph[0], ph[1], ph[2], ph[3]}, vl = {pl[0], pl[1], pl[2], pl[3]};
      gBh = __builtin_bit_cast(bf16x8, vh); gBl = __builtin_bit_cast(bf16x8, vl); }
    const float gbias = F.inp(I_GLA_BG)[h * DK + gdk];
    __syncthreads();
    f32x16 st[4];
#pragma unroll
    for (int i = 0; i < 4; ++i)
#pragma unroll
        for (int j = 0; j < 16; ++j) st[i][j] = 0.f;
    v4u rk[2], rq[2], rv[4]; f32x4 rg;
    const size_t rowb = (size_t)b * SEQ;
    const unsigned vo_kq = (unsigned)(((tid >> 4) * NQKVR + (tid & 15) * 8) * 2), vo_v = (unsigned)(((tid >> 5) * NQKVR + (tid & 31) * 8) * 2), vo_g = (unsigned)(tid * 16);
    const unsigned lo_k = (unsigned)(SC_K + (tid >> 4) * SC_KSTR + (tid & 15) * 16), lo_q = (unsigned)(SC_Q + (tid >> 4) * SC_QSTR + (tid & 15) * 16), lo_v = (unsigned)(SC_V + (tid >> 5) * SC_VSTR + (tid & 31) * 16);
#define SC_LOAD(c) do { size_t cb_ = (rowb + (size_t)(c) * CHUNK) * NQKVR * 2; asm volatile("" : "+s"(cb_)); const char* gb_ = (const char*)qkvr + cb_ + (size_t)(h * DK * 2); \
        _Pragma("unroll") for (int i = 0; i < 2; ++i) { \
            rk[i] = *(const v4u*)(gb_ + (size_t)(HK * 2 + i * 32 * NQKVR * 2) + vo_kq); rq[i] = *(const v4u*)(gb_ + (size_t)(i * 32 * NQKVR * 2) + vo_kq); } \
        _Pragma("unroll") for (int i = 0; i < 4; ++i) rv[i] = *(const v4u*)(gb_ + (size_t)(2 * HK * 2 + h * (DV - DK) * 2 + i * 16 * NQKVR * 2) + vo_v); \
        if (tid < 256) rg = *(const f32x4*)((const char*)glr + (rowb + (size_t)(c) * CHUNK) * RANK * 4 + vo_g); } while (0)
#define SC_STORE() do { \
        _Pragma("unroll") for (int i = 0; i < 2; ++i) { *(LAS v4u*)(L + lo_k + i * 32 * SC_KSTR) = rk[i]; *(LAS v4u*)(L + lo_q + i * 32 * SC_QSTR) = rq[i]; } \
        _Pragma("unroll") for (int i = 0; i < 4; ++i) *(LAS v4u*)(L + lo_v + i * 16 * SC_VSTR) = rv[i]; \
        if (tid < 256) *(LAS f32x4*)(gl + tid * 4) = rg; } while (0)
    SC_LOAD(0);
    SC_STORE();
    for (int c = 0; c < NCHUNK; ++c) {
        if (c == cbar) xcd_barrier(*xb_);
        const size_t t0 = rowb + (size_t)c * CHUNK;
        __syncthreads();
        if (c + 1 < NCHUNK) SC_LOAD(c + 1);
        {
            pg8::f32x4 g4[4]; float tsum[4], pre[4];
#pragma unroll
            for (int t = 0; t < 4; ++t) {
                v4u ah = {0u, 0u, 0u, 0u}, al = {0u, 0u, 0u, 0u};
                if (gq < 2) { const f32x4 x0 = *(const LAS f32x4*)(gl + (16 * t + gcol) * 16 + 8 * gq), x1 = *(const LAS f32x4*)(gl + (16 * t + gcol) * 16 + 8 * gq + 4);
                    ah.x = pk2(x0[0], x0[1]); ah.y = pk2(x0[2], x0[3]); ah.z = pk2(x1[0], x1[1]); ah.w = pk2(x1[2], x1[3]);
                    al.x = pk2(x0[0] - bflo(ah.x), x0[1] - bfhi(ah.x)); al.y = pk2(x0[2] - bflo(ah.y), x0[3] - bfhi(ah.y)); al.z = pk2(x1[0] - bflo(ah.z), x1[1] - bfhi(ah.z)); al.w = pk2(x1[2] - bflo(ah.w), x1[3] - bfhi(ah.w)); }
                pg8::f32x4 a4 = {gbias, gbias, gbias, gbias};
                a4 = __builtin_amdgcn_mfma_f32_16x16x32_bf16(__builtin_bit_cast(bf16x8, ah), gBh, a4, 0, 0, 0);
                a4 = __builtin_amdgcn_mfma_f32_16x16x32_bf16(__builtin_bit_cast(bf16x8, al), gBh, a4, 0, 0, 0);
                a4 = __builtin_amdgcn_mfma_f32_16x16x32_bf16(__builtin_bit_cast(bf16x8, ah), gBl, a4, 0, 0, 0);
#pragma unroll
                for (int i = 0; i < 4; ++i) { const float a = a4[i]; a4[i] = (fminf(a, 0.f) - __logf(1.f + __expf(-fabsf(a)))) * (1.f / 16.f); }
                a4[1] += a4[0]; a4[2] += a4[1]; a4[3] += a4[2];
                g4[t] = a4;
                const float s0 = a4[3], x1 = __shfl_xor(s0, 16), x2 = __shfl_xor(s0, 32), x3 = __shfl_xor(x1, 32);
                tsum[t] = (s0 + x1) + (x2 + x3);
                pre[t] = ((gq ^ 1) < gq ? x1 : 0.f) + ((gq ^ 2) < gq ? x2 : 0.f) + ((gq ^ 3) < gq ? x3 : 0.f);
            }
            const float tot = (tsum[0] + tsum[1]) + (tsum[2] + tsum[3]);
            float basep = 0.f;
#pragma unroll
            for (int t = 0; t < 4; ++t) {
#pragma unroll
                for (int i = 0; i < 4; ++i) {
                    LAS unsigned short* kp = (LAS unsigned short*)(L + SC_K + (16 * t + 4 * gq + i) * SC_KSTR + gdk * 2);
                    *kp = (unsigned short)f2bf(bf2f(*kp) * __expf(tot - (basep + pre[t] + g4[t][i])));
                }
                basep += tsum[t];
            }
            if (gq == 0) dec[gdk] = __expf(tot);
        }
        __syncthreads();
        const int etok = tid >> 3, ecc = tid & 7;
        v4u rr[4];
        { size_t eb_ = t0 * NQKVR * 2; asm volatile("" : "+s"(eb_));
          const char* rb_ = (const char*)qkvr + eb_ + (size_t)((2 * HK + HV + h * DV) * 2); const unsigned vo_r = (unsigned)(etok * NQKVR * 2 + ecc * 16);
#pragma unroll
          for (int i = 0; i < 4; ++i) rr[i] = *(const v4u*)(rb_ + vo_r + i * 128); }
#pragma unroll
        for (int i = 0; i < 4; ++i)
#pragma unroll
            for (int g4 = 0; g4 < 4; ++g4) { const f32x4 d4 = *(const LAS f32x4*)(dec + 32 * i + 8 * g4 + 4 * hh);
#pragma unroll
                for (int j = 0; j < 4; ++j) st[i][4 * g4 + j] *= d4[j]; }
#pragma unroll
        for (int s = 0; s < 4; ++s) {
            const int trow = 16 * s + 8 * hh + q4;
            const s16x4 v0 = tr_read16(L + SC_V + trow * SC_VSTR + (32 * w + 16 * blk + 4 * p4) * 2), v1 = tr_read16(L + SC_V + (trow + 4) * SC_VSTR + (32 * w + 16 * blk + 4 * p4) * 2);
            const bf16x8 Bv = {v0[0], v0[1], v0[2], v0[3], v1[0], v1[1], v1[2], v1[3]};
#pragma unroll
            for (int i = 0; i < 4; ++i) {
                const s16x4 k0 = tr_read16(L + SC_K + trow * SC_KSTR + (32 * i + 16 * blk + 4 * p4) * 2), k1 = tr_read16(L + SC_K + (trow + 4) * SC_KSTR + (32 * i + 16 * blk + 4 * p4) * 2);
                const bf16x8 Ak = {k0[0], k0[1], k0[2], k0[3], k1[0], k1[1], k1[2], k1[3]};
                st[i] = __builtin_amdgcn_mfma_f32_32x32x16_bf16(Ak, Bv, st[i], 0, 0, 0);
            }
        }
        {
        f32x16 oacc[2];
#pragma unroll
        for (int ot = 0; ot < 2; ++ot)
#pragma unroll
            for (int j = 0; j < 16; ++j) oacc[ot][j] = 0.f;
#pragma unroll
        for (int i = 0; i < 4; ++i)
#pragma unroll
            for (int s2 = 0; s2 < 2; ++s2) {
                v4u pb; pb.x = pk2(st[i][8 * s2 + 0], st[i][8 * s2 + 1]); pb.y = pk2(st[i][8 * s2 + 2], st[i][8 * s2 + 3]); pb.z = pk2(st[i][8 * s2 + 4], st[i][8 * s2 + 5]); pb.w = pk2(st[i][8 * s2 + 6], st[i][8 * s2 + 7]);
                const bf16x8 Bs = __builtin_bit_cast(bf16x8, pb);
#pragma unroll
                for (int ot = 0; ot < 2; ++ot) {
                    LAS const unsigned char* qp = L + SC_Q + (32 * ot + r32) * SC_QSTR + (32 * i + 16 * s2 + 4 * hh) * 2;
                    const v2u a0 = *(const LAS v2u*)qp, a1 = *(const LAS v2u*)(qp + 16);
                    v4u pa; pa.x = a0.x; pa.y = a0.y; pa.z = a1.x; pa.w = a1.y;
                    oacc[ot] = __builtin_amdgcn_mfma_f32_32x32x16_bf16(__builtin_bit_cast(bf16x8, pa), Bs, oacc[ot], 0, 0, 0);
                }
            }
#pragma unroll
        for (int ot = 0; ot < 2; ++ot)
#pragma unroll
            for (int rg16 = 0; rg16 < 16; ++rg16) {
                const int tok = 32 * ot + (rg16 & 3) + 8 * (rg16 >> 2) + 4 * hh;
                *(LAS unsigned short*)(L + SC_O + tok * SC_OSTR + (32 * w + r32) * 2) = (unsigned short)f2bf(oacc[ot][rg16]);
            }
        }
        __syncthreads();
        if (c + 1 < NCHUNK) SC_STORE();
        {
        {
            const int tok = etok, cc = ecc;
            v4u ov[4]; float ss = 0.f;
#pragma unroll
            for (int i = 0; i < 4; ++i) ov[i] = *(const LAS v4u*)(L + SC_O + tok * SC_OSTR + cc * 16 + i * 128);
#pragma unroll
            for (int i = 0; i < 4; ++i) { const float a0 = bflo(ov[i].x), a1 = bfhi(ov[i].x), a2 = bflo(ov[i].y), a3 = bfhi(ov[i].y), a4 = bflo(ov[i].z), a5 = bfhi(ov[i].z), a6 = bflo(ov[i].w), a7 = bfhi(ov[i].w);
                ss += (a0 * a0 + a1 * a1) + (a2 * a2 + a3 * a3) + (a4 * a4 + a5 * a5) + (a6 * a6 + a7 * a7); }
            ss += __shfl_xor(ss, 1); ss += __shfl_xor(ss, 2); ss += __shfl_xor(ss, 4);
            const float rms = __builtin_amdgcn_rsqf(ss * (1.f / DV) + EPS);
            size_t ob_ = (t0 * D + h * DV) * 2; asm volatile("" : "+s"(ob_)); const unsigned vo_o = (unsigned)(tok * D * 2 + cc * 16);
#pragma unroll
            for (int i = 0; i < 4; ++i) {
                v4u o;
                o.x = pk2(bflo(ov[i].x) * rms * bflo(rr[i].x), bfhi(ov[i].x) * rms * bfhi(rr[i].x));
                o.y = pk2(bflo(ov[i].y) * rms * bflo(rr[i].y), bfhi(ov[i].y) * rms * bfhi(rr[i].y));
                o.z = pk2(bflo(ov[i].z) * rms * bflo(rr[i].z), bfhi(ov[i].z) * rms * bfhi(rr[i].z));
                o.w = pk2(bflo(ov[i].w) * rms * bflo(rr[i].w), bfhi(ov[i].w) * rms * bfhi(rr[i].w));
                *(v4u*)((char*)aout + ob_ + vo_o + i * 128) = o;
            }
        }
            }
    }
    __syncthreads();
#undef SC_LOAD
#undef SC_STORE
}
constexpr int SCAN_C1 = 20;
__device__ __forceinline__ void f_scan_outproj(Frame& F, const XcdBarrier& xbar) {
    constexpr int NITEM = NBATCH * GLA_H;
    if (F.bid < NITEM) f_scan_item(F, F.bid, &xbar, SCAN_C1);
    else { f_convert_rest(F, (F.bid - NITEM) * NWAVES + FWAVE, (F.G - NITEM) * NWAVES); xcd_barrier(xbar); f_gemm_out_rows(F, 0, SCAN_C1 / 4, NITEM); }
    xcd_barrier(xbar);
    f_gemm_out_rows(F, SCAN_C1 / 4, 8, 0);
}
constexpr int MX_W = 0, MX_WSTR = 272;
constexpr int MX_V0 = 34816, MX_VSTR = 320, MX_VBYTES = 40960;
constexpr int MX_MU = 116736;
constexpr int MX_LN = MX_MU + 2560;
__device__ __forceinline__ void f_mix(Frame& F) {
    LAS unsigned char* L = F.lds;
    LAS float* mu = (LAS float*)(L + MX_MU); LAS float* rs = mu + 128; LAS float* m1 = rs + 128; LAS float* m0 = m1 + 128; LAS float* bsg = m0 + 128;
    LAS float* lgs = (LAS float*)(L + MX_LN); LAS float* lbs = lgs + 512;
    bf16* u = WSP(bf16, WS_U); const bf16* v = WSP(bf16, WS_V); const float* st = WSP(float, WS_STATS); bf16* uout = u;
    const int tid = FTID, lane = FLANE, w = FWAVE;
    const int r32 = lane & 31, hh = lane >> 5, blk = (lane >> 4) & 1, q4 = (lane & 15) >> 2, p4 = lane & 3;
    const int ct = w >> 1, th = w & 1;
    const unsigned vo_v = (unsigned)(((tid >> 4) * SGU_HALF + (tid & 15) * 8) * 2), lo_v = (unsigned)(MX_V0 + (tid >> 4) * MX_VSTR + (tid & 15) * 16);
    constexpr int MX_MSTR = 272;
    for (int bn = F.bid; bn < T / SGU_BLK; bn += F.G) {
        const size_t t0 = (size_t)bn * SGU_BLK;
        __syncthreads();
        {
            const int row = tid & 127, pq = tid >> 7; float s = 0.f, q = 0.f;
#pragma unroll
            for (int p = 0; p < 8; ++p) { const pg8::f32x2 a = *(const pg8::f32x2*)(st + ((size_t)(pq * 8 + p) * T + t0 + row) * 2); s += a.x; q += a.y; }
            LAS float* red = (LAS float*)(L + MX_V0);
            red[(pq * 128 + row) * 2] = s; red[(pq * 128 + row) * 2 + 1] = q;
            __syncthreads();
            if (tid < 128) { float s4 = 0.f, q4 = 0.f;
#pragma unroll
                for (int p = 0; p < 4; ++p) { s4 += red[(p * 128 + tid) * 2]; q4 += red[(p * 128 + tid) * 2 + 1]; }
                const float m = s4 * (1.f / SGU_HALF); mu[tid] = m; rs[tid] = __builtin_amdgcn_rsqf(fmaxf(q4 * (1.f / SGU_HALF) - m * m, 0.f) + EPS); }
            __syncthreads();
        }
        v4u preA[4], preB[4]; v4u uuA[4], uuB[4];
#define MX_LOAD(pre_, it_) do { size_t vb_ = (t0 * SGU_HALF + (size_t)(it_) * 128) * 2; asm volatile("" : "+s"(vb_)); \
        _Pragma("unroll") for (int i = 0; i < 4; ++i) pre_[i] = *(const v4u*)((const char*)v + vb_ + (size_t)(i * 32 * SGU_HALF * 2) + vo_v); } while (0)
#define MX_STORE(buf_, pre_) do { _Pragma("unroll") for (int i = 0; i < 4; ++i) *(LAS v4u*)(L + lo_v + (buf_) * MX_VBYTES + 32 * i * MX_VSTR) = pre_[i]; } while (0)
#define MX_ULOAD(uu_, it_) do { size_t ub_ = (t0 * SGU_HALF + (size_t)(it_) * 128) * 2; asm volatile("" : "+s"(ub_)); \
        _Pragma("unroll") for (int i = 0; i < 4; ++i) uu_[i] = *(const v4u*)((const char*)u + ub_ + (size_t)(i * 32 * SGU_HALF * 2) + vo_v); } while (0)
#define MX_TILE(it_, buf_, uu_) do { \
        f32x16 acc[2]; \
        _Pragma("unroll") for (int tt = 0; tt < 2; ++tt) _Pragma("unroll") for (int j = 0; j < 16; ++j) acc[tt][j] = 0.f; \
        LAS unsigned char* Vb = L + MX_V0 + (buf_) * MX_VBYTES; \
        const int nks = th == 0 ? 4 : 8; \
        for (int ks = 0; ks < nks; ++ks) { \
            const int srow = 16 * ks + 8 * hh + q4; \
            const s16x4 a0 = tr_read16(Vb + srow * MX_VSTR + (32 * ct + 16 * blk + 4 * p4) * 2), a1 = tr_read16(Vb + (srow + 4) * MX_VSTR + (32 * ct + 16 * blk + 4 * p4) * 2); \
            const bf16x8 Av = {a0[0], a0[1], a0[2], a0[3], a1[0], a1[1], a1[2], a1[3]}; \
            _Pragma("unroll") for (int tt = 0; tt < 2; ++tt) { \
                const bf16x8 Bw = *(const LAS bf16x8*)(L + MX_W + (64 * th + 32 * tt + r32) * MX_WSTR + (16 * ks + 8 * hh) * 2); \
                acc[tt] = __builtin_amdgcn_mfma_f32_32x32x16_bf16(Av, Bw, acc[tt], 0, 0, 0); } } \
        const int cl = ((it_) & 3) * 128 + 32 * ct + 4 * hh;                    \
        __syncthreads();                                                         \
        _Pragma("unroll") for (int tt = 0; tt < 2; ++tt) { \
            const int t = 64 * th + 32 * tt + r32; const float tm1 = m1[t], tm0 = m0[t], tb = bsg[t]; \
            _Pragma("unroll") for (int g4 = 0; g4 < 4; ++g4) { \
                const f32x4 lg = *(const LAS f32x4*)(lgs + cl + 8 * g4), lb = *(const LAS f32x4*)(lbs + cl + 8 * g4); \
                v2u o; o.x = pk2(lg[0] * (acc[tt][4 * g4 + 0] - tm1) + lb[0] * tm0 + tb, lg[1] * (acc[tt][4 * g4 + 1] - tm1) + lb[1] * tm0 + tb); \
                o.y = pk2(lg[2] * (acc[tt][4 * g4 + 2] - tm1) + lb[2] * tm0 + tb, lg[3] * (acc[tt][4 * g4 + 3] - tm1) + lb[3] * tm0 + tb); \
                *(LAS v2u*)(Vb + t * MX_MSTR + (32 * ct + 8 * g4 + 4 * hh) * 2) = o; } } \
        __syncthreads();                                                         \
        size_t ob_ = (t0 * SGU_HALF + (size_t)(it_) * 128) * 2; asm volatile("" : "+s"(ob_)); \
        _Pragma("unroll") for (int i = 0; i < 4; ++i) { \
            const v4u mx = *(const LAS v4u*)(Vb + ((tid >> 4) + 32 * i) * MX_MSTR + (tid & 15) * 16); const v4u ux = uu_[i]; v4u o; \
            o.x = pk2(bflo(ux.x) * bflo(mx.x), bfhi(ux.x) * bfhi(mx.x)); o.y = pk2(bflo(ux.y) * bflo(mx.y), bfhi(ux.y) * bfhi(mx.y)); \
            o.z = pk2(bflo(ux.z) * bflo(mx.z), bfhi(ux.z) * bfhi(mx.z)); o.w = pk2(bflo(ux.w) * bflo(mx.w), bfhi(ux.w) * bfhi(mx.w)); \
            *(v4u*)((char*)uout + ob_ + (size_t)(i * 32 * SGU_HALF * 2) + vo_v) = o; } } while (0)
        MX_LOAD(preA, 0); MX_LOAD(preB, 1); MX_ULOAD(uuA, 0);
        for (int it = 0; it < 16; it += 2) {
            if ((it & 3) == 0) {
                const int g = it >> 2;
                __syncthreads();
                const int t = tid >> 2, sq = tid & 3; const float* wsrc = F.inp(I_SGU_WS) + ((size_t)g * 128 + t) * 128 + sq * 8;
                float a1 = 0.f, a0 = 0.f;
#pragma unroll
                for (int i = 0; i < 4; ++i) {
                    const f32x4 x0 = *(const f32x4*)(wsrc + i * 32), x1 = *(const f32x4*)(wsrc + i * 32 + 4); float wv[8] = {x0[0], x0[1], x0[2], x0[3], x1[0], x1[1], x1[2], x1[3]}; float hv[8];
#pragma unroll
                    for (int j = 0; j < 8; ++j) { const int s = i * 32 + sq * 8 + j; const float wm = ((t >> 6) >= (s >> 6)) ? wv[j] : 0.f; a0 += wm; hv[j] = wm * rs[s]; }
                    v4u o; o.x = pk2(hv[0], hv[1]); o.y = pk2(hv[2], hv[3]); o.z = pk2(hv[4], hv[5]); o.w = pk2(hv[6], hv[7]);
                    const unsigned ow[4] = {o.x, o.y, o.z, o.w};
#pragma unroll
                    for (int j = 0; j < 4; ++j) a1 += bflo(ow[j]) * mu[i * 32 + sq * 8 + 2 * j] + bfhi(ow[j]) * mu[i * 32 + sq * 8 + 2 * j + 1];
                    *(LAS v4u*)(L + MX_W + t * MX_WSTR + (i * 32 + sq * 8) * 2) = o;
                }
                a1 += __shfl_xor(a1, 1); a1 += __shfl_xor(a1, 2); a0 += __shfl_xor(a0, 1); a0 += __shfl_xor(a0, 2);
                if (sq == 0) { m1[t] = a1; m0[t] = a0; }
                if (tid < 128) bsg[tid] = F.inp(I_SGU_BS)[g * 128 + tid];
                lgs[tid] = F.inp(I_SGU_LNG)[g * SGU_GC + tid]; lbs[tid] = F.inp(I_SGU_LNB)[g * SGU_GC + tid];
            }
            MX_STORE(0, preA);
            __syncthreads();
            if (it + 2 < 16) MX_LOAD(preA, it + 2);
            MX_ULOAD(uuB, it + 1);
            MX_TILE(it, 0, uuA);
            MX_STORE(1, preB);
            __syncthreads();
            if (it + 3 < 16) MX_LOAD(preB, it + 3);
            if (it + 2 < 16) MX_ULOAD(uuA, it + 2);
            MX_TILE(it + 1, 1, uuB);
        }
#undef MX_LOAD
#undef MX_STORE
#undef MX_ULOAD
#undef MX_TILE
    }
}
constexpr int RW_STR = 2064;
constexpr int RW_LG = 48 * RW_STR;
constexpr int RW_HIST = RW_LG + 8 * 16 * 48 * 4;
template <int MODE> __device__ __forceinline__ void f_rowgroup(Frame& F, int Lyr) {
    constexpr int NCT = MODE == 0 ? 1 : 3;
    LAS unsigned char* L = F.lds;
    const int tid = FTID, lane = FLANE, w = FWAVE, rw = lane & 15, q = lane >> 4;
    const float* xsrc = F.inp(I_X);
    bf16* xb = WSP(bf16, WS_XN); float* rsout = WSP(float, WS_RS);
    __syncthreads();
    for (int k = tid; k < D; k += NTHREADS) {
        if (MODE == 0) {
            const float gn = F.inp(I_GLA_NORM)[k]; const float* wr_ = F.inp(I_GLA_WIN) + (size_t)k * GLA_IN + NQKVR;
#pragma unroll
            for (int c4 = 0; c4 < 4; ++c4) { const f32x4 x = *(const f32x4*)(wr_ + 4 * c4);
#pragma unroll
                for (int j = 0; j < 4; ++j) *(LAS unsigned short*)(L + (4 * c4 + j) * RW_STR + k * 2) = (unsigned short)f2bf(x[j] * gn); }
        } else {
            const float gn = F.inp(I_MOE_NORM)[Lyr * D + k];
            const f32x4 xg = *(const f32x4*)(F.inp(I_MOE_WG) + ((size_t)Lyr * D + k) * 4);
#pragma unroll
            for (int j = 0; j < 4; ++j) *(LAS unsigned short*)(L + j * RW_STR + k * 2) = (unsigned short)f2bf(xg[j] * gn);
#pragma unroll
            for (int g = 0; g < 4; ++g) { const float* ws_ = F.inp(I_MOE_WSUB) + (((size_t)Lyr * 4 + g) * D + k) * EPG; const f32x4 a = *(const f32x4*)ws_, b = *(const f32x4*)(ws_ + 4);
#pragma unroll
                for (int j = 0; j < 4; ++j) { *(LAS unsigned short*)(L + (4 + 8 * g + j) * RW_STR + k * 2) = (unsigned short)f2bf(a[j] * gn); *(LAS unsigned short*)(L + (8 + 8 * g + j) * RW_STR + k * 2) = (unsigned short)f2bf(b[j] * gn); } }
#pragma unroll
            for (int c = 36; c < 48; ++c) *(LAS unsigned short*)(L + c * RW_STR + k * 2) = 0;
        }
    }
    LAS int* hist = (LAS int*)(L + RW_HIST); LAS int* hbase = hist + 32;
    if (MODE == 1 && tid < 32) hist[tid] = 0;
    __syncthreads();
    const int ngroups = T / 16, niter = (ngroups + F.G * NWAVES - 1) / (F.G * NWAVES);
    for (int iter = 0; iter < niter; ++iter) {
        const int grp = (iter * F.G + F.bid) * NWAVES + w; const bool valid = grp < ngroups;
        const size_t row = (size_t)grp * 16 + rw;
        float rstd = 0.f; pg8::f32x4 acc[NCT];
        if (valid) {
#pragma unroll
            for (int c = 0; c < NCT; ++c) acc[c] = (pg8::f32x4){0.f, 0.f, 0.f, 0.f};
            float ss = 0.f;
#pragma unroll 8
            for (int s = 0; s < 32; ++s) {
                v4u pa;
                if (MODE == 0) {
                    const float* xr = xsrc + row * D + 8 * q + 32 * s;
                    const f32x4 x0 = *(const f32x4*)xr, x1 = *(const f32x4*)(xr + 4);
                    ss += (x0[0] * x0[0] + x0[1] * x0[1]) + (x0[2] * x0[2] + x0[3] * x0[3]) + (x1[0] * x1[0] + x1[1] * x1[1]) + (x1[2] * x1[2] + x1[3] * x1[3]);
                    pa.x = pk2(x0[0], x0[1]); pa.y = pk2(x0[2], x0[3]); pa.z = pk2(x1[0], x1[1]); pa.w = pk2(x1[2], x1[3]);
                    *(v4u*)(xb + row * D + 8 * q + 32 * s) = pa;
                } else {
                    pa = *(const v4u*)(xb + row * D + 8 * q + 32 * s);
                    const float a0 = bflo(pa.x), a1 = bfhi(pa.x), a2 = bflo(pa.y), a3 = bfhi(pa.y), a4 = bflo(pa.z), a5 = bfhi(pa.z), a6 = bflo(pa.w), a7 = bfhi(pa.w);
                    ss += (a0 * a0 + a1 * a1) + (a2 * a2 + a3 * a3) + (a4 * a4 + a5 * a5) + (a6 * a6 + a7 * a7);
                    int w0 = __builtin_amdgcn_cvt_pk_fp8_f32(a0, a1, 0, false); w0 = __builtin_amdgcn_cvt_pk_fp8_f32(a2, a3, w0, true);
                    int w1 = __builtin_amdgcn_cvt_pk_fp8_f32(a4, a5, 0, false); w1 = __builtin_amdgcn_cvt_pk_fp8_f32(a6, a7, w1, true);
                    v2u o8; o8.x = (unsigned)w0; o8.y = (unsigned)w1; *(v2u*)(WSP(unsigned char, WS_XB8) + row * D + 8 * q + 32 * s) = o8;
                }
                const bf16x8 A = __builtin_bit_cast(bf16x8, pa);
#pragma unroll
                for (int c = 0; c < NCT; ++c) { const bf16x8 B = *(const LAS bf16x8*)(L + (16 * c + rw) * RW_STR + (32 * s + 8 * q) * 2); acc[c] = __builtin_amdgcn_mfma_f32_16x16x32_bf16(A, B, acc[c], 0, 0, 0); }
            }
            ss += __shfl_xor(ss, 16); ss += __shfl_xor(ss, 32);
            rstd = __builtin_amdgcn_rsqf(ss * (1.f / D) + EPS);
            if (q == 0) rsout[row] = rstd;
        }
        float rs4[4];
#pragma unroll
        for (int i = 0; i < 4; ++i) rs4[i] = __shfl(rstd, 4 * q + i);
        int e1 = 0, e2 = 0, rk1 = 0, rk2 = 0; float gt1 = 0.f, gt2 = 0.f;
        if (MODE == 0) {
            if (valid) {
                float* glr = WSP(float, WS_GLR);
#pragma unroll
                for (int i = 0; i < 4; ++i) glr[((size_t)grp * 16 + 4 * q + i) * RANK + rw] = acc[0][i] * rs4[i];
            }
        } else {
            LAS float* lgw = (LAS float*)(L + RW_LG) + w * 16 * 48;
            if (valid) {
#pragma unroll
                for (int c = 0; c < NCT; ++c)
#pragma unroll
                    for (int i = 0; i < 4; ++i) lgw[(4 * q + i) * 48 + 16 * c + rw] = acc[c][i] * rs4[i];
            }
            LDS_WAIT(); asm volatile("" ::: "memory");
            if (valid && lane < 16) {
                const LAS float* lr = lgw + lane * 48; const float* bg = F.inp(I_MOE_BG) + Lyr * 4;
                float lg[4];
#pragma unroll
                for (int c = 0; c < 4; ++c) lg[c] = lr[c] + bg[c];
                int g = 0; float gm = lg[0];
#pragma unroll
                for (int c = 1; c < 4; ++c) if (lg[c] > gm) { gm = lg[c]; g = c; }
                float gs = 0.f;
#pragma unroll
                for (int c = 0; c < 4; ++c) gs += __expf(lg[c] - gm);
                const float g_w = 1.f / gs; const float* bs = F.inp(I_MOE_BSUB) + (Lyr * 4 + g) * EPG;
                int i1 = 0, i2 = 0; float m1v = -3.0e38f, m2v = -3.0e38f;
                for (int e = 0; e < EPG; ++e) { const float x = lr[4 + 8 * g + e] + bs[e];
                    if (x > m1v) { m2v = m1v; i2 = i1; m1v = x; i1 = e; } else if (x > m2v) { m2v = x; i2 = e; } }
                const float w1 = 1.f / (1.f + __expf(m2v - m1v));
                e1 = g * EPG + i1; e2 = g * EPG + i2; gt1 = g_w * w1; gt2 = g_w * (1.f - w1);
                rk1 = __hip_atomic_fetch_add(&hist[e1], 1, __ATOMIC_RELAXED, __HIP_MEMORY_SCOPE_WORKGROUP); rk2 = __hip_atomic_fetch_add(&hist[e2], 1, __ATOMIC_RELAXED, __HIP_MEMORY_SCOPE_WORKGROUP);
            }
            __syncthreads();
            if (tid < 32) { const int hcount = hist[tid]; hbase[tid] = hcount ? (int)atomicAdd(WSP(unsigned, WS_CTL) + CW_CNT + Lyr * 2048 + 64 * tid, (unsigned)hcount) : 0; hist[tid] = 0; }
            __syncthreads();
            if (valid && lane < 16) {
                const int tok = grp * 16 + lane; const int p1 = hbase[e1] + rk1, p2 = hbase[e2] + rk2;
                WSP(int, WS_LIST)[(size_t)e1 * T + p1] = tok * 2; WSP(int, WS_LIST)[(size_t)e2 * T + p2] = tok * 2 + 1;
                WSP(float, WS_GATE)[tok * 2] = gt1; WSP(float, WS_GATE)[tok * 2 + 1] = gt2;
            }
        }
    }
    __syncthreads();
}
template <bool FINAL> __device__ __forceinline__ void f_rowadd(Frame& F) {
    bf16* xb = WSP(bf16, WS_XN); const unsigned char* y = WSP(unsigned char, WS_Y); float* rsout = WSP(float, WS_RS); bf16* xo = xb;
    const int lane = FLANE, w = FWAVE;
    f32x4 gf[4];
    if (FINAL) {
#pragma unroll
        for (int j = 0; j < 2; ++j) { gf[2 * j] = *(const f32x4*)(F.inp(I_FINAL) + 8 * lane + 512 * j); gf[2 * j + 1] = *(const f32x4*)(F.inp(I_FINAL) + 8 * lane + 512 * j + 4); }
    }
    for (int r0 = (F.bid * NWAVES + w) * 2; r0 < T; r0 += F.G * NWAVES * 2) {
        v4u xa[2][2]; v2u ya[2][2], yb[2][2];
#pragma unroll
        for (int rr = 0; rr < 2; ++rr)
#pragma unroll
            for (int j = 0; j < 2; ++j) { const size_t o = (size_t)(r0 + rr) * D + 8 * lane + 512 * j;
                xa[rr][j] = *(const v4u*)(xb + o); ya[rr][j] = *(const v2u*)(y + o); yb[rr][j] = *(const v2u*)(y + (size_t)T * D + o); }
#pragma unroll
        for (int rr = 0; rr < 2; ++rr) {
            float v[16]; float ss = 0.f;
#pragma unroll
            for (int j = 0; j < 2; ++j) {
                const unsigned xw[4] = {xa[rr][j].x, xa[rr][j].y, xa[rr][j].z, xa[rr][j].w};
                const pg8::f32x2 a0 = __builtin_amdgcn_cvt_pk_f32_fp8((int)ya[rr][j].x, false), a1 = __builtin_amdgcn_cvt_pk_f32_fp8((int)ya[rr][j].x, true), a2 = __builtin_amdgcn_cvt_pk_f32_fp8((int)ya[rr][j].y, false), a3 = __builtin_amdgcn_cvt_pk_f32_fp8((int)ya[rr][j].y, true);
                const pg8::f32x2 b0 = __builtin_amdgcn_cvt_pk_f32_fp8((int)yb[rr][j].x, false), b1 = __builtin_amdgcn_cvt_pk_f32_fp8((int)yb[rr][j].x, true), b2 = __builtin_amdgcn_cvt_pk_f32_fp8((int)yb[rr][j].y, false), b3 = __builtin_amdgcn_cvt_pk_f32_fp8((int)yb[rr][j].y, true);
                const float ysum[8] = {a0.x + b0.x, a0.y + b0.y, a1.x + b1.x, a1.y + b1.y, a2.x + b2.x, a2.y + b2.y, a3.x + b3.x, a3.y + b3.y};
#pragma unroll
                for (int e = 0; e < 4; ++e) { const float lo = bflo(xw[e]) + ysum[2 * e], hi = bfhi(xw[e]) + ysum[2 * e + 1]; v[8 * j + 2 * e] = lo; v[8 * j + 2 * e + 1] = hi; ss += lo * lo + hi * hi; }
            }
            const float rstd = __builtin_amdgcn_rsqf(wave_sum(ss) * (1.f / D) + EPS);
            const size_t ro = (size_t)(r0 + rr) * D + 8 * lane;
            if (FINAL) {
#pragma unroll
                for (int j = 0; j < 2; ++j) {
                    f32x4 o0 = {v[8 * j] * rstd, v[8 * j + 1] * rstd, v[8 * j + 2] * rstd, v[8 * j + 3] * rstd}, o1 = {v[8 * j + 4] * rstd, v[8 * j + 5] * rstd, v[8 * j + 6] * rstd, v[8 * j + 7] * rstd};
                    *(f32x4*)(F.out + ro + 512 * j) = o0 * gf[2 * j]; *(f32x4*)(F.out + ro + 512 * j + 4) = o1 * gf[2 * j + 1]; }
            } else {
#pragma unroll
                for (int j = 0; j < 2; ++j) { v4u o; o.x = pk2(v[8 * j], v[8 * j + 1]); o.y = pk2(v[8 * j + 2], v[8 * j + 3]); o.z = pk2(v[8 * j + 4], v[8 * j + 5]); o.w = pk2(v[8 * j + 6], v[8 * j + 7]); *(v4u*)(xo + ro + 512 * j) = o; }
                if (lane == 0) rsout[r0 + rr] = rstd;
            }
        }
    }
}
__device__ __forceinline__ void f_prep0(Frame& F) { f_convert_gla(F); f_rowgroup<0>(F, 0); }
__device__ __forceinline__ void f_rowpass_router(Frame& F, int L) { f_rowgroup<1>(F, L); }
__device__ __forceinline__ void f_rowpass_add(Frame& F) { f_rowadd<false>(F); }
__device__ __forceinline__ void f_final(Frame& F) { f_rowadd<true>(F); }
constexpr int LDS_BYTES = 155648;
struct Args { const float* in[23]; float* out; unsigned char* ws; int ph_lo, ph_hi; };

__global__ void __launch_bounds__(NTHREADS, 2) fwd(Args args) {
    extern __shared__ __attribute__((aligned(16))) unsigned char lds_raw[];
    Frame F;
    F.lds = (LAS unsigned char*)lds_raw;
    F.G = gridDim.x; F.bid = blockIdx.x;
    F.out = args.out; F.ws = args.ws;
    volatile LAS unsigned* bst = (volatile LAS unsigned*)(F.lds + LX_PTR + 192);
    if (FTID == 0) {
        LAS unsigned long long* pt = (LAS unsigned long long*)(F.lds + LX_PTR);
#pragma unroll
        for (int i = 0; i < 23; ++i) pt[i] = (unsigned long long)args.in[i];
    }
    if (FTID < 2) bst[FTID] = 0u;
    __syncthreads();
    cg::grid_group grid = cg::this_grid();
    const XcdBarrier xbar = xcd_barrier_post(WSP(unsigned, WS_CTL) + CW_BAR, bst);
    const int lo = args.ph_lo, hi = args.ph_hi;
    if (lo > 1000) grid.sync();
#define IN(k) (lo <= (k) && (k) < hi)
#define SEAM() xcd_barrier(xbar)

    if (IN(0)) f_prep0(F);                 SEAM();
    if (IN(1)) f_gemm_in(F);               SEAM();
    if (IN(2)) f_scan_outproj(F, xbar);    SEAM();
    if (IN(3)) f_rowpass_router(F, 0);     SEAM();
    if (IN(4)) f_moe(F, 0);                SEAM();
    if (IN(5)) f_rowpass_add(F);           SEAM();
    if (IN(6)) f_gemm_sgu_in(F);           SEAM();
    if (IN(7)) f_mix(F);                   SEAM();
    if (IN(8)) f_gemm_sgu_out(F);          SEAM();
    if (IN(9)) f_rowpass_router(F, 1);     SEAM();
    if (IN(10)) f_moe(F, 1);               SEAM();
    if (IN(11)) f_final(F);
#undef IN
#undef SEAM
}

extern "C" void kernel_launch(void* const* d_in, const int* in_sizes, int n_in, void* d_out, int out_size, void* d_ws, size_t ws_size, hipStream_t stream) {
    static int grid = 0;
    if (grid == 0) {
        if (n_in != 23 || out_size != T * D || in_sizes[0] != T * D || ws_size < WS_END) { fprintf(stderr, "kernel_launch: unexpected shapes (n_in %d out %d ws %zu): nothing launched\n", n_in, out_size, ws_size); grid = -1; return; }
        int dev = 0, cus = 0, per_cu = 0;
        if (hipGetDevice(&dev) != hipSuccess || hipDeviceGetAttribute(&cus, hipDeviceAttributeMultiprocessorCount, dev) != hipSuccess) { grid = -1; return; }
        if (hipFuncSetAttribute((const void*)fwd, hipFuncAttributeMaxDynamicSharedMemorySize, LDS_BYTES) != hipSuccess) { fprintf(stderr, "kernel_launch: cannot get %d bytes of dynamic LDS\n", LDS_BYTES); grid = -1; return; }
        if (hipOccupancyMaxActiveBlocksPerMultiprocessor(&per_cu, (const void*)fwd, NTHREADS, LDS_BYTES) != hipSuccess || per_cu < 1) { fprintf(stderr, "kernel_launch: occupancy query admits %d workgroups per CU: nothing launched\n", per_cu); grid = -1; (void)hipGetLastError(); return; }
        grid = cus;
        if (grid < 128) { fprintf(stderr, "kernel_launch: %d CUs; this kernel's phase program needs at least 128 workgroups\n", grid); grid = -1; return; }
    }
    if (grid < 0) return;
    (void)hipMemsetAsync((char*)d_ws + WS_CTL, 0, CTL_ZERO_BYTES, stream);
    Args a{};
    for (int i = 0; i < 23; ++i) a.in[i] = (const float*)d_in[i];
    a.out = (float*)d_out; a.ws = (unsigned char*)d_ws; a.ph_lo = 0; a.ph_hi = 12;
    void* kargs[] = {&a};
    const hipError_t e = hipLaunchCooperativeKernel((const void*)fwd, dim3(grid), dim3(NTHREADS), kargs, LDS_BYTES, stream);
    if (e != hipSuccess) fprintf(stderr, "cooperative launch failed: %s (grid %d)\n", hipGetErrorString(e), grid);
}
```

```cpp
#include <hip/hip_runtime.h>
#include <hip/hip_cooperative_groups.h>
#include <cstdio>
#include <cstdint>
namespace cg = cooperative_groups;


constexpr int T = 32768, D = 1024, NBATCH = 16, SEQ = 2048;
constexpr int GLA_H = 4, DK = 128, DV = 256, HK = 512, HV = 1024, RANK = 16, GLA_IN = 3088, NQKVR = 3072, CHUNK = 64, NCHUNK = 32;
constexpr int SGU_FFN = 4096, SGU_HALF = 2048, SGU_BLK = 128, SGU_GC = 512;
constexpr int NE = 32, EPG = 8, FF = 512;
constexpr float EPS = 1e-6f;
constexpr int NTHREADS = 512, NWAVES = 8;

constexpr size_t MiB = 1u << 20;
constexpr size_t WS_CTL = 0, CTL_ZERO_BYTES = 128 * 1024;
constexpr size_t WS_GLR = 1 * MiB;
constexpr size_t WS_GATE = 3 * MiB;
constexpr size_t WS_STATS = 4 * MiB;
constexpr size_t WS_LIST = 12 * MiB;
constexpr size_t WS_WIN = 16 * MiB;
constexpr size_t WS_WOUT = 22 * MiB;
constexpr size_t WS_WSIN = 24 * MiB;
constexpr size_t WS_WSOUT = 32 * MiB;
constexpr size_t WS_W13 = 36 * MiB;
constexpr size_t WS_W2 = 164 * MiB;
constexpr float MOE_WSCALE = 32.f;
constexpr size_t WS_XN = 228 * MiB;
constexpr size_t WS_AOUT = 484 * MiB;
constexpr size_t WS_RS = 3 * MiB + 256 * 1024;
constexpr size_t WS_QKVR = 292 * MiB;
constexpr size_t WS_HID = 292 * MiB;
constexpr size_t WS_XB8 = 328 * MiB;
constexpr size_t WS_Y = 364 * MiB;
constexpr size_t WS_U = 292 * MiB;
constexpr size_t WS_V = 420 * MiB;
constexpr size_t WS_END = 548 * MiB;
constexpr int CW_BAR = 1024;
constexpr int CW_HID = 16384;
constexpr int CW_CNT = 8192;

#define GAS __attribute__((address_space(1)))
#define LAS __attribute__((address_space(3)))
typedef unsigned short bf16;
typedef unsigned v4u __attribute__((ext_vector_type(4)));
typedef unsigned v2u __attribute__((ext_vector_type(2)));
typedef float f32x4 __attribute__((ext_vector_type(4)));
typedef float f32x16 __attribute__((ext_vector_type(16)));
typedef short bf16x8 __attribute__((ext_vector_type(8)));
typedef short s16x4 __attribute__((ext_vector_type(4)));
#define LDS_WAIT() asm volatile("s_waitcnt lgkmcnt(0)" ::: "memory")
#define VM_WAIT() asm volatile("s_waitcnt vmcnt(0)" ::: "memory")
typedef float f32x2_t __attribute__((ext_vector_type(2))); typedef __bf16 bf16x2_t __attribute__((ext_vector_type(2)));
__device__ __forceinline__ unsigned pk2(float lo, float hi) { f32x2_t v = {lo, hi}; bf16x2_t b = __builtin_convertvector(v, bf16x2_t); return __builtin_bit_cast(unsigned, b); }
__device__ __forceinline__ unsigned f2bf(float f) { return pk2(f, 0.f) & 0xffffu; }
__device__ __forceinline__ float bf2f(unsigned short b) { return __builtin_bit_cast(float, (unsigned)b << 16); }
__device__ __forceinline__ float bflo(unsigned w) { return __builtin_bit_cast(float, w << 16); }
__device__ __forceinline__ float bfhi(unsigned w) { return __builtin_bit_cast(float, w & 0xffff0000u); }
__device__ __forceinline__ float wave_sum(float v) {
#pragma unroll
    for (int o = 1; o < 64; o <<= 1) v += __shfl_xor(v, o);
    return v;
}
__device__ __forceinline__ float silu_f(float x) { return x * __builtin_amdgcn_rcpf(1.f + __expf(-x)); }
namespace pg8 {
#define PG8_LAS __attribute__((address_space(3)))
typedef unsigned short bf16_t;
typedef short bf16x8 __attribute__((ext_vector_type(8)));
typedef float f32x4 __attribute__((ext_vector_type(4)));
typedef unsigned u32x4 __attribute__((ext_vector_type(4)));
constexpr int BM = 256, BK = 64, HALF = 128, HTB = HALF * BK * 2  , STAGE_BYTES = 8 * HTB, NXCD = 8, WGM = 2;

__host__ __device__ __forceinline__ int lds_byte(int r, int c) { const int st = (r >> 4) * 2 + (c >> 5), rr = r & 15, cc = c & 31, ob = rr * 64 + cc * 2; return st * 1024 + (ob ^ (((ob >> 9) & 1) << 5)); }
__host__ __device__ __forceinline__ void stage_rc(int b, int& R, int& C) { const int st = b / 1024, sb = b % 1024, swz = sb ^ (((sb >> 9) & 1) << 5); R = (st >> 1) * 16 + swz / 64; C = (st & 1) * 32 + (swz % 64) / 2; }
__host__ __device__ __forceinline__ int perm32(int rho) { const int n = rho >> 4, i = rho & 15; return 8 * (i >> 2) + 4 * n + (i & 3); }

struct Unit { int pm, pn, e, slot; };

struct DenseOrder {
    static constexpr bool GATHER = false;
    int nM, nN, nwg, G, c, K; const char* Bt;
    __device__ void init(int M, int N, int K_, const bf16_t* Bt_, int G_, int c_) { nM = M / BM; nN = N / BM; nwg = nM * nN; G = G_; c = c_; K = K_; Bt = (const char*)Bt_; }
    __device__ __forceinline__ bool next(int i, Unit& u) const {
        const long L = (long)i * G + c; if (L >= nwg) return false;
        int wgid = (int)L; { const int q = nwg / NXCD, r = nwg % NXCD, xcd = wgid % NXCD, off = wgid / NXCD; wgid = (xcd < r ? xcd * (q + 1) : r * (q + 1) + (xcd - r) * q) + off; }
        const int nig = WGM * nN, gid = wgid / nig, fm = gid * WGM, gsz = (nM - fm) < WGM ? (nM - fm) : WGM;
        u.pm = fm + ((wgid % nig) % gsz); u.pn = (wgid % nig) / gsz; u.e = 0; u.slot = 0; return true;
    }
    __device__ __forceinline__ const char* bptr(const Unit& u) const { return Bt + (size_t)u.pn * BM * K * 2; }
    __device__ __forceinline__ size_t abase(const Unit& u) const { return (size_t)u.pm * BM * K * 2; }
    __device__ __forceinline__ int a_rowstride(int dflt) const { return dflt; }
    __device__ __forceinline__ size_t a_hstep(size_t dflt) const { return dflt; }
    __device__ __forceinline__ size_t a_koff(int kt) const { return (size_t)kt * 128; }
    __device__ __forceinline__ unsigned aoff(const Unit& u, int h, int R, int C) const { return (unsigned)(((u.pm * BM + h * HALF + R) * K + C) * 2); }
    __device__ __forceinline__ void a_ready(const Unit&) const {}
    __device__ __forceinline__ void done(const Unit&) const {}
};

__device__ __forceinline__ unsigned cvt_pk_bf16(float lo, float hi) { unsigned r; asm volatile("v_cvt_pk_bf16_f32 %0, %1, %2" : "=v"(r) : "v"(lo), "v"(hi)); return r; }
typedef float f32x2 __attribute__((ext_vector_type(2)));
__device__ __forceinline__ f32x2 gelu_pk(f32x2 v) {
    const f32x2 av = __builtin_elementwise_abs(v), d = av * 0.2316418882f + 1.0f;
    f32x2 t; t.x = __builtin_amdgcn_rcpf(d.x); t.y = __builtin_amdgcn_rcpf(d.y);
    f32x2 q = t * 0.5307027145f + (-0.7265760135f); q = q * t + 0.7107068705f; q = q * t + (-0.142248368f); q = q * t + 0.127414796f; q = q * t;
    const f32x2 s = (v * v) * (-0.72134752044f);
    f32x2 e; e.x = __builtin_amdgcn_exp2f(s.x); e.y = __builtin_amdgcn_exp2f(s.y);
    const f32x2 m = v * (q * e), r = v - m;
    f32x2 o; o.x = v.x < 0.f ? m.x : r.x; o.y = v.y < 0.f ? m.y : r.y; return o;
}

typedef int v8i __attribute__((ext_vector_type(8)));
typedef int v4i __attribute__((ext_vector_type(4)));
template <int ES, class Epi, class Sched>
__device__ __forceinline__ void gemm_phase_es(PG8_LAS unsigned char* lds, const void* Abase, const int K, const Sched& S, const Epi& E) {
    const int tid = threadIdx.x, wid = __builtin_amdgcn_readfirstlane(tid >> 6), lane = tid & 63, wr = wid >> 2, wc = wid & 3, fr = lane & 15, fq = lane >> 4;
    const int nt = K * ES / 128;
    int sR[2], sC[2]; unsigned voffA[2], voffB[2];
#pragma unroll
    for (int i = 0; i < 2; ++i) { stage_rc(tid * 16 + i * 8192, sR[i], sC[i]); const int Rb = Epi::PERM ? ((sR[i] & ~31) + perm32(sR[i] & 31)) : sR[i];
        voffA[i] = (unsigned)(sR[i] * S.a_rowstride(K * ES) + sC[i] * 2); voffB[i] = (unsigned)(Rb * K * ES + sC[i] * 2); }
    const size_t kstep = (size_t)(BK * 2);
    const size_t hstep = (size_t)HALF * K * ES;
    const size_t hstepA = S.a_hstep(hstep);
    const unsigned ldsw = (unsigned)wid * 1024u;
    const int aoff = lds_byte(wr * 64 + fr, fq * (ES == 2 ? 8 : 16)), boff = lds_byte(wc * 32 + fr, fq * (ES == 2 ? 8 : 16));
    const char* const Ab = (const char*)Abase;
#define PG8_SA(b, h) (((b) * 2 + (h)) * HTB)
#define PG8_SB(b, h) ((4 + (b) * 2 + (h)) * HTB)
#define PG8_STAGE(bufoff, gbase, voff) do { _Pragma("unroll") for (int _i = 0; _i < 2; ++_i) \
        __builtin_amdgcn_global_load_lds((const unsigned*)((const char*)(gbase) + (voff)[_i]), (PG8_LAS unsigned*)(lds + (bufoff) + ldsw + _i * 8192), 16, 0, 0); } while (0)
#define PG8_STAGE_A(bufoff, nx, h, kt) do { if constexpr (Sched::GATHER) { PG8_STAGE(bufoff, Ab + (size_t)(kt) * kstep, gc[h]); } \
        else PG8_STAGE(bufoff, ((nx) ? xA : cA) + (size_t)(h) * hstepA + S.a_koff(kt), voffA); } while (0)
#define PG8_LDA(dst, b, h) do { if constexpr (ES == 2) { _Pragma("unroll") for (int m = 0; m < 4; ++m) _Pragma("unroll") for (int k = 0; k < 2; ++k) dst[m][k] = *(const PG8_LAS bf16x8*)(lds + PG8_SA(b, h) + aoff + m * 2048 + k * 1024); } \
        else { _Pragma("unroll") for (int m = 0; m < 4; ++m) { const v4i lo_ = *(const PG8_LAS v4i*)(lds + PG8_SA(b, h) + aoff + m * 2048), hi_ = *(const PG8_LAS v4i*)(lds + PG8_SA(b, h) + aoff + m * 2048 + 16); dst##8[m] = __builtin_shufflevector(lo_, hi_, 0, 1, 2, 3, 4, 5, 6, 7); } } } while (0)
#define PG8_LDB(dst, b, h) do { if constexpr (ES == 2) { _Pragma("unroll") for (int n = 0; n < 2; ++n) _Pragma("unroll") for (int k = 0; k < 2; ++k) dst[n][k] = *(const PG8_LAS bf16x8*)(lds + PG8_SB(b, h) + boff + n * 2048 + k * 1024); } \
        else { _Pragma("unroll") for (int n = 0; n < 2; ++n) { const v4i lo_ = *(const PG8_LAS v4i*)(lds + PG8_SB(b, h) + boff + n * 2048), hi_ = *(const PG8_LAS v4i*)(lds + PG8_SB(b, h) + boff + n * 2048 + 16); dst##8[n] = __builtin_shufflevector(lo_, hi_, 0, 1, 2, 3, 4, 5, 6, 7); } } } while (0)
#define PG8_MMA(ai, bj, At, Bt) do { __builtin_amdgcn_s_setprio(1); if constexpr (ES == 2) { _Pragma("unroll") for (int m = 0; m < 4; ++m) _Pragma("unroll") for (int n = 0; n < 2; ++n) _Pragma("unroll") for (int k = 0; k < 2; ++k) \
        acc[ai][bj][m][n] = __builtin_amdgcn_mfma_f32_16x16x32_bf16(Bt[n][k], At[m][k], acc[ai][bj][m][n], 0, 0, 0); } \
        else { _Pragma("unroll") for (int m = 0; m < 4; ++m) _Pragma("unroll") for (int n = 0; n < 2; ++n) \
        asm volatile("s_nop 1\n\tv_mfma_f32_16x16x128_f8f6f4 %0, %1, %2, %0" : "+v"(acc[ai][bj][m][n]) : "v"(Bt##8[n]), "v"(At##8[m])); }   \
        __builtin_amdgcn_s_setprio(0); } while (0)
#define PG8_WAIT_V(n) asm volatile("s_waitcnt vmcnt(" #n ")" ::: "memory")
#define PG8_WAIT_L(n) asm volatile("s_waitcnt lgkmcnt(" #n ")" ::: "memory")
#define PG8_BAR __builtin_amdgcn_s_barrier()
#define PG8_SCHED __builtin_amdgcn_sched_barrier(0)
    Unit cur, nxt, prv; int ui = 0; bool have_prv = false;
    if (!S.next(0, cur)) return;
    f32x4 acc[2][2][4][2];
#pragma unroll
    for (int a = 0; a < 2; ++a)
#pragma unroll
        for (int b = 0; b < 2; ++b)
#pragma unroll
            for (int m = 0; m < 4; ++m)
#pragma unroll
                for (int n = 0; n < 2; ++n) acc[a][b][m][n] = (f32x4){0.f, 0.f, 0.f, 0.f};
    bf16x8 At[4][2], B0[2][2], B1[2][2]; v8i At8[4], B08[2], B18[2];
    unsigned gc[2][2];
    const char* cA = Ab; const char* xA = Ab;
    if constexpr (Sched::GATHER) {
#pragma unroll
        for (int h = 0; h < 2; ++h)
#pragma unroll
            for (int i = 0; i < 2; ++i) gc[h][i] = S.aoff(cur, h, sR[i], sC[i]);
    } else { cA = Ab + S.abase(cur); xA = cA; }
    const char* cB = S.bptr(cur);
    S.a_ready(cur);
    if constexpr (Epi::RS_DMA) { if (wid == 0) __builtin_amdgcn_global_load_lds((const unsigned*)((const char*)E.rs + (size_t)cur.pm * 1024 + lane * 16), (PG8_LAS unsigned*)(lds + STAGE_BYTES + 512), 16, 0, 0); }
    PG8_STAGE(PG8_SB(0, 0), cB, voffB); PG8_STAGE(PG8_SB(0, 1), cB + hstep, voffB); PG8_STAGE_A(PG8_SA(0, 0), false, 0, 0); PG8_STAGE_A(PG8_SA(0, 1), false, 1, 0);
    if (wr == 1) PG8_BAR;
    PG8_WAIT_V(2); PG8_BAR;
    PG8_STAGE(PG8_SB(1, 0), cB + kstep, voffB); PG8_STAGE_A(PG8_SA(1, 0), false, 0, 1); PG8_STAGE(PG8_SB(1, 1), cB + hstep + kstep, voffB);
    PG8_WAIT_V(6); PG8_BAR;
    for (;;) {
        const bool has_next = S.next(ui + 1, nxt);
        const char* nB = has_next ? S.bptr(nxt) : cB;
        if constexpr (Epi::RS_DMA) { if (has_next && wid == 0) __builtin_amdgcn_global_load_lds((const unsigned*)((const char*)E.rs + (size_t)nxt.pm * 1024 + lane * 16), (PG8_LAS unsigned*)(lds + STAGE_BYTES + 512 + ((ui + 1) % 3) * 1024), 16, 0, 0); }
        for (int t = 0; t < nt; t += 2) {
            const bool last = (t == nt - 2);
            const int kt2 = last ? 0 : t + 2;
            const char* b2 = last ? nB : cB + (size_t)(t + 2) * kstep; const char* b3 = b2 + kstep;
            if (last && has_next) {
                if constexpr (!Sched::GATHER) xA = Ab + S.abase(nxt);
                S.a_ready(nxt);
            }
            PG8_LDB(B0, 0, 0); PG8_LDB(B1, 0, 1); PG8_SCHED; PG8_LDA(At, 0, 0); PG8_STAGE_A(PG8_SA(1, 1), false, 1, t + 1);
            if constexpr (Sched::GATHER) { if (last && has_next) {
#pragma unroll
                for (int h = 0; h < 2; ++h)
#pragma unroll
                    for (int i = 0; i < 2; ++i) gc[h][i] = S.aoff(nxt, h, sR[i], sC[i]); } }
            PG8_WAIT_V(8); PG8_WAIT_L(0); PG8_BAR; PG8_MMA(0, 0, At, B0); PG8_MMA(0, 1, At, B1); PG8_BAR; PG8_SCHED;
            PG8_LDA(At, 0, 1); PG8_STAGE(PG8_SB(0, 0), b2, voffB); PG8_STAGE(PG8_SB(0, 1), b2 + hstep, voffB); PG8_STAGE_A(PG8_SA(0, 0), last, 0, kt2);
            PG8_WAIT_V(8); PG8_WAIT_L(0); PG8_BAR; PG8_MMA(1, 0, At, B0); PG8_MMA(1, 1, At, B1); PG8_BAR; PG8_SCHED;
            PG8_LDB(B0, 1, 0); PG8_LDB(B1, 1, 1); PG8_SCHED; PG8_LDA(At, 1, 0); PG8_STAGE_A(PG8_SA(0, 1), last, 1, kt2);
            PG8_WAIT_V(8); PG8_WAIT_L(0);
            if (have_prv) { S.done(prv); have_prv = false; }
            PG8_BAR; PG8_MMA(0, 0, At, B0); PG8_MMA(0, 1, At, B1); PG8_BAR; PG8_SCHED;
            PG8_LDA(At, 1, 1); PG8_STAGE(PG8_SB(1, 0), b3, voffB); PG8_STAGE(PG8_SB(1, 1), b3 + hstep, voffB); PG8_STAGE_A(PG8_SA(1, 0), last, 0, kt2 + 1);
            PG8_WAIT_V(8); PG8_WAIT_L(0); PG8_BAR; PG8_MMA(1, 0, At, B0); PG8_MMA(1, 1, At, B1); PG8_BAR; PG8_SCHED;
        }
        if (wr == 0) PG8_BAR;
        if constexpr (ES == 1) asm volatile("s_nop 15\n\ts_nop 15" ::: "memory");
        E(acc, cur, wr, wc, fr, fq, (const PG8_LAS float*)(lds + STAGE_BYTES + 512 + (ui % 3) * 1024)); prv = cur; have_prv = true;
        if (!has_next) break;
#pragma unroll
        for (int a = 0; a < 2; ++a)
#pragma unroll
            for (int b = 0; b < 2; ++b)
#pragma unroll
                for (int m = 0; m < 4; ++m)
#pragma unroll
                    for (int n = 0; n < 2; ++n) acc[a][b][m][n] = (f32x4){0.f, 0.f, 0.f, 0.f};
        cur = nxt; cB = nB; ++ui;
        if constexpr (!Sched::GATHER) cA = xA;
        if (wr == 1) PG8_BAR;
    }
    PG8_WAIT_V(0);
    if (have_prv) S.done(prv);
    PG8_BAR;
#undef PG8_STAGE_A
#undef PG8_SA
#undef PG8_SB
#undef PG8_STAGE
#undef PG8_LDA
#undef PG8_LDB
#undef PG8_MMA
#undef PG8_WAIT_V
#undef PG8_WAIT_L
#undef PG8_BAR
#undef PG8_SCHED
}
template <class Epi, class Sched>
__device__ __forceinline__ void gemm_phase(PG8_LAS unsigned char* lds, const bf16_t* Abase, const int K, const Sched& S, const Epi& E) { gemm_phase_es<2>(lds, Abase, K, S, E); }
}
constexpr int LX_PTR = 155648 - 256;
#define FTID ((int)threadIdx.x)
#define FLANE ((int)threadIdx.x & 63)
#define FWAVE ((int)__builtin_amdgcn_readfirstlane((int)threadIdx.x >> 6))
struct Frame {
    LAS unsigned char* lds;
    int G, bid;
    float* out; unsigned char* ws;
    __device__ __forceinline__ const float* inp(int i) const {
        const LAS unsigned* p = (const LAS unsigned*)(lds + LX_PTR) + 2 * i;
        const unsigned lo = __builtin_amdgcn_readfirstlane(p[0]), hi = __builtin_amdgcn_readfirstlane(p[1]);
        return (const float*)(((unsigned long long)hi << 32) | lo);
    }
};
enum { I_X = 0, I_GLA_NORM, I_GLA_WIN, I_GLA_WGU, I_GLA_BG, I_GLA_HG, I_GLA_WOUT, I_SGU_NORM, I_SGU_WIN, I_SGU_LNG, I_SGU_LNB, I_SGU_WS, I_SGU_BS, I_SGU_WOUT,
       I_MOE_NORM, I_MOE_WG, I_MOE_BG, I_MOE_WSUB, I_MOE_BSUB, I_MOE_W1, I_MOE_W3, I_MOE_W2, I_FINAL };
#define WSP(type, off) ((type*)(F.ws + (off)))

#define XB_TMO      128
#define XB_XCNT(j)  (256  + 64 * (j))
#define XB_XSUB(j)  (1280 + 64 * (j))
#define XB_XGEN(j)  (2304 + 64 * (j))
#define XB_TOP      3328
#define XB_TOPGEN   3392
#define XCD_BAR_WORDS 3456
#define XB_SPIN_CAP (1u << 18)

__device__ __forceinline__ unsigned xb_ld(unsigned* p)              { return __hip_atomic_load(p, __ATOMIC_RELAXED, __HIP_MEMORY_SCOPE_AGENT); }
__device__ __forceinline__ unsigned xb_add(unsigned* p, unsigned v) { return __hip_atomic_fetch_add(p, v, __ATOMIC_RELAXED, __HIP_MEMORY_SCOPE_AGENT); }
__device__ __forceinline__ unsigned xb_xcc_id() { return (unsigned)__builtin_amdgcn_s_getreg((3 << 11) | 20) & 0xFu; }
#define XB_SPIN(cond, bar) do { unsigned _sp = 0; while (cond) { __builtin_amdgcn_s_sleep(1); \
    if ((++_sp & 255u) == 0u) { if (xb_ld(&(bar)[XB_TMO])) break; if (_sp > XB_SPIN_CAP) { atomicAdd(&(bar)[XB_TMO], 1u); break; } } } } while (0)

struct XcdBarrier {
    unsigned* bar; unsigned x;
    volatile LAS unsigned* st;
};

__device__ __forceinline__ XcdBarrier xcd_barrier_post(unsigned* bar, volatile LAS unsigned* st) {
    XcdBarrier b; b.bar = bar; b.x = xb_xcc_id(); b.st = st;
    if (threadIdx.x == 0) (void)xb_add(&bar[XB_XCNT(b.x)], 1u);
    return b;
}
__device__ __forceinline__ void xcd_barrier_complete(unsigned* bar, unsigned x, unsigned& nloc, unsigned& nx) {
    const unsigned G = gridDim.x * gridDim.y * gridDim.z;
    unsigned sum, cnt, mine, sp = 0u;
    for (;;) {
        sum = 0u; cnt = 0u; mine = 0u;
#pragma unroll
        for (unsigned j = 0; j < 16; ++j) { const unsigned c = xb_ld(&bar[XB_XCNT(j)]); sum += c; cnt += (c > 0u) ? 1u : 0u; mine = (j == x) ? c : mine; }
        if (sum == G) break;
        __builtin_amdgcn_s_sleep(1);
        if ((++sp & 255u) == 0u) { if (xb_ld(&bar[XB_TMO])) break; if (sp > XB_SPIN_CAP) { atomicAdd(&bar[XB_TMO], 1u); break; } }
    }
    nloc = mine > 0u ? mine : 1u; nx = cnt > 0u ? cnt : 1u;
}

__device__ __forceinline__ void xcd_barrier(const XcdBarrier& b) {
    asm volatile("s_waitcnt vmcnt(0)" ::: "memory");
    __syncthreads();
    if (threadIdx.x == 0) {
        unsigned* bar = b.bar;
        __builtin_amdgcn_s_waitcnt(0);
        unsigned nloc = b.st[0], nx = b.st[1];
        if (nloc == 0u) { xcd_barrier_complete(bar, b.x, nloc, nx); b.st[0] = nloc; b.st[1] = nx; }
        const unsigned old = xb_add(&bar[XB_XSUB(b.x)], 1u);
        const unsigned gen = old / nloc;
        if (old + 1u == (gen + 1u) * nloc) {
            __builtin_amdgcn_fence(__ATOMIC_RELEASE, "agent");
            asm volatile("s_waitcnt vmcnt(0)" ::: "memory");
            const unsigned og = xb_add(&bar[XB_TOP], 1u);
            const unsigned tg = og / nx;
            if (og + 1u == (tg + 1u) * nx) xb_add(&bar[XB_TOPGEN], 1u);
            else XB_SPIN(xb_ld(&bar[XB_TOPGEN]) == tg, bar);
            __builtin_amdgcn_fence(__ATOMIC_ACQUIRE, "agent");
            xb_add(&bar[XB_XGEN(b.x)], 1u);
            asm volatile("s_waitcnt vmcnt(0)" ::: "memory");
        } else {
            XB_SPIN(xb_ld(&bar[XB_XGEN(b.x)]) == gen, bar);
            __builtin_amdgcn_fence(__ATOMIC_ACQUIRE, "agent");
            asm volatile("s_waitcnt vmcnt(0)" ::: "memory");
        }
    }
    __syncthreads();
}
constexpr int RING_BYTES = 131072;
constexpr int LX_TST = RING_BYTES;
constexpr int MOE_MAXU = 6;
constexpr int LX_TAB = RING_BYTES + 512;
constexpr int LX_GT = LX_TAB + MOE_MAXU * 1024;

struct EpiStoreBf16 {
    static constexpr bool RS_DMA = true;
    static constexpr bool PERM = true;
    bf16* O; int ldc; const float* rs; int silu_from;
    __device__ __forceinline__ void operator()(const pg8::f32x4 (&acc)[2][2][4][2], const pg8::Unit& u, int wr, int wc, int fr, int fq, const LAS float* rsl) const {
        const int row0 = u.pm * 256 + wr * 64 + fr, col0 = u.pn * 256 + wc * 32 + 8 * fq;
#pragma unroll
        for (int ai = 0; ai < 2; ++ai)
#pragma unroll
            for (int m = 0; m < 4; ++m) { const int row = row0 + ai * 128 + m * 16; bf16* rowp = O + (size_t)row * ldc + col0; const float sc = rsl[ai * 128 + wr * 64 + m * 16 + fr];
#pragma unroll
                for (int bj = 0; bj < 2; ++bj) { pg8::f32x4 v0 = acc[ai][bj][m][0] * sc, v1 = acc[ai][bj][m][1] * sc;
                    if (silu_from >= 0 && u.pn >= silu_from) {
#pragma unroll
                        for (int i = 0; i < 4; ++i) { v0[i] = v0[i] * __builtin_amdgcn_rcpf(1.f + __expf(-v0[i])); v1[i] = v1[i] * __builtin_amdgcn_rcpf(1.f + __expf(-v1[i])); } }
                    v4u w; w.x = pg8::cvt_pk_bf16(v0[0], v0[1]); w.y = pg8::cvt_pk_bf16(v0[2], v0[3]); w.z = pg8::cvt_pk_bf16(v1[0], v1[1]); w.w = pg8::cvt_pk_bf16(v1[2], v1[3]);
                    *(v4u*)(rowp + bj * 128) = w; } }
    }
};
struct EpiResBf16 {
    static constexpr bool RS_DMA = false;
    static constexpr bool PERM = true;
    bf16* X;
    __device__ __forceinline__ void operator()(const pg8::f32x4 (&acc)[2][2][4][2], const pg8::Unit& u, int wr, int wc, int fr, int fq, const LAS float* rsl) const {
        const int row0 = u.pm * 256 + wr * 64 + fr, col0 = u.pn * 256 + wc * 32 + 8 * fq;
#pragma unroll
        for (int ai = 0; ai < 2; ++ai)
#pragma unroll
            for (int m = 0; m < 4; ++m) { bf16* rowp = X + (size_t)(row0 + ai * 128 + m * 16) * D + col0;
#pragma unroll
                for (int bj = 0; bj < 2; ++bj) { const v4u r = *(const v4u*)(rowp + bj * 128); const pg8::f32x4 v0 = acc[ai][bj][m][0], v1 = acc[ai][bj][m][1];
                    v4u w; w.x = pg8::cvt_pk_bf16(bflo(r.x) + v0[0], bfhi(r.x) + v0[1]); w.y = pg8::cvt_pk_bf16(bflo(r.y) + v0[2], bfhi(r.y) + v0[3]);
                    w.z = pg8::cvt_pk_bf16(bflo(r.z) + v1[0], bfhi(r.z) + v1[1]); w.w = pg8::cvt_pk_bf16(bflo(r.w) + v1[2], bfhi(r.w) + v1[3]);
                    *(v4u*)(rowp + bj * 128) = w; } }
    }
};
__device__ __forceinline__ size_t sgu_blk(int row, int col) { return ((size_t)((row >> 7) * 16 + (col >> 7)) << 15) + (size_t)((row & 127) << 8) + (size_t)((col & 127) << 1); }
struct EpiGeluSplit {
    static constexpr bool RS_DMA = true;
    static constexpr bool PERM = true;
    bf16* U; bf16* V; float* st; const float* rs;
    __device__ __forceinline__ void operator()(const pg8::f32x4 (&acc)[2][2][4][2], const pg8::Unit& u, int wr, int wc, int fr, int fq, const LAS float* rsl) const {
        const bool isv = u.pn >= 8; const int pnl = isv ? u.pn - 8 : u.pn;
        bf16* O = isv ? V : U;
        const int row0 = u.pm * 256 + wr * 64 + fr, col0 = pnl * 256 + wc * 32 + 8 * fq;
#pragma unroll
        for (int ai = 0; ai < 2; ++ai)
#pragma unroll
            for (int m = 0; m < 4; ++m) { const int row = row0 + ai * 128 + m * 16; bf16* rowp = (bf16*)((char*)O + sgu_blk(row, col0)); float s = 0.f, q = 0.f;   const float sc = rsl[ai * 128 + wr * 64 + m * 16 + fr];
#pragma unroll
                for (int bj = 0; bj < 2; ++bj) { const pg8::f32x4 v0 = acc[ai][bj][m][0] * sc, v1 = acc[ai][bj][m][1] * sc;
                    const pg8::f32x2 a = pg8::gelu_pk((pg8::f32x2){v0[0], v0[1]}), b = pg8::gelu_pk((pg8::f32x2){v0[2], v0[3]}), c = pg8::gelu_pk((pg8::f32x2){v1[0], v1[1]}), d = pg8::gelu_pk((pg8::f32x2){v1[2], v1[3]});
                    s += (a.x + a.y) + (b.x + b.y) + (c.x + c.y) + (d.x + d.y);
                    q += (a.x * a.x + a.y * a.y) + (b.x * b.x + b.y * b.y) + (c.x * c.x + c.y * c.y) + (d.x * d.x + d.y * d.y);
                    v4u w; w.x = pg8::cvt_pk_bf16(a.x, a.y); w.y = pg8::cvt_pk_bf16(b.x, b.y); w.z = pg8::cvt_pk_bf16(c.x, c.y); w.w = pg8::cvt_pk_bf16(d.x, d.y);
                    *(v4u*)((char*)rowp + bj * 32768) = w; }
                if (isv) { s += __shfl_xor(s, 16); s += __shfl_xor(s, 32); q += __shfl_xor(q, 16); q += __shfl_xor(q, 32);
                    if (fq == 0) { pg8::f32x2 o = {s, q}; *(pg8::f32x2*)(st + ((size_t)(pnl * 4 + wc) * T + row) * 2) = o; } } }
    }
};

__device__ __forceinline__ void f_gemm_in(Frame& F) {
    pg8::DenseOrder S; S.init(T, NQKVR, D, WSP(bf16, WS_WIN), F.G, F.bid);
    EpiStoreBf16 E{WSP(bf16, WS_QKVR), NQKVR, WSP(float, WS_RS), 8};
    pg8::gemm_phase(F.lds, WSP(bf16, WS_XN), D, S, E);
}
struct BlockedAOrder : pg8::DenseOrder {
    __device__ __forceinline__ size_t abase(const pg8::Unit& u) const { return (size_t)u.pm * 2 * 16 * 32768; }
    __device__ __forceinline__ int a_rowstride(int) const { return 256; }
    __device__ __forceinline__ size_t a_hstep(size_t) const { return (size_t)16 * 32768; }
    __device__ __forceinline__ size_t a_koff(int kt) const { return (size_t)(kt >> 1) * 32768 + (size_t)(kt & 1) * 128; }
};
struct RowSetOrder {
    static constexpr bool GATHER = false;
    int nb, c, j0, nunits, K; const char* Bt;
    __device__ __forceinline__ bool next(int i, pg8::Unit& u) const {
        if (c < 0) return false;
        const int q = i * nb + c; if (q >= nunits) return false;
        u.pm = ((q & 63) >> 2) * 8 + j0 + (q >> 6); u.pn = q & 3; u.e = 0; u.slot = 0; return true;
    }
    __device__ __forceinline__ const char* bptr(const pg8::Unit& u) const { return Bt + (size_t)u.pn * 256 * K * 2; }
    __device__ __forceinline__ size_t abase(const pg8::Unit& u) const { return (size_t)u.pm * 256 * K * 2; }
    __device__ __forceinline__ int a_rowstride(int dflt) const { return dflt; }
    __device__ __forceinline__ size_t a_hstep(size_t dflt) const { return dflt; }
    __device__ __forceinline__ size_t a_koff(int kt) const { return (size_t)kt * 128; }
    __device__ __forceinline__ unsigned aoff(const pg8::Unit&, int, int, int) const { return 0u; }
    __device__ __forceinline__ void a_ready(const pg8::Unit&) const {}
    __device__ __forceinline__ void done(const pg8::Unit&) const {}
};
__device__ __forceinline__ void f_gemm_out_rows(Frame& F, int j0, int j1, int boff) {
    RowSetOrder S; S.nb = F.G - boff; S.c = F.bid - boff; S.j0 = j0; S.nunits = (j1 - j0) * 64; S.K = HV; S.Bt = (const char*)WSP(bf16, WS_WOUT);
    EpiResBf16 E{WSP(bf16, WS_XN)};
    pg8::gemm_phase(F.lds, WSP(bf16, WS_AOUT), HV, S, E);
}
__device__ __forceinline__ void f_gemm_sgu_in(Frame& F) {
    pg8::DenseOrder S; S.init(T, SGU_FFN, D, WSP(bf16, WS_WSIN), F.G, F.bid);
    EpiGeluSplit E{WSP(bf16, WS_U), WSP(bf16, WS_V), WSP(float, WS_STATS), WSP(float, WS_RS)};
    pg8::gemm_phase(F.lds, WSP(bf16, WS_XN), D, S, E);
}
__device__ __forceinline__ void f_gemm_sgu_out(Frame& F) {
    BlockedAOrder S; S.init(T, D, SGU_HALF, WSP(bf16, WS_WSOUT), F.G, F.bid);
    EpiResBf16 E{WSP(bf16, WS_XN)};
    pg8::gemm_phase(F.lds, WSP(bf16, WS_U), SGU_HALF, S, E);
}

template <bool GATHER_> struct MoeOrder {
    static constexpr bool GATHER = GATHER_;
    int G, c, nunits, ibase, K, rowb, mode;
    const char* W; size_t estride;
    LAS const int* tst; LAS const int* tab; unsigned* hcnt; unsigned rdy;
    int n5, rb;
    __device__ __forceinline__ bool next(int i, pg8::Unit& u) const {
        if (i >= MOE_MAXU) return false;
        const int ii = ibase + i; int Lu;
        if (GATHER || n5 <= 0 || ii < rb) Lu = ii * G + c;
        else { if (c < n5) return false; Lu = rb * G + (ii - rb) * (G - n5) + (c - n5); }
        if (Lu >= nunits) return false;
        const int rt = Lu >> 2; int e = 0;
        while (e < NE - 1 && tst[e + 1] <= rt) ++e;
        u.pm = rt; u.pn = Lu & 3; u.e = e; u.slot = i; return true;
    }
    __device__ __forceinline__ const char* bptr(const pg8::Unit& u) const { return W + (size_t)u.e * estride + (size_t)u.pn * 256 * rowb; }
    __device__ __forceinline__ size_t abase(const pg8::Unit& u) const { return (size_t)u.pm * 256 * rowb; }
    __device__ __forceinline__ int a_rowstride(int dflt) const { return dflt; }
    __device__ __forceinline__ size_t a_hstep(size_t dflt) const { return dflt; }
    __device__ __forceinline__ size_t a_koff(int kt) const { return (size_t)kt * 128; }
    __device__ __forceinline__ unsigned aoff(const pg8::Unit& u, int h, int R, int C) const {
        if (mode == 0) { int ent = tab[u.slot * 256 + h * 128 + R]; ent = ent < 0 ? 0 : ent; return (unsigned)((ent >> 1) * rowb + C * 2); }
        return (unsigned)((u.pm * 256 + h * 128 + R) * rowb + C * 2);
    }
    __device__ __forceinline__ void a_ready(const pg8::Unit& u) const {
        if (GATHER || ((rdy >> u.slot) & 1u)) return;
        if (threadIdx.x < 64) {
            unsigned spins = 0;
            while ((unsigned)__builtin_amdgcn_readfirstlane(__hip_atomic_load(hcnt + 16 * u.pm, __ATOMIC_RELAXED, __HIP_MEMORY_SCOPE_AGENT)) < 32u) { __builtin_amdgcn_s_sleep(2); if (++spins > (1u << 20)) break; }
            __builtin_amdgcn_fence(__ATOMIC_ACQUIRE, "agent");
            asm volatile("s_waitcnt vmcnt(0)" ::: "memory");
        }
        asm volatile("" ::: "memory"); __builtin_amdgcn_s_barrier(); asm volatile("" ::: "memory");
    }
    __device__ __forceinline__ void done(const pg8::Unit& u) const {
        if (!GATHER) return;
        if ((threadIdx.x & 63) == 0) __hip_atomic_fetch_add(hcnt + 16 * u.pm, 1u, __ATOMIC_RELAXED, __HIP_MEMORY_SCOPE_AGENT);
    }
};
struct EpiSwiglu {
    static constexpr bool RS_DMA = false;
    static constexpr bool PERM = true;
    unsigned char* H; LAS const float* gt;
    __device__ __forceinline__ void operator()(const pg8::f32x4 (&acc)[2][2][4][2], const pg8::Unit& u, int wr, int wc, int fr, int fq, const LAS float* rsl) const {
        const __amdgpu_buffer_rsrc_t hrs = __builtin_amdgcn_make_buffer_rsrc((void*)H, (short)0, 73728 * FF, 0x00020000);
        const int row0 = u.pm * 256 + wr * 64 + fr, col0 = u.pn * 128 + wc * 32 + 8 * fq;
#pragma unroll
        for (int ai = 0; ai < 2; ++ai)
#pragma unroll
            for (int m = 0; m < 4; ++m) { float h[8]; const float sc = gt[u.slot * 256 + ai * 128 + wr * 64 + m * 16 + fr] * (1.f / MOE_WSCALE);
#pragma unroll
                for (int n = 0; n < 2; ++n)
#pragma unroll
                    for (int i = 0; i < 4; ++i) { const float a = acc[ai][0][m][n][i] * sc, b = acc[ai][1][m][n][i] * sc; h[n * 4 + i] = a * __builtin_amdgcn_rcpf(1.f + __expf(-a)) * b; }
                int w0 = __builtin_amdgcn_cvt_pk_fp8_f32(h[0], h[1], 0, false); w0 = __builtin_amdgcn_cvt_pk_fp8_f32(h[2], h[3], w0, true);
                int w1 = __builtin_amdgcn_cvt_pk_fp8_f32(h[4], h[5], 0, false); w1 = __builtin_amdgcn_cvt_pk_fp8_f32(h[6], h[7], w1, true);
                v2u w; w.x = (unsigned)w0; w.y = (unsigned)w1;
                __builtin_amdgcn_raw_buffer_store_b64(w, hrs, (row0 + ai * 128 + m * 16) * FF + col0, 0, 16); }
    }
};
struct EpiScatterY {
    static constexpr bool RS_DMA = false;
    static constexpr bool PERM = true;
    unsigned char* Y; LAS const int* tab; LAS const float* gt;
    __device__ __forceinline__ void operator()(const pg8::f32x4 (&acc)[2][2][4][2], const pg8::Unit& u, int wr, int wc, int fr, int fq, const LAS float* rsl) const {
        const int col0 = u.pn * 256 + wc * 32 + 8 * fq;
#pragma unroll
        for (int ai = 0; ai < 2; ++ai)
#pragma unroll
            for (int m = 0; m < 4; ++m) { const int r = ai * 128 + wr * 64 + m * 16 + fr; const int ent = tab[u.slot * 256 + r]; const float g = gt[u.slot * 256 + r] * (1.f / MOE_WSCALE);
                if (ent >= 0) { unsigned char* rowp = Y + ((size_t)(ent & 1) * T + (ent >> 1)) * D + col0;
#pragma unroll
                    for (int bj = 0; bj < 2; ++bj) { const pg8::f32x4 v0 = acc[ai][bj][m][0] * g, v1 = acc[ai][bj][m][1] * g;
                        int w0 = __builtin_amdgcn_cvt_pk_fp8_f32(v0[0], v0[1], 0, false); w0 = __builtin_amdgcn_cvt_pk_fp8_f32(v0[2], v0[3], w0, true);
                        int w1 = __builtin_amdgcn_cvt_pk_fp8_f32(v1[0], v1[1], 0, false); w1 = __builtin_amdgcn_cvt_pk_fp8_f32(v1[2], v1[3], w1, true);
                        v2u w; w.x = (unsigned)w0; w.y = (unsigned)w1; *(v2u*)(rowp + bj * 128) = w; } } }
    }
};
template <int MODE> __device__ __forceinline__ void f_moe_gemm(Frame& F, int L, LAS int* tst, LAS int* cntl) {
    LAS int* tab = (LAS int*)(F.lds + LX_TAB); LAS float* gt = (LAS float*)(F.lds + LX_GT);
    MoeOrder<MODE == 0> S; S.G = F.G; S.c = F.bid; S.nunits = 4 * tst[NE]; S.K = MODE == 0 ? D : FF; S.rowb = S.K; S.mode = MODE; S.tst = tst; S.tab = tab;
    S.hcnt = WSP(unsigned, WS_CTL) + CW_HID + L * 4608;
    { const int r1 = (S.nunits + F.G - 1) / F.G, nlast = S.nunits - (r1 - 1) * F.G;
      S.n5 = (MODE == 1 && r1 >= 3 && nlast < F.G) ? nlast : 0; S.rb = r1 - 2; }
    S.W = MODE == 0 ? (const char*)(WSP(unsigned char, WS_W13) + (size_t)L * NE * 1024 * 1024) : (const char*)(WSP(unsigned char, WS_W2) + (size_t)L * NE * 1024 * 512);
    S.estride = MODE == 0 ? (size_t)1024 * 1024 : (size_t)1024 * 512;
    const int* list = WSP(int, WS_LIST); const float* gates = WSP(float, WS_GATE);
    for (int ibase = 0; ibase * (S.n5 > 0 ? F.G - S.n5 : F.G) < S.nunits; ibase += MOE_MAXU) {
        S.ibase = ibase;
        {
            static_assert(MOE_MAXU == 6, "three table slots per thread half");
            int ents[3]; float gsv[3]; const int r = FTID & 255, hsel = FTID >> 8;
#pragma unroll
            for (int k = 0; k < 3; ++k) { pg8::Unit u; ents[k] = -1;
                if (S.next(2 * k + hsel, u)) { const int idx = (u.pm - tst[u.e]) * 256 + r; if (idx < cntl[u.e]) ents[k] = list[(size_t)u.e * T + idx]; } }
#pragma unroll
            for (int k = 0; k < 3; ++k) gsv[k] = ents[k] >= 0 ? (MODE == 0 ? WSP(float, WS_RS)[ents[k] >> 1] : gates[ents[k]]) : 0.f;
#pragma unroll
            for (int k = 0; k < 3; ++k) { tab[(2 * k + hsel) * 256 + r] = ents[k]; gt[(2 * k + hsel) * 256 + r] = gsv[k]; }
        }
        S.rdy = 0u;
        if (MODE == 1) {
            LAS unsigned* rdyw = (LAS unsigned*)(F.lds + LX_TST + 448);
            if (FTID < 64) { unsigned m = 0u;
                for (int i = 0; i < MOE_MAXU; ++i) { pg8::Unit u; if (S.next(i, u) && (unsigned)__builtin_amdgcn_readfirstlane(__hip_atomic_load(S.hcnt + 16 * u.pm, __ATOMIC_RELAXED, __HIP_MEMORY_SCOPE_AGENT)) >= 32u) m |= 1u << i; }
                __builtin_amdgcn_fence(__ATOMIC_ACQUIRE, "agent"); asm volatile("s_waitcnt vmcnt(0)" ::: "memory");
                if (FTID == 0) *rdyw = m; }
            __syncthreads();
            S.rdy = *rdyw;
        }
        __syncthreads();
        if (MODE == 0) { EpiSwiglu E{WSP(unsigned char, WS_HID), gt}; pg8::gemm_phase_es<1>(F.lds, WSP(unsigned char, WS_XB8), D, S, E); }
        else { EpiScatterY E{WSP(unsigned char, WS_Y), tab, gt}; pg8::gemm_phase_es<1>(F.lds, WSP(unsigned char, WS_HID), FF, S, E); }
        __syncthreads();
    }
}
__device__ __forceinline__ void f_moe(Frame& F, int L) {
    LAS int* tst = (LAS int*)(F.lds + LX_TST); LAS int* cntl = tst + 64;
    unsigned* ctl = WSP(unsigned, WS_CTL);
    __syncthreads();
    if (FTID < NE) cntl[FTID] = (int)__hip_atomic_load(&ctl[CW_CNT + L * 2048 + 64 * FTID], __ATOMIC_RELAXED, __HIP_MEMORY_SCOPE_AGENT);
    __syncthreads();
    if (FTID == 0) { int s = 0; for (int e = 0; e < NE; ++e) { tst[e] = s; s += (cntl[e] + 255) >> 8; } tst[NE] = s; }
    __syncthreads();
    f_moe_gemm<0>(F, L, tst, cntl);
    f_moe_gemm<1>(F, L, tst, cntl);
}
__device__ __forceinline__ void transpose_item(const float* W, int ldw, const float* kscale, float cs, bf16* WT, int K, int dst_row0, LAS float* scr, int k0, int n0, int lane) {
    f32x4 x[8]; float ks[8];
    const int kr = lane >> 3, n4 = (lane & 7) * 4;
#pragma unroll
    for (int i = 0; i < 8; ++i) { x[i] = *(const f32x4*)(W + (size_t)(k0 + 8 * i + kr) * ldw + n0 + n4); ks[i] = kscale ? kscale[k0 + 8 * i + kr] * cs : cs; }
#pragma unroll
    for (int i = 0; i < 8; ++i) { LAS float* d = scr + (8 * i + kr) * 33 + n4; d[0] = x[i][0] * ks[i]; d[1] = x[i][1] * ks[i]; d[2] = x[i][2] * ks[i]; d[3] = x[i][3] * ks[i]; }
    LDS_WAIT(); asm volatile("" ::: "memory");
    const int c = lane & 7;
#pragma unroll
    for (int j = 0; j < 4; ++j) { const int n = (lane >> 3) + 8 * j; const LAS float* s = scr + (8 * c) * 33 + n;
        v4u o; o.x = pk2(s[0 * 33], s[1 * 33]); o.y = pk2(s[2 * 33], s[3 * 33]); o.z = pk2(s[4 * 33], s[5 * 33]); o.w = pk2(s[6 * 33], s[7 * 33]);
        *(v4u*)(WT + (size_t)(dst_row0 + n) * K + k0 + 8 * c) = o; }
    LDS_WAIT(); asm volatile("" ::: "memory");
}
__device__ __forceinline__ void transpose_item8(const float* W, int ldw, const float* kscale, float cs, unsigned char* WT, int K, int dst_row0, LAS float* scr, int k0, int n0, int lane) {
    f32x4 x[8]; float ks[8];
    const int kr = lane >> 3, n4 = (lane & 7) * 4;
#pragma unroll
    for (int i = 0; i < 8; ++i) { x[i] = *(const f32x4*)(W + (size_t)(k0 + 8 * i + kr) * ldw + n0 + n4); ks[i] = kscale ? kscale[k0 + 8 * i + kr] * cs : cs; }
#pragma unroll
    for (int i = 0; i < 8; ++i) { LAS float* d = scr + (8 * i + kr) * 33 + n4; d[0] = x[i][0] * ks[i]; d[1] = x[i][1] * ks[i]; d[2] = x[i][2] * ks[i]; d[3] = x[i][3] * ks[i]; }
    LDS_WAIT(); asm volatile("" ::: "memory");
    const int c = lane & 7;
#pragma unroll
    for (int j = 0; j < 4; ++j) { const int n = (lane >> 3) + 8 * j; const LAS float* s = scr + (8 * c) * 33 + n;
        int w0 = __builtin_amdgcn_cvt_pk_fp8_f32(s[0 * 33], s[1 * 33], 0, false); w0 = __builtin_amdgcn_cvt_pk_fp8_f32(s[2 * 33], s[3 * 33], w0, true);
        int w1 = __builtin_amdgcn_cvt_pk_fp8_f32(s[4 * 33], s[5 * 33], 0, false); w1 = __builtin_amdgcn_cvt_pk_fp8_f32(s[6 * 33], s[7 * 33], w1, true);
        v2u o; o.x = (unsigned)w0; o.y = (unsigned)w1; *(v2u*)(WT + (size_t)(dst_row0 + n) * K + k0 + 8 * c) = o; }
    LDS_WAIT(); asm volatile("" ::: "memory");
}
__device__ __forceinline__ void convert_job_item8(const float* W, int ldw, int K, int N, const float* kscale, float cs, unsigned char* WT, int rowmap, LAS float* scr, int item, int lane) {
    const int nblk = N / 32, kb = item / nblk, nb = item % nblk, k0 = 64 * kb, n0 = 32 * nb;
    const int dr = rowmap == 0 ? n0 : ((n0 >> 7) * 256 + (n0 & 127) + (rowmap == 2 ? 128 : 0));
    transpose_item8(W, ldw, kscale, cs, WT, K, dr, scr, k0, n0, lane);
}
__device__ __forceinline__ void convert_job_item(const float* W, int ldw, int K, int N, const float* kscale, int qcols, float qs, bf16* WT, int rowmap, LAS float* scr, int item, int lane) {
    const int nblk = N / 32, kb = item / nblk, nb = item % nblk, k0 = 64 * kb, n0 = 32 * nb;
    const int dr = rowmap == 0 ? n0 : ((n0 >> 7) * 256 + (n0 & 127) + (rowmap == 2 ? 128 : 0));
    transpose_item(W, ldw, kscale, n0 < qcols ? qs : 1.f, WT, K, dr, scr, k0, n0, lane);
}
__device__ __forceinline__ void f_convert_gla(Frame& F) {
    LAS float* scr = (LAS float*)(F.lds + FWAVE * 8448);
    const int gw = F.bid * NWAVES + FWAVE, NGW = F.G * NWAVES;
    constexpr int I0 = (D / 64) * (NQKVR / 32), I1 = (HV / 64) * (D / 32);
    for (int it = gw; it < I0 + I1; it += NGW) {
        if (it < I0) convert_job_item(F.inp(I_GLA_WIN), GLA_IN, D, NQKVR, F.inp(I_GLA_NORM), HK, 0.08838834764831845f, WSP(bf16, WS_WIN), 0, scr, it, FLANE);
        else convert_job_item(F.inp(I_GLA_WOUT), D, HV, D, F.inp(I_GLA_HG), 0, 1.f, WSP(bf16, WS_WOUT), 0, scr, it - I0, FLANE);
    }
}
__device__ __forceinline__ void f_convert_rest(Frame& F, int cw, int NCW, int pct0 = 0, int pct1 = 1000) {
    LAS float* scr = (LAS float*)(F.lds + FWAVE * 8448);
    constexpr int I0 = (D / 64) * (SGU_FFN / 32), I1 = (SGU_HALF / 64) * (D / 32), IE1 = (D / 64) * (FF / 32), IE2 = (FF / 64) * (D / 32);
    constexpr int IM = 2 * NE * IE1;
    static_assert(IE1 == IE2, "w1 / w2 item counts");
    constexpr int NIT = I0 + I1 + 3 * IM; const int it_lo = (int)((long)NIT * pct0 / 1000), it_hi = (int)((long)NIT * pct1 / 1000);
    for (int it = it_lo + cw; it < it_hi; it += NCW) {
        int r = it;
        if (r < I0) { convert_job_item(F.inp(I_SGU_WIN), SGU_FFN, D, SGU_FFN, F.inp(I_SGU_NORM), 0, 1.f, WSP(bf16, WS_WSIN), 0, scr, r, FLANE); continue; } r -= I0;
        if (r < I1) { convert_job_item(F.inp(I_SGU_WOUT), D, SGU_HALF, D, nullptr, 0, 1.f, WSP(bf16, WS_WSOUT), 0, scr, r, FLANE); continue; } r -= I1;
        const int which = r / IM; r -= which * IM; const int le = r / IE1, li = r % IE1, L = le / NE;
        if (which == 0) convert_job_item8(F.inp(I_MOE_W1) + (size_t)le * D * FF, FF, D, FF, F.inp(I_MOE_NORM) + L * D, MOE_WSCALE, WSP(unsigned char, WS_W13) + (size_t)le * 1024 * 1024, 1, scr, li, FLANE);
        else if (which == 1) convert_job_item8(F.inp(I_MOE_W3) + (size_t)le * D * FF, FF, D, FF, F.inp(I_MOE_NORM) + L * D, MOE_WSCALE, WSP(unsigned char, WS_W13) + (size_t)le * 1024 * 1024, 2, scr, li, FLANE);
        else convert_job_item8(F.inp(I_MOE_W2) + (size_t)le * FF * D, D, FF, D, nullptr, MOE_WSCALE, WSP(unsigned char, WS_W2) + (size_t)le * 1024 * 512, 0, scr, li, FLANE);
    }
}

constexpr int SC_K = 0, SC_KSTR = 320;
constexpr int SC_V = 20480, SC_VSTR = 576;
constexpr int SC_Q = 57344, SC_QSTR = 272;
constexpr int SC_O = 74752, SC_OSTR = 528;
constexpr int SC_GL = 108544, SC_PART = 112640, SC_DEC = 114688, SC_WG = 115200;
__device__ __forceinline__ s16x4 tr_read16(LAS const unsigned char* p) {
    typedef short v4i16_t __attribute__((ext_vector_type(4)));
    return __builtin_bit_cast(s16x4, __builtin_amdgcn_ds_read_tr16_b64_v4i16((LAS v4i16_t*)p));
}
__device__ __forceinline__ void f_scan_item(Frame& F, int item, const XcdBarrier* xb_ = nullptr, int cbar = -1) {
    const int b = item / GLA_H, h = item % GLA_H;
    const bf16* qkvr = WSP(bf16, WS_QKVR); const float* glr = WSP(float, WS_GLR); bf16* aout = WSP(bf16, WS_AOUT);
    LAS unsigned char* L = F.lds;
    LAS float* gl = (LAS float*)(L + SC_GL); LAS float* part = (LAS float*)(L + SC_PART); LAS float* dec = (LAS float*)(L + SC_DEC);
    const int tid = FTID, lane = FLANE, w = FWAVE;
    const int r32 = lane & 31, hh = lane >> 5, blk = (lane >> 4) & 1, q4 = (lane & 15) >> 2, p4 = lane & 3;
    const int dk = tid & 127, tg = tid >> 7;
    const int gq = lane >> 4, gcol = lane & 15, gdk = 16 * w + gcol;
    bf16x8 gBh, gBl;
    { unsigned ph[4], pl[4];
#pragma unroll
      for (int j = 0; j < 4; ++j) { const float x0 = gq < 2 ? F.inp(I_GLA_WGU)[(8 * gq + 2 * j) * HK + h * DK + gdk] : 0.f, x1 = gq < 2 ? F.inp(I_GLA_WGU)[(8 * gq + 2 * j + 1) * HK + h * DK + gdk] : 0.f;
          ph[j] = pk2(x0, x1); pl[j] = pk2(x0 - bflo(ph[j]), x1 - bfhi(ph[j])); }
      v4u vh = {ph[0], ph[1], ph[2], ph[3]}, vl = {pl[0], pl[1], pl[2], pl[3]};
      gBh = __builtin_bit_cast(bf16x8, vh); gBl = __builtin_bit_cast(bf16x8, vl); }
    const float gbias = F.inp(I_GLA_BG)[h * DK + gdk];
    __syncthreads();
    f32x16 st[4];
#pragma unroll
    for (int i = 0; i < 4; ++i)
#pragma unroll
        for (int j = 0; j < 16; ++j) st[i][j] = 0.f;
    v4u rk[2], rq[2], rv[4]; f32x4 rg;
    const size_t rowb = (size_t)b * SEQ;
    const unsigned vo_kq = (unsigned)(((tid >> 4) * NQKVR + (tid & 15) * 8) * 2), vo_v = (unsigned)(((tid >> 5) * NQKVR + (tid & 31) * 8) * 2), vo_g = (unsigned)(tid * 16);
    const unsigned lo_k = (unsigned)(SC_K + (tid >> 4) * SC_KSTR + (tid & 15) * 16), lo_q = (unsigned)(SC_Q + (tid >> 4) * SC_QSTR + (tid & 15) * 16), lo_v = (unsigned)(SC_V + (tid >> 5) * SC_VSTR + (tid & 31) * 16);
#define SC_LOAD(c) do { size_t cb_ = (rowb + (size_t)(c) * CHUNK) * NQKVR * 2; asm volatile("" : "+s"(cb_)); const char* gb_ = (const char*)qkvr + cb_ + (size_t)(h * DK * 2); \
        _Pragma("unroll") for (int i = 0; i < 2; ++i) { \
            rk[i] = *(const v4u*)(gb_ + (size_t)(HK * 2 + i * 32 * NQKVR * 2) + vo_kq); rq[i] = *(const v4u*)(gb_ + (size_t)(i * 32 * NQKVR * 2) + vo_kq); } \
        _Pragma("unroll") for (int i = 0; i < 4; ++i) rv[i] = *(const v4u*)(gb_ + (size_t)(2 * HK * 2 + h * (DV - DK) * 2 + i * 16 * NQKVR * 2) + vo_v); \
        if (tid < 256) rg = *(const f32x4*)((const char*)glr + (rowb + (size_t)(c) * CHUNK) * RANK * 4 + vo_g); } while (0)
#define SC_STORE() do { \
        _Pragma("unroll") for (int i = 0; i < 2; ++i) { *(LAS v4u*)(L + lo_k + i * 32 * SC_KSTR) = rk[i]; *(LAS v4u*)(L + lo_q + i * 32 * SC_QSTR) = rq[i]; } \
        _Pragma("unroll") for (int i = 0; i < 4; ++i) *(LAS v4u*)(L + lo_v + i * 16 * SC_VSTR) = rv[i]; \
        if (tid < 256) *(LAS f32x4*)(gl + tid * 4) = rg; } while (0)
    SC_LOAD(0);
    SC_STORE();
    for (int c = 0; c < NCHUNK; ++c) {
        if (c == cbar) xcd_barrier(*xb_);
        const size_t t0 = rowb + (size_t)c * CHUNK;
        __syncthreads();
        if (c + 1 < NCHUNK) SC_LOAD(c + 1);
        {
            pg8::f32x4 g4[4]; float tsum[4], pre[4];
#pragma unroll
            for (int t = 0; t < 4; ++t) {
                v4u ah = {0u, 0u, 0u, 0u}, al = {0u, 0u, 0u, 0u};
                if (gq < 2) { const f32x4 x0 = *(const LAS f32x4*)(gl + (16 * t + gcol) * 16 + 8 * gq), x1 = *(const LAS f32x4*)(gl + (16 * t + gcol) * 16 + 8 * gq + 4);
                    ah.x = pk2(x0[0], x0[1]); ah.y = pk2(x0[2], x0[3]); ah.z = pk2(x1[0], x1[1]); ah.w = pk2(x1[2], x1[3]);
                    al.x = pk2(x0[0] - bflo(ah.x), x0[1] - bfhi(ah.x)); al.y = pk2(x0[2] - bflo(ah.y), x0[3] - bfhi(ah.y)); al.z = pk2(x1[0] - bflo(ah.z), x1[1] - bfhi(ah.z)); al.w = pk2(x1[2] - bflo(ah.w), x1[3] - bfhi(ah.w)); }
                pg8::f32x4 a4 = {gbias, gbias, gbias, gbias};
                a4 = __builtin_amdgcn_mfma_f32_16x16x32_bf16(__builtin_bit_cast(bf16x8, ah), gBh, a4, 0, 0, 0);
                a4 = __builtin_amdgcn_mfma_f32_16x16x32_bf16(__builtin_bit_cast(bf16x8, al), gBh, a4, 0, 0, 0);
                a4 = __builtin_amdgcn_mfma_f32_16x16x32_bf16(__builtin_bit_cast(bf16x8, ah), gBl, a4, 0, 0, 0);
#pragma unroll
                for (int i = 0; i < 4; ++i) { const float a = a4[i]; a4[i] = (fminf(a, 0.f) - __logf(1.f + __expf(-fabsf(a)))) * (1.f / 16.f); }
                a4[1] += a4[0]; a4[2] += a4[1]; a4[3] += a4[2];
                g4[t] = a4;
                const float s0 = a4[3], x1 = __shfl_xor(s0, 16), x2 = __shfl_xor(s0, 32), x3 = __shfl_xor(x1, 32);
                tsum[t] = (s0 + x1) + (x2 + x3);
                pre[t] = ((gq ^ 1) < gq ? x1 : 0.f) + ((gq ^ 2) < gq ? x2 : 0.f) + ((gq ^ 3) < gq ? x3 : 0.f);
            }
            const float tot = (tsum[0] + tsum[1]) + (tsum[2] + tsum[3]);
            float basep = 0.f;
#pragma unroll
            for (int t = 0; t < 4; ++t) {
#pragma unroll
                for (int i = 0; i < 4; ++i) {
                    LAS unsigned short* kp = (LAS unsigned short*)(L + SC_K + (16 * t + 4 * gq + i) * SC_KSTR + gdk * 2);
                    *kp = (unsigned short)f2bf(bf2f(*kp) * __expf(tot - (basep + pre[t] + g4[t][i])));
                }
                basep += tsum[t];
            }
            if (gq == 0) dec[gdk] = __expf(tot);
        }
        __syncthreads();
        const int etok = tid >> 3, ecc = tid & 7;
        v4u rr[4];
        { size_t eb_ = t0 * NQKVR * 2; asm volatile("" : "+s"(eb_));
          const char* rb_ = (const char*)qkvr + eb_ + (size_t)((2 * HK + HV + h * DV) * 2); const unsigned vo_r = (unsigned)(etok * NQKVR * 2 + ecc * 16);
#pragma unroll
          for (int i = 0; i < 4; ++i) rr[i] = *(const v4u*)(rb_ + vo_r + i * 128); }
#pragma unroll
        for (int i = 0; i < 4; ++i)
#pragma unroll
            for (int g4 = 0; g4 < 4; ++g4) { const f32x4 d4 = *(const LAS f32x4*)(dec + 32 * i + 8 * g4 + 4 * hh);
#pragma unroll
                for (int j = 0; j < 4; ++j) st[i][4 * g4 + j] *= d4[j]; }
#pragma unroll
        for (int s = 0; s < 4; ++s) {
            const int trow = 16 * s + 8 * hh + q4;
            const s16x4 v0 = tr_read16(L + SC_V + trow * SC_VSTR + (32 * w + 16 * blk + 4 * p4) * 2), v1 = tr_read16(L + SC_V + (trow + 4) * SC_VSTR + (32 * w + 16 * blk + 4 * p4) * 2);
            const bf16x8 Bv = {v0[0], v0[1], v0[2], v0[3], v1[0], v1[1], v1[2], v1[3]};
#pragma unroll
            for (int i = 0; i < 4; ++i) {
                const s16x4 k0 = tr_read16(L + SC_K + trow * SC_KSTR + (32 * i + 16 * blk + 4 * p4) * 2), k1 = tr_read16(L + SC_K + (trow + 4) * SC_KSTR + (32 * i + 16 * blk + 4 * p4) * 2);
                const bf16x8 Ak = {k0[0], k0[1], k0[2], k0[3], k1[0], k1[1], k1[2], k1[3]};
                st[i] = __builtin_amdgcn_mfma_f32_32x32x16_bf16(Ak, Bv, st[i], 0, 0, 0);
            }
        }
        {
        f32x16 oacc[2];
#pragma unroll
        for (int ot = 0; ot < 2; ++ot)
#pragma unroll
            for (int j = 0; j < 16; ++j) oacc[ot][j] = 0.f;
#pragma unroll
        for (int i = 0; i < 4; ++i)
#pragma unroll
            for (int s2 = 0; s2 < 2; ++s2) {
                v4u pb; pb.x = pk2(st[i][8 * s2 + 0], st[i][8 * s2 + 1]); pb.y = pk2(st[i][8 * s2 + 2], st[i][8 * s2 + 3]); pb.z = pk2(st[i][8 * s2 + 4], st[i][8 * s2 + 5]); pb.w = pk2(st[i][8 * s2 + 6], st[i][8 * s2 + 7]);
                const bf16x8 Bs = __builtin_bit_cast(bf16x8, pb);
#pragma unroll
                for (int ot = 0; ot < 2; ++ot) {
                    LAS const unsigned char* qp = L + SC_Q + (32 * ot + r32) * SC_QSTR + (32 * i + 16 * s2 + 4 * hh) * 2;
                    const v2u a0 = *(const LAS v2u*)qp, a1 = *(const LAS v2u*)(qp + 16);
                    v4u pa; pa.x = a0.x; pa.y = a0.y; pa.z = a1.x; pa.w = a1.y;
                    oacc[ot] = __builtin_amdgcn_mfma_f32_32x32x16_bf16(__builtin_bit_cast(bf16x8, pa), Bs, oacc[ot], 0, 0, 0);
                }
            }
#pragma unroll
        for (int ot = 0; ot < 2; ++ot)
#pragma unroll
            for (int rg16 = 0; rg16 < 16; ++rg16) {
                const int tok = 32 * ot + (rg16 & 3) + 8 * (rg16 >> 2) + 4 * hh;
                *(LAS unsigned short*)(L + SC_O + tok * SC_OSTR + (32 * w + r32) * 2) = (unsigned short)f2bf(oacc[ot][rg16]);
            }
        }
        __syncthreads();
        if (c + 1 < NCHUNK) SC_STORE();
        {
        {
            const int tok = etok, cc = ecc;
            v4u ov[4]; float ss = 0.f;
#pragma unroll
            for (int i = 0; i < 4; ++i) ov[i] = *(const LAS v4u*)(L + SC_O + tok * SC_OSTR + cc * 16 + i * 128);
#pragma unroll
            for (int i = 0; i < 4; ++i) { const float a0 = bflo(ov[i].x), a1 = bfhi(ov[i].x), a2 = bflo(ov[i].y), a3 = bfhi(ov[i].y), a4 = bflo(ov[i].z), a5 = bfhi(ov[i].z), a6 = bflo(ov[i].w), a7 = bfhi(ov[i].w);
                ss += (a0 * a0 + a1 * a1) + (a2 * a2 + a3 * a3) + (a4 * a4 + a5 * a5) + (a6 * a6 + a7 * a7); }
            ss += __shfl_xor(ss, 1); ss += __shfl_xor(ss, 2); ss += __shfl_xor(ss, 4);
            const float rms = __builtin_amdgcn_rsqf(ss * (1.f / DV) + EPS);
            size_t ob_ = (t0 * D + h * DV) * 2; asm volatile("" : "+s"(ob_)); const unsigned vo_o = (unsigned)(tok * D * 2 + cc * 16);
#pragma unroll
            for (int i = 0; i < 4; ++i) {
                v4u o;
                o.x = pk2(bflo(ov[i].x) * rms * bflo(rr[i].x), bfhi(ov[i].x) * rms * bfhi(rr[i].x));
                o.y = pk2(bflo(ov[i].y) * rms * bflo(rr[i].y), bfhi(ov[i].y) * rms * bfhi(rr[i].y));
                o.z = pk2(bflo(ov[i].z) * rms * bflo(rr[i].z), bfhi(ov[i].z) * rms * bfhi(rr[i].z));
                o.w = pk2(bflo(ov[i].w) * rms * bflo(rr[i].w), bfhi(ov[i].w) * rms * bfhi(rr[i].w));
                *(v4u*)((char*)aout + ob_ + vo_o + i * 128) = o;
            }
        }
            }
    }
    __syncthreads();
#undef SC_LOAD
#undef SC_STORE
}
constexpr int SCAN_C1 = 20;
__device__ __forceinline__ void f_scan_outproj(Frame& F, const XcdBarrier& xbar) {
    constexpr int NITEM = NBATCH * GLA_H;
    if (F.bid < NITEM) f_scan_item(F, F.bid, &xbar, SCAN_C1);
    else { f_convert_rest(F, (F.bid - NITEM) * NWAVES + FWAVE, (F.G - NITEM) * NWAVES); xcd_barrier(xbar); f_gemm_out_rows(F, 0, SCAN_C1 / 4, NITEM); }
    xcd_barrier(xbar);
    f_gemm_out_rows(F, SCAN_C1 / 4, 8, 0);
}
constexpr int MX_W = 0, MX_WSTR = 272;
constexpr int MX_V0 = 34816, MX_VSTR = 320, MX_VBYTES = 40960;
constexpr int MX_MU = 116736;
constexpr int MX_LN = MX_MU + 2560;
__device__ __forceinline__ void f_mix(Frame& F) {
    LAS unsigned char* L = F.lds;
    LAS float* mu = (LAS float*)(L + MX_MU); LAS float* rs = mu + 128; LAS float* m1 = rs + 128; LAS float* m0 = m1 + 128; LAS float* bsg = m0 + 128;
    LAS float* lgs = (LAS float*)(L + MX_LN); LAS float* lbs = lgs + 512;
    bf16* u = WSP(bf16, WS_U); const bf16* v = WSP(bf16, WS_V); const float* st = WSP(float, WS_STATS); bf16* uout = u;
    const int tid = FTID, lane = FLANE, w = FWAVE;
    const int r32 = lane & 31, hh = lane >> 5, blk = (lane >> 4) & 1, q4 = (lane & 15) >> 2, p4 = lane & 3;
    const int ct = w >> 1, th = w & 1;
    const unsigned vo_v = (unsigned)(tid * 16), lo_v = (unsigned)(MX_V0 + (tid >> 4) * MX_VSTR + (tid & 15) * 16);
    constexpr int MX_MSTR = 272;
    for (int bn = F.bid; bn < T / SGU_BLK; bn += F.G) {
        const size_t t0 = (size_t)bn * SGU_BLK;
        __syncthreads();
        {
            const int row = tid & 127, pq = tid >> 7; float s = 0.f, q = 0.f;
#pragma unroll
            for (int p = 0; p < 8; ++p) { const pg8::f32x2 a = *(const pg8::f32x2*)(st + ((size_t)(pq * 8 + p) * T + t0 + row) * 2); s += a.x; q += a.y; }
            LAS float* red = (LAS float*)(L + MX_V0);
            red[(pq * 128 + row) * 2] = s; red[(pq * 128 + row) * 2 + 1] = q;
            __syncthreads();
            if (tid < 128) { float s4 = 0.f, q4 = 0.f;
#pragma unroll
                for (int p = 0; p < 4; ++p) { s4 += red[(p * 128 + tid) * 2]; q4 += red[(p * 128 + tid) * 2 + 1]; }
                const float m = s4 * (1.f / SGU_HALF); mu[tid] = m; rs[tid] = __builtin_amdgcn_rsqf(fmaxf(q4 * (1.f / SGU_HALF) - m * m, 0.f) + EPS); }
            __syncthreads();
        }
        v4u preA[4], preB[4]; v4u uuA[4], uuB[4];
#define MX_LOAD(pre_, it_) do { size_t vb_ = ((size_t)bn * 16 + (size_t)(it_)) << 15; asm volatile("" : "+s"(vb_)); \
        _Pragma("unroll") for (int i = 0; i < 4; ++i) pre_[i] = *(const v4u*)((const char*)v + vb_ + (size_t)(i * 8192) + vo_v); } while (0)
#define MX_STORE(buf_, pre_) do { _Pragma("unroll") for (int i = 0; i < 4; ++i) *(LAS v4u*)(L + lo_v + (buf_) * MX_VBYTES + 32 * i * MX_VSTR) = pre_[i]; } while (0)
#define MX_ULOAD(uu_, it_) do { size_t ub_ = ((size_t)bn * 16 + (size_t)(it_)) << 15; asm volatile("" : "+s"(ub_)); \
        _Pragma("unroll") for (int i = 0; i < 4; ++i) uu_[i] = *(const v4u*)((const char*)u + ub_ + (size_t)(i * 8192) + vo_v); } while (0)
#define MX_TILE(it_, buf_, uu_) do { \
        f32x16 acc[2]; \
        _Pragma("unroll") for (int tt = 0; tt < 2; ++tt) _Pragma("unroll") for (int j = 0; j < 16; ++j) acc[tt][j] = 0.f; \
        LAS unsigned char* Vb = L + MX_V0 + (buf_) * MX_VBYTES; \
        const int nks = th == 0 ? 4 : 8; \
        for (int ks = 0; ks < nks; ++ks) { \
            const int srow = 16 * ks + 8 * hh + q4; \
            const s16x4 a0 = tr_read16(Vb + srow * MX_VSTR + (32 * ct + 16 * blk + 4 * p4) * 2), a1 = tr_read16(Vb + (srow + 4) * MX_VSTR + (32 * ct + 16 * blk + 4 * p4) * 2); \
            const bf16x8 Av = {a0[0], a0[1], a0[2], a0[3], a1[0], a1[1], a1[2], a1[3]}; \
            _Pragma("unroll") for (int tt = 0; tt < 2; ++tt) { \
                const bf16x8 Bw = *(const LAS bf16x8*)(L + MX_W + (64 * th + 32 * tt + r32) * MX_WSTR + (16 * ks + 8 * hh) * 2); \
                acc[tt] = __builtin_amdgcn_mfma_f32_32x32x16_bf16(Av, Bw, acc[tt], 0, 0, 0); } } \
        const int cl = ((it_) & 3) * 128 + 32 * ct + 4 * hh;                    \
        __syncthreads();                                                         \
        _Pragma("unroll") for (int tt = 0; tt < 2; ++tt) { \
            const int t = 64 * th + 32 * tt + r32; const float tm1 = m1[t], tm0 = m0[t], tb = bsg[t]; \
            _Pragma("unroll") for (int g4 = 0; g4 < 4; ++g4) { \
                const f32x4 lg = *(const LAS f32x4*)(lgs + cl + 8 * g4), lb = *(const LAS f32x4*)(lbs + cl + 8 * g4); \
                v2u o; o.x = pk2(lg[0] * (acc[tt][4 * g4 + 0] - tm1) + lb[0] * tm0 + tb, lg[1] * (acc[tt][4 * g4 + 1] - tm1) + lb[1] * tm0 + tb); \
                o.y = pk2(lg[2] * (acc[tt][4 * g4 + 2] - tm1) + lb[2] * tm0 + tb, lg[3] * (acc[tt][4 * g4 + 3] - tm1) + lb[3] * tm0 + tb); \
                *(LAS v2u*)(Vb + t * MX_MSTR + (32 * ct + 8 * g4 + 4 * hh) * 2) = o; } } \
        __syncthreads();                                                         \
        size_t ob_ = ((size_t)bn * 16 + (size_t)(it_)) << 15; asm volatile("" : "+s"(ob_)); \
        _Pragma("unroll") for (int i = 0; i < 4; ++i) { \
            const v4u mx = *(const LAS v4u*)(Vb + ((tid >> 4) + 32 * i) * MX_MSTR + (tid & 15) * 16); const v4u ux = uu_[i]; v4u o; \
            o.x = pk2(bflo(ux.x) * bflo(mx.x), bfhi(ux.x) * bfhi(mx.x)); o.y = pk2(bflo(ux.y) * bflo(mx.y), bfhi(ux.y) * bfhi(mx.y)); \
            o.z = pk2(bflo(ux.z) * bflo(mx.z), bfhi(ux.z) * bfhi(mx.z)); o.w = pk2(bflo(ux.w) * bflo(mx.w), bfhi(ux.w) * bfhi(mx.w)); \
            *(v4u*)((char*)uout + ob_ + (size_t)(i * 8192) + vo_v) = o; } } while (0)
        MX_LOAD(preA, 0); MX_LOAD(preB, 1); MX_ULOAD(uuA, 0);
        for (int it = 0; it < 16; it += 2) {
            if ((it & 3) == 0) {
                const int g = it >> 2;
                __syncthreads();
                const int t = tid >> 2, sq = tid & 3; const float* wsrc = F.inp(I_SGU_WS) + ((size_t)g * 128 + t) * 128 + sq * 8;
                float a1 = 0.f, a0 = 0.f;
#pragma unroll
                for (int i = 0; i < 4; ++i) {
                    const f32x4 x0 = *(const f32x4*)(wsrc + i * 32), x1 = *(const f32x4*)(wsrc + i * 32 + 4); float wv[8] = {x0[0], x0[1], x0[2], x0[3], x1[0], x1[1], x1[2], x1[3]}; float hv[8];
#pragma unroll
                    for (int j = 0; j < 8; ++j) { const int s = i * 32 + sq * 8 + j; const float wm = ((t >> 6) >= (s >> 6)) ? wv[j] : 0.f; a0 += wm; hv[j] = wm * rs[s]; }
                    v4u o; o.x = pk2(hv[0], hv[1]); o.y = pk2(hv[2], hv[3]); o.z = pk2(hv[4], hv[5]); o.w = pk2(hv[6], hv[7]);
                    const unsigned ow[4] = {o.x, o.y, o.z, o.w};
#pragma unroll
                    for (int j = 0; j < 4; ++j) a1 += bflo(ow[j]) * mu[i * 32 + sq * 8 + 2 * j] + bfhi(ow[j]) * mu[i * 32 + sq * 8 + 2 * j + 1];
                    *(LAS v4u*)(L + MX_W + t * MX_WSTR + (i * 32 + sq * 8) * 2) = o;
                }
                a1 += __shfl_xor(a1, 1); a1 += __shfl_xor(a1, 2); a0 += __shfl_xor(a0, 1); a0 += __shfl_xor(a0, 2);
                if (sq == 0) { m1[t] = a1; m0[t] = a0; }
                if (tid < 128) bsg[tid] = F.inp(I_SGU_BS)[g * 128 + tid];
                lgs[tid] = F.inp(I_SGU_LNG)[g * SGU_GC + tid]; lbs[tid] = F.inp(I_SGU_LNB)[g * SGU_GC + tid];
            }
            MX_STORE(0, preA);
            __syncthreads();
            if (it + 2 < 16) MX_LOAD(preA, it + 2);
            MX_ULOAD(uuB, it + 1);
            MX_TILE(it, 0, uuA);
            MX_STORE(1, preB);
            __syncthreads();
            if (it + 3 < 16) MX_LOAD(preB, it + 3);
            if (it + 2 < 16) MX_ULOAD(uuA, it + 2);
            MX_TILE(it + 1, 1, uuB);
        }
#undef MX_LOAD
#undef MX_STORE
#undef MX_ULOAD
#undef MX_TILE
    }
}
constexpr int RW_STR = 2064;
constexpr int RW_LG = 48 * RW_STR;
constexpr int RW_HIST = RW_LG + 8 * 16 * 48 * 4;
template <int MODE> __device__ __forceinline__ void f_rowgroup(Frame& F, int Lyr) {
    constexpr int NCT = MODE == 0 ? 1 : 3;
    LAS unsigned char* L = F.lds;
    const int tid = FTID, lane = FLANE, w = FWAVE, rw = lane & 15, q = lane >> 4;
    const float* xsrc = F.inp(I_X);
    bf16* xb = WSP(bf16, WS_XN); float* rsout = WSP(float, WS_RS);
    __syncthreads();
    for (int k = tid; k < D; k += NTHREADS) {
        if (MODE == 0) {
            const float gn = F.inp(I_GLA_NORM)[k]; const float* wr_ = F.inp(I_GLA_WIN) + (size_t)k * GLA_IN + NQKVR;
#pragma unroll
            for (int c4 = 0; c4 < 4; ++c4) { const f32x4 x = *(const f32x4*)(wr_ + 4 * c4);
#pragma unroll
                for (int j = 0; j < 4; ++j) *(LAS unsigned short*)(L + (4 * c4 + j) * RW_STR + k * 2) = (unsigned short)f2bf(x[j] * gn); }
        } else {
            const float gn = F.inp(I_MOE_NORM)[Lyr * D + k];
            const f32x4 xg = *(const f32x4*)(F.inp(I_MOE_WG) + ((size_t)Lyr * D + k) * 4);
#pragma unroll
            for (int j = 0; j < 4; ++j) *(LAS unsigned short*)(L + j * RW_STR + k * 2) = (unsigned short)f2bf(xg[j] * gn);
#pragma unroll
            for (int g = 0; g < 4; ++g) { const float* ws_ = F.inp(I_MOE_WSUB) + (((size_t)Lyr * 4 + g) * D + k) * EPG; const f32x4 a = *(const f32x4*)ws_, b = *(const f32x4*)(ws_ + 4);
#pragma unroll
                for (int j = 0; j < 4; ++j) { *(LAS unsigned short*)(L + (4 + 8 * g + j) * RW_STR + k * 2) = (unsigned short)f2bf(a[j] * gn); *(LAS unsigned short*)(L + (8 + 8 * g + j) * RW_STR + k * 2) = (unsigned short)f2bf(b[j] * gn); } }
#pragma unroll
            for (int c = 36; c < 48; ++c) *(LAS unsigned short*)(L + c * RW_STR + k * 2) = 0;
        }
    }
    LAS int* hist = (LAS int*)(L + RW_HIST); LAS int* hbase = hist + 32;
    if (MODE == 1 && tid < 32) hist[tid] = 0;
    __syncthreads();
    const int ngroups = T / 16, niter = (ngroups + F.G * NWAVES - 1) / (F.G * NWAVES);
    for (int iter = 0; iter < niter; ++iter) {
        const int grp = (iter * F.G + F.bid) * NWAVES + w; const bool valid = grp < ngroups;
        const size_t row = (size_t)grp * 16 + rw;
        float rstd = 0.f; pg8::f32x4 acc[NCT];
        if (valid) {
#pragma unroll
            for (int c = 0; c < NCT; ++c) acc[c] = (pg8::f32x4){0.f, 0.f, 0.f, 0.f};
            float ss = 0.f;
#pragma unroll 8
            for (int s = 0; s < 32; ++s) {
                v4u pa;
                if (MODE == 0) {
                    const float* xr = xsrc + row * D + 8 * q + 32 * s;
                    const f32x4 x0 = *(const f32x4*)xr, x1 = *(const f32x4*)(xr + 4);
                    ss += (x0[0] * x0[0] + x0[1] * x0[1]) + (x0[2] * x0[2] + x0[3] * x0[3]) + (x1[0] * x1[0] + x1[1] * x1[1]) + (x1[2] * x1[2] + x1[3] * x1[3]);
                    pa.x = pk2(x0[0], x0[1]); pa.y = pk2(x0[2], x0[3]); pa.z = pk2(x1[0], x1[1]); pa.w = pk2(x1[2], x1[3]);
                    *(v4u*)(xb + row * D + 8 * q + 32 * s) = pa;
                } else {
                    pa = *(const v4u*)(xb + row * D + 8 * q + 32 * s);
                    const float a0 = bflo(pa.x), a1 = bfhi(pa.x), a2 = bflo(pa.y), a3 = bfhi(pa.y), a4 = bflo(pa.z), a5 = bfhi(pa.z), a6 = bflo(pa.w), a7 = bfhi(pa.w);
                    ss += (a0 * a0 + a1 * a1) + (a2 * a2 + a3 * a3) + (a4 * a4 + a5 * a5) + (a6 * a6 + a7 * a7);
                    int w0 = __builtin_amdgcn_cvt_pk_fp8_f32(a0, a1, 0, false); w0 = __builtin_amdgcn_cvt_pk_fp8_f32(a2, a3, w0, true);
                    int w1 = __builtin_amdgcn_cvt_pk_fp8_f32(a4, a5, 0, false); w1 = __builtin_amdgcn_cvt_pk_fp8_f32(a6, a7, w1, true);
                    v2u o8; o8.x = (unsigned)w0; o8.y = (unsigned)w1; *(v2u*)(WSP(unsigned char, WS_XB8) + row * D + 8 * q + 32 * s) = o8;
                }
                const bf16x8 A = __builtin_bit_cast(bf16x8, pa);
#pragma unroll
                for (int c = 0; c < NCT; ++c) { const bf16x8 B = *(const LAS bf16x8*)(L + (16 * c + rw) * RW_STR + (32 * s + 8 * q) * 2); acc[c] = __builtin_amdgcn_mfma_f32_16x16x32_bf16(A, B, acc[c], 0, 0, 0); }
            }
            ss += __shfl_xor(ss, 16); ss += __shfl_xor(ss, 32);
            rstd = __builtin_amdgcn_rsqf(ss * (1.f / D) + EPS);
            if (q == 0) rsout[row] = rstd;
        }
        float rs4[4];
#pragma unroll
        for (int i = 0; i < 4; ++i) rs4[i] = __shfl(rstd, 4 * q + i);
        int e1 = 0, e2 = 0, rk1 = 0, rk2 = 0; float gt1 = 0.f, gt2 = 0.f;
        if (MODE == 0) {
            if (valid) {
                float* glr = WSP(float, WS_GLR);
#pragma unroll
                for (int i = 0; i < 4; ++i) glr[((size_t)grp * 16 + 4 * q + i) * RANK + rw] = acc[0][i] * rs4[i];
            }
        } else {
            LAS float* lgw = (LAS float*)(L + RW_LG) + w * 16 * 48;
            if (valid) {
#pragma unroll
                for (int c = 0; c < NCT; ++c)
#pragma unroll
                    for (int i = 0; i < 4; ++i) lgw[(4 * q + i) * 48 + 16 * c + rw] = acc[c][i] * rs4[i];
            }
            LDS_WAIT(); asm volatile("" ::: "memory");
            if (valid && lane < 16) {
                const LAS float* lr = lgw + lane * 48; const float* bg = F.inp(I_MOE_BG) + Lyr * 4;
                float lg[4];
#pragma unroll
                for (int c = 0; c < 4; ++c) lg[c] = lr[c] + bg[c];
                int g = 0; float gm = lg[0];
#pragma unroll
                for (int c = 1; c < 4; ++c) if (lg[c] > gm) { gm = lg[c]; g = c; }
                float gs = 0.f;
#pragma unroll
                for (int c = 0; c < 4; ++c) gs += __expf(lg[c] - gm);
                const float g_w = 1.f / gs; const float* bs = F.inp(I_MOE_BSUB) + (Lyr * 4 + g) * EPG;
                int i1 = 0, i2 = 0; float m1v = -3.0e38f, m2v = -3.0e38f;
                for (int e = 0; e < EPG; ++e) { const float x = lr[4 + 8 * g + e] + bs[e];
                    if (x > m1v) { m2v = m1v; i2 = i1; m1v = x; i1 = e; } else if (x > m2v) { m2v = x; i2 = e; } }
                const float w1 = 1.f / (1.f + __expf(m2v - m1v));
                e1 = g * EPG + i1; e2 = g * EPG + i2; gt1 = g_w * w1; gt2 = g_w * (1.f - w1);
                rk1 = __hip_atomic_fetch_add(&hist[e1], 1, __ATOMIC_RELAXED, __HIP_MEMORY_SCOPE_WORKGROUP); rk2 = __hip_atomic_fetch_add(&hist[e2], 1, __ATOMIC_RELAXED, __HIP_MEMORY_SCOPE_WORKGROUP);
            }
            __syncthreads();
            if (tid < 32) { const int hcount = hist[tid]; hbase[tid] = hcount ? (int)atomicAdd(WSP(unsigned, WS_CTL) + CW_CNT + Lyr * 2048 + 64 * tid, (unsigned)hcount) : 0; hist[tid] = 0; }
            __syncthreads();
            if (valid && lane < 16) {
                const int tok = grp * 16 + lane; const int p1 = hbase[e1] + rk1, p2 = hbase[e2] + rk2;
                WSP(int, WS_LIST)[(size_t)e1 * T + p1] = tok * 2; WSP(int, WS_LIST)[(size_t)e2 * T + p2] = tok * 2 + 1;
                WSP(float, WS_GATE)[tok * 2] = gt1; WSP(float, WS_GATE)[tok * 2 + 1] = gt2;
            }
        }
    }
    __syncthreads();
}
template <bool FINAL> __device__ __forceinline__ void f_rowadd(Frame& F) {
    bf16* xb = WSP(bf16, WS_XN); const unsigned char* y = WSP(unsigned char, WS_Y); float* rsout = WSP(float, WS_RS); bf16* xo = xb;
    const int lane = FLANE, w = FWAVE;
    f32x4 gf[4];
    if (FINAL) {
#pragma unroll
        for (int j = 0; j < 2; ++j) { gf[2 * j] = *(const f32x4*)(F.inp(I_FINAL) + 8 * lane + 512 * j); gf[2 * j + 1] = *(const f32x4*)(F.inp(I_FINAL) + 8 * lane + 512 * j + 4); }
    }
    for (int r0 = (F.bid * NWAVES + w) * 2; r0 < T; r0 += F.G * NWAVES * 2) {
        v4u xa[2][2]; v2u ya[2][2], yb[2][2];
#pragma unroll
        for (int rr = 0; rr < 2; ++rr)
#pragma unroll
            for (int j = 0; j < 2; ++j) { const size_t o = (size_t)(r0 + rr) * D + 8 * lane + 512 * j;
                xa[rr][j] = *(const v4u*)(xb + o); ya[rr][j] = *(const v2u*)(y + o); yb[rr][j] = *(const v2u*)(y + (size_t)T * D + o); }
#pragma unroll
        for (int rr = 0; rr < 2; ++rr) {
            float v[16]; float ss = 0.f;
#pragma unroll
            for (int j = 0; j < 2; ++j) {
                const unsigned xw[4] = {xa[rr][j].x, xa[rr][j].y, xa[rr][j].z, xa[rr][j].w};
                const pg8::f32x2 a0 = __builtin_amdgcn_cvt_pk_f32_fp8((int)ya[rr][j].x, false), a1 = __builtin_amdgcn_cvt_pk_f32_fp8((int)ya[rr][j].x, true), a2 = __builtin_amdgcn_cvt_pk_f32_fp8((int)ya[rr][j].y, false), a3 = __builtin_amdgcn_cvt_pk_f32_fp8((int)ya[rr][j].y, true);
                const pg8::f32x2 b0 = __builtin_amdgcn_cvt_pk_f32_fp8((int)yb[rr][j].x, false), b1 = __builtin_amdgcn_cvt_pk_f32_fp8((int)yb[rr][j].x, true), b2 = __builtin_amdgcn_cvt_pk_f32_fp8((int)yb[rr][j].y, false), b3 = __builtin_amdgcn_cvt_pk_f32_fp8((int)yb[rr][j].y, true);
                const float ysum[8] = {a0.x + b0.x, a0.y + b0.y, a1.x + b1.x, a1.y + b1.y, a2.x + b2.x, a2.y + b2.y, a3.x + b3.x, a3.y + b3.y};
#pragma unroll
                for (int e = 0; e < 4; ++e) { const float lo = bflo(xw[e]) + ysum[2 * e], hi = bfhi(xw[e]) + ysum[2 * e + 1]; v[8 * j + 2 * e] = lo; v[8 * j + 2 * e + 1] = hi; ss += lo * lo + hi * hi; }
            }
            const float rstd = __builtin_amdgcn_rsqf(wave_sum(ss) * (1.f / D) + EPS);
            const size_t ro = (size_t)(r0 + rr) * D + 8 * lane;
            if (FINAL) {
#pragma unroll
                for (int j = 0; j < 2; ++j) {
                    f32x4 o0 = {v[8 * j] * rstd, v[8 * j + 1] * rstd, v[8 * j + 2] * rstd, v[8 * j + 3] * rstd}, o1 = {v[8 * j + 4] * rstd, v[8 * j + 5] * rstd, v[8 * j + 6] * rstd, v[8 * j + 7] * rstd};
                    *(f32x4*)(F.out + ro + 512 * j) = o0 * gf[2 * j]; *(f32x4*)(F.out + ro + 512 * j + 4) = o1 * gf[2 * j + 1]; }
            } else {
#pragma unroll
                for (int j = 0; j < 2; ++j) { v4u o; o.x = pk2(v[8 * j], v[8 * j + 1]); o.y = pk2(v[8 * j + 2], v[8 * j + 3]); o.z = pk2(v[8 * j + 4], v[8 * j + 5]); o.w = pk2(v[8 * j + 6], v[8 * j + 7]); *(v4u*)(xo + ro + 512 * j) = o; }
                if (lane == 0) rsout[r0 + rr] = rstd;
            }
        }
    }
}
__device__ __forceinline__ void f_prep0(Frame& F) { f_convert_gla(F); f_rowgroup<0>(F, 0); }
__device__ __forceinline__ void f_rowpass_router(Frame& F, int L) { f_rowgroup<1>(F, L); }
__device__ __forceinline__ void f_rowpass_add(Frame& F) { f_rowadd<false>(F); }
__device__ __forceinline__ void f_final(Frame& F) { f_rowadd<true>(F); }
constexpr int LDS_BYTES = 155648;
struct Args { const float* in[23]; float* out; unsigned char* ws; int ph_lo, ph_hi; };

__global__ void __launch_bounds__(NTHREADS, 2) fwd(Args args) {
    extern __shared__ __attribute__((aligned(16))) unsigned char lds_raw[];
    Frame F;
    F.lds = (LAS unsigned char*)lds_raw;
    F.G = gridDim.x; F.bid = blockIdx.x;
    F.out = args.out; F.ws = args.ws;
    volatile LAS unsigned* bst = (volatile LAS unsigned*)(F.lds + LX_PTR + 192);
    if (FTID == 0) {
        LAS unsigned long long* pt = (LAS unsigned long long*)(F.lds + LX_PTR);
#pragma unroll
        for (int i = 0; i < 23; ++i) pt[i] = (unsigned long long)args.in[i];
    }
    if (FTID < 2) bst[FTID] = 0u;
    __syncthreads();
    cg::grid_group grid = cg::this_grid();
    const XcdBarrier xbar = xcd_barrier_post(WSP(unsigned, WS_CTL) + CW_BAR, bst);
    const int lo = args.ph_lo, hi = args.ph_hi;
    if (lo > 1000) grid.sync();
#define IN(k) (lo <= (k) && (k) < hi)
#define SEAM() xcd_barrier(xbar)

    if (IN(0)) f_prep0(F);                 SEAM();
    if (IN(1)) f_gemm_in(F);               SEAM();
    if (IN(2)) f_scan_outproj(F, xbar);    SEAM();
    if (IN(3)) f_rowpass_router(F, 0);     SEAM();
    if (IN(4)) f_moe(F, 0);                SEAM();
    if (IN(5)) f_rowpass_add(F);           SEAM();
    if (IN(6)) f_gemm_sgu_in(F);           SEAM();
    if (IN(7)) f_mix(F);                   SEAM();
    if (IN(8)) f_gemm_sgu_out(F);          SEAM();
    if (IN(9)) f_rowpass_router(F, 1);     SEAM();
    if (IN(10)) f_moe(F, 1);               SEAM();
    if (IN(11)) f_final(F);
#undef IN
#undef SEAM
}

extern "C" void kernel_launch(void* const* d_in, const int* in_sizes, int n_in, void* d_out, int out_size, void* d_ws, size_t ws_size, hipStream_t stream) {
    static int grid = 0;
    if (grid == 0) {
        if (n_in != 23 || out_size != T * D || in_sizes[0] != T * D || ws_size < WS_END) { fprintf(stderr, "kernel_launch: unexpected shapes (n_in %d out %d ws %zu): nothing launched\n", n_in, out_size, ws_size); grid = -1; return; }
        int dev = 0, cus = 0, per_cu = 0;
        if (hipGetDevice(&dev) != hipSuccess || hipDeviceGetAttribute(&cus, hipDeviceAttributeMultiprocessorCount, dev) != hipSuccess) { grid = -1; return; }
        if (hipFuncSetAttribute((const void*)fwd, hipFuncAttributeMaxDynamicSharedMemorySize, LDS_BYTES) != hipSuccess) { fprintf(stderr, "kernel_launch: cannot get %d bytes of dynamic LDS\n", LDS_BYTES); grid = -1; return; }
        if (hipOccupancyMaxActiveBlocksPerMultiprocessor(&per_cu, (const void*)fwd, NTHREADS, LDS_BYTES) != hipSuccess || per_cu < 1) { fprintf(stderr, "kernel_launch: occupancy query admits %d workgroups per CU: nothing launched\n", per_cu); grid = -1; (void)hipGetLastError(); return; }
        grid = cus;
        if (grid < 128) { fprintf(stderr, "kernel_launch: %d CUs; this kernel's phase program needs at least 128 workgroups\n", grid); grid = -1; return; }
    }
    if (grid < 0) return;
    (void)hipMemsetAsync((char*)d_ws + WS_CTL, 0, CTL_ZERO_BYTES, stream);
    Args a{};
    for (int i = 0; i < 23; ++i) a.in[i] = (const float*)d_in[i];
    a.out = (float*)d_out; a.ws = (unsigned char*)d_ws; a.ph_lo = 0; a.ph_hi = 12;
    void* kargs[] = {&a};
    const hipError_t e = hipLaunchCooperativeKernel((const void*)fwd, dim3(grid), dim3(NTHREADS), kargs, LDS_BYTES, stream);
    if (e != hipSuccess) fprintf(stderr, "cooperative launch failed: %s (grid %d)\n", hipGetErrorString(e), grid);
}
```

```cpp
#include <hip/hip_runtime.h>
#include <hip/hip_cooperative_groups.h>
#include <cstdio>
#include <cstdint>
namespace cg = cooperative_groups;


constexpr int T = 32768, D = 1024, NBATCH = 16, SEQ = 2048;
constexpr int GLA_H = 4, DK = 128, DV = 256, HK = 512, HV = 1024, RANK = 16, GLA_IN = 3088, NQKVR = 3072, CHUNK = 64, NCHUNK = 32;
constexpr int SGU_FFN = 4096, SGU_HALF = 2048, SGU_BLK = 128, SGU_GC = 512;
constexpr int NE = 32, EPG = 8, FF = 512;
constexpr float EPS = 1e-6f;
constexpr int NTHREADS = 512, NWAVES = 8;

constexpr size_t MiB = 1u << 20;
constexpr size_t WS_CTL = 0, CTL_ZERO_BYTES = 128 * 1024;
constexpr size_t WS_GLR = 1 * MiB;
constexpr size_t WS_GATE = 3 * MiB;
constexpr size_t WS_STATS = 4 * MiB;
constexpr size_t WS_LIST = 12 * MiB;
constexpr size_t WS_WIN = 16 * MiB;
constexpr size_t WS_WOUT = 22 * MiB;
constexpr size_t WS_WSIN = 24 * MiB;
constexpr size_t WS_WSOUT = 32 * MiB;
constexpr size_t WS_W13 = 36 * MiB;
constexpr size_t WS_W2 = 164 * MiB;
constexpr float MOE_WSCALE = 32.f;
constexpr size_t WS_XN = 228 * MiB;
constexpr size_t WS_AOUT = 484 * MiB;
constexpr size_t WS_RS = 3 * MiB + 256 * 1024;
constexpr size_t WS_QKVR = 292 * MiB;
constexpr size_t WS_HID = 292 * MiB;
constexpr size_t WS_XB8 = 100 * MiB;
constexpr size_t WS_Y = 364 * MiB;
constexpr size_t WS_U = 292 * MiB;
constexpr size_t WS_V = 420 * MiB;
constexpr size_t WS_END = 548 * MiB;
constexpr int CW_BAR = 1024;
constexpr int CW_HID = 16384;
constexpr int CW_CNT = 8192;

#define GAS __attribute__((address_space(1)))
#define LAS __attribute__((address_space(3)))
typedef unsigned short bf16;
typedef unsigned v4u __attribute__((ext_vector_type(4)));
typedef unsigned v2u __attribute__((ext_vector_type(2)));
typedef float f32x4 __attribute__((ext_vector_type(4)));
typedef float f32x16 __attribute__((ext_vector_type(16)));
typedef short bf16x8 __attribute__((ext_vector_type(8)));
typedef short s16x4 __attribute__((ext_vector_type(4)));
#define LDS_WAIT() asm volatile("s_waitcnt lgkmcnt(0)" ::: "memory")
#define VM_WAIT() asm volatile("s_waitcnt vmcnt(0)" ::: "memory")
typedef float f32x2_t __attribute__((ext_vector_type(2))); typedef __bf16 bf16x2_t __attribute__((ext_vector_type(2)));
__device__ __forceinline__ unsigned pk2(float lo, float hi) { f32x2_t v = {lo, hi}; bf16x2_t b = __builtin_convertvector(v, bf16x2_t); return __builtin_bit_cast(unsigned, b); }
__device__ __forceinline__ unsigned f2bf(float f) { return pk2(f, 0.f) & 0xffffu; }
__device__ __forceinline__ float bf2f(unsigned short b) { return __builtin_bit_cast(float, (unsigned)b << 16); }
__device__ __forceinline__ float bflo(unsigned w) { return __builtin_bit_cast(float, w << 16); }
__device__ __forceinline__ float bfhi(unsigned w) { return __builtin_bit_cast(float, w & 0xffff0000u); }
__device__ __forceinline__ float wave_sum(float v) {
#pragma unroll
    for (int o = 1; o < 64; o <<= 1) v += __shfl_xor(v, o);
    return v;
}
__device__ __forceinline__ float silu_f(float x) { return x * __builtin_amdgcn_rcpf(1.f + __expf(-x)); }
namespace pg8 {
#define PG8_LAS __attribute__((address_space(3)))
typedef unsigned short bf16_t;
typedef short bf16x8 __attribute__((ext_vector_type(8)));
typedef float f32x4 __attribute__((ext_vector_type(4)));
typedef unsigned u32x4 __attribute__((ext_vector_type(4)));
constexpr int BM = 256, BK = 64, HALF = 128, HTB = HALF * BK * 2  , STAGE_BYTES = 8 * HTB, NXCD = 8, WGM = 2;

__host__ __device__ __forceinline__ int lds_byte(int r, int c) { const int st = (r >> 4) * 2 + (c >> 5), rr = r & 15, cc = c & 31, ob = rr * 64 + cc * 2; return st * 1024 + (ob ^ (((ob >> 9) & 1) << 5)); }
__host__ __device__ __forceinline__ void stage_rc(int b, int& R, int& C) { const int st = b / 1024, sb = b % 1024, swz = sb ^ (((sb >> 9) & 1) << 5); R = (st >> 1) * 16 + swz / 64; C = (st & 1) * 32 + (swz % 64) / 2; }
__host__ __device__ __forceinline__ int perm32(int rho) { const int n = rho >> 4, i = rho & 15; return 8 * (i >> 2) + 4 * n + (i & 3); }

struct Unit { int pm, pn, e, slot; };

struct DenseOrder {
    static constexpr bool GATHER = false;
    int nM, nN, nwg, G, c, K; const char* Bt;
    __device__ void init(int M, int N, int K_, const bf16_t* Bt_, int G_, int c_) { nM = M / BM; nN = N / BM; nwg = nM * nN; G = G_; c = c_; K = K_; Bt = (const char*)Bt_; }
    __device__ __forceinline__ bool next(int i, Unit& u) const {
        const long L = (long)i * G + c; if (L >= nwg) return false;
        int wgid = (int)L; { const int q = nwg / NXCD, r = nwg % NXCD, xcd = wgid % NXCD, off = wgid / NXCD; wgid = (xcd < r ? xcd * (q + 1) : r * (q + 1) + (xcd - r) * q) + off; }
        const int nig = WGM * nN, gid = wgid / nig, fm = gid * WGM, gsz = (nM - fm) < WGM ? (nM - fm) : WGM;
        u.pm = fm + ((wgid % nig) % gsz); u.pn = (wgid % nig) / gsz; u.e = 0; u.slot = 0; return true;
    }
    __device__ __forceinline__ const char* bptr(const Unit& u) const { return Bt + (size_t)u.pn * BM * K * 2; }
    __device__ __forceinline__ size_t abase(const Unit& u) const { return (size_t)u.pm * BM * K * 2; }
    __device__ __forceinline__ int a_rowstride(int dflt) const { return dflt; }
    __device__ __forceinline__ size_t a_hstep(size_t dflt) const { return dflt; }
    __device__ __forceinline__ size_t a_koff(int kt) const { return (size_t)kt * 128; }
    __device__ __forceinline__ unsigned aoff(const Unit& u, int h, int R, int C) const { return (unsigned)(((u.pm * BM + h * HALF + R) * K + C) * 2); }
    __device__ __forceinline__ void a_ready(const Unit&) const {}
    __device__ __forceinline__ void done(const Unit&) const {}
};

__device__ __forceinline__ unsigned cvt_pk_bf16(float lo, float hi) { unsigned r; asm volatile("v_cvt_pk_bf16_f32 %0, %1, %2" : "=v"(r) : "v"(lo), "v"(hi)); return r; }
typedef float f32x2 __attribute__((ext_vector_type(2)));
__device__ __forceinline__ f32x2 gelu_pk(f32x2 v) {
    const f32x2 av = __builtin_elementwise_abs(v), d = av * 0.2316418882f + 1.0f;
    f32x2 t; t.x = __builtin_amdgcn_rcpf(d.x); t.y = __builtin_amdgcn_rcpf(d.y);
    f32x2 q = t * 0.5307027145f + (-0.7265760135f); q = q * t + 0.7107068705f; q = q * t + (-0.142248368f); q = q * t + 0.127414796f; q = q * t;
    const f32x2 s = (v * v) * (-0.72134752044f);
    f32x2 e; e.x = __builtin_amdgcn_exp2f(s.x); e.y = __builtin_amdgcn_exp2f(s.y);
    const f32x2 m = v * (q * e), r = v - m;
    f32x2 o; o.x = v.x < 0.f ? m.x : r.x; o.y = v.y < 0.f ? m.y : r.y; return o;
}

typedef int v8i __attribute__((ext_vector_type(8)));
typedef int v4i __attribute__((ext_vector_type(4)));
template <int ES, class Epi, class Sched>
__device__ __forceinline__ void gemm_phase_es(PG8_LAS unsigned char* lds, const void* Abase, const int K, const Sched& S, const Epi& E) {
    const int tid = threadIdx.x, wid = __builtin_amdgcn_readfirstlane(tid >> 6), lane = tid & 63, wr = wid >> 2, wc = wid & 3, fr = lane & 15, fq = lane >> 4;
    const int nt = K * ES / 128;
    int sR[2], sC[2]; unsigned voffA[2], voffB[2];
#pragma unroll
    for (int i = 0; i < 2; ++i) { stage_rc(tid * 16 + i * 8192, sR[i], sC[i]); const int Rb = Epi::PERM ? ((sR[i] & ~31) + perm32(sR[i] & 31)) : sR[i];
        voffA[i] = (unsigned)(sR[i] * S.a_rowstride(K * ES) + sC[i] * 2); voffB[i] = (unsigned)(Rb * K * ES + sC[i] * 2); }
    const size_t kstep = (size_t)(BK * 2);
    const size_t hstep = (size_t)HALF * K * ES;
    const size_t hstepA = S.a_hstep(hstep);
    const unsigned ldsw = (unsigned)wid * 1024u;
    const int aoff = lds_byte(wr * 64 + fr, fq * (ES == 2 ? 8 : 16)), boff = lds_byte(wc * 32 + fr, fq * (ES == 2 ? 8 : 16));
    const char* const Ab = (const char*)Abase;
#define PG8_SA(b, h) (((b) * 2 + (h)) * HTB)
#define PG8_SB(b, h) ((4 + (b) * 2 + (h)) * HTB)
#define PG8_STAGE(bufoff, gbase, voff) do { _Pragma("unroll") for (int _i = 0; _i < 2; ++_i) \
        __builtin_amdgcn_global_load_lds((const unsigned*)((const char*)(gbase) + (voff)[_i]), (PG8_LAS unsigned*)(lds + (bufoff) + ldsw + _i * 8192), 16, 0, 0); } while (0)
#define PG8_STAGE_A(bufoff, nx, h, kt) do { if constexpr (Sched::GATHER) { PG8_STAGE(bufoff, Ab + (size_t)(kt) * kstep, gc[h]); } \
        else PG8_STAGE(bufoff, ((nx) ? xA : cA) + (size_t)(h) * hstepA + S.a_koff(kt), voffA); } while (0)
#define PG8_LDA(dst, b, h) do { if constexpr (ES == 2) { _Pragma("unroll") for (int m = 0; m < 4; ++m) _Pragma("unroll") for (int k = 0; k < 2; ++k) dst[m][k] = *(const PG8_LAS bf16x8*)(lds + PG8_SA(b, h) + aoff + m * 2048 + k * 1024); } \
        else { _Pragma("unroll") for (int m = 0; m < 4; ++m) { const v4i lo_ = *(const PG8_LAS v4i*)(lds + PG8_SA(b, h) + aoff + m * 2048), hi_ = *(const PG8_LAS v4i*)(lds + PG8_SA(b, h) + aoff + m * 2048 + 16); dst##8[m] = __builtin_shufflevector(lo_, hi_, 0, 1, 2, 3, 4, 5, 6, 7); } } } while (0)
#define PG8_LDB(dst, b, h) do { if constexpr (ES == 2) { _Pragma("unroll") for (int n = 0; n < 2; ++n) _Pragma("unroll") for (int k = 0; k < 2; ++k) dst[n][k] = *(const PG8_LAS bf16x8*)(lds + PG8_SB(b, h) + boff + n * 2048 + k * 1024); } \
        else { _Pragma("unroll") for (int n = 0; n < 2; ++n) { const v4i lo_ = *(const PG8_LAS v4i*)(lds + PG8_SB(b, h) + boff + n * 2048), hi_ = *(const PG8_LAS v4i*)(lds + PG8_SB(b, h) + boff + n * 2048 + 16); dst##8[n] = __builtin_shufflevector(lo_, hi_, 0, 1, 2, 3, 4, 5, 6, 7); } } } while (0)
#define PG8_MMA(ai, bj, At, Bt) do { __builtin_amdgcn_s_setprio(1); if constexpr (ES == 2) { _Pragma("unroll") for (int m = 0; m < 4; ++m) _Pragma("unroll") for (int n = 0; n < 2; ++n) _Pragma("unroll") for (int k = 0; k < 2; ++k) \
        acc[ai][bj][m][n] = __builtin_amdgcn_mfma_f32_16x16x32_bf16(Bt[n][k], At[m][k], acc[ai][bj][m][n], 0, 0, 0); } \
        else { _Pragma("unroll") for (int m = 0; m < 4; ++m) _Pragma("unroll") for (int n = 0; n < 2; ++n) \
        asm volatile("s_nop 1\n\tv_mfma_f32_16x16x128_f8f6f4 %0, %1, %2, %0" : "+v"(acc[ai][bj][m][n]) : "v"(Bt##8[n]), "v"(At##8[m])); }   \
        __builtin_amdgcn_s_setprio(0); } while (0)
#define PG8_WAIT_V(n) asm volatile("s_waitcnt vmcnt(" #n ")" ::: "memory")
#define PG8_WAIT_L(n) asm volatile("s_waitcnt lgkmcnt(" #n ")" ::: "memory")
#define PG8_BAR __builtin_amdgcn_s_barrier()
#define PG8_SCHED __builtin_amdgcn_sched_barrier(0)
    Unit cur, nxt, prv; int ui = 0; bool have_prv = false;
    if (!S.next(0, cur)) return;
    f32x4 acc[2][2][4][2];
#pragma unroll
    for (int a = 0; a < 2; ++a)
#pragma unroll
        for (int b = 0; b < 2; ++b)
#pragma unroll
            for (int m = 0; m < 4; ++m)
#pragma unroll
                for (int n = 0; n < 2; ++n) acc[a][b][m][n] = (f32x4){0.f, 0.f, 0.f, 0.f};
    bf16x8 At[4][2], B0[2][2], B1[2][2]; v8i At8[4], B08[2], B18[2];
    unsigned gc[2][2];
    const char* cA = Ab; const char* xA = Ab;
    if constexpr (Sched::GATHER) {
#pragma unroll
        for (int h = 0; h < 2; ++h)
#pragma unroll
            for (int i = 0; i < 2; ++i) gc[h][i] = S.aoff(cur, h, sR[i], sC[i]);
    } else { cA = Ab + S.abase(cur); xA = cA; }
    const char* cB = S.bptr(cur);
    S.a_ready(cur);
    if constexpr (Epi::RS_DMA) { if (wid == 0) __builtin_amdgcn_global_load_lds((const unsigned*)((const char*)E.rs + (size_t)cur.pm * 1024 + lane * 16), (PG8_LAS unsigned*)(lds + STAGE_BYTES + 512), 16, 0, 0); }
    PG8_STAGE(PG8_SB(0, 0), cB, voffB); PG8_STAGE(PG8_SB(0, 1), cB + hstep, voffB); PG8_STAGE_A(PG8_SA(0, 0), false, 0, 0); PG8_STAGE_A(PG8_SA(0, 1), false, 1, 0);
    if (wr == 1) PG8_BAR;
    PG8_WAIT_V(2); PG8_BAR;
    PG8_STAGE(PG8_SB(1, 0), cB + kstep, voffB); PG8_STAGE_A(PG8_SA(1, 0), false, 0, 1); PG8_STAGE(PG8_SB(1, 1), cB + hstep + kstep, voffB);
    PG8_WAIT_V(6); PG8_BAR;
    for (;;) {
        const bool has_next = S.next(ui + 1, nxt);
        const char* nB = has_next ? S.bptr(nxt) : cB;
        if constexpr (Epi::RS_DMA) { if (has_next && wid == 0) __builtin_amdgcn_global_load_lds((const unsigned*)((const char*)E.rs + (size_t)nxt.pm * 1024 + lane * 16), (PG8_LAS unsigned*)(lds + STAGE_BYTES + 512 + ((ui + 1) % 3) * 1024), 16, 0, 0); }
        for (int t = 0; t < nt; t += 2) {
            const bool last = (t == nt - 2);
            const int kt2 = last ? 0 : t + 2;
            const char* b2 = last ? nB : cB + (size_t)(t + 2) * kstep; const char* b3 = b2 + kstep;
            if (last && has_next) {
                if constexpr (!Sched::GATHER) xA = Ab + S.abase(nxt);
                S.a_ready(nxt);
            }
            PG8_LDB(B0, 0, 0); PG8_LDB(B1, 0, 1); PG8_SCHED; PG8_LDA(At, 0, 0); PG8_STAGE_A(PG8_SA(1, 1), false, 1, t + 1);
            if constexpr (Sched::GATHER) { if (last && has_next) {
#pragma unroll
                for (int h = 0; h < 2; ++h)
#pragma unroll
                    for (int i = 0; i < 2; ++i) gc[h][i] = S.aoff(nxt, h, sR[i], sC[i]); } }
            PG8_WAIT_V(8); PG8_WAIT_L(0); PG8_BAR; PG8_MMA(0, 0, At, B0); PG8_MMA(0, 1, At, B1); PG8_BAR; PG8_SCHED;
            PG8_LDA(At, 0, 1); PG8_STAGE(PG8_SB(0, 0), b2, voffB); PG8_STAGE(PG8_SB(0, 1), b2 + hstep, voffB); PG8_STAGE_A(PG8_SA(0, 0), last, 0, kt2);
            PG8_WAIT_V(8); PG8_WAIT_L(0); PG8_BAR; PG8_MMA(1, 0, At, B0); PG8_MMA(1, 1, At, B1); PG8_BAR; PG8_SCHED;
            PG8_LDB(B0, 1, 0); PG8_LDB(B1, 1, 1); PG8_SCHED; PG8_LDA(At, 1, 0); PG8_STAGE_A(PG8_SA(0, 1), last, 1, kt2);
            PG8_WAIT_V(8); PG8_WAIT_L(0);
            if (have_prv) { S.done(prv); have_prv = false; }
            PG8_BAR; PG8_MMA(0, 0, At, B0); PG8_MMA(0, 1, At, B1); PG8_BAR; PG8_SCHED;
            PG8_LDA(At, 1, 1); PG8_STAGE(PG8_SB(1, 0), b3, voffB); PG8_STAGE(PG8_SB(1, 1), b3 + hstep, voffB); PG8_STAGE_A(PG8_SA(1, 0), last, 0, kt2 + 1);
            PG8_WAIT_V(8); PG8_WAIT_L(0); PG8_BAR; PG8_MMA(1, 0, At, B0); PG8_MMA(1, 1, At, B1); PG8_BAR; PG8_SCHED;
        }
        if (wr == 0) PG8_BAR;
        if constexpr (ES == 1) asm volatile("s_nop 15\n\ts_nop 15" ::: "memory");
        E(acc, cur, wr, wc, fr, fq, (const PG8_LAS float*)(lds + STAGE_BYTES + 512 + (ui % 3) * 1024)); prv = cur; have_prv = true;
        if (!has_next) break;
#pragma unroll
        for (int a = 0; a < 2; ++a)
#pragma unroll
            for (int b = 0; b < 2; ++b)
#pragma unroll
                for (int m = 0; m < 4; ++m)
#pragma unroll
                    for (int n = 0; n < 2; ++n) acc[a][b][m][n] = (f32x4){0.f, 0.f, 0.f, 0.f};
        cur = nxt; cB = nB; ++ui;
        if constexpr (!Sched::GATHER) cA = xA;
        if (wr == 1) PG8_BAR;
    }
    PG8_WAIT_V(0);
    if (have_prv) S.done(prv);
    PG8_BAR;
#undef PG8_STAGE_A
#undef PG8_SA
#undef PG8_SB
#undef PG8_STAGE
#undef PG8_LDA
#undef PG8_LDB
#undef PG8_MMA
#undef PG8_WAIT_V
#undef PG8_WAIT_L
#undef PG8_BAR
#undef PG8_SCHED
}
template <class Epi, class Sched>
__device__ __forceinline__ void gemm_phase(PG8_LAS unsigned char* lds, const bf16_t* Abase, const int K, const Sched& S, const Epi& E) { gemm_phase_es<2>(lds, Abase, K, S, E); }
}
constexpr int LX_PTR = 155648 - 256;
#define FTID ((int)threadIdx.x)
#define FLANE ((int)threadIdx.x & 63)
#define FWAVE ((int)__builtin_amdgcn_readfirstlane((int)threadIdx.x >> 6))
struct Frame {
    LAS unsigned char* lds;
    int G, bid;
    float* out; unsigned char* ws;
    __device__ __forceinline__ const float* inp(int i) const {
        const LAS unsigned* p = (const LAS unsigned*)(lds + LX_PTR) + 2 * i;
        const unsigned lo = __builtin_amdgcn_readfirstlane(p[0]), hi = __builtin_amdgcn_readfirstlane(p[1]);
        return (const float*)(((unsigned long long)hi << 32) | lo);
    }
};
enum { I_X = 0, I_GLA_NORM, I_GLA_WIN, I_GLA_WGU, I_GLA_BG, I_GLA_HG, I_GLA_WOUT, I_SGU_NORM, I_SGU_WIN, I_SGU_LNG, I_SGU_LNB, I_SGU_WS, I_SGU_BS, I_SGU_WOUT,
       I_MOE_NORM, I_MOE_WG, I_MOE_BG, I_MOE_WSUB, I_MOE_BSUB, I_MOE_W1, I_MOE_W3, I_MOE_W2, I_FINAL };
#define WSP(type, off) ((type*)(F.ws + (off)))

#define XB_TMO      128
#define XB_XCNT(j)  (256  + 64 * (j))
#define XB_XSUB(j)  (1280 + 64 * (j))
#define XB_XGEN(j)  (2304 + 64 * (j))
#define XB_TOP      3328
#define XB_TOPGEN   3392
#define XCD_BAR_WORDS 3456
#define XB_SPIN_CAP (1u << 18)

__device__ __forceinline__ unsigned xb_ld(unsigned* p)              { return __hip_atomic_load(p, __ATOMIC_RELAXED, __HIP_MEMORY_SCOPE_AGENT); }
__device__ __forceinline__ unsigned xb_add(unsigned* p, unsigned v) { return __hip_atomic_fetch_add(p, v, __ATOMIC_RELAXED, __HIP_MEMORY_SCOPE_AGENT); }
__device__ __forceinline__ unsigned xb_xcc_id() { return (unsigned)__builtin_amdgcn_s_getreg((3 << 11) | 20) & 0xFu; }
#define XB_SPIN(cond, bar) do { unsigned _sp = 0; while (cond) { __builtin_amdgcn_s_sleep(1); \
    if ((++_sp & 255u) == 0u) { if (xb_ld(&(bar)[XB_TMO])) break; if (_sp > XB_SPIN_CAP) { atomicAdd(&(bar)[XB_TMO], 1u); break; } } } } while (0)

struct XcdBarrier {
    unsigned* bar; unsigned x;
    volatile LAS unsigned* st;
};

__device__ __forceinline__ XcdBarrier xcd_barrier_post(unsigned* bar, volatile LAS unsigned* st) {
    XcdBarrier b; b.bar = bar; b.x = xb_xcc_id(); b.st = st;
    if (threadIdx.x == 0) (void)xb_add(&bar[XB_XCNT(b.x)], 1u);
    return b;
}
__device__ __forceinline__ void xcd_barrier_complete(unsigned* bar, unsigned x, unsigned& nloc, unsigned& nx) {
    const unsigned G = gridDim.x * gridDim.y * gridDim.z;
    unsigned sum, cnt, mine, sp = 0u;
    for (;;) {
        sum = 0u; cnt = 0u; mine = 0u;
#pragma unroll
        for (unsigned j = 0; j < 16; ++j) { const unsigned c = xb_ld(&bar[XB_XCNT(j)]); sum += c; cnt += (c > 0u) ? 1u : 0u; mine = (j == x) ? c : mine; }
        if (sum == G) break;
        __builtin_amdgcn_s_sleep(1);
        if ((++sp & 255u) == 0u) { if (xb_ld(&bar[XB_TMO])) break; if (sp > XB_SPIN_CAP) { atomicAdd(&bar[XB_TMO], 1u); break; } }
    }
    nloc = mine > 0u ? mine : 1u; nx = cnt > 0u ? cnt : 1u;
}

__device__ __forceinline__ void xcd_barrier(const XcdBarrier& b) {
    asm volatile("s_waitcnt vmcnt(0)" ::: "memory");
    __syncthreads();
    if (threadIdx.x == 0) {
        unsigned* bar = b.bar;
        __builtin_amdgcn_s_waitcnt(0);
        unsigned nloc = b.st[0], nx = b.st[1];
        if (nloc == 0u) { xcd_barrier_complete(bar, b.x, nloc, nx); b.st[0] = nloc; b.st[1] = nx; }
        const unsigned old = xb_add(&bar[XB_XSUB(b.x)], 1u);
        const unsigned gen = old / nloc;
        if (old + 1u == (gen + 1u) * nloc) {
            __builtin_amdgcn_fence(__ATOMIC_RELEASE, "agent");
            asm volatile("s_waitcnt vmcnt(0)" ::: "memory");
            const unsigned og = xb_add(&bar[XB_TOP], 1u);
            const unsigned tg = og / nx;
            if (og + 1u == (tg + 1u) * nx) xb_add(&bar[XB_TOPGEN], 1u);
            else XB_SPIN(xb_ld(&bar[XB_TOPGEN]) == tg, bar);
            __builtin_amdgcn_fence(__ATOMIC_ACQUIRE, "agent");
            xb_add(&bar[XB_XGEN(b.x)], 1u);
            asm volatile("s_waitcnt vmcnt(0)" ::: "memory");
        } else {
            XB_SPIN(xb_ld(&bar[XB_XGEN(b.x)]) == gen, bar);
            __builtin_amdgcn_fence(__ATOMIC_ACQUIRE, "agent");
            asm volatile("s_waitcnt vmcnt(0)" ::: "memory");
        }
    }
    __syncthreads();
}
constexpr int RING_BYTES = 131072;
constexpr int LX_TST = RING_BYTES;
constexpr int MOE_MAXU = 6;
constexpr int LX_TAB = RING_BYTES + 512;
constexpr int LX_GT = LX_TAB + MOE_MAXU * 1024;

struct EpiStoreBf16 {
    static constexpr bool RS_DMA = true;
    static constexpr bool PERM = true;
    bf16* O; int ldc; const float* rs; int silu_from;
    __device__ __forceinline__ void operator()(const pg8::f32x4 (&acc)[2][2][4][2], const pg8::Unit& u, int wr, int wc, int fr, int fq, const LAS float* rsl) const {
        const int row0 = u.pm * 256 + wr * 64 + fr, col0 = u.pn * 256 + wc * 32 + 8 * fq;
#pragma unroll
        for (int ai = 0; ai < 2; ++ai)
#pragma unroll
            for (int m = 0; m < 4; ++m) { const int row = row0 + ai * 128 + m * 16; bf16* rowp = O + (size_t)row * ldc + col0; const float sc = rsl[ai * 128 + wr * 64 + m * 16 + fr];
#pragma unroll
                for (int bj = 0; bj < 2; ++bj) { pg8::f32x4 v0 = acc[ai][bj][m][0] * sc, v1 = acc[ai][bj][m][1] * sc;
                    if (silu_from >= 0 && u.pn >= silu_from) {
#pragma unroll
                        for (int i = 0; i < 4; ++i) { v0[i] = v0[i] * __builtin_amdgcn_rcpf(1.f + __expf(-v0[i])); v1[i] = v1[i] * __builtin_amdgcn_rcpf(1.f + __expf(-v1[i])); } }
                    v4u w; w.x = pg8::cvt_pk_bf16(v0[0], v0[1]); w.y = pg8::cvt_pk_bf16(v0[2], v0[3]); w.z = pg8::cvt_pk_bf16(v1[0], v1[1]); w.w = pg8::cvt_pk_bf16(v1[2], v1[3]);
                    *(v4u*)(rowp + bj * 128) = w; } }
    }
};
struct EpiResBf16 {
    static constexpr bool RS_DMA = false;
    static constexpr bool PERM = true;
    bf16* X;
    __device__ __forceinline__ void operator()(const pg8::f32x4 (&acc)[2][2][4][2], const pg8::Unit& u, int wr, int wc, int fr, int fq, const LAS float* rsl) const {
        const int row0 = u.pm * 256 + wr * 64 + fr, col0 = u.pn * 256 + wc * 32 + 8 * fq;
#pragma unroll
        for (int ai = 0; ai < 2; ++ai)
#pragma unroll
            for (int m = 0; m < 4; ++m) { bf16* rowp = X + (size_t)(row0 + ai * 128 + m * 16) * D + col0;
#pragma unroll
                for (int bj = 0; bj < 2; ++bj) { const v4u r = *(const v4u*)(rowp + bj * 128); const pg8::f32x4 v0 = acc[ai][bj][m][0], v1 = acc[ai][bj][m][1];
                    v4u w; w.x = pg8::cvt_pk_bf16(bflo(r.x) + v0[0], bfhi(r.x) + v0[1]); w.y = pg8::cvt_pk_bf16(bflo(r.y) + v0[2], bfhi(r.y) + v0[3]);
                    w.z = pg8::cvt_pk_bf16(bflo(r.z) + v1[0], bfhi(r.z) + v1[1]); w.w = pg8::cvt_pk_bf16(bflo(r.w) + v1[2], bfhi(r.w) + v1[3]);
                    *(v4u*)(rowp + bj * 128) = w; } }
    }
};
__device__ __forceinline__ size_t sgu_blk(int row, int col) { return ((size_t)((row >> 7) * 16 + (col >> 7)) << 15) + (size_t)((row & 127) << 8) + (size_t)((col & 127) << 1); }
struct EpiGeluSplit {
    static constexpr bool RS_DMA = true;
    static constexpr bool PERM = true;
    bf16* U; bf16* V; float* st; const float* rs;
    __device__ __forceinline__ void operator()(const pg8::f32x4 (&acc)[2][2][4][2], const pg8::Unit& u, int wr, int wc, int fr, int fq, const LAS float* rsl) const {
        const bool isv = u.pn >= 8; const int pnl = isv ? u.pn - 8 : u.pn;
        bf16* O = isv ? V : U;
        const int row0 = u.pm * 256 + wr * 64 + fr, col0 = pnl * 256 + wc * 32 + 8 * fq;
#pragma unroll
        for (int ai = 0; ai < 2; ++ai)
#pragma unroll
            for (int m = 0; m < 4; ++m) { const int row = row0 + ai * 128 + m * 16; bf16* rowp = (bf16*)((char*)O + sgu_blk(row, col0)); float s = 0.f, q = 0.f;   const float sc = rsl[ai * 128 + wr * 64 + m * 16 + fr] * (1.f / MOE_WSCALE);
#pragma unroll
                for (int bj = 0; bj < 2; ++bj) { const pg8::f32x4 v0 = acc[ai][bj][m][0] * sc, v1 = acc[ai][bj][m][1] * sc;
                    const pg8::f32x2 a = pg8::gelu_pk((pg8::f32x2){v0[0], v0[1]}), b = pg8::gelu_pk((pg8::f32x2){v0[2], v0[3]}), c = pg8::gelu_pk((pg8::f32x2){v1[0], v1[1]}), d = pg8::gelu_pk((pg8::f32x2){v1[2], v1[3]});
                    s += (a.x + a.y) + (b.x + b.y) + (c.x + c.y) + (d.x + d.y);
                    q += (a.x * a.x + a.y * a.y) + (b.x * b.x + b.y * b.y) + (c.x * c.x + c.y * c.y) + (d.x * d.x + d.y * d.y);
                    v4u w; w.x = pg8::cvt_pk_bf16(a.x, a.y); w.y = pg8::cvt_pk_bf16(b.x, b.y); w.z = pg8::cvt_pk_bf16(c.x, c.y); w.w = pg8::cvt_pk_bf16(d.x, d.y);
                    *(v4u*)((char*)rowp + bj * 32768) = w; }
                if (isv) { s += __shfl_xor(s, 16); s += __shfl_xor(s, 32); q += __shfl_xor(q, 16); q += __shfl_xor(q, 32);
                    if (fq == 0) { pg8::f32x2 o = {s, q}; *(pg8::f32x2*)(st + ((size_t)(pnl * 4 + wc) * T + row) * 2) = o; } } }
    }
};

__device__ __forceinline__ void f_gemm_in(Frame& F) {
    pg8::DenseOrder S; S.init(T, NQKVR, D, WSP(bf16, WS_WIN), F.G, F.bid);
    EpiStoreBf16 E{WSP(bf16, WS_QKVR), NQKVR, WSP(float, WS_RS), 8};
    pg8::gemm_phase(F.lds, WSP(bf16, WS_XN), D, S, E);
}
struct DenseOrder8 : pg8::DenseOrder {
    __device__ __forceinline__ const char* bptr(const pg8::Unit& u) const { return Bt + (size_t)u.pn * 256 * K; }
    __device__ __forceinline__ size_t abase(const pg8::Unit& u) const { return (size_t)u.pm * 256 * K; }
};
struct BlockedAOrder : pg8::DenseOrder {
    __device__ __forceinline__ size_t abase(const pg8::Unit& u) const { return (size_t)u.pm * 2 * 16 * 32768; }
    __device__ __forceinline__ int a_rowstride(int) const { return 256; }
    __device__ __forceinline__ size_t a_hstep(size_t) const { return (size_t)16 * 32768; }
    __device__ __forceinline__ size_t a_koff(int kt) const { return (size_t)(kt >> 1) * 32768 + (size_t)(kt & 1) * 128; }
};
struct RowSetOrder {
    static constexpr bool GATHER = false;
    int nb, c, j0, nunits, K; const char* Bt;
    __device__ __forceinline__ bool next(int i, pg8::Unit& u) const {
        if (c < 0) return false;
        const int q = i * nb + c; if (q >= nunits) return false;
        u.pm = ((q & 63) >> 2) * 8 + j0 + (q >> 6); u.pn = q & 3; u.e = 0; u.slot = 0; return true;
    }
    __device__ __forceinline__ const char* bptr(const pg8::Unit& u) const { return Bt + (size_t)u.pn * 256 * K * 2; }
    __device__ __forceinline__ size_t abase(const pg8::Unit& u) const { return (size_t)u.pm * 256 * K * 2; }
    __device__ __forceinline__ int a_rowstride(int dflt) const { return dflt; }
    __device__ __forceinline__ size_t a_hstep(size_t dflt) const { return dflt; }
    __device__ __forceinline__ size_t a_koff(int kt) const { return (size_t)kt * 128; }
    __device__ __forceinline__ unsigned aoff(const pg8::Unit&, int, int, int) const { return 0u; }
    __device__ __forceinline__ void a_ready(const pg8::Unit&) const {}
    __device__ __forceinline__ void done(const pg8::Unit&) const {}
};
__device__ __forceinline__ void f_gemm_out_rows(Frame& F, int j0, int j1, int boff) {
    RowSetOrder S; S.nb = F.G - boff; S.c = F.bid - boff; S.j0 = j0; S.nunits = (j1 - j0) * 64; S.K = HV; S.Bt = (const char*)WSP(bf16, WS_WOUT);
    EpiResBf16 E{WSP(bf16, WS_XN)};
    pg8::gemm_phase(F.lds, WSP(bf16, WS_AOUT), HV, S, E);
}
__device__ __forceinline__ void f_gemm_sgu_in(Frame& F) {
    DenseOrder8 S; S.init(T, SGU_FFN, D, WSP(bf16, WS_WSIN), F.G, F.bid);
    EpiGeluSplit E{WSP(bf16, WS_U), WSP(bf16, WS_V), WSP(float, WS_STATS), WSP(float, WS_RS)};
    pg8::gemm_phase_es<1>(F.lds, WSP(unsigned char, WS_XB8), D, S, E);
}
__device__ __forceinline__ void f_gemm_sgu_out(Frame& F) {
    BlockedAOrder S; S.init(T, D, SGU_HALF, WSP(bf16, WS_WSOUT), F.G, F.bid);
    EpiResBf16 E{WSP(bf16, WS_XN)};
    pg8::gemm_phase(F.lds, WSP(bf16, WS_U), SGU_HALF, S, E);
}

template <bool GATHER_> struct MoeOrder {
    static constexpr bool GATHER = GATHER_;
    int G, c, nunits, ibase, K, rowb, mode;
    const char* W; size_t estride;
    LAS const int* tst; LAS const int* tab; unsigned* hcnt; unsigned rdy;
    int n5, rb;
    __device__ __forceinline__ bool next(int i, pg8::Unit& u) const {
        if (i >= MOE_MAXU) return false;
        const int ii = ibase + i; int Lu;
        if (GATHER || n5 <= 0 || ii < rb) Lu = ii * G + c;
        else { if (c < n5) return false; Lu = rb * G + (ii - rb) * (G - n5) + (c - n5); }
        if (Lu >= nunits) return false;
        const int rt = Lu >> 2; int e = 0;
        while (e < NE - 1 && tst[e + 1] <= rt) ++e;
        u.pm = rt; u.pn = Lu & 3; u.e = e; u.slot = i; return true;
    }
    __device__ __forceinline__ const char* bptr(const pg8::Unit& u) const { return W + (size_t)u.e * estride + (size_t)u.pn * 256 * rowb; }
    __device__ __forceinline__ size_t abase(const pg8::Unit& u) const { return (size_t)u.pm * 256 * rowb; }
    __device__ __forceinline__ int a_rowstride(int dflt) const { return dflt; }
    __device__ __forceinline__ size_t a_hstep(size_t dflt) const { return dflt; }
    __device__ __forceinline__ size_t a_koff(int kt) const { return (size_t)kt * 128; }
    __device__ __forceinline__ unsigned aoff(const pg8::Unit& u, int h, int R, int C) const {
        if (mode == 0) { int ent = tab[u.slot * 256 + h * 128 + R]; ent = ent < 0 ? 0 : ent; return (unsigned)((ent >> 1) * rowb + C * 2); }
        return (unsigned)((u.pm * 256 + h * 128 + R) * rowb + C * 2);
    }
    __device__ __forceinline__ void a_ready(const pg8::Unit& u) const {
        if (GATHER || ((rdy >> u.slot) & 1u)) return;
        if (threadIdx.x < 64) {
            unsigned spins = 0;
            while ((unsigned)__builtin_amdgcn_readfirstlane(__hip_atomic_load(hcnt + 16 * u.pm, __ATOMIC_RELAXED, __HIP_MEMORY_SCOPE_AGENT)) < 32u) { __builtin_amdgcn_s_sleep(2); if (++spins > (1u << 20)) break; }
            __builtin_amdgcn_fence(__ATOMIC_ACQUIRE, "agent");
            asm volatile("s_waitcnt vmcnt(0)" ::: "memory");
        }
        asm volatile("" ::: "memory"); __builtin_amdgcn_s_barrier(); asm volatile("" ::: "memory");
    }
    __device__ __forceinline__ void done(const pg8::Unit& u) const {
        if (!GATHER) return;
        if ((threadIdx.x & 63) == 0) __hip_atomic_fetch_add(hcnt + 16 * u.pm, 1u, __ATOMIC_RELAXED, __HIP_MEMORY_SCOPE_AGENT);
    }
};
struct EpiSwiglu {
    static constexpr bool RS_DMA = false;
    static constexpr bool PERM = true;
    unsigned char* H; LAS const float* gt;
    __device__ __forceinline__ void operator()(const pg8::f32x4 (&acc)[2][2][4][2], const pg8::Unit& u, int wr, int wc, int fr, int fq, const LAS float* rsl) const {
        const __amdgpu_buffer_rsrc_t hrs = __builtin_amdgcn_make_buffer_rsrc((void*)H, (short)0, 73728 * FF, 0x00020000);
        const int row0 = u.pm * 256 + wr * 64 + fr, col0 = u.pn * 128 + wc * 32 + 8 * fq;
#pragma unroll
        for (int ai = 0; ai < 2; ++ai)
#pragma unroll
            for (int m = 0; m < 4; ++m) { float h[8]; const float sc = gt[u.slot * 256 + ai * 128 + wr * 64 + m * 16 + fr] * (1.f / MOE_WSCALE);
#pragma unroll
                for (int n = 0; n < 2; ++n)
#pragma unroll
                    for (int i = 0; i < 4; ++i) { const float a = acc[ai][0][m][n][i] * sc, b = acc[ai][1][m][n][i] * sc; h[n * 4 + i] = a * __builtin_amdgcn_rcpf(1.f + __expf(-a)) * b; }
                int w0 = __builtin_amdgcn_cvt_pk_fp8_f32(h[0], h[1], 0, false); w0 = __builtin_amdgcn_cvt_pk_fp8_f32(h[2], h[3], w0, true);
                int w1 = __builtin_amdgcn_cvt_pk_fp8_f32(h[4], h[5], 0, false); w1 = __builtin_amdgcn_cvt_pk_fp8_f32(h[6], h[7], w1, true);
                v2u w; w.x = (unsigned)w0; w.y = (unsigned)w1;
                __builtin_amdgcn_raw_buffer_store_b64(w, hrs, (row0 + ai * 128 + m * 16) * FF + col0, 0, 16); }
    }
};
struct EpiScatterY {
    static constexpr bool RS_DMA = false;
    static constexpr bool PERM = true;
    unsigned char* Y; LAS const int* tab; LAS const float* gt;
    __device__ __forceinline__ void operator()(const pg8::f32x4 (&acc)[2][2][4][2], const pg8::Unit& u, int wr, int wc, int fr, int fq, const LAS float* rsl) const {
        const int col0 = u.pn * 256 + wc * 32 + 8 * fq;
#pragma unroll
        for (int ai = 0; ai < 2; ++ai)
#pragma unroll
            for (int m = 0; m < 4; ++m) { const int r = ai * 128 + wr * 64 + m * 16 + fr; const int ent = tab[u.slot * 256 + r]; const float g = gt[u.slot * 256 + r] * (1.f / MOE_WSCALE);
                if (ent >= 0) { unsigned char* rowp = Y + ((size_t)(ent & 1) * T + (ent >> 1)) * D + col0;
#pragma unroll
                    for (int bj = 0; bj < 2; ++bj) { const pg8::f32x4 v0 = acc[ai][bj][m][0] * g, v1 = acc[ai][bj][m][1] * g;
                        int w0 = __builtin_amdgcn_cvt_pk_fp8_f32(v0[0], v0[1], 0, false); w0 = __builtin_amdgcn_cvt_pk_fp8_f32(v0[2], v0[3], w0, true);
                        int w1 = __builtin_amdgcn_cvt_pk_fp8_f32(v1[0], v1[1], 0, false); w1 = __builtin_amdgcn_cvt_pk_fp8_f32(v1[2], v1[3], w1, true);
                        v2u w; w.x = (unsigned)w0; w.y = (unsigned)w1; *(v2u*)(rowp + bj * 128) = w; } } }
    }
};
template <int MODE> __device__ __forceinline__ void f_moe_gemm(Frame& F, int L, LAS int* tst, LAS int* cntl) {
    LAS int* tab = (LAS int*)(F.lds + LX_TAB); LAS float* gt = (LAS float*)(F.lds + LX_GT);
    MoeOrder<MODE == 0> S; S.G = F.G; S.c = F.bid; S.nunits = 4 * tst[NE]; S.K = MODE == 0 ? D : FF; S.rowb = S.K; S.mode = MODE; S.tst = tst; S.tab = tab;
    S.hcnt = WSP(unsigned, WS_CTL) + CW_HID + L * 4608;
    { const int r1 = (S.nunits + F.G - 1) / F.G, nlast = S.nunits - (r1 - 1) * F.G;
      S.n5 = (MODE == 1 && r1 >= 3 && nlast < F.G) ? nlast : 0; S.rb = r1 - 2; }
    S.W = MODE == 0 ? (const char*)(WSP(unsigned char, WS_W13) + (size_t)L * NE * 1024 * 1024) : (const char*)(WSP(unsigned char, WS_W2) + (size_t)L * NE * 1024 * 512);
    S.estride = MODE == 0 ? (size_t)1024 * 1024 : (size_t)1024 * 512;
    const int* list = WSP(int, WS_LIST); const float* gates = WSP(float, WS_GATE);
    for (int ibase = 0; ibase * (S.n5 > 0 ? F.G - S.n5 : F.G) < S.nunits; ibase += MOE_MAXU) {
        S.ibase = ibase;
        {
            static_assert(MOE_MAXU == 6, "three table slots per thread half");
            int ents[3]; float gsv[3]; const int r = FTID & 255, hsel = FTID >> 8;
#pragma unroll
            for (int k = 0; k < 3; ++k) { pg8::Unit u; ents[k] = -1;
                if (S.next(2 * k + hsel, u)) { const int idx = (u.pm - tst[u.e]) * 256 + r; if (idx < cntl[u.e]) ents[k] = list[(size_t)u.e * T + idx]; } }
#pragma unroll
            for (int k = 0; k < 3; ++k) gsv[k] = ents[k] >= 0 ? (MODE == 0 ? WSP(float, WS_RS)[ents[k] >> 1] : gates[ents[k]]) : 0.f;
#pragma unroll
            for (int k = 0; k < 3; ++k) { tab[(2 * k + hsel) * 256 + r] = ents[k]; gt[(2 * k + hsel) * 256 + r] = gsv[k]; }
        }
        S.rdy = 0u;
        if (MODE == 1) {
            LAS unsigned* rdyw = (LAS unsigned*)(F.lds + LX_TST + 448);
            if (FTID < 64) { unsigned m = 0u;
                for (int i = 0; i < MOE_MAXU; ++i) { pg8::Unit u; if (S.next(i, u) && (unsigned)__builtin_amdgcn_readfirstlane(__hip_atomic_load(S.hcnt + 16 * u.pm, __ATOMIC_RELAXED, __HIP_MEMORY_SCOPE_AGENT)) >= 32u) m |= 1u << i; }
                __builtin_amdgcn_fence(__ATOMIC_ACQUIRE, "agent"); asm volatile("s_waitcnt vmcnt(0)" ::: "memory");
                if (FTID == 0) *rdyw = m; }
            __syncthreads();
            S.rdy = *rdyw;
        }
        __syncthreads();
        if (MODE == 0) { EpiSwiglu E{WSP(unsigned char, WS_HID), gt}; pg8::gemm_phase_es<1>(F.lds, WSP(unsigned char, WS_XB8), D, S, E); }
        else { EpiScatterY E{WSP(unsigned char, WS_Y), tab, gt}; pg8::gemm_phase_es<1>(F.lds, WSP(unsigned char, WS_HID), FF, S, E); }
        __syncthreads();
    }
}
__device__ __forceinline__ void f_moe(Frame& F, int L) {
    LAS int* tst = (LAS int*)(F.lds + LX_TST); LAS int* cntl = tst + 64;
    unsigned* ctl = WSP(unsigned, WS_CTL);
    __syncthreads();
    if (FTID < NE) cntl[FTID] = (int)__hip_atomic_load(&ctl[CW_CNT + L * 2048 + 64 * FTID], __ATOMIC_RELAXED, __HIP_MEMORY_SCOPE_AGENT);
    __syncthreads();
    if (FTID == 0) { int s = 0; for (int e = 0; e < NE; ++e) { tst[e] = s; s += (cntl[e] + 255) >> 8; } tst[NE] = s; }
    __syncthreads();
    f_moe_gemm<0>(F, L, tst, cntl);
    f_moe_gemm<1>(F, L, tst, cntl);
}
__device__ __forceinline__ void transpose_item(const float* W, int ldw, const float* kscale, float cs, bf16* WT, int K, int dst_row0, LAS float* scr, int k0, int n0, int lane) {
    f32x4 x[8]; float ks[8];
    const int kr = lane >> 3, n4 = (lane & 7) * 4;
#pragma unroll
    for (int i = 0; i < 8; ++i) { x[i] = *(const f32x4*)(W + (size_t)(k0 + 8 * i + kr) * ldw + n0 + n4); ks[i] = kscale ? kscale[k0 + 8 * i + kr] * cs : cs; }
#pragma unroll
    for (int i = 0; i < 8; ++i) { LAS float* d = scr + (8 * i + kr) * 33 + n4; d[0] = x[i][0] * ks[i]; d[1] = x[i][1] * ks[i]; d[2] = x[i][2] * ks[i]; d[3] = x[i][3] * ks[i]; }
    LDS_WAIT(); asm volatile("" ::: "memory");
    const int c = lane & 7;
#pragma unroll
    for (int j = 0; j < 4; ++j) { const int n = (lane >> 3) + 8 * j; const LAS float* s = scr + (8 * c) * 33 + n;
        v4u o; o.x = pk2(s[0 * 33], s[1 * 33]); o.y = pk2(s[2 * 33], s[3 * 33]); o.z = pk2(s[4 * 33], s[5 * 33]); o.w = pk2(s[6 * 33], s[7 * 33]);
        *(v4u*)(WT + (size_t)(dst_row0 + n) * K + k0 + 8 * c) = o; }
    LDS_WAIT(); asm volatile("" ::: "memory");
}
__device__ __forceinline__ void transpose_item8(const float* W, int ldw, const float* kscale, float cs, unsigned char* WT, int K, int dst_row0, LAS float* scr, int k0, int n0, int lane) {
    f32x4 x[8]; float ks[8];
    const int kr = lane >> 3, n4 = (lane & 7) * 4;
#pragma unroll
    for (int i = 0; i < 8; ++i) { x[i] = *(const f32x4*)(W + (size_t)(k0 + 8 * i + kr) * ldw + n0 + n4); ks[i] = kscale ? kscale[k0 + 8 * i + kr] * cs : cs; }
#pragma unroll
    for (int i = 0; i < 8; ++i) { LAS float* d = scr + (8 * i + kr) * 33 + n4; d[0] = x[i][0] * ks[i]; d[1] = x[i][1] * ks[i]; d[2] = x[i][2] * ks[i]; d[3] = x[i][3] * ks[i]; }
    LDS_WAIT(); asm volatile("" ::: "memory");
    const int c = lane & 7;
#pragma unroll
    for (int j = 0; j < 4; ++j) { const int n = (lane >> 3) + 8 * j; const LAS float* s = scr + (8 * c) * 33 + n;
        int w0 = __builtin_amdgcn_cvt_pk_fp8_f32(s[0 * 33], s[1 * 33], 0, false); w0 = __builtin_amdgcn_cvt_pk_fp8_f32(s[2 * 33], s[3 * 33], w0, true);
        int w1 = __builtin_amdgcn_cvt_pk_fp8_f32(s[4 * 33], s[5 * 33], 0, false); w1 = __builtin_amdgcn_cvt_pk_fp8_f32(s[6 * 33], s[7 * 33], w1, true);
        v2u o; o.x = (unsigned)w0; o.y = (unsigned)w1; *(v2u*)(WT + (size_t)(dst_row0 + n) * K + k0 + 8 * c) = o; }
    LDS_WAIT(); asm volatile("" ::: "memory");
}
__device__ __forceinline__ void convert_job_item8(const float* W, int ldw, int K, int N, const float* kscale, float cs, unsigned char* WT, int rowmap, LAS float* scr, int item, int lane) {
    const int nblk = N / 32, kb = item / nblk, nb = item % nblk, k0 = 64 * kb, n0 = 32 * nb;
    const int dr = rowmap == 0 ? n0 : ((n0 >> 7) * 256 + (n0 & 127) + (rowmap == 2 ? 128 : 0));
    transpose_item8(W, ldw, kscale, cs, WT, K, dr, scr, k0, n0, lane);
}
__device__ __forceinline__ void convert_job_item(const float* W, int ldw, int K, int N, const float* kscale, int qcols, float qs, bf16* WT, int rowmap, LAS float* scr, int item, int lane) {
    const int nblk = N / 32, kb = item / nblk, nb = item % nblk, k0 = 64 * kb, n0 = 32 * nb;
    const int dr = rowmap == 0 ? n0 : ((n0 >> 7) * 256 + (n0 & 127) + (rowmap == 2 ? 128 : 0));
    transpose_item(W, ldw, kscale, n0 < qcols ? qs : 1.f, WT, K, dr, scr, k0, n0, lane);
}
__device__ __forceinline__ void f_convert_gla(Frame& F) {
    LAS float* scr = (LAS float*)(F.lds + FWAVE * 8448);
    const int gw = F.bid * NWAVES + FWAVE, NGW = F.G * NWAVES;
    constexpr int I0 = (D / 64) * (NQKVR / 32), I1 = (HV / 64) * (D / 32);
    for (int it = gw; it < I0 + I1; it += NGW) {
        if (it < I0) convert_job_item(F.inp(I_GLA_WIN), GLA_IN, D, NQKVR, F.inp(I_GLA_NORM), HK, 0.08838834764831845f, WSP(bf16, WS_WIN), 0, scr, it, FLANE);
        else convert_job_item(F.inp(I_GLA_WOUT), D, HV, D, F.inp(I_GLA_HG), 0, 1.f, WSP(bf16, WS_WOUT), 0, scr, it - I0, FLANE);
    }
}
__device__ __forceinline__ void f_convert_rest(Frame& F, int cw, int NCW, int pct0 = 0, int pct1 = 1000) {
    LAS float* scr = (LAS float*)(F.lds + FWAVE * 8448);
    constexpr int I0 = (D / 64) * (SGU_FFN / 32), I1 = (SGU_HALF / 64) * (D / 32), IE1 = (D / 64) * (FF / 32), IE2 = (FF / 64) * (D / 32);
    constexpr int IM = 2 * NE * IE1;
    static_assert(IE1 == IE2, "w1 / w2 item counts");
    constexpr int NIT = I0 + I1 + 3 * IM; const int it_lo = (int)((long)NIT * pct0 / 1000), it_hi = (int)((long)NIT * pct1 / 1000);
    for (int it = it_lo + cw; it < it_hi; it += NCW) {
        int r = it;
        if (r < I0) { convert_job_item8(F.inp(I_SGU_WIN), SGU_FFN, D, SGU_FFN, F.inp(I_SGU_NORM), MOE_WSCALE, WSP(unsigned char, WS_WSIN), 0, scr, r, FLANE); continue; } r -= I0;
        if (r < I1) { convert_job_item(F.inp(I_SGU_WOUT), D, SGU_HALF, D, nullptr, 0, 1.f, WSP(bf16, WS_WSOUT), 0, scr, r, FLANE); continue; } r -= I1;
        const int which = r / IM; r -= which * IM; const int le = r / IE1, li = r % IE1, L = le / NE;
        if (which == 0) convert_job_item8(F.inp(I_MOE_W1) + (size_t)le * D * FF, FF, D, FF, F.inp(I_MOE_NORM) + L * D, MOE_WSCALE, WSP(unsigned char, WS_W13) + (size_t)le * 1024 * 1024, 1, scr, li, FLANE);
        else if (which == 1) convert_job_item8(F.inp(I_MOE_W3) + (size_t)le * D * FF, FF, D, FF, F.inp(I_MOE_NORM) + L * D, MOE_WSCALE, WSP(unsigned char, WS_W13) + (size_t)le * 1024 * 1024, 2, scr, li, FLANE);
        else convert_job_item8(F.inp(I_MOE_W2) + (size_t)le * FF * D, D, FF, D, nullptr, MOE_WSCALE, WSP(unsigned char, WS_W2) + (size_t)le * 1024 * 512, 0, scr, li, FLANE);
    }
}

constexpr int SC_K = 0, SC_KSTR = 320;
constexpr int SC_V = 20480, SC_VSTR = 576;
constexpr int SC_Q = 57344, SC_QSTR = 272;
constexpr int SC_O = 74752, SC_OSTR = 528;
constexpr int SC_GL = 108544, SC_PART = 112640, SC_DEC = 114688, SC_WG = 115200;
__device__ __forceinline__ s16x4 tr_read16(LAS const unsigned char* p) {
    typedef short v4i16_t __attribute__((ext_vector_type(4)));
    return __builtin_bit_cast(s16x4, __builtin_amdgcn_ds_read_tr16_b64_v4i16((LAS v4i16_t*)p));
}
__device__ __forceinline__ void f_scan_item(Frame& F, int item, const XcdBarrier* xb_ = nullptr, int cbar = -1) {
    const int b = item / GLA_H, h = item % GLA_H;
    const bf16* qkvr = WSP(bf16, WS_QKVR); const float* glr = WSP(float, WS_GLR); bf16* aout = WSP(bf16, WS_AOUT);
    LAS unsigned char* L = F.lds;
    LAS float* gl = (LAS float*)(L + SC_GL); LAS float* part = (LAS float*)(L + SC_PART); LAS float* dec = (LAS float*)(L + SC_DEC);
    const int tid = FTID, lane = FLANE, w = FWAVE;
    const int r32 = lane & 31, hh = lane >> 5, blk = (lane >> 4) & 1, q4 = (lane & 15) >> 2, p4 = lane & 3;
    const int dk = tid & 127, tg = tid >> 7;
    const int gq = lane >> 4, gcol = lane & 15, gdk = 16 * w + gcol;
    bf16x8 gBh, gBl;
    { unsigned ph[4], pl[4];
#pragma unroll
      for (int j = 0; j < 4; ++j) { const float x0 = gq < 2 ? F.inp(I_GLA_WGU)[(8 * gq + 2 * j) * HK + h * DK + gdk] : 0.f, x1 = gq < 2 ? F.inp(I_GLA_WGU)[(8 * gq + 2 * j + 1) * HK + h * DK + gdk] : 0.f;
          ph[j] = pk2(x0, x1); pl[j] = pk2(x0 - bflo(ph[j]), x1 - bfhi(ph[j])); }
      v4u vh = {ph[0], ph[1], ph[2], ph[3]}, vl = {pl[0], pl[1], pl[2], pl[3]};
      gBh = __builtin_bit_cast(bf16x8, vh); gBl = __builtin_bit_cast(bf16x8, vl); }
    const float gbias = F.inp(I_GLA_BG)[h * DK + gdk];
    __syncthreads();
    f32x16 st[4];
#pragma unroll
    for (int i = 0; i < 4; ++i)
#pragma unroll
        for (int j = 0; j < 16; ++j) st[i][j] = 0.f;
    v4u rk[2], rq[2], rv[4]; f32x4 rg;
    const size_t rowb = (size_t)b * SEQ;
    const unsigned vo_kq = (unsigned)(((tid >> 4) * NQKVR + (tid & 15) * 8) * 2), vo_v = (unsigned)(((tid >> 5) * NQKVR + (tid & 31) * 8) * 2), vo_g = (unsigned)(tid * 16);
    const unsigned lo_k = (unsigned)(SC_K + (tid >> 4) * SC_KSTR + (tid & 15) * 16), lo_q = (unsigned)(SC_Q + (tid >> 4) * SC_QSTR + (tid & 15) * 16), lo_v = (unsigned)(SC_V + (tid >> 5) * SC_VSTR + (tid & 31) * 16);
#define SC_LOAD(c) do { size_t cb_ = (rowb + (size_t)(c) * CHUNK) * NQKVR * 2; asm volatile("" : "+s"(cb_)); const char* gb_ = (const char*)qkvr + cb_ + (size_t)(h * DK * 2); \
        _Pragma("unroll") for (int i = 0; i < 2; ++i) { \
            rk[i] = *(const v4u*)(gb_ + (size_t)(HK * 2 + i * 32 * NQKVR * 2) + vo_kq); rq[i] = *(const v4u*)(gb_ + (size_t)(i * 32 * NQKVR * 2) + vo_kq); } \
        _Pragma("unroll") for (int i = 0; i < 4; ++i) rv[i] = *(const v4u*)(gb_ + (size_t)(2 * HK * 2 + h * (DV - DK) * 2 + i * 16 * NQKVR * 2) + vo_v); \
        if (tid < 256) rg = *(const f32x4*)((const char*)glr + (rowb + (size_t)(c) * CHUNK) * RANK * 4 + vo_g); } while (0)
#define SC_STORE() do { \
        _Pragma("unroll") for (int i = 0; i < 2; ++i) { *(LAS v4u*)(L + lo_k + i * 32 * SC_KSTR) = rk[i]; *(LAS v4u*)(L + lo_q + i * 32 * SC_QSTR) = rq[i]; } \
        _Pragma("unroll") for (int i = 0; i < 4; ++i) *(LAS v4u*)(L + lo_v + i * 16 * SC_VSTR) = rv[i]; \
        if (tid < 256) *(LAS f32x4*)(gl + tid * 4) = rg; } while (0)
    SC_LOAD(0);
    SC_STORE();
    for (int c = 0; c < NCHUNK; ++c) {
        if (c == cbar) xcd_barrier(*xb_);
        const size_t t0 = rowb + (size_t)c * CHUNK;
        __syncthreads();
        if (c + 1 < NCHUNK) SC_LOAD(c + 1);
        {
            pg8::f32x4 g4[4]; float tsum[4], pre[4];
#pragma unroll
            for (int t = 0; t < 4; ++t) {
                v4u ah = {0u, 0u, 0u, 0u}, al = {0u, 0u, 0u, 0u};
                if (gq < 2) { const f32x4 x0 = *(const LAS f32x4*)(gl + (16 * t + gcol) * 16 + 8 * gq), x1 = *(const LAS f32x4*)(gl + (16 * t + gcol) * 16 + 8 * gq + 4);
                    ah.x = pk2(x0[0], x0[1]); ah.y = pk2(x0[2], x0[3]); ah.z = pk2(x1[0], x1[1]); ah.w = pk2(x1[2], x1[3]);
                    al.x = pk2(x0[0] - bflo(ah.x), x0[1] - bfhi(ah.x)); al.y = pk2(x0[2] - bflo(ah.y), x0[3] - bfhi(ah.y)); al.z = pk2(x1[0] - bflo(ah.z), x1[1] - bfhi(ah.z)); al.w = pk2(x1[2] - bflo(ah.w), x1[3] - bfhi(ah.w)); }
                pg8::f32x4 a4 = {gbias, gbias, gbias, gbias};
                a4 = __builtin_amdgcn_mfma_f32_16x16x32_bf16(__builtin_bit_cast(bf16x8, ah), gBh, a4, 0, 0, 0);
                a4 = __builtin_amdgcn_mfma_f32_16x16x32_bf16(__builtin_bit_cast(bf16x8, al), gBh, a4, 0, 0, 0);
                a4 = __builtin_amdgcn_mfma_f32_16x16x32_bf16(__builtin_bit_cast(bf16x8, ah), gBl, a4, 0, 0, 0);
#pragma unroll
                for (int i = 0; i < 4; ++i) { const float a = a4[i]; a4[i] = (fminf(a, 0.f) - __logf(1.f + __expf(-fabsf(a)))) * (1.f / 16.f); }
                a4[1] += a4[0]; a4[2] += a4[1]; a4[3] += a4[2];
                g4[t] = a4;
                const float s0 = a4[3], x1 = __shfl_xor(s0, 16), x2 = __shfl_xor(s0, 32), x3 = __shfl_xor(x1, 32);
                tsum[t] = (s0 + x1) + (x2 + x3);
                pre[t] = ((gq ^ 1) < gq ? x1 : 0.f) + ((gq ^ 2) < gq ? x2 : 0.f) + ((gq ^ 3) < gq ? x3 : 0.f);
            }
            const float tot = (tsum[0] + tsum[1]) + (tsum[2] + tsum[3]);
            float basep = 0.f;
#pragma unroll
            for (int t = 0; t < 4; ++t) {
#pragma unroll
                for (int i = 0; i < 4; ++i) {
                    LAS unsigned short* kp = (LAS unsigned short*)(L + SC_K + (16 * t + 4 * gq + i) * SC_KSTR + gdk * 2);
                    *kp = (unsigned short)f2bf(bf2f(*kp) * __expf(tot - (basep + pre[t] + g4[t][i])));
                }
                basep += tsum[t];
            }
            if (gq == 0) dec[gdk] = __expf(tot);
        }
        __syncthreads();
        const int etok = tid >> 3, ecc = tid & 7;
        v4u rr[4];
        { size_t eb_ = t0 * NQKVR * 2; asm volatile("" : "+s"(eb_));
          const char* rb_ = (const char*)qkvr + eb_ + (size_t)((2 * HK + HV + h * DV) * 2); const unsigned vo_r = (unsigned)(etok * NQKVR * 2 + ecc * 16);
#pragma unroll
          for (int i = 0; i < 4; ++i) rr[i] = *(const v4u*)(rb_ + vo_r + i * 128); }
#pragma unroll
        for (int i = 0; i < 4; ++i)
#pragma unroll
            for (int g4 = 0; g4 < 4; ++g4) { const f32x4 d4 = *(const LAS f32x4*)(dec + 32 * i + 8 * g4 + 4 * hh);
#pragma unroll
                for (int j = 0; j < 4; ++j) st[i][4 * g4 + j] *= d4[j]; }
#pragma unroll
        for (int s = 0; s < 4; ++s) {
            const int trow = 16 * s + 8 * hh + q4;
            const s16x4 v0 = tr_read16(L + SC_V + trow * SC_VSTR + (32 * w + 16 * blk + 4 * p4) * 2), v1 = tr_read16(L + SC_V + (trow + 4) * SC_VSTR + (32 * w + 16 * blk + 4 * p4) * 2);
            const bf16x8 Bv = {v0[0], v0[1], v0[2], v0[3], v1[0], v1[1], v1[2], v1[3]};
#pragma unroll
            for (int i = 0; i < 4; ++i) {
                const s16x4 k0 = tr_read16(L + SC_K + trow * SC_KSTR + (32 * i + 16 * blk + 4 * p4) * 2), k1 = tr_read16(L + SC_K + (trow + 4) * SC_KSTR + (32 * i + 16 * blk + 4 * p4) * 2);
                const bf16x8 Ak = {k0[0], k0[1], k0[2], k0[3], k1[0], k1[1], k1[2], k1[3]};
                st[i] = __builtin_amdgcn_mfma_f32_32x32x16_bf16(Ak, Bv, st[i], 0, 0, 0);
            }
        }
        {
        f32x16 oacc[2];
#pragma unroll
        for (int ot = 0; ot < 2; ++ot)
#pragma unroll
            for (int j = 0; j < 16; ++j) oacc[ot][j] = 0.f;
#pragma unroll
        for (int i = 0; i < 4; ++i)
#pragma unroll
            for (int s2 = 0; s2 < 2; ++s2) {
                v4u pb; pb.x = pk2(st[i][8 * s2 + 0], st[i][8 * s2 + 1]); pb.y = pk2(st[i][8 * s2 + 2], st[i][8 * s2 + 3]); pb.z = pk2(st[i][8 * s2 + 4], st[i][8 * s2 + 5]); pb.w = pk2(st[i][8 * s2 + 6], st[i][8 * s2 + 7]);
                const bf16x8 Bs = __builtin_bit_cast(bf16x8, pb);
#pragma unroll
                for (int ot = 0; ot < 2; ++ot) {
                    LAS const unsigned char* qp = L + SC_Q + (32 * ot + r32) * SC_QSTR + (32 * i + 16 * s2 + 4 * hh) * 2;
                    const v2u a0 = *(const LAS v2u*)qp, a1 = *(const LAS v2u*)(qp + 16);
                    v4u pa; pa.x = a0.x; pa.y = a0.y; pa.z = a1.x; pa.w = a1.y;
                    oacc[ot] = __builtin_amdgcn_mfma_f32_32x32x16_bf16(__builtin_bit_cast(bf16x8, pa), Bs, oacc[ot], 0, 0, 0);
                }
            }
#pragma unroll
        for (int ot = 0; ot < 2; ++ot)
#pragma unroll
            for (int rg16 = 0; rg16 < 16; ++rg16) {
                const int tok = 32 * ot + (rg16 & 3) + 8 * (rg16 >> 2) + 4 * hh;
                *(LAS unsigned short*)(L + SC_O + tok * SC_OSTR + (32 * w + r32) * 2) = (unsigned short)f2bf(oacc[ot][rg16]);
            }
        }
        __syncthreads();
        if (c + 1 < NCHUNK) SC_STORE();
        {
        {
            const int tok = etok, cc = ecc;
            v4u ov[4]; float ss = 0.f;
#pragma unroll
            for (int i = 0; i < 4; ++i) ov[i] = *(const LAS v4u*)(L + SC_O + tok * SC_OSTR + cc * 16 + i * 128);
#pragma unroll
            for (int i = 0; i < 4; ++i) { const float a0 = bflo(ov[i].x), a1 = bfhi(ov[i].x), a2 = bflo(ov[i].y), a3 = bfhi(ov[i].y), a4 = bflo(ov[i].z), a5 = bfhi(ov[i].z), a6 = bflo(ov[i].w), a7 = bfhi(ov[i].w);
                ss += (a0 * a0 + a1 * a1) + (a2 * a2 + a3 * a3) + (a4 * a4 + a5 * a5) + (a6 * a6 + a7 * a7); }
            ss += __shfl_xor(ss, 1); ss += __shfl_xor(ss, 2); ss += __shfl_xor(ss, 4);
            const float rms = __builtin_amdgcn_rsqf(ss * (1.f / DV) + EPS);
            size_t ob_ = (t0 * D + h * DV) * 2; asm volatile("" : "+s"(ob_)); const unsigned vo_o = (unsigned)(tok * D * 2 + cc * 16);
#pragma unroll
            for (int i = 0; i < 4; ++i) {
                v4u o;
                o.x = pk2(bflo(ov[i].x) * rms * bflo(rr[i].x), bfhi(ov[i].x) * rms * bfhi(rr[i].x));
                o.y = pk2(bflo(ov[i].y) * rms * bflo(rr[i].y), bfhi(ov[i].y) * rms * bfhi(rr[i].y));
                o.z = pk2(bflo(ov[i].z) * rms * bflo(rr[i].z), bfhi(ov[i].z) * rms * bfhi(rr[i].z));
                o.w = pk2(bflo(ov[i].w) * rms * bflo(rr[i].w), bfhi(ov[i].w) * rms * bfhi(rr[i].w));
                *(v4u*)((char*)aout + ob_ + vo_o + i * 128) = o;
            }
        }
            }
    }
    __syncthreads();
#undef SC_LOAD
#undef SC_STORE
}
constexpr int SCAN_C1 = 20;
__device__ __forceinline__ void f_scan_outproj(Frame& F, const XcdBarrier& xbar) {
    constexpr int NITEM = NBATCH * GLA_H;
    if (F.bid < NITEM) f_scan_item(F, F.bid, &xbar, SCAN_C1);
    else { f_convert_rest(F, (F.bid - NITEM) * NWAVES + FWAVE, (F.G - NITEM) * NWAVES); xcd_barrier(xbar); f_gemm_out_rows(F, 0, SCAN_C1 / 4, NITEM); }
    xcd_barrier(xbar);
    f_gemm_out_rows(F, SCAN_C1 / 4, 8, 0);
}
constexpr int MX_W = 0, MX_WSTR = 272;
constexpr int MX_V0 = 34816, MX_VSTR = 320, MX_VBYTES = 40960;
constexpr int MX_MU = 116736;
constexpr int MX_LN = MX_MU + 2560;
__device__ __forceinline__ void f_mix(Frame& F) {
    LAS unsigned char* L = F.lds;
    LAS float* mu = (LAS float*)(L + MX_MU); LAS float* rs = mu + 128; LAS float* m1 = rs + 128; LAS float* m0 = m1 + 128; LAS float* bsg = m0 + 128;
    LAS float* lgs = (LAS float*)(L + MX_LN); LAS float* lbs = lgs + 512;
    bf16* u = WSP(bf16, WS_U); const bf16* v = WSP(bf16, WS_V); const float* st = WSP(float, WS_STATS); bf16* uout = u;
    const int tid = FTID, lane = FLANE, w = FWAVE;
    const int r32 = lane & 31, hh = lane >> 5, blk = (lane >> 4) & 1, q4 = (lane & 15) >> 2, p4 = lane & 3;
    const int ct = w >> 1, th = w & 1;
    const unsigned vo_v = (unsigned)(tid * 16), lo_v = (unsigned)(MX_V0 + (tid >> 4) * MX_VSTR + (tid & 15) * 16);
    constexpr int MX_MSTR = 272;
    for (int bn = F.bid; bn < T / SGU_BLK; bn += F.G) {
        const size_t t0 = (size_t)bn * SGU_BLK;
        __syncthreads();
        {
            const int row = tid & 127, pq = tid >> 7; float s = 0.f, q = 0.f;
#pragma unroll
            for (int p = 0; p < 8; ++p) { const pg8::f32x2 a = *(const pg8::f32x2*)(st + ((size_t)(pq * 8 + p) * T + t0 + row) * 2); s += a.x; q += a.y; }
            LAS float* red = (LAS float*)(L + MX_V0);
            red[(pq * 128 + row) * 2] = s; red[(pq * 128 + row) * 2 + 1] = q;
            __syncthreads();
            if (tid < 128) { float s4 = 0.f, q4 = 0.f;
#pragma unroll
                for (int p = 0; p < 4; ++p) { s4 += red[(p * 128 + tid) * 2]; q4 += red[(p * 128 + tid) * 2 + 1]; }
                const float m = s4 * (1.f / SGU_HALF); mu[tid] = m; rs[tid] = __builtin_amdgcn_rsqf(fmaxf(q4 * (1.f / SGU_HALF) - m * m, 0.f) + EPS); }
            __syncthreads();
        }
        v4u preA[4], preB[4]; v4u uuA[4], uuB[4];
#define MX_LOAD(pre_, it_) do { size_t vb_ = ((size_t)bn * 16 + (size_t)(it_)) << 15; asm volatile("" : "+s"(vb_)); \
        _Pragma("unroll") for (int i = 0; i < 4; ++i) pre_[i] = *(const v4u*)((const char*)v + vb_ + (size_t)(i * 8192) + vo_v); } while (0)
#define MX_STORE(buf_, pre_) do { _Pragma("unroll") for (int i = 0; i < 4; ++i) *(LAS v4u*)(L + lo_v + (buf_) * MX_VBYTES + 32 * i * MX_VSTR) = pre_[i]; } while (0)
#define MX_ULOAD(uu_, it_) do { size_t ub_ = ((size_t)bn * 16 + (size_t)(it_)) << 15; asm volatile("" : "+s"(ub_)); \
        _Pragma("unroll") for (int i = 0; i < 4; ++i) uu_[i] = *(const v4u*)((const char*)u + ub_ + (size_t)(i * 8192) + vo_v); } while (0)
#define MX_TILE(it_, buf_, uu_) do { \
        f32x16 acc[2]; \
        _Pragma("unroll") for (int tt = 0; tt < 2; ++tt) _Pragma("unroll") for (int j = 0; j < 16; ++j) acc[tt][j] = 0.f; \
        LAS unsigned char* Vb = L + MX_V0 + (buf_) * MX_VBYTES; \
        const int nks = th == 0 ? 4 : 8; \
        for (int ks = 0; ks < nks; ++ks) { \
            const int srow = 16 * ks + 8 * hh + q4; \
            const s16x4 a0 = tr_read16(Vb + srow * MX_VSTR + (32 * ct + 16 * blk + 4 * p4) * 2), a1 = tr_read16(Vb + (srow + 4) * MX_VSTR + (32 * ct + 16 * blk + 4 * p4) * 2); \
            const bf16x8 Av = {a0[0], a0[1], a0[2], a0[3], a1[0], a1[1], a1[2], a1[3]}; \
            _Pragma("unroll") for (int tt = 0; tt < 2; ++tt) { \
                const bf16x8 Bw = *(const LAS bf16x8*)(L + MX_W + (64 * th + 32 * tt + r32) * MX_WSTR + (16 * ks + 8 * hh) * 2); \
                acc[tt] = __builtin_amdgcn_mfma_f32_32x32x16_bf16(Av, Bw, acc[tt], 0, 0, 0); } } \
        const int cl = ((it_) & 3) * 128 + 32 * ct + 4 * hh;                    \
        __syncthreads();                                                         \
        _Pragma("unroll") for (int tt = 0; tt < 2; ++tt) { \
            const int t = 64 * th + 32 * tt + r32; const float tm1 = m1[t], tm0 = m0[t], tb = bsg[t]; \
            _Pragma("unroll") for (int g4 = 0; g4 < 4; ++g4) { \
                const f32x4 lg = *(const LAS f32x4*)(lgs + cl + 8 * g4), lb = *(const LAS f32x4*)(lbs + cl + 8 * g4); \
                v2u o; o.x = pk2(lg[0] * (acc[tt][4 * g4 + 0] - tm1) + lb[0] * tm0 + tb, lg[1] * (acc[tt][4 * g4 + 1] - tm1) + lb[1] * tm0 + tb); \
                o.y = pk2(lg[2] * (acc[tt][4 * g4 + 2] - tm1) + lb[2] * tm0 + tb, lg[3] * (acc[tt][4 * g4 + 3] - tm1) + lb[3] * tm0 + tb); \
                *(LAS v2u*)(Vb + t * MX_MSTR + (32 * ct + 8 * g4 + 4 * hh) * 2) = o; } } \
        __syncthreads();                                                         \
        size_t ob_ = ((size_t)bn * 16 + (size_t)(it_)) << 15; asm volatile("" : "+s"(ob_)); \
        _Pragma("unroll") for (int i = 0; i < 4; ++i) { \
            const v4u mx = *(const LAS v4u*)(Vb + ((tid >> 4) + 32 * i) * MX_MSTR + (tid & 15) * 16); const v4u ux = uu_[i]; v4u o; \
            o.x = pk2(bflo(ux.x) * bflo(mx.x), bfhi(ux.x) * bfhi(mx.x)); o.y = pk2(bflo(ux.y) * bflo(mx.y), bfhi(ux.y) * bfhi(mx.y)); \
            o.z = pk2(bflo(ux.z) * bflo(mx.z), bfhi(ux.z) * bfhi(mx.z)); o.w = pk2(bflo(ux.w) * bflo(mx.w), bfhi(ux.w) * bfhi(mx.w)); \
            *(v4u*)((char*)uout + ob_ + (size_t)(i * 8192) + vo_v) = o; } } while (0)
        MX_LOAD(preA, 0); MX_LOAD(preB, 1); MX_ULOAD(uuA, 0);
        for (int it = 0; it < 16; it += 2) {
            if ((it & 3) == 0) {
                const int g = it >> 2;
                __syncthreads();
                const int t = tid >> 2, sq = tid & 3; const float* wsrc = F.inp(I_SGU_WS) + ((size_t)g * 128 + t) * 128 + sq * 8;
                float a1 = 0.f, a0 = 0.f;
#pragma unroll
                for (int i = 0; i < 4; ++i) {
                    const f32x4 x0 = *(const f32x4*)(wsrc + i * 32), x1 = *(const f32x4*)(wsrc + i * 32 + 4); float wv[8] = {x0[0], x0[1], x0[2], x0[3], x1[0], x1[1], x1[2], x1[3]}; float hv[8];
#pragma unroll
                    for (int j = 0; j < 8; ++j) { const int s = i * 32 + sq * 8 + j; const float wm = ((t >> 6) >= (s >> 6)) ? wv[j] : 0.f; a0 += wm; hv[j] = wm * rs[s]; }
                    v4u o; o.x = pk2(hv[0], hv[1]); o.y = pk2(hv[2], hv[3]); o.z = pk2(hv[4], hv[5]); o.w = pk2(hv[6], hv[7]);
                    const unsigned ow[4] = {o.x, o.y, o.z, o.w};
#pragma unroll
                    for (int j = 0; j < 4; ++j) a1 += bflo(ow[j]) * mu[i * 32 + sq * 8 + 2 * j] + bfhi(ow[j]) * mu[i * 32 + sq * 8 + 2 * j + 1];
                    *(LAS v4u*)(L + MX_W + t * MX_WSTR + (i * 32 + sq * 8) * 2) = o;
                }
                a1 += __shfl_xor(a1, 1); a1 += __shfl_xor(a1, 2); a0 += __shfl_xor(a0, 1); a0 += __shfl_xor(a0, 2);
                if (sq == 0) { m1[t] = a1; m0[t] = a0; }
                if (tid < 128) bsg[tid] = F.inp(I_SGU_BS)[g * 128 + tid];
                lgs[tid] = F.inp(I_SGU_LNG)[g * SGU_GC + tid]; lbs[tid] = F.inp(I_SGU_LNB)[g * SGU_GC + tid];
            }
            MX_STORE(0, preA);
            __syncthreads();
            if (it + 2 < 16) MX_LOAD(preA, it + 2);
            MX_ULOAD(uuB, it + 1);
            MX_TILE(it, 0, uuA);
            MX_STORE(1, preB);
            __syncthreads();
            if (it + 3 < 16) MX_LOAD(preB, it + 3);
            if (it + 2 < 16) MX_ULOAD(uuA, it + 2);
            MX_TILE(it + 1, 1, uuB);
        }
#undef MX_LOAD
#undef MX_STORE
#undef MX_ULOAD
#undef MX_TILE
    }
}
constexpr int RW_STR = 2064;
constexpr int RW_LG = 48 * RW_STR;
constexpr int RW_HIST = RW_LG + 8 * 16 * 48 * 4;
template <int MODE> __device__ __forceinline__ void f_rowgroup(Frame& F, int Lyr) {
    constexpr int NCT = MODE == 0 ? 1 : 3;
    LAS unsigned char* L = F.lds;
    const int tid = FTID, lane = FLANE, w = FWAVE, rw = lane & 15, q = lane >> 4;
    const float* xsrc = F.inp(I_X);
    bf16* xb = WSP(bf16, WS_XN); float* rsout = WSP(float, WS_RS);
    __syncthreads();
    for (int k = tid; k < D; k += NTHREADS) {
        if (MODE == 0) {
            const float gn = F.inp(I_GLA_NORM)[k]; const float* wr_ = F.inp(I_GLA_WIN) + (size_t)k * GLA_IN + NQKVR;
#pragma unroll
            for (int c4 = 0; c4 < 4; ++c4) { const f32x4 x = *(const f32x4*)(wr_ + 4 * c4);
#pragma unroll
                for (int j = 0; j < 4; ++j) *(LAS unsigned short*)(L + (4 * c4 + j) * RW_STR + k * 2) = (unsigned short)f2bf(x[j] * gn); }
        } else {
            const float gn = F.inp(I_MOE_NORM)[Lyr * D + k];
            const f32x4 xg = *(const f32x4*)(F.inp(I_MOE_WG) + ((size_t)Lyr * D + k) * 4);
#pragma unroll
            for (int j = 0; j < 4; ++j) *(LAS unsigned short*)(L + j * RW_STR + k * 2) = (unsigned short)f2bf(xg[j] * gn);
#pragma unroll
            for (int g = 0; g < 4; ++g) { const float* ws_ = F.inp(I_MOE_WSUB) + (((size_t)Lyr * 4 + g) * D + k) * EPG; const f32x4 a = *(const f32x4*)ws_, b = *(const f32x4*)(ws_ + 4);
#pragma unroll
                for (int j = 0; j < 4; ++j) { *(LAS unsigned short*)(L + (4 + 8 * g + j) * RW_STR + k * 2) = (unsigned short)f2bf(a[j] * gn); *(LAS unsigned short*)(L + (8 + 8 * g + j) * RW_STR + k * 2) = (unsigned short)f2bf(b[j] * gn); } }
#pragma unroll
            for (int c = 36; c < 48; ++c) *(LAS unsigned short*)(L + c * RW_STR + k * 2) = 0;
        }
    }
    LAS int* hist = (LAS int*)(L + RW_HIST); LAS int* hbase = hist + 32;
    if (MODE == 1 && tid < 32) hist[tid] = 0;
    __syncthreads();
    const int ngroups = T / 16, niter = (ngroups + F.G * NWAVES - 1) / (F.G * NWAVES);
    for (int iter = 0; iter < niter; ++iter) {
        const int grp = (iter * F.G + F.bid) * NWAVES + w; const bool valid = grp < ngroups;
        const size_t row = (size_t)grp * 16 + rw;
        float rstd = 0.f; pg8::f32x4 acc[NCT];
        if (valid) {
#pragma unroll
            for (int c = 0; c < NCT; ++c) acc[c] = (pg8::f32x4){0.f, 0.f, 0.f, 0.f};
            float ss = 0.f;
#pragma unroll 8
            for (int s = 0; s < 32; ++s) {
                v4u pa;
                if (MODE == 0) {
                    const float* xr = xsrc + row * D + 8 * q + 32 * s;
                    const f32x4 x0 = *(const f32x4*)xr, x1 = *(const f32x4*)(xr + 4);
                    ss += (x0[0] * x0[0] + x0[1] * x0[1]) + (x0[2] * x0[2] + x0[3] * x0[3]) + (x1[0] * x1[0] + x1[1] * x1[1]) + (x1[2] * x1[2] + x1[3] * x1[3]);
                    pa.x = pk2(x0[0], x0[1]); pa.y = pk2(x0[2], x0[3]); pa.z = pk2(x1[0], x1[1]); pa.w = pk2(x1[2], x1[3]);
                    *(v4u*)(xb + row * D + 8 * q + 32 * s) = pa;
                } else {
                    pa = *(const v4u*)(xb + row * D + 8 * q + 32 * s);
                    const float a0 = bflo(pa.x), a1 = bfhi(pa.x), a2 = bflo(pa.y), a3 = bfhi(pa.y), a4 = bflo(pa.z), a5 = bfhi(pa.z), a6 = bflo(pa.w), a7 = bfhi(pa.w);
                    ss += (a0 * a0 + a1 * a1) + (a2 * a2 + a3 * a3) + (a4 * a4 + a5 * a5) + (a6 * a6 + a7 * a7);
                    int w0 = __builtin_amdgcn_cvt_pk_fp8_f32(a0, a1, 0, false); w0 = __builtin_amdgcn_cvt_pk_fp8_f32(a2, a3, w0, true);
                    int w1 = __builtin_amdgcn_cvt_pk_fp8_f32(a4, a5, 0, false); w1 = __builtin_amdgcn_cvt_pk_fp8_f32(a6, a7, w1, true);
                    v2u o8; o8.x = (unsigned)w0; o8.y = (unsigned)w1; *(v2u*)(WSP(unsigned char, WS_XB8) + row * D + 8 * q + 32 * s) = o8;
                }
                const bf16x8 A = __builtin_bit_cast(bf16x8, pa);
#pragma unroll
                for (int c = 0; c < NCT; ++c) { const bf16x8 B = *(const LAS bf16x8*)(L + (16 * c + rw) * RW_STR + (32 * s + 8 * q) * 2); acc[c] = __builtin_amdgcn_mfma_f32_16x16x32_bf16(A, B, acc[c], 0, 0, 0); }
            }
            ss += __shfl_xor(ss, 16); ss += __shfl_xor(ss, 32);
            rstd = __builtin_amdgcn_rsqf(ss * (1.f / D) + EPS);
            if (q == 0) rsout[row] = rstd;
        }
        float rs4[4];
#pragma unroll
        for (int i = 0; i < 4; ++i) rs4[i] = __shfl(rstd, 4 * q + i);
        int e1 = 0, e2 = 0, rk1 = 0, rk2 = 0; float gt1 = 0.f, gt2 = 0.f;
        if (MODE == 0) {
            if (valid) {
                float* glr = WSP(float, WS_GLR);
#pragma unroll
                for (int i = 0; i < 4; ++i) glr[((size_t)grp * 16 + 4 * q + i) * RANK + rw] = acc[0][i] * rs4[i];
            }
        } else {
            LAS float* lgw = (LAS float*)(L + RW_LG) + w * 16 * 48;
            if (valid) {
#pragma unroll
                for (int c = 0; c < NCT; ++c)
#pragma unroll
                    for (int i = 0; i < 4; ++i) lgw[(4 * q + i) * 48 + 16 * c + rw] = acc[c][i] * rs4[i];
            }
            LDS_WAIT(); asm volatile("" ::: "memory");
            if (valid && lane < 16) {
                const LAS float* lr = lgw + lane * 48; const float* bg = F.inp(I_MOE_BG) + Lyr * 4;
                float lg[4];
#pragma unroll
                for (int c = 0; c < 4; ++c) lg[c] = lr[c] + bg[c];
                int g = 0; float gm = lg[0];
#pragma unroll
                for (int c = 1; c < 4; ++c) if (lg[c] > gm) { gm = lg[c]; g = c; }
                float gs = 0.f;
#pragma unroll
                for (int c = 0; c < 4; ++c) gs += __expf(lg[c] - gm);
                const float g_w = 1.f / gs; const float* bs = F.inp(I_MOE_BSUB) + (Lyr * 4 + g) * EPG;
                int i1 = 0, i2 = 0; float m1v = -3.0e38f, m2v = -3.0e38f;
                for (int e = 0; e < EPG; ++e) { const float x = lr[4 + 8 * g + e] + bs[e];
                    if (x > m1v) { m2v = m1v; i2 = i1; m1v = x; i1 = e; } else if (x > m2v) { m2v = x; i2 = e; } }
                const float w1 = 1.f / (1.f + __expf(m2v - m1v));
                e1 = g * EPG + i1; e2 = g * EPG + i2; gt1 = g_w * w1; gt2 = g_w * (1.f - w1);
                rk1 = __hip_atomic_fetch_add(&hist[e1], 1, __ATOMIC_RELAXED, __HIP_MEMORY_SCOPE_WORKGROUP); rk2 = __hip_atomic_fetch_add(&hist[e2], 1, __ATOMIC_RELAXED, __HIP_MEMORY_SCOPE_WORKGROUP);
            }
            __syncthreads();
            if (tid < 32) { const int hcount = hist[tid]; hbase[tid] = hcount ? (int)atomicAdd(WSP(unsigned, WS_CTL) + CW_CNT + Lyr * 2048 + 64 * tid, (unsigned)hcount) : 0; hist[tid] = 0; }
            __syncthreads();
            if (valid && lane < 16) {
                const int tok = grp * 16 + lane; const int p1 = hbase[e1] + rk1, p2 = hbase[e2] + rk2;
                WSP(int, WS_LIST)[(size_t)e1 * T + p1] = tok * 2; WSP(int, WS_LIST)[(size_t)e2 * T + p2] = tok * 2 + 1;
                WSP(float, WS_GATE)[tok * 2] = gt1; WSP(float, WS_GATE)[tok * 2 + 1] = gt2;
            }
        }
    }
    __syncthreads();
}
template <bool FINAL> __device__ __forceinline__ void f_rowadd(Frame& F) {
    bf16* xb = WSP(bf16, WS_XN); const unsigned char* y = WSP(unsigned char, WS_Y); float* rsout = WSP(float, WS_RS); bf16* xo = xb;
    const int lane = FLANE, w = FWAVE;
    f32x4 gf[4];
    if (FINAL) {
#pragma unroll
        for (int j = 0; j < 2; ++j) { gf[2 * j] = *(const f32x4*)(F.inp(I_FINAL) + 8 * lane + 512 * j); gf[2 * j + 1] = *(const f32x4*)(F.inp(I_FINAL) + 8 * lane + 512 * j + 4); }
    }
    for (int r0 = (F.bid * NWAVES + w) * 2; r0 < T; r0 += F.G * NWAVES * 2) {
        v4u xa[2][2]; v2u ya[2][2], yb[2][2];
#pragma unroll
        for (int rr = 0; rr < 2; ++rr)
#pragma unroll
            for (int j = 0; j < 2; ++j) { const size_t o = (size_t)(r0 + rr) * D + 8 * lane + 512 * j;
                xa[rr][j] = *(const v4u*)(xb + o); ya[rr][j] = *(const v2u*)(y + o); yb[rr][j] = *(const v2u*)(y + (size_t)T * D + o); }
#pragma unroll
        for (int rr = 0; rr < 2; ++rr) {
            float v[16]; float ss = 0.f;
#pragma unroll
            for (int j = 0; j < 2; ++j) {
                const unsigned xw[4] = {xa[rr][j].x, xa[rr][j].y, xa[rr][j].z, xa[rr][j].w};
                const pg8::f32x2 a0 = __builtin_amdgcn_cvt_pk_f32_fp8((int)ya[rr][j].x, false), a1 = __builtin_amdgcn_cvt_pk_f32_fp8((int)ya[rr][j].x, true), a2 = __builtin_amdgcn_cvt_pk_f32_fp8((int)ya[rr][j].y, false), a3 = __builtin_amdgcn_cvt_pk_f32_fp8((int)ya[rr][j].y, true);
                const pg8::f32x2 b0 = __builtin_amdgcn_cvt_pk_f32_fp8((int)yb[rr][j].x, false), b1 = __builtin_amdgcn_cvt_pk_f32_fp8((int)yb[rr][j].x, true), b2 = __builtin_amdgcn_cvt_pk_f32_fp8((int)yb[rr][j].y, false), b3 = __builtin_amdgcn_cvt_pk_f32_fp8((int)yb[rr][j].y, true);
                const float ysum[8] = {a0.x + b0.x, a0.y + b0.y, a1.x + b1.x, a1.y + b1.y, a2.x + b2.x, a2.y + b2.y, a3.x + b3.x, a3.y + b3.y};
#pragma unroll
                for (int e = 0; e < 4; ++e) { const float lo = bflo(xw[e]) + ysum[2 * e], hi = bfhi(xw[e]) + ysum[2 * e + 1]; v[8 * j + 2 * e] = lo; v[8 * j + 2 * e + 1] = hi; ss += lo * lo + hi * hi; }
            }
            const float rstd = __builtin_amdgcn_rsqf(wave_sum(ss) * (1.f / D) + EPS);
            const size_t ro = (size_t)(r0 + rr) * D + 8 * lane;
            if (FINAL) {
#pragma unroll
                for (int j = 0; j < 2; ++j) {
                    f32x4 o0 = {v[8 * j] * rstd, v[8 * j + 1] * rstd, v[8 * j + 2] * rstd, v[8 * j + 3] * rstd}, o1 = {v[8 * j + 4] * rstd, v[8 * j + 5] * rstd, v[8 * j + 6] * rstd, v[8 * j + 7] * rstd};
                    *(f32x4*)(F.out + ro + 512 * j) = o0 * gf[2 * j]; *(f32x4*)(F.out + ro + 512 * j + 4) = o1 * gf[2 * j + 1]; }
            } else {
#pragma unroll
                for (int j = 0; j < 2; ++j) { v4u o; o.x = pk2(v[8 * j], v[8 * j + 1]); o.y = pk2(v[8 * j + 2], v[8 * j + 3]); o.z = pk2(v[8 * j + 4], v[8 * j + 5]); o.w = pk2(v[8 * j + 6], v[8 * j + 7]); *(v4u*)(xo + ro + 512 * j) = o;
                    int w0 = __builtin_amdgcn_cvt_pk_fp8_f32(v[8 * j], v[8 * j + 1], 0, false); w0 = __builtin_amdgcn_cvt_pk_fp8_f32(v[8 * j + 2], v[8 * j + 3], w0, true);
                    int w1 = __builtin_amdgcn_cvt_pk_fp8_f32(v[8 * j + 4], v[8 * j + 5], 0, false); w1 = __builtin_amdgcn_cvt_pk_fp8_f32(v[8 * j + 6], v[8 * j + 7], w1, true);
                    v2u o8; o8.x = (unsigned)w0; o8.y = (unsigned)w1; *(v2u*)(WSP(unsigned char, WS_XB8) + ro + 512 * j) = o8; }
                if (lane == 0) rsout[r0 + rr] = rstd;
            }
        }
    }
}
__device__ __forceinline__ void f_prep0(Frame& F) { f_convert_gla(F); f_rowgroup<0>(F, 0); }
__device__ __forceinline__ void f_rowpass_router(Frame& F, int L) { f_rowgroup<1>(F, L); }
__device__ __forceinline__ void f_rowpass_add(Frame& F) { f_rowadd<false>(F); }
__device__ __forceinline__ void f_final(Frame& F) { f_rowadd<true>(F); }
constexpr int LDS_BYTES = 155648;
struct Args { const float* in[23]; float* out; unsigned char* ws; int ph_lo, ph_hi; };

__global__ void __launch_bounds__(NTHREADS, 2) fwd(Args args) {
    extern __shared__ __attribute__((aligned(16))) unsigned char lds_raw[];
    Frame F;
    F.lds = (LAS unsigned char*)lds_raw;
    F.G = gridDim.x; F.bid = blockIdx.x;
    F.out = args.out; F.ws = args.ws;
    volatile LAS unsigned* bst = (volatile LAS unsigned*)(F.lds + LX_PTR + 192);
    if (FTID == 0) {
        LAS unsigned long long* pt = (LAS unsigned long long*)(F.lds + LX_PTR);
#pragma unroll
        for (int i = 0; i < 23; ++i) pt[i] = (unsigned long long)args.in[i];
    }
    if (FTID < 2) bst[FTID] = 0u;
    __syncthreads();
    cg::grid_group grid = cg::this_grid();
    const XcdBarrier xbar = xcd_barrier_post(WSP(unsigned, WS_CTL) + CW_BAR, bst);
    const int lo = args.ph_lo, hi = args.ph_hi;
    if (lo > 1000) grid.sync();
#define IN(k) (lo <= (k) && (k) < hi)
#define SEAM() xcd_barrier(xbar)

    if (IN(0)) f_prep0(F);                 SEAM();
    if (IN(1)) f_gemm_in(F);               SEAM();
    if (IN(2)) f_scan_outproj(F, xbar);    SEAM();
    if (IN(3)) f_rowpass_router(F, 0);     SEAM();
    if (IN(4)) f_moe(F, 0);                SEAM();
    if (IN(5)) f_rowpass_add(F);           SEAM();
    if (IN(6)) f_gemm_sgu_in(F);           SEAM();
    if (IN(7)) f_mix(F);                   SEAM();
    if (IN(8)) f_gemm_sgu_out(F);          SEAM();
    if (IN(9)) f_rowpass_router(F, 1);     SEAM();
    if (IN(10)) f_moe(F, 1);               SEAM();
    if (IN(11)) f_final(F);
#undef IN
#undef SEAM
}

extern "C" void kernel_launch(void* const* d_in, const int* in_sizes, int n_in, void* d_out, int out_size, void* d_ws, size_t ws_size, hipStream_t stream) {
    static int grid = 0;
    if (grid == 0) {
        if (n_in != 23 || out_size != T * D || in_sizes[0] != T * D || ws_size < WS_END) { fprintf(stderr, "kernel_launch: unexpected shapes (n_in %d out %d ws %zu): nothing launched\n", n_in, out_size, ws_size); grid = -1; return; }
        int dev = 0, cus = 0, per_cu = 0;
        if (hipGetDevice(&dev) != hipSuccess || hipDeviceGetAttribute(&cus, hipDeviceAttributeMultiprocessorCount, dev) != hipSuccess) { grid = -1; return; }
        if (hipFuncSetAttribute((const void*)fwd, hipFuncAttributeMaxDynamicSharedMemorySize, LDS_BYTES) != hipSuccess) { fprintf(stderr, "kernel_launch: cannot get %d bytes of dynamic LDS\n", LDS_BYTES); grid = -1; return; }
        if (hipOccupancyMaxActiveBlocksPerMultiprocessor(&per_cu, (const void*)fwd, NTHREADS, LDS_BYTES) != hipSuccess || per_cu < 1) { fprintf(stderr, "kernel_launch: occupancy query admits %d workgroups per CU: nothing launched\n", per_cu); grid = -1; (void)hipGetLastError(); return; }
        grid = cus;
        if (grid < 128) { fprintf(stderr, "kernel_launch: %d CUs; this kernel's phase program needs at least 128 workgroups\n", grid); grid = -1; return; }
    }
    if (grid < 0) return;
    (void)hipMemsetAsync((char*)d_ws + WS_CTL, 0, CTL_ZERO_BYTES, stream);
    Args a{};
    for (int i = 0; i < 23; ++i) a.in[i] = (const float*)d_in[i];
    a.out = (float*)d_out; a.ws = (unsigned char*)d_ws; a.ph_lo = 0; a.ph_hi = 12;
    void* kargs[] = {&a};
    const hipError_t e = hipLaunchCooperativeKernel((const void*)fwd, dim3(grid), dim3(NTHREADS), kargs, LDS_BYTES, stream);
    if (e != hipSuccess) fprintf(stderr, "cooperative launch failed: %s (grid %d)\n", hipGetErrorString(e), grid);
}
```

```cpp
#include <hip/hip_runtime.h>
#include <hip/hip_cooperative_groups.h>
#include <cstdio>
#include <cstdint>
namespace cg = cooperative_groups;


constexpr int T = 32768, D = 1024, NBATCH = 16, SEQ = 2048;
constexpr int GLA_H = 4, DK = 128, DV = 256, HK = 512, HV = 1024, RANK = 16, GLA_IN = 3088, NQKVR = 3072, CHUNK = 64, NCHUNK = 32;
constexpr int SGU_FFN = 4096, SGU_HALF = 2048, SGU_BLK = 128, SGU_GC = 512;
constexpr int NE = 32, EPG = 8, FF = 512;
constexpr float EPS = 1e-6f;
constexpr int NTHREADS = 512, NWAVES = 8;

constexpr size_t MiB = 1u << 20;
constexpr size_t WS_CTL = 0, CTL_ZERO_BYTES = 128 * 1024;
constexpr size_t WS_GLR = 1 * MiB;
constexpr size_t WS_GATE = 3 * MiB;
constexpr size_t WS_STATS = 4 * MiB;
constexpr size_t WS_LIST = 12 * MiB;
constexpr size_t WS_WIN = 16 * MiB;
constexpr size_t WS_WOUT = 22 * MiB;
constexpr size_t WS_WSIN = 24 * MiB;
constexpr size_t WS_WSOUT = 32 * MiB;
constexpr size_t WS_UG8 = 100 * MiB;
constexpr size_t WS_W13 = 36 * MiB;
constexpr size_t WS_W2 = 164 * MiB;
constexpr float MOE_WSCALE = 32.f;
constexpr size_t WS_XN = 228 * MiB;
constexpr size_t WS_AOUT = 484 * MiB;
constexpr size_t WS_RS = 3 * MiB + 256 * 1024;
constexpr size_t WS_QKVR = 292 * MiB;
constexpr size_t WS_HID = 292 * MiB;
constexpr size_t WS_XB8 = 100 * MiB;
constexpr size_t WS_Y = 364 * MiB;
constexpr size_t WS_U = 292 * MiB;
constexpr size_t WS_V = 420 * MiB;
constexpr size_t WS_END = 548 * MiB;
constexpr int CW_BAR = 1024;
constexpr int CW_HID = 16384;
constexpr int CW_CNT = 8192;

#define GAS __attribute__((address_space(1)))
#define LAS __attribute__((address_space(3)))
typedef unsigned short bf16;
typedef unsigned v4u __attribute__((ext_vector_type(4)));
typedef unsigned v2u __attribute__((ext_vector_type(2)));
typedef float f32x4 __attribute__((ext_vector_type(4)));
typedef float f32x16 __attribute__((ext_vector_type(16)));
typedef short bf16x8 __attribute__((ext_vector_type(8)));
typedef short s16x4 __attribute__((ext_vector_type(4)));
#define LDS_WAIT() asm volatile("s_waitcnt lgkmcnt(0)" ::: "memory")
#define VM_WAIT() asm volatile("s_waitcnt vmcnt(0)" ::: "memory")
typedef float f32x2_t __attribute__((ext_vector_type(2))); typedef __bf16 bf16x2_t __attribute__((ext_vector_type(2)));
__device__ __forceinline__ unsigned pk2(float lo, float hi) { f32x2_t v = {lo, hi}; bf16x2_t b = __builtin_convertvector(v, bf16x2_t); return __builtin_bit_cast(unsigned, b); }
__device__ __forceinline__ unsigned f2bf(float f) { return pk2(f, 0.f) & 0xffffu; }
__device__ __forceinline__ float bf2f(unsigned short b) { return __builtin_bit_cast(float, (unsigned)b << 16); }
__device__ __forceinline__ float bflo(unsigned w) { return __builtin_bit_cast(float, w << 16); }
__device__ __forceinline__ float bfhi(unsigned w) { return __builtin_bit_cast(float, w & 0xffff0000u); }
__device__ __forceinline__ float wave_sum(float v) {
#pragma unroll
    for (int o = 1; o < 64; o <<= 1) v += __shfl_xor(v, o);
    return v;
}
__device__ __forceinline__ float silu_f(float x) { return x * __builtin_amdgcn_rcpf(1.f + __expf(-x)); }
namespace pg8 {
#define PG8_LAS __attribute__((address_space(3)))
typedef unsigned short bf16_t;
typedef short bf16x8 __attribute__((ext_vector_type(8)));
typedef float f32x4 __attribute__((ext_vector_type(4)));
typedef unsigned u32x4 __attribute__((ext_vector_type(4)));
constexpr int BM = 256, BK = 64, HALF = 128, HTB = HALF * BK * 2  , STAGE_BYTES = 8 * HTB, NXCD = 8, WGM = 2;

__host__ __device__ __forceinline__ int lds_byte(int r, int c) { const int st = (r >> 4) * 2 + (c >> 5), rr = r & 15, cc = c & 31, ob = rr * 64 + cc * 2; return st * 1024 + (ob ^ (((ob >> 9) & 1) << 5)); }
__host__ __device__ __forceinline__ void stage_rc(int b, int& R, int& C) { const int st = b / 1024, sb = b % 1024, swz = sb ^ (((sb >> 9) & 1) << 5); R = (st >> 1) * 16 + swz / 64; C = (st & 1) * 32 + (swz % 64) / 2; }
__host__ __device__ __forceinline__ int perm32(int rho) { const int n = rho >> 4, i = rho & 15; return 8 * (i >> 2) + 4 * n + (i & 3); }

struct Unit { int pm, pn, e, slot; };

struct DenseOrder {
    static constexpr bool GATHER = false;
    int nM, nN, nwg, G, c, K; const char* Bt;
    __device__ void init(int M, int N, int K_, const bf16_t* Bt_, int G_, int c_) { nM = M / BM; nN = N / BM; nwg = nM * nN; G = G_; c = c_; K = K_; Bt = (const char*)Bt_; }
    __device__ __forceinline__ bool next(int i, Unit& u) const {
        const long L = (long)i * G + c; if (L >= nwg) return false;
        int wgid = (int)L; { const int q = nwg / NXCD, r = nwg % NXCD, xcd = wgid % NXCD, off = wgid / NXCD; wgid = (xcd < r ? xcd * (q + 1) : r * (q + 1) + (xcd - r) * q) + off; }
        const int nig = WGM * nN, gid = wgid / nig, fm = gid * WGM, gsz = (nM - fm) < WGM ? (nM - fm) : WGM;
        u.pm = fm + ((wgid % nig) % gsz); u.pn = (wgid % nig) / gsz; u.e = 0; u.slot = 0; return true;
    }
    __device__ __forceinline__ const char* bptr(const Unit& u) const { return Bt + (size_t)u.pn * BM * K * 2; }
    __device__ __forceinline__ size_t abase(const Unit& u) const { return (size_t)u.pm * BM * K * 2; }
    __device__ __forceinline__ int a_rowstride(int dflt) const { return dflt; }
    __device__ __forceinline__ size_t a_hstep(size_t dflt) const { return dflt; }
    __device__ __forceinline__ size_t a_koff(int kt) const { return (size_t)kt * 128; }
    __device__ __forceinline__ unsigned aoff(const Unit& u, int h, int R, int C) const { return (unsigned)(((u.pm * BM + h * HALF + R) * K + C) * 2); }
    __device__ __forceinline__ void a_ready(const Unit&) const {}
    __device__ __forceinline__ void done(const Unit&) const {}
};

__device__ __forceinline__ unsigned cvt_pk_bf16(float lo, float hi) { unsigned r; asm volatile("v_cvt_pk_bf16_f32 %0, %1, %2" : "=v"(r) : "v"(lo), "v"(hi)); return r; }
typedef float f32x2 __attribute__((ext_vector_type(2)));
__device__ __forceinline__ f32x2 gelu_pk(f32x2 v) {
    const f32x2 av = __builtin_elementwise_abs(v), d = av * 0.2316418882f + 1.0f;
    f32x2 t; t.x = __builtin_amdgcn_rcpf(d.x); t.y = __builtin_amdgcn_rcpf(d.y);
    f32x2 q = t * 0.5307027145f + (-0.7265760135f); q = q * t + 0.7107068705f; q = q * t + (-0.142248368f); q = q * t + 0.127414796f; q = q * t;
    const f32x2 s = (v * v) * (-0.72134752044f);
    f32x2 e; e.x = __builtin_amdgcn_exp2f(s.x); e.y = __builtin_amdgcn_exp2f(s.y);
    const f32x2 m = v * (q * e), r = v - m;
    f32x2 o; o.x = v.x < 0.f ? m.x : r.x; o.y = v.y < 0.f ? m.y : r.y; return o;
}

typedef int v8i __attribute__((ext_vector_type(8)));
typedef int v4i __attribute__((ext_vector_type(4)));
template <int ES, class Epi, class Sched>
__device__ __forceinline__ void gemm_phase_es(PG8_LAS unsigned char* lds, const void* Abase, const int K, const Sched& S, const Epi& E) {
    const int tid = threadIdx.x, wid = __builtin_amdgcn_readfirstlane(tid >> 6), lane = tid & 63, wr = wid >> 2, wc = wid & 3, fr = lane & 15, fq = lane >> 4;
    const int nt = K * ES / 128;
    int sR[2], sC[2]; unsigned voffA[2], voffB[2];
#pragma unroll
    for (int i = 0; i < 2; ++i) { stage_rc(tid * 16 + i * 8192, sR[i], sC[i]); const int Rb = Epi::PERM ? ((sR[i] & ~31) + perm32(sR[i] & 31)) : sR[i];
        voffA[i] = (unsigned)(sR[i] * S.a_rowstride(K * ES) + sC[i] * 2); voffB[i] = (unsigned)(Rb * K * ES + sC[i] * 2); }
    const size_t kstep = (size_t)(BK * 2);
    const size_t hstep = (size_t)HALF * K * ES;
    const size_t hstepA = S.a_hstep(hstep);
    const unsigned ldsw = (unsigned)wid * 1024u;
    const int aoff = lds_byte(wr * 64 + fr, fq * (ES == 2 ? 8 : 16)), boff = lds_byte(wc * 32 + fr, fq * (ES == 2 ? 8 : 16));
    const char* const Ab = (const char*)Abase;
#define PG8_SA(b, h) (((b) * 2 + (h)) * HTB)
#define PG8_SB(b, h) ((4 + (b) * 2 + (h)) * HTB)
#define PG8_STAGE(bufoff, gbase, voff) do { _Pragma("unroll") for (int _i = 0; _i < 2; ++_i) \
        __builtin_amdgcn_global_load_lds((const unsigned*)((const char*)(gbase) + (voff)[_i]), (PG8_LAS unsigned*)(lds + (bufoff) + ldsw + _i * 8192), 16, 0, 0); } while (0)
#define PG8_STAGE_A(bufoff, nx, h, kt) do { if constexpr (Sched::GATHER) { PG8_STAGE(bufoff, Ab + (size_t)(kt) * kstep, gc[h]); } \
        else PG8_STAGE(bufoff, ((nx) ? xA : cA) + (size_t)(h) * hstepA + S.a_koff(kt), voffA); } while (0)
#define PG8_LDA(dst, b, h) do { if constexpr (ES == 2) { _Pragma("unroll") for (int m = 0; m < 4; ++m) _Pragma("unroll") for (int k = 0; k < 2; ++k) dst[m][k] = *(const PG8_LAS bf16x8*)(lds + PG8_SA(b, h) + aoff + m * 2048 + k * 1024); } \
        else { _Pragma("unroll") for (int m = 0; m < 4; ++m) { const v4i lo_ = *(const PG8_LAS v4i*)(lds + PG8_SA(b, h) + aoff + m * 2048), hi_ = *(const PG8_LAS v4i*)(lds + PG8_SA(b, h) + aoff + m * 2048 + 16); dst##8[m] = __builtin_shufflevector(lo_, hi_, 0, 1, 2, 3, 4, 5, 6, 7); } } } while (0)
#define PG8_LDB(dst, b, h) do { if constexpr (ES == 2) { _Pragma("unroll") for (int n = 0; n < 2; ++n) _Pragma("unroll") for (int k = 0; k < 2; ++k) dst[n][k] = *(const PG8_LAS bf16x8*)(lds + PG8_SB(b, h) + boff + n * 2048 + k * 1024); } \
        else { _Pragma("unroll") for (int n = 0; n < 2; ++n) { const v4i lo_ = *(const PG8_LAS v4i*)(lds + PG8_SB(b, h) + boff + n * 2048), hi_ = *(const PG8_LAS v4i*)(lds + PG8_SB(b, h) + boff + n * 2048 + 16); dst##8[n] = __builtin_shufflevector(lo_, hi_, 0, 1, 2, 3, 4, 5, 6, 7); } } } while (0)
#define PG8_MMA(ai, bj, At, Bt) do { __builtin_amdgcn_s_setprio(1); if constexpr (ES == 2) { _Pragma("unroll") for (int m = 0; m < 4; ++m) _Pragma("unroll") for (int n = 0; n < 2; ++n) _Pragma("unroll") for (int k = 0; k < 2; ++k) \
        acc[ai][bj][m][n] = __builtin_amdgcn_mfma_f32_16x16x32_bf16(Bt[n][k], At[m][k], acc[ai][bj][m][n], 0, 0, 0); } \
        else { _Pragma("unroll") for (int m = 0; m < 4; ++m) _Pragma("unroll") for (int n = 0; n < 2; ++n) \
        asm volatile("s_nop 1\n\tv_mfma_f32_16x16x128_f8f6f4 %0, %1, %2, %0" : "+v"(acc[ai][bj][m][n]) : "v"(Bt##8[n]), "v"(At##8[m])); }   \
        __builtin_amdgcn_s_setprio(0); } while (0)
#define PG8_WAIT_V(n) asm volatile("s_waitcnt vmcnt(" #n ")" ::: "memory")
#define PG8_WAIT_L(n) asm volatile("s_waitcnt lgkmcnt(" #n ")" ::: "memory")
#define PG8_BAR __builtin_amdgcn_s_barrier()
#define PG8_SCHED __builtin_amdgcn_sched_barrier(0)
    Unit cur, nxt, prv; int ui = 0; bool have_prv = false;
    if (!S.next(0, cur)) return;
    f32x4 acc[2][2][4][2];
#pragma unroll
    for (int a = 0; a < 2; ++a)
#pragma unroll
        for (int b = 0; b < 2; ++b)
#pragma unroll
            for (int m = 0; m < 4; ++m)
#pragma unroll
                for (int n = 0; n < 2; ++n) acc[a][b][m][n] = (f32x4){0.f, 0.f, 0.f, 0.f};
    bf16x8 At[4][2], B0[2][2], B1[2][2]; v8i At8[4], B08[2], B18[2];
    unsigned gc[2][2];
    const char* cA = Ab; const char* xA = Ab;
    if constexpr (Sched::GATHER) {
#pragma unroll
        for (int h = 0; h < 2; ++h)
#pragma unroll
            for (int i = 0; i < 2; ++i) gc[h][i] = S.aoff(cur, h, sR[i], sC[i]);
    } else { cA = Ab + S.abase(cur); xA = cA; }
    const char* cB = S.bptr(cur);
    S.a_ready(cur);
    if constexpr (Epi::RS_DMA) { if (wid == 0) __builtin_amdgcn_global_load_lds((const unsigned*)((const char*)E.rs + (size_t)cur.pm * 1024 + lane * 16), (PG8_LAS unsigned*)(lds + STAGE_BYTES + 512), 16, 0, 0); }
    PG8_STAGE(PG8_SB(0, 0), cB, voffB); PG8_STAGE(PG8_SB(0, 1), cB + hstep, voffB); PG8_STAGE_A(PG8_SA(0, 0), false, 0, 0); PG8_STAGE_A(PG8_SA(0, 1), false, 1, 0);
    if (wr == 1) PG8_BAR;
    PG8_WAIT_V(2); PG8_BAR;
    PG8_STAGE(PG8_SB(1, 0), cB + kstep, voffB); PG8_STAGE_A(PG8_SA(1, 0), false, 0, 1); PG8_STAGE(PG8_SB(1, 1), cB + hstep + kstep, voffB);
    PG8_WAIT_V(6); PG8_BAR;
    for (;;) {
        const bool has_next = S.next(ui + 1, nxt);
        const char* nB = has_next ? S.bptr(nxt) : cB;
        if constexpr (Epi::RS_DMA) { if (has_next && wid == 0) __builtin_amdgcn_global_load_lds((const unsigned*)((const char*)E.rs + (size_t)nxt.pm * 1024 + lane * 16), (PG8_LAS unsigned*)(lds + STAGE_BYTES + 512 + ((ui + 1) % 3) * 1024), 16, 0, 0); }
        for (int t = 0; t < nt; t += 2) {
            const bool last = (t == nt - 2);
            const int kt2 = last ? 0 : t + 2;
            const char* b2 = last ? nB : cB + (size_t)(t + 2) * kstep; const char* b3 = b2 + kstep;
            if (last && has_next) {
                if constexpr (!Sched::GATHER) xA = Ab + S.abase(nxt);
                S.a_ready(nxt);
            }
            PG8_LDB(B0, 0, 0); PG8_LDB(B1, 0, 1); PG8_SCHED; PG8_LDA(At, 0, 0); PG8_STAGE_A(PG8_SA(1, 1), false, 1, t + 1);
            if constexpr (Sched::GATHER) { if (last && has_next) {
#pragma unroll
                for (int h = 0; h < 2; ++h)
#pragma unroll
                    for (int i = 0; i < 2; ++i) gc[h][i] = S.aoff(nxt, h, sR[i], sC[i]); } }
            PG8_WAIT_V(8); PG8_WAIT_L(0); PG8_BAR; PG8_MMA(0, 0, At, B0); PG8_MMA(0, 1, At, B1); PG8_BAR; PG8_SCHED;
            PG8_LDA(At, 0, 1); PG8_STAGE(PG8_SB(0, 0), b2, voffB); PG8_STAGE(PG8_SB(0, 1), b2 + hstep, voffB); PG8_STAGE_A(PG8_SA(0, 0), last, 0, kt2);
            PG8_WAIT_V(8); PG8_WAIT_L(0); PG8_BAR; PG8_MMA(1, 0, At, B0); PG8_MMA(1, 1, At, B1); PG8_BAR; PG8_SCHED;
            PG8_LDB(B0, 1, 0); PG8_LDB(B1, 1, 1); PG8_SCHED; PG8_LDA(At, 1, 0); PG8_STAGE_A(PG8_SA(0, 1), last, 1, kt2);
            PG8_WAIT_V(8); PG8_WAIT_L(0);
            if (have_prv) { S.done(prv); have_prv = false; }
            PG8_BAR; PG8_MMA(0, 0, At, B0); PG8_MMA(0, 1, At, B1); PG8_BAR; PG8_SCHED;
            PG8_LDA(At, 1, 1); PG8_STAGE(PG8_SB(1, 0), b3, voffB); PG8_STAGE(PG8_SB(1, 1), b3 + hstep, voffB); PG8_STAGE_A(PG8_SA(1, 0), last, 0, kt2 + 1);
            PG8_WAIT_V(8); PG8_WAIT_L(0); PG8_BAR; PG8_MMA(1, 0, At, B0); PG8_MMA(1, 1, At, B1); PG8_BAR; PG8_SCHED;
        }
        if (wr == 0) PG8_BAR;
        if constexpr (ES == 1) asm volatile("s_nop 15\n\ts_nop 15" ::: "memory");
        E(acc, cur, wr, wc, fr, fq, (const PG8_LAS float*)(lds + STAGE_BYTES + 512 + (ui % 3) * 1024)); prv = cur; have_prv = true;
        if (!has_next) break;
#pragma unroll
        for (int a = 0; a < 2; ++a)
#pragma unroll
            for (int b = 0; b < 2; ++b)
#pragma unroll
                for (int m = 0; m < 4; ++m)
#pragma unroll
                    for (int n = 0; n < 2; ++n) acc[a][b][m][n] = (f32x4){0.f, 0.f, 0.f, 0.f};
        cur = nxt; cB = nB; ++ui;
        if constexpr (!Sched::GATHER) cA = xA;
        if (wr == 1) PG8_BAR;
    }
    PG8_WAIT_V(0);
    if (have_prv) S.done(prv);
    PG8_BAR;
#undef PG8_STAGE_A
#undef PG8_SA
#undef PG8_SB
#undef PG8_STAGE
#undef PG8_LDA
#undef PG8_LDB
#undef PG8_MMA
#undef PG8_WAIT_V
#undef PG8_WAIT_L
#undef PG8_BAR
#undef PG8_SCHED
}
template <class Epi, class Sched>
__device__ __forceinline__ void gemm_phase(PG8_LAS unsigned char* lds, const bf16_t* Abase, const int K, const Sched& S, const Epi& E) { gemm_phase_es<2>(lds, Abase, K, S, E); }
}
constexpr int LX_PTR = 155648 - 256;
#define FTID ((int)threadIdx.x)
#define FLANE ((int)threadIdx.x & 63)
#define FWAVE ((int)__builtin_amdgcn_readfirstlane((int)threadIdx.x >> 6))
struct Frame {
    LAS unsigned char* lds;
    int G, bid;
    float* out; unsigned char* ws;
    __device__ __forceinline__ const float* inp(int i) const {
        const LAS unsigned* p = (const LAS unsigned*)(lds + LX_PTR) + 2 * i;
        const unsigned lo = __builtin_amdgcn_readfirstlane(p[0]), hi = __builtin_amdgcn_readfirstlane(p[1]);
        return (const float*)(((unsigned long long)hi << 32) | lo);
    }
};
enum { I_X = 0, I_GLA_NORM, I_GLA_WIN, I_GLA_WGU, I_GLA_BG, I_GLA_HG, I_GLA_WOUT, I_SGU_NORM, I_SGU_WIN, I_SGU_LNG, I_SGU_LNB, I_SGU_WS, I_SGU_BS, I_SGU_WOUT,
       I_MOE_NORM, I_MOE_WG, I_MOE_BG, I_MOE_WSUB, I_MOE_BSUB, I_MOE_W1, I_MOE_W3, I_MOE_W2, I_FINAL };
#define WSP(type, off) ((type*)(F.ws + (off)))

#define XB_TMO      128
#define XB_XCNT(j)  (256  + 64 * (j))
#define XB_XSUB(j)  (1280 + 64 * (j))
#define XB_XGEN(j)  (2304 + 64 * (j))
#define XB_TOP      3328
#define XB_TOPGEN   3392
#define XCD_BAR_WORDS 3456
#define XB_SPIN_CAP (1u << 18)

__device__ __forceinline__ unsigned xb_ld(unsigned* p)              { return __hip_atomic_load(p, __ATOMIC_RELAXED, __HIP_MEMORY_SCOPE_AGENT); }
__device__ __forceinline__ unsigned xb_add(unsigned* p, unsigned v) { return __hip_atomic_fetch_add(p, v, __ATOMIC_RELAXED, __HIP_MEMORY_SCOPE_AGENT); }
__device__ __forceinline__ unsigned xb_xcc_id() { return (unsigned)__builtin_amdgcn_s_getreg((3 << 11) | 20) & 0xFu; }
#define XB_SPIN(cond, bar) do { unsigned _sp = 0; while (cond) { __builtin_amdgcn_s_sleep(1); \
    if ((++_sp & 255u) == 0u) { if (xb_ld(&(bar)[XB_TMO])) break; if (_sp > XB_SPIN_CAP) { atomicAdd(&(bar)[XB_TMO], 1u); break; } } } } while (0)

struct XcdBarrier {
    unsigned* bar; unsigned x;
    volatile LAS unsigned* st;
};

__device__ __forceinline__ XcdBarrier xcd_barrier_post(unsigned* bar, volatile LAS unsigned* st) {
    XcdBarrier b; b.bar = bar; b.x = xb_xcc_id(); b.st = st;
    if (threadIdx.x == 0) (void)xb_add(&bar[XB_XCNT(b.x)], 1u);
    return b;
}
__device__ __forceinline__ void xcd_barrier_complete(unsigned* bar, unsigned x, unsigned& nloc, unsigned& nx) {
    const unsigned G = gridDim.x * gridDim.y * gridDim.z;
    unsigned sum, cnt, mine, sp = 0u;
    for (;;) {
        sum = 0u; cnt = 0u; mine = 0u;
#pragma unroll
        for (unsigned j = 0; j < 16; ++j) { const unsigned c = xb_ld(&bar[XB_XCNT(j)]); sum += c; cnt += (c > 0u) ? 1u : 0u; mine = (j == x) ? c : mine; }
        if (sum == G) break;
        __builtin_amdgcn_s_sleep(1);
        if ((++sp & 255u) == 0u) { if (xb_ld(&bar[XB_TMO])) break; if (sp > XB_SPIN_CAP) { atomicAdd(&bar[XB_TMO], 1u); break; } }
    }
    nloc = mine > 0u ? mine : 1u; nx = cnt > 0u ? cnt : 1u;
}

__device__ __forceinline__ void xcd_barrier(const XcdBarrier& b) {
    asm volatile("s_waitcnt vmcnt(0)" ::: "memory");
    __syncthreads();
    if (threadIdx.x == 0) {
        unsigned* bar = b.bar;
        __builtin_amdgcn_s_waitcnt(0);
        unsigned nloc = b.st[0], nx = b.st[1];
        if (nloc == 0u) { xcd_barrier_complete(bar, b.x, nloc, nx); b.st[0] = nloc; b.st[1] = nx; }
        const unsigned old = xb_add(&bar[XB_XSUB(b.x)], 1u);
        const unsigned gen = old / nloc;
        if (old + 1u == (gen + 1u) * nloc) {
            __builtin_amdgcn_fence(__ATOMIC_RELEASE, "agent");
            asm volatile("s_waitcnt vmcnt(0)" ::: "memory");
            const unsigned og = xb_add(&bar[XB_TOP], 1u);
            const unsigned tg = og / nx;
            if (og + 1u == (tg + 1u) * nx) xb_add(&bar[XB_TOPGEN], 1u);
            else XB_SPIN(xb_ld(&bar[XB_TOPGEN]) == tg, bar);
            __builtin_amdgcn_fence(__ATOMIC_ACQUIRE, "agent");
            xb_add(&bar[XB_XGEN(b.x)], 1u);
            asm volatile("s_waitcnt vmcnt(0)" ::: "memory");
        } else {
            XB_SPIN(xb_ld(&bar[XB_XGEN(b.x)]) == gen, bar);
            __builtin_amdgcn_fence(__ATOMIC_ACQUIRE, "agent");
            asm volatile("s_waitcnt vmcnt(0)" ::: "memory");
        }
    }
    __syncthreads();
}
constexpr int RING_BYTES = 131072;
constexpr int LX_TST = RING_BYTES;
constexpr int MOE_MAXU = 6;
constexpr int LX_TAB = RING_BYTES + 512;
constexpr int LX_GT = LX_TAB + MOE_MAXU * 1024;

struct EpiStoreBf16 {
    static constexpr bool RS_DMA = true;
    static constexpr bool PERM = true;
    bf16* O; int ldc; const float* rs; int silu_from;
    __device__ __forceinline__ void operator()(const pg8::f32x4 (&acc)[2][2][4][2], const pg8::Unit& u, int wr, int wc, int fr, int fq, const LAS float* rsl) const {
        const int row0 = u.pm * 256 + wr * 64 + fr, col0 = u.pn * 256 + wc * 32 + 8 * fq;
#pragma unroll
        for (int ai = 0; ai < 2; ++ai)
#pragma unroll
            for (int m = 0; m < 4; ++m) { const int row = row0 + ai * 128 + m * 16; bf16* rowp = O + (size_t)row * ldc + col0; const float sc = rsl[ai * 128 + wr * 64 + m * 16 + fr];
#pragma unroll
                for (int bj = 0; bj < 2; ++bj) { pg8::f32x4 v0 = acc[ai][bj][m][0] * sc, v1 = acc[ai][bj][m][1] * sc;
                    if (silu_from >= 0 && u.pn >= silu_from) {
#pragma unroll
                        for (int i = 0; i < 4; ++i) { v0[i] = v0[i] * __builtin_amdgcn_rcpf(1.f + __expf(-v0[i])); v1[i] = v1[i] * __builtin_amdgcn_rcpf(1.f + __expf(-v1[i])); } }
                    v4u w; w.x = pg8::cvt_pk_bf16(v0[0], v0[1]); w.y = pg8::cvt_pk_bf16(v0[2], v0[3]); w.z = pg8::cvt_pk_bf16(v1[0], v1[1]); w.w = pg8::cvt_pk_bf16(v1[2], v1[3]);
                    *(v4u*)(rowp + bj * 128) = w; } }
    }
};
struct EpiResBf16 {
    static constexpr bool RS_DMA = false;
    static constexpr bool PERM = true;
    bf16* X; float sc;
    __device__ __forceinline__ void operator()(const pg8::f32x4 (&acc)[2][2][4][2], const pg8::Unit& u, int wr, int wc, int fr, int fq, const LAS float* rsl) const {
        const int row0 = u.pm * 256 + wr * 64 + fr, col0 = u.pn * 256 + wc * 32 + 8 * fq;
#pragma unroll
        for (int ai = 0; ai < 2; ++ai)
#pragma unroll
            for (int m = 0; m < 4; ++m) { bf16* rowp = X + (size_t)(row0 + ai * 128 + m * 16) * D + col0;
#pragma unroll
                for (int bj = 0; bj < 2; ++bj) { const v4u r = *(const v4u*)(rowp + bj * 128); const pg8::f32x4 v0 = acc[ai][bj][m][0] * sc, v1 = acc[ai][bj][m][1] * sc;
                    v4u w; w.x = pg8::cvt_pk_bf16(bflo(r.x) + v0[0], bfhi(r.x) + v0[1]); w.y = pg8::cvt_pk_bf16(bflo(r.y) + v0[2], bfhi(r.y) + v0[3]);
                    w.z = pg8::cvt_pk_bf16(bflo(r.z) + v1[0], bfhi(r.z) + v1[1]); w.w = pg8::cvt_pk_bf16(bflo(r.w) + v1[2], bfhi(r.w) + v1[3]);
                    *(v4u*)(rowp + bj * 128) = w; } }
    }
};
__device__ __forceinline__ size_t sgu_blk(int row, int col) { return ((size_t)((row >> 7) * 16 + (col >> 7)) << 15) + (size_t)((row & 127) << 8) + (size_t)((col & 127) << 1); }
struct EpiGeluSplit {
    static constexpr bool RS_DMA = true;
    static constexpr bool PERM = true;
    bf16* U; bf16* V; float* st; const float* rs;
    __device__ __forceinline__ void operator()(const pg8::f32x4 (&acc)[2][2][4][2], const pg8::Unit& u, int wr, int wc, int fr, int fq, const LAS float* rsl) const {
        const bool isv = u.pn >= 8; const int pnl = isv ? u.pn - 8 : u.pn;
        bf16* O = isv ? V : U;
        const int row0 = u.pm * 256 + wr * 64 + fr, col0 = pnl * 256 + wc * 32 + 8 * fq;
#pragma unroll
        for (int ai = 0; ai < 2; ++ai)
#pragma unroll
            for (int m = 0; m < 4; ++m) { const int row = row0 + ai * 128 + m * 16; bf16* rowp = (bf16*)((char*)O + sgu_blk(row, col0)); float s = 0.f, q = 0.f;   const float sc = rsl[ai * 128 + wr * 64 + m * 16 + fr] * (1.f / MOE_WSCALE);
#pragma unroll
                for (int bj = 0; bj < 2; ++bj) { const pg8::f32x4 v0 = acc[ai][bj][m][0] * sc, v1 = acc[ai][bj][m][1] * sc;
                    const pg8::f32x2 a = pg8::gelu_pk((pg8::f32x2){v0[0], v0[1]}), b = pg8::gelu_pk((pg8::f32x2){v0[2], v0[3]}), c = pg8::gelu_pk((pg8::f32x2){v1[0], v1[1]}), d = pg8::gelu_pk((pg8::f32x2){v1[2], v1[3]});
                    s += (a.x + a.y) + (b.x + b.y) + (c.x + c.y) + (d.x + d.y);
                    q += (a.x * a.x + a.y * a.y) + (b.x * b.x + b.y * b.y) + (c.x * c.x + c.y * c.y) + (d.x * d.x + d.y * d.y);
                    v4u w; w.x = pg8::cvt_pk_bf16(a.x, a.y); w.y = pg8::cvt_pk_bf16(b.x, b.y); w.z = pg8::cvt_pk_bf16(c.x, c.y); w.w = pg8::cvt_pk_bf16(d.x, d.y);
                    *(v4u*)((char*)rowp + bj * 32768) = w; }
                if (isv) { s += __shfl_xor(s, 16); s += __shfl_xor(s, 32); q += __shfl_xor(q, 16); q += __shfl_xor(q, 32);
                    if (fq == 0) { pg8::f32x2 o = {s, q}; *(pg8::f32x2*)(st + ((size_t)(pnl * 4 + wc) * T + row) * 2) = o; } } }
    }
};

__device__ __forceinline__ void f_gemm_in(Frame& F) {
    pg8::DenseOrder S; S.init(T, NQKVR, D, WSP(bf16, WS_WIN), F.G, F.bid);
    EpiStoreBf16 E{WSP(bf16, WS_QKVR), NQKVR, WSP(float, WS_RS), 8};
    pg8::gemm_phase(F.lds, WSP(bf16, WS_XN), D, S, E);
}
struct DenseOrder8 : pg8::DenseOrder {
    __device__ __forceinline__ const char* bptr(const pg8::Unit& u) const { return Bt + (size_t)u.pn * 256 * K; }
    __device__ __forceinline__ size_t abase(const pg8::Unit& u) const { return (size_t)u.pm * 256 * K; }
};
struct BlockedAOrder : pg8::DenseOrder {
    __device__ __forceinline__ const char* bptr(const pg8::Unit& u) const { return Bt + (size_t)u.pn * 256 * K; }
    __device__ __forceinline__ size_t abase(const pg8::Unit& u) const { return (size_t)u.pm * 2 * 16 * 16384; }
    __device__ __forceinline__ int a_rowstride(int) const { return 128; }
    __device__ __forceinline__ size_t a_hstep(size_t) const { return (size_t)16 * 16384; }
    __device__ __forceinline__ size_t a_koff(int kt) const { return (size_t)kt * 16384; }
};
struct RowSetOrder {
    static constexpr bool GATHER = false;
    int nb, c, j0, nunits, K; const char* Bt;
    __device__ __forceinline__ bool next(int i, pg8::Unit& u) const {
        if (c < 0) return false;
        const int q = i * nb + c; if (q >= nunits) return false;
        u.pm = ((q & 63) >> 2) * 8 + j0 + (q >> 6); u.pn = q & 3; u.e = 0; u.slot = 0; return true;
    }
    __device__ __forceinline__ const char* bptr(const pg8::Unit& u) const { return Bt + (size_t)u.pn * 256 * K * 2; }
    __device__ __forceinline__ size_t abase(const pg8::Unit& u) const { return (size_t)u.pm * 256 * K * 2; }
    __device__ __forceinline__ int a_rowstride(int dflt) const { return dflt; }
    __device__ __forceinline__ size_t a_hstep(size_t dflt) const { return dflt; }
    __device__ __forceinline__ size_t a_koff(int kt) const { return (size_t)kt * 128; }
    __device__ __forceinline__ unsigned aoff(const pg8::Unit&, int, int, int) const { return 0u; }
    __device__ __forceinline__ void a_ready(const pg8::Unit&) const {}
    __device__ __forceinline__ void done(const pg8::Unit&) const {}
};
__device__ __forceinline__ void f_gemm_out_rows(Frame& F, int j0, int j1, int boff) {
    RowSetOrder S; S.nb = F.G - boff; S.c = F.bid - boff; S.j0 = j0; S.nunits = (j1 - j0) * 64; S.K = HV; S.Bt = (const char*)WSP(bf16, WS_WOUT);
    EpiResBf16 E{WSP(bf16, WS_XN), 1.f};
    pg8::gemm_phase(F.lds, WSP(bf16, WS_AOUT), HV, S, E);
}
__device__ __forceinline__ void f_gemm_sgu_in(Frame& F) {
    DenseOrder8 S; S.init(T, SGU_FFN, D, WSP(bf16, WS_WSIN), F.G, F.bid);
    EpiGeluSplit E{WSP(bf16, WS_U), WSP(bf16, WS_V), WSP(float, WS_STATS), WSP(float, WS_RS)};
    pg8::gemm_phase_es<1>(F.lds, WSP(unsigned char, WS_XB8), D, S, E);
}
__device__ __forceinline__ void f_gemm_sgu_out(Frame& F) {
    BlockedAOrder S; S.init(T, D, SGU_HALF, WSP(bf16, WS_WSOUT), F.G, F.bid);
    EpiResBf16 E{WSP(bf16, WS_XN), 1.f / MOE_WSCALE};
    pg8::gemm_phase_es<1>(F.lds, WSP(unsigned char, WS_UG8), SGU_HALF, S, E);
}

template <bool GATHER_> struct MoeOrder {
    static constexpr bool GATHER = GATHER_;
    int G, c, nunits, ibase, K, rowb, mode;
    const char* W; size_t estride;
    LAS const int* tst; LAS const int* tab; unsigned* hcnt; unsigned rdy;
    int n5, rb;
    __device__ __forceinline__ bool next(int i, pg8::Unit& u) const {
        if (i >= MOE_MAXU) return false;
        const int ii = ibase + i; int Lu;
        if (GATHER || n5 <= 0 || ii < rb) Lu = ii * G + c;
        else { if (c < n5) return false; Lu = rb * G + (ii - rb) * (G - n5) + (c - n5); }
        if (Lu >= nunits) return false;
        const int rt = Lu >> 2; int e = 0;
        while (e < NE - 1 && tst[e + 1] <= rt) ++e;
        u.pm = rt; u.pn = Lu & 3; u.e = e; u.slot = i; return true;
    }
    __device__ __forceinline__ const char* bptr(const pg8::Unit& u) const { return W + (size_t)u.e * estride + (size_t)u.pn * 256 * rowb; }
    __device__ __forceinline__ size_t abase(const pg8::Unit& u) const { return (size_t)u.pm * 256 * rowb; }
    __device__ __forceinline__ int a_rowstride(int dflt) const { return dflt; }
    __device__ __forceinline__ size_t a_hstep(size_t dflt) const { return dflt; }
    __device__ __forceinline__ size_t a_koff(int kt) const { return (size_t)kt * 128; }
    __device__ __forceinline__ unsigned aoff(const pg8::Unit& u, int h, int R, int C) const {
        if (mode == 0) { int ent = tab[u.slot * 256 + h * 128 + R]; ent = ent < 0 ? 0 : ent; return (unsigned)((ent >> 1) * rowb + C * 2); }
        return (unsigned)((u.pm * 256 + h * 128 + R) * rowb + C * 2);
    }
    __device__ __forceinline__ void a_ready(const pg8::Unit& u) const {
        if (GATHER || ((rdy >> u.slot) & 1u)) return;
        if (threadIdx.x < 64) {
            unsigned spins = 0;
            while ((unsigned)__builtin_amdgcn_readfirstlane(__hip_atomic_load(hcnt + 16 * u.pm, __ATOMIC_RELAXED, __HIP_MEMORY_SCOPE_AGENT)) < 32u) { __builtin_amdgcn_s_sleep(2); if (++spins > (1u << 20)) break; }
            __builtin_amdgcn_fence(__ATOMIC_ACQUIRE, "agent");
            asm volatile("s_waitcnt vmcnt(0)" ::: "memory");
        }
        asm volatile("" ::: "memory"); __builtin_amdgcn_s_barrier(); asm volatile("" ::: "memory");
    }
    __device__ __forceinline__ void done(const pg8::Unit& u) const {
        if (!GATHER) return;
        if ((threadIdx.x & 63) == 0) __hip_atomic_fetch_add(hcnt + 16 * u.pm, 1u, __ATOMIC_RELAXED, __HIP_MEMORY_SCOPE_AGENT);
    }
};
struct EpiSwiglu {
    static constexpr bool RS_DMA = false;
    static constexpr bool PERM = true;
    unsigned char* H; LAS const float* gt;
    __device__ __forceinline__ void operator()(const pg8::f32x4 (&acc)[2][2][4][2], const pg8::Unit& u, int wr, int wc, int fr, int fq, const LAS float* rsl) const {
        const __amdgpu_buffer_rsrc_t hrs = __builtin_amdgcn_make_buffer_rsrc((void*)H, (short)0, 73728 * FF, 0x00020000);
        const int row0 = u.pm * 256 + wr * 64 + fr, col0 = u.pn * 128 + wc * 32 + 8 * fq;
#pragma unroll
        for (int ai = 0; ai < 2; ++ai)
#pragma unroll
            for (int m = 0; m < 4; ++m) { float h[8]; const float sc = gt[u.slot * 256 + ai * 128 + wr * 64 + m * 16 + fr] * (1.f / MOE_WSCALE);
#pragma unroll
                for (int n = 0; n < 2; ++n)
#pragma unroll
                    for (int i = 0; i < 4; ++i) { const float a = acc[ai][0][m][n][i] * sc, b = acc[ai][1][m][n][i] * sc; h[n * 4 + i] = a * __builtin_amdgcn_rcpf(1.f + __expf(-a)) * b; }
                int w0 = __builtin_amdgcn_cvt_pk_fp8_f32(h[0], h[1], 0, false); w0 = __builtin_amdgcn_cvt_pk_fp8_f32(h[2], h[3], w0, true);
                int w1 = __builtin_amdgcn_cvt_pk_fp8_f32(h[4], h[5], 0, false); w1 = __builtin_amdgcn_cvt_pk_fp8_f32(h[6], h[7], w1, true);
                v2u w; w.x = (unsigned)w0; w.y = (unsigned)w1;
                __builtin_amdgcn_raw_buffer_store_b64(w, hrs, (row0 + ai * 128 + m * 16) * FF + col0, 0, 16); }
    }
};
struct EpiScatterY {
    static constexpr bool RS_DMA = false;
    static constexpr bool PERM = true;
    unsigned char* Y; LAS const int* tab; LAS const float* gt;
    __device__ __forceinline__ void operator()(const pg8::f32x4 (&acc)[2][2][4][2], const pg8::Unit& u, int wr, int wc, int fr, int fq, const LAS float* rsl) const {
        const int col0 = u.pn * 256 + wc * 32 + 8 * fq;
#pragma unroll
        for (int ai = 0; ai < 2; ++ai)
#pragma unroll
            for (int m = 0; m < 4; ++m) { const int r = ai * 128 + wr * 64 + m * 16 + fr; const int ent = tab[u.slot * 256 + r]; const float g = gt[u.slot * 256 + r] * (1.f / MOE_WSCALE);
                if (ent >= 0) { unsigned char* rowp = Y + ((size_t)(ent & 1) * T + (ent >> 1)) * D + col0;
#pragma unroll
                    for (int bj = 0; bj < 2; ++bj) { const pg8::f32x4 v0 = acc[ai][bj][m][0] * g, v1 = acc[ai][bj][m][1] * g;
                        int w0 = __builtin_amdgcn_cvt_pk_fp8_f32(v0[0], v0[1], 0, false); w0 = __builtin_amdgcn_cvt_pk_fp8_f32(v0[2], v0[3], w0, true);
                        int w1 = __builtin_amdgcn_cvt_pk_fp8_f32(v1[0], v1[1], 0, false); w1 = __builtin_amdgcn_cvt_pk_fp8_f32(v1[2], v1[3], w1, true);
                        v2u w; w.x = (unsigned)w0; w.y = (unsigned)w1; *(v2u*)(rowp + bj * 128) = w; } } }
    }
};
template <int MODE> __device__ __forceinline__ void f_moe_gemm(Frame& F, int L, LAS int* tst, LAS int* cntl) {
    LAS int* tab = (LAS int*)(F.lds + LX_TAB); LAS float* gt = (LAS float*)(F.lds + LX_GT);
    MoeOrder<MODE == 0> S; S.G = F.G; S.c = F.bid; S.nunits = 4 * tst[NE]; S.K = MODE == 0 ? D : FF; S.rowb = S.K; S.mode = MODE; S.tst = tst; S.tab = tab;
    S.hcnt = WSP(unsigned, WS_CTL) + CW_HID + L * 4608;
    { const int r1 = (S.nunits + F.G - 1) / F.G, nlast = S.nunits - (r1 - 1) * F.G;
      S.n5 = (MODE == 1 && r1 >= 3 && nlast < F.G) ? nlast : 0; S.rb = r1 - 2; }
    S.W = MODE == 0 ? (const char*)(WSP(unsigned char, WS_W13) + (size_t)L * NE * 1024 * 1024) : (const char*)(WSP(unsigned char, WS_W2) + (size_t)L * NE * 1024 * 512);
    S.estride = MODE == 0 ? (size_t)1024 * 1024 : (size_t)1024 * 512;
    const int* list = WSP(int, WS_LIST); const float* gates = WSP(float, WS_GATE);
    for (int ibase = 0; ibase * (S.n5 > 0 ? F.G - S.n5 : F.G) < S.nunits; ibase += MOE_MAXU) {
        S.ibase = ibase;
        {
            static_assert(MOE_MAXU == 6, "three table slots per thread half");
            int ents[3]; float gsv[3]; const int r = FTID & 255, hsel = FTID >> 8;
#pragma unroll
            for (int k = 0; k < 3; ++k) { pg8::Unit u; ents[k] = -1;
                if (S.next(2 * k + hsel, u)) { const int idx = (u.pm - tst[u.e]) * 256 + r; if (idx < cntl[u.e]) ents[k] = list[(size_t)u.e * T + idx]; } }
#pragma unroll
            for (int k = 0; k < 3; ++k) gsv[k] = ents[k] >= 0 ? (MODE == 0 ? WSP(float, WS_RS)[ents[k] >> 1] : gates[ents[k]]) : 0.f;
#pragma unroll
            for (int k = 0; k < 3; ++k) { tab[(2 * k + hsel) * 256 + r] = ents[k]; gt[(2 * k + hsel) * 256 + r] = gsv[k]; }
        }
        S.rdy = 0u;
        if (MODE == 1) {
            LAS unsigned* rdyw = (LAS unsigned*)(F.lds + LX_TST + 448);
            if (FTID < 64) { unsigned m = 0u;
                for (int i = 0; i < MOE_MAXU; ++i) { pg8::Unit u; if (S.next(i, u) && (unsigned)__builtin_amdgcn_readfirstlane(__hip_atomic_load(S.hcnt + 16 * u.pm, __ATOMIC_RELAXED, __HIP_MEMORY_SCOPE_AGENT)) >= 32u) m |= 1u << i; }
                __builtin_amdgcn_fence(__ATOMIC_ACQUIRE, "agent"); asm volatile("s_waitcnt vmcnt(0)" ::: "memory");
                if (FTID == 0) *rdyw = m; }
            __syncthreads();
            S.rdy = *rdyw;
        }
        __syncthreads();
        if (MODE == 0) { EpiSwiglu E{WSP(unsigned char, WS_HID), gt}; pg8::gemm_phase_es<1>(F.lds, WSP(unsigned char, WS_XB8), D, S, E); }
        else { EpiScatterY E{WSP(unsigned char, WS_Y), tab, gt}; pg8::gemm_phase_es<1>(F.lds, WSP(unsigned char, WS_HID), FF, S, E); }
        __syncthreads();
    }
}
__device__ __forceinline__ void f_moe(Frame& F, int L) {
    LAS int* tst = (LAS int*)(F.lds + LX_TST); LAS int* cntl = tst + 64;
    unsigned* ctl = WSP(unsigned, WS_CTL);
    __syncthreads();
    if (FTID < NE) cntl[FTID] = (int)__hip_atomic_load(&ctl[CW_CNT + L * 2048 + 64 * FTID], __ATOMIC_RELAXED, __HIP_MEMORY_SCOPE_AGENT);
    __syncthreads();
    if (FTID == 0) { int s = 0; for (int e = 0; e < NE; ++e) { tst[e] = s; s += (cntl[e] + 255) >> 8; } tst[NE] = s; }
    __syncthreads();
    f_moe_gemm<0>(F, L, tst, cntl);
    f_moe_gemm<1>(F, L, tst, cntl);
}
__device__ __forceinline__ void transpose_item(const float* W, int ldw, const float* kscale, float cs, bf16* WT, int K, int dst_row0, LAS float* scr, int k0, int n0, int lane) {
    f32x4 x[8]; float ks[8];
    const int kr = lane >> 3, n4 = (lane & 7) * 4;
#pragma unroll
    for (int i = 0; i < 8; ++i) { x[i] = *(const f32x4*)(W + (size_t)(k0 + 8 * i + kr) * ldw + n0 + n4); ks[i] = kscale ? kscale[k0 + 8 * i + kr] * cs : cs; }
#pragma unroll
    for (int i = 0; i < 8; ++i) { LAS float* d = scr + (8 * i + kr) * 33 + n4; d[0] = x[i][0] * ks[i]; d[1] = x[i][1] * ks[i]; d[2] = x[i][2] * ks[i]; d[3] = x[i][3] * ks[i]; }
    LDS_WAIT(); asm volatile("" ::: "memory");
    const int c = lane & 7;
#pragma unroll
    for (int j = 0; j < 4; ++j) { const int n = (lane >> 3) + 8 * j; const LAS float* s = scr + (8 * c) * 33 + n;
        v4u o; o.x = pk2(s[0 * 33], s[1 * 33]); o.y = pk2(s[2 * 33], s[3 * 33]); o.z = pk2(s[4 * 33], s[5 * 33]); o.w = pk2(s[6 * 33], s[7 * 33]);
        *(v4u*)(WT + (size_t)(dst_row0 + n) * K + k0 + 8 * c) = o; }
    LDS_WAIT(); asm volatile("" ::: "memory");
}
__device__ __forceinline__ void transpose_item8(const float* W, int ldw, const float* kscale, float cs, unsigned char* WT, int K, int dst_row0, LAS float* scr, int k0, int n0, int lane) {
    f32x4 x[8]; float ks[8];
    const int kr = lane >> 3, n4 = (lane & 7) * 4;
#pragma unroll
    for (int i = 0; i < 8; ++i) { x[i] = *(const f32x4*)(W + (size_t)(k0 + 8 * i + kr) * ldw + n0 + n4); ks[i] = kscale ? kscale[k0 + 8 * i + kr] * cs : cs; }
#pragma unroll
    for (int i = 0; i < 8; ++i) { LAS float* d = scr + (8 * i + kr) * 33 + n4; d[0] = x[i][0] * ks[i]; d[1] = x[i][1] * ks[i]; d[2] = x[i][2] * ks[i]; d[3] = x[i][3] * ks[i]; }
    LDS_WAIT(); asm volatile("" ::: "memory");
    const int c = lane & 7;
#pragma unroll
    for (int j = 0; j < 4; ++j) { const int n = (lane >> 3) + 8 * j; const LAS float* s = scr + (8 * c) * 33 + n;
        int w0 = __builtin_amdgcn_cvt_pk_fp8_f32(s[0 * 33], s[1 * 33], 0, false); w0 = __builtin_amdgcn_cvt_pk_fp8_f32(s[2 * 33], s[3 * 33], w0, true);
        int w1 = __builtin_amdgcn_cvt_pk_fp8_f32(s[4 * 33], s[5 * 33], 0, false); w1 = __builtin_amdgcn_cvt_pk_fp8_f32(s[6 * 33], s[7 * 33], w1, true);
        v2u o; o.x = (unsigned)w0; o.y = (unsigned)w1; *(v2u*)(WT + (size_t)(dst_row0 + n) * K + k0 + 8 * c) = o; }
    LDS_WAIT(); asm volatile("" ::: "memory");
}
__device__ __forceinline__ void convert_job_item8(const float* W, int ldw, int K, int N, const float* kscale, float cs, unsigned char* WT, int rowmap, LAS float* scr, int item, int lane) {
    const int nblk = N / 32, kb = item / nblk, nb = item % nblk, k0 = 64 * kb, n0 = 32 * nb;
    const int dr = rowmap == 0 ? n0 : ((n0 >> 7) * 256 + (n0 & 127) + (rowmap == 2 ? 128 : 0));
    transpose_item8(W, ldw, kscale, cs, WT, K, dr, scr, k0, n0, lane);
}
__device__ __forceinline__ void convert_job_item(const float* W, int ldw, int K, int N, const float* kscale, int qcols, float qs, bf16* WT, int rowmap, LAS float* scr, int item, int lane) {
    const int nblk = N / 32, kb = item / nblk, nb = item % nblk, k0 = 64 * kb, n0 = 32 * nb;
    const int dr = rowmap == 0 ? n0 : ((n0 >> 7) * 256 + (n0 & 127) + (rowmap == 2 ? 128 : 0));
    transpose_item(W, ldw, kscale, n0 < qcols ? qs : 1.f, WT, K, dr, scr, k0, n0, lane);
}
__device__ __forceinline__ void f_convert_gla(Frame& F) {
    LAS float* scr = (LAS float*)(F.lds + FWAVE * 8448);
    const int gw = F.bid * NWAVES + FWAVE, NGW = F.G * NWAVES;
    constexpr int I0 = (D / 64) * (NQKVR / 32), I1 = (HV / 64) * (D / 32);
    for (int it = gw; it < I0 + I1; it += NGW) {
        if (it < I0) convert_job_item(F.inp(I_GLA_WIN), GLA_IN, D, NQKVR, F.inp(I_GLA_NORM), HK, 0.08838834764831845f, WSP(bf16, WS_WIN), 0, scr, it, FLANE);
        else convert_job_item(F.inp(I_GLA_WOUT), D, HV, D, F.inp(I_GLA_HG), 0, 1.f, WSP(bf16, WS_WOUT), 0, scr, it - I0, FLANE);
    }
}
__device__ __forceinline__ void f_convert_rest(Frame& F, int cw, int NCW, int pct0 = 0, int pct1 = 1000) {
    LAS float* scr = (LAS float*)(F.lds + FWAVE * 8448);
    constexpr int I0 = (D / 64) * (SGU_FFN / 32), I1 = (SGU_HALF / 64) * (D / 32), IE1 = (D / 64) * (FF / 32), IE2 = (FF / 64) * (D / 32);
    constexpr int IM = 2 * NE * IE1;
    static_assert(IE1 == IE2, "w1 / w2 item counts");
    constexpr int NIT = I0 + I1 + 3 * IM; const int it_lo = (int)((long)NIT * pct0 / 1000), it_hi = (int)((long)NIT * pct1 / 1000);
    for (int it = it_lo + cw; it < it_hi; it += NCW) {
        int r = it;
        if (r < I0) { convert_job_item8(F.inp(I_SGU_WIN), SGU_FFN, D, SGU_FFN, F.inp(I_SGU_NORM), MOE_WSCALE, WSP(unsigned char, WS_WSIN), 0, scr, r, FLANE); continue; } r -= I0;
        if (r < I1) { convert_job_item8(F.inp(I_SGU_WOUT), D, SGU_HALF, D, nullptr, MOE_WSCALE, WSP(unsigned char, WS_WSOUT), 0, scr, r, FLANE); continue; } r -= I1;
        const int which = r / IM; r -= which * IM; const int le = r / IE1, li = r % IE1, L = le / NE;
        if (which == 0) convert_job_item8(F.inp(I_MOE_W1) + (size_t)le * D * FF, FF, D, FF, F.inp(I_MOE_NORM) + L * D, MOE_WSCALE, WSP(unsigned char, WS_W13) + (size_t)le * 1024 * 1024, 1, scr, li, FLANE);
        else if (which == 1) convert_job_item8(F.inp(I_MOE_W3) + (size_t)le * D * FF, FF, D, FF, F.inp(I_MOE_NORM) + L * D, MOE_WSCALE, WSP(unsigned char, WS_W13) + (size_t)le * 1024 * 1024, 2, scr, li, FLANE);
        else convert_job_item8(F.inp(I_MOE_W2) + (size_t)le * FF * D, D, FF, D, nullptr, MOE_WSCALE, WSP(unsigned char, WS_W2) + (size_t)le * 1024 * 512, 0, scr, li, FLANE);
    }
}

constexpr int SC_K = 0, SC_KSTR = 320;
constexpr int SC_V = 20480, SC_VSTR = 576;
constexpr int SC_Q = 57344, SC_QSTR = 272;
constexpr int SC_O = 74752, SC_OSTR = 528;
constexpr int SC_GL = 108544, SC_PART = 112640, SC_DEC = 114688, SC_WG = 115200;
__device__ __forceinline__ s16x4 tr_read16(LAS const unsigned char* p) {
    typedef short v4i16_t __attribute__((ext_vector_type(4)));
    return __builtin_bit_cast(s16x4, __builtin_amdgcn_ds_read_tr16_b64_v4i16((LAS v4i16_t*)p));
}
__device__ __forceinline__ void f_scan_item(Frame& F, int item, const XcdBarrier* xb_ = nullptr, int cbar = -1) {
    const int b = item / GLA_H, h = item % GLA_H;
    const bf16* qkvr = WSP(bf16, WS_QKVR); const float* glr = WSP(float, WS_GLR); bf16* aout = WSP(bf16, WS_AOUT);
    LAS unsigned char* L = F.lds;
    LAS float* gl = (LAS float*)(L + SC_GL); LAS float* part = (LAS float*)(L + SC_PART); LAS float* dec = (LAS float*)(L + SC_DEC);
    const int tid = FTID, lane = FLANE, w = FWAVE;
    const int r32 = lane & 31, hh = lane >> 5, blk = (lane >> 4) & 1, q4 = (lane & 15) >> 2, p4 = lane & 3;
    const int dk = tid & 127, tg = tid >> 7;
    const int gq = lane >> 4, gcol = lane & 15, gdk = 16 * w + gcol;
    bf16x8 gBh, gBl;
    { unsigned ph[4], pl[4];
#pragma unroll
      for (int j = 0; j < 4; ++j) { const float x0 = gq < 2 ? F.inp(I_GLA_WGU)[(8 * gq + 2 * j) * HK + h * DK + gdk] : 0.f, x1 = gq < 2 ? F.inp(I_GLA_WGU)[(8 * gq + 2 * j + 1) * HK + h * DK + gdk] : 0.f;
          ph[j] = pk2(x0, x1); pl[j] = pk2(x0 - bflo(ph[j]), x1 - bfhi(ph[j])); }
      v4u vh = {ph[0], ph[1], ph[2], ph[3]}, vl = {pl[0], pl[1], pl[2], pl[3]};
      gBh = __builtin_bit_cast(bf16x8, vh); gBl = __builtin_bit_cast(bf16x8, vl); }
    const float gbias = F.inp(I_GLA_BG)[h * DK + gdk];
    __syncthreads();
    f32x16 st[4];
#pragma unroll
    for (int i = 0; i < 4; ++i)
#pragma unroll
        for (int j = 0; j < 16; ++j) st[i][j] = 0.f;
    v4u rk[2], rq[2], rv[4]; f32x4 rg;
    const size_t rowb = (size_t)b * SEQ;
    const unsigned vo_kq = (unsigned)(((tid >> 4) * NQKVR + (tid & 15) * 8) * 2), vo_v = (unsigned)(((tid >> 5) * NQKVR + (tid & 31) * 8) * 2), vo_g = (unsigned)(tid * 16);
    const unsigned lo_k = (unsigned)(SC_K + (tid >> 4) * SC_KSTR + (tid & 15) * 16), lo_q = (unsigned)(SC_Q + (tid >> 4) * SC_QSTR + (tid & 15) * 16), lo_v = (unsigned)(SC_V + (tid >> 5) * SC_VSTR + (tid & 31) * 16);
#define SC_LOAD(c) do { size_t cb_ = (rowb + (size_t)(c) * CHUNK) * NQKVR * 2; asm volatile("" : "+s"(cb_)); const char* gb_ = (const char*)qkvr + cb_ + (size_t)(h * DK * 2); \
        _Pragma("unroll") for (int i = 0; i < 2; ++i) { \
            rk[i] = *(const v4u*)(gb_ + (size_t)(HK * 2 + i * 32 * NQKVR * 2) + vo_kq); rq[i] = *(const v4u*)(gb_ + (size_t)(i * 32 * NQKVR * 2) + vo_kq); } \
        _Pragma("unroll") for (int i = 0; i < 4; ++i) rv[i] = *(const v4u*)(gb_ + (size_t)(2 * HK * 2 + h * (DV - DK) * 2 + i * 16 * NQKVR * 2) + vo_v); \
        if (tid < 256) rg = *(const f32x4*)((const char*)glr + (rowb + (size_t)(c) * CHUNK) * RANK * 4 + vo_g); } while (0)
#define SC_STORE() do { \
        _Pragma("unroll") for (int i = 0; i < 2; ++i) { *(LAS v4u*)(L + lo_k + i * 32 * SC_KSTR) = rk[i]; *(LAS v4u*)(L + lo_q + i * 32 * SC_QSTR) = rq[i]; } \
        _Pragma("unroll") for (int i = 0; i < 4; ++i) *(LAS v4u*)(L + lo_v + i * 16 * SC_VSTR) = rv[i]; \
        if (tid < 256) *(LAS f32x4*)(gl + tid * 4) = rg; } while (0)
    SC_LOAD(0);
    SC_STORE();
    for (int c = 0; c < NCHUNK; ++c) {
        if (c == cbar) xcd_barrier(*xb_);
        const size_t t0 = rowb + (size_t)c * CHUNK;
        __syncthreads();
        if (c + 1 < NCHUNK) SC_LOAD(c + 1);
        {
            pg8::f32x4 g4[4]; float tsum[4], pre[4];
#pragma unroll
            for (int t = 0; t < 4; ++t) {
                v4u ah = {0u, 0u, 0u, 0u}, al = {0u, 0u, 0u, 0u};
                if (gq < 2) { const f32x4 x0 = *(const LAS f32x4*)(gl + (16 * t + gcol) * 16 + 8 * gq), x1 = *(const LAS f32x4*)(gl + (16 * t + gcol) * 16 + 8 * gq + 4);
                    ah.x = pk2(x0[0], x0[1]); ah.y = pk2(x0[2], x0[3]); ah.z = pk2(x1[0], x1[1]); ah.w = pk2(x1[2], x1[3]);
                    al.x = pk2(x0[0] - bflo(ah.x), x0[1] - bfhi(ah.x)); al.y = pk2(x0[2] - bflo(ah.y), x0[3] - bfhi(ah.y)); al.z = pk2(x1[0] - bflo(ah.z), x1[1] - bfhi(ah.z)); al.w = pk2(x1[2] - bflo(ah.w), x1[3] - bfhi(ah.w)); }
                pg8::f32x4 a4 = {gbias, gbias, gbias, gbias};
                a4 = __builtin_amdgcn_mfma_f32_16x16x32_bf16(__builtin_bit_cast(bf16x8, ah), gBh, a4, 0, 0, 0);
                a4 = __builtin_amdgcn_mfma_f32_16x16x32_bf16(__builtin_bit_cast(bf16x8, al), gBh, a4, 0, 0, 0);
                a4 = __builtin_amdgcn_mfma_f32_16x16x32_bf16(__builtin_bit_cast(bf16x8, ah), gBl, a4, 0, 0, 0);
#pragma unroll
                for (int i = 0; i < 4; ++i) { const float a = a4[i]; a4[i] = (fminf(a, 0.f) - __logf(1.f + __expf(-fabsf(a)))) * (1.f / 16.f); }
                a4[1] += a4[0]; a4[2] += a4[1]; a4[3] += a4[2];
                g4[t] = a4;
                const float s0 = a4[3], x1 = __shfl_xor(s0, 16), x2 = __shfl_xor(s0, 32), x3 = __shfl_xor(x1, 32);
                tsum[t] = (s0 + x1) + (x2 + x3);
                pre[t] = ((gq ^ 1) < gq ? x1 : 0.f) + ((gq ^ 2) < gq ? x2 : 0.f) + ((gq ^ 3) < gq ? x3 : 0.f);
            }
            const float tot = (tsum[0] + tsum[1]) + (tsum[2] + tsum[3]);
            float basep = 0.f;
#pragma unroll
            for (int t = 0; t < 4; ++t) {
#pragma unroll
                for (int i = 0; i < 4; ++i) {
                    LAS unsigned short* kp = (LAS unsigned short*)(L + SC_K + (16 * t + 4 * gq + i) * SC_KSTR + gdk * 2);
                    *kp = (unsigned short)f2bf(bf2f(*kp) * __expf(tot - (basep + pre[t] + g4[t][i])));
                }
                basep += tsum[t];
            }
            if (gq == 0) dec[gdk] = __expf(tot);
        }
        __syncthreads();
        const int etok = tid >> 3, ecc = tid & 7;
        v4u rr[4];
        { size_t eb_ = t0 * NQKVR * 2; asm volatile("" : "+s"(eb_));
          const char* rb_ = (const char*)qkvr + eb_ + (size_t)((2 * HK + HV + h * DV) * 2); const unsigned vo_r = (unsigned)(etok * NQKVR * 2 + ecc * 16);
#pragma unroll
          for (int i = 0; i < 4; ++i) rr[i] = *(const v4u*)(rb_ + vo_r + i * 128); }
#pragma unroll
        for (int i = 0; i < 4; ++i)
#pragma unroll
            for (int g4 = 0; g4 < 4; ++g4) { const f32x4 d4 = *(const LAS f32x4*)(dec + 32 * i + 8 * g4 + 4 * hh);
#pragma unroll
                for (int j = 0; j < 4; ++j) st[i][4 * g4 + j] *= d4[j]; }
#pragma unroll
        for (int s = 0; s < 4; ++s) {
            const int trow = 16 * s + 8 * hh + q4;
            const s16x4 v0 = tr_read16(L + SC_V + trow * SC_VSTR + (32 * w + 16 * blk + 4 * p4) * 2), v1 = tr_read16(L + SC_V + (trow + 4) * SC_VSTR + (32 * w + 16 * blk + 4 * p4) * 2);
            const bf16x8 Bv = {v0[0], v0[1], v0[2], v0[3], v1[0], v1[1], v1[2], v1[3]};
#pragma unroll
            for (int i = 0; i < 4; ++i) {
                const s16x4 k0 = tr_read16(L + SC_K + trow * SC_KSTR + (32 * i + 16 * blk + 4 * p4) * 2), k1 = tr_read16(L + SC_K + (trow + 4) * SC_KSTR + (32 * i + 16 * blk + 4 * p4) * 2);
                const bf16x8 Ak = {k0[0], k0[1], k0[2], k0[3], k1[0], k1[1], k1[2], k1[3]};
                st[i] = __builtin_amdgcn_mfma_f32_32x32x16_bf16(Ak, Bv, st[i], 0, 0, 0);
            }
        }
        {
        f32x16 oacc[2];
#pragma unroll
        for (int ot = 0; ot < 2; ++ot)
#pragma unroll
            for (int j = 0; j < 16; ++j) oacc[ot][j] = 0.f;
#pragma unroll
        for (int i = 0; i < 4; ++i)
#pragma unroll
            for (int s2 = 0; s2 < 2; ++s2) {
                v4u pb; pb.x = pk2(st[i][8 * s2 + 0], st[i][8 * s2 + 1]); pb.y = pk2(st[i][8 * s2 + 2], st[i][8 * s2 + 3]); pb.z = pk2(st[i][8 * s2 + 4], st[i][8 * s2 + 5]); pb.w = pk2(st[i][8 * s2 + 6], st[i][8 * s2 + 7]);
                const bf16x8 Bs = __builtin_bit_cast(bf16x8, pb);
#pragma unroll
                for (int ot = 0; ot < 2; ++ot) {
                    LAS const unsigned char* qp = L + SC_Q + (32 * ot + r32) * SC_QSTR + (32 * i + 16 * s2 + 4 * hh) * 2;
                    const v2u a0 = *(const LAS v2u*)qp, a1 = *(const LAS v2u*)(qp + 16);
                    v4u pa; pa.x = a0.x; pa.y = a0.y; pa.z = a1.x; pa.w = a1.y;
                    oacc[ot] = __builtin_amdgcn_mfma_f32_32x32x16_bf16(__builtin_bit_cast(bf16x8, pa), Bs, oacc[ot], 0, 0, 0);
                }
            }
#pragma unroll
        for (int ot = 0; ot < 2; ++ot)
#pragma unroll
            for (int rg16 = 0; rg16 < 16; ++rg16) {
                const int tok = 32 * ot + (rg16 & 3) + 8 * (rg16 >> 2) + 4 * hh;
                *(LAS unsigned short*)(L + SC_O + tok * SC_OSTR + (32 * w + r32) * 2) = (unsigned short)f2bf(oacc[ot][rg16]);
            }
        }
        __syncthreads();
        if (c + 1 < NCHUNK) SC_STORE();
        {
        {
            const int tok = etok, cc = ecc;
            v4u ov[4]; float ss = 0.f;
#pragma unroll
            for (int i = 0; i < 4; ++i) ov[i] = *(const LAS v4u*)(L + SC_O + tok * SC_OSTR + cc * 16 + i * 128);
#pragma unroll
            for (int i = 0; i < 4; ++i) { const float a0 = bflo(ov[i].x), a1 = bfhi(ov[i].x), a2 = bflo(ov[i].y), a3 = bfhi(ov[i].y), a4 = bflo(ov[i].z), a5 = bfhi(ov[i].z), a6 = bflo(ov[i].w), a7 = bfhi(ov[i].w);
                ss += (a0 * a0 + a1 * a1) + (a2 * a2 + a3 * a3) + (a4 * a4 + a5 * a5) + (a6 * a6 + a7 * a7); }
            ss += __shfl_xor(ss, 1); ss += __shfl_xor(ss, 2); ss += __shfl_xor(ss, 4);
            const float rms = __builtin_amdgcn_rsqf(ss * (1.f / DV) + EPS);
            size_t ob_ = (t0 * D + h * DV) * 2; asm volatile("" : "+s"(ob_)); const unsigned vo_o = (unsigned)(tok * D * 2 + cc * 16);
#pragma unroll
            for (int i = 0; i < 4; ++i) {
                v4u o;
                o.x = pk2(bflo(ov[i].x) * rms * bflo(rr[i].x), bfhi(ov[i].x) * rms * bfhi(rr[i].x));
                o.y = pk2(bflo(ov[i].y) * rms * bflo(rr[i].y), bfhi(ov[i].y) * rms * bfhi(rr[i].y));
                o.z = pk2(bflo(ov[i].z) * rms * bflo(rr[i].z), bfhi(ov[i].z) * rms * bfhi(rr[i].z));
                o.w = pk2(bflo(ov[i].w) * rms * bflo(rr[i].w), bfhi(ov[i].w) * rms * bfhi(rr[i].w));
                *(v4u*)((char*)aout + ob_ + vo_o + i * 128) = o;
            }
        }
            }
    }
    __syncthreads();
#undef SC_LOAD
#undef SC_STORE
}
constexpr int SCAN_C1 = 20;
__device__ __forceinline__ void f_scan_outproj(Frame& F, const XcdBarrier& xbar) {
    constexpr int NITEM = NBATCH * GLA_H;
    if (F.bid < NITEM) f_scan_item(F, F.bid, &xbar, SCAN_C1);
    else { f_convert_rest(F, (F.bid - NITEM) * NWAVES + FWAVE, (F.G - NITEM) * NWAVES); xcd_barrier(xbar); f_gemm_out_rows(F, 0, SCAN_C1 / 4, NITEM); }
    xcd_barrier(xbar);
    f_gemm_out_rows(F, SCAN_C1 / 4, 8, 0);
}
constexpr int MX_W = 0, MX_WSTR = 272;
constexpr int MX_V0 = 34816, MX_VSTR = 320, MX_VBYTES = 40960;
constexpr int MX_MU = 116736;
constexpr int MX_LN = MX_MU + 2560;
__device__ __forceinline__ void f_mix(Frame& F) {
    LAS unsigned char* L = F.lds;
    LAS float* mu = (LAS float*)(L + MX_MU); LAS float* rs = mu + 128; LAS float* m1 = rs + 128; LAS float* m0 = m1 + 128; LAS float* bsg = m0 + 128;
    LAS float* lgs = (LAS float*)(L + MX_LN); LAS float* lbs = lgs + 512;
    bf16* u = WSP(bf16, WS_U); const bf16* v = WSP(bf16, WS_V); const float* st = WSP(float, WS_STATS); unsigned char* uout = WSP(unsigned char, WS_UG8);
    const int tid = FTID, lane = FLANE, w = FWAVE;
    const int r32 = lane & 31, hh = lane >> 5, blk = (lane >> 4) & 1, q4 = (lane & 15) >> 2, p4 = lane & 3;
    const int ct = w >> 1, th = w & 1;
    const unsigned vo_v = (unsigned)(tid * 16), lo_v = (unsigned)(MX_V0 + (tid >> 4) * MX_VSTR + (tid & 15) * 16);
    constexpr int MX_MSTR = 272;
    for (int bn = F.bid; bn < T / SGU_BLK; bn += F.G) {
        const size_t t0 = (size_t)bn * SGU_BLK;
        __syncthreads();
        {
            const int row = tid & 127, pq = tid >> 7; float s = 0.f, q = 0.f;
#pragma unroll
            for (int p = 0; p < 8; ++p) { const pg8::f32x2 a = *(const pg8::f32x2*)(st + ((size_t)(pq * 8 + p) * T + t0 + row) * 2); s += a.x; q += a.y; }
            LAS float* red = (LAS float*)(L + MX_V0);
            red[(pq * 128 + row) * 2] = s; red[(pq * 128 + row) * 2 + 1] = q;
            __syncthreads();
            if (tid < 128) { float s4 = 0.f, q4 = 0.f;
#pragma unroll
                for (int p = 0; p < 4; ++p) { s4 += red[(p * 128 + tid) * 2]; q4 += red[(p * 128 + tid) * 2 + 1]; }
                const float m = s4 * (1.f / SGU_HALF); mu[tid] = m; rs[tid] = __builtin_amdgcn_rsqf(fmaxf(q4 * (1.f / SGU_HALF) - m * m, 0.f) + EPS); }
            __syncthreads();
        }
        v4u preA[4], preB[4]; v4u uuA[4], uuB[4];
#define MX_LOAD(pre_, it_) do { size_t vb_ = ((size_t)bn * 16 + (size_t)(it_)) << 15; asm volatile("" : "+s"(vb_)); \
        _Pragma("unroll") for (int i = 0; i < 4; ++i) pre_[i] = *(const v4u*)((const char*)v + vb_ + (size_t)(i * 8192) + vo_v); } while (0)
#define MX_STORE(buf_, pre_) do { _Pragma("unroll") for (int i = 0; i < 4; ++i) *(LAS v4u*)(L + lo_v + (buf_) * MX_VBYTES + 32 * i * MX_VSTR) = pre_[i]; } while (0)
#define MX_ULOAD(uu_, it_) do { size_t ub_ = ((size_t)bn * 16 + (size_t)(it_)) << 15; asm volatile("" : "+s"(ub_)); \
        _Pragma("unroll") for (int i = 0; i < 4; ++i) uu_[i] = *(const v4u*)((const char*)u + ub_ + (size_t)(i * 8192) + vo_v); } while (0)
#define MX_TILE(it_, buf_, uu_) do { \
        f32x16 acc[2]; \
        _Pragma("unroll") for (int tt = 0; tt < 2; ++tt) _Pragma("unroll") for (int j = 0; j < 16; ++j) acc[tt][j] = 0.f; \
        LAS unsigned char* Vb = L + MX_V0 + (buf_) * MX_VBYTES; \
        const int nks = th == 0 ? 4 : 8; \
        for (int ks = 0; ks < nks; ++ks) { \
            const int srow = 16 * ks + 8 * hh + q4; \
            const s16x4 a0 = tr_read16(Vb + srow * MX_VSTR + (32 * ct + 16 * blk + 4 * p4) * 2), a1 = tr_read16(Vb + (srow + 4) * MX_VSTR + (32 * ct + 16 * blk + 4 * p4) * 2); \
            const bf16x8 Av = {a0[0], a0[1], a0[2], a0[3], a1[0], a1[1], a1[2], a1[3]}; \
            _Pragma("unroll") for (int tt = 0; tt < 2; ++tt) { \
                const bf16x8 Bw = *(const LAS bf16x8*)(L + MX_W + (64 * th + 32 * tt + r32) * MX_WSTR + (16 * ks + 8 * hh) * 2); \
                acc[tt] = __builtin_amdgcn_mfma_f32_32x32x16_bf16(Av, Bw, acc[tt], 0, 0, 0); } } \
        const int cl = ((it_) & 3) * 128 + 32 * ct + 4 * hh;                    \
        __syncthreads();                                                         \
        _Pragma("unroll") for (int tt = 0; tt < 2; ++tt) { \
            const int t = 64 * th + 32 * tt + r32; const float tm1 = m1[t], tm0 = m0[t], tb = bsg[t]; \
            _Pragma("unroll") for (int g4 = 0; g4 < 4; ++g4) { \
                const f32x4 lg = *(const LAS f32x4*)(lgs + cl + 8 * g4), lb = *(const LAS f32x4*)(lbs + cl + 8 * g4); \
                v2u o; o.x = pk2(lg[0] * (acc[tt][4 * g4 + 0] - tm1) + lb[0] * tm0 + tb, lg[1] * (acc[tt][4 * g4 + 1] - tm1) + lb[1] * tm0 + tb); \
                o.y = pk2(lg[2] * (acc[tt][4 * g4 + 2] - tm1) + lb[2] * tm0 + tb, lg[3] * (acc[tt][4 * g4 + 3] - tm1) + lb[3] * tm0 + tb); \
                *(LAS v2u*)(Vb + t * MX_MSTR + (32 * ct + 8 * g4 + 4 * hh) * 2) = o; } } \
        __syncthreads();                                                         \
        size_t ob_ = ((size_t)bn * 16 + (size_t)(it_)) << 14; asm volatile("" : "+s"(ob_));     \
        _Pragma("unroll") for (int i = 0; i < 4; ++i) { \
            const v4u mx = *(const LAS v4u*)(Vb + ((tid >> 4) + 32 * i) * MX_MSTR + (tid & 15) * 16); const v4u ux = uu_[i]; v2u o; \
            int w0_ = __builtin_amdgcn_cvt_pk_fp8_f32(bflo(ux.x) * bflo(mx.x), bfhi(ux.x) * bfhi(mx.x), 0, false); w0_ = __builtin_amdgcn_cvt_pk_fp8_f32(bflo(ux.y) * bflo(mx.y), bfhi(ux.y) * bfhi(mx.y), w0_, true); \
            int w1_ = __builtin_amdgcn_cvt_pk_fp8_f32(bflo(ux.z) * bflo(mx.z), bfhi(ux.z) * bfhi(mx.z), 0, false); w1_ = __builtin_amdgcn_cvt_pk_fp8_f32(bflo(ux.w) * bflo(mx.w), bfhi(ux.w) * bfhi(mx.w), w1_, true); \
            o.x = (unsigned)w0_; o.y = (unsigned)w1_; *(v2u*)(uout + ob_ + (size_t)(i * 4096) + (unsigned)(tid * 8)) = o; } } while (0)
        MX_LOAD(preA, 0); MX_LOAD(preB, 1); MX_ULOAD(uuA, 0);
        for (int it = 0; it < 16; it += 2) {
            if ((it & 3) == 0) {
                const int g = it >> 2;
                __syncthreads();
                const int t = tid >> 2, sq = tid & 3; const float* wsrc = F.inp(I_SGU_WS) + ((size_t)g * 128 + t) * 128 + sq * 8;
                float a1 = 0.f, a0 = 0.f;
#pragma unroll
                for (int i = 0; i < 4; ++i) {
                    const f32x4 x0 = *(const f32x4*)(wsrc + i * 32), x1 = *(const f32x4*)(wsrc + i * 32 + 4); float wv[8] = {x0[0], x0[1], x0[2], x0[3], x1[0], x1[1], x1[2], x1[3]}; float hv[8];
#pragma unroll
                    for (int j = 0; j < 8; ++j) { const int s = i * 32 + sq * 8 + j; const float wm = ((t >> 6) >= (s >> 6)) ? wv[j] : 0.f; a0 += wm; hv[j] = wm * rs[s]; }
                    v4u o; o.x = pk2(hv[0], hv[1]); o.y = pk2(hv[2], hv[3]); o.z = pk2(hv[4], hv[5]); o.w = pk2(hv[6], hv[7]);
                    const unsigned ow[4] = {o.x, o.y, o.z, o.w};
#pragma unroll
                    for (int j = 0; j < 4; ++j) a1 += bflo(ow[j]) * mu[i * 32 + sq * 8 + 2 * j] + bfhi(ow[j]) * mu[i * 32 + sq * 8 + 2 * j + 1];
                    *(LAS v4u*)(L + MX_W + t * MX_WSTR + (i * 32 + sq * 8) * 2) = o;
                }
                a1 += __shfl_xor(a1, 1); a1 += __shfl_xor(a1, 2); a0 += __shfl_xor(a0, 1); a0 += __shfl_xor(a0, 2);
                if (sq == 0) { m1[t] = a1; m0[t] = a0; }
                if (tid < 128) bsg[tid] = F.inp(I_SGU_BS)[g * 128 + tid];
                lgs[tid] = F.inp(I_SGU_LNG)[g * SGU_GC + tid]; lbs[tid] = F.inp(I_SGU_LNB)[g * SGU_GC + tid];
            }
            MX_STORE(0, preA);
            __syncthreads();
            if (it + 2 < 16) MX_LOAD(preA, it + 2);
            MX_ULOAD(uuB, it + 1);
            MX_TILE(it, 0, uuA);
            MX_STORE(1, preB);
            __syncthreads();
            if (it + 3 < 16) MX_LOAD(preB, it + 3);
            if (it + 2 < 16) MX_ULOAD(uuA, it + 2);
            MX_TILE(it + 1, 1, uuB);
        }
#undef MX_LOAD
#undef MX_STORE
#undef MX_ULOAD
#undef MX_TILE
    }
}
constexpr int RW_STR = 2064;
constexpr int RW_LG = 48 * RW_STR;
constexpr int RW_HIST = RW_LG + 8 * 16 * 48 * 4;
template <int MODE> __device__ __forceinline__ void f_rowgroup(Frame& F, int Lyr) {
    constexpr int NCT = MODE == 0 ? 1 : 3;
    LAS unsigned char* L = F.lds;
    const int tid = FTID, lane = FLANE, w = FWAVE, rw = lane & 15, q = lane >> 4;
    const float* xsrc = F.inp(I_X);
    bf16* xb = WSP(bf16, WS_XN); float* rsout = WSP(float, WS_RS);
    __syncthreads();
    for (int k = tid; k < D; k += NTHREADS) {
        if (MODE == 0) {
            const float gn = F.inp(I_GLA_NORM)[k]; const float* wr_ = F.inp(I_GLA_WIN) + (size_t)k * GLA_IN + NQKVR;
#pragma unroll
            for (int c4 = 0; c4 < 4; ++c4) { const f32x4 x = *(const f32x4*)(wr_ + 4 * c4);
#pragma unroll
                for (int j = 0; j < 4; ++j) *(LAS unsigned short*)(L + (4 * c4 + j) * RW_STR + k * 2) = (unsigned short)f2bf(x[j] * gn); }
        } else {
            const float gn = F.inp(I_MOE_NORM)[Lyr * D + k];
            const f32x4 xg = *(const f32x4*)(F.inp(I_MOE_WG) + ((size_t)Lyr * D + k) * 4);
#pragma unroll
            for (int j = 0; j < 4; ++j) *(LAS unsigned short*)(L + j * RW_STR + k * 2) = (unsigned short)f2bf(xg[j] * gn);
#pragma unroll
            for (int g = 0; g < 4; ++g) { const float* ws_ = F.inp(I_MOE_WSUB) + (((size_t)Lyr * 4 + g) * D + k) * EPG; const f32x4 a = *(const f32x4*)ws_, b = *(const f32x4*)(ws_ + 4);
#pragma unroll
                for (int j = 0; j < 4; ++j) { *(LAS unsigned short*)(L + (4 + 8 * g + j) * RW_STR + k * 2) = (unsigned short)f2bf(a[j] * gn); *(LAS unsigned short*)(L + (8 + 8 * g + j) * RW_STR + k * 2) = (unsigned short)f2bf(b[j] * gn); } }
#pragma unroll
            for (int c = 36; c < 48; ++c) *(LAS unsigned short*)(L + c * RW_STR + k * 2) = 0;
        }
    }
    LAS int* hist = (LAS int*)(L + RW_HIST); LAS int* hbase = hist + 32;
    if (MODE == 1 && tid < 32) hist[tid] = 0;
    __syncthreads();
    const int ngroups = T / 16, niter = (ngroups + F.G * NWAVES - 1) / (F.G * NWAVES);
    for (int iter = 0; iter < niter; ++iter) {
        const int grp = (iter * F.G + F.bid) * NWAVES + w; const bool valid = grp < ngroups;
        const size_t row = (size_t)grp * 16 + rw;
        float rstd = 0.f; pg8::f32x4 acc[NCT];
        if (valid) {
#pragma unroll
            for (int c = 0; c < NCT; ++c) acc[c] = (pg8::f32x4){0.f, 0.f, 0.f, 0.f};
            float ss = 0.f;
#pragma unroll 8
            for (int s = 0; s < 32; ++s) {
                v4u pa;
                if (MODE == 0) {
                    const float* xr = xsrc + row * D + 8 * q + 32 * s;
                    const f32x4 x0 = *(const f32x4*)xr, x1 = *(const f32x4*)(xr + 4);
                    ss += (x0[0] * x0[0] + x0[1] * x0[1]) + (x0[2] * x0[2] + x0[3] * x0[3]) + (x1[0] * x1[0] + x1[1] * x1[1]) + (x1[2] * x1[2] + x1[3] * x1[3]);
                    pa.x = pk2(x0[0], x0[1]); pa.y = pk2(x0[2], x0[3]); pa.z = pk2(x1[0], x1[1]); pa.w = pk2(x1[2], x1[3]);
                    *(v4u*)(xb + row * D + 8 * q + 32 * s) = pa;
                } else {
                    pa = *(const v4u*)(xb + row * D + 8 * q + 32 * s);
                    const float a0 = bflo(pa.x), a1 = bfhi(pa.x), a2 = bflo(pa.y), a3 = bfhi(pa.y), a4 = bflo(pa.z), a5 = bfhi(pa.z), a6 = bflo(pa.w), a7 = bfhi(pa.w);
                    ss += (a0 * a0 + a1 * a1) + (a2 * a2 + a3 * a3) + (a4 * a4 + a5 * a5) + (a6 * a6 + a7 * a7);
                    int w0 = __builtin_amdgcn_cvt_pk_fp8_f32(a0, a1, 0, false); w0 = __builtin_amdgcn_cvt_pk_fp8_f32(a2, a3, w0, true);
                    int w1 = __builtin_amdgcn_cvt_pk_fp8_f32(a4, a5, 0, false); w1 = __builtin_amdgcn_cvt_pk_fp8_f32(a6, a7, w1, true);
                    v2u o8; o8.x = (unsigned)w0; o8.y = (unsigned)w1; *(v2u*)(WSP(unsigned char, WS_XB8) + row * D + 8 * q + 32 * s) = o8;
                }
                const bf16x8 A = __builtin_bit_cast(bf16x8, pa);
#pragma unroll
                for (int c = 0; c < NCT; ++c) { const bf16x8 B = *(const LAS bf16x8*)(L + (16 * c + rw) * RW_STR + (32 * s + 8 * q) * 2); acc[c] = __builtin_amdgcn_mfma_f32_16x16x32_bf16(A, B, acc[c], 0, 0, 0); }
            }
            ss += __shfl_xor(ss, 16); ss += __shfl_xor(ss, 32);
            rstd = __builtin_amdgcn_rsqf(ss * (1.f / D) + EPS);
            if (q == 0) rsout[row] = rstd;
        }
        float rs4[4];
#pragma unroll
        for (int i = 0; i < 4; ++i) rs4[i] = __shfl(rstd, 4 * q + i);
        int e1 = 0, e2 = 0, rk1 = 0, rk2 = 0; float gt1 = 0.f, gt2 = 0.f;
        if (MODE == 0) {
            if (valid) {
                float* glr = WSP(float, WS_GLR);
#pragma unroll
                for (int i = 0; i < 4; ++i) glr[((size_t)grp * 16 + 4 * q + i) * RANK + rw] = acc[0][i] * rs4[i];
            }
        } else {
            LAS float* lgw = (LAS float*)(L + RW_LG) + w * 16 * 48;
            if (valid) {
#pragma unroll
                for (int c = 0; c < NCT; ++c)
#pragma unroll
                    for (int i = 0; i < 4; ++i) lgw[(4 * q + i) * 48 + 16 * c + rw] = acc[c][i] * rs4[i];
            }
            LDS_WAIT(); asm volatile("" ::: "memory");
            if (valid && lane < 16) {
                const LAS float* lr = lgw + lane * 48; const float* bg = F.inp(I_MOE_BG) + Lyr * 4;
                float lg[4];
#pragma unroll
                for (int c = 0; c < 4; ++c) lg[c] = lr[c] + bg[c];
                int g = 0; float gm = lg[0];
#pragma unroll
                for (int c = 1; c < 4; ++c) if (lg[c] > gm) { gm = lg[c]; g = c; }
                float gs = 0.f;
#pragma unroll
                for (int c = 0; c < 4; ++c) gs += __expf(lg[c] - gm);
                const float g_w = 1.f / gs; const float* bs = F.inp(I_MOE_BSUB) + (Lyr * 4 + g) * EPG;
                int i1 = 0, i2 = 0; float m1v = -3.0e38f, m2v = -3.0e38f;
                for (int e = 0; e < EPG; ++e) { const float x = lr[4 + 8 * g + e] + bs[e];
                    if (x > m1v) { m2v = m1v; i2 = i1; m1v = x; i1 = e; } else if (x > m2v) { m2v = x; i2 = e; } }
                const float w1 = 1.f / (1.f + __expf(m2v - m1v));
                e1 = g * EPG + i1; e2 = g * EPG + i2; gt1 = g_w * w1; gt2 = g_w * (1.f - w1);
                rk1 = __hip_atomic_fetch_add(&hist[e1], 1, __ATOMIC_RELAXED, __HIP_MEMORY_SCOPE_WORKGROUP); rk2 = __hip_atomic_fetch_add(&hist[e2], 1, __ATOMIC_RELAXED, __HIP_MEMORY_SCOPE_WORKGROUP);
            }
            __syncthreads();
            if (tid < 32) { const int hcount = hist[tid]; hbase[tid] = hcount ? (int)atomicAdd(WSP(unsigned, WS_CTL) + CW_CNT + Lyr * 2048 + 64 * tid, (unsigned)hcount) : 0; hist[tid] = 0; }
            __syncthreads();
            if (valid && lane < 16) {
                const int tok = grp * 16 + lane; const int p1 = hbase[e1] + rk1, p2 = hbase[e2] + rk2;
                WSP(int, WS_LIST)[(size_t)e1 * T + p1] = tok * 2; WSP(int, WS_LIST)[(size_t)e2 * T + p2] = tok * 2 + 1;
                WSP(float, WS_GATE)[tok * 2] = gt1; WSP(float, WS_GATE)[tok * 2 + 1] = gt2;
            }
        }
    }
    __syncthreads();
}
template <bool FINAL> __device__ __forceinline__ void f_rowadd(Frame& F) {
    bf16* xb = WSP(bf16, WS_XN); const unsigned char* y = WSP(unsigned char, WS_Y); float* rsout = WSP(float, WS_RS); bf16* xo = xb;
    const int lane = FLANE, w = FWAVE;
    f32x4 gf[4];
    if (FINAL) {
#pragma unroll
        for (int j = 0; j < 2; ++j) { gf[2 * j] = *(const f32x4*)(F.inp(I_FINAL) + 8 * lane + 512 * j); gf[2 * j + 1] = *(const f32x4*)(F.inp(I_FINAL) + 8 * lane + 512 * j + 4); }
    }
    for (int r0 = (F.bid * NWAVES + w) * 2; r0 < T; r0 += F.G * NWAVES * 2) {
        v4u xa[2][2]; v2u ya[2][2], yb[2][2];
#pragma unroll
        for (int rr = 0; rr < 2; ++rr)
#pragma unroll
            for (int j = 0; j < 2; ++j) { const size_t o = (size_t)(r0 + rr) * D + 8 * lane + 512 * j;
                xa[rr][j] = *(const v4u*)(xb + o); ya[rr][j] = *(const v2u*)(y + o); yb[rr][j] = *(const v2u*)(y + (size_t)T * D + o); }
#pragma unroll
        for (int rr = 0; rr < 2; ++rr) {
            float v[16]; float ss = 0.f;
#pragma unroll
            for (int j = 0; j < 2; ++j) {
                const unsigned xw[4] = {xa[rr][j].x, xa[rr][j].y, xa[rr][j].z, xa[rr][j].w};
                const pg8::f32x2 a0 = __builtin_amdgcn_cvt_pk_f32_fp8((int)ya[rr][j].x, false), a1 = __builtin_amdgcn_cvt_pk_f32_fp8((int)ya[rr][j].x, true), a2 = __builtin_amdgcn_cvt_pk_f32_fp8((int)ya[rr][j].y, false), a3 = __builtin_amdgcn_cvt_pk_f32_fp8((int)ya[rr][j].y, true);
                const pg8::f32x2 b0 = __builtin_amdgcn_cvt_pk_f32_fp8((int)yb[rr][j].x, false), b1 = __builtin_amdgcn_cvt_pk_f32_fp8((int)yb[rr][j].x, true), b2 = __builtin_amdgcn_cvt_pk_f32_fp8((int)yb[rr][j].y, false), b3 = __builtin_amdgcn_cvt_pk_f32_fp8((int)yb[rr][j].y, true);
                const float ysum[8] = {a0.x + b0.x, a0.y + b0.y, a1.x + b1.x, a1.y + b1.y, a2.x + b2.x, a2.y + b2.y, a3.x + b3.x, a3.y + b3.y};
#pragma unroll
                for (int e = 0; e < 4; ++e) { const float lo = bflo(xw[e]) + ysum[2 * e], hi = bfhi(xw[e]) + ysum[2 * e + 1]; v[8 * j + 2 * e] = lo; v[8 * j + 2 * e + 1] = hi; ss += lo * lo + hi * hi; }
            }
            const float rstd = __builtin_amdgcn_rsqf(wave_sum(ss) * (1.f / D) + EPS);
            const size_t ro = (size_t)(r0 + rr) * D + 8 * lane;
            if (FINAL) {
#pragma unroll
                for (int j = 0; j < 2; ++j) {
                    f32x4 o0 = {v[8 * j] * rstd, v[8 * j + 1] * rstd, v[8 * j + 2] * rstd, v[8 * j + 3] * rstd}, o1 = {v[8 * j + 4] * rstd, v[8 * j + 5] * rstd, v[8 * j + 6] * rstd, v[8 * j + 7] * rstd};
                    *(f32x4*)(F.out + ro + 512 * j) = o0 * gf[2 * j]; *(f32x4*)(F.out + ro + 512 * j + 4) = o1 * gf[2 * j + 1]; }
            } else {
#pragma unroll
                for (int j = 0; j < 2; ++j) { v4u o; o.x = pk2(v[8 * j], v[8 * j + 1]); o.y = pk2(v[8 * j + 2], v[8 * j + 3]); o.z = pk2(v[8 * j + 4], v[8 * j + 5]); o.w = pk2(v[8 * j + 6], v[8 * j + 7]); *(v4u*)(xo + ro + 512 * j) = o;
                    int w0 = __builtin_amdgcn_cvt_pk_fp8_f32(v[8 * j], v[8 * j + 1], 0, false); w0 = __builtin_amdgcn_cvt_pk_fp8_f32(v[8 * j + 2], v[8 * j + 3], w0, true);
                    int w1 = __builtin_amdgcn_cvt_pk_fp8_f32(v[8 * j + 4], v[8 * j + 5], 0, false); w1 = __builtin_amdgcn_cvt_pk_fp8_f32(v[8 * j + 6], v[8 * j + 7], w1, true);
                    v2u o8; o8.x = (unsigned)w0; o8.y = (unsigned)w1; *(v2u*)(WSP(unsigned char, WS_XB8) + ro + 512 * j) = o8; }
                if (lane == 0) rsout[r0 + rr] = rstd;
            }
        }
    }
}
__device__ __forceinline__ void f_prep0(Frame& F) { f_convert_gla(F); f_rowgroup<0>(F, 0); }
__device__ __forceinline__ void f_rowpass_router(Frame& F, int L) { f_rowgroup<1>(F, L); }
__device__ __forceinline__ void f_rowpass_add(Frame& F) { f_rowadd<false>(F); }
__device__ __forceinline__ void f_final(Frame& F) { f_rowadd<true>(F); }
constexpr int LDS_BYTES = 155648;
struct Args { const float* in[23]; float* out; unsigned char* ws; int ph_lo, ph_hi; };

__global__ void __launch_bounds__(NTHREADS, 2) fwd(Args args) {
    extern __shared__ __attribute__((aligned(16))) unsigned char lds_raw[];
    Frame F;
    F.lds = (LAS unsigned char*)lds_raw;
    F.G = gridDim.x; F.bid = blockIdx.x;
    F.out = args.out; F.ws = args.ws;
    volatile LAS unsigned* bst = (volatile LAS unsigned*)(F.lds + LX_PTR + 192);
    if (FTID == 0) {
        LAS unsigned long long* pt = (LAS unsigned long long*)(F.lds + LX_PTR);
#pragma unroll
        for (int i = 0; i < 23; ++i) pt[i] = (unsigned long long)args.in[i];
    }
    if (FTID < 2) bst[FTID] = 0u;
    __syncthreads();
    cg::grid_group grid = cg::this_grid();
    const XcdBarrier xbar = xcd_barrier_post(WSP(unsigned, WS_CTL) + CW_BAR, bst);
    const int lo = args.ph_lo, hi = args.ph_hi;
    if (lo > 1000) grid.sync();
#define IN(k) (lo <= (k) && (k) < hi)
#define SEAM() xcd_barrier(xbar)

    if (IN(0)) f_prep0(F);                 SEAM();
    if (IN(1)) f_gemm_in(F);               SEAM();
    if (IN(2)) f_scan_outproj(F, xbar);    SEAM();
    if (IN(3)) f_rowpass_router(F, 0);     SEAM();
    if (IN(4)) f_moe(F, 0);                SEAM();
    if (IN(5)) f_rowpass_add(F);           SEAM();
    if (IN(6)) f_gemm_sgu_in(F);           SEAM();
    if (IN(7)) f_mix(F);                   SEAM();
    if (IN(8)) f_gemm_sgu_out(F);          SEAM();
    if (IN(9)) f_rowpass_router(F, 1);     SEAM();
    if (IN(10)) f_moe(F, 1);               SEAM();
    if (IN(11)) f_final(F);
#undef IN
#undef SEAM
}

extern "C" void kernel_launch(void* const* d_in, const int* in_sizes, int n_in, void* d_out, int out_size, void* d_ws, size_t ws_size, hipStream_t stream) {
    static int grid = 0;
    if (grid == 0) {
        if (n_in != 23 || out_size != T * D || in_sizes[0] != T * D || ws_size < WS_END) { fprintf(stderr, "kernel_launch: unexpected shapes (n_in %d out %d ws %zu): nothing launched\n", n_in, out_size, ws_size); grid = -1; return; }
        int dev = 0, cus = 0, per_cu = 0;
        if (hipGetDevice(&dev) != hipSuccess || hipDeviceGetAttribute(&cus, hipDeviceAttributeMultiprocessorCount, dev) != hipSuccess) { grid = -1; return; }
        if (hipFuncSetAttribute((const void*)fwd, hipFuncAttributeMaxDynamicSharedMemorySize, LDS_BYTES) != hipSuccess) { fprintf(stderr, "kernel_launch: cannot get %d bytes of dynamic LDS\n", LDS_BYTES); grid = -1; return; }
        if (hipOccupancyMaxActiveBlocksPerMultiprocessor(&per_cu, (const void*)fwd, NTHREADS, LDS_BYTES) != hipSuccess || per_cu < 1) { fprintf(stderr, "kernel_launch: occupancy query admits %d workgroups per CU: nothing launched\n", per_cu); grid = -1; (void)hipGetLastError(); return; }
        grid = cus;
        if (grid < 128) { fprintf(stderr, "kernel_launch: %d CUs; this kernel's phase program needs at least 128 workgroups\n", grid); grid = -1; return; }
    }
    if (grid < 0) return;
    (void)hipMemsetAsync((char*)d_ws + WS_CTL, 0, CTL_ZERO_BYTES, stream);
    Args a{};
    for (int i = 0; i < 23; ++i) a.in[i] = (const float*)d_in[i];
    a.out = (float*)d_out; a.ws = (unsigned char*)d_ws; a.ph_lo = 0; a.ph_hi = 12;
    void* kargs[] = {&a};
    const hipError_t e = hipLaunchCooperativeKernel((const void*)fwd, dim3(grid), dim3(NTHREADS), kargs, LDS_BYTES, stream);
    if (e != hipSuccess) fprintf(stderr, "cooperative launch failed: %s (grid %d)\n", hipGetErrorString(e), grid);
}
```

```cpp
#include <hip/hip_runtime.h>
#include <hip/hip_cooperative_groups.h>
#include <cstdio>
#include <cstdint>
namespace cg = cooperative_groups;


constexpr int T = 32768, D = 1024, NBATCH = 16, SEQ = 2048;
constexpr int GLA_H = 4, DK = 128, DV = 256, HK = 512, HV = 1024, RANK = 16, GLA_IN = 3088, NQKVR = 3072, CHUNK = 64, NCHUNK = 32;
constexpr int SGU_FFN = 4096, SGU_HALF = 2048, SGU_BLK = 128, SGU_GC = 512;
constexpr int NE = 32, EPG = 8, FF = 512;
constexpr float EPS = 1e-6f;
constexpr int NTHREADS = 512, NWAVES = 8;

constexpr size_t MiB = 1u << 20;
constexpr size_t WS_CTL = 0, CTL_ZERO_BYTES = 128 * 1024;
constexpr size_t WS_GLR = 1 * MiB;
constexpr size_t WS_GATE = 3 * MiB;
constexpr size_t WS_STATS = 4 * MiB;
constexpr size_t WS_LIST = 12 * MiB;
constexpr size_t WS_WIN = 16 * MiB;
constexpr size_t WS_WOUT = 22 * MiB;
constexpr size_t WS_WSIN = 24 * MiB;
constexpr size_t WS_WSOUT = 32 * MiB;
constexpr size_t WS_UG8 = 100 * MiB;
constexpr size_t WS_W13 = 36 * MiB;
constexpr size_t WS_W2 = 164 * MiB;
constexpr float MOE_WSCALE = 32.f;
constexpr size_t WS_XN = 228 * MiB;
constexpr size_t WS_AOUT = 484 * MiB;
constexpr size_t WS_RS = 3 * MiB + 256 * 1024;
constexpr size_t WS_QKVR = 292 * MiB;
constexpr size_t WS_HID = 292 * MiB;
constexpr size_t WS_XB8 = 100 * MiB;
constexpr size_t WS_Y = 364 * MiB;
constexpr size_t WS_U = 292 * MiB;
constexpr size_t WS_V = 420 * MiB;
constexpr size_t WS_END = 548 * MiB;
constexpr int CW_BAR = 1024;
constexpr int CW_HID = 16384;
constexpr int CW_SP = 12288;
constexpr int CW_QU = 14400, CW_QC = 14464;
constexpr int CW_CNT = 8192;

#define GAS __attribute__((address_space(1)))
#define LAS __attribute__((address_space(3)))
typedef unsigned short bf16;
typedef unsigned v4u __attribute__((ext_vector_type(4)));
typedef unsigned v2u __attribute__((ext_vector_type(2)));
typedef float f32x4 __attribute__((ext_vector_type(4)));
typedef float f32x16 __attribute__((ext_vector_type(16)));
typedef short bf16x8 __attribute__((ext_vector_type(8)));
typedef short s16x4 __attribute__((ext_vector_type(4)));
#define LDS_WAIT() asm volatile("s_waitcnt lgkmcnt(0)" ::: "memory")
#define VM_WAIT() asm volatile("s_waitcnt vmcnt(0)" ::: "memory")
typedef float f32x2_t __attribute__((ext_vector_type(2))); typedef __bf16 bf16x2_t __attribute__((ext_vector_type(2)));
__device__ __forceinline__ unsigned pk2(float lo, float hi) { f32x2_t v = {lo, hi}; bf16x2_t b = __builtin_convertvector(v, bf16x2_t); return __builtin_bit_cast(unsigned, b); }
__device__ __forceinline__ unsigned f2bf(float f) { return pk2(f, 0.f) & 0xffffu; }
__device__ __forceinline__ float bf2f(unsigned short b) { return __builtin_bit_cast(float, (unsigned)b << 16); }
__device__ __forceinline__ float bflo(unsigned w) { return __builtin_bit_cast(float, w << 16); }
__device__ __forceinline__ float bfhi(unsigned w) { return __builtin_bit_cast(float, w & 0xffff0000u); }
__device__ __forceinline__ float wave_sum(float v) {
#pragma unroll
    for (int o = 1; o < 64; o <<= 1) v += __shfl_xor(v, o);
    return v;
}
__device__ __forceinline__ float silu_f(float x) { return x * __builtin_amdgcn_rcpf(1.f + __expf(-x)); }
namespace pg8 {
#define PG8_LAS __attribute__((address_space(3)))
typedef unsigned short bf16_t;
typedef short bf16x8 __attribute__((ext_vector_type(8)));
typedef float f32x4 __attribute__((ext_vector_type(4)));
typedef unsigned u32x4 __attribute__((ext_vector_type(4)));
constexpr int BM = 256, BK = 64, HALF = 128, HTB = HALF * BK * 2  , STAGE_BYTES = 8 * HTB, NXCD = 8, WGM = 2;

__host__ __device__ __forceinline__ int lds_byte(int r, int c) { const int st = (r >> 4) * 2 + (c >> 5), rr = r & 15, cc = c & 31, ob = rr * 64 + cc * 2; return st * 1024 + (ob ^ (((ob >> 9) & 1) << 5)); }
__host__ __device__ __forceinline__ void stage_rc(int b, int& R, int& C) { const int st = b / 1024, sb = b % 1024, swz = sb ^ (((sb >> 9) & 1) << 5); R = (st >> 1) * 16 + swz / 64; C = (st & 1) * 32 + (swz % 64) / 2; }
__host__ __device__ __forceinline__ int perm32(int rho) { const int n = rho >> 4, i = rho & 15; return 8 * (i >> 2) + 4 * n + (i & 3); }

struct Unit { int pm, pn, e, slot; };

struct DenseOrder {
    static constexpr bool GATHER = false;
    int nM, nN, nwg, G, c, K; const char* Bt;
    __device__ void init(int M, int N, int K_, const bf16_t* Bt_, int G_, int c_) { nM = M / BM; nN = N / BM; nwg = nM * nN; G = G_; c = c_; K = K_; Bt = (const char*)Bt_; }
    __device__ __forceinline__ bool next(int i, Unit& u) const {
        const long L = (long)i * G + c; if (L >= nwg) return false;
        int wgid = (int)L; { const int q = nwg / NXCD, r = nwg % NXCD, xcd = wgid % NXCD, off = wgid / NXCD; wgid = (xcd < r ? xcd * (q + 1) : r * (q + 1) + (xcd - r) * q) + off; }
        const int nig = WGM * nN, gid = wgid / nig, fm = gid * WGM, gsz = (nM - fm) < WGM ? (nM - fm) : WGM;
        u.pm = fm + ((wgid % nig) % gsz); u.pn = (wgid % nig) / gsz; u.e = 0; u.slot = 0; return true;
    }
    __device__ __forceinline__ const char* bptr(const Unit& u) const { return Bt + (size_t)u.pn * BM * K * 2; }
    __device__ __forceinline__ size_t abase(const Unit& u) const { return (size_t)u.pm * BM * K * 2; }
    __device__ __forceinline__ int a_rowstride(int dflt) const { return dflt; }
    __device__ __forceinline__ size_t a_hstep(size_t dflt) const { return dflt; }
    __device__ __forceinline__ size_t a_koff(int kt) const { return (size_t)kt * 128; }
    __device__ __forceinline__ unsigned aoff(const Unit& u, int h, int R, int C) const { return (unsigned)(((u.pm * BM + h * HALF + R) * K + C) * 2); }
    __device__ __forceinline__ void a_ready(const Unit&) const {}
    __device__ __forceinline__ void done(const Unit&) const {}
};

__device__ __forceinline__ unsigned cvt_pk_bf16(float lo, float hi) { unsigned r; asm volatile("v_cvt_pk_bf16_f32 %0, %1, %2" : "=v"(r) : "v"(lo), "v"(hi)); return r; }
typedef float f32x2 __attribute__((ext_vector_type(2)));
__device__ __forceinline__ f32x2 gelu_pk(f32x2 v) {
    f32x2 xc; xc.x = __builtin_amdgcn_fmed3f(v.x, -5.f, 5.f); xc.y = __builtin_amdgcn_fmed3f(v.y, -5.f, 5.f);
    const f32x2 u = (xc * xc) * 0.08f + (-1.0f);
    f32x2 p = u * (-1.096248219e-03f) + 3.194360377e-03f;
    p = p * u + (-3.887098463e-03f); p = p * u + 5.113467309e-03f; p = p * u + (-1.016528703e-02f); p = p * u + 1.690999552e-02f; p = p * u + (-2.362500388e-02f);
    p = p * u + 3.135676375e-02f; p = p * u + (-4.039197823e-02f); p = p * u + 5.152539331e-02f; p = p * u + (-7.029823295e-02f); p = p * u + 1.413637479e-01f;
    return v * (xc * p + 0.5f);
}

#define PG8_SB0 __builtin_amdgcn_sched_barrier(0)
__device__ __forceinline__ void gelu_pk4(f32x2& a, f32x2& b, f32x2& c, f32x2& d) {
    f32x2 xa, xb, xc, xd;
    xa.x = __builtin_amdgcn_fmed3f(a.x, -5.f, 5.f); xa.y = __builtin_amdgcn_fmed3f(a.y, -5.f, 5.f); xb.x = __builtin_amdgcn_fmed3f(b.x, -5.f, 5.f); xb.y = __builtin_amdgcn_fmed3f(b.y, -5.f, 5.f);
    xc.x = __builtin_amdgcn_fmed3f(c.x, -5.f, 5.f); xc.y = __builtin_amdgcn_fmed3f(c.y, -5.f, 5.f); xd.x = __builtin_amdgcn_fmed3f(d.x, -5.f, 5.f); xd.y = __builtin_amdgcn_fmed3f(d.y, -5.f, 5.f);
    f32x2 ua = xa * xa, ub = xb * xb, uc = xc * xc, ud = xd * xd; PG8_SB0;
    ua = ua * 0.08f + (-1.0f); ub = ub * 0.08f + (-1.0f); uc = uc * 0.08f + (-1.0f); ud = ud * 0.08f + (-1.0f); PG8_SB0;
    f32x2 pa = ua * (-1.096248219e-03f) + 3.194360377e-03f, pb = ub * (-1.096248219e-03f) + 3.194360377e-03f, pc = uc * (-1.096248219e-03f) + 3.194360377e-03f, pd = ud * (-1.096248219e-03f) + 3.194360377e-03f; PG8_SB0;
#define PG8_H4(k) pa = pa * ua + (k); pb = pb * ub + (k); pc = pc * uc + (k); pd = pd * ud + (k); PG8_SB0
    PG8_H4(-3.887098463e-03f); PG8_H4(5.113467309e-03f); PG8_H4(-1.016528703e-02f); PG8_H4(1.690999552e-02f); PG8_H4(-2.362500388e-02f);
    PG8_H4(3.135676375e-02f); PG8_H4(-4.039197823e-02f); PG8_H4(5.152539331e-02f); PG8_H4(-7.029823295e-02f); PG8_H4(1.413637479e-01f);
#undef PG8_H4
    pa = xa * pa + 0.5f; pb = xb * pb + 0.5f; pc = xc * pc + 0.5f; pd = xd * pd + 0.5f; PG8_SB0;
    a = a * pa; b = b * pb; c = c * pc; d = d * pd;
}

typedef int v8i __attribute__((ext_vector_type(8)));
typedef int v4i __attribute__((ext_vector_type(4)));
template <int ES, class Epi, class Sched>
__device__ __forceinline__ void gemm_phase_es(PG8_LAS unsigned char* lds, const void* Abase, const int K, const Sched& S, const Epi& E) {
    const int tid = threadIdx.x, wid = __builtin_amdgcn_readfirstlane(tid >> 6), lane = tid & 63, wr = wid >> 2, wc = wid & 3, fr = lane & 15, fq = lane >> 4;
    const int nt = K * ES / 128;
    int sR[2], sC[2]; unsigned voffA[2], voffB[2];
#pragma unroll
    for (int i = 0; i < 2; ++i) { stage_rc(tid * 16 + i * 8192, sR[i], sC[i]); const int Rb = Epi::PERM ? ((sR[i] & ~31) + perm32(sR[i] & 31)) : sR[i];
        voffA[i] = (unsigned)(sR[i] * S.a_rowstride(K * ES) + sC[i] * 2); voffB[i] = (unsigned)(Rb * K * ES + sC[i] * 2); }
    const size_t kstep = (size_t)(BK * 2);
    const size_t hstep = (size_t)HALF * K * ES;
    const size_t hstepA = S.a_hstep(hstep);
    const unsigned ldsw = (unsigned)wid * 1024u;
    const int aoff = lds_byte(wr * 64 + fr, fq * (ES == 2 ? 8 : 16)), boff = lds_byte(wc * 32 + fr, fq * (ES == 2 ? 8 : 16));
    const char* const Ab = (const char*)Abase;
#define PG8_SA(b, h) (((b) * 2 + (h)) * HTB)
#define PG8_SB(b, h) ((4 + (b) * 2 + (h)) * HTB)
#define PG8_STAGE(bufoff, gbase, voff) do { _Pragma("unroll") for (int _i = 0; _i < 2; ++_i) \
        __builtin_amdgcn_global_load_lds((const unsigned*)((const char*)(gbase) + (voff)[_i]), (PG8_LAS unsigned*)(lds + (bufoff) + ldsw + _i * 8192), 16, 0, 0); } while (0)
#define PG8_STAGE_A(bufoff, nx, h, kt) do { if constexpr (Sched::GATHER) { PG8_STAGE(bufoff, Ab + (size_t)(kt) * kstep, gc[h]); } \
        else PG8_STAGE(bufoff, ((nx) ? xA : cA) + (size_t)(h) * hstepA + S.a_koff(kt), voffA); } while (0)
#define PG8_LDA(dst, b, h) do { if constexpr (ES == 2) { _Pragma("unroll") for (int m = 0; m < 4; ++m) _Pragma("unroll") for (int k = 0; k < 2; ++k) dst[m][k] = *(const PG8_LAS bf16x8*)(lds + PG8_SA(b, h) + aoff + m * 2048 + k * 1024); } \
        else { _Pragma("unroll") for (int m = 0; m < 4; ++m) { const v4i lo_ = *(const PG8_LAS v4i*)(lds + PG8_SA(b, h) + aoff + m * 2048), hi_ = *(const PG8_LAS v4i*)(lds + PG8_SA(b, h) + aoff + m * 2048 + 16); dst##8[m] = __builtin_shufflevector(lo_, hi_, 0, 1, 2, 3, 4, 5, 6, 7); } } } while (0)
#define PG8_LDB(dst, b, h) do { if constexpr (ES == 2) { _Pragma("unroll") for (int n = 0; n < 2; ++n) _Pragma("unroll") for (int k = 0; k < 2; ++k) dst[n][k] = *(const PG8_LAS bf16x8*)(lds + PG8_SB(b, h) + boff + n * 2048 + k * 1024); } \
        else { _Pragma("unroll") for (int n = 0; n < 2; ++n) { const v4i lo_ = *(const PG8_LAS v4i*)(lds + PG8_SB(b, h) + boff + n * 2048), hi_ = *(const PG8_LAS v4i*)(lds + PG8_SB(b, h) + boff + n * 2048 + 16); dst##8[n] = __builtin_shufflevector(lo_, hi_, 0, 1, 2, 3, 4, 5, 6, 7); } } } while (0)
#define PG8_MMA(ai, bj, At, Bt) do { __builtin_amdgcn_s_setprio(1); if constexpr (ES == 2) { _Pragma("unroll") for (int m = 0; m < 4; ++m) _Pragma("unroll") for (int n = 0; n < 2; ++n) _Pragma("unroll") for (int k = 0; k < 2; ++k) \
        acc[ai][bj][m][n] = __builtin_amdgcn_mfma_f32_16x16x32_bf16(Bt[n][k], At[m][k], acc[ai][bj][m][n], 0, 0, 0); } \
        else { _Pragma("unroll") for (int m = 0; m < 4; ++m) _Pragma("unroll") for (int n = 0; n < 2; ++n) \
        asm volatile("s_nop 1\n\tv_mfma_f32_16x16x128_f8f6f4 %0, %1, %2, %0" : "+v"(acc[ai][bj][m][n]) : "v"(Bt##8[n]), "v"(At##8[m])); }   \
        __builtin_amdgcn_s_setprio(0); } while (0)
#define PG8_WAIT_V(n) asm volatile("s_waitcnt vmcnt(" #n ")" ::: "memory")
#define PG8_WAIT_L(n) asm volatile("s_waitcnt lgkmcnt(" #n ")" ::: "memory")
#define PG8_BAR __builtin_amdgcn_s_barrier()
#define PG8_SCHED __builtin_amdgcn_sched_barrier(0)
    Unit cur, nxt, prv; int ui = 0; bool have_prv = false;
    if (!S.next(0, cur)) return;
    f32x4 acc[2][2][4][2];
#pragma unroll
    for (int a = 0; a < 2; ++a)
#pragma unroll
        for (int b = 0; b < 2; ++b)
#pragma unroll
            for (int m = 0; m < 4; ++m)
#pragma unroll
                for (int n = 0; n < 2; ++n) acc[a][b][m][n] = (f32x4){0.f, 0.f, 0.f, 0.f};
    bf16x8 At[4][2], B0[2][2], B1[2][2]; v8i At8[4], B08[2], B18[2];
    unsigned gc[2][2];
    const char* cA = Ab; const char* xA = Ab;
    if constexpr (Sched::GATHER) {
#pragma unroll
        for (int h = 0; h < 2; ++h)
#pragma unroll
            for (int i = 0; i < 2; ++i) gc[h][i] = S.aoff(cur, h, sR[i], sC[i]);
    } else { cA = Ab + S.abase(cur); xA = cA; }
    const char* cB = S.bptr(cur);
    S.a_ready(cur);
    if constexpr (Epi::RS_DMA) { if (wid == 0) __builtin_amdgcn_global_load_lds((const unsigned*)((const char*)E.rs + (size_t)cur.pm * 1024 + lane * 16), (PG8_LAS unsigned*)(lds + STAGE_BYTES + 512), 16, 0, 0); }
    PG8_STAGE(PG8_SB(0, 0), cB, voffB); PG8_STAGE(PG8_SB(0, 1), cB + hstep, voffB); PG8_STAGE_A(PG8_SA(0, 0), false, 0, 0); PG8_STAGE_A(PG8_SA(0, 1), false, 1, 0);
    if (wr == 1) PG8_BAR;
    PG8_WAIT_V(2); PG8_BAR;
    PG8_STAGE(PG8_SB(1, 0), cB + kstep, voffB); PG8_STAGE_A(PG8_SA(1, 0), false, 0, 1); PG8_STAGE(PG8_SB(1, 1), cB + hstep + kstep, voffB);
    PG8_WAIT_V(6); PG8_BAR;
    for (;;) {
        const bool has_next = S.next(ui + 1, nxt);
        const char* nB = has_next ? S.bptr(nxt) : cB;
        if constexpr (Epi::RS_DMA) { if (has_next && wid == 0) __builtin_amdgcn_global_load_lds((const unsigned*)((const char*)E.rs + (size_t)nxt.pm * 1024 + lane * 16), (PG8_LAS unsigned*)(lds + STAGE_BYTES + 512 + ((ui + 1) % 3) * 1024), 16, 0, 0); }
        for (int t = 0; t < nt; t += 2) {
            const bool last = (t == nt - 2);
            const int kt2 = last ? 0 : t + 2;
            const char* b2 = last ? nB : cB + (size_t)(t + 2) * kstep; const char* b3 = b2 + kstep;
            if (last && has_next) {
                if constexpr (!Sched::GATHER) xA = Ab + S.abase(nxt);
                S.a_ready(nxt);
            }
            PG8_LDB(B0, 0, 0); PG8_LDB(B1, 0, 1); PG8_SCHED; PG8_LDA(At, 0, 0); PG8_STAGE_A(PG8_SA(1, 1), false, 1, t + 1);
            if constexpr (Sched::GATHER) { if (last && has_next) {
#pragma unroll
                for (int h = 0; h < 2; ++h)
#pragma unroll
                    for (int i = 0; i < 2; ++i) gc[h][i] = S.aoff(nxt, h, sR[i], sC[i]); } }
            PG8_WAIT_V(8); PG8_WAIT_L(0); PG8_BAR; PG8_MMA(0, 0, At, B0); PG8_MMA(0, 1, At, B1); PG8_BAR; PG8_SCHED;
            PG8_LDA(At, 0, 1); PG8_STAGE(PG8_SB(0, 0), b2, voffB); PG8_STAGE(PG8_SB(0, 1), b2 + hstep, voffB); PG8_STAGE_A(PG8_SA(0, 0), last, 0, kt2);
            PG8_WAIT_V(8); PG8_WAIT_L(0); PG8_BAR; PG8_MMA(1, 0, At, B0); PG8_MMA(1, 1, At, B1); PG8_BAR; PG8_SCHED;
            PG8_LDB(B0, 1, 0); PG8_LDB(B1, 1, 1); PG8_SCHED; PG8_LDA(At, 1, 0); PG8_STAGE_A(PG8_SA(0, 1), last, 1, kt2);
            PG8_WAIT_V(8); PG8_WAIT_L(0);
            if (have_prv) { S.done(prv); have_prv = false; }
            PG8_BAR; PG8_MMA(0, 0, At, B0); PG8_MMA(0, 1, At, B1); PG8_BAR; PG8_SCHED;
            PG8_LDA(At, 1, 1); PG8_STAGE(PG8_SB(1, 0), b3, voffB); PG8_STAGE(PG8_SB(1, 1), b3 + hstep, voffB); PG8_STAGE_A(PG8_SA(1, 0), last, 0, kt2 + 1);
            PG8_WAIT_V(8); PG8_WAIT_L(0); PG8_BAR; PG8_MMA(1, 0, At, B0); PG8_MMA(1, 1, At, B1); PG8_BAR; PG8_SCHED;
        }
        if (wr == 0) PG8_BAR;
        if constexpr (ES == 1) asm volatile("s_nop 15\n\ts_nop 15" ::: "memory");
        E(acc, cur, wr, wc, fr, fq, (const PG8_LAS float*)(lds + STAGE_BYTES + 512 + (ui % 3) * 1024)); prv = cur; have_prv = true;
        if (!has_next) break;
#pragma unroll
        for (int a = 0; a < 2; ++a)
#pragma unroll
            for (int b = 0; b < 2; ++b)
#pragma unroll
                for (int m = 0; m < 4; ++m)
#pragma unroll
                    for (int n = 0; n < 2; ++n) acc[a][b][m][n] = (f32x4){0.f, 0.f, 0.f, 0.f};
        cur = nxt; cB = nB; ++ui;
        if constexpr (!Sched::GATHER) cA = xA;
        if (wr == 1) PG8_BAR;
    }
    PG8_WAIT_V(0);
    if (have_prv) S.done(prv);
    PG8_BAR;
#undef PG8_STAGE_A
#undef PG8_SA
#undef PG8_SB
#undef PG8_STAGE
#undef PG8_LDA
#undef PG8_LDB
#undef PG8_MMA
#undef PG8_WAIT_V
#undef PG8_WAIT_L
#undef PG8_BAR
#undef PG8_SCHED
}
template <class Epi, class Sched>
__device__ __forceinline__ void gemm_phase(PG8_LAS unsigned char* lds, const bf16_t* Abase, const int K, const Sched& S, const Epi& E) { gemm_phase_es<2>(lds, Abase, K, S, E); }
}
constexpr int LX_PTR = 155648 - 256;
#define FTID ((int)threadIdx.x)
#define FLANE ((int)threadIdx.x & 63)
#define FWAVE ((int)__builtin_amdgcn_readfirstlane((int)threadIdx.x >> 6))
struct Frame {
    LAS unsigned char* lds;
    int G, bid;
    float* out; unsigned char* ws;
    __device__ __forceinline__ const float* inp(int i) const {
        const LAS unsigned* p = (const LAS unsigned*)(lds + LX_PTR) + 2 * i;
        const unsigned lo = __builtin_amdgcn_readfirstlane(p[0]), hi = __builtin_amdgcn_readfirstlane(p[1]);
        return (const float*)(const GAS float*)(((unsigned long long)hi << 32) | lo);
    }
};
enum { I_X = 0, I_GLA_NORM, I_GLA_WIN, I_GLA_WGU, I_GLA_BG, I_GLA_HG, I_GLA_WOUT, I_SGU_NORM, I_SGU_WIN, I_SGU_LNG, I_SGU_LNB, I_SGU_WS, I_SGU_BS, I_SGU_WOUT,
       I_MOE_NORM, I_MOE_WG, I_MOE_BG, I_MOE_WSUB, I_MOE_BSUB, I_MOE_W1, I_MOE_W3, I_MOE_W2, I_FINAL };
#define WSP(type, off) ((type*)(F.ws + (off)))

#define XB_TMO      128
#define XB_XCNT(j)  (256  + 64 * (j))
#define XB_XSUB(j)  (1280 + 64 * (j))
#define XB_XGEN(j)  (2304 + 64 * (j))
#define XB_TOP      3328
#define XB_TOPGEN   3392
#define XCD_BAR_WORDS 3456
#define XB_SPIN_CAP (1u << 18)

__device__ __forceinline__ unsigned xb_ld(unsigned* p)              { return __hip_atomic_load(p, __ATOMIC_RELAXED, __HIP_MEMORY_SCOPE_AGENT); }
__device__ __forceinline__ unsigned xb_add(unsigned* p, unsigned v) { return __hip_atomic_fetch_add(p, v, __ATOMIC_RELAXED, __HIP_MEMORY_SCOPE_AGENT); }
__device__ __forceinline__ unsigned xb_xcc_id() { return (unsigned)__builtin_amdgcn_s_getreg((3 << 11) | 20) & 0xFu; }
#define XB_SPIN(cond, bar) do { unsigned _sp = 0; while (cond) { __builtin_amdgcn_s_sleep(1); \
    if ((++_sp & 255u) == 0u) { if (xb_ld(&(bar)[XB_TMO])) break; if (_sp > XB_SPIN_CAP) { atomicAdd(&(bar)[XB_TMO], 1u); break; } } } } while (0)

struct XcdBarrier {
    unsigned* bar; unsigned x;
    volatile LAS unsigned* st;
};

__device__ __forceinline__ XcdBarrier xcd_barrier_post(unsigned* bar, volatile LAS unsigned* st) {
    XcdBarrier b; b.bar = bar; b.x = xb_xcc_id(); b.st = st;
    if (threadIdx.x == 0) (void)xb_add(&bar[XB_XCNT(b.x)], 1u);
    return b;
}
__device__ __forceinline__ void xcd_barrier_complete(unsigned* bar, unsigned x, unsigned& nloc, unsigned& nx) {
    const unsigned G = gridDim.x * gridDim.y * gridDim.z;
    unsigned sum, cnt, mine, sp = 0u;
    for (;;) {
        sum = 0u; cnt = 0u; mine = 0u;
#pragma unroll
        for (unsigned j = 0; j < 16; ++j) { const unsigned c = xb_ld(&bar[XB_XCNT(j)]); sum += c; cnt += (c > 0u) ? 1u : 0u; mine = (j == x) ? c : mine; }
        if (sum == G) break;
        __builtin_amdgcn_s_sleep(1);
        if ((++sp & 255u) == 0u) { if (xb_ld(&bar[XB_TMO])) break; if (sp > XB_SPIN_CAP) { atomicAdd(&bar[XB_TMO], 1u); break; } }
    }
    nloc = mine > 0u ? mine : 1u; nx = cnt > 0u ? cnt : 1u;
}

__device__ __forceinline__ void xcd_barrier(const XcdBarrier& b) {
    asm volatile("s_waitcnt vmcnt(0)" ::: "memory");
    __syncthreads();
    if (threadIdx.x == 0) {
        unsigned* bar = b.bar;
        __builtin_amdgcn_s_waitcnt(0);
        unsigned nloc = b.st[0], nx = b.st[1];
        if (nloc == 0u) { xcd_barrier_complete(bar, b.x, nloc, nx); b.st[0] = nloc; b.st[1] = nx; }
        const unsigned old = xb_add(&bar[XB_XSUB(b.x)], 1u);
        const unsigned gen = old / nloc;
        if (old + 1u == (gen + 1u) * nloc) {
            __builtin_amdgcn_fence(__ATOMIC_RELEASE, "agent");
            asm volatile("s_waitcnt vmcnt(0)" ::: "memory");
            const unsigned og = xb_add(&bar[XB_TOP], 1u);
            const unsigned tg = og / nx;
            if (og + 1u == (tg + 1u) * nx) xb_add(&bar[XB_TOPGEN], 1u);
            else XB_SPIN(xb_ld(&bar[XB_TOPGEN]) == tg, bar);
            __builtin_amdgcn_fence(__ATOMIC_ACQUIRE, "agent");
            xb_add(&bar[XB_XGEN(b.x)], 1u);
            asm volatile("s_waitcnt vmcnt(0)" ::: "memory");
        } else {
            XB_SPIN(xb_ld(&bar[XB_XGEN(b.x)]) == gen, bar);
            __builtin_amdgcn_fence(__ATOMIC_ACQUIRE, "agent");
            asm volatile("s_waitcnt vmcnt(0)" ::: "memory");
        }
    }
    __syncthreads();
}
constexpr int RING_BYTES = 131072;
constexpr int LX_TST = RING_BYTES;
constexpr int MOE_MAXU = 6;
constexpr int LX_TAB = RING_BYTES + 512;
constexpr int LX_GT = LX_TAB + MOE_MAXU * 1024;

struct EpiStoreBf16 {
    static constexpr bool RS_DMA = true;
    static constexpr bool PERM = true;
    bf16* O; int ldc; const float* rs; int silu_from;
    __device__ __forceinline__ void operator()(const pg8::f32x4 (&acc)[2][2][4][2], const pg8::Unit& u, int wr, int wc, int fr, int fq, const LAS float* rsl) const {
        const int row0 = u.pm * 256 + wr * 64 + fr, col0 = u.pn * 256 + wc * 32 + 8 * fq;
#pragma unroll
        for (int ai = 0; ai < 2; ++ai)
#pragma unroll
            for (int m = 0; m < 4; ++m) { const int row = row0 + ai * 128 + m * 16; bf16* rowp = O + (size_t)row * ldc + col0; const float sc = rsl[ai * 128 + wr * 64 + m * 16 + fr];
#pragma unroll
                for (int bj = 0; bj < 2; ++bj) { pg8::f32x4 v0 = acc[ai][bj][m][0] * sc, v1 = acc[ai][bj][m][1] * sc;
                    if (silu_from >= 0 && u.pn >= silu_from) {
#pragma unroll
                        for (int i = 0; i < 4; ++i) { v0[i] = v0[i] * __builtin_amdgcn_rcpf(1.f + __expf(-v0[i])); v1[i] = v1[i] * __builtin_amdgcn_rcpf(1.f + __expf(-v1[i])); } }
                    v4u w; w.x = pg8::cvt_pk_bf16(v0[0], v0[1]); w.y = pg8::cvt_pk_bf16(v0[2], v0[3]); w.z = pg8::cvt_pk_bf16(v1[0], v1[1]); w.w = pg8::cvt_pk_bf16(v1[2], v1[3]);
                    *(v4u*)(rowp + bj * 128) = w; } }
    }
};
template <bool BATCH> struct EpiResBf16T {
    static constexpr bool RS_DMA = false;
    static constexpr bool PERM = true;
    bf16* X; float sc;
    __device__ __forceinline__ void operator()(const pg8::f32x4 (&acc)[2][2][4][2], const pg8::Unit& u, int wr, int wc, int fr, int fq, const LAS float* rsl) const {
        const int row0 = u.pm * 256 + wr * 64 + fr, col0 = u.pn * 256 + wc * 32 + 8 * fq;
        if constexpr (BATCH) {
#pragma unroll
            for (int ai = 0; ai < 2; ++ai) {
                v4u r[4][2];
#pragma unroll
                for (int m = 0; m < 4; ++m) { const bf16* rowp = X + (size_t)(row0 + ai * 128 + m * 16) * D + col0;
#pragma unroll
                    for (int bj = 0; bj < 2; ++bj) r[m][bj] = *(const v4u*)(rowp + bj * 128); }
                asm volatile("s_waitcnt vmcnt(0)" ::: "memory");
#pragma unroll
                for (int m = 0; m < 4; ++m) { bf16* rowp = X + (size_t)(row0 + ai * 128 + m * 16) * D + col0;
#pragma unroll
                    for (int bj = 0; bj < 2; ++bj) { const v4u rx = r[m][bj]; const pg8::f32x4 v0 = acc[ai][bj][m][0] * sc, v1 = acc[ai][bj][m][1] * sc;
                        v4u w; w.x = pg8::cvt_pk_bf16(bflo(rx.x) + v0[0], bfhi(rx.x) + v0[1]); w.y = pg8::cvt_pk_bf16(bflo(rx.y) + v0[2], bfhi(rx.y) + v0[3]);
                        w.z = pg8::cvt_pk_bf16(bflo(rx.z) + v1[0], bfhi(rx.z) + v1[1]); w.w = pg8::cvt_pk_bf16(bflo(rx.w) + v1[2], bfhi(rx.w) + v1[3]);
                        *(v4u*)(rowp + bj * 128) = w; } }
            }
        } else {
#pragma unroll
        for (int ai = 0; ai < 2; ++ai)
#pragma unroll
            for (int m = 0; m < 4; ++m) { bf16* rowp = X + (size_t)(row0 + ai * 128 + m * 16) * D + col0;
#pragma unroll
                for (int bj = 0; bj < 2; ++bj) { const v4u r = *(const v4u*)(rowp + bj * 128); const pg8::f32x4 v0 = acc[ai][bj][m][0] * sc, v1 = acc[ai][bj][m][1] * sc;
                    v4u w; w.x = pg8::cvt_pk_bf16(bflo(r.x) + v0[0], bfhi(r.x) + v0[1]); w.y = pg8::cvt_pk_bf16(bflo(r.y) + v0[2], bfhi(r.y) + v0[3]);
                    w.z = pg8::cvt_pk_bf16(bflo(r.z) + v1[0], bfhi(r.z) + v1[1]); w.w = pg8::cvt_pk_bf16(bflo(r.w) + v1[2], bfhi(r.w) + v1[3]);
                    *(v4u*)(rowp + bj * 128) = w; } }
        }
    }
};
#ifndef RES_BATCH_OUT
#define RES_BATCH_OUT true
#endif
#ifndef RES_BATCH_SGU
#define RES_BATCH_SGU true
#endif
typedef EpiResBf16T<RES_BATCH_OUT> EpiResBf16;
__device__ __forceinline__ size_t sgu_blk(int row, int col) { return ((size_t)((row >> 7) * 16 + (col >> 7)) << 15) + (size_t)((row & 127) << 8) + (size_t)((col & 127) << 1); }
struct EpiGeluSplit {
    static constexpr bool RS_DMA = true;
    static constexpr bool PERM = true;
    bf16* U; bf16* V; float* st; const float* rs;
    __device__ __forceinline__ void operator()(const pg8::f32x4 (&acc)[2][2][4][2], const pg8::Unit& u, int wr, int wc, int fr, int fq, const LAS float* rsl) const {
        const bool isv = u.pn >= 8; const int pnl = isv ? u.pn - 8 : u.pn;
        bf16* O = isv ? V : U;
        const int row0 = u.pm * 256 + wr * 64 + fr, col0 = pnl * 256 + wc * 32 + 8 * fq;
#pragma unroll
        for (int ai = 0; ai < 2; ++ai)
#pragma unroll
            for (int m = 0; m < 4; ++m) { const int row = row0 + ai * 128 + m * 16; bf16* rowp = (bf16*)((char*)O + sgu_blk(row, col0)); pg8::f32x2 s2 = {0.f, 0.f}, q2 = {0.f, 0.f};   const float sc = rsl[ai * 128 + wr * 64 + m * 16 + fr] * (1.f / MOE_WSCALE);
#pragma unroll
                for (int bj = 0; bj < 2; ++bj) { const pg8::f32x4 v0 = acc[ai][bj][m][0] * sc, v1 = acc[ai][bj][m][1] * sc;
                    pg8::f32x2 a = {v0[0], v0[1]}, b = {v0[2], v0[3]}, c = {v1[0], v1[1]}, d = {v1[2], v1[3]}; pg8::gelu_pk4(a, b, c, d);
                    s2 += (a + b) + (c + d); q2 += (a * a + b * b) + (c * c + d * d);
                    v4u w; w.x = pg8::cvt_pk_bf16(a.x, a.y); w.y = pg8::cvt_pk_bf16(b.x, b.y); w.z = pg8::cvt_pk_bf16(c.x, c.y); w.w = pg8::cvt_pk_bf16(d.x, d.y);
                    *(v4u*)((char*)rowp + bj * 32768) = w; }
                if (isv) { float s = s2.x + s2.y, q = q2.x + q2.y; s += __shfl_xor(s, 16); s += __shfl_xor(s, 32); q += __shfl_xor(q, 16); q += __shfl_xor(q, 32);
                    if (fq == 0) { pg8::f32x2 o = {s, q}; *(pg8::f32x2*)(st + ((size_t)(pnl * 4 + wc) * T + row) * 2) = o; } } }
    }
};

__device__ __forceinline__ void f_gemm_in(Frame& F) {
    pg8::DenseOrder S; S.init(T, NQKVR, D, WSP(bf16, WS_WIN), F.G, F.bid);
    EpiStoreBf16 E{WSP(bf16, WS_QKVR), NQKVR, WSP(float, WS_RS), 8};
    pg8::gemm_phase(F.lds, WSP(bf16, WS_XN), D, S, E);
}
struct DenseOrder8 : pg8::DenseOrder {
    __device__ __forceinline__ const char* bptr(const pg8::Unit& u) const { return Bt + (size_t)u.pn * 256 * K; }
    __device__ __forceinline__ size_t abase(const pg8::Unit& u) const { return (size_t)u.pm * 256 * K; }
};
struct BlockedAOrder : pg8::DenseOrder {
    __device__ __forceinline__ const char* bptr(const pg8::Unit& u) const { return Bt + (size_t)u.pn * 256 * K; }
    __device__ __forceinline__ size_t abase(const pg8::Unit& u) const { return (size_t)u.pm * 2 * 16 * 16384; }
    __device__ __forceinline__ int a_rowstride(int) const { return 128; }
    __device__ __forceinline__ size_t a_hstep(size_t) const { return (size_t)16 * 16384; }
    __device__ __forceinline__ size_t a_koff(int kt) const { return (size_t)kt * 16384; }
};
struct RowSetOrder {
    static constexpr bool GATHER = false;
    int nb, c, j0, nunits, K; const char* Bt;
    __device__ __forceinline__ bool next(int i, pg8::Unit& u) const {
        if (c < 0) return false;
        const int q = i * nb + c; if (q >= nunits) return false;
        u.pm = ((q & 63) >> 2) * 8 + j0 + (q >> 6); u.pn = q & 3; u.e = 0; u.slot = 0; return true;
    }
    __device__ __forceinline__ const char* bptr(const pg8::Unit& u) const { return Bt + (size_t)u.pn * 256 * K * 2; }
    __device__ __forceinline__ size_t abase(const pg8::Unit& u) const { return (size_t)u.pm * 256 * K * 2; }
    __device__ __forceinline__ int a_rowstride(int dflt) const { return dflt; }
    __device__ __forceinline__ size_t a_hstep(size_t dflt) const { return dflt; }
    __device__ __forceinline__ size_t a_koff(int kt) const { return (size_t)kt * 128; }
    __device__ __forceinline__ unsigned aoff(const pg8::Unit&, int, int, int) const { return 0u; }
    __device__ __forceinline__ void a_ready(const pg8::Unit&) const {}
    __device__ __forceinline__ void done(const pg8::Unit&) const {}
};
__device__ __forceinline__ void f_gemm_out_rows(Frame& F, int j0, int j1, int boff) {
    RowSetOrder S; S.nb = F.G - boff; S.c = F.bid - boff; S.j0 = j0; S.nunits = (j1 - j0) * 64; S.K = HV; S.Bt = (const char*)WSP(bf16, WS_WOUT);
    EpiResBf16 E{WSP(bf16, WS_XN), 1.f};
    pg8::gemm_phase(F.lds, WSP(bf16, WS_AOUT), HV, S, E);
}
__device__ __forceinline__ void f_gemm_sgu_in(Frame& F) {
    DenseOrder8 S; S.init(T, SGU_FFN, D, WSP(bf16, WS_WSIN), F.G, F.bid);
    EpiGeluSplit E{WSP(bf16, WS_U), WSP(bf16, WS_V), WSP(float, WS_STATS), WSP(float, WS_RS)};
    pg8::gemm_phase_es<1>(F.lds, WSP(unsigned char, WS_XB8), D, S, E);
}
__device__ __forceinline__ void f_gemm_sgu_out(Frame& F, float scmul = 1.f) {
    BlockedAOrder S; S.init(T, D, SGU_HALF, WSP(bf16, WS_WSOUT), F.G, F.bid);
    EpiResBf16T<RES_BATCH_SGU> E{WSP(bf16, WS_XN), scmul * (1.f / MOE_WSCALE)};
    pg8::gemm_phase_es<1>(F.lds, WSP(unsigned char, WS_UG8), SGU_HALF, S, E);
}

template <bool GATHER_> struct MoeOrder {
    static constexpr bool GATHER = GATHER_;
    int G, c, nunits, ibase, K, rowb, mode;
    const char* W; size_t estride;
    LAS const int* tst; LAS const int* tab; unsigned* hcnt; unsigned rdy;
    int n5, rb;
    __device__ __forceinline__ bool next(int i, pg8::Unit& u) const {
        if (i >= MOE_MAXU) return false;
        const int ii = ibase + i; int Lu;
        if (GATHER || n5 <= 0 || ii < rb) Lu = ii * G + c;
        else { if (c < n5) return false; Lu = rb * G + (ii - rb) * (G - n5) + (c - n5); }
        if (Lu >= nunits) return false;
        const int rt = Lu >> 2; int e = 0;
        while (e < NE - 1 && tst[e + 1] <= rt) ++e;
        u.pm = rt; u.pn = Lu & 3; u.e = e; u.slot = i; return true;
    }
    __device__ __forceinline__ const char* bptr(const pg8::Unit& u) const { return W + (size_t)u.e * estride + (size_t)u.pn * 256 * rowb; }
    __device__ __forceinline__ size_t abase(const pg8::Unit& u) const { return (size_t)u.pm * 256 * rowb; }
    __device__ __forceinline__ int a_rowstride(int dflt) const { return dflt; }
    __device__ __forceinline__ size_t a_hstep(size_t dflt) const { return dflt; }
    __device__ __forceinline__ size_t a_koff(int kt) const { return (size_t)kt * 128; }
    __device__ __forceinline__ unsigned aoff(const pg8::Unit& u, int h, int R, int C) const {
        if (mode == 0) { int ent = tab[u.slot * 256 + h * 128 + R]; ent = ent < 0 ? 0 : ent; return (unsigned)((ent >> 1) * rowb + C * 2); }
        return (unsigned)((u.pm * 256 + h * 128 + R) * rowb + C * 2);
    }
    __device__ __forceinline__ void a_ready(const pg8::Unit& u) const {
        if (GATHER || ((rdy >> u.slot) & 1u)) return;
        if (threadIdx.x < 64) {
            unsigned spins = 0;
            while ((unsigned)__builtin_amdgcn_readfirstlane(__hip_atomic_load(hcnt + 16 * u.pm, __ATOMIC_RELAXED, __HIP_MEMORY_SCOPE_AGENT)) < 32u) { __builtin_amdgcn_s_sleep(2); if (++spins > (1u << 20)) break; }
            __builtin_amdgcn_fence(__ATOMIC_ACQUIRE, "agent");
            asm volatile("s_waitcnt vmcnt(0)" ::: "memory");
        }
        asm volatile("" ::: "memory"); __builtin_amdgcn_s_barrier(); asm volatile("" ::: "memory");
    }
    __device__ __forceinline__ void done(const pg8::Unit& u) const {
        if (!GATHER) return;
        if ((threadIdx.x & 63) == 0) __hip_atomic_fetch_add(hcnt + 16 * u.pm, 1u, __ATOMIC_RELAXED, __HIP_MEMORY_SCOPE_AGENT);
    }
};
struct EpiSwiglu {
    static constexpr bool RS_DMA = false;
    static constexpr bool PERM = true;
    unsigned char* H; LAS const float* gt;
    __device__ __forceinline__ void operator()(const pg8::f32x4 (&acc)[2][2][4][2], const pg8::Unit& u, int wr, int wc, int fr, int fq, const LAS float* rsl) const {
        const __amdgpu_buffer_rsrc_t hrs = __builtin_amdgcn_make_buffer_rsrc((void*)H, (short)0, 73728 * FF, 0x00020000);
        const int row0 = u.pm * 256 + wr * 64 + fr, col0 = u.pn * 128 + wc * 32 + 8 * fq;
#pragma unroll
        for (int ai = 0; ai < 2; ++ai)
#pragma unroll
            for (int m = 0; m < 4; ++m) { float h[8]; const float sc = gt[u.slot * 256 + ai * 128 + wr * 64 + m * 16 + fr] * (1.f / MOE_WSCALE);
#pragma unroll
                for (int n = 0; n < 2; ++n)
#pragma unroll
                    for (int i = 0; i < 4; ++i) { const float a = acc[ai][0][m][n][i] * sc, b = acc[ai][1][m][n][i] * sc; h[n * 4 + i] = a * __builtin_amdgcn_rcpf(1.f + __expf(-a)) * b; }
                int w0 = __builtin_amdgcn_cvt_pk_fp8_f32(h[0], h[1], 0, false); w0 = __builtin_amdgcn_cvt_pk_fp8_f32(h[2], h[3], w0, true);
                int w1 = __builtin_amdgcn_cvt_pk_fp8_f32(h[4], h[5], 0, false); w1 = __builtin_amdgcn_cvt_pk_fp8_f32(h[6], h[7], w1, true);
                v2u w; w.x = (unsigned)w0; w.y = (unsigned)w1;
                __builtin_amdgcn_raw_buffer_store_b64(w, hrs, (row0 + ai * 128 + m * 16) * FF + col0, 0, 16); }
    }
};
struct EpiScatterY {
    static constexpr bool RS_DMA = false;
    static constexpr bool PERM = true;
    unsigned char* Y; LAS const int* tab; LAS const float* gt;
    __device__ __forceinline__ void operator()(const pg8::f32x4 (&acc)[2][2][4][2], const pg8::Unit& u, int wr, int wc, int fr, int fq, const LAS float* rsl) const {
        const int col0 = u.pn * 256 + wc * 32 + 8 * fq;
#pragma unroll
        for (int ai = 0; ai < 2; ++ai)
#pragma unroll
            for (int m = 0; m < 4; ++m) { const int r = ai * 128 + wr * 64 + m * 16 + fr; const int ent = tab[u.slot * 256 + r]; const float g = gt[u.slot * 256 + r] * (1.f / MOE_WSCALE);
                if (ent >= 0) { unsigned char* rowp = Y + ((size_t)(ent & 1) * T + (ent >> 1)) * D + col0;
#pragma unroll
                    for (int bj = 0; bj < 2; ++bj) { const pg8::f32x4 v0 = acc[ai][bj][m][0] * g, v1 = acc[ai][bj][m][1] * g;
                        int w0 = __builtin_amdgcn_cvt_pk_fp8_f32(v0[0], v0[1], 0, false); w0 = __builtin_amdgcn_cvt_pk_fp8_f32(v0[2], v0[3], w0, true);
                        int w1 = __builtin_amdgcn_cvt_pk_fp8_f32(v1[0], v1[1], 0, false); w1 = __builtin_amdgcn_cvt_pk_fp8_f32(v1[2], v1[3], w1, true);
                        v2u w; w.x = (unsigned)w0; w.y = (unsigned)w1; *(v2u*)(rowp + bj * 128) = w; } } }
    }
};
template <int MODE> __device__ __forceinline__ void f_moe_gemm(Frame& F, int L, LAS int* tst, LAS int* cntl) {
    LAS int* tab = (LAS int*)(F.lds + LX_TAB); LAS float* gt = (LAS float*)(F.lds + LX_GT);
    MoeOrder<MODE == 0> S; S.G = F.G; S.c = F.bid; S.nunits = 4 * tst[NE]; S.K = MODE == 0 ? D : FF; S.rowb = S.K; S.mode = MODE; S.tst = tst; S.tab = tab;
    S.hcnt = WSP(unsigned, WS_CTL) + CW_HID + L * 4608;
    { const int r1 = (S.nunits + F.G - 1) / F.G, nlast = S.nunits - (r1 - 1) * F.G;
      S.n5 = (MODE == 1 && r1 >= 3 && nlast < F.G) ? nlast : 0; S.rb = r1 - 2; }
    S.W = MODE == 0 ? (const char*)(WSP(unsigned char, WS_W13) + (size_t)L * NE * 1024 * 1024) : (const char*)(WSP(unsigned char, WS_W2) + (size_t)L * NE * 1024 * 512);
    S.estride = MODE == 0 ? (size_t)1024 * 1024 : (size_t)1024 * 512;
    const int* list = WSP(int, WS_LIST); const float* gates = WSP(float, WS_GATE);
    for (int ibase = 0; ibase * (S.n5 > 0 ? F.G - S.n5 : F.G) < S.nunits; ibase += MOE_MAXU) {
        S.ibase = ibase;
        {
            static_assert(MOE_MAXU == 6, "three table slots per thread half");
            int ents[3]; float gsv[3]; const int r = FTID & 255, hsel = FTID >> 8;
#pragma unroll
            for (int k = 0; k < 3; ++k) { pg8::Unit u; ents[k] = -1;
                if (S.next(2 * k + hsel, u)) { const int idx = (u.pm - tst[u.e]) * 256 + r; if (idx < cntl[u.e]) ents[k] = list[(size_t)u.e * T + idx]; } }
#pragma unroll
            for (int k = 0; k < 3; ++k) gsv[k] = ents[k] >= 0 ? (MODE == 0 ? WSP(float, WS_RS)[ents[k] >> 1] : gates[ents[k]]) : 0.f;
#pragma unroll
            for (int k = 0; k < 3; ++k) { tab[(2 * k + hsel) * 256 + r] = ents[k]; gt[(2 * k + hsel) * 256 + r] = gsv[k]; }
        }
        S.rdy = 0u;
        if (MODE == 1) {
            LAS unsigned* rdyw = (LAS unsigned*)(F.lds + LX_TST + 448);
            if (FTID < 64) { unsigned m = 0u;
                for (int i = 0; i < MOE_MAXU; ++i) { pg8::Unit u; if (S.next(i, u) && (unsigned)__builtin_amdgcn_readfirstlane(__hip_atomic_load(S.hcnt + 16 * u.pm, __ATOMIC_RELAXED, __HIP_MEMORY_SCOPE_AGENT)) >= 32u) m |= 1u << i; }
                __builtin_amdgcn_fence(__ATOMIC_ACQUIRE, "agent"); asm volatile("s_waitcnt vmcnt(0)" ::: "memory");
                if (FTID == 0) *rdyw = m; }
            __syncthreads();
            S.rdy = *rdyw;
        }
        __syncthreads();
        if (MODE == 0) { EpiSwiglu E{WSP(unsigned char, WS_HID), gt}; pg8::gemm_phase_es<1>(F.lds, WSP(unsigned char, WS_XB8), D, S, E); }
        else { EpiScatterY E{WSP(unsigned char, WS_Y), tab, gt}; pg8::gemm_phase_es<1>(F.lds, WSP(unsigned char, WS_HID), FF, S, E); }
        __syncthreads();
    }
}
__device__ __forceinline__ void f_moe(Frame& F, int L) {
    LAS int* tst = (LAS int*)(F.lds + LX_TST); LAS int* cntl = tst + 64;
    unsigned* ctl = WSP(unsigned, WS_CTL);
    __syncthreads();
    if (FTID < NE) cntl[FTID] = (int)__hip_atomic_load(&ctl[CW_CNT + L * 2048 + 64 * FTID], __ATOMIC_RELAXED, __HIP_MEMORY_SCOPE_AGENT);
    __syncthreads();
    if (FTID == 0) { int s = 0; for (int e = 0; e < NE; ++e) { tst[e] = s; s += (cntl[e] + 255) >> 8; } tst[NE] = s; }
    __syncthreads();
    f_moe_gemm<0>(F, L, tst, cntl);
    f_moe_gemm<1>(F, L, tst, cntl);
}
__device__ __forceinline__ void transpose_item(const float* W, int ldw, const float* kscale, float cs, bf16* WT, int K, int dst_row0, LAS float* scr, int k0, int n0, int lane) {
    f32x4 x[8]; float ks[8];
    const int kr = lane >> 3, n4 = (lane & 7) * 4;
#pragma unroll
    for (int i = 0; i < 8; ++i) { x[i] = *(const f32x4*)(W + (size_t)(k0 + 8 * i + kr) * ldw + n0 + n4); ks[i] = kscale ? kscale[k0 + 8 * i + kr] * cs : cs; }
#pragma unroll
    for (int i = 0; i < 8; ++i) { LAS float* d = scr + (8 * i + kr) * 33 + n4; d[0] = x[i][0] * ks[i]; d[1] = x[i][1] * ks[i]; d[2] = x[i][2] * ks[i]; d[3] = x[i][3] * ks[i]; }
    LDS_WAIT(); asm volatile("" ::: "memory");
    const int c = lane & 7;
#pragma unroll
    for (int j = 0; j < 4; ++j) { const int n = (lane >> 3) + 8 * j; const LAS float* s = scr + (8 * c) * 33 + n;
        v4u o; o.x = pk2(s[0 * 33], s[1 * 33]); o.y = pk2(s[2 * 33], s[3 * 33]); o.z = pk2(s[4 * 33], s[5 * 33]); o.w = pk2(s[6 * 33], s[7 * 33]);
        *(v4u*)(WT + (size_t)(dst_row0 + n) * K + k0 + 8 * c) = o; }
    LDS_WAIT(); asm volatile("" ::: "memory");
}
__device__ __forceinline__ void transpose_item8(const float* W, int ldw, const float* kscale, float cs, unsigned char* WT, int K, int dst_row0, LAS float* scr, int k0, int n0, int lane) {
    f32x4 x[8]; float ks[8];
    const int kr = lane >> 3, n4 = (lane & 7) * 4;
#pragma unroll
    for (int i = 0; i < 8; ++i) { x[i] = *(const f32x4*)(W + (size_t)(k0 + 8 * i + kr) * ldw + n0 + n4); ks[i] = kscale ? kscale[k0 + 8 * i + kr] * cs : cs; }
#pragma unroll
    for (int i = 0; i < 8; ++i) { LAS float* d = scr + (8 * i + kr) * 33 + n4; d[0] = x[i][0] * ks[i]; d[1] = x[i][1] * ks[i]; d[2] = x[i][2] * ks[i]; d[3] = x[i][3] * ks[i]; }
    LDS_WAIT(); asm volatile("" ::: "memory");
    const int c = lane & 7;
#pragma unroll
    for (int j = 0; j < 4; ++j) { const int n = (lane >> 3) + 8 * j; const LAS float* s = scr + (8 * c) * 33 + n;
        int w0 = __builtin_amdgcn_cvt_pk_fp8_f32(s[0 * 33], s[1 * 33], 0, false); w0 = __builtin_amdgcn_cvt_pk_fp8_f32(s[2 * 33], s[3 * 33], w0, true);
        int w1 = __builtin_amdgcn_cvt_pk_fp8_f32(s[4 * 33], s[5 * 33], 0, false); w1 = __builtin_amdgcn_cvt_pk_fp8_f32(s[6 * 33], s[7 * 33], w1, true);
        v2u o; o.x = (unsigned)w0; o.y = (unsigned)w1; *(v2u*)(WT + (size_t)(dst_row0 + n) * K + k0 + 8 * c) = o; }
    LDS_WAIT(); asm volatile("" ::: "memory");
}
__device__ __forceinline__ void convert_job_item8(const float* W, int ldw, int K, int N, const float* kscale, float cs, unsigned char* WT, int rowmap, LAS float* scr, int item, int lane) {
    const int nblk = N / 32, kb = item / nblk, nb = item % nblk, k0 = 64 * kb, n0 = 32 * nb;
    const int dr = rowmap == 0 ? n0 : ((n0 >> 7) * 256 + (n0 & 127) + (rowmap == 2 ? 128 : 0));
    transpose_item8(W, ldw, kscale, cs, WT, K, dr, scr, k0, n0, lane);
}
__device__ __forceinline__ void convert_job_item(const float* W, int ldw, int K, int N, const float* kscale, int qcols, float qs, bf16* WT, int rowmap, LAS float* scr, int item, int lane) {
    const int nblk = N / 32, kb = item / nblk, nb = item % nblk, k0 = 64 * kb, n0 = 32 * nb;
    const int dr = rowmap == 0 ? n0 : ((n0 >> 7) * 256 + (n0 & 127) + (rowmap == 2 ? 128 : 0));
    transpose_item(W, ldw, kscale, n0 < qcols ? qs : 1.f, WT, K, dr, scr, k0, n0, lane);
}
__device__ __forceinline__ void f_convert_gla(Frame& F) {
    LAS float* scr = (LAS float*)(F.lds + FWAVE * 8448);
    const int gw = F.bid * NWAVES + FWAVE, NGW = F.G * NWAVES;
    constexpr int I0 = (D / 64) * (NQKVR / 32), I1 = (HV / 64) * (D / 32);
    for (int it = gw; it < I0 + I1; it += NGW) {
        if (it < I0) convert_job_item(F.inp(I_GLA_WIN), GLA_IN, D, NQKVR, F.inp(I_GLA_NORM), HK, 0.08838834764831845f, WSP(bf16, WS_WIN), 0, scr, it, FLANE);
        else convert_job_item(F.inp(I_GLA_WOUT), D, HV, D, F.inp(I_GLA_HG), 0, 1.f, WSP(bf16, WS_WOUT), 0, scr, it - I0, FLANE);
    }
}
struct Cv8 { const float* W; const float* kscale; unsigned char* WT; int ldw, K, dr, k0, n0; };
__device__ __forceinline__ Cv8 cv8_decode(Frame& F, int it) {
    constexpr int I0 = (D / 128) * (SGU_FFN / 64), I1 = (SGU_HALF / 128) * (D / 64), IE1 = (D / 128) * (FF / 64), IM = 2 * NE * IE1;
    Cv8 d; int r = it, N, rowmap = 0;
    if (r < I0) { d.W = F.inp(I_SGU_WIN); d.ldw = SGU_FFN; d.K = D; N = SGU_FFN; d.kscale = F.inp(I_SGU_NORM); d.WT = WSP(unsigned char, WS_WSIN); }
    else if ((r -= I0) < I1) { d.W = F.inp(I_SGU_WOUT); d.ldw = D; d.K = SGU_HALF; N = D; d.kscale = nullptr; d.WT = WSP(unsigned char, WS_WSOUT); }
    else { r -= I1; const int which = r / IM; r -= which * IM; const int le = r / IE1, L = le / NE; r = r % IE1;
        if (which < 2) { d.W = (which == 0 ? F.inp(I_MOE_W1) : F.inp(I_MOE_W3)) + (size_t)le * D * FF; d.ldw = FF; d.K = D; N = FF; d.kscale = F.inp(I_MOE_NORM) + L * D; d.WT = WSP(unsigned char, WS_W13) + (size_t)le * 1024 * 1024; rowmap = 1 + which; }
        else { d.W = F.inp(I_MOE_W2) + (size_t)le * FF * D; d.ldw = D; d.K = FF; N = D; d.kscale = nullptr; d.WT = WSP(unsigned char, WS_W2) + (size_t)le * 1024 * 512; } }
    const int nblk = N / 64, kb = r / nblk, nb = r % nblk; d.k0 = 128 * kb; d.n0 = 64 * nb;
    d.dr = rowmap == 0 ? d.n0 : ((d.n0 >> 7) * 256 + (d.n0 & 127) + (rowmap == 2 ? 128 : 0));
    return d;
}
constexpr int CV_PITCH = 132;
__device__ __forceinline__ void cv8_item(const Cv8& d, LAS unsigned char* tile, int lane) {
    const int n4 = lane & 15, gq = lane >> 4;
#pragma unroll 1
    for (int ss = 0; ss < 4; ss += 2) {
        f32x4 x[2][2][4]; float ks[2][2][4];
#pragma unroll
        for (int s2 = 0; s2 < 2; ++s2)
#pragma unroll
            for (int i = 0; i < 2; ++i)
#pragma unroll
                for (int r = 0; r < 4; ++r) { const int k = d.k0 + 32 * (ss + s2) + 4 * (gq + 4 * i) + r;
                    x[s2][i][r] = __builtin_nontemporal_load((const f32x4*)(d.W + (size_t)k * d.ldw + d.n0 + 4 * n4));     ks[s2][i][r] = d.kscale ? d.kscale[k] * MOE_WSCALE : MOE_WSCALE; }
#pragma unroll
        for (int s2 = 0; s2 < 2; ++s2)
#pragma unroll
            for (int i = 0; i < 2; ++i) { const int g = 8 * (ss + s2) + gq + 4 * i;
#pragma unroll
                for (int j = 0; j < 4; ++j) {
                    int w = __builtin_amdgcn_cvt_pk_fp8_f32(x[s2][i][0][j] * ks[s2][i][0], x[s2][i][1][j] * ks[s2][i][1], 0, false);
                    w = __builtin_amdgcn_cvt_pk_fp8_f32(x[s2][i][2][j] * ks[s2][i][2], x[s2][i][3][j] * ks[s2][i][3], w, true);
                    *(LAS int*)(tile + (4 * n4 + j) * CV_PITCH + 4 * g) = w; } }
    }
    LDS_WAIT(); asm volatile("" ::: "memory");
    const int rr = lane >> 3, pc = lane & 7;
#pragma unroll
    for (int p = 0; p < 8; ++p) { const int n = rr + 8 * p; const LAS unsigned* src = (const LAS unsigned*)(tile + n * CV_PITCH + 16 * pc);
        v4u o; o.x = src[0]; o.y = src[1]; o.z = src[2]; o.w = src[3];
        *(v4u*)(d.WT + (size_t)(d.dr + n) * d.K + d.k0 + 16 * pc) = o; }
    LDS_WAIT(); asm volatile("" ::: "memory");
}
__device__ __forceinline__ void f_convert_rest(Frame& F, int cw, int NCW, int pct0 = 0, int pct1 = 1000) {
    LAS unsigned char* tile = F.lds + FWAVE * 8448;
    constexpr int I0 = (D / 128) * (SGU_FFN / 64), I1 = (SGU_HALF / 128) * (D / 64), IE1 = (D / 128) * (FF / 64), IE2 = (FF / 128) * (D / 64);
    constexpr int IM = 2 * NE * IE1;
    static_assert(IE1 == IE2, "w1 / w2 item counts");
    constexpr int NIT = I0 + I1 + 3 * IM; const int it_lo = (int)((long)NIT * pct0 / 1000), it_hi = (int)((long)NIT * pct1 / 1000);
    const int lane = FLANE;
    for (int it = it_lo + cw; it < it_hi; it += NCW) { const Cv8 d = cv8_decode(F, it); cv8_item(d, tile, lane); }
}

constexpr int SC_K = 0, SC_KSTR = 320;
constexpr int SC_V = 20480, SC_VSTR = 576;
constexpr int SC_Q = 57344, SC_QSTR = 272;
constexpr int SC_O = 74752, SC_OSTR = 528;
constexpr int SC_GL = 108544, SC_PART = 112640, SC_DEC = 114688, SC_WG = 115200;
__device__ __forceinline__ s16x4 tr_read16(LAS const unsigned char* p) {
    typedef short v4i16_t __attribute__((ext_vector_type(4)));
    return __builtin_bit_cast(s16x4, __builtin_amdgcn_ds_read_tr16_b64_v4i16((LAS v4i16_t*)p));
}
__device__ __forceinline__ void f_scan_item(Frame& F, int item) {
    const int b = item / GLA_H, h = item % GLA_H;
    const bf16* qkvr = WSP(bf16, WS_QKVR); const float* glr = WSP(float, WS_GLR); bf16* aout = WSP(bf16, WS_AOUT);
    LAS unsigned char* L = F.lds;
    LAS float* gl = (LAS float*)(L + SC_GL); LAS float* part = (LAS float*)(L + SC_PART); LAS float* dec = (LAS float*)(L + SC_DEC);
    const int tid = FTID, lane = FLANE, w = FWAVE;
    const int r32 = lane & 31, hh = lane >> 5, blk = (lane >> 4) & 1, q4 = (lane & 15) >> 2, p4 = lane & 3;
    const int dk = tid & 127, tg = tid >> 7;
    const int gq = lane >> 4, gcol = lane & 15, gdk = 16 * w + gcol;
    bf16x8 gBh, gBl;
    { unsigned ph[4], pl[4];
#pragma unroll
      for (int j = 0; j < 4; ++j) { const float x0 = gq < 2 ? F.inp(I_GLA_WGU)[(8 * gq + 2 * j) * HK + h * DK + gdk] : 0.f, x1 = gq < 2 ? F.inp(I_GLA_WGU)[(8 * gq + 2 * j + 1) * HK + h * DK + gdk] : 0.f;
          ph[j] = pk2(x0, x1); pl[j] = pk2(x0 - bflo(ph[j]), x1 - bfhi(ph[j])); }
      v4u vh = {ph[0], ph[1], ph[2], ph[3]}, vl = {pl[0], pl[1], pl[2], pl[3]};
      gBh = __builtin_bit_cast(bf16x8, vh); gBl = __builtin_bit_cast(bf16x8, vl); }
    const float gbias = F.inp(I_GLA_BG)[h * DK + gdk];
    __syncthreads();
    f32x16 st[4];
#pragma unroll
    for (int i = 0; i < 4; ++i)
#pragma unroll
        for (int j = 0; j < 16; ++j) st[i][j] = 0.f;
    v4u rk[2], rq[2], rv[4]; f32x4 rg;
    const size_t rowb = (size_t)b * SEQ;
    const unsigned vo_kq = (unsigned)(((tid >> 4) * NQKVR + (tid & 15) * 8) * 2), vo_v = (unsigned)(((tid >> 5) * NQKVR + (tid & 31) * 8) * 2), vo_g = (unsigned)(tid * 16);
    const unsigned lo_k = (unsigned)(SC_K + (tid >> 4) * SC_KSTR + (tid & 15) * 16), lo_q = (unsigned)(SC_Q + (tid >> 4) * SC_QSTR + (tid & 15) * 16), lo_v = (unsigned)(SC_V + (tid >> 5) * SC_VSTR + (tid & 31) * 16);
#define SC_LOAD(c) do { size_t cb_ = (rowb + (size_t)(c) * CHUNK) * NQKVR * 2; asm volatile("" : "+s"(cb_)); const char* gb_ = (const char*)qkvr + cb_ + (size_t)(h * DK * 2); \
        _Pragma("unroll") for (int i = 0; i < 2; ++i) { \
            rk[i] = __builtin_nontemporal_load((const v4u*)(gb_ + (size_t)(HK * 2 + i * 32 * NQKVR * 2) + vo_kq)); rq[i] = __builtin_nontemporal_load((const v4u*)(gb_ + (size_t)(i * 32 * NQKVR * 2) + vo_kq)); } \
        _Pragma("unroll") for (int i = 0; i < 4; ++i) rv[i] = __builtin_nontemporal_load((const v4u*)(gb_ + (size_t)(2 * HK * 2 + h * (DV - DK) * 2 + i * 16 * NQKVR * 2) + vo_v)); \
        if (tid < 256) rg = *(const f32x4*)((const char*)glr + (rowb + (size_t)(c) * CHUNK) * RANK * 4 + vo_g); } while (0)
#define SC_STORE() do { \
        _Pragma("unroll") for (int i = 0; i < 2; ++i) { *(LAS v4u*)(L + lo_k + i * 32 * SC_KSTR) = rk[i]; *(LAS v4u*)(L + lo_q + i * 32 * SC_QSTR) = rq[i]; } \
        _Pragma("unroll") for (int i = 0; i < 4; ++i) *(LAS v4u*)(L + lo_v + i * 16 * SC_VSTR) = rv[i]; \
        if (tid < 256) *(LAS f32x4*)(gl + tid * 4) = rg; } while (0)
    SC_LOAD(0);
    SC_STORE();
    for (int c = 0; c < NCHUNK; ++c) {
        const size_t t0 = rowb + (size_t)c * CHUNK;
        __syncthreads();
        if (c + 1 < NCHUNK) SC_LOAD(c + 1);
        {
            pg8::f32x4 g4[4]; float tsum[4], pre[4];
#pragma unroll
            for (int t = 0; t < 4; ++t) {
                v4u ah = {0u, 0u, 0u, 0u}, al = {0u, 0u, 0u, 0u};
                if (gq < 2) { const f32x4 x0 = *(const LAS f32x4*)(gl + (16 * t + gcol) * 16 + 8 * gq), x1 = *(const LAS f32x4*)(gl + (16 * t + gcol) * 16 + 8 * gq + 4);
                    ah.x = pk2(x0[0], x0[1]); ah.y = pk2(x0[2], x0[3]); ah.z = pk2(x1[0], x1[1]); ah.w = pk2(x1[2], x1[3]);
                    al.x = pk2(x0[0] - bflo(ah.x), x0[1] - bfhi(ah.x)); al.y = pk2(x0[2] - bflo(ah.y), x0[3] - bfhi(ah.y)); al.z = pk2(x1[0] - bflo(ah.z), x1[1] - bfhi(ah.z)); al.w = pk2(x1[2] - bflo(ah.w), x1[3] - bfhi(ah.w)); }
                pg8::f32x4 a4 = {gbias, gbias, gbias, gbias};
                a4 = __builtin_amdgcn_mfma_f32_16x16x32_bf16(__builtin_bit_cast(bf16x8, ah), gBh, a4, 0, 0, 0);
                a4 = __builtin_amdgcn_mfma_f32_16x16x32_bf16(__builtin_bit_cast(bf16x8, al), gBh, a4, 0, 0, 0);
                a4 = __builtin_amdgcn_mfma_f32_16x16x32_bf16(__builtin_bit_cast(bf16x8, ah), gBl, a4, 0, 0, 0);
#pragma unroll
                for (int i = 0; i < 4; ++i) { const float a = a4[i]; a4[i] = (fminf(a, 0.f) - __logf(1.f + __expf(-fabsf(a)))) * (1.f / 16.f); }
                a4[1] += a4[0]; a4[2] += a4[1]; a4[3] += a4[2];
                g4[t] = a4;
                const float s0 = a4[3], x1 = __shfl_xor(s0, 16), x2 = __shfl_xor(s0, 32), x3 = __shfl_xor(x1, 32);
                tsum[t] = (s0 + x1) + (x2 + x3);
                pre[t] = ((gq ^ 1) < gq ? x1 : 0.f) + ((gq ^ 2) < gq ? x2 : 0.f) + ((gq ^ 3) < gq ? x3 : 0.f);
            }
            const float tot = (tsum[0] + tsum[1]) + (tsum[2] + tsum[3]);
            float basep = 0.f;
#pragma unroll
            for (int t = 0; t < 4; ++t) {
#pragma unroll
                for (int i = 0; i < 4; ++i) {
                    LAS unsigned short* kp = (LAS unsigned short*)(L + SC_K + (16 * t + 4 * gq + i) * SC_KSTR + gdk * 2);
                    *kp = (unsigned short)f2bf(bf2f(*kp) * __expf(tot - (basep + pre[t] + g4[t][i])));
                }
                basep += tsum[t];
            }
            if (gq == 0) dec[gdk] = __expf(tot);
        }
        __syncthreads();
        const int etok = tid >> 3, ecc = tid & 7;
        v4u rr[4];
        { size_t eb_ = t0 * NQKVR * 2; asm volatile("" : "+s"(eb_));
          const char* rb_ = (const char*)qkvr + eb_ + (size_t)((2 * HK + HV + h * DV) * 2); const unsigned vo_r = (unsigned)(etok * NQKVR * 2 + ecc * 16);
#pragma unroll
          for (int i = 0; i < 4; ++i) rr[i] = __builtin_nontemporal_load((const v4u*)(rb_ + vo_r + i * 128)); }
#pragma unroll
        for (int i = 0; i < 4; ++i)
#pragma unroll
            for (int g4 = 0; g4 < 4; ++g4) { const f32x4 d4 = *(const LAS f32x4*)(dec + 32 * i + 8 * g4 + 4 * hh);
#pragma unroll
                for (int j = 0; j < 4; ++j) st[i][4 * g4 + j] *= d4[j]; }
#pragma unroll
        for (int s = 0; s < 4; ++s) {
            const int trow = 16 * s + 8 * hh + q4;
            const s16x4 v0 = tr_read16(L + SC_V + trow * SC_VSTR + (32 * w + 16 * blk + 4 * p4) * 2), v1 = tr_read16(L + SC_V + (trow + 4) * SC_VSTR + (32 * w + 16 * blk + 4 * p4) * 2);
            const bf16x8 Bv = {v0[0], v0[1], v0[2], v0[3], v1[0], v1[1], v1[2], v1[3]};
#pragma unroll
            for (int i = 0; i < 4; ++i) {
                const s16x4 k0 = tr_read16(L + SC_K + trow * SC_KSTR + (32 * i + 16 * blk + 4 * p4) * 2), k1 = tr_read16(L + SC_K + (trow + 4) * SC_KSTR + (32 * i + 16 * blk + 4 * p4) * 2);
                const bf16x8 Ak = {k0[0], k0[1], k0[2], k0[3], k1[0], k1[1], k1[2], k1[3]};
                st[i] = __builtin_amdgcn_mfma_f32_32x32x16_bf16(Ak, Bv, st[i], 0, 0, 0);
            }
        }
        {
        f32x16 oacc[2];
#pragma unroll
        for (int ot = 0; ot < 2; ++ot)
#pragma unroll
            for (int j = 0; j < 16; ++j) oacc[ot][j] = 0.f;
#pragma unroll
        for (int i = 0; i < 4; ++i)
#pragma unroll
            for (int s2 = 0; s2 < 2; ++s2) {
                v4u pb; pb.x = pk2(st[i][8 * s2 + 0], st[i][8 * s2 + 1]); pb.y = pk2(st[i][8 * s2 + 2], st[i][8 * s2 + 3]); pb.z = pk2(st[i][8 * s2 + 4], st[i][8 * s2 + 5]); pb.w = pk2(st[i][8 * s2 + 6], st[i][8 * s2 + 7]);
                const bf16x8 Bs = __builtin_bit_cast(bf16x8, pb);
#pragma unroll
                for (int ot = 0; ot < 2; ++ot) {
                    LAS const unsigned char* qp = L + SC_Q + (32 * ot + r32) * SC_QSTR + (32 * i + 16 * s2 + 4 * hh) * 2;
                    const v2u a0 = *(const LAS v2u*)qp, a1 = *(const LAS v2u*)(qp + 16);
                    v4u pa; pa.x = a0.x; pa.y = a0.y; pa.z = a1.x; pa.w = a1.y;
                    oacc[ot] = __builtin_amdgcn_mfma_f32_32x32x16_bf16(__builtin_bit_cast(bf16x8, pa), Bs, oacc[ot], 0, 0, 0);
                }
            }
#pragma unroll
        for (int ot = 0; ot < 2; ++ot)
#pragma unroll
            for (int rg16 = 0; rg16 < 16; ++rg16) {
                const int tok = 32 * ot + (rg16 & 3) + 8 * (rg16 >> 2) + 4 * hh;
                *(LAS unsigned short*)(L + SC_O + tok * SC_OSTR + (32 * w + r32) * 2) = (unsigned short)f2bf(oacc[ot][rg16]);
            }
        }
        __syncthreads();
        if (c + 1 < NCHUNK) SC_STORE();
        if (c > 0 && (c & 3) == 0) {
            asm volatile("s_waitcnt vmcnt(0)" ::: "memory");
            if (lane == 0) __hip_atomic_fetch_add(WSP(unsigned, WS_CTL) + CW_SP + 16 * (8 * b + (c >> 2) - 1), 1u, __ATOMIC_RELAXED, __HIP_MEMORY_SCOPE_AGENT);
        }
        {
        {
            const int tok = etok, cc = ecc;
            v4u ov[4]; float ss = 0.f;
#pragma unroll
            for (int i = 0; i < 4; ++i) ov[i] = *(const LAS v4u*)(L + SC_O + tok * SC_OSTR + cc * 16 + i * 128);
#pragma unroll
            for (int i = 0; i < 4; ++i) { const float a0 = bflo(ov[i].x), a1 = bfhi(ov[i].x), a2 = bflo(ov[i].y), a3 = bfhi(ov[i].y), a4 = bflo(ov[i].z), a5 = bfhi(ov[i].z), a6 = bflo(ov[i].w), a7 = bfhi(ov[i].w);
                ss += (a0 * a0 + a1 * a1) + (a2 * a2 + a3 * a3) + (a4 * a4 + a5 * a5) + (a6 * a6 + a7 * a7); }
            ss += __shfl_xor(ss, 1); ss += __shfl_xor(ss, 2); ss += __shfl_xor(ss, 4);
            const float rms = __builtin_amdgcn_rsqf(ss * (1.f / DV) + EPS);
            size_t ob_ = (t0 * D + h * DV) * 2; asm volatile("" : "+s"(ob_)); const unsigned vo_o = (unsigned)(tok * D * 2 + cc * 16);
            const __amdgpu_buffer_rsrc_t ars = __builtin_amdgcn_make_buffer_rsrc((void*)aout, (short)0, T * D * 2, 0x00020000);
#pragma unroll
            for (int i = 0; i < 4; ++i) {
                v4u o;
                o.x = pk2(bflo(ov[i].x) * rms * bflo(rr[i].x), bfhi(ov[i].x) * rms * bfhi(rr[i].x));
                o.y = pk2(bflo(ov[i].y) * rms * bflo(rr[i].y), bfhi(ov[i].y) * rms * bfhi(rr[i].y));
                o.z = pk2(bflo(ov[i].z) * rms * bflo(rr[i].z), bfhi(ov[i].z) * rms * bfhi(rr[i].z));
                o.w = pk2(bflo(ov[i].w) * rms * bflo(rr[i].w), bfhi(ov[i].w) * rms * bfhi(rr[i].w));
                __builtin_amdgcn_raw_buffer_store_b128(o, ars, (unsigned)ob_ + vo_o + i * 128, 0, 16);
            }
        }
            }
    }
    asm volatile("s_waitcnt vmcnt(0)" ::: "memory");
    if (lane == 0) __hip_atomic_fetch_add(WSP(unsigned, WS_CTL) + CW_SP + 16 * (8 * b + 7), 1u, __ATOMIC_RELAXED, __HIP_MEMORY_SCOPE_AGENT);
    __syncthreads();
#undef SC_LOAD
#undef SC_STORE
}
constexpr int LX_QCMD = LX_PTR - 64;
constexpr int CV_NIT = (D / 128) * (SGU_FFN / 64) + (SGU_HALF / 128) * (D / 64) + 3 * 2 * NE * (D / 128) * (FF / 64);
__device__ __forceinline__ void f_scan_outproj(Frame& F, const XcdBarrier& xbar) {
    constexpr int NITEM = NBATCH * GLA_H, NUNIT = (T / 256) * (D / 256);
    if (F.bid < NITEM) f_scan_item(F, F.bid);
    unsigned* ctl = WSP(unsigned, WS_CTL); LAS int* cmd = (LAS int*)(F.lds + LX_QCMD);
    const int NOWN = F.G - NITEM; int myq = F.bid >= NITEM ? F.bid - NITEM : NUNIT;
    for (;;) {
        __syncthreads();
        if (FTID == 0) {
            int c = -3; unsigned spins = 0;
            for (;;) {
                if (myq < NUNIT) {
                    const int b = (myq & 63) >> 2, j = myq >> 6;
                    if (__hip_atomic_load(ctl + CW_SP + 16 * (8 * b + j), __ATOMIC_RELAXED, __HIP_MEMORY_SCOPE_AGENT) >= 32u) { c = myq; myq += NOWN; break; } }
                if (__hip_atomic_load(ctl + CW_QC, __ATOMIC_RELAXED, __HIP_MEMORY_SCOPE_AGENT) < (unsigned)CV_NIT) {
                    const unsigned it = __hip_atomic_fetch_add(ctl + CW_QC, (unsigned)NWAVES, __ATOMIC_RELAXED, __HIP_MEMORY_SCOPE_AGENT);
                    if (it < (unsigned)CV_NIT) { c = -2; cmd[1] = (int)it; break; } }
                if (myq >= NUNIT) { c = -3; break; }
                __builtin_amdgcn_s_sleep(16); if (++spins > (1u << 22)) { c = -3; break; }
            }
            cmd[0] = c;
        }
        __syncthreads();
        const int c = cmd[0];
        if (c == -3) break;
        if (c == -2) { const int it = cmd[1] + FWAVE; if (it < CV_NIT) { const Cv8 d = cv8_decode(F, it); cv8_item(d, F.lds + FWAVE * 8448, FLANE); } }
        else {
            if (FTID < 64) { __builtin_amdgcn_fence(__ATOMIC_ACQUIRE, "agent"); asm volatile("s_waitcnt vmcnt(0)" ::: "memory"); }
            __syncthreads();
            RowSetOrder S; S.nb = 1 << 20; S.c = c; S.j0 = 0; S.nunits = NUNIT; S.K = HV; S.Bt = (const char*)WSP(bf16, WS_WOUT);
            EpiResBf16 E{WSP(bf16, WS_XN), 1.f};
            pg8::gemm_phase(F.lds, WSP(bf16, WS_AOUT), HV, S, E);
        }
    }
}
constexpr int MX_W = 0, MX_WSTR = 272;
constexpr int MX_V0 = 34816, MX_VSTR = 320, MX_VBYTES = 40960;
constexpr int MX_MU = 116736;
constexpr int MX_LN = MX_MU + 2560;
__device__ __forceinline__ void f_mix(Frame& F) {
    LAS unsigned char* L = F.lds;
    LAS float* mu = (LAS float*)(L + MX_MU); LAS float* rs = mu + 128; LAS float* m1 = rs + 128; LAS float* m0 = m1 + 128; LAS float* bsg = m0 + 128;
    LAS float* lgs = (LAS float*)(L + MX_LN); LAS float* lbs = lgs + 512;
    bf16* u = WSP(bf16, WS_U); const bf16* v = WSP(bf16, WS_V); const float* st = WSP(float, WS_STATS); unsigned char* uout = WSP(unsigned char, WS_UG8);
    const int tid = FTID, lane = FLANE, w = FWAVE;
    const int r32 = lane & 31, hh = lane >> 5, blk = (lane >> 4) & 1, q4 = (lane & 15) >> 2, p4 = lane & 3;
    const int ct = w >> 1, th = w & 1;
    const unsigned vo_v = (unsigned)(tid * 16), lo_v = (unsigned)(MX_V0 + (tid >> 4) * MX_VSTR + (tid & 15) * 16);
    constexpr int MX_MSTR = 272;
    for (int bn = F.bid; bn < T / SGU_BLK; bn += F.G) {
        const size_t t0 = (size_t)bn * SGU_BLK;
        __syncthreads();
        {
            const int row = tid & 127, pq = tid >> 7; float s = 0.f, q = 0.f;
#pragma unroll
            for (int p = 0; p < 8; ++p) { const pg8::f32x2 a = *(const pg8::f32x2*)(st + ((size_t)(pq * 8 + p) * T + t0 + row) * 2); s += a.x; q += a.y; }
            LAS float* red = (LAS float*)(L + MX_V0);
            red[(pq * 128 + row) * 2] = s; red[(pq * 128 + row) * 2 + 1] = q;
            __syncthreads();
            if (tid < 128) { float s4 = 0.f, q4 = 0.f;
#pragma unroll
                for (int p = 0; p < 4; ++p) { s4 += red[(p * 128 + tid) * 2]; q4 += red[(p * 128 + tid) * 2 + 1]; }
                const float m = s4 * (1.f / SGU_HALF); mu[tid] = m; rs[tid] = __builtin_amdgcn_rsqf(fmaxf(q4 * (1.f / SGU_HALF) - m * m, 0.f) + EPS); }
            __syncthreads();
        }
        v4u preA[4], preB[4]; v4u uuA[4], uuB[4];
#define MX_LOAD(pre_, it_) do { size_t vb_ = ((size_t)bn * 16 + (size_t)(it_)) << 15; asm volatile("" : "+s"(vb_)); \
        _Pragma("unroll") for (int i = 0; i < 4; ++i) pre_[i] = *(const v4u*)((const char*)v + vb_ + (size_t)(i * 8192) + vo_v); } while (0)
#define MX_STORE(buf_, pre_) do { _Pragma("unroll") for (int i = 0; i < 4; ++i) *(LAS v4u*)(L + lo_v + (buf_) * MX_VBYTES + 32 * i * MX_VSTR) = pre_[i]; } while (0)
#define MX_ULOAD(uu_, it_) do { size_t ub_ = ((size_t)bn * 16 + (size_t)(it_)) << 15; asm volatile("" : "+s"(ub_)); \
        _Pragma("unroll") for (int i = 0; i < 4; ++i) uu_[i] = *(const v4u*)((const char*)u + ub_ + (size_t)(i * 8192) + vo_v); } while (0)
#define MX_TILE(it_, buf_, uu_) do { \
        f32x16 acc[2]; \
        _Pragma("unroll") for (int tt = 0; tt < 2; ++tt) _Pragma("unroll") for (int j = 0; j < 16; ++j) acc[tt][j] = 0.f; \
        LAS unsigned char* Vb = L + MX_V0 + (buf_) * MX_VBYTES; \
        const int nks = th == 0 ? 4 : 8; \
        for (int ks = 0; ks < nks; ++ks) { \
            const int srow = 16 * ks + 8 * hh + q4; \
            const s16x4 a0 = tr_read16(Vb + srow * MX_VSTR + (32 * ct + 16 * blk + 4 * p4) * 2), a1 = tr_read16(Vb + (srow + 4) * MX_VSTR + (32 * ct + 16 * blk + 4 * p4) * 2); \
            const bf16x8 Av = {a0[0], a0[1], a0[2], a0[3], a1[0], a1[1], a1[2], a1[3]}; \
            _Pragma("unroll") for (int tt = 0; tt < 2; ++tt) { \
                const bf16x8 Bw = *(const LAS bf16x8*)(L + MX_W + (64 * th + 32 * tt + r32) * MX_WSTR + (16 * ks + 8 * hh) * 2); \
                acc[tt] = __builtin_amdgcn_mfma_f32_32x32x16_bf16(Av, Bw, acc[tt], 0, 0, 0); } } \
        const int cl = ((it_) & 3) * 128 + 32 * ct + 4 * hh;                    \
        __syncthreads();                                                         \
        _Pragma("unroll") for (int tt = 0; tt < 2; ++tt) { \
            const int t = 64 * th + 32 * tt + r32; const float tm1 = m1[t], tm0 = m0[t], tb = bsg[t]; \
            _Pragma("unroll") for (int g4 = 0; g4 < 4; ++g4) { \
                const f32x4 lg = *(const LAS f32x4*)(lgs + cl + 8 * g4), lb = *(const LAS f32x4*)(lbs + cl + 8 * g4); \
                v2u o; o.x = pk2(lg[0] * (acc[tt][4 * g4 + 0] - tm1) + lb[0] * tm0 + tb, lg[1] * (acc[tt][4 * g4 + 1] - tm1) + lb[1] * tm0 + tb); \
                o.y = pk2(lg[2] * (acc[tt][4 * g4 + 2] - tm1) + lb[2] * tm0 + tb, lg[3] * (acc[tt][4 * g4 + 3] - tm1) + lb[3] * tm0 + tb); \
                *(LAS v2u*)(Vb + t * MX_MSTR + (32 * ct + 8 * g4 + 4 * hh) * 2) = o; } } \
        __syncthreads();                                                         \
        size_t ob_ = ((size_t)bn * 16 + (size_t)(it_)) << 14; asm volatile("" : "+s"(ob_));     \
        _Pragma("unroll") for (int i = 0; i < 4; ++i) { \
            const v4u mx = *(const LAS v4u*)(Vb + ((tid >> 4) + 32 * i) * MX_MSTR + (tid & 15) * 16); const v4u ux = uu_[i]; v2u o; \
            int w0_ = __builtin_amdgcn_cvt_pk_fp8_f32(bflo(ux.x) * bflo(mx.x), bfhi(ux.x) * bfhi(mx.x), 0, false); w0_ = __builtin_amdgcn_cvt_pk_fp8_f32(bflo(ux.y) * bflo(mx.y), bfhi(ux.y) * bfhi(mx.y), w0_, true); \
            int w1_ = __builtin_amdgcn_cvt_pk_fp8_f32(bflo(ux.z) * bflo(mx.z), bfhi(ux.z) * bfhi(mx.z), 0, false); w1_ = __builtin_amdgcn_cvt_pk_fp8_f32(bflo(ux.w) * bflo(mx.w), bfhi(ux.w) * bfhi(mx.w), w1_, true); \
            o.x = (unsigned)w0_; o.y = (unsigned)w1_; *(v2u*)(uout + ob_ + (size_t)(i * 4096) + (unsigned)(tid * 8)) = o; } } while (0)
        MX_LOAD(preA, 0); MX_LOAD(preB, 1); MX_ULOAD(uuA, 0);
        for (int it = 0; it < 16; it += 2) {
            if ((it & 3) == 0) {
                const int g = it >> 2;
                __syncthreads();
                const int t = tid >> 2, sq = tid & 3; const float* wsrc = F.inp(I_SGU_WS) + ((size_t)g * 128 + t) * 128 + sq * 8;
                float a1 = 0.f, a0 = 0.f;
#pragma unroll
                for (int i = 0; i < 4; ++i) {
                    const f32x4 x0 = *(const f32x4*)(wsrc + i * 32), x1 = *(const f32x4*)(wsrc + i * 32 + 4); float wv[8] = {x0[0], x0[1], x0[2], x0[3], x1[0], x1[1], x1[2], x1[3]}; float hv[8];
#pragma unroll
                    for (int j = 0; j < 8; ++j) { const int s = i * 32 + sq * 8 + j; const float wm = ((t >> 6) >= (s >> 6)) ? wv[j] : 0.f; a0 += wm; hv[j] = wm * rs[s]; }
                    v4u o; o.x = pk2(hv[0], hv[1]); o.y = pk2(hv[2], hv[3]); o.z = pk2(hv[4], hv[5]); o.w = pk2(hv[6], hv[7]);
                    const unsigned ow[4] = {o.x, o.y, o.z, o.w};
#pragma unroll
                    for (int j = 0; j < 4; ++j) a1 += bflo(ow[j]) * mu[i * 32 + sq * 8 + 2 * j] + bfhi(ow[j]) * mu[i * 32 + sq * 8 + 2 * j + 1];
                    *(LAS v4u*)(L + MX_W + t * MX_WSTR + (i * 32 + sq * 8) * 2) = o;
                }
                a1 += __shfl_xor(a1, 1); a1 += __shfl_xor(a1, 2); a0 += __shfl_xor(a0, 1); a0 += __shfl_xor(a0, 2);
                if (sq == 0) { m1[t] = a1; m0[t] = a0; }
                if (tid < 128) bsg[tid] = F.inp(I_SGU_BS)[g * 128 + tid];
                lgs[tid] = F.inp(I_SGU_LNG)[g * SGU_GC + tid]; lbs[tid] = F.inp(I_SGU_LNB)[g * SGU_GC + tid];
            }
            MX_STORE(0, preA);
            __syncthreads();
            if (it + 2 < 16) MX_LOAD(preA, it + 2);
            MX_ULOAD(uuB, it + 1);
            MX_TILE(it, 0, uuA);
            MX_STORE(1, preB);
            __syncthreads();
            if (it + 3 < 16) MX_LOAD(preB, it + 3);
            if (it + 2 < 16) MX_ULOAD(uuA, it + 2);
            MX_TILE(it + 1, 1, uuB);
        }
#undef MX_LOAD
#undef MX_STORE
#undef MX_ULOAD
#undef MX_TILE
    }
}
constexpr int RW_STR = 2064;
constexpr int RW_LG = 48 * RW_STR;
constexpr int RW_HIST = RW_LG + 8 * 16 * 48 * 4;
template <int MODE> __device__ __forceinline__ void f_rowgroup(Frame& F, int Lyr) {
    constexpr int NCT = MODE == 0 ? 1 : 3;
    LAS unsigned char* L = F.lds;
    const int tid = FTID, lane = FLANE, w = FWAVE, rw = lane & 15, q = lane >> 4;
    const float* xsrc = F.inp(I_X);
    bf16* xb = WSP(bf16, WS_XN); float* rsout = WSP(float, WS_RS);
    __syncthreads();
    for (int k = tid; k < D; k += NTHREADS) {
        if (MODE == 0) {
            const float gn = F.inp(I_GLA_NORM)[k]; const float* wr_ = F.inp(I_GLA_WIN) + (size_t)k * GLA_IN + NQKVR;
#pragma unroll
            for (int c4 = 0; c4 < 4; ++c4) { const f32x4 x = *(const f32x4*)(wr_ + 4 * c4);
#pragma unroll
                for (int j = 0; j < 4; ++j) *(LAS unsigned short*)(L + (4 * c4 + j) * RW_STR + k * 2) = (unsigned short)f2bf(x[j] * gn); }
        } else {
            const float gn = F.inp(I_MOE_NORM)[Lyr * D + k];
            const f32x4 xg = *(const f32x4*)(F.inp(I_MOE_WG) + ((size_t)Lyr * D + k) * 4);
#pragma unroll
            for (int j = 0; j < 4; ++j) *(LAS unsigned short*)(L + j * RW_STR + k * 2) = (unsigned short)f2bf(xg[j] * gn);
#pragma unroll
            for (int g = 0; g < 4; ++g) { const float* ws_ = F.inp(I_MOE_WSUB) + (((size_t)Lyr * 4 + g) * D + k) * EPG; const f32x4 a = *(const f32x4*)ws_, b = *(const f32x4*)(ws_ + 4);
#pragma unroll
                for (int j = 0; j < 4; ++j) { *(LAS unsigned short*)(L + (4 + 8 * g + j) * RW_STR + k * 2) = (unsigned short)f2bf(a[j] * gn); *(LAS unsigned short*)(L + (8 + 8 * g + j) * RW_STR + k * 2) = (unsigned short)f2bf(b[j] * gn); } }
#pragma unroll
            for (int c = 36; c < 48; ++c) *(LAS unsigned short*)(L + c * RW_STR + k * 2) = 0;
        }
    }
    LAS int* hist = (LAS int*)(L + RW_HIST); LAS int* hbase = hist + 32;
    if (MODE == 1 && tid < 32) hist[tid] = 0;
    __syncthreads();
    const int ngroups = T / 16, niter = (ngroups + F.G * NWAVES - 1) / (F.G * NWAVES);
    for (int iter = 0; iter < niter; ++iter) {
        const int grp = (iter * F.G + F.bid) * NWAVES + w; const bool valid = grp < ngroups;
        const size_t row = (size_t)grp * 16 + rw;
        float rstd = 0.f; pg8::f32x4 acc[NCT];
        if (valid) {
#pragma unroll
            for (int c = 0; c < NCT; ++c) acc[c] = (pg8::f32x4){0.f, 0.f, 0.f, 0.f};
            float ss = 0.f;
#pragma unroll 8
            for (int s = 0; s < 32; ++s) {
                v4u pa;
                if (MODE == 0) {
                    const float* xr = xsrc + row * D + 8 * q + 32 * s;
                    const f32x4 x0 = __builtin_nontemporal_load((const f32x4*)xr), x1 = __builtin_nontemporal_load((const f32x4*)(xr + 4));
                    ss += (x0[0] * x0[0] + x0[1] * x0[1]) + (x0[2] * x0[2] + x0[3] * x0[3]) + (x1[0] * x1[0] + x1[1] * x1[1]) + (x1[2] * x1[2] + x1[3] * x1[3]);
                    pa.x = pk2(x0[0], x0[1]); pa.y = pk2(x0[2], x0[3]); pa.z = pk2(x1[0], x1[1]); pa.w = pk2(x1[2], x1[3]);
                    *(v4u*)(xb + row * D + 8 * q + 32 * s) = pa;
                } else {
                    pa = *(const v4u*)(xb + row * D + 8 * q + 32 * s);
                    const float a0 = bflo(pa.x), a1 = bfhi(pa.x), a2 = bflo(pa.y), a3 = bfhi(pa.y), a4 = bflo(pa.z), a5 = bfhi(pa.z), a6 = bflo(pa.w), a7 = bfhi(pa.w);
                    ss += (a0 * a0 + a1 * a1) + (a2 * a2 + a3 * a3) + (a4 * a4 + a5 * a5) + (a6 * a6 + a7 * a7);
                    int w0 = __builtin_amdgcn_cvt_pk_fp8_f32(a0, a1, 0, false); w0 = __builtin_amdgcn_cvt_pk_fp8_f32(a2, a3, w0, true);
                    int w1 = __builtin_amdgcn_cvt_pk_fp8_f32(a4, a5, 0, false); w1 = __builtin_amdgcn_cvt_pk_fp8_f32(a6, a7, w1, true);
                    v2u o8; o8.x = (unsigned)w0; o8.y = (unsigned)w1; *(v2u*)(WSP(unsigned char, WS_XB8) + row * D + 8 * q + 32 * s) = o8;
                }
                const bf16x8 A = __builtin_bit_cast(bf16x8, pa);
#pragma unroll
                for (int c = 0; c < NCT; ++c) { const bf16x8 B = *(const LAS bf16x8*)(L + (16 * c + rw) * RW_STR + (32 * s + 8 * q) * 2); acc[c] = __builtin_amdgcn_mfma_f32_16x16x32_bf16(A, B, acc[c], 0, 0, 0); }
            }
            ss += __shfl_xor(ss, 16); ss += __shfl_xor(ss, 32);
            rstd = __builtin_amdgcn_rsqf(ss * (1.f / D) + EPS);
            if (q == 0) rsout[row] = rstd;
        }
        float rs4[4];
#pragma unroll
        for (int i = 0; i < 4; ++i) rs4[i] = __shfl(rstd, 4 * q + i);
        int e1 = 0, e2 = 0, rk1 = 0, rk2 = 0; float gt1 = 0.f, gt2 = 0.f;
        if (MODE == 0) {
            if (valid) {
                float* glr = WSP(float, WS_GLR);
#pragma unroll
                for (int i = 0; i < 4; ++i) glr[((size_t)grp * 16 + 4 * q + i) * RANK + rw] = acc[0][i] * rs4[i];
            }
        } else {
            LAS float* lgw = (LAS float*)(L + RW_LG) + w * 16 * 48;
            if (valid) {
#pragma unroll
                for (int c = 0; c < NCT; ++c)
#pragma unroll
                    for (int i = 0; i < 4; ++i) lgw[(4 * q + i) * 48 + 16 * c + rw] = acc[c][i] * rs4[i];
            }
            LDS_WAIT(); asm volatile("" ::: "memory");
            if (valid && lane < 16) {
                const LAS float* lr = lgw + lane * 48; const float* bg = F.inp(I_MOE_BG) + Lyr * 4;
                float lg[4];
#pragma unroll
                for (int c = 0; c < 4; ++c) lg[c] = lr[c] + bg[c];
                int g = 0; float gm = lg[0];
#pragma unroll
                for (int c = 1; c < 4; ++c) if (lg[c] > gm) { gm = lg[c]; g = c; }
                float gs = 0.f;
#pragma unroll
                for (int c = 0; c < 4; ++c) gs += __expf(lg[c] - gm);
                const float g_w = 1.f / gs; const float* bs = F.inp(I_MOE_BSUB) + (Lyr * 4 + g) * EPG;
                int i1 = 0, i2 = 0; float m1v = -3.0e38f, m2v = -3.0e38f;
                for (int e = 0; e < EPG; ++e) { const float x = lr[4 + 8 * g + e] + bs[e];
                    if (x > m1v) { m2v = m1v; i2 = i1; m1v = x; i1 = e; } else if (x > m2v) { m2v = x; i2 = e; } }
                const float w1 = 1.f / (1.f + __expf(m2v - m1v));
                e1 = g * EPG + i1; e2 = g * EPG + i2; gt1 = g_w * w1; gt2 = g_w * (1.f - w1);
                rk1 = __hip_atomic_fetch_add(&hist[e1], 1, __ATOMIC_RELAXED, __HIP_MEMORY_SCOPE_WORKGROUP); rk2 = __hip_atomic_fetch_add(&hist[e2], 1, __ATOMIC_RELAXED, __HIP_MEMORY_SCOPE_WORKGROUP);
            }
            __syncthreads();
            if (tid < 32) { const int hcount = hist[tid]; hbase[tid] = hcount ? (int)atomicAdd(WSP(unsigned, WS_CTL) + CW_CNT + Lyr * 2048 + 64 * tid, (unsigned)hcount) : 0; hist[tid] = 0; }
            __syncthreads();
            if (valid && lane < 16) {
                const int tok = grp * 16 + lane; const int p1 = hbase[e1] + rk1, p2 = hbase[e2] + rk2;
                WSP(int, WS_LIST)[(size_t)e1 * T + p1] = tok * 2; WSP(int, WS_LIST)[(size_t)e2 * T + p2] = tok * 2 + 1;
                WSP(float, WS_GATE)[tok * 2] = gt1; WSP(float, WS_GATE)[tok * 2 + 1] = gt2;
            }
        }
    }
    __syncthreads();
}
template <bool FINAL> __device__ __forceinline__ void f_rowadd(Frame& F) {
    bf16* xb = WSP(bf16, WS_XN); const unsigned char* y = WSP(unsigned char, WS_Y); float* rsout = WSP(float, WS_RS); bf16* xo = xb;
    const int lane = FLANE, w = FWAVE;
    f32x4 gf[4];
    if (FINAL) {
#pragma unroll
        for (int j = 0; j < 2; ++j) { gf[2 * j] = *(const f32x4*)(F.inp(I_FINAL) + 8 * lane + 512 * j); gf[2 * j + 1] = *(const f32x4*)(F.inp(I_FINAL) + 8 * lane + 512 * j + 4); }
    }
    for (int r0 = (F.bid * NWAVES + w) * 2; r0 < T; r0 += F.G * NWAVES * 2) {
        v4u xa[2][2]; v2u ya[2][2], yb[2][2];
#pragma unroll
        for (int rr = 0; rr < 2; ++rr)
#pragma unroll
            for (int j = 0; j < 2; ++j) { const size_t o = (size_t)(r0 + rr) * D + 8 * lane + 512 * j;
                xa[rr][j] = *(const v4u*)(xb + o); ya[rr][j] = *(const v2u*)(y + o); yb[rr][j] = *(const v2u*)(y + (size_t)T * D + o); }
#pragma unroll
        for (int rr = 0; rr < 2; ++rr) {
            float v[16]; float ss = 0.f;
#pragma unroll
            for (int j = 0; j < 2; ++j) {
                const unsigned xw[4] = {xa[rr][j].x, xa[rr][j].y, xa[rr][j].z, xa[rr][j].w};
                const pg8::f32x2 a0 = __builtin_amdgcn_cvt_pk_f32_fp8((int)ya[rr][j].x, false), a1 = __builtin_amdgcn_cvt_pk_f32_fp8((int)ya[rr][j].x, true), a2 = __builtin_amdgcn_cvt_pk_f32_fp8((int)ya[rr][j].y, false), a3 = __builtin_amdgcn_cvt_pk_f32_fp8((int)ya[rr][j].y, true);
                const pg8::f32x2 b0 = __builtin_amdgcn_cvt_pk_f32_fp8((int)yb[rr][j].x, false), b1 = __builtin_amdgcn_cvt_pk_f32_fp8((int)yb[rr][j].x, true), b2 = __builtin_amdgcn_cvt_pk_f32_fp8((int)yb[rr][j].y, false), b3 = __builtin_amdgcn_cvt_pk_f32_fp8((int)yb[rr][j].y, true);
                const float ysum[8] = {a0.x + b0.x, a0.y + b0.y, a1.x + b1.x, a1.y + b1.y, a2.x + b2.x, a2.y + b2.y, a3.x + b3.x, a3.y + b3.y};
#pragma unroll
                for (int e = 0; e < 4; ++e) { const float lo = bflo(xw[e]) + ysum[2 * e], hi = bfhi(xw[e]) + ysum[2 * e + 1]; v[8 * j + 2 * e] = lo; v[8 * j + 2 * e + 1] = hi; ss += lo * lo + hi * hi; }
            }
            const float rstd = __builtin_amdgcn_rsqf(wave_sum(ss) * (1.f / D) + EPS);
            const size_t ro = (size_t)(r0 + rr) * D + 8 * lane;
            if (FINAL) {
#pragma unroll
                for (int j = 0; j < 2; ++j) {
                    f32x4 o0 = {v[8 * j] * rstd, v[8 * j + 1] * rstd, v[8 * j + 2] * rstd, v[8 * j + 3] * rstd}, o1 = {v[8 * j + 4] * rstd, v[8 * j + 5] * rstd, v[8 * j + 6] * rstd, v[8 * j + 7] * rstd};
                    __builtin_nontemporal_store(o0 * gf[2 * j], (f32x4*)(F.out + ro + 512 * j)); __builtin_nontemporal_store(o1 * gf[2 * j + 1], (f32x4*)(F.out + ro + 512 * j + 4)); }
            } else {
#pragma unroll
                for (int j = 0; j < 2; ++j) { v4u o; o.x = pk2(v[8 * j], v[8 * j + 1]); o.y = pk2(v[8 * j + 2], v[8 * j + 3]); o.z = pk2(v[8 * j + 4], v[8 * j + 5]); o.w = pk2(v[8 * j + 6], v[8 * j + 7]); *(v4u*)(xo + ro + 512 * j) = o;
                    int w0 = __builtin_amdgcn_cvt_pk_fp8_f32(v[8 * j], v[8 * j + 1], 0, false); w0 = __builtin_amdgcn_cvt_pk_fp8_f32(v[8 * j + 2], v[8 * j + 3], w0, true);
                    int w1 = __builtin_amdgcn_cvt_pk_fp8_f32(v[8 * j + 4], v[8 * j + 5], 0, false); w1 = __builtin_amdgcn_cvt_pk_fp8_f32(v[8 * j + 6], v[8 * j + 7], w1, true);
                    v2u o8; o8.x = (unsigned)w0; o8.y = (unsigned)w1; *(v2u*)(WSP(unsigned char, WS_XB8) + ro + 512 * j) = o8; }
                if (lane == 0) rsout[r0 + rr] = rstd;
            }
        }
    }
}
__device__ __forceinline__ void f_prep0(Frame& F) { f_convert_gla(F); f_rowgroup<0>(F, 0); }
__device__ __forceinline__ void f_rowpass_router(Frame& F, int L) { f_rowgroup<1>(F, L); }
__device__ __forceinline__ void f_rowpass_add(Frame& F) { f_rowadd<false>(F); }
__device__ __forceinline__ void f_final(Frame& F) { f_rowadd<true>(F); }
constexpr int LDS_BYTES = 155648;
struct Args { const float* in[23]; float* out; unsigned char* ws; int ph_lo, ph_hi; };

__global__ void __launch_bounds__(NTHREADS, 2) fwd(Args args) {
    extern __shared__ __attribute__((aligned(16))) unsigned char lds_raw[];
    Frame F;
    F.lds = (LAS unsigned char*)lds_raw;
    F.G = gridDim.x; F.bid = blockIdx.x;
    F.out = args.out; F.ws = args.ws;
    volatile LAS unsigned* bst = (volatile LAS unsigned*)(F.lds + LX_PTR + 192);
    if (FTID == 0) {
        LAS unsigned long long* pt = (LAS unsigned long long*)(F.lds + LX_PTR);
#pragma unroll
        for (int i = 0; i < 23; ++i) pt[i] = (unsigned long long)args.in[i];
    }
    if (FTID < 2) bst[FTID] = 0u;
    __syncthreads();
    cg::grid_group grid = cg::this_grid();
    const XcdBarrier xbar = xcd_barrier_post(WSP(unsigned, WS_CTL) + CW_BAR, bst);
    const int lo = args.ph_lo, hi = args.ph_hi;
    if (lo > 1000) grid.sync();
#define IN(k) (lo <= (k) && (k) < hi)
#define SEAM() xcd_barrier(xbar)

    if (IN(0)) f_prep0(F);                 SEAM();
    if (IN(1)) f_gemm_in(F);               SEAM();
    if (IN(2)) f_scan_outproj(F, xbar);    SEAM();
    if (IN(3)) f_rowpass_router(F, 0);     SEAM();
    if (IN(4)) f_moe(F, 0);                SEAM();
    if (IN(5)) f_rowpass_add(F);           SEAM();
    if (IN(6)) f_gemm_sgu_in(F);           SEAM();
    if (IN(7)) f_mix(F);                   SEAM();
    if (IN(8)) f_gemm_sgu_out(F);          SEAM();
    if (IN(9)) f_rowpass_router(F, 1);     SEAM();
    if (IN(10)) f_moe(F, 1);               SEAM();
    if (IN(11)) f_final(F);
#undef IN
#undef SEAM
}

extern "C" void kernel_launch(void* const* d_in, const int* in_sizes, int n_in, void* d_out, int out_size, void* d_ws, size_t ws_size, hipStream_t stream) {
    static int grid = 0;
    if (grid == 0) {
        if (n_in != 23 || out_size != T * D || in_sizes[0] != T * D || ws_size < WS_END) { fprintf(stderr, "kernel_launch: unexpected shapes (n_in %d out %d ws %zu): nothing launched\n", n_in, out_size, ws_size); grid = -1; return; }
        int dev = 0, cus = 0, per_cu = 0;
        if (hipGetDevice(&dev) != hipSuccess || hipDeviceGetAttribute(&cus, hipDeviceAttributeMultiprocessorCount, dev) != hipSuccess) { grid = -1; return; }
        if (hipFuncSetAttribute((const void*)fwd, hipFuncAttributeMaxDynamicSharedMemorySize, LDS_BYTES) != hipSuccess) { fprintf(stderr, "kernel_launch: cannot get %d bytes of dynamic LDS\n", LDS_BYTES); grid = -1; return; }
        if (hipOccupancyMaxActiveBlocksPerMultiprocessor(&per_cu, (const void*)fwd, NTHREADS, LDS_BYTES) != hipSuccess || per_cu < 1) { fprintf(stderr, "kernel_launch: occupancy query admits %d workgroups per CU: nothing launched\n", per_cu); grid = -1; (void)hipGetLastError(); return; }
        grid = cus;
        if (grid < 128) { fprintf(stderr, "kernel_launch: %d CUs; this kernel's phase program needs at least 128 workgroups\n", grid); grid = -1; return; }
    }
    if (grid < 0) return;
    (void)hipMemsetAsync((char*)d_ws + WS_CTL, 0, CTL_ZERO_BYTES, stream);
    Args a{};
    for (int i = 0; i < 23; ++i) a.in[i] = (const float*)d_in[i];
    a.out = (float*)d_out; a.ws = (unsigned char*)d_ws; a.ph_lo = 0; a.ph_hi = 12;
    void* kargs[] = {&a};
    const hipError_t e = hipLaunchCooperativeKernel((const void*)fwd, dim3(grid), dim3(NTHREADS), kargs, LDS_BYTES, stream);
    if (e != hipSuccess) fprintf(stderr, "cooperative launch failed: %s (grid %d)\n", hipGetErrorString(e), grid);
}
```

```cpp
#include <hip/hip_runtime.h>
#include <hip/hip_cooperative_groups.h>
#include <cstdio>
#include <cstdint>
namespace cg = cooperative_groups;


constexpr int T = 32768, D = 1024, NBATCH = 16, SEQ = 2048;
constexpr int GLA_H = 4, DK = 128, DV = 256, HK = 512, HV = 1024, RANK = 16, GLA_IN = 3088, NQKVR = 3072, CHUNK = 64, NCHUNK = 32;
constexpr int SGU_FFN = 4096, SGU_HALF = 2048, SGU_BLK = 128, SGU_GC = 512;
constexpr int NE = 32, EPG = 8, FF = 512;
constexpr float EPS = 1e-6f;
constexpr int NTHREADS = 512, NWAVES = 8;

constexpr size_t MiB = 1u << 20;
constexpr size_t WS_CTL = 0, CTL_ZERO_BYTES = 128 * 1024;
constexpr size_t WS_GLR = 1 * MiB;
constexpr size_t WS_GATE = 3 * MiB;
constexpr size_t WS_STATS = 4 * MiB;
constexpr size_t WS_LIST = 12 * MiB;
constexpr size_t WS_WIN = 16 * MiB;
constexpr size_t WS_WOUT = 22 * MiB;
constexpr size_t WS_WSIN = 24 * MiB;
constexpr size_t WS_WSOUT = 32 * MiB;
constexpr size_t WS_UG8 = 100 * MiB;
constexpr size_t WS_W13 = 36 * MiB;
constexpr size_t WS_W2 = 164 * MiB;
constexpr float MOE_WSCALE = 32.f;
constexpr size_t WS_XN = 228 * MiB;
constexpr size_t WS_AOUT = 484 * MiB;
constexpr size_t WS_RS = 3 * MiB + 256 * 1024;
constexpr size_t WS_QKVR = 292 * MiB;
constexpr size_t WS_HID = 292 * MiB;
constexpr size_t WS_XB8 = 100 * MiB;
constexpr size_t WS_Y = 364 * MiB;
constexpr size_t WS_U = 292 * MiB;
constexpr size_t WS_V = 420 * MiB;
constexpr size_t WS_END = 548 * MiB;
constexpr int CW_BAR = 1024;
constexpr int CW_HID = 16384;
constexpr int CW_SP = 12288;
constexpr int CW_QU = 14400, CW_QC = 14464;
constexpr int CW_CNT = 8192;

#define GAS __attribute__((address_space(1)))
#define LAS __attribute__((address_space(3)))
typedef unsigned short bf16;
typedef unsigned v4u __attribute__((ext_vector_type(4)));
typedef unsigned v2u __attribute__((ext_vector_type(2)));
typedef float f32x4 __attribute__((ext_vector_type(4)));
typedef float f32x16 __attribute__((ext_vector_type(16)));
typedef short bf16x8 __attribute__((ext_vector_type(8)));
typedef short s16x4 __attribute__((ext_vector_type(4)));
#define LDS_WAIT() asm volatile("s_waitcnt lgkmcnt(0)" ::: "memory")
#define VM_WAIT() asm volatile("s_waitcnt vmcnt(0)" ::: "memory")
typedef float f32x2_t __attribute__((ext_vector_type(2))); typedef __bf16 bf16x2_t __attribute__((ext_vector_type(2)));
__device__ __forceinline__ unsigned pk2(float lo, float hi) { f32x2_t v = {lo, hi}; bf16x2_t b = __builtin_convertvector(v, bf16x2_t); return __builtin_bit_cast(unsigned, b); }
__device__ __forceinline__ unsigned f2bf(float f) { return pk2(f, 0.f) & 0xffffu; }
__device__ __forceinline__ float bf2f(unsigned short b) { return __builtin_bit_cast(float, (unsigned)b << 16); }
__device__ __forceinline__ float bflo(unsigned w) { return __builtin_bit_cast(float, w << 16); }
__device__ __forceinline__ float bfhi(unsigned w) { return __builtin_bit_cast(float, w & 0xffff0000u); }
__device__ __forceinline__ float wave_sum(float v) {
#pragma unroll
    for (int o = 1; o < 64; o <<= 1) v += __shfl_xor(v, o);
    return v;
}
__device__ __forceinline__ float silu_f(float x) { return x * __builtin_amdgcn_rcpf(1.f + __expf(-x)); }
namespace pg8 {
#define PG8_LAS __attribute__((address_space(3)))
typedef unsigned short bf16_t;
typedef short bf16x8 __attribute__((ext_vector_type(8)));
typedef float f32x4 __attribute__((ext_vector_type(4)));
typedef unsigned u32x4 __attribute__((ext_vector_type(4)));
constexpr int BM = 256, BK = 64, HALF = 128, HTB = HALF * BK * 2  , STAGE_BYTES = 8 * HTB, NXCD = 8, WGM = 2;

__host__ __device__ __forceinline__ int lds_byte(int r, int c) { const int st = (r >> 4) * 2 + (c >> 5), rr = r & 15, cc = c & 31, ob = rr * 64 + cc * 2; return st * 1024 + (ob ^ (((ob >> 9) & 1) << 5)); }
__host__ __device__ __forceinline__ void stage_rc(int b, int& R, int& C) { const int st = b / 1024, sb = b % 1024, swz = sb ^ (((sb >> 9) & 1) << 5); R = (st >> 1) * 16 + swz / 64; C = (st & 1) * 32 + (swz % 64) / 2; }
__host__ __device__ __forceinline__ int perm32(int rho) { const int n = rho >> 4, i = rho & 15; return 8 * (i >> 2) + 4 * n + (i & 3); }

struct Unit { int pm, pn, e, slot; };

struct DenseOrder {
    static constexpr bool GATHER = false;
    int nM, nN, nwg, G, c, K; const char* Bt;
    __device__ void init(int M, int N, int K_, const bf16_t* Bt_, int G_, int c_) { nM = M / BM; nN = N / BM; nwg = nM * nN; G = G_; c = c_; K = K_; Bt = (const char*)Bt_; }
    __device__ __forceinline__ bool next(int i, Unit& u) const {
        const long L = (long)i * G + c; if (L >= nwg) return false;
        int wgid = (int)L; { const int q = nwg / NXCD, r = nwg % NXCD, xcd = wgid % NXCD, off = wgid / NXCD; wgid = (xcd < r ? xcd * (q + 1) : r * (q + 1) + (xcd - r) * q) + off; }
        const int nig = WGM * nN, gid = wgid / nig, fm = gid * WGM, gsz = (nM - fm) < WGM ? (nM - fm) : WGM;
        u.pm = fm + ((wgid % nig) % gsz); u.pn = (wgid % nig) / gsz; u.e = 0; u.slot = 0; return true;
    }
    __device__ __forceinline__ const char* bptr(const Unit& u) const { return Bt + (size_t)u.pn * BM * K * 2; }
    __device__ __forceinline__ size_t abase(const Unit& u) const { return (size_t)u.pm * BM * K * 2; }
    __device__ __forceinline__ int a_rowstride(int dflt) const { return dflt; }
    __device__ __forceinline__ size_t a_hstep(size_t dflt) const { return dflt; }
    __device__ __forceinline__ size_t a_koff(int kt) const { return (size_t)kt * 128; }
    __device__ __forceinline__ unsigned aoff(const Unit& u, int h, int R, int C) const { return (unsigned)(((u.pm * BM + h * HALF + R) * K + C) * 2); }
    __device__ __forceinline__ void a_ready(const Unit&) const {}
    __device__ __forceinline__ void done(const Unit&) const {}
};

__device__ __forceinline__ unsigned cvt_pk_bf16(float lo, float hi) { unsigned r; asm volatile("v_cvt_pk_bf16_f32 %0, %1, %2" : "=v"(r) : "v"(lo), "v"(hi)); return r; }
typedef float f32x2 __attribute__((ext_vector_type(2)));
__device__ __forceinline__ f32x2 gelu_pk(f32x2 v) {
    f32x2 xc; xc.x = __builtin_amdgcn_fmed3f(v.x, -5.f, 5.f); xc.y = __builtin_amdgcn_fmed3f(v.y, -5.f, 5.f);
    const f32x2 u = (xc * xc) * 0.08f + (-1.0f);
    f32x2 p = u * (-1.096248219e-03f) + 3.194360377e-03f;
    p = p * u + (-3.887098463e-03f); p = p * u + 5.113467309e-03f; p = p * u + (-1.016528703e-02f); p = p * u + 1.690999552e-02f; p = p * u + (-2.362500388e-02f);
    p = p * u + 3.135676375e-02f; p = p * u + (-4.039197823e-02f); p = p * u + 5.152539331e-02f; p = p * u + (-7.029823295e-02f); p = p * u + 1.413637479e-01f;
    return v * (xc * p + 0.5f);
}

#define PG8_SB0 __builtin_amdgcn_sched_barrier(0)
__device__ __forceinline__ void gelu_pk4(f32x2& a, f32x2& b, f32x2& c, f32x2& d) {
    f32x2 xa, xb, xc, xd;
    xa.x = __builtin_amdgcn_fmed3f(a.x, -5.f, 5.f); xa.y = __builtin_amdgcn_fmed3f(a.y, -5.f, 5.f); xb.x = __builtin_amdgcn_fmed3f(b.x, -5.f, 5.f); xb.y = __builtin_amdgcn_fmed3f(b.y, -5.f, 5.f);
    xc.x = __builtin_amdgcn_fmed3f(c.x, -5.f, 5.f); xc.y = __builtin_amdgcn_fmed3f(c.y, -5.f, 5.f); xd.x = __builtin_amdgcn_fmed3f(d.x, -5.f, 5.f); xd.y = __builtin_amdgcn_fmed3f(d.y, -5.f, 5.f);
    f32x2 ua = xa * xa, ub = xb * xb, uc = xc * xc, ud = xd * xd; PG8_SB0;
    ua = ua * 0.08f + (-1.0f); ub = ub * 0.08f + (-1.0f); uc = uc * 0.08f + (-1.0f); ud = ud * 0.08f + (-1.0f); PG8_SB0;
    f32x2 pa = ua * (-1.096248219e-03f) + 3.194360377e-03f, pb = ub * (-1.096248219e-03f) + 3.194360377e-03f, pc = uc * (-1.096248219e-03f) + 3.194360377e-03f, pd = ud * (-1.096248219e-03f) + 3.194360377e-03f; PG8_SB0;
#define PG8_H4(k) pa = pa * ua + (k); pb = pb * ub + (k); pc = pc * uc + (k); pd = pd * ud + (k); PG8_SB0
    PG8_H4(-3.887098463e-03f); PG8_H4(5.113467309e-03f); PG8_H4(-1.016528703e-02f); PG8_H4(1.690999552e-02f); PG8_H4(-2.362500388e-02f);
    PG8_H4(3.135676375e-02f); PG8_H4(-4.039197823e-02f); PG8_H4(5.152539331e-02f); PG8_H4(-7.029823295e-02f); PG8_H4(1.413637479e-01f);
#undef PG8_H4
    pa = xa * pa + 0.5f; pb = xb * pb + 0.5f; pc = xc * pc + 0.5f; pd = xd * pd + 0.5f; PG8_SB0;
    a = a * pa; b = b * pb; c = c * pc; d = d * pd;
}

typedef int v8i __attribute__((ext_vector_type(8)));
typedef int v4i __attribute__((ext_vector_type(4)));
template <int ES, class Epi, class Sched>
__device__ __forceinline__ void gemm_phase_es(PG8_LAS unsigned char* lds, const void* Abase, const int K, const Sched& S, const Epi& E) {
    const int tid = threadIdx.x, wid = __builtin_amdgcn_readfirstlane(tid >> 6), lane = tid & 63, wr = wid >> 2, wc = wid & 3, fr = lane & 15, fq = lane >> 4;
    const int nt = K * ES / 128;
    int sR[2], sC[2]; unsigned voffA[2], voffB[2];
#pragma unroll
    for (int i = 0; i < 2; ++i) { stage_rc(tid * 16 + i * 8192, sR[i], sC[i]); const int Rb = Epi::PERM ? ((sR[i] & ~31) + perm32(sR[i] & 31)) : sR[i];
        voffA[i] = (unsigned)(sR[i] * S.a_rowstride(K * ES) + sC[i] * 2); voffB[i] = (unsigned)(Rb * K * ES + sC[i] * 2); }
    const size_t kstep = (size_t)(BK * 2);
    const size_t hstep = (size_t)HALF * K * ES;
    const size_t hstepA = S.a_hstep(hstep);
    const unsigned ldsw = (unsigned)wid * 1024u;
    const int aoff = lds_byte(wr * 64 + fr, fq * (ES == 2 ? 8 : 16)), boff = lds_byte(wc * 32 + fr, fq * (ES == 2 ? 8 : 16));
    const char* const Ab = (const char*)Abase;
#define PG8_SA(b, h) (((b) * 2 + (h)) * HTB)
#define PG8_SB(b, h) ((4 + (b) * 2 + (h)) * HTB)
#define PG8_STAGE(bufoff, gbase, voff) do { _Pragma("unroll") for (int _i = 0; _i < 2; ++_i) \
        __builtin_amdgcn_global_load_lds((const unsigned*)((const char*)(gbase) + (voff)[_i]), (PG8_LAS unsigned*)(lds + (bufoff) + ldsw + _i * 8192), 16, 0, 0); } while (0)
#define PG8_STAGE_A(bufoff, nx, h, kt) do { if constexpr (Sched::GATHER) { PG8_STAGE(bufoff, Ab + (size_t)(kt) * kstep, gc[h]); } \
        else PG8_STAGE(bufoff, ((nx) ? xA : cA) + (size_t)(h) * hstepA + S.a_koff(kt), voffA); } while (0)
#define PG8_LDA(dst, b, h) do { if constexpr (ES == 2) { _Pragma("unroll") for (int m = 0; m < 4; ++m) _Pragma("unroll") for (int k = 0; k < 2; ++k) dst[m][k] = *(const PG8_LAS bf16x8*)(lds + PG8_SA(b, h) + aoff + m * 2048 + k * 1024); } \
        else { _Pragma("unroll") for (int m = 0; m < 4; ++m) { const v4i lo_ = *(const PG8_LAS v4i*)(lds + PG8_SA(b, h) + aoff + m * 2048), hi_ = *(const PG8_LAS v4i*)(lds + PG8_SA(b, h) + aoff + m * 2048 + 16); dst##8[m] = __builtin_shufflevector(lo_, hi_, 0, 1, 2, 3, 4, 5, 6, 7); } } } while (0)
#define PG8_LDB(dst, b, h) do { if constexpr (ES == 2) { _Pragma("unroll") for (int n = 0; n < 2; ++n) _Pragma("unroll") for (int k = 0; k < 2; ++k) dst[n][k] = *(const PG8_LAS bf16x8*)(lds + PG8_SB(b, h) + boff + n * 2048 + k * 1024); } \
        else { _Pragma("unroll") for (int n = 0; n < 2; ++n) { const v4i lo_ = *(const PG8_LAS v4i*)(lds + PG8_SB(b, h) + boff + n * 2048), hi_ = *(const PG8_LAS v4i*)(lds + PG8_SB(b, h) + boff + n * 2048 + 16); dst##8[n] = __builtin_shufflevector(lo_, hi_, 0, 1, 2, 3, 4, 5, 6, 7); } } } while (0)
#define PG8_MMA(ai, bj, At, Bt) do { __builtin_amdgcn_s_setprio(1); if constexpr (ES == 2) { _Pragma("unroll") for (int m = 0; m < 4; ++m) _Pragma("unroll") for (int n = 0; n < 2; ++n) _Pragma("unroll") for (int k = 0; k < 2; ++k) \
        acc[ai][bj][m][n] = __builtin_amdgcn_mfma_f32_16x16x32_bf16(Bt[n][k], At[m][k], acc[ai][bj][m][n], 0, 0, 0); } \
        else { _Pragma("unroll") for (int m = 0; m < 4; ++m) _Pragma("unroll") for (int n = 0; n < 2; ++n) \
        asm volatile("s_nop 1\n\tv_mfma_f32_16x16x128_f8f6f4 %0, %1, %2, %0" : "+v"(acc[ai][bj][m][n]) : "v"(Bt##8[n]), "v"(At##8[m])); }   \
        __builtin_amdgcn_s_setprio(0); } while (0)
#define PG8_WAIT_V(n) asm volatile("s_waitcnt vmcnt(" #n ")" ::: "memory")
#define PG8_WAIT_L(n) asm volatile("s_waitcnt lgkmcnt(" #n ")" ::: "memory")
#define PG8_BAR __builtin_amdgcn_s_barrier()
#define PG8_SCHED __builtin_amdgcn_sched_barrier(0)
    Unit cur, nxt, prv; int ui = 0; bool have_prv = false;
    if (!S.next(0, cur)) return;
    f32x4 acc[2][2][4][2];
#pragma unroll
    for (int a = 0; a < 2; ++a)
#pragma unroll
        for (int b = 0; b < 2; ++b)
#pragma unroll
            for (int m = 0; m < 4; ++m)
#pragma unroll
                for (int n = 0; n < 2; ++n) acc[a][b][m][n] = (f32x4){0.f, 0.f, 0.f, 0.f};
    bf16x8 At[4][2], B0[2][2], B1[2][2]; v8i At8[4], B08[2], B18[2];
    unsigned gc[2][2];
    const char* cA = Ab; const char* xA = Ab;
    if constexpr (Sched::GATHER) {
#pragma unroll
        for (int h = 0; h < 2; ++h)
#pragma unroll
            for (int i = 0; i < 2; ++i) gc[h][i] = S.aoff(cur, h, sR[i], sC[i]);
    } else { cA = Ab + S.abase(cur); xA = cA; }
    const char* cB = S.bptr(cur);
    S.a_ready(cur);
    if constexpr (Epi::RS_DMA) { if (wid == 0) __builtin_amdgcn_global_load_lds((const unsigned*)((const char*)E.rs + (size_t)cur.pm * 1024 + lane * 16), (PG8_LAS unsigned*)(lds + STAGE_BYTES + 512), 16, 0, 0); }
    PG8_STAGE(PG8_SB(0, 0), cB, voffB); PG8_STAGE(PG8_SB(0, 1), cB + hstep, voffB); PG8_STAGE_A(PG8_SA(0, 0), false, 0, 0); PG8_STAGE_A(PG8_SA(0, 1), false, 1, 0);
    if (wr == 1) PG8_BAR;
    PG8_WAIT_V(2); PG8_BAR;
    PG8_STAGE(PG8_SB(1, 0), cB + kstep, voffB); PG8_STAGE_A(PG8_SA(1, 0), false, 0, 1); PG8_STAGE(PG8_SB(1, 1), cB + hstep + kstep, voffB);
    PG8_WAIT_V(6); PG8_BAR;
    for (;;) {
        const bool has_next = S.next(ui + 1, nxt);
        const char* nB = has_next ? S.bptr(nxt) : cB;
        if constexpr (Epi::RS_DMA) { if (has_next && wid == 0) __builtin_amdgcn_global_load_lds((const unsigned*)((const char*)E.rs + (size_t)nxt.pm * 1024 + lane * 16), (PG8_LAS unsigned*)(lds + STAGE_BYTES + 512 + ((ui + 1) % 3) * 1024), 16, 0, 0); }
        for (int t = 0; t < nt; t += 2) {
            const bool last = (t == nt - 2);
            const int kt2 = last ? 0 : t + 2;
            const char* b2 = last ? nB : cB + (size_t)(t + 2) * kstep; const char* b3 = b2 + kstep;
            if (last && has_next) {
                if constexpr (!Sched::GATHER) xA = Ab + S.abase(nxt);
                S.a_ready(nxt);
            }
            PG8_LDB(B0, 0, 0); PG8_LDB(B1, 0, 1); PG8_SCHED; PG8_LDA(At, 0, 0); PG8_STAGE_A(PG8_SA(1, 1), false, 1, t + 1);
            if constexpr (Sched::GATHER) { if (last && has_next) {
#pragma unroll
                for (int h = 0; h < 2; ++h)
#pragma unroll
                    for (int i = 0; i < 2; ++i) gc[h][i] = S.aoff(nxt, h, sR[i], sC[i]); } }
            PG8_WAIT_V(8); PG8_WAIT_L(0); PG8_BAR; PG8_MMA(0, 0, At, B0); PG8_MMA(0, 1, At, B1); PG8_BAR; PG8_SCHED;
            PG8_LDA(At, 0, 1); PG8_STAGE(PG8_SB(0, 0), b2, voffB); PG8_STAGE(PG8_SB(0, 1), b2 + hstep, voffB); PG8_STAGE_A(PG8_SA(0, 0), last, 0, kt2);
            PG8_WAIT_V(8); PG8_WAIT_L(0); PG8_BAR; PG8_MMA(1, 0, At, B0); PG8_MMA(1, 1, At, B1); PG8_BAR; PG8_SCHED;
            PG8_LDB(B0, 1, 0); PG8_LDB(B1, 1, 1); PG8_SCHED; PG8_LDA(At, 1, 0); PG8_STAGE_A(PG8_SA(0, 1), last, 1, kt2);
            PG8_WAIT_V(8); PG8_WAIT_L(0);
            if (have_prv) { S.done(prv); have_prv = false; }
            PG8_BAR; PG8_MMA(0, 0, At, B0); PG8_MMA(0, 1, At, B1); PG8_BAR; PG8_SCHED;
            PG8_LDA(At, 1, 1); PG8_STAGE(PG8_SB(1, 0), b3, voffB); PG8_STAGE(PG8_SB(1, 1), b3 + hstep, voffB); PG8_STAGE_A(PG8_SA(1, 0), last, 0, kt2 + 1);
            PG8_WAIT_V(8); PG8_WAIT_L(0); PG8_BAR; PG8_MMA(1, 0, At, B0); PG8_MMA(1, 1, At, B1); PG8_BAR; PG8_SCHED;
        }
        if (wr == 0) PG8_BAR;
        if constexpr (ES == 1) asm volatile("s_nop 15\n\ts_nop 15" ::: "memory");
        E(acc, cur, wr, wc, fr, fq, (const PG8_LAS float*)(lds + STAGE_BYTES + 512 + (ui % 3) * 1024)); prv = cur; have_prv = true;
        if (!has_next) break;
#pragma unroll
        for (int a = 0; a < 2; ++a)
#pragma unroll
            for (int b = 0; b < 2; ++b)
#pragma unroll
                for (int m = 0; m < 4; ++m)
#pragma unroll
                    for (int n = 0; n < 2; ++n) acc[a][b][m][n] = (f32x4){0.f, 0.f, 0.f, 0.f};
        cur = nxt; cB = nB; ++ui;
        if constexpr (!Sched::GATHER) cA = xA;
        if (wr == 1) PG8_BAR;
    }
    PG8_WAIT_V(0);
    if (have_prv) S.done(prv);
    PG8_BAR;
#undef PG8_STAGE_A
#undef PG8_SA
#undef PG8_SB
#undef PG8_STAGE
#undef PG8_LDA
#undef PG8_LDB
#undef PG8_MMA
#undef PG8_WAIT_V
#undef PG8_WAIT_L
#undef PG8_BAR
#undef PG8_SCHED
}
template <class Epi, class Sched>
__device__ __forceinline__ void gemm_phase(PG8_LAS unsigned char* lds, const bf16_t* Abase, const int K, const Sched& S, const Epi& E) { gemm_phase_es<2>(lds, Abase, K, S, E); }
}
constexpr int LX_PTR = 155648 - 256;
#define FTID ((int)threadIdx.x)
#define FLANE ((int)threadIdx.x & 63)
#define FWAVE ((int)__builtin_amdgcn_readfirstlane((int)threadIdx.x >> 6))
struct Frame {
    LAS unsigned char* lds;
    int G, bid;
    float* out; unsigned char* ws;
    __device__ __forceinline__ const float* inp(int i) const {
        const LAS unsigned* p = (const LAS unsigned*)(lds + LX_PTR) + 2 * i;
        const unsigned lo = __builtin_amdgcn_readfirstlane(p[0]), hi = __builtin_amdgcn_readfirstlane(p[1]);
        return (const float*)(const GAS float*)(((unsigned long long)hi << 32) | lo);
    }
};
enum { I_X = 0, I_GLA_NORM, I_GLA_WIN, I_GLA_WGU, I_GLA_BG, I_GLA_HG, I_GLA_WOUT, I_SGU_NORM, I_SGU_WIN, I_SGU_LNG, I_SGU_LNB, I_SGU_WS, I_SGU_BS, I_SGU_WOUT,
       I_MOE_NORM, I_MOE_WG, I_MOE_BG, I_MOE_WSUB, I_MOE_BSUB, I_MOE_W1, I_MOE_W3, I_MOE_W2, I_FINAL };
#define WSP(type, off) ((type*)(F.ws + (off)))

#define XB_TMO      128
#define XB_XCNT(j)  (256  + 64 * (j))
#define XB_XSUB(j)  (1280 + 64 * (j))
#define XB_XGEN(j)  (2304 + 64 * (j))
#define XB_TOP      3328
#define XB_TOPGEN   3392
#define XCD_BAR_WORDS 3456
#define XB_SPIN_CAP (1u << 18)

__device__ __forceinline__ unsigned xb_ld(unsigned* p)              { return __hip_atomic_load(p, __ATOMIC_RELAXED, __HIP_MEMORY_SCOPE_AGENT); }
__device__ __forceinline__ unsigned xb_add(unsigned* p, unsigned v) { return __hip_atomic_fetch_add(p, v, __ATOMIC_RELAXED, __HIP_MEMORY_SCOPE_AGENT); }
__device__ __forceinline__ unsigned xb_xcc_id() { return (unsigned)__builtin_amdgcn_s_getreg((3 << 11) | 20) & 0xFu; }
#define XB_SPIN(cond, bar) do { unsigned _sp = 0; while (cond) { __builtin_amdgcn_s_sleep(1); \
    if ((++_sp & 255u) == 0u) { if (xb_ld(&(bar)[XB_TMO])) break; if (_sp > XB_SPIN_CAP) { atomicAdd(&(bar)[XB_TMO], 1u); break; } } } } while (0)

struct XcdBarrier {
    unsigned* bar; unsigned x;
    volatile LAS unsigned* st;
};

__device__ __forceinline__ XcdBarrier xcd_barrier_post(unsigned* bar, volatile LAS unsigned* st) {
    XcdBarrier b; b.bar = bar; b.x = xb_xcc_id(); b.st = st;
    if (threadIdx.x == 0) (void)xb_add(&bar[XB_XCNT(b.x)], 1u);
    return b;
}
__device__ __forceinline__ void xcd_barrier_complete(unsigned* bar, unsigned x, unsigned& nloc, unsigned& nx) {
    const unsigned G = gridDim.x * gridDim.y * gridDim.z;
    unsigned sum, cnt, mine, sp = 0u;
    for (;;) {
        sum = 0u; cnt = 0u; mine = 0u;
#pragma unroll
        for (unsigned j = 0; j < 16; ++j) { const unsigned c = xb_ld(&bar[XB_XCNT(j)]); sum += c; cnt += (c > 0u) ? 1u : 0u; mine = (j == x) ? c : mine; }
        if (sum == G) break;
        __builtin_amdgcn_s_sleep(1);
        if ((++sp & 255u) == 0u) { if (xb_ld(&bar[XB_TMO])) break; if (sp > XB_SPIN_CAP) { atomicAdd(&bar[XB_TMO], 1u); break; } }
    }
    nloc = mine > 0u ? mine : 1u; nx = cnt > 0u ? cnt : 1u;
}

__device__ __forceinline__ void xcd_barrier(const XcdBarrier& b) {
    asm volatile("s_waitcnt vmcnt(0)" ::: "memory");
    __syncthreads();
    if (threadIdx.x == 0) {
        unsigned* bar = b.bar;
        __builtin_amdgcn_s_waitcnt(0);
        unsigned nloc = b.st[0], nx = b.st[1];
        if (nloc == 0u) { xcd_barrier_complete(bar, b.x, nloc, nx); b.st[0] = nloc; b.st[1] = nx; }
        const unsigned old = xb_add(&bar[XB_XSUB(b.x)], 1u);
        const unsigned gen = old / nloc;
        if (old + 1u == (gen + 1u) * nloc) {
            __builtin_amdgcn_fence(__ATOMIC_RELEASE, "agent");
            asm volatile("s_waitcnt vmcnt(0)" ::: "memory");
            const unsigned og = xb_add(&bar[XB_TOP], 1u);
            const unsigned tg = og / nx;
            if (og + 1u == (tg + 1u) * nx) xb_add(&bar[XB_TOPGEN], 1u);
            else XB_SPIN(xb_ld(&bar[XB_TOPGEN]) == tg, bar);
            __builtin_amdgcn_fence(__ATOMIC_ACQUIRE, "agent");
            xb_add(&bar[XB_XGEN(b.x)], 1u);
            asm volatile("s_waitcnt vmcnt(0)" ::: "memory");
        } else {
            XB_SPIN(xb_ld(&bar[XB_XGEN(b.x)]) == gen, bar);
            __builtin_amdgcn_fence(__ATOMIC_ACQUIRE, "agent");
            asm volatile("s_waitcnt vmcnt(0)" ::: "memory");
        }
    }
    __syncthreads();
}
constexpr int RING_BYTES = 131072;
constexpr int LX_TST = RING_BYTES;
constexpr int MOE_MAXU = 6;
constexpr int LX_TAB = RING_BYTES + 512;
constexpr int LX_GT = LX_TAB + MOE_MAXU * 1024;

struct EpiStoreBf16 {
    static constexpr bool RS_DMA = true;
    static constexpr bool PERM = true;
    bf16* O; int ldc; const float* rs; int silu_from;
    __device__ __forceinline__ void operator()(const pg8::f32x4 (&acc)[2][2][4][2], const pg8::Unit& u, int wr, int wc, int fr, int fq, const LAS float* rsl) const {
        const int row0 = u.pm * 256 + wr * 64 + fr, col0 = u.pn * 256 + wc * 32 + 8 * fq;
#pragma unroll
        for (int ai = 0; ai < 2; ++ai)
#pragma unroll
            for (int m = 0; m < 4; ++m) { const int row = row0 + ai * 128 + m * 16; bf16* rowp = O + (size_t)row * ldc + col0; const float sc = rsl[ai * 128 + wr * 64 + m * 16 + fr];
#pragma unroll
                for (int bj = 0; bj < 2; ++bj) { pg8::f32x4 v0 = acc[ai][bj][m][0] * sc, v1 = acc[ai][bj][m][1] * sc;
                    if (silu_from >= 0 && u.pn >= silu_from) {
#pragma unroll
                        for (int i = 0; i < 4; ++i) { v0[i] = v0[i] * __builtin_amdgcn_rcpf(1.f + __expf(-v0[i])); v1[i] = v1[i] * __builtin_amdgcn_rcpf(1.f + __expf(-v1[i])); } }
                    v4u w; w.x = pg8::cvt_pk_bf16(v0[0], v0[1]); w.y = pg8::cvt_pk_bf16(v0[2], v0[3]); w.z = pg8::cvt_pk_bf16(v1[0], v1[1]); w.w = pg8::cvt_pk_bf16(v1[2], v1[3]);
                    __builtin_nontemporal_store(w, (v4u*)(rowp + bj * 128)); } }
    }
};
template <bool BATCH> struct EpiResBf16T {
    static constexpr bool RS_DMA = false;
    static constexpr bool PERM = true;
    bf16* X; float sc;
    __device__ __forceinline__ void operator()(const pg8::f32x4 (&acc)[2][2][4][2], const pg8::Unit& u, int wr, int wc, int fr, int fq, const LAS float* rsl) const {
        const int row0 = u.pm * 256 + wr * 64 + fr, col0 = u.pn * 256 + wc * 32 + 8 * fq;
        if constexpr (BATCH) {
#pragma unroll
            for (int ai = 0; ai < 2; ++ai) {
                v4u r[4][2];
#pragma unroll
                for (int m = 0; m < 4; ++m) { const bf16* rowp = X + (size_t)(row0 + ai * 128 + m * 16) * D + col0;
#pragma unroll
                    for (int bj = 0; bj < 2; ++bj) r[m][bj] = *(const v4u*)(rowp + bj * 128); }
                asm volatile("s_waitcnt vmcnt(0)" ::: "memory");
#pragma unroll
                for (int m = 0; m < 4; ++m) { bf16* rowp = X + (size_t)(row0 + ai * 128 + m * 16) * D + col0;
#pragma unroll
                    for (int bj = 0; bj < 2; ++bj) { const v4u rx = r[m][bj]; const pg8::f32x4 v0 = acc[ai][bj][m][0] * sc, v1 = acc[ai][bj][m][1] * sc;
                        v4u w; w.x = pg8::cvt_pk_bf16(bflo(rx.x) + v0[0], bfhi(rx.x) + v0[1]); w.y = pg8::cvt_pk_bf16(bflo(rx.y) + v0[2], bfhi(rx.y) + v0[3]);
                        w.z = pg8::cvt_pk_bf16(bflo(rx.z) + v1[0], bfhi(rx.z) + v1[1]); w.w = pg8::cvt_pk_bf16(bflo(rx.w) + v1[2], bfhi(rx.w) + v1[3]);
                        *(v4u*)(rowp + bj * 128) = w; } }
            }
        } else {
#pragma unroll
        for (int ai = 0; ai < 2; ++ai)
#pragma unroll
            for (int m = 0; m < 4; ++m) { bf16* rowp = X + (size_t)(row0 + ai * 128 + m * 16) * D + col0;
#pragma unroll
                for (int bj = 0; bj < 2; ++bj) { const v4u r = *(const v4u*)(rowp + bj * 128); const pg8::f32x4 v0 = acc[ai][bj][m][0] * sc, v1 = acc[ai][bj][m][1] * sc;
                    v4u w; w.x = pg8::cvt_pk_bf16(bflo(r.x) + v0[0], bfhi(r.x) + v0[1]); w.y = pg8::cvt_pk_bf16(bflo(r.y) + v0[2], bfhi(r.y) + v0[3]);
                    w.z = pg8::cvt_pk_bf16(bflo(r.z) + v1[0], bfhi(r.z) + v1[1]); w.w = pg8::cvt_pk_bf16(bflo(r.w) + v1[2], bfhi(r.w) + v1[3]);
                    *(v4u*)(rowp + bj * 128) = w; } }
        }
    }
};
#ifndef RES_BATCH_OUT
#define RES_BATCH_OUT true
#endif
#ifndef RES_BATCH_SGU
#define RES_BATCH_SGU true
#endif
typedef EpiResBf16T<RES_BATCH_OUT> EpiResBf16;
__device__ __forceinline__ size_t sgu_blk(int row, int col) { return ((size_t)((row >> 7) * 16 + (col >> 7)) << 15) + (size_t)((row & 127) << 8) + (size_t)((col & 127) << 1); }
struct EpiGeluSplit {
    static constexpr bool RS_DMA = true;
    static constexpr bool PERM = true;
    bf16* U; bf16* V; float* st; const float* rs;
    __device__ __forceinline__ void operator()(const pg8::f32x4 (&acc)[2][2][4][2], const pg8::Unit& u, int wr, int wc, int fr, int fq, const LAS float* rsl) const {
        const bool isv = u.pn >= 8; const int pnl = isv ? u.pn - 8 : u.pn;
        bf16* O = isv ? V : U;
        const int row0 = u.pm * 256 + wr * 64 + fr, col0 = pnl * 256 + wc * 32 + 8 * fq;
#pragma unroll
        for (int ai = 0; ai < 2; ++ai)
#pragma unroll
            for (int m = 0; m < 4; ++m) { const int row = row0 + ai * 128 + m * 16; bf16* rowp = (bf16*)((char*)O + sgu_blk(row, col0)); pg8::f32x2 s2 = {0.f, 0.f}, q2 = {0.f, 0.f};   const float sc = rsl[ai * 128 + wr * 64 + m * 16 + fr] * (1.f / MOE_WSCALE);
#pragma unroll
                for (int bj = 0; bj < 2; ++bj) { const pg8::f32x4 v0 = acc[ai][bj][m][0] * sc, v1 = acc[ai][bj][m][1] * sc;
                    pg8::f32x2 a = {v0[0], v0[1]}, b = {v0[2], v0[3]}, c = {v1[0], v1[1]}, d = {v1[2], v1[3]}; pg8::gelu_pk4(a, b, c, d);
                    s2 += (a + b) + (c + d); q2 += (a * a + b * b) + (c * c + d * d);
                    v4u w; w.x = pg8::cvt_pk_bf16(a.x, a.y); w.y = pg8::cvt_pk_bf16(b.x, b.y); w.z = pg8::cvt_pk_bf16(c.x, c.y); w.w = pg8::cvt_pk_bf16(d.x, d.y);
                    __builtin_nontemporal_store(w, (v4u*)((char*)rowp + bj * 32768)); }
                if (isv) { float s = s2.x + s2.y, q = q2.x + q2.y; s += __shfl_xor(s, 16); s += __shfl_xor(s, 32); q += __shfl_xor(q, 16); q += __shfl_xor(q, 32);
                    if (fq == 0) { pg8::f32x2 o = {s, q}; *(pg8::f32x2*)(st + ((size_t)(pnl * 4 + wc) * T + row) * 2) = o; } } }
    }
};

__device__ __forceinline__ void f_gemm_in(Frame& F) {
    pg8::DenseOrder S; S.init(T, NQKVR, D, WSP(bf16, WS_WIN), F.G, F.bid);
    EpiStoreBf16 E{WSP(bf16, WS_QKVR), NQKVR, WSP(float, WS_RS), 8};
    pg8::gemm_phase(F.lds, WSP(bf16, WS_XN), D, S, E);
}
struct DenseOrder8 : pg8::DenseOrder {
    __device__ __forceinline__ const char* bptr(const pg8::Unit& u) const { return Bt + (size_t)u.pn * 256 * K; }
    __device__ __forceinline__ size_t abase(const pg8::Unit& u) const { return (size_t)u.pm * 256 * K; }
};
struct BlockedAOrder : pg8::DenseOrder {
    __device__ __forceinline__ const char* bptr(const pg8::Unit& u) const { return Bt + (size_t)u.pn * 256 * K; }
    __device__ __forceinline__ size_t abase(const pg8::Unit& u) const { return (size_t)u.pm * 2 * 16 * 16384; }
    __device__ __forceinline__ int a_rowstride(int) const { return 128; }
    __device__ __forceinline__ size_t a_hstep(size_t) const { return (size_t)16 * 16384; }
    __device__ __forceinline__ size_t a_koff(int kt) const { return (size_t)kt * 16384; }
};
struct RowSetOrder {
    static constexpr bool GATHER = false;
    int nb, c, j0, nunits, K; const char* Bt;
    __device__ __forceinline__ bool next(int i, pg8::Unit& u) const {
        if (c < 0) return false;
        const int q = i * nb + c; if (q >= nunits) return false;
        u.pm = ((q & 63) >> 2) * 8 + j0 + (q >> 6); u.pn = q & 3; u.e = 0; u.slot = 0; return true;
    }
    __device__ __forceinline__ const char* bptr(const pg8::Unit& u) const { return Bt + (size_t)u.pn * 256 * K * 2; }
    __device__ __forceinline__ size_t abase(const pg8::Unit& u) const { return (size_t)u.pm * 256 * K * 2; }
    __device__ __forceinline__ int a_rowstride(int dflt) const { return dflt; }
    __device__ __forceinline__ size_t a_hstep(size_t dflt) const { return dflt; }
    __device__ __forceinline__ size_t a_koff(int kt) const { return (size_t)kt * 128; }
    __device__ __forceinline__ unsigned aoff(const pg8::Unit&, int, int, int) const { return 0u; }
    __device__ __forceinline__ void a_ready(const pg8::Unit&) const {}
    __device__ __forceinline__ void done(const pg8::Unit&) const {}
};
__device__ __forceinline__ void f_gemm_out_rows(Frame& F, int j0, int j1, int boff) {
    RowSetOrder S; S.nb = F.G - boff; S.c = F.bid - boff; S.j0 = j0; S.nunits = (j1 - j0) * 64; S.K = HV; S.Bt = (const char*)WSP(bf16, WS_WOUT);
    EpiResBf16 E{WSP(bf16, WS_XN), 1.f};
    pg8::gemm_phase(F.lds, WSP(bf16, WS_AOUT), HV, S, E);
}
__device__ __forceinline__ void f_gemm_sgu_in(Frame& F) {
    DenseOrder8 S; S.init(T, SGU_FFN, D, WSP(bf16, WS_WSIN), F.G, F.bid);
    EpiGeluSplit E{WSP(bf16, WS_U), WSP(bf16, WS_V), WSP(float, WS_STATS), WSP(float, WS_RS)};
    pg8::gemm_phase_es<1>(F.lds, WSP(unsigned char, WS_XB8), D, S, E);
}
__device__ __forceinline__ void f_gemm_sgu_out(Frame& F, float scmul = 1.f) {
    BlockedAOrder S; S.init(T, D, SGU_HALF, WSP(bf16, WS_WSOUT), F.G, F.bid);
    EpiResBf16T<RES_BATCH_SGU> E{WSP(bf16, WS_XN), scmul * (1.f / MOE_WSCALE)};
    pg8::gemm_phase_es<1>(F.lds, WSP(unsigned char, WS_UG8), SGU_HALF, S, E);
}

template <bool GATHER_> struct MoeOrder {
    static constexpr bool GATHER = GATHER_;
    int G, c, nunits, ibase, K, rowb, mode;
    const char* W; size_t estride;
    LAS const int* tst; LAS const int* tab; unsigned* hcnt; unsigned rdy;
    int n5, rb;
    __device__ __forceinline__ bool next(int i, pg8::Unit& u) const {
        if (i >= MOE_MAXU) return false;
        const int ii = ibase + i; int Lu;
        if (GATHER || n5 <= 0 || ii < rb) Lu = ii * G + c;
        else { if (c < n5) return false; Lu = rb * G + (ii - rb) * (G - n5) + (c - n5); }
        if (Lu >= nunits) return false;
        const int rt = Lu >> 2; int e = 0;
        while (e < NE - 1 && tst[e + 1] <= rt) ++e;
        u.pm = rt; u.pn = Lu & 3; u.e = e; u.slot = i; return true;
    }
    __device__ __forceinline__ const char* bptr(const pg8::Unit& u) const { return W + (size_t)u.e * estride + (size_t)u.pn * 256 * rowb; }
    __device__ __forceinline__ size_t abase(const pg8::Unit& u) const { return (size_t)u.pm * 256 * rowb; }
    __device__ __forceinline__ int a_rowstride(int dflt) const { return dflt; }
    __device__ __forceinline__ size_t a_hstep(size_t dflt) const { return dflt; }
    __device__ __forceinline__ size_t a_koff(int kt) const { return (size_t)kt * 128; }
    __device__ __forceinline__ unsigned aoff(const pg8::Unit& u, int h, int R, int C) const {
        if (mode == 0) { int ent = tab[u.slot * 256 + h * 128 + R]; ent = ent < 0 ? 0 : ent; return (unsigned)((ent >> 1) * rowb + C * 2); }
        return (unsigned)((u.pm * 256 + h * 128 + R) * rowb + C * 2);
    }
    __device__ __forceinline__ void a_ready(const pg8::Unit& u) const {
        if (GATHER || ((rdy >> u.slot) & 1u)) return;
        if (threadIdx.x < 64) {
            unsigned spins = 0;
            while ((unsigned)__builtin_amdgcn_readfirstlane(__hip_atomic_load(hcnt + 16 * u.pm, __ATOMIC_RELAXED, __HIP_MEMORY_SCOPE_AGENT)) < 32u) { __builtin_amdgcn_s_sleep(2); if (++spins > (1u << 20)) break; }
            __builtin_amdgcn_fence(__ATOMIC_ACQUIRE, "agent");
            asm volatile("s_waitcnt vmcnt(0)" ::: "memory");
        }
        asm volatile("" ::: "memory"); __builtin_amdgcn_s_barrier(); asm volatile("" ::: "memory");
    }
    __device__ __forceinline__ void done(const pg8::Unit& u) const {
        if (!GATHER) return;
        if ((threadIdx.x & 63) == 0) __hip_atomic_fetch_add(hcnt + 16 * u.pm, 1u, __ATOMIC_RELAXED, __HIP_MEMORY_SCOPE_AGENT);
    }
};
struct EpiSwiglu {
    static constexpr bool RS_DMA = false;
    static constexpr bool PERM = true;
    unsigned char* H; LAS const float* gt;
    __device__ __forceinline__ void operator()(const pg8::f32x4 (&acc)[2][2][4][2], const pg8::Unit& u, int wr, int wc, int fr, int fq, const LAS float* rsl) const {
        const __amdgpu_buffer_rsrc_t hrs = __builtin_amdgcn_make_buffer_rsrc((void*)H, (short)0, 73728 * FF, 0x00020000);
        const int row0 = u.pm * 256 + wr * 64 + fr, col0 = u.pn * 128 + wc * 32 + 8 * fq;
#pragma unroll
        for (int ai = 0; ai < 2; ++ai)
#pragma unroll
            for (int m = 0; m < 4; ++m) { float h[8]; const float sc = gt[u.slot * 256 + ai * 128 + wr * 64 + m * 16 + fr] * (1.f / MOE_WSCALE);
#pragma unroll
                for (int n = 0; n < 2; ++n)
#pragma unroll
                    for (int i = 0; i < 4; ++i) { const float a = acc[ai][0][m][n][i] * sc, b = acc[ai][1][m][n][i] * sc; h[n * 4 + i] = a * __builtin_amdgcn_rcpf(1.f + __expf(-a)) * b; }
                int w0 = __builtin_amdgcn_cvt_pk_fp8_f32(h[0], h[1], 0, false); w0 = __builtin_amdgcn_cvt_pk_fp8_f32(h[2], h[3], w0, true);
                int w1 = __builtin_amdgcn_cvt_pk_fp8_f32(h[4], h[5], 0, false); w1 = __builtin_amdgcn_cvt_pk_fp8_f32(h[6], h[7], w1, true);
                v2u w; w.x = (unsigned)w0; w.y = (unsigned)w1;
                __builtin_amdgcn_raw_buffer_store_b64(w, hrs, (row0 + ai * 128 + m * 16) * FF + col0, 0, 16); }
    }
};
struct EpiScatterY {
    static constexpr bool RS_DMA = false;
    static constexpr bool PERM = true;
    unsigned char* Y; LAS const int* tab; LAS const float* gt;
    __device__ __forceinline__ void operator()(const pg8::f32x4 (&acc)[2][2][4][2], const pg8::Unit& u, int wr, int wc, int fr, int fq, const LAS float* rsl) const {
        const int col0 = u.pn * 256 + wc * 32 + 8 * fq;
#pragma unroll
        for (int ai = 0; ai < 2; ++ai)
#pragma unroll
            for (int m = 0; m < 4; ++m) { const int r = ai * 128 + wr * 64 + m * 16 + fr; const int ent = tab[u.slot * 256 + r]; const float g = gt[u.slot * 256 + r] * (1.f / MOE_WSCALE);
                if (ent >= 0) { unsigned char* rowp = Y + ((size_t)(ent & 1) * T + (ent >> 1)) * D + col0;
#pragma unroll
                    for (int bj = 0; bj < 2; ++bj) { const pg8::f32x4 v0 = acc[ai][bj][m][0] * g, v1 = acc[ai][bj][m][1] * g;
                        int w0 = __builtin_amdgcn_cvt_pk_fp8_f32(v0[0], v0[1], 0, false); w0 = __builtin_amdgcn_cvt_pk_fp8_f32(v0[2], v0[3], w0, true);
                        int w1 = __builtin_amdgcn_cvt_pk_fp8_f32(v1[0], v1[1], 0, false); w1 = __builtin_amdgcn_cvt_pk_fp8_f32(v1[2], v1[3], w1, true);
                        v2u w; w.x = (unsigned)w0; w.y = (unsigned)w1; *(v2u*)(rowp + bj * 128) = w; } } }
    }
};
template <int MODE> __device__ __forceinline__ void f_moe_gemm(Frame& F, int L, LAS int* tst, LAS int* cntl) {
    LAS int* tab = (LAS int*)(F.lds + LX_TAB); LAS float* gt = (LAS float*)(F.lds + LX_GT);
    MoeOrder<MODE == 0> S; S.G = F.G; S.c = F.bid; S.nunits = 4 * tst[NE]; S.K = MODE == 0 ? D : FF; S.rowb = S.K; S.mode = MODE; S.tst = tst; S.tab = tab;
    S.hcnt = WSP(unsigned, WS_CTL) + CW_HID + L * 4608;
    { const int r1 = (S.nunits + F.G - 1) / F.G, nlast = S.nunits - (r1 - 1) * F.G;
      S.n5 = (MODE == 1 && r1 >= 3 && nlast < F.G) ? nlast : 0; S.rb = r1 - 2; }
    S.W = MODE == 0 ? (const char*)(WSP(unsigned char, WS_W13) + (size_t)L * NE * 1024 * 1024) : (const char*)(WSP(unsigned char, WS_W2) + (size_t)L * NE * 1024 * 512);
    S.estride = MODE == 0 ? (size_t)1024 * 1024 : (size_t)1024 * 512;
    const int* list = WSP(int, WS_LIST); const float* gates = WSP(float, WS_GATE);
    for (int ibase = 0; ibase * (S.n5 > 0 ? F.G - S.n5 : F.G) < S.nunits; ibase += MOE_MAXU) {
        S.ibase = ibase;
        {
            static_assert(MOE_MAXU == 6, "three table slots per thread half");
            int ents[3]; float gsv[3]; const int r = FTID & 255, hsel = FTID >> 8;
#pragma unroll
            for (int k = 0; k < 3; ++k) { pg8::Unit u; ents[k] = -1;
                if (S.next(2 * k + hsel, u)) { const int idx = (u.pm - tst[u.e]) * 256 + r; if (idx < cntl[u.e]) ents[k] = list[(size_t)u.e * T + idx]; } }
#pragma unroll
            for (int k = 0; k < 3; ++k) gsv[k] = ents[k] >= 0 ? (MODE == 0 ? WSP(float, WS_RS)[ents[k] >> 1] : gates[ents[k]]) : 0.f;
#pragma unroll
            for (int k = 0; k < 3; ++k) { tab[(2 * k + hsel) * 256 + r] = ents[k]; gt[(2 * k + hsel) * 256 + r] = gsv[k]; }
        }
        S.rdy = 0u;
        if (MODE == 1) {
            LAS unsigned* rdyw = (LAS unsigned*)(F.lds + LX_TST + 448);
            if (FTID < 64) { unsigned m = 0u;
                for (int i = 0; i < MOE_MAXU; ++i) { pg8::Unit u; if (S.next(i, u) && (unsigned)__builtin_amdgcn_readfirstlane(__hip_atomic_load(S.hcnt + 16 * u.pm, __ATOMIC_RELAXED, __HIP_MEMORY_SCOPE_AGENT)) >= 32u) m |= 1u << i; }
                __builtin_amdgcn_fence(__ATOMIC_ACQUIRE, "agent"); asm volatile("s_waitcnt vmcnt(0)" ::: "memory");
                if (FTID == 0) *rdyw = m; }
            __syncthreads();
            S.rdy = *rdyw;
        }
        __syncthreads();
        if (MODE == 0) { EpiSwiglu E{WSP(unsigned char, WS_HID), gt}; pg8::gemm_phase_es<1>(F.lds, WSP(unsigned char, WS_XB8), D, S, E); }
        else { EpiScatterY E{WSP(unsigned char, WS_Y), tab, gt}; pg8::gemm_phase_es<1>(F.lds, WSP(unsigned char, WS_HID), FF, S, E); }
        __syncthreads();
    }
}
__device__ __forceinline__ void f_moe(Frame& F, int L) {
    LAS int* tst = (LAS int*)(F.lds + LX_TST); LAS int* cntl = tst + 64;
    unsigned* ctl = WSP(unsigned, WS_CTL);
    __syncthreads();
    if (FTID < NE) cntl[FTID] = (int)__hip_atomic_load(&ctl[CW_CNT + L * 2048 + 64 * FTID], __ATOMIC_RELAXED, __HIP_MEMORY_SCOPE_AGENT);
    __syncthreads();
    if (FTID == 0) { int s = 0; for (int e = 0; e < NE; ++e) { tst[e] = s; s += (cntl[e] + 255) >> 8; } tst[NE] = s; }
    __syncthreads();
    f_moe_gemm<0>(F, L, tst, cntl);
    f_moe_gemm<1>(F, L, tst, cntl);
}
__device__ __forceinline__ void transpose_item(const float* W, int ldw, const float* kscale, float cs, bf16* WT, int K, int dst_row0, LAS float* scr, int k0, int n0, int lane) {
    f32x4 x[8]; float ks[8];
    const int kr = lane >> 3, n4 = (lane & 7) * 4;
#pragma unroll
    for (int i = 0; i < 8; ++i) { x[i] = *(const f32x4*)(W + (size_t)(k0 + 8 * i + kr) * ldw + n0 + n4); ks[i] = kscale ? kscale[k0 + 8 * i + kr] * cs : cs; }
#pragma unroll
    for (int i = 0; i < 8; ++i) { LAS float* d = scr + (8 * i + kr) * 33 + n4; d[0] = x[i][0] * ks[i]; d[1] = x[i][1] * ks[i]; d[2] = x[i][2] * ks[i]; d[3] = x[i][3] * ks[i]; }
    LDS_WAIT(); asm volatile("" ::: "memory");
    const int c = lane & 7;
#pragma unroll
    for (int j = 0; j < 4; ++j) { const int n = (lane >> 3) + 8 * j; const LAS float* s = scr + (8 * c) * 33 + n;
        v4u o; o.x = pk2(s[0 * 33], s[1 * 33]); o.y = pk2(s[2 * 33], s[3 * 33]); o.z = pk2(s[4 * 33], s[5 * 33]); o.w = pk2(s[6 * 33], s[7 * 33]);
        *(v4u*)(WT + (size_t)(dst_row0 + n) * K + k0 + 8 * c) = o; }
    LDS_WAIT(); asm volatile("" ::: "memory");
}
__device__ __forceinline__ void transpose_item8(const float* W, int ldw, const float* kscale, float cs, unsigned char* WT, int K, int dst_row0, LAS float* scr, int k0, int n0, int lane) {
    f32x4 x[8]; float ks[8];
    const int kr = lane >> 3, n4 = (lane & 7) * 4;
#pragma unroll
    for (int i = 0; i < 8; ++i) { x[i] = *(const f32x4*)(W + (size_t)(k0 + 8 * i + kr) * ldw + n0 + n4); ks[i] = kscale ? kscale[k0 + 8 * i + kr] * cs : cs; }
#pragma unroll
    for (int i = 0; i < 8; ++i) { LAS float* d = scr + (8 * i + kr) * 33 + n4; d[0] = x[i][0] * ks[i]; d[1] = x[i][1] * ks[i]; d[2] = x[i][2] * ks[i]; d[3] = x[i][3] * ks[i]; }
    LDS_WAIT(); asm volatile("" ::: "memory");
    const int c = lane & 7;
#pragma unroll
    for (int j = 0; j < 4; ++j) { const int n = (lane >> 3) + 8 * j; const LAS float* s = scr + (8 * c) * 33 + n;
        int w0 = __builtin_amdgcn_cvt_pk_fp8_f32(s[0 * 33], s[1 * 33], 0, false); w0 = __builtin_amdgcn_cvt_pk_fp8_f32(s[2 * 33], s[3 * 33], w0, true);
        int w1 = __builtin_amdgcn_cvt_pk_fp8_f32(s[4 * 33], s[5 * 33], 0, false); w1 = __builtin_amdgcn_cvt_pk_fp8_f32(s[6 * 33], s[7 * 33], w1, true);
        v2u o; o.x = (unsigned)w0; o.y = (unsigned)w1; *(v2u*)(WT + (size_t)(dst_row0 + n) * K + k0 + 8 * c) = o; }
    LDS_WAIT(); asm volatile("" ::: "memory");
}
__device__ __forceinline__ void convert_job_item8(const float* W, int ldw, int K, int N, const float* kscale, float cs, unsigned char* WT, int rowmap, LAS float* scr, int item, int lane) {
    const int nblk = N / 32, kb = item / nblk, nb = item % nblk, k0 = 64 * kb, n0 = 32 * nb;
    const int dr = rowmap == 0 ? n0 : ((n0 >> 7) * 256 + (n0 & 127) + (rowmap == 2 ? 128 : 0));
    transpose_item8(W, ldw, kscale, cs, WT, K, dr, scr, k0, n0, lane);
}
__device__ __forceinline__ void convert_job_item(const float* W, int ldw, int K, int N, const float* kscale, int qcols, float qs, bf16* WT, int rowmap, LAS float* scr, int item, int lane) {
    const int nblk = N / 32, kb = item / nblk, nb = item % nblk, k0 = 64 * kb, n0 = 32 * nb;
    const int dr = rowmap == 0 ? n0 : ((n0 >> 7) * 256 + (n0 & 127) + (rowmap == 2 ? 128 : 0));
    transpose_item(W, ldw, kscale, n0 < qcols ? qs : 1.f, WT, K, dr, scr, k0, n0, lane);
}
__device__ __forceinline__ void f_convert_gla(Frame& F) {
    LAS float* scr = (LAS float*)(F.lds + FWAVE * 8448);
    const int gw = F.bid * NWAVES + FWAVE, NGW = F.G * NWAVES;
    constexpr int I0 = (D / 64) * (NQKVR / 32), I1 = (HV / 64) * (D / 32);
    for (int it = gw; it < I0 + I1; it += NGW) {
        if (it < I0) convert_job_item(F.inp(I_GLA_WIN), GLA_IN, D, NQKVR, F.inp(I_GLA_NORM), HK, 0.08838834764831845f, WSP(bf16, WS_WIN), 0, scr, it, FLANE);
        else convert_job_item(F.inp(I_GLA_WOUT), D, HV, D, F.inp(I_GLA_HG), 0, 1.f, WSP(bf16, WS_WOUT), 0, scr, it - I0, FLANE);
    }
}
struct Cv8 { const float* W; const float* kscale; unsigned char* WT; int ldw, K, dr, k0, n0; };
__device__ __forceinline__ Cv8 cv8_decode(Frame& F, int it) {
    constexpr int I0 = (D / 128) * (SGU_FFN / 64), I1 = (SGU_HALF / 128) * (D / 64), IE1 = (D / 128) * (FF / 64), IM = 2 * NE * IE1;
    Cv8 d; int r = it, N, rowmap = 0;
    if (r < I0) { d.W = F.inp(I_SGU_WIN); d.ldw = SGU_FFN; d.K = D; N = SGU_FFN; d.kscale = F.inp(I_SGU_NORM); d.WT = WSP(unsigned char, WS_WSIN); }
    else if ((r -= I0) < I1) { d.W = F.inp(I_SGU_WOUT); d.ldw = D; d.K = SGU_HALF; N = D; d.kscale = nullptr; d.WT = WSP(unsigned char, WS_WSOUT); }
    else { r -= I1; const int which = r / IM; r -= which * IM; const int le = r / IE1, L = le / NE; r = r % IE1;
        if (which < 2) { d.W = (which == 0 ? F.inp(I_MOE_W1) : F.inp(I_MOE_W3)) + (size_t)le * D * FF; d.ldw = FF; d.K = D; N = FF; d.kscale = F.inp(I_MOE_NORM) + L * D; d.WT = WSP(unsigned char, WS_W13) + (size_t)le * 1024 * 1024; rowmap = 1 + which; }
        else { d.W = F.inp(I_MOE_W2) + (size_t)le * FF * D; d.ldw = D; d.K = FF; N = D; d.kscale = nullptr; d.WT = WSP(unsigned char, WS_W2) + (size_t)le * 1024 * 512; } }
    const int nblk = N / 64, kb = r / nblk, nb = r % nblk; d.k0 = 128 * kb; d.n0 = 64 * nb;
    d.dr = rowmap == 0 ? d.n0 : ((d.n0 >> 7) * 256 + (d.n0 & 127) + (rowmap == 2 ? 128 : 0));
    return d;
}
constexpr int CV_PITCH = 132;
__device__ __forceinline__ void cv8_item(const Cv8& d, LAS unsigned char* tile, int lane) {
    const int n4 = lane & 15, gq = lane >> 4;
#pragma unroll 1
    for (int ss = 0; ss < 4; ss += 2) {
        f32x4 x[2][2][4]; float ks[2][2][4];
#pragma unroll
        for (int s2 = 0; s2 < 2; ++s2)
#pragma unroll
            for (int i = 0; i < 2; ++i)
#pragma unroll
                for (int r = 0; r < 4; ++r) { const int k = d.k0 + 32 * (ss + s2) + 4 * (gq + 4 * i) + r;
                    x[s2][i][r] = __builtin_nontemporal_load((const f32x4*)(d.W + (size_t)k * d.ldw + d.n0 + 4 * n4));     ks[s2][i][r] = d.kscale ? d.kscale[k] * MOE_WSCALE : MOE_WSCALE; }
#pragma unroll
        for (int s2 = 0; s2 < 2; ++s2)
#pragma unroll
            for (int i = 0; i < 2; ++i) { const int g = 8 * (ss + s2) + gq + 4 * i;
#pragma unroll
                for (int j = 0; j < 4; ++j) {
                    int w = __builtin_amdgcn_cvt_pk_fp8_f32(x[s2][i][0][j] * ks[s2][i][0], x[s2][i][1][j] * ks[s2][i][1], 0, false);
                    w = __builtin_amdgcn_cvt_pk_fp8_f32(x[s2][i][2][j] * ks[s2][i][2], x[s2][i][3][j] * ks[s2][i][3], w, true);
                    *(LAS int*)(tile + (4 * n4 + j) * CV_PITCH + 4 * g) = w; } }
    }
    LDS_WAIT(); asm volatile("" ::: "memory");
    const int rr = lane >> 3, pc = lane & 7;
#pragma unroll
    for (int p = 0; p < 8; ++p) { const int n = rr + 8 * p; const LAS unsigned* src = (const LAS unsigned*)(tile + n * CV_PITCH + 16 * pc);
        v4u o; o.x = src[0]; o.y = src[1]; o.z = src[2]; o.w = src[3];
        *(v4u*)(d.WT + (size_t)(d.dr + n) * d.K + d.k0 + 16 * pc) = o; }
    LDS_WAIT(); asm volatile("" ::: "memory");
}
__device__ __forceinline__ void f_convert_rest(Frame& F, int cw, int NCW, int pct0 = 0, int pct1 = 1000) {
    LAS unsigned char* tile = F.lds + FWAVE * 8448;
    constexpr int I0 = (D / 128) * (SGU_FFN / 64), I1 = (SGU_HALF / 128) * (D / 64), IE1 = (D / 128) * (FF / 64), IE2 = (FF / 128) * (D / 64);
    constexpr int IM = 2 * NE * IE1;
    static_assert(IE1 == IE2, "w1 / w2 item counts");
    constexpr int NIT = I0 + I1 + 3 * IM; const int it_lo = (int)((long)NIT * pct0 / 1000), it_hi = (int)((long)NIT * pct1 / 1000);
    const int lane = FLANE;
    for (int it = it_lo + cw; it < it_hi; it += NCW) { const Cv8 d = cv8_decode(F, it); cv8_item(d, tile, lane); }
}

constexpr int SC_K = 0, SC_KSTR = 320;
constexpr int SC_V = 20480, SC_VSTR = 576;
constexpr int SC_Q = 57344, SC_QSTR = 272;
constexpr int SC_O = 74752, SC_OSTR = 528;
constexpr int SC_GL = 108544, SC_PART = 112640, SC_DEC = 114688, SC_WG = 115200;
__device__ __forceinline__ s16x4 tr_read16(LAS const unsigned char* p) {
    typedef short v4i16_t __attribute__((ext_vector_type(4)));
    return __builtin_bit_cast(s16x4, __builtin_amdgcn_ds_read_tr16_b64_v4i16((LAS v4i16_t*)p));
}
__device__ __forceinline__ void f_scan_item(Frame& F, int item) {
    const int b = item / GLA_H, h = item % GLA_H;
    const bf16* qkvr = WSP(bf16, WS_QKVR); const float* glr = WSP(float, WS_GLR); bf16* aout = WSP(bf16, WS_AOUT);
    LAS unsigned char* L = F.lds;
    LAS float* gl = (LAS float*)(L + SC_GL); LAS float* part = (LAS float*)(L + SC_PART); LAS float* dec = (LAS float*)(L + SC_DEC);
    const int tid = FTID, lane = FLANE, w = FWAVE;
    const int r32 = lane & 31, hh = lane >> 5, blk = (lane >> 4) & 1, q4 = (lane & 15) >> 2, p4 = lane & 3;
    const int dk = tid & 127, tg = tid >> 7;
    const int gq = lane >> 4, gcol = lane & 15, gdk = 16 * w + gcol;
    bf16x8 gBh, gBl;
    { unsigned ph[4], pl[4];
#pragma unroll
      for (int j = 0; j < 4; ++j) { const float x0 = gq < 2 ? F.inp(I_GLA_WGU)[(8 * gq + 2 * j) * HK + h * DK + gdk] : 0.f, x1 = gq < 2 ? F.inp(I_GLA_WGU)[(8 * gq + 2 * j + 1) * HK + h * DK + gdk] : 0.f;
          ph[j] = pk2(x0, x1); pl[j] = pk2(x0 - bflo(ph[j]), x1 - bfhi(ph[j])); }
      v4u vh = {ph[0], ph[1], ph[2], ph[3]}, vl = {pl[0], pl[1], pl[2], pl[3]};
      gBh = __builtin_bit_cast(bf16x8, vh); gBl = __builtin_bit_cast(bf16x8, vl); }
    const float gbias = F.inp(I_GLA_BG)[h * DK + gdk];
    __syncthreads();
    f32x16 st[4];
#pragma unroll
    for (int i = 0; i < 4; ++i)
#pragma unroll
        for (int j = 0; j < 16; ++j) st[i][j] = 0.f;
    v4u rk[2], rq[2], rv[4]; f32x4 rg;
    const size_t rowb = (size_t)b * SEQ;
    const unsigned vo_kq = (unsigned)(((tid >> 4) * NQKVR + (tid & 15) * 8) * 2), vo_v = (unsigned)(((tid >> 5) * NQKVR + (tid & 31) * 8) * 2), vo_g = (unsigned)(tid * 16);
    const unsigned lo_k = (unsigned)(SC_K + (tid >> 4) * SC_KSTR + (tid & 15) * 16), lo_q = (unsigned)(SC_Q + (tid >> 4) * SC_QSTR + (tid & 15) * 16), lo_v = (unsigned)(SC_V + (tid >> 5) * SC_VSTR + (tid & 31) * 16);
#define SC_LOAD(c) do { size_t cb_ = (rowb + (size_t)(c) * CHUNK) * NQKVR * 2; asm volatile("" : "+s"(cb_)); const char* gb_ = (const char*)qkvr + cb_ + (size_t)(h * DK * 2); \
        _Pragma("unroll") for (int i = 0; i < 2; ++i) { \
            rk[i] = __builtin_nontemporal_load((const v4u*)(gb_ + (size_t)(HK * 2 + i * 32 * NQKVR * 2) + vo_kq)); rq[i] = __builtin_nontemporal_load((const v4u*)(gb_ + (size_t)(i * 32 * NQKVR * 2) + vo_kq)); } \
        _Pragma("unroll") for (int i = 0; i < 4; ++i) rv[i] = __builtin_nontemporal_load((const v4u*)(gb_ + (size_t)(2 * HK * 2 + h * (DV - DK) * 2 + i * 16 * NQKVR * 2) + vo_v)); \
        if (tid < 256) rg = *(const f32x4*)((const char*)glr + (rowb + (size_t)(c) * CHUNK) * RANK * 4 + vo_g); } while (0)
#define SC_STORE() do { \
        _Pragma("unroll") for (int i = 0; i < 2; ++i) { *(LAS v4u*)(L + lo_k + i * 32 * SC_KSTR) = rk[i]; *(LAS v4u*)(L + lo_q + i * 32 * SC_QSTR) = rq[i]; } \
        _Pragma("unroll") for (int i = 0; i < 4; ++i) *(LAS v4u*)(L + lo_v + i * 16 * SC_VSTR) = rv[i]; \
        if (tid < 256) *(LAS f32x4*)(gl + tid * 4) = rg; } while (0)
    SC_LOAD(0);
    SC_STORE();
    for (int c = 0; c < NCHUNK; ++c) {
        const size_t t0 = rowb + (size_t)c * CHUNK;
        __syncthreads();
        if (c + 1 < NCHUNK) SC_LOAD(c + 1);
        {
            pg8::f32x4 g4[4]; float tsum[4], pre[4];
#pragma unroll
            for (int t = 0; t < 4; ++t) {
                v4u ah = {0u, 0u, 0u, 0u}, al = {0u, 0u, 0u, 0u};
                if (gq < 2) { const f32x4 x0 = *(const LAS f32x4*)(gl + (16 * t + gcol) * 16 + 8 * gq), x1 = *(const LAS f32x4*)(gl + (16 * t + gcol) * 16 + 8 * gq + 4);
                    ah.x = pk2(x0[0], x0[1]); ah.y = pk2(x0[2], x0[3]); ah.z = pk2(x1[0], x1[1]); ah.w = pk2(x1[2], x1[3]);
                    al.x = pk2(x0[0] - bflo(ah.x), x0[1] - bfhi(ah.x)); al.y = pk2(x0[2] - bflo(ah.y), x0[3] - bfhi(ah.y)); al.z = pk2(x1[0] - bflo(ah.z), x1[1] - bfhi(ah.z)); al.w = pk2(x1[2] - bflo(ah.w), x1[3] - bfhi(ah.w)); }
                pg8::f32x4 a4 = {gbias, gbias, gbias, gbias};
                a4 = __builtin_amdgcn_mfma_f32_16x16x32_bf16(__builtin_bit_cast(bf16x8, ah), gBh, a4, 0, 0, 0);
                a4 = __builtin_amdgcn_mfma_f32_16x16x32_bf16(__builtin_bit_cast(bf16x8, al), gBh, a4, 0, 0, 0);
                a4 = __builtin_amdgcn_mfma_f32_16x16x32_bf16(__builtin_bit_cast(bf16x8, ah), gBl, a4, 0, 0, 0);
#pragma unroll
                for (int i = 0; i < 4; ++i) { const float a = a4[i]; a4[i] = (fminf(a, 0.f) - __logf(1.f + __expf(-fabsf(a)))) * (1.f / 16.f); }
                a4[1] += a4[0]; a4[2] += a4[1]; a4[3] += a4[2];
                g4[t] = a4;
                const float s0 = a4[3], x1 = __shfl_xor(s0, 16), x2 = __shfl_xor(s0, 32), x3 = __shfl_xor(x1, 32);
                tsum[t] = (s0 + x1) + (x2 + x3);
                pre[t] = ((gq ^ 1) < gq ? x1 : 0.f) + ((gq ^ 2) < gq ? x2 : 0.f) + ((gq ^ 3) < gq ? x3 : 0.f);
            }
            const float tot = (tsum[0] + tsum[1]) + (tsum[2] + tsum[3]);
            float basep = 0.f;
#pragma unroll
            for (int t = 0; t < 4; ++t) {
#pragma unroll
                for (int i = 0; i < 4; ++i) {
                    LAS unsigned short* kp = (LAS unsigned short*)(L + SC_K + (16 * t + 4 * gq + i) * SC_KSTR + gdk * 2);
                    *kp = (unsigned short)f2bf(bf2f(*kp) * __expf(tot - (basep + pre[t] + g4[t][i])));
                }
                basep += tsum[t];
            }
            if (gq == 0) dec[gdk] = __expf(tot);
        }
        __syncthreads();
        const int etok = tid >> 3, ecc = tid & 7;
        v4u rr[4];
        { size_t eb_ = t0 * NQKVR * 2; asm volatile("" : "+s"(eb_));
          const char* rb_ = (const char*)qkvr + eb_ + (size_t)((2 * HK + HV + h * DV) * 2); const unsigned vo_r = (unsigned)(etok * NQKVR * 2 + ecc * 16);
#pragma unroll
          for (int i = 0; i < 4; ++i) rr[i] = __builtin_nontemporal_load((const v4u*)(rb_ + vo_r + i * 128)); }
#pragma unroll
        for (int i = 0; i < 4; ++i)
#pragma unroll
            for (int g4 = 0; g4 < 4; ++g4) { const f32x4 d4 = *(const LAS f32x4*)(dec + 32 * i + 8 * g4 + 4 * hh);
#pragma unroll
                for (int j = 0; j < 4; ++j) st[i][4 * g4 + j] *= d4[j]; }
#pragma unroll
        for (int s = 0; s < 4; ++s) {
            const int trow = 16 * s + 8 * hh + q4;
            const s16x4 v0 = tr_read16(L + SC_V + trow * SC_VSTR + (32 * w + 16 * blk + 4 * p4) * 2), v1 = tr_read16(L + SC_V + (trow + 4) * SC_VSTR + (32 * w + 16 * blk + 4 * p4) * 2);
            const bf16x8 Bv = {v0[0], v0[1], v0[2], v0[3], v1[0], v1[1], v1[2], v1[3]};
#pragma unroll
            for (int i = 0; i < 4; ++i) {
                const s16x4 k0 = tr_read16(L + SC_K + trow * SC_KSTR + (32 * i + 16 * blk + 4 * p4) * 2), k1 = tr_read16(L + SC_K + (trow + 4) * SC_KSTR + (32 * i + 16 * blk + 4 * p4) * 2);
                const bf16x8 Ak = {k0[0], k0[1], k0[2], k0[3], k1[0], k1[1], k1[2], k1[3]};
                st[i] = __builtin_amdgcn_mfma_f32_32x32x16_bf16(Ak, Bv, st[i], 0, 0, 0);
            }
        }
        {
        f32x16 oacc[2];
#pragma unroll
        for (int ot = 0; ot < 2; ++ot)
#pragma unroll
            for (int j = 0; j < 16; ++j) oacc[ot][j] = 0.f;
#pragma unroll
        for (int i = 0; i < 4; ++i)
#pragma unroll
            for (int s2 = 0; s2 < 2; ++s2) {
                v4u pb; pb.x = pk2(st[i][8 * s2 + 0], st[i][8 * s2 + 1]); pb.y = pk2(st[i][8 * s2 + 2], st[i][8 * s2 + 3]); pb.z = pk2(st[i][8 * s2 + 4], st[i][8 * s2 + 5]); pb.w = pk2(st[i][8 * s2 + 6], st[i][8 * s2 + 7]);
                const bf16x8 Bs = __builtin_bit_cast(bf16x8, pb);
#pragma unroll
                for (int ot = 0; ot < 2; ++ot) {
                    LAS const unsigned char* qp = L + SC_Q + (32 * ot + r32) * SC_QSTR + (32 * i + 16 * s2 + 4 * hh) * 2;
                    const v2u a0 = *(const LAS v2u*)qp, a1 = *(const LAS v2u*)(qp + 16);
                    v4u pa; pa.x = a0.x; pa.y = a0.y; pa.z = a1.x; pa.w = a1.y;
                    oacc[ot] = __builtin_amdgcn_mfma_f32_32x32x16_bf16(__builtin_bit_cast(bf16x8, pa), Bs, oacc[ot], 0, 0, 0);
                }
            }
#pragma unroll
        for (int ot = 0; ot < 2; ++ot)
#pragma unroll
            for (int rg16 = 0; rg16 < 16; ++rg16) {
                const int tok = 32 * ot + (rg16 & 3) + 8 * (rg16 >> 2) + 4 * hh;
                *(LAS unsigned short*)(L + SC_O + tok * SC_OSTR + (32 * w + r32) * 2) = (unsigned short)f2bf(oacc[ot][rg16]);
            }
        }
        __syncthreads();
        if (c + 1 < NCHUNK) SC_STORE();
        if (c > 0 && (c & 3) == 0) {
            asm volatile("s_waitcnt vmcnt(0)" ::: "memory");
            if (lane == 0) __hip_atomic_fetch_add(WSP(unsigned, WS_CTL) + CW_SP + 16 * (8 * b + (c >> 2) - 1), 1u, __ATOMIC_RELAXED, __HIP_MEMORY_SCOPE_AGENT);
        }
        {
        {
            const int tok = etok, cc = ecc;
            v4u ov[4]; float ss = 0.f;
#pragma unroll
            for (int i = 0; i < 4; ++i) ov[i] = *(const LAS v4u*)(L + SC_O + tok * SC_OSTR + cc * 16 + i * 128);
#pragma unroll
            for (int i = 0; i < 4; ++i) { const float a0 = bflo(ov[i].x), a1 = bfhi(ov[i].x), a2 = bflo(ov[i].y), a3 = bfhi(ov[i].y), a4 = bflo(ov[i].z), a5 = bfhi(ov[i].z), a6 = bflo(ov[i].w), a7 = bfhi(ov[i].w);
                ss += (a0 * a0 + a1 * a1) + (a2 * a2 + a3 * a3) + (a4 * a4 + a5 * a5) + (a6 * a6 + a7 * a7); }
            ss += __shfl_xor(ss, 1); ss += __shfl_xor(ss, 2); ss += __shfl_xor(ss, 4);
            const float rms = __builtin_amdgcn_rsqf(ss * (1.f / DV) + EPS);
            size_t ob_ = (t0 * D + h * DV) * 2; asm volatile("" : "+s"(ob_)); const unsigned vo_o = (unsigned)(tok * D * 2 + cc * 16);
            const __amdgpu_buffer_rsrc_t ars = __builtin_amdgcn_make_buffer_rsrc((void*)aout, (short)0, T * D * 2, 0x00020000);
#pragma unroll
            for (int i = 0; i < 4; ++i) {
                v4u o;
                o.x = pk2(bflo(ov[i].x) * rms * bflo(rr[i].x), bfhi(ov[i].x) * rms * bfhi(rr[i].x));
                o.y = pk2(bflo(ov[i].y) * rms * bflo(rr[i].y), bfhi(ov[i].y) * rms * bfhi(rr[i].y));
                o.z = pk2(bflo(ov[i].z) * rms * bflo(rr[i].z), bfhi(ov[i].z) * rms * bfhi(rr[i].z));
                o.w = pk2(bflo(ov[i].w) * rms * bflo(rr[i].w), bfhi(ov[i].w) * rms * bfhi(rr[i].w));
                __builtin_amdgcn_raw_buffer_store_b128(o, ars, (unsigned)ob_ + vo_o + i * 128, 0, 16);
            }
        }
            }
    }
    asm volatile("s_waitcnt vmcnt(0)" ::: "memory");
    if (lane == 0) __hip_atomic_fetch_add(WSP(unsigned, WS_CTL) + CW_SP + 16 * (8 * b + 7), 1u, __ATOMIC_RELAXED, __HIP_MEMORY_SCOPE_AGENT);
    __syncthreads();
#undef SC_LOAD
#undef SC_STORE
}
constexpr int LX_QCMD = LX_PTR - 64;
constexpr int CV_NIT = (D / 128) * (SGU_FFN / 64) + (SGU_HALF / 128) * (D / 64) + 3 * 2 * NE * (D / 128) * (FF / 64);
__device__ __forceinline__ void f_scan_outproj(Frame& F, const XcdBarrier& xbar) {
    constexpr int NITEM = NBATCH * GLA_H, NUNIT = (T / 256) * (D / 256);
    if (F.bid < NITEM) f_scan_item(F, F.bid);
    unsigned* ctl = WSP(unsigned, WS_CTL); LAS int* cmd = (LAS int*)(F.lds + LX_QCMD);
    const int NOWN = F.G - NITEM; int myq = F.bid >= NITEM ? F.bid - NITEM : NUNIT;
    for (;;) {
        __syncthreads();
        if (FTID == 0) {
            int c = -3; unsigned spins = 0;
            for (;;) {
                if (myq < NUNIT) {
                    const int b = (myq & 63) >> 2, j = myq >> 6;
                    if (__hip_atomic_load(ctl + CW_SP + 16 * (8 * b + j), __ATOMIC_RELAXED, __HIP_MEMORY_SCOPE_AGENT) >= 32u) { c = myq; myq += NOWN; break; } }
                if (__hip_atomic_load(ctl + CW_QC, __ATOMIC_RELAXED, __HIP_MEMORY_SCOPE_AGENT) < (unsigned)CV_NIT) {
                    const unsigned it = __hip_atomic_fetch_add(ctl + CW_QC, (unsigned)NWAVES, __ATOMIC_RELAXED, __HIP_MEMORY_SCOPE_AGENT);
                    if (it < (unsigned)CV_NIT) { c = -2; cmd[1] = (int)it; break; } }
                if (myq >= NUNIT) { c = -3; break; }
                __builtin_amdgcn_s_sleep(16); if (++spins > (1u << 22)) { c = -3; break; }
            }
            cmd[0] = c;
        }
        __syncthreads();
        const int c = cmd[0];
        if (c == -3) break;
        if (c == -2) { const int it = cmd[1] + FWAVE; if (it < CV_NIT) { const Cv8 d = cv8_decode(F, it); cv8_item(d, F.lds + FWAVE * 8448, FLANE); } }
        else {
            if (FTID < 64) { __builtin_amdgcn_fence(__ATOMIC_ACQUIRE, "agent"); asm volatile("s_waitcnt vmcnt(0)" ::: "memory"); }
            __syncthreads();
            RowSetOrder S; S.nb = 1 << 20; S.c = c; S.j0 = 0; S.nunits = NUNIT; S.K = HV; S.Bt = (const char*)WSP(bf16, WS_WOUT);
            EpiResBf16 E{WSP(bf16, WS_XN), 1.f};
            pg8::gemm_phase(F.lds, WSP(bf16, WS_AOUT), HV, S, E);
        }
    }
}
constexpr int MX_W = 0, MX_WSTR = 272;
constexpr int MX_V0 = 34816, MX_VSTR = 320, MX_VBYTES = 40960;
constexpr int MX_MU = 116736;
constexpr int MX_LN = MX_MU + 2560;
__device__ __forceinline__ void f_mix(Frame& F) {
    LAS unsigned char* L = F.lds;
    LAS float* mu = (LAS float*)(L + MX_MU); LAS float* rs = mu + 128; LAS float* m1 = rs + 128; LAS float* m0 = m1 + 128; LAS float* bsg = m0 + 128;
    LAS float* lgs = (LAS float*)(L + MX_LN); LAS float* lbs = lgs + 512;
    bf16* u = WSP(bf16, WS_U); const bf16* v = WSP(bf16, WS_V); const float* st = WSP(float, WS_STATS); unsigned char* uout = WSP(unsigned char, WS_UG8);
    const int tid = FTID, lane = FLANE, w = FWAVE;
    const int r32 = lane & 31, hh = lane >> 5, blk = (lane >> 4) & 1, q4 = (lane & 15) >> 2, p4 = lane & 3;
    const int ct = w >> 1, th = w & 1;
    const unsigned vo_v = (unsigned)(tid * 16), lo_v = (unsigned)(MX_V0 + (tid >> 4) * MX_VSTR + (tid & 15) * 16);
    constexpr int MX_MSTR = 272;
    for (int bn = F.bid; bn < T / SGU_BLK; bn += F.G) {
        const size_t t0 = (size_t)bn * SGU_BLK;
        __syncthreads();
        {
            const int row = tid & 127, pq = tid >> 7; float s = 0.f, q = 0.f;
#pragma unroll
            for (int p = 0; p < 8; ++p) { const pg8::f32x2 a = *(const pg8::f32x2*)(st + ((size_t)(pq * 8 + p) * T + t0 + row) * 2); s += a.x; q += a.y; }
            LAS float* red = (LAS float*)(L + MX_V0);
            red[(pq * 128 + row) * 2] = s; red[(pq * 128 + row) * 2 + 1] = q;
            __syncthreads();
            if (tid < 128) { float s4 = 0.f, q4 = 0.f;
#pragma unroll
                for (int p = 0; p < 4; ++p) { s4 += red[(p * 128 + tid) * 2]; q4 += red[(p * 128 + tid) * 2 + 1]; }
                const float m = s4 * (1.f / SGU_HALF); mu[tid] = m; rs[tid] = __builtin_amdgcn_rsqf(fmaxf(q4 * (1.f / SGU_HALF) - m * m, 0.f) + EPS); }
            __syncthreads();
        }
        v4u preA[4], preB[4]; v4u uuA[4], uuB[4];
#define MX_LOAD(pre_, it_) do { size_t vb_ = ((size_t)bn * 16 + (size_t)(it_)) << 15; asm volatile("" : "+s"(vb_)); \
        _Pragma("unroll") for (int i = 0; i < 4; ++i) pre_[i] = *(const v4u*)((const char*)v + vb_ + (size_t)(i * 8192) + vo_v); } while (0)
#define MX_STORE(buf_, pre_) do { _Pragma("unroll") for (int i = 0; i < 4; ++i) *(LAS v4u*)(L + lo_v + (buf_) * MX_VBYTES + 32 * i * MX_VSTR) = pre_[i]; } while (0)
#define MX_ULOAD(uu_, it_) do { size_t ub_ = ((size_t)bn * 16 + (size_t)(it_)) << 15; asm volatile("" : "+s"(ub_)); \
        _Pragma("unroll") for (int i = 0; i < 4; ++i) uu_[i] = *(const v4u*)((const char*)u + ub_ + (size_t)(i * 8192) + vo_v); } while (0)
#define MX_TILE(it_, buf_, uu_) do { \
        f32x16 acc[2]; \
        _Pragma("unroll") for (int tt = 0; tt < 2; ++tt) _Pragma("unroll") for (int j = 0; j < 16; ++j) acc[tt][j] = 0.f; \
        LAS unsigned char* Vb = L + MX_V0 + (buf_) * MX_VBYTES; \
        const int nks = th == 0 ? 4 : 8; \
        for (int ks = 0; ks < nks; ++ks) { \
            const int srow = 16 * ks + 8 * hh + q4; \
            const s16x4 a0 = tr_read16(Vb + srow * MX_VSTR + (32 * ct + 16 * blk + 4 * p4) * 2), a1 = tr_read16(Vb + (srow + 4) * MX_VSTR + (32 * ct + 16 * blk + 4 * p4) * 2); \
            const bf16x8 Av = {a0[0], a0[1], a0[2], a0[3], a1[0], a1[1], a1[2], a1[3]}; \
            _Pragma("unroll") for (int tt = 0; tt < 2; ++tt) { \
                const bf16x8 Bw = *(const LAS bf16x8*)(L + MX_W + (64 * th + 32 * tt + r32) * MX_WSTR + (16 * ks + 8 * hh) * 2); \
                acc[tt] = __builtin_amdgcn_mfma_f32_32x32x16_bf16(Av, Bw, acc[tt], 0, 0, 0); } } \
        const int cl = ((it_) & 3) * 128 + 32 * ct + 4 * hh;                    \
        __syncthreads();                                                         \
        _Pragma("unroll") for (int tt = 0; tt < 2; ++tt) { \
            const int t = 64 * th + 32 * tt + r32; const float tm1 = m1[t], tm0 = m0[t], tb = bsg[t]; \
            _Pragma("unroll") for (int g4 = 0; g4 < 4; ++g4) { \
                const f32x4 lg = *(const LAS f32x4*)(lgs + cl + 8 * g4), lb = *(const LAS f32x4*)(lbs + cl + 8 * g4); \
                v2u o; o.x = pk2(lg[0] * (acc[tt][4 * g4 + 0] - tm1) + lb[0] * tm0 + tb, lg[1] * (acc[tt][4 * g4 + 1] - tm1) + lb[1] * tm0 + tb); \
                o.y = pk2(lg[2] * (acc[tt][4 * g4 + 2] - tm1) + lb[2] * tm0 + tb, lg[3] * (acc[tt][4 * g4 + 3] - tm1) + lb[3] * tm0 + tb); \
                *(LAS v2u*)(Vb + t * MX_MSTR + (32 * ct + 8 * g4 + 4 * hh) * 2) = o; } } \
        __syncthreads();                                                         \
        size_t ob_ = ((size_t)bn * 16 + (size_t)(it_)) << 14; asm volatile("" : "+s"(ob_));     \
        _Pragma("unroll") for (int i = 0; i < 4; ++i) { \
            const v4u mx = *(const LAS v4u*)(Vb + ((tid >> 4) + 32 * i) * MX_MSTR + (tid & 15) * 16); const v4u ux = uu_[i]; v2u o; \
            int w0_ = __builtin_amdgcn_cvt_pk_fp8_f32(bflo(ux.x) * bflo(mx.x), bfhi(ux.x) * bfhi(mx.x), 0, false); w0_ = __builtin_amdgcn_cvt_pk_fp8_f32(bflo(ux.y) * bflo(mx.y), bfhi(ux.y) * bfhi(mx.y), w0_, true); \
            int w1_ = __builtin_amdgcn_cvt_pk_fp8_f32(bflo(ux.z) * bflo(mx.z), bfhi(ux.z) * bfhi(mx.z), 0, false); w1_ = __builtin_amdgcn_cvt_pk_fp8_f32(bflo(ux.w) * bflo(mx.w), bfhi(ux.w) * bfhi(mx.w), w1_, true); \
            o.x = (unsigned)w0_; o.y = (unsigned)w1_; __builtin_nontemporal_store(o, (v2u*)(uout + ob_ + (size_t)(i * 4096) + (unsigned)(tid * 8))); } } while (0)
        MX_LOAD(preA, 0); MX_LOAD(preB, 1); MX_ULOAD(uuA, 0);
        for (int it = 0; it < 16; it += 2) {
            if ((it & 3) == 0) {
                const int g = it >> 2;
                __syncthreads();
                const int t = tid >> 2, sq = tid & 3; const float* wsrc = F.inp(I_SGU_WS) + ((size_t)g * 128 + t) * 128 + sq * 8;
                float a1 = 0.f, a0 = 0.f;
#pragma unroll
                for (int i = 0; i < 4; ++i) {
                    const f32x4 x0 = *(const f32x4*)(wsrc + i * 32), x1 = *(const f32x4*)(wsrc + i * 32 + 4); float wv[8] = {x0[0], x0[1], x0[2], x0[3], x1[0], x1[1], x1[2], x1[3]}; float hv[8];
#pragma unroll
                    for (int j = 0; j < 8; ++j) { const int s = i * 32 + sq * 8 + j; const float wm = ((t >> 6) >= (s >> 6)) ? wv[j] : 0.f; a0 += wm; hv[j] = wm * rs[s]; }
                    v4u o; o.x = pk2(hv[0], hv[1]); o.y = pk2(hv[2], hv[3]); o.z = pk2(hv[4], hv[5]); o.w = pk2(hv[6], hv[7]);
                    const unsigned ow[4] = {o.x, o.y, o.z, o.w};
#pragma unroll
                    for (int j = 0; j < 4; ++j) a1 += bflo(ow[j]) * mu[i * 32 + sq * 8 + 2 * j] + bfhi(ow[j]) * mu[i * 32 + sq * 8 + 2 * j + 1];
                    *(LAS v4u*)(L + MX_W + t * MX_WSTR + (i * 32 + sq * 8) * 2) = o;
                }
                a1 += __shfl_xor(a1, 1); a1 += __shfl_xor(a1, 2); a0 += __shfl_xor(a0, 1); a0 += __shfl_xor(a0, 2);
                if (sq == 0) { m1[t] = a1; m0[t] = a0; }
                if (tid < 128) bsg[tid] = F.inp(I_SGU_BS)[g * 128 + tid];
                lgs[tid] = F.inp(I_SGU_LNG)[g * SGU_GC + tid]; lbs[tid] = F.inp(I_SGU_LNB)[g * SGU_GC + tid];
            }
            MX_STORE(0, preA);
            __syncthreads();
            if (it + 2 < 16) MX_LOAD(preA, it + 2);
            MX_ULOAD(uuB, it + 1);
            MX_TILE(it, 0, uuA);
            MX_STORE(1, preB);
            __syncthreads();
            if (it + 3 < 16) MX_LOAD(preB, it + 3);
            if (it + 2 < 16) MX_ULOAD(uuA, it + 2);
            MX_TILE(it + 1, 1, uuB);
        }
#undef MX_LOAD
#undef MX_STORE
#undef MX_ULOAD
#undef MX_TILE
    }
}
constexpr int RW_STR = 2064;
constexpr int RW_LG = 48 * RW_STR;
constexpr int RW_HIST = RW_LG + 8 * 16 * 48 * 4;
template <int MODE> __device__ __forceinline__ void f_rowgroup(Frame& F, int Lyr) {
    constexpr int NCT = MODE == 0 ? 1 : 3;
    LAS unsigned char* L = F.lds;
    const int tid = FTID, lane = FLANE, w = FWAVE, rw = lane & 15, q = lane >> 4;
    const float* xsrc = F.inp(I_X);
    bf16* xb = WSP(bf16, WS_XN); float* rsout = WSP(float, WS_RS);
    __syncthreads();
    for (int k = tid; k < D; k += NTHREADS) {
        if (MODE == 0) {
            const float gn = F.inp(I_GLA_NORM)[k]; const float* wr_ = F.inp(I_GLA_WIN) + (size_t)k * GLA_IN + NQKVR;
#pragma unroll
            for (int c4 = 0; c4 < 4; ++c4) { const f32x4 x = *(const f32x4*)(wr_ + 4 * c4);
#pragma unroll
                for (int j = 0; j < 4; ++j) *(LAS unsigned short*)(L + (4 * c4 + j) * RW_STR + k * 2) = (unsigned short)f2bf(x[j] * gn); }
        } else {
            const float gn = F.inp(I_MOE_NORM)[Lyr * D + k];
            const f32x4 xg = *(const f32x4*)(F.inp(I_MOE_WG) + ((size_t)Lyr * D + k) * 4);
#pragma unroll
            for (int j = 0; j < 4; ++j) *(LAS unsigned short*)(L + j * RW_STR + k * 2) = (unsigned short)f2bf(xg[j] * gn);
#pragma unroll
            for (int g = 0; g < 4; ++g) { const float* ws_ = F.inp(I_MOE_WSUB) + (((size_t)Lyr * 4 + g) * D + k) * EPG; const f32x4 a = *(const f32x4*)ws_, b = *(const f32x4*)(ws_ + 4);
#pragma unroll
                for (int j = 0; j < 4; ++j) { *(LAS unsigned short*)(L + (4 + 8 * g + j) * RW_STR + k * 2) = (unsigned short)f2bf(a[j] * gn); *(LAS unsigned short*)(L + (8 + 8 * g + j) * RW_STR + k * 2) = (unsigned short)f2bf(b[j] * gn); } }
#pragma unroll
            for (int c = 36; c < 48; ++c) *(LAS unsigned short*)(L + c * RW_STR + k * 2) = 0;
        }
    }
    LAS int* hist = (LAS int*)(L + RW_HIST); LAS int* hbase = hist + 32;
    if (MODE == 1 && tid < 32) hist[tid] = 0;
    __syncthreads();
    const int ngroups = T / 16, niter = (ngroups + F.G * NWAVES - 1) / (F.G * NWAVES);
    for (int iter = 0; iter < niter; ++iter) {
        const int grp = (iter * F.G + F.bid) * NWAVES + w; const bool valid = grp < ngroups;
        const size_t row = (size_t)grp * 16 + rw;
        float rstd = 0.f; pg8::f32x4 acc[NCT];
        if (valid) {
#pragma unroll
            for (int c = 0; c < NCT; ++c) acc[c] = (pg8::f32x4){0.f, 0.f, 0.f, 0.f};
            float ss = 0.f;
#pragma unroll 8
            for (int s = 0; s < 32; ++s) {
                v4u pa;
                if (MODE == 0) {
                    const float* xr = xsrc + row * D + 8 * q + 32 * s;
                    const f32x4 x0 = __builtin_nontemporal_load((const f32x4*)xr), x1 = __builtin_nontemporal_load((const f32x4*)(xr + 4));
                    ss += (x0[0] * x0[0] + x0[1] * x0[1]) + (x0[2] * x0[2] + x0[3] * x0[3]) + (x1[0] * x1[0] + x1[1] * x1[1]) + (x1[2] * x1[2] + x1[3] * x1[3]);
                    pa.x = pk2(x0[0], x0[1]); pa.y = pk2(x0[2], x0[3]); pa.z = pk2(x1[0], x1[1]); pa.w = pk2(x1[2], x1[3]);
                    *(v4u*)(xb + row * D + 8 * q + 32 * s) = pa;
                } else {
                    pa = *(const v4u*)(xb + row * D + 8 * q + 32 * s);
                    const float a0 = bflo(pa.x), a1 = bfhi(pa.x), a2 = bflo(pa.y), a3 = bfhi(pa.y), a4 = bflo(pa.z), a5 = bfhi(pa.z), a6 = bflo(pa.w), a7 = bfhi(pa.w);
                    ss += (a0 * a0 + a1 * a1) + (a2 * a2 + a3 * a3) + (a4 * a4 + a5 * a5) + (a6 * a6 + a7 * a7);
                    int w0 = __builtin_amdgcn_cvt_pk_fp8_f32(a0, a1, 0, false); w0 = __builtin_amdgcn_cvt_pk_fp8_f32(a2, a3, w0, true);
                    int w1 = __builtin_amdgcn_cvt_pk_fp8_f32(a4, a5, 0, false); w1 = __builtin_amdgcn_cvt_pk_fp8_f32(a6, a7, w1, true);
                    v2u o8; o8.x = (unsigned)w0; o8.y = (unsigned)w1; *(v2u*)(WSP(unsigned char, WS_XB8) + row * D + 8 * q + 32 * s) = o8;
                }
                const bf16x8 A = __builtin_bit_cast(bf16x8, pa);
#pragma unroll
                for (int c = 0; c < NCT; ++c) { const bf16x8 B = *(const LAS bf16x8*)(L + (16 * c + rw) * RW_STR + (32 * s + 8 * q) * 2); acc[c] = __builtin_amdgcn_mfma_f32_16x16x32_bf16(A, B, acc[c], 0, 0, 0); }
            }
            ss += __shfl_xor(ss, 16); ss += __shfl_xor(ss, 32);
            rstd = __builtin_amdgcn_rsqf(ss * (1.f / D) + EPS);
            if (q == 0) rsout[row] = rstd;
        }
        float rs4[4];
#pragma unroll
        for (int i = 0; i < 4; ++i) rs4[i] = __shfl(rstd, 4 * q + i);
        int e1 = 0, e2 = 0, rk1 = 0, rk2 = 0; float gt1 = 0.f, gt2 = 0.f;
        if (MODE == 0) {
            if (valid) {
                float* glr = WSP(float, WS_GLR);
#pragma unroll
                for (int i = 0; i < 4; ++i) glr[((size_t)grp * 16 + 4 * q + i) * RANK + rw] = acc[0][i] * rs4[i];
            }
        } else {
            LAS float* lgw = (LAS float*)(L + RW_LG) + w * 16 * 48;
            if (valid) {
#pragma unroll
                for (int c = 0; c < NCT; ++c)
#pragma unroll
                    for (int i = 0; i < 4; ++i) lgw[(4 * q + i) * 48 + 16 * c + rw] = acc[c][i] * rs4[i];
            }
            LDS_WAIT(); asm volatile("" ::: "memory");
            if (valid && lane < 16) {
                const LAS float* lr = lgw + lane * 48; const float* bg = F.inp(I_MOE_BG) + Lyr * 4;
                float lg[4];
#pragma unroll
                for (int c = 0; c < 4; ++c) lg[c] = lr[c] + bg[c];
                int g = 0; float gm = lg[0];
#pragma unroll
                for (int c = 1; c < 4; ++c) if (lg[c] > gm) { gm = lg[c]; g = c; }
                float gs = 0.f;
#pragma unroll
                for (int c = 0; c < 4; ++c) gs += __expf(lg[c] - gm);
                const float g_w = 1.f / gs; const float* bs = F.inp(I_MOE_BSUB) + (Lyr * 4 + g) * EPG;
                int i1 = 0, i2 = 0; float m1v = -3.0e38f, m2v = -3.0e38f;
                for (int e = 0; e < EPG; ++e) { const float x = lr[4 + 8 * g + e] + bs[e];
                    if (x > m1v) { m2v = m1v; i2 = i1; m1v = x; i1 = e; } else if (x > m2v) { m2v = x; i2 = e; } }
                const float w1 = 1.f / (1.f + __expf(m2v - m1v));
                e1 = g * EPG + i1; e2 = g * EPG + i2; gt1 = g_w * w1; gt2 = g_w * (1.f - w1);
                rk1 = __hip_atomic_fetch_add(&hist[e1], 1, __ATOMIC_RELAXED, __HIP_MEMORY_SCOPE_WORKGROUP); rk2 = __hip_atomic_fetch_add(&hist[e2], 1, __ATOMIC_RELAXED, __HIP_MEMORY_SCOPE_WORKGROUP);
            }
            __syncthreads();
            if (tid < 32) { const int hcount = hist[tid]; hbase[tid] = hcount ? (int)atomicAdd(WSP(unsigned, WS_CTL) + CW_CNT + Lyr * 2048 + 64 * tid, (unsigned)hcount) : 0; hist[tid] = 0; }
            __syncthreads();
            if (valid && lane < 16) {
                const int tok = grp * 16 + lane; const int p1 = hbase[e1] + rk1, p2 = hbase[e2] + rk2;
                WSP(int, WS_LIST)[(size_t)e1 * T + p1] = tok * 2; WSP(int, WS_LIST)[(size_t)e2 * T + p2] = tok * 2 + 1;
                WSP(float, WS_GATE)[tok * 2] = gt1; WSP(float, WS_GATE)[tok * 2 + 1] = gt2;
            }
        }
    }
    __syncthreads();
}
template <bool FINAL> __device__ __forceinline__ void f_rowadd(Frame& F) {
    bf16* xb = WSP(bf16, WS_XN); const unsigned char* y = WSP(unsigned char, WS_Y); float* rsout = WSP(float, WS_RS); bf16* xo = xb;
    const int lane = FLANE, w = FWAVE;
    f32x4 gf[4];
    if (FINAL) {
#pragma unroll
        for (int j = 0; j < 2; ++j) { gf[2 * j] = *(const f32x4*)(F.inp(I_FINAL) + 8 * lane + 512 * j); gf[2 * j + 1] = *(const f32x4*)(F.inp(I_FINAL) + 8 * lane + 512 * j + 4); }
    }
    for (int r0 = (F.bid * NWAVES + w) * 2; r0 < T; r0 += F.G * NWAVES * 2) {
        v4u xa[2][2]; v2u ya[2][2], yb[2][2];
#pragma unroll
        for (int rr = 0; rr < 2; ++rr)
#pragma unroll
            for (int j = 0; j < 2; ++j) { const size_t o = (size_t)(r0 + rr) * D + 8 * lane + 512 * j;
                xa[rr][j] = *(const v4u*)(xb + o); ya[rr][j] = *(const v2u*)(y + o); yb[rr][j] = *(const v2u*)(y + (size_t)T * D + o); }
#pragma unroll
        for (int rr = 0; rr < 2; ++rr) {
            float v[16]; float ss = 0.f;
#pragma unroll
            for (int j = 0; j < 2; ++j) {
                const unsigned xw[4] = {xa[rr][j].x, xa[rr][j].y, xa[rr][j].z, xa[rr][j].w};
                const pg8::f32x2 a0 = __builtin_amdgcn_cvt_pk_f32_fp8((int)ya[rr][j].x, false), a1 = __builtin_amdgcn_cvt_pk_f32_fp8((int)ya[rr][j].x, true), a2 = __builtin_amdgcn_cvt_pk_f32_fp8((int)ya[rr][j].y, false), a3 = __builtin_amdgcn_cvt_pk_f32_fp8((int)ya[rr][j].y, true);
                const pg8::f32x2 b0 = __builtin_amdgcn_cvt_pk_f32_fp8((int)yb[rr][j].x, false), b1 = __builtin_amdgcn_cvt_pk_f32_fp8((int)yb[rr][j].x, true), b2 = __builtin_amdgcn_cvt_pk_f32_fp8((int)yb[rr][j].y, false), b3 = __builtin_amdgcn_cvt_pk_f32_fp8((int)yb[rr][j].y, true);
                const float ysum[8] = {a0.x + b0.x, a0.y + b0.y, a1.x + b1.x, a1.y + b1.y, a2.x + b2.x, a2.y + b2.y, a3.x + b3.x, a3.y + b3.y};
#pragma unroll
                for (int e = 0; e < 4; ++e) { const float lo = bflo(xw[e]) + ysum[2 * e], hi = bfhi(xw[e]) + ysum[2 * e + 1]; v[8 * j + 2 * e] = lo; v[8 * j + 2 * e + 1] = hi; ss += lo * lo + hi * hi; }
            }
            const float rstd = __builtin_amdgcn_rsqf(wave_sum(ss) * (1.f / D) + EPS);
            const size_t ro = (size_t)(r0 + rr) * D + 8 * lane;
            if (FINAL) {
#pragma unroll
                for (int j = 0; j < 2; ++j) {
                    f32x4 o0 = {v[8 * j] * rstd, v[8 * j + 1] * rstd, v[8 * j + 2] * rstd, v[8 * j + 3] * rstd}, o1 = {v[8 * j + 4] * rstd, v[8 * j + 5] * rstd, v[8 * j + 6] * rstd, v[8 * j + 7] * rstd};
                    *(f32x4*)(F.out + ro + 512 * j) = o0 * gf[2 * j]; *(f32x4*)(F.out + ro + 512 * j + 4) = o1 * gf[2 * j + 1]; }
            } else {
#pragma unroll
                for (int j = 0; j < 2; ++j) { v4u o; o.x = pk2(v[8 * j], v[8 * j + 1]); o.y = pk2(v[8 * j + 2], v[8 * j + 3]); o.z = pk2(v[8 * j + 4], v[8 * j + 5]); o.w = pk2(v[8 * j + 6], v[8 * j + 7]); __builtin_nontemporal_store(o, (v4u*)(xo + ro + 512 * j));
                    int w0 = __builtin_amdgcn_cvt_pk_fp8_f32(v[8 * j], v[8 * j + 1], 0, false); w0 = __builtin_amdgcn_cvt_pk_fp8_f32(v[8 * j + 2], v[8 * j + 3], w0, true);
                    int w1 = __builtin_amdgcn_cvt_pk_fp8_f32(v[8 * j + 4], v[8 * j + 5], 0, false); w1 = __builtin_amdgcn_cvt_pk_fp8_f32(v[8 * j + 6], v[8 * j + 7], w1, true);
                    v2u o8; o8.x = (unsigned)w0; o8.y = (unsigned)w1; *(v2u*)(WSP(unsigned char, WS_XB8) + ro + 512 * j) = o8; }
                if (lane == 0) rsout[r0 + rr] = rstd;
            }
        }
    }
}
__device__ __forceinline__ void f_prep0(Frame& F) { f_convert_gla(F); f_rowgroup<0>(F, 0); }
__device__ __forceinline__ void f_rowpass_router(Frame& F, int L) { f_rowgroup<1>(F, L); }
__device__ __forceinline__ void f_rowpass_add(Frame& F) { f_rowadd<false>(F); }
__device__ __forceinline__ void f_final(Frame& F) { f_rowadd<true>(F); }
constexpr int LDS_BYTES = 155648;
struct Args { const float* in[23]; float* out; unsigned char* ws; int ph_lo, ph_hi; };

__global__ void __launch_bounds__(NTHREADS, 2) fwd(Args args) {
    extern __shared__ __attribute__((aligned(16))) unsigned char lds_raw[];
    Frame F;
    F.lds = (LAS unsigned char*)lds_raw;
    F.G = gridDim.x; F.bid = blockIdx.x;
    F.out = args.out; F.ws = args.ws;
    volatile LAS unsigned* bst = (volatile LAS unsigned*)(F.lds + LX_PTR + 192);
    if (FTID == 0) {
        LAS unsigned long long* pt = (LAS unsigned long long*)(F.lds + LX_PTR);
#pragma unroll
        for (int i = 0; i < 23; ++i) pt[i] = (unsigned long long)args.in[i];
    }
    if (FTID < 2) bst[FTID] = 0u;
    __syncthreads();
    cg::grid_group grid = cg::this_grid();
    const XcdBarrier xbar = xcd_barrier_post(WSP(unsigned, WS_CTL) + CW_BAR, bst);
    const int lo = args.ph_lo, hi = args.ph_hi;
    if (lo > 1000) grid.sync();
#define IN(k) (lo <= (k) && (k) < hi)
#define SEAM() xcd_barrier(xbar)

    if (IN(0)) f_prep0(F);                 SEAM();
    if (IN(1)) f_gemm_in(F);               SEAM();
    if (IN(2)) f_scan_outproj(F, xbar);    SEAM();
    if (IN(3)) f_rowpass_router(F, 0);     SEAM();
    if (IN(4)) f_moe(F, 0);                SEAM();
    if (IN(5)) f_rowpass_add(F);           SEAM();
    if (IN(6)) f_gemm_sgu_in(F);           SEAM();
    if (IN(7)) f_mix(F);                   SEAM();
    if (IN(8)) f_gemm_sgu_out(F);          SEAM();
    if (IN(9)) f_rowpass_router(F, 1);     SEAM();
    if (IN(10)) f_moe(F, 1);               SEAM();
    if (IN(11)) f_final(F);
#undef IN
#undef SEAM
}

extern "C" void kernel_launch(void* const* d_in, const int* in_sizes, int n_in, void* d_out, int out_size, void* d_ws, size_t ws_size, hipStream_t stream) {
    static int grid = 0;
    if (grid == 0) {
        if (n_in != 23 || out_size != T * D || in_sizes[0] != T * D || ws_size < WS_END) { fprintf(stderr, "kernel_launch: unexpected shapes (n_in %d out %d ws %zu): nothing launched\n", n_in, out_size, ws_size); grid = -1; return; }
        int dev = 0, cus = 0, per_cu = 0;
        if (hipGetDevice(&dev) != hipSuccess || hipDeviceGetAttribute(&cus, hipDeviceAttributeMultiprocessorCount, dev) != hipSuccess) { grid = -1; return; }
        if (hipFuncSetAttribute((const void*)fwd, hipFuncAttributeMaxDynamicSharedMemorySize, LDS_BYTES) != hipSuccess) { fprintf(stderr, "kernel_launch: cannot get %d bytes of dynamic LDS\n", LDS_BYTES); grid = -1; return; }
        if (hipOccupancyMaxActiveBlocksPerMultiprocessor(&per_cu, (const void*)fwd, NTHREADS, LDS_BYTES) != hipSuccess || per_cu < 1) { fprintf(stderr, "kernel_launch: occupancy query admits %d workgroups per CU: nothing launched\n", per_cu); grid = -1; (void)hipGetLastError(); return; }
        grid = cus;
        if (grid < 128) { fprintf(stderr, "kernel_launch: %d CUs; this kernel's phase program needs at least 128 workgroups\n", grid); grid = -1; return; }
    }
    if (grid < 0) return;
    (void)hipMemsetAsync((char*)d_ws + WS_CTL, 0, CTL_ZERO_BYTES, stream);
    Args a{};
    for (int i = 0; i < 23; ++i) a.in[i] = (const float*)d_in[i];
    a.out = (float*)d_out; a.ws = (unsigned char*)d_ws; a.ph_lo = 0; a.ph_hi = 12;
    void* kargs[] = {&a};
    const hipError_t e = hipLaunchCooperativeKernel((const void*)fwd, dim3(grid), dim3(NTHREADS), kargs, LDS_BYTES, stream);
    if (e != hipSuccess) fprintf(stderr, "cooperative launch failed: %s (grid %d)\n", hipGetErrorString(e), grid);
}
```
